# Optimizing an MI355X kernel written in HIP

```python
import math
import jax, jax.numpy as jnp
from jax import lax
import numpy as np

D_MODEL = 1024
BATCH = 16
SEQ = 256
DEPTH = 4
DEC_BATCH = 2
DEC_SEQ = 4096
PAST_LEN = 512

GRID_W = 64
HEAD_DIM = 64
A_HEADS = 6
A_KV_HEADS = 2
A_GROUP = A_HEADS // A_KV_HEADS
A_WIDTH = A_HEADS * HEAD_DIM
WINDOW = 128
BLK = 128
B_HEADS = 4
B_QK_DIM = 32
B_V_DIM = 2 * B_QK_DIM
B_WIDTH = B_HEADS * B_V_DIM
C_HEADS = 6
C_HEAD_DIM = 64
C_WIDTH = C_HEADS * C_HEAD_DIM
C_W_RANK = 64
C_A_RANK = 64
C_G_RANK = 128
MIX_W = A_WIDTH + B_WIDTH + C_WIDTH
D_FF = -(-8 * D_MODEL // (3 * 256)) * 256
IN_SPLITS = (A_WIDTH, A_KV_HEADS * HEAD_DIM, A_KV_HEADS * HEAD_DIM,
             B_WIDTH, B_WIDTH, B_WIDTH,
             3 * C_WIDTH, 2 * C_W_RANK, 2 * C_A_RANK, C_G_RANK)
IN_COLS = sum(IN_SPLITS)
ROPE_THETA = 10000.0
NORM_EPS = 1e-6
GN_EPS = 64e-5
DECAY_SCALE = 0.606531
NEG_INF = -1e30

kernel_name = "hybrid_prefix_diffusion_step"


def rmsnorm(x, g):
    xf = x.astype(jnp.float32)
    y = xf * lax.rsqrt(jnp.mean(xf * xf, axis=-1, keepdims=True) + NORM_EPS)
    return (y * g.astype(jnp.float32)).astype(x.dtype)


def rope_1d(x, pos):
    d = x.shape[-1]
    inv = ROPE_THETA ** (-jnp.arange(0, d, 2, dtype=jnp.float32) / d)
    ang = pos.astype(jnp.float32)[:, None] * inv[None, :]
    ang = jnp.concatenate([ang, ang], axis=-1)
    shape = (x.shape[1],) + (1,) * (x.ndim - 3) + (d,)
    cos = jnp.cos(ang).reshape(shape).astype(x.dtype)
    sin = jnp.sin(ang).reshape(shape).astype(x.dtype)
    x1, x2 = jnp.split(x, 2, axis=-1)
    return x * cos + jnp.concatenate([-x2, x1], axis=-1) * sin


def axial_rope(x):
    n_rows = x.shape[1] // GRID_W
    rows = jnp.repeat(jnp.arange(n_rows), GRID_W)
    cols = jnp.tile(jnp.arange(GRID_W), n_rows)
    xr, xc = jnp.split(x, 2, axis=-1)
    return jnp.concatenate([rope_1d(xr, rows), rope_1d(xc, cols)], axis=-1)


def short_conv3(x, w):
    xp = jnp.pad(x, ((0, 0), (1, 1), (0, 0)))
    return xp[:, :-2] * w[0] + xp[:, 1:-1] * w[1] + xp[:, 2:] * w[2]


def adaln(cvec, w, b):
    m = jax.nn.silu(cvec) @ w + b
    return jnp.split(m[:, None, :], 6, axis=-1)


def swiglu(h, w1, w3, w2):
    return (jax.nn.silu(h @ w1) * (h @ w3)) @ w2


def to_blocks(q):
    b, t = q.shape[:2]
    return jnp.moveaxis(q.reshape((b, t // BLK, BLK) + q.shape[2:]), 1, 0)


def from_blocks(o):
    nb, b = o.shape[:2]
    return jnp.moveaxis(o, 0, 1).reshape((b, nb * BLK) + o.shape[3:])


def sink_attend(q, k, v, sink, mask):
    s = jnp.einsum('bqhgd,bshd->bhgqs', q, k, preferred_element_type=jnp.float32) * (HEAD_DIM ** -0.5)
    if mask is not None:
        s = jnp.where(mask, s, NEG_INF)
    sk = jnp.broadcast_to(sink.astype(jnp.float32)[None, :, :, None, None], s.shape[:-1] + (1,))
    p = jax.nn.softmax(jnp.concatenate([s, sk], axis=-1), axis=-1)[..., :-1]
    return jnp.einsum('bhgqs,bshd->bqhgd', p.astype(v.dtype), v)


def window_attn_context(q, k, v, sink):
    return from_blocks(lax.map(lambda qb: sink_attend(qb, k, v, sink, None), to_blocks(q)))


def window_attn_latent(q, k, v, kc, vc, sink):
    t = q.shape[1]
    c_len = kc.shape[1]
    pad = ((0, 0), (BLK, BLK), (0, 0), (0, 0))
    kp = jnp.pad(k, pad)
    vp = jnp.pad(v, pad)
    qi = jnp.arange(BLK)[:, None]
    kj = jnp.arange(3 * BLK)[None, :]
    ctx_mask = jnp.ones((BLK, c_len), dtype=bool)

    def blk(args):
        qb, b = args
        start = b * BLK
        kw = lax.dynamic_slice_in_dim(kp, start, 3 * BLK, axis=1)
        vw = lax.dynamic_slice_in_dim(vp, start, 3 * BLK, axis=1)
        pos = start - BLK + kj
        win = (jnp.abs(kj - BLK - qi) <= WINDOW) & (pos >= 0) & (pos < t)
        mask = jnp.concatenate([win, ctx_mask], axis=1)
        return sink_attend(qb, jnp.concatenate([kw, kc], axis=1), jnp.concatenate([vw, vc], axis=1), sink, mask)

    return from_blocks(lax.map(blk, (to_blocks(q), jnp.arange(t // BLK))))


def diff_lambda(lp, lam_init):
    lp = lp.astype(jnp.float32)
    return jnp.exp(jnp.sum(lp[0] * lp[1])) - jnp.exp(jnp.sum(lp[2] * lp[3])) + lam_init


def diff_attend(q, k, v, lam):
    def blk(qb):
        s = jnp.einsum('bqhmd,bshmd->bhmqs', qb, k, preferred_element_type=jnp.float32) * (B_QK_DIM ** -0.5)
        p = jax.nn.softmax(s, axis=-1)
        a = p[:, :, 0] - lam * p[:, :, 1]
        return jnp.einsum('bhqs,bshd->bqhd', a.astype(v.dtype), v)
    return from_blocks(lax.map(blk, to_blocks(q)))


def wkv_scan(s0, r, w, k, v, kk, a, reverse):
    xs = tuple(jnp.moveaxis(t, 1, 0) for t in (r, w, k, v, kk, a))

    def step(s, inp):
        rt, wt, kt, vt, kkt, at = inp
        sa = jnp.einsum('bhij,bhj->bhi', s, -kkt)
        s = s * wt[:, :, None, :] + sa[..., None] * (kkt * at)[:, :, None, :] + vt[..., None] * kt[:, :, None, :]
        return s, jnp.einsum('bhij,bhj->bhi', s, rt)

    s, y = lax.scan(step, s0, xs, reverse=reverse)
    return s, jnp.moveaxis(y, 0, 1)


def rwkv_mix(rkv, cw, ca, cg, p, s_f, s_b):
    b, t = rkv.shape[:2]
    f32 = jnp.float32
    hs = lambda z: z.reshape(z.shape[:-1] + (C_HEADS, C_HEAD_DIM))
    r, k, v = [hs(z.astype(f32)) for z in jnp.split(rkv, 3, axis=-1)]
    cw = cw.astype(f32).reshape(b, t, 2, C_W_RANK)
    ca = ca.astype(f32).reshape(b, t, 2, C_A_RANK)
    w = jnp.exp(-DECAY_SCALE * jax.nn.sigmoid(p['c_w0'] + jnp.einsum('btdr,drc->btdc', jnp.tanh(cw), p['c_w2'])))
    a = jax.nn.sigmoid(p['c_a0'] + jnp.einsum('btdr,drc->btdc', ca, p['c_a2']))
    w, a = hs(w), hs(a)
    kk = k * hs(p['c_kk']).astype(f32)
    kk = kk / jnp.maximum(jnp.sqrt(jnp.sum(kk * kk, axis=-1, keepdims=True)), 1e-12)
    kd = k[:, :, None] * (1.0 + (a - 1.0) * hs(p['c_ka']).astype(f32))
    s_f, y_f = wkv_scan(s_f, r, w[:, :, 0], kd[:, :, 0], v, kk, a[:, :, 0], False)
    s_b, y_b = wkv_scan(s_b, r, w[:, :, 1], kd[:, :, 1], v, kk, a[:, :, 1], True)
    bonus = jnp.sum(jnp.sum(r[:, :, None] * kd * p['c_rk'].astype(f32), axis=-1, keepdims=True) * v[:, :, None], axis=2)
    y = y_f + y_b + bonus
    mu = jnp.mean(y, axis=-1, keepdims=True)
    var = jnp.mean(jnp.square(y - mu), axis=-1, keepdims=True)
    y = ((y - mu) * lax.rsqrt(var + GN_EPS)).reshape(b, t, C_WIDTH) * p['c_lnx_g'] + p['c_lnx_b']
    g = jax.nn.sigmoid(cg) @ p['c_g2']
    return (y * g).astype(rkv.dtype), s_f, s_b


def project(h, p, latent):
    b, t = h.shape[:2]
    z = h @ p['w_in']
    idx = np.cumsum(IN_SPLITS)[:-1].tolist()
    aq, ak, av, bq, bk, bv, rkv, cw, ca, cg = jnp.split(z, idx, axis=-1)
    aq = aq.reshape(b, t, A_KV_HEADS, A_GROUP, HEAD_DIM)
    ak = ak.reshape(b, t, A_KV_HEADS, HEAD_DIM)
    av = av.reshape(b, t, A_KV_HEADS, HEAD_DIM)
    bq = bq.reshape(b, t, B_HEADS, 2, B_QK_DIM)
    bk = bk.reshape(b, t, B_HEADS, 2, B_QK_DIM)
    bv = bv.reshape(b, t, B_HEADS, B_V_DIM)
    if latent:
        aq, ak, bq, bk = axial_rope(aq), axial_rope(ak), axial_rope(bq), axial_rope(bk)
    rkv = short_conv3(rkv, p['c_conv'])
    return aq, ak, av, bq, bk, bv, rkv, cw, ca, cg


def merge_out(a_o, b_o, c_o, p, lam_init):
    b, t = c_o.shape[:2]
    b_o = rmsnorm(b_o, p['b_subln_g']) * (1.0 - lam_init)
    m = jnp.concatenate([a_o.reshape(b, t, A_WIDTH), b_o.reshape(b, t, B_WIDTH), c_o], axis=-1)
    return m @ p['w_out']


def mixers_context(h, p, l):
    aq, ak, av, bq, bk, bv, rkv, cw, ca, cg = project(h, p, False)
    lam_init = 0.8 - 0.6 * math.exp(-0.3 * l)
    lam = diff_lambda(p['b_lambda'], lam_init)
    a_o = window_attn_context(aq, ak, av, p['a_sink'].reshape(A_KV_HEADS, A_GROUP))
    b_o = diff_attend(bq, bk, bv, lam)
    s0 = jnp.zeros((h.shape[0], C_HEADS, C_HEAD_DIM, C_HEAD_DIM), jnp.float32)
    c_o, s_f, s_b = rwkv_mix(rkv, cw, ca, cg, p, s0, s0)
    return merge_out(a_o, b_o, c_o, p, lam_init), (ak, av, bk, bv, s_f, s_b)


def mixers_latent(h, p, l, ctx):
    kc_a, vc_a, kc_b, vc_b, s_f, s_b = ctx
    aq, ak, av, bq, bk, bv, rkv, cw, ca, cg = project(h, p, True)
    lam_init = 0.8 - 0.6 * math.exp(-0.3 * l)
    lam = diff_lambda(p['b_lambda'], lam_init)
    a_o = window_attn_latent(aq, ak, av, kc_a, vc_a, p['a_sink'].reshape(A_KV_HEADS, A_GROUP))
    b_o = diff_attend(bq, jnp.concatenate([bk, kc_b], axis=1), jnp.concatenate([bv, vc_b], axis=1), lam)
    c_o, _, _ = rwkv_mix(rkv, cw, ca, cg, p, s_f.astype(jnp.float32), s_b.astype(jnp.float32))
    return merge_out(a_o, b_o, c_o, p, lam_init)


def block(x, cvec, p, mixer):
    sh1, sc1, g1, sh2, sc2, g2 = adaln(cvec, p['ada_w'], p['ada_b'])
    h = rmsnorm(x, p['norm1_g']) * (1 + sc1) + sh1
    m, extra = mixer(h)
    x = x + g1 * m
    h = rmsnorm(x, p['norm2_g']) * (1 + sc2) + sh2
    x = x + g2 * swiglu(h, p['ffn_w1'], p['ffn_w3'], p['ffn_w2'])
    return x, extra


def setup_inputs(seed: int = 0) -> dict:
    key = jax.random.key(seed)
    ks = iter(jax.random.split(key, 40))

    def nrm(shape, scale):
        return jax.random.normal(next(ks), shape, jnp.float32) * scale

    L = DEPTH
    return {
        "x_prompt": nrm((BATCH, SEQ, D_MODEL), 1.0),
        "x_sample": nrm((DEC_BATCH, DEC_SEQ, D_MODEL), 1.0),
        "cache_a_k": nrm((DEC_BATCH, L, PAST_LEN, A_KV_HEADS, HEAD_DIM), 1.0),
        "cache_a_v": nrm((DEC_BATCH, L, PAST_LEN, A_KV_HEADS, HEAD_DIM), 1.0),
        "cache_b_k": nrm((DEC_BATCH, L, PAST_LEN, B_HEADS, 2, B_QK_DIM), 1.0),
        "cache_b_v": nrm((DEC_BATCH, L, PAST_LEN, B_HEADS, B_V_DIM), 1.0),
        "state_c_fwd": nrm((DEC_BATCH, L, C_HEADS, C_HEAD_DIM, C_HEAD_DIM), 0.3),
        "state_c_bwd": nrm((DEC_BATCH, L, C_HEADS, C_HEAD_DIM, C_HEAD_DIM), 0.3),
        "c": nrm((DEC_BATCH, D_MODEL), 1.0),
        "c_ctx": nrm((D_MODEL,), 1.0),
        "ada_w": nrm((L, D_MODEL, 6 * D_MODEL), 0.5 * D_MODEL ** -0.5),
        "ada_b": nrm((L, 6 * D_MODEL), 0.02),
        "norm1_g": 1.0 + nrm((L, D_MODEL), 0.02),
        "norm2_g": 1.0 + nrm((L, D_MODEL), 0.02),
        "w_in": nrm((L, D_MODEL, IN_COLS), D_MODEL ** -0.5),
        "a_sink": nrm((L, A_HEADS), 0.5),
        "b_lambda": nrm((L, 4, B_QK_DIM), 0.1),
        "b_subln_g": 1.0 + nrm((L, B_V_DIM), 0.02),
        "c_conv": jnp.array([0.25, 1.0, 0.25], jnp.float32)[None, :, None] + nrm((L, 3, 3 * C_WIDTH), 0.1),
        "c_w0": nrm((L, 2, C_WIDTH), 0.5),
        "c_w2": nrm((L, 2, C_W_RANK, C_WIDTH), 0.1),
        "c_a0": nrm((L, 2, C_WIDTH), 0.5),
        "c_a2": nrm((L, 2, C_A_RANK, C_WIDTH), 0.1),
        "c_g2": nrm((L, C_G_RANK, C_WIDTH), C_G_RANK ** -0.5),
        "c_kk": 1.0 + nrm((L, C_WIDTH), 0.1),
        "c_ka": 1.0 + nrm((L, C_WIDTH), 0.1),
        "c_rk": nrm((L, C_HEADS, C_HEAD_DIM), 0.1),
        "c_lnx_g": 1.0 + nrm((L, C_WIDTH), 0.02),
        "c_lnx_b": nrm((L, C_WIDTH), 0.02),
        "w_out": nrm((L, MIX_W, D_MODEL), MIX_W ** -0.5),
        "ffn_w1": nrm((L, D_MODEL, D_FF), D_MODEL ** -0.5),
        "ffn_w3": nrm((L, D_MODEL, D_FF), D_MODEL ** -0.5),
        "ffn_w2": nrm((L, D_FF, D_MODEL), D_FF ** -0.5),
        "final_g": 1.0 + nrm((D_MODEL,), 0.02),
    }


def reference(x_prompt, x_sample, cache_a_k, cache_a_v, cache_b_k, cache_b_v, state_c_fwd, state_c_bwd,
              c, c_ctx, ada_w, ada_b, norm1_g, norm2_g, w_in, a_sink, b_lambda, b_subln_g,
              c_conv, c_w0, c_w2, c_a0, c_a2, c_g2, c_kk, c_ka, c_rk, c_lnx_g, c_lnx_b,
              w_out, ffn_w1, ffn_w3, ffn_w2, final_g):
    weights = dict(ada_w=ada_w, ada_b=ada_b, norm1_g=norm1_g, norm2_g=norm2_g, w_in=w_in, a_sink=a_sink,
                   b_lambda=b_lambda, b_subln_g=b_subln_g, c_conv=c_conv, c_w0=c_w0, c_w2=c_w2, c_a0=c_a0,
                   c_a2=c_a2, c_g2=c_g2, c_kk=c_kk, c_ka=c_ka, c_rk=c_rk, c_lnx_g=c_lnx_g, c_lnx_b=c_lnx_b,
                   w_out=w_out, ffn_w1=ffn_w1, ffn_w3=ffn_w3, ffn_w2=ffn_w2)
    xp = x_prompt
    xs = x_sample
    new_ak, new_av, new_bk, new_bv, new_sf, new_sb = [], [], [], [], [], []
    for l in range(DEPTH):
        p = {name: w[l] for name, w in weights.items()}
        xp, ctx_new = block(xp, c_ctx[None], p, lambda h: mixers_context(h, p, l))
        ak, av, bk, bv, sf, sb = ctx_new
        new_ak.append(ak)
        new_av.append(av)
        new_bk.append(bk)
        new_bv.append(bv)
        new_sf.append(sf.astype(xp.dtype))
        new_sb.append(sb.astype(xp.dtype))
        ctx_cached = (cache_a_k[:, l], cache_a_v[:, l], cache_b_k[:, l], cache_b_v[:, l],
                      state_c_fwd[:, l], state_c_bwd[:, l])
        xs, _ = block(xs, c, p, lambda h: (mixers_latent(h, p, l, ctx_cached), None))
    y_prompt = rmsnorm(xp, final_g)
    y_sample = rmsnorm(xs, final_g)
    new_a_k = jnp.stack(new_ak, axis=1)
    new_a_v = jnp.stack(new_av, axis=1)
    new_b_k = jnp.stack(new_bk, axis=1)
    new_b_v = jnp.stack(new_bv, axis=1)
    new_c_fwd = jnp.stack(new_sf, axis=1)
    new_c_bwd = jnp.stack(new_sb, axis=1)
    return (y_prompt, y_sample, new_a_k, new_a_v, new_b_k, new_b_v, new_c_fwd, new_c_bwd)
```

```cpp
#include <hip/hip_runtime.h>
#include <hip/hip_cooperative_groups.h>
#include <cstdio>
#include <cstdint>
namespace cg = cooperative_groups;

#ifndef MK_ONE_LAUNCH
#define MK_ONE_LAUNCH 1
#endif

#undef MK_ONE_LAUNCH
#define MK_ONE_LAUNCH 1
#define REP_PHASE -1
#define REP_COUNT 1
#define REP_PART 0
#define RA_REP 0
#define ATT_PROBE 0
namespace pg8 {
#define PG8_LAS __attribute__((address_space(3)))
typedef unsigned short bf16_t;
typedef short bf16x8 __attribute__((ext_vector_type(8)));
typedef float f32x4 __attribute__((ext_vector_type(4)));
typedef unsigned u32x4 __attribute__((ext_vector_type(4)));
constexpr int BM = 256, BK = 64, HALF = 128, HTB = HALF * BK * 2  , STAGE_BYTES = 8 * HTB, NXCD = 8, WGM = 8;

__host__ __device__ __forceinline__ int lds_byte(int r, int c) { const int st = (r >> 4) * 2 + (c >> 5), rr = r & 15, cc = c & 31, ob = rr * 64 + cc * 2; return st * 1024 + (ob ^ (((ob >> 9) & 1) << 5)); }
__host__ __device__ __forceinline__ void stage_rc(int b, int& R, int& C) { const int st = b / 1024, sb = b % 1024, swz = sb ^ (((sb >> 9) & 1) << 5); R = (st >> 1) * 16 + swz / 64; C = (st & 1) * 32 + (swz % 64) / 2; }
__host__ __device__ __forceinline__ int perm32(int rho) { const int n = rho >> 4, i = rho & 15; return 8 * (i >> 2) + 4 * n + (i & 3); }

struct Unit { int pm, pn; };
struct Gemm { const bf16_t* A; const bf16_t* Bt; int M, N, K; };

struct StaticOrder {
    int nM, nN, nwg, G, c;
    __host__ __device__ void init(int M, int N, int G_, int c_) { nM = M / BM; nN = N / BM; nwg = nM * nN; G = G_; c = c_; }
    __host__ __device__ bool next(int i, Unit& u) const {
        const long L = (long)i * G + c; if (L >= nwg) return false;
        int wgid = (int)L; { const int q = nwg / NXCD, r = nwg % NXCD, xcd = wgid % NXCD, off = wgid / NXCD; wgid = (xcd < r ? xcd * (q + 1) : r * (q + 1) + (xcd - r) * q) + off; }
        const int nig = WGM * nN, gid = wgid / nig, fm = gid * WGM, gsz = (nM - fm) < WGM ? (nM - fm) : WGM;
        u.pm = fm + ((wgid % nig) % gsz); u.pn = (wgid % nig) / gsz; return true;
    }
    __device__ __forceinline__ void a_ready(const Unit&) const {}
    __device__ __forceinline__ void done(const Unit&) const {}
};

template <class Epi, class Sched, bool ALIGN_EPI = false, bool SP2 = false>
__device__ __forceinline__ void gemm_phase(PG8_LAS unsigned char* lds, const Gemm g, const Sched& S, const Epi& E, const int tid_in) {
    const int tid = tid_in, wid = __builtin_amdgcn_readfirstlane(tid >> 6), lane = tid & 63, wr = wid >> 2, wc = wid & 3, fr = lane & 15, fq = lane >> 4;
    const int K = g.K, nt = K / BK;
    unsigned voffA[2], voffB[2];
#pragma unroll
    for (int i = 0; i < 2; ++i) { int R, C; stage_rc(tid * 16 + i * 8192, R, C); const int Rb = Epi::PERM ? ((R & ~31) + perm32(R & 31)) : R;
        voffA[i] = (unsigned)(R * K + C) * 2u; voffB[i] = (unsigned)(Rb * K + C) * 2u; }
    const size_t kstep = (size_t)(BK * 2);
    const size_t hstep = (size_t)HALF * K * 2;
    const size_t tstep = 2 * hstep;
    const unsigned ldsw = (unsigned)wid * 1024u;
    const int aoff = lds_byte(wr * 64 + fr, fq * 8), boff = lds_byte(wc * 32 + fr, fq * 8);
#define PG8_SA(b, h) (((b) * 2 + (h)) * HTB)
#define PG8_SB(b, h) ((4 + (b) * 2 + (h)) * HTB)
#define PG8_STAGE(bufoff, gbase, voff) do { _Pragma("unroll") for (int _i = 0; _i < 2; ++_i) \
        __builtin_amdgcn_global_load_lds((const unsigned*)((const char*)(gbase) + (voff)[_i]), (PG8_LAS unsigned*)(lds + (bufoff) + ldsw + _i * 8192), 16, 0, 0); } while (0)
#define PG8_LDA(dst, b, h) do { _Pragma("unroll") for (int m = 0; m < 4; ++m) _Pragma("unroll") for (int k = 0; k < 2; ++k) dst[m][k] = *(const PG8_LAS bf16x8*)(lds + PG8_SA(b, h) + aoff + m * 2048 + k * 1024); } while (0)
#define PG8_LDB(dst, b, h) do { _Pragma("unroll") for (int n = 0; n < 2; ++n) _Pragma("unroll") for (int k = 0; k < 2; ++k) dst[n][k] = *(const PG8_LAS bf16x8*)(lds + PG8_SB(b, h) + boff + n * 2048 + k * 1024); } while (0)
#define PG8_MMA(ai, bj, At, Bt) do { __builtin_amdgcn_s_setprio(1); _Pragma("unroll") for (int m = 0; m < 4; ++m) _Pragma("unroll") for (int n = 0; n < 2; ++n) _Pragma("unroll") for (int k = 0; k < 2; ++k) \
        acc[ai][bj][m][n] = __builtin_amdgcn_mfma_f32_16x16x32_bf16(Bt[n][k], At[m][k], acc[ai][bj][m][n], 0, 0, 0); __builtin_amdgcn_s_setprio(0); } while (0)
#define PG8_WAIT_V(n) asm volatile("s_waitcnt vmcnt(" #n ")" ::: "memory")
#define PG8_WAIT_L(n) asm volatile("s_waitcnt lgkmcnt(" #n ")" ::: "memory")
#define PG8_BAR __builtin_amdgcn_s_barrier()
#define PG8_SCHED __builtin_amdgcn_sched_barrier(0)
    Unit cur, nxt; int ui = 0;
    if (!S.next(0, cur)) return;
    f32x4 acc[2][2][4][2];
#pragma unroll
    for (int a = 0; a < 2; ++a)
#pragma unroll
        for (int b = 0; b < 2; ++b)
#pragma unroll
            for (int m = 0; m < 4; ++m)
#pragma unroll
                for (int n = 0; n < 2; ++n) acc[a][b][m][n] = (f32x4){0.f, 0.f, 0.f, 0.f};
    bf16x8 At[4][2], B0[2][2], B1[2][2];
#define PG8_SGPR64(p) ((const char*)(((unsigned long long)(unsigned)__builtin_amdgcn_readfirstlane((int)((unsigned long long)(p) >> 32)) << 32) | (unsigned)__builtin_amdgcn_readfirstlane((int)(unsigned long long)(p))))
    const char* cA = PG8_SGPR64((const char*)g.A + (size_t)cur.pm * tstep); const char* cB = PG8_SGPR64((const char*)g.Bt + (size_t)cur.pn * tstep);
    S.a_ready(cur);
    if constexpr (SP2) {
        PG8_STAGE(PG8_SB(0, 0), cB, voffB); PG8_STAGE(PG8_SB(0, 1), cB + hstep, voffB); PG8_STAGE(PG8_SA(0, 0), cA, voffA); PG8_STAGE(PG8_SA(0, 1), cA + hstep, voffA);
        if (wr == 1) PG8_BAR;
        PG8_WAIT_V(2); PG8_BAR;
        PG8_STAGE(PG8_SB(1, 0), cB + kstep, voffB); PG8_STAGE(PG8_SA(1, 0), cA + kstep, voffA); PG8_STAGE(PG8_SB(1, 1), cB + hstep + kstep, voffB);
        PG8_WAIT_V(6); PG8_BAR;
    } else {
        PG8_STAGE(PG8_SB(0, 0), cB, voffB); PG8_STAGE(PG8_SA(0, 0), cA, voffA); PG8_STAGE(PG8_SB(0, 1), cB + hstep, voffB); PG8_STAGE(PG8_SA(0, 1), cA + hstep, voffA);
        if (wr == 1) PG8_BAR;
        PG8_WAIT_V(4); PG8_BAR;
        PG8_STAGE(PG8_SB(1, 0), cB + kstep, voffB); PG8_STAGE(PG8_SA(1, 0), cA + kstep, voffA); PG8_STAGE(PG8_SB(1, 1), cB + hstep + kstep, voffB);
        PG8_WAIT_V(6); PG8_BAR;
    }
    for (;;) {
        const bool has_next = S.next(ui + 1, nxt);
        const char* nA = PG8_SGPR64(has_next ? (const char*)g.A + (size_t)nxt.pm * tstep : cA); const char* nB = PG8_SGPR64(has_next ? (const char*)g.Bt + (size_t)nxt.pn * tstep : cB);
        for (int t = 0; t < nt; t += 2) {
            const bool last = (t == nt - 2);
            const char* a1 = cA + (size_t)(t + 1) * kstep;
            const char* a2 = last ? nA : cA + (size_t)(t + 2) * kstep; const char* b2 = last ? nB : cB + (size_t)(t + 2) * kstep;
            const char* a3 = a2 + kstep; const char* b3 = b2 + kstep;
            if (last && has_next) S.a_ready(nxt);
            if constexpr (SP2) {
            PG8_LDB(B0, 0, 0); PG8_LDB(B1, 0, 1); PG8_SCHED; PG8_LDA(At, 0, 0); PG8_STAGE(PG8_SA(1, 1), a1 + hstep, voffA);
            PG8_WAIT_V(8); PG8_WAIT_L(0); PG8_BAR; PG8_MMA(0, 0, At, B0); PG8_MMA(0, 1, At, B1); PG8_BAR; PG8_SCHED;
            PG8_LDA(At, 0, 1); PG8_STAGE(PG8_SB(0, 0), b2, voffB); PG8_STAGE(PG8_SB(0, 1), b2 + hstep, voffB); PG8_STAGE(PG8_SA(0, 0), a2, voffA);
            PG8_WAIT_V(8); PG8_WAIT_L(0); PG8_BAR; PG8_MMA(1, 0, At, B0); PG8_MMA(1, 1, At, B1); PG8_BAR; PG8_SCHED;
            PG8_LDB(B0, 1, 0); PG8_LDB(B1, 1, 1); PG8_SCHED; PG8_LDA(At, 1, 0); PG8_STAGE(PG8_SA(0, 1), a2 + hstep, voffA);
            PG8_WAIT_V(8); PG8_WAIT_L(0); PG8_BAR; PG8_MMA(0, 0, At, B0); PG8_MMA(0, 1, At, B1); PG8_BAR; PG8_SCHED;
            PG8_LDA(At, 1, 1); PG8_STAGE(PG8_SB(1, 0), b3, voffB); PG8_STAGE(PG8_SB(1, 1), b3 + hstep, voffB); PG8_STAGE(PG8_SA(1, 0), a3, voffA);
            PG8_WAIT_V(8); PG8_WAIT_L(0); PG8_BAR; PG8_MMA(1, 0, At, B0); PG8_MMA(1, 1, At, B1); PG8_BAR; PG8_SCHED;
            } else {
            PG8_LDB(B0, 0, 0); PG8_SCHED; PG8_LDA(At, 0, 0); PG8_STAGE(PG8_SA(1, 1), a1 + hstep, voffA);
            PG8_WAIT_L(8); PG8_BAR; PG8_WAIT_L(0); PG8_MMA(0, 0, At, B0); PG8_BAR; PG8_SCHED;
            PG8_LDB(B1, 0, 1); PG8_STAGE(PG8_SB(0, 0), b2, voffB);
            PG8_BAR; PG8_WAIT_L(0); PG8_MMA(0, 1, At, B1); PG8_BAR;
            PG8_LDA(At, 0, 1); PG8_STAGE(PG8_SA(0, 0), a2, voffA);
            PG8_BAR; PG8_WAIT_L(0); PG8_MMA(1, 0, At, B0); PG8_BAR; PG8_SCHED;
            PG8_STAGE(PG8_SB(0, 1), b2 + hstep, voffB);
            PG8_WAIT_V(6); PG8_BAR; PG8_MMA(1, 1, At, B1); PG8_BAR;
            PG8_LDB(B0, 1, 0); PG8_SCHED; PG8_LDA(At, 1, 0); PG8_STAGE(PG8_SA(0, 1), a2 + hstep, voffA);
            PG8_WAIT_L(8); PG8_BAR; PG8_WAIT_L(0); PG8_MMA(0, 0, At, B0); PG8_BAR; PG8_SCHED;
            PG8_LDB(B1, 1, 1); PG8_STAGE(PG8_SB(1, 0), b3, voffB);
            PG8_BAR; PG8_WAIT_L(0); PG8_MMA(0, 1, At, B1); PG8_BAR;
            PG8_LDA(At, 1, 1); PG8_STAGE(PG8_SA(1, 0), a3, voffA);
            PG8_BAR; PG8_WAIT_L(0); PG8_MMA(1, 0, At, B0); PG8_BAR; PG8_SCHED;
            PG8_STAGE(PG8_SB(1, 1), b3 + hstep, voffB);
            PG8_WAIT_V(6); PG8_BAR; PG8_MMA(1, 1, At, B1); PG8_BAR;
            }
        }
        if constexpr (ALIGN_EPI) { if (wr == 0) PG8_BAR; }
        if constexpr (!Epi::AFTER_DRAIN) { E(acc, cur, wr, wc, fr, fq); S.done(cur); }
        if (!has_next) break;
#pragma unroll
        for (int a = 0; a < 2; ++a)
#pragma unroll
            for (int b = 0; b < 2; ++b)
#pragma unroll
                for (int m = 0; m < 4; ++m)
#pragma unroll
                    for (int n = 0; n < 2; ++n) acc[a][b][m][n] = (f32x4){0.f, 0.f, 0.f, 0.f};
        cur = nxt; cA = nA; cB = nB; ++ui;
        if constexpr (ALIGN_EPI) { if (wr == 1) PG8_BAR; }
    }
    PG8_WAIT_V(0);
    if constexpr (!ALIGN_EPI) { if (wr == 0) PG8_BAR; }
    PG8_BAR;
    if constexpr (Epi::AFTER_DRAIN) { E.fused(acc, cur, wr, wc, fr, fq, lds, wid, lane); S.done(cur); }
#undef PG8_SA
#undef PG8_SB
#undef PG8_STAGE
#undef PG8_LDA
#undef PG8_LDB
#undef PG8_MMA
#undef PG8_WAIT_V
#undef PG8_WAIT_L
#undef PG8_BAR
#undef PG8_SCHED
}
}

using pg8::bf16_t; using pg8::bf16x8; using pg8::f32x4; using pg8::u32x4;
typedef float f32x16 __attribute__((ext_vector_type(16)));
typedef float f32x2 __attribute__((ext_vector_type(2)));
typedef short s16x4 __attribute__((ext_vector_type(4)));
typedef unsigned u32x2 __attribute__((ext_vector_type(2)));
typedef __bf16 bf16x2_t __attribute__((ext_vector_type(2)));
#define LAS __attribute__((address_space(3)))
#define LDG(T, base, boff) (*(const __attribute__((address_space(1))) T*)((const __attribute__((address_space(1))) unsigned char*)(base) + (unsigned)(boff)))
#define STG(T, base, boff) (*(__attribute__((address_space(1))) T*)((__attribute__((address_space(1))) unsigned char*)(base) + (unsigned)(boff)))

__device__ __forceinline__ unsigned pk2(float lo, float hi) { f32x2 v = {lo, hi}; bf16x2_t b = __builtin_convertvector(v, bf16x2_t); return __builtin_bit_cast(unsigned, b); }
__device__ __forceinline__ float bf_lo(unsigned u) { return __uint_as_float(u << 16); }
__device__ __forceinline__ float bf_hi(unsigned u) { return __uint_as_float(u & 0xffff0000u); }
__device__ __forceinline__ f32x4 unpack4(u32x2 v) { return (f32x4){bf_lo(v.x), bf_hi(v.x), bf_lo(v.y), bf_hi(v.y)}; }
__device__ __forceinline__ u32x2 pack4(f32x4 v) { u32x2 r; r.x = pk2(v[0], v[1]); r.y = pk2(v[2], v[3]); return r; }
__device__ __forceinline__ float sigmf(float x) { return __builtin_amdgcn_rcpf(1.f + __expf(-x)); }
template <int CTRL> __device__ __forceinline__ float dpp_f(float x) { return __builtin_bit_cast(float, __builtin_amdgcn_update_dpp(0, __builtin_bit_cast(int, x), CTRL, 0xF, 0xF, true)); }
__device__ __forceinline__ float allreduce16(float x) { x += dpp_f<0xB1>(x); x += dpp_f<0x4E>(x); x += dpp_f<0x141>(x); x += dpp_f<0x140>(x); return x; }
__device__ __forceinline__ float rdlane(float x, int l) { return __builtin_bit_cast(float, __builtin_amdgcn_readlane(__builtin_bit_cast(int, x), l)); }
__device__ __forceinline__ float wave_sum(float v) {
    v = allreduce16(v);
    return (rdlane(v, 0) + rdlane(v, 16)) + (rdlane(v, 32) + rdlane(v, 48));
}
__device__ __forceinline__ float swap32_sum(float x) { auto rr = __builtin_amdgcn_permlane32_swap(__float_as_uint(x), __float_as_uint(x), false, false); return __uint_as_float(rr[0]) + __uint_as_float(rr[1]); }
__device__ __forceinline__ float swap32_max(float x) { auto rr = __builtin_amdgcn_permlane32_swap(__float_as_uint(x), __float_as_uint(x), false, false); return fmaxf(__uint_as_float(rr[0]), __uint_as_float(rr[1])); }

constexpr int M = 12288, MC = 4096, DM = 1024, NIN = 3072, FF = 2816, NFF2 = 5632, DEPTH = 4;
constexpr float LOG2E = 1.4426950408889634f;
constexpr float QSCALE_A = 0.125f * LOG2E;
constexpr float QSCALE_B = 0.17677669529663687f * LOG2E;
constexpr unsigned OFF_AK = 12582912, OFF_AV = 14680064, OFF_BK = 16777216, OFF_BV = 20971520, OFF_CF = 25165824, OFF_CB = 26738688;
constexpr unsigned MiB = 1u << 20;
constexpr unsigned WS_CTL = 0, CTL_BYTES = 1 * MiB;
constexpr unsigned WS_MOD = 1 * MiB;
constexpr unsigned WS_TAB = 1 * MiB + 512 * 1024;
constexpr unsigned WS_SMALLW = 2 * MiB;
constexpr unsigned WS_CACHE = 4 * MiB;
constexpr unsigned WS_WIN = 10 * MiB, WS_WOUT = 16 * MiB, WS_W13 = 18 * MiB, WS_W2 = 29 * MiB;
constexpr unsigned WSET_STRIDE = 184 * MiB;
constexpr unsigned WS_ACT = 35 * MiB;
constexpr unsigned WS_QA = 59 * MiB, WS_KA = 68 * MiB, WS_VTA = 71 * MiB, WS_QB = 74 * MiB, WS_KB = 80 * MiB, WS_VTB = 86 * MiB;
constexpr unsigned WS_RKV = 92 * MiB, WS_CW = 119 * MiB, WS_CA = 122 * MiB, WS_CG = 125 * MiB;
constexpr unsigned WS_YF = 128 * MiB, WS_YB = 146 * MiB;
constexpr unsigned WS_SV = 164 * MiB;
constexpr unsigned WS_BO2 = 182 * MiB, WS_ML = 230 * MiB;
constexpr unsigned WS_WSET1 = 194 * MiB;
constexpr unsigned WS_RM = 236 * MiB, WS_RN = 254 * MiB, WS_RP = 324 * MiB, WS_RH = 342 * MiB;
constexpr int NCHUNK = 2304;
constexpr unsigned WS_U = 128 * MiB;
constexpr unsigned WS_G = 290 * MiB, WS_SB = 299 * MiB, WS_BO = 300 * MiB, WS_END = 360 * MiB;
constexpr int SMALLW_L = 147456;
constexpr int TAB_COSA = 0, TAB_SINA = 1024, TAB_COSB = 2048, TAB_SINB = 2560, TAB_LAM = 3072;
constexpr int LDS_BYTES = 147456;
constexpr int NPHASE = 2 + 9 * DEPTH;

struct Args {
    const float* in[34];
    float* out; unsigned char* ws;
    int ph_lo, ph_hi;
};

struct EpiRes {
    static constexpr bool PERM = false, AFTER_DRAIN = false;
    const float* baseC; const float* baseL; float* X; const float* gate;
    __device__ __forceinline__ void operator()(const f32x4 (&acc)[2][2][4][2], const pg8::Unit& u, int wr, int wc, int fr_, int fq_) const {
        int fr = fr_, fq = fq_; asm volatile("" : "+v"(fr), "+v"(fq));
        const int v = u.pm < 16 ? 0 : (u.pm < 32 ? 1 : 2);
        const float* base = u.pm < 16 ? baseC : baseL;
        const unsigned col0 = u.pn * 256 + wc * 32 + 4 * fq, row0 = u.pm * 256 + wr * 64 + fr;
        f32x4 g4[2][2];
#pragma unroll
        for (int bj = 0; bj < 2; ++bj)
#pragma unroll
            for (int n = 0; n < 2; ++n) g4[bj][n] = LDG(f32x4, gate, (v * 6144 + col0 + bj * 128 + n * 16) * 4);
#pragma unroll
        for (int ai = 0; ai < 2; ++ai)
#pragma unroll
            for (int m = 0; m < 4; ++m) { const unsigned off = ((row0 + ai * 128 + m * 16) * DM + col0) * 4;
#pragma unroll
                for (int bj = 0; bj < 2; ++bj)
#pragma unroll
                    for (int n = 0; n < 2; ++n) { const f32x4 b = LDG(f32x4, base, off + (bj * 128 + n * 16) * 4); STG(f32x4, X, off + (bj * 128 + n * 16) * 4) = b + g4[bj][n] * acc[ai][bj][m][n]; } }
    }
};
struct EpiSwi {
    static constexpr bool PERM = true, AFTER_DRAIN = false;
    bf16_t* U;
    __device__ __forceinline__ void operator()(const f32x4 (&acc)[2][2][4][2], const pg8::Unit& u, int wr, int wc, int fr_, int fq_) const {
        int fr = fr_, fq = fq_; asm volatile("" : "+v"(fr), "+v"(fq));
        const unsigned row0 = u.pm * 256 + wr * 64 + fr, oc0 = u.pn * 128 + wc * 16 + 4 * fq;
#pragma unroll
        for (int ai = 0; ai < 2; ++ai)
#pragma unroll
            for (int m = 0; m < 4; ++m) { const unsigned ro = ((row0 + ai * 128 + m * 16) * FF + oc0) * 2;
#pragma unroll
                for (int bj = 0; bj < 2; ++bj) { const f32x4 g = acc[ai][bj][m][0], up = acc[ai][bj][m][1]; f32x4 o;
#pragma unroll
                    for (int e = 0; e < 4; ++e) o[e] = g[e] * sigmf(g[e]) * up[e];
                    STG(u32x2, U, ro + bj * 128) = pack4(o); } asm volatile("" ::: "memory"); }
    }
};
struct EpiWin {
    static constexpr bool PERM = true, AFTER_DRAIN = false;
    unsigned char* ws; float* out; int l;
    __device__ __forceinline__ void operator()(const f32x4 (&acc)[2][2][4][2], const pg8::Unit& u, int wr, int wc, int fr_, int fq_) const {
        int fr = fr_, fq = fq_; asm volatile("" : "+v"(fr), "+v"(fq));
        const bool lat = u.pm >= 16;
        const unsigned row0 = u.pm * 256 + wr * 64 + fr;
#pragma unroll
        for (int bj = 0; bj < 2; ++bj) {
            const unsigned c32 = u.pn * 256 + bj * 128 + wc * 32;
            const unsigned c8 = c32 + 8 * fq;
            if (c32 < 1152 && (c32 < 512 || c32 >= 640)) {
                const bool isA = c32 < 512;
                const bool isK = isA ? (c32 >= 384) : (c32 >= 896);
                const float qs = isK ? 1.f : (isA ? QSCALE_A : QSCALE_B);
                const unsigned ck = isA ? c8 - 384 : c8 - 896;
                const unsigned dbase = isA ? (isK ? WS_KA + (((ck >> 6) * 4 + ((ck & 63) >> 4)) * 64 + ((ck >> 3) & 1) * 32) * 16 : WS_QA + c8 * 2)
                                           : (isK ? WS_KB + (((ck >> 5) * 2 + ((ck & 31) >> 4)) * 64 + ((ck >> 3) & 1) * 32) * 16 : WS_QB + (c8 - 640) * 2);
                const unsigned dpitch = isA ? 768u : 512u;
#pragma unroll
                for (int ai = 0; ai < 2; ++ai)
#pragma unroll
                    for (int m = 0; m < 4; ++m) {
                        const unsigned row = row0 + ai * 128 + m * 16;
                        f32x4 v0 = acc[ai][bj][m][0], v1 = acc[ai][bj][m][1];
                        if (lat) {
                            const unsigned t = (row - MC) & 4095, rp = t >> 6, cp = t & 63;
                            unsigned to_;
                            if (isA) { const unsigned pos = ((c32 >> 5) & 1) ? cp : rp; to_ = WS_TAB + (TAB_COSA + pos * 16 + 4 * fq) * 4; }
                            else { const unsigned pos = (fq >> 1) ? cp : rp; to_ = WS_TAB + (TAB_COSB + pos * 8 + 4 * (fq & 1)) * 4; }
                            const f32x4 c4 = LDG(f32x4, ws, to_), s4 = LDG(f32x4, ws, to_ + (isA ? 4096u : 2048u));
                            f32x4 w0, w1;
                            w0[0] = v0[0] * c4[0] - v0[1] * s4[0]; w0[1] = v0[1] * c4[0] + v0[0] * s4[0];
                            w0[2] = v0[2] * c4[1] - v0[3] * s4[1]; w0[3] = v0[3] * c4[1] + v0[2] * s4[1];
                            w1[0] = v1[0] * c4[2] - v1[1] * s4[2]; w1[1] = v1[1] * c4[2] + v1[0] * s4[2];
                            w1[2] = v1[2] * c4[3] - v1[3] * s4[3]; w1[3] = v1[3] * c4[3] + v1[2] * s4[3];
                            v0 = w0; v1 = w1;
                        } else if (isK) {
                            const unsigned b = row >> 8, t = row & 255;
                            const f32x4 ev = {v0[0], v0[2], v1[0], v1[2]}, od = {v0[1], v0[3], v1[1], v1[3]};
                            if (isA) { const unsigned o = (OFF_AK + ((b * 4 + l) * 256 + t) * 128 + (c32 - 384) + 4 * fq) * 4; STG(f32x4, out, o) = ev; STG(f32x4, out, o + 64) = od; }
                            else { const unsigned o = (OFF_BK + ((b * 4 + l) * 256 + t) * 256 + ((c8 - 896) & ~15u) + 4 * (fq & 1)) * 4; STG(f32x4, out, o) = ev; STG(f32x4, out, o + 32) = od; }
                        }
                        v0 = v0 * qs; v1 = v1 * qs;
                        u32x4 w; w.x = pk2(v0[0], v0[1]); w.y = pk2(v0[2], v0[3]); w.z = pk2(v1[0], v1[1]); w.w = pk2(v1[2], v1[3]);
                        STG(u32x4, ws, isK ? dbase + (row >> 5) * (isA ? 8192u : 16384u) + (row & 31) * 16 : dbase + row * dpitch) = w;
                        asm volatile("" ::: "memory");
                    }
            } else if (c32 < 1408) {
                const bool isA = c32 < 640;
                const unsigned cc = isA ? (c8 - 512) : (c8 - 1152);
                const unsigned vt = (isA ? WS_VTA : WS_VTB) + ((((cc >> 6) * 2 + ((cc >> 5) & 1)) * 2) * 64 + (cc & 31)) * 16;
#pragma unroll
                for (int ai = 0; ai < 2; ++ai)
#pragma unroll
                    for (int m = 0; m < 4; ++m) {
                        const unsigned row = row0 + ai * 128 + m * 16;
                        const f32x4 v0 = acc[ai][bj][m][0], v1 = acc[ai][bj][m][1];
                        if (!lat) { const unsigned b = row >> 8, t = row & 255;
                            const unsigned o = isA ? (OFF_AV + ((b * 4 + l) * 256 + t) * 128 + cc) * 4 : (OFF_BV + ((b * 4 + l) * 256 + t) * 256 + cc) * 4;
                            STG(f32x4, out, o) = v0; STG(f32x4, out, o + 16) = v1; }
                        const unsigned p0 = pk2(v0[0], v0[1]), p1 = pk2(v0[2], v0[3]), p2 = pk2(v1[0], v1[1]), p3 = pk2(v1[2], v1[3]);
                        const unsigned tt = row & 31, rem = tt & 15;
                        const unsigned vo = vt + (row >> 5) * (isA ? 8192u : 16384u) + (tt >> 4) * 1024 + ((rem >> 2) & 1) * 512 + (4 * (rem >> 3) + (rem & 3)) * 2;
                        STG(bf16_t, ws, vo + 0 * 16) = (bf16_t)(p0 & 0xffff); STG(bf16_t, ws, vo + 1 * 16) = (bf16_t)(p0 >> 16);
                        STG(bf16_t, ws, vo + 2 * 16) = (bf16_t)(p1 & 0xffff); STG(bf16_t, ws, vo + 3 * 16) = (bf16_t)(p1 >> 16);
                        STG(bf16_t, ws, vo + 4 * 16) = (bf16_t)(p2 & 0xffff); STG(bf16_t, ws, vo + 5 * 16) = (bf16_t)(p2 >> 16);
                        STG(bf16_t, ws, vo + 6 * 16) = (bf16_t)(p3 & 0xffff); STG(bf16_t, ws, vo + 7 * 16) = (bf16_t)(p3 >> 16);
                        asm volatile("" ::: "memory");
                    }
            } else if (c32 < 2944) {
                const int kind = c32 < 2560 ? 0 : (c32 < 2688 ? 1 : (c32 < 2816 ? 2 : 3));
                const unsigned dbase = kind == 0 ? WS_RKV + (c8 - 1408) * 2 : (kind == 1 ? WS_CW + (c8 - 2560) * 2 : (kind == 2 ? WS_CA + (c8 - 2688) * 2 : WS_CG + (c8 - 2816) * 2));
                const unsigned dpitch = kind == 0 ? 2304u : 256u;
#pragma unroll
                for (int ai = 0; ai < 2; ++ai)
#pragma unroll
                    for (int m = 0; m < 4; ++m) {
                        const unsigned row = row0 + ai * 128 + m * 16;
                        f32x4 v0 = acc[ai][bj][m][0], v1 = acc[ai][bj][m][1];
                        if (kind == 1) {
#pragma unroll
                            for (int e = 0; e < 4; ++e) { v0[e] = 1.f - 2.f * __builtin_amdgcn_rcpf(__expf(2.f * v0[e]) + 1.f); v1[e] = 1.f - 2.f * __builtin_amdgcn_rcpf(__expf(2.f * v1[e]) + 1.f); }
                        } else if (kind == 3) {
#pragma unroll
                            for (int e = 0; e < 4; ++e) { v0[e] = sigmf(v0[e]); v1[e] = sigmf(v1[e]); }
                        }
                        u32x4 w; w.x = pk2(v0[0], v0[1]); w.y = pk2(v0[2], v0[3]); w.z = pk2(v1[0], v1[1]); w.w = pk2(v1[2], v1[3]);
                        STG(u32x4, ws, dbase + row * dpitch) = w;
                        asm volatile("" ::: "memory");
                    }
            }
        }
    }
};

struct Frame {
    LAS unsigned char* lds;
    const float* const* in;
    float* out; unsigned char* ws;
    int tid, lane, wave, gw, ngw, G, bid;
};
#define GAS __attribute__((address_space(1)))
template <class T> __device__ __forceinline__ T* gptr(T* p) {
#if defined(__HIP_DEVICE_COMPILE__)
    __builtin_assume(!__builtin_amdgcn_is_shared((const void*)p)); __builtin_assume(!__builtin_amdgcn_is_private((const void*)p));
#endif
    return p; }
#define INP(k) gptr(F.in[k])
#define WSP(T, off) gptr((T*)(F.ws + (off)))

__device__ __forceinline__ void phase_prologue(Frame& F) {
    const float* cvec = INP(8); const float* cctx = INP(9); const float* ada_w = INP(10); const float* ada_b = INP(11);
    LAS float* sl = (LAS float*)F.lds;
    LAS float* red = (LAS float*)(F.lds + 16384);
    for (int i = F.tid; i < 3072; i += 512) { const int v = i >> 10, k = i & 1023; const float x = v == 0 ? cctx[k] : cvec[(v - 1) * 1024 + k]; sl[i] = x / (1.f + __expf(-x)); }
    __syncthreads();
    float* mod = WSP(float, WS_MOD);
    for (int it = F.bid; it < 384; it += F.G) {
        const int l = it / 96, n0 = (it % 96) * 64;
        const float* W = ada_w + (size_t)l * 1024 * 6144 + n0 + F.lane;
        float a0 = 0.f, a1 = 0.f, a2 = 0.f;
        const int k0 = F.wave * 128;
#pragma unroll 8
        for (int k = k0; k < k0 + 128; ++k) { const float w = *(const GAS float*)(W + (size_t)k * 6144); a0 += sl[k] * w; a1 += sl[1024 + k] * w; a2 += sl[2048 + k] * w; }
        red[(F.wave * 3 + 0) * 64 + F.lane] = a0; red[(F.wave * 3 + 1) * 64 + F.lane] = a1; red[(F.wave * 3 + 2) * 64 + F.lane] = a2;
        __syncthreads();
        if (F.wave < 3) { float s = ada_b[l * 6144 + n0 + F.lane];
#pragma unroll
            for (int w = 0; w < 8; ++w) s += red[(w * 3 + F.wave) * 64 + F.lane];
            mod[(size_t)(l * 3 + F.wave) * 6144 + n0 + F.lane] = s; }
        __syncthreads();
    }
    float* tab = WSP(float, WS_TAB);
    if (F.bid == F.G - 1) {
        for (int i = F.tid; i < 1024; i += 512) { const int pos = i >> 4, f = i & 15; const float ang = (float)pos * __builtin_amdgcn_exp2f(-(float)f * (13.287712379549449f / 16.f)); tab[TAB_COSA + i] = __cosf(ang); tab[TAB_SINA + i] = __sinf(ang); }
        for (int i = F.tid; i < 512; i += 512) { const int pos = i >> 3, f = i & 7; const float ang = (float)pos * __builtin_amdgcn_exp2f(-(float)f * (13.287712379549449f / 8.f)); tab[TAB_COSB + i] = __cosf(ang); tab[TAB_SINB + i] = __sinf(ang); }
        if (F.wave < 4) { const float* lp = INP(16) + F.wave * 128; const int d = F.lane & 31;
            const float p1 = wave_sum(F.lane < 32 ? lp[d] * lp[32 + d] : 0.f), p2 = wave_sum(F.lane < 32 ? 0.f : lp[64 + d] * lp[96 + d]);
            if (F.lane == 0) tab[TAB_LAM + F.wave] = __expf(p1) - __expf(p2); }
    }
    const int gtid = F.bid * 512 + F.tid, gnt = F.G * 512;
    { bf16_t* sw = WSP(bf16_t, WS_SMALLW); const float* cw2 = INP(20); const float* ca2 = INP(22); const float* cg2 = INP(23);
      for (int idx = gtid; idx < 4 * SMALLW_L; idx += gnt) { const int l = idx / SMALLW_L, r = idx % SMALLW_L; float v;
          if (r < 98304) { const int which = r / 49152, rr = r % 49152, d = rr / 24576, ch = (rr % 24576) / 64, k = rr % 64; v = (which ? ca2 : cw2)[((size_t)(l * 2 + d) * 64 + k) * 384 + ch]; }
          else { const int rr = r - 98304, ch = rr / 128, k = rr % 128; v = cg2[((size_t)l * 128 + k) * 384 + ch]; }
          sw[idx] = (bf16_t)(pk2(v, 0.f) & 0xffff); } }
    { bf16_t* kca = WSP(bf16_t, WS_CACHE); bf16_t* vca = kca + 524288; bf16_t* kcb = vca + 524288; bf16_t* vcb = kcb + 1048576;
      const float* cak = INP(2); const float* cav = INP(3); const float* cbk = INP(4); const float* cbv = INP(5);
      for (int e = gtid; e < 524288; e += gnt) {
          const int j = e & 7, ln = (e >> 3) & 63, hi = ln >> 5, r32 = ln & 31, blk = (e >> 12) & 15, bl = e >> 16;
          { const int s = (e >> 9) & 3, kvh = (e >> 11) & 1, cp = kvh * 64 + 16 * s + 8 * hi + j, o = cp & 31, c = (cp - o) + (o >> 1) + 16 * (o & 1);
            kca[e] = (bf16_t)(pk2(cak[((size_t)bl * 512 + blk * 32 + r32) * 128 + c], 0.f) & 0xffff); }
          { const int ks = (e >> 9) & 1, db = (e >> 10) & 1, kvh = (e >> 11) & 1, key = blk * 32 + 16 * ks + 8 * (j >> 2) + 4 * hi + (j & 3);
            vca[e] = (bf16_t)(pk2(cav[((size_t)bl * 512 + key) * 128 + kvh * 64 + db * 32 + r32], 0.f) & 0xffff); } }
      for (int e = gtid; e < 1048576; e += gnt) {
          const int j = e & 7, ln = (e >> 3) & 63, hi = ln >> 5, r32 = ln & 31, blk = (e >> 13) & 15, bl = e >> 17;
          { const int s = (e >> 9) & 1, hm = (e >> 10) & 7, cp = hm * 32 + 16 * s + 8 * hi + j, o = cp & 15, c = (cp - o) + (o >> 1) + 8 * (o & 1);
            kcb[e] = (bf16_t)(pk2(cbk[((size_t)bl * 512 + blk * 32 + r32) * 256 + c], 0.f) & 0xffff); }
          { const int ks = (e >> 9) & 1, db = (e >> 10) & 1, h = (e >> 11) & 3, key = blk * 32 + 16 * ks + 8 * (j >> 2) + 4 * hi + (j & 3);
            vcb[e] = (bf16_t)(pk2(cbv[((size_t)bl * 512 + key) * 256 + h * 64 + db * 32 + r32], 0.f) & 0xffff); } } }
    for (int st = 0; st < 1; ++st) { u32x4* z = (u32x4*)(WSP(bf16_t, WS_WIN + st * WSET_STRIDE) + (size_t)2944 * 1024); unsigned z0; asm volatile("v_mov_b32 %0, 0" : "=v"(z0)); for (int i = gtid; i < 128 * 1024 / 8; i += gnt) z[i] = (u32x4){z0, z0, z0, z0}; }
}

template <int MAP> __device__ __forceinline__ int dest_row(int n) {
    if (MAP == 1) {
        if (n < 512) { const int o = n & 31; return (n - o) + 2 * (o & 15) + (o >> 4); }
        if (n >= 640 && n < 1152) { const int o = n & 15; return (n - o) + 2 * (o & 7) + (o >> 3); }
        return n;
    }
    if (MAP == 2) return (n >> 2) * 8 + (n & 3);
    if (MAP == 3) return (n >> 2) * 8 + 4 + (n & 3);
    return n;
}
template <int MAP> __device__ __forceinline__ void transpose_item(const float* W, int K, int N, bf16_t* WT, LAS float* scr, int item, int lane) {
    const int nblk = N / 32, kb = item / nblk, nb = item % nblk, k0 = 64 * kb, n0 = 32 * nb;
#pragma unroll 8
    for (int i = 0; i < 32; ++i) { const int kk = 2 * i + (lane >> 5); scr[kk * 33 + (lane & 31)] = *(const GAS float*)(W + (size_t)(k0 + kk) * N + n0 + (lane & 31)); }
    asm volatile("s_waitcnt lgkmcnt(0)" ::: "memory");
    const int c = lane & 7;
#pragma unroll
    for (int j = 0; j < 4; ++j) { const int n = (lane >> 3) + 8 * j; const LAS float* s = scr + (8 * c) * 33 + n;
        u32x4 o; o.x = pk2(s[0 * 33], s[1 * 33]); o.y = pk2(s[2 * 33], s[3 * 33]); o.z = pk2(s[4 * 33], s[5 * 33]); o.w = pk2(s[6 * 33], s[7 * 33]);
        *(GAS u32x4*)(WT + (size_t)dest_row<MAP>(n0 + n) * K + k0 + 8 * c) = o; }
    asm volatile("s_waitcnt lgkmcnt(0)" ::: "memory");
}
template <int MAP> __device__ __forceinline__ void convert_item(const float* W, int K, int N, bf16_t* WT, int item, int lane) {
    const int nblk = N / 64, kb = item / nblk, nb = item % nblk, n = nb * 64 + lane;
    const GAS float* src = (const GAS float*)W + (size_t)(kb * 128) * N + n;
    GAS bf16_t* dst = (GAS bf16_t*)WT + (size_t)dest_row<MAP>(n) * K + kb * 128;
#pragma unroll
    for (int g = 0; g < 16; ++g) { float v[8];
#pragma unroll
        for (int e = 0; e < 8; ++e) v[e] = src[(size_t)(8 * g + e) * N];
        u32x4 o; o.x = pk2(v[0], v[1]); o.y = pk2(v[2], v[3]); o.z = pk2(v[4], v[5]); o.w = pk2(v[6], v[7]);
        *(GAS u32x4*)(dst + 8 * g) = o; }
}
constexpr int CV_IN = 46 * 8, CV_OUT = 16 * 8, CV_1 = 44 * 8, CV_2 = 16 * 22, CV_TOTAL = CV_IN + CV_OUT + 2 * CV_1 + CV_2;
__device__ __forceinline__ void convert_item_any(Frame& F, int l, int it) {
    const unsigned so = 0u * WSET_STRIDE;
    int r = it;
    if (r < CV_IN) { convert_item<1>(INP(14) + (size_t)l * 1024 * 2944, 1024, 2944, WSP(bf16_t, WS_WIN + so), r, F.lane); return; } r -= CV_IN;
    if (r < CV_OUT) { convert_item<0>(INP(29) + (size_t)l * 1024 * 1024, 1024, 1024, WSP(bf16_t, WS_WOUT + so), r, F.lane); return; } r -= CV_OUT;
    if (r < CV_1) { convert_item<2>(INP(30) + (size_t)l * 1024 * FF, 1024, FF, WSP(bf16_t, WS_W13 + so), r, F.lane); return; } r -= CV_1;
    if (r < CV_1) { convert_item<3>(INP(31) + (size_t)l * 1024 * FF, 1024, FF, WSP(bf16_t, WS_W13 + so), r, F.lane); return; } r -= CV_1;
    convert_item<0>(INP(32) + (size_t)l * FF * 1024, FF, 1024, WSP(bf16_t, WS_W2 + so), r, F.lane);
}
__device__ __forceinline__ void convert_weights(Frame& F, int l) {
    LAS float* scr = (LAS float*)(F.lds + F.wave * 16384); const unsigned so = 0u * WSET_STRIDE;
    const float* w_in = INP(14) + (size_t)l * 1024 * 2944; const float* w_out = INP(29) + (size_t)l * 1024 * 1024;
    const float* w1 = INP(30) + (size_t)l * 1024 * FF; const float* w3 = INP(31) + (size_t)l * 1024 * FF; const float* w2 = INP(32) + (size_t)l * FF * 1024;
    constexpr int I_IN = 16 * 92, I_OUT = 16 * 32, I_1 = 16 * 88, I_2 = 44 * 32;
    constexpr int NIT = I_IN + I_OUT + 2 * I_1 + I_2;
    for (int it = F.gw; it < NIT; it += F.ngw) {
        int r = it;
        if (r < I_IN) { transpose_item<1>(w_in, 1024, 2944, WSP(bf16_t, WS_WIN + so), scr, r, F.lane); continue; } r -= I_IN;
        if (r < I_OUT) { transpose_item<0>(w_out, 1024, 1024, WSP(bf16_t, WS_WOUT + so), scr, r, F.lane); continue; } r -= I_OUT;
        if (r < I_1) { transpose_item<2>(w1, 1024, FF, WSP(bf16_t, WS_W13 + so), scr, r, F.lane); continue; } r -= I_1;
        if (r < I_1) { transpose_item<3>(w3, 1024, FF, WSP(bf16_t, WS_W13 + so), scr, r, F.lane); continue; } r -= I_1;
        transpose_item<0>(w2, FF, 1024, WSP(bf16_t, WS_W2 + so), scr, r, F.lane);
    }
}

__device__ __forceinline__ const float* xrow_ptr(Frame& F, int l_first, int row) {
    if (l_first) return row < MC ? INP(0) + (size_t)row * DM : INP(1) + (size_t)(row - MC) * DM;
    return gptr(F.out + (size_t)row * DM);
}
__device__ __forceinline__ void phase_norm(Frame& F, int l, int which  ) {
    const float* g = (which ? INP(13) : INP(12)) + l * 1024;
    const float* mod = WSP(float, WS_MOD) + (size_t)l * 3 * 6144 + (which ? 3072 : 0);
    bf16_t* H = WSP(bf16_t, WS_ACT);
    f32x4 gv[4];
#pragma unroll
    for (int j = 0; j < 4; ++j) gv[j] = *(const GAS f32x4*)(g + 4 * F.lane + 256 * j);
    for (int row = F.gw; row < M; row += F.ngw) {
        const float* xr = xrow_ptr(F, (l == 0 && which == 0) ? 1 : 0, row);
        const float* mv = mod + (row < MC ? 0 : (row < 2 * MC ? 1 : 2)) * 6144;
        f32x4 v[4]; float ss = 0.f;
#pragma unroll
        for (int j = 0; j < 4; ++j) { v[j] = *(const GAS f32x4*)(xr + 4 * F.lane + 256 * j); ss += (v[j][0] * v[j][0] + v[j][1] * v[j][1]) + (v[j][2] * v[j][2] + v[j][3] * v[j][3]); }
        const float rstd = rsqrtf(wave_sum(ss) * (1.f / 1024.f) + 1e-6f);
#pragma unroll
        for (int j = 0; j < 4; ++j) { const f32x4 sh = *(const GAS f32x4*)(mv + 4 * F.lane + 256 * j), sc = *(const GAS f32x4*)(mv + 1024 + 4 * F.lane + 256 * j);
            const f32x4 h = v[j] * rstd * gv[j] * (sc + 1.f) + sh;
            *(GAS u32x2*)(H + (size_t)row * DM + 4 * F.lane + 256 * j) = pack4(h); }
    }
}
__device__ __forceinline__ void phase_final_norm(Frame& F) {
    const float* g = INP(33);
    f32x4 gv[4];
#pragma unroll
    for (int j = 0; j < 4; ++j) gv[j] = *(const GAS f32x4*)(g + 4 * F.lane + 256 * j);
    for (int row = F.gw; row < M; row += F.ngw) {
        float* xr = gptr(F.out + (size_t)row * DM);
        f32x4 v[4]; float ss = 0.f;
#pragma unroll
        for (int j = 0; j < 4; ++j) { v[j] = *(const GAS f32x4*)(xr + 4 * F.lane + 256 * j); ss += (v[j][0] * v[j][0] + v[j][1] * v[j][1]) + (v[j][2] * v[j][2] + v[j][3] * v[j][3]); }
        const float rstd = rsqrtf(wave_sum(ss) * (1.f / 1024.f) + 1e-6f);
#pragma unroll
        for (int j = 0; j < 4; ++j) *(GAS f32x4*)(xr + 4 * F.lane + 256 * j) = v[j] * rstd * gv[j];
    }
}

#define MFMA32(a, b, c) __builtin_amdgcn_mfma_f32_32x32x16_bf16((a), (b), (c), 0, 0, 0)
#ifndef ATT_PROBE
#define ATT_PROBE 0
#endif
struct AttnQ { float m, l; bool mz; f32x16 o[2]; };
template <int DQK, bool MASK, int NQ>
__device__ __forceinline__ void attn_block(const bf16x8 (&qf)[NQ][DQK / 16], const bf16x8 (&kf)[DQK / 16], const bf16x8 (&vf)[4], AttnQ (&st)[NQ], int b, const int (&qpos)[NQ], int kpos0, int hi) {
    constexpr int NS = DQK / 16;
    f32x16 sc[NQ];
#pragma unroll
    for (int q = 0; q < NQ; ++q) { const f32x16 z = {}; sc[q] = MFMA32(kf[0], qf[q][0], z);
#pragma unroll
        for (int s = 1; s < NS; ++s) sc[q] = MFMA32(kf[s], qf[q][s], sc[q]); }
#pragma unroll
    for (int q = 0; q < NQ; ++q) {
        if (!st[q].mz) {
#pragma unroll
            for (int r = 0; r < 16; ++r) sc[q][r] -= st[q].m; }
        if (MASK) {
#pragma unroll
            for (int r = 0; r < 16; ++r) { const int key = kpos0 + 32 * b + (r & 3) + 8 * (r >> 2) + 4 * hi; const int dlt = key - qpos[q]; if (dlt > 128 || dlt < -128) sc[q][r] = -1e30f; }
        }
        float bm = fmaxf(fmaxf(sc[q][0], sc[q][1]), sc[q][2]);
#pragma unroll
        for (int r = 3; r < 15; r += 2) bm = fmaxf(fmaxf(bm, sc[q][r]), sc[q][r + 1]);
        bm = fmaxf(bm, sc[q][15]);
        bm = swap32_max(bm);
        if (__builtin_amdgcn_ballot_w64(bm > 64.f) != 0ull) {
            const float d = fmaxf(bm, 0.f);
            const float alpha = __builtin_amdgcn_exp2f(-d);
            st[q].m += d; st[q].l *= alpha; st[q].mz = false;
#pragma unroll
            for (int r = 0; r < 16; ++r) { st[q].o[0][r] *= alpha; st[q].o[1][r] *= alpha; sc[q][r] -= d; }
        }
#if ATT_PROBE == 1
        { float dmy = 0.f;
#pragma unroll
          for (int r = 0; r < 16; ++r) { float e_; asm volatile("v_exp_f32 %0, %1" : "=v"(e_) : "v"(sc[q][r])); dmy += e_; }
          asm volatile("" :: "v"(dmy)); }
#endif
        f32x2 rs2 = {0.f, 0.f};
#pragma unroll
        for (int r = 0; r < 16; r += 2) { sc[q][r] = __builtin_amdgcn_exp2f(sc[q][r]); sc[q][r + 1] = __builtin_amdgcn_exp2f(sc[q][r + 1]); rs2 += (f32x2){sc[q][r], sc[q][r + 1]}; }
        st[q].l += rs2[0] + rs2[1];
#if ATT_PROBE == 3
        { float d0 = 0.f, d1 = 0.f, d2 = 0.f, d3 = 0.f;
#pragma unroll
          for (int rr = 0; rr < 10; ++rr) { asm volatile("v_add_f32 %0, %0, %4\n\tv_add_f32 %1, %1, %5\n\tv_add_f32 %2, %2, %6\n\tv_add_f32 %3, %3, %7" : "+v"(d0), "+v"(d1), "+v"(d2), "+v"(d3) : "v"(sc[q][0]), "v"(sc[q][1]), "v"(sc[q][2]), "v"(sc[q][3])); }
          asm volatile("" :: "v"(d0), "v"(d1), "v"(d2), "v"(d3)); }
#endif
#if ATT_PROBE == 2
        { f32x16 dm = sc[q]; dm = MFMA32(kf[0], qf[q][0], dm); dm = MFMA32(kf[0], qf[q][0], dm); dm = MFMA32(kf[0], qf[q][0], dm); asm volatile("" :: "v"(dm)); }
#endif
        bf16x8 pb[2];
#pragma unroll
        for (int ks = 0; ks < 2; ++ks) { u32x4 w; w.x = pk2(sc[q][8 * ks], sc[q][8 * ks + 1]); w.y = pk2(sc[q][8 * ks + 2], sc[q][8 * ks + 3]); w.z = pk2(sc[q][8 * ks + 4], sc[q][8 * ks + 5]); w.w = pk2(sc[q][8 * ks + 6], sc[q][8 * ks + 7]); pb[ks] = __builtin_bit_cast(bf16x8, w); }
#pragma unroll
        for (int db = 0; db < 2; ++db)
#pragma unroll
            for (int ks = 0; ks < 2; ++ks) st[q].o[db] = MFMA32(vf[db * 2 + ks], pb[ks], st[q].o[db]);
    }
}
template <int DQK, bool MASK, int NQ>
__device__ __forceinline__ void attn_seg(const unsigned char* ws, const bf16x8 (&qf)[NQ][DQK / 16], AttnQ (&st)[NQ],
                                         unsigned kp, unsigned kblk  , unsigned vp, unsigned vblk, int nblk, const int (&qpos)[NQ], int kpos0, int hi) {
    constexpr int NS = DQK / 16;
    const GAS unsigned char* kq = (const GAS unsigned char*)ws + kp; const GAS unsigned char* vq = (const GAS unsigned char*)ws + vp;
    bf16x8 ka[NS], va[4], kb[NS], vb[4];
#define ATT_LOAD(kd, vd) do { _Pragma("unroll") for (int s = 0; s < NS; ++s) kd[s] = *(const GAS bf16x8*)(kq + 1024 * s); _Pragma("unroll") for (int f = 0; f < 4; ++f) vd[f] = *(const GAS bf16x8*)(vq + 1024 * f); } while (0)
    ATT_LOAD(ka, va);
    int b = 0;
    for (; b + 1 < nblk; b += 2) {
        kq += kblk; vq += vblk; ATT_LOAD(kb, vb);
        attn_block<DQK, MASK, NQ>(qf, ka, va, st, b, qpos, kpos0, hi);
        if (b + 2 < nblk) { kq += kblk; vq += vblk; }
        ATT_LOAD(ka, va);
        attn_block<DQK, MASK, NQ>(qf, kb, vb, st, b + 1, qpos, kpos0, hi);
    }
    if (b < nblk) attn_block<DQK, MASK, NQ>(qf, ka, va, st, b, qpos, kpos0, hi);
#undef ATT_LOAD
}
__device__ __forceinline__ void attnq_init(AttnQ& s, float l0) { s.m = 0.f; s.mz = true; s.l = l0; s.o[0] = (f32x16){}; s.o[1] = (f32x16){}; }
__device__ __forceinline__ void attn_a_item(Frame& F, int l, bool lat, int item) {
    int lane = F.lane; asm volatile("" : "+v"(lane));
    const unsigned char* ws = F.ws;
    const unsigned r32 = lane & 31, hi = lane >> 5;
    const unsigned nqb = lat ? 128 : 8;
    const unsigned qb = item % nqb, hq = (item / nqb) % 6, b = item / (nqb * 6), kvh = hq / 3;
    const unsigned seq0 = lat ? MC + b * 4096 : b * 256, q0 = qb * 32, row = seq0 + q0 + r32;
    const unsigned qo = WS_QA + (row * 384 + hq * 64 + 8 * hi) * 2;
    bf16x8 qf[1][4];
#pragma unroll
    for (int s = 0; s < 4; ++s) qf[0][s] = LDG(bf16x8, ws, qo + 32 * s);
    AttnQ st[1]; attnq_init(st[0], hi == 0 ? __builtin_amdgcn_exp2f(INP(15)[l * 6 + hq] * LOG2E) : 0.f);
    const int qpos[1] = {(int)(q0 + r32)};
    const unsigned fo = kvh * 4096 + lane * 16;
    if (!lat) {
        attn_seg<64, false, 1>(ws, qf, st, WS_KA + (seq0 >> 5) * 8192 + fo, 8192, WS_VTA + (seq0 >> 5) * 8192 + fo, 8192, 8, qpos, 0, hi);
    } else {
        const int ks = (int)q0 - 128 < 0 ? 0 : (int)q0 - 128, ke = q0 + 160 > 4096 ? 4096 : q0 + 160;
        attn_seg<64, true, 1>(ws, qf, st, WS_KA + ((seq0 + ks) >> 5) * 8192 + fo, 8192, WS_VTA + ((seq0 + ks) >> 5) * 8192 + fo, 8192, (ke - ks) >> 5, qpos, ks, hi);
        attn_seg<64, false, 1>(ws, qf, st, WS_CACHE + (b * 4 + l) * 131072 + fo, 8192, WS_CACHE + 1 * MiB + (b * 4 + l) * 131072 + fo, 8192, 16, qpos, 0, hi);
    }
    const float rl = 1.f / swap32_sum(st[0].l);
    const unsigned oo = WS_ACT + (row * DM + hq * 64 + 4 * hi) * 2;
#pragma unroll
    for (int db = 0; db < 2; ++db)
#pragma unroll
        for (int g = 0; g < 4; ++g) { const f32x4 v = {st[0].o[db][4 * g] * rl, st[0].o[db][4 * g + 1] * rl, st[0].o[db][4 * g + 2] * rl, st[0].o[db][4 * g + 3] * rl}; STG(u32x2, F.ws, oo + (32 * db + 8 * g) * 2) = pack4(v); }
}
__device__ __forceinline__ void attn_b_store(Frame& F, const AttnQ& s, unsigned mp, unsigned kh, unsigned row, unsigned h, unsigned hi) {
    const float lt = swap32_sum(s.l);
    const unsigned oo = WS_BO2 + (((mp * 2 + kh) * M + row) * 256 + h * 64 + 4 * hi) * 2;
#pragma unroll
    for (int db = 0; db < 2; ++db)
#pragma unroll
        for (int g = 0; g < 4; ++g) STG(u32x2, F.ws, oo + (32 * db + 8 * g) * 2) = pack4((f32x4){s.o[db][4 * g], s.o[db][4 * g + 1], s.o[db][4 * g + 2], s.o[db][4 * g + 3]});
    if (hi == 0) STG(f32x2, F.ws, WS_ML + ((((mp * 2 + kh) * M + row) * 4 + h) * 2) * 4) = (f32x2){s.m, lt};
}
__device__ __forceinline__ void attn_b_item(Frame& F, int l, bool lat, int item) {
    int lane = F.lane; asm volatile("" : "+v"(lane));
    const unsigned char* ws = F.ws;
    const unsigned r32 = lane & 31, hi = lane >> 5;
    if (lat) {
        const unsigned kh = item & 1, qb = (item >> 1) & 63, mp = (item >> 7) & 1, h = (item >> 8) & 3, b = item >> 10;
        const unsigned seq0 = MC + b * 4096, row0 = seq0 + qb * 64 + r32;
        bf16x8 qf[2][2];
#pragma unroll
        for (int q = 0; q < 2; ++q)
#pragma unroll
            for (int s = 0; s < 2; ++s) qf[q][s] = LDG(bf16x8, ws, WS_QB + ((row0 + 32 * q) * 256 + h * 64 + mp * 32 + 8 * hi) * 2 + 32 * s);
        AttnQ st[2]; attnq_init(st[0], 0.f); attnq_init(st[1], 0.f);
        const int qpos[2] = {0, 0};
        const unsigned kfo = (h * 2 + mp) * 2048 + lane * 16, vfo = h * 4096 + lane * 16;
        const unsigned blk0 = kh ? 72u : 0u, nb = kh ? 56 : 72;
        attn_seg<32, false, 2>(ws, qf, st, WS_KB + ((seq0 >> 5) + blk0) * 16384 + kfo, 16384, WS_VTB + ((seq0 >> 5) + blk0) * 16384 + vfo, 16384, nb, qpos, 0, hi);
        if (kh) attn_seg<32, false, 2>(ws, qf, st, WS_CACHE + 2 * MiB + (b * 4 + l) * 262144 + kfo, 16384, WS_CACHE + 4 * MiB + (b * 4 + l) * 262144 + vfo, 16384, 16, qpos, 0, hi);
        attn_b_store(F, st[0], mp, kh, row0, h, hi); attn_b_store(F, st[1], mp, kh, row0 + 32, h, hi);
    } else {
        const unsigned qb = item & 7, mp = (item >> 3) & 1, h = (item >> 4) & 3, b = item >> 6;
        const unsigned seq0 = b * 256, row = seq0 + qb * 32 + r32;
        bf16x8 qf[1][2];
#pragma unroll
        for (int s = 0; s < 2; ++s) qf[0][s] = LDG(bf16x8, ws, WS_QB + (row * 256 + h * 64 + mp * 32 + 8 * hi) * 2 + 32 * s);
        AttnQ st[1]; attnq_init(st[0], 0.f);
        const int qpos[1] = {0};
        const unsigned kfo = (h * 2 + mp) * 2048 + lane * 16, vfo = h * 4096 + lane * 16;
        attn_seg<32, false, 1>(ws, qf, st, WS_KB + (seq0 >> 5) * 16384 + kfo, 16384, WS_VTB + (seq0 >> 5) * 16384 + vfo, 16384, 8, qpos, 0, hi);
        attn_b_store(F, st[0], mp, 0, row, h, hi);
    }
}

constexpr int L_KT = 0, L_RT = 9216, L_BT = 18432, L_KK = 27648, L_VT = 36864, L_KKT = 46080, L_BTT = 55296, L_A1 = 64512, L_RHS2 = 81920, L_WT = 99328, L_U0T = 108544, L_GC = 117760, L_X0 = 118016;
constexpr int RPB = 144, RPF = 272;
__device__ __forceinline__ void chunk_decode(int cid, unsigned& seq0, int& T, unsigned& b, unsigned& h, unsigned& dir, int& c) {
    unsigned chain;
    if (cid < 768) { chain = (unsigned)cid >> 2; c = cid & 3; T = 256; b = chain / 12; seq0 = b * 256; }
    else { const unsigned x = (unsigned)cid - 768; chain = x >> 6; c = (int)(x & 63); T = 4096; b = chain / 12; seq0 = MC + b * 4096; }
    dir = chain & 1; h = (chain >> 1) % 6;
}
__device__ __forceinline__ bf16x8 acc_frag(const f32x16& x, int ks, float sgn) {
    u32x4 w; w.x = pk2(sgn * x[8 * ks], sgn * x[8 * ks + 1]); w.y = pk2(sgn * x[8 * ks + 2], sgn * x[8 * ks + 3]); w.z = pk2(sgn * x[8 * ks + 4], sgn * x[8 * ks + 5]); w.w = pk2(sgn * x[8 * ks + 6], sgn * x[8 * ks + 7]);
    return __builtin_bit_cast(bf16x8, w);
}
__device__ __forceinline__ bf16x8 lds_frag_nat(const LAS unsigned char* img, unsigned row, int ks, unsigned hi) { return *(const LAS bf16x8*)(img + row * RPB + (16 * ks + 8 * hi) * 2); }
__device__ __forceinline__ bf16x8 lds_frag_perm(const LAS unsigned char* img, unsigned row, int k0, unsigned hi) {
    const s16x4 a = *(const LAS s16x4*)(img + row * RPB + (k0 + 4 * hi) * 2), b = *(const LAS s16x4*)(img + row * RPB + (k0 + 8 + 4 * hi) * 2);
    return (bf16x8){a[0], a[1], a[2], a[3], b[0], b[1], b[2], b[3]};
}
__device__ __forceinline__ f32x16 gram_tile(const LAS unsigned char* lds, int aimg, int bimg, int sb, int tb, unsigned r32, unsigned hi, bool strict) {
    f32x16 acc = {};
#pragma unroll
    for (int ks = 0; ks < 4; ++ks) acc = MFMA32(lds_frag_nat(lds + aimg, 32 * sb + r32, ks, hi), lds_frag_nat(lds + bimg, 32 * tb + r32, ks, hi), acc);
    if (sb == tb) {
#pragma unroll
        for (int r = 0; r < 16; ++r) { const unsigned s_ = (r & 3) + 8 * (r >> 2) + 4 * hi; const bool keep = strict ? s_ < r32 : s_ <= r32; acc[r] = keep ? acc[r] : 0.f; }
    }
    return acc;
}
__device__ __forceinline__ void lds_barrier() { asm volatile("s_waitcnt lgkmcnt(0)\n\ts_barrier" ::: "memory"); }
__device__ __forceinline__ void rwkv_chunk_block(Frame& F, int l, int cid) {
    int lane = F.lane; asm volatile("" : "+v"(lane));
    const unsigned char* ws = F.ws; LAS unsigned char* lds = F.lds;
    const int w = F.wave; const unsigned r32 = lane & 31, hi = lane >> 5;
    unsigned seq0, b, h, dir; int T, c; chunk_decode(cid, seq0, T, b, h, dir, c);
    const int q0 = 64 * c;
#ifndef RA_REP
#define RA_REP 0
#endif
    const int role = w >> 1, tb = w & 1;
    const unsigned swo = WS_SMALLW + l * (SMALLW_L * 2);
    {
        const int pw_ = w < 4, pb = (w >> 1) & 1, cb = w & 1;
        const int p_ = 32 * pb + r32; const unsigned tokp = seq0 + (dir ? T - 1 - (q0 + p_) : q0 + p_);
        const unsigned xo = (pw_ ? WS_CW : WS_CA) + (tokp * 128 + dir * 64 + 8 * hi) * 2, wo = swo + ((pw_ ? 0 : 49152) + (dir * 384 + h * 64 + 32 * cb + r32) * 64 + 8 * hi) * 2;
        f32x16 acc = {};
#pragma unroll
        for (int ks = 0; ks < 4; ++ks) acc = MFMA32(LDG(bf16x8, ws, xo + 32 * ks), LDG(bf16x8, ws, wo + 32 * ks), acc);
        {
            const float bias = LDG(float, pw_ ? INP(19) : INP(21), ((l * 2 + dir) * 384 + h * 64 + 32 * cb + r32) * 4);
#pragma unroll
            for (int r = 0; r < 16; ++r) { const float sg = sigmf(bias + acc[r]);
                *(LAS float*)(lds + (pw_ ? L_A1 : L_RHS2) + (32 * pb + (r & 3) + 8 * (r >> 2) + 4 * hi) * RPF + (32 * cb + r32) * 4) = pw_ ? -0.606531f * sg : sg; }
        }
        if (dir == 0 && w < 4) {
            f32x16 ag = {};
            const unsigned go = WS_CG + (tokp * 128 + 8 * hi) * 2, gw_ = swo + (98304 + (h * 64 + 32 * cb + r32) * 128 + 8 * hi) * 2;
#pragma unroll
            for (int ks = 0; ks < 8; ++ks) ag = MFMA32(LDG(bf16x8, ws, go + 32 * ks), LDG(bf16x8, ws, gw_ + 32 * ks), ag);
#pragma unroll
            for (int r = 0; r < 16; ++r) { const int pp_ = 32 * pb + (r & 3) + 8 * (r >> 2) + 4 * hi; const unsigned tk = seq0 + q0 + pp_;
                STG(bf16_t, F.ws, WS_G + (tk * 384 + h * 64 + 32 * cb + r32) * 2) = (bf16_t)(pk2(ag[r], 0.f) & 0xffff); }
        }
    }
    lds_barrier();
    {
        const unsigned cch = h * 64 + lane;
        const float* convp = INP(18) + (size_t)l * 3 * 1152;
        float cw_[3][3];
#pragma unroll
        for (int tap = 0; tap < 3; ++tap)
#pragma unroll
            for (int seg = 0; seg < 3; ++seg) cw_[tap][seg] = LDG(float, convp, (tap * 1152 + seg * 384 + cch) * 4);
        const float ckk = LDG(float, INP(24), (l * 384 + cch) * 4), cka = LDG(float, INP(25), (l * 384 + cch) * 4), crk = LDG(float, INP(26), (l * 384 + cch) * 4);
        const int tb0 = dir ? T - 1 - (q0 + 8 * w + 7) : q0 + 8 * w;
        float xr[10][3];
#pragma unroll
        for (int rr = 0; rr < 10; ++rr) { const int tr = tb0 - 1 + rr; const bool ok = tr >= 0 && tr < T; const unsigned tk = seq0 + (ok ? tr : tb0);
#pragma unroll
            for (int seg = 0; seg < 3; ++seg) { const float x = bf_lo((unsigned)LDG(bf16_t, ws, WS_RKV + (tk * 1152 + seg * 384 + cch) * 2)); xr[rr][seg] = ok ? x : 0.f; } }
        float lwv[8], kkv[8], btv[8], kdv[8], rv[8], vv[8], g = 0.f;
#pragma unroll
        for (int pp = 0; pp < 8; ++pp) {
            const int rr = 1 + (dir ? 7 - pp : pp); const int p = 8 * w + pp; const unsigned tok = seq0 + (unsigned)(tb0 + rr - 1);
            const float r_ = xr[rr - 1][0] * cw_[0][0] + xr[rr][0] * cw_[1][0] + xr[rr + 1][0] * cw_[2][0];
            const float k_ = xr[rr - 1][1] * cw_[0][1] + xr[rr][1] * cw_[1][1] + xr[rr + 1][1] * cw_[2][1];
            const float v_ = xr[rr - 1][2] * cw_[0][2] + xr[rr][2] * cw_[1][2] + xr[rr + 1][2] * cw_[2][2];
            const float kraw = k_ * ckk; const float n2 = wave_sum(kraw * kraw); const float kk_ = kraw * __builtin_amdgcn_rsqf(fmaxf(n2, 1e-24f));
            const float lw = *(const LAS float*)(lds + L_A1 + p * RPF + lane * 4), av = *(const LAS float*)(lds + L_RHS2 + p * RPF + lane * 4);
            const float kd_ = k_ * (1.f + (av - 1.f) * cka);
            const float bon = wave_sum(r_ * kd_ * crk);
            if (lane == 0) STG(float, F.ws, WS_SB + ((dir * M + tok) * 8 + h) * 4) = bon;
            if (dir == 0) STG(float, F.ws, WS_SV + (tok * 384 + cch) * 4) = v_;
            lwv[pp] = lw; kkv[pp] = kk_; btv[pp] = kk_ * av; kdv[pp] = kd_; rv[pp] = r_; vv[pp] = v_; g += lw;
        }
        g = 0.f;
        for (int wq = 0; wq < w; ++wq) { float t8[8];
#pragma unroll
            for (int e = 0; e < 8; ++e) t8[e] = *(const LAS float*)(lds + L_A1 + (8 * wq + e) * RPF + lane * 4);
            g += ((t8[0] + t8[1]) + (t8[2] + t8[3])) + ((t8[4] + t8[5]) + (t8[6] + t8[7])); }
        unsigned vt[4], kkt[4], btt[4]; float e_pos = __expf(g);
#pragma unroll
        for (int pp = 0; pp < 8; ++pp) {
            const int p = 8 * w + pp;
            const float e_prev = e_pos; g += lwv[pp]; e_pos = __expf(g); const float e_neg = __expf(-g);
            const unsigned pk_kr = pk2(kkv[pp] * e_prev, rv[pp] * e_pos), pk_bk = pk2(btv[pp] * e_neg, kdv[pp] * e_neg), pk_v = pk2(vv[pp], 0.f);
            *(LAS bf16_t*)(lds + L_KT + p * RPB + lane * 2) = (bf16_t)(pk_kr & 0xffff); *(LAS bf16_t*)(lds + L_RT + p * RPB + lane * 2) = (bf16_t)(pk_kr >> 16);
            *(LAS bf16_t*)(lds + L_BT + p * RPB + lane * 2) = (bf16_t)(pk_bk & 0xffff); *(LAS bf16_t*)(lds + L_KK + p * RPB + lane * 2) = (bf16_t)(pk_bk >> 16);
            if (pp & 1) { vt[pp >> 1] |= pk_v << 16; kkt[pp >> 1] |= pk_bk & 0xffff0000u; btt[pp >> 1] |= pk_bk << 16; }
            else { vt[pp >> 1] = pk_v & 0xffff; kkt[pp >> 1] = pk_bk >> 16; btt[pp >> 1] = pk_bk & 0xffff; }
        }
        *(LAS u32x4*)(lds + L_VT + lane * RPB + 16 * w) = (u32x4){vt[0], vt[1], vt[2], vt[3]};
        *(LAS u32x4*)(lds + L_KKT + lane * RPB + 16 * w) = (u32x4){kkt[0], kkt[1], kkt[2], kkt[3]};
        *(LAS u32x4*)(lds + L_BTT + lane * RPB + 16 * w) = (u32x4){btt[0], btt[1], btt[2], btt[3]};
        if (w == 7) *(LAS float*)(lds + L_GC + lane * 4) = e_pos;
    }
    lds_barrier();
    f32x16 keep[2]; bf16x8 x4f[2][2];
    if (role == 0) {
        for (int sb = 0; sb <= tb; ++sb) { const f32x16 x = gram_tile(lds, L_BT, L_KT, sb, tb, r32, hi, true);
            if (sb == tb) {
#pragma unroll
                for (int r = 0; r < 16; ++r) *(LAS float*)(lds + L_A1 + tb * 4608 + ((r & 3) + 8 * (r >> 2) + 4 * hi) * 144 + r32 * 4) = -x[r];
            } else {
#pragma unroll
                for (int g4 = 0; g4 < 4; ++g4) *(LAS f32x4*)(lds + L_A1 + 9216 + r32 * 144 + (8 * g4 + 4 * hi) * 4) = (f32x4){x[4 * g4], x[4 * g4 + 1], x[4 * g4 + 2], x[4 * g4 + 3]};
            } }
    } else if (role == 1) {
        f32x16 o[2] = {};
        for (int sb = 0; sb <= tb; ++sb) {
            const f32x16 x = gram_tile(lds, L_KK, L_KT, sb, tb, r32, hi, true);
#pragma unroll
            for (int ks = 0; ks < 2; ++ks) { const bf16x8 a = acc_frag(x, ks, 1.f);
#pragma unroll
                for (int ib = 0; ib < 2; ++ib) o[ib] = MFMA32(a, lds_frag_perm(lds + L_VT, 32 * ib + r32, 32 * sb + 16 * ks, hi), o[ib]); }
        }
#pragma unroll
        for (int ib = 0; ib < 2; ++ib)
#pragma unroll
            for (int r = 0; r < 16; ++r) *(LAS float*)(lds + L_RHS2 + (32 * tb + (r & 3) + 8 * (r >> 2) + 4 * hi) * RPF + (32 * ib + r32) * 4) = o[ib][r];
    } else if (role == 2) {
#pragma unroll
        for (int sb = 0; sb < 2; ++sb) { x4f[sb][0] = (bf16x8){}; x4f[sb][1] = (bf16x8){}; }
        keep[0] = (f32x16){}; keep[1] = (f32x16){};
        for (int sb = 0; sb <= tb; ++sb) {
            const f32x16 x3 = gram_tile(lds, L_KK, L_RT, sb, tb, r32, hi, false), x4 = gram_tile(lds, L_BT, L_RT, sb, tb, r32, hi, false);
#pragma unroll
            for (int ks = 0; ks < 2; ++ks) { const bf16x8 a3 = acc_frag(x3, ks, 1.f); const bf16x8 a4 = acc_frag(x4, ks, -1.f);
                if (sb == 0) x4f[0][ks] = a4; else x4f[1][ks] = a4;
#pragma unroll
                for (int cb = 0; cb < 2; ++cb) keep[cb] = MFMA32(a3, lds_frag_perm(lds + L_VT, 32 * cb + r32, 32 * sb + 16 * ks, hi), keep[cb]); }
        }
    } else {
        keep[0] = (f32x16){}; keep[1] = (f32x16){};
#pragma unroll
        for (int ks = 0; ks < 4; ++ks) { const bf16x8 ak = lds_frag_nat(lds + L_KKT, 32 * tb + r32, ks, hi);
#pragma unroll
            for (int cb = 0; cb < 2; ++cb) keep[cb] = MFMA32(ak, lds_frag_nat(lds + L_VT, 32 * cb + r32, ks, hi), keep[cb]); }
    }
    lds_barrier();
    if (w < 2) {
        const LAS unsigned char* a1p = lds + L_A1; asm volatile("" : "+v"(a1p));
        LAS unsigned char* xp = lds + (w == 0 ? L_X0 : L_RHS2) + lane * 4; asm volatile("" : "+v"(xp));
        const LAS unsigned char* kp = lds + L_KT + lane * 2; asm volatile("" : "+v"(kp));
        LAS unsigned char* dst = lds + (w == 0 ? L_WT : L_U0T) + lane * RPB; asm volatile("" : "+v"(dst));
#pragma unroll
        for (int B = 0; B < 2; ++B) {
            float acc[32];
            if (w == 0 && B == 0) {
#pragma unroll
                for (int r = 0; r < 32; ++r) acc[r] = bf_lo((unsigned)*(const LAS bf16_t*)(kp + r * RPB));
            } else {
#pragma unroll
                for (int r = 0; r < 32; ++r) acc[r] = *(const LAS float*)(xp + (32 * B + r) * RPF);
            }
            f32x2 ac2[16];
#pragma unroll
            for (int k = 0; k < 16; ++k) ac2[k] = (f32x2){acc[2 * k], acc[2 * k + 1]};
            f32x4 ca[8], cn[8];
#pragma unroll
            for (int tg = 0; tg < 8; ++tg) ca[tg] = *(const LAS f32x4*)(a1p + B * 4608 + tg * 16);
#pragma unroll
            for (int s_ = 0; s_ < 31; ++s_) {
                if (s_ + 1 < 31) {
#pragma unroll
                    for (int tg = (s_ + 2) / 4; tg < 8; ++tg) cn[tg] = *(const LAS f32x4*)(a1p + B * 4608 + (s_ + 1) * 144 + tg * 16);
                }
                __builtin_amdgcn_sched_barrier(0);
                const float xs = ac2[s_ >> 1][s_ & 1];
                const f32x2 xs2 = {xs, xs};
#pragma unroll
                for (int tg = (s_ + 1) / 4; tg < 8; ++tg) {
                    ac2[2 * tg] = __builtin_elementwise_fma((f32x2){ca[tg][0], ca[tg][1]}, xs2, ac2[2 * tg]);
                    ac2[2 * tg + 1] = __builtin_elementwise_fma((f32x2){ca[tg][2], ca[tg][3]}, xs2, ac2[2 * tg + 1]); }
                __builtin_amdgcn_sched_barrier(0);
#pragma unroll
                for (int tg = 0; tg < 8; ++tg) ca[tg] = cn[tg];
            }
#pragma unroll
            for (int k = 0; k < 16; ++k) { acc[2 * k] = ac2[k][0]; acc[2 * k + 1] = ac2[k][1]; }
#pragma unroll
            for (int k8 = 0; k8 < 4; ++k8) { u32x4 v; v.x = pk2(acc[8 * k8], acc[8 * k8 + 1]); v.y = pk2(acc[8 * k8 + 2], acc[8 * k8 + 3]); v.z = pk2(acc[8 * k8 + 4], acc[8 * k8 + 5]); v.w = pk2(acc[8 * k8 + 6], acc[8 * k8 + 7]);
                *(LAS u32x4*)(dst + 64 * B + 16 * k8) = v; }
            if (B == 0) {
                asm volatile("s_waitcnt lgkmcnt(0)" ::: "memory");
                f32x16 u[2];
#pragma unroll
                for (int cb = 0; cb < 2; ++cb)
#pragma unroll
                    for (int r = 0; r < 16; ++r) { const int t = 32 + (r & 3) + 8 * (r >> 2) + 4 * hi;
                        u[cb][r] = w == 0 ? bf_lo((unsigned)*(const LAS bf16_t*)(lds + L_KT + t * RPB + (32 * cb + r32) * 2)) : *(const LAS float*)(lds + L_RHS2 + t * RPF + (32 * cb + r32) * 4); }
#pragma unroll
                for (int ks = 0; ks < 2; ++ks) { const f32x4 a0 = *(const LAS f32x4*)(lds + L_A1 + 9216 + r32 * 144 + (16 * ks + 8 * hi) * 4), a1 = *(const LAS f32x4*)(lds + L_A1 + 9216 + r32 * 144 + (16 * ks + 8 * hi + 4) * 4);
                    u32x4 aw; aw.x = pk2(-a0[0], -a0[1]); aw.y = pk2(-a0[2], -a0[3]); aw.z = pk2(-a1[0], -a1[1]); aw.w = pk2(-a1[2], -a1[3]);
#pragma unroll
                    for (int cb = 0; cb < 2; ++cb) u[cb] = MFMA32(__builtin_bit_cast(bf16x8, aw), lds_frag_nat(lds + (w == 0 ? L_WT : L_U0T), 32 * cb + r32, ks, hi), u[cb]); }
#pragma unroll
                for (int cb = 0; cb < 2; ++cb)
#pragma unroll
                    for (int r = 0; r < 16; ++r) *(LAS float*)(lds + (w == 0 ? L_X0 : L_RHS2) + (32 + (r & 3) + 8 * (r >> 2) + 4 * hi) * RPF + (32 * cb + r32) * 4) = u[cb][r];
                asm volatile("s_waitcnt lgkmcnt(0)" ::: "memory");
            }
        }
    }
    lds_barrier();
    if (role == 2) {
        f32x16 pj[2];
#pragma unroll
        for (int jb = 0; jb < 2; ++jb)
#pragma unroll
            for (int r = 0; r < 16; ++r) pj[jb][r] = bf_lo((unsigned)*(const LAS bf16_t*)(lds + L_RT + (32 * tb + (r & 3) + 8 * (r >> 2) + 4 * hi) * RPB + (32 * jb + r32) * 2));
#pragma unroll
        for (int sb = 0; sb < 2; ++sb)
#pragma unroll
            for (int ks = 0; ks < 2; ++ks)
#pragma unroll
                for (int cb = 0; cb < 2; ++cb) {
                    keep[cb] = MFMA32(x4f[sb][ks], lds_frag_perm(lds + L_U0T, 32 * cb + r32, 32 * sb + 16 * ks, hi), keep[cb]);
                    pj[cb] = MFMA32(x4f[sb][ks], lds_frag_perm(lds + L_WT, 32 * cb + r32, 32 * sb + 16 * ks, hi), pj[cb]); }
        f32x16 (&y0)[2] = keep;
        const unsigned yb = dir ? WS_YB : WS_YF;
#pragma unroll
        for (int r = 0; r < 16; ++r) { const int t = 32 * tb + (r & 3) + 8 * (r >> 2) + 4 * hi; const unsigned tok = seq0 + (dir ? T - 1 - (q0 + t) : q0 + t);
#pragma unroll
            for (int cb = 0; cb < 2; ++cb) { STG(float, F.ws, yb + (tok * 384 + h * 64 + 32 * cb + r32) * 4) = y0[cb][r];
                STG(bf16_t, F.ws, WS_RP + (((unsigned)cid * 64 + t) * 64 + 32 * cb + r32) * 2) = (bf16_t)(pk2(pj[cb][r], 0.f) & 0xffff); } }
    } else if (role == 3) {
        const int jb = tb;
        f32x16 q1[2] = {}, q2[2] = {}; f32x16 (&n1)[2] = keep;
#pragma unroll
        for (int ks = 0; ks < 4; ++ks) { const bf16x8 a = lds_frag_nat(lds + L_BTT, 32 * jb + r32, ks, hi);
#pragma unroll
            for (int cb = 0; cb < 2; ++cb) { q1[cb] = MFMA32(a, lds_frag_nat(lds + L_WT, 32 * cb + r32, ks, hi), q1[cb]); q2[cb] = MFMA32(a, lds_frag_nat(lds + L_U0T, 32 * cb + r32, ks, hi), q2[cb]); } }
#pragma unroll
        for (int r = 0; r < 16; ++r) { const int j = 32 * jb + (r & 3) + 8 * (r >> 2) + 4 * hi; const float gc = *(const LAS float*)(lds + L_GC + j * 4);
#pragma unroll
            for (int cb = 0; cb < 2; ++cb) {
                STG(float, F.ws, WS_RN + (((((unsigned)cid * 2 + jb) * 2 + cb) * 16 + r) * 64 + lane) * 4) = gc * (n1[cb][r] - q2[cb][r]);
                const float mv = ((unsigned)j == 32 * cb + r32 ? gc : 0.f) - gc * q1[cb][r];
                STG(bf16_t, F.ws, WS_RM + (((unsigned)cid * 64 + j) * 64 + 32 * cb + r32) * 2) = (bf16_t)(pk2(mv, 0.f) & 0xffff); } }
    }
    lds_barrier();
}
__device__ __forceinline__ void rwkv_chain_wave(Frame& F, int l, bool lat, int chain, int ib) {
    int lane = F.lane; asm volatile("" : "+v"(lane));
    const unsigned char* ws = F.ws; const unsigned r32 = lane & 31, hi = lane >> 5;
    const unsigned dir = chain & 1, h = (chain >> 1) % 6, b = chain / 12;
    const int nc = lat ? 64 : 4; const unsigned cid0 = lat ? 768 + chain * 64 : chain * 4;
    const unsigned i = 32 * ib + r32;
    const unsigned so = ((((b * 4 + l) * 6 + h) * 64 + i) * 64) * 4;
    f32x16 H[2];
#pragma unroll
    for (int jb = 0; jb < 2; ++jb)
#pragma unroll
        for (int g4 = 0; g4 < 4; ++g4) { f32x4 v = {0.f, 0.f, 0.f, 0.f}; if (lat) v = LDG(f32x4, dir ? INP(7) : INP(6), so + (32 * jb + 8 * g4 + 4 * hi) * 4);
            H[jb][4 * g4] = v[0]; H[jb][4 * g4 + 1] = v[1]; H[jb][4 * g4 + 2] = v[2]; H[jb][4 * g4 + 3] = v[3]; }
    s16x4 ma[2][2][2][2]; f32x16 nt[2];
#define RB_LOAD(cid_) do { const unsigned mo_ = WS_RM + (((cid_) * 64 + r32) * 64 + 4 * hi) * 2; \
        _Pragma("unroll") for (int jo = 0; jo < 2; ++jo) _Pragma("unroll") for (int ji = 0; ji < 2; ++ji) _Pragma("unroll") for (int ks = 0; ks < 2; ++ks) { \
            ma[jo][ji][ks][0] = LDG(s16x4, ws, mo_ + (jo * 32 * 64 + 32 * ji + 16 * ks) * 2); ma[jo][ji][ks][1] = LDG(s16x4, ws, mo_ + (jo * 32 * 64 + 32 * ji + 16 * ks + 8) * 2); } \
        _Pragma("unroll") for (int jo = 0; jo < 2; ++jo) _Pragma("unroll") for (int r = 0; r < 16; ++r) nt[jo][r] = LDG(float, ws, WS_RN + ((((cid_) * 2 + jo) * 2 + ib) * 16 + r) * 256 + lane * 4); } while (0)
    RB_LOAD(cid0);
    for (int c = 0; c < nc; ++c) {
        const unsigned cid = cid0 + c;
#pragma unroll
        for (int jb = 0; jb < 2; ++jb)
#pragma unroll
            for (int g4 = 0; g4 < 4; ++g4) STG(u32x2, F.ws, WS_RH + ((cid * 64 + i) * 64 + 32 * jb + 8 * g4 + 4 * hi) * 2) = pack4((f32x4){H[jb][4 * g4], H[jb][4 * g4 + 1], H[jb][4 * g4 + 2], H[jb][4 * g4 + 3]});
        bf16x8 hf[2][2];
#pragma unroll
        for (int ji = 0; ji < 2; ++ji) { hf[ji][0] = acc_frag(H[ji], 0, 1.f); hf[ji][1] = acc_frag(H[ji], 1, 1.f); }
        f32x16 acc[2] = {nt[0], nt[1]};
#pragma unroll
        for (int jo = 0; jo < 2; ++jo)
#pragma unroll
            for (int ji = 0; ji < 2; ++ji)
#pragma unroll
                for (int ks = 0; ks < 2; ++ks) { const s16x4 a0 = ma[jo][ji][ks][0], a1 = ma[jo][ji][ks][1];
                    acc[jo] = MFMA32(((bf16x8){a0[0], a0[1], a0[2], a0[3], a1[0], a1[1], a1[2], a1[3]}), hf[ji][ks], acc[jo]); }
        if (c + 1 < nc) RB_LOAD(cid + 1);
        H[0] = acc[0]; H[1] = acc[1];
    }
#undef RB_LOAD
    if (!lat) {
#pragma unroll
        for (int jb = 0; jb < 2; ++jb)
#pragma unroll
            for (int g4 = 0; g4 < 4; ++g4) STG(f32x4, F.out, (dir ? OFF_CB : OFF_CF) * 4 + so + (32 * jb + 8 * g4 + 4 * hi) * 4) = (f32x4){H[jb][4 * g4], H[jb][4 * g4 + 1], H[jb][4 * g4 + 2], H[jb][4 * g4 + 3]};
    }
}
__device__ __forceinline__ void rwkv_apply_wave(Frame& F, int item) {
    int lane = F.lane; asm volatile("" : "+v"(lane));
    const unsigned char* ws = F.ws; const unsigned r32 = lane & 31, hi = lane >> 5;
    const int cid = item >> 1, tb = item & 1;
    unsigned seq0, b, h, dir; int T, c; chunk_decode(cid, seq0, T, b, h, dir, c);
    const unsigned yb = dir ? WS_YB : WS_YF;
    f32x16 acc[2];
#pragma unroll
    for (int r = 0; r < 16; ++r) { const int t = 32 * tb + (r & 3) + 8 * (r >> 2) + 4 * hi; const unsigned tok = seq0 + (dir ? T - 1 - (64 * c + t) : 64 * c + t);
        acc[0][r] = LDG(float, ws, yb + (tok * 384 + h * 64 + r32) * 4); acc[1][r] = LDG(float, ws, yb + (tok * 384 + h * 64 + 32 + r32) * 4); }
#pragma unroll
    for (int ks = 0; ks < 4; ++ks) { const bf16x8 a = LDG(bf16x8, ws, WS_RP + (((unsigned)cid * 64 + 32 * tb + r32) * 64 + 16 * ks + 8 * hi) * 2);
#pragma unroll
        for (int ib = 0; ib < 2; ++ib) acc[ib] = MFMA32(a, LDG(bf16x8, ws, WS_RH + (((unsigned)cid * 64 + 32 * ib + r32) * 64 + 16 * ks + 8 * hi) * 2), acc[ib]); }
#pragma unroll
    for (int r = 0; r < 16; ++r) { const int t = 32 * tb + (r & 3) + 8 * (r >> 2) + 4 * hi; const unsigned tok = seq0 + (dir ? T - 1 - (64 * c + t) : 64 * c + t);
        STG(float, F.ws, yb + (tok * 384 + h * 64 + r32) * 4) = acc[0][r]; STG(float, F.ws, yb + (tok * 384 + h * 64 + 32 + r32) * 4) = acc[1][r]; }
}

__device__ __forceinline__ void rwkv_out_item(Frame& F, int l, int item) {
    int lane = F.lane; asm volatile("" : "+v"(lane));
    const unsigned char* ws = F.ws; const unsigned r32 = lane & 31, hi = lane >> 5;
    const int tb = item & 1, h = (item >> 1) % 6, sk = item / 12;
    const bool lat = sk >= 64; const int b = lat ? (sk - 64) >> 6 : sk >> 2, k = lat ? (sk - 64) & 63 : sk & 3, nc = lat ? 64 : 4;
    const unsigned seq0 = lat ? MC + b * 4096 : b * 256, base = lat ? 768u : 0u;
    const unsigned chf = (b * 6 + h) * 2, cidf = base + chf * nc + k, cidb = base + (chf + 1) * nc + (nc - 1 - k);
    const unsigned tok0 = seq0 + 64 * k + 32 * tb;
    f32x16 acc[2];
#pragma unroll
    for (int r = 0; r < 16; ++r) { const unsigned tok = tok0 + (r & 3) + 8 * (r >> 2) + 4 * hi; const unsigned e = (tok * 384 + h * 64 + r32) * 4;
        acc[0][r] = LDG(float, ws, WS_YF + e) + LDG(float, ws, WS_YB + e); acc[1][r] = LDG(float, ws, WS_YF + e + 128) + LDG(float, ws, WS_YB + e + 128); }
    const unsigned pf = 32 * tb + r32, pb_ = 63 - 32 * tb - r32;
#pragma unroll
    for (int ks = 0; ks < 4; ++ks) {
        const bf16x8 af = LDG(bf16x8, ws, WS_RP + ((cidf * 64 + pf) * 64 + 16 * ks + 8 * hi) * 2), ab = LDG(bf16x8, ws, WS_RP + ((cidb * 64 + pb_) * 64 + 16 * ks + 8 * hi) * 2);
#pragma unroll
        for (int ib = 0; ib < 2; ++ib) { acc[ib] = MFMA32(af, LDG(bf16x8, ws, WS_RH + ((cidf * 64 + 32 * ib + r32) * 64 + 16 * ks + 8 * hi) * 2), acc[ib]);
            acc[ib] = MFMA32(ab, LDG(bf16x8, ws, WS_RH + ((cidb * 64 + 32 * ib + r32) * 64 + 16 * ks + 8 * hi) * 2), acc[ib]); } }
    const float g0 = LDG(float, INP(27), (l * 384 + h * 64 + r32) * 4), g1 = LDG(float, INP(27), (l * 384 + h * 64 + 32 + r32) * 4), b0 = LDG(float, INP(28), (l * 384 + h * 64 + r32) * 4), b1 = LDG(float, INP(28), (l * 384 + h * 64 + 32 + r32) * 4);
    const int xl = (lane ^ 16) << 2;
#pragma unroll
    for (int r = 0; r < 16; ++r) { const unsigned tok = tok0 + (r & 3) + 8 * (r >> 2) + 4 * hi; const unsigned e = tok * 384 + h * 64 + r32;
        const float bon = LDG(float, ws, WS_SB + (tok * 8 + h) * 4) + LDG(float, ws, WS_SB + ((M + tok) * 8 + h) * 4);
        const float y0 = acc[0][r] + bon * LDG(float, ws, WS_SV + e * 4), y1 = acc[1][r] + bon * LDG(float, ws, WS_SV + (e + 32) * 4);
        float s = allreduce16(y0 + y1); s += __builtin_bit_cast(float, __builtin_amdgcn_ds_bpermute(xl, __builtin_bit_cast(int, s)));
        const float mu = s * (1.f / 64.f), d0 = y0 - mu, d1 = y1 - mu;
        float q = allreduce16(d0 * d0 + d1 * d1); q += __builtin_bit_cast(float, __builtin_amdgcn_ds_bpermute(xl, __builtin_bit_cast(int, q)));
        const float rs = rsqrtf(q * (1.f / 64.f) + 64e-5f);
        const float o0 = (d0 * rs * g0 + b0) * bf_lo((unsigned)LDG(bf16_t, ws, WS_G + e * 2)), o1 = (d1 * rs * g1 + b1) * bf_lo((unsigned)LDG(bf16_t, ws, WS_G + (e + 32) * 2));
        const unsigned pk = pk2(o0, o1);
        STG(bf16_t, F.ws, WS_ACT + (tok * DM + 640 + h * 64 + r32) * 2) = (bf16_t)(pk & 0xffff); STG(bf16_t, F.ws, WS_ACT + (tok * DM + 640 + h * 64 + 32 + r32) * 2) = (bf16_t)(pk >> 16); }
}

constexpr int AU_R = 8, AU_D = 4, AU_SLOT = 6144;
__device__ __forceinline__ void attn_b_unit(Frame& F, int l, int unit) {
    int lane = F.lane; asm volatile("" : "+v"(lane));
    const unsigned char* ws = F.ws; LAS unsigned char* lds = F.lds;
    const int w = F.wave; const unsigned r32 = lane & 31, hi = lane >> 5;
    const unsigned kh = unit & 1, qb = (unit >> 1) & 15, mp = (unit >> 5) & 1, h = (unit >> 6) & 3, b = unit >> 8;
    const unsigned seq0 = MC + b * 4096, row = seq0 + qb * 256 + 32 * w + r32;
    bf16x8 qf[1][2];
#pragma unroll
    for (int s = 0; s < 2; ++s) qf[0][s] = LDG(bf16x8, ws, WS_QB + (row * 256 + h * 64 + mp * 32 + 8 * hi) * 2 + 32 * s);
    AttnQ st[1]; attnq_init(st[0], 0.f);
    const int qpos[1] = {0};
    const int n0 = kh ? 56 : 72, nt = 72;
    const unsigned pofs = (w < 2 ? (h * 2 + mp) * 2048 + w * 1024 : h * 4096 + (w - 2) * 1024) + lane * 16;
    const unsigned base0 = (w < 2 ? WS_KB : WS_VTB) + ((seq0 >> 5) + (kh ? 72u : 0u)) * 16384 + pofs;
    const unsigned base1 = WS_CACHE + (w < 2 ? 2 * MiB : 4 * MiB) + (b * 4 + l) * 262144 + pofs;
#define AU_DMA(t_) do { const int tt_ = (t_) < nt ? (t_) : nt - 1; const unsigned src_ = tt_ < n0 ? base0 + tt_ * 16384 : base1 + (tt_ - n0) * 16384; \
        __builtin_amdgcn_global_load_lds((const GAS unsigned*)(ws + src_), (LAS unsigned*)(lds + ((t_) % AU_R) * AU_SLOT + w * 1024), 16, 0, 0); } while (0)
    if (w < 6) {
#pragma unroll
        for (int t = 0; t < AU_D; ++t) AU_DMA(t);
    }
    for (int t = 0; t < nt; ++t) {
        if (w < 6) asm volatile("s_waitcnt vmcnt(3)" ::: "memory");
        asm volatile("s_barrier" ::: "memory");
        const LAS unsigned char* sl = lds + (t % AU_R) * AU_SLOT + lane * 16;
        bf16x8 kf[2], vf[4];
        kf[0] = *(const LAS bf16x8*)(sl); kf[1] = *(const LAS bf16x8*)(sl + 1024);
#pragma unroll
        for (int f = 0; f < 4; ++f) vf[f] = *(const LAS bf16x8*)(sl + 2048 + 1024 * f);
        if (w < 6) AU_DMA(t + AU_D);
        attn_block<32, false, 1>(qf, kf, vf, st, t, qpos, 0, hi);
    }
#undef AU_DMA
    asm volatile("s_waitcnt vmcnt(0) lgkmcnt(0)\n\ts_barrier" ::: "memory");
    attn_b_store(F, st[0], mp, kh, row, h, hi);
}

constexpr int Q_BLAT = 2048, Q_ALAT = 1536, Q_BCTX = 1024, Q_ACTX = 768;
constexpr int Q_TOTAL = Q_BLAT + Q_ALAT + Q_BCTX + Q_ACTX;
#ifndef XCD_DEAL
#define XCD_DEAL 0
#endif
__device__ __forceinline__ void phase_mixer(Frame& F, int l, int rep) {
    if (rep == 0 || REP_PART == 0 || REP_PART == 1) {
        const int si = F.bid + F.G * F.wave;
        if (si < 48) rwkv_chain_wave(F, l, true, si >> 1, si & 1);
        else if (si < 48 + 384) rwkv_chain_wave(F, l, false, (si - 48) >> 1, (si - 48) & 1);
    }
    if (rep == 0 || REP_PART == 2 || REP_PART == 4) {
        unsigned* uctr = (unsigned*)(F.ws + WS_CTL) + 64 * (32 + l + 4 * rep);
        LAS int* ubox = (LAS int*)(F.lds + 65536);
        for (;;) {
            if (F.wave == 0 && F.lane == 0) *ubox = (int)atomicAdd(uctr, 1u);
            lds_barrier();
            const int un = __builtin_amdgcn_readfirstlane(*ubox);
            lds_barrier();
            if (un >= 512) break;
            attn_b_unit(F, l, un);
        }
    }
    unsigned* ctr = (unsigned*)(F.ws + WS_CTL) + 64 * (1 + l + 4 * rep);
    if (rep == 0 || REP_PART != 1) for (;;) {
        int it = 0;
        if (F.lane == 0) it = (int)atomicAdd(ctr, 1u);
        it = __builtin_amdgcn_readfirstlane(it) + Q_BLAT;
        if (it >= Q_TOTAL) break;
        if (it < Q_BLAT) { if (rep == 0 || REP_PART == 2 || REP_PART == 4) attn_b_item(F, l, true, it); continue; } it -= Q_BLAT;
        if (it < Q_ALAT) { if (rep == 0 || REP_PART == 2 || REP_PART == 3) attn_a_item(F, l, true, it); continue; } it -= Q_ALAT;
        if (it < Q_BCTX) { if (rep == 0 || REP_PART == 2 || REP_PART == 5) attn_b_item(F, l, false, it); continue; } it -= Q_BCTX;
        if (rep == 0 || REP_PART == 2 || REP_PART == 5) attn_a_item(F, l, false, it);
    }
}

__device__ __forceinline__ void phase_finalize(Frame& F, int l) {
    const unsigned char* ws = F.ws;
    const unsigned lane = F.lane;
    const float lami = 0.8f - 0.6f * __expf(-0.3f * (float)l);
    const float lam = LDG(float, ws, WS_TAB + (TAB_LAM + l) * 4) + lami;
    const float omli = 1.f - lami;
    const float sg = LDG(float, INP(17), (l * 64 + lane) * 4);
    for (unsigned row = F.gw; row < M; row += F.ngw) {
#pragma unroll
        for (int k = 0; k < 4; ++k) { float om[2];
#pragma unroll
            for (int mp = 0; mp < 2; ++mp) { const unsigned o0 = (((mp * 2) * M + row) * 256 + 64 * k + lane) * 2, q0 = ((((mp * 2) * M + row) * 4 + k) * 2) * 4;
                const f32x2 ml0 = LDG(f32x2, ws, WS_ML + q0);
                if (row >= MC) { const f32x2 ml1 = LDG(f32x2, ws, WS_ML + q0 + M * 32); const float ms = fmaxf(ml0[0], ml1[0]), w0 = __builtin_amdgcn_exp2f(ml0[0] - ms), w1 = __builtin_amdgcn_exp2f(ml1[0] - ms);
                    om[mp] = (bf_lo((unsigned)LDG(bf16_t, ws, WS_BO2 + o0)) * w0 + bf_lo((unsigned)LDG(bf16_t, ws, WS_BO2 + o0 + M * 512)) * w1) * __builtin_amdgcn_rcpf(ml0[1] * w0 + ml1[1] * w1); }
                else om[mp] = bf_lo((unsigned)LDG(bf16_t, ws, WS_BO2 + o0)) * __builtin_amdgcn_rcpf(ml0[1]); }
            const float v = om[0] - lam * om[1];
            const float ms = wave_sum(v * v) * (1.f / 64.f);
            STG(bf16_t, F.ws, WS_ACT + (row * DM + 384 + 64 * k + lane) * 2) = (bf16_t)(pk2(v * rsqrtf(ms + 1e-6f) * sg * omli, 0.f) & 0xffff); }
    }
}


typedef unsigned v4u __attribute__((ext_vector_type(4)));
#define XB_TMO      128
#define XB_XCNT(j)  (256  + 64 * (j))
#define XB_XSUB(j)  (1280 + 64 * (j))
#define XB_XGEN(j)  (2304 + 64 * (j))
#define XB_TOP      3328
#define XB_TOPGEN   3392
#define XCD_BAR_WORDS 3456
#define XB_SPIN_CAP (1u << 18)

__device__ __forceinline__ unsigned xb_ld(unsigned* p)              { return __hip_atomic_load(p, __ATOMIC_RELAXED, __HIP_MEMORY_SCOPE_AGENT); }
__device__ __forceinline__ unsigned xb_add(unsigned* p, unsigned v) { return __hip_atomic_fetch_add(p, v, __ATOMIC_RELAXED, __HIP_MEMORY_SCOPE_AGENT); }
__device__ __forceinline__ unsigned xb_xcc_id() { return (unsigned)__builtin_amdgcn_s_getreg((3 << 11) | 20) & 0xFu; }
#define XB_SPIN(cond, bar) do { unsigned _sp = 0; while (cond) { __builtin_amdgcn_s_sleep(1); \
    if ((++_sp & 255u) == 0u) { if (xb_ld(&(bar)[XB_TMO])) break; if (_sp > XB_SPIN_CAP) { atomicAdd(&(bar)[XB_TMO], 1u); break; } } } } while (0)

struct XcdBarrier {
    unsigned* bar; unsigned x;
    volatile LAS unsigned* st;
};

__device__ __forceinline__ XcdBarrier xcd_barrier_post(unsigned* bar, volatile LAS unsigned* st) {
    XcdBarrier b; b.bar = bar; b.x = xb_xcc_id(); b.st = st;
    if (threadIdx.x == 0) (void)xb_add(&bar[XB_XCNT(b.x)], 1u);
    return b;
}
__device__ __forceinline__ void xcd_barrier_complete(unsigned* bar, unsigned x, unsigned& nloc, unsigned& nx) {
    const unsigned G = gridDim.x * gridDim.y * gridDim.z;
    unsigned sum, cnt, mine, sp = 0u;
    for (;;) {
        sum = 0u; cnt = 0u; mine = 0u;
#pragma unroll
        for (unsigned j = 0; j < 16; ++j) { const unsigned c = xb_ld(&bar[XB_XCNT(j)]); sum += c; cnt += (c > 0u) ? 1u : 0u; mine = (j == x) ? c : mine; }
        if (sum == G) break;
        __builtin_amdgcn_s_sleep(1);
        if ((++sp & 255u) == 0u) { if (xb_ld(&bar[XB_TMO])) break; if (sp > XB_SPIN_CAP) { atomicAdd(&bar[XB_TMO], 1u); break; } }
    }
    nloc = mine > 0u ? mine : 1u; nx = cnt > 0u ? cnt : 1u;
}

__device__ __forceinline__ void xcd_barrier(const XcdBarrier& b) {
    asm volatile("s_waitcnt vmcnt(0)" ::: "memory");
    __syncthreads();
    if (threadIdx.x == 0) {
        unsigned* bar = b.bar;
        __builtin_amdgcn_s_waitcnt(0);
        unsigned nloc = b.st[0], nx = b.st[1];
        if (nloc == 0u) { xcd_barrier_complete(bar, b.x, nloc, nx); b.st[0] = nloc; b.st[1] = nx; }
        const unsigned old = xb_add(&bar[XB_XSUB(b.x)], 1u);
        const unsigned gen = old / nloc;
        if (old + 1u == (gen + 1u) * nloc) {
            __builtin_amdgcn_fence(__ATOMIC_RELEASE, "agent");
            asm volatile("s_waitcnt vmcnt(0)" ::: "memory");
            const unsigned og = xb_add(&bar[XB_TOP], 1u);
            const unsigned tg = og / nx;
            if (og + 1u == (tg + 1u) * nx) xb_add(&bar[XB_TOPGEN], 1u);
            else XB_SPIN(xb_ld(&bar[XB_TOPGEN]) == tg, bar);
            __builtin_amdgcn_fence(__ATOMIC_ACQUIRE, "agent");
            xb_add(&bar[XB_XGEN(b.x)], 1u);
            asm volatile("s_waitcnt vmcnt(0)" ::: "memory");
        } else {
            XB_SPIN(xb_ld(&bar[XB_XGEN(b.x)]) == gen, bar);
            __builtin_amdgcn_fence(__ATOMIC_ACQUIRE, "agent");
            asm volatile("s_waitcnt vmcnt(0)" ::: "memory");
        }
    }
    __syncthreads();
}

#ifndef DIS
#define DIS 0
#endif
#ifndef REP_PHASE
#define REP_PHASE -1
#define REP_COUNT 1
#endif
constexpr int NEXTRA = (REP_PHASE >= 0 && REP_PHASE < 9) ? REP_COUNT - 1 : 0, NPL = 9 + NEXTRA, NPRE = (REP_PHASE == 100) ? REP_COUNT : 1, NPHASE_RUN = NPRE + 1 + NPL * DEPTH;
__global__ void __launch_bounds__(512, 2) mega(Args a) {
    extern __shared__ __attribute__((aligned(16))) unsigned char lds[];
    Frame F;
    F.lds = (LAS unsigned char*)lds;
    volatile LAS unsigned* bst = (volatile LAS unsigned*)(F.lds + LDS_BYTES - 64);
    if (threadIdx.x < 2) bst[threadIdx.x] = 0u;
    __syncthreads();
    const XcdBarrier xbar = xcd_barrier_post((unsigned*)((GAS unsigned char*)a.ws + WS_CTL) + 4096, bst);
    const int wave_id = __builtin_amdgcn_readfirstlane((int)threadIdx.x >> 6);
    for (int ph = a.ph_lo; ph < a.ph_hi; ++ph) {
        { const unsigned char* kp = (const unsigned char*)__builtin_amdgcn_kernarg_segment_ptr(); asm volatile("" : "+s"(kp));
          const Args* ap = (const Args*)kp; F.in = ap->in; F.out = gptr(ap->out); F.ws = gptr(ap->ws); }
        { unsigned ones = ~0u; asm volatile("" : "+s"(ones)); int ln = (int)__builtin_amdgcn_mbcnt_hi(ones, __builtin_amdgcn_mbcnt_lo(ones, 0u)); int wv = wave_id, bid = (int)blockIdx.x, gg = (int)gridDim.x; asm volatile("" : "+s"(wv), "+s"(bid), "+s"(gg));
          F.lane = ln; F.wave = wv; F.bid = bid; F.G = gg; F.ngw = gg * 8; F.tid = wv * 64 + ln; F.gw = bid * 8 + wv; }
        if (ph < NPRE) { if (!(DIS & 1)) phase_prologue(F); }
        else if (ph == NPHASE_RUN - 1) { if (!(DIS & 2)) phase_final_norm(F); }
        else {
            const int l = (ph - NPRE) / NPL, sidx = (ph - NPRE) % NPL, rep = (REP_PHASE >= 0 && REP_PHASE < 9 && sidx > REP_PHASE && sidx <= REP_PHASE + NEXTRA) ? sidx - REP_PHASE : 0, s = (REP_PHASE >= 0 && REP_PHASE < 9 && sidx > REP_PHASE) ? (sidx <= REP_PHASE + NEXTRA ? REP_PHASE : sidx - NEXTRA) : sidx;
            if (s == 0) { convert_weights(F, l); phase_norm(F, l, 0); }
            else if (s == 1) {
                pg8::Gemm g{WSP(bf16_t, WS_ACT), WSP(bf16_t, WS_WIN + 0u * WSET_STRIDE), M, NIN, 1024}; pg8::StaticOrder S; S.init(M, NIN, F.G, F.bid);
                EpiWin E{F.ws, F.out, l};
                if (!(DIS & 16)) pg8::gemm_phase<EpiWin, pg8::StaticOrder, false, true>(F.lds, g, S, E, F.tid);
                if (false) { const int wv_ = (F.bid - 64) * 8 + F.wave; convert_item_any(F, l + 1, wv_); if (wv_ < CV_TOTAL - 1536) convert_item_any(F, l + 1, 1536 + wv_); }
            }
            else if (s == 2) { for (int cid = F.bid; cid < NCHUNK; cid += F.G) rwkv_chunk_block(F, l, cid); }
            else if (s == 3) { if (!(DIS & 64)) phase_mixer(F, l, rep); }
            else if (s == 4) { phase_finalize(F, l); for (int it = F.gw; it < 192 * 12; it += F.ngw) rwkv_out_item(F, l, it); }
            else if (s == 5 || s == 8) {
                const bool second = s == 8;
                pg8::Gemm g{second ? WSP(bf16_t, WS_U) : WSP(bf16_t, WS_ACT), second ? WSP(bf16_t, WS_W2 + 0u * WSET_STRIDE) : WSP(bf16_t, WS_WOUT + 0u * WSET_STRIDE), M, 1024, second ? FF : 1024};
                pg8::StaticOrder S; S.init(M, 1024, F.G, F.bid);
                const bool first = (l == 0 && !second);
                EpiRes E{first ? INP(0) : F.out, first ? INP(1) - (size_t)MC * DM : F.out, F.out, WSP(float, WS_MOD) + (size_t)l * 3 * 6144 + (second ? 5120 : 2048)};
                if (!(DIS & 256)) pg8::gemm_phase<EpiRes, pg8::StaticOrder, false, true>(F.lds, g, S, E, F.tid);
            }
            else if (s == 6) { if (!(DIS & 8)) phase_norm(F, l, 1); }
            else {
                pg8::Gemm g{WSP(bf16_t, WS_ACT), WSP(bf16_t, WS_W13 + 0u * WSET_STRIDE), M, NFF2, 1024}; pg8::StaticOrder S; S.init(M, NFF2, F.G, F.bid);
                EpiSwi E{WSP(bf16_t, WS_U)};
                if (!(DIS & 512)) pg8::gemm_phase<EpiSwi, pg8::StaticOrder, true, true>(F.lds, g, S, E, F.tid);
            }
        }
        if (ph + 1 < a.ph_hi) { if (ph == a.ph_lo) { __threadfence(); cg::this_grid().sync(); } else xcd_barrier(xbar); }
    }
}

extern "C" void kernel_launch(void* const* d_in, const int* in_sizes, int n_in, void* d_out, int out_size, void* d_ws, size_t ws_size, hipStream_t stream) {
    static int grid = 0;
    if (grid == 0) {
        int dev = 0, cus = 0, per_cu = 0;
        if (n_in != 34 || ws_size < WS_END) { fprintf(stderr, "kernel_launch: unexpected n_in %d / ws_size %zu (need %zu)\n", n_in, ws_size, (size_t)WS_END); grid = -1; return; }
        if (hipGetDevice(&dev) != hipSuccess || hipDeviceGetAttribute(&cus, hipDeviceAttributeMultiprocessorCount, dev) != hipSuccess) { grid = -1; return; }
        if (hipFuncSetAttribute((const void*)mega, hipFuncAttributeMaxDynamicSharedMemorySize, LDS_BYTES) != hipSuccess) { fprintf(stderr, "kernel_launch: hipFuncSetAttribute failed\n"); grid = -1; return; }
        if (hipOccupancyMaxActiveBlocksPerMultiprocessor(&per_cu, (const void*)mega, 512, LDS_BYTES) != hipSuccess || per_cu < 1) { fprintf(stderr, "kernel_launch: occupancy query says %d\n", per_cu); per_cu = 1; }
        (void)hipGetLastError();
        grid = cus * 1;
        if (grid > cus * per_cu) grid = cus * per_cu;
    }
    if (grid < 0) return;
    (void)hipMemsetAsync((char*)d_ws + WS_CTL, 0, CTL_BYTES, stream);
    Args a{};
    for (int i = 0; i < 34; ++i) a.in[i] = (const float*)d_in[i];
    a.out = (float*)d_out; a.ws = (unsigned char*)d_ws;
#if MK_ONE_LAUNCH
    a.ph_lo = 0; a.ph_hi = NPHASE_RUN;
    void* args[] = {&a};
    hipError_t e = hipLaunchCooperativeKernel((const void*)mega, dim3(grid), dim3(512), args, LDS_BYTES, stream);
    if (e != hipSuccess) fprintf(stderr, "kernel_launch: cooperative launch failed: %s (grid %d)\n", hipGetErrorString(e), grid);
#else
    for (int ph = 0; ph < NPHASE_RUN; ++ph) { a.ph_lo = ph; a.ph_hi = ph + 1; hipLaunchKernelGGL(mega, dim3(grid), dim3(512), LDS_BYTES, stream, a); }
#endif
}
```

```cpp
#include <hip/hip_runtime.h>
#include <hip/hip_cooperative_groups.h>
#include <cstdio>
#include <cstdint>
namespace cg = cooperative_groups;

#ifndef MK_ONE_LAUNCH
#define MK_ONE_LAUNCH 1
#endif

#undef MK_ONE_LAUNCH
#define MK_ONE_LAUNCH 1
#define REP_PHASE -1
#define REP_COUNT 1
#define REP_PART 0
#define RA_REP 0
#define ATT_PROBE 0
namespace pg8 {
#define PG8_LAS __attribute__((address_space(3)))
typedef unsigned short bf16_t;
typedef short bf16x8 __attribute__((ext_vector_type(8)));
typedef float f32x4 __attribute__((ext_vector_type(4)));
typedef unsigned u32x4 __attribute__((ext_vector_type(4)));
constexpr int BM = 256, BK = 64, HALF = 128, HTB = HALF * BK * 2  , STAGE_BYTES = 8 * HTB, NXCD = 8, WGM = 8;

__host__ __device__ __forceinline__ int lds_byte(int r, int c) { const int st = (r >> 4) * 2 + (c >> 5), rr = r & 15, cc = c & 31, ob = rr * 64 + cc * 2; return st * 1024 + (ob ^ (((ob >> 9) & 1) << 5)); }
__host__ __device__ __forceinline__ void stage_rc(int b, int& R, int& C) { const int st = b / 1024, sb = b % 1024, swz = sb ^ (((sb >> 9) & 1) << 5); R = (st >> 1) * 16 + swz / 64; C = (st & 1) * 32 + (swz % 64) / 2; }
__host__ __device__ __forceinline__ int perm32(int rho) { const int n = rho >> 4, i = rho & 15; return 8 * (i >> 2) + 4 * n + (i & 3); }

struct Unit { int pm, pn; };
struct Gemm { const bf16_t* A; const bf16_t* Bt; int M, N, K; };

struct StaticOrder {
    int nM, nN, nwg, G, c;
    __host__ __device__ void init(int M, int N, int G_, int c_, int bm = BM) { nM = M / bm; nN = N / BM; nwg = nM * nN; G = G_; c = c_; }
    __host__ __device__ bool next(int i, Unit& u) const {
        const long L = (long)i * G + c; if (L >= nwg) return false;
        int wgid = (int)L; { const int q = nwg / NXCD, r = nwg % NXCD, xcd = wgid % NXCD, off = wgid / NXCD; wgid = (xcd < r ? xcd * (q + 1) : r * (q + 1) + (xcd - r) * q) + off; }
        const int nig = WGM * nN, gid = wgid / nig, fm = gid * WGM, gsz = (nM - fm) < WGM ? (nM - fm) : WGM;
        u.pm = fm + ((wgid % nig) % gsz); u.pn = (wgid % nig) / gsz; return true;
    }
    __device__ __forceinline__ void a_ready(const Unit&) const {}
    __device__ __forceinline__ void done(const Unit&) const {}
};

template <class Epi, class Sched, bool ALIGN_EPI = false, bool SP2 = false, int MF = 4>
__device__ __forceinline__ void gemm_phase(PG8_LAS unsigned char* lds, const Gemm g, const Sched& S, const Epi& E, const int tid_in) {
    const int tid = tid_in, wid = __builtin_amdgcn_readfirstlane(tid >> 6), lane = tid & 63, wr = wid >> 2, wc = wid & 3, fr = lane & 15, fq = lane >> 4;
    static_assert(MF == 4 || (MF == 3 && SP2), "192-row tiles: SP2 schedule only");
    const int K = g.K, nt = K / BK;
    unsigned voffA[2], voffB[2];
#pragma unroll
    for (int i = 0; i < 2; ++i) { int R, C; stage_rc(tid * 16 + i * 8192, R, C); const int Rb = Epi::PERM ? ((R & ~31) + perm32(R & 31)) : R;
        voffA[i] = (unsigned)(R * K + C) * 2u; voffB[i] = (unsigned)(Rb * K + C) * 2u; }
    const size_t kstep = (size_t)(BK * 2);
    const size_t hstep = (size_t)HALF * K * 2;
    const size_t tstep = 2 * hstep;
    const size_t hstepA = (size_t)(MF * 32) * K * 2, tstepA = 2 * hstepA;
    const unsigned ldsw = (unsigned)wid * 1024u;
    const int aoff = lds_byte(wr * (MF * 16) + fr, fq * 8), boff = lds_byte(wc * 32 + fr, fq * 8);
#define PG8_SA(b, h) (((b) * 2 + (h)) * HTB)
#define PG8_SB(b, h) ((4 + (b) * 2 + (h)) * HTB)
#define PG8_STAGE(bufoff, gbase, voff) do { _Pragma("unroll") for (int _i = 0; _i < 2; ++_i) \
        __builtin_amdgcn_global_load_lds((const unsigned*)((const char*)(gbase) + (voff)[_i]), (PG8_LAS unsigned*)(lds + (bufoff) + ldsw + _i * 8192), 16, 0, 0); } while (0)
#define PG8_STAGEA(bufoff, gbase, voff) do { __builtin_amdgcn_global_load_lds((const unsigned*)((const char*)(gbase) + (voff)[0]), (PG8_LAS unsigned*)(lds + (bufoff) + ldsw), 16, 0, 0); \
        if (MF == 4 || wr == 0) __builtin_amdgcn_global_load_lds((const unsigned*)((const char*)(gbase) + (voff)[1]), (PG8_LAS unsigned*)(lds + (bufoff) + ldsw + 8192), 16, 0, 0); } while (0)
#define PG8_LDA(dst, b, h) do { _Pragma("unroll") for (int m = 0; m < MF; ++m) _Pragma("unroll") for (int k = 0; k < 2; ++k) dst[m][k] = *(const PG8_LAS bf16x8*)(lds + PG8_SA(b, h) + aoff + m * 2048 + k * 1024); } while (0)
#define PG8_LDB(dst, b, h) do { _Pragma("unroll") for (int n = 0; n < 2; ++n) _Pragma("unroll") for (int k = 0; k < 2; ++k) dst[n][k] = *(const PG8_LAS bf16x8*)(lds + PG8_SB(b, h) + boff + n * 2048 + k * 1024); } while (0)
#define PG8_MMA(ai, bj, At, Bt) do { __builtin_amdgcn_s_setprio(1); _Pragma("unroll") for (int m = 0; m < MF; ++m) _Pragma("unroll") for (int n = 0; n < 2; ++n) _Pragma("unroll") for (int k = 0; k < 2; ++k) \
        acc[ai][bj][m][n] = __builtin_amdgcn_mfma_f32_16x16x32_bf16(Bt[n][k], At[m][k], acc[ai][bj][m][n], 0, 0, 0); __builtin_amdgcn_s_setprio(0); } while (0)
#define PG8_WAIT_V(n) asm volatile("s_waitcnt vmcnt(" #n ")" ::: "memory")
#define PG8_WAIT_V2(a, b) do { if (MF == 4 || wr == 0) asm volatile("s_waitcnt vmcnt(" #a ")" ::: "memory"); else asm volatile("s_waitcnt vmcnt(" #b ")" ::: "memory"); } while (0)
#define PG8_WAIT_L(n) asm volatile("s_waitcnt lgkmcnt(" #n ")" ::: "memory")
#define PG8_BAR __builtin_amdgcn_s_barrier()
#define PG8_SCHED __builtin_amdgcn_sched_barrier(0)
    Unit cur, nxt; int ui = 0;
    if (!S.next(0, cur)) return;
    f32x4 acc[2][2][MF][2];
#pragma unroll
    for (int a = 0; a < 2; ++a)
#pragma unroll
        for (int b = 0; b < 2; ++b)
#pragma unroll
            for (int m = 0; m < MF; ++m)
#pragma unroll
                for (int n = 0; n < 2; ++n) acc[a][b][m][n] = (f32x4){0.f, 0.f, 0.f, 0.f};
    bf16x8 At[MF][2], B0[2][2], B1[2][2];
#define PG8_SGPR64(p) ((const char*)(((unsigned long long)(unsigned)__builtin_amdgcn_readfirstlane((int)((unsigned long long)(p) >> 32)) << 32) | (unsigned)__builtin_amdgcn_readfirstlane((int)(unsigned long long)(p))))
    const char* cA = PG8_SGPR64((const char*)g.A + (size_t)cur.pm * tstepA); const char* cB = PG8_SGPR64((const char*)g.Bt + (size_t)cur.pn * tstep);
    S.a_ready(cur);
    if constexpr (SP2) {
        PG8_STAGE(PG8_SB(0, 0), cB, voffB); PG8_STAGE(PG8_SB(0, 1), cB + hstep, voffB); PG8_STAGEA(PG8_SA(0, 0), cA, voffA); PG8_STAGEA(PG8_SA(0, 1), cA + hstepA, voffA);
        if (wr == 1) PG8_BAR;
        PG8_WAIT_V2(2, 1); PG8_BAR;
        PG8_STAGE(PG8_SB(1, 0), cB + kstep, voffB); PG8_STAGEA(PG8_SA(1, 0), cA + kstep, voffA); PG8_STAGE(PG8_SB(1, 1), cB + hstep + kstep, voffB);
        PG8_WAIT_V2(6, 5); PG8_BAR;
    } else {
        PG8_STAGE(PG8_SB(0, 0), cB, voffB); PG8_STAGEA(PG8_SA(0, 0), cA, voffA); PG8_STAGE(PG8_SB(0, 1), cB + hstep, voffB); PG8_STAGEA(PG8_SA(0, 1), cA + hstepA, voffA);
        if (wr == 1) PG8_BAR;
        PG8_WAIT_V(4); PG8_BAR;
        PG8_STAGE(PG8_SB(1, 0), cB + kstep, voffB); PG8_STAGEA(PG8_SA(1, 0), cA + kstep, voffA); PG8_STAGE(PG8_SB(1, 1), cB + hstep + kstep, voffB);
        PG8_WAIT_V(6); PG8_BAR;
    }
    for (;;) {
        const bool has_next = S.next(ui + 1, nxt);
        const char* nA = PG8_SGPR64(has_next ? (const char*)g.A + (size_t)nxt.pm * tstepA : cA); const char* nB = PG8_SGPR64(has_next ? (const char*)g.Bt + (size_t)nxt.pn * tstep : cB);
        for (int t = 0; t < nt; t += 2) {
            const bool last = (t == nt - 2);
            const char* a1 = cA + (size_t)(t + 1) * kstep;
            const char* a2 = last ? nA : cA + (size_t)(t + 2) * kstep; const char* b2 = last ? nB : cB + (size_t)(t + 2) * kstep;
            const char* a3 = a2 + kstep; const char* b3 = b2 + kstep;
            if (last && has_next) S.a_ready(nxt);
            if constexpr (SP2) {
            PG8_LDB(B0, 0, 0); PG8_LDB(B1, 0, 1); PG8_SCHED; PG8_LDA(At, 0, 0); PG8_STAGEA(PG8_SA(1, 1), a1 + hstepA, voffA);
            PG8_WAIT_V2(8, 6); PG8_WAIT_L(0); PG8_BAR; PG8_MMA(0, 0, At, B0); PG8_MMA(0, 1, At, B1); PG8_BAR; PG8_SCHED;
            PG8_LDA(At, 0, 1); PG8_STAGE(PG8_SB(0, 0), b2, voffB); PG8_STAGE(PG8_SB(0, 1), b2 + hstep, voffB); PG8_STAGEA(PG8_SA(0, 0), a2, voffA);
            PG8_WAIT_V2(8, 6); PG8_WAIT_L(0); PG8_BAR; PG8_MMA(1, 0, At, B0); PG8_MMA(1, 1, At, B1); PG8_BAR; PG8_SCHED;
            PG8_LDB(B0, 1, 0); PG8_LDB(B1, 1, 1); PG8_SCHED; PG8_LDA(At, 1, 0); PG8_STAGEA(PG8_SA(0, 1), a2 + hstepA, voffA);
            PG8_WAIT_V2(8, 6); PG8_WAIT_L(0); PG8_BAR; PG8_MMA(0, 0, At, B0); PG8_MMA(0, 1, At, B1); PG8_BAR; PG8_SCHED;
            PG8_LDA(At, 1, 1); PG8_STAGE(PG8_SB(1, 0), b3, voffB); PG8_STAGE(PG8_SB(1, 1), b3 + hstep, voffB); PG8_STAGEA(PG8_SA(1, 0), a3, voffA);
            PG8_WAIT_V2(8, 6); PG8_WAIT_L(0); PG8_BAR; PG8_MMA(1, 0, At, B0); PG8_MMA(1, 1, At, B1); PG8_BAR; PG8_SCHED;
            } else {
            PG8_LDB(B0, 0, 0); PG8_SCHED; PG8_LDA(At, 0, 0); PG8_STAGEA(PG8_SA(1, 1), a1 + hstepA, voffA);
            PG8_WAIT_L(8); PG8_BAR; PG8_WAIT_L(0); PG8_MMA(0, 0, At, B0); PG8_BAR; PG8_SCHED;
            PG8_LDB(B1, 0, 1); PG8_STAGE(PG8_SB(0, 0), b2, voffB);
            PG8_BAR; PG8_WAIT_L(0); PG8_MMA(0, 1, At, B1); PG8_BAR;
            PG8_LDA(At, 0, 1); PG8_STAGEA(PG8_SA(0, 0), a2, voffA);
            PG8_BAR; PG8_WAIT_L(0); PG8_MMA(1, 0, At, B0); PG8_BAR; PG8_SCHED;
            PG8_STAGE(PG8_SB(0, 1), b2 + hstep, voffB);
            PG8_WAIT_V(6); PG8_BAR; PG8_MMA(1, 1, At, B1); PG8_BAR;
            PG8_LDB(B0, 1, 0); PG8_SCHED; PG8_LDA(At, 1, 0); PG8_STAGEA(PG8_SA(0, 1), a2 + hstepA, voffA);
            PG8_WAIT_L(8); PG8_BAR; PG8_WAIT_L(0); PG8_MMA(0, 0, At, B0); PG8_BAR; PG8_SCHED;
            PG8_LDB(B1, 1, 1); PG8_STAGE(PG8_SB(1, 0), b3, voffB);
            PG8_BAR; PG8_WAIT_L(0); PG8_MMA(0, 1, At, B1); PG8_BAR;
            PG8_LDA(At, 1, 1); PG8_STAGEA(PG8_SA(1, 0), a3, voffA);
            PG8_BAR; PG8_WAIT_L(0); PG8_MMA(1, 0, At, B0); PG8_BAR; PG8_SCHED;
            PG8_STAGE(PG8_SB(1, 1), b3 + hstep, voffB);
            PG8_WAIT_V(6); PG8_BAR; PG8_MMA(1, 1, At, B1); PG8_BAR;
            }
        }
        if constexpr (ALIGN_EPI) { if (wr == 0) PG8_BAR; }
        if constexpr (!Epi::AFTER_DRAIN) { E.template operator()<MF>(acc, cur, wr, wc, fr, fq); S.done(cur); }
        if (!has_next) break;
#pragma unroll
        for (int a = 0; a < 2; ++a)
#pragma unroll
            for (int b = 0; b < 2; ++b)
#pragma unroll
                for (int m = 0; m < MF; ++m)
#pragma unroll
                    for (int n = 0; n < 2; ++n) acc[a][b][m][n] = (f32x4){0.f, 0.f, 0.f, 0.f};
        cur = nxt; cA = nA; cB = nB; ++ui;
        if constexpr (ALIGN_EPI) { if (wr == 1) PG8_BAR; }
    }
    PG8_WAIT_V(0);
    if constexpr (!ALIGN_EPI) { if (wr == 0) PG8_BAR; }
    PG8_BAR;
    if constexpr (Epi::AFTER_DRAIN) { E.fused(acc, cur, wr, wc, fr, fq, lds, wid, lane); S.done(cur); }
#undef PG8_SA
#undef PG8_SB
#undef PG8_STAGE
#undef PG8_STAGEA
#undef PG8_WAIT_V2
#undef PG8_LDA
#undef PG8_LDB
#undef PG8_MMA
#undef PG8_WAIT_V
#undef PG8_WAIT_L
#undef PG8_BAR
#undef PG8_SCHED
}
}

using pg8::bf16_t; using pg8::bf16x8; using pg8::f32x4; using pg8::u32x4;
typedef float f32x16 __attribute__((ext_vector_type(16)));
typedef float f32x2 __attribute__((ext_vector_type(2)));
typedef short s16x4 __attribute__((ext_vector_type(4)));
typedef unsigned u32x2 __attribute__((ext_vector_type(2)));
typedef __bf16 bf16x2_t __attribute__((ext_vector_type(2)));
#define LAS __attribute__((address_space(3)))
#define LDG(T, base, boff) (*(const __attribute__((address_space(1))) T*)((const __attribute__((address_space(1))) unsigned char*)(base) + (unsigned)(boff)))
#define STG(T, base, boff) (*(__attribute__((address_space(1))) T*)((__attribute__((address_space(1))) unsigned char*)(base) + (unsigned)(boff)))

__device__ __forceinline__ unsigned pk2(float lo, float hi) { f32x2 v = {lo, hi}; bf16x2_t b = __builtin_convertvector(v, bf16x2_t); return __builtin_bit_cast(unsigned, b); }
__device__ __forceinline__ float bf_lo(unsigned u) { return __uint_as_float(u << 16); }
__device__ __forceinline__ float bf_hi(unsigned u) { return __uint_as_float(u & 0xffff0000u); }
__device__ __forceinline__ f32x4 unpack4(u32x2 v) { return (f32x4){bf_lo(v.x), bf_hi(v.x), bf_lo(v.y), bf_hi(v.y)}; }
__device__ __forceinline__ u32x2 pack4(f32x4 v) { u32x2 r; r.x = pk2(v[0], v[1]); r.y = pk2(v[2], v[3]); return r; }
__device__ __forceinline__ float sigmf(float x) { return __builtin_amdgcn_rcpf(1.f + __expf(-x)); }
template <int CTRL> __device__ __forceinline__ float dpp_f(float x) { return __builtin_bit_cast(float, __builtin_amdgcn_update_dpp(0, __builtin_bit_cast(int, x), CTRL, 0xF, 0xF, true)); }
__device__ __forceinline__ float allreduce16(float x) { x += dpp_f<0xB1>(x); x += dpp_f<0x4E>(x); x += dpp_f<0x141>(x); x += dpp_f<0x140>(x); return x; }
__device__ __forceinline__ float rdlane(float x, int l) { return __builtin_bit_cast(float, __builtin_amdgcn_readlane(__builtin_bit_cast(int, x), l)); }
__device__ __forceinline__ float wave_sum(float v) {
    v = allreduce16(v);
    return (rdlane(v, 0) + rdlane(v, 16)) + (rdlane(v, 32) + rdlane(v, 48));
}
__device__ __forceinline__ float swap32_sum(float x) { auto rr = __builtin_amdgcn_permlane32_swap(__float_as_uint(x), __float_as_uint(x), false, false); return __uint_as_float(rr[0]) + __uint_as_float(rr[1]); }
__device__ __forceinline__ float swap32_max(float x) { auto rr = __builtin_amdgcn_permlane32_swap(__float_as_uint(x), __float_as_uint(x), false, false); return fmaxf(__uint_as_float(rr[0]), __uint_as_float(rr[1])); }

constexpr int M = 12288, MC = 4096, DM = 1024, NIN = 3072, FF = 2816, NFF2 = 5632, DEPTH = 4;
constexpr float LOG2E = 1.4426950408889634f;
constexpr float QSCALE_A = 0.125f * LOG2E;
constexpr float QSCALE_B = 0.17677669529663687f * LOG2E;
constexpr unsigned OFF_AK = 12582912, OFF_AV = 14680064, OFF_BK = 16777216, OFF_BV = 20971520, OFF_CF = 25165824, OFF_CB = 26738688;
constexpr unsigned MiB = 1u << 20;
constexpr unsigned WS_CTL = 0, CTL_BYTES = 1 * MiB;
constexpr unsigned WS_MOD = 1 * MiB;
constexpr unsigned WS_TAB = 1 * MiB + 512 * 1024;
constexpr unsigned WS_SMALLW = 2 * MiB;
constexpr unsigned WS_CACHE = 4 * MiB;
constexpr unsigned WS_WIN = 10 * MiB, WS_WOUT = 16 * MiB, WS_W13 = 18 * MiB, WS_W2 = 29 * MiB;
constexpr unsigned WSET_STRIDE = 184 * MiB;
constexpr unsigned WS_ACT = 35 * MiB;
constexpr unsigned WS_QA = 59 * MiB, WS_KA = 68 * MiB, WS_VTA = 71 * MiB, WS_QB = 74 * MiB, WS_KB = 80 * MiB, WS_VTB = 86 * MiB;
constexpr unsigned WS_RKV = 92 * MiB, WS_CW = 119 * MiB, WS_CA = 122 * MiB, WS_CG = 125 * MiB;
constexpr unsigned WS_YF = 128 * MiB, WS_YB = 146 * MiB;
constexpr unsigned WS_SV = 164 * MiB;
constexpr unsigned WS_BO2 = 182 * MiB, WS_ML = 230 * MiB;
constexpr unsigned WS_WSET1 = 194 * MiB;
constexpr unsigned WS_RM = 236 * MiB, WS_RN = 254 * MiB, WS_RP = 324 * MiB, WS_RH = 342 * MiB;
constexpr int NCHUNK = 2304;
constexpr unsigned WS_U = 128 * MiB;
constexpr unsigned WS_G = 290 * MiB, WS_SB = 299 * MiB, WS_BO = 300 * MiB, WS_END = 360 * MiB;
constexpr int SMALLW_L = 147456;
constexpr int TAB_COSA = 0, TAB_SINA = 1024, TAB_COSB = 2048, TAB_SINB = 2560, TAB_LAM = 3072;
constexpr int LDS_BYTES = 147456;
constexpr int NPHASE = 2 + 9 * DEPTH;

struct Args {
    const float* in[34];
    float* out; unsigned char* ws;
    int ph_lo, ph_hi;
};

struct EpiRes {
    static constexpr bool PERM = false, AFTER_DRAIN = false;
    const float* baseC; const float* baseL; float* X; const float* gate;
    template <int MF>
    __device__ __forceinline__ void operator()(const f32x4 (&acc)[2][2][MF][2], const pg8::Unit& u, int wr, int wc, int fr_, int fq_) const {
        int fr = fr_, fq = fq_; asm volatile("" : "+v"(fr), "+v"(fq));
        const unsigned col0 = u.pn * 256 + wc * 32 + 4 * fq, rowb = u.pm * (MF * 64) + wr * (MF * 16);
        f32x4 g4[2][2]; int vcur = -1;
#pragma unroll
        for (int ai = 0; ai < 2; ++ai)
#pragma unroll
            for (int m = 0; m < MF; ++m) { const unsigned rf = rowb + ai * (MF * 32) + m * 16, off = ((rf + fr) * DM + col0) * 4;
                const int v = rf < MC ? 0 : (rf < MC + 4096 ? 1 : 2);
                const float* base = rf < MC ? baseC : baseL;
                if (v != vcur) { vcur = v;
#pragma unroll
                    for (int bj = 0; bj < 2; ++bj)
#pragma unroll
                        for (int n = 0; n < 2; ++n) g4[bj][n] = LDG(f32x4, gate, (v * 6144 + col0 + bj * 128 + n * 16) * 4); }
#pragma unroll
                for (int bj = 0; bj < 2; ++bj)
#pragma unroll
                    for (int n = 0; n < 2; ++n) { const f32x4 b = LDG(f32x4, base, off + (bj * 128 + n * 16) * 4); STG(f32x4, X, off + (bj * 128 + n * 16) * 4) = b + g4[bj][n] * acc[ai][bj][m][n]; } }
    }
};
struct EpiSwi {
    static constexpr bool PERM = true, AFTER_DRAIN = false;
    bf16_t* U;
    template <int MF>
    __device__ __forceinline__ void operator()(const f32x4 (&acc)[2][2][MF][2], const pg8::Unit& u, int wr, int wc, int fr_, int fq_) const {
        int fr = fr_, fq = fq_; asm volatile("" : "+v"(fr), "+v"(fq));
        const unsigned row0 = u.pm * (MF * 64) + wr * (MF * 16) + fr, oc0 = u.pn * 128 + wc * 16 + 4 * fq;
#pragma unroll
        for (int ai = 0; ai < 2; ++ai)
#pragma unroll
            for (int m = 0; m < MF; ++m) { const unsigned ro = ((row0 + ai * (MF * 32) + m * 16) * FF + oc0) * 2;
#pragma unroll
                for (int bj = 0; bj < 2; ++bj) { const f32x4 g = acc[ai][bj][m][0], up = acc[ai][bj][m][1]; f32x4 o;
#pragma unroll
                    for (int e = 0; e < 4; ++e) o[e] = g[e] * sigmf(g[e]) * up[e];
                    STG(u32x2, U, ro + bj * 128) = pack4(o); } asm volatile("" ::: "memory"); }
    }
};
struct EpiWin {
    static constexpr bool PERM = true, AFTER_DRAIN = false;
    unsigned char* ws; float* out; int l;
    template <int MF>
    __device__ __forceinline__ void operator()(const f32x4 (&acc)[2][2][MF][2], const pg8::Unit& u, int wr, int wc, int fr_, int fq_) const {
        int fr = fr_, fq = fq_; asm volatile("" : "+v"(fr), "+v"(fq));
        const unsigned rowb = u.pm * (MF * 64) + wr * (MF * 16), row0 = rowb + fr;
#pragma unroll
        for (int bj = 0; bj < 2; ++bj) {
            const unsigned c32 = u.pn * 256 + bj * 128 + wc * 32;
            const unsigned c8 = c32 + 8 * fq;
            if (c32 < 1152 && (c32 < 512 || c32 >= 640)) {
                const bool isA = c32 < 512;
                const bool isK = isA ? (c32 >= 384) : (c32 >= 896);
                const float qs = isK ? 1.f : (isA ? QSCALE_A : QSCALE_B);
                const unsigned ck = isA ? c8 - 384 : c8 - 896;
                const unsigned dbase = isA ? (isK ? WS_KA + (((ck >> 6) * 4 + ((ck & 63) >> 4)) * 64 + ((ck >> 3) & 1) * 32) * 16 : WS_QA + c8 * 2)
                                           : (isK ? WS_KB + (((ck >> 5) * 2 + ((ck & 31) >> 4)) * 64 + ((ck >> 3) & 1) * 32) * 16 : WS_QB + (c8 - 640) * 2);
                const unsigned dpitch = isA ? 768u : 512u;
#pragma unroll
                for (int ai = 0; ai < 2; ++ai)
#pragma unroll
                    for (int m = 0; m < MF; ++m) {
                        const unsigned row = row0 + ai * (MF * 32) + m * 16; const bool lat = rowb + ai * (MF * 32) + m * 16 >= (unsigned)MC;
                        f32x4 v0 = acc[ai][bj][m][0], v1 = acc[ai][bj][m][1];
                        if (lat) {
                            const unsigned t = (row - MC) & 4095, rp = t >> 6, cp = t & 63;
                            unsigned to_;
                            if (isA) { const unsigned pos = ((c32 >> 5) & 1) ? cp : rp; to_ = WS_TAB + (TAB_COSA + pos * 16 + 4 * fq) * 4; }
                            else { const unsigned pos = (fq >> 1) ? cp : rp; to_ = WS_TAB + (TAB_COSB + pos * 8 + 4 * (fq & 1)) * 4; }
                            const f32x4 c4 = LDG(f32x4, ws, to_), s4 = LDG(f32x4, ws, to_ + (isA ? 4096u : 2048u));
                            f32x4 w0, w1;
                            w0[0] = v0[0] * c4[0] - v0[1] * s4[0]; w0[1] = v0[1] * c4[0] + v0[0] * s4[0];
                            w0[2] = v0[2] * c4[1] - v0[3] * s4[1]; w0[3] = v0[3] * c4[1] + v0[2] * s4[1];
                            w1[0] = v1[0] * c4[2] - v1[1] * s4[2]; w1[1] = v1[1] * c4[2] + v1[0] * s4[2];
                            w1[2] = v1[2] * c4[3] - v1[3] * s4[3]; w1[3] = v1[3] * c4[3] + v1[2] * s4[3];
                            v0 = w0; v1 = w1;
                        } else if (isK) {
                            const unsigned b = row >> 8, t = row & 255;
                            const f32x4 ev = {v0[0], v0[2], v1[0], v1[2]}, od = {v0[1], v0[3], v1[1], v1[3]};
                            if (isA) { const unsigned o = (OFF_AK + ((b * 4 + l) * 256 + t) * 128 + (c32 - 384) + 4 * fq) * 4; STG(f32x4, out, o) = ev; STG(f32x4, out, o + 64) = od; }
                            else { const unsigned o = (OFF_BK + ((b * 4 + l) * 256 + t) * 256 + ((c8 - 896) & ~15u) + 4 * (fq & 1)) * 4; STG(f32x4, out, o) = ev; STG(f32x4, out, o + 32) = od; }
                        }
                        v0 = v0 * qs; v1 = v1 * qs;
                        u32x4 w; w.x = pk2(v0[0], v0[1]); w.y = pk2(v0[2], v0[3]); w.z = pk2(v1[0], v1[1]); w.w = pk2(v1[2], v1[3]);
                        STG(u32x4, ws, isK ? dbase + (row >> 5) * (isA ? 8192u : 16384u) + (row & 31) * 16 : dbase + row * dpitch) = w;
                        asm volatile("" ::: "memory");
                    }
            } else if (c32 < 1408) {
                const bool isA = c32 < 640;
                const unsigned cc = isA ? (c8 - 512) : (c8 - 1152);
                const unsigned vt = (isA ? WS_VTA : WS_VTB) + ((((cc >> 6) * 2 + ((cc >> 5) & 1)) * 2) * 64 + (cc & 31)) * 16;
#pragma unroll
                for (int ai = 0; ai < 2; ++ai)
#pragma unroll
                    for (int m = 0; m < MF; ++m) {
                        const unsigned row = row0 + ai * (MF * 32) + m * 16; const bool lat = rowb + ai * (MF * 32) + m * 16 >= (unsigned)MC;
                        const f32x4 v0 = acc[ai][bj][m][0], v1 = acc[ai][bj][m][1];
                        if (!lat) { const unsigned b = row >> 8, t = row & 255;
                            const unsigned o = isA ? (OFF_AV + ((b * 4 + l) * 256 + t) * 128 + cc) * 4 : (OFF_BV + ((b * 4 + l) * 256 + t) * 256 + cc) * 4;
                            STG(f32x4, out, o) = v0; STG(f32x4, out, o + 16) = v1; }
                        const unsigned p0 = pk2(v0[0], v0[1]), p1 = pk2(v0[2], v0[3]), p2 = pk2(v1[0], v1[1]), p3 = pk2(v1[2], v1[3]);
                        const unsigned tt = row & 31, rem = tt & 15;
                        const unsigned vo = vt + (row >> 5) * (isA ? 8192u : 16384u) + (tt >> 4) * 1024 + ((rem >> 2) & 1) * 512 + (4 * (rem >> 3) + (rem & 3)) * 2;
                        STG(bf16_t, ws, vo + 0 * 16) = (bf16_t)(p0 & 0xffff); STG(bf16_t, ws, vo + 1 * 16) = (bf16_t)(p0 >> 16);
                        STG(bf16_t, ws, vo + 2 * 16) = (bf16_t)(p1 & 0xffff); STG(bf16_t, ws, vo + 3 * 16) = (bf16_t)(p1 >> 16);
                        STG(bf16_t, ws, vo + 4 * 16) = (bf16_t)(p2 & 0xffff); STG(bf16_t, ws, vo + 5 * 16) = (bf16_t)(p2 >> 16);
                        STG(bf16_t, ws, vo + 6 * 16) = (bf16_t)(p3 & 0xffff); STG(bf16_t, ws, vo + 7 * 16) = (bf16_t)(p3 >> 16);
                        asm volatile("" ::: "memory");
                    }
            } else if (c32 < 2944) {
                const int kind = c32 < 2560 ? 0 : (c32 < 2688 ? 1 : (c32 < 2816 ? 2 : 3));
                const unsigned dbase = kind == 0 ? WS_RKV + (c8 - 1408) * 2 : (kind == 1 ? WS_CW + (c8 - 2560) * 2 : (kind == 2 ? WS_CA + (c8 - 2688) * 2 : WS_CG + (c8 - 2816) * 2));
                const unsigned dpitch = kind == 0 ? 2304u : 256u;
#pragma unroll
                for (int ai = 0; ai < 2; ++ai)
#pragma unroll
                    for (int m = 0; m < MF; ++m) {
                        const unsigned row = row0 + ai * (MF * 32) + m * 16; const bool lat = rowb + ai * (MF * 32) + m * 16 >= (unsigned)MC;
                        f32x4 v0 = acc[ai][bj][m][0], v1 = acc[ai][bj][m][1];
                        if (kind == 1) {
#pragma unroll
                            for (int e = 0; e < 4; ++e) { v0[e] = 1.f - 2.f * __builtin_amdgcn_rcpf(__expf(2.f * v0[e]) + 1.f); v1[e] = 1.f - 2.f * __builtin_amdgcn_rcpf(__expf(2.f * v1[e]) + 1.f); }
                        } else if (kind == 3) {
#pragma unroll
                            for (int e = 0; e < 4; ++e) { v0[e] = sigmf(v0[e]); v1[e] = sigmf(v1[e]); }
                        }
                        u32x4 w; w.x = pk2(v0[0], v0[1]); w.y = pk2(v0[2], v0[3]); w.z = pk2(v1[0], v1[1]); w.w = pk2(v1[2], v1[3]);
                        STG(u32x4, ws, dbase + row * dpitch) = w;
                        asm volatile("" ::: "memory");
                    }
            }
        }
    }
};

struct Frame {
    LAS unsigned char* lds;
    const float* const* in;
    float* out; unsigned char* ws;
    int tid, lane, wave, gw, ngw, G, bid;
};
#define GAS __attribute__((address_space(1)))
template <class T> __device__ __forceinline__ T* gptr(T* p) {
#if defined(__HIP_DEVICE_COMPILE__)
    __builtin_assume(!__builtin_amdgcn_is_shared((const void*)p)); __builtin_assume(!__builtin_amdgcn_is_private((const void*)p));
#endif
    return p; }
#define INP(k) gptr(F.in[k])
#define WSP(T, off) gptr((T*)(F.ws + (off)))

__device__ __forceinline__ void phase_prologue(Frame& F) {
    const float* cvec = INP(8); const float* cctx = INP(9); const float* ada_w = INP(10); const float* ada_b = INP(11);
    LAS float* sl = (LAS float*)F.lds;
    LAS float* red = (LAS float*)(F.lds + 16384);
    for (int i = F.tid; i < 3072; i += 512) { const int v = i >> 10, k = i & 1023; const float x = v == 0 ? cctx[k] : cvec[(v - 1) * 1024 + k]; sl[i] = x / (1.f + __expf(-x)); }
    __syncthreads();
    float* mod = WSP(float, WS_MOD);
    for (int it = F.bid; it < 384; it += F.G) {
        const int l = it / 96, n0 = (it % 96) * 64;
        const float* W = ada_w + (size_t)l * 1024 * 6144 + n0 + F.lane;
        float a0 = 0.f, a1 = 0.f, a2 = 0.f;
        const int k0 = F.wave * 128;
#pragma unroll 8
        for (int k = k0; k < k0 + 128; ++k) { const float w = *(const GAS float*)(W + (size_t)k * 6144); a0 += sl[k] * w; a1 += sl[1024 + k] * w; a2 += sl[2048 + k] * w; }
        red[(F.wave * 3 + 0) * 64 + F.lane] = a0; red[(F.wave * 3 + 1) * 64 + F.lane] = a1; red[(F.wave * 3 + 2) * 64 + F.lane] = a2;
        __syncthreads();
        if (F.wave < 3) { float s = ada_b[l * 6144 + n0 + F.lane];
#pragma unroll
            for (int w = 0; w < 8; ++w) s += red[(w * 3 + F.wave) * 64 + F.lane];
            mod[(size_t)(l * 3 + F.wave) * 6144 + n0 + F.lane] = s; }
        __syncthreads();
    }
    float* tab = WSP(float, WS_TAB);
    if (F.bid == F.G - 1) {
        for (int i = F.tid; i < 1024; i += 512) { const int pos = i >> 4, f = i & 15; const float ang = (float)pos * __builtin_amdgcn_exp2f(-(float)f * (13.287712379549449f / 16.f)); tab[TAB_COSA + i] = __cosf(ang); tab[TAB_SINA + i] = __sinf(ang); }
        for (int i = F.tid; i < 512; i += 512) { const int pos = i >> 3, f = i & 7; const float ang = (float)pos * __builtin_amdgcn_exp2f(-(float)f * (13.287712379549449f / 8.f)); tab[TAB_COSB + i] = __cosf(ang); tab[TAB_SINB + i] = __sinf(ang); }
        if (F.wave < 4) { const float* lp = INP(16) + F.wave * 128; const int d = F.lane & 31;
            const float p1 = wave_sum(F.lane < 32 ? lp[d] * lp[32 + d] : 0.f), p2 = wave_sum(F.lane < 32 ? 0.f : lp[64 + d] * lp[96 + d]);
            if (F.lane == 0) tab[TAB_LAM + F.wave] = __expf(p1) - __expf(p2); }
    }
    const int gtid = F.bid * 512 + F.tid, gnt = F.G * 512;
    { bf16_t* sw = WSP(bf16_t, WS_SMALLW); const float* cw2 = INP(20); const float* ca2 = INP(22); const float* cg2 = INP(23);
      for (int idx = gtid; idx < 4 * SMALLW_L; idx += gnt) { const int l = idx / SMALLW_L, r = idx % SMALLW_L; float v;
          if (r < 98304) { const int which = r / 49152, rr = r % 49152, d = rr / 24576, ch = (rr % 24576) / 64, k = rr % 64; v = (which ? ca2 : cw2)[((size_t)(l * 2 + d) * 64 + k) * 384 + ch]; }
          else { const int rr = r - 98304, ch = rr / 128, k = rr % 128; v = cg2[((size_t)l * 128 + k) * 384 + ch]; }
          sw[idx] = (bf16_t)(pk2(v, 0.f) & 0xffff); } }
    { bf16_t* kca = WSP(bf16_t, WS_CACHE); bf16_t* vca = kca + 524288; bf16_t* kcb = vca + 524288; bf16_t* vcb = kcb + 1048576;
      const float* cak = INP(2); const float* cav = INP(3); const float* cbk = INP(4); const float* cbv = INP(5);
      for (int e = gtid; e < 524288; e += gnt) {
          const int j = e & 7, ln = (e >> 3) & 63, hi = ln >> 5, r32 = ln & 31, blk = (e >> 12) & 15, bl = e >> 16;
          { const int s = (e >> 9) & 3, kvh = (e >> 11) & 1, cp = kvh * 64 + 16 * s + 8 * hi + j, o = cp & 31, c = (cp - o) + (o >> 1) + 16 * (o & 1);
            kca[e] = (bf16_t)(pk2(cak[((size_t)bl * 512 + blk * 32 + r32) * 128 + c], 0.f) & 0xffff); }
          { const int ks = (e >> 9) & 1, db = (e >> 10) & 1, kvh = (e >> 11) & 1, key = blk * 32 + 16 * ks + 8 * (j >> 2) + 4 * hi + (j & 3);
            vca[e] = (bf16_t)(pk2(cav[((size_t)bl * 512 + key) * 128 + kvh * 64 + db * 32 + r32], 0.f) & 0xffff); } }
      for (int e = gtid; e < 1048576; e += gnt) {
          const int j = e & 7, ln = (e >> 3) & 63, hi = ln >> 5, r32 = ln & 31, blk = (e >> 13) & 15, bl = e >> 17;
          { const int s = (e >> 9) & 1, hm = (e >> 10) & 7, cp = hm * 32 + 16 * s + 8 * hi + j, o = cp & 15, c = (cp - o) + (o >> 1) + 8 * (o & 1);
            kcb[e] = (bf16_t)(pk2(cbk[((size_t)bl * 512 + blk * 32 + r32) * 256 + c], 0.f) & 0xffff); }
          { const int ks = (e >> 9) & 1, db = (e >> 10) & 1, h = (e >> 11) & 3, key = blk * 32 + 16 * ks + 8 * (j >> 2) + 4 * hi + (j & 3);
            vcb[e] = (bf16_t)(pk2(cbv[((size_t)bl * 512 + key) * 256 + h * 64 + db * 32 + r32], 0.f) & 0xffff); } } }
    for (int st = 0; st < 1; ++st) { u32x4* z = (u32x4*)(WSP(bf16_t, WS_WIN + st * WSET_STRIDE) + (size_t)2944 * 1024); unsigned z0; asm volatile("v_mov_b32 %0, 0" : "=v"(z0)); for (int i = gtid; i < 128 * 1024 / 8; i += gnt) z[i] = (u32x4){z0, z0, z0, z0}; }
}

template <int MAP> __device__ __forceinline__ int dest_row(int n) {
    if (MAP == 1) {
        if (n < 512) { const int o = n & 31; return (n - o) + 2 * (o & 15) + (o >> 4); }
        if (n >= 640 && n < 1152) { const int o = n & 15; return (n - o) + 2 * (o & 7) + (o >> 3); }
        return n;
    }
    if (MAP == 2) return (n >> 2) * 8 + (n & 3);
    if (MAP == 3) return (n >> 2) * 8 + 4 + (n & 3);
    return n;
}
template <int MAP> __device__ __forceinline__ void transpose_item(const float* W, int K, int N, bf16_t* WT, LAS float* scr, int item, int lane) {
    const int nblk = N / 32, kb = item / nblk, nb = item % nblk, k0 = 64 * kb, n0 = 32 * nb;
#pragma unroll 8
    for (int i = 0; i < 32; ++i) { const int kk = 2 * i + (lane >> 5); scr[kk * 33 + (lane & 31)] = *(const GAS float*)(W + (size_t)(k0 + kk) * N + n0 + (lane & 31)); }
    asm volatile("s_waitcnt lgkmcnt(0)" ::: "memory");
    const int c = lane & 7;
#pragma unroll
    for (int j = 0; j < 4; ++j) { const int n = (lane >> 3) + 8 * j; const LAS float* s = scr + (8 * c) * 33 + n;
        u32x4 o; o.x = pk2(s[0 * 33], s[1 * 33]); o.y = pk2(s[2 * 33], s[3 * 33]); o.z = pk2(s[4 * 33], s[5 * 33]); o.w = pk2(s[6 * 33], s[7 * 33]);
        *(GAS u32x4*)(WT + (size_t)dest_row<MAP>(n0 + n) * K + k0 + 8 * c) = o; }
    asm volatile("s_waitcnt lgkmcnt(0)" ::: "memory");
}
template <int MAP> __device__ __forceinline__ void convert_item(const float* W, int K, int N, bf16_t* WT, int item, int lane) {
    const int nblk = N / 64, kb = item / nblk, nb = item % nblk, n = nb * 64 + lane;
    const GAS float* src = (const GAS float*)W + (size_t)(kb * 128) * N + n;
    GAS bf16_t* dst = (GAS bf16_t*)WT + (size_t)dest_row<MAP>(n) * K + kb * 128;
#pragma unroll
    for (int g = 0; g < 16; ++g) { float v[8];
#pragma unroll
        for (int e = 0; e < 8; ++e) v[e] = src[(size_t)(8 * g + e) * N];
        u32x4 o; o.x = pk2(v[0], v[1]); o.y = pk2(v[2], v[3]); o.z = pk2(v[4], v[5]); o.w = pk2(v[6], v[7]);
        *(GAS u32x4*)(dst + 8 * g) = o; }
}
constexpr int CV_IN = 46 * 8, CV_OUT = 16 * 8, CV_1 = 44 * 8, CV_2 = 16 * 22, CV_TOTAL = CV_IN + CV_OUT + 2 * CV_1 + CV_2;
__device__ __forceinline__ void convert_item_any(Frame& F, int l, int it) {
    const unsigned so = 0u * WSET_STRIDE;
    int r = it;
    if (r < CV_IN) { convert_item<1>(INP(14) + (size_t)l * 1024 * 2944, 1024, 2944, WSP(bf16_t, WS_WIN + so), r, F.lane); return; } r -= CV_IN;
    if (r < CV_OUT) { convert_item<0>(INP(29) + (size_t)l * 1024 * 1024, 1024, 1024, WSP(bf16_t, WS_WOUT + so), r, F.lane); return; } r -= CV_OUT;
    if (r < CV_1) { convert_item<2>(INP(30) + (size_t)l * 1024 * FF, 1024, FF, WSP(bf16_t, WS_W13 + so), r, F.lane); return; } r -= CV_1;
    if (r < CV_1) { convert_item<3>(INP(31) + (size_t)l * 1024 * FF, 1024, FF, WSP(bf16_t, WS_W13 + so), r, F.lane); return; } r -= CV_1;
    convert_item<0>(INP(32) + (size_t)l * FF * 1024, FF, 1024, WSP(bf16_t, WS_W2 + so), r, F.lane);
}
__device__ __forceinline__ void convert_weights(Frame& F, int l) {
    LAS float* scr = (LAS float*)(F.lds + F.wave * 16384); const unsigned so = 0u * WSET_STRIDE;
    const float* w_in = INP(14) + (size_t)l * 1024 * 2944; const float* w_out = INP(29) + (size_t)l * 1024 * 1024;
    const float* w1 = INP(30) + (size_t)l * 1024 * FF; const float* w3 = INP(31) + (size_t)l * 1024 * FF; const float* w2 = INP(32) + (size_t)l * FF * 1024;
    constexpr int I_IN = 16 * 92, I_OUT = 16 * 32, I_1 = 16 * 88, I_2 = 44 * 32;
    constexpr int NIT = I_IN + I_OUT + 2 * I_1 + I_2;
    for (int it = F.gw; it < NIT; it += F.ngw) {
        int r = it;
        if (r < I_IN) { transpose_item<1>(w_in, 1024, 2944, WSP(bf16_t, WS_WIN + so), scr, r, F.lane); continue; } r -= I_IN;
        if (r < I_OUT) { transpose_item<0>(w_out, 1024, 1024, WSP(bf16_t, WS_WOUT + so), scr, r, F.lane); continue; } r -= I_OUT;
        if (r < I_1) { transpose_item<2>(w1, 1024, FF, WSP(bf16_t, WS_W13 + so), scr, r, F.lane); continue; } r -= I_1;
        if (r < I_1) { transpose_item<3>(w3, 1024, FF, WSP(bf16_t, WS_W13 + so), scr, r, F.lane); continue; } r -= I_1;
        transpose_item<0>(w2, FF, 1024, WSP(bf16_t, WS_W2 + so), scr, r, F.lane);
    }
}

__device__ __forceinline__ const float* xrow_ptr(Frame& F, int l_first, int row) {
    if (l_first) return row < MC ? INP(0) + (size_t)row * DM : INP(1) + (size_t)(row - MC) * DM;
    return gptr(F.out + (size_t)row * DM);
}
__device__ __forceinline__ void phase_norm(Frame& F, int l, int which  ) {
    const float* g = (which ? INP(13) : INP(12)) + l * 1024;
    const float* mod = WSP(float, WS_MOD) + (size_t)l * 3 * 6144 + (which ? 3072 : 0);
    bf16_t* H = WSP(bf16_t, WS_ACT);
    f32x4 gv[4];
#pragma unroll
    for (int j = 0; j < 4; ++j) gv[j] = *(const GAS f32x4*)(g + 4 * F.lane + 256 * j);
    for (int row = F.gw; row < M; row += F.ngw) {
        const float* xr = xrow_ptr(F, (l == 0 && which == 0) ? 1 : 0, row);
        const float* mv = mod + (row < MC ? 0 : (row < 2 * MC ? 1 : 2)) * 6144;
        f32x4 v[4]; float ss = 0.f;
#pragma unroll
        for (int j = 0; j < 4; ++j) { v[j] = *(const GAS f32x4*)(xr + 4 * F.lane + 256 * j); ss += (v[j][0] * v[j][0] + v[j][1] * v[j][1]) + (v[j][2] * v[j][2] + v[j][3] * v[j][3]); }
        const float rstd = rsqrtf(wave_sum(ss) * (1.f / 1024.f) + 1e-6f);
#pragma unroll
        for (int j = 0; j < 4; ++j) { const f32x4 sh = *(const GAS f32x4*)(mv + 4 * F.lane + 256 * j), sc = *(const GAS f32x4*)(mv + 1024 + 4 * F.lane + 256 * j);
            const f32x4 h = v[j] * rstd * gv[j] * (sc + 1.f) + sh;
            *(GAS u32x2*)(H + (size_t)row * DM + 4 * F.lane + 256 * j) = pack4(h); }
    }
}
__device__ __forceinline__ void phase_final_norm(Frame& F) {
    const float* g = INP(33);
    f32x4 gv[4];
#pragma unroll
    for (int j = 0; j < 4; ++j) gv[j] = *(const GAS f32x4*)(g + 4 * F.lane + 256 * j);
    for (int row = F.gw; row < M; row += F.ngw) {
        float* xr = gptr(F.out + (size_t)row * DM);
        f32x4 v[4]; float ss = 0.f;
#pragma unroll
        for (int j = 0; j < 4; ++j) { v[j] = *(const GAS f32x4*)(xr + 4 * F.lane + 256 * j); ss += (v[j][0] * v[j][0] + v[j][1] * v[j][1]) + (v[j][2] * v[j][2] + v[j][3] * v[j][3]); }
        const float rstd = rsqrtf(wave_sum(ss) * (1.f / 1024.f) + 1e-6f);
#pragma unroll
        for (int j = 0; j < 4; ++j) *(GAS f32x4*)(xr + 4 * F.lane + 256 * j) = v[j] * rstd * gv[j];
    }
}

#define MFMA32(a, b, c) __builtin_amdgcn_mfma_f32_32x32x16_bf16((a), (b), (c), 0, 0, 0)
#ifndef ATT_PROBE
#define ATT_PROBE 0
#endif
struct AttnQ { float m, l; bool mz; f32x16 o[2]; };
template <int DQK, bool MASK, int NQ>
__device__ __forceinline__ void attn_block(const bf16x8 (&qf)[NQ][DQK / 16], const bf16x8 (&kf)[DQK / 16], const bf16x8 (&vf)[4], AttnQ (&st)[NQ], int b, const int (&qpos)[NQ], int kpos0, int hi) {
    constexpr int NS = DQK / 16;
    f32x16 sc[NQ];
#pragma unroll
    for (int q = 0; q < NQ; ++q) { const f32x16 z = {}; sc[q] = MFMA32(kf[0], qf[q][0], z);
#pragma unroll
        for (int s = 1; s < NS; ++s) sc[q] = MFMA32(kf[s], qf[q][s], sc[q]); }
#pragma unroll
    for (int q = 0; q < NQ; ++q) {
        if (!st[q].mz) {
#pragma unroll
            for (int r = 0; r < 16; ++r) sc[q][r] -= st[q].m; }
        if (MASK) {
#pragma unroll
            for (int r = 0; r < 16; ++r) { const int key = kpos0 + 32 * b + (r & 3) + 8 * (r >> 2) + 4 * hi; const int dlt = key - qpos[q]; if (dlt > 128 || dlt < -128) sc[q][r] = -1e30f; }
        }
        float bm = fmaxf(fmaxf(sc[q][0], sc[q][1]), sc[q][2]);
#pragma unroll
        for (int r = 3; r < 15; r += 2) bm = fmaxf(fmaxf(bm, sc[q][r]), sc[q][r + 1]);
        bm = fmaxf(bm, sc[q][15]);
        bm = swap32_max(bm);
        if (__builtin_amdgcn_ballot_w64(bm > 64.f) != 0ull) {
            const float d = fmaxf(bm, 0.f);
            const float alpha = __builtin_amdgcn_exp2f(-d);
            st[q].m += d; st[q].l *= alpha; st[q].mz = false;
#pragma unroll
            for (int r = 0; r < 16; ++r) { st[q].o[0][r] *= alpha; st[q].o[1][r] *= alpha; sc[q][r] -= d; }
        }
#if ATT_PROBE == 1
        { float dmy = 0.f;
#pragma unroll
          for (int r = 0; r < 16; ++r) { float e_; asm volatile("v_exp_f32 %0, %1" : "=v"(e_) : "v"(sc[q][r])); dmy += e_; }
          asm volatile("" :: "v"(dmy)); }
#endif
        f32x2 rs2 = {0.f, 0.f};
#pragma unroll
        for (int r = 0; r < 16; r += 2) { sc[q][r] = __builtin_amdgcn_exp2f(sc[q][r]); sc[q][r + 1] = __builtin_amdgcn_exp2f(sc[q][r + 1]); rs2 += (f32x2){sc[q][r], sc[q][r + 1]}; }
        st[q].l += rs2[0] + rs2[1];
#if ATT_PROBE == 3
        { float d0 = 0.f, d1 = 0.f, d2 = 0.f, d3 = 0.f;
#pragma unroll
          for (int rr = 0; rr < 10; ++rr) { asm volatile("v_add_f32 %0, %0, %4\n\tv_add_f32 %1, %1, %5\n\tv_add_f32 %2, %2, %6\n\tv_add_f32 %3, %3, %7" : "+v"(d0), "+v"(d1), "+v"(d2), "+v"(d3) : "v"(sc[q][0]), "v"(sc[q][1]), "v"(sc[q][2]), "v"(sc[q][3])); }
          asm volatile("" :: "v"(d0), "v"(d1), "v"(d2), "v"(d3)); }
#endif
#if ATT_PROBE == 2
        { f32x16 dm = sc[q]; dm = MFMA32(kf[0], qf[q][0], dm); dm = MFMA32(kf[0], qf[q][0], dm); dm = MFMA32(kf[0], qf[q][0], dm); asm volatile("" :: "v"(dm)); }
#endif
        bf16x8 pb[2];
#pragma unroll
        for (int ks = 0; ks < 2; ++ks) { u32x4 w; w.x = pk2(sc[q][8 * ks], sc[q][8 * ks + 1]); w.y = pk2(sc[q][8 * ks + 2], sc[q][8 * ks + 3]); w.z = pk2(sc[q][8 * ks + 4], sc[q][8 * ks + 5]); w.w = pk2(sc[q][8 * ks + 6], sc[q][8 * ks + 7]); pb[ks] = __builtin_bit_cast(bf16x8, w); }
#pragma unroll
        for (int db = 0; db < 2; ++db)
#pragma unroll
            for (int ks = 0; ks < 2; ++ks) st[q].o[db] = MFMA32(vf[db * 2 + ks], pb[ks], st[q].o[db]);
    }
}
template <int DQK, bool MASK, int NQ>
__device__ __forceinline__ void attn_seg(const unsigned char* ws, const bf16x8 (&qf)[NQ][DQK / 16], AttnQ (&st)[NQ],
                                         unsigned kp, unsigned kblk  , unsigned vp, unsigned vblk, int nblk, const int (&qpos)[NQ], int kpos0, int hi) {
    constexpr int NS = DQK / 16;
    const GAS unsigned char* kq = (const GAS unsigned char*)ws + kp; const GAS unsigned char* vq = (const GAS unsigned char*)ws + vp;
    bf16x8 ka[NS], va[4], kb[NS], vb[4];
#define ATT_LOAD(kd, vd) do { _Pragma("unroll") for (int s = 0; s < NS; ++s) kd[s] = *(const GAS bf16x8*)(kq + 1024 * s); _Pragma("unroll") for (int f = 0; f < 4; ++f) vd[f] = *(const GAS bf16x8*)(vq + 1024 * f); } while (0)
    ATT_LOAD(ka, va);
    int b = 0;
    for (; b + 1 < nblk; b += 2) {
        kq += kblk; vq += vblk; ATT_LOAD(kb, vb);
        attn_block<DQK, MASK, NQ>(qf, ka, va, st, b, qpos, kpos0, hi);
        if (b + 2 < nblk) { kq += kblk; vq += vblk; }
        ATT_LOAD(ka, va);
        attn_block<DQK, MASK, NQ>(qf, kb, vb, st, b + 1, qpos, kpos0, hi);
    }
    if (b < nblk) attn_block<DQK, MASK, NQ>(qf, ka, va, st, b, qpos, kpos0, hi);
#undef ATT_LOAD
}
__device__ __forceinline__ void attnq_init(AttnQ& s, float l0) { s.m = 0.f; s.mz = true; s.l = l0; s.o[0] = (f32x16){}; s.o[1] = (f32x16){}; }
__device__ __forceinline__ void attn_a_item(Frame& F, int l, bool lat, int item) {
    int lane = F.lane; asm volatile("" : "+v"(lane));
    const unsigned char* ws = F.ws;
    const unsigned r32 = lane & 31, hi = lane >> 5;
    const unsigned nqb = lat ? 128 : 8;
    const unsigned qb = item % nqb, hq = (item / nqb) % 6, b = item / (nqb * 6), kvh = hq / 3;
    const unsigned seq0 = lat ? MC + b * 4096 : b * 256, q0 = qb * 32, row = seq0 + q0 + r32;
    const unsigned qo = WS_QA + (row * 384 + hq * 64 + 8 * hi) * 2;
    bf16x8 qf[1][4];
#pragma unroll
    for (int s = 0; s < 4; ++s) qf[0][s] = LDG(bf16x8, ws, qo + 32 * s);
    AttnQ st[1]; attnq_init(st[0], hi == 0 ? __builtin_amdgcn_exp2f(INP(15)[l * 6 + hq] * LOG2E) : 0.f);
    const int qpos[1] = {(int)(q0 + r32)};
    const unsigned fo = kvh * 4096 + lane * 16;
    if (!lat) {
        attn_seg<64, false, 1>(ws, qf, st, WS_KA + (seq0 >> 5) * 8192 + fo, 8192, WS_VTA + (seq0 >> 5) * 8192 + fo, 8192, 8, qpos, 0, hi);
    } else {
        const int ks = (int)q0 - 128 < 0 ? 0 : (int)q0 - 128, ke = q0 + 160 > 4096 ? 4096 : q0 + 160;
        attn_seg<64, true, 1>(ws, qf, st, WS_KA + ((seq0 + ks) >> 5) * 8192 + fo, 8192, WS_VTA + ((seq0 + ks) >> 5) * 8192 + fo, 8192, (ke - ks) >> 5, qpos, ks, hi);
        attn_seg<64, false, 1>(ws, qf, st, WS_CACHE + (b * 4 + l) * 131072 + fo, 8192, WS_CACHE + 1 * MiB + (b * 4 + l) * 131072 + fo, 8192, 16, qpos, 0, hi);
    }
    const float rl = 1.f / swap32_sum(st[0].l);
    const unsigned oo = WS_ACT + (row * DM + hq * 64 + 4 * hi) * 2;
#pragma unroll
    for (int db = 0; db < 2; ++db)
#pragma unroll
        for (int g = 0; g < 4; ++g) { const f32x4 v = {st[0].o[db][4 * g] * rl, st[0].o[db][4 * g + 1] * rl, st[0].o[db][4 * g + 2] * rl, st[0].o[db][4 * g + 3] * rl}; STG(u32x2, F.ws, oo + (32 * db + 8 * g) * 2) = pack4(v); }
}
__device__ __forceinline__ void attn_b_store(Frame& F, const AttnQ& s, unsigned mp, unsigned kh, unsigned row, unsigned h, unsigned hi) {
    const float lt = swap32_sum(s.l);
    const unsigned oo = WS_BO2 + (((mp * 2 + kh) * M + row) * 256 + h * 64 + 4 * hi) * 2;
#pragma unroll
    for (int db = 0; db < 2; ++db)
#pragma unroll
        for (int g = 0; g < 4; ++g) STG(u32x2, F.ws, oo + (32 * db + 8 * g) * 2) = pack4((f32x4){s.o[db][4 * g], s.o[db][4 * g + 1], s.o[db][4 * g + 2], s.o[db][4 * g + 3]});
    if (hi == 0) STG(f32x2, F.ws, WS_ML + ((((mp * 2 + kh) * M + row) * 4 + h) * 2) * 4) = (f32x2){s.m, lt};
}
__device__ __forceinline__ void attn_b_item(Frame& F, int l, bool lat, int item) {
    int lane = F.lane; asm volatile("" : "+v"(lane));
    const unsigned char* ws = F.ws;
    const unsigned r32 = lane & 31, hi = lane >> 5;
    if (lat) {
        const unsigned kh = item & 1, qb = (item >> 1) & 63, mp = (item >> 7) & 1, h = (item >> 8) & 3, b = item >> 10;
        const unsigned seq0 = MC + b * 4096, row0 = seq0 + qb * 64 + r32;
        bf16x8 qf[2][2];
#pragma unroll
        for (int q = 0; q < 2; ++q)
#pragma unroll
            for (int s = 0; s < 2; ++s) qf[q][s] = LDG(bf16x8, ws, WS_QB + ((row0 + 32 * q) * 256 + h * 64 + mp * 32 + 8 * hi) * 2 + 32 * s);
        AttnQ st[2]; attnq_init(st[0], 0.f); attnq_init(st[1], 0.f);
        const int qpos[2] = {0, 0};
        const unsigned kfo = (h * 2 + mp) * 2048 + lane * 16, vfo = h * 4096 + lane * 16;
        const unsigned blk0 = kh ? 72u : 0u, nb = kh ? 56 : 72;
        attn_seg<32, false, 2>(ws, qf, st, WS_KB + ((seq0 >> 5) + blk0) * 16384 + kfo, 16384, WS_VTB + ((seq0 >> 5) + blk0) * 16384 + vfo, 16384, nb, qpos, 0, hi);
        if (kh) attn_seg<32, false, 2>(ws, qf, st, WS_CACHE + 2 * MiB + (b * 4 + l) * 262144 + kfo, 16384, WS_CACHE + 4 * MiB + (b * 4 + l) * 262144 + vfo, 16384, 16, qpos, 0, hi);
        attn_b_store(F, st[0], mp, kh, row0, h, hi); attn_b_store(F, st[1], mp, kh, row0 + 32, h, hi);
    } else {
        const unsigned qb = item & 7, mp = (item >> 3) & 1, h = (item >> 4) & 3, b = item >> 6;
        const unsigned seq0 = b * 256, row = seq0 + qb * 32 + r32;
        bf16x8 qf[1][2];
#pragma unroll
        for (int s = 0; s < 2; ++s) qf[0][s] = LDG(bf16x8, ws, WS_QB + (row * 256 + h * 64 + mp * 32 + 8 * hi) * 2 + 32 * s);
        AttnQ st[1]; attnq_init(st[0], 0.f);
        const int qpos[1] = {0};
        const unsigned kfo = (h * 2 + mp) * 2048 + lane * 16, vfo = h * 4096 + lane * 16;
        attn_seg<32, false, 1>(ws, qf, st, WS_KB + (seq0 >> 5) * 16384 + kfo, 16384, WS_VTB + (seq0 >> 5) * 16384 + vfo, 16384, 8, qpos, 0, hi);
        attn_b_store(F, st[0], mp, 0, row, h, hi);
    }
}

constexpr int L_KT = 0, L_RT = 9216, L_BT = 18432, L_KK = 27648, L_VT = 36864, L_KKT = 46080, L_BTT = 55296, L_A1 = 64512, L_RHS2 = 81920, L_WT = 99328, L_U0T = 108544, L_GC = 117760, L_X0 = 118016;
constexpr int RPB = 144, RPF = 272;
__device__ __forceinline__ void chunk_decode(int cid, unsigned& seq0, int& T, unsigned& b, unsigned& h, unsigned& dir, int& c) {
    unsigned chain;
    if (cid < 768) { chain = (unsigned)cid >> 2; c = cid & 3; T = 256; b = chain / 12; seq0 = b * 256; }
    else { const unsigned x = (unsigned)cid - 768; chain = x >> 6; c = (int)(x & 63); T = 4096; b = chain / 12; seq0 = MC + b * 4096; }
    dir = chain & 1; h = (chain >> 1) % 6;
}
__device__ __forceinline__ bf16x8 acc_frag(const f32x16& x, int ks, float sgn) {
    u32x4 w; w.x = pk2(sgn * x[8 * ks], sgn * x[8 * ks + 1]); w.y = pk2(sgn * x[8 * ks + 2], sgn * x[8 * ks + 3]); w.z = pk2(sgn * x[8 * ks + 4], sgn * x[8 * ks + 5]); w.w = pk2(sgn * x[8 * ks + 6], sgn * x[8 * ks + 7]);
    return __builtin_bit_cast(bf16x8, w);
}
__device__ __forceinline__ bf16x8 lds_frag_nat(const LAS unsigned char* img, unsigned row, int ks, unsigned hi) { return *(const LAS bf16x8*)(img + row * RPB + (16 * ks + 8 * hi) * 2); }
__device__ __forceinline__ bf16x8 lds_frag_perm(const LAS unsigned char* img, unsigned row, int k0, unsigned hi) {
    const s16x4 a = *(const LAS s16x4*)(img + row * RPB + (k0 + 4 * hi) * 2), b = *(const LAS s16x4*)(img + row * RPB + (k0 + 8 + 4 * hi) * 2);
    return (bf16x8){a[0], a[1], a[2], a[3], b[0], b[1], b[2], b[3]};
}
__device__ __forceinline__ f32x16 gram_tile(const LAS unsigned char* lds, int aimg, int bimg, int sb, int tb, unsigned r32, unsigned hi, bool strict) {
    f32x16 acc = {};
#pragma unroll
    for (int ks = 0; ks < 4; ++ks) acc = MFMA32(lds_frag_nat(lds + aimg, 32 * sb + r32, ks, hi), lds_frag_nat(lds + bimg, 32 * tb + r32, ks, hi), acc);
    if (sb == tb) {
#pragma unroll
        for (int r = 0; r < 16; ++r) { const unsigned s_ = (r & 3) + 8 * (r >> 2) + 4 * hi; const bool keep = strict ? s_ < r32 : s_ <= r32; acc[r] = keep ? acc[r] : 0.f; }
    }
    return acc;
}
__device__ __forceinline__ void lds_barrier() { asm volatile("s_waitcnt lgkmcnt(0)\n\ts_barrier" ::: "memory"); }
__device__ __forceinline__ void rwkv_chunk_block(Frame& F, int l, int cid) {
    int lane = F.lane; asm volatile("" : "+v"(lane));
    const unsigned char* ws = F.ws; LAS unsigned char* lds = F.lds;
    const int w = F.wave; const unsigned r32 = lane & 31, hi = lane >> 5;
    unsigned seq0, b, h, dir; int T, c; chunk_decode(cid, seq0, T, b, h, dir, c);
    const int q0 = 64 * c;
#ifndef RA_REP
#define RA_REP 0
#endif
    const int role = w >> 1, tb = w & 1;
    const unsigned swo = WS_SMALLW + l * (SMALLW_L * 2);
    {
        const int pw_ = w < 4, pb = (w >> 1) & 1, cb = w & 1;
        const int p_ = 32 * pb + r32; const unsigned tokp = seq0 + (dir ? T - 1 - (q0 + p_) : q0 + p_);
        const unsigned xo = (pw_ ? WS_CW : WS_CA) + (tokp * 128 + dir * 64 + 8 * hi) * 2, wo = swo + ((pw_ ? 0 : 49152) + (dir * 384 + h * 64 + 32 * cb + r32) * 64 + 8 * hi) * 2;
        f32x16 acc = {};
#pragma unroll
        for (int ks = 0; ks < 4; ++ks) acc = MFMA32(LDG(bf16x8, ws, xo + 32 * ks), LDG(bf16x8, ws, wo + 32 * ks), acc);
        {
            const float bias = LDG(float, pw_ ? INP(19) : INP(21), ((l * 2 + dir) * 384 + h * 64 + 32 * cb + r32) * 4);
#pragma unroll
            for (int r = 0; r < 16; ++r) { const float sg = sigmf(bias + acc[r]);
                *(LAS float*)(lds + (pw_ ? L_A1 : L_RHS2) + (32 * pb + (r & 3) + 8 * (r >> 2) + 4 * hi) * RPF + (32 * cb + r32) * 4) = pw_ ? -0.606531f * sg : sg; }
        }
        if (dir == 0 && w < 4) {
            f32x16 ag = {};
            const unsigned go = WS_CG + (tokp * 128 + 8 * hi) * 2, gw_ = swo + (98304 + (h * 64 + 32 * cb + r32) * 128 + 8 * hi) * 2;
#pragma unroll
            for (int ks = 0; ks < 8; ++ks) ag = MFMA32(LDG(bf16x8, ws, go + 32 * ks), LDG(bf16x8, ws, gw_ + 32 * ks), ag);
#pragma unroll
            for (int r = 0; r < 16; ++r) { const int pp_ = 32 * pb + (r & 3) + 8 * (r >> 2) + 4 * hi; const unsigned tk = seq0 + q0 + pp_;
                STG(bf16_t, F.ws, WS_G + (tk * 384 + h * 64 + 32 * cb + r32) * 2) = (bf16_t)(pk2(ag[r], 0.f) & 0xffff); }
        }
    }
    lds_barrier();
    {
        const unsigned cch = h * 64 + lane;
        const float* convp = INP(18) + (size_t)l * 3 * 1152;
        float cw_[3][3];
#pragma unroll
        for (int tap = 0; tap < 3; ++tap)
#pragma unroll
            for (int seg = 0; seg < 3; ++seg) cw_[tap][seg] = LDG(float, convp, (tap * 1152 + seg * 384 + cch) * 4);
        const float ckk = LDG(float, INP(24), (l * 384 + cch) * 4), cka = LDG(float, INP(25), (l * 384 + cch) * 4), crk = LDG(float, INP(26), (l * 384 + cch) * 4);
        const int tb0 = dir ? T - 1 - (q0 + 8 * w + 7) : q0 + 8 * w;
        float xr[10][3];
#pragma unroll
        for (int rr = 0; rr < 10; ++rr) { const int tr = tb0 - 1 + rr; const bool ok = tr >= 0 && tr < T; const unsigned tk = seq0 + (ok ? tr : tb0);
#pragma unroll
            for (int seg = 0; seg < 3; ++seg) { const float x = bf_lo((unsigned)LDG(bf16_t, ws, WS_RKV + (tk * 1152 + seg * 384 + cch) * 2)); xr[rr][seg] = ok ? x : 0.f; } }
        float lwv[8], kkv[8], btv[8], kdv[8], rv[8], vv[8], g = 0.f;
#pragma unroll
        for (int pp = 0; pp < 8; ++pp) {
            const int rr = 1 + (dir ? 7 - pp : pp); const int p = 8 * w + pp; const unsigned tok = seq0 + (unsigned)(tb0 + rr - 1);
            const float r_ = xr[rr - 1][0] * cw_[0][0] + xr[rr][0] * cw_[1][0] + xr[rr + 1][0] * cw_[2][0];
            const float k_ = xr[rr - 1][1] * cw_[0][1] + xr[rr][1] * cw_[1][1] + xr[rr + 1][1] * cw_[2][1];
            const float v_ = xr[rr - 1][2] * cw_[0][2] + xr[rr][2] * cw_[1][2] + xr[rr + 1][2] * cw_[2][2];
            const float kraw = k_ * ckk; const float n2 = wave_sum(kraw * kraw); const float kk_ = kraw * __builtin_amdgcn_rsqf(fmaxf(n2, 1e-24f));
            const float lw = *(const LAS float*)(lds + L_A1 + p * RPF + lane * 4), av = *(const LAS float*)(lds + L_RHS2 + p * RPF + lane * 4);
            const float kd_ = k_ * (1.f + (av - 1.f) * cka);
            const float bon = wave_sum(r_ * kd_ * crk);
            if (lane == 0) STG(float, F.ws, WS_SB + ((dir * M + tok) * 8 + h) * 4) = bon;
            if (dir == 0) STG(float, F.ws, WS_SV + (tok * 384 + cch) * 4) = v_;
            lwv[pp] = lw; kkv[pp] = kk_; btv[pp] = kk_ * av; kdv[pp] = kd_; rv[pp] = r_; vv[pp] = v_; g += lw;
        }
        g = 0.f;
        for (int wq = 0; wq < w; ++wq) { float t8[8];
#pragma unroll
            for (int e = 0; e < 8; ++e) t8[e] = *(const LAS float*)(lds + L_A1 + (8 * wq + e) * RPF + lane * 4);
            g += ((t8[0] + t8[1]) + (t8[2] + t8[3])) + ((t8[4] + t8[5]) + (t8[6] + t8[7])); }
        unsigned vt[4], kkt[4], btt[4]; float e_pos = __expf(g);
#pragma unroll
        for (int pp = 0; pp < 8; ++pp) {
            const int p = 8 * w + pp;
            const float e_prev = e_pos; g += lwv[pp]; e_pos = __expf(g); const float e_neg = __expf(-g);
            const unsigned pk_kr = pk2(kkv[pp] * e_prev, rv[pp] * e_pos), pk_bk = pk2(btv[pp] * e_neg, kdv[pp] * e_neg), pk_v = pk2(vv[pp], 0.f);
            *(LAS bf16_t*)(lds + L_KT + p * RPB + lane * 2) = (bf16_t)(pk_kr & 0xffff); *(LAS bf16_t*)(lds + L_RT + p * RPB + lane * 2) = (bf16_t)(pk_kr >> 16);
            *(LAS bf16_t*)(lds + L_BT + p * RPB + lane * 2) = (bf16_t)(pk_bk & 0xffff); *(LAS bf16_t*)(lds + L_KK + p * RPB + lane * 2) = (bf16_t)(pk_bk >> 16);
            if (pp & 1) { vt[pp >> 1] |= pk_v << 16; kkt[pp >> 1] |= pk_bk & 0xffff0000u; btt[pp >> 1] |= pk_bk << 16; }
            else { vt[pp >> 1] = pk_v & 0xffff; kkt[pp >> 1] = pk_bk >> 16; btt[pp >> 1] = pk_bk & 0xffff; }
        }
        *(LAS u32x4*)(lds + L_VT + lane * RPB + 16 * w) = (u32x4){vt[0], vt[1], vt[2], vt[3]};
        *(LAS u32x4*)(lds + L_KKT + lane * RPB + 16 * w) = (u32x4){kkt[0], kkt[1], kkt[2], kkt[3]};
        *(LAS u32x4*)(lds + L_BTT + lane * RPB + 16 * w) = (u32x4){btt[0], btt[1], btt[2], btt[3]};
        if (w == 7) *(LAS float*)(lds + L_GC + lane * 4) = e_pos;
    }
    lds_barrier();
    f32x16 keep[2]; bf16x8 x4f[2][2];
    if (role == 0) {
        for (int sb = 0; sb <= tb; ++sb) { const f32x16 x = gram_tile(lds, L_BT, L_KT, sb, tb, r32, hi, true);
            if (sb == tb) {
#pragma unroll
                for (int r = 0; r < 16; ++r) *(LAS float*)(lds + L_A1 + tb * 4608 + ((r & 3) + 8 * (r >> 2) + 4 * hi) * 144 + r32 * 4) = -x[r];
            } else {
#pragma unroll
                for (int g4 = 0; g4 < 4; ++g4) *(LAS f32x4*)(lds + L_A1 + 9216 + r32 * 144 + (8 * g4 + 4 * hi) * 4) = (f32x4){x[4 * g4], x[4 * g4 + 1], x[4 * g4 + 2], x[4 * g4 + 3]};
            } }
    } else if (role == 1) {
        f32x16 o[2] = {};
        for (int sb = 0; sb <= tb; ++sb) {
            const f32x16 x = gram_tile(lds, L_KK, L_KT, sb, tb, r32, hi, true);
#pragma unroll
            for (int ks = 0; ks < 2; ++ks) { const bf16x8 a = acc_frag(x, ks, 1.f);
#pragma unroll
                for (int ib = 0; ib < 2; ++ib) o[ib] = MFMA32(a, lds_frag_perm(lds + L_VT, 32 * ib + r32, 32 * sb + 16 * ks, hi), o[ib]); }
        }
#pragma unroll
        for (int ib = 0; ib < 2; ++ib)
#pragma unroll
            for (int r = 0; r < 16; ++r) *(LAS float*)(lds + L_RHS2 + (32 * tb + (r & 3) + 8 * (r >> 2) + 4 * hi) * RPF + (32 * ib + r32) * 4) = o[ib][r];
    } else if (role == 2) {
#pragma unroll
        for (int sb = 0; sb < 2; ++sb) { x4f[sb][0] = (bf16x8){}; x4f[sb][1] = (bf16x8){}; }
        keep[0] = (f32x16){}; keep[1] = (f32x16){};
        for (int sb = 0; sb <= tb; ++sb) {
            const f32x16 x3 = gram_tile(lds, L_KK, L_RT, sb, tb, r32, hi, false), x4 = gram_tile(lds, L_BT, L_RT, sb, tb, r32, hi, false);
#pragma unroll
            for (int ks = 0; ks < 2; ++ks) { const bf16x8 a3 = acc_frag(x3, ks, 1.f); const bf16x8 a4 = acc_frag(x4, ks, -1.f);
                if (sb == 0) x4f[0][ks] = a4; else x4f[1][ks] = a4;
#pragma unroll
                for (int cb = 0; cb < 2; ++cb) keep[cb] = MFMA32(a3, lds_frag_perm(lds + L_VT, 32 * cb + r32, 32 * sb + 16 * ks, hi), keep[cb]); }
        }
    } else {
        keep[0] = (f32x16){}; keep[1] = (f32x16){};
#pragma unroll
        for (int ks = 0; ks < 4; ++ks) { const bf16x8 ak = lds_frag_nat(lds + L_KKT, 32 * tb + r32, ks, hi);
#pragma unroll
            for (int cb = 0; cb < 2; ++cb) keep[cb] = MFMA32(ak, lds_frag_nat(lds + L_VT, 32 * cb + r32, ks, hi), keep[cb]); }
    }
    lds_barrier();
    if (w < 2) {
        const LAS unsigned char* a1p = lds + L_A1; asm volatile("" : "+v"(a1p));
        LAS unsigned char* xp = lds + (w == 0 ? L_X0 : L_RHS2) + lane * 4; asm volatile("" : "+v"(xp));
        const LAS unsigned char* kp = lds + L_KT + lane * 2; asm volatile("" : "+v"(kp));
        LAS unsigned char* dst = lds + (w == 0 ? L_WT : L_U0T) + lane * RPB; asm volatile("" : "+v"(dst));
#pragma unroll
        for (int B = 0; B < 2; ++B) {
            float acc[32];
            if (w == 0 && B == 0) {
#pragma unroll
                for (int r = 0; r < 32; ++r) acc[r] = bf_lo((unsigned)*(const LAS bf16_t*)(kp + r * RPB));
            } else {
#pragma unroll
                for (int r = 0; r < 32; ++r) acc[r] = *(const LAS float*)(xp + (32 * B + r) * RPF);
            }
            f32x2 ac2[16];
#pragma unroll
            for (int k = 0; k < 16; ++k) ac2[k] = (f32x2){acc[2 * k], acc[2 * k + 1]};
            f32x4 ca[8], cn[8];
#pragma unroll
            for (int tg = 0; tg < 8; ++tg) ca[tg] = *(const LAS f32x4*)(a1p + B * 4608 + tg * 16);
#pragma unroll
            for (int s_ = 0; s_ < 31; ++s_) {
                if (s_ + 1 < 31) {
#pragma unroll
                    for (int tg = (s_ + 2) / 4; tg < 8; ++tg) cn[tg] = *(const LAS f32x4*)(a1p + B * 4608 + (s_ + 1) * 144 + tg * 16);
                }
                __builtin_amdgcn_sched_barrier(0);
                const float xs = ac2[s_ >> 1][s_ & 1];
                const f32x2 xs2 = {xs, xs};
#pragma unroll
                for (int tg = (s_ + 1) / 4; tg < 8; ++tg) {
                    ac2[2 * tg] = __builtin_elementwise_fma((f32x2){ca[tg][0], ca[tg][1]}, xs2, ac2[2 * tg]);
                    ac2[2 * tg + 1] = __builtin_elementwise_fma((f32x2){ca[tg][2], ca[tg][3]}, xs2, ac2[2 * tg + 1]); }
                __builtin_amdgcn_sched_barrier(0);
#pragma unroll
                for (int tg = 0; tg < 8; ++tg) ca[tg] = cn[tg];
            }
#pragma unroll
            for (int k = 0; k < 16; ++k) { acc[2 * k] = ac2[k][0]; acc[2 * k + 1] = ac2[k][1]; }
#pragma unroll
            for (int k8 = 0; k8 < 4; ++k8) { u32x4 v; v.x = pk2(acc[8 * k8], acc[8 * k8 + 1]); v.y = pk2(acc[8 * k8 + 2], acc[8 * k8 + 3]); v.z = pk2(acc[8 * k8 + 4], acc[8 * k8 + 5]); v.w = pk2(acc[8 * k8 + 6], acc[8 * k8 + 7]);
                *(LAS u32x4*)(dst + 64 * B + 16 * k8) = v; }
            if (B == 0) {
                asm volatile("s_waitcnt lgkmcnt(0)" ::: "memory");
                f32x16 u[2];
#pragma unroll
                for (int cb = 0; cb < 2; ++cb)
#pragma unroll
                    for (int r = 0; r < 16; ++r) { const int t = 32 + (r & 3) + 8 * (r >> 2) + 4 * hi;
                        u[cb][r] = w == 0 ? bf_lo((unsigned)*(const LAS bf16_t*)(lds + L_KT + t * RPB + (32 * cb + r32) * 2)) : *(const LAS float*)(lds + L_RHS2 + t * RPF + (32 * cb + r32) * 4); }
#pragma unroll
                for (int ks = 0; ks < 2; ++ks) { const f32x4 a0 = *(const LAS f32x4*)(lds + L_A1 + 9216 + r32 * 144 + (16 * ks + 8 * hi) * 4), a1 = *(const LAS f32x4*)(lds + L_A1 + 9216 + r32 * 144 + (16 * ks + 8 * hi + 4) * 4);
                    u32x4 aw; aw.x = pk2(-a0[0], -a0[1]); aw.y = pk2(-a0[2], -a0[3]); aw.z = pk2(-a1[0], -a1[1]); aw.w = pk2(-a1[2], -a1[3]);
#pragma unroll
                    for (int cb = 0; cb < 2; ++cb) u[cb] = MFMA32(__builtin_bit_cast(bf16x8, aw), lds_frag_nat(lds + (w == 0 ? L_WT : L_U0T), 32 * cb + r32, ks, hi), u[cb]); }
#pragma unroll
                for (int cb = 0; cb < 2; ++cb)
#pragma unroll
                    for (int r = 0; r < 16; ++r) *(LAS float*)(lds + (w == 0 ? L_X0 : L_RHS2) + (32 + (r & 3) + 8 * (r >> 2) + 4 * hi) * RPF + (32 * cb + r32) * 4) = u[cb][r];
                asm volatile("s_waitcnt lgkmcnt(0)" ::: "memory");
            }
        }
    }
    lds_barrier();
    if (role == 2) {
        f32x16 pj[2];
#pragma unroll
        for (int jb = 0; jb < 2; ++jb)
#pragma unroll
            for (int r = 0; r < 16; ++r) pj[jb][r] = bf_lo((unsigned)*(const LAS bf16_t*)(lds + L_RT + (32 * tb + (r & 3) + 8 * (r >> 2) + 4 * hi) * RPB + (32 * jb + r32) * 2));
#pragma unroll
        for (int sb = 0; sb < 2; ++sb)
#pragma unroll
            for (int ks = 0; ks < 2; ++ks)
#pragma unroll
                for (int cb = 0; cb < 2; ++cb) {
                    keep[cb] = MFMA32(x4f[sb][ks], lds_frag_perm(lds + L_U0T, 32 * cb + r32, 32 * sb + 16 * ks, hi), keep[cb]);
                    pj[cb] = MFMA32(x4f[sb][ks], lds_frag_perm(lds + L_WT, 32 * cb + r32, 32 * sb + 16 * ks, hi), pj[cb]); }
        f32x16 (&y0)[2] = keep;
        const unsigned yb = dir ? WS_YB : WS_YF;
#pragma unroll
        for (int r = 0; r < 16; ++r) { const int t = 32 * tb + (r & 3) + 8 * (r >> 2) + 4 * hi; const unsigned tok = seq0 + (dir ? T - 1 - (q0 + t) : q0 + t);
#pragma unroll
            for (int cb = 0; cb < 2; ++cb) { STG(float, F.ws, yb + (tok * 384 + h * 64 + 32 * cb + r32) * 4) = y0[cb][r];
                STG(bf16_t, F.ws, WS_RP + (((unsigned)cid * 64 + t) * 64 + 32 * cb + r32) * 2) = (bf16_t)(pk2(pj[cb][r], 0.f) & 0xffff); } }
    } else if (role == 3) {
        const int jb = tb;
        f32x16 q1[2] = {}, q2[2] = {}; f32x16 (&n1)[2] = keep;
#pragma unroll
        for (int ks = 0; ks < 4; ++ks) { const bf16x8 a = lds_frag_nat(lds + L_BTT, 32 * jb + r32, ks, hi);
#pragma unroll
            for (int cb = 0; cb < 2; ++cb) { q1[cb] = MFMA32(a, lds_frag_nat(lds + L_WT, 32 * cb + r32, ks, hi), q1[cb]); q2[cb] = MFMA32(a, lds_frag_nat(lds + L_U0T, 32 * cb + r32, ks, hi), q2[cb]); } }
#pragma unroll
        for (int r = 0; r < 16; ++r) { const int j = 32 * jb + (r & 3) + 8 * (r >> 2) + 4 * hi; const float gc = *(const LAS float*)(lds + L_GC + j * 4);
#pragma unroll
            for (int cb = 0; cb < 2; ++cb) {
                STG(float, F.ws, WS_RN + (((((unsigned)cid * 2 + jb) * 2 + cb) * 16 + r) * 64 + lane) * 4) = gc * (n1[cb][r] - q2[cb][r]);
                const float mv = ((unsigned)j == 32 * cb + r32 ? gc : 0.f) - gc * q1[cb][r];
                STG(bf16_t, F.ws, WS_RM + (((unsigned)cid * 64 + j) * 64 + 32 * cb + r32) * 2) = (bf16_t)(pk2(mv, 0.f) & 0xffff); } }
    }
    lds_barrier();
}
__device__ __forceinline__ void rwkv_chain_wave(Frame& F, int l, bool lat, int chain, int ib) {
    int lane = F.lane; asm volatile("" : "+v"(lane));
    const unsigned char* ws = F.ws; const unsigned r32 = lane & 31, hi = lane >> 5;
    const unsigned dir = chain & 1, h = (chain >> 1) % 6, b = chain / 12;
    const int nc = lat ? 64 : 4; const unsigned cid0 = lat ? 768 + chain * 64 : chain * 4;
    const unsigned i = 32 * ib + r32;
    const unsigned so = ((((b * 4 + l) * 6 + h) * 64 + i) * 64) * 4;
    f32x16 H[2];
#pragma unroll
    for (int jb = 0; jb < 2; ++jb)
#pragma unroll
        for (int g4 = 0; g4 < 4; ++g4) { f32x4 v = {0.f, 0.f, 0.f, 0.f}; if (lat) v = LDG(f32x4, dir ? INP(7) : INP(6), so + (32 * jb + 8 * g4 + 4 * hi) * 4);
            H[jb][4 * g4] = v[0]; H[jb][4 * g4 + 1] = v[1]; H[jb][4 * g4 + 2] = v[2]; H[jb][4 * g4 + 3] = v[3]; }
    s16x4 ma[2][2][2][2]; f32x16 nt[2];
#define RB_LOAD(cid_) do { const unsigned mo_ = WS_RM + (((cid_) * 64 + r32) * 64 + 4 * hi) * 2; \
        _Pragma("unroll") for (int jo = 0; jo < 2; ++jo) _Pragma("unroll") for (int ji = 0; ji < 2; ++ji) _Pragma("unroll") for (int ks = 0; ks < 2; ++ks) { \
            ma[jo][ji][ks][0] = LDG(s16x4, ws, mo_ + (jo * 32 * 64 + 32 * ji + 16 * ks) * 2); ma[jo][ji][ks][1] = LDG(s16x4, ws, mo_ + (jo * 32 * 64 + 32 * ji + 16 * ks + 8) * 2); } \
        _Pragma("unroll") for (int jo = 0; jo < 2; ++jo) _Pragma("unroll") for (int r = 0; r < 16; ++r) nt[jo][r] = LDG(float, ws, WS_RN + ((((cid_) * 2 + jo) * 2 + ib) * 16 + r) * 256 + lane * 4); } while (0)
    RB_LOAD(cid0);
    for (int c = 0; c < nc; ++c) {
        const unsigned cid = cid0 + c;
#pragma unroll
        for (int jb = 0; jb < 2; ++jb)
#pragma unroll
            for (int g4 = 0; g4 < 4; ++g4) STG(u32x2, F.ws, WS_RH + ((cid * 64 + i) * 64 + 32 * jb + 8 * g4 + 4 * hi) * 2) = pack4((f32x4){H[jb][4 * g4], H[jb][4 * g4 + 1], H[jb][4 * g4 + 2], H[jb][4 * g4 + 3]});
        bf16x8 hf[2][2];
#pragma unroll
        for (int ji = 0; ji < 2; ++ji) { hf[ji][0] = acc_frag(H[ji], 0, 1.f); hf[ji][1] = acc_frag(H[ji], 1, 1.f); }
        f32x16 acc[2] = {nt[0], nt[1]};
#pragma unroll
        for (int jo = 0; jo < 2; ++jo)
#pragma unroll
            for (int ji = 0; ji < 2; ++ji)
#pragma unroll
                for (int ks = 0; ks < 2; ++ks) { const s16x4 a0 = ma[jo][ji][ks][0], a1 = ma[jo][ji][ks][1];
                    acc[jo] = MFMA32(((bf16x8){a0[0], a0[1], a0[2], a0[3], a1[0], a1[1], a1[2], a1[3]}), hf[ji][ks], acc[jo]); }
        if (c + 1 < nc) RB_LOAD(cid + 1);
        H[0] = acc[0]; H[1] = acc[1];
    }
#undef RB_LOAD
    if (!lat) {
#pragma unroll
        for (int jb = 0; jb < 2; ++jb)
#pragma unroll
            for (int g4 = 0; g4 < 4; ++g4) STG(f32x4, F.out, (dir ? OFF_CB : OFF_CF) * 4 + so + (32 * jb + 8 * g4 + 4 * hi) * 4) = (f32x4){H[jb][4 * g4], H[jb][4 * g4 + 1], H[jb][4 * g4 + 2], H[jb][4 * g4 + 3]};
    }
}
__device__ __forceinline__ void rwkv_apply_wave(Frame& F, int item) {
    int lane = F.lane; asm volatile("" : "+v"(lane));
    const unsigned char* ws = F.ws; const unsigned r32 = lane & 31, hi = lane >> 5;
    const int cid = item >> 1, tb = item & 1;
    unsigned seq0, b, h, dir; int T, c; chunk_decode(cid, seq0, T, b, h, dir, c);
    const unsigned yb = dir ? WS_YB : WS_YF;
    f32x16 acc[2];
#pragma unroll
    for (int r = 0; r < 16; ++r) { const int t = 32 * tb + (r & 3) + 8 * (r >> 2) + 4 * hi; const unsigned tok = seq0 + (dir ? T - 1 - (64 * c + t) : 64 * c + t);
        acc[0][r] = LDG(float, ws, yb + (tok * 384 + h * 64 + r32) * 4); acc[1][r] = LDG(float, ws, yb + (tok * 384 + h * 64 + 32 + r32) * 4); }
#pragma unroll
    for (int ks = 0; ks < 4; ++ks) { const bf16x8 a = LDG(bf16x8, ws, WS_RP + (((unsigned)cid * 64 + 32 * tb + r32) * 64 + 16 * ks + 8 * hi) * 2);
#pragma unroll
        for (int ib = 0; ib < 2; ++ib) acc[ib] = MFMA32(a, LDG(bf16x8, ws, WS_RH + (((unsigned)cid * 64 + 32 * ib + r32) * 64 + 16 * ks + 8 * hi) * 2), acc[ib]); }
#pragma unroll
    for (int r = 0; r < 16; ++r) { const int t = 32 * tb + (r & 3) + 8 * (r >> 2) + 4 * hi; const unsigned tok = seq0 + (dir ? T - 1 - (64 * c + t) : 64 * c + t);
        STG(float, F.ws, yb + (tok * 384 + h * 64 + r32) * 4) = acc[0][r]; STG(float, F.ws, yb + (tok * 384 + h * 64 + 32 + r32) * 4) = acc[1][r]; }
}

__device__ __forceinline__ void rwkv_out_item(Frame& F, int l, int item) {
    int lane = F.lane; asm volatile("" : "+v"(lane));
    const unsigned char* ws = F.ws; const unsigned r32 = lane & 31, hi = lane >> 5;
    const int tb = item & 1, h = (item >> 1) % 6, sk = item / 12;
    const bool lat = sk >= 64; const int b = lat ? (sk - 64) >> 6 : sk >> 2, k = lat ? (sk - 64) & 63 : sk & 3, nc = lat ? 64 : 4;
    const unsigned seq0 = lat ? MC + b * 4096 : b * 256, base = lat ? 768u : 0u;
    const unsigned chf = (b * 6 + h) * 2, cidf = base + chf * nc + k, cidb = base + (chf + 1) * nc + (nc - 1 - k);
    const unsigned tok0 = seq0 + 64 * k + 32 * tb;
    f32x16 acc[2];
#pragma unroll
    for (int r = 0; r < 16; ++r) { const unsigned tok = tok0 + (r & 3) + 8 * (r >> 2) + 4 * hi; const unsigned e = (tok * 384 + h * 64 + r32) * 4;
        acc[0][r] = LDG(float, ws, WS_YF + e) + LDG(float, ws, WS_YB + e); acc[1][r] = LDG(float, ws, WS_YF + e + 128) + LDG(float, ws, WS_YB + e + 128); }
    const unsigned pf = 32 * tb + r32, pb_ = 63 - 32 * tb - r32;
#pragma unroll
    for (int ks = 0; ks < 4; ++ks) {
        const bf16x8 af = LDG(bf16x8, ws, WS_RP + ((cidf * 64 + pf) * 64 + 16 * ks + 8 * hi) * 2), ab = LDG(bf16x8, ws, WS_RP + ((cidb * 64 + pb_) * 64 + 16 * ks + 8 * hi) * 2);
#pragma unroll
        for (int ib = 0; ib < 2; ++ib) { acc[ib] = MFMA32(af, LDG(bf16x8, ws, WS_RH + ((cidf * 64 + 32 * ib + r32) * 64 + 16 * ks + 8 * hi) * 2), acc[ib]);
            acc[ib] = MFMA32(ab, LDG(bf16x8, ws, WS_RH + ((cidb * 64 + 32 * ib + r32) * 64 + 16 * ks + 8 * hi) * 2), acc[ib]); } }
    const float g0 = LDG(float, INP(27), (l * 384 + h * 64 + r32) * 4), g1 = LDG(float, INP(27), (l * 384 + h * 64 + 32 + r32) * 4), b0 = LDG(float, INP(28), (l * 384 + h * 64 + r32) * 4), b1 = LDG(float, INP(28), (l * 384 + h * 64 + 32 + r32) * 4);
    const int xl = (lane ^ 16) << 2;
#pragma unroll
    for (int r = 0; r < 16; ++r) { const unsigned tok = tok0 + (r & 3) + 8 * (r >> 2) + 4 * hi; const unsigned e = tok * 384 + h * 64 + r32;
        const float bon = LDG(float, ws, WS_SB + (tok * 8 + h) * 4) + LDG(float, ws, WS_SB + ((M + tok) * 8 + h) * 4);
        const float y0 = acc[0][r] + bon * LDG(float, ws, WS_SV + e * 4), y1 = acc[1][r] + bon * LDG(float, ws, WS_SV + (e + 32) * 4);
        float s = allreduce16(y0 + y1); s += __builtin_bit_cast(float, __builtin_amdgcn_ds_bpermute(xl, __builtin_bit_cast(int, s)));
        const float mu = s * (1.f / 64.f), d0 = y0 - mu, d1 = y1 - mu;
        float q = allreduce16(d0 * d0 + d1 * d1); q += __builtin_bit_cast(float, __builtin_amdgcn_ds_bpermute(xl, __builtin_bit_cast(int, q)));
        const float rs = rsqrtf(q * (1.f / 64.f) + 64e-5f);
        const float o0 = (d0 * rs * g0 + b0) * bf_lo((unsigned)LDG(bf16_t, ws, WS_G + e * 2)), o1 = (d1 * rs * g1 + b1) * bf_lo((unsigned)LDG(bf16_t, ws, WS_G + (e + 32) * 2));
        const unsigned pk = pk2(o0, o1);
        STG(bf16_t, F.ws, WS_ACT + (tok * DM + 640 + h * 64 + r32) * 2) = (bf16_t)(pk & 0xffff); STG(bf16_t, F.ws, WS_ACT + (tok * DM + 640 + h * 64 + 32 + r32) * 2) = (bf16_t)(pk >> 16); }
}

constexpr int AU_R = 8, AU_D = 4, AU_SLOT = 6144;
__device__ __forceinline__ void attn_b_unit(Frame& F, int l, int unit) {
    int lane = F.lane; asm volatile("" : "+v"(lane));
    const unsigned char* ws = F.ws; LAS unsigned char* lds = F.lds;
    const int w = F.wave; const unsigned r32 = lane & 31, hi = lane >> 5;
    const unsigned kh = unit & 1, qb = (unit >> 1) & 15, mp = (unit >> 5) & 1, h = (unit >> 6) & 3, b = unit >> 8;
    const unsigned seq0 = MC + b * 4096, row = seq0 + qb * 256 + 32 * w + r32;
    bf16x8 qf[1][2];
#pragma unroll
    for (int s = 0; s < 2; ++s) qf[0][s] = LDG(bf16x8, ws, WS_QB + (row * 256 + h * 64 + mp * 32 + 8 * hi) * 2 + 32 * s);
    AttnQ st[1]; attnq_init(st[0], 0.f);
    const int qpos[1] = {0};
    const int n0 = kh ? 56 : 72, nt = 72;
    const unsigned pofs = (w < 2 ? (h * 2 + mp) * 2048 + w * 1024 : h * 4096 + (w - 2) * 1024) + lane * 16;
    const unsigned base0 = (w < 2 ? WS_KB : WS_VTB) + ((seq0 >> 5) + (kh ? 72u : 0u)) * 16384 + pofs;
    const unsigned base1 = WS_CACHE + (w < 2 ? 2 * MiB : 4 * MiB) + (b * 4 + l) * 262144 + pofs;
#define AU_DMA(t_) do { const int tt_ = (t_) < nt ? (t_) : nt - 1; const unsigned src_ = tt_ < n0 ? base0 + tt_ * 16384 : base1 + (tt_ - n0) * 16384; \
        __builtin_amdgcn_global_load_lds((const GAS unsigned*)(ws + src_), (LAS unsigned*)(lds + ((t_) % AU_R) * AU_SLOT + w * 1024), 16, 0, 0); } while (0)
    if (w < 6) {
#pragma unroll
        for (int t = 0; t < AU_D; ++t) AU_DMA(t);
    }
    for (int t = 0; t < nt; ++t) {
        if (w < 6) asm volatile("s_waitcnt vmcnt(3)" ::: "memory");
        asm volatile("s_barrier" ::: "memory");
        const LAS unsigned char* sl = lds + (t % AU_R) * AU_SLOT + lane * 16;
        bf16x8 kf[2], vf[4];
        kf[0] = *(const LAS bf16x8*)(sl); kf[1] = *(const LAS bf16x8*)(sl + 1024);
#pragma unroll
        for (int f = 0; f < 4; ++f) vf[f] = *(const LAS bf16x8*)(sl + 2048 + 1024 * f);
        if (w < 6) AU_DMA(t + AU_D);
        attn_block<32, false, 1>(qf, kf, vf, st, t, qpos, 0, hi);
    }
#undef AU_DMA
    asm volatile("s_waitcnt vmcnt(0) lgkmcnt(0)\n\ts_barrier" ::: "memory");
    attn_b_store(F, st[0], mp, kh, row, h, hi);
}

constexpr int Q_BLAT = 2048, Q_ALAT = 1536, Q_BCTX = 1024, Q_ACTX = 768;
constexpr int Q_TOTAL = Q_BLAT + Q_ALAT + Q_BCTX + Q_ACTX;
#ifndef XCD_DEAL
#define XCD_DEAL 0
#endif
__device__ __forceinline__ void phase_mixer(Frame& F, int l, int rep) {
    if (rep == 0 || REP_PART == 0 || REP_PART == 1) {
        const int si = F.bid + F.G * F.wave;
        if (si < 48) rwkv_chain_wave(F, l, true, si >> 1, si & 1);
        else if (si < 48 + 384) rwkv_chain_wave(F, l, false, (si - 48) >> 1, (si - 48) & 1);
    }
    if (rep == 0 || REP_PART == 2 || REP_PART == 4) {
        unsigned* uctr = (unsigned*)(F.ws + WS_CTL) + 64 * (32 + l + 4 * rep);
        LAS int* ubox = (LAS int*)(F.lds + 65536);
        for (;;) {
            if (F.wave == 0 && F.lane == 0) *ubox = (int)atomicAdd(uctr, 1u);
            lds_barrier();
            const int un = __builtin_amdgcn_readfirstlane(*ubox);
            lds_barrier();
            if (un >= 512) break;
            attn_b_unit(F, l, un);
        }
    }
    unsigned* ctr = (unsigned*)(F.ws + WS_CTL) + 64 * (1 + l + 4 * rep);
    if (rep == 0 || REP_PART != 1) for (;;) {
        int it = 0;
        if (F.lane == 0) it = (int)atomicAdd(ctr, 1u);
        it = __builtin_amdgcn_readfirstlane(it) + Q_BLAT;
        if (it >= Q_TOTAL) break;
        if (it < Q_BLAT) { if (rep == 0 || REP_PART == 2 || REP_PART == 4) attn_b_item(F, l, true, it); continue; } it -= Q_BLAT;
        if (it < Q_ALAT) { if (rep == 0 || REP_PART == 2 || REP_PART == 3) attn_a_item(F, l, true, it); continue; } it -= Q_ALAT;
        if (it < Q_BCTX) { if (rep == 0 || REP_PART == 2 || REP_PART == 5) attn_b_item(F, l, false, it); continue; } it -= Q_BCTX;
        if (rep == 0 || REP_PART == 2 || REP_PART == 5) attn_a_item(F, l, false, it);
    }
}

__device__ __forceinline__ void phase_finalize(Frame& F, int l) {
    const unsigned char* ws = F.ws;
    const unsigned lane = F.lane;
    const float lami = 0.8f - 0.6f * __expf(-0.3f * (float)l);
    const float lam = LDG(float, ws, WS_TAB + (TAB_LAM + l) * 4) + lami;
    const float omli = 1.f - lami;
    const float sg = LDG(float, INP(17), (l * 64 + lane) * 4);
    for (unsigned row = F.gw; row < M; row += F.ngw) {
#pragma unroll
        for (int k = 0; k < 4; ++k) { float om[2];
#pragma unroll
            for (int mp = 0; mp < 2; ++mp) { const unsigned o0 = (((mp * 2) * M + row) * 256 + 64 * k + lane) * 2, q0 = ((((mp * 2) * M + row) * 4 + k) * 2) * 4;
                const f32x2 ml0 = LDG(f32x2, ws, WS_ML + q0);
                if (row >= MC) { const f32x2 ml1 = LDG(f32x2, ws, WS_ML + q0 + M * 32); const float ms = fmaxf(ml0[0], ml1[0]), w0 = __builtin_amdgcn_exp2f(ml0[0] - ms), w1 = __builtin_amdgcn_exp2f(ml1[0] - ms);
                    om[mp] = (bf_lo((unsigned)LDG(bf16_t, ws, WS_BO2 + o0)) * w0 + bf_lo((unsigned)LDG(bf16_t, ws, WS_BO2 + o0 + M * 512)) * w1) * __builtin_amdgcn_rcpf(ml0[1] * w0 + ml1[1] * w1); }
                else om[mp] = bf_lo((unsigned)LDG(bf16_t, ws, WS_BO2 + o0)) * __builtin_amdgcn_rcpf(ml0[1]); }
            const float v = om[0] - lam * om[1];
            const float ms = wave_sum(v * v) * (1.f / 64.f);
            STG(bf16_t, F.ws, WS_ACT + (row * DM + 384 + 64 * k + lane) * 2) = (bf16_t)(pk2(v * rsqrtf(ms + 1e-6f) * sg * omli, 0.f) & 0xffff); }
    }
}


typedef unsigned v4u __attribute__((ext_vector_type(4)));
#define XB_TMO      128
#define XB_XCNT(j)  (256  + 64 * (j))
#define XB_XSUB(j)  (1280 + 64 * (j))
#define XB_XGEN(j)  (2304 + 64 * (j))
#define XB_TOP      3328
#define XB_TOPGEN   3392
#define XCD_BAR_WORDS 3456
#define XB_SPIN_CAP (1u << 18)

__device__ __forceinline__ unsigned xb_ld(unsigned* p)              { return __hip_atomic_load(p, __ATOMIC_RELAXED, __HIP_MEMORY_SCOPE_AGENT); }
__device__ __forceinline__ unsigned xb_add(unsigned* p, unsigned v) { return __hip_atomic_fetch_add(p, v, __ATOMIC_RELAXED, __HIP_MEMORY_SCOPE_AGENT); }
__device__ __forceinline__ unsigned xb_xcc_id() { return (unsigned)__builtin_amdgcn_s_getreg((3 << 11) | 20) & 0xFu; }
#define XB_SPIN(cond, bar) do { unsigned _sp = 0; while (cond) { __builtin_amdgcn_s_sleep(1); \
    if ((++_sp & 255u) == 0u) { if (xb_ld(&(bar)[XB_TMO])) break; if (_sp > XB_SPIN_CAP) { atomicAdd(&(bar)[XB_TMO], 1u); break; } } } } while (0)

struct XcdBarrier {
    unsigned* bar; unsigned x;
    volatile LAS unsigned* st;
};

__device__ __forceinline__ XcdBarrier xcd_barrier_post(unsigned* bar, volatile LAS unsigned* st) {
    XcdBarrier b; b.bar = bar; b.x = xb_xcc_id(); b.st = st;
    if (threadIdx.x == 0) (void)xb_add(&bar[XB_XCNT(b.x)], 1u);
    return b;
}
__device__ __forceinline__ void xcd_barrier_complete(unsigned* bar, unsigned x, unsigned& nloc, unsigned& nx) {
    const unsigned G = gridDim.x * gridDim.y * gridDim.z;
    unsigned sum, cnt, mine, sp = 0u;
    for (;;) {
        sum = 0u; cnt = 0u; mine = 0u;
#pragma unroll
        for (unsigned j = 0; j < 16; ++j) { const unsigned c = xb_ld(&bar[XB_XCNT(j)]); sum += c; cnt += (c > 0u) ? 1u : 0u; mine = (j == x) ? c : mine; }
        if (sum == G) break;
        __builtin_amdgcn_s_sleep(1);
        if ((++sp & 255u) == 0u) { if (xb_ld(&bar[XB_TMO])) break; if (sp > XB_SPIN_CAP) { atomicAdd(&bar[XB_TMO], 1u); break; } }
    }
    nloc = mine > 0u ? mine : 1u; nx = cnt > 0u ? cnt : 1u;
}

__device__ __forceinline__ void xcd_barrier(const XcdBarrier& b) {
    asm volatile("s_waitcnt vmcnt(0)" ::: "memory");
    __syncthreads();
    if (threadIdx.x == 0) {
        unsigned* bar = b.bar;
        __builtin_amdgcn_s_waitcnt(0);
        unsigned nloc = b.st[0], nx = b.st[1];
        if (nloc == 0u) { xcd_barrier_complete(bar, b.x, nloc, nx); b.st[0] = nloc; b.st[1] = nx; }
        const unsigned old = xb_add(&bar[XB_XSUB(b.x)], 1u);
        const unsigned gen = old / nloc;
        if (old + 1u == (gen + 1u) * nloc) {
            __builtin_amdgcn_fence(__ATOMIC_RELEASE, "agent");
            asm volatile("s_waitcnt vmcnt(0)" ::: "memory");
            const unsigned og = xb_add(&bar[XB_TOP], 1u);
            const unsigned tg = og / nx;
            if (og + 1u == (tg + 1u) * nx) xb_add(&bar[XB_TOPGEN], 1u);
            else XB_SPIN(xb_ld(&bar[XB_TOPGEN]) == tg, bar);
            __builtin_amdgcn_fence(__ATOMIC_ACQUIRE, "agent");
            xb_add(&bar[XB_XGEN(b.x)], 1u);
            asm volatile("s_waitcnt vmcnt(0)" ::: "memory");
        } else {
            XB_SPIN(xb_ld(&bar[XB_XGEN(b.x)]) == gen, bar);
            __builtin_amdgcn_fence(__ATOMIC_ACQUIRE, "agent");
            asm volatile("s_waitcnt vmcnt(0)" ::: "memory");
        }
    }
    __syncthreads();
}

#ifndef DIS
#define DIS 0
#endif
#ifndef GEMM_MF
#define GEMM_MF 7
#endif
#ifndef REP_PHASE
#define REP_PHASE -1
#define REP_COUNT 1
#endif
constexpr int NEXTRA = (REP_PHASE >= 0 && REP_PHASE < 9) ? REP_COUNT - 1 : 0, NPL = 9 + NEXTRA, NPRE = (REP_PHASE == 100) ? REP_COUNT : 1, NPHASE_RUN = NPRE + 1 + NPL * DEPTH;
__global__ void __launch_bounds__(512, 2) mega(Args a) {
    extern __shared__ __attribute__((aligned(16))) unsigned char lds[];
    Frame F;
    F.lds = (LAS unsigned char*)lds;
    volatile LAS unsigned* bst = (volatile LAS unsigned*)(F.lds + LDS_BYTES - 64);
    if (threadIdx.x < 2) bst[threadIdx.x] = 0u;
    __syncthreads();
    const XcdBarrier xbar = xcd_barrier_post((unsigned*)((GAS unsigned char*)a.ws + WS_CTL) + 4096, bst);
    const int wave_id = __builtin_amdgcn_readfirstlane((int)threadIdx.x >> 6);
    for (int ph = a.ph_lo; ph < a.ph_hi; ++ph) {
        { const unsigned char* kp = (const unsigned char*)__builtin_amdgcn_kernarg_segment_ptr(); asm volatile("" : "+s"(kp));
          const Args* ap = (const Args*)kp; F.in = ap->in; F.out = gptr(ap->out); F.ws = gptr(ap->ws); }
        { unsigned ones = ~0u; asm volatile("" : "+s"(ones)); int ln = (int)__builtin_amdgcn_mbcnt_hi(ones, __builtin_amdgcn_mbcnt_lo(ones, 0u)); int wv = wave_id, bid = (int)blockIdx.x, gg = (int)gridDim.x; asm volatile("" : "+s"(wv), "+s"(bid), "+s"(gg));
          F.lane = ln; F.wave = wv; F.bid = bid; F.G = gg; F.ngw = gg * 8; F.tid = wv * 64 + ln; F.gw = bid * 8 + wv; }
        if (ph < NPRE) { if (!(DIS & 1)) phase_prologue(F); }
        else if (ph == NPHASE_RUN - 1) { if (!(DIS & 2)) phase_final_norm(F); }
        else {
            const int l = (ph - NPRE) / NPL, sidx = (ph - NPRE) % NPL, rep = (REP_PHASE >= 0 && REP_PHASE < 9 && sidx > REP_PHASE && sidx <= REP_PHASE + NEXTRA) ? sidx - REP_PHASE : 0, s = (REP_PHASE >= 0 && REP_PHASE < 9 && sidx > REP_PHASE) ? (sidx <= REP_PHASE + NEXTRA ? REP_PHASE : sidx - NEXTRA) : sidx;
            if (s == 0) { convert_weights(F, l); phase_norm(F, l, 0); }
            else if (s == 1) {
                pg8::Gemm g{WSP(bf16_t, WS_ACT), WSP(bf16_t, WS_WIN + 0u * WSET_STRIDE), M, NIN, 1024}; pg8::StaticOrder S; S.init(M, NIN, F.G, F.bid, (GEMM_MF & 1) ? 192 : 256);
                EpiWin E{F.ws, F.out, l};
                if (!(DIS & 16)) pg8::gemm_phase<EpiWin, pg8::StaticOrder, false, true, (GEMM_MF & 1) ? 3 : 4>(F.lds, g, S, E, F.tid);
                if (false) { const int wv_ = (F.bid - 64) * 8 + F.wave; convert_item_any(F, l + 1, wv_); if (wv_ < CV_TOTAL - 1536) convert_item_any(F, l + 1, 1536 + wv_); }
            }
            else if (s == 2) { for (int cid = F.bid; cid < NCHUNK; cid += F.G) rwkv_chunk_block(F, l, cid); }
            else if (s == 3) { if (!(DIS & 64)) phase_mixer(F, l, rep); }
            else if (s == 4) { phase_finalize(F, l); for (int it = F.gw; it < 192 * 12; it += F.ngw) rwkv_out_item(F, l, it); }
            else if (s == 5 || s == 8) {
                const bool second = s == 8;
                pg8::Gemm g{second ? WSP(bf16_t, WS_U) : WSP(bf16_t, WS_ACT), second ? WSP(bf16_t, WS_W2 + 0u * WSET_STRIDE) : WSP(bf16_t, WS_WOUT + 0u * WSET_STRIDE), M, 1024, second ? FF : 1024};
                pg8::StaticOrder S; S.init(M, 1024, F.G, F.bid, (GEMM_MF & 2) ? 192 : 256);
                const bool first = (l == 0 && !second);
                EpiRes E{first ? INP(0) : F.out, first ? INP(1) - (size_t)MC * DM : F.out, F.out, WSP(float, WS_MOD) + (size_t)l * 3 * 6144 + (second ? 5120 : 2048)};
                if (!(DIS & 256)) pg8::gemm_phase<EpiRes, pg8::StaticOrder, false, true, (GEMM_MF & 2) ? 3 : 4>(F.lds, g, S, E, F.tid);
            }
            else if (s == 6) { if (!(DIS & 8)) phase_norm(F, l, 1); }
            else {
                pg8::Gemm g{WSP(bf16_t, WS_ACT), WSP(bf16_t, WS_W13 + 0u * WSET_STRIDE), M, NFF2, 1024}; pg8::StaticOrder S; S.init(M, NFF2, F.G, F.bid, (GEMM_MF & 4) ? 192 : 256);
                EpiSwi E{WSP(bf16_t, WS_U)};
                if (!(DIS & 512)) pg8::gemm_phase<EpiSwi, pg8::StaticOrder, true, true, (GEMM_MF & 4) ? 3 : 4>(F.lds, g, S, E, F.tid);
            }
        }
        if (ph + 1 < a.ph_hi) { if (ph == a.ph_lo) { __threadfence(); cg::this_grid().sync(); } else xcd_barrier(xbar); }
    }
}

extern "C" void kernel_launch(void* const* d_in, const int* in_sizes, int n_in, void* d_out, int out_size, void* d_ws, size_t ws_size, hipStream_t stream) {
    static int grid = 0;
    if (grid == 0) {
        int dev = 0, cus = 0, per_cu = 0;
        if (n_in != 34 || ws_size < WS_END) { fprintf(stderr, "kernel_launch: unexpected n_in %d / ws_size %zu (need %zu)\n", n_in, ws_size, (size_t)WS_END); grid = -1; return; }
        if (hipGetDevice(&dev) != hipSuccess || hipDeviceGetAttribute(&cus, hipDeviceAttributeMultiprocessorCount, dev) != hipSuccess) { grid = -1; return; }
        if (hipFuncSetAttribute((const void*)mega, hipFuncAttributeMaxDynamicSharedMemorySize, LDS_BYTES) != hipSuccess) { fprintf(stderr, "kernel_launch: hipFuncSetAttribute failed\n"); grid = -1; return; }
        if (hipOccupancyMaxActiveBlocksPerMultiprocessor(&per_cu, (const void*)mega, 512, LDS_BYTES) != hipSuccess || per_cu < 1) { fprintf(stderr, "kernel_launch: occupancy query says %d\n", per_cu); per_cu = 1; }
        (void)hipGetLastError();
        grid = cus * 1;
        if (grid > cus * per_cu) grid = cus * per_cu;
    }
    if (grid < 0) return;
    (void)hipMemsetAsync((char*)d_ws + WS_CTL, 0, CTL_BYTES, stream);
    Args a{};
    for (int i = 0; i < 34; ++i) a.in[i] = (const float*)d_in[i];
    a.out = (float*)d_out; a.ws = (unsigned char*)d_ws;
#if MK_ONE_LAUNCH
    a.ph_lo = 0; a.ph_hi = NPHASE_RUN;
    void* args[] = {&a};
    hipError_t e = hipLaunchCooperativeKernel((const void*)mega, dim3(grid), dim3(512), args, LDS_BYTES, stream);
    if (e != hipSuccess) fprintf(stderr, "kernel_launch: cooperative launch failed: %s (grid %d)\n", hipGetErrorString(e), grid);
#else
    for (int ph = 0; ph < NPHASE_RUN; ++ph) { a.ph_lo = ph; a.ph_hi = ph + 1; hipLaunchKernelGGL(mega, dim3(grid), dim3(512), LDS_BYTES, stream, a); }
#endif
}
```

```cpp
#include <hip/hip_runtime.h>
#include <hip/hip_cooperative_groups.h>
#include <cstdio>
#include <cstdint>
namespace cg = cooperative_groups;

#ifndef MK_ONE_LAUNCH
#define MK_ONE_LAUNCH 1
#endif

#undef MK_ONE_LAUNCH
#define MK_ONE_LAUNCH 1
#define REP_PHASE -1
#define REP_COUNT 1
#define REP_PART 0
#define RA_REP 0
#define ATT_PROBE 0
namespace pg8 {
#define PG8_LAS __attribute__((address_space(3)))
typedef unsigned short bf16_t;
typedef short bf16x8 __attribute__((ext_vector_type(8)));
typedef float f32x4 __attribute__((ext_vector_type(4)));
typedef unsigned u32x4 __attribute__((ext_vector_type(4)));
constexpr int BM = 256, BK = 64, HALF = 128, HTB = HALF * BK * 2  , STAGE_BYTES = 8 * HTB, NXCD = 8, WGM = 8;

__host__ __device__ __forceinline__ int lds_byte(int r, int c) { const int st = (r >> 4) * 2 + (c >> 5), rr = r & 15, cc = c & 31, ob = rr * 64 + cc * 2; return st * 1024 + (ob ^ (((ob >> 9) & 1) << 5)); }
__host__ __device__ __forceinline__ void stage_rc(int b, int& R, int& C) { const int st = b / 1024, sb = b % 1024, swz = sb ^ (((sb >> 9) & 1) << 5); R = (st >> 1) * 16 + swz / 64; C = (st & 1) * 32 + (swz % 64) / 2; }
__host__ __device__ __forceinline__ int perm32(int rho) { const int n = rho >> 4, i = rho & 15; return 8 * (i >> 2) + 4 * n + (i & 3); }

struct Unit { int pm, pn; };
struct Gemm { const bf16_t* A; const bf16_t* Bt; int M, N, K; };

struct StaticOrder {
    int nM, nN, nwg, G, c;
    __host__ __device__ void init(int M, int N, int G_, int c_, int bm = BM) { nM = M / bm; nN = N / BM; nwg = nM * nN; G = G_; c = c_; }
    __host__ __device__ bool next(int i, Unit& u) const {
        const long L = (long)i * G + c; if (L >= nwg) return false;
        int wgid = (int)L; { const int q = nwg / NXCD, r = nwg % NXCD, xcd = wgid % NXCD, off = wgid / NXCD; wgid = (xcd < r ? xcd * (q + 1) : r * (q + 1) + (xcd - r) * q) + off; }
        const int nig = WGM * nN, gid = wgid / nig, fm = gid * WGM, gsz = (nM - fm) < WGM ? (nM - fm) : WGM;
        u.pm = fm + ((wgid % nig) % gsz); u.pn = (wgid % nig) / gsz; return true;
    }
    __device__ __forceinline__ void a_ready(const Unit&) const {}
    __device__ __forceinline__ void done(const Unit&) const {}
};

template <class Epi, class Sched, bool ALIGN_EPI = false, bool SP2 = false, int MF = 4>
__device__ __forceinline__ void gemm_phase(PG8_LAS unsigned char* lds, const Gemm g, const Sched& S, const Epi& E, const int tid_in) {
    const int tid = tid_in, wid = __builtin_amdgcn_readfirstlane(tid >> 6), lane = tid & 63, wr = wid >> 2, wc = wid & 3, fr = lane & 15, fq = lane >> 4;
    static_assert(MF == 4 || (MF == 3 && SP2), "192-row tiles: SP2 schedule only");
    const int K = g.K, nt = K / BK;
    unsigned voffA[2], voffB[2];
#pragma unroll
    for (int i = 0; i < 2; ++i) { int R, C; stage_rc(tid * 16 + i * 8192, R, C); const int Rb = Epi::PERM ? ((R & ~31) + perm32(R & 31)) : R;
        voffA[i] = (unsigned)(R * K + C) * 2u; voffB[i] = (unsigned)(Rb * K + C) * 2u; }
    const size_t kstep = (size_t)(BK * 2);
    const size_t hstep = (size_t)HALF * K * 2;
    const size_t tstep = 2 * hstep;
    const size_t hstepA = (size_t)(MF * 32) * K * 2, tstepA = 2 * hstepA;
    const unsigned ldsw = (unsigned)wid * 1024u;
    const int aoff = lds_byte(wr * (MF * 16) + fr, fq * 8), boff = lds_byte(wc * 32 + fr, fq * 8);
#define PG8_SA(b, h) (((b) * 2 + (h)) * HTB)
#define PG8_SB(b, h) ((4 + (b) * 2 + (h)) * HTB)
#define PG8_STAGE(bufoff, gbase, voff) do { _Pragma("unroll") for (int _i = 0; _i < 2; ++_i) \
        __builtin_amdgcn_global_load_lds((const unsigned*)((const char*)(gbase) + (voff)[_i]), (PG8_LAS unsigned*)(lds + (bufoff) + ldsw + _i * 8192), 16, 0, 0); } while (0)
#define PG8_STAGEA(bufoff, gbase, voff) do { __builtin_amdgcn_global_load_lds((const unsigned*)((const char*)(gbase) + (voff)[0]), (PG8_LAS unsigned*)(lds + (bufoff) + ldsw), 16, 0, 0); \
        if (MF == 4 || wr == 0) __builtin_amdgcn_global_load_lds((const unsigned*)((const char*)(gbase) + (voff)[1]), (PG8_LAS unsigned*)(lds + (bufoff) + ldsw + 8192), 16, 0, 0); } while (0)
#define PG8_LDA(dst, b, h) do { _Pragma("unroll") for (int m = 0; m < MF; ++m) _Pragma("unroll") for (int k = 0; k < 2; ++k) dst[m][k] = *(const PG8_LAS bf16x8*)(lds + PG8_SA(b, h) + aoff + m * 2048 + k * 1024); } while (0)
#define PG8_LDB(dst, b, h) do { _Pragma("unroll") for (int n = 0; n < 2; ++n) _Pragma("unroll") for (int k = 0; k < 2; ++k) dst[n][k] = *(const PG8_LAS bf16x8*)(lds + PG8_SB(b, h) + boff + n * 2048 + k * 1024); } while (0)
#define PG8_MMA(ai, bj, At, Bt) do { __builtin_amdgcn_s_setprio(1); _Pragma("unroll") for (int m = 0; m < MF; ++m) _Pragma("unroll") for (int n = 0; n < 2; ++n) _Pragma("unroll") for (int k = 0; k < 2; ++k) \
        acc[ai][bj][m][n] = __builtin_amdgcn_mfma_f32_16x16x32_bf16(Bt[n][k], At[m][k], acc[ai][bj][m][n], 0, 0, 0); __builtin_amdgcn_s_setprio(0); } while (0)
#define PG8_WAIT_V(n) asm volatile("s_waitcnt vmcnt(" #n ")" ::: "memory")
#define PG8_WAIT_V2(a, b) do { if (MF == 4 || wr == 0) asm volatile("s_waitcnt vmcnt(" #a ")" ::: "memory"); else asm volatile("s_waitcnt vmcnt(" #b ")" ::: "memory"); } while (0)
#define PG8_WAIT_L(n) asm volatile("s_waitcnt lgkmcnt(" #n ")" ::: "memory")
#define PG8_BAR __builtin_amdgcn_s_barrier()
#define PG8_SCHED __builtin_amdgcn_sched_barrier(0)
    Unit cur, nxt; int ui = 0;
    if (!S.next(0, cur)) return;
    f32x4 acc[2][2][MF][2];
#pragma unroll
    for (int a = 0; a < 2; ++a)
#pragma unroll
        for (int b = 0; b < 2; ++b)
#pragma unroll
            for (int m = 0; m < MF; ++m)
#pragma unroll
                for (int n = 0; n < 2; ++n) acc[a][b][m][n] = (f32x4){0.f, 0.f, 0.f, 0.f};
    bf16x8 At[MF][2], B0[2][2], B1[2][2];
#define PG8_SGPR64(p) ((const char*)(((unsigned long long)(unsigned)__builtin_amdgcn_readfirstlane((int)((unsigned long long)(p) >> 32)) << 32) | (unsigned)__builtin_amdgcn_readfirstlane((int)(unsigned long long)(p))))
    const char* cA = PG8_SGPR64((const char*)g.A + (size_t)cur.pm * tstepA); const char* cB = PG8_SGPR64((const char*)g.Bt + (size_t)cur.pn * tstep);
    S.a_ready(cur);
    if constexpr (SP2) {
        PG8_STAGE(PG8_SB(0, 0), cB, voffB); PG8_STAGE(PG8_SB(0, 1), cB + hstep, voffB); PG8_STAGEA(PG8_SA(0, 0), cA, voffA); PG8_STAGEA(PG8_SA(0, 1), cA + hstepA, voffA);
        if (wr == 1) PG8_BAR;
        PG8_WAIT_V2(2, 1); PG8_BAR;
        PG8_STAGE(PG8_SB(1, 0), cB + kstep, voffB); PG8_STAGEA(PG8_SA(1, 0), cA + kstep, voffA); PG8_STAGE(PG8_SB(1, 1), cB + hstep + kstep, voffB);
        PG8_WAIT_V2(6, 5); PG8_BAR;
    } else {
        PG8_STAGE(PG8_SB(0, 0), cB, voffB); PG8_STAGEA(PG8_SA(0, 0), cA, voffA); PG8_STAGE(PG8_SB(0, 1), cB + hstep, voffB); PG8_STAGEA(PG8_SA(0, 1), cA + hstepA, voffA);
        if (wr == 1) PG8_BAR;
        PG8_WAIT_V(4); PG8_BAR;
        PG8_STAGE(PG8_SB(1, 0), cB + kstep, voffB); PG8_STAGEA(PG8_SA(1, 0), cA + kstep, voffA); PG8_STAGE(PG8_SB(1, 1), cB + hstep + kstep, voffB);
        PG8_WAIT_V(6); PG8_BAR;
    }
    for (;;) {
        const bool has_next = S.next(ui + 1, nxt);
        const char* nA = PG8_SGPR64(has_next ? (const char*)g.A + (size_t)nxt.pm * tstepA : cA); const char* nB = PG8_SGPR64(has_next ? (const char*)g.Bt + (size_t)nxt.pn * tstep : cB);
        for (int t = 0; t < nt; t += 2) {
            const bool last = (t == nt - 2);
            const char* a1 = cA + (size_t)(t + 1) * kstep;
            const char* a2 = last ? nA : cA + (size_t)(t + 2) * kstep; const char* b2 = last ? nB : cB + (size_t)(t + 2) * kstep;
            const char* a3 = a2 + kstep; const char* b3 = b2 + kstep;
            if (last && has_next) S.a_ready(nxt);
            if constexpr (SP2) {
            PG8_LDB(B0, 0, 0); PG8_LDB(B1, 0, 1); PG8_SCHED; PG8_LDA(At, 0, 0); PG8_STAGEA(PG8_SA(1, 1), a1 + hstepA, voffA);
            PG8_WAIT_V2(8, 6); PG8_WAIT_L(0); PG8_BAR; PG8_MMA(0, 0, At, B0); PG8_MMA(0, 1, At, B1); PG8_BAR; PG8_SCHED;
            PG8_LDA(At, 0, 1); PG8_STAGE(PG8_SB(0, 0), b2, voffB); PG8_STAGE(PG8_SB(0, 1), b2 + hstep, voffB); PG8_STAGEA(PG8_SA(0, 0), a2, voffA);
            PG8_WAIT_V2(8, 6); PG8_WAIT_L(0); PG8_BAR; PG8_MMA(1, 0, At, B0); PG8_MMA(1, 1, At, B1); PG8_BAR; PG8_SCHED;
            PG8_LDB(B0, 1, 0); PG8_LDB(B1, 1, 1); PG8_SCHED; PG8_LDA(At, 1, 0); PG8_STAGEA(PG8_SA(0, 1), a2 + hstepA, voffA);
            PG8_WAIT_V2(8, 6); PG8_WAIT_L(0); PG8_BAR; PG8_MMA(0, 0, At, B0); PG8_MMA(0, 1, At, B1); PG8_BAR; PG8_SCHED;
            PG8_LDA(At, 1, 1); PG8_STAGE(PG8_SB(1, 0), b3, voffB); PG8_STAGE(PG8_SB(1, 1), b3 + hstep, voffB); PG8_STAGEA(PG8_SA(1, 0), a3, voffA);
            PG8_WAIT_V2(8, 6); PG8_WAIT_L(0); PG8_BAR; PG8_MMA(1, 0, At, B0); PG8_MMA(1, 1, At, B1); PG8_BAR; PG8_SCHED;
            } else {
            PG8_LDB(B0, 0, 0); PG8_SCHED; PG8_LDA(At, 0, 0); PG8_STAGEA(PG8_SA(1, 1), a1 + hstepA, voffA);
            PG8_WAIT_L(8); PG8_BAR; PG8_WAIT_L(0); PG8_MMA(0, 0, At, B0); PG8_BAR; PG8_SCHED;
            PG8_LDB(B1, 0, 1); PG8_STAGE(PG8_SB(0, 0), b2, voffB);
            PG8_BAR; PG8_WAIT_L(0); PG8_MMA(0, 1, At, B1); PG8_BAR;
            PG8_LDA(At, 0, 1); PG8_STAGEA(PG8_SA(0, 0), a2, voffA);
            PG8_BAR; PG8_WAIT_L(0); PG8_MMA(1, 0, At, B0); PG8_BAR; PG8_SCHED;
            PG8_STAGE(PG8_SB(0, 1), b2 + hstep, voffB);
            PG8_WAIT_V(6); PG8_BAR; PG8_MMA(1, 1, At, B1); PG8_BAR;
            PG8_LDB(B0, 1, 0); PG8_SCHED; PG8_LDA(At, 1, 0); PG8_STAGEA(PG8_SA(0, 1), a2 + hstepA, voffA);
            PG8_WAIT_L(8); PG8_BAR; PG8_WAIT_L(0); PG8_MMA(0, 0, At, B0); PG8_BAR; PG8_SCHED;
            PG8_LDB(B1, 1, 1); PG8_STAGE(PG8_SB(1, 0), b3, voffB);
            PG8_BAR; PG8_WAIT_L(0); PG8_MMA(0, 1, At, B1); PG8_BAR;
            PG8_LDA(At, 1, 1); PG8_STAGEA(PG8_SA(1, 0), a3, voffA);
            PG8_BAR; PG8_WAIT_L(0); PG8_MMA(1, 0, At, B0); PG8_BAR; PG8_SCHED;
            PG8_STAGE(PG8_SB(1, 1), b3 + hstep, voffB);
            PG8_WAIT_V(6); PG8_BAR; PG8_MMA(1, 1, At, B1); PG8_BAR;
            }
        }
        if constexpr (ALIGN_EPI) { if (wr == 0) PG8_BAR; }
        if constexpr (!Epi::AFTER_DRAIN) { E.template operator()<MF>(acc, cur, wr, wc, fr, fq); S.done(cur); }
        if (!has_next) break;
#pragma unroll
        for (int a = 0; a < 2; ++a)
#pragma unroll
            for (int b = 0; b < 2; ++b)
#pragma unroll
                for (int m = 0; m < MF; ++m)
#pragma unroll
                    for (int n = 0; n < 2; ++n) acc[a][b][m][n] = (f32x4){0.f, 0.f, 0.f, 0.f};
        cur = nxt; cA = nA; cB = nB; ++ui;
        if constexpr (ALIGN_EPI) { if (wr == 1) PG8_BAR; }
    }
    PG8_WAIT_V(0);
    if constexpr (!ALIGN_EPI) { if (wr == 0) PG8_BAR; }
    PG8_BAR;
    if constexpr (Epi::AFTER_DRAIN) { E.fused(acc, cur, wr, wc, fr, fq, lds, wid, lane); S.done(cur); }
#undef PG8_SA
#undef PG8_SB
#undef PG8_STAGE
#undef PG8_STAGEA
#undef PG8_WAIT_V2
#undef PG8_LDA
#undef PG8_LDB
#undef PG8_MMA
#undef PG8_WAIT_V
#undef PG8_WAIT_L
#undef PG8_BAR
#undef PG8_SCHED
}
}

using pg8::bf16_t; using pg8::bf16x8; using pg8::f32x4; using pg8::u32x4;
typedef float f32x16 __attribute__((ext_vector_type(16)));
typedef float f32x2 __attribute__((ext_vector_type(2)));
typedef short s16x4 __attribute__((ext_vector_type(4)));
typedef unsigned u32x2 __attribute__((ext_vector_type(2)));
typedef __bf16 bf16x2_t __attribute__((ext_vector_type(2)));
#define LAS __attribute__((address_space(3)))
#define LDG(T, base, boff) (*(const __attribute__((address_space(1))) T*)((const __attribute__((address_space(1))) unsigned char*)(base) + (unsigned)(boff)))
#define STG(T, base, boff) (*(__attribute__((address_space(1))) T*)((__attribute__((address_space(1))) unsigned char*)(base) + (unsigned)(boff)))

__device__ __forceinline__ unsigned pk2(float lo, float hi) { f32x2 v = {lo, hi}; bf16x2_t b = __builtin_convertvector(v, bf16x2_t); return __builtin_bit_cast(unsigned, b); }
__device__ __forceinline__ float bf_lo(unsigned u) { return __uint_as_float(u << 16); }
__device__ __forceinline__ float bf_hi(unsigned u) { return __uint_as_float(u & 0xffff0000u); }
__device__ __forceinline__ f32x4 unpack4(u32x2 v) { return (f32x4){bf_lo(v.x), bf_hi(v.x), bf_lo(v.y), bf_hi(v.y)}; }
__device__ __forceinline__ u32x2 pack4(f32x4 v) { u32x2 r; r.x = pk2(v[0], v[1]); r.y = pk2(v[2], v[3]); return r; }
__device__ __forceinline__ float sigmf(float x) { return __builtin_amdgcn_rcpf(1.f + __expf(-x)); }
template <int CTRL> __device__ __forceinline__ float dpp_f(float x) { return __builtin_bit_cast(float, __builtin_amdgcn_update_dpp(0, __builtin_bit_cast(int, x), CTRL, 0xF, 0xF, true)); }
__device__ __forceinline__ float allreduce16(float x) { x += dpp_f<0xB1>(x); x += dpp_f<0x4E>(x); x += dpp_f<0x141>(x); x += dpp_f<0x140>(x); return x; }
__device__ __forceinline__ float rdlane(float x, int l) { return __builtin_bit_cast(float, __builtin_amdgcn_readlane(__builtin_bit_cast(int, x), l)); }
__device__ __forceinline__ float wave_sum(float v) {
    v = allreduce16(v);
    return (rdlane(v, 0) + rdlane(v, 16)) + (rdlane(v, 32) + rdlane(v, 48));
}
__device__ __forceinline__ float swap32_sum(float x) { auto rr = __builtin_amdgcn_permlane32_swap(__float_as_uint(x), __float_as_uint(x), false, false); return __uint_as_float(rr[0]) + __uint_as_float(rr[1]); }
__device__ __forceinline__ float swap32_max(float x) { auto rr = __builtin_amdgcn_permlane32_swap(__float_as_uint(x), __float_as_uint(x), false, false); return fmaxf(__uint_as_float(rr[0]), __uint_as_float(rr[1])); }

constexpr int M = 12288, MC = 4096, DM = 1024, NIN = 3072, FF = 2816, NFF2 = 5632, DEPTH = 4;
constexpr float LOG2E = 1.4426950408889634f;
constexpr float QSCALE_A = 0.125f * LOG2E;
constexpr float QSCALE_B = 0.17677669529663687f * LOG2E;
constexpr unsigned OFF_AK = 12582912, OFF_AV = 14680064, OFF_BK = 16777216, OFF_BV = 20971520, OFF_CF = 25165824, OFF_CB = 26738688;
constexpr unsigned MiB = 1u << 20;
constexpr unsigned WS_CTL = 0, CTL_BYTES = 1 * MiB;
constexpr unsigned WS_MOD = 1 * MiB;
constexpr unsigned WS_TAB = 1 * MiB + 512 * 1024;
constexpr unsigned WS_SMALLW = 2 * MiB;
constexpr unsigned WS_CACHE = 4 * MiB;
constexpr unsigned WS_WIN = 10 * MiB, WS_WOUT = 16 * MiB, WS_W13 = 18 * MiB, WS_W2 = 29 * MiB;
constexpr unsigned WSET_STRIDE = 184 * MiB;
constexpr unsigned WS_ACT = 35 * MiB;
constexpr unsigned WS_QA = 59 * MiB, WS_KA = 68 * MiB, WS_VTA = 71 * MiB, WS_QB = 74 * MiB, WS_KB = 80 * MiB, WS_VTB = 86 * MiB;
constexpr unsigned WS_RKV = 92 * MiB, WS_CW = 119 * MiB, WS_CA = 122 * MiB, WS_CG = 125 * MiB;
constexpr unsigned WS_YF = 128 * MiB, WS_YB = 146 * MiB;
constexpr unsigned WS_SV = 164 * MiB;
constexpr unsigned WS_BO2 = 182 * MiB, WS_ML = 230 * MiB;
constexpr unsigned WS_XB = 206 * MiB;
constexpr unsigned WS_WSET1 = 194 * MiB;
constexpr unsigned WS_RM = 236 * MiB, WS_RN = 254 * MiB, WS_RP = 324 * MiB, WS_RH = 342 * MiB;
constexpr int NCHUNK = 2304;
constexpr unsigned WS_U = 128 * MiB;
constexpr unsigned WS_G = 290 * MiB, WS_SB = 299 * MiB, WS_BO = 300 * MiB, WS_END = 360 * MiB;
constexpr int SMALLW_L = 147456;
constexpr int TAB_COSA = 0, TAB_SINA = 1024, TAB_COSB = 2048, TAB_SINB = 2560, TAB_LAM = 3072;
constexpr int LDS_BYTES = 147456;
constexpr int NPHASE = 2 + 9 * DEPTH;

struct Args {
    const float* in[34];
    float* out; unsigned char* ws;
    int ph_lo, ph_hi;
};

struct EpiRes {
    static constexpr bool PERM = true, AFTER_DRAIN = false;
    const float* baseC; const float* baseL; unsigned char* ws; const float* gate; bool first;
    template <int MF>
    __device__ __forceinline__ void operator()(const f32x4 (&acc)[2][2][MF][2], const pg8::Unit& u, int wr, int wc, int fr_, int fq_) const {
        int fr = fr_, fq = fq_; asm volatile("" : "+v"(fr), "+v"(fq));
        const unsigned col0 = u.pn * 256 + wc * 32 + 8 * fq, rowb = u.pm * (MF * 64) + wr * (MF * 16);
        f32x4 g4[2][2]; int vcur = -1;
#pragma unroll
        for (int ai = 0; ai < 2; ++ai)
#pragma unroll
            for (int m = 0; m < MF; ++m) { const unsigned rf = rowb + ai * (MF * 32) + m * 16, off = (rf + fr) * DM + col0;
                const int v = rf < MC ? 0 : (rf < MC + 4096 ? 1 : 2);
                if (v != vcur) { vcur = v;
#pragma unroll
                    for (int bj = 0; bj < 2; ++bj)
#pragma unroll
                        for (int n = 0; n < 2; ++n) g4[bj][n] = LDG(f32x4, gate, (v * 6144 + col0 + bj * 128 + n * 4) * 4); }
#pragma unroll
                for (int bj = 0; bj < 2; ++bj) { f32x4 b0, b1;
                    if (first) { const float* base = rf < MC ? baseC : baseL; b0 = LDG(f32x4, base, (off + bj * 128) * 4); b1 = LDG(f32x4, base, (off + bj * 128 + 4) * 4); }
                    else { const u32x4 xb = LDG(u32x4, ws, WS_XB + (off + bj * 128) * 2); b0 = (f32x4){bf_lo(xb.x), bf_hi(xb.x), bf_lo(xb.y), bf_hi(xb.y)}; b1 = (f32x4){bf_lo(xb.z), bf_hi(xb.z), bf_lo(xb.w), bf_hi(xb.w)}; }
                    b0 = b0 + g4[bj][0] * acc[ai][bj][m][0]; b1 = b1 + g4[bj][1] * acc[ai][bj][m][1];
                    u32x4 w; w.x = pk2(b0[0], b0[1]); w.y = pk2(b0[2], b0[3]); w.z = pk2(b1[0], b1[1]); w.w = pk2(b1[2], b1[3]);
                    STG(u32x4, ws, WS_XB + (off + bj * 128) * 2) = w; } }
    }
};
struct EpiSwi {
    static constexpr bool PERM = true, AFTER_DRAIN = false;
    bf16_t* U;
    template <int MF>
    __device__ __forceinline__ void operator()(const f32x4 (&acc)[2][2][MF][2], const pg8::Unit& u, int wr, int wc, int fr_, int fq_) const {
        int fr = fr_, fq = fq_; asm volatile("" : "+v"(fr), "+v"(fq));
        const unsigned row0 = u.pm * (MF * 64) + wr * (MF * 16) + fr, oc0 = u.pn * 128 + wc * 16 + 4 * fq;
#pragma unroll
        for (int ai = 0; ai < 2; ++ai)
#pragma unroll
            for (int m = 0; m < MF; ++m) { const unsigned ro = ((row0 + ai * (MF * 32) + m * 16) * FF + oc0) * 2;
#pragma unroll
                for (int bj = 0; bj < 2; ++bj) { const f32x4 g = acc[ai][bj][m][0], up = acc[ai][bj][m][1]; f32x4 o;
#pragma unroll
                    for (int e = 0; e < 4; ++e) o[e] = g[e] * sigmf(g[e]) * up[e];
                    STG(u32x2, U, ro + bj * 128) = pack4(o); } asm volatile("" ::: "memory"); }
    }
};
struct EpiWin {
    static constexpr bool PERM = true, AFTER_DRAIN = false;
    unsigned char* ws; float* out; int l;
    template <int MF>
    __device__ __forceinline__ void operator()(const f32x4 (&acc)[2][2][MF][2], const pg8::Unit& u, int wr, int wc, int fr_, int fq_) const {
        int fr = fr_, fq = fq_; asm volatile("" : "+v"(fr), "+v"(fq));
        const unsigned rowb = u.pm * (MF * 64) + wr * (MF * 16), row0 = rowb + fr;
#pragma unroll
        for (int bj = 0; bj < 2; ++bj) {
            const unsigned c32 = u.pn * 256 + bj * 128 + wc * 32;
            const unsigned c8 = c32 + 8 * fq;
            if (c32 < 1152 && (c32 < 512 || c32 >= 640)) {
                const bool isA = c32 < 512;
                const bool isK = isA ? (c32 >= 384) : (c32 >= 896);
                const float qs = isK ? 1.f : (isA ? QSCALE_A : QSCALE_B);
                const unsigned ck = isA ? c8 - 384 : c8 - 896;
                const unsigned dbase = isA ? (isK ? WS_KA + (((ck >> 6) * 4 + ((ck & 63) >> 4)) * 64 + ((ck >> 3) & 1) * 32) * 16 : WS_QA + c8 * 2)
                                           : (isK ? WS_KB + (((ck >> 5) * 2 + ((ck & 31) >> 4)) * 64 + ((ck >> 3) & 1) * 32) * 16 : WS_QB + (c8 - 640) * 2);
                const unsigned dpitch = isA ? 768u : 512u;
#pragma unroll
                for (int ai = 0; ai < 2; ++ai)
#pragma unroll
                    for (int m = 0; m < MF; ++m) {
                        const unsigned row = row0 + ai * (MF * 32) + m * 16; const bool lat = rowb + ai * (MF * 32) + m * 16 >= (unsigned)MC;
                        f32x4 v0 = acc[ai][bj][m][0], v1 = acc[ai][bj][m][1];
                        if (lat) {
                            const unsigned t = (row - MC) & 4095, rp = t >> 6, cp = t & 63;
                            unsigned to_;
                            if (isA) { const unsigned pos = ((c32 >> 5) & 1) ? cp : rp; to_ = WS_TAB + (TAB_COSA + pos * 16 + 4 * fq) * 4; }
                            else { const unsigned pos = (fq >> 1) ? cp : rp; to_ = WS_TAB + (TAB_COSB + pos * 8 + 4 * (fq & 1)) * 4; }
                            const f32x4 c4 = LDG(f32x4, ws, to_), s4 = LDG(f32x4, ws, to_ + (isA ? 4096u : 2048u));
                            f32x4 w0, w1;
                            w0[0] = v0[0] * c4[0] - v0[1] * s4[0]; w0[1] = v0[1] * c4[0] + v0[0] * s4[0];
                            w0[2] = v0[2] * c4[1] - v0[3] * s4[1]; w0[3] = v0[3] * c4[1] + v0[2] * s4[1];
                            w1[0] = v1[0] * c4[2] - v1[1] * s4[2]; w1[1] = v1[1] * c4[2] + v1[0] * s4[2];
                            w1[2] = v1[2] * c4[3] - v1[3] * s4[3]; w1[3] = v1[3] * c4[3] + v1[2] * s4[3];
                            v0 = w0; v1 = w1;
                        } else if (isK) {
                            const unsigned b = row >> 8, t = row & 255;
                            const f32x4 ev = {v0[0], v0[2], v1[0], v1[2]}, od = {v0[1], v0[3], v1[1], v1[3]};
                            if (isA) { const unsigned o = (OFF_AK + ((b * 4 + l) * 256 + t) * 128 + (c32 - 384) + 4 * fq) * 4; STG(f32x4, out, o) = ev; STG(f32x4, out, o + 64) = od; }
                            else { const unsigned o = (OFF_BK + ((b * 4 + l) * 256 + t) * 256 + ((c8 - 896) & ~15u) + 4 * (fq & 1)) * 4; STG(f32x4, out, o) = ev; STG(f32x4, out, o + 32) = od; }
                        }
                        v0 = v0 * qs; v1 = v1 * qs;
                        u32x4 w; w.x = pk2(v0[0], v0[1]); w.y = pk2(v0[2], v0[3]); w.z = pk2(v1[0], v1[1]); w.w = pk2(v1[2], v1[3]);
                        STG(u32x4, ws, isK ? dbase + (row >> 5) * (isA ? 8192u : 16384u) + (row & 31) * 16 : dbase + row * dpitch) = w;
                        asm volatile("" ::: "memory");
                    }
            } else if (c32 < 1408) {
                const bool isA = c32 < 640;
                const unsigned cc = isA ? (c8 - 512) : (c8 - 1152);
                const unsigned vt = (isA ? WS_VTA : WS_VTB) + ((((cc >> 6) * 2 + ((cc >> 5) & 1)) * 2) * 64 + (cc & 31)) * 16;
#pragma unroll
                for (int ai = 0; ai < 2; ++ai)
#pragma unroll
                    for (int m = 0; m < MF; ++m) {
                        const unsigned row = row0 + ai * (MF * 32) + m * 16; const bool lat = rowb + ai * (MF * 32) + m * 16 >= (unsigned)MC;
                        const f32x4 v0 = acc[ai][bj][m][0], v1 = acc[ai][bj][m][1];
                        if (!lat) { const unsigned b = row >> 8, t = row & 255;
                            const unsigned o = isA ? (OFF_AV + ((b * 4 + l) * 256 + t) * 128 + cc) * 4 : (OFF_BV + ((b * 4 + l) * 256 + t) * 256 + cc) * 4;
                            STG(f32x4, out, o) = v0; STG(f32x4, out, o + 16) = v1; }
                        const unsigned p0 = pk2(v0[0], v0[1]), p1 = pk2(v0[2], v0[3]), p2 = pk2(v1[0], v1[1]), p3 = pk2(v1[2], v1[3]);
                        const unsigned tt = row & 31, rem = tt & 15;
                        const unsigned vo = vt + (row >> 5) * (isA ? 8192u : 16384u) + (tt >> 4) * 1024 + ((rem >> 2) & 1) * 512 + (4 * (rem >> 3) + (rem & 3)) * 2;
                        STG(bf16_t, ws, vo + 0 * 16) = (bf16_t)(p0 & 0xffff); STG(bf16_t, ws, vo + 1 * 16) = (bf16_t)(p0 >> 16);
                        STG(bf16_t, ws, vo + 2 * 16) = (bf16_t)(p1 & 0xffff); STG(bf16_t, ws, vo + 3 * 16) = (bf16_t)(p1 >> 16);
                        STG(bf16_t, ws, vo + 4 * 16) = (bf16_t)(p2 & 0xffff); STG(bf16_t, ws, vo + 5 * 16) = (bf16_t)(p2 >> 16);
                        STG(bf16_t, ws, vo + 6 * 16) = (bf16_t)(p3 & 0xffff); STG(bf16_t, ws, vo + 7 * 16) = (bf16_t)(p3 >> 16);
                        asm volatile("" ::: "memory");
                    }
            } else if (c32 < 2944) {
                const int kind = c32 < 2560 ? 0 : (c32 < 2688 ? 1 : (c32 < 2816 ? 2 : 3));
                const unsigned dbase = kind == 0 ? WS_RKV + (c8 - 1408) * 2 : (kind == 1 ? WS_CW + (c8 - 2560) * 2 : (kind == 2 ? WS_CA + (c8 - 2688) * 2 : WS_CG + (c8 - 2816) * 2));
                const unsigned dpitch = kind == 0 ? 2304u : 256u;
#pragma unroll
                for (int ai = 0; ai < 2; ++ai)
#pragma unroll
                    for (int m = 0; m < MF; ++m) {
                        const unsigned row = row0 + ai * (MF * 32) + m * 16; const bool lat = rowb + ai * (MF * 32) + m * 16 >= (unsigned)MC;
                        f32x4 v0 = acc[ai][bj][m][0], v1 = acc[ai][bj][m][1];
                        if (kind == 1) {
#pragma unroll
                            for (int e = 0; e < 4; ++e) { v0[e] = 1.f - 2.f * __builtin_amdgcn_rcpf(__expf(2.f * v0[e]) + 1.f); v1[e] = 1.f - 2.f * __builtin_amdgcn_rcpf(__expf(2.f * v1[e]) + 1.f); }
                        } else if (kind == 3) {
#pragma unroll
                            for (int e = 0; e < 4; ++e) { v0[e] = sigmf(v0[e]); v1[e] = sigmf(v1[e]); }
                        }
                        u32x4 w; w.x = pk2(v0[0], v0[1]); w.y = pk2(v0[2], v0[3]); w.z = pk2(v1[0], v1[1]); w.w = pk2(v1[2], v1[3]);
                        STG(u32x4, ws, dbase + row * dpitch) = w;
                        asm volatile("" ::: "memory");
                    }
            }
        }
    }
};

struct Frame {
    LAS unsigned char* lds;
    const float* const* in;
    float* out; unsigned char* ws;
    int tid, lane, wave, gw, ngw, G, bid;
};
#define GAS __attribute__((address_space(1)))
template <class T> __device__ __forceinline__ T* gptr(T* p) {
#if defined(__HIP_DEVICE_COMPILE__)
    __builtin_assume(!__builtin_amdgcn_is_shared((const void*)p)); __builtin_assume(!__builtin_amdgcn_is_private((const void*)p));
#endif
    return p; }
#define INP(k) gptr(F.in[k])
#define WSP(T, off) gptr((T*)(F.ws + (off)))

__device__ __forceinline__ void phase_prologue(Frame& F) {
    const float* cvec = INP(8); const float* cctx = INP(9); const float* ada_w = INP(10); const float* ada_b = INP(11);
    LAS float* sl = (LAS float*)F.lds;
    LAS float* red = (LAS float*)(F.lds + 16384);
    for (int i = F.tid; i < 3072; i += 512) { const int v = i >> 10, k = i & 1023; const float x = v == 0 ? cctx[k] : cvec[(v - 1) * 1024 + k]; sl[i] = x / (1.f + __expf(-x)); }
    __syncthreads();
    float* mod = WSP(float, WS_MOD);
    for (int it = F.bid; it < 384; it += F.G) {
        const int l = it / 96, n0 = (it % 96) * 64;
        const float* W = ada_w + (size_t)l * 1024 * 6144 + n0 + F.lane;
        float a0 = 0.f, a1 = 0.f, a2 = 0.f;
        const int k0 = F.wave * 128;
#pragma unroll 8
        for (int k = k0; k < k0 + 128; ++k) { const float w = *(const GAS float*)(W + (size_t)k * 6144); a0 += sl[k] * w; a1 += sl[1024 + k] * w; a2 += sl[2048 + k] * w; }
        red[(F.wave * 3 + 0) * 64 + F.lane] = a0; red[(F.wave * 3 + 1) * 64 + F.lane] = a1; red[(F.wave * 3 + 2) * 64 + F.lane] = a2;
        __syncthreads();
        if (F.wave < 3) { float s = ada_b[l * 6144 + n0 + F.lane];
#pragma unroll
            for (int w = 0; w < 8; ++w) s += red[(w * 3 + F.wave) * 64 + F.lane];
            mod[(size_t)(l * 3 + F.wave) * 6144 + n0 + F.lane] = s; }
        __syncthreads();
    }
    float* tab = WSP(float, WS_TAB);
    if (F.bid == F.G - 1) {
        for (int i = F.tid; i < 1024; i += 512) { const int pos = i >> 4, f = i & 15; const float ang = (float)pos * __builtin_amdgcn_exp2f(-(float)f * (13.287712379549449f / 16.f)); tab[TAB_COSA + i] = __cosf(ang); tab[TAB_SINA + i] = __sinf(ang); }
        for (int i = F.tid; i < 512; i += 512) { const int pos = i >> 3, f = i & 7; const float ang = (float)pos * __builtin_amdgcn_exp2f(-(float)f * (13.287712379549449f / 8.f)); tab[TAB_COSB + i] = __cosf(ang); tab[TAB_SINB + i] = __sinf(ang); }
        if (F.wave < 4) { const float* lp = INP(16) + F.wave * 128; const int d = F.lane & 31;
            const float p1 = wave_sum(F.lane < 32 ? lp[d] * lp[32 + d] : 0.f), p2 = wave_sum(F.lane < 32 ? 0.f : lp[64 + d] * lp[96 + d]);
            if (F.lane == 0) tab[TAB_LAM + F.wave] = __expf(p1) - __expf(p2); }
    }
    const int gtid = F.bid * 512 + F.tid, gnt = F.G * 512;
    { bf16_t* sw = WSP(bf16_t, WS_SMALLW); const float* cw2 = INP(20); const float* ca2 = INP(22); const float* cg2 = INP(23);
      for (int idx = gtid; idx < 4 * SMALLW_L; idx += gnt) { const int l = idx / SMALLW_L, r = idx % SMALLW_L; float v;
          if (r < 98304) { const int which = r / 49152, rr = r % 49152, d = rr / 24576, ch = (rr % 24576) / 64, k = rr % 64; v = (which ? ca2 : cw2)[((size_t)(l * 2 + d) * 64 + k) * 384 + ch]; }
          else { const int rr = r - 98304, ch = rr / 128, k = rr % 128; v = cg2[((size_t)l * 128 + k) * 384 + ch]; }
          sw[idx] = (bf16_t)(pk2(v, 0.f) & 0xffff); } }
    { bf16_t* kca = WSP(bf16_t, WS_CACHE); bf16_t* vca = kca + 524288; bf16_t* kcb = vca + 524288; bf16_t* vcb = kcb + 1048576;
      const float* cak = INP(2); const float* cav = INP(3); const float* cbk = INP(4); const float* cbv = INP(5);
      for (int e = gtid; e < 524288; e += gnt) {
          const int j = e & 7, ln = (e >> 3) & 63, hi = ln >> 5, r32 = ln & 31, blk = (e >> 12) & 15, bl = e >> 16;
          { const int s = (e >> 9) & 3, kvh = (e >> 11) & 1, cp = kvh * 64 + 16 * s + 8 * hi + j, o = cp & 31, c = (cp - o) + (o >> 1) + 16 * (o & 1);
            kca[e] = (bf16_t)(pk2(cak[((size_t)bl * 512 + blk * 32 + r32) * 128 + c], 0.f) & 0xffff); }
          { const int ks = (e >> 9) & 1, db = (e >> 10) & 1, kvh = (e >> 11) & 1, key = blk * 32 + 16 * ks + 8 * (j >> 2) + 4 * hi + (j & 3);
            vca[e] = (bf16_t)(pk2(cav[((size_t)bl * 512 + key) * 128 + kvh * 64 + db * 32 + r32], 0.f) & 0xffff); } }
      for (int e = gtid; e < 1048576; e += gnt) {
          const int j = e & 7, ln = (e >> 3) & 63, hi = ln >> 5, r32 = ln & 31, blk = (e >> 13) & 15, bl = e >> 17;
          { const int s = (e >> 9) & 1, hm = (e >> 10) & 7, cp = hm * 32 + 16 * s + 8 * hi + j, o = cp & 15, c = (cp - o) + (o >> 1) + 8 * (o & 1);
            kcb[e] = (bf16_t)(pk2(cbk[((size_t)bl * 512 + blk * 32 + r32) * 256 + c], 0.f) & 0xffff); }
          { const int ks = (e >> 9) & 1, db = (e >> 10) & 1, h = (e >> 11) & 3, key = blk * 32 + 16 * ks + 8 * (j >> 2) + 4 * hi + (j & 3);
            vcb[e] = (bf16_t)(pk2(cbv[((size_t)bl * 512 + key) * 256 + h * 64 + db * 32 + r32], 0.f) & 0xffff); } } }
    for (int st = 0; st < 1; ++st) { u32x4* z = (u32x4*)(WSP(bf16_t, WS_WIN + st * WSET_STRIDE) + (size_t)2944 * 1024); unsigned z0; asm volatile("v_mov_b32 %0, 0" : "=v"(z0)); for (int i = gtid; i < 128 * 1024 / 8; i += gnt) z[i] = (u32x4){z0, z0, z0, z0}; }
}

template <int MAP> __device__ __forceinline__ int dest_row(int n) {
    if (MAP == 1) {
        if (n < 512) { const int o = n & 31; return (n - o) + 2 * (o & 15) + (o >> 4); }
        if (n >= 640 && n < 1152) { const int o = n & 15; return (n - o) + 2 * (o & 7) + (o >> 3); }
        return n;
    }
    if (MAP == 2) return (n >> 2) * 8 + (n & 3);
    if (MAP == 3) return (n >> 2) * 8 + 4 + (n & 3);
    return n;
}
template <int MAP> __device__ __forceinline__ void transpose_item(const float* W, int K, int N, bf16_t* WT, LAS float* scr, int item, int lane) {
    const int nblk = N / 32, kb = item / nblk, nb = item % nblk, k0 = 64 * kb, n0 = 32 * nb;
#pragma unroll 8
    for (int i = 0; i < 32; ++i) { const int kk = 2 * i + (lane >> 5); scr[kk * 33 + (lane & 31)] = *(const GAS float*)(W + (size_t)(k0 + kk) * N + n0 + (lane & 31)); }
    asm volatile("s_waitcnt lgkmcnt(0)" ::: "memory");
    const int c = lane & 7;
#pragma unroll
    for (int j = 0; j < 4; ++j) { const int n = (lane >> 3) + 8 * j; const LAS float* s = scr + (8 * c) * 33 + n;
        u32x4 o; o.x = pk2(s[0 * 33], s[1 * 33]); o.y = pk2(s[2 * 33], s[3 * 33]); o.z = pk2(s[4 * 33], s[5 * 33]); o.w = pk2(s[6 * 33], s[7 * 33]);
        *(GAS u32x4*)(WT + (size_t)dest_row<MAP>(n0 + n) * K + k0 + 8 * c) = o; }
    asm volatile("s_waitcnt lgkmcnt(0)" ::: "memory");
}
template <int MAP> __device__ __forceinline__ void convert_item(const float* W, int K, int N, bf16_t* WT, int item, int lane) {
    const int nblk = N / 64, kb = item / nblk, nb = item % nblk, n = nb * 64 + lane;
    const GAS float* src = (const GAS float*)W + (size_t)(kb * 128) * N + n;
    GAS bf16_t* dst = (GAS bf16_t*)WT + (size_t)dest_row<MAP>(n) * K + kb * 128;
#pragma unroll
    for (int g = 0; g < 16; ++g) { float v[8];
#pragma unroll
        for (int e = 0; e < 8; ++e) v[e] = src[(size_t)(8 * g + e) * N];
        u32x4 o; o.x = pk2(v[0], v[1]); o.y = pk2(v[2], v[3]); o.z = pk2(v[4], v[5]); o.w = pk2(v[6], v[7]);
        *(GAS u32x4*)(dst + 8 * g) = o; }
}
constexpr int CV_IN = 46 * 8, CV_OUT = 16 * 8, CV_1 = 44 * 8, CV_2 = 16 * 22, CV_TOTAL = CV_IN + CV_OUT + 2 * CV_1 + CV_2;
__device__ __forceinline__ void convert_item_any(Frame& F, int l, int it) {
    const unsigned so = 0u * WSET_STRIDE;
    int r = it;
    if (r < CV_IN) { convert_item<1>(INP(14) + (size_t)l * 1024 * 2944, 1024, 2944, WSP(bf16_t, WS_WIN + so), r, F.lane); return; } r -= CV_IN;
    if (r < CV_OUT) { convert_item<0>(INP(29) + (size_t)l * 1024 * 1024, 1024, 1024, WSP(bf16_t, WS_WOUT + so), r, F.lane); return; } r -= CV_OUT;
    if (r < CV_1) { convert_item<2>(INP(30) + (size_t)l * 1024 * FF, 1024, FF, WSP(bf16_t, WS_W13 + so), r, F.lane); return; } r -= CV_1;
    if (r < CV_1) { convert_item<3>(INP(31) + (size_t)l * 1024 * FF, 1024, FF, WSP(bf16_t, WS_W13 + so), r, F.lane); return; } r -= CV_1;
    convert_item<0>(INP(32) + (size_t)l * FF * 1024, FF, 1024, WSP(bf16_t, WS_W2 + so), r, F.lane);
}
__device__ __forceinline__ void convert_weights(Frame& F, int l) {
    LAS float* scr = (LAS float*)(F.lds + F.wave * 16384); const unsigned so = 0u * WSET_STRIDE;
    const float* w_in = INP(14) + (size_t)l * 1024 * 2944; const float* w_out = INP(29) + (size_t)l * 1024 * 1024;
    const float* w1 = INP(30) + (size_t)l * 1024 * FF; const float* w3 = INP(31) + (size_t)l * 1024 * FF; const float* w2 = INP(32) + (size_t)l * FF * 1024;
    constexpr int I_IN = 16 * 92, I_OUT = 16 * 32, I_1 = 16 * 88, I_2 = 44 * 32;
    constexpr int NIT = I_IN + I_OUT + 2 * I_1 + I_2;
    for (int it = F.gw; it < NIT; it += F.ngw) {
        int r = it;
        if (r < I_IN) { transpose_item<1>(w_in, 1024, 2944, WSP(bf16_t, WS_WIN + so), scr, r, F.lane); continue; } r -= I_IN;
        if (r < I_OUT) { transpose_item<0>(w_out, 1024, 1024, WSP(bf16_t, WS_WOUT + so), scr, r, F.lane); continue; } r -= I_OUT;
        if (r < I_1) { transpose_item<2>(w1, 1024, FF, WSP(bf16_t, WS_W13 + so), scr, r, F.lane); continue; } r -= I_1;
        if (r < I_1) { transpose_item<3>(w3, 1024, FF, WSP(bf16_t, WS_W13 + so), scr, r, F.lane); continue; } r -= I_1;
        transpose_item<0>(w2, FF, 1024, WSP(bf16_t, WS_W2 + so), scr, r, F.lane);
    }
}

__device__ __forceinline__ void phase_norm(Frame& F, int l, int which  ) {
    const float* g = (which ? INP(13) : INP(12)) + l * 1024;
    const float* mod = WSP(float, WS_MOD) + (size_t)l * 3 * 6144 + (which ? 3072 : 0);
    bf16_t* H = WSP(bf16_t, WS_ACT);
    const bool first = (l == 0 && which == 0);
    f32x4 gv[4];
#pragma unroll
    for (int j = 0; j < 4; ++j) gv[j] = *(const GAS f32x4*)(g + 4 * F.lane + 256 * j);
    for (int row = F.gw; row < M; row += F.ngw) {
        const float* mv = mod + (row < MC ? 0 : (row < 2 * MC ? 1 : 2)) * 6144;
        f32x4 v[4]; float ss = 0.f;
        if (first) { const float* xr = row < MC ? INP(0) + (size_t)row * DM : INP(1) + (size_t)(row - MC) * DM;
#pragma unroll
            for (int j = 0; j < 4; ++j) v[j] = *(const GAS f32x4*)(xr + 4 * F.lane + 256 * j); }
        else {
#pragma unroll
            for (int j = 0; j < 4; ++j) v[j] = unpack4(LDG(u32x2, F.ws, WS_XB + ((unsigned)row * DM + 4 * F.lane + 256 * j) * 2)); }
#pragma unroll
        for (int j = 0; j < 4; ++j) ss += (v[j][0] * v[j][0] + v[j][1] * v[j][1]) + (v[j][2] * v[j][2] + v[j][3] * v[j][3]);
        const float rstd = rsqrtf(wave_sum(ss) * (1.f / 1024.f) + 1e-6f);
#pragma unroll
        for (int j = 0; j < 4; ++j) { const f32x4 sh = *(const GAS f32x4*)(mv + 4 * F.lane + 256 * j), sc = *(const GAS f32x4*)(mv + 1024 + 4 * F.lane + 256 * j);
            const f32x4 h = v[j] * rstd * gv[j] * (sc + 1.f) + sh;
            *(GAS u32x2*)(H + (size_t)row * DM + 4 * F.lane + 256 * j) = pack4(h); }
    }
}
__device__ __forceinline__ void phase_final_norm(Frame& F) {
    const float* g = INP(33);
    f32x4 gv[4];
#pragma unroll
    for (int j = 0; j < 4; ++j) gv[j] = *(const GAS f32x4*)(g + 4 * F.lane + 256 * j);
    for (int row = F.gw; row < M; row += F.ngw) {
        float* xr = gptr(F.out + (size_t)row * DM);
        f32x4 v[4]; float ss = 0.f;
#pragma unroll
        for (int j = 0; j < 4; ++j) { v[j] = unpack4(LDG(u32x2, F.ws, WS_XB + ((unsigned)row * DM + 4 * F.lane + 256 * j) * 2)); ss += (v[j][0] * v[j][0] + v[j][1] * v[j][1]) + (v[j][2] * v[j][2] + v[j][3] * v[j][3]); }
        const float rstd = rsqrtf(wave_sum(ss) * (1.f / 1024.f) + 1e-6f);
#pragma unroll
        for (int j = 0; j < 4; ++j) *(GAS f32x4*)(xr + 4 * F.lane + 256 * j) = v[j] * rstd * gv[j];
    }
}

#define MFMA32(a, b, c) __builtin_amdgcn_mfma_f32_32x32x16_bf16((a), (b), (c), 0, 0, 0)
#ifndef ATT_PROBE
#define ATT_PROBE 0
#endif
struct AttnQ { float m, l; bool mz; f32x16 o[2]; };
template <int DQK, bool MASK, int NQ>
__device__ __forceinline__ void attn_block(const bf16x8 (&qf)[NQ][DQK / 16], const bf16x8 (&kf)[DQK / 16], const bf16x8 (&vf)[4], AttnQ (&st)[NQ], int b, const int (&qpos)[NQ], int kpos0, int hi) {
    constexpr int NS = DQK / 16;
    f32x16 sc[NQ];
#pragma unroll
    for (int q = 0; q < NQ; ++q) { const f32x16 z = {}; sc[q] = MFMA32(kf[0], qf[q][0], z);
#pragma unroll
        for (int s = 1; s < NS; ++s) sc[q] = MFMA32(kf[s], qf[q][s], sc[q]); }
#pragma unroll
    for (int q = 0; q < NQ; ++q) {
        if (!st[q].mz) {
#pragma unroll
            for (int r = 0; r < 16; ++r) sc[q][r] -= st[q].m; }
        if (MASK) {
#pragma unroll
            for (int r = 0; r < 16; ++r) { const int key = kpos0 + 32 * b + (r & 3) + 8 * (r >> 2) + 4 * hi; const int dlt = key - qpos[q]; if (dlt > 128 || dlt < -128) sc[q][r] = -1e30f; }
        }
        float bm = fmaxf(fmaxf(sc[q][0], sc[q][1]), sc[q][2]);
#pragma unroll
        for (int r = 3; r < 15; r += 2) bm = fmaxf(fmaxf(bm, sc[q][r]), sc[q][r + 1]);
        bm = fmaxf(bm, sc[q][15]);
        bm = swap32_max(bm);
        if (__builtin_amdgcn_ballot_w64(bm > 64.f) != 0ull) {
            const float d = fmaxf(bm, 0.f);
            const float alpha = __builtin_amdgcn_exp2f(-d);
            st[q].m += d; st[q].l *= alpha; st[q].mz = false;
#pragma unroll
            for (int r = 0; r < 16; ++r) { st[q].o[0][r] *= alpha; st[q].o[1][r] *= alpha; sc[q][r] -= d; }
        }
#if ATT_PROBE == 1
        { float dmy = 0.f;
#pragma unroll
          for (int r = 0; r < 16; ++r) { float e_; asm volatile("v_exp_f32 %0, %1" : "=v"(e_) : "v"(sc[q][r])); dmy += e_; }
          asm volatile("" :: "v"(dmy)); }
#endif
        f32x2 rs2 = {0.f, 0.f};
#pragma unroll
        for (int r = 0; r < 16; r += 2) { sc[q][r] = __builtin_amdgcn_exp2f(sc[q][r]); sc[q][r + 1] = __builtin_amdgcn_exp2f(sc[q][r + 1]); rs2 += (f32x2){sc[q][r], sc[q][r + 1]}; }
        st[q].l += rs2[0] + rs2[1];
#if ATT_PROBE == 3
        { float d0 = 0.f, d1 = 0.f, d2 = 0.f, d3 = 0.f;
#pragma unroll
          for (int rr = 0; rr < 10; ++rr) { asm volatile("v_add_f32 %0, %0, %4\n\tv_add_f32 %1, %1, %5\n\tv_add_f32 %2, %2, %6\n\tv_add_f32 %3, %3, %7" : "+v"(d0), "+v"(d1), "+v"(d2), "+v"(d3) : "v"(sc[q][0]), "v"(sc[q][1]), "v"(sc[q][2]), "v"(sc[q][3])); }
          asm volatile("" :: "v"(d0), "v"(d1), "v"(d2), "v"(d3)); }
#endif
#if ATT_PROBE == 2
        { f32x16 dm = sc[q]; dm = MFMA32(kf[0], qf[q][0], dm); dm = MFMA32(kf[0], qf[q][0], dm); dm = MFMA32(kf[0], qf[q][0], dm); asm volatile("" :: "v"(dm)); }
#endif
        bf16x8 pb[2];
#pragma unroll
        for (int ks = 0; ks < 2; ++ks) { u32x4 w; w.x = pk2(sc[q][8 * ks], sc[q][8 * ks + 1]); w.y = pk2(sc[q][8 * ks + 2], sc[q][8 * ks + 3]); w.z = pk2(sc[q][8 * ks + 4], sc[q][8 * ks + 5]); w.w = pk2(sc[q][8 * ks + 6], sc[q][8 * ks + 7]); pb[ks] = __builtin_bit_cast(bf16x8, w); }
#pragma unroll
        for (int db = 0; db < 2; ++db)
#pragma unroll
            for (int ks = 0; ks < 2; ++ks) st[q].o[db] = MFMA32(vf[db * 2 + ks], pb[ks], st[q].o[db]);
    }
}
template <int DQK, bool MASK, int NQ>
__device__ __forceinline__ void attn_seg(const unsigned char* ws, const bf16x8 (&qf)[NQ][DQK / 16], AttnQ (&st)[NQ],
                                         unsigned kp, unsigned kblk  , unsigned vp, unsigned vblk, int nblk, const int (&qpos)[NQ], int kpos0, int hi) {
    constexpr int NS = DQK / 16;
    const GAS unsigned char* kq = (const GAS unsigned char*)ws + kp; const GAS unsigned char* vq = (const GAS unsigned char*)ws + vp;
    bf16x8 ka[NS], va[4], kb[NS], vb[4];
#define ATT_LOAD(kd, vd) do { _Pragma("unroll") for (int s = 0; s < NS; ++s) kd[s] = *(const GAS bf16x8*)(kq + 1024 * s); _Pragma("unroll") for (int f = 0; f < 4; ++f) vd[f] = *(const GAS bf16x8*)(vq + 1024 * f); } while (0)
    ATT_LOAD(ka, va);
    int b = 0;
    for (; b + 1 < nblk; b += 2) {
        kq += kblk; vq += vblk; ATT_LOAD(kb, vb);
        attn_block<DQK, MASK, NQ>(qf, ka, va, st, b, qpos, kpos0, hi);
        if (b + 2 < nblk) { kq += kblk; vq += vblk; }
        ATT_LOAD(ka, va);
        attn_block<DQK, MASK, NQ>(qf, kb, vb, st, b + 1, qpos, kpos0, hi);
    }
    if (b < nblk) attn_block<DQK, MASK, NQ>(qf, ka, va, st, b, qpos, kpos0, hi);
#undef ATT_LOAD
}
__device__ __forceinline__ void attnq_init(AttnQ& s, float l0) { s.m = 0.f; s.mz = true; s.l = l0; s.o[0] = (f32x16){}; s.o[1] = (f32x16){}; }
__device__ __forceinline__ void attn_a_item(Frame& F, int l, bool lat, int item) {
    int lane = F.lane; asm volatile("" : "+v"(lane));
    const unsigned char* ws = F.ws;
    const unsigned r32 = lane & 31, hi = lane >> 5;
    const unsigned nqb = lat ? 128 : 8;
    const unsigned qb = item % nqb, hq = (item / nqb) % 6, b = item / (nqb * 6), kvh = hq / 3;
    const unsigned seq0 = lat ? MC + b * 4096 : b * 256, q0 = qb * 32, row = seq0 + q0 + r32;
    const unsigned qo = WS_QA + (row * 384 + hq * 64 + 8 * hi) * 2;
    bf16x8 qf[1][4];
#pragma unroll
    for (int s = 0; s < 4; ++s) qf[0][s] = LDG(bf16x8, ws, qo + 32 * s);
    AttnQ st[1]; attnq_init(st[0], hi == 0 ? __builtin_amdgcn_exp2f(INP(15)[l * 6 + hq] * LOG2E) : 0.f);
    const int qpos[1] = {(int)(q0 + r32)};
    const unsigned fo = kvh * 4096 + lane * 16;
    if (!lat) {
        attn_seg<64, false, 1>(ws, qf, st, WS_KA + (seq0 >> 5) * 8192 + fo, 8192, WS_VTA + (seq0 >> 5) * 8192 + fo, 8192, 8, qpos, 0, hi);
    } else {
        const int ks = (int)q0 - 128 < 0 ? 0 : (int)q0 - 128, ke = q0 + 160 > 4096 ? 4096 : q0 + 160;
        attn_seg<64, true, 1>(ws, qf, st, WS_KA + ((seq0 + ks) >> 5) * 8192 + fo, 8192, WS_VTA + ((seq0 + ks) >> 5) * 8192 + fo, 8192, (ke - ks) >> 5, qpos, ks, hi);
        attn_seg<64, false, 1>(ws, qf, st, WS_CACHE + (b * 4 + l) * 131072 + fo, 8192, WS_CACHE + 1 * MiB + (b * 4 + l) * 131072 + fo, 8192, 16, qpos, 0, hi);
    }
    const float rl = 1.f / swap32_sum(st[0].l);
    const unsigned oo = WS_ACT + (row * DM + hq * 64 + 4 * hi) * 2;
#pragma unroll
    for (int db = 0; db < 2; ++db)
#pragma unroll
        for (int g = 0; g < 4; ++g) { const f32x4 v = {st[0].o[db][4 * g] * rl, st[0].o[db][4 * g + 1] * rl, st[0].o[db][4 * g + 2] * rl, st[0].o[db][4 * g + 3] * rl}; STG(u32x2, F.ws, oo + (32 * db + 8 * g) * 2) = pack4(v); }
}
__device__ __forceinline__ void attn_b_store(Frame& F, const AttnQ& s, unsigned mp, unsigned kh, unsigned row, unsigned h, unsigned hi) {
    const float lt = swap32_sum(s.l);
    const unsigned oo = WS_BO2 + (((mp * 2 + kh) * M + row) * 256 + h * 64 + 4 * hi) * 2;
#pragma unroll
    for (int db = 0; db < 2; ++db)
#pragma unroll
        for (int g = 0; g < 4; ++g) STG(u32x2, F.ws, oo + (32 * db + 8 * g) * 2) = pack4((f32x4){s.o[db][4 * g], s.o[db][4 * g + 1], s.o[db][4 * g + 2], s.o[db][4 * g + 3]});
    if (hi == 0) STG(f32x2, F.ws, WS_ML + ((((mp * 2 + kh) * M + row) * 4 + h) * 2) * 4) = (f32x2){s.m, lt};
}
__device__ __forceinline__ void attn_b_item(Frame& F, int l, bool lat, int item) {
    int lane = F.lane; asm volatile("" : "+v"(lane));
    const unsigned char* ws = F.ws;
    const unsigned r32 = lane & 31, hi = lane >> 5;
    if (lat) {
        const unsigned kh = item & 1, qb = (item >> 1) & 63, mp = (item >> 7) & 1, h = (item >> 8) & 3, b = item >> 10;
        const unsigned seq0 = MC + b * 4096, row0 = seq0 + qb * 64 + r32;
        bf16x8 qf[2][2];
#pragma unroll
        for (int q = 0; q < 2; ++q)
#pragma unroll
            for (int s = 0; s < 2; ++s) qf[q][s] = LDG(bf16x8, ws, WS_QB + ((row0 + 32 * q) * 256 + h * 64 + mp * 32 + 8 * hi) * 2 + 32 * s);
        AttnQ st[2]; attnq_init(st[0], 0.f); attnq_init(st[1], 0.f);
        const int qpos[2] = {0, 0};
        const unsigned kfo = (h * 2 + mp) * 2048 + lane * 16, vfo = h * 4096 + lane * 16;
        const unsigned blk0 = kh ? 72u : 0u, nb = kh ? 56 : 72;
        attn_seg<32, false, 2>(ws, qf, st, WS_KB + ((seq0 >> 5) + blk0) * 16384 + kfo, 16384, WS_VTB + ((seq0 >> 5) + blk0) * 16384 + vfo, 16384, nb, qpos, 0, hi);
        if (kh) attn_seg<32, false, 2>(ws, qf, st, WS_CACHE + 2 * MiB + (b * 4 + l) * 262144 + kfo, 16384, WS_CACHE + 4 * MiB + (b * 4 + l) * 262144 + vfo, 16384, 16, qpos, 0, hi);
        attn_b_store(F, st[0], mp, kh, row0, h, hi); attn_b_store(F, st[1], mp, kh, row0 + 32, h, hi);
    } else {
        const unsigned qb = item & 7, mp = (item >> 3) & 1, h = (item >> 4) & 3, b = item >> 6;
        const unsigned seq0 = b * 256, row = seq0 + qb * 32 + r32;
        bf16x8 qf[1][2];
#pragma unroll
        for (int s = 0; s < 2; ++s) qf[0][s] = LDG(bf16x8, ws, WS_QB + (row * 256 + h * 64 + mp * 32 + 8 * hi) * 2 + 32 * s);
        AttnQ st[1]; attnq_init(st[0], 0.f);
        const int qpos[1] = {0};
        const unsigned kfo = (h * 2 + mp) * 2048 + lane * 16, vfo = h * 4096 + lane * 16;
        attn_seg<32, false, 1>(ws, qf, st, WS_KB + (seq0 >> 5) * 16384 + kfo, 16384, WS_VTB + (seq0 >> 5) * 16384 + vfo, 16384, 8, qpos, 0, hi);
        attn_b_store(F, st[0], mp, 0, row, h, hi);
    }
}

constexpr int L_KT = 0, L_RT = 9216, L_BT = 18432, L_KK = 27648, L_VT = 36864, L_KKT = 46080, L_BTT = 55296, L_A1 = 64512, L_RHS2 = 81920, L_WT = 99328, L_U0T = 108544, L_GC = 117760, L_X0 = 118016;
constexpr int RPB = 144, RPF = 272;
__device__ __forceinline__ void chunk_decode(int cid, unsigned& seq0, int& T, unsigned& b, unsigned& h, unsigned& dir, int& c) {
    unsigned chain;
    if (cid < 768) { chain = (unsigned)cid >> 2; c = cid & 3; T = 256; b = chain / 12; seq0 = b * 256; }
    else { const unsigned x = (unsigned)cid - 768; chain = x >> 6; c = (int)(x & 63); T = 4096; b = chain / 12; seq0 = MC + b * 4096; }
    dir = chain & 1; h = (chain >> 1) % 6;
}
__device__ __forceinline__ bf16x8 acc_frag(const f32x16& x, int ks, float sgn) {
    u32x4 w; w.x = pk2(sgn * x[8 * ks], sgn * x[8 * ks + 1]); w.y = pk2(sgn * x[8 * ks + 2], sgn * x[8 * ks + 3]); w.z = pk2(sgn * x[8 * ks + 4], sgn * x[8 * ks + 5]); w.w = pk2(sgn * x[8 * ks + 6], sgn * x[8 * ks + 7]);
    return __builtin_bit_cast(bf16x8, w);
}
__device__ __forceinline__ bf16x8 lds_frag_nat(const LAS unsigned char* img, unsigned row, int ks, unsigned hi) { return *(const LAS bf16x8*)(img + row * RPB + (16 * ks + 8 * hi) * 2); }
__device__ __forceinline__ bf16x8 lds_frag_perm(const LAS unsigned char* img, unsigned row, int k0, unsigned hi) {
    const s16x4 a = *(const LAS s16x4*)(img + row * RPB + (k0 + 4 * hi) * 2), b = *(const LAS s16x4*)(img + row * RPB + (k0 + 8 + 4 * hi) * 2);
    return (bf16x8){a[0], a[1], a[2], a[3], b[0], b[1], b[2], b[3]};
}
__device__ __forceinline__ f32x16 gram_tile(const LAS unsigned char* lds, int aimg, int bimg, int sb, int tb, unsigned r32, unsigned hi, bool strict) {
    f32x16 acc = {};
#pragma unroll
    for (int ks = 0; ks < 4; ++ks) acc = MFMA32(lds_frag_nat(lds + aimg, 32 * sb + r32, ks, hi), lds_frag_nat(lds + bimg, 32 * tb + r32, ks, hi), acc);
    if (sb == tb) {
#pragma unroll
        for (int r = 0; r < 16; ++r) { const unsigned s_ = (r & 3) + 8 * (r >> 2) + 4 * hi; const bool keep = strict ? s_ < r32 : s_ <= r32; acc[r] = keep ? acc[r] : 0.f; }
    }
    return acc;
}
__device__ __forceinline__ void lds_barrier() { asm volatile("s_waitcnt lgkmcnt(0)\n\ts_barrier" ::: "memory"); }
__device__ __forceinline__ void rwkv_chunk_block(Frame& F, int l, int cid) {
    int lane = F.lane; asm volatile("" : "+v"(lane));
    const unsigned char* ws = F.ws; LAS unsigned char* lds = F.lds;
    const int w = F.wave; const unsigned r32 = lane & 31, hi = lane >> 5;
    unsigned seq0, b, h, dir; int T, c; chunk_decode(cid, seq0, T, b, h, dir, c);
    const int q0 = 64 * c;
#ifndef RA_REP
#define RA_REP 0
#endif
    const int role = w >> 1, tb = w & 1;
    const unsigned swo = WS_SMALLW + l * (SMALLW_L * 2);
    {
        const int pw_ = w < 4, pb = (w >> 1) & 1, cb = w & 1;
        const int p_ = 32 * pb + r32; const unsigned tokp = seq0 + (dir ? T - 1 - (q0 + p_) : q0 + p_);
        const unsigned xo = (pw_ ? WS_CW : WS_CA) + (tokp * 128 + dir * 64 + 8 * hi) * 2, wo = swo + ((pw_ ? 0 : 49152) + (dir * 384 + h * 64 + 32 * cb + r32) * 64 + 8 * hi) * 2;
        f32x16 acc = {};
#pragma unroll
        for (int ks = 0; ks < 4; ++ks) acc = MFMA32(LDG(bf16x8, ws, xo + 32 * ks), LDG(bf16x8, ws, wo + 32 * ks), acc);
        {
            const float bias = LDG(float, pw_ ? INP(19) : INP(21), ((l * 2 + dir) * 384 + h * 64 + 32 * cb + r32) * 4);
#pragma unroll
            for (int r = 0; r < 16; ++r) { const float sg = sigmf(bias + acc[r]);
                *(LAS float*)(lds + (pw_ ? L_A1 : L_RHS2) + (32 * pb + (r & 3) + 8 * (r >> 2) + 4 * hi) * RPF + (32 * cb + r32) * 4) = pw_ ? -0.606531f * sg : sg; }
        }
        if (dir == 0 && w < 4) {
            f32x16 ag = {};
            const unsigned go = WS_CG + (tokp * 128 + 8 * hi) * 2, gw_ = swo + (98304 + (h * 64 + 32 * cb + r32) * 128 + 8 * hi) * 2;
#pragma unroll
            for (int ks = 0; ks < 8; ++ks) ag = MFMA32(LDG(bf16x8, ws, go + 32 * ks), LDG(bf16x8, ws, gw_ + 32 * ks), ag);
#pragma unroll
            for (int r = 0; r < 16; ++r) { const int pp_ = 32 * pb + (r & 3) + 8 * (r >> 2) + 4 * hi; const unsigned tk = seq0 + q0 + pp_;
                STG(bf16_t, F.ws, WS_G + (tk * 384 + h * 64 + 32 * cb + r32) * 2) = (bf16_t)(pk2(ag[r], 0.f) & 0xffff); }
        }
    }
    lds_barrier();
    {
        const unsigned cch = h * 64 + lane;
        const float* convp = INP(18) + (size_t)l * 3 * 1152;
        float cw_[3][3];
#pragma unroll
        for (int tap = 0; tap < 3; ++tap)
#pragma unroll
            for (int seg = 0; seg < 3; ++seg) cw_[tap][seg] = LDG(float, convp, (tap * 1152 + seg * 384 + cch) * 4);
        const float ckk = LDG(float, INP(24), (l * 384 + cch) * 4), cka = LDG(float, INP(25), (l * 384 + cch) * 4), crk = LDG(float, INP(26), (l * 384 + cch) * 4);
        const int tb0 = dir ? T - 1 - (q0 + 8 * w + 7) : q0 + 8 * w;
        float xr[10][3];
#pragma unroll
        for (int rr = 0; rr < 10; ++rr) { const int tr = tb0 - 1 + rr; const bool ok = tr >= 0 && tr < T; const unsigned tk = seq0 + (ok ? tr : tb0);
#pragma unroll
            for (int seg = 0; seg < 3; ++seg) { const float x = bf_lo((unsigned)LDG(bf16_t, ws, WS_RKV + (tk * 1152 + seg * 384 + cch) * 2)); xr[rr][seg] = ok ? x : 0.f; } }
        float lwv[8], kkv[8], btv[8], kdv[8], rv[8], vv[8], g = 0.f;
#pragma unroll
        for (int pp = 0; pp < 8; ++pp) {
            const int rr = 1 + (dir ? 7 - pp : pp); const int p = 8 * w + pp; const unsigned tok = seq0 + (unsigned)(tb0 + rr - 1);
            const float r_ = xr[rr - 1][0] * cw_[0][0] + xr[rr][0] * cw_[1][0] + xr[rr + 1][0] * cw_[2][0];
            const float k_ = xr[rr - 1][1] * cw_[0][1] + xr[rr][1] * cw_[1][1] + xr[rr + 1][1] * cw_[2][1];
            const float v_ = xr[rr - 1][2] * cw_[0][2] + xr[rr][2] * cw_[1][2] + xr[rr + 1][2] * cw_[2][2];
            const float kraw = k_ * ckk; const float n2 = wave_sum(kraw * kraw); const float kk_ = kraw * __builtin_amdgcn_rsqf(fmaxf(n2, 1e-24f));
            const float lw = *(const LAS float*)(lds + L_A1 + p * RPF + lane * 4), av = *(const LAS float*)(lds + L_RHS2 + p * RPF + lane * 4);
            const float kd_ = k_ * (1.f + (av - 1.f) * cka);
            const float bon = wave_sum(r_ * kd_ * crk);
            if (lane == 0) STG(float, F.ws, WS_SB + ((dir * M + tok) * 8 + h) * 4) = bon;
            if (dir == 0) STG(float, F.ws, WS_SV + (tok * 384 + cch) * 4) = v_;
            lwv[pp] = lw; kkv[pp] = kk_; btv[pp] = kk_ * av; kdv[pp] = kd_; rv[pp] = r_; vv[pp] = v_; g += lw;
        }
        g = 0.f;
        for (int wq = 0; wq < w; ++wq) { float t8[8];
#pragma unroll
            for (int e = 0; e < 8; ++e) t8[e] = *(const LAS float*)(lds + L_A1 + (8 * wq + e) * RPF + lane * 4);
            g += ((t8[0] + t8[1]) + (t8[2] + t8[3])) + ((t8[4] + t8[5]) + (t8[6] + t8[7])); }
        unsigned vt[4], kkt[4], btt[4]; float e_pos = __expf(g);
#pragma unroll
        for (int pp = 0; pp < 8; ++pp) {
            const int p = 8 * w + pp;
            const float e_prev = e_pos; g += lwv[pp]; e_pos = __expf(g); const float e_neg = __expf(-g);
            const unsigned pk_kr = pk2(kkv[pp] * e_prev, rv[pp] * e_pos), pk_bk = pk2(btv[pp] * e_neg, kdv[pp] * e_neg), pk_v = pk2(vv[pp], 0.f);
            *(LAS bf16_t*)(lds + L_KT + p * RPB + lane * 2) = (bf16_t)(pk_kr & 0xffff); *(LAS bf16_t*)(lds + L_RT + p * RPB + lane * 2) = (bf16_t)(pk_kr >> 16);
            *(LAS bf16_t*)(lds + L_BT + p * RPB + lane * 2) = (bf16_t)(pk_bk & 0xffff); *(LAS bf16_t*)(lds + L_KK + p * RPB + lane * 2) = (bf16_t)(pk_bk >> 16);
            if (pp & 1) { vt[pp >> 1] |= pk_v << 16; kkt[pp >> 1] |= pk_bk & 0xffff0000u; btt[pp >> 1] |= pk_bk << 16; }
            else { vt[pp >> 1] = pk_v & 0xffff; kkt[pp >> 1] = pk_bk >> 16; btt[pp >> 1] = pk_bk & 0xffff; }
        }
        *(LAS u32x4*)(lds + L_VT + lane * RPB + 16 * w) = (u32x4){vt[0], vt[1], vt[2], vt[3]};
        *(LAS u32x4*)(lds + L_KKT + lane * RPB + 16 * w) = (u32x4){kkt[0], kkt[1], kkt[2], kkt[3]};
        *(LAS u32x4*)(lds + L_BTT + lane * RPB + 16 * w) = (u32x4){btt[0], btt[1], btt[2], btt[3]};
        if (w == 7) *(LAS float*)(lds + L_GC + lane * 4) = e_pos;
    }
    lds_barrier();
    f32x16 keep[2]; bf16x8 x4f[2][2];
    if (role == 0) {
        for (int sb = 0; sb <= tb; ++sb) { const f32x16 x = gram_tile(lds, L_BT, L_KT, sb, tb, r32, hi, true);
            if (sb == tb) {
#pragma unroll
                for (int r = 0; r < 16; ++r) *(LAS float*)(lds + L_A1 + tb * 4608 + ((r & 3) + 8 * (r >> 2) + 4 * hi) * 144 + r32 * 4) = -x[r];
            } else {
#pragma unroll
                for (int g4 = 0; g4 < 4; ++g4) *(LAS f32x4*)(lds + L_A1 + 9216 + r32 * 144 + (8 * g4 + 4 * hi) * 4) = (f32x4){x[4 * g4], x[4 * g4 + 1], x[4 * g4 + 2], x[4 * g4 + 3]};
            } }
    } else if (role == 1) {
        f32x16 o[2] = {};
        for (int sb = 0; sb <= tb; ++sb) {
            const f32x16 x = gram_tile(lds, L_KK, L_KT, sb, tb, r32, hi, true);
#pragma unroll
            for (int ks = 0; ks < 2; ++ks) { const bf16x8 a = acc_frag(x, ks, 1.f);
#pragma unroll
                for (int ib = 0; ib < 2; ++ib) o[ib] = MFMA32(a, lds_frag_perm(lds + L_VT, 32 * ib + r32, 32 * sb + 16 * ks, hi), o[ib]); }
        }
#pragma unroll
        for (int ib = 0; ib < 2; ++ib)
#pragma unroll
            for (int r = 0; r < 16; ++r) *(LAS float*)(lds + L_RHS2 + (32 * tb + (r & 3) + 8 * (r >> 2) + 4 * hi) * RPF + (32 * ib + r32) * 4) = o[ib][r];
    } else if (role == 2) {
#pragma unroll
        for (int sb = 0; sb < 2; ++sb) { x4f[sb][0] = (bf16x8){}; x4f[sb][1] = (bf16x8){}; }
        keep[0] = (f32x16){}; keep[1] = (f32x16){};
        for (int sb = 0; sb <= tb; ++sb) {
            const f32x16 x3 = gram_tile(lds, L_KK, L_RT, sb, tb, r32, hi, false), x4 = gram_tile(lds, L_BT, L_RT, sb, tb, r32, hi, false);
#pragma unroll
            for (int ks = 0; ks < 2; ++ks) { const bf16x8 a3 = acc_frag(x3, ks, 1.f); const bf16x8 a4 = acc_frag(x4, ks, -1.f);
                if (sb == 0) x4f[0][ks] = a4; else x4f[1][ks] = a4;
#pragma unroll
                for (int cb = 0; cb < 2; ++cb) keep[cb] = MFMA32(a3, lds_frag_perm(lds + L_VT, 32 * cb + r32, 32 * sb + 16 * ks, hi), keep[cb]); }
        }
    } else {
        keep[0] = (f32x16){}; keep[1] = (f32x16){};
#pragma unroll
        for (int ks = 0; ks < 4; ++ks) { const bf16x8 ak = lds_frag_nat(lds + L_KKT, 32 * tb + r32, ks, hi);
#pragma unroll
            for (int cb = 0; cb < 2; ++cb) keep[cb] = MFMA32(ak, lds_frag_nat(lds + L_VT, 32 * cb + r32, ks, hi), keep[cb]); }
    }
    lds_barrier();
    if (w < 2) {
        const LAS unsigned char* a1p = lds + L_A1; asm volatile("" : "+v"(a1p));
        LAS unsigned char* xp = lds + (w == 0 ? L_X0 : L_RHS2) + lane * 4; asm volatile("" : "+v"(xp));
        const LAS unsigned char* kp = lds + L_KT + lane * 2; asm volatile("" : "+v"(kp));
        LAS unsigned char* dst = lds + (w == 0 ? L_WT : L_U0T) + lane * RPB; asm volatile("" : "+v"(dst));
#pragma unroll
        for (int B = 0; B < 2; ++B) {
            float acc[32];
            if (w == 0 && B == 0) {
#pragma unroll
                for (int r = 0; r < 32; ++r) acc[r] = bf_lo((unsigned)*(const LAS bf16_t*)(kp + r * RPB));
            } else {
#pragma unroll
                for (int r = 0; r < 32; ++r) acc[r] = *(const LAS float*)(xp + (32 * B + r) * RPF);
            }
            f32x2 ac2[16];
#pragma unroll
            for (int k = 0; k < 16; ++k) ac2[k] = (f32x2){acc[2 * k], acc[2 * k + 1]};
            f32x4 ca[8], cn[8];
#pragma unroll
            for (int tg = 0; tg < 8; ++tg) ca[tg] = *(const LAS f32x4*)(a1p + B * 4608 + tg * 16);
#pragma unroll
            for (int s_ = 0; s_ < 31; ++s_) {
                if (s_ + 1 < 31) {
#pragma unroll
                    for (int tg = (s_ + 2) / 4; tg < 8; ++tg) cn[tg] = *(const LAS f32x4*)(a1p + B * 4608 + (s_ + 1) * 144 + tg * 16);
                }
                __builtin_amdgcn_sched_barrier(0);
                const float xs = ac2[s_ >> 1][s_ & 1];
                const f32x2 xs2 = {xs, xs};
#pragma unroll
                for (int tg = (s_ + 1) / 4; tg < 8; ++tg) {
                    ac2[2 * tg] = __builtin_elementwise_fma((f32x2){ca[tg][0], ca[tg][1]}, xs2, ac2[2 * tg]);
                    ac2[2 * tg + 1] = __builtin_elementwise_fma((f32x2){ca[tg][2], ca[tg][3]}, xs2, ac2[2 * tg + 1]); }
                __builtin_amdgcn_sched_barrier(0);
#pragma unroll
                for (int tg = 0; tg < 8; ++tg) ca[tg] = cn[tg];
            }
#pragma unroll
            for (int k = 0; k < 16; ++k) { acc[2 * k] = ac2[k][0]; acc[2 * k + 1] = ac2[k][1]; }
#pragma unroll
            for (int k8 = 0; k8 < 4; ++k8) { u32x4 v; v.x = pk2(acc[8 * k8], acc[8 * k8 + 1]); v.y = pk2(acc[8 * k8 + 2], acc[8 * k8 + 3]); v.z = pk2(acc[8 * k8 + 4], acc[8 * k8 + 5]); v.w = pk2(acc[8 * k8 + 6], acc[8 * k8 + 7]);
                *(LAS u32x4*)(dst + 64 * B + 16 * k8) = v; }
            if (B == 0) {
                asm volatile("s_waitcnt lgkmcnt(0)" ::: "memory");
                f32x16 u[2];
#pragma unroll
                for (int cb = 0; cb < 2; ++cb)
#pragma unroll
                    for (int r = 0; r < 16; ++r) { const int t = 32 + (r & 3) + 8 * (r >> 2) + 4 * hi;
                        u[cb][r] = w == 0 ? bf_lo((unsigned)*(const LAS bf16_t*)(lds + L_KT + t * RPB + (32 * cb + r32) * 2)) : *(const LAS float*)(lds + L_RHS2 + t * RPF + (32 * cb + r32) * 4); }
#pragma unroll
                for (int ks = 0; ks < 2; ++ks) { const f32x4 a0 = *(const LAS f32x4*)(lds + L_A1 + 9216 + r32 * 144 + (16 * ks + 8 * hi) * 4), a1 = *(const LAS f32x4*)(lds + L_A1 + 9216 + r32 * 144 + (16 * ks + 8 * hi + 4) * 4);
                    u32x4 aw; aw.x = pk2(-a0[0], -a0[1]); aw.y = pk2(-a0[2], -a0[3]); aw.z = pk2(-a1[0], -a1[1]); aw.w = pk2(-a1[2], -a1[3]);
#pragma unroll
                    for (int cb = 0; cb < 2; ++cb) u[cb] = MFMA32(__builtin_bit_cast(bf16x8, aw), lds_frag_nat(lds + (w == 0 ? L_WT : L_U0T), 32 * cb + r32, ks, hi), u[cb]); }
#pragma unroll
                for (int cb = 0; cb < 2; ++cb)
#pragma unroll
                    for (int r = 0; r < 16; ++r) *(LAS float*)(lds + (w == 0 ? L_X0 : L_RHS2) + (32 + (r & 3) + 8 * (r >> 2) + 4 * hi) * RPF + (32 * cb + r32) * 4) = u[cb][r];
                asm volatile("s_waitcnt lgkmcnt(0)" ::: "memory");
            }
        }
    }
    lds_barrier();
    if (role == 2) {
        f32x16 pj[2];
#pragma unroll
        for (int jb = 0; jb < 2; ++jb)
#pragma unroll
            for (int r = 0; r < 16; ++r) pj[jb][r] = bf_lo((unsigned)*(const LAS bf16_t*)(lds + L_RT + (32 * tb + (r & 3) + 8 * (r >> 2) + 4 * hi) * RPB + (32 * jb + r32) * 2));
#pragma unroll
        for (int sb = 0; sb < 2; ++sb)
#pragma unroll
            for (int ks = 0; ks < 2; ++ks)
#pragma unroll
                for (int cb = 0; cb < 2; ++cb) {
                    keep[cb] = MFMA32(x4f[sb][ks], lds_frag_perm(lds + L_U0T, 32 * cb + r32, 32 * sb + 16 * ks, hi), keep[cb]);
                    pj[cb] = MFMA32(x4f[sb][ks], lds_frag_perm(lds + L_WT, 32 * cb + r32, 32 * sb + 16 * ks, hi), pj[cb]); }
        f32x16 (&y0)[2] = keep;
        const unsigned yb = dir ? WS_YB : WS_YF;
#pragma unroll
        for (int r = 0; r < 16; ++r) { const int t = 32 * tb + (r & 3) + 8 * (r >> 2) + 4 * hi; const unsigned tok = seq0 + (dir ? T - 1 - (q0 + t) : q0 + t);
#pragma unroll
            for (int cb = 0; cb < 2; ++cb) { STG(float, F.ws, yb + (tok * 384 + h * 64 + 32 * cb + r32) * 4) = y0[cb][r];
                STG(bf16_t, F.ws, WS_RP + (((unsigned)cid * 64 + t) * 64 + 32 * cb + r32) * 2) = (bf16_t)(pk2(pj[cb][r], 0.f) & 0xffff); } }
    } else if (role == 3) {
        const int jb = tb;
        f32x16 q1[2] = {}, q2[2] = {}; f32x16 (&n1)[2] = keep;
#pragma unroll
        for (int ks = 0; ks < 4; ++ks) { const bf16x8 a = lds_frag_nat(lds + L_BTT, 32 * jb + r32, ks, hi);
#pragma unroll
            for (int cb = 0; cb < 2; ++cb) { q1[cb] = MFMA32(a, lds_frag_nat(lds + L_WT, 32 * cb + r32, ks, hi), q1[cb]); q2[cb] = MFMA32(a, lds_frag_nat(lds + L_U0T, 32 * cb + r32, ks, hi), q2[cb]); } }
#pragma unroll
        for (int r = 0; r < 16; ++r) { const int j = 32 * jb + (r & 3) + 8 * (r >> 2) + 4 * hi; const float gc = *(const LAS float*)(lds + L_GC + j * 4);
#pragma unroll
            for (int cb = 0; cb < 2; ++cb) {
                STG(float, F.ws, WS_RN + (((((unsigned)cid * 2 + jb) * 2 + cb) * 16 + r) * 64 + lane) * 4) = gc * (n1[cb][r] - q2[cb][r]);
                const float mv = ((unsigned)j == 32 * cb + r32 ? gc : 0.f) - gc * q1[cb][r];
                STG(bf16_t, F.ws, WS_RM + (((unsigned)cid * 64 + j) * 64 + 32 * cb + r32) * 2) = (bf16_t)(pk2(mv, 0.f) & 0xffff); } }
    }
    lds_barrier();
}
__device__ __forceinline__ void rwkv_chain_wave(Frame& F, int l, bool lat, int chain, int ib) {
    int lane = F.lane; asm volatile("" : "+v"(lane));
    const unsigned char* ws = F.ws; const unsigned r32 = lane & 31, hi = lane >> 5;
    const unsigned dir = chain & 1, h = (chain >> 1) % 6, b = chain / 12;
    const int nc = lat ? 64 : 4; const unsigned cid0 = lat ? 768 + chain * 64 : chain * 4;
    const unsigned i = 32 * ib + r32;
    const unsigned so = ((((b * 4 + l) * 6 + h) * 64 + i) * 64) * 4;
    f32x16 H[2];
#pragma unroll
    for (int jb = 0; jb < 2; ++jb)
#pragma unroll
        for (int g4 = 0; g4 < 4; ++g4) { f32x4 v = {0.f, 0.f, 0.f, 0.f}; if (lat) v = LDG(f32x4, dir ? INP(7) : INP(6), so + (32 * jb + 8 * g4 + 4 * hi) * 4);
            H[jb][4 * g4] = v[0]; H[jb][4 * g4 + 1] = v[1]; H[jb][4 * g4 + 2] = v[2]; H[jb][4 * g4 + 3] = v[3]; }
    s16x4 ma[2][2][2][2]; f32x16 nt[2];
#define RB_LOAD(cid_) do { const unsigned mo_ = WS_RM + (((cid_) * 64 + r32) * 64 + 4 * hi) * 2; \
        _Pragma("unroll") for (int jo = 0; jo < 2; ++jo) _Pragma("unroll") for (int ji = 0; ji < 2; ++ji) _Pragma("unroll") for (int ks = 0; ks < 2; ++ks) { \
            ma[jo][ji][ks][0] = LDG(s16x4, ws, mo_ + (jo * 32 * 64 + 32 * ji + 16 * ks) * 2); ma[jo][ji][ks][1] = LDG(s16x4, ws, mo_ + (jo * 32 * 64 + 32 * ji + 16 * ks + 8) * 2); } \
        _Pragma("unroll") for (int jo = 0; jo < 2; ++jo) _Pragma("unroll") for (int r = 0; r < 16; ++r) nt[jo][r] = LDG(float, ws, WS_RN + ((((cid_) * 2 + jo) * 2 + ib) * 16 + r) * 256 + lane * 4); } while (0)
    RB_LOAD(cid0);
    for (int c = 0; c < nc; ++c) {
        const unsigned cid = cid0 + c;
#pragma unroll
        for (int jb = 0; jb < 2; ++jb)
#pragma unroll
            for (int g4 = 0; g4 < 4; ++g4) STG(u32x2, F.ws, WS_RH + ((cid * 64 + i) * 64 + 32 * jb + 8 * g4 + 4 * hi) * 2) = pack4((f32x4){H[jb][4 * g4], H[jb][4 * g4 + 1], H[jb][4 * g4 + 2], H[jb][4 * g4 + 3]});
        bf16x8 hf[2][2];
#pragma unroll
        for (int ji = 0; ji < 2; ++ji) { hf[ji][0] = acc_frag(H[ji], 0, 1.f); hf[ji][1] = acc_frag(H[ji], 1, 1.f); }
        f32x16 acc[2] = {nt[0], nt[1]};
#pragma unroll
        for (int jo = 0; jo < 2; ++jo)
#pragma unroll
            for (int ji = 0; ji < 2; ++ji)
#pragma unroll
                for (int ks = 0; ks < 2; ++ks) { const s16x4 a0 = ma[jo][ji][ks][0], a1 = ma[jo][ji][ks][1];
                    acc[jo] = MFMA32(((bf16x8){a0[0], a0[1], a0[2], a0[3], a1[0], a1[1], a1[2], a1[3]}), hf[ji][ks], acc[jo]); }
        if (c + 1 < nc) RB_LOAD(cid + 1);
        H[0] = acc[0]; H[1] = acc[1];
    }
#undef RB_LOAD
    if (!lat) {
#pragma unroll
        for (int jb = 0; jb < 2; ++jb)
#pragma unroll
            for (int g4 = 0; g4 < 4; ++g4) STG(f32x4, F.out, (dir ? OFF_CB : OFF_CF) * 4 + so + (32 * jb + 8 * g4 + 4 * hi) * 4) = (f32x4){H[jb][4 * g4], H[jb][4 * g4 + 1], H[jb][4 * g4 + 2], H[jb][4 * g4 + 3]};
    }
}
__device__ __forceinline__ void rwkv_apply_wave(Frame& F, int item) {
    int lane = F.lane; asm volatile("" : "+v"(lane));
    const unsigned char* ws = F.ws; const unsigned r32 = lane & 31, hi = lane >> 5;
    const int cid = item >> 1, tb = item & 1;
    unsigned seq0, b, h, dir; int T, c; chunk_decode(cid, seq0, T, b, h, dir, c);
    const unsigned yb = dir ? WS_YB : WS_YF;
    f32x16 acc[2];
#pragma unroll
    for (int r = 0; r < 16; ++r) { const int t = 32 * tb + (r & 3) + 8 * (r >> 2) + 4 * hi; const unsigned tok = seq0 + (dir ? T - 1 - (64 * c + t) : 64 * c + t);
        acc[0][r] = LDG(float, ws, yb + (tok * 384 + h * 64 + r32) * 4); acc[1][r] = LDG(float, ws, yb + (tok * 384 + h * 64 + 32 + r32) * 4); }
#pragma unroll
    for (int ks = 0; ks < 4; ++ks) { const bf16x8 a = LDG(bf16x8, ws, WS_RP + (((unsigned)cid * 64 + 32 * tb + r32) * 64 + 16 * ks + 8 * hi) * 2);
#pragma unroll
        for (int ib = 0; ib < 2; ++ib) acc[ib] = MFMA32(a, LDG(bf16x8, ws, WS_RH + (((unsigned)cid * 64 + 32 * ib + r32) * 64 + 16 * ks + 8 * hi) * 2), acc[ib]); }
#pragma unroll
    for (int r = 0; r < 16; ++r) { const int t = 32 * tb + (r & 3) + 8 * (r >> 2) + 4 * hi; const unsigned tok = seq0 + (dir ? T - 1 - (64 * c + t) : 64 * c + t);
        STG(float, F.ws, yb + (tok * 384 + h * 64 + r32) * 4) = acc[0][r]; STG(float, F.ws, yb + (tok * 384 + h * 64 + 32 + r32) * 4) = acc[1][r]; }
}

__device__ __forceinline__ void rwkv_out_item(Frame& F, int l, int item) {
    int lane = F.lane; asm volatile("" : "+v"(lane));
    const unsigned char* ws = F.ws; const unsigned r32 = lane & 31, hi = lane >> 5;
    const int tb = item & 1, h = (item >> 1) % 6, sk = item / 12;
    const bool lat = sk >= 64; const int b = lat ? (sk - 64) >> 6 : sk >> 2, k = lat ? (sk - 64) & 63 : sk & 3, nc = lat ? 64 : 4;
    const unsigned seq0 = lat ? MC + b * 4096 : b * 256, base = lat ? 768u : 0u;
    const unsigned chf = (b * 6 + h) * 2, cidf = base + chf * nc + k, cidb = base + (chf + 1) * nc + (nc - 1 - k);
    const unsigned tok0 = seq0 + 64 * k + 32 * tb;
    f32x16 acc[2];
#pragma unroll
    for (int r = 0; r < 16; ++r) { const unsigned tok = tok0 + (r & 3) + 8 * (r >> 2) + 4 * hi; const unsigned e = (tok * 384 + h * 64 + r32) * 4;
        acc[0][r] = LDG(float, ws, WS_YF + e) + LDG(float, ws, WS_YB + e); acc[1][r] = LDG(float, ws, WS_YF + e + 128) + LDG(float, ws, WS_YB + e + 128); }
    const unsigned pf = 32 * tb + r32, pb_ = 63 - 32 * tb - r32;
#pragma unroll
    for (int ks = 0; ks < 4; ++ks) {
        const bf16x8 af = LDG(bf16x8, ws, WS_RP + ((cidf * 64 + pf) * 64 + 16 * ks + 8 * hi) * 2), ab = LDG(bf16x8, ws, WS_RP + ((cidb * 64 + pb_) * 64 + 16 * ks + 8 * hi) * 2);
#pragma unroll
        for (int ib = 0; ib < 2; ++ib) { acc[ib] = MFMA32(af, LDG(bf16x8, ws, WS_RH + ((cidf * 64 + 32 * ib + r32) * 64 + 16 * ks + 8 * hi) * 2), acc[ib]);
            acc[ib] = MFMA32(ab, LDG(bf16x8, ws, WS_RH + ((cidb * 64 + 32 * ib + r32) * 64 + 16 * ks + 8 * hi) * 2), acc[ib]); } }
    const float g0 = LDG(float, INP(27), (l * 384 + h * 64 + r32) * 4), g1 = LDG(float, INP(27), (l * 384 + h * 64 + 32 + r32) * 4), b0 = LDG(float, INP(28), (l * 384 + h * 64 + r32) * 4), b1 = LDG(float, INP(28), (l * 384 + h * 64 + 32 + r32) * 4);
    const int xl = (lane ^ 16) << 2;
#pragma unroll
    for (int r = 0; r < 16; ++r) { const unsigned tok = tok0 + (r & 3) + 8 * (r >> 2) + 4 * hi; const unsigned e = tok * 384 + h * 64 + r32;
        const float bon = LDG(float, ws, WS_SB + (tok * 8 + h) * 4) + LDG(float, ws, WS_SB + ((M + tok) * 8 + h) * 4);
        const float y0 = acc[0][r] + bon * LDG(float, ws, WS_SV + e * 4), y1 = acc[1][r] + bon * LDG(float, ws, WS_SV + (e + 32) * 4);
        float s = allreduce16(y0 + y1); s += __builtin_bit_cast(float, __builtin_amdgcn_ds_bpermute(xl, __builtin_bit_cast(int, s)));
        const float mu = s * (1.f / 64.f), d0 = y0 - mu, d1 = y1 - mu;
        float q = allreduce16(d0 * d0 + d1 * d1); q += __builtin_bit_cast(float, __builtin_amdgcn_ds_bpermute(xl, __builtin_bit_cast(int, q)));
        const float rs = rsqrtf(q * (1.f / 64.f) + 64e-5f);
        const float o0 = (d0 * rs * g0 + b0) * bf_lo((unsigned)LDG(bf16_t, ws, WS_G + e * 2)), o1 = (d1 * rs * g1 + b1) * bf_lo((unsigned)LDG(bf16_t, ws, WS_G + (e + 32) * 2));
        const unsigned pk = pk2(o0, o1);
        STG(bf16_t, F.ws, WS_ACT + (tok * DM + 640 + h * 64 + r32) * 2) = (bf16_t)(pk & 0xffff); STG(bf16_t, F.ws, WS_ACT + (tok * DM + 640 + h * 64 + 32 + r32) * 2) = (bf16_t)(pk >> 16); }
}

constexpr int AU_R = 8, AU_D = 4, AU_SLOT = 6144;
__device__ __forceinline__ void attn_b_unit(Frame& F, int l, int unit) {
    int lane = F.lane; asm volatile("" : "+v"(lane));
    const unsigned char* ws = F.ws; LAS unsigned char* lds = F.lds;
    const int w = F.wave; const unsigned r32 = lane & 31, hi = lane >> 5;
    const unsigned kh = unit & 1, qb = (unit >> 1) & 15, mp = (unit >> 5) & 1, h = (unit >> 6) & 3, b = unit >> 8;
    const unsigned seq0 = MC + b * 4096, row = seq0 + qb * 256 + 32 * w + r32;
    bf16x8 qf[1][2];
#pragma unroll
    for (int s = 0; s < 2; ++s) qf[0][s] = LDG(bf16x8, ws, WS_QB + (row * 256 + h * 64 + mp * 32 + 8 * hi) * 2 + 32 * s);
    AttnQ st[1]; attnq_init(st[0], 0.f);
    const int qpos[1] = {0};
    const int n0 = kh ? 56 : 72, nt = 72;
    const unsigned pofs = (w < 2 ? (h * 2 + mp) * 2048 + w * 1024 : h * 4096 + (w - 2) * 1024) + lane * 16;
    const unsigned base0 = (w < 2 ? WS_KB : WS_VTB) + ((seq0 >> 5) + (kh ? 72u : 0u)) * 16384 + pofs;
    const unsigned base1 = WS_CACHE + (w < 2 ? 2 * MiB : 4 * MiB) + (b * 4 + l) * 262144 + pofs;
#define AU_DMA(t_) do { const int tt_ = (t_) < nt ? (t_) : nt - 1; const unsigned src_ = tt_ < n0 ? base0 + tt_ * 16384 : base1 + (tt_ - n0) * 16384; \
        __builtin_amdgcn_global_load_lds((const GAS unsigned*)(ws + src_), (LAS unsigned*)(lds + ((t_) % AU_R) * AU_SLOT + w * 1024), 16, 0, 0); } while (0)
    if (w < 6) {
#pragma unroll
        for (int t = 0; t < AU_D; ++t) AU_DMA(t);
    }
    for (int t = 0; t < nt; ++t) {
        if (w < 6) asm volatile("s_waitcnt vmcnt(3)" ::: "memory");
        asm volatile("s_barrier" ::: "memory");
        const LAS unsigned char* sl = lds + (t % AU_R) * AU_SLOT + lane * 16;
        bf16x8 kf[2], vf[4];
        kf[0] = *(const LAS bf16x8*)(sl); kf[1] = *(const LAS bf16x8*)(sl + 1024);
#pragma unroll
        for (int f = 0; f < 4; ++f) vf[f] = *(const LAS bf16x8*)(sl + 2048 + 1024 * f);
        if (w < 6) AU_DMA(t + AU_D);
        attn_block<32, false, 1>(qf, kf, vf, st, t, qpos, 0, hi);
    }
#undef AU_DMA
    asm volatile("s_waitcnt vmcnt(0) lgkmcnt(0)\n\ts_barrier" ::: "memory");
    attn_b_store(F, st[0], mp, kh, row, h, hi);
}

constexpr int Q_BLAT = 2048, Q_ALAT = 1536, Q_BCTX = 1024, Q_ACTX = 768;
constexpr int Q_TOTAL = Q_BLAT + Q_ALAT + Q_BCTX + Q_ACTX;
#ifndef XCD_DEAL
#define XCD_DEAL 0
#endif
__device__ __forceinline__ void phase_mixer(Frame& F, int l, int rep) {
    if (rep == 0 || REP_PART == 0 || REP_PART == 1) {
        const int si = F.bid + F.G * F.wave;
        if (si < 48) rwkv_chain_wave(F, l, true, si >> 1, si & 1);
        else if (si < 48 + 384) rwkv_chain_wave(F, l, false, (si - 48) >> 1, (si - 48) & 1);
    }
    if (rep == 0 || REP_PART == 2 || REP_PART == 4) {
        unsigned* uctr = (unsigned*)(F.ws + WS_CTL) + 64 * (32 + l + 4 * rep);
        LAS int* ubox = (LAS int*)(F.lds + 65536);
        for (;;) {
            if (F.wave == 0 && F.lane == 0) *ubox = (int)atomicAdd(uctr, 1u);
            lds_barrier();
            const int un = __builtin_amdgcn_readfirstlane(*ubox);
            lds_barrier();
            if (un >= 512) break;
            attn_b_unit(F, l, un);
        }
    }
    unsigned* ctr = (unsigned*)(F.ws + WS_CTL) + 64 * (1 + l + 4 * rep);
    if (rep == 0 || REP_PART != 1) for (;;) {
        int it = 0;
        if (F.lane == 0) it = (int)atomicAdd(ctr, 1u);
        it = __builtin_amdgcn_readfirstlane(it) + Q_BLAT;
        if (it >= Q_TOTAL) break;
        if (it < Q_BLAT) { if (rep == 0 || REP_PART == 2 || REP_PART == 4) attn_b_item(F, l, true, it); continue; } it -= Q_BLAT;
        if (it < Q_ALAT) { if (rep == 0 || REP_PART == 2 || REP_PART == 3) attn_a_item(F, l, true, it); continue; } it -= Q_ALAT;
        if (it < Q_BCTX) { if (rep == 0 || REP_PART == 2 || REP_PART == 5) attn_b_item(F, l, false, it); continue; } it -= Q_BCTX;
        if (rep == 0 || REP_PART == 2 || REP_PART == 5) attn_a_item(F, l, false, it);
    }
}

__device__ __forceinline__ void phase_finalize(Frame& F, int l) {
    const unsigned char* ws = F.ws;
    const unsigned lane = F.lane;
    const float lami = 0.8f - 0.6f * __expf(-0.3f * (float)l);
    const float lam = LDG(float, ws, WS_TAB + (TAB_LAM + l) * 4) + lami;
    const float omli = 1.f - lami;
    const float sg = LDG(float, INP(17), (l * 64 + lane) * 4);
    for (unsigned row = F.gw; row < M; row += F.ngw) {
#pragma unroll
        for (int k = 0; k < 4; ++k) { float om[2];
#pragma unroll
            for (int mp = 0; mp < 2; ++mp) { const unsigned o0 = (((mp * 2) * M + row) * 256 + 64 * k + lane) * 2, q0 = ((((mp * 2) * M + row) * 4 + k) * 2) * 4;
                const f32x2 ml0 = LDG(f32x2, ws, WS_ML + q0);
                if (row >= MC) { const f32x2 ml1 = LDG(f32x2, ws, WS_ML + q0 + M * 32); const float ms = fmaxf(ml0[0], ml1[0]), w0 = __builtin_amdgcn_exp2f(ml0[0] - ms), w1 = __builtin_amdgcn_exp2f(ml1[0] - ms);
                    om[mp] = (bf_lo((unsigned)LDG(bf16_t, ws, WS_BO2 + o0)) * w0 + bf_lo((unsigned)LDG(bf16_t, ws, WS_BO2 + o0 + M * 512)) * w1) * __builtin_amdgcn_rcpf(ml0[1] * w0 + ml1[1] * w1); }
                else om[mp] = bf_lo((unsigned)LDG(bf16_t, ws, WS_BO2 + o0)) * __builtin_amdgcn_rcpf(ml0[1]); }
            const float v = om[0] - lam * om[1];
            const float ms = wave_sum(v * v) * (1.f / 64.f);
            STG(bf16_t, F.ws, WS_ACT + (row * DM + 384 + 64 * k + lane) * 2) = (bf16_t)(pk2(v * rsqrtf(ms + 1e-6f) * sg * omli, 0.f) & 0xffff); }
    }
}


typedef unsigned v4u __attribute__((ext_vector_type(4)));
#define XB_TMO      128
#define XB_XCNT(j)  (256  + 64 * (j))
#define XB_XSUB(j)  (1280 + 64 * (j))
#define XB_XGEN(j)  (2304 + 64 * (j))
#define XB_TOP      3328
#define XB_TOPGEN   3392
#define XCD_BAR_WORDS 3456
#define XB_SPIN_CAP (1u << 18)

__device__ __forceinline__ unsigned xb_ld(unsigned* p)              { return __hip_atomic_load(p, __ATOMIC_RELAXED, __HIP_MEMORY_SCOPE_AGENT); }
__device__ __forceinline__ unsigned xb_add(unsigned* p, unsigned v) { return __hip_atomic_fetch_add(p, v, __ATOMIC_RELAXED, __HIP_MEMORY_SCOPE_AGENT); }
__device__ __forceinline__ unsigned xb_xcc_id() { return (unsigned)__builtin_amdgcn_s_getreg((3 << 11) | 20) & 0xFu; }
#define XB_SPIN(cond, bar) do { unsigned _sp = 0; while (cond) { __builtin_amdgcn_s_sleep(1); \
    if ((++_sp & 255u) == 0u) { if (xb_ld(&(bar)[XB_TMO])) break; if (_sp > XB_SPIN_CAP) { atomicAdd(&(bar)[XB_TMO], 1u); break; } } } } while (0)

struct XcdBarrier {
    unsigned* bar; unsigned x;
    volatile LAS unsigned* st;
};

__device__ __forceinline__ XcdBarrier xcd_barrier_post(unsigned* bar, volatile LAS unsigned* st) {
    XcdBarrier b; b.bar = bar; b.x = xb_xcc_id(); b.st = st;
    if (threadIdx.x == 0) (void)xb_add(&bar[XB_XCNT(b.x)], 1u);
    return b;
}
__device__ __forceinline__ void xcd_barrier_complete(unsigned* bar, unsigned x, unsigned& nloc, unsigned& nx) {
    const unsigned G = gridDim.x * gridDim.y * gridDim.z;
    unsigned sum, cnt, mine, sp = 0u;
    for (;;) {
        sum = 0u; cnt = 0u; mine = 0u;
#pragma unroll
        for (unsigned j = 0; j < 16; ++j) { const unsigned c = xb_ld(&bar[XB_XCNT(j)]); sum += c; cnt += (c > 0u) ? 1u : 0u; mine = (j == x) ? c : mine; }
        if (sum == G) break;
        __builtin_amdgcn_s_sleep(1);
        if ((++sp & 255u) == 0u) { if (xb_ld(&bar[XB_TMO])) break; if (sp > XB_SPIN_CAP) { atomicAdd(&bar[XB_TMO], 1u); break; } }
    }
    nloc = mine > 0u ? mine : 1u; nx = cnt > 0u ? cnt : 1u;
}

__device__ __forceinline__ void xcd_barrier(const XcdBarrier& b) {
    asm volatile("s_waitcnt vmcnt(0)" ::: "memory");
    __syncthreads();
    if (threadIdx.x == 0) {
        unsigned* bar = b.bar;
        __builtin_amdgcn_s_waitcnt(0);
        unsigned nloc = b.st[0], nx = b.st[1];
        if (nloc == 0u) { xcd_barrier_complete(bar, b.x, nloc, nx); b.st[0] = nloc; b.st[1] = nx; }
        const unsigned old = xb_add(&bar[XB_XSUB(b.x)], 1u);
        const unsigned gen = old / nloc;
        if (old + 1u == (gen + 1u) * nloc) {
            __builtin_amdgcn_fence(__ATOMIC_RELEASE, "agent");
            asm volatile("s_waitcnt vmcnt(0)" ::: "memory");
            const unsigned og = xb_add(&bar[XB_TOP], 1u);
            const unsigned tg = og / nx;
            if (og + 1u == (tg + 1u) * nx) xb_add(&bar[XB_TOPGEN], 1u);
            else XB_SPIN(xb_ld(&bar[XB_TOPGEN]) == tg, bar);
            __builtin_amdgcn_fence(__ATOMIC_ACQUIRE, "agent");
            xb_add(&bar[XB_XGEN(b.x)], 1u);
            asm volatile("s_waitcnt vmcnt(0)" ::: "memory");
        } else {
            XB_SPIN(xb_ld(&bar[XB_XGEN(b.x)]) == gen, bar);
            __builtin_amdgcn_fence(__ATOMIC_ACQUIRE, "agent");
            asm volatile("s_waitcnt vmcnt(0)" ::: "memory");
        }
    }
    __syncthreads();
}

#ifndef DIS
#define DIS 0
#endif
#ifndef GEMM_MF
#define GEMM_MF 7
#endif
#ifndef REP_PHASE
#define REP_PHASE -1
#define REP_COUNT 1
#endif
constexpr int NEXTRA = (REP_PHASE >= 0 && REP_PHASE < 9) ? REP_COUNT - 1 : 0, NPL = 9 + NEXTRA, NPRE = (REP_PHASE == 100) ? REP_COUNT : 1, NPHASE_RUN = NPRE + 1 + NPL * DEPTH;
__global__ void __launch_bounds__(512, 2) mega(Args a) {
    extern __shared__ __attribute__((aligned(16))) unsigned char lds[];
    Frame F;
    F.lds = (LAS unsigned char*)lds;
    volatile LAS unsigned* bst = (volatile LAS unsigned*)(F.lds + LDS_BYTES - 64);
    if (threadIdx.x < 2) bst[threadIdx.x] = 0u;
    __syncthreads();
    const XcdBarrier xbar = xcd_barrier_post((unsigned*)((GAS unsigned char*)a.ws + WS_CTL) + 4096, bst);
    const int wave_id = __builtin_amdgcn_readfirstlane((int)threadIdx.x >> 6);
    for (int ph = a.ph_lo; ph < a.ph_hi; ++ph) {
        { const unsigned char* kp = (const unsigned char*)__builtin_amdgcn_kernarg_segment_ptr(); asm volatile("" : "+s"(kp));
          const Args* ap = (const Args*)kp; F.in = ap->in; F.out = gptr(ap->out); F.ws = gptr(ap->ws); }
        { unsigned ones = ~0u; asm volatile("" : "+s"(ones)); int ln = (int)__builtin_amdgcn_mbcnt_hi(ones, __builtin_amdgcn_mbcnt_lo(ones, 0u)); int wv = wave_id, bid = (int)blockIdx.x, gg = (int)gridDim.x; asm volatile("" : "+s"(wv), "+s"(bid), "+s"(gg));
          F.lane = ln; F.wave = wv; F.bid = bid; F.G = gg; F.ngw = gg * 8; F.tid = wv * 64 + ln; F.gw = bid * 8 + wv; }
        if (ph < NPRE) { if (!(DIS & 1)) phase_prologue(F); }
        else if (ph == NPHASE_RUN - 1) { if (!(DIS & 2)) phase_final_norm(F); }
        else {
            const int l = (ph - NPRE) / NPL, sidx = (ph - NPRE) % NPL, rep = (REP_PHASE >= 0 && REP_PHASE < 9 && sidx > REP_PHASE && sidx <= REP_PHASE + NEXTRA) ? sidx - REP_PHASE : 0, s = (REP_PHASE >= 0 && REP_PHASE < 9 && sidx > REP_PHASE) ? (sidx <= REP_PHASE + NEXTRA ? REP_PHASE : sidx - NEXTRA) : sidx;
            if (s == 0) { convert_weights(F, l); phase_norm(F, l, 0); }
            else if (s == 1) {
                pg8::Gemm g{WSP(bf16_t, WS_ACT), WSP(bf16_t, WS_WIN + 0u * WSET_STRIDE), M, NIN, 1024}; pg8::StaticOrder S; S.init(M, NIN, F.G, F.bid, (GEMM_MF & 1) ? 192 : 256);
                EpiWin E{F.ws, F.out, l};
                if (!(DIS & 16)) pg8::gemm_phase<EpiWin, pg8::StaticOrder, false, true, (GEMM_MF & 1) ? 3 : 4>(F.lds, g, S, E, F.tid);
                if (false) { const int wv_ = (F.bid - 64) * 8 + F.wave; convert_item_any(F, l + 1, wv_); if (wv_ < CV_TOTAL - 1536) convert_item_any(F, l + 1, 1536 + wv_); }
            }
            else if (s == 2) { for (int cid = F.bid; cid < NCHUNK; cid += F.G) rwkv_chunk_block(F, l, cid); }
            else if (s == 3) { if (!(DIS & 64)) phase_mixer(F, l, rep); }
            else if (s == 4) { phase_finalize(F, l); for (int it = F.gw; it < 192 * 12; it += F.ngw) rwkv_out_item(F, l, it); }
            else if (s == 5 || s == 8) {
                const bool second = s == 8;
                pg8::Gemm g{second ? WSP(bf16_t, WS_U) : WSP(bf16_t, WS_ACT), second ? WSP(bf16_t, WS_W2 + 0u * WSET_STRIDE) : WSP(bf16_t, WS_WOUT + 0u * WSET_STRIDE), M, 1024, second ? FF : 1024};
                pg8::StaticOrder S; S.init(M, 1024, F.G, F.bid, (GEMM_MF & 2) ? 192 : 256);
                const bool first = (l == 0 && !second);
                EpiRes E{INP(0), INP(1) - (size_t)MC * DM, F.ws, WSP(float, WS_MOD) + (size_t)l * 3 * 6144 + (second ? 5120 : 2048), first};
                if (!(DIS & 256)) pg8::gemm_phase<EpiRes, pg8::StaticOrder, false, true, (GEMM_MF & 2) ? 3 : 4>(F.lds, g, S, E, F.tid);
            }
            else if (s == 6) { if (!(DIS & 8)) phase_norm(F, l, 1); }
            else {
                pg8::Gemm g{WSP(bf16_t, WS_ACT), WSP(bf16_t, WS_W13 + 0u * WSET_STRIDE), M, NFF2, 1024}; pg8::StaticOrder S; S.init(M, NFF2, F.G, F.bid, (GEMM_MF & 4) ? 192 : 256);
                EpiSwi E{WSP(bf16_t, WS_U)};
                if (!(DIS & 512)) pg8::gemm_phase<EpiSwi, pg8::StaticOrder, true, true, (GEMM_MF & 4) ? 3 : 4>(F.lds, g, S, E, F.tid);
            }
        }
        if (ph + 1 < a.ph_hi) { if (ph == a.ph_lo) { __threadfence(); cg::this_grid().sync(); } else xcd_barrier(xbar); }
    }
}

extern "C" void kernel_launch(void* const* d_in, const int* in_sizes, int n_in, void* d_out, int out_size, void* d_ws, size_t ws_size, hipStream_t stream) {
    static int grid = 0;
    if (grid == 0) {
        int dev = 0, cus = 0, per_cu = 0;
        if (n_in != 34 || ws_size < WS_END) { fprintf(stderr, "kernel_launch: unexpected n_in %d / ws_size %zu (need %zu)\n", n_in, ws_size, (size_t)WS_END); grid = -1; return; }
        if (hipGetDevice(&dev) != hipSuccess || hipDeviceGetAttribute(&cus, hipDeviceAttributeMultiprocessorCount, dev) != hipSuccess) { grid = -1; return; }
        if (hipFuncSetAttribute((const void*)mega, hipFuncAttributeMaxDynamicSharedMemorySize, LDS_BYTES) != hipSuccess) { fprintf(stderr, "kernel_launch: hipFuncSetAttribute failed\n"); grid = -1; return; }
        if (hipOccupancyMaxActiveBlocksPerMultiprocessor(&per_cu, (const void*)mega, 512, LDS_BYTES) != hipSuccess || per_cu < 1) { fprintf(stderr, "kernel_launch: occupancy query says %d\n", per_cu); per_cu = 1; }
        (void)hipGetLastError();
        grid = cus * 1;
        if (grid > cus * per_cu) grid = cus * per_cu;
    }
    if (grid < 0) return;
    (void)hipMemsetAsync((char*)d_ws + WS_CTL, 0, CTL_BYTES, stream);
    Args a{};
    for (int i = 0; i < 34; ++i) a.in[i] = (const float*)d_in[i];
    a.out = (float*)d_out; a.ws = (unsigned char*)d_ws;
#if MK_ONE_LAUNCH
    a.ph_lo = 0; a.ph_hi = NPHASE_RUN;
    void* args[] = {&a};
    hipError_t e = hipLaunchCooperativeKernel((const void*)mega, dim3(grid), dim3(512), args, LDS_BYTES, stream);
    if (e != hipSuccess) fprintf(stderr, "kernel_launch: cooperative launch failed: %s (grid %d)\n", hipGetErrorString(e), grid);
#else
    for (int ph = 0; ph < NPHASE_RUN; ++ph) { a.ph_lo = ph; a.ph_hi = ph + 1; hipLaunchKernelGGL(mega, dim3(grid), dim3(512), LDS_BYTES, stream, a); }
#endif
}
```

```cpp
#include <hip/hip_runtime.h>
#include <hip/hip_cooperative_groups.h>
#include <cstdio>
#include <cstdint>
namespace cg = cooperative_groups;

#ifndef MK_ONE_LAUNCH
#define MK_ONE_LAUNCH 1
#endif

#undef MK_ONE_LAUNCH
#define MK_ONE_LAUNCH 1
#define REP_PHASE -1
#define REP_COUNT 1
#define REP_PART 0
#define RA_REP 0
#define ATT_PROBE 0
namespace pg8 {
#define PG8_LAS __attribute__((address_space(3)))
typedef unsigned short bf16_t;
typedef short bf16x8 __attribute__((ext_vector_type(8)));
typedef float f32x4 __attribute__((ext_vector_type(4)));
typedef unsigned u32x4 __attribute__((ext_vector_type(4)));
constexpr int BM = 256, BK = 64, HALF = 128, HTB = HALF * BK * 2  , STAGE_BYTES = 8 * HTB, NXCD = 8, WGM = 8;

__host__ __device__ __forceinline__ int lds_byte(int r, int c) { const int st = (r >> 4) * 2 + (c >> 5), rr = r & 15, cc = c & 31, ob = rr * 64 + cc * 2; return st * 1024 + (ob ^ (((ob >> 9) & 1) << 5)); }
__host__ __device__ __forceinline__ void stage_rc(int b, int& R, int& C) { const int st = b / 1024, sb = b % 1024, swz = sb ^ (((sb >> 9) & 1) << 5); R = (st >> 1) * 16 + swz / 64; C = (st & 1) * 32 + (swz % 64) / 2; }
__host__ __device__ __forceinline__ int perm32(int rho) { const int n = rho >> 4, i = rho & 15; return 8 * (i >> 2) + 4 * n + (i & 3); }

struct Unit { int pm, pn; };
struct Gemm { const bf16_t* A; const bf16_t* Bt; int M, N, K; };

struct StaticOrder {
    int nM, nN, nwg, G, c;
    __host__ __device__ void init(int M, int N, int G_, int c_, int bm = BM) { nM = M / bm; nN = N / BM; nwg = nM * nN; G = G_; c = c_; }
    __host__ __device__ bool next(int i, Unit& u) const {
        const long L = (long)i * G + c; if (L >= nwg) return false;
        int wgid = (int)L; { const int q = nwg / NXCD, r = nwg % NXCD, xcd = wgid % NXCD, off = wgid / NXCD; wgid = (xcd < r ? xcd * (q + 1) : r * (q + 1) + (xcd - r) * q) + off; }
        const int nig = WGM * nN, gid = wgid / nig, fm = gid * WGM, gsz = (nM - fm) < WGM ? (nM - fm) : WGM;
        u.pm = fm + ((wgid % nig) % gsz); u.pn = (wgid % nig) / gsz; return true;
    }
    __device__ __forceinline__ void a_ready(const Unit&) const {}
    __device__ __forceinline__ void done(const Unit&) const {}
};

template <class Epi, class Sched, bool ALIGN_EPI = false, bool SP2 = false, int MF = 4>
__device__ __forceinline__ void gemm_phase(PG8_LAS unsigned char* lds, const Gemm g, const Sched& S, const Epi& E, const int tid_in) {
    const int tid = tid_in, wid = __builtin_amdgcn_readfirstlane(tid >> 6), lane = tid & 63, wr = wid >> 2, wc = wid & 3, fr = lane & 15, fq = lane >> 4;
    static_assert(MF == 4 || (MF == 3 && SP2), "192-row tiles: SP2 schedule only");
    const int K = g.K, nt = K / BK;
    unsigned voffA[2], voffB[2];
#pragma unroll
    for (int i = 0; i < 2; ++i) { int R, C; stage_rc(tid * 16 + i * 8192, R, C); const int Rb = Epi::PERM ? ((R & ~31) + perm32(R & 31)) : R;
        voffA[i] = (unsigned)(R * K + C) * 2u; voffB[i] = (unsigned)(Rb * K + C) * 2u; }
    const size_t kstep = (size_t)(BK * 2);
    const size_t hstep = (size_t)HALF * K * 2;
    const size_t tstep = 2 * hstep;
    const size_t hstepA = (size_t)(MF * 32) * K * 2, tstepA = 2 * hstepA;
    const unsigned ldsw = (unsigned)wid * 1024u;
    const int aoff = lds_byte(wr * (MF * 16) + fr, fq * 8), boff = lds_byte(wc * 32 + fr, fq * 8);
#define PG8_SA(b, h) (((b) * 2 + (h)) * HTB)
#define PG8_SB(b, h) ((4 + (b) * 2 + (h)) * HTB)
#define PG8_STAGE(bufoff, gbase, voff) do { _Pragma("unroll") for (int _i = 0; _i < 2; ++_i) \
        __builtin_amdgcn_global_load_lds((const unsigned*)((const char*)(gbase) + (voff)[_i]), (PG8_LAS unsigned*)(lds + (bufoff) + ldsw + _i * 8192), 16, 0, 0); } while (0)
#define PG8_STAGEA(bufoff, gbase, voff) do { __builtin_amdgcn_global_load_lds((const unsigned*)((const char*)(gbase) + (voff)[0]), (PG8_LAS unsigned*)(lds + (bufoff) + ldsw), 16, 0, 0); \
        if (MF == 4 || wr == 0) __builtin_amdgcn_global_load_lds((const unsigned*)((const char*)(gbase) + (voff)[1]), (PG8_LAS unsigned*)(lds + (bufoff) + ldsw + 8192), 16, 0, 0); } while (0)
#define PG8_LDA(dst, b, h) do { _Pragma("unroll") for (int m = 0; m < MF; ++m) _Pragma("unroll") for (int k = 0; k < 2; ++k) dst[m][k] = *(const PG8_LAS bf16x8*)(lds + PG8_SA(b, h) + aoff + m * 2048 + k * 1024); } while (0)
#define PG8_LDB(dst, b, h) do { _Pragma("unroll") for (int n = 0; n < 2; ++n) _Pragma("unroll") for (int k = 0; k < 2; ++k) dst[n][k] = *(const PG8_LAS bf16x8*)(lds + PG8_SB(b, h) + boff + n * 2048 + k * 1024); } while (0)
#define PG8_MMA(ai, bj, At, Bt) do { __builtin_amdgcn_s_setprio(1); _Pragma("unroll") for (int m = 0; m < MF; ++m) _Pragma("unroll") for (int n = 0; n < 2; ++n) _Pragma("unroll") for (int k = 0; k < 2; ++k) \
        acc[ai][bj][m][n] = __builtin_amdgcn_mfma_f32_16x16x32_bf16(Bt[n][k], At[m][k], acc[ai][bj][m][n], 0, 0, 0); __builtin_amdgcn_s_setprio(0); } while (0)
#define PG8_WAIT_V(n) asm volatile("s_waitcnt vmcnt(" #n ")" ::: "memory")
#define PG8_WAIT_V2(a, b) do { if (MF == 4 || wr == 0) asm volatile("s_waitcnt vmcnt(" #a ")" ::: "memory"); else asm volatile("s_waitcnt vmcnt(" #b ")" ::: "memory"); } while (0)
#define PG8_WAIT_L(n) asm volatile("s_waitcnt lgkmcnt(" #n ")" ::: "memory")
#define PG8_BAR __builtin_amdgcn_s_barrier()
#define PG8_SCHED __builtin_amdgcn_sched_barrier(0)
    Unit cur, nxt; int ui = 0;
    if (!S.next(0, cur)) return;
    f32x4 acc[2][2][MF][2];
#pragma unroll
    for (int a = 0; a < 2; ++a)
#pragma unroll
        for (int b = 0; b < 2; ++b)
#pragma unroll
            for (int m = 0; m < MF; ++m)
#pragma unroll
                for (int n = 0; n < 2; ++n) acc[a][b][m][n] = (f32x4){0.f, 0.f, 0.f, 0.f};
    bf16x8 At[MF][2], B0[2][2], B1[2][2];
#define PG8_SGPR64(p) ((const char*)(((unsigned long long)(unsigned)__builtin_amdgcn_readfirstlane((int)((unsigned long long)(p) >> 32)) << 32) | (unsigned)__builtin_amdgcn_readfirstlane((int)(unsigned long long)(p))))
    const char* cA = PG8_SGPR64((const char*)g.A + (size_t)cur.pm * tstepA); const char* cB = PG8_SGPR64((const char*)g.Bt + (size_t)cur.pn * tstep);
    S.a_ready(cur);
    if constexpr (SP2) {
        PG8_STAGE(PG8_SB(0, 0), cB, voffB); PG8_STAGE(PG8_SB(0, 1), cB + hstep, voffB); PG8_STAGEA(PG8_SA(0, 0), cA, voffA); PG8_STAGEA(PG8_SA(0, 1), cA + hstepA, voffA);
        if (wr == 1) PG8_BAR;
        PG8_WAIT_V2(2, 1); PG8_BAR;
        PG8_STAGE(PG8_SB(1, 0), cB + kstep, voffB); PG8_STAGEA(PG8_SA(1, 0), cA + kstep, voffA); PG8_STAGE(PG8_SB(1, 1), cB + hstep + kstep, voffB);
        PG8_WAIT_V2(6, 5); PG8_BAR;
    } else {
        PG8_STAGE(PG8_SB(0, 0), cB, voffB); PG8_STAGEA(PG8_SA(0, 0), cA, voffA); PG8_STAGE(PG8_SB(0, 1), cB + hstep, voffB); PG8_STAGEA(PG8_SA(0, 1), cA + hstepA, voffA);
        if (wr == 1) PG8_BAR;
        PG8_WAIT_V(4); PG8_BAR;
        PG8_STAGE(PG8_SB(1, 0), cB + kstep, voffB); PG8_STAGEA(PG8_SA(1, 0), cA + kstep, voffA); PG8_STAGE(PG8_SB(1, 1), cB + hstep + kstep, voffB);
        PG8_WAIT_V(6); PG8_BAR;
    }
    for (;;) {
        const bool has_next = S.next(ui + 1, nxt);
        const char* nA = PG8_SGPR64(has_next ? (const char*)g.A + (size_t)nxt.pm * tstepA : cA); const char* nB = PG8_SGPR64(has_next ? (const char*)g.Bt + (size_t)nxt.pn * tstep : cB);
        for (int t = 0; t < nt; t += 2) {
            const bool last = (t == nt - 2);
            const char* a1 = cA + (size_t)(t + 1) * kstep;
            const char* a2 = last ? nA : cA + (size_t)(t + 2) * kstep; const char* b2 = last ? nB : cB + (size_t)(t + 2) * kstep;
            const char* a3 = a2 + kstep; const char* b3 = b2 + kstep;
            if (last && has_next) S.a_ready(nxt);
            if constexpr (SP2) {
            PG8_LDB(B0, 0, 0); PG8_LDB(B1, 0, 1); PG8_SCHED; PG8_LDA(At, 0, 0); PG8_STAGEA(PG8_SA(1, 1), a1 + hstepA, voffA);
            PG8_WAIT_V2(8, 6); PG8_WAIT_L(0); PG8_BAR; PG8_MMA(0, 0, At, B0); PG8_MMA(0, 1, At, B1); PG8_BAR; PG8_SCHED;
            PG8_LDA(At, 0, 1); PG8_STAGE(PG8_SB(0, 0), b2, voffB); PG8_STAGE(PG8_SB(0, 1), b2 + hstep, voffB); PG8_STAGEA(PG8_SA(0, 0), a2, voffA);
            PG8_WAIT_V2(8, 6); PG8_WAIT_L(0); PG8_BAR; PG8_MMA(1, 0, At, B0); PG8_MMA(1, 1, At, B1); PG8_BAR; PG8_SCHED;
            PG8_LDB(B0, 1, 0); PG8_LDB(B1, 1, 1); PG8_SCHED; PG8_LDA(At, 1, 0); PG8_STAGEA(PG8_SA(0, 1), a2 + hstepA, voffA);
            PG8_WAIT_V2(8, 6); PG8_WAIT_L(0); PG8_BAR; PG8_MMA(0, 0, At, B0); PG8_MMA(0, 1, At, B1); PG8_BAR; PG8_SCHED;
            PG8_LDA(At, 1, 1); PG8_STAGE(PG8_SB(1, 0), b3, voffB); PG8_STAGE(PG8_SB(1, 1), b3 + hstep, voffB); PG8_STAGEA(PG8_SA(1, 0), a3, voffA);
            PG8_WAIT_V2(8, 6); PG8_WAIT_L(0); PG8_BAR; PG8_MMA(1, 0, At, B0); PG8_MMA(1, 1, At, B1); PG8_BAR; PG8_SCHED;
            } else {
            PG8_LDB(B0, 0, 0); PG8_SCHED; PG8_LDA(At, 0, 0); PG8_STAGEA(PG8_SA(1, 1), a1 + hstepA, voffA);
            PG8_WAIT_L(8); PG8_BAR; PG8_WAIT_L(0); PG8_MMA(0, 0, At, B0); PG8_BAR; PG8_SCHED;
            PG8_LDB(B1, 0, 1); PG8_STAGE(PG8_SB(0, 0), b2, voffB);
            PG8_BAR; PG8_WAIT_L(0); PG8_MMA(0, 1, At, B1); PG8_BAR;
            PG8_LDA(At, 0, 1); PG8_STAGEA(PG8_SA(0, 0), a2, voffA);
            PG8_BAR; PG8_WAIT_L(0); PG8_MMA(1, 0, At, B0); PG8_BAR; PG8_SCHED;
            PG8_STAGE(PG8_SB(0, 1), b2 + hstep, voffB);
            PG8_WAIT_V(6); PG8_BAR; PG8_MMA(1, 1, At, B1); PG8_BAR;
            PG8_LDB(B0, 1, 0); PG8_SCHED; PG8_LDA(At, 1, 0); PG8_STAGEA(PG8_SA(0, 1), a2 + hstepA, voffA);
            PG8_WAIT_L(8); PG8_BAR; PG8_WAIT_L(0); PG8_MMA(0, 0, At, B0); PG8_BAR; PG8_SCHED;
            PG8_LDB(B1, 1, 1); PG8_STAGE(PG8_SB(1, 0), b3, voffB);
            PG8_BAR; PG8_WAIT_L(0); PG8_MMA(0, 1, At, B1); PG8_BAR;
            PG8_LDA(At, 1, 1); PG8_STAGEA(PG8_SA(1, 0), a3, voffA);
            PG8_BAR; PG8_WAIT_L(0); PG8_MMA(1, 0, At, B0); PG8_BAR; PG8_SCHED;
            PG8_STAGE(PG8_SB(1, 1), b3 + hstep, voffB);
            PG8_WAIT_V(6); PG8_BAR; PG8_MMA(1, 1, At, B1); PG8_BAR;
            }
        }
        if constexpr (ALIGN_EPI) { if (wr == 0) PG8_BAR; }
        if constexpr (!Epi::AFTER_DRAIN) { E.template operator()<MF>(acc, cur, wr, wc, fr, fq); S.done(cur); }
        if (!has_next) break;
#pragma unroll
        for (int a = 0; a < 2; ++a)
#pragma unroll
            for (int b = 0; b < 2; ++b)
#pragma unroll
                for (int m = 0; m < MF; ++m)
#pragma unroll
                    for (int n = 0; n < 2; ++n) acc[a][b][m][n] = (f32x4){0.f, 0.f, 0.f, 0.f};
        cur = nxt; cA = nA; cB = nB; ++ui;
        if constexpr (ALIGN_EPI) { if (wr == 1) PG8_BAR; }
    }
    PG8_WAIT_V(0);
    if constexpr (!ALIGN_EPI) { if (wr == 0) PG8_BAR; }
    PG8_BAR;
    if constexpr (Epi::AFTER_DRAIN) { E.fused(acc, cur, wr, wc, fr, fq, lds, wid, lane); S.done(cur); }
#undef PG8_SA
#undef PG8_SB
#undef PG8_STAGE
#undef PG8_STAGEA
#undef PG8_WAIT_V2
#undef PG8_LDA
#undef PG8_LDB
#undef PG8_MMA
#undef PG8_WAIT_V
#undef PG8_WAIT_L
#undef PG8_BAR
#undef PG8_SCHED
}
}

using pg8::bf16_t; using pg8::bf16x8; using pg8::f32x4; using pg8::u32x4;
typedef float f32x16 __attribute__((ext_vector_type(16)));
typedef float f32x2 __attribute__((ext_vector_type(2)));
typedef short s16x4 __attribute__((ext_vector_type(4)));
typedef unsigned u32x2 __attribute__((ext_vector_type(2)));
typedef __bf16 bf16x2_t __attribute__((ext_vector_type(2)));
#define LAS __attribute__((address_space(3)))
#define LDG(T, base, boff) (*(const __attribute__((address_space(1))) T*)((const __attribute__((address_space(1))) unsigned char*)(base) + (unsigned)(boff)))
#define STG(T, base, boff) (*(__attribute__((address_space(1))) T*)((__attribute__((address_space(1))) unsigned char*)(base) + (unsigned)(boff)))

__device__ __forceinline__ unsigned pk2(float lo, float hi) { f32x2 v = {lo, hi}; bf16x2_t b = __builtin_convertvector(v, bf16x2_t); return __builtin_bit_cast(unsigned, b); }
__device__ __forceinline__ float bf_lo(unsigned u) { return __uint_as_float(u << 16); }
__device__ __forceinline__ float bf_hi(unsigned u) { return __uint_as_float(u & 0xffff0000u); }
__device__ __forceinline__ f32x4 unpack4(u32x2 v) { return (f32x4){bf_lo(v.x), bf_hi(v.x), bf_lo(v.y), bf_hi(v.y)}; }
__device__ __forceinline__ u32x2 pack4(f32x4 v) { u32x2 r; r.x = pk2(v[0], v[1]); r.y = pk2(v[2], v[3]); return r; }
__device__ __forceinline__ float sigmf(float x) { return __builtin_amdgcn_rcpf(1.f + __expf(-x)); }
template <int CTRL> __device__ __forceinline__ float dpp_f(float x) { return __builtin_bit_cast(float, __builtin_amdgcn_update_dpp(0, __builtin_bit_cast(int, x), CTRL, 0xF, 0xF, true)); }
__device__ __forceinline__ float allreduce16(float x) { x += dpp_f<0xB1>(x); x += dpp_f<0x4E>(x); x += dpp_f<0x141>(x); x += dpp_f<0x140>(x); return x; }
__device__ __forceinline__ float rdlane(float x, int l) { return __builtin_bit_cast(float, __builtin_amdgcn_readlane(__builtin_bit_cast(int, x), l)); }
__device__ __forceinline__ float wave_sum(float v) {
    v = allreduce16(v);
    return (rdlane(v, 0) + rdlane(v, 16)) + (rdlane(v, 32) + rdlane(v, 48));
}
__device__ __forceinline__ float swap32_sum(float x) { auto rr = __builtin_amdgcn_permlane32_swap(__float_as_uint(x), __float_as_uint(x), false, false); return __uint_as_float(rr[0]) + __uint_as_float(rr[1]); }
__device__ __forceinline__ float swap32_max(float x) { auto rr = __builtin_amdgcn_permlane32_swap(__float_as_uint(x), __float_as_uint(x), false, false); return fmaxf(__uint_as_float(rr[0]), __uint_as_float(rr[1])); }

constexpr int M = 12288, MC = 4096, DM = 1024, NIN = 3072, FF = 2816, NFF2 = 5632, DEPTH = 4;
constexpr float LOG2E = 1.4426950408889634f;
constexpr float QSCALE_A = 0.125f * LOG2E;
constexpr float QSCALE_B = 0.17677669529663687f * LOG2E;
constexpr unsigned OFF_AK = 12582912, OFF_AV = 14680064, OFF_BK = 16777216, OFF_BV = 20971520, OFF_CF = 25165824, OFF_CB = 26738688;
constexpr unsigned MiB = 1u << 20;
constexpr unsigned WS_CTL = 0, CTL_BYTES = 1 * MiB;
constexpr unsigned WS_MOD = 1 * MiB;
constexpr unsigned WS_TAB = 1 * MiB + 512 * 1024;
constexpr unsigned WS_SMALLW = 2 * MiB;
constexpr unsigned WS_CACHE = 4 * MiB;
constexpr unsigned WS_WIN = 10 * MiB, WS_WOUT = 16 * MiB, WS_W13 = 18 * MiB, WS_W2 = 29 * MiB;
constexpr unsigned WSET_STRIDE = 184 * MiB;
constexpr unsigned WS_ACT = 35 * MiB;
constexpr unsigned WS_QA = 59 * MiB, WS_KA = 68 * MiB, WS_VTA = 71 * MiB, WS_QB = 74 * MiB, WS_KB = 80 * MiB, WS_VTB = 86 * MiB;
constexpr unsigned WS_RKV = 92 * MiB, WS_CW = 119 * MiB, WS_CA = 122 * MiB, WS_CG = 125 * MiB;
constexpr unsigned WS_YF = 128 * MiB, WS_YB = 146 * MiB;
constexpr unsigned WS_SV = 164 * MiB;
constexpr unsigned WS_BO2 = 182 * MiB, WS_ML = 230 * MiB;
constexpr unsigned WS_XB = 206 * MiB;
constexpr unsigned WS_WSET1 = 194 * MiB;
constexpr unsigned WS_RM = 236 * MiB, WS_RN = 254 * MiB, WS_RP = 324 * MiB, WS_RH = 342 * MiB;
constexpr int NCHUNK = 2304;
constexpr unsigned WS_U = 128 * MiB;
constexpr unsigned WS_G = 290 * MiB, WS_SB = 299 * MiB, WS_BO = 300 * MiB, WS_END = 360 * MiB;
constexpr int SMALLW_L = 147456;
constexpr int TAB_COSA = 0, TAB_SINA = 1024, TAB_COSB = 2048, TAB_SINB = 2560, TAB_LAM = 3072;
constexpr int LDS_BYTES = 147456;
constexpr int NPHASE = 2 + 9 * DEPTH;

struct Args {
    const float* in[34];
    float* out; unsigned char* ws;
    int ph_lo, ph_hi;
};

struct EpiRes {
    static constexpr bool PERM = true, AFTER_DRAIN = false;
    const float* baseC; const float* baseL; unsigned char* ws; const float* gate; bool first;
    template <int MF>
    __device__ __forceinline__ void operator()(const f32x4 (&acc)[2][2][MF][2], const pg8::Unit& u, int wr, int wc, int fr_, int fq_) const {
        int fr = fr_, fq = fq_; asm volatile("" : "+v"(fr), "+v"(fq));
        const unsigned col0 = u.pn * 256 + wc * 32 + 8 * fq, rowb = u.pm * (MF * 64) + wr * (MF * 16);
        f32x4 g4[2][2]; int vcur = -1;
#pragma unroll
        for (int ai = 0; ai < 2; ++ai)
#pragma unroll
            for (int m = 0; m < MF; ++m) { const unsigned rf = rowb + ai * (MF * 32) + m * 16, off = (rf + fr) * DM + col0;
                const int v = rf < MC ? 0 : (rf < MC + 4096 ? 1 : 2);
                if (v != vcur) { vcur = v;
#pragma unroll
                    for (int bj = 0; bj < 2; ++bj)
#pragma unroll
                        for (int n = 0; n < 2; ++n) g4[bj][n] = LDG(f32x4, gate, (v * 6144 + col0 + bj * 128 + n * 4) * 4); }
#pragma unroll
                for (int bj = 0; bj < 2; ++bj) { f32x4 b0, b1;
                    if (first) { const float* base = rf < MC ? baseC : baseL; b0 = LDG(f32x4, base, (off + bj * 128) * 4); b1 = LDG(f32x4, base, (off + bj * 128 + 4) * 4); }
                    else { const u32x4 xb = LDG(u32x4, ws, WS_XB + (off + bj * 128) * 2); b0 = (f32x4){bf_lo(xb.x), bf_hi(xb.x), bf_lo(xb.y), bf_hi(xb.y)}; b1 = (f32x4){bf_lo(xb.z), bf_hi(xb.z), bf_lo(xb.w), bf_hi(xb.w)}; }
                    b0 = b0 + g4[bj][0] * acc[ai][bj][m][0]; b1 = b1 + g4[bj][1] * acc[ai][bj][m][1];
                    u32x4 w; w.x = pk2(b0[0], b0[1]); w.y = pk2(b0[2], b0[3]); w.z = pk2(b1[0], b1[1]); w.w = pk2(b1[2], b1[3]);
                    STG(u32x4, ws, WS_XB + (off + bj * 128) * 2) = w; } }
    }
};
struct EpiSwi {
    static constexpr bool PERM = true, AFTER_DRAIN = false;
    bf16_t* U;
    template <int MF>
    __device__ __forceinline__ void operator()(const f32x4 (&acc)[2][2][MF][2], const pg8::Unit& u, int wr, int wc, int fr_, int fq_) const {
        int fr = fr_, fq = fq_; asm volatile("" : "+v"(fr), "+v"(fq));
        const unsigned row0 = u.pm * (MF * 64) + wr * (MF * 16) + fr, oc0 = u.pn * 128 + wc * 16 + 4 * fq;
#pragma unroll
        for (int ai = 0; ai < 2; ++ai)
#pragma unroll
            for (int m = 0; m < MF; ++m) { const unsigned ro = ((row0 + ai * (MF * 32) + m * 16) * FF + oc0) * 2;
#pragma unroll
                for (int bj = 0; bj < 2; ++bj) { const f32x4 g = acc[ai][bj][m][0], up = acc[ai][bj][m][1]; f32x4 o;
#pragma unroll
                    for (int e = 0; e < 4; ++e) o[e] = g[e] * sigmf(g[e]) * up[e];
                    STG(u32x2, U, ro + bj * 128) = pack4(o); } asm volatile("" ::: "memory"); }
    }
};
struct EpiWin {
    static constexpr bool PERM = true, AFTER_DRAIN = false;
    unsigned char* ws; float* out; int l;
    template <int MF>
    __device__ __forceinline__ void operator()(const f32x4 (&acc)[2][2][MF][2], const pg8::Unit& u, int wr, int wc, int fr_, int fq_) const {
        int fr = fr_, fq = fq_; asm volatile("" : "+v"(fr), "+v"(fq));
        const unsigned rowb = u.pm * (MF * 64) + wr * (MF * 16), row0 = rowb + fr;
#pragma unroll
        for (int bj = 0; bj < 2; ++bj) {
            const unsigned c32 = u.pn * 256 + bj * 128 + wc * 32;
            const unsigned c8 = c32 + 8 * fq;
            if (c32 < 1152 && (c32 < 512 || c32 >= 640)) {
                const bool isA = c32 < 512;
                const bool isK = isA ? (c32 >= 384) : (c32 >= 896);
                const float qs = isK ? 1.f : (isA ? QSCALE_A : QSCALE_B);
                const unsigned ck = isA ? c8 - 384 : c8 - 896;
                const unsigned dbase = isA ? (isK ? WS_KA + (((ck >> 6) * 4 + ((ck & 63) >> 4)) * 64 + ((ck >> 3) & 1) * 32) * 16 : WS_QA + c8 * 2)
                                           : (isK ? WS_KB + (((ck >> 5) * 2 + ((ck & 31) >> 4)) * 64 + ((ck >> 3) & 1) * 32) * 16 : WS_QB + (c8 - 640) * 2);
                const unsigned dpitch = isA ? 768u : 512u;
#pragma unroll
                for (int ai = 0; ai < 2; ++ai)
#pragma unroll
                    for (int m = 0; m < MF; ++m) {
                        const unsigned row = row0 + ai * (MF * 32) + m * 16; const bool lat = rowb + ai * (MF * 32) + m * 16 >= (unsigned)MC;
                        f32x4 v0 = acc[ai][bj][m][0], v1 = acc[ai][bj][m][1];
                        if (lat) {
                            const unsigned t = (row - MC) & 4095, rp = t >> 6, cp = t & 63;
                            unsigned to_;
                            if (isA) { const unsigned pos = ((c32 >> 5) & 1) ? cp : rp; to_ = WS_TAB + (TAB_COSA + pos * 16 + 4 * fq) * 4; }
                            else { const unsigned pos = (fq >> 1) ? cp : rp; to_ = WS_TAB + (TAB_COSB + pos * 8 + 4 * (fq & 1)) * 4; }
                            const f32x4 c4 = LDG(f32x4, ws, to_), s4 = LDG(f32x4, ws, to_ + (isA ? 4096u : 2048u));
                            f32x4 w0, w1;
                            w0[0] = v0[0] * c4[0] - v0[1] * s4[0]; w0[1] = v0[1] * c4[0] + v0[0] * s4[0];
                            w0[2] = v0[2] * c4[1] - v0[3] * s4[1]; w0[3] = v0[3] * c4[1] + v0[2] * s4[1];
                            w1[0] = v1[0] * c4[2] - v1[1] * s4[2]; w1[1] = v1[1] * c4[2] + v1[0] * s4[2];
                            w1[2] = v1[2] * c4[3] - v1[3] * s4[3]; w1[3] = v1[3] * c4[3] + v1[2] * s4[3];
                            v0 = w0; v1 = w1;
                        } else if (isK) {
                            const unsigned b = row >> 8, t = row & 255;
                            const f32x4 ev = {v0[0], v0[2], v1[0], v1[2]}, od = {v0[1], v0[3], v1[1], v1[3]};
                            if (isA) { const unsigned o = (OFF_AK + ((b * 4 + l) * 256 + t) * 128 + (c32 - 384) + 4 * fq) * 4; STG(f32x4, out, o) = ev; STG(f32x4, out, o + 64) = od; }
                            else { const unsigned o = (OFF_BK + ((b * 4 + l) * 256 + t) * 256 + ((c8 - 896) & ~15u) + 4 * (fq & 1)) * 4; STG(f32x4, out, o) = ev; STG(f32x4, out, o + 32) = od; }
                        }
                        v0 = v0 * qs; v1 = v1 * qs;
                        u32x4 w; w.x = pk2(v0[0], v0[1]); w.y = pk2(v0[2], v0[3]); w.z = pk2(v1[0], v1[1]); w.w = pk2(v1[2], v1[3]);
                        STG(u32x4, ws, isK ? dbase + (row >> 5) * (isA ? 8192u : 16384u) + (row & 31) * 16 : dbase + row * dpitch) = w;
                        asm volatile("" ::: "memory");
                    }
            } else if (c32 < 1408) {
                const bool isA = c32 < 640;
                const unsigned cc = isA ? (c8 - 512) : (c8 - 1152);
                const unsigned vt = (isA ? WS_VTA : WS_VTB) + ((((cc >> 6) * 2 + ((cc >> 5) & 1)) * 2) * 64 + (cc & 31)) * 16;
#pragma unroll
                for (int ai = 0; ai < 2; ++ai)
#pragma unroll
                    for (int m = 0; m < MF; ++m) {
                        const unsigned row = row0 + ai * (MF * 32) + m * 16; const bool lat = rowb + ai * (MF * 32) + m * 16 >= (unsigned)MC;
                        const f32x4 v0 = acc[ai][bj][m][0], v1 = acc[ai][bj][m][1];
                        if (!lat) { const unsigned b = row >> 8, t = row & 255;
                            const unsigned o = isA ? (OFF_AV + ((b * 4 + l) * 256 + t) * 128 + cc) * 4 : (OFF_BV + ((b * 4 + l) * 256 + t) * 256 + cc) * 4;
                            STG(f32x4, out, o) = v0; STG(f32x4, out, o + 16) = v1; }
                        const unsigned p0 = pk2(v0[0], v0[1]), p1 = pk2(v0[2], v0[3]), p2 = pk2(v1[0], v1[1]), p3 = pk2(v1[2], v1[3]);
                        const unsigned tt = row & 31, rem = tt & 15;
                        const unsigned vo = vt + (row >> 5) * (isA ? 8192u : 16384u) + (tt >> 4) * 1024 + ((rem >> 2) & 1) * 512 + (4 * (rem >> 3) + (rem & 3)) * 2;
                        STG(bf16_t, ws, vo + 0 * 16) = (bf16_t)(p0 & 0xffff); STG(bf16_t, ws, vo + 1 * 16) = (bf16_t)(p0 >> 16);
                        STG(bf16_t, ws, vo + 2 * 16) = (bf16_t)(p1 & 0xffff); STG(bf16_t, ws, vo + 3 * 16) = (bf16_t)(p1 >> 16);
                        STG(bf16_t, ws, vo + 4 * 16) = (bf16_t)(p2 & 0xffff); STG(bf16_t, ws, vo + 5 * 16) = (bf16_t)(p2 >> 16);
                        STG(bf16_t, ws, vo + 6 * 16) = (bf16_t)(p3 & 0xffff); STG(bf16_t, ws, vo + 7 * 16) = (bf16_t)(p3 >> 16);
                        asm volatile("" ::: "memory");
                    }
            } else if (c32 < 2944) {
                const int kind = c32 < 2560 ? 0 : (c32 < 2688 ? 1 : (c32 < 2816 ? 2 : 3));
                const unsigned dbase = kind == 0 ? WS_RKV + (c8 - 1408) * 2 : (kind == 1 ? WS_CW + (c8 - 2560) * 2 : (kind == 2 ? WS_CA + (c8 - 2688) * 2 : WS_CG + (c8 - 2816) * 2));
                const unsigned dpitch = kind == 0 ? 2304u : 256u;
#pragma unroll
                for (int ai = 0; ai < 2; ++ai)
#pragma unroll
                    for (int m = 0; m < MF; ++m) {
                        const unsigned row = row0 + ai * (MF * 32) + m * 16; const bool lat = rowb + ai * (MF * 32) + m * 16 >= (unsigned)MC;
                        f32x4 v0 = acc[ai][bj][m][0], v1 = acc[ai][bj][m][1];
                        if (kind == 1) {
#pragma unroll
                            for (int e = 0; e < 4; ++e) { v0[e] = 1.f - 2.f * __builtin_amdgcn_rcpf(__expf(2.f * v0[e]) + 1.f); v1[e] = 1.f - 2.f * __builtin_amdgcn_rcpf(__expf(2.f * v1[e]) + 1.f); }
                        } else if (kind == 3) {
#pragma unroll
                            for (int e = 0; e < 4; ++e) { v0[e] = sigmf(v0[e]); v1[e] = sigmf(v1[e]); }
                        }
                        u32x4 w; w.x = pk2(v0[0], v0[1]); w.y = pk2(v0[2], v0[3]); w.z = pk2(v1[0], v1[1]); w.w = pk2(v1[2], v1[3]);
                        STG(u32x4, ws, dbase + row * dpitch) = w;
                        asm volatile("" ::: "memory");
                    }
            }
        }
    }
};

struct Frame {
    LAS unsigned char* lds;
    const float* const* in;
    float* out; unsigned char* ws;
    int tid, lane, wave, gw, ngw, G, bid;
};
#define GAS __attribute__((address_space(1)))
template <class T> __device__ __forceinline__ T* gptr(T* p) {
#if defined(__HIP_DEVICE_COMPILE__)
    __builtin_assume(!__builtin_amdgcn_is_shared((const void*)p)); __builtin_assume(!__builtin_amdgcn_is_private((const void*)p));
#endif
    return p; }
#define INP(k) gptr(F.in[k])
#define WSP(T, off) gptr((T*)(F.ws + (off)))

__device__ __forceinline__ void phase_prologue(Frame& F) {
    const float* cvec = INP(8); const float* cctx = INP(9); const float* ada_w = INP(10); const float* ada_b = INP(11);
    LAS float* sl = (LAS float*)F.lds;
    LAS float* red = (LAS float*)(F.lds + 16384);
    for (int i = F.tid; i < 3072; i += 512) { const int v = i >> 10, k = i & 1023; const float x = v == 0 ? cctx[k] : cvec[(v - 1) * 1024 + k]; sl[i] = x / (1.f + __expf(-x)); }
    __syncthreads();
    float* mod = WSP(float, WS_MOD);
    for (int it = F.bid; it < 384; it += F.G) {
        const int l = it / 96, n0 = (it % 96) * 64;
        const float* W = ada_w + (size_t)l * 1024 * 6144 + n0 + F.lane;
        float a0 = 0.f, a1 = 0.f, a2 = 0.f;
        const int k0 = F.wave * 128;
#pragma unroll 8
        for (int k = k0; k < k0 + 128; ++k) { const float w = *(const GAS float*)(W + (size_t)k * 6144); a0 += sl[k] * w; a1 += sl[1024 + k] * w; a2 += sl[2048 + k] * w; }
        red[(F.wave * 3 + 0) * 64 + F.lane] = a0; red[(F.wave * 3 + 1) * 64 + F.lane] = a1; red[(F.wave * 3 + 2) * 64 + F.lane] = a2;
        __syncthreads();
        if (F.wave < 3) { float s = ada_b[l * 6144 + n0 + F.lane];
#pragma unroll
            for (int w = 0; w < 8; ++w) s += red[(w * 3 + F.wave) * 64 + F.lane];
            mod[(size_t)(l * 3 + F.wave) * 6144 + n0 + F.lane] = s; }
        __syncthreads();
    }
    float* tab = WSP(float, WS_TAB);
    if (F.bid == F.G - 1) {
        for (int i = F.tid; i < 1024; i += 512) { const int pos = i >> 4, f = i & 15; const float ang = (float)pos * __builtin_amdgcn_exp2f(-(float)f * (13.287712379549449f / 16.f)); tab[TAB_COSA + i] = __cosf(ang); tab[TAB_SINA + i] = __sinf(ang); }
        for (int i = F.tid; i < 512; i += 512) { const int pos = i >> 3, f = i & 7; const float ang = (float)pos * __builtin_amdgcn_exp2f(-(float)f * (13.287712379549449f / 8.f)); tab[TAB_COSB + i] = __cosf(ang); tab[TAB_SINB + i] = __sinf(ang); }
        if (F.wave < 4) { const float* lp = INP(16) + F.wave * 128; const int d = F.lane & 31;
            const float p1 = wave_sum(F.lane < 32 ? lp[d] * lp[32 + d] : 0.f), p2 = wave_sum(F.lane < 32 ? 0.f : lp[64 + d] * lp[96 + d]);
            if (F.lane == 0) tab[TAB_LAM + F.wave] = __expf(p1) - __expf(p2); }
    }
    const int gtid = F.bid * 512 + F.tid, gnt = F.G * 512;
    { bf16_t* sw = WSP(bf16_t, WS_SMALLW); const float* cw2 = INP(20); const float* ca2 = INP(22); const float* cg2 = INP(23);
      for (int idx = gtid; idx < 4 * SMALLW_L; idx += gnt) { const int l = idx / SMALLW_L, r = idx % SMALLW_L; float v;
          if (r < 98304) { const int which = r / 49152, rr = r % 49152, d = rr / 24576, ch = (rr % 24576) / 64, k = rr % 64; v = (which ? ca2 : cw2)[((size_t)(l * 2 + d) * 64 + k) * 384 + ch]; }
          else { const int rr = r - 98304, ch = rr / 128, k = rr % 128; v = cg2[((size_t)l * 128 + k) * 384 + ch]; }
          sw[idx] = (bf16_t)(pk2(v, 0.f) & 0xffff); } }
    { bf16_t* kca = WSP(bf16_t, WS_CACHE); bf16_t* vca = kca + 524288; bf16_t* kcb = vca + 524288; bf16_t* vcb = kcb + 1048576;
      const float* cak = INP(2); const float* cav = INP(3); const float* cbk = INP(4); const float* cbv = INP(5);
      for (int e = gtid; e < 524288; e += gnt) {
          const int j = e & 7, ln = (e >> 3) & 63, hi = ln >> 5, r32 = ln & 31, blk = (e >> 12) & 15, bl = e >> 16;
          { const int s = (e >> 9) & 3, kvh = (e >> 11) & 1, cp = kvh * 64 + 16 * s + 8 * hi + j, o = cp & 31, c = (cp - o) + (o >> 1) + 16 * (o & 1);
            kca[e] = (bf16_t)(pk2(cak[((size_t)bl * 512 + blk * 32 + r32) * 128 + c], 0.f) & 0xffff); }
          { const int ks = (e >> 9) & 1, db = (e >> 10) & 1, kvh = (e >> 11) & 1, key = blk * 32 + 16 * ks + 8 * (j >> 2) + 4 * hi + (j & 3);
            vca[e] = (bf16_t)(pk2(cav[((size_t)bl * 512 + key) * 128 + kvh * 64 + db * 32 + r32], 0.f) & 0xffff); } }
      for (int e = gtid; e < 1048576; e += gnt) {
          const int j = e & 7, ln = (e >> 3) & 63, hi = ln >> 5, r32 = ln & 31, blk = (e >> 13) & 15, bl = e >> 17;
          { const int s = (e >> 9) & 1, hm = (e >> 10) & 7, cp = hm * 32 + 16 * s + 8 * hi + j, o = cp & 15, c = (cp - o) + (o >> 1) + 8 * (o & 1);
            kcb[e] = (bf16_t)(pk2(cbk[((size_t)bl * 512 + blk * 32 + r32) * 256 + c], 0.f) & 0xffff); }
          { const int ks = (e >> 9) & 1, db = (e >> 10) & 1, h = (e >> 11) & 3, key = blk * 32 + 16 * ks + 8 * (j >> 2) + 4 * hi + (j & 3);
            vcb[e] = (bf16_t)(pk2(cbv[((size_t)bl * 512 + key) * 256 + h * 64 + db * 32 + r32], 0.f) & 0xffff); } } }
    for (int st = 0; st < 1; ++st) { u32x4* z = (u32x4*)(WSP(bf16_t, WS_WIN + st * WSET_STRIDE) + (size_t)2944 * 1024); unsigned z0; asm volatile("v_mov_b32 %0, 0" : "=v"(z0)); for (int i = gtid; i < 128 * 1024 / 8; i += gnt) z[i] = (u32x4){z0, z0, z0, z0}; }
}

template <int MAP> __device__ __forceinline__ int dest_row(int n) {
    if (MAP == 1) {
        if (n < 512) { const int o = n & 31; return (n - o) + 2 * (o & 15) + (o >> 4); }
        if (n >= 640 && n < 1152) { const int o = n & 15; return (n - o) + 2 * (o & 7) + (o >> 3); }
        return n;
    }
    if (MAP == 2) return (n >> 2) * 8 + (n & 3);
    if (MAP == 3) return (n >> 2) * 8 + 4 + (n & 3);
    return n;
}
template <int MAP> __device__ __forceinline__ void transpose_item(const float* W, int K, int N, bf16_t* WT, LAS float* scr, int item, int lane) {
    const int nblk = N / 32, kb = item / nblk, nb = item % nblk, k0 = 64 * kb, n0 = 32 * nb;
#pragma unroll 8
    for (int i = 0; i < 32; ++i) { const int kk = 2 * i + (lane >> 5); scr[kk * 33 + (lane & 31)] = *(const GAS float*)(W + (size_t)(k0 + kk) * N + n0 + (lane & 31)); }
    asm volatile("s_waitcnt lgkmcnt(0)" ::: "memory");
    const int c = lane & 7;
#pragma unroll
    for (int j = 0; j < 4; ++j) { const int n = (lane >> 3) + 8 * j; const LAS float* s = scr + (8 * c) * 33 + n;
        u32x4 o; o.x = pk2(s[0 * 33], s[1 * 33]); o.y = pk2(s[2 * 33], s[3 * 33]); o.z = pk2(s[4 * 33], s[5 * 33]); o.w = pk2(s[6 * 33], s[7 * 33]);
        *(GAS u32x4*)(WT + (size_t)dest_row<MAP>(n0 + n) * K + k0 + 8 * c) = o; }
    asm volatile("s_waitcnt lgkmcnt(0)" ::: "memory");
}
template <int MAP> __device__ __forceinline__ void convert_item(const float* W, int K, int N, bf16_t* WT, int item, int lane) {
    const int nblk = N / 64, kb = item / nblk, nb = item % nblk, n = nb * 64 + lane;
    const GAS float* src = (const GAS float*)W + (size_t)(kb * 128) * N + n;
    GAS bf16_t* dst = (GAS bf16_t*)WT + (size_t)dest_row<MAP>(n) * K + kb * 128;
#pragma unroll
    for (int g = 0; g < 16; ++g) { float v[8];
#pragma unroll
        for (int e = 0; e < 8; ++e) v[e] = src[(size_t)(8 * g + e) * N];
        u32x4 o; o.x = pk2(v[0], v[1]); o.y = pk2(v[2], v[3]); o.z = pk2(v[4], v[5]); o.w = pk2(v[6], v[7]);
        *(GAS u32x4*)(dst + 8 * g) = o; }
}
constexpr int CV_IN = 46 * 8, CV_OUT = 16 * 8, CV_1 = 44 * 8, CV_2 = 16 * 22, CV_TOTAL = CV_IN + CV_OUT + 2 * CV_1 + CV_2;
__device__ __forceinline__ void convert_item_any(Frame& F, int l, int it) {
    const unsigned so = 0u * WSET_STRIDE;
    int r = it;
    if (r < CV_IN) { convert_item<1>(INP(14) + (size_t)l * 1024 * 2944, 1024, 2944, WSP(bf16_t, WS_WIN + so), r, F.lane); return; } r -= CV_IN;
    if (r < CV_OUT) { convert_item<0>(INP(29) + (size_t)l * 1024 * 1024, 1024, 1024, WSP(bf16_t, WS_WOUT + so), r, F.lane); return; } r -= CV_OUT;
    if (r < CV_1) { convert_item<2>(INP(30) + (size_t)l * 1024 * FF, 1024, FF, WSP(bf16_t, WS_W13 + so), r, F.lane); return; } r -= CV_1;
    if (r < CV_1) { convert_item<3>(INP(31) + (size_t)l * 1024 * FF, 1024, FF, WSP(bf16_t, WS_W13 + so), r, F.lane); return; } r -= CV_1;
    convert_item<0>(INP(32) + (size_t)l * FF * 1024, FF, 1024, WSP(bf16_t, WS_W2 + so), r, F.lane);
}
__device__ __forceinline__ void convert_weights(Frame& F, int l) {
    LAS float* scr = (LAS float*)(F.lds + F.wave * 16384); const unsigned so = 0u * WSET_STRIDE;
    const float* w_in = INP(14) + (size_t)l * 1024 * 2944; const float* w_out = INP(29) + (size_t)l * 1024 * 1024;
    const float* w1 = INP(30) + (size_t)l * 1024 * FF; const float* w3 = INP(31) + (size_t)l * 1024 * FF; const float* w2 = INP(32) + (size_t)l * FF * 1024;
    constexpr int I_IN = 16 * 92, I_OUT = 16 * 32, I_1 = 16 * 88, I_2 = 44 * 32;
    constexpr int NIT = I_IN + I_OUT + 2 * I_1 + I_2;
    for (int it = F.gw; it < NIT; it += F.ngw) {
        int r = it;
        if (r < I_IN) { transpose_item<1>(w_in, 1024, 2944, WSP(bf16_t, WS_WIN + so), scr, r, F.lane); continue; } r -= I_IN;
        if (r < I_OUT) { transpose_item<0>(w_out, 1024, 1024, WSP(bf16_t, WS_WOUT + so), scr, r, F.lane); continue; } r -= I_OUT;
        if (r < I_1) { transpose_item<2>(w1, 1024, FF, WSP(bf16_t, WS_W13 + so), scr, r, F.lane); continue; } r -= I_1;
        if (r < I_1) { transpose_item<3>(w3, 1024, FF, WSP(bf16_t, WS_W13 + so), scr, r, F.lane); continue; } r -= I_1;
        transpose_item<0>(w2, FF, 1024, WSP(bf16_t, WS_W2 + so), scr, r, F.lane);
    }
}

__device__ __forceinline__ void phase_norm(Frame& F, int l, int which  ) {
    const float* g = (which ? INP(13) : INP(12)) + l * 1024;
    const float* mod = WSP(float, WS_MOD) + (size_t)l * 3 * 6144 + (which ? 3072 : 0);
    bf16_t* H = WSP(bf16_t, WS_ACT);
    const bool first = (l == 0 && which == 0);
    f32x4 gv[4];
#pragma unroll
    for (int j = 0; j < 4; ++j) gv[j] = *(const GAS f32x4*)(g + 4 * F.lane + 256 * j);
    for (int row = F.gw; row < M; row += F.ngw) {
        const float* mv = mod + (row < MC ? 0 : (row < 2 * MC ? 1 : 2)) * 6144;
        f32x4 v[4]; float ss = 0.f;
        if (first) { const float* xr = row < MC ? INP(0) + (size_t)row * DM : INP(1) + (size_t)(row - MC) * DM;
#pragma unroll
            for (int j = 0; j < 4; ++j) v[j] = *(const GAS f32x4*)(xr + 4 * F.lane + 256 * j); }
        else {
#pragma unroll
            for (int j = 0; j < 4; ++j) v[j] = unpack4(LDG(u32x2, F.ws, WS_XB + ((unsigned)row * DM + 4 * F.lane + 256 * j) * 2)); }
#pragma unroll
        for (int j = 0; j < 4; ++j) ss += (v[j][0] * v[j][0] + v[j][1] * v[j][1]) + (v[j][2] * v[j][2] + v[j][3] * v[j][3]);
        const float rstd = rsqrtf(wave_sum(ss) * (1.f / 1024.f) + 1e-6f);
#pragma unroll
        for (int j = 0; j < 4; ++j) { const f32x4 sh = *(const GAS f32x4*)(mv + 4 * F.lane + 256 * j), sc = *(const GAS f32x4*)(mv + 1024 + 4 * F.lane + 256 * j);
            const f32x4 h = v[j] * rstd * gv[j] * (sc + 1.f) + sh;
            *(GAS u32x2*)(H + (size_t)row * DM + 4 * F.lane + 256 * j) = pack4(h); }
    }
}
__device__ __forceinline__ void phase_final_norm(Frame& F) {
    const float* g = INP(33);
    f32x4 gv[4];
#pragma unroll
    for (int j = 0; j < 4; ++j) gv[j] = *(const GAS f32x4*)(g + 4 * F.lane + 256 * j);
    for (int row = F.gw; row < M; row += F.ngw) {
        float* xr = gptr(F.out + (size_t)row * DM);
        f32x4 v[4]; float ss = 0.f;
#pragma unroll
        for (int j = 0; j < 4; ++j) { v[j] = unpack4(LDG(u32x2, F.ws, WS_XB + ((unsigned)row * DM + 4 * F.lane + 256 * j) * 2)); ss += (v[j][0] * v[j][0] + v[j][1] * v[j][1]) + (v[j][2] * v[j][2] + v[j][3] * v[j][3]); }
        const float rstd = rsqrtf(wave_sum(ss) * (1.f / 1024.f) + 1e-6f);
#pragma unroll
        for (int j = 0; j < 4; ++j) *(GAS f32x4*)(xr + 4 * F.lane + 256 * j) = v[j] * rstd * gv[j];
    }
}

#define MFMA32(a, b, c) __builtin_amdgcn_mfma_f32_32x32x16_bf16((a), (b), (c), 0, 0, 0)
#ifndef ATT_PROBE
#define ATT_PROBE 0
#endif
struct AttnQ { float m, l; bool mz; f32x16 o[2]; };
template <int DQK, bool MASK, int NQ>
__device__ __forceinline__ void attn_block(const bf16x8 (&qf)[NQ][DQK / 16], const bf16x8 (&kf)[DQK / 16], const bf16x8 (&vf)[4], AttnQ (&st)[NQ], int b, const int (&qpos)[NQ], int kpos0, int hi) {
    constexpr int NS = DQK / 16;
    f32x16 sc[NQ];
#pragma unroll
    for (int q = 0; q < NQ; ++q) { const f32x16 z = {}; sc[q] = MFMA32(kf[0], qf[q][0], z);
#pragma unroll
        for (int s = 1; s < NS; ++s) sc[q] = MFMA32(kf[s], qf[q][s], sc[q]); }
#pragma unroll
    for (int q = 0; q < NQ; ++q) {
        if (!st[q].mz) {
#pragma unroll
            for (int r = 0; r < 16; ++r) sc[q][r] -= st[q].m; }
        if (MASK) {
#pragma unroll
            for (int r = 0; r < 16; ++r) { const int key = kpos0 + 32 * b + (r & 3) + 8 * (r >> 2) + 4 * hi; const int dlt = key - qpos[q]; if (dlt > 128 || dlt < -128) sc[q][r] = -1e30f; }
        }
        float bm = fmaxf(fmaxf(sc[q][0], sc[q][1]), sc[q][2]);
#pragma unroll
        for (int r = 3; r < 15; r += 2) bm = fmaxf(fmaxf(bm, sc[q][r]), sc[q][r + 1]);
        bm = fmaxf(bm, sc[q][15]);
        bm = swap32_max(bm);
        if (__builtin_amdgcn_ballot_w64(bm > 64.f) != 0ull) {
            const float d = fmaxf(bm, 0.f);
            const float alpha = __builtin_amdgcn_exp2f(-d);
            st[q].m += d; st[q].l *= alpha; st[q].mz = false;
#pragma unroll
            for (int r = 0; r < 16; ++r) { st[q].o[0][r] *= alpha; st[q].o[1][r] *= alpha; sc[q][r] -= d; }
        }
#if ATT_PROBE == 1
        { float dmy = 0.f;
#pragma unroll
          for (int r = 0; r < 16; ++r) { float e_; asm volatile("v_exp_f32 %0, %1" : "=v"(e_) : "v"(sc[q][r])); dmy += e_; }
          asm volatile("" :: "v"(dmy)); }
#endif
        f32x2 rs2 = {0.f, 0.f};
#pragma unroll
        for (int r = 0; r < 16; r += 2) { sc[q][r] = __builtin_amdgcn_exp2f(sc[q][r]); sc[q][r + 1] = __builtin_amdgcn_exp2f(sc[q][r + 1]); rs2 += (f32x2){sc[q][r], sc[q][r + 1]}; }
        st[q].l += rs2[0] + rs2[1];
#if ATT_PROBE == 3
        { float d0 = 0.f, d1 = 0.f, d2 = 0.f, d3 = 0.f;
#pragma unroll
          for (int rr = 0; rr < 10; ++rr) { asm volatile("v_add_f32 %0, %0, %4\n\tv_add_f32 %1, %1, %5\n\tv_add_f32 %2, %2, %6\n\tv_add_f32 %3, %3, %7" : "+v"(d0), "+v"(d1), "+v"(d2), "+v"(d3) : "v"(sc[q][0]), "v"(sc[q][1]), "v"(sc[q][2]), "v"(sc[q][3])); }
          asm volatile("" :: "v"(d0), "v"(d1), "v"(d2), "v"(d3)); }
#endif
#if ATT_PROBE == 2
        { f32x16 dm = sc[q]; dm = MFMA32(kf[0], qf[q][0], dm); dm = MFMA32(kf[0], qf[q][0], dm); dm = MFMA32(kf[0], qf[q][0], dm); asm volatile("" :: "v"(dm)); }
#endif
        bf16x8 pb[2];
#pragma unroll
        for (int ks = 0; ks < 2; ++ks) { u32x4 w; w.x = pk2(sc[q][8 * ks], sc[q][8 * ks + 1]); w.y = pk2(sc[q][8 * ks + 2], sc[q][8 * ks + 3]); w.z = pk2(sc[q][8 * ks + 4], sc[q][8 * ks + 5]); w.w = pk2(sc[q][8 * ks + 6], sc[q][8 * ks + 7]); pb[ks] = __builtin_bit_cast(bf16x8, w); }
#pragma unroll
        for (int db = 0; db < 2; ++db)
#pragma unroll
            for (int ks = 0; ks < 2; ++ks) st[q].o[db] = MFMA32(vf[db * 2 + ks], pb[ks], st[q].o[db]);
    }
}
template <int DQK, bool MASK, int NQ>
__device__ __forceinline__ void attn_seg(const unsigned char* ws, const bf16x8 (&qf)[NQ][DQK / 16], AttnQ (&st)[NQ],
                                         unsigned kp, unsigned kblk  , unsigned vp, unsigned vblk, int nblk, const int (&qpos)[NQ], int kpos0, int hi) {
    constexpr int NS = DQK / 16;
    const GAS unsigned char* kq = (const GAS unsigned char*)ws + kp; const GAS unsigned char* vq = (const GAS unsigned char*)ws + vp;
    bf16x8 ka[NS], va[4], kb[NS], vb[4];
#define ATT_LOAD(kd, vd) do { _Pragma("unroll") for (int s = 0; s < NS; ++s) kd[s] = *(const GAS bf16x8*)(kq + 1024 * s); _Pragma("unroll") for (int f = 0; f < 4; ++f) vd[f] = *(const GAS bf16x8*)(vq + 1024 * f); } while (0)
    ATT_LOAD(ka, va);
    int b = 0;
    for (; b + 1 < nblk; b += 2) {
        kq += kblk; vq += vblk; ATT_LOAD(kb, vb);
        attn_block<DQK, MASK, NQ>(qf, ka, va, st, b, qpos, kpos0, hi);
        if (b + 2 < nblk) { kq += kblk; vq += vblk; }
        ATT_LOAD(ka, va);
        attn_block<DQK, MASK, NQ>(qf, kb, vb, st, b + 1, qpos, kpos0, hi);
    }
    if (b < nblk) attn_block<DQK, MASK, NQ>(qf, ka, va, st, b, qpos, kpos0, hi);
#undef ATT_LOAD
}
__device__ __forceinline__ void attnq_init(AttnQ& s, float l0) { s.m = 0.f; s.mz = true; s.l = l0; s.o[0] = (f32x16){}; s.o[1] = (f32x16){}; }
__device__ __forceinline__ void attn_a_item(Frame& F, int l, bool lat, int item) {
    int lane = F.lane; asm volatile("" : "+v"(lane));
    const unsigned char* ws = F.ws;
    const unsigned r32 = lane & 31, hi = lane >> 5;
    const unsigned nqb = lat ? 128 : 8;
    const unsigned qb = item % nqb, hq = (item / nqb) % 6, b = item / (nqb * 6), kvh = hq / 3;
    const unsigned seq0 = lat ? MC + b * 4096 : b * 256, q0 = qb * 32, row = seq0 + q0 + r32;
    const unsigned qo = WS_QA + (row * 384 + hq * 64 + 8 * hi) * 2;
    bf16x8 qf[1][4];
#pragma unroll
    for (int s = 0; s < 4; ++s) qf[0][s] = LDG(bf16x8, ws, qo + 32 * s);
    AttnQ st[1]; attnq_init(st[0], hi == 0 ? __builtin_amdgcn_exp2f(INP(15)[l * 6 + hq] * LOG2E) : 0.f);
    const int qpos[1] = {(int)(q0 + r32)};
    const unsigned fo = kvh * 4096 + lane * 16;
    if (!lat) {
        attn_seg<64, false, 1>(ws, qf, st, WS_KA + (seq0 >> 5) * 8192 + fo, 8192, WS_VTA + (seq0 >> 5) * 8192 + fo, 8192, 8, qpos, 0, hi);
    } else {
        const int ks = (int)q0 - 128 < 0 ? 0 : (int)q0 - 128, ke = q0 + 160 > 4096 ? 4096 : q0 + 160;
        attn_seg<64, true, 1>(ws, qf, st, WS_KA + ((seq0 + ks) >> 5) * 8192 + fo, 8192, WS_VTA + ((seq0 + ks) >> 5) * 8192 + fo, 8192, (ke - ks) >> 5, qpos, ks, hi);
        attn_seg<64, false, 1>(ws, qf, st, WS_CACHE + (b * 4 + l) * 131072 + fo, 8192, WS_CACHE + 1 * MiB + (b * 4 + l) * 131072 + fo, 8192, 16, qpos, 0, hi);
    }
    const float rl = 1.f / swap32_sum(st[0].l);
    const unsigned oo = WS_ACT + (row * DM + hq * 64 + 4 * hi) * 2;
#pragma unroll
    for (int db = 0; db < 2; ++db)
#pragma unroll
        for (int g = 0; g < 4; ++g) { const f32x4 v = {st[0].o[db][4 * g] * rl, st[0].o[db][4 * g + 1] * rl, st[0].o[db][4 * g + 2] * rl, st[0].o[db][4 * g + 3] * rl}; STG(u32x2, F.ws, oo + (32 * db + 8 * g) * 2) = pack4(v); }
}
__device__ __forceinline__ void attn_b_store(Frame& F, const AttnQ& s, unsigned mp, unsigned kh, unsigned row, unsigned h, unsigned hi) {
    const float lt = swap32_sum(s.l);
    const unsigned oo = WS_BO2 + (((mp * 2 + kh) * M + row) * 256 + h * 64 + 4 * hi) * 2;
#pragma unroll
    for (int db = 0; db < 2; ++db)
#pragma unroll
        for (int g = 0; g < 4; ++g) STG(u32x2, F.ws, oo + (32 * db + 8 * g) * 2) = pack4((f32x4){s.o[db][4 * g], s.o[db][4 * g + 1], s.o[db][4 * g + 2], s.o[db][4 * g + 3]});
    if (hi == 0) STG(f32x2, F.ws, WS_ML + ((((mp * 2 + kh) * M + row) * 4 + h) * 2) * 4) = (f32x2){s.m, lt};
}
__device__ __forceinline__ void attn_b_item(Frame& F, int l, bool lat, int item) {
    int lane = F.lane; asm volatile("" : "+v"(lane));
    const unsigned char* ws = F.ws;
    const unsigned r32 = lane & 31, hi = lane >> 5;
    if (lat) {
        const unsigned kh = item & 1, qb = (item >> 1) & 63, mp = (item >> 7) & 1, h = (item >> 8) & 3, b = item >> 10;
        const unsigned seq0 = MC + b * 4096, row0 = seq0 + qb * 64 + r32;
        bf16x8 qf[2][2];
#pragma unroll
        for (int q = 0; q < 2; ++q)
#pragma unroll
            for (int s = 0; s < 2; ++s) qf[q][s] = LDG(bf16x8, ws, WS_QB + ((row0 + 32 * q) * 256 + h * 64 + mp * 32 + 8 * hi) * 2 + 32 * s);
        AttnQ st[2]; attnq_init(st[0], 0.f); attnq_init(st[1], 0.f);
        const int qpos[2] = {0, 0};
        const unsigned kfo = (h * 2 + mp) * 2048 + lane * 16, vfo = h * 4096 + lane * 16;
        const unsigned blk0 = kh ? 72u : 0u, nb = kh ? 56 : 72;
        attn_seg<32, false, 2>(ws, qf, st, WS_KB + ((seq0 >> 5) + blk0) * 16384 + kfo, 16384, WS_VTB + ((seq0 >> 5) + blk0) * 16384 + vfo, 16384, nb, qpos, 0, hi);
        if (kh) attn_seg<32, false, 2>(ws, qf, st, WS_CACHE + 2 * MiB + (b * 4 + l) * 262144 + kfo, 16384, WS_CACHE + 4 * MiB + (b * 4 + l) * 262144 + vfo, 16384, 16, qpos, 0, hi);
        attn_b_store(F, st[0], mp, kh, row0, h, hi); attn_b_store(F, st[1], mp, kh, row0 + 32, h, hi);
    } else {
        const unsigned qb = item & 7, mp = (item >> 3) & 1, h = (item >> 4) & 3, b = item >> 6;
        const unsigned seq0 = b * 256, row = seq0 + qb * 32 + r32;
        bf16x8 qf[1][2];
#pragma unroll
        for (int s = 0; s < 2; ++s) qf[0][s] = LDG(bf16x8, ws, WS_QB + (row * 256 + h * 64 + mp * 32 + 8 * hi) * 2 + 32 * s);
        AttnQ st[1]; attnq_init(st[0], 0.f);
        const int qpos[1] = {0};
        const unsigned kfo = (h * 2 + mp) * 2048 + lane * 16, vfo = h * 4096 + lane * 16;
        attn_seg<32, false, 1>(ws, qf, st, WS_KB + (seq0 >> 5) * 16384 + kfo, 16384, WS_VTB + (seq0 >> 5) * 16384 + vfo, 16384, 8, qpos, 0, hi);
        attn_b_store(F, st[0], mp, 0, row, h, hi);
    }
}

constexpr int L_KT = 0, L_RT = 9216, L_BT = 18432, L_KK = 27648, L_VT = 36864, L_KKT = 46080, L_BTT = 55296, L_A1 = 64512, L_RHS2 = 81920, L_WT = 99328, L_U0T = 108544, L_GC = 117760, L_X0 = 118016;
constexpr int RPB = 144, RPF = 272;
__device__ __forceinline__ void chunk_decode(int cid, unsigned& seq0, int& T, unsigned& b, unsigned& h, unsigned& dir, int& c) {
    unsigned chain;
    if (cid < 768) { chain = (unsigned)cid >> 2; c = cid & 3; T = 256; b = chain / 12; seq0 = b * 256; }
    else { const unsigned x = (unsigned)cid - 768; chain = x >> 6; c = (int)(x & 63); T = 4096; b = chain / 12; seq0 = MC + b * 4096; }
    dir = chain & 1; h = (chain >> 1) % 6;
}
__device__ __forceinline__ bf16x8 acc_frag(const f32x16& x, int ks, float sgn) {
    u32x4 w; w.x = pk2(sgn * x[8 * ks], sgn * x[8 * ks + 1]); w.y = pk2(sgn * x[8 * ks + 2], sgn * x[8 * ks + 3]); w.z = pk2(sgn * x[8 * ks + 4], sgn * x[8 * ks + 5]); w.w = pk2(sgn * x[8 * ks + 6], sgn * x[8 * ks + 7]);
    return __builtin_bit_cast(bf16x8, w);
}
__device__ __forceinline__ bf16x8 lds_frag_nat(const LAS unsigned char* img, unsigned row, int ks, unsigned hi) { return *(const LAS bf16x8*)(img + row * RPB + (16 * ks + 8 * hi) * 2); }
__device__ __forceinline__ bf16x8 lds_frag_perm(const LAS unsigned char* img, unsigned row, int k0, unsigned hi) {
    const s16x4 a = *(const LAS s16x4*)(img + row * RPB + (k0 + 4 * hi) * 2), b = *(const LAS s16x4*)(img + row * RPB + (k0 + 8 + 4 * hi) * 2);
    return (bf16x8){a[0], a[1], a[2], a[3], b[0], b[1], b[2], b[3]};
}
__device__ __forceinline__ f32x16 gram_tile(const LAS unsigned char* lds, int aimg, int bimg, int sb, int tb, unsigned r32, unsigned hi, bool strict) {
    f32x16 acc = {};
#pragma unroll
    for (int ks = 0; ks < 4; ++ks) acc = MFMA32(lds_frag_nat(lds + aimg, 32 * sb + r32, ks, hi), lds_frag_nat(lds + bimg, 32 * tb + r32, ks, hi), acc);
    if (sb == tb) {
#pragma unroll
        for (int r = 0; r < 16; ++r) { const unsigned s_ = (r & 3) + 8 * (r >> 2) + 4 * hi; const bool keep = strict ? s_ < r32 : s_ <= r32; acc[r] = keep ? acc[r] : 0.f; }
    }
    return acc;
}
__device__ __forceinline__ void lds_barrier() { asm volatile("s_waitcnt lgkmcnt(0)\n\ts_barrier" ::: "memory"); }
__device__ __forceinline__ void rwkv_chunk_block(Frame& F, int l, int cid) {
    int lane = F.lane; asm volatile("" : "+v"(lane));
    const unsigned char* ws = F.ws; LAS unsigned char* lds = F.lds;
    const int w = F.wave; const unsigned r32 = lane & 31, hi = lane >> 5;
    unsigned seq0, b, h, dir; int T, c; chunk_decode(cid, seq0, T, b, h, dir, c);
    const int q0 = 64 * c;
#ifndef RA_REP
#define RA_REP 0
#endif
    const int role = w >> 1, tb = w & 1;
    const unsigned swo = WS_SMALLW + l * (SMALLW_L * 2);
    {
        const int pw_ = w < 4, pb = (w >> 1) & 1, cb = w & 1;
        const int p_ = 32 * pb + r32; const unsigned tokp = seq0 + (dir ? T - 1 - (q0 + p_) : q0 + p_);
        const unsigned xo = (pw_ ? WS_CW : WS_CA) + (tokp * 128 + dir * 64 + 8 * hi) * 2, wo = swo + ((pw_ ? 0 : 49152) + (dir * 384 + h * 64 + 32 * cb + r32) * 64 + 8 * hi) * 2;
        f32x16 acc = {};
#pragma unroll
        for (int ks = 0; ks < 4; ++ks) acc = MFMA32(LDG(bf16x8, ws, xo + 32 * ks), LDG(bf16x8, ws, wo + 32 * ks), acc);
        {
            const float bias = LDG(float, pw_ ? INP(19) : INP(21), ((l * 2 + dir) * 384 + h * 64 + 32 * cb + r32) * 4);
#pragma unroll
            for (int r = 0; r < 16; ++r) { const float sg = sigmf(bias + acc[r]);
                *(LAS float*)(lds + (pw_ ? L_A1 : L_RHS2) + (32 * pb + (r & 3) + 8 * (r >> 2) + 4 * hi) * RPF + (32 * cb + r32) * 4) = pw_ ? -0.606531f * sg : sg; }
        }
        if (dir == 0 && w < 4) {
            f32x16 ag = {};
            const unsigned go = WS_CG + (tokp * 128 + 8 * hi) * 2, gw_ = swo + (98304 + (h * 64 + 32 * cb + r32) * 128 + 8 * hi) * 2;
#pragma unroll
            for (int ks = 0; ks < 8; ++ks) ag = MFMA32(LDG(bf16x8, ws, go + 32 * ks), LDG(bf16x8, ws, gw_ + 32 * ks), ag);
#pragma unroll
            for (int r = 0; r < 16; ++r) { const int pp_ = 32 * pb + (r & 3) + 8 * (r >> 2) + 4 * hi; const unsigned tk = seq0 + q0 + pp_;
                STG(bf16_t, F.ws, WS_G + (tk * 384 + h * 64 + 32 * cb + r32) * 2) = (bf16_t)(pk2(ag[r], 0.f) & 0xffff); }
        }
    }
    lds_barrier();
    {
        const unsigned cch = h * 64 + lane;
        const float* convp = INP(18) + (size_t)l * 3 * 1152;
        float cw_[3][3];
#pragma unroll
        for (int tap = 0; tap < 3; ++tap)
#pragma unroll
            for (int seg = 0; seg < 3; ++seg) cw_[tap][seg] = LDG(float, convp, (tap * 1152 + seg * 384 + cch) * 4);
        const float ckk = LDG(float, INP(24), (l * 384 + cch) * 4), cka = LDG(float, INP(25), (l * 384 + cch) * 4), crk = LDG(float, INP(26), (l * 384 + cch) * 4);
        const int tb0 = dir ? T - 1 - (q0 + 8 * w + 7) : q0 + 8 * w;
        float xr[10][3];
#pragma unroll
        for (int rr = 0; rr < 10; ++rr) { const int tr = tb0 - 1 + rr; const bool ok = tr >= 0 && tr < T; const unsigned tk = seq0 + (ok ? tr : tb0);
#pragma unroll
            for (int seg = 0; seg < 3; ++seg) { const float x = bf_lo((unsigned)LDG(bf16_t, ws, WS_RKV + (tk * 1152 + seg * 384 + cch) * 2)); xr[rr][seg] = ok ? x : 0.f; } }
        float lwv[8], kkv[8], btv[8], kdv[8], rv[8], vv[8], g = 0.f;
#pragma unroll
        for (int pp = 0; pp < 8; ++pp) {
            const int rr = 1 + (dir ? 7 - pp : pp); const int p = 8 * w + pp; const unsigned tok = seq0 + (unsigned)(tb0 + rr - 1);
            const float r_ = xr[rr - 1][0] * cw_[0][0] + xr[rr][0] * cw_[1][0] + xr[rr + 1][0] * cw_[2][0];
            const float k_ = xr[rr - 1][1] * cw_[0][1] + xr[rr][1] * cw_[1][1] + xr[rr + 1][1] * cw_[2][1];
            const float v_ = xr[rr - 1][2] * cw_[0][2] + xr[rr][2] * cw_[1][2] + xr[rr + 1][2] * cw_[2][2];
            const float kraw = k_ * ckk; const float n2 = wave_sum(kraw * kraw); const float kk_ = kraw * __builtin_amdgcn_rsqf(fmaxf(n2, 1e-24f));
            const float lw = *(const LAS float*)(lds + L_A1 + p * RPF + lane * 4), av = *(const LAS float*)(lds + L_RHS2 + p * RPF + lane * 4);
            const float kd_ = k_ * (1.f + (av - 1.f) * cka);
            const float bon = wave_sum(r_ * kd_ * crk);
            if (lane == 0) STG(float, F.ws, WS_SB + ((dir * M + tok) * 8 + h) * 4) = bon;
            if (dir == 0) STG(float, F.ws, WS_SV + (tok * 384 + cch) * 4) = v_;
            lwv[pp] = lw; kkv[pp] = kk_; btv[pp] = kk_ * av; kdv[pp] = kd_; rv[pp] = r_; vv[pp] = v_; g += lw;
        }
        g = 0.f;
        for (int wq = 0; wq < w; ++wq) { float t8[8];
#pragma unroll
            for (int e = 0; e < 8; ++e) t8[e] = *(const LAS float*)(lds + L_A1 + (8 * wq + e) * RPF + lane * 4);
            g += ((t8[0] + t8[1]) + (t8[2] + t8[3])) + ((t8[4] + t8[5]) + (t8[6] + t8[7])); }
        unsigned vt[4], kkt[4], btt[4]; float e_pos = __expf(g);
#pragma unroll
        for (int pp = 0; pp < 8; ++pp) {
            const int p = 8 * w + pp;
            const float e_prev = e_pos; g += lwv[pp]; e_pos = __expf(g); const float e_neg = __expf(-g);
            const unsigned pk_kr = pk2(kkv[pp] * e_prev, rv[pp] * e_pos), pk_bk = pk2(btv[pp] * e_neg, kdv[pp] * e_neg), pk_v = pk2(vv[pp], 0.f);
            *(LAS bf16_t*)(lds + L_KT + p * RPB + lane * 2) = (bf16_t)(pk_kr & 0xffff); *(LAS bf16_t*)(lds + L_RT + p * RPB + lane * 2) = (bf16_t)(pk_kr >> 16);
            *(LAS bf16_t*)(lds + L_BT + p * RPB + lane * 2) = (bf16_t)(pk_bk & 0xffff); *(LAS bf16_t*)(lds + L_KK + p * RPB + lane * 2) = (bf16_t)(pk_bk >> 16);
            if (pp & 1) { vt[pp >> 1] |= pk_v << 16; kkt[pp >> 1] |= pk_bk & 0xffff0000u; btt[pp >> 1] |= pk_bk << 16; }
            else { vt[pp >> 1] = pk_v & 0xffff; kkt[pp >> 1] = pk_bk >> 16; btt[pp >> 1] = pk_bk & 0xffff; }
        }
        *(LAS u32x4*)(lds + L_VT + lane * RPB + 16 * w) = (u32x4){vt[0], vt[1], vt[2], vt[3]};
        *(LAS u32x4*)(lds + L_KKT + lane * RPB + 16 * w) = (u32x4){kkt[0], kkt[1], kkt[2], kkt[3]};
        *(LAS u32x4*)(lds + L_BTT + lane * RPB + 16 * w) = (u32x4){btt[0], btt[1], btt[2], btt[3]};
        if (w == 7) *(LAS float*)(lds + L_GC + lane * 4) = e_pos;
    }
    lds_barrier();
    f32x16 keep[2]; bf16x8 x4f[2][2];
    if (role == 0) {
        for (int sb = 0; sb <= tb; ++sb) { const f32x16 x = gram_tile(lds, L_BT, L_KT, sb, tb, r32, hi, true);
            if (sb == tb) {
#pragma unroll
                for (int r = 0; r < 16; ++r) *(LAS float*)(lds + L_A1 + tb * 4608 + ((r & 3) + 8 * (r >> 2) + 4 * hi) * 144 + r32 * 4) = -x[r];
            } else {
#pragma unroll
                for (int g4 = 0; g4 < 4; ++g4) *(LAS f32x4*)(lds + L_A1 + 9216 + r32 * 144 + (8 * g4 + 4 * hi) * 4) = (f32x4){x[4 * g4], x[4 * g4 + 1], x[4 * g4 + 2], x[4 * g4 + 3]};
            } }
    } else if (role == 1) {
        f32x16 o[2] = {};
        for (int sb = 0; sb <= tb; ++sb) {
            const f32x16 x = gram_tile(lds, L_KK, L_KT, sb, tb, r32, hi, true);
#pragma unroll
            for (int ks = 0; ks < 2; ++ks) { const bf16x8 a = acc_frag(x, ks, 1.f);
#pragma unroll
                for (int ib = 0; ib < 2; ++ib) o[ib] = MFMA32(a, lds_frag_perm(lds + L_VT, 32 * ib + r32, 32 * sb + 16 * ks, hi), o[ib]); }
        }
#pragma unroll
        for (int ib = 0; ib < 2; ++ib)
#pragma unroll
            for (int r = 0; r < 16; ++r) *(LAS float*)(lds + L_RHS2 + (32 * tb + (r & 3) + 8 * (r >> 2) + 4 * hi) * RPF + (32 * ib + r32) * 4) = o[ib][r];
    } else if (role == 2) {
#pragma unroll
        for (int sb = 0; sb < 2; ++sb) { x4f[sb][0] = (bf16x8){}; x4f[sb][1] = (bf16x8){}; }
        keep[0] = (f32x16){}; keep[1] = (f32x16){};
        for (int sb = 0; sb <= tb; ++sb) {
            const f32x16 x3 = gram_tile(lds, L_KK, L_RT, sb, tb, r32, hi, false), x4 = gram_tile(lds, L_BT, L_RT, sb, tb, r32, hi, false);
#pragma unroll
            for (int ks = 0; ks < 2; ++ks) { const bf16x8 a3 = acc_frag(x3, ks, 1.f); const bf16x8 a4 = acc_frag(x4, ks, -1.f);
                if (sb == 0) x4f[0][ks] = a4; else x4f[1][ks] = a4;
#pragma unroll
                for (int cb = 0; cb < 2; ++cb) keep[cb] = MFMA32(a3, lds_frag_perm(lds + L_VT, 32 * cb + r32, 32 * sb + 16 * ks, hi), keep[cb]); }
        }
    } else {
        keep[0] = (f32x16){}; keep[1] = (f32x16){};
#pragma unroll
        for (int ks = 0; ks < 4; ++ks) { const bf16x8 ak = lds_frag_nat(lds + L_KKT, 32 * tb + r32, ks, hi);
#pragma unroll
            for (int cb = 0; cb < 2; ++cb) keep[cb] = MFMA32(ak, lds_frag_nat(lds + L_VT, 32 * cb + r32, ks, hi), keep[cb]); }
    }
    lds_barrier();
    if (w < 2) {
        const LAS unsigned char* a1p = lds + L_A1; asm volatile("" : "+v"(a1p));
        LAS unsigned char* xp = lds + (w == 0 ? L_X0 : L_RHS2) + lane * 4; asm volatile("" : "+v"(xp));
        const LAS unsigned char* kp = lds + L_KT + lane * 2; asm volatile("" : "+v"(kp));
        LAS unsigned char* dst = lds + (w == 0 ? L_WT : L_U0T) + lane * RPB; asm volatile("" : "+v"(dst));
#pragma unroll
        for (int B = 0; B < 2; ++B) {
            float acc[32];
            if (w == 0 && B == 0) {
#pragma unroll
                for (int r = 0; r < 32; ++r) acc[r] = bf_lo((unsigned)*(const LAS bf16_t*)(kp + r * RPB));
            } else {
#pragma unroll
                for (int r = 0; r < 32; ++r) acc[r] = *(const LAS float*)(xp + (32 * B + r) * RPF);
            }
            f32x2 ac2[16];
#pragma unroll
            for (int k = 0; k < 16; ++k) ac2[k] = (f32x2){acc[2 * k], acc[2 * k + 1]};
            f32x4 ca[8], cn[8];
#pragma unroll
            for (int tg = 0; tg < 8; ++tg) ca[tg] = *(const LAS f32x4*)(a1p + B * 4608 + tg * 16);
#pragma unroll
            for (int s_ = 0; s_ < 31; ++s_) {
                if (s_ + 1 < 31) {
#pragma unroll
                    for (int tg = (s_ + 2) / 4; tg < 8; ++tg) cn[tg] = *(const LAS f32x4*)(a1p + B * 4608 + (s_ + 1) * 144 + tg * 16);
                }
                __builtin_amdgcn_sched_barrier(0);
                const float xs = ac2[s_ >> 1][s_ & 1];
                const f32x2 xs2 = {xs, xs};
#pragma unroll
                for (int tg = (s_ + 1) / 4; tg < 8; ++tg) {
                    ac2[2 * tg] = __builtin_elementwise_fma((f32x2){ca[tg][0], ca[tg][1]}, xs2, ac2[2 * tg]);
                    ac2[2 * tg + 1] = __builtin_elementwise_fma((f32x2){ca[tg][2], ca[tg][3]}, xs2, ac2[2 * tg + 1]); }
                __builtin_amdgcn_sched_barrier(0);
#pragma unroll
                for (int tg = 0; tg < 8; ++tg) ca[tg] = cn[tg];
            }
#pragma unroll
            for (int k = 0; k < 16; ++k) { acc[2 * k] = ac2[k][0]; acc[2 * k + 1] = ac2[k][1]; }
#pragma unroll
            for (int k8 = 0; k8 < 4; ++k8) { u32x4 v; v.x = pk2(acc[8 * k8], acc[8 * k8 + 1]); v.y = pk2(acc[8 * k8 + 2], acc[8 * k8 + 3]); v.z = pk2(acc[8 * k8 + 4], acc[8 * k8 + 5]); v.w = pk2(acc[8 * k8 + 6], acc[8 * k8 + 7]);
                *(LAS u32x4*)(dst + 64 * B + 16 * k8) = v; }
            if (B == 0) {
                asm volatile("s_waitcnt lgkmcnt(0)" ::: "memory");
                f32x16 u[2];
#pragma unroll
                for (int cb = 0; cb < 2; ++cb)
#pragma unroll
                    for (int r = 0; r < 16; ++r) { const int t = 32 + (r & 3) + 8 * (r >> 2) + 4 * hi;
                        u[cb][r] = w == 0 ? bf_lo((unsigned)*(const LAS bf16_t*)(lds + L_KT + t * RPB + (32 * cb + r32) * 2)) : *(const LAS float*)(lds + L_RHS2 + t * RPF + (32 * cb + r32) * 4); }
#pragma unroll
                for (int ks = 0; ks < 2; ++ks) { const f32x4 a0 = *(const LAS f32x4*)(lds + L_A1 + 9216 + r32 * 144 + (16 * ks + 8 * hi) * 4), a1 = *(const LAS f32x4*)(lds + L_A1 + 9216 + r32 * 144 + (16 * ks + 8 * hi + 4) * 4);
                    u32x4 aw; aw.x = pk2(-a0[0], -a0[1]); aw.y = pk2(-a0[2], -a0[3]); aw.z = pk2(-a1[0], -a1[1]); aw.w = pk2(-a1[2], -a1[3]);
#pragma unroll
                    for (int cb = 0; cb < 2; ++cb) u[cb] = MFMA32(__builtin_bit_cast(bf16x8, aw), lds_frag_nat(lds + (w == 0 ? L_WT : L_U0T), 32 * cb + r32, ks, hi), u[cb]); }
#pragma unroll
                for (int cb = 0; cb < 2; ++cb)
#pragma unroll
                    for (int r = 0; r < 16; ++r) *(LAS float*)(lds + (w == 0 ? L_X0 : L_RHS2) + (32 + (r & 3) + 8 * (r >> 2) + 4 * hi) * RPF + (32 * cb + r32) * 4) = u[cb][r];
                asm volatile("s_waitcnt lgkmcnt(0)" ::: "memory");
            }
        }
    }
    lds_barrier();
    if (role == 2) {
        f32x16 pj[2];
#pragma unroll
        for (int jb = 0; jb < 2; ++jb)
#pragma unroll
            for (int r = 0; r < 16; ++r) pj[jb][r] = bf_lo((unsigned)*(const LAS bf16_t*)(lds + L_RT + (32 * tb + (r & 3) + 8 * (r >> 2) + 4 * hi) * RPB + (32 * jb + r32) * 2));
#pragma unroll
        for (int sb = 0; sb < 2; ++sb)
#pragma unroll
            for (int ks = 0; ks < 2; ++ks)
#pragma unroll
                for (int cb = 0; cb < 2; ++cb) {
                    keep[cb] = MFMA32(x4f[sb][ks], lds_frag_perm(lds + L_U0T, 32 * cb + r32, 32 * sb + 16 * ks, hi), keep[cb]);
                    pj[cb] = MFMA32(x4f[sb][ks], lds_frag_perm(lds + L_WT, 32 * cb + r32, 32 * sb + 16 * ks, hi), pj[cb]); }
        f32x16 (&y0)[2] = keep;
        const unsigned yb = dir ? WS_YB : WS_YF;
#pragma unroll
        for (int r = 0; r < 16; ++r) { const int t = 32 * tb + (r & 3) + 8 * (r >> 2) + 4 * hi; const unsigned tok = seq0 + (dir ? T - 1 - (q0 + t) : q0 + t);
#pragma unroll
            for (int cb = 0; cb < 2; ++cb) { STG(float, F.ws, yb + (tok * 384 + h * 64 + 32 * cb + r32) * 4) = y0[cb][r];
                STG(bf16_t, F.ws, WS_RP + (((unsigned)cid * 64 + t) * 64 + 32 * cb + r32) * 2) = (bf16_t)(pk2(pj[cb][r], 0.f) & 0xffff); } }
    } else if (role == 3) {
        const int jb = tb;
        f32x16 q1[2] = {}, q2[2] = {}; f32x16 (&n1)[2] = keep;
#pragma unroll
        for (int ks = 0; ks < 4; ++ks) { const bf16x8 a = lds_frag_nat(lds + L_BTT, 32 * jb + r32, ks, hi);
#pragma unroll
            for (int cb = 0; cb < 2; ++cb) { q1[cb] = MFMA32(lds_frag_nat(lds + L_WT, 32 * cb + r32, ks, hi), a, q1[cb]); q2[cb] = MFMA32(a, lds_frag_nat(lds + L_U0T, 32 * cb + r32, ks, hi), q2[cb]); } }
#pragma unroll
        for (int q = 0; q < 4; ++q) { f32x4 gc4;
#pragma unroll
            for (int e = 0; e < 4; ++e) gc4[e] = *(const LAS float*)(lds + L_GC + (32 * jb + e + 8 * q + 4 * hi) * 4);
#pragma unroll
            for (int cb = 0; cb < 2; ++cb) { f32x4 nv;
#pragma unroll
                for (int e = 0; e < 4; ++e) nv[e] = gc4[e] * (n1[cb][4 * q + e] - q2[cb][4 * q + e]);
                STG(f32x4, F.ws, WS_RN + ((((unsigned)cid * 2 + jb) * 2 + cb) * 4 + q) * 1024 + lane * 16) = nv; } }
        { const float gl = *(const LAS float*)(lds + L_GC + (32 * jb + r32) * 4);
#pragma unroll
          for (int cb = 0; cb < 2; ++cb)
#pragma unroll
            for (int s2 = 0; s2 < 2; ++s2) { float mv[8];
#pragma unroll
                for (int e = 0; e < 8; ++e) { const int r = 8 * s2 + e; const unsigned c = 32 * cb + (r & 3) + 8 * (r >> 2) + 4 * hi; mv[e] = (c == 32 * jb + r32 ? gl : 0.f) - gl * q1[cb][r]; }
                u32x4 w; w.x = pk2(mv[0], mv[1]); w.y = pk2(mv[2], mv[3]); w.z = pk2(mv[4], mv[5]); w.w = pk2(mv[6], mv[7]);
                STG(u32x4, F.ws, WS_RM + (unsigned)cid * 8192 + ((jb * 2 + cb) * 2 + s2) * 1024 + lane * 16) = w; } }
    }
    lds_barrier();
}
__device__ __forceinline__ void rwkv_chain_wave(Frame& F, int l, bool lat, int chain, int ib) {
    int lane = F.lane; asm volatile("" : "+v"(lane));
    const unsigned char* ws = F.ws; const unsigned r32 = lane & 31, hi = lane >> 5;
    const unsigned dir = chain & 1, h = (chain >> 1) % 6, b = chain / 12;
    const int nc = lat ? 64 : 4; const unsigned cid0 = lat ? 768 + chain * 64 : chain * 4;
    const unsigned i = 32 * ib + r32;
    const unsigned so = ((((b * 4 + l) * 6 + h) * 64 + i) * 64) * 4;
    f32x16 H[2];
#pragma unroll
    for (int jb = 0; jb < 2; ++jb)
#pragma unroll
        for (int g4 = 0; g4 < 4; ++g4) { f32x4 v = {0.f, 0.f, 0.f, 0.f}; if (lat) v = LDG(f32x4, dir ? INP(7) : INP(6), so + (32 * jb + 8 * g4 + 4 * hi) * 4);
            H[jb][4 * g4] = v[0]; H[jb][4 * g4 + 1] = v[1]; H[jb][4 * g4 + 2] = v[2]; H[jb][4 * g4 + 3] = v[3]; }
    bf16x8 maA[2][2][2], maB[2][2][2]; f32x16 ntA[2], ntB[2];
    const GAS unsigned char* pm = (const GAS unsigned char*)ws + (WS_RM + cid0 * 8192 + lane * 16);
    const GAS unsigned char* pn = (const GAS unsigned char*)ws + (WS_RN + (cid0 * 4 + ib) * 4096 + lane * 16);
#define RB_LOAD(ma, nt, k_) do { \
        _Pragma("unroll") for (int jo = 0; jo < 2; ++jo) _Pragma("unroll") for (int ji = 0; ji < 2; ++ji) _Pragma("unroll") for (int ks = 0; ks < 2; ++ks) ma[jo][ji][ks] = *(const GAS bf16x8*)(pm + ((k_) * 8192 + ((jo * 2 + ji) * 2 + ks) * 1024)); \
        _Pragma("unroll") for (int jo = 0; jo < 2; ++jo) _Pragma("unroll") for (int q = 0; q < 4; ++q) { const f32x4 t_ = *(const GAS f32x4*)(pn + ((k_) * 16384 + (jo * 8 + q) * 1024)); \
            nt[jo][4 * q] = t_[0]; nt[jo][4 * q + 1] = t_[1]; nt[jo][4 * q + 2] = t_[2]; nt[jo][4 * q + 3] = t_[3]; } } while (0)
#define RB_STEP(ma, nt, cid_) do { \
        bf16x8 hf[2][2]; \
        _Pragma("unroll") for (int ji = 0; ji < 2; ++ji) { hf[ji][0] = acc_frag(H[ji], 0, 1.f); hf[ji][1] = acc_frag(H[ji], 1, 1.f); } \
        _Pragma("unroll") for (int ji = 0; ji < 2; ++ji) _Pragma("unroll") for (int ks = 0; ks < 2; ++ks) STG(bf16x8, F.ws, WS_RH + (cid_) * 8192 + ((ib * 2 + ji) * 2 + ks) * 1024 + lane * 16) = hf[ji][ks]; \
        f32x16 acc[2] = {nt[0], nt[1]}; \
        _Pragma("unroll") for (int jo = 0; jo < 2; ++jo) _Pragma("unroll") for (int ji = 0; ji < 2; ++ji) _Pragma("unroll") for (int ks = 0; ks < 2; ++ks) acc[jo] = MFMA32(ma[jo][ji][ks], hf[ji][ks], acc[jo]); \
        H[0] = acc[0]; H[1] = acc[1]; } while (0)
    RB_LOAD(maA, ntA, 0); RB_LOAD(maB, ntB, 1);
#pragma unroll 1
    for (int c = 0; c < nc; c += 2) {
        const unsigned cid = cid0 + c;
        RB_STEP(maA, ntA, cid);
        if (c + 2 < nc) RB_LOAD(maA, ntA, 2);
        RB_STEP(maB, ntB, cid + 1);
        if (c + 2 < nc) RB_LOAD(maB, ntB, 3);
        pm += 16384; pn += 32768;
    }
#undef RB_LOAD
#undef RB_STEP
    if (!lat) {
#pragma unroll
        for (int jb = 0; jb < 2; ++jb)
#pragma unroll
            for (int g4 = 0; g4 < 4; ++g4) STG(f32x4, F.out, (dir ? OFF_CB : OFF_CF) * 4 + so + (32 * jb + 8 * g4 + 4 * hi) * 4) = (f32x4){H[jb][4 * g4], H[jb][4 * g4 + 1], H[jb][4 * g4 + 2], H[jb][4 * g4 + 3]};
    }
}
__device__ __forceinline__ void rwkv_apply_wave(Frame& F, int item) {
    int lane = F.lane; asm volatile("" : "+v"(lane));
    const unsigned char* ws = F.ws; const unsigned r32 = lane & 31, hi = lane >> 5;
    const int cid = item >> 1, tb = item & 1;
    unsigned seq0, b, h, dir; int T, c; chunk_decode(cid, seq0, T, b, h, dir, c);
    const unsigned yb = dir ? WS_YB : WS_YF;
    f32x16 acc[2];
#pragma unroll
    for (int r = 0; r < 16; ++r) { const int t = 32 * tb + (r & 3) + 8 * (r >> 2) + 4 * hi; const unsigned tok = seq0 + (dir ? T - 1 - (64 * c + t) : 64 * c + t);
        acc[0][r] = LDG(float, ws, yb + (tok * 384 + h * 64 + r32) * 4); acc[1][r] = LDG(float, ws, yb + (tok * 384 + h * 64 + 32 + r32) * 4); }
#pragma unroll
    for (int ks = 0; ks < 4; ++ks) { const bf16x8 a = LDG(bf16x8, ws, WS_RP + (((unsigned)cid * 64 + 32 * tb + r32) * 64 + 16 * ks + 8 * hi) * 2);
#pragma unroll
        for (int ib = 0; ib < 2; ++ib) acc[ib] = MFMA32(a, LDG(bf16x8, ws, WS_RH + (((unsigned)cid * 64 + 32 * ib + r32) * 64 + 16 * ks + 8 * hi) * 2), acc[ib]); }
#pragma unroll
    for (int r = 0; r < 16; ++r) { const int t = 32 * tb + (r & 3) + 8 * (r >> 2) + 4 * hi; const unsigned tok = seq0 + (dir ? T - 1 - (64 * c + t) : 64 * c + t);
        STG(float, F.ws, yb + (tok * 384 + h * 64 + r32) * 4) = acc[0][r]; STG(float, F.ws, yb + (tok * 384 + h * 64 + 32 + r32) * 4) = acc[1][r]; }
}

__device__ __forceinline__ void rwkv_out_item(Frame& F, int l, int item) {
    int lane = F.lane; asm volatile("" : "+v"(lane));
    const unsigned char* ws = F.ws; const unsigned r32 = lane & 31, hi = lane >> 5;
    const int tb = item & 1, h = (item >> 1) % 6, sk = item / 12;
    const bool lat = sk >= 64; const int b = lat ? (sk - 64) >> 6 : sk >> 2, k = lat ? (sk - 64) & 63 : sk & 3, nc = lat ? 64 : 4;
    const unsigned seq0 = lat ? MC + b * 4096 : b * 256, base = lat ? 768u : 0u;
    const unsigned chf = (b * 6 + h) * 2, cidf = base + chf * nc + k, cidb = base + (chf + 1) * nc + (nc - 1 - k);
    const unsigned tok0 = seq0 + 64 * k + 32 * tb;
    f32x16 acc[2];
#pragma unroll
    for (int r = 0; r < 16; ++r) { const unsigned tok = tok0 + (r & 3) + 8 * (r >> 2) + 4 * hi; const unsigned e = (tok * 384 + h * 64 + r32) * 4;
        acc[0][r] = LDG(float, ws, WS_YF + e) + LDG(float, ws, WS_YB + e); acc[1][r] = LDG(float, ws, WS_YF + e + 128) + LDG(float, ws, WS_YB + e + 128); }
    const unsigned pf = 32 * tb + r32, pb_ = 63 - 32 * tb - r32;
#pragma unroll
    for (int ks = 0; ks < 4; ++ks) {
        const s16x4 f0 = LDG(s16x4, ws, WS_RP + ((cidf * 64 + pf) * 64 + 16 * ks + 4 * hi) * 2), f1 = LDG(s16x4, ws, WS_RP + ((cidf * 64 + pf) * 64 + 16 * ks + 8 + 4 * hi) * 2);
        const s16x4 b0_ = LDG(s16x4, ws, WS_RP + ((cidb * 64 + pb_) * 64 + 16 * ks + 4 * hi) * 2), b1_ = LDG(s16x4, ws, WS_RP + ((cidb * 64 + pb_) * 64 + 16 * ks + 8 + 4 * hi) * 2);
        const bf16x8 af = {f0[0], f0[1], f0[2], f0[3], f1[0], f1[1], f1[2], f1[3]}, ab = {b0_[0], b0_[1], b0_[2], b0_[3], b1_[0], b1_[1], b1_[2], b1_[3]};
#pragma unroll
        for (int ib = 0; ib < 2; ++ib) { acc[ib] = MFMA32(af, LDG(bf16x8, ws, WS_RH + cidf * 8192 + (ib * 4 + ks) * 1024 + lane * 16), acc[ib]);
            acc[ib] = MFMA32(ab, LDG(bf16x8, ws, WS_RH + cidb * 8192 + (ib * 4 + ks) * 1024 + lane * 16), acc[ib]); } }
    const float g0 = LDG(float, INP(27), (l * 384 + h * 64 + r32) * 4), g1 = LDG(float, INP(27), (l * 384 + h * 64 + 32 + r32) * 4), b0 = LDG(float, INP(28), (l * 384 + h * 64 + r32) * 4), b1 = LDG(float, INP(28), (l * 384 + h * 64 + 32 + r32) * 4);
    const int xl = (lane ^ 16) << 2;
#pragma unroll
    for (int r = 0; r < 16; ++r) { const unsigned tok = tok0 + (r & 3) + 8 * (r >> 2) + 4 * hi; const unsigned e = tok * 384 + h * 64 + r32;
        const float bon = LDG(float, ws, WS_SB + (tok * 8 + h) * 4) + LDG(float, ws, WS_SB + ((M + tok) * 8 + h) * 4);
        const float y0 = acc[0][r] + bon * LDG(float, ws, WS_SV + e * 4), y1 = acc[1][r] + bon * LDG(float, ws, WS_SV + (e + 32) * 4);
        float s = allreduce16(y0 + y1); s += __builtin_bit_cast(float, __builtin_amdgcn_ds_bpermute(xl, __builtin_bit_cast(int, s)));
        const float mu = s * (1.f / 64.f), d0 = y0 - mu, d1 = y1 - mu;
        float q = allreduce16(d0 * d0 + d1 * d1); q += __builtin_bit_cast(float, __builtin_amdgcn_ds_bpermute(xl, __builtin_bit_cast(int, q)));
        const float rs = rsqrtf(q * (1.f / 64.f) + 64e-5f);
        const float o0 = (d0 * rs * g0 + b0) * bf_lo((unsigned)LDG(bf16_t, ws, WS_G + e * 2)), o1 = (d1 * rs * g1 + b1) * bf_lo((unsigned)LDG(bf16_t, ws, WS_G + (e + 32) * 2));
        const unsigned pk = pk2(o0, o1);
        STG(bf16_t, F.ws, WS_ACT + (tok * DM + 640 + h * 64 + r32) * 2) = (bf16_t)(pk & 0xffff); STG(bf16_t, F.ws, WS_ACT + (tok * DM + 640 + h * 64 + 32 + r32) * 2) = (bf16_t)(pk >> 16); }
}

constexpr int AU_R = 8, AU_D = 4, AU_SLOT = 6144;
__device__ __forceinline__ void attn_b_unit(Frame& F, int l, int unit) {
    int lane = F.lane; asm volatile("" : "+v"(lane));
    const unsigned char* ws = F.ws; LAS unsigned char* lds = F.lds;
    const int w = F.wave; const unsigned r32 = lane & 31, hi = lane >> 5;
    const unsigned kh = unit & 1, qb = (unit >> 1) & 15, mp = (unit >> 5) & 1, h = (unit >> 6) & 3, b = unit >> 8;
    const unsigned seq0 = MC + b * 4096, row = seq0 + qb * 256 + 32 * w + r32;
    bf16x8 qf[1][2];
#pragma unroll
    for (int s = 0; s < 2; ++s) qf[0][s] = LDG(bf16x8, ws, WS_QB + (row * 256 + h * 64 + mp * 32 + 8 * hi) * 2 + 32 * s);
    AttnQ st[1]; attnq_init(st[0], 0.f);
    const int qpos[1] = {0};
    const int n0 = kh ? 56 : 72, nt = 72;
    const unsigned pofs = (w < 2 ? (h * 2 + mp) * 2048 + w * 1024 : h * 4096 + (w - 2) * 1024) + lane * 16;
    const unsigned base0 = (w < 2 ? WS_KB : WS_VTB) + ((seq0 >> 5) + (kh ? 72u : 0u)) * 16384 + pofs;
    const unsigned base1 = WS_CACHE + (w < 2 ? 2 * MiB : 4 * MiB) + (b * 4 + l) * 262144 + pofs;
#define AU_DMA(t_) do { const int tt_ = (t_) < nt ? (t_) : nt - 1; const unsigned src_ = tt_ < n0 ? base0 + tt_ * 16384 : base1 + (tt_ - n0) * 16384; \
        __builtin_amdgcn_global_load_lds((const GAS unsigned*)(ws + src_), (LAS unsigned*)(lds + ((t_) % AU_R) * AU_SLOT + w * 1024), 16, 0, 0); } while (0)
    if (w < 6) {
#pragma unroll
        for (int t = 0; t < AU_D; ++t) AU_DMA(t);
    }
    for (int t = 0; t < nt; ++t) {
        if (w < 6) asm volatile("s_waitcnt vmcnt(3)" ::: "memory");
        asm volatile("s_barrier" ::: "memory");
        const LAS unsigned char* sl = lds + (t % AU_R) * AU_SLOT + lane * 16;
        bf16x8 kf[2], vf[4];
        kf[0] = *(const LAS bf16x8*)(sl); kf[1] = *(const LAS bf16x8*)(sl + 1024);
#pragma unroll
        for (int f = 0; f < 4; ++f) vf[f] = *(const LAS bf16x8*)(sl + 2048 + 1024 * f);
        if (w < 6) AU_DMA(t + AU_D);
        attn_block<32, false, 1>(qf, kf, vf, st, t, qpos, 0, hi);
    }
#undef AU_DMA
    asm volatile("s_waitcnt vmcnt(0) lgkmcnt(0)\n\ts_barrier" ::: "memory");
    attn_b_store(F, st[0], mp, kh, row, h, hi);
}

constexpr int Q_BLAT = 2048, Q_ALAT = 1536, Q_BCTX = 1024, Q_ACTX = 768;
constexpr int Q_TOTAL = Q_BLAT + Q_ALAT + Q_BCTX + Q_ACTX;
#ifndef XCD_DEAL
#define XCD_DEAL 0
#endif
__device__ __forceinline__ void phase_mixer(Frame& F, int l, int rep) {
    if (rep == 0 || REP_PART == 0 || REP_PART == 1) {
        const int si = F.bid + F.G * F.wave;
        if (si < 48) rwkv_chain_wave(F, l, true, si >> 1, si & 1);
        else if (si < 48 + 384) rwkv_chain_wave(F, l, false, (si - 48) >> 1, (si - 48) & 1);
    }
    if (rep == 0 || REP_PART == 2 || REP_PART == 4) {
        unsigned* uctr = (unsigned*)(F.ws + WS_CTL) + 64 * (32 + l + 4 * rep);
        LAS int* ubox = (LAS int*)(F.lds + 65536);
        for (;;) {
            if (F.wave == 0 && F.lane == 0) *ubox = (int)atomicAdd(uctr, 1u);
            lds_barrier();
            const int un = __builtin_amdgcn_readfirstlane(*ubox);
            lds_barrier();
            if (un >= 512) break;
            attn_b_unit(F, l, un);
        }
    }
    unsigned* ctr = (unsigned*)(F.ws + WS_CTL) + 64 * (1 + l + 4 * rep);
    if (rep == 0 || REP_PART != 1) for (;;) {
        int it = 0;
        if (F.lane == 0) it = (int)atomicAdd(ctr, 1u);
        it = __builtin_amdgcn_readfirstlane(it) + Q_BLAT;
        if (it >= Q_TOTAL) break;
        if (it < Q_BLAT) { if (rep == 0 || REP_PART == 2 || REP_PART == 4) attn_b_item(F, l, true, it); continue; } it -= Q_BLAT;
        if (it < Q_ALAT) { if (rep == 0 || REP_PART == 2 || REP_PART == 3) attn_a_item(F, l, true, it); continue; } it -= Q_ALAT;
        if (it < Q_BCTX) { if (rep == 0 || REP_PART == 2 || REP_PART == 5) attn_b_item(F, l, false, it); continue; } it -= Q_BCTX;
        if (rep == 0 || REP_PART == 2 || REP_PART == 5) attn_a_item(F, l, false, it);
    }
}

__device__ __forceinline__ void phase_finalize(Frame& F, int l) {
    const unsigned char* ws = F.ws;
    const unsigned lane = F.lane;
    const float lami = 0.8f - 0.6f * __expf(-0.3f * (float)l);
    const float lam = LDG(float, ws, WS_TAB + (TAB_LAM + l) * 4) + lami;
    const float omli = 1.f - lami;
    const float sg = LDG(float, INP(17), (l * 64 + lane) * 4);
    for (unsigned row = F.gw; row < M; row += F.ngw) {
#pragma unroll
        for (int k = 0; k < 4; ++k) { float om[2];
#pragma unroll
            for (int mp = 0; mp < 2; ++mp) { const unsigned o0 = (((mp * 2) * M + row) * 256 + 64 * k + lane) * 2, q0 = ((((mp * 2) * M + row) * 4 + k) * 2) * 4;
                const f32x2 ml0 = LDG(f32x2, ws, WS_ML + q0);
                if (row >= MC) { const f32x2 ml1 = LDG(f32x2, ws, WS_ML + q0 + M * 32); const float ms = fmaxf(ml0[0], ml1[0]), w0 = __builtin_amdgcn_exp2f(ml0[0] - ms), w1 = __builtin_amdgcn_exp2f(ml1[0] - ms);
                    om[mp] = (bf_lo((unsigned)LDG(bf16_t, ws, WS_BO2 + o0)) * w0 + bf_lo((unsigned)LDG(bf16_t, ws, WS_BO2 + o0 + M * 512)) * w1) * __builtin_amdgcn_rcpf(ml0[1] * w0 + ml1[1] * w1); }
                else om[mp] = bf_lo((unsigned)LDG(bf16_t, ws, WS_BO2 + o0)) * __builtin_amdgcn_rcpf(ml0[1]); }
            const float v = om[0] - lam * om[1];
            const float ms = wave_sum(v * v) * (1.f / 64.f);
            STG(bf16_t, F.ws, WS_ACT + (row * DM + 384 + 64 * k + lane) * 2) = (bf16_t)(pk2(v * rsqrtf(ms + 1e-6f) * sg * omli, 0.f) & 0xffff); }
    }
}


typedef unsigned v4u __attribute__((ext_vector_type(4)));
#define XB_TMO      128
#define XB_XCNT(j)  (256  + 64 * (j))
#define XB_XSUB(j)  (1280 + 64 * (j))
#define XB_XGEN(j)  (2304 + 64 * (j))
#define XB_TOP      3328
#define XB_TOPGEN   3392
#define XCD_BAR_WORDS 3456
#define XB_SPIN_CAP (1u << 18)

__device__ __forceinline__ unsigned xb_ld(unsigned* p)              { return __hip_atomic_load(p, __ATOMIC_RELAXED, __HIP_MEMORY_SCOPE_AGENT); }
__device__ __forceinline__ unsigned xb_add(unsigned* p, unsigned v) { return __hip_atomic_fetch_add(p, v, __ATOMIC_RELAXED, __HIP_MEMORY_SCOPE_AGENT); }
__device__ __forceinline__ unsigned xb_xcc_id() { return (unsigned)__builtin_amdgcn_s_getreg((3 << 11) | 20) & 0xFu; }
#define XB_SPIN(cond, bar) do { unsigned _sp = 0; while (cond) { __builtin_amdgcn_s_sleep(1); \
    if ((++_sp & 255u) == 0u) { if (xb_ld(&(bar)[XB_TMO])) break; if (_sp > XB_SPIN_CAP) { atomicAdd(&(bar)[XB_TMO], 1u); break; } } } } while (0)

struct XcdBarrier {
    unsigned* bar; unsigned x;
    volatile LAS unsigned* st;
};

__device__ __forceinline__ XcdBarrier xcd_barrier_post(unsigned* bar, volatile LAS unsigned* st) {
    XcdBarrier b; b.bar = bar; b.x = xb_xcc_id(); b.st = st;
    if (threadIdx.x == 0) (void)xb_add(&bar[XB_XCNT(b.x)], 1u);
    return b;
}
__device__ __forceinline__ void xcd_barrier_complete(unsigned* bar, unsigned x, unsigned& nloc, unsigned& nx) {
    const unsigned G = gridDim.x * gridDim.y * gridDim.z;
    unsigned sum, cnt, mine, sp = 0u;
    for (;;) {
        sum = 0u; cnt = 0u; mine = 0u;
#pragma unroll
        for (unsigned j = 0; j < 16; ++j) { const unsigned c = xb_ld(&bar[XB_XCNT(j)]); sum += c; cnt += (c > 0u) ? 1u : 0u; mine = (j == x) ? c : mine; }
        if (sum == G) break;
        __builtin_amdgcn_s_sleep(1);
        if ((++sp & 255u) == 0u) { if (xb_ld(&bar[XB_TMO])) break; if (sp > XB_SPIN_CAP) { atomicAdd(&bar[XB_TMO], 1u); break; } }
    }
    nloc = mine > 0u ? mine : 1u; nx = cnt > 0u ? cnt : 1u;
}

__device__ __forceinline__ void xcd_barrier(const XcdBarrier& b) {
    asm volatile("s_waitcnt vmcnt(0)" ::: "memory");
    __syncthreads();
    if (threadIdx.x == 0) {
        unsigned* bar = b.bar;
        __builtin_amdgcn_s_waitcnt(0);
        unsigned nloc = b.st[0], nx = b.st[1];
        if (nloc == 0u) { xcd_barrier_complete(bar, b.x, nloc, nx); b.st[0] = nloc; b.st[1] = nx; }
        const unsigned old = xb_add(&bar[XB_XSUB(b.x)], 1u);
        const unsigned gen = old / nloc;
        if (old + 1u == (gen + 1u) * nloc) {
            __builtin_amdgcn_fence(__ATOMIC_RELEASE, "agent");
            asm volatile("s_waitcnt vmcnt(0)" ::: "memory");
            const unsigned og = xb_add(&bar[XB_TOP], 1u);
            const unsigned tg = og / nx;
            if (og + 1u == (tg + 1u) * nx) xb_add(&bar[XB_TOPGEN], 1u);
            else XB_SPIN(xb_ld(&bar[XB_TOPGEN]) == tg, bar);
            __builtin_amdgcn_fence(__ATOMIC_ACQUIRE, "agent");
            xb_add(&bar[XB_XGEN(b.x)], 1u);
            asm volatile("s_waitcnt vmcnt(0)" ::: "memory");
        } else {
            XB_SPIN(xb_ld(&bar[XB_XGEN(b.x)]) == gen, bar);
            __builtin_amdgcn_fence(__ATOMIC_ACQUIRE, "agent");
            asm volatile("s_waitcnt vmcnt(0)" ::: "memory");
        }
    }
    __syncthreads();
}

#ifndef DIS
#define DIS 0
#endif
#ifndef GEMM_MF
#define GEMM_MF 7
#endif
#ifndef REP_PHASE
#define REP_PHASE -1
#define REP_COUNT 1
#endif
constexpr int NEXTRA = (REP_PHASE >= 0 && REP_PHASE < 9) ? REP_COUNT - 1 : 0, NPL = 9 + NEXTRA, NPRE = (REP_PHASE == 100) ? REP_COUNT : 1, NPHASE_RUN = NPRE + 1 + NPL * DEPTH;
__global__ void __launch_bounds__(512, 2) mega(Args a) {
    extern __shared__ __attribute__((aligned(16))) unsigned char lds[];
    Frame F;
    F.lds = (LAS unsigned char*)lds;
    volatile LAS unsigned* bst = (volatile LAS unsigned*)(F.lds + LDS_BYTES - 64);
    if (threadIdx.x < 2) bst[threadIdx.x] = 0u;
    __syncthreads();
    const XcdBarrier xbar = xcd_barrier_post((unsigned*)((GAS unsigned char*)a.ws + WS_CTL) + 4096, bst);
    const int wave_id = __builtin_amdgcn_readfirstlane((int)threadIdx.x >> 6);
    for (int ph = a.ph_lo; ph < a.ph_hi; ++ph) {
        { const unsigned char* kp = (const unsigned char*)__builtin_amdgcn_kernarg_segment_ptr(); asm volatile("" : "+s"(kp));
          const Args* ap = (const Args*)kp; F.in = ap->in; F.out = gptr(ap->out); F.ws = gptr(ap->ws); }
        { unsigned ones = ~0u; asm volatile("" : "+s"(ones)); int ln = (int)__builtin_amdgcn_mbcnt_hi(ones, __builtin_amdgcn_mbcnt_lo(ones, 0u)); int wv = wave_id, bid = (int)blockIdx.x, gg = (int)gridDim.x; asm volatile("" : "+s"(wv), "+s"(bid), "+s"(gg));
          F.lane = ln; F.wave = wv; F.bid = bid; F.G = gg; F.ngw = gg * 8; F.tid = wv * 64 + ln; F.gw = bid * 8 + wv; }
        if (ph < NPRE) { if (!(DIS & 1)) phase_prologue(F); }
        else if (ph == NPHASE_RUN - 1) { if (!(DIS & 2)) phase_final_norm(F); }
        else {
            const int l = (ph - NPRE) / NPL, sidx = (ph - NPRE) % NPL, rep = (REP_PHASE >= 0 && REP_PHASE < 9 && sidx > REP_PHASE && sidx <= REP_PHASE + NEXTRA) ? sidx - REP_PHASE : 0, s = (REP_PHASE >= 0 && REP_PHASE < 9 && sidx > REP_PHASE) ? (sidx <= REP_PHASE + NEXTRA ? REP_PHASE : sidx - NEXTRA) : sidx;
            if (s == 0) { convert_weights(F, l); phase_norm(F, l, 0); }
            else if (s == 1) {
                pg8::Gemm g{WSP(bf16_t, WS_ACT), WSP(bf16_t, WS_WIN + 0u * WSET_STRIDE), M, NIN, 1024}; pg8::StaticOrder S; S.init(M, NIN, F.G, F.bid, (GEMM_MF & 1) ? 192 : 256);
                EpiWin E{F.ws, F.out, l};
                if (!(DIS & 16)) pg8::gemm_phase<EpiWin, pg8::StaticOrder, false, true, (GEMM_MF & 1) ? 3 : 4>(F.lds, g, S, E, F.tid);
                if (false) { const int wv_ = (F.bid - 64) * 8 + F.wave; convert_item_any(F, l + 1, wv_); if (wv_ < CV_TOTAL - 1536) convert_item_any(F, l + 1, 1536 + wv_); }
            }
            else if (s == 2) { for (int cid = F.bid; cid < NCHUNK; cid += F.G) rwkv_chunk_block(F, l, cid); }
            else if (s == 3) { if (!(DIS & 64)) phase_mixer(F, l, rep); }
            else if (s == 4) { phase_finalize(F, l); for (int it = F.gw; it < 192 * 12; it += F.ngw) rwkv_out_item(F, l, it); }
            else if (s == 5 || s == 8) {
                const bool second = s == 8;
                pg8::Gemm g{second ? WSP(bf16_t, WS_U) : WSP(bf16_t, WS_ACT), second ? WSP(bf16_t, WS_W2 + 0u * WSET_STRIDE) : WSP(bf16_t, WS_WOUT + 0u * WSET_STRIDE), M, 1024, second ? FF : 1024};
                pg8::StaticOrder S; S.init(M, 1024, F.G, F.bid, (GEMM_MF & 2) ? 192 : 256);
                const bool first = (l == 0 && !second);
                EpiRes E{INP(0), INP(1) - (size_t)MC * DM, F.ws, WSP(float, WS_MOD) + (size_t)l * 3 * 6144 + (second ? 5120 : 2048), first};
                if (!(DIS & 256)) pg8::gemm_phase<EpiRes, pg8::StaticOrder, false, true, (GEMM_MF & 2) ? 3 : 4>(F.lds, g, S, E, F.tid);
            }
            else if (s == 6) { if (!(DIS & 8)) phase_norm(F, l, 1); }
            else {
                pg8::Gemm g{WSP(bf16_t, WS_ACT), WSP(bf16_t, WS_W13 + 0u * WSET_STRIDE), M, NFF2, 1024}; pg8::StaticOrder S; S.init(M, NFF2, F.G, F.bid, (GEMM_MF & 4) ? 192 : 256);
                EpiSwi E{WSP(bf16_t, WS_U)};
                if (!(DIS & 512)) pg8::gemm_phase<EpiSwi, pg8::StaticOrder, true, true, (GEMM_MF & 4) ? 3 : 4>(F.lds, g, S, E, F.tid);
            }
        }
        if (ph + 1 < a.ph_hi) { if (ph == a.ph_lo) { __threadfence(); cg::this_grid().sync(); } else xcd_barrier(xbar); }
    }
}

extern "C" void kernel_launch(void* const* d_in, const int* in_sizes, int n_in, void* d_out, int out_size, void* d_ws, size_t ws_size, hipStream_t stream) {
    static int grid = 0;
    if (grid == 0) {
        int dev = 0, cus = 0, per_cu = 0;
        if (n_in != 34 || ws_size < WS_END) { fprintf(stderr, "kernel_launch: unexpected n_in %d / ws_size %zu (need %zu)\n", n_in, ws_size, (size_t)WS_END); grid = -1; return; }
        if (hipGetDevice(&dev) != hipSuccess || hipDeviceGetAttribute(&cus, hipDeviceAttributeMultiprocessorCount, dev) != hipSuccess) { grid = -1; return; }
        if (hipFuncSetAttribute((const void*)mega, hipFuncAttributeMaxDynamicSharedMemorySize, LDS_BYTES) != hipSuccess) { fprintf(stderr, "kernel_launch: hipFuncSetAttribute failed\n"); grid = -1; return; }
        if (hipOccupancyMaxActiveBlocksPerMultiprocessor(&per_cu, (const void*)mega, 512, LDS_BYTES) != hipSuccess || per_cu < 1) { fprintf(stderr, "kernel_launch: occupancy query says %d\n", per_cu); per_cu = 1; }
        (void)hipGetLastError();
        grid = cus * 1;
        if (grid > cus * per_cu) grid = cus * per_cu;
    }
    if (grid < 0) return;
    (void)hipMemsetAsync((char*)d_ws + WS_CTL, 0, CTL_BYTES, stream);
    Args a{};
    for (int i = 0; i < 34; ++i) a.in[i] = (const float*)d_in[i];
    a.out = (float*)d_out; a.ws = (unsigned char*)d_ws;
#if MK_ONE_LAUNCH
    a.ph_lo = 0; a.ph_hi = NPHASE_RUN;
    void* args[] = {&a};
    hipError_t e = hipLaunchCooperativeKernel((const void*)mega, dim3(grid), dim3(512), args, LDS_BYTES, stream);
    if (e != hipSuccess) fprintf(stderr, "kernel_launch: cooperative launch failed: %s (grid %d)\n", hipGetErrorString(e), grid);
#else
    for (int ph = 0; ph < NPHASE_RUN; ++ph) { a.ph_lo = ph; a.ph_hi = ph + 1; hipLaunchKernelGGL(mega, dim3(grid), dim3(512), LDS_BYTES, stream, a); }
#endif
}
```

```cpp
#include <hip/hip_runtime.h>
#include <hip/hip_cooperative_groups.h>
#include <cstdio>
#include <cstdint>
namespace cg = cooperative_groups;

#ifndef MK_ONE_LAUNCH
#define MK_ONE_LAUNCH 1
#endif

#undef MK_ONE_LAUNCH
#define MK_ONE_LAUNCH 1
#define REP_PHASE -1
#define REP_COUNT 1
#define REP_PART 0
#define RA_REP 0
#define ATT_PROBE 0
namespace pg8 {
#define PG8_LAS __attribute__((address_space(3)))
typedef unsigned short bf16_t;
typedef short bf16x8 __attribute__((ext_vector_type(8)));
typedef float f32x4 __attribute__((ext_vector_type(4)));
typedef unsigned u32x4 __attribute__((ext_vector_type(4)));
constexpr int BM = 256, BK = 64, HALF = 128, HTB = HALF * BK * 2  , STAGE_BYTES = 8 * HTB, NXCD = 8, WGM = 8;

__host__ __device__ __forceinline__ int lds_byte(int r, int c) { const int st = (r >> 4) * 2 + (c >> 5), rr = r & 15, cc = c & 31, ob = rr * 64 + cc * 2; return st * 1024 + (ob ^ (((ob >> 9) & 1) << 5)); }
__host__ __device__ __forceinline__ void stage_rc(int b, int& R, int& C) { const int st = b / 1024, sb = b % 1024, swz = sb ^ (((sb >> 9) & 1) << 5); R = (st >> 1) * 16 + swz / 64; C = (st & 1) * 32 + (swz % 64) / 2; }
__host__ __device__ __forceinline__ int perm32(int rho) { const int n = rho >> 4, i = rho & 15; return 8 * (i >> 2) + 4 * n + (i & 3); }

struct Unit { int pm, pn; };
struct Gemm { const bf16_t* A; const bf16_t* Bt; int M, N, K; };

struct StaticOrder {
    int nM, nN, nwg, G, c;
    __host__ __device__ void init(int M, int N, int G_, int c_, int bm = BM) { nM = M / bm; nN = N / BM; nwg = nM * nN; G = G_; c = c_; }
    __host__ __device__ bool next(int i, Unit& u) const {
        const long L = (long)i * G + c; if (L >= nwg) return false;
        int wgid = (int)L; { const int q = nwg / NXCD, r = nwg % NXCD, xcd = wgid % NXCD, off = wgid / NXCD; wgid = (xcd < r ? xcd * (q + 1) : r * (q + 1) + (xcd - r) * q) + off; }
        const int nig = WGM * nN, gid = wgid / nig, fm = gid * WGM, gsz = (nM - fm) < WGM ? (nM - fm) : WGM;
        u.pm = fm + ((wgid % nig) % gsz); u.pn = (wgid % nig) / gsz; return true;
    }
    __device__ __forceinline__ void a_ready(const Unit&) const {}
    __device__ __forceinline__ void done(const Unit&) const {}
};

template <class Epi, class Sched, bool ALIGN_EPI = false, bool SP2 = false, int MF = 4>
__device__ __forceinline__ void gemm_phase(PG8_LAS unsigned char* lds, const Gemm g, const Sched& S, const Epi& E, const int tid_in) {
    const int tid = tid_in, wid = __builtin_amdgcn_readfirstlane(tid >> 6), lane = tid & 63, wr = wid >> 2, wc = wid & 3, fr = lane & 15, fq = lane >> 4;
    static_assert(MF == 4 || (MF == 3 && SP2), "192-row tiles: SP2 schedule only");
    const int K = g.K, nt = K / BK;
    unsigned voffA[2], voffB[2];
#pragma unroll
    for (int i = 0; i < 2; ++i) { int R, C; stage_rc(tid * 16 + i * 8192, R, C); const int Rb = Epi::PERM ? ((R & ~31) + perm32(R & 31)) : R;
        voffA[i] = (unsigned)(R * K + C) * 2u; voffB[i] = (unsigned)(Rb * K + C) * 2u; }
    const size_t kstep = (size_t)(BK * 2);
    const size_t hstep = (size_t)HALF * K * 2;
    const size_t tstep = 2 * hstep;
    const size_t hstepA = (size_t)(MF * 32) * K * 2, tstepA = 2 * hstepA;
    const unsigned ldsw = (unsigned)wid * 1024u;
    const int aoff = lds_byte(wr * (MF * 16) + fr, fq * 8), boff = lds_byte(wc * 32 + fr, fq * 8);
#define PG8_SA(b, h) (((b) * 2 + (h)) * HTB)
#define PG8_SB(b, h) ((4 + (b) * 2 + (h)) * HTB)
#define PG8_STAGE(bufoff, gbase, voff) do { _Pragma("unroll") for (int _i = 0; _i < 2; ++_i) \
        __builtin_amdgcn_global_load_lds((const unsigned*)((const char*)(gbase) + (voff)[_i]), (PG8_LAS unsigned*)(lds + (bufoff) + ldsw + _i * 8192), 16, 0, 0); } while (0)
#define PG8_STAGEA(bufoff, gbase, voff) do { __builtin_amdgcn_global_load_lds((const unsigned*)((const char*)(gbase) + (voff)[0]), (PG8_LAS unsigned*)(lds + (bufoff) + ldsw), 16, 0, 0); \
        if (MF == 4 || wr == 0) __builtin_amdgcn_global_load_lds((const unsigned*)((const char*)(gbase) + (voff)[1]), (PG8_LAS unsigned*)(lds + (bufoff) + ldsw + 8192), 16, 0, 0); } while (0)
#define PG8_LDA(dst, b, h) do { _Pragma("unroll") for (int m = 0; m < MF; ++m) _Pragma("unroll") for (int k = 0; k < 2; ++k) dst[m][k] = *(const PG8_LAS bf16x8*)(lds + PG8_SA(b, h) + aoff + m * 2048 + k * 1024); } while (0)
#define PG8_LDB(dst, b, h) do { _Pragma("unroll") for (int n = 0; n < 2; ++n) _Pragma("unroll") for (int k = 0; k < 2; ++k) dst[n][k] = *(const PG8_LAS bf16x8*)(lds + PG8_SB(b, h) + boff + n * 2048 + k * 1024); } while (0)
#define PG8_MMA(ai, bj, At, Bt) do { __builtin_amdgcn_s_setprio(1); _Pragma("unroll") for (int m = 0; m < MF; ++m) _Pragma("unroll") for (int n = 0; n < 2; ++n) _Pragma("unroll") for (int k = 0; k < 2; ++k) \
        acc[ai][bj][m][n] = __builtin_amdgcn_mfma_f32_16x16x32_bf16(Bt[n][k], At[m][k], acc[ai][bj][m][n], 0, 0, 0); __builtin_amdgcn_s_setprio(0); } while (0)
#define PG8_WAIT_V(n) asm volatile("s_waitcnt vmcnt(" #n ")" ::: "memory")
#define PG8_WAIT_V2(a, b) do { if (MF == 4 || wr == 0) asm volatile("s_waitcnt vmcnt(" #a ")" ::: "memory"); else asm volatile("s_waitcnt vmcnt(" #b ")" ::: "memory"); } while (0)
#define PG8_WAIT_L(n) asm volatile("s_waitcnt lgkmcnt(" #n ")" ::: "memory")
#define PG8_BAR __builtin_amdgcn_s_barrier()
#define PG8_SCHED __builtin_amdgcn_sched_barrier(0)
    Unit cur, nxt; int ui = 0;
    if (!S.next(0, cur)) return;
    f32x4 acc[2][2][MF][2];
#pragma unroll
    for (int a = 0; a < 2; ++a)
#pragma unroll
        for (int b = 0; b < 2; ++b)
#pragma unroll
            for (int m = 0; m < MF; ++m)
#pragma unroll
                for (int n = 0; n < 2; ++n) acc[a][b][m][n] = (f32x4){0.f, 0.f, 0.f, 0.f};
    bf16x8 At[MF][2], B0[2][2], B1[2][2];
#define PG8_SGPR64(p) ((const char*)(((unsigned long long)(unsigned)__builtin_amdgcn_readfirstlane((int)((unsigned long long)(p) >> 32)) << 32) | (unsigned)__builtin_amdgcn_readfirstlane((int)(unsigned long long)(p))))
    const char* cA = PG8_SGPR64((const char*)g.A + (size_t)cur.pm * tstepA); const char* cB = PG8_SGPR64((const char*)g.Bt + (size_t)cur.pn * tstep);
    S.a_ready(cur);
    if constexpr (SP2) {
        PG8_STAGE(PG8_SB(0, 0), cB, voffB); PG8_STAGE(PG8_SB(0, 1), cB + hstep, voffB); PG8_STAGEA(PG8_SA(0, 0), cA, voffA); PG8_STAGEA(PG8_SA(0, 1), cA + hstepA, voffA);
        if (wr == 1) PG8_BAR;
        PG8_WAIT_V2(2, 1); PG8_BAR;
        PG8_STAGE(PG8_SB(1, 0), cB + kstep, voffB); PG8_STAGEA(PG8_SA(1, 0), cA + kstep, voffA); PG8_STAGE(PG8_SB(1, 1), cB + hstep + kstep, voffB);
        PG8_WAIT_V2(6, 5); PG8_BAR;
    } else {
        PG8_STAGE(PG8_SB(0, 0), cB, voffB); PG8_STAGEA(PG8_SA(0, 0), cA, voffA); PG8_STAGE(PG8_SB(0, 1), cB + hstep, voffB); PG8_STAGEA(PG8_SA(0, 1), cA + hstepA, voffA);
        if (wr == 1) PG8_BAR;
        PG8_WAIT_V(4); PG8_BAR;
        PG8_STAGE(PG8_SB(1, 0), cB + kstep, voffB); PG8_STAGEA(PG8_SA(1, 0), cA + kstep, voffA); PG8_STAGE(PG8_SB(1, 1), cB + hstep + kstep, voffB);
        PG8_WAIT_V(6); PG8_BAR;
    }
    for (;;) {
        const bool has_next = S.next(ui + 1, nxt);
        const char* nA = PG8_SGPR64(has_next ? (const char*)g.A + (size_t)nxt.pm * tstepA : cA); const char* nB = PG8_SGPR64(has_next ? (const char*)g.Bt + (size_t)nxt.pn * tstep : cB);
        for (int t = 0; t < nt; t += 2) {
            const bool last = (t == nt - 2);
            const char* a1 = cA + (size_t)(t + 1) * kstep;
            const char* a2 = last ? nA : cA + (size_t)(t + 2) * kstep; const char* b2 = last ? nB : cB + (size_t)(t + 2) * kstep;
            const char* a3 = a2 + kstep; const char* b3 = b2 + kstep;
            if (last && has_next) S.a_ready(nxt);
            if constexpr (SP2) {
            PG8_LDB(B0, 0, 0); PG8_LDB(B1, 0, 1); PG8_SCHED; PG8_LDA(At, 0, 0); PG8_STAGEA(PG8_SA(1, 1), a1 + hstepA, voffA);
            PG8_WAIT_V2(8, 6); PG8_WAIT_L(0); PG8_BAR; PG8_MMA(0, 0, At, B0); PG8_MMA(0, 1, At, B1); PG8_BAR; PG8_SCHED;
            PG8_LDA(At, 0, 1); PG8_STAGE(PG8_SB(0, 0), b2, voffB); PG8_STAGE(PG8_SB(0, 1), b2 + hstep, voffB); PG8_STAGEA(PG8_SA(0, 0), a2, voffA);
            PG8_WAIT_V2(8, 6); PG8_WAIT_L(0); PG8_BAR; PG8_MMA(1, 0, At, B0); PG8_MMA(1, 1, At, B1); PG8_BAR; PG8_SCHED;
            PG8_LDB(B0, 1, 0); PG8_LDB(B1, 1, 1); PG8_SCHED; PG8_LDA(At, 1, 0); PG8_STAGEA(PG8_SA(0, 1), a2 + hstepA, voffA);
            PG8_WAIT_V2(8, 6); PG8_WAIT_L(0); PG8_BAR; PG8_MMA(0, 0, At, B0); PG8_MMA(0, 1, At, B1); PG8_BAR; PG8_SCHED;
            PG8_LDA(At, 1, 1); PG8_STAGE(PG8_SB(1, 0), b3, voffB); PG8_STAGE(PG8_SB(1, 1), b3 + hstep, voffB); PG8_STAGEA(PG8_SA(1, 0), a3, voffA);
            PG8_WAIT_V2(8, 6); PG8_WAIT_L(0); PG8_BAR; PG8_MMA(1, 0, At, B0); PG8_MMA(1, 1, At, B1); PG8_BAR; PG8_SCHED;
            } else {
            PG8_LDB(B0, 0, 0); PG8_SCHED; PG8_LDA(At, 0, 0); PG8_STAGEA(PG8_SA(1, 1), a1 + hstepA, voffA);
            PG8_WAIT_L(8); PG8_BAR; PG8_WAIT_L(0); PG8_MMA(0, 0, At, B0); PG8_BAR; PG8_SCHED;
            PG8_LDB(B1, 0, 1); PG8_STAGE(PG8_SB(0, 0), b2, voffB);
            PG8_BAR; PG8_WAIT_L(0); PG8_MMA(0, 1, At, B1); PG8_BAR;
            PG8_LDA(At, 0, 1); PG8_STAGEA(PG8_SA(0, 0), a2, voffA);
            PG8_BAR; PG8_WAIT_L(0); PG8_MMA(1, 0, At, B0); PG8_BAR; PG8_SCHED;
            PG8_STAGE(PG8_SB(0, 1), b2 + hstep, voffB);
            PG8_WAIT_V(6); PG8_BAR; PG8_MMA(1, 1, At, B1); PG8_BAR;
            PG8_LDB(B0, 1, 0); PG8_SCHED; PG8_LDA(At, 1, 0); PG8_STAGEA(PG8_SA(0, 1), a2 + hstepA, voffA);
            PG8_WAIT_L(8); PG8_BAR; PG8_WAIT_L(0); PG8_MMA(0, 0, At, B0); PG8_BAR; PG8_SCHED;
            PG8_LDB(B1, 1, 1); PG8_STAGE(PG8_SB(1, 0), b3, voffB);
            PG8_BAR; PG8_WAIT_L(0); PG8_MMA(0, 1, At, B1); PG8_BAR;
            PG8_LDA(At, 1, 1); PG8_STAGEA(PG8_SA(1, 0), a3, voffA);
            PG8_BAR; PG8_WAIT_L(0); PG8_MMA(1, 0, At, B0); PG8_BAR; PG8_SCHED;
            PG8_STAGE(PG8_SB(1, 1), b3 + hstep, voffB);
            PG8_WAIT_V(6); PG8_BAR; PG8_MMA(1, 1, At, B1); PG8_BAR;
            }
        }
        if constexpr (ALIGN_EPI) { if (wr == 0) PG8_BAR; }
        if constexpr (!Epi::AFTER_DRAIN) { E.template operator()<MF>(acc, cur, wr, wc, fr, fq); S.done(cur); }
        if (!has_next) break;
#pragma unroll
        for (int a = 0; a < 2; ++a)
#pragma unroll
            for (int b = 0; b < 2; ++b)
#pragma unroll
                for (int m = 0; m < MF; ++m)
#pragma unroll
                    for (int n = 0; n < 2; ++n) acc[a][b][m][n] = (f32x4){0.f, 0.f, 0.f, 0.f};
        cur = nxt; cA = nA; cB = nB; ++ui;
        if constexpr (ALIGN_EPI) { if (wr == 1) PG8_BAR; }
    }
    PG8_WAIT_V(0);
    if constexpr (!ALIGN_EPI) { if (wr == 0) PG8_BAR; }
    PG8_BAR;
    if constexpr (Epi::AFTER_DRAIN) { E.fused(acc, cur, wr, wc, fr, fq, lds, wid, lane); S.done(cur); }
#undef PG8_SA
#undef PG8_SB
#undef PG8_STAGE
#undef PG8_STAGEA
#undef PG8_WAIT_V2
#undef PG8_LDA
#undef PG8_LDB
#undef PG8_MMA
#undef PG8_WAIT_V
#undef PG8_WAIT_L
#undef PG8_BAR
#undef PG8_SCHED
}
}

using pg8::bf16_t; using pg8::bf16x8; using pg8::f32x4; using pg8::u32x4;
typedef float f32x16 __attribute__((ext_vector_type(16)));
typedef float f32x2 __attribute__((ext_vector_type(2)));
typedef short s16x4 __attribute__((ext_vector_type(4)));
typedef unsigned u32x2 __attribute__((ext_vector_type(2)));
typedef __bf16 bf16x2_t __attribute__((ext_vector_type(2)));
#define LAS __attribute__((address_space(3)))
#define LDG(T, base, boff) (*(const __attribute__((address_space(1))) T*)((const __attribute__((address_space(1))) unsigned char*)(base) + (unsigned)(boff)))
#define STG(T, base, boff) (*(__attribute__((address_space(1))) T*)((__attribute__((address_space(1))) unsigned char*)(base) + (unsigned)(boff)))

__device__ __forceinline__ unsigned pk2(float lo, float hi) { f32x2 v = {lo, hi}; bf16x2_t b = __builtin_convertvector(v, bf16x2_t); return __builtin_bit_cast(unsigned, b); }
__device__ __forceinline__ float bf_lo(unsigned u) { return __uint_as_float(u << 16); }
__device__ __forceinline__ float bf_hi(unsigned u) { return __uint_as_float(u & 0xffff0000u); }
__device__ __forceinline__ f32x4 unpack4(u32x2 v) { return (f32x4){bf_lo(v.x), bf_hi(v.x), bf_lo(v.y), bf_hi(v.y)}; }
__device__ __forceinline__ u32x2 pack4(f32x4 v) { u32x2 r; r.x = pk2(v[0], v[1]); r.y = pk2(v[2], v[3]); return r; }
__device__ __forceinline__ float sigmf(float x) { return __builtin_amdgcn_rcpf(1.f + __expf(-x)); }
template <int CTRL> __device__ __forceinline__ float dpp_f(float x) { return __builtin_bit_cast(float, __builtin_amdgcn_update_dpp(0, __builtin_bit_cast(int, x), CTRL, 0xF, 0xF, true)); }
__device__ __forceinline__ float allreduce16(float x) { x += dpp_f<0xB1>(x); x += dpp_f<0x4E>(x); x += dpp_f<0x141>(x); x += dpp_f<0x140>(x); return x; }
__device__ __forceinline__ float rdlane(float x, int l) { return __builtin_bit_cast(float, __builtin_amdgcn_readlane(__builtin_bit_cast(int, x), l)); }
__device__ __forceinline__ float wave_sum(float v) {
    v = allreduce16(v);
    return (rdlane(v, 0) + rdlane(v, 16)) + (rdlane(v, 32) + rdlane(v, 48));
}
__device__ __forceinline__ float swap32_sum(float x) { auto rr = __builtin_amdgcn_permlane32_swap(__float_as_uint(x), __float_as_uint(x), false, false); return __uint_as_float(rr[0]) + __uint_as_float(rr[1]); }
__device__ __forceinline__ float swap32_max(float x) { auto rr = __builtin_amdgcn_permlane32_swap(__float_as_uint(x), __float_as_uint(x), false, false); return fmaxf(__uint_as_float(rr[0]), __uint_as_float(rr[1])); }

constexpr int M = 12288, MC = 4096, DM = 1024, NIN = 3072, FF = 2816, NFF2 = 5632, DEPTH = 4;
constexpr float LOG2E = 1.4426950408889634f;
constexpr float QSCALE_A = 0.125f * LOG2E;
constexpr float QSCALE_B = 0.17677669529663687f * LOG2E;
constexpr unsigned OFF_AK = 12582912, OFF_AV = 14680064, OFF_BK = 16777216, OFF_BV = 20971520, OFF_CF = 25165824, OFF_CB = 26738688;
constexpr unsigned MiB = 1u << 20;
constexpr unsigned WS_CTL = 0, CTL_BYTES = 1 * MiB;
constexpr unsigned WS_MOD = 1 * MiB;
constexpr unsigned WS_TAB = 1 * MiB + 512 * 1024;
constexpr unsigned WS_SMALLW = 2 * MiB;
constexpr unsigned WS_CACHE = 4 * MiB;
constexpr unsigned WS_WIN = 10 * MiB, WS_WOUT = 16 * MiB, WS_W13 = 18 * MiB, WS_W2 = 29 * MiB;
constexpr unsigned WSET_STRIDE = 184 * MiB;
constexpr unsigned WS_ACT = 35 * MiB;
constexpr unsigned WS_QA = 59 * MiB, WS_KA = 68 * MiB, WS_VTA = 71 * MiB, WS_QB = 74 * MiB, WS_KB = 80 * MiB, WS_VTB = 86 * MiB;
constexpr unsigned WS_RKV = 92 * MiB, WS_CW = 119 * MiB, WS_CA = 122 * MiB, WS_CG = 125 * MiB;
constexpr unsigned WS_YF = 128 * MiB, WS_YB = 146 * MiB;
constexpr unsigned WS_SV = 164 * MiB;
constexpr unsigned WS_BO2 = 182 * MiB, WS_ML = 230 * MiB;
constexpr unsigned WS_XB = 206 * MiB;
constexpr unsigned WS_WSET1 = 194 * MiB;
constexpr unsigned WS_RM = 236 * MiB, WS_RN = 254 * MiB, WS_RP = 324 * MiB, WS_RH = 342 * MiB;
constexpr int NCHUNK = 2304;
constexpr unsigned WS_U = 128 * MiB;
constexpr unsigned WS_G = 290 * MiB, WS_SB = 299 * MiB, WS_BO = 300 * MiB, WS_END = 360 * MiB;
constexpr int SMALLW_L = 147456;
constexpr int TAB_COSA = 0, TAB_SINA = 1024, TAB_COSB = 2048, TAB_SINB = 2560, TAB_LAM = 3072;
constexpr int LDS_BYTES = 147456;
constexpr int NPHASE = 2 + 9 * DEPTH;

struct Args {
    const float* in[34];
    float* out; unsigned char* ws;
    int ph_lo, ph_hi;
};

struct EpiRes {
    static constexpr bool PERM = true, AFTER_DRAIN = false;
    const float* baseC; const float* baseL; unsigned char* ws; const float* gate; bool first;
    template <int MF>
    __device__ __forceinline__ void operator()(const f32x4 (&acc)[2][2][MF][2], const pg8::Unit& u, int wr, int wc, int fr_, int fq_) const {
        int fr = fr_, fq = fq_; asm volatile("" : "+v"(fr), "+v"(fq));
        const unsigned col0 = u.pn * 256 + wc * 32 + 8 * fq, rowb = u.pm * (MF * 64) + wr * (MF * 16);
        f32x4 g4[2][2]; int vcur = -1;
#pragma unroll
        for (int ai = 0; ai < 2; ++ai)
#pragma unroll
            for (int m = 0; m < MF; ++m) { const unsigned rf = rowb + ai * (MF * 32) + m * 16, off = (rf + fr) * DM + col0;
                const int v = rf < MC ? 0 : (rf < MC + 4096 ? 1 : 2);
                if (v != vcur) { vcur = v;
#pragma unroll
                    for (int bj = 0; bj < 2; ++bj)
#pragma unroll
                        for (int n = 0; n < 2; ++n) g4[bj][n] = LDG(f32x4, gate, (v * 6144 + col0 + bj * 128 + n * 4) * 4); }
#pragma unroll
                for (int bj = 0; bj < 2; ++bj) { f32x4 b0, b1;
                    if (first) { const float* base = rf < MC ? baseC : baseL; b0 = LDG(f32x4, base, (off + bj * 128) * 4); b1 = LDG(f32x4, base, (off + bj * 128 + 4) * 4); }
                    else { const u32x4 xb = LDG(u32x4, ws, WS_XB + (off + bj * 128) * 2); b0 = (f32x4){bf_lo(xb.x), bf_hi(xb.x), bf_lo(xb.y), bf_hi(xb.y)}; b1 = (f32x4){bf_lo(xb.z), bf_hi(xb.z), bf_lo(xb.w), bf_hi(xb.w)}; }
                    b0 = b0 + g4[bj][0] * acc[ai][bj][m][0]; b1 = b1 + g4[bj][1] * acc[ai][bj][m][1];
                    u32x4 w; w.x = pk2(b0[0], b0[1]); w.y = pk2(b0[2], b0[3]); w.z = pk2(b1[0], b1[1]); w.w = pk2(b1[2], b1[3]);
                    STG(u32x4, ws, WS_XB + (off + bj * 128) * 2) = w; } }
    }
};
struct EpiSwi {
    static constexpr bool PERM = true, AFTER_DRAIN = false;
    bf16_t* U;
    template <int MF>
    __device__ __forceinline__ void operator()(const f32x4 (&acc)[2][2][MF][2], const pg8::Unit& u, int wr, int wc, int fr_, int fq_) const {
        int fr = fr_, fq = fq_; asm volatile("" : "+v"(fr), "+v"(fq));
        const unsigned row0 = u.pm * (MF * 64) + wr * (MF * 16) + fr, oc0 = u.pn * 128 + wc * 16 + 4 * fq;
#pragma unroll
        for (int ai = 0; ai < 2; ++ai)
#pragma unroll
            for (int m = 0; m < MF; ++m) { const unsigned ro = ((row0 + ai * (MF * 32) + m * 16) * FF + oc0) * 2;
#pragma unroll
                for (int bj = 0; bj < 2; ++bj) { const f32x4 g = acc[ai][bj][m][0], up = acc[ai][bj][m][1]; f32x4 o;
#pragma unroll
                    for (int e = 0; e < 4; ++e) o[e] = g[e] * sigmf(g[e]) * up[e];
                    STG(u32x2, U, ro + bj * 128) = pack4(o); } asm volatile("" ::: "memory"); }
    }
};
struct EpiWin {
    static constexpr bool PERM = true, AFTER_DRAIN = false;
    unsigned char* ws; float* out; int l;
    template <int MF>
    __device__ __forceinline__ void operator()(const f32x4 (&acc)[2][2][MF][2], const pg8::Unit& u, int wr, int wc, int fr_, int fq_) const {
        int fr = fr_, fq = fq_; asm volatile("" : "+v"(fr), "+v"(fq));
        const unsigned rowb = u.pm * (MF * 64) + wr * (MF * 16), row0 = rowb + fr;
#pragma unroll
        for (int bj = 0; bj < 2; ++bj) {
            const unsigned c32 = u.pn * 256 + bj * 128 + wc * 32;
            const unsigned c8 = c32 + 8 * fq;
            if (c32 < 1152 && (c32 < 512 || c32 >= 640)) {
                const bool isA = c32 < 512;
                const bool isK = isA ? (c32 >= 384) : (c32 >= 896);
                const float qs = isK ? 1.f : (isA ? QSCALE_A : QSCALE_B);
                const unsigned ck = isA ? c8 - 384 : c8 - 896;
                const unsigned dbase = isA ? (isK ? WS_KA + (((ck >> 6) * 4 + ((ck & 63) >> 4)) * 64 + ((ck >> 3) & 1) * 32) * 16 : WS_QA + c8 * 2)
                                           : (isK ? WS_KB + (((ck >> 5) * 2 + ((ck & 31) >> 4)) * 64 + ((ck >> 3) & 1) * 32) * 16 : WS_QB + (c8 - 640) * 2);
                const unsigned dpitch = isA ? 768u : 512u;
#pragma unroll
                for (int ai = 0; ai < 2; ++ai)
#pragma unroll
                    for (int m = 0; m < MF; ++m) {
                        const unsigned row = row0 + ai * (MF * 32) + m * 16; const bool lat = rowb + ai * (MF * 32) + m * 16 >= (unsigned)MC;
                        f32x4 v0 = acc[ai][bj][m][0], v1 = acc[ai][bj][m][1];
                        if (lat) {
                            const unsigned t = (row - MC) & 4095, rp = t >> 6, cp = t & 63;
                            unsigned to_;
                            if (isA) { const unsigned pos = ((c32 >> 5) & 1) ? cp : rp; to_ = WS_TAB + (TAB_COSA + pos * 16 + 4 * fq) * 4; }
                            else { const unsigned pos = (fq >> 1) ? cp : rp; to_ = WS_TAB + (TAB_COSB + pos * 8 + 4 * (fq & 1)) * 4; }
                            const f32x4 c4 = LDG(f32x4, ws, to_), s4 = LDG(f32x4, ws, to_ + (isA ? 4096u : 2048u));
                            f32x4 w0, w1;
                            w0[0] = v0[0] * c4[0] - v0[1] * s4[0]; w0[1] = v0[1] * c4[0] + v0[0] * s4[0];
                            w0[2] = v0[2] * c4[1] - v0[3] * s4[1]; w0[3] = v0[3] * c4[1] + v0[2] * s4[1];
                            w1[0] = v1[0] * c4[2] - v1[1] * s4[2]; w1[1] = v1[1] * c4[2] + v1[0] * s4[2];
                            w1[2] = v1[2] * c4[3] - v1[3] * s4[3]; w1[3] = v1[3] * c4[3] + v1[2] * s4[3];
                            v0 = w0; v1 = w1;
                        } else if (isK) {
                            const unsigned b = row >> 8, t = row & 255;
                            const f32x4 ev = {v0[0], v0[2], v1[0], v1[2]}, od = {v0[1], v0[3], v1[1], v1[3]};
                            if (isA) { const unsigned o = (OFF_AK + ((b * 4 + l) * 256 + t) * 128 + (c32 - 384) + 4 * fq) * 4; STG(f32x4, out, o) = ev; STG(f32x4, out, o + 64) = od; }
                            else { const unsigned o = (OFF_BK + ((b * 4 + l) * 256 + t) * 256 + ((c8 - 896) & ~15u) + 4 * (fq & 1)) * 4; STG(f32x4, out, o) = ev; STG(f32x4, out, o + 32) = od; }
                        }
                        v0 = v0 * qs; v1 = v1 * qs;
                        u32x4 w; w.x = pk2(v0[0], v0[1]); w.y = pk2(v0[2], v0[3]); w.z = pk2(v1[0], v1[1]); w.w = pk2(v1[2], v1[3]);
                        STG(u32x4, ws, isK ? dbase + (row >> 5) * (isA ? 8192u : 16384u) + (row & 31) * 16 : dbase + row * dpitch) = w;
                        asm volatile("" ::: "memory");
                    }
            } else if (c32 < 1408) {
                const bool isA = c32 < 640;
                const unsigned cc = isA ? (c8 - 512) : (c8 - 1152);
                const unsigned vt = (isA ? WS_VTA : WS_VTB) + ((((cc >> 6) * 2 + ((cc >> 5) & 1)) * 2) * 64 + (cc & 31)) * 16;
#pragma unroll
                for (int ai = 0; ai < 2; ++ai)
#pragma unroll
                    for (int m = 0; m < MF; ++m) {
                        const unsigned row = row0 + ai * (MF * 32) + m * 16; const bool lat = rowb + ai * (MF * 32) + m * 16 >= (unsigned)MC;
                        const f32x4 v0 = acc[ai][bj][m][0], v1 = acc[ai][bj][m][1];
                        if (!lat) { const unsigned b = row >> 8, t = row & 255;
                            const unsigned o = isA ? (OFF_AV + ((b * 4 + l) * 256 + t) * 128 + cc) * 4 : (OFF_BV + ((b * 4 + l) * 256 + t) * 256 + cc) * 4;
                            STG(f32x4, out, o) = v0; STG(f32x4, out, o + 16) = v1; }
                        const unsigned p0 = pk2(v0[0], v0[1]), p1 = pk2(v0[2], v0[3]), p2 = pk2(v1[0], v1[1]), p3 = pk2(v1[2], v1[3]);
                        const unsigned tt = row & 31, rem = tt & 15;
                        const unsigned vo = vt + (row >> 5) * (isA ? 8192u : 16384u) + (tt >> 4) * 1024 + ((rem >> 2) & 1) * 512 + (4 * (rem >> 3) + (rem & 3)) * 2;
                        STG(bf16_t, ws, vo + 0 * 16) = (bf16_t)(p0 & 0xffff); STG(bf16_t, ws, vo + 1 * 16) = (bf16_t)(p0 >> 16);
                        STG(bf16_t, ws, vo + 2 * 16) = (bf16_t)(p1 & 0xffff); STG(bf16_t, ws, vo + 3 * 16) = (bf16_t)(p1 >> 16);
                        STG(bf16_t, ws, vo + 4 * 16) = (bf16_t)(p2 & 0xffff); STG(bf16_t, ws, vo + 5 * 16) = (bf16_t)(p2 >> 16);
                        STG(bf16_t, ws, vo + 6 * 16) = (bf16_t)(p3 & 0xffff); STG(bf16_t, ws, vo + 7 * 16) = (bf16_t)(p3 >> 16);
                        asm volatile("" ::: "memory");
                    }
            } else if (c32 < 2944) {
                const int kind = c32 < 2560 ? 0 : (c32 < 2688 ? 1 : (c32 < 2816 ? 2 : 3));
                const unsigned dbase = kind == 0 ? WS_RKV + (c8 - 1408) * 2 : (kind == 1 ? WS_CW + (c8 - 2560) * 2 : (kind == 2 ? WS_CA + (c8 - 2688) * 2 : WS_CG + (c8 - 2816) * 2));
                const unsigned dpitch = kind == 0 ? 2304u : 256u;
#pragma unroll
                for (int ai = 0; ai < 2; ++ai)
#pragma unroll
                    for (int m = 0; m < MF; ++m) {
                        const unsigned row = row0 + ai * (MF * 32) + m * 16; const bool lat = rowb + ai * (MF * 32) + m * 16 >= (unsigned)MC;
                        f32x4 v0 = acc[ai][bj][m][0], v1 = acc[ai][bj][m][1];
                        if (kind == 1) {
#pragma unroll
                            for (int e = 0; e < 4; ++e) { v0[e] = 1.f - 2.f * __builtin_amdgcn_rcpf(__expf(2.f * v0[e]) + 1.f); v1[e] = 1.f - 2.f * __builtin_amdgcn_rcpf(__expf(2.f * v1[e]) + 1.f); }
                        } else if (kind == 3) {
#pragma unroll
                            for (int e = 0; e < 4; ++e) { v0[e] = sigmf(v0[e]); v1[e] = sigmf(v1[e]); }
                        }
                        u32x4 w; w.x = pk2(v0[0], v0[1]); w.y = pk2(v0[2], v0[3]); w.z = pk2(v1[0], v1[1]); w.w = pk2(v1[2], v1[3]);
                        STG(u32x4, ws, dbase + row * dpitch) = w;
                        asm volatile("" ::: "memory");
                    }
            }
        }
    }
};

struct Frame {
    LAS unsigned char* lds;
    const float* const* in;
    float* out; unsigned char* ws;
    int tid, lane, wave, gw, ngw, G, bid;
};
#define GAS __attribute__((address_space(1)))
template <class T> __device__ __forceinline__ T* gptr(T* p) {
#if defined(__HIP_DEVICE_COMPILE__)
    __builtin_assume(!__builtin_amdgcn_is_shared((const void*)p)); __builtin_assume(!__builtin_amdgcn_is_private((const void*)p));
#endif
    return p; }
#define INP(k) gptr(F.in[k])
#define WSP(T, off) gptr((T*)(F.ws + (off)))

__device__ __forceinline__ void phase_prologue(Frame& F) {
    const float* cvec = INP(8); const float* cctx = INP(9); const float* ada_w = INP(10); const float* ada_b = INP(11);
    LAS float* sl = (LAS float*)F.lds;
    LAS float* red = (LAS float*)(F.lds + 16384);
    for (int i = F.tid; i < 3072; i += 512) { const int v = i >> 10, k = i & 1023; const float x = v == 0 ? cctx[k] : cvec[(v - 1) * 1024 + k]; sl[i] = x / (1.f + __expf(-x)); }
    __syncthreads();
    float* mod = WSP(float, WS_MOD);
    for (int it = F.bid; it < 384; it += F.G) {
        const int l = it / 96, n0 = (it % 96) * 64;
        const float* W = ada_w + (size_t)l * 1024 * 6144 + n0 + F.lane;
        float a0 = 0.f, a1 = 0.f, a2 = 0.f;
        const int k0 = F.wave * 128;
#pragma unroll 8
        for (int k = k0; k < k0 + 128; ++k) { const float w = *(const GAS float*)(W + (size_t)k * 6144); a0 += sl[k] * w; a1 += sl[1024 + k] * w; a2 += sl[2048 + k] * w; }
        red[(F.wave * 3 + 0) * 64 + F.lane] = a0; red[(F.wave * 3 + 1) * 64 + F.lane] = a1; red[(F.wave * 3 + 2) * 64 + F.lane] = a2;
        __syncthreads();
        if (F.wave < 3) { float s = ada_b[l * 6144 + n0 + F.lane];
#pragma unroll
            for (int w = 0; w < 8; ++w) s += red[(w * 3 + F.wave) * 64 + F.lane];
            mod[(size_t)(l * 3 + F.wave) * 6144 + n0 + F.lane] = s; }
        __syncthreads();
    }
    float* tab = WSP(float, WS_TAB);
    if (F.bid == F.G - 1) {
        for (int i = F.tid; i < 1024; i += 512) { const int pos = i >> 4, f = i & 15; const float ang = (float)pos * __builtin_amdgcn_exp2f(-(float)f * (13.287712379549449f / 16.f)); tab[TAB_COSA + i] = __cosf(ang); tab[TAB_SINA + i] = __sinf(ang); }
        for (int i = F.tid; i < 512; i += 512) { const int pos = i >> 3, f = i & 7; const float ang = (float)pos * __builtin_amdgcn_exp2f(-(float)f * (13.287712379549449f / 8.f)); tab[TAB_COSB + i] = __cosf(ang); tab[TAB_SINB + i] = __sinf(ang); }
        if (F.wave < 4) { const float* lp = INP(16) + F.wave * 128; const int d = F.lane & 31;
            const float p1 = wave_sum(F.lane < 32 ? lp[d] * lp[32 + d] : 0.f), p2 = wave_sum(F.lane < 32 ? 0.f : lp[64 + d] * lp[96 + d]);
            if (F.lane == 0) tab[TAB_LAM + F.wave] = __expf(p1) - __expf(p2); }
    }
    const int gtid = F.bid * 512 + F.tid, gnt = F.G * 512;
    { bf16_t* sw = WSP(bf16_t, WS_SMALLW); const float* cw2 = INP(20); const float* ca2 = INP(22); const float* cg2 = INP(23);
      for (int idx = gtid; idx < 4 * SMALLW_L; idx += gnt) { const int l = idx / SMALLW_L, r = idx % SMALLW_L; float v;
          if (r < 98304) { const int which = r / 49152, rr = r % 49152, d = rr / 24576, ch = (rr % 24576) / 64, k = rr % 64; v = (which ? ca2 : cw2)[((size_t)(l * 2 + d) * 64 + k) * 384 + ch]; }
          else { const int rr = r - 98304, ch = rr / 128, k = rr % 128; v = cg2[((size_t)l * 128 + k) * 384 + ch]; }
          sw[idx] = (bf16_t)(pk2(v, 0.f) & 0xffff); } }
    { bf16_t* kca = WSP(bf16_t, WS_CACHE); bf16_t* vca = kca + 524288; bf16_t* kcb = vca + 524288; bf16_t* vcb = kcb + 1048576;
      const float* cak = INP(2); const float* cav = INP(3); const float* cbk = INP(4); const float* cbv = INP(5);
      for (int e = gtid; e < 524288; e += gnt) {
          const int j = e & 7, ln = (e >> 3) & 63, hi = ln >> 5, r32 = ln & 31, blk = (e >> 12) & 15, bl = e >> 16;
          { const int s = (e >> 9) & 3, kvh = (e >> 11) & 1, cp = kvh * 64 + 16 * s + 8 * hi + j, o = cp & 31, c = (cp - o) + (o >> 1) + 16 * (o & 1);
            kca[e] = (bf16_t)(pk2(cak[((size_t)bl * 512 + blk * 32 + r32) * 128 + c], 0.f) & 0xffff); }
          { const int ks = (e >> 9) & 1, db = (e >> 10) & 1, kvh = (e >> 11) & 1, key = blk * 32 + 16 * ks + 8 * (j >> 2) + 4 * hi + (j & 3);
            vca[e] = (bf16_t)(pk2(cav[((size_t)bl * 512 + key) * 128 + kvh * 64 + db * 32 + r32], 0.f) & 0xffff); } }
      for (int e = gtid; e < 1048576; e += gnt) {
          const int j = e & 7, ln = (e >> 3) & 63, hi = ln >> 5, r32 = ln & 31, blk = (e >> 13) & 15, bl = e >> 17;
          { const int s = (e >> 9) & 1, hm = (e >> 10) & 7, cp = hm * 32 + 16 * s + 8 * hi + j, o = cp & 15, c = (cp - o) + (o >> 1) + 8 * (o & 1);
            kcb[e] = (bf16_t)(pk2(cbk[((size_t)bl * 512 + blk * 32 + r32) * 256 + c], 0.f) & 0xffff); }
          { const int ks = (e >> 9) & 1, db = (e >> 10) & 1, h = (e >> 11) & 3, key = blk * 32 + 16 * ks + 8 * (j >> 2) + 4 * hi + (j & 3);
            vcb[e] = (bf16_t)(pk2(cbv[((size_t)bl * 512 + key) * 256 + h * 64 + db * 32 + r32], 0.f) & 0xffff); } } }
    for (int st = 0; st < 1; ++st) { u32x4* z = (u32x4*)(WSP(bf16_t, WS_WIN + st * WSET_STRIDE) + (size_t)2944 * 1024); unsigned z0; asm volatile("v_mov_b32 %0, 0" : "=v"(z0)); for (int i = gtid; i < 128 * 1024 / 8; i += gnt) z[i] = (u32x4){z0, z0, z0, z0}; }
}

template <int MAP> __device__ __forceinline__ int dest_row(int n) {
    if (MAP == 1) {
        if (n < 512) { const int o = n & 31; return (n - o) + 2 * (o & 15) + (o >> 4); }
        if (n >= 640 && n < 1152) { const int o = n & 15; return (n - o) + 2 * (o & 7) + (o >> 3); }
        return n;
    }
    if (MAP == 2) return (n >> 2) * 8 + (n & 3);
    if (MAP == 3) return (n >> 2) * 8 + 4 + (n & 3);
    return n;
}
template <int MAP> __device__ __forceinline__ void transpose_item(const float* W, int K, int N, bf16_t* WT, LAS float* scr, int item, int lane) {
    const int nblk = N / 32, kb = item / nblk, nb = item % nblk, k0 = 64 * kb, n0 = 32 * nb;
#pragma unroll 8
    for (int i = 0; i < 32; ++i) { const int kk = 2 * i + (lane >> 5); scr[kk * 33 + (lane & 31)] = *(const GAS float*)(W + (size_t)(k0 + kk) * N + n0 + (lane & 31)); }
    asm volatile("s_waitcnt lgkmcnt(0)" ::: "memory");
    const int c = lane & 7;
#pragma unroll
    for (int j = 0; j < 4; ++j) { const int n = (lane >> 3) + 8 * j; const LAS float* s = scr + (8 * c) * 33 + n;
        u32x4 o; o.x = pk2(s[0 * 33], s[1 * 33]); o.y = pk2(s[2 * 33], s[3 * 33]); o.z = pk2(s[4 * 33], s[5 * 33]); o.w = pk2(s[6 * 33], s[7 * 33]);
        *(GAS u32x4*)(WT + (size_t)dest_row<MAP>(n0 + n) * K + k0 + 8 * c) = o; }
    asm volatile("s_waitcnt lgkmcnt(0)" ::: "memory");
}
template <int MAP> __device__ __forceinline__ void convert_item(const float* W, int K, int N, bf16_t* WT, int item, int lane) {
    const int nblk = N / 64, kb = item / nblk, nb = item % nblk, n = nb * 64 + lane;
    const GAS float* src = (const GAS float*)W + (size_t)(kb * 128) * N + n;
    GAS bf16_t* dst = (GAS bf16_t*)WT + (size_t)dest_row<MAP>(n) * K + kb * 128;
#pragma unroll
    for (int g = 0; g < 16; ++g) { float v[8];
#pragma unroll
        for (int e = 0; e < 8; ++e) v[e] = src[(size_t)(8 * g + e) * N];
        u32x4 o; o.x = pk2(v[0], v[1]); o.y = pk2(v[2], v[3]); o.z = pk2(v[4], v[5]); o.w = pk2(v[6], v[7]);
        *(GAS u32x4*)(dst + 8 * g) = o; }
}
constexpr int CV_IN = 46 * 8, CV_OUT = 16 * 8, CV_1 = 44 * 8, CV_2 = 16 * 22, CV_TOTAL = CV_IN + CV_OUT + 2 * CV_1 + CV_2;
__device__ __forceinline__ void convert_item_any(Frame& F, int l, int it) {
    const unsigned so = 0u * WSET_STRIDE;
    int r = it;
    if (r < CV_IN) { convert_item<1>(INP(14) + (size_t)l * 1024 * 2944, 1024, 2944, WSP(bf16_t, WS_WIN + so), r, F.lane); return; } r -= CV_IN;
    if (r < CV_OUT) { convert_item<0>(INP(29) + (size_t)l * 1024 * 1024, 1024, 1024, WSP(bf16_t, WS_WOUT + so), r, F.lane); return; } r -= CV_OUT;
    if (r < CV_1) { convert_item<2>(INP(30) + (size_t)l * 1024 * FF, 1024, FF, WSP(bf16_t, WS_W13 + so), r, F.lane); return; } r -= CV_1;
    if (r < CV_1) { convert_item<3>(INP(31) + (size_t)l * 1024 * FF, 1024, FF, WSP(bf16_t, WS_W13 + so), r, F.lane); return; } r -= CV_1;
    convert_item<0>(INP(32) + (size_t)l * FF * 1024, FF, 1024, WSP(bf16_t, WS_W2 + so), r, F.lane);
}
__device__ __forceinline__ void convert_weights(Frame& F, int l) {
    LAS float* scr = (LAS float*)(F.lds + F.wave * 16384); const unsigned so = 0u * WSET_STRIDE;
    const float* w_in = INP(14) + (size_t)l * 1024 * 2944; const float* w_out = INP(29) + (size_t)l * 1024 * 1024;
    const float* w1 = INP(30) + (size_t)l * 1024 * FF; const float* w3 = INP(31) + (size_t)l * 1024 * FF; const float* w2 = INP(32) + (size_t)l * FF * 1024;
    constexpr int I_IN = 16 * 92, I_OUT = 16 * 32, I_1 = 16 * 88, I_2 = 44 * 32;
    constexpr int NIT = I_IN + I_OUT + 2 * I_1 + I_2;
    for (int it = F.gw; it < NIT; it += F.ngw) {
        int r = it;
        if (r < I_IN) { transpose_item<1>(w_in, 1024, 2944, WSP(bf16_t, WS_WIN + so), scr, r, F.lane); continue; } r -= I_IN;
        if (r < I_OUT) { transpose_item<0>(w_out, 1024, 1024, WSP(bf16_t, WS_WOUT + so), scr, r, F.lane); continue; } r -= I_OUT;
        if (r < I_1) { transpose_item<2>(w1, 1024, FF, WSP(bf16_t, WS_W13 + so), scr, r, F.lane); continue; } r -= I_1;
        if (r < I_1) { transpose_item<3>(w3, 1024, FF, WSP(bf16_t, WS_W13 + so), scr, r, F.lane); continue; } r -= I_1;
        transpose_item<0>(w2, FF, 1024, WSP(bf16_t, WS_W2 + so), scr, r, F.lane);
    }
}

__device__ __forceinline__ void phase_norm(Frame& F, int l, int which  ) {
    const float* g = (which ? INP(13) : INP(12)) + l * 1024;
    const float* mod = WSP(float, WS_MOD) + (size_t)l * 3 * 6144 + (which ? 3072 : 0);
    bf16_t* H = WSP(bf16_t, WS_ACT);
    const bool first = (l == 0 && which == 0);
    f32x4 gv[4];
#pragma unroll
    for (int j = 0; j < 4; ++j) gv[j] = *(const GAS f32x4*)(g + 4 * F.lane + 256 * j);
    for (int row = F.gw; row < M; row += F.ngw) {
        const float* mv = mod + (row < MC ? 0 : (row < 2 * MC ? 1 : 2)) * 6144;
        f32x4 v[4]; float ss = 0.f;
        if (first) { const float* xr = row < MC ? INP(0) + (size_t)row * DM : INP(1) + (size_t)(row - MC) * DM;
#pragma unroll
            for (int j = 0; j < 4; ++j) v[j] = *(const GAS f32x4*)(xr + 4 * F.lane + 256 * j); }
        else {
#pragma unroll
            for (int j = 0; j < 4; ++j) v[j] = unpack4(LDG(u32x2, F.ws, WS_XB + ((unsigned)row * DM + 4 * F.lane + 256 * j) * 2)); }
#pragma unroll
        for (int j = 0; j < 4; ++j) ss += (v[j][0] * v[j][0] + v[j][1] * v[j][1]) + (v[j][2] * v[j][2] + v[j][3] * v[j][3]);
        const float rstd = rsqrtf(wave_sum(ss) * (1.f / 1024.f) + 1e-6f);
#pragma unroll
        for (int j = 0; j < 4; ++j) { const f32x4 sh = *(const GAS f32x4*)(mv + 4 * F.lane + 256 * j), sc = *(const GAS f32x4*)(mv + 1024 + 4 * F.lane + 256 * j);
            const f32x4 h = v[j] * rstd * gv[j] * (sc + 1.f) + sh;
            *(GAS u32x2*)(H + (size_t)row * DM + 4 * F.lane + 256 * j) = pack4(h); }
    }
}
__device__ __forceinline__ void phase_final_norm(Frame& F) {
    const float* g = INP(33);
    f32x4 gv[4];
#pragma unroll
    for (int j = 0; j < 4; ++j) gv[j] = *(const GAS f32x4*)(g + 4 * F.lane + 256 * j);
    for (int row = F.gw; row < M; row += F.ngw) {
        float* xr = gptr(F.out + (size_t)row * DM);
        f32x4 v[4]; float ss = 0.f;
#pragma unroll
        for (int j = 0; j < 4; ++j) { v[j] = unpack4(LDG(u32x2, F.ws, WS_XB + ((unsigned)row * DM + 4 * F.lane + 256 * j) * 2)); ss += (v[j][0] * v[j][0] + v[j][1] * v[j][1]) + (v[j][2] * v[j][2] + v[j][3] * v[j][3]); }
        const float rstd = rsqrtf(wave_sum(ss) * (1.f / 1024.f) + 1e-6f);
#pragma unroll
        for (int j = 0; j < 4; ++j) *(GAS f32x4*)(xr + 4 * F.lane + 256 * j) = v[j] * rstd * gv[j];
    }
}

#define MFMA32(a, b, c) __builtin_amdgcn_mfma_f32_32x32x16_bf16((a), (b), (c), 0, 0, 0)
#ifndef ATT_PROBE
#define ATT_PROBE 0
#endif
struct AttnQ { float m, l; bool mz; f32x16 o[2]; };
template <int DQK, bool MASK, int NQ>
__device__ __forceinline__ void attn_block(const bf16x8 (&qf)[NQ][DQK / 16], const bf16x8 (&kf)[DQK / 16], const bf16x8 (&vf)[4], AttnQ (&st)[NQ], int b, const int (&qpos)[NQ], int kpos0, int hi) {
    constexpr int NS = DQK / 16;
    f32x16 sc[NQ];
#pragma unroll
    for (int q = 0; q < NQ; ++q) { const f32x16 z = {}; sc[q] = MFMA32(kf[0], qf[q][0], z);
#pragma unroll
        for (int s = 1; s < NS; ++s) sc[q] = MFMA32(kf[s], qf[q][s], sc[q]); }
#pragma unroll
    for (int q = 0; q < NQ; ++q) {
        if (!st[q].mz) {
#pragma unroll
            for (int r = 0; r < 16; ++r) sc[q][r] -= st[q].m; }
        if (MASK) {
#pragma unroll
            for (int r = 0; r < 16; ++r) { const int key = kpos0 + 32 * b + (r & 3) + 8 * (r >> 2) + 4 * hi; const int dlt = key - qpos[q]; if (dlt > 128 || dlt < -128) sc[q][r] = -1e30f; }
        }
        float bm = fmaxf(fmaxf(sc[q][0], sc[q][1]), sc[q][2]);
#pragma unroll
        for (int r = 3; r < 15; r += 2) bm = fmaxf(fmaxf(bm, sc[q][r]), sc[q][r + 1]);
        bm = fmaxf(bm, sc[q][15]);
        bm = swap32_max(bm);
        if (__builtin_amdgcn_ballot_w64(bm > 64.f) != 0ull) {
            const float d = fmaxf(bm, 0.f);
            const float alpha = __builtin_amdgcn_exp2f(-d);
            st[q].m += d; st[q].l *= alpha; st[q].mz = false;
#pragma unroll
            for (int r = 0; r < 16; ++r) { st[q].o[0][r] *= alpha; st[q].o[1][r] *= alpha; sc[q][r] -= d; }
        }
#if ATT_PROBE == 1
        { float dmy = 0.f;
#pragma unroll
          for (int r = 0; r < 16; ++r) { float e_; asm volatile("v_exp_f32 %0, %1" : "=v"(e_) : "v"(sc[q][r])); dmy += e_; }
          asm volatile("" :: "v"(dmy)); }
#endif
        f32x2 rs2 = {0.f, 0.f};
#pragma unroll
        for (int r = 0; r < 16; r += 2) { sc[q][r] = __builtin_amdgcn_exp2f(sc[q][r]); sc[q][r + 1] = __builtin_amdgcn_exp2f(sc[q][r + 1]); rs2 += (f32x2){sc[q][r], sc[q][r + 1]}; }
        st[q].l += rs2[0] + rs2[1];
#if ATT_PROBE == 3
        { float d0 = 0.f, d1 = 0.f, d2 = 0.f, d3 = 0.f;
#pragma unroll
          for (int rr = 0; rr < 10; ++rr) { asm volatile("v_add_f32 %0, %0, %4\n\tv_add_f32 %1, %1, %5\n\tv_add_f32 %2, %2, %6\n\tv_add_f32 %3, %3, %7" : "+v"(d0), "+v"(d1), "+v"(d2), "+v"(d3) : "v"(sc[q][0]), "v"(sc[q][1]), "v"(sc[q][2]), "v"(sc[q][3])); }
          asm volatile("" :: "v"(d0), "v"(d1), "v"(d2), "v"(d3)); }
#endif
#if ATT_PROBE == 2
        { f32x16 dm = sc[q]; dm = MFMA32(kf[0], qf[q][0], dm); dm = MFMA32(kf[0], qf[q][0], dm); dm = MFMA32(kf[0], qf[q][0], dm); asm volatile("" :: "v"(dm)); }
#endif
        bf16x8 pb[2];
#pragma unroll
        for (int ks = 0; ks < 2; ++ks) { u32x4 w; w.x = pk2(sc[q][8 * ks], sc[q][8 * ks + 1]); w.y = pk2(sc[q][8 * ks + 2], sc[q][8 * ks + 3]); w.z = pk2(sc[q][8 * ks + 4], sc[q][8 * ks + 5]); w.w = pk2(sc[q][8 * ks + 6], sc[q][8 * ks + 7]); pb[ks] = __builtin_bit_cast(bf16x8, w); }
#pragma unroll
        for (int db = 0; db < 2; ++db)
#pragma unroll
            for (int ks = 0; ks < 2; ++ks) st[q].o[db] = MFMA32(vf[db * 2 + ks], pb[ks], st[q].o[db]);
    }
}
template <int DQK, bool MASK, int NQ>
__device__ __forceinline__ void attn_seg(const unsigned char* ws, const bf16x8 (&qf)[NQ][DQK / 16], AttnQ (&st)[NQ],
                                         unsigned kp, unsigned kblk  , unsigned vp, unsigned vblk, int nblk, const int (&qpos)[NQ], int kpos0, int hi) {
    constexpr int NS = DQK / 16;
    const GAS unsigned char* kq = (const GAS unsigned char*)ws + kp; const GAS unsigned char* vq = (const GAS unsigned char*)ws + vp;
    bf16x8 ka[NS], va[4], kb[NS], vb[4];
#define ATT_LOAD(kd, vd) do { _Pragma("unroll") for (int s = 0; s < NS; ++s) kd[s] = *(const GAS bf16x8*)(kq + 1024 * s); _Pragma("unroll") for (int f = 0; f < 4; ++f) vd[f] = *(const GAS bf16x8*)(vq + 1024 * f); } while (0)
    ATT_LOAD(ka, va);
    int b = 0;
    for (; b + 1 < nblk; b += 2) {
        kq += kblk; vq += vblk; ATT_LOAD(kb, vb);
        attn_block<DQK, MASK, NQ>(qf, ka, va, st, b, qpos, kpos0, hi);
        if (b + 2 < nblk) { kq += kblk; vq += vblk; }
        ATT_LOAD(ka, va);
        attn_block<DQK, MASK, NQ>(qf, kb, vb, st, b + 1, qpos, kpos0, hi);
    }
    if (b < nblk) attn_block<DQK, MASK, NQ>(qf, ka, va, st, b, qpos, kpos0, hi);
#undef ATT_LOAD
}
__device__ __forceinline__ void attnq_init(AttnQ& s, float l0) { s.m = 0.f; s.mz = true; s.l = l0; s.o[0] = (f32x16){}; s.o[1] = (f32x16){}; }
__device__ __forceinline__ void attn_a_item(Frame& F, int l, bool lat, int item) {
    int lane = F.lane; asm volatile("" : "+v"(lane));
    const unsigned char* ws = F.ws;
    const unsigned r32 = lane & 31, hi = lane >> 5;
    const unsigned nqb = lat ? 128 : 8;
    const unsigned qb = item % nqb, hq = (item / nqb) % 6, b = item / (nqb * 6), kvh = hq / 3;
    const unsigned seq0 = lat ? MC + b * 4096 : b * 256, q0 = qb * 32, row = seq0 + q0 + r32;
    const unsigned qo = WS_QA + (row * 384 + hq * 64 + 8 * hi) * 2;
    bf16x8 qf[1][4];
#pragma unroll
    for (int s = 0; s < 4; ++s) qf[0][s] = LDG(bf16x8, ws, qo + 32 * s);
    AttnQ st[1]; attnq_init(st[0], hi == 0 ? __builtin_amdgcn_exp2f(INP(15)[l * 6 + hq] * LOG2E) : 0.f);
    const int qpos[1] = {(int)(q0 + r32)};
    const unsigned fo = kvh * 4096 + lane * 16;
    if (!lat) {
        attn_seg<64, false, 1>(ws, qf, st, WS_KA + (seq0 >> 5) * 8192 + fo, 8192, WS_VTA + (seq0 >> 5) * 8192 + fo, 8192, 8, qpos, 0, hi);
    } else {
        const int ks = (int)q0 - 128 < 0 ? 0 : (int)q0 - 128, ke = q0 + 160 > 4096 ? 4096 : q0 + 160;
        attn_seg<64, true, 1>(ws, qf, st, WS_KA + ((seq0 + ks) >> 5) * 8192 + fo, 8192, WS_VTA + ((seq0 + ks) >> 5) * 8192 + fo, 8192, (ke - ks) >> 5, qpos, ks, hi);
        attn_seg<64, false, 1>(ws, qf, st, WS_CACHE + (b * 4 + l) * 131072 + fo, 8192, WS_CACHE + 1 * MiB + (b * 4 + l) * 131072 + fo, 8192, 16, qpos, 0, hi);
    }
    const float rl = 1.f / swap32_sum(st[0].l);
    const unsigned oo = WS_ACT + (row * DM + hq * 64 + 4 * hi) * 2;
#pragma unroll
    for (int db = 0; db < 2; ++db)
#pragma unroll
        for (int g = 0; g < 4; ++g) { const f32x4 v = {st[0].o[db][4 * g] * rl, st[0].o[db][4 * g + 1] * rl, st[0].o[db][4 * g + 2] * rl, st[0].o[db][4 * g + 3] * rl}; STG(u32x2, F.ws, oo + (32 * db + 8 * g) * 2) = pack4(v); }
}
__device__ __forceinline__ void attn_b_store(Frame& F, const AttnQ& s, unsigned mp, unsigned kh, unsigned row, unsigned h, unsigned hi) {
    const float lt = swap32_sum(s.l);
    const unsigned oo = WS_BO2 + (((mp * 2 + kh) * M + row) * 256 + h * 64 + 4 * hi) * 2;
#pragma unroll
    for (int db = 0; db < 2; ++db)
#pragma unroll
        for (int g = 0; g < 4; ++g) STG(u32x2, F.ws, oo + (32 * db + 8 * g) * 2) = pack4((f32x4){s.o[db][4 * g], s.o[db][4 * g + 1], s.o[db][4 * g + 2], s.o[db][4 * g + 3]});
    if (hi == 0) STG(f32x2, F.ws, WS_ML + ((((mp * 2 + kh) * M + row) * 4 + h) * 2) * 4) = (f32x2){s.m, lt};
}
__device__ __forceinline__ void attn_b_item(Frame& F, int l, bool lat, int item) {
    int lane = F.lane; asm volatile("" : "+v"(lane));
    const unsigned char* ws = F.ws;
    const unsigned r32 = lane & 31, hi = lane >> 5;
    if (lat) {
        const unsigned kh = item & 1, qb = (item >> 1) & 63, mp = (item >> 7) & 1, h = (item >> 8) & 3, b = item >> 10;
        const unsigned seq0 = MC + b * 4096, row0 = seq0 + qb * 64 + r32;
        bf16x8 qf[2][2];
#pragma unroll
        for (int q = 0; q < 2; ++q)
#pragma unroll
            for (int s = 0; s < 2; ++s) qf[q][s] = LDG(bf16x8, ws, WS_QB + ((row0 + 32 * q) * 256 + h * 64 + mp * 32 + 8 * hi) * 2 + 32 * s);
        AttnQ st[2]; attnq_init(st[0], 0.f); attnq_init(st[1], 0.f);
        const int qpos[2] = {0, 0};
        const unsigned kfo = (h * 2 + mp) * 2048 + lane * 16, vfo = h * 4096 + lane * 16;
        const unsigned blk0 = kh ? 72u : 0u, nb = kh ? 56 : 72;
        attn_seg<32, false, 2>(ws, qf, st, WS_KB + ((seq0 >> 5) + blk0) * 16384 + kfo, 16384, WS_VTB + ((seq0 >> 5) + blk0) * 16384 + vfo, 16384, nb, qpos, 0, hi);
        if (kh) attn_seg<32, false, 2>(ws, qf, st, WS_CACHE + 2 * MiB + (b * 4 + l) * 262144 + kfo, 16384, WS_CACHE + 4 * MiB + (b * 4 + l) * 262144 + vfo, 16384, 16, qpos, 0, hi);
        attn_b_store(F, st[0], mp, kh, row0, h, hi); attn_b_store(F, st[1], mp, kh, row0 + 32, h, hi);
    } else {
        const unsigned qb = item & 7, mp = (item >> 3) & 1, h = (item >> 4) & 3, b = item >> 6;
        const unsigned seq0 = b * 256, row = seq0 + qb * 32 + r32;
        bf16x8 qf[1][2];
#pragma unroll
        for (int s = 0; s < 2; ++s) qf[0][s] = LDG(bf16x8, ws, WS_QB + (row * 256 + h * 64 + mp * 32 + 8 * hi) * 2 + 32 * s);
        AttnQ st[1]; attnq_init(st[0], 0.f);
        const int qpos[1] = {0};
        const unsigned kfo = (h * 2 + mp) * 2048 + lane * 16, vfo = h * 4096 + lane * 16;
        attn_seg<32, false, 1>(ws, qf, st, WS_KB + (seq0 >> 5) * 16384 + kfo, 16384, WS_VTB + (seq0 >> 5) * 16384 + vfo, 16384, 8, qpos, 0, hi);
        attn_b_store(F, st[0], mp, 0, row, h, hi);
    }
}

constexpr int L_KT = 0, L_RT = 9216, L_BT = 18432, L_KK = 27648, L_VT = 36864, L_KKT = 46080, L_BTT = 55296, L_A1 = 64512, L_RHS2 = 81920, L_WT = 99328, L_U0T = 108544, L_GC = 117760, L_X0 = 118016;
constexpr int RPB = 144, RPF = 272;
__device__ __forceinline__ void chunk_decode(int cid, unsigned& seq0, int& T, unsigned& b, unsigned& h, unsigned& dir, int& c) {
    unsigned chain;
    if (cid < 768) { chain = (unsigned)cid >> 2; c = cid & 3; T = 256; b = chain / 12; seq0 = b * 256; }
    else { const unsigned x = (unsigned)cid - 768; chain = x >> 6; c = (int)(x & 63); T = 4096; b = chain / 12; seq0 = MC + b * 4096; }
    dir = chain & 1; h = (chain >> 1) % 6;
}
__device__ __forceinline__ bf16x8 acc_frag(const f32x16& x, int ks, float sgn) {
    u32x4 w; w.x = pk2(sgn * x[8 * ks], sgn * x[8 * ks + 1]); w.y = pk2(sgn * x[8 * ks + 2], sgn * x[8 * ks + 3]); w.z = pk2(sgn * x[8 * ks + 4], sgn * x[8 * ks + 5]); w.w = pk2(sgn * x[8 * ks + 6], sgn * x[8 * ks + 7]);
    return __builtin_bit_cast(bf16x8, w);
}
__device__ __forceinline__ bf16x8 lds_frag_nat(const LAS unsigned char* img, unsigned row, int ks, unsigned hi) { return *(const LAS bf16x8*)(img + row * RPB + (16 * ks + 8 * hi) * 2); }
__device__ __forceinline__ bf16x8 lds_frag_perm(const LAS unsigned char* img, unsigned row, int k0, unsigned hi) {
    const s16x4 a = *(const LAS s16x4*)(img + row * RPB + (k0 + 4 * hi) * 2), b = *(const LAS s16x4*)(img + row * RPB + (k0 + 8 + 4 * hi) * 2);
    return (bf16x8){a[0], a[1], a[2], a[3], b[0], b[1], b[2], b[3]};
}
__device__ __forceinline__ f32x16 gram_tile(const LAS unsigned char* lds, int aimg, int bimg, int sb, int tb, unsigned r32, unsigned hi, bool strict) {
    f32x16 acc = {};
#pragma unroll
    for (int ks = 0; ks < 4; ++ks) acc = MFMA32(lds_frag_nat(lds + aimg, 32 * sb + r32, ks, hi), lds_frag_nat(lds + bimg, 32 * tb + r32, ks, hi), acc);
    if (sb == tb) {
#pragma unroll
        for (int r = 0; r < 16; ++r) { const unsigned s_ = (r & 3) + 8 * (r >> 2) + 4 * hi; const bool keep = strict ? s_ < r32 : s_ <= r32; acc[r] = keep ? acc[r] : 0.f; }
    }
    return acc;
}
__device__ __forceinline__ void lds_barrier() { asm volatile("s_waitcnt lgkmcnt(0)\n\ts_barrier" ::: "memory"); }
__device__ __forceinline__ void rwkv_chunk_block(Frame& F, int l, int cid) {
    int lane = F.lane; asm volatile("" : "+v"(lane));
    const unsigned char* ws = F.ws; LAS unsigned char* lds = F.lds;
    const int w = F.wave; const unsigned r32 = lane & 31, hi = lane >> 5;
    unsigned seq0, b, h, dir; int T, c; chunk_decode(cid, seq0, T, b, h, dir, c);
    const int q0 = 64 * c;
#ifndef RA_REP
#define RA_REP 0
#endif
    const int role = w >> 1, tb = w & 1;
    const unsigned swo = WS_SMALLW + l * (SMALLW_L * 2);
    {
        const int pw_ = w < 4, pb = (w >> 1) & 1, cb = w & 1;
        const int p_ = 32 * pb + r32; const unsigned tokp = seq0 + (dir ? T - 1 - (q0 + p_) : q0 + p_);
        const unsigned xo = (pw_ ? WS_CW : WS_CA) + (tokp * 128 + dir * 64 + 8 * hi) * 2, wo = swo + ((pw_ ? 0 : 49152) + (dir * 384 + h * 64 + 32 * cb + r32) * 64 + 8 * hi) * 2;
        f32x16 acc = {};
#pragma unroll
        for (int ks = 0; ks < 4; ++ks) acc = MFMA32(LDG(bf16x8, ws, xo + 32 * ks), LDG(bf16x8, ws, wo + 32 * ks), acc);
        {
            const float bias = LDG(float, pw_ ? INP(19) : INP(21), ((l * 2 + dir) * 384 + h * 64 + 32 * cb + r32) * 4);
#pragma unroll
            for (int r = 0; r < 16; ++r) { const float sg = sigmf(bias + acc[r]);
                *(LAS float*)(lds + (pw_ ? L_A1 : L_RHS2) + (32 * pb + (r & 3) + 8 * (r >> 2) + 4 * hi) * RPF + (32 * cb + r32) * 4) = pw_ ? -0.606531f * sg : sg; }
        }
        if (dir == 0 && w < 4) {
            f32x16 ag = {};
            const unsigned go = WS_CG + (tokp * 128 + 8 * hi) * 2, gw_ = swo + (98304 + (h * 64 + 32 * cb + r32) * 128 + 8 * hi) * 2;
#pragma unroll
            for (int ks = 0; ks < 8; ++ks) ag = MFMA32(LDG(bf16x8, ws, go + 32 * ks), LDG(bf16x8, ws, gw_ + 32 * ks), ag);
#pragma unroll
            for (int r = 0; r < 16; ++r) { const int pp_ = 32 * pb + (r & 3) + 8 * (r >> 2) + 4 * hi; const unsigned tk = seq0 + q0 + pp_;
                STG(bf16_t, F.ws, WS_G + (tk * 384 + h * 64 + 32 * cb + r32) * 2) = (bf16_t)(pk2(ag[r], 0.f) & 0xffff); }
        }
    }
    lds_barrier();
    {
        const unsigned cch = h * 64 + lane;
        const float* convp = INP(18) + (size_t)l * 3 * 1152;
        float cw_[3][3];
#pragma unroll
        for (int tap = 0; tap < 3; ++tap)
#pragma unroll
            for (int seg = 0; seg < 3; ++seg) cw_[tap][seg] = LDG(float, convp, (tap * 1152 + seg * 384 + cch) * 4);
        const float ckk = LDG(float, INP(24), (l * 384 + cch) * 4), cka = LDG(float, INP(25), (l * 384 + cch) * 4), crk = LDG(float, INP(26), (l * 384 + cch) * 4);
        const int tb0 = dir ? T - 1 - (q0 + 8 * w + 7) : q0 + 8 * w;
        float xr[10][3];
#pragma unroll
        for (int rr = 0; rr < 10; ++rr) { const int tr = tb0 - 1 + rr; const bool ok = tr >= 0 && tr < T; const unsigned tk = seq0 + (ok ? tr : tb0);
#pragma unroll
            for (int seg = 0; seg < 3; ++seg) { const float x = bf_lo((unsigned)LDG(bf16_t, ws, WS_RKV + (tk * 1152 + seg * 384 + cch) * 2)); xr[rr][seg] = ok ? x : 0.f; } }
        float lwv[8], kkv[8], btv[8], kdv[8], rv[8], vv[8], g = 0.f;
#pragma unroll
        for (int pp = 0; pp < 8; ++pp) {
            const int rr = 1 + (dir ? 7 - pp : pp); const int p = 8 * w + pp; const unsigned tok = seq0 + (unsigned)(tb0 + rr - 1);
            const float r_ = xr[rr - 1][0] * cw_[0][0] + xr[rr][0] * cw_[1][0] + xr[rr + 1][0] * cw_[2][0];
            const float k_ = xr[rr - 1][1] * cw_[0][1] + xr[rr][1] * cw_[1][1] + xr[rr + 1][1] * cw_[2][1];
            const float v_ = xr[rr - 1][2] * cw_[0][2] + xr[rr][2] * cw_[1][2] + xr[rr + 1][2] * cw_[2][2];
            const float kraw = k_ * ckk; const float n2 = wave_sum(kraw * kraw); const float kk_ = kraw * __builtin_amdgcn_rsqf(fmaxf(n2, 1e-24f));
            const float lw = *(const LAS float*)(lds + L_A1 + p * RPF + lane * 4), av = *(const LAS float*)(lds + L_RHS2 + p * RPF + lane * 4);
            const float kd_ = k_ * (1.f + (av - 1.f) * cka);
            const float bon = wave_sum(r_ * kd_ * crk);
            if (lane == 0) STG(float, F.ws, WS_SB + ((dir * M + tok) * 8 + h) * 4) = bon;
            if (dir == 0) STG(float, F.ws, WS_SV + (tok * 384 + cch) * 4) = v_;
            lwv[pp] = lw; kkv[pp] = kk_; btv[pp] = kk_ * av; kdv[pp] = kd_; rv[pp] = r_; vv[pp] = v_; g += lw;
        }
        g = 0.f;
        for (int wq = 0; wq < w; ++wq) { float t8[8];
#pragma unroll
            for (int e = 0; e < 8; ++e) t8[e] = *(const LAS float*)(lds + L_A1 + (8 * wq + e) * RPF + lane * 4);
            g += ((t8[0] + t8[1]) + (t8[2] + t8[3])) + ((t8[4] + t8[5]) + (t8[6] + t8[7])); }
        unsigned vt[4], kkt[4], btt[4]; float e_pos = __expf(g);
#pragma unroll
        for (int pp = 0; pp < 8; ++pp) {
            const int p = 8 * w + pp;
            const float e_prev = e_pos; g += lwv[pp]; e_pos = __expf(g); const float e_neg = __expf(-g);
            const unsigned pk_kr = pk2(kkv[pp] * e_prev, rv[pp] * e_pos), pk_bk = pk2(btv[pp] * e_neg, kdv[pp] * e_neg), pk_v = pk2(vv[pp], 0.f);
            *(LAS bf16_t*)(lds + L_KT + p * RPB + lane * 2) = (bf16_t)(pk_kr & 0xffff); *(LAS bf16_t*)(lds + L_RT + p * RPB + lane * 2) = (bf16_t)(pk_kr >> 16);
            *(LAS bf16_t*)(lds + L_BT + p * RPB + lane * 2) = (bf16_t)(pk_bk & 0xffff); *(LAS bf16_t*)(lds + L_KK + p * RPB + lane * 2) = (bf16_t)(pk_bk >> 16);
            if (pp & 1) { vt[pp >> 1] |= pk_v << 16; kkt[pp >> 1] |= pk_bk & 0xffff0000u; btt[pp >> 1] |= pk_bk << 16; }
            else { vt[pp >> 1] = pk_v & 0xffff; kkt[pp >> 1] = pk_bk >> 16; btt[pp >> 1] = pk_bk & 0xffff; }
        }
        *(LAS u32x4*)(lds + L_VT + lane * RPB + 16 * w) = (u32x4){vt[0], vt[1], vt[2], vt[3]};
        *(LAS u32x4*)(lds + L_KKT + lane * RPB + 16 * w) = (u32x4){kkt[0], kkt[1], kkt[2], kkt[3]};
        *(LAS u32x4*)(lds + L_BTT + lane * RPB + 16 * w) = (u32x4){btt[0], btt[1], btt[2], btt[3]};
        if (w == 7) *(LAS float*)(lds + L_GC + lane * 4) = e_pos;
    }
    lds_barrier();
    f32x16 keep[2]; bf16x8 x4f[2][2];
    if (role == 0) {
        for (int sb = 0; sb <= tb; ++sb) { const f32x16 x = gram_tile(lds, L_BT, L_KT, sb, tb, r32, hi, true);
            if (sb == tb) {
#pragma unroll
                for (int r = 0; r < 16; ++r) *(LAS float*)(lds + L_A1 + tb * 4608 + ((r & 3) + 8 * (r >> 2) + 4 * hi) * 144 + r32 * 4) = -x[r];
            } else {
#pragma unroll
                for (int g4 = 0; g4 < 4; ++g4) *(LAS f32x4*)(lds + L_A1 + 9216 + r32 * 144 + (8 * g4 + 4 * hi) * 4) = (f32x4){x[4 * g4], x[4 * g4 + 1], x[4 * g4 + 2], x[4 * g4 + 3]};
            } }
    } else if (role == 1) {
        f32x16 o[2] = {};
        for (int sb = 0; sb <= tb; ++sb) {
            const f32x16 x = gram_tile(lds, L_KK, L_KT, sb, tb, r32, hi, true);
#pragma unroll
            for (int ks = 0; ks < 2; ++ks) { const bf16x8 a = acc_frag(x, ks, 1.f);
#pragma unroll
                for (int ib = 0; ib < 2; ++ib) o[ib] = MFMA32(a, lds_frag_perm(lds + L_VT, 32 * ib + r32, 32 * sb + 16 * ks, hi), o[ib]); }
        }
#pragma unroll
        for (int ib = 0; ib < 2; ++ib)
#pragma unroll
            for (int r = 0; r < 16; ++r) *(LAS float*)(lds + L_RHS2 + (32 * tb + (r & 3) + 8 * (r >> 2) + 4 * hi) * RPF + (32 * ib + r32) * 4) = o[ib][r];
    } else if (role == 2) {
#pragma unroll
        for (int sb = 0; sb < 2; ++sb) { x4f[sb][0] = (bf16x8){}; x4f[sb][1] = (bf16x8){}; }
        keep[0] = (f32x16){}; keep[1] = (f32x16){};
        for (int sb = 0; sb <= tb; ++sb) {
            const f32x16 x3 = gram_tile(lds, L_KK, L_RT, sb, tb, r32, hi, false), x4 = gram_tile(lds, L_BT, L_RT, sb, tb, r32, hi, false);
#pragma unroll
            for (int ks = 0; ks < 2; ++ks) { const bf16x8 a3 = acc_frag(x3, ks, 1.f); const bf16x8 a4 = acc_frag(x4, ks, -1.f);
                if (sb == 0) x4f[0][ks] = a4; else x4f[1][ks] = a4;
#pragma unroll
                for (int cb = 0; cb < 2; ++cb) keep[cb] = MFMA32(a3, lds_frag_perm(lds + L_VT, 32 * cb + r32, 32 * sb + 16 * ks, hi), keep[cb]); }
        }
    } else {
        keep[0] = (f32x16){}; keep[1] = (f32x16){};
#pragma unroll
        for (int ks = 0; ks < 4; ++ks) { const bf16x8 ak = lds_frag_nat(lds + L_KKT, 32 * tb + r32, ks, hi);
#pragma unroll
            for (int cb = 0; cb < 2; ++cb) keep[cb] = MFMA32(ak, lds_frag_nat(lds + L_VT, 32 * cb + r32, ks, hi), keep[cb]); }
    }
    lds_barrier();
    if (w < 2) {
        const LAS unsigned char* a1p = lds + L_A1; asm volatile("" : "+v"(a1p));
        LAS unsigned char* xp = lds + (w == 0 ? L_X0 : L_RHS2) + lane * 4; asm volatile("" : "+v"(xp));
        const LAS unsigned char* kp = lds + L_KT + lane * 2; asm volatile("" : "+v"(kp));
        LAS unsigned char* dst = lds + (w == 0 ? L_WT : L_U0T) + lane * RPB; asm volatile("" : "+v"(dst));
#pragma unroll
        for (int B = 0; B < 2; ++B) {
            float acc[32];
            if (w == 0 && B == 0) {
#pragma unroll
                for (int r = 0; r < 32; ++r) acc[r] = bf_lo((unsigned)*(const LAS bf16_t*)(kp + r * RPB));
            } else {
#pragma unroll
                for (int r = 0; r < 32; ++r) acc[r] = *(const LAS float*)(xp + (32 * B + r) * RPF);
            }
            f32x2 ac2[16];
#pragma unroll
            for (int k = 0; k < 16; ++k) ac2[k] = (f32x2){acc[2 * k], acc[2 * k + 1]};
            f32x4 ca[8], cn[8];
#pragma unroll
            for (int tg = 0; tg < 8; ++tg) ca[tg] = *(const LAS f32x4*)(a1p + B * 4608 + tg * 16);
#pragma unroll
            for (int s_ = 0; s_ < 31; ++s_) {
                if (s_ + 1 < 31) {
#pragma unroll
                    for (int tg = (s_ + 2) / 4; tg < 8; ++tg) cn[tg] = *(const LAS f32x4*)(a1p + B * 4608 + (s_ + 1) * 144 + tg * 16);
                }
                __builtin_amdgcn_sched_barrier(0);
                const float xs = ac2[s_ >> 1][s_ & 1];
                const f32x2 xs2 = {xs, xs};
#pragma unroll
                for (int tg = (s_ + 1) / 4; tg < 8; ++tg) {
                    ac2[2 * tg] = __builtin_elementwise_fma((f32x2){ca[tg][0], ca[tg][1]}, xs2, ac2[2 * tg]);
                    ac2[2 * tg + 1] = __builtin_elementwise_fma((f32x2){ca[tg][2], ca[tg][3]}, xs2, ac2[2 * tg + 1]); }
                __builtin_amdgcn_sched_barrier(0);
#pragma unroll
                for (int tg = 0; tg < 8; ++tg) ca[tg] = cn[tg];
            }
#pragma unroll
            for (int k = 0; k < 16; ++k) { acc[2 * k] = ac2[k][0]; acc[2 * k + 1] = ac2[k][1]; }
#pragma unroll
            for (int k8 = 0; k8 < 4; ++k8) { u32x4 v; v.x = pk2(acc[8 * k8], acc[8 * k8 + 1]); v.y = pk2(acc[8 * k8 + 2], acc[8 * k8 + 3]); v.z = pk2(acc[8 * k8 + 4], acc[8 * k8 + 5]); v.w = pk2(acc[8 * k8 + 6], acc[8 * k8 + 7]);
                *(LAS u32x4*)(dst + 64 * B + 16 * k8) = v; }
            if (B == 0) {
                asm volatile("s_waitcnt lgkmcnt(0)" ::: "memory");
                f32x16 u[2];
#pragma unroll
                for (int cb = 0; cb < 2; ++cb)
#pragma unroll
                    for (int r = 0; r < 16; ++r) { const int t = 32 + (r & 3) + 8 * (r >> 2) + 4 * hi;
                        u[cb][r] = w == 0 ? bf_lo((unsigned)*(const LAS bf16_t*)(lds + L_KT + t * RPB + (32 * cb + r32) * 2)) : *(const LAS float*)(lds + L_RHS2 + t * RPF + (32 * cb + r32) * 4); }
#pragma unroll
                for (int ks = 0; ks < 2; ++ks) { const f32x4 a0 = *(const LAS f32x4*)(lds + L_A1 + 9216 + r32 * 144 + (16 * ks + 8 * hi) * 4), a1 = *(const LAS f32x4*)(lds + L_A1 + 9216 + r32 * 144 + (16 * ks + 8 * hi + 4) * 4);
                    u32x4 aw; aw.x = pk2(-a0[0], -a0[1]); aw.y = pk2(-a0[2], -a0[3]); aw.z = pk2(-a1[0], -a1[1]); aw.w = pk2(-a1[2], -a1[3]);
#pragma unroll
                    for (int cb = 0; cb < 2; ++cb) u[cb] = MFMA32(__builtin_bit_cast(bf16x8, aw), lds_frag_nat(lds + (w == 0 ? L_WT : L_U0T), 32 * cb + r32, ks, hi), u[cb]); }
#pragma unroll
                for (int cb = 0; cb < 2; ++cb)
#pragma unroll
                    for (int r = 0; r < 16; ++r) *(LAS float*)(lds + (w == 0 ? L_X0 : L_RHS2) + (32 + (r & 3) + 8 * (r >> 2) + 4 * hi) * RPF + (32 * cb + r32) * 4) = u[cb][r];
                asm volatile("s_waitcnt lgkmcnt(0)" ::: "memory");
            }
        }
    }
    lds_barrier();
    if (role == 2) {
        f32x16 pj[2];
#pragma unroll
        for (int jb = 0; jb < 2; ++jb)
#pragma unroll
            for (int r = 0; r < 16; ++r) pj[jb][r] = bf_lo((unsigned)*(const LAS bf16_t*)(lds + L_RT + (32 * tb + (r & 3) + 8 * (r >> 2) + 4 * hi) * RPB + (32 * jb + r32) * 2));
#pragma unroll
        for (int sb = 0; sb < 2; ++sb)
#pragma unroll
            for (int ks = 0; ks < 2; ++ks)
#pragma unroll
                for (int cb = 0; cb < 2; ++cb) {
                    keep[cb] = MFMA32(x4f[sb][ks], lds_frag_perm(lds + L_U0T, 32 * cb + r32, 32 * sb + 16 * ks, hi), keep[cb]);
                    pj[cb] = MFMA32(x4f[sb][ks], lds_frag_perm(lds + L_WT, 32 * cb + r32, 32 * sb + 16 * ks, hi), pj[cb]); }
        f32x16 (&y0)[2] = keep;
        const unsigned yb = dir ? WS_YB : WS_YF;
#pragma unroll
        for (int r = 0; r < 16; ++r) { const int t = 32 * tb + (r & 3) + 8 * (r >> 2) + 4 * hi; const unsigned tok = seq0 + (dir ? T - 1 - (q0 + t) : q0 + t);
#pragma unroll
            for (int cb = 0; cb < 2; ++cb) { STG(float, F.ws, yb + (tok * 384 + h * 64 + 32 * cb + r32) * 4) = y0[cb][r];
                STG(bf16_t, F.ws, WS_RP + (((unsigned)cid * 64 + t) * 64 + 32 * cb + r32) * 2) = (bf16_t)(pk2(pj[cb][r], 0.f) & 0xffff); } }
    } else if (role == 3) {
        const int jb = tb;
        f32x16 q1[2] = {}, q2[2] = {}; f32x16 (&n1)[2] = keep;
#pragma unroll
        for (int ks = 0; ks < 4; ++ks) { const bf16x8 a = lds_frag_nat(lds + L_BTT, 32 * jb + r32, ks, hi);
#pragma unroll
            for (int cb = 0; cb < 2; ++cb) { q1[cb] = MFMA32(lds_frag_nat(lds + L_WT, 32 * cb + r32, ks, hi), a, q1[cb]); q2[cb] = MFMA32(a, lds_frag_nat(lds + L_U0T, 32 * cb + r32, ks, hi), q2[cb]); } }
#pragma unroll
        for (int q = 0; q < 4; ++q) { f32x4 gc4;
#pragma unroll
            for (int e = 0; e < 4; ++e) gc4[e] = *(const LAS float*)(lds + L_GC + (32 * jb + e + 8 * q + 4 * hi) * 4);
#pragma unroll
            for (int cb = 0; cb < 2; ++cb) { f32x4 nv;
#pragma unroll
                for (int e = 0; e < 4; ++e) nv[e] = gc4[e] * (n1[cb][4 * q + e] - q2[cb][4 * q + e]);
                STG(f32x4, F.ws, WS_RN + ((((unsigned)cid * 2 + jb) * 2 + cb) * 4 + q) * 1024 + lane * 16) = nv; } }
        { const float gl = *(const LAS float*)(lds + L_GC + (32 * jb + r32) * 4);
#pragma unroll
          for (int cb = 0; cb < 2; ++cb)
#pragma unroll
            for (int s2 = 0; s2 < 2; ++s2) { float mv[8];
#pragma unroll
                for (int e = 0; e < 8; ++e) { const int r = 8 * s2 + e; const unsigned c = 32 * cb + (r & 3) + 8 * (r >> 2) + 4 * hi; mv[e] = (c == 32 * jb + r32 ? gl : 0.f) - gl * q1[cb][r]; }
                u32x4 w; w.x = pk2(mv[0], mv[1]); w.y = pk2(mv[2], mv[3]); w.z = pk2(mv[4], mv[5]); w.w = pk2(mv[6], mv[7]);
                STG(u32x4, F.ws, WS_RM + (unsigned)cid * 8192 + ((jb * 2 + cb) * 2 + s2) * 1024 + lane * 16) = w; } }
    }
    lds_barrier();
}
__device__ __forceinline__ void rwkv_chain_wave(Frame& F, int l, bool lat, int chain, int ib) {
    int lane = F.lane; asm volatile("" : "+v"(lane));
    const unsigned char* ws = F.ws; const unsigned r32 = lane & 31, hi = lane >> 5;
    const unsigned dir = chain & 1, h = (chain >> 1) % 6, b = chain / 12;
    const int nc = lat ? 64 : 4; const unsigned cid0 = lat ? 768 + chain * 64 : chain * 4;
    const unsigned i = 32 * ib + r32;
    const unsigned so = ((((b * 4 + l) * 6 + h) * 64 + i) * 64) * 4;
    f32x16 H[2];
#pragma unroll
    for (int jb = 0; jb < 2; ++jb)
#pragma unroll
        for (int g4 = 0; g4 < 4; ++g4) { f32x4 v = {0.f, 0.f, 0.f, 0.f}; if (lat) v = LDG(f32x4, dir ? INP(7) : INP(6), so + (32 * jb + 8 * g4 + 4 * hi) * 4);
            H[jb][4 * g4] = v[0]; H[jb][4 * g4 + 1] = v[1]; H[jb][4 * g4 + 2] = v[2]; H[jb][4 * g4 + 3] = v[3]; }
    bf16x8 maA[2][2][2], maB[2][2][2]; f32x16 ntA[2], ntB[2];
    const GAS unsigned char* pm = (const GAS unsigned char*)ws + (WS_RM + cid0 * 8192 + lane * 16);
    const GAS unsigned char* pn = (const GAS unsigned char*)ws + (WS_RN + (cid0 * 4 + ib) * 4096 + lane * 16);
#define RB_LOAD(ma, nt, k_) do { \
        _Pragma("unroll") for (int jo = 0; jo < 2; ++jo) _Pragma("unroll") for (int ji = 0; ji < 2; ++ji) _Pragma("unroll") for (int ks = 0; ks < 2; ++ks) ma[jo][ji][ks] = *(const GAS bf16x8*)(pm + ((k_) * 8192 + ((jo * 2 + ji) * 2 + ks) * 1024)); \
        _Pragma("unroll") for (int jo = 0; jo < 2; ++jo) _Pragma("unroll") for (int q = 0; q < 4; ++q) { const f32x4 t_ = *(const GAS f32x4*)(pn + ((k_) * 16384 + (jo * 8 + q) * 1024)); \
            nt[jo][4 * q] = t_[0]; nt[jo][4 * q + 1] = t_[1]; nt[jo][4 * q + 2] = t_[2]; nt[jo][4 * q + 3] = t_[3]; } } while (0)
#define RB_STEP(ma, nt, cid_) do { \
        bf16x8 hf[2][2]; \
        _Pragma("unroll") for (int ji = 0; ji < 2; ++ji) { hf[ji][0] = acc_frag(H[ji], 0, 1.f); hf[ji][1] = acc_frag(H[ji], 1, 1.f); } \
        _Pragma("unroll") for (int ji = 0; ji < 2; ++ji) _Pragma("unroll") for (int ks = 0; ks < 2; ++ks) STG(bf16x8, F.ws, WS_RH + (cid_) * 8192 + ((ib * 2 + ji) * 2 + ks) * 1024 + lane * 16) = hf[ji][ks]; \
        f32x16 acc[2] = {nt[0], nt[1]}; \
        _Pragma("unroll") for (int jo = 0; jo < 2; ++jo) _Pragma("unroll") for (int ji = 0; ji < 2; ++ji) _Pragma("unroll") for (int ks = 0; ks < 2; ++ks) acc[jo] = MFMA32(ma[jo][ji][ks], hf[ji][ks], acc[jo]); \
        H[0] = acc[0]; H[1] = acc[1]; } while (0)
    RB_LOAD(maA, ntA, 0); RB_LOAD(maB, ntB, 1);
#pragma unroll 1
    for (int c = 0; c < nc; c += 2) {
        const unsigned cid = cid0 + c;
        RB_STEP(maA, ntA, cid);
        if (c + 2 < nc) RB_LOAD(maA, ntA, 2);
        RB_STEP(maB, ntB, cid + 1);
        if (c + 2 < nc) RB_LOAD(maB, ntB, 3);
        pm += 16384; pn += 32768;
    }
#undef RB_LOAD
#undef RB_STEP
    if (!lat) {
#pragma unroll
        for (int jb = 0; jb < 2; ++jb)
#pragma unroll
            for (int g4 = 0; g4 < 4; ++g4) STG(f32x4, F.out, (dir ? OFF_CB : OFF_CF) * 4 + so + (32 * jb + 8 * g4 + 4 * hi) * 4) = (f32x4){H[jb][4 * g4], H[jb][4 * g4 + 1], H[jb][4 * g4 + 2], H[jb][4 * g4 + 3]};
    }
}
__device__ __forceinline__ void rwkv_apply_wave(Frame& F, int item) {
    int lane = F.lane; asm volatile("" : "+v"(lane));
    const unsigned char* ws = F.ws; const unsigned r32 = lane & 31, hi = lane >> 5;
    const int cid = item >> 1, tb = item & 1;
    unsigned seq0, b, h, dir; int T, c; chunk_decode(cid, seq0, T, b, h, dir, c);
    const unsigned yb = dir ? WS_YB : WS_YF;
    f32x16 acc[2];
#pragma unroll
    for (int r = 0; r < 16; ++r) { const int t = 32 * tb + (r & 3) + 8 * (r >> 2) + 4 * hi; const unsigned tok = seq0 + (dir ? T - 1 - (64 * c + t) : 64 * c + t);
        acc[0][r] = LDG(float, ws, yb + (tok * 384 + h * 64 + r32) * 4); acc[1][r] = LDG(float, ws, yb + (tok * 384 + h * 64 + 32 + r32) * 4); }
#pragma unroll
    for (int ks = 0; ks < 4; ++ks) { const bf16x8 a = LDG(bf16x8, ws, WS_RP + (((unsigned)cid * 64 + 32 * tb + r32) * 64 + 16 * ks + 8 * hi) * 2);
#pragma unroll
        for (int ib = 0; ib < 2; ++ib) acc[ib] = MFMA32(a, LDG(bf16x8, ws, WS_RH + (((unsigned)cid * 64 + 32 * ib + r32) * 64 + 16 * ks + 8 * hi) * 2), acc[ib]); }
#pragma unroll
    for (int r = 0; r < 16; ++r) { const int t = 32 * tb + (r & 3) + 8 * (r >> 2) + 4 * hi; const unsigned tok = seq0 + (dir ? T - 1 - (64 * c + t) : 64 * c + t);
        STG(float, F.ws, yb + (tok * 384 + h * 64 + r32) * 4) = acc[0][r]; STG(float, F.ws, yb + (tok * 384 + h * 64 + 32 + r32) * 4) = acc[1][r]; }
}

__device__ __forceinline__ void rwkv_out_item(Frame& F, int l, int item) {
    int lane = F.lane; asm volatile("" : "+v"(lane));
    const unsigned char* ws = F.ws; const unsigned r32 = lane & 31, hi = lane >> 5;
    const int tb = item & 1, h = (item >> 1) % 6, sk = item / 12;
    const bool lat = sk >= 64; const int b = lat ? (sk - 64) >> 6 : sk >> 2, k = lat ? (sk - 64) & 63 : sk & 3, nc = lat ? 64 : 4;
    const unsigned seq0 = lat ? MC + b * 4096 : b * 256, base = lat ? 768u : 0u;
    const unsigned chf = (b * 6 + h) * 2, cidf = base + chf * nc + k, cidb = base + (chf + 1) * nc + (nc - 1 - k);
    const unsigned tok0 = seq0 + 64 * k + 32 * tb;
    f32x16 acc[2];
#pragma unroll
    for (int r = 0; r < 16; ++r) { const unsigned tok = tok0 + (r & 3) + 8 * (r >> 2) + 4 * hi; const unsigned e = (tok * 384 + h * 64 + r32) * 4;
        acc[0][r] = LDG(float, ws, WS_YF + e) + LDG(float, ws, WS_YB + e); acc[1][r] = LDG(float, ws, WS_YF + e + 128) + LDG(float, ws, WS_YB + e + 128); }
    const unsigned pf = 32 * tb + r32, pb_ = 63 - 32 * tb - r32;
#pragma unroll
    for (int ks = 0; ks < 4; ++ks) {
        const s16x4 f0 = LDG(s16x4, ws, WS_RP + ((cidf * 64 + pf) * 64 + 16 * ks + 4 * hi) * 2), f1 = LDG(s16x4, ws, WS_RP + ((cidf * 64 + pf) * 64 + 16 * ks + 8 + 4 * hi) * 2);
        const s16x4 b0_ = LDG(s16x4, ws, WS_RP + ((cidb * 64 + pb_) * 64 + 16 * ks + 4 * hi) * 2), b1_ = LDG(s16x4, ws, WS_RP + ((cidb * 64 + pb_) * 64 + 16 * ks + 8 + 4 * hi) * 2);
        const bf16x8 af = {f0[0], f0[1], f0[2], f0[3], f1[0], f1[1], f1[2], f1[3]}, ab = {b0_[0], b0_[1], b0_[2], b0_[3], b1_[0], b1_[1], b1_[2], b1_[3]};
#pragma unroll
        for (int ib = 0; ib < 2; ++ib) { acc[ib] = MFMA32(af, LDG(bf16x8, ws, WS_RH + cidf * 8192 + (ib * 4 + ks) * 1024 + lane * 16), acc[ib]);
            acc[ib] = MFMA32(ab, LDG(bf16x8, ws, WS_RH + cidb * 8192 + (ib * 4 + ks) * 1024 + lane * 16), acc[ib]); } }
    const float g0 = LDG(float, INP(27), (l * 384 + h * 64 + r32) * 4), g1 = LDG(float, INP(27), (l * 384 + h * 64 + 32 + r32) * 4), b0 = LDG(float, INP(28), (l * 384 + h * 64 + r32) * 4), b1 = LDG(float, INP(28), (l * 384 + h * 64 + 32 + r32) * 4);
    const int xl = (lane ^ 16) << 2;
#pragma unroll
    for (int r = 0; r < 16; ++r) { const unsigned tok = tok0 + (r & 3) + 8 * (r >> 2) + 4 * hi; const unsigned e = tok * 384 + h * 64 + r32;
        const float bon = LDG(float, ws, WS_SB + (tok * 8 + h) * 4) + LDG(float, ws, WS_SB + ((M + tok) * 8 + h) * 4);
        const float y0 = acc[0][r] + bon * LDG(float, ws, WS_SV + e * 4), y1 = acc[1][r] + bon * LDG(float, ws, WS_SV + (e + 32) * 4);
        float s = allreduce16(y0 + y1); s += __builtin_bit_cast(float, __builtin_amdgcn_ds_bpermute(xl, __builtin_bit_cast(int, s)));
        const float mu = s * (1.f / 64.f), d0 = y0 - mu, d1 = y1 - mu;
        float q = allreduce16(d0 * d0 + d1 * d1); q += __builtin_bit_cast(float, __builtin_amdgcn_ds_bpermute(xl, __builtin_bit_cast(int, q)));
        const float rs = rsqrtf(q * (1.f / 64.f) + 64e-5f);
        const float o0 = (d0 * rs * g0 + b0) * bf_lo((unsigned)LDG(bf16_t, ws, WS_G + e * 2)), o1 = (d1 * rs * g1 + b1) * bf_lo((unsigned)LDG(bf16_t, ws, WS_G + (e + 32) * 2));
        const unsigned pk = pk2(o0, o1);
        STG(bf16_t, F.ws, WS_ACT + (tok * DM + 640 + h * 64 + r32) * 2) = (bf16_t)(pk & 0xffff); STG(bf16_t, F.ws, WS_ACT + (tok * DM + 640 + h * 64 + 32 + r32) * 2) = (bf16_t)(pk >> 16); }
}

#ifndef B_UNIT
#define B_UNIT 0
#endif
constexpr int AU_R = 8, AU_D = 4, AU_SLOT = 6144;
__device__ __forceinline__ void attn_b_unit(Frame& F, int l, int unit) {
    int lane = F.lane; asm volatile("" : "+v"(lane));
    const unsigned char* ws = F.ws; LAS unsigned char* lds = F.lds;
    const int w = F.wave; const unsigned r32 = lane & 31, hi = lane >> 5;
    const unsigned kh = unit & 1, qb = (unit >> 1) & 15, mp = (unit >> 5) & 1, h = (unit >> 6) & 3, b = unit >> 8;
    const unsigned seq0 = MC + b * 4096, row = seq0 + qb * 256 + 32 * w + r32;
    bf16x8 qf[1][2];
#pragma unroll
    for (int s = 0; s < 2; ++s) qf[0][s] = LDG(bf16x8, ws, WS_QB + (row * 256 + h * 64 + mp * 32 + 8 * hi) * 2 + 32 * s);
    AttnQ st[1]; attnq_init(st[0], 0.f);
    const int qpos[1] = {0};
    const int n0 = kh ? 56 : 72, nt = 72;
    const unsigned pofs = (w < 2 ? (h * 2 + mp) * 2048 + w * 1024 : h * 4096 + (w - 2) * 1024) + lane * 16;
    const unsigned base0 = (w < 2 ? WS_KB : WS_VTB) + ((seq0 >> 5) + (kh ? 72u : 0u)) * 16384 + pofs;
    const unsigned base1 = WS_CACHE + (w < 2 ? 2 * MiB : 4 * MiB) + (b * 4 + l) * 262144 + pofs;
#define AU_DMA(t_) do { const int tt_ = (t_) < nt ? (t_) : nt - 1; const unsigned src_ = tt_ < n0 ? base0 + tt_ * 16384 : base1 + (tt_ - n0) * 16384; \
        __builtin_amdgcn_global_load_lds((const GAS unsigned*)(ws + src_), (LAS unsigned*)(lds + ((t_) % AU_R) * AU_SLOT + w * 1024), 16, 0, 0); } while (0)
    if (w < 6) {
#pragma unroll
        for (int t = 0; t < AU_D; ++t) AU_DMA(t);
    }
    for (int t = 0; t < nt; ++t) {
        if (w < 6) asm volatile("s_waitcnt vmcnt(3)" ::: "memory");
        asm volatile("s_barrier" ::: "memory");
        const LAS unsigned char* sl = lds + (t % AU_R) * AU_SLOT + lane * 16;
        bf16x8 kf[2], vf[4];
        kf[0] = *(const LAS bf16x8*)(sl); kf[1] = *(const LAS bf16x8*)(sl + 1024);
#pragma unroll
        for (int f = 0; f < 4; ++f) vf[f] = *(const LAS bf16x8*)(sl + 2048 + 1024 * f);
        if (w < 6) AU_DMA(t + AU_D);
        attn_block<32, false, 1>(qf, kf, vf, st, t, qpos, 0, hi);
    }
#undef AU_DMA
    asm volatile("s_waitcnt vmcnt(0) lgkmcnt(0)\n\ts_barrier" ::: "memory");
    attn_b_store(F, st[0], mp, kh, row, h, hi);
}

constexpr int Q_BLAT = 2048, Q_ALAT = 1536, Q_BCTX = 1024, Q_ACTX = 768;
constexpr int Q_TOTAL = Q_BLAT + Q_ALAT + Q_BCTX + Q_ACTX;
#ifndef XCD_DEAL
#define XCD_DEAL 0
#endif
__device__ __forceinline__ void phase_mixer(Frame& F, int l, int rep) {
    if (rep == 0 || REP_PART == 0 || REP_PART == 1) {
        const int si = F.bid + F.G * F.wave;
        if (si < 48) rwkv_chain_wave(F, l, true, si >> 1, si & 1);
        else if (si < 48 + 384) rwkv_chain_wave(F, l, false, (si - 48) >> 1, (si - 48) & 1);
    }
    if (B_UNIT && (rep == 0 || REP_PART == 2 || REP_PART == 4)) {
        unsigned* uctr = (unsigned*)(F.ws + WS_CTL) + 64 * (32 + l + 4 * rep);
        LAS int* ubox = (LAS int*)(F.lds + 65536);
        for (;;) {
            if (F.wave == 0 && F.lane == 0) *ubox = (int)atomicAdd(uctr, 1u);
            lds_barrier();
            const int un = __builtin_amdgcn_readfirstlane(*ubox);
            lds_barrier();
            if (un >= 512) break;
            attn_b_unit(F, l, un);
        }
    }
    unsigned* ctr = (unsigned*)(F.ws + WS_CTL) + 64 * (1 + l + 4 * rep);
    if (rep == 0 || REP_PART != 1) for (;;) {
        int it = 0;
        if (F.lane == 0) it = (int)atomicAdd(ctr, 1u);
        it = __builtin_amdgcn_readfirstlane(it) + (B_UNIT ? Q_BLAT : 0);
        if (it >= Q_TOTAL) break;
        if (it < Q_BLAT) { if (rep == 0 || REP_PART == 2 || REP_PART == 4) attn_b_item(F, l, true, it); continue; } it -= Q_BLAT;
        if (it < Q_ALAT) { if (rep == 0 || REP_PART == 2 || REP_PART == 3) attn_a_item(F, l, true, it); continue; } it -= Q_ALAT;
        if (it < Q_BCTX) { if (rep == 0 || REP_PART == 2 || REP_PART == 5) attn_b_item(F, l, false, it); continue; } it -= Q_BCTX;
        if (rep == 0 || REP_PART == 2 || REP_PART == 5) attn_a_item(F, l, false, it);
    }
}

__device__ __forceinline__ void phase_finalize(Frame& F, int l) {
    const unsigned char* ws = F.ws;
    const unsigned lane = F.lane;
    const float lami = 0.8f - 0.6f * __expf(-0.3f * (float)l);
    const float lam = LDG(float, ws, WS_TAB + (TAB_LAM + l) * 4) + lami;
    const float omli = 1.f - lami;
    const float sg = LDG(float, INP(17), (l * 64 + lane) * 4);
    for (unsigned row = F.gw; row < M; row += F.ngw) {
#pragma unroll
        for (int k = 0; k < 4; ++k) { float om[2];
#pragma unroll
            for (int mp = 0; mp < 2; ++mp) { const unsigned o0 = (((mp * 2) * M + row) * 256 + 64 * k + lane) * 2, q0 = ((((mp * 2) * M + row) * 4 + k) * 2) * 4;
                const f32x2 ml0 = LDG(f32x2, ws, WS_ML + q0);
                if (row >= MC) { const f32x2 ml1 = LDG(f32x2, ws, WS_ML + q0 + M * 32); const float ms = fmaxf(ml0[0], ml1[0]), w0 = __builtin_amdgcn_exp2f(ml0[0] - ms), w1 = __builtin_amdgcn_exp2f(ml1[0] - ms);
                    om[mp] = (bf_lo((unsigned)LDG(bf16_t, ws, WS_BO2 + o0)) * w0 + bf_lo((unsigned)LDG(bf16_t, ws, WS_BO2 + o0 + M * 512)) * w1) * __builtin_amdgcn_rcpf(ml0[1] * w0 + ml1[1] * w1); }
                else om[mp] = bf_lo((unsigned)LDG(bf16_t, ws, WS_BO2 + o0)) * __builtin_amdgcn_rcpf(ml0[1]); }
            const float v = om[0] - lam * om[1];
            const float ms = wave_sum(v * v) * (1.f / 64.f);
            STG(bf16_t, F.ws, WS_ACT + (row * DM + 384 + 64 * k + lane) * 2) = (bf16_t)(pk2(v * rsqrtf(ms + 1e-6f) * sg * omli, 0.f) & 0xffff); }
    }
}


typedef unsigned v4u __attribute__((ext_vector_type(4)));
#define XB_TMO      128
#define XB_XCNT(j)  (256  + 64 * (j))
#define XB_XSUB(j)  (1280 + 64 * (j))
#define XB_XGEN(j)  (2304 + 64 * (j))
#define XB_TOP      3328
#define XB_TOPGEN   3392
#define XCD_BAR_WORDS 3456
#define XB_SPIN_CAP (1u << 18)

__device__ __forceinline__ unsigned xb_ld(unsigned* p)              { return __hip_atomic_load(p, __ATOMIC_RELAXED, __HIP_MEMORY_SCOPE_AGENT); }
__device__ __forceinline__ unsigned xb_add(unsigned* p, unsigned v) { return __hip_atomic_fetch_add(p, v, __ATOMIC_RELAXED, __HIP_MEMORY_SCOPE_AGENT); }
__device__ __forceinline__ unsigned xb_xcc_id() { return (unsigned)__builtin_amdgcn_s_getreg((3 << 11) | 20) & 0xFu; }
#define XB_SPIN(cond, bar) do { unsigned _sp = 0; while (cond) { __builtin_amdgcn_s_sleep(1); \
    if ((++_sp & 255u) == 0u) { if (xb_ld(&(bar)[XB_TMO])) break; if (_sp > XB_SPIN_CAP) { atomicAdd(&(bar)[XB_TMO], 1u); break; } } } } while (0)

struct XcdBarrier {
    unsigned* bar; unsigned x;
    volatile LAS unsigned* st;
};

__device__ __forceinline__ XcdBarrier xcd_barrier_post(unsigned* bar, volatile LAS unsigned* st) {
    XcdBarrier b; b.bar = bar; b.x = xb_xcc_id(); b.st = st;
    if (threadIdx.x == 0) (void)xb_add(&bar[XB_XCNT(b.x)], 1u);
    return b;
}
__device__ __forceinline__ void xcd_barrier_complete(unsigned* bar, unsigned x, unsigned& nloc, unsigned& nx) {
    const unsigned G = gridDim.x * gridDim.y * gridDim.z;
    unsigned sum, cnt, mine, sp = 0u;
    for (;;) {
        sum = 0u; cnt = 0u; mine = 0u;
#pragma unroll
        for (unsigned j = 0; j < 16; ++j) { const unsigned c = xb_ld(&bar[XB_XCNT(j)]); sum += c; cnt += (c > 0u) ? 1u : 0u; mine = (j == x) ? c : mine; }
        if (sum == G) break;
        __builtin_amdgcn_s_sleep(1);
        if ((++sp & 255u) == 0u) { if (xb_ld(&bar[XB_TMO])) break; if (sp > XB_SPIN_CAP) { atomicAdd(&bar[XB_TMO], 1u); break; } }
    }
    nloc = mine > 0u ? mine : 1u; nx = cnt > 0u ? cnt : 1u;
}

__device__ __forceinline__ void xcd_barrier(const XcdBarrier& b) {
    asm volatile("s_waitcnt vmcnt(0)" ::: "memory");
    __syncthreads();
    if (threadIdx.x == 0) {
        unsigned* bar = b.bar;
        __builtin_amdgcn_s_waitcnt(0);
        unsigned nloc = b.st[0], nx = b.st[1];
        if (nloc == 0u) { xcd_barrier_complete(bar, b.x, nloc, nx); b.st[0] = nloc; b.st[1] = nx; }
        const unsigned old = xb_add(&bar[XB_XSUB(b.x)], 1u);
        const unsigned gen = old / nloc;
        if (old + 1u == (gen + 1u) * nloc) {
            __builtin_amdgcn_fence(__ATOMIC_RELEASE, "agent");
            asm volatile("s_waitcnt vmcnt(0)" ::: "memory");
            const unsigned og = xb_add(&bar[XB_TOP], 1u);
            const unsigned tg = og / nx;
            if (og + 1u == (tg + 1u) * nx) xb_add(&bar[XB_TOPGEN], 1u);
            else XB_SPIN(xb_ld(&bar[XB_TOPGEN]) == tg, bar);
            __builtin_amdgcn_fence(__ATOMIC_ACQUIRE, "agent");
            xb_add(&bar[XB_XGEN(b.x)], 1u);
            asm volatile("s_waitcnt vmcnt(0)" ::: "memory");
        } else {
            XB_SPIN(xb_ld(&bar[XB_XGEN(b.x)]) == gen, bar);
            __builtin_amdgcn_fence(__ATOMIC_ACQUIRE, "agent");
            asm volatile("s_waitcnt vmcnt(0)" ::: "memory");
        }
    }
    __syncthreads();
}

#ifndef DIS
#define DIS 0
#endif
#ifndef GEMM_MF
#define GEMM_MF 7
#endif
#ifndef REP_PHASE
#define REP_PHASE -1
#define REP_COUNT 1
#endif
constexpr int NEXTRA = (REP_PHASE >= 0 && REP_PHASE < 9) ? REP_COUNT - 1 : 0, NPL = 9 + NEXTRA, NPRE = (REP_PHASE == 100) ? REP_COUNT : 1, NPHASE_RUN = NPRE + 1 + NPL * DEPTH;
__global__ void __launch_bounds__(512, 2) mega(Args a) {
    extern __shared__ __attribute__((aligned(16))) unsigned char lds[];
    Frame F;
    F.lds = (LAS unsigned char*)lds;
    volatile LAS unsigned* bst = (volatile LAS unsigned*)(F.lds + LDS_BYTES - 64);
    if (threadIdx.x < 2) bst[threadIdx.x] = 0u;
    __syncthreads();
    const XcdBarrier xbar = xcd_barrier_post((unsigned*)((GAS unsigned char*)a.ws + WS_CTL) + 4096, bst);
    const int wave_id = __builtin_amdgcn_readfirstlane((int)threadIdx.x >> 6);
    for (int ph = a.ph_lo; ph < a.ph_hi; ++ph) {
        { const unsigned char* kp = (const unsigned char*)__builtin_amdgcn_kernarg_segment_ptr(); asm volatile("" : "+s"(kp));
          const Args* ap = (const Args*)kp; F.in = ap->in; F.out = gptr(ap->out); F.ws = gptr(ap->ws); }
        { unsigned ones = ~0u; asm volatile("" : "+s"(ones)); int ln = (int)__builtin_amdgcn_mbcnt_hi(ones, __builtin_amdgcn_mbcnt_lo(ones, 0u)); int wv = wave_id, bid = (int)blockIdx.x, gg = (int)gridDim.x; asm volatile("" : "+s"(wv), "+s"(bid), "+s"(gg));
          F.lane = ln; F.wave = wv; F.bid = bid; F.G = gg; F.ngw = gg * 8; F.tid = wv * 64 + ln; F.gw = bid * 8 + wv; }
        if (ph < NPRE) { if (!(DIS & 1)) phase_prologue(F); }
        else if (ph == NPHASE_RUN - 1) { if (!(DIS & 2)) phase_final_norm(F); }
        else {
            const int l = (ph - NPRE) / NPL, sidx = (ph - NPRE) % NPL, rep = (REP_PHASE >= 0 && REP_PHASE < 9 && sidx > REP_PHASE && sidx <= REP_PHASE + NEXTRA) ? sidx - REP_PHASE : 0, s = (REP_PHASE >= 0 && REP_PHASE < 9 && sidx > REP_PHASE) ? (sidx <= REP_PHASE + NEXTRA ? REP_PHASE : sidx - NEXTRA) : sidx;
            if (s == 0) { convert_weights(F, l); phase_norm(F, l, 0); }
            else if (s == 1) {
                pg8::Gemm g{WSP(bf16_t, WS_ACT), WSP(bf16_t, WS_WIN + 0u * WSET_STRIDE), M, NIN, 1024}; pg8::StaticOrder S; S.init(M, NIN, F.G, F.bid, (GEMM_MF & 1) ? 192 : 256);
                EpiWin E{F.ws, F.out, l};
                if (!(DIS & 16)) pg8::gemm_phase<EpiWin, pg8::StaticOrder, false, true, (GEMM_MF & 1) ? 3 : 4>(F.lds, g, S, E, F.tid);
                if (false) { const int wv_ = (F.bid - 64) * 8 + F.wave; convert_item_any(F, l + 1, wv_); if (wv_ < CV_TOTAL - 1536) convert_item_any(F, l + 1, 1536 + wv_); }
            }
            else if (s == 2) { for (int cid = F.bid; cid < NCHUNK; cid += F.G) rwkv_chunk_block(F, l, cid); }
            else if (s == 3) { if (!(DIS & 64)) phase_mixer(F, l, rep); }
            else if (s == 4) { phase_finalize(F, l); for (int it = F.gw; it < 192 * 12; it += F.ngw) rwkv_out_item(F, l, it); }
            else if (s == 5 || s == 8) {
                const bool second = s == 8;
                pg8::Gemm g{second ? WSP(bf16_t, WS_U) : WSP(bf16_t, WS_ACT), second ? WSP(bf16_t, WS_W2 + 0u * WSET_STRIDE) : WSP(bf16_t, WS_WOUT + 0u * WSET_STRIDE), M, 1024, second ? FF : 1024};
                pg8::StaticOrder S; S.init(M, 1024, F.G, F.bid, (GEMM_MF & 2) ? 192 : 256);
                const bool first = (l == 0 && !second);
                EpiRes E{INP(0), INP(1) - (size_t)MC * DM, F.ws, WSP(float, WS_MOD) + (size_t)l * 3 * 6144 + (second ? 5120 : 2048), first};
                if (!(DIS & 256)) pg8::gemm_phase<EpiRes, pg8::StaticOrder, false, true, (GEMM_MF & 2) ? 3 : 4>(F.lds, g, S, E, F.tid);
            }
            else if (s == 6) { if (!(DIS & 8)) phase_norm(F, l, 1); }
            else {
                pg8::Gemm g{WSP(bf16_t, WS_ACT), WSP(bf16_t, WS_W13 + 0u * WSET_STRIDE), M, NFF2, 1024}; pg8::StaticOrder S; S.init(M, NFF2, F.G, F.bid, (GEMM_MF & 4) ? 192 : 256);
                EpiSwi E{WSP(bf16_t, WS_U)};
                if (!(DIS & 512)) pg8::gemm_phase<EpiSwi, pg8::StaticOrder, true, true, (GEMM_MF & 4) ? 3 : 4>(F.lds, g, S, E, F.tid);
            }
        }
        if (ph + 1 < a.ph_hi) { if (ph == a.ph_lo) { __threadfence(); cg::this_grid().sync(); } else xcd_barrier(xbar); }
    }
}

extern "C" void kernel_launch(void* const* d_in, const int* in_sizes, int n_in, void* d_out, int out_size, void* d_ws, size_t ws_size, hipStream_t stream) {
    static int grid = 0;
    if (grid == 0) {
        int dev = 0, cus = 0, per_cu = 0;
        if (n_in != 34 || ws_size < WS_END) { fprintf(stderr, "kernel_launch: unexpected n_in %d / ws_size %zu (need %zu)\n", n_in, ws_size, (size_t)WS_END); grid = -1; return; }
        if (hipGetDevice(&dev) != hipSuccess || hipDeviceGetAttribute(&cus, hipDeviceAttributeMultiprocessorCount, dev) != hipSuccess) { grid = -1; return; }
        if (hipFuncSetAttribute((const void*)mega, hipFuncAttributeMaxDynamicSharedMemorySize, LDS_BYTES) != hipSuccess) { fprintf(stderr, "kernel_launch: hipFuncSetAttribute failed\n"); grid = -1; return; }
        if (hipOccupancyMaxActiveBlocksPerMultiprocessor(&per_cu, (const void*)mega, 512, LDS_BYTES) != hipSuccess || per_cu < 1) { fprintf(stderr, "kernel_launch: occupancy query says %d\n", per_cu); per_cu = 1; }
        (void)hipGetLastError();
        grid = cus * 1;
        if (grid > cus * per_cu) grid = cus * per_cu;
    }
    if (grid < 0) return;
    (void)hipMemsetAsync((char*)d_ws + WS_CTL, 0, CTL_BYTES, stream);
    Args a{};
    for (int i = 0; i < 34; ++i) a.in[i] = (const float*)d_in[i];
    a.out = (float*)d_out; a.ws = (unsigned char*)d_ws;
#if MK_ONE_LAUNCH
    a.ph_lo = 0; a.ph_hi = NPHASE_RUN;
    void* args[] = {&a};
    hipError_t e = hipLaunchCooperativeKernel((const void*)mega, dim3(grid), dim3(512), args, LDS_BYTES, stream);
    if (e != hipSuccess) fprintf(stderr, "kernel_launch: cooperative launch failed: %s (grid %d)\n", hipGetErrorString(e), grid);
#else
    for (int ph = 0; ph < NPHASE_RUN; ++ph) { a.ph_lo = ph; a.ph_hi = ph + 1; hipLaunchKernelGGL(mega, dim3(grid), dim3(512), LDS_BYTES, stream, a); }
#endif
}
```

```cpp
#include <hip/hip_runtime.h>
#include <hip/hip_cooperative_groups.h>
#include <cstdio>
#include <cstdint>
namespace cg = cooperative_groups;

#ifndef MK_ONE_LAUNCH
#define MK_ONE_LAUNCH 1
#endif

#undef MK_ONE_LAUNCH
#define MK_ONE_LAUNCH 1
#define REP_PHASE -1
#define REP_COUNT 1
#define REP_PART 0
#define RA_REP 0
#define ATT_PROBE 0
namespace pg8 {
#define PG8_LAS __attribute__((address_space(3)))
typedef unsigned short bf16_t;
typedef short bf16x8 __attribute__((ext_vector_type(8)));
typedef float f32x4 __attribute__((ext_vector_type(4)));
typedef unsigned u32x4 __attribute__((ext_vector_type(4)));
constexpr int BM = 256, BK = 64, HALF = 128, HTB = HALF * BK * 2  , STAGE_BYTES = 8 * HTB, NXCD = 8, WGM = 8;

__host__ __device__ __forceinline__ int lds_byte(int r, int c) { const int st = (r >> 4) * 2 + (c >> 5), rr = r & 15, cc = c & 31, ob = rr * 64 + cc * 2; return st * 1024 + (ob ^ (((ob >> 9) & 1) << 5)); }
__host__ __device__ __forceinline__ void stage_rc(int b, int& R, int& C) { const int st = b / 1024, sb = b % 1024, swz = sb ^ (((sb >> 9) & 1) << 5); R = (st >> 1) * 16 + swz / 64; C = (st & 1) * 32 + (swz % 64) / 2; }
__host__ __device__ __forceinline__ int perm32(int rho) { const int n = rho >> 4, i = rho & 15; return 8 * (i >> 2) + 4 * n + (i & 3); }

struct Unit { int pm, pn; };
struct Gemm { const bf16_t* A; const bf16_t* Bt; int M, N, K; };

struct StaticOrder {
    int nM, nN, nwg, G, c;
    __host__ __device__ void init(int M, int N, int G_, int c_, int bm = BM) { nM = M / bm; nN = N / BM; nwg = nM * nN; G = G_; c = c_; }
    __host__ __device__ bool next(int i, Unit& u) const {
        const long L = (long)i * G + c; if (L >= nwg) return false;
        int wgid = (int)L; { const int q = nwg / NXCD, r = nwg % NXCD, xcd = wgid % NXCD, off = wgid / NXCD; wgid = (xcd < r ? xcd * (q + 1) : r * (q + 1) + (xcd - r) * q) + off; }
        const int nig = WGM * nN, gid = wgid / nig, fm = gid * WGM, gsz = (nM - fm) < WGM ? (nM - fm) : WGM;
        u.pm = fm + ((wgid % nig) % gsz); u.pn = (wgid % nig) / gsz; return true;
    }
    __device__ __forceinline__ void a_ready(const Unit&) const {}
    __device__ __forceinline__ void done(const Unit&) const {}
};

template <class Epi, class Sched, bool ALIGN_EPI = false, bool SP2 = false, int MF = 4>
__device__ __forceinline__ void gemm_phase(PG8_LAS unsigned char* lds, const Gemm g, const Sched& S, const Epi& E, const int tid_in) {
    const int tid = tid_in, wid = __builtin_amdgcn_readfirstlane(tid >> 6), lane = tid & 63, wr = wid >> 2, wc = wid & 3, fr = lane & 15, fq = lane >> 4;
    static_assert(MF == 4 || (MF == 3 && SP2), "192-row tiles: SP2 schedule only");
    const int K = g.K, nt = K / BK;
    unsigned voffA[2], voffB[2];
#pragma unroll
    for (int i = 0; i < 2; ++i) { int R, C; stage_rc(tid * 16 + i * 8192, R, C); const int Rb = Epi::PERM ? ((R & ~31) + perm32(R & 31)) : R;
        voffA[i] = (unsigned)(R * K + C) * 2u; voffB[i] = (unsigned)(Rb * K + C) * 2u; }
    const size_t kstep = (size_t)(BK * 2);
    const size_t hstep = (size_t)HALF * K * 2;
    const size_t tstep = 2 * hstep;
    const size_t hstepA = (size_t)(MF * 32) * K * 2, tstepA = 2 * hstepA;
    const unsigned ldsw = (unsigned)wid * 1024u;
    const int aoff = lds_byte(wr * (MF * 16) + fr, fq * 8), boff = lds_byte(wc * 32 + fr, fq * 8);
#define PG8_SA(b, h) (((b) * 2 + (h)) * HTB)
#define PG8_SB(b, h) ((4 + (b) * 2 + (h)) * HTB)
#define PG8_STAGE(bufoff, gbase, voff) do { _Pragma("unroll") for (int _i = 0; _i < 2; ++_i) \
        __builtin_amdgcn_global_load_lds((const unsigned*)((const char*)(gbase) + (voff)[_i]), (PG8_LAS unsigned*)(lds + (bufoff) + ldsw + _i * 8192), 16, 0, 0); } while (0)
#define PG8_STAGEA(bufoff, gbase, voff) do { __builtin_amdgcn_global_load_lds((const unsigned*)((const char*)(gbase) + (voff)[0]), (PG8_LAS unsigned*)(lds + (bufoff) + ldsw), 16, 0, 0); \
        if (MF == 4 || wr == 0) __builtin_amdgcn_global_load_lds((const unsigned*)((const char*)(gbase) + (voff)[1]), (PG8_LAS unsigned*)(lds + (bufoff) + ldsw + 8192), 16, 0, 0); } while (0)
#define PG8_LDA(dst, b, h) do { _Pragma("unroll") for (int m = 0; m < MF; ++m) _Pragma("unroll") for (int k = 0; k < 2; ++k) dst[m][k] = *(const PG8_LAS bf16x8*)(lds + PG8_SA(b, h) + aoff + m * 2048 + k * 1024); } while (0)
#define PG8_LDB(dst, b, h) do { _Pragma("unroll") for (int n = 0; n < 2; ++n) _Pragma("unroll") for (int k = 0; k < 2; ++k) dst[n][k] = *(const PG8_LAS bf16x8*)(lds + PG8_SB(b, h) + boff + n * 2048 + k * 1024); } while (0)
#define PG8_MMA(ai, bj, At, Bt) do { __builtin_amdgcn_s_setprio(1); _Pragma("unroll") for (int m = 0; m < MF; ++m) _Pragma("unroll") for (int n = 0; n < 2; ++n) _Pragma("unroll") for (int k = 0; k < 2; ++k) \
        acc[ai][bj][m][n] = __builtin_amdgcn_mfma_f32_16x16x32_bf16(Bt[n][k], At[m][k], acc[ai][bj][m][n], 0, 0, 0); __builtin_amdgcn_s_setprio(0); } while (0)
#define PG8_WAIT_V(n) asm volatile("s_waitcnt vmcnt(" #n ")" ::: "memory")
#define PG8_WAIT_V2(a, b) do { if (MF == 4 || wr == 0) asm volatile("s_waitcnt vmcnt(" #a ")" ::: "memory"); else asm volatile("s_waitcnt vmcnt(" #b ")" ::: "memory"); } while (0)
#define PG8_WAIT_L(n) asm volatile("s_waitcnt lgkmcnt(" #n ")" ::: "memory")
#define PG8_BAR __builtin_amdgcn_s_barrier()
#define PG8_SCHED __builtin_amdgcn_sched_barrier(0)
    Unit cur, nxt; int ui = 0;
    if (!S.next(0, cur)) return;
    f32x4 acc[2][2][MF][2];
#pragma unroll
    for (int a = 0; a < 2; ++a)
#pragma unroll
        for (int b = 0; b < 2; ++b)
#pragma unroll
            for (int m = 0; m < MF; ++m)
#pragma unroll
                for (int n = 0; n < 2; ++n) acc[a][b][m][n] = (f32x4){0.f, 0.f, 0.f, 0.f};
    bf16x8 At[MF][2], B0[2][2], B1[2][2];
#define PG8_SGPR64(p) ((const char*)(((unsigned long long)(unsigned)__builtin_amdgcn_readfirstlane((int)((unsigned long long)(p) >> 32)) << 32) | (unsigned)__builtin_amdgcn_readfirstlane((int)(unsigned long long)(p))))
    const char* cA = PG8_SGPR64((const char*)g.A + (size_t)cur.pm * tstepA); const char* cB = PG8_SGPR64((const char*)g.Bt + (size_t)cur.pn * tstep);
    S.a_ready(cur);
    if constexpr (SP2) {
        PG8_STAGE(PG8_SB(0, 0), cB, voffB); PG8_STAGE(PG8_SB(0, 1), cB + hstep, voffB); PG8_STAGEA(PG8_SA(0, 0), cA, voffA); PG8_STAGEA(PG8_SA(0, 1), cA + hstepA, voffA);
        if (wr == 1) PG8_BAR;
        PG8_WAIT_V2(2, 1); PG8_BAR;
        PG8_STAGE(PG8_SB(1, 0), cB + kstep, voffB); PG8_STAGEA(PG8_SA(1, 0), cA + kstep, voffA); PG8_STAGE(PG8_SB(1, 1), cB + hstep + kstep, voffB);
        PG8_WAIT_V2(6, 5); PG8_BAR;
    } else {
        PG8_STAGE(PG8_SB(0, 0), cB, voffB); PG8_STAGEA(PG8_SA(0, 0), cA, voffA); PG8_STAGE(PG8_SB(0, 1), cB + hstep, voffB); PG8_STAGEA(PG8_SA(0, 1), cA + hstepA, voffA);
        if (wr == 1) PG8_BAR;
        PG8_WAIT_V(4); PG8_BAR;
        PG8_STAGE(PG8_SB(1, 0), cB + kstep, voffB); PG8_STAGEA(PG8_SA(1, 0), cA + kstep, voffA); PG8_STAGE(PG8_SB(1, 1), cB + hstep + kstep, voffB);
        PG8_WAIT_V(6); PG8_BAR;
    }
    for (;;) {
        const bool has_next = S.next(ui + 1, nxt);
        const char* nA = PG8_SGPR64(has_next ? (const char*)g.A + (size_t)nxt.pm * tstepA : cA); const char* nB = PG8_SGPR64(has_next ? (const char*)g.Bt + (size_t)nxt.pn * tstep : cB);
        for (int t = 0; t < nt; t += 2) {
            const bool last = (t == nt - 2);
            const char* a1 = cA + (size_t)(t + 1) * kstep;
            const char* a2 = last ? nA : cA + (size_t)(t + 2) * kstep; const char* b2 = last ? nB : cB + (size_t)(t + 2) * kstep;
            const char* a3 = a2 + kstep; const char* b3 = b2 + kstep;
            if (last && has_next) S.a_ready(nxt);
            if constexpr (SP2) {
            PG8_LDB(B0, 0, 0); PG8_LDB(B1, 0, 1); PG8_SCHED; PG8_LDA(At, 0, 0); PG8_STAGEA(PG8_SA(1, 1), a1 + hstepA, voffA);
            PG8_WAIT_V2(8, 6); PG8_WAIT_L(0); PG8_BAR; PG8_MMA(0, 0, At, B0); PG8_MMA(0, 1, At, B1); PG8_BAR; PG8_SCHED;
            PG8_LDA(At, 0, 1); PG8_STAGE(PG8_SB(0, 0), b2, voffB); PG8_STAGE(PG8_SB(0, 1), b2 + hstep, voffB); PG8_STAGEA(PG8_SA(0, 0), a2, voffA);
            PG8_WAIT_V2(8, 6); PG8_WAIT_L(0); PG8_BAR; PG8_MMA(1, 0, At, B0); PG8_MMA(1, 1, At, B1); PG8_BAR; PG8_SCHED;
            PG8_LDB(B0, 1, 0); PG8_LDB(B1, 1, 1); PG8_SCHED; PG8_LDA(At, 1, 0); PG8_STAGEA(PG8_SA(0, 1), a2 + hstepA, voffA);
            PG8_WAIT_V2(8, 6); PG8_WAIT_L(0); PG8_BAR; PG8_MMA(0, 0, At, B0); PG8_MMA(0, 1, At, B1); PG8_BAR; PG8_SCHED;
            PG8_LDA(At, 1, 1); PG8_STAGE(PG8_SB(1, 0), b3, voffB); PG8_STAGE(PG8_SB(1, 1), b3 + hstep, voffB); PG8_STAGEA(PG8_SA(1, 0), a3, voffA);
            PG8_WAIT_V2(8, 6); PG8_WAIT_L(0); PG8_BAR; PG8_MMA(1, 0, At, B0); PG8_MMA(1, 1, At, B1); PG8_BAR; PG8_SCHED;
            } else {
            PG8_LDB(B0, 0, 0); PG8_SCHED; PG8_LDA(At, 0, 0); PG8_STAGEA(PG8_SA(1, 1), a1 + hstepA, voffA);
            PG8_WAIT_L(8); PG8_BAR; PG8_WAIT_L(0); PG8_MMA(0, 0, At, B0); PG8_BAR; PG8_SCHED;
            PG8_LDB(B1, 0, 1); PG8_STAGE(PG8_SB(0, 0), b2, voffB);
            PG8_BAR; PG8_WAIT_L(0); PG8_MMA(0, 1, At, B1); PG8_BAR;
            PG8_LDA(At, 0, 1); PG8_STAGEA(PG8_SA(0, 0), a2, voffA);
            PG8_BAR; PG8_WAIT_L(0); PG8_MMA(1, 0, At, B0); PG8_BAR; PG8_SCHED;
            PG8_STAGE(PG8_SB(0, 1), b2 + hstep, voffB);
            PG8_WAIT_V(6); PG8_BAR; PG8_MMA(1, 1, At, B1); PG8_BAR;
            PG8_LDB(B0, 1, 0); PG8_SCHED; PG8_LDA(At, 1, 0); PG8_STAGEA(PG8_SA(0, 1), a2 + hstepA, voffA);
            PG8_WAIT_L(8); PG8_BAR; PG8_WAIT_L(0); PG8_MMA(0, 0, At, B0); PG8_BAR; PG8_SCHED;
            PG8_LDB(B1, 1, 1); PG8_STAGE(PG8_SB(1, 0), b3, voffB);
            PG8_BAR; PG8_WAIT_L(0); PG8_MMA(0, 1, At, B1); PG8_BAR;
            PG8_LDA(At, 1, 1); PG8_STAGEA(PG8_SA(1, 0), a3, voffA);
            PG8_BAR; PG8_WAIT_L(0); PG8_MMA(1, 0, At, B0); PG8_BAR; PG8_SCHED;
            PG8_STAGE(PG8_SB(1, 1), b3 + hstep, voffB);
            PG8_WAIT_V(6); PG8_BAR; PG8_MMA(1, 1, At, B1); PG8_BAR;
            }
        }
        if constexpr (ALIGN_EPI) { if (wr == 0) PG8_BAR; }
        if constexpr (!Epi::AFTER_DRAIN) { E.template operator()<MF>(acc, cur, wr, wc, fr, fq); S.done(cur); }
        if (!has_next) break;
#pragma unroll
        for (int a = 0; a < 2; ++a)
#pragma unroll
            for (int b = 0; b < 2; ++b)
#pragma unroll
                for (int m = 0; m < MF; ++m)
#pragma unroll
                    for (int n = 0; n < 2; ++n) acc[a][b][m][n] = (f32x4){0.f, 0.f, 0.f, 0.f};
        cur = nxt; cA = nA; cB = nB; ++ui;
        if constexpr (ALIGN_EPI) { if (wr == 1) PG8_BAR; }
    }
    PG8_WAIT_V(0);
    if constexpr (!ALIGN_EPI) { if (wr == 0) PG8_BAR; }
    PG8_BAR;
    if constexpr (Epi::AFTER_DRAIN) { E.fused(acc, cur, wr, wc, fr, fq, lds, wid, lane); S.done(cur); }
#undef PG8_SA
#undef PG8_SB
#undef PG8_STAGE
#undef PG8_STAGEA
#undef PG8_WAIT_V2
#undef PG8_LDA
#undef PG8_LDB
#undef PG8_MMA
#undef PG8_WAIT_V
#undef PG8_WAIT_L
#undef PG8_BAR
#undef PG8_SCHED
}
}

using pg8::bf16_t; using pg8::bf16x8; using pg8::f32x4; using pg8::u32x4;
typedef float f32x16 __attribute__((ext_vector_type(16)));
typedef float f32x2 __attribute__((ext_vector_type(2)));
typedef short s16x4 __attribute__((ext_vector_type(4)));
typedef unsigned u32x2 __attribute__((ext_vector_type(2)));
typedef __bf16 bf16x2_t __attribute__((ext_vector_type(2)));
#define LAS __attribute__((address_space(3)))
#define LDG(T, base, boff) (*(const __attribute__((address_space(1))) T*)((const __attribute__((address_space(1))) unsigned char*)(base) + (unsigned)(boff)))
#define STG(T, base, boff) (*(__attribute__((address_space(1))) T*)((__attribute__((address_space(1))) unsigned char*)(base) + (unsigned)(boff)))

__device__ __forceinline__ unsigned pk2(float lo, float hi) { f32x2 v = {lo, hi}; bf16x2_t b = __builtin_convertvector(v, bf16x2_t); return __builtin_bit_cast(unsigned, b); }
__device__ __forceinline__ float bf_lo(unsigned u) { return __uint_as_float(u << 16); }
__device__ __forceinline__ float bf_hi(unsigned u) { return __uint_as_float(u & 0xffff0000u); }
__device__ __forceinline__ f32x4 unpack4(u32x2 v) { return (f32x4){bf_lo(v.x), bf_hi(v.x), bf_lo(v.y), bf_hi(v.y)}; }
__device__ __forceinline__ u32x2 pack4(f32x4 v) { u32x2 r; r.x = pk2(v[0], v[1]); r.y = pk2(v[2], v[3]); return r; }
__device__ __forceinline__ float sigmf(float x) { return __builtin_amdgcn_rcpf(1.f + __expf(-x)); }
template <int CTRL> __device__ __forceinline__ float dpp_f(float x) { return __builtin_bit_cast(float, __builtin_amdgcn_update_dpp(0, __builtin_bit_cast(int, x), CTRL, 0xF, 0xF, true)); }
__device__ __forceinline__ float allreduce16(float x) { x += dpp_f<0xB1>(x); x += dpp_f<0x4E>(x); x += dpp_f<0x141>(x); x += dpp_f<0x140>(x); return x; }
__device__ __forceinline__ float rdlane(float x, int l) { return __builtin_bit_cast(float, __builtin_amdgcn_readlane(__builtin_bit_cast(int, x), l)); }
__device__ __forceinline__ float wave_sum(float v) {
    v = allreduce16(v);
    return (rdlane(v, 0) + rdlane(v, 16)) + (rdlane(v, 32) + rdlane(v, 48));
}
__device__ __forceinline__ float swap32_sum(float x) { auto rr = __builtin_amdgcn_permlane32_swap(__float_as_uint(x), __float_as_uint(x), false, false); return __uint_as_float(rr[0]) + __uint_as_float(rr[1]); }
__device__ __forceinline__ float swap32_max(float x) { auto rr = __builtin_amdgcn_permlane32_swap(__float_as_uint(x), __float_as_uint(x), false, false); return fmaxf(__uint_as_float(rr[0]), __uint_as_float(rr[1])); }

constexpr int M = 12288, MC = 4096, DM = 1024, NIN = 3072, FF = 2816, NFF2 = 5632, DEPTH = 4;
constexpr float LOG2E = 1.4426950408889634f;
constexpr float QSCALE_A = 0.125f * LOG2E;
constexpr float QSCALE_B = 0.17677669529663687f * LOG2E;
constexpr unsigned OFF_AK = 12582912, OFF_AV = 14680064, OFF_BK = 16777216, OFF_BV = 20971520, OFF_CF = 25165824, OFF_CB = 26738688;
constexpr unsigned MiB = 1u << 20;
constexpr unsigned WS_CTL = 0, CTL_BYTES = 1 * MiB;
constexpr unsigned WS_MOD = 1 * MiB;
constexpr unsigned WS_TAB = 1 * MiB + 512 * 1024;
constexpr unsigned WS_SMALLW = 2 * MiB;
constexpr unsigned WS_CACHE = 4 * MiB;
constexpr unsigned WS_WIN = 10 * MiB, WS_WOUT = 16 * MiB, WS_W13 = 18 * MiB, WS_W2 = 29 * MiB;
constexpr unsigned WSET_STRIDE = 184 * MiB;
constexpr unsigned WS_ACT = 35 * MiB;
constexpr unsigned WS_QA = 59 * MiB, WS_KA = 68 * MiB, WS_VTA = 71 * MiB, WS_QB = 74 * MiB, WS_KB = 80 * MiB, WS_VTB = 86 * MiB;
constexpr unsigned WS_RKV = 92 * MiB, WS_CW = 119 * MiB, WS_CA = 122 * MiB, WS_CG = 125 * MiB;
constexpr unsigned WS_YF = 128 * MiB, WS_YB = 146 * MiB;
constexpr unsigned WS_SV = 164 * MiB;
constexpr unsigned WS_BO2 = 182 * MiB, WS_ML = 230 * MiB;
constexpr unsigned WS_XB = 206 * MiB;
constexpr unsigned WS_WSET1 = 194 * MiB;
constexpr unsigned WS_RM = 236 * MiB, WS_RN = 254 * MiB, WS_RP = 324 * MiB, WS_RH = 342 * MiB;
constexpr int NCHUNK = 2304;
constexpr unsigned WS_U = 128 * MiB;
constexpr unsigned WS_G = 290 * MiB, WS_SB = 299 * MiB, WS_BO = 300 * MiB, WS_END = 360 * MiB;
constexpr int SMALLW_L = 147456;
constexpr int TAB_COSA = 0, TAB_SINA = 1024, TAB_COSB = 2048, TAB_SINB = 2560, TAB_LAM = 3072;
constexpr int LDS_BYTES = 147456;
constexpr int NPHASE = 2 + 9 * DEPTH;

struct Args {
    const float* in[34];
    float* out; unsigned char* ws;
    int ph_lo, ph_hi;
};

struct EpiRes {
    static constexpr bool PERM = true, AFTER_DRAIN = false;
    const float* baseC; const float* baseL; unsigned char* ws; const float* gate; bool first;
    template <int MF>
    __device__ __forceinline__ void operator()(const f32x4 (&acc)[2][2][MF][2], const pg8::Unit& u, int wr, int wc, int fr_, int fq_) const {
        int fr = fr_, fq = fq_; asm volatile("" : "+v"(fr), "+v"(fq));
        const unsigned col0 = u.pn * 256 + wc * 32 + 8 * fq, rowb = u.pm * (MF * 64) + wr * (MF * 16);
        f32x4 g4[2][2]; int vcur = -1;
#pragma unroll
        for (int ai = 0; ai < 2; ++ai)
#pragma unroll
            for (int m = 0; m < MF; ++m) { const unsigned rf = rowb + ai * (MF * 32) + m * 16, off = (rf + fr) * DM + col0;
                const int v = rf < MC ? 0 : (rf < MC + 4096 ? 1 : 2);
                if (v != vcur) { vcur = v;
#pragma unroll
                    for (int bj = 0; bj < 2; ++bj)
#pragma unroll
                        for (int n = 0; n < 2; ++n) g4[bj][n] = LDG(f32x4, gate, (v * 6144 + col0 + bj * 128 + n * 4) * 4); }
#pragma unroll
                for (int bj = 0; bj < 2; ++bj) { f32x4 b0, b1;
                    if (first) { const float* base = rf < MC ? baseC : baseL; b0 = LDG(f32x4, base, (off + bj * 128) * 4); b1 = LDG(f32x4, base, (off + bj * 128 + 4) * 4); }
                    else { const u32x4 xb = LDG(u32x4, ws, WS_XB + (off + bj * 128) * 2); b0 = (f32x4){bf_lo(xb.x), bf_hi(xb.x), bf_lo(xb.y), bf_hi(xb.y)}; b1 = (f32x4){bf_lo(xb.z), bf_hi(xb.z), bf_lo(xb.w), bf_hi(xb.w)}; }
                    b0 = b0 + g4[bj][0] * acc[ai][bj][m][0]; b1 = b1 + g4[bj][1] * acc[ai][bj][m][1];
                    u32x4 w; w.x = pk2(b0[0], b0[1]); w.y = pk2(b0[2], b0[3]); w.z = pk2(b1[0], b1[1]); w.w = pk2(b1[2], b1[3]);
                    STG(u32x4, ws, WS_XB + (off + bj * 128) * 2) = w; } }
    }
};
struct EpiSwi {
    static constexpr bool PERM = true, AFTER_DRAIN = false;
    bf16_t* U;
    template <int MF>
    __device__ __forceinline__ void operator()(const f32x4 (&acc)[2][2][MF][2], const pg8::Unit& u, int wr, int wc, int fr_, int fq_) const {
        int fr = fr_, fq = fq_; asm volatile("" : "+v"(fr), "+v"(fq));
        const unsigned row0 = u.pm * (MF * 64) + wr * (MF * 16) + fr, oc0 = u.pn * 128 + wc * 32 + 8 * fq;
#pragma unroll
        for (int ai = 0; ai < 2; ++ai)
#pragma unroll
            for (int m = 0; m < MF; ++m) { const unsigned ro = ((row0 + ai * (MF * 32) + m * 16) * FF + oc0) * 2; f32x4 o[2];
#pragma unroll
                for (int bj = 0; bj < 2; ++bj) { const f32x4 g = acc[ai][bj][m][0], up = acc[ai][bj][m][1];
#pragma unroll
                    for (int e = 0; e < 4; ++e) o[bj][e] = g[e] * sigmf(g[e]) * up[e]; }
                const u32x2 lo = pack4(o[0]), hi2 = pack4(o[1]);
                STG(u32x4, U, ro) = (u32x4){lo.x, lo.y, hi2.x, hi2.y}; asm volatile("" ::: "memory"); }
    }
};
struct EpiWin {
    static constexpr bool PERM = true, AFTER_DRAIN = false;
    unsigned char* ws; float* out; int l;
    template <int MF>
    __device__ __forceinline__ void operator()(const f32x4 (&acc)[2][2][MF][2], const pg8::Unit& u, int wr, int wc, int fr_, int fq_) const {
        int fr = fr_, fq = fq_; asm volatile("" : "+v"(fr), "+v"(fq));
        const unsigned rowb = u.pm * (MF * 64) + wr * (MF * 16), row0 = rowb + fr;
#pragma unroll
        for (int bj = 0; bj < 2; ++bj) {
            const unsigned c32 = u.pn * 256 + bj * 128 + wc * 32;
            const unsigned c8 = c32 + 8 * fq;
            if (c32 < 1152 && (c32 < 512 || c32 >= 640)) {
                const bool isA = c32 < 512;
                const bool isK = isA ? (c32 >= 384) : (c32 >= 896);
                const float qs = isK ? 1.f : (isA ? QSCALE_A : QSCALE_B);
                const unsigned ck = isA ? c8 - 384 : c8 - 896;
                const unsigned dbase = isA ? (isK ? WS_KA + (((ck >> 6) * 4 + ((ck & 63) >> 4)) * 64 + ((ck >> 3) & 1) * 32) * 16 : WS_QA + c8 * 2)
                                           : (isK ? WS_KB + (((ck >> 5) * 2 + ((ck & 31) >> 4)) * 64 + ((ck >> 3) & 1) * 32) * 16 : WS_QB + (c8 - 640) * 2);
                const unsigned dpitch = isA ? 768u : 512u;
#pragma unroll
                for (int ai = 0; ai < 2; ++ai)
#pragma unroll
                    for (int m = 0; m < MF; ++m) {
                        const unsigned row = row0 + ai * (MF * 32) + m * 16; const bool lat = rowb + ai * (MF * 32) + m * 16 >= (unsigned)MC;
                        f32x4 v0 = acc[ai][bj][m][0], v1 = acc[ai][bj][m][1];
                        if (lat) {
                            const unsigned t = (row - MC) & 4095, rp = t >> 6, cp = t & 63;
                            unsigned to_;
                            if (isA) { const unsigned pos = ((c32 >> 5) & 1) ? cp : rp; to_ = WS_TAB + (TAB_COSA + pos * 16 + 4 * fq) * 4; }
                            else { const unsigned pos = (fq >> 1) ? cp : rp; to_ = WS_TAB + (TAB_COSB + pos * 8 + 4 * (fq & 1)) * 4; }
                            const f32x4 c4 = LDG(f32x4, ws, to_), s4 = LDG(f32x4, ws, to_ + (isA ? 4096u : 2048u));
                            f32x4 w0, w1;
                            w0[0] = v0[0] * c4[0] - v0[1] * s4[0]; w0[1] = v0[1] * c4[0] + v0[0] * s4[0];
                            w0[2] = v0[2] * c4[1] - v0[3] * s4[1]; w0[3] = v0[3] * c4[1] + v0[2] * s4[1];
                            w1[0] = v1[0] * c4[2] - v1[1] * s4[2]; w1[1] = v1[1] * c4[2] + v1[0] * s4[2];
                            w1[2] = v1[2] * c4[3] - v1[3] * s4[3]; w1[3] = v1[3] * c4[3] + v1[2] * s4[3];
                            v0 = w0; v1 = w1;
                        } else if (isK) {
                            const unsigned b = row >> 8, t = row & 255;
                            const f32x4 ev = {v0[0], v0[2], v1[0], v1[2]}, od = {v0[1], v0[3], v1[1], v1[3]};
                            if (isA) { const unsigned o = (OFF_AK + ((b * 4 + l) * 256 + t) * 128 + (c32 - 384) + 4 * fq) * 4; STG(f32x4, out, o) = ev; STG(f32x4, out, o + 64) = od; }
                            else { const unsigned o = (OFF_BK + ((b * 4 + l) * 256 + t) * 256 + ((c8 - 896) & ~15u) + 4 * (fq & 1)) * 4; STG(f32x4, out, o) = ev; STG(f32x4, out, o + 32) = od; }
                        }
                        v0 = v0 * qs; v1 = v1 * qs;
                        u32x4 w; w.x = pk2(v0[0], v0[1]); w.y = pk2(v0[2], v0[3]); w.z = pk2(v1[0], v1[1]); w.w = pk2(v1[2], v1[3]);
                        STG(u32x4, ws, isK ? dbase + (row >> 5) * (isA ? 8192u : 16384u) + (row & 31) * 16 : dbase + row * dpitch) = w;
                        asm volatile("" ::: "memory");
                    }
            } else if (c32 < 1408) {
                const bool isA = c32 < 640;
                const unsigned cc = isA ? (c8 - 512) : (c8 - 1152);
                const unsigned vt = (isA ? WS_VTA : WS_VTB) + ((((cc >> 6) * 2 + ((cc >> 5) & 1)) * 2) * 64 + (cc & 31)) * 16;
#pragma unroll
                for (int ai = 0; ai < 2; ++ai)
#pragma unroll
                    for (int m = 0; m < MF; ++m) {
                        const unsigned row = row0 + ai * (MF * 32) + m * 16; const bool lat = rowb + ai * (MF * 32) + m * 16 >= (unsigned)MC;
                        const f32x4 v0 = acc[ai][bj][m][0], v1 = acc[ai][bj][m][1];
                        if (!lat) { const unsigned b = row >> 8, t = row & 255;
                            const unsigned o = isA ? (OFF_AV + ((b * 4 + l) * 256 + t) * 128 + cc) * 4 : (OFF_BV + ((b * 4 + l) * 256 + t) * 256 + cc) * 4;
                            STG(f32x4, out, o) = v0; STG(f32x4, out, o + 16) = v1; }
                        const unsigned p0 = pk2(v0[0], v0[1]), p1 = pk2(v0[2], v0[3]), p2 = pk2(v1[0], v1[1]), p3 = pk2(v1[2], v1[3]);
                        const unsigned tt = row & 31, rem = tt & 15;
                        const unsigned vo = vt + (row >> 5) * (isA ? 8192u : 16384u) + (tt >> 4) * 1024 + ((rem >> 2) & 1) * 512 + (4 * (rem >> 3) + (rem & 3)) * 2;
                        STG(bf16_t, ws, vo + 0 * 16) = (bf16_t)(p0 & 0xffff); STG(bf16_t, ws, vo + 1 * 16) = (bf16_t)(p0 >> 16);
                        STG(bf16_t, ws, vo + 2 * 16) = (bf16_t)(p1 & 0xffff); STG(bf16_t, ws, vo + 3 * 16) = (bf16_t)(p1 >> 16);
                        STG(bf16_t, ws, vo + 4 * 16) = (bf16_t)(p2 & 0xffff); STG(bf16_t, ws, vo + 5 * 16) = (bf16_t)(p2 >> 16);
                        STG(bf16_t, ws, vo + 6 * 16) = (bf16_t)(p3 & 0xffff); STG(bf16_t, ws, vo + 7 * 16) = (bf16_t)(p3 >> 16);
                        asm volatile("" ::: "memory");
                    }
            } else if (c32 < 2944) {
                const int kind = c32 < 2560 ? 0 : (c32 < 2688 ? 1 : (c32 < 2816 ? 2 : 3));
                const unsigned dbase = kind == 0 ? WS_RKV + (c8 - 1408) * 2 : (kind == 1 ? WS_CW + (c8 - 2560) * 2 : (kind == 2 ? WS_CA + (c8 - 2688) * 2 : WS_CG + (c8 - 2816) * 2));
                const unsigned dpitch = kind == 0 ? 2304u : 256u;
#pragma unroll
                for (int ai = 0; ai < 2; ++ai)
#pragma unroll
                    for (int m = 0; m < MF; ++m) {
                        const unsigned row = row0 + ai * (MF * 32) + m * 16; const bool lat = rowb + ai * (MF * 32) + m * 16 >= (unsigned)MC;
                        f32x4 v0 = acc[ai][bj][m][0], v1 = acc[ai][bj][m][1];
                        if (kind == 1) {
#pragma unroll
                            for (int e = 0; e < 4; ++e) { v0[e] = 1.f - 2.f * __builtin_amdgcn_rcpf(__expf(2.f * v0[e]) + 1.f); v1[e] = 1.f - 2.f * __builtin_amdgcn_rcpf(__expf(2.f * v1[e]) + 1.f); }
                        } else if (kind == 3) {
#pragma unroll
                            for (int e = 0; e < 4; ++e) { v0[e] = sigmf(v0[e]); v1[e] = sigmf(v1[e]); }
                        }
                        u32x4 w; w.x = pk2(v0[0], v0[1]); w.y = pk2(v0[2], v0[3]); w.z = pk2(v1[0], v1[1]); w.w = pk2(v1[2], v1[3]);
                        STG(u32x4, ws, dbase + row * dpitch) = w;
                        asm volatile("" ::: "memory");
                    }
            }
        }
    }
};

struct Frame {
    LAS unsigned char* lds;
    const float* const* in;
    float* out; unsigned char* ws;
    int tid, lane, wave, gw, ngw, G, bid;
};
#define GAS __attribute__((address_space(1)))
template <class T> __device__ __forceinline__ T* gptr(T* p) {
#if defined(__HIP_DEVICE_COMPILE__)
    __builtin_assume(!__builtin_amdgcn_is_shared((const void*)p)); __builtin_assume(!__builtin_amdgcn_is_private((const void*)p));
#endif
    return p; }
#define INP(k) gptr(F.in[k])
#define WSP(T, off) gptr((T*)(F.ws + (off)))

__device__ __forceinline__ void phase_prologue(Frame& F) {
    const float* cvec = INP(8); const float* cctx = INP(9); const float* ada_w = INP(10); const float* ada_b = INP(11);
    LAS float* sl = (LAS float*)F.lds;
    LAS float* red = (LAS float*)(F.lds + 16384);
    for (int i = F.tid; i < 3072; i += 512) { const int v = i >> 10, k = i & 1023; const float x = v == 0 ? cctx[k] : cvec[(v - 1) * 1024 + k]; sl[i] = x / (1.f + __expf(-x)); }
    __syncthreads();
    float* mod = WSP(float, WS_MOD);
    for (int it = F.bid; it < 384; it += F.G) {
        const int l = it / 96, n0 = (it % 96) * 64;
        const float* W = ada_w + (size_t)l * 1024 * 6144 + n0 + F.lane;
        float a0 = 0.f, a1 = 0.f, a2 = 0.f;
        const int k0 = F.wave * 128;
#pragma unroll 8
        for (int k = k0; k < k0 + 128; ++k) { const float w = *(const GAS float*)(W + (size_t)k * 6144); a0 += sl[k] * w; a1 += sl[1024 + k] * w; a2 += sl[2048 + k] * w; }
        red[(F.wave * 3 + 0) * 64 + F.lane] = a0; red[(F.wave * 3 + 1) * 64 + F.lane] = a1; red[(F.wave * 3 + 2) * 64 + F.lane] = a2;
        __syncthreads();
        if (F.wave < 3) { float s = ada_b[l * 6144 + n0 + F.lane];
#pragma unroll
            for (int w = 0; w < 8; ++w) s += red[(w * 3 + F.wave) * 64 + F.lane];
            mod[(size_t)(l * 3 + F.wave) * 6144 + n0 + F.lane] = s; }
        __syncthreads();
    }
    float* tab = WSP(float, WS_TAB);
    if (F.bid == F.G - 1) {
        for (int i = F.tid; i < 1024; i += 512) { const int pos = i >> 4, f = i & 15; const float ang = (float)pos * __builtin_amdgcn_exp2f(-(float)f * (13.287712379549449f / 16.f)); tab[TAB_COSA + i] = __cosf(ang); tab[TAB_SINA + i] = __sinf(ang); }
        for (int i = F.tid; i < 512; i += 512) { const int pos = i >> 3, f = i & 7; const float ang = (float)pos * __builtin_amdgcn_exp2f(-(float)f * (13.287712379549449f / 8.f)); tab[TAB_COSB + i] = __cosf(ang); tab[TAB_SINB + i] = __sinf(ang); }
        if (F.wave < 4) { const float* lp = INP(16) + F.wave * 128; const int d = F.lane & 31;
            const float p1 = wave_sum(F.lane < 32 ? lp[d] * lp[32 + d] : 0.f), p2 = wave_sum(F.lane < 32 ? 0.f : lp[64 + d] * lp[96 + d]);
            if (F.lane == 0) tab[TAB_LAM + F.wave] = __expf(p1) - __expf(p2); }
    }
    const int gtid = F.bid * 512 + F.tid, gnt = F.G * 512;
    { bf16_t* sw = WSP(bf16_t, WS_SMALLW); const float* cw2 = INP(20); const float* ca2 = INP(22); const float* cg2 = INP(23);
      for (int idx = gtid; idx < 4 * SMALLW_L; idx += gnt) { const int l = idx / SMALLW_L, r = idx % SMALLW_L; float v;
          if (r < 98304) { const int which = r / 49152, rr = r % 49152, d = rr / 24576, ch = (rr % 24576) / 64, k = rr % 64; v = (which ? ca2 : cw2)[((size_t)(l * 2 + d) * 64 + k) * 384 + ch]; }
          else { const int rr = r - 98304, ch = rr / 128, k = rr % 128; v = cg2[((size_t)l * 128 + k) * 384 + ch]; }
          sw[idx] = (bf16_t)(pk2(v, 0.f) & 0xffff); } }
    { bf16_t* kca = WSP(bf16_t, WS_CACHE); bf16_t* vca = kca + 524288; bf16_t* kcb = vca + 524288; bf16_t* vcb = kcb + 1048576;
      const float* cak = INP(2); const float* cav = INP(3); const float* cbk = INP(4); const float* cbv = INP(5);
      for (int e = gtid; e < 524288; e += gnt) {
          const int j = e & 7, ln = (e >> 3) & 63, hi = ln >> 5, r32 = ln & 31, blk = (e >> 12) & 15, bl = e >> 16;
          { const int s = (e >> 9) & 3, kvh = (e >> 11) & 1, cp = kvh * 64 + 16 * s + 8 * hi + j, o = cp & 31, c = (cp - o) + (o >> 1) + 16 * (o & 1);
            kca[e] = (bf16_t)(pk2(cak[((size_t)bl * 512 + blk * 32 + r32) * 128 + c], 0.f) & 0xffff); }
          { const int ks = (e >> 9) & 1, db = (e >> 10) & 1, kvh = (e >> 11) & 1, key = blk * 32 + 16 * ks + 8 * (j >> 2) + 4 * hi + (j & 3);
            vca[e] = (bf16_t)(pk2(cav[((size_t)bl * 512 + key) * 128 + kvh * 64 + db * 32 + r32], 0.f) & 0xffff); } }
      for (int e = gtid; e < 1048576; e += gnt) {
          const int j = e & 7, ln = (e >> 3) & 63, hi = ln >> 5, r32 = ln & 31, blk = (e >> 13) & 15, bl = e >> 17;
          { const int s = (e >> 9) & 1, hm = (e >> 10) & 7, cp = hm * 32 + 16 * s + 8 * hi + j, o = cp & 15, c = (cp - o) + (o >> 1) + 8 * (o & 1);
            kcb[e] = (bf16_t)(pk2(cbk[((size_t)bl * 512 + blk * 32 + r32) * 256 + c], 0.f) & 0xffff); }
          { const int ks = (e >> 9) & 1, db = (e >> 10) & 1, h = (e >> 11) & 3, key = blk * 32 + 16 * ks + 8 * (j >> 2) + 4 * hi + (j & 3);
            vcb[e] = (bf16_t)(pk2(cbv[((size_t)bl * 512 + key) * 256 + h * 64 + db * 32 + r32], 0.f) & 0xffff); } } }
    for (int st = 0; st < 1; ++st) { u32x4* z = (u32x4*)(WSP(bf16_t, WS_WIN + st * WSET_STRIDE) + (size_t)2944 * 1024); unsigned z0; asm volatile("v_mov_b32 %0, 0" : "=v"(z0)); for (int i = gtid; i < 128 * 1024 / 8; i += gnt) z[i] = (u32x4){z0, z0, z0, z0}; }
}

template <int MAP> __device__ __forceinline__ int dest_row(int n) {
    if (MAP == 1) {
        if (n < 512) { const int o = n & 31; return (n - o) + 2 * (o & 15) + (o >> 4); }
        if (n >= 640 && n < 1152) { const int o = n & 15; return (n - o) + 2 * (o & 7) + (o >> 3); }
        return n;
    }
    if (MAP == 2 || MAP == 3) return (n >> 7) * 256 + ((n >> 2) & 1) * 128 + ((n >> 5) & 3) * 32 + ((n >> 3) & 3) * 8 + (MAP == 3 ? 4 : 0) + (n & 3);
    return n;
}
template <int MAP> __device__ __forceinline__ void transpose_item(const float* W, int K, int N, bf16_t* WT, LAS float* scr, int item, int lane) {
    const int nblk = N / 32, kb = item / nblk, nb = item % nblk, k0 = 64 * kb, n0 = 32 * nb;
#pragma unroll 8
    for (int i = 0; i < 32; ++i) { const int kk = 2 * i + (lane >> 5); scr[kk * 33 + (lane & 31)] = *(const GAS float*)(W + (size_t)(k0 + kk) * N + n0 + (lane & 31)); }
    asm volatile("s_waitcnt lgkmcnt(0)" ::: "memory");
    const int c = lane & 7;
#pragma unroll
    for (int j = 0; j < 4; ++j) { const int n = (lane >> 3) + 8 * j; const LAS float* s = scr + (8 * c) * 33 + n;
        u32x4 o; o.x = pk2(s[0 * 33], s[1 * 33]); o.y = pk2(s[2 * 33], s[3 * 33]); o.z = pk2(s[4 * 33], s[5 * 33]); o.w = pk2(s[6 * 33], s[7 * 33]);
        *(GAS u32x4*)(WT + (size_t)dest_row<MAP>(n0 + n) * K + k0 + 8 * c) = o; }
    asm volatile("s_waitcnt lgkmcnt(0)" ::: "memory");
}
template <int MAP> __device__ __forceinline__ void convert_item(const float* W, int K, int N, bf16_t* WT, int item, int lane) {
    const int nblk = N / 64, kb = item / nblk, nb = item % nblk, n = nb * 64 + lane;
    const GAS float* src = (const GAS float*)W + (size_t)(kb * 128) * N + n;
    GAS bf16_t* dst = (GAS bf16_t*)WT + (size_t)dest_row<MAP>(n) * K + kb * 128;
#pragma unroll
    for (int g = 0; g < 16; ++g) { float v[8];
#pragma unroll
        for (int e = 0; e < 8; ++e) v[e] = src[(size_t)(8 * g + e) * N];
        u32x4 o; o.x = pk2(v[0], v[1]); o.y = pk2(v[2], v[3]); o.z = pk2(v[4], v[5]); o.w = pk2(v[6], v[7]);
        *(GAS u32x4*)(dst + 8 * g) = o; }
}
constexpr int CV_IN = 46 * 8, CV_OUT = 16 * 8, CV_1 = 44 * 8, CV_2 = 16 * 22, CV_TOTAL = CV_IN + CV_OUT + 2 * CV_1 + CV_2;
__device__ __forceinline__ void convert_item_any(Frame& F, int l, int it) {
    const unsigned so = 0u * WSET_STRIDE;
    int r = it;
    if (r < CV_IN) { convert_item<1>(INP(14) + (size_t)l * 1024 * 2944, 1024, 2944, WSP(bf16_t, WS_WIN + so), r, F.lane); return; } r -= CV_IN;
    if (r < CV_OUT) { convert_item<0>(INP(29) + (size_t)l * 1024 * 1024, 1024, 1024, WSP(bf16_t, WS_WOUT + so), r, F.lane); return; } r -= CV_OUT;
    if (r < CV_1) { convert_item<2>(INP(30) + (size_t)l * 1024 * FF, 1024, FF, WSP(bf16_t, WS_W13 + so), r, F.lane); return; } r -= CV_1;
    if (r < CV_1) { convert_item<3>(INP(31) + (size_t)l * 1024 * FF, 1024, FF, WSP(bf16_t, WS_W13 + so), r, F.lane); return; } r -= CV_1;
    convert_item<0>(INP(32) + (size_t)l * FF * 1024, FF, 1024, WSP(bf16_t, WS_W2 + so), r, F.lane);
}
__device__ __forceinline__ void convert_weights(Frame& F, int l) {
    LAS float* scr = (LAS float*)(F.lds + F.wave * 16384); const unsigned so = 0u * WSET_STRIDE;
    const float* w_in = INP(14) + (size_t)l * 1024 * 2944; const float* w_out = INP(29) + (size_t)l * 1024 * 1024;
    const float* w1 = INP(30) + (size_t)l * 1024 * FF; const float* w3 = INP(31) + (size_t)l * 1024 * FF; const float* w2 = INP(32) + (size_t)l * FF * 1024;
    constexpr int I_IN = 16 * 92, I_OUT = 16 * 32, I_1 = 16 * 88, I_2 = 44 * 32;
    constexpr int NIT = I_IN + I_OUT + 2 * I_1 + I_2;
    for (int it = F.gw; it < NIT; it += F.ngw) {
        int r = it;
        if (r < I_IN) { transpose_item<1>(w_in, 1024, 2944, WSP(bf16_t, WS_WIN + so), scr, r, F.lane); continue; } r -= I_IN;
        if (r < I_OUT) { transpose_item<0>(w_out, 1024, 1024, WSP(bf16_t, WS_WOUT + so), scr, r, F.lane); continue; } r -= I_OUT;
        if (r < I_1) { transpose_item<2>(w1, 1024, FF, WSP(bf16_t, WS_W13 + so), scr, r, F.lane); continue; } r -= I_1;
        if (r < I_1) { transpose_item<3>(w3, 1024, FF, WSP(bf16_t, WS_W13 + so), scr, r, F.lane); continue; } r -= I_1;
        transpose_item<0>(w2, FF, 1024, WSP(bf16_t, WS_W2 + so), scr, r, F.lane);
    }
}

__device__ __forceinline__ void phase_norm(Frame& F, int l, int which  ) {
    const float* g = (which ? INP(13) : INP(12)) + l * 1024;
    const float* mod = WSP(float, WS_MOD) + (size_t)l * 3 * 6144 + (which ? 3072 : 0);
    bf16_t* H = WSP(bf16_t, WS_ACT);
    const bool first = (l == 0 && which == 0);
    f32x4 gv[4];
#pragma unroll
    for (int j = 0; j < 4; ++j) gv[j] = *(const GAS f32x4*)(g + 4 * F.lane + 256 * j);
    for (int row = F.gw; row < M; row += F.ngw) {
        const float* mv = mod + (row < MC ? 0 : (row < 2 * MC ? 1 : 2)) * 6144;
        f32x4 v[4]; float ss = 0.f;
        if (first) { const float* xr = row < MC ? INP(0) + (size_t)row * DM : INP(1) + (size_t)(row - MC) * DM;
#pragma unroll
            for (int j = 0; j < 4; ++j) v[j] = *(const GAS f32x4*)(xr + 4 * F.lane + 256 * j); }
        else {
#pragma unroll
            for (int j = 0; j < 4; ++j) v[j] = unpack4(LDG(u32x2, F.ws, WS_XB + ((unsigned)row * DM + 4 * F.lane + 256 * j) * 2)); }
#pragma unroll
        for (int j = 0; j < 4; ++j) ss += (v[j][0] * v[j][0] + v[j][1] * v[j][1]) + (v[j][2] * v[j][2] + v[j][3] * v[j][3]);
        const float rstd = rsqrtf(wave_sum(ss) * (1.f / 1024.f) + 1e-6f);
#pragma unroll
        for (int j = 0; j < 4; ++j) { const f32x4 sh = *(const GAS f32x4*)(mv + 4 * F.lane + 256 * j), sc = *(const GAS f32x4*)(mv + 1024 + 4 * F.lane + 256 * j);
            const f32x4 h = v[j] * rstd * gv[j] * (sc + 1.f) + sh;
            *(GAS u32x2*)(H + (size_t)row * DM + 4 * F.lane + 256 * j) = pack4(h); }
    }
}
__device__ __forceinline__ void phase_final_norm(Frame& F) {
    const float* g = INP(33);
    f32x4 gv[4];
#pragma unroll
    for (int j = 0; j < 4; ++j) gv[j] = *(const GAS f32x4*)(g + 4 * F.lane + 256 * j);
    for (int row = F.gw; row < M; row += F.ngw) {
        float* xr = gptr(F.out + (size_t)row * DM);
        f32x4 v[4]; float ss = 0.f;
#pragma unroll
        for (int j = 0; j < 4; ++j) { v[j] = unpack4(LDG(u32x2, F.ws, WS_XB + ((unsigned)row * DM + 4 * F.lane + 256 * j) * 2)); ss += (v[j][0] * v[j][0] + v[j][1] * v[j][1]) + (v[j][2] * v[j][2] + v[j][3] * v[j][3]); }
        const float rstd = rsqrtf(wave_sum(ss) * (1.f / 1024.f) + 1e-6f);
#pragma unroll
        for (int j = 0; j < 4; ++j) *(GAS f32x4*)(xr + 4 * F.lane + 256 * j) = v[j] * rstd * gv[j];
    }
}

#define MFMA32(a, b, c) __builtin_amdgcn_mfma_f32_32x32x16_bf16((a), (b), (c), 0, 0, 0)
#ifndef ATT_PROBE
#define ATT_PROBE 0
#endif
struct AttnQ { float m, l; bool mz; f32x16 o[2]; };
template <int DQK, bool MASK, int NQ>
__device__ __forceinline__ void attn_block(const bf16x8 (&qf)[NQ][DQK / 16], const bf16x8 (&kf)[DQK / 16], const bf16x8 (&vf)[4], AttnQ (&st)[NQ], int b, const int (&qpos)[NQ], int kpos0, int hi) {
    constexpr int NS = DQK / 16;
    f32x16 sc[NQ];
#pragma unroll
    for (int q = 0; q < NQ; ++q) { const f32x16 z = {}; sc[q] = MFMA32(kf[0], qf[q][0], z);
#pragma unroll
        for (int s = 1; s < NS; ++s) sc[q] = MFMA32(kf[s], qf[q][s], sc[q]); }
#pragma unroll
    for (int q = 0; q < NQ; ++q) {
        if (!st[q].mz) {
#pragma unroll
            for (int r = 0; r < 16; ++r) sc[q][r] -= st[q].m; }
        if (MASK) {
#pragma unroll
            for (int r = 0; r < 16; ++r) { const int key = kpos0 + 32 * b + (r & 3) + 8 * (r >> 2) + 4 * hi; const int dlt = key - qpos[q]; if (dlt > 128 || dlt < -128) sc[q][r] = -1e30f; }
        }
        float bm = fmaxf(fmaxf(sc[q][0], sc[q][1]), sc[q][2]);
#pragma unroll
        for (int r = 3; r < 15; r += 2) bm = fmaxf(fmaxf(bm, sc[q][r]), sc[q][r + 1]);
        bm = fmaxf(bm, sc[q][15]);
        bm = swap32_max(bm);
        if (__builtin_amdgcn_ballot_w64(bm > 64.f) != 0ull) {
            const float d = fmaxf(bm, 0.f);
            const float alpha = __builtin_amdgcn_exp2f(-d);
            st[q].m += d; st[q].l *= alpha; st[q].mz = false;
#pragma unroll
            for (int r = 0; r < 16; ++r) { st[q].o[0][r] *= alpha; st[q].o[1][r] *= alpha; sc[q][r] -= d; }
        }
#if ATT_PROBE == 1
        { float dmy = 0.f;
#pragma unroll
          for (int r = 0; r < 16; ++r) { float e_; asm volatile("v_exp_f32 %0, %1" : "=v"(e_) : "v"(sc[q][r])); dmy += e_; }
          asm volatile("" :: "v"(dmy)); }
#endif
        f32x2 rs2 = {0.f, 0.f};
#pragma unroll
        for (int r = 0; r < 16; r += 2) { sc[q][r] = __builtin_amdgcn_exp2f(sc[q][r]); sc[q][r + 1] = __builtin_amdgcn_exp2f(sc[q][r + 1]); rs2 += (f32x2){sc[q][r], sc[q][r + 1]}; }
        st[q].l += rs2[0] + rs2[1];
#if ATT_PROBE == 3
        { float d0 = 0.f, d1 = 0.f, d2 = 0.f, d3 = 0.f;
#pragma unroll
          for (int rr = 0; rr < 10; ++rr) { asm volatile("v_add_f32 %0, %0, %4\n\tv_add_f32 %1, %1, %5\n\tv_add_f32 %2, %2, %6\n\tv_add_f32 %3, %3, %7" : "+v"(d0), "+v"(d1), "+v"(d2), "+v"(d3) : "v"(sc[q][0]), "v"(sc[q][1]), "v"(sc[q][2]), "v"(sc[q][3])); }
          asm volatile("" :: "v"(d0), "v"(d1), "v"(d2), "v"(d3)); }
#endif
#if ATT_PROBE == 2
        { f32x16 dm = sc[q]; dm = MFMA32(kf[0], qf[q][0], dm); dm = MFMA32(kf[0], qf[q][0], dm); dm = MFMA32(kf[0], qf[q][0], dm); asm volatile("" :: "v"(dm)); }
#endif
        bf16x8 pb[2];
#pragma unroll
        for (int ks = 0; ks < 2; ++ks) { u32x4 w; w.x = pk2(sc[q][8 * ks], sc[q][8 * ks + 1]); w.y = pk2(sc[q][8 * ks + 2], sc[q][8 * ks + 3]); w.z = pk2(sc[q][8 * ks + 4], sc[q][8 * ks + 5]); w.w = pk2(sc[q][8 * ks + 6], sc[q][8 * ks + 7]); pb[ks] = __builtin_bit_cast(bf16x8, w); }
#pragma unroll
        for (int db = 0; db < 2; ++db)
#pragma unroll
            for (int ks = 0; ks < 2; ++ks) st[q].o[db] = MFMA32(vf[db * 2 + ks], pb[ks], st[q].o[db]);
    }
}
template <int DQK, bool MASK, int NQ>
__device__ __forceinline__ void attn_seg(const unsigned char* ws, const bf16x8 (&qf)[NQ][DQK / 16], AttnQ (&st)[NQ],
                                         unsigned kp, unsigned kblk  , unsigned vp, unsigned vblk, int nblk, const int (&qpos)[NQ], int kpos0, int hi) {
    constexpr int NS = DQK / 16;
    const GAS unsigned char* kq = (const GAS unsigned char*)ws + kp; const GAS unsigned char* vq = (const GAS unsigned char*)ws + vp;
    bf16x8 ka[NS], va[4], kb[NS], vb[4];
#define ATT_LOAD(kd, vd) do { _Pragma("unroll") for (int s = 0; s < NS; ++s) kd[s] = *(const GAS bf16x8*)(kq + 1024 * s); _Pragma("unroll") for (int f = 0; f < 4; ++f) vd[f] = *(const GAS bf16x8*)(vq + 1024 * f); } while (0)
    ATT_LOAD(ka, va);
    int b = 0;
    for (; b + 1 < nblk; b += 2) {
        kq += kblk; vq += vblk; ATT_LOAD(kb, vb);
        attn_block<DQK, MASK, NQ>(qf, ka, va, st, b, qpos, kpos0, hi);
        if (b + 2 < nblk) { kq += kblk; vq += vblk; }
        ATT_LOAD(ka, va);
        attn_block<DQK, MASK, NQ>(qf, kb, vb, st, b + 1, qpos, kpos0, hi);
    }
    if (b < nblk) attn_block<DQK, MASK, NQ>(qf, ka, va, st, b, qpos, kpos0, hi);
#undef ATT_LOAD
}
__device__ __forceinline__ void attnq_init(AttnQ& s, float l0) { s.m = 0.f; s.mz = true; s.l = l0; s.o[0] = (f32x16){}; s.o[1] = (f32x16){}; }
__device__ __forceinline__ void attn_a_item(Frame& F, int l, bool lat, int item) {
    int lane = F.lane; asm volatile("" : "+v"(lane));
    const unsigned char* ws = F.ws;
    const unsigned r32 = lane & 31, hi = lane >> 5;
    const unsigned nqb = lat ? 128 : 8;
    const unsigned qb = item % nqb, hq = (item / nqb) % 6, b = item / (nqb * 6), kvh = hq / 3;
    const unsigned seq0 = lat ? MC + b * 4096 : b * 256, q0 = qb * 32, row = seq0 + q0 + r32;
    const unsigned qo = WS_QA + (row * 384 + hq * 64 + 8 * hi) * 2;
    bf16x8 qf[1][4];
#pragma unroll
    for (int s = 0; s < 4; ++s) qf[0][s] = LDG(bf16x8, ws, qo + 32 * s);
    AttnQ st[1]; attnq_init(st[0], hi == 0 ? __builtin_amdgcn_exp2f(INP(15)[l * 6 + hq] * LOG2E) : 0.f);
    const int qpos[1] = {(int)(q0 + r32)};
    const unsigned fo = kvh * 4096 + lane * 16;
    if (!lat) {
        attn_seg<64, false, 1>(ws, qf, st, WS_KA + (seq0 >> 5) * 8192 + fo, 8192, WS_VTA + (seq0 >> 5) * 8192 + fo, 8192, 8, qpos, 0, hi);
    } else {
        const int ks = (int)q0 - 128 < 0 ? 0 : (int)q0 - 128, ke = q0 + 160 > 4096 ? 4096 : q0 + 160;
        attn_seg<64, true, 1>(ws, qf, st, WS_KA + ((seq0 + ks) >> 5) * 8192 + fo, 8192, WS_VTA + ((seq0 + ks) >> 5) * 8192 + fo, 8192, (ke - ks) >> 5, qpos, ks, hi);
        attn_seg<64, false, 1>(ws, qf, st, WS_CACHE + (b * 4 + l) * 131072 + fo, 8192, WS_CACHE + 1 * MiB + (b * 4 + l) * 131072 + fo, 8192, 16, qpos, 0, hi);
    }
    const float rl = 1.f / swap32_sum(st[0].l);
    const unsigned oo = WS_ACT + (row * DM + hq * 64 + 4 * hi) * 2;
#pragma unroll
    for (int db = 0; db < 2; ++db)
#pragma unroll
        for (int g = 0; g < 4; ++g) { const f32x4 v = {st[0].o[db][4 * g] * rl, st[0].o[db][4 * g + 1] * rl, st[0].o[db][4 * g + 2] * rl, st[0].o[db][4 * g + 3] * rl}; STG(u32x2, F.ws, oo + (32 * db + 8 * g) * 2) = pack4(v); }
}
__device__ __forceinline__ void attn_b_store(Frame& F, const AttnQ& s, unsigned mp, unsigned kh, unsigned row, unsigned h, unsigned hi) {
    const float lt = swap32_sum(s.l);
    const unsigned oo = WS_BO2 + (((mp * 2 + kh) * M + row) * 256 + h * 64 + 4 * hi) * 2;
#pragma unroll
    for (int db = 0; db < 2; ++db)
#pragma unroll
        for (int g = 0; g < 4; ++g) STG(u32x2, F.ws, oo + (32 * db + 8 * g) * 2) = pack4((f32x4){s.o[db][4 * g], s.o[db][4 * g + 1], s.o[db][4 * g + 2], s.o[db][4 * g + 3]});
    if (hi == 0) STG(f32x2, F.ws, WS_ML + ((((mp * 2 + kh) * M + row) * 4 + h) * 2) * 4) = (f32x2){s.m, lt};
}
__device__ __forceinline__ void attn_b_item(Frame& F, int l, bool lat, int item) {
    int lane = F.lane; asm volatile("" : "+v"(lane));
    const unsigned char* ws = F.ws;
    const unsigned r32 = lane & 31, hi = lane >> 5;
    if (lat) {
        const unsigned kh = item & 1, qb = (item >> 1) & 63, mp = (item >> 7) & 1, h = (item >> 8) & 3, b = item >> 10;
        const unsigned seq0 = MC + b * 4096, row0 = seq0 + qb * 64 + r32;
        bf16x8 qf[2][2];
#pragma unroll
        for (int q = 0; q < 2; ++q)
#pragma unroll
            for (int s = 0; s < 2; ++s) qf[q][s] = LDG(bf16x8, ws, WS_QB + ((row0 + 32 * q) * 256 + h * 64 + mp * 32 + 8 * hi) * 2 + 32 * s);
        AttnQ st[2]; attnq_init(st[0], 0.f); attnq_init(st[1], 0.f);
        const int qpos[2] = {0, 0};
        const unsigned kfo = (h * 2 + mp) * 2048 + lane * 16, vfo = h * 4096 + lane * 16;
        const unsigned blk0 = kh ? 72u : 0u, nb = kh ? 56 : 72;
        attn_seg<32, false, 2>(ws, qf, st, WS_KB + ((seq0 >> 5) + blk0) * 16384 + kfo, 16384, WS_VTB + ((seq0 >> 5) + blk0) * 16384 + vfo, 16384, nb, qpos, 0, hi);
        if (kh) attn_seg<32, false, 2>(ws, qf, st, WS_CACHE + 2 * MiB + (b * 4 + l) * 262144 + kfo, 16384, WS_CACHE + 4 * MiB + (b * 4 + l) * 262144 + vfo, 16384, 16, qpos, 0, hi);
        attn_b_store(F, st[0], mp, kh, row0, h, hi); attn_b_store(F, st[1], mp, kh, row0 + 32, h, hi);
    } else {
        const unsigned qb = item & 7, mp = (item >> 3) & 1, h = (item >> 4) & 3, b = item >> 6;
        const unsigned seq0 = b * 256, row = seq0 + qb * 32 + r32;
        bf16x8 qf[1][2];
#pragma unroll
        for (int s = 0; s < 2; ++s) qf[0][s] = LDG(bf16x8, ws, WS_QB + (row * 256 + h * 64 + mp * 32 + 8 * hi) * 2 + 32 * s);
        AttnQ st[1]; attnq_init(st[0], 0.f);
        const int qpos[1] = {0};
        const unsigned kfo = (h * 2 + mp) * 2048 + lane * 16, vfo = h * 4096 + lane * 16;
        attn_seg<32, false, 1>(ws, qf, st, WS_KB + (seq0 >> 5) * 16384 + kfo, 16384, WS_VTB + (seq0 >> 5) * 16384 + vfo, 16384, 8, qpos, 0, hi);
        attn_b_store(F, st[0], mp, 0, row, h, hi);
    }
}

constexpr int L_KT = 0, L_RT = 9216, L_BT = 18432, L_KK = 27648, L_VT = 36864, L_KKT = 46080, L_BTT = 55296, L_A1 = 64512, L_RHS2 = 81920, L_WT = 99328, L_U0T = 108544, L_GC = 117760, L_X0 = 118016;
constexpr int RPB = 144, RPF = 272;
__device__ __forceinline__ void chunk_decode(int cid, unsigned& seq0, int& T, unsigned& b, unsigned& h, unsigned& dir, int& c) {
    unsigned chain;
    if (cid < 768) { chain = (unsigned)cid >> 2; c = cid & 3; T = 256; b = chain / 12; seq0 = b * 256; }
    else { const unsigned x = (unsigned)cid - 768; chain = x >> 6; c = (int)(x & 63); T = 4096; b = chain / 12; seq0 = MC + b * 4096; }
    dir = chain & 1; h = (chain >> 1) % 6;
}
__device__ __forceinline__ bf16x8 acc_frag(const f32x16& x, int ks, float sgn) {
    u32x4 w; w.x = pk2(sgn * x[8 * ks], sgn * x[8 * ks + 1]); w.y = pk2(sgn * x[8 * ks + 2], sgn * x[8 * ks + 3]); w.z = pk2(sgn * x[8 * ks + 4], sgn * x[8 * ks + 5]); w.w = pk2(sgn * x[8 * ks + 6], sgn * x[8 * ks + 7]);
    return __builtin_bit_cast(bf16x8, w);
}
__device__ __forceinline__ bf16x8 lds_frag_nat(const LAS unsigned char* img, unsigned row, int ks, unsigned hi) { return *(const LAS bf16x8*)(img + row * RPB + (16 * ks + 8 * hi) * 2); }
__device__ __forceinline__ bf16x8 lds_frag_perm(const LAS unsigned char* img, unsigned row, int k0, unsigned hi) {
    const s16x4 a = *(const LAS s16x4*)(img + row * RPB + (k0 + 4 * hi) * 2), b = *(const LAS s16x4*)(img + row * RPB + (k0 + 8 + 4 * hi) * 2);
    return (bf16x8){a[0], a[1], a[2], a[3], b[0], b[1], b[2], b[3]};
}
__device__ __forceinline__ f32x16 gram_tile(const LAS unsigned char* lds, int aimg, int bimg, int sb, int tb, unsigned r32, unsigned hi, bool strict) {
    f32x16 acc = {};
#pragma unroll
    for (int ks = 0; ks < 4; ++ks) acc = MFMA32(lds_frag_nat(lds + aimg, 32 * sb + r32, ks, hi), lds_frag_nat(lds + bimg, 32 * tb + r32, ks, hi), acc);
    if (sb == tb) {
#pragma unroll
        for (int r = 0; r < 16; ++r) { const unsigned s_ = (r & 3) + 8 * (r >> 2) + 4 * hi; const bool keep = strict ? s_ < r32 : s_ <= r32; acc[r] = keep ? acc[r] : 0.f; }
    }
    return acc;
}
__device__ __forceinline__ void lds_barrier() { asm volatile("s_waitcnt lgkmcnt(0)\n\ts_barrier" ::: "memory"); }
__device__ __forceinline__ void rwkv_chunk_block(Frame& F, int l, int cid) {
    int lane = F.lane; asm volatile("" : "+v"(lane));
    const unsigned char* ws = F.ws; LAS unsigned char* lds = F.lds;
    const int w = F.wave; const unsigned r32 = lane & 31, hi = lane >> 5;
    unsigned seq0, b, h, dir; int T, c; chunk_decode(cid, seq0, T, b, h, dir, c);
    const int q0 = 64 * c;
#ifndef RA_REP
#define RA_REP 0
#endif
    const int role = w >> 1, tb = w & 1;
    const unsigned swo = WS_SMALLW + l * (SMALLW_L * 2);
    {
        const int pw_ = w < 4, pb = (w >> 1) & 1, cb = w & 1;
        const int p_ = 32 * pb + r32; const unsigned tokp = seq0 + (dir ? T - 1 - (q0 + p_) : q0 + p_);
        const unsigned xo = (pw_ ? WS_CW : WS_CA) + (tokp * 128 + dir * 64 + 8 * hi) * 2, wo = swo + ((pw_ ? 0 : 49152) + (dir * 384 + h * 64 + 32 * cb + r32) * 64 + 8 * hi) * 2;
        f32x16 acc = {};
#pragma unroll
        for (int ks = 0; ks < 4; ++ks) acc = MFMA32(LDG(bf16x8, ws, xo + 32 * ks), LDG(bf16x8, ws, wo + 32 * ks), acc);
        {
            const float bias = LDG(float, pw_ ? INP(19) : INP(21), ((l * 2 + dir) * 384 + h * 64 + 32 * cb + r32) * 4);
#pragma unroll
            for (int r = 0; r < 16; ++r) { const float sg = sigmf(bias + acc[r]);
                *(LAS float*)(lds + (pw_ ? L_A1 : L_RHS2) + (32 * pb + (r & 3) + 8 * (r >> 2) + 4 * hi) * RPF + (32 * cb + r32) * 4) = pw_ ? -0.606531f * sg : sg; }
        }
        if (dir == 0 && w < 4) {
            f32x16 ag = {};
            const unsigned go = WS_CG + (tokp * 128 + 8 * hi) * 2, gw_ = swo + (98304 + (h * 64 + 32 * cb + r32) * 128 + 8 * hi) * 2;
#pragma unroll
            for (int ks = 0; ks < 8; ++ks) ag = MFMA32(LDG(bf16x8, ws, go + 32 * ks), LDG(bf16x8, ws, gw_ + 32 * ks), ag);
#pragma unroll
            for (int r = 0; r < 16; ++r) { const int pp_ = 32 * pb + (r & 3) + 8 * (r >> 2) + 4 * hi; const unsigned tk = seq0 + q0 + pp_;
                STG(bf16_t, F.ws, WS_G + (tk * 384 + h * 64 + 32 * cb + r32) * 2) = (bf16_t)(pk2(ag[r], 0.f) & 0xffff); }
        }
    }
    lds_barrier();
    {
        const unsigned cch = h * 64 + lane;
        const float* convp = INP(18) + (size_t)l * 3 * 1152;
        float cw_[3][3];
#pragma unroll
        for (int tap = 0; tap < 3; ++tap)
#pragma unroll
            for (int seg = 0; seg < 3; ++seg) cw_[tap][seg] = LDG(float, convp, (tap * 1152 + seg * 384 + cch) * 4);
        const float ckk = LDG(float, INP(24), (l * 384 + cch) * 4), cka = LDG(float, INP(25), (l * 384 + cch) * 4), crk = LDG(float, INP(26), (l * 384 + cch) * 4);
        const int tb0 = dir ? T - 1 - (q0 + 8 * w + 7) : q0 + 8 * w;
        float xr[10][3];
#pragma unroll
        for (int rr = 0; rr < 10; ++rr) { const int tr = tb0 - 1 + rr; const bool ok = tr >= 0 && tr < T; const unsigned tk = seq0 + (ok ? tr : tb0);
#pragma unroll
            for (int seg = 0; seg < 3; ++seg) { const float x = bf_lo((unsigned)LDG(bf16_t, ws, WS_RKV + (tk * 1152 + seg * 384 + cch) * 2)); xr[rr][seg] = ok ? x : 0.f; } }
        float lwv[8], kkv[8], btv[8], kdv[8], rv[8], vv[8], g = 0.f;
#pragma unroll
        for (int pp = 0; pp < 8; ++pp) {
            const int rr = 1 + (dir ? 7 - pp : pp); const int p = 8 * w + pp; const unsigned tok = seq0 + (unsigned)(tb0 + rr - 1);
            const float r_ = xr[rr - 1][0] * cw_[0][0] + xr[rr][0] * cw_[1][0] + xr[rr + 1][0] * cw_[2][0];
            const float k_ = xr[rr - 1][1] * cw_[0][1] + xr[rr][1] * cw_[1][1] + xr[rr + 1][1] * cw_[2][1];
            const float v_ = xr[rr - 1][2] * cw_[0][2] + xr[rr][2] * cw_[1][2] + xr[rr + 1][2] * cw_[2][2];
            const float kraw = k_ * ckk; const float n2 = wave_sum(kraw * kraw); const float kk_ = kraw * __builtin_amdgcn_rsqf(fmaxf(n2, 1e-24f));
            const float lw = *(const LAS float*)(lds + L_A1 + p * RPF + lane * 4), av = *(const LAS float*)(lds + L_RHS2 + p * RPF + lane * 4);
            const float kd_ = k_ * (1.f + (av - 1.f) * cka);
            const float bon = wave_sum(r_ * kd_ * crk);
            if (lane == 0) STG(float, F.ws, WS_SB + ((dir * M + tok) * 8 + h) * 4) = bon;
            if (dir == 0) STG(float, F.ws, WS_SV + (tok * 384 + cch) * 4) = v_;
            lwv[pp] = lw; kkv[pp] = kk_; btv[pp] = kk_ * av; kdv[pp] = kd_; rv[pp] = r_; vv[pp] = v_; g += lw;
        }
        g = 0.f;
        for (int wq = 0; wq < w; ++wq) { float t8[8];
#pragma unroll
            for (int e = 0; e < 8; ++e) t8[e] = *(const LAS float*)(lds + L_A1 + (8 * wq + e) * RPF + lane * 4);
            g += ((t8[0] + t8[1]) + (t8[2] + t8[3])) + ((t8[4] + t8[5]) + (t8[6] + t8[7])); }
        unsigned vt[4], kkt[4], btt[4]; float e_pos = __expf(g);
#pragma unroll
        for (int pp = 0; pp < 8; ++pp) {
            const int p = 8 * w + pp;
            const float e_prev = e_pos; g += lwv[pp]; e_pos = __expf(g); const float e_neg = __expf(-g);
            const unsigned pk_kr = pk2(kkv[pp] * e_prev, rv[pp] * e_pos), pk_bk = pk2(btv[pp] * e_neg, kdv[pp] * e_neg), pk_v = pk2(vv[pp], 0.f);
            *(LAS bf16_t*)(lds + L_KT + p * RPB + lane * 2) = (bf16_t)(pk_kr & 0xffff); *(LAS bf16_t*)(lds + L_RT + p * RPB + lane * 2) = (bf16_t)(pk_kr >> 16);
            *(LAS bf16_t*)(lds + L_BT + p * RPB + lane * 2) = (bf16_t)(pk_bk & 0xffff); *(LAS bf16_t*)(lds + L_KK + p * RPB + lane * 2) = (bf16_t)(pk_bk >> 16);
            if (pp & 1) { vt[pp >> 1] |= pk_v << 16; kkt[pp >> 1] |= pk_bk & 0xffff0000u; btt[pp >> 1] |= pk_bk << 16; }
            else { vt[pp >> 1] = pk_v & 0xffff; kkt[pp >> 1] = pk_bk >> 16; btt[pp >> 1] = pk_bk & 0xffff; }
        }
        *(LAS u32x4*)(lds + L_VT + lane * RPB + 16 * w) = (u32x4){vt[0], vt[1], vt[2], vt[3]};
        *(LAS u32x4*)(lds + L_KKT + lane * RPB + 16 * w) = (u32x4){kkt[0], kkt[1], kkt[2], kkt[3]};
        *(LAS u32x4*)(lds + L_BTT + lane * RPB + 16 * w) = (u32x4){btt[0], btt[1], btt[2], btt[3]};
        if (w == 7) *(LAS float*)(lds + L_GC + lane * 4) = e_pos;
    }
    lds_barrier();
    f32x16 keep[2]; bf16x8 x4f[2][2];
    if (role == 0) {
        for (int sb = 0; sb <= tb; ++sb) { const f32x16 x = gram_tile(lds, L_BT, L_KT, sb, tb, r32, hi, true);
            if (sb == tb) {
#pragma unroll
                for (int r = 0; r < 16; ++r) *(LAS float*)(lds + L_A1 + tb * 4608 + ((r & 3) + 8 * (r >> 2) + 4 * hi) * 144 + r32 * 4) = -x[r];
            } else {
#pragma unroll
                for (int g4 = 0; g4 < 4; ++g4) *(LAS f32x4*)(lds + L_A1 + 9216 + r32 * 144 + (8 * g4 + 4 * hi) * 4) = (f32x4){x[4 * g4], x[4 * g4 + 1], x[4 * g4 + 2], x[4 * g4 + 3]};
            } }
    } else if (role == 1) {
        f32x16 o[2] = {};
        for (int sb = 0; sb <= tb; ++sb) {
            const f32x16 x = gram_tile(lds, L_KK, L_KT, sb, tb, r32, hi, true);
#pragma unroll
            for (int ks = 0; ks < 2; ++ks) { const bf16x8 a = acc_frag(x, ks, 1.f);
#pragma unroll
                for (int ib = 0; ib < 2; ++ib) o[ib] = MFMA32(a, lds_frag_perm(lds + L_VT, 32 * ib + r32, 32 * sb + 16 * ks, hi), o[ib]); }
        }
#pragma unroll
        for (int ib = 0; ib < 2; ++ib)
#pragma unroll
            for (int r = 0; r < 16; ++r) *(LAS float*)(lds + L_RHS2 + (32 * tb + (r & 3) + 8 * (r >> 2) + 4 * hi) * RPF + (32 * ib + r32) * 4) = o[ib][r];
    } else if (role == 2) {
#pragma unroll
        for (int sb = 0; sb < 2; ++sb) { x4f[sb][0] = (bf16x8){}; x4f[sb][1] = (bf16x8){}; }
        keep[0] = (f32x16){}; keep[1] = (f32x16){};
        for (int sb = 0; sb <= tb; ++sb) {
            const f32x16 x3 = gram_tile(lds, L_KK, L_RT, sb, tb, r32, hi, false), x4 = gram_tile(lds, L_BT, L_RT, sb, tb, r32, hi, false);
#pragma unroll
            for (int ks = 0; ks < 2; ++ks) { const bf16x8 a3 = acc_frag(x3, ks, 1.f); const bf16x8 a4 = acc_frag(x4, ks, -1.f);
                if (sb == 0) x4f[0][ks] = a4; else x4f[1][ks] = a4;
#pragma unroll
                for (int cb = 0; cb < 2; ++cb) keep[cb] = MFMA32(a3, lds_frag_perm(lds + L_VT, 32 * cb + r32, 32 * sb + 16 * ks, hi), keep[cb]); }
        }
    } else {
        keep[0] = (f32x16){}; keep[1] = (f32x16){};
#pragma unroll
        for (int ks = 0; ks < 4; ++ks) { const bf16x8 ak = lds_frag_nat(lds + L_KKT, 32 * tb + r32, ks, hi);
#pragma unroll
            for (int cb = 0; cb < 2; ++cb) keep[cb] = MFMA32(ak, lds_frag_nat(lds + L_VT, 32 * cb + r32, ks, hi), keep[cb]); }
    }
    lds_barrier();
    if (w < 2) {
        const LAS unsigned char* a1p = lds + L_A1; asm volatile("" : "+v"(a1p));
        LAS unsigned char* xp = lds + (w == 0 ? L_X0 : L_RHS2) + lane * 4; asm volatile("" : "+v"(xp));
        const LAS unsigned char* kp = lds + L_KT + lane * 2; asm volatile("" : "+v"(kp));
        LAS unsigned char* dst = lds + (w == 0 ? L_WT : L_U0T) + lane * RPB; asm volatile("" : "+v"(dst));
#pragma unroll
        for (int B = 0; B < 2; ++B) {
            float acc[32];
            if (w == 0 && B == 0) {
#pragma unroll
                for (int r = 0; r < 32; ++r) acc[r] = bf_lo((unsigned)*(const LAS bf16_t*)(kp + r * RPB));
            } else {
#pragma unroll
                for (int r = 0; r < 32; ++r) acc[r] = *(const LAS float*)(xp + (32 * B + r) * RPF);
            }
            f32x2 ac2[16];
#pragma unroll
            for (int k = 0; k < 16; ++k) ac2[k] = (f32x2){acc[2 * k], acc[2 * k + 1]};
            f32x4 ca[8], cn[8];
#pragma unroll
            for (int tg = 0; tg < 8; ++tg) ca[tg] = *(const LAS f32x4*)(a1p + B * 4608 + tg * 16);
#pragma unroll
            for (int s_ = 0; s_ < 31; ++s_) {
                if (s_ + 1 < 31) {
#pragma unroll
                    for (int tg = (s_ + 2) / 4; tg < 8; ++tg) cn[tg] = *(const LAS f32x4*)(a1p + B * 4608 + (s_ + 1) * 144 + tg * 16);
                }
                __builtin_amdgcn_sched_barrier(0);
                const float xs = ac2[s_ >> 1][s_ & 1];
                const f32x2 xs2 = {xs, xs};
#pragma unroll
                for (int tg = (s_ + 1) / 4; tg < 8; ++tg) {
                    ac2[2 * tg] = __builtin_elementwise_fma((f32x2){ca[tg][0], ca[tg][1]}, xs2, ac2[2 * tg]);
                    ac2[2 * tg + 1] = __builtin_elementwise_fma((f32x2){ca[tg][2], ca[tg][3]}, xs2, ac2[2 * tg + 1]); }
                __builtin_amdgcn_sched_barrier(0);
#pragma unroll
                for (int tg = 0; tg < 8; ++tg) ca[tg] = cn[tg];
            }
#pragma unroll
            for (int k = 0; k < 16; ++k) { acc[2 * k] = ac2[k][0]; acc[2 * k + 1] = ac2[k][1]; }
#pragma unroll
            for (int k8 = 0; k8 < 4; ++k8) { u32x4 v; v.x = pk2(acc[8 * k8], acc[8 * k8 + 1]); v.y = pk2(acc[8 * k8 + 2], acc[8 * k8 + 3]); v.z = pk2(acc[8 * k8 + 4], acc[8 * k8 + 5]); v.w = pk2(acc[8 * k8 + 6], acc[8 * k8 + 7]);
                *(LAS u32x4*)(dst + 64 * B + 16 * k8) = v; }
            if (B == 0) {
                asm volatile("s_waitcnt lgkmcnt(0)" ::: "memory");
                f32x16 u[2];
#pragma unroll
                for (int cb = 0; cb < 2; ++cb)
#pragma unroll
                    for (int r = 0; r < 16; ++r) { const int t = 32 + (r & 3) + 8 * (r >> 2) + 4 * hi;
                        u[cb][r] = w == 0 ? bf_lo((unsigned)*(const LAS bf16_t*)(lds + L_KT + t * RPB + (32 * cb + r32) * 2)) : *(const LAS float*)(lds + L_RHS2 + t * RPF + (32 * cb + r32) * 4); }
#pragma unroll
                for (int ks = 0; ks < 2; ++ks) { const f32x4 a0 = *(const LAS f32x4*)(lds + L_A1 + 9216 + r32 * 144 + (16 * ks + 8 * hi) * 4), a1 = *(const LAS f32x4*)(lds + L_A1 + 9216 + r32 * 144 + (16 * ks + 8 * hi + 4) * 4);
                    u32x4 aw; aw.x = pk2(-a0[0], -a0[1]); aw.y = pk2(-a0[2], -a0[3]); aw.z = pk2(-a1[0], -a1[1]); aw.w = pk2(-a1[2], -a1[3]);
#pragma unroll
                    for (int cb = 0; cb < 2; ++cb) u[cb] = MFMA32(__builtin_bit_cast(bf16x8, aw), lds_frag_nat(lds + (w == 0 ? L_WT : L_U0T), 32 * cb + r32, ks, hi), u[cb]); }
#pragma unroll
                for (int cb = 0; cb < 2; ++cb)
#pragma unroll
                    for (int r = 0; r < 16; ++r) *(LAS float*)(lds + (w == 0 ? L_X0 : L_RHS2) + (32 + (r & 3) + 8 * (r >> 2) + 4 * hi) * RPF + (32 * cb + r32) * 4) = u[cb][r];
                asm volatile("s_waitcnt lgkmcnt(0)" ::: "memory");
            }
        }
    }
    lds_barrier();
    if (role == 2) {
        f32x16 pj[2];
#pragma unroll
        for (int jb = 0; jb < 2; ++jb)
#pragma unroll
            for (int r = 0; r < 16; ++r) pj[jb][r] = bf_lo((unsigned)*(const LAS bf16_t*)(lds + L_RT + (32 * tb + (r & 3) + 8 * (r >> 2) + 4 * hi) * RPB + (32 * jb + r32) * 2));
#pragma unroll
        for (int sb = 0; sb < 2; ++sb)
#pragma unroll
            for (int ks = 0; ks < 2; ++ks)
#pragma unroll
                for (int cb = 0; cb < 2; ++cb) {
                    keep[cb] = MFMA32(x4f[sb][ks], lds_frag_perm(lds + L_U0T, 32 * cb + r32, 32 * sb + 16 * ks, hi), keep[cb]);
                    pj[cb] = MFMA32(x4f[sb][ks], lds_frag_perm(lds + L_WT, 32 * cb + r32, 32 * sb + 16 * ks, hi), pj[cb]); }
        f32x16 (&y0)[2] = keep;
        const unsigned yb = dir ? WS_YB : WS_YF;
#pragma unroll
        for (int r = 0; r < 16; ++r) { const int t = 32 * tb + (r & 3) + 8 * (r >> 2) + 4 * hi; const unsigned tok = seq0 + (dir ? T - 1 - (q0 + t) : q0 + t);
#pragma unroll
            for (int cb = 0; cb < 2; ++cb) { STG(float, F.ws, yb + (tok * 384 + h * 64 + 32 * cb + r32) * 4) = y0[cb][r];
                STG(bf16_t, F.ws, WS_RP + (((unsigned)cid * 64 + t) * 64 + 32 * cb + r32) * 2) = (bf16_t)(pk2(pj[cb][r], 0.f) & 0xffff); } }
    } else if (role == 3) {
        const int jb = tb;
        f32x16 q1[2] = {}, q2[2] = {}; f32x16 (&n1)[2] = keep;
#pragma unroll
        for (int ks = 0; ks < 4; ++ks) { const bf16x8 a = lds_frag_nat(lds + L_BTT, 32 * jb + r32, ks, hi);
#pragma unroll
            for (int cb = 0; cb < 2; ++cb) { q1[cb] = MFMA32(lds_frag_nat(lds + L_WT, 32 * cb + r32, ks, hi), a, q1[cb]); q2[cb] = MFMA32(a, lds_frag_nat(lds + L_U0T, 32 * cb + r32, ks, hi), q2[cb]); } }
#pragma unroll
        for (int q = 0; q < 4; ++q) { f32x4 gc4;
#pragma unroll
            for (int e = 0; e < 4; ++e) gc4[e] = *(const LAS float*)(lds + L_GC + (32 * jb + e + 8 * q + 4 * hi) * 4);
#pragma unroll
            for (int cb = 0; cb < 2; ++cb) { f32x4 nv;
#pragma unroll
                for (int e = 0; e < 4; ++e) nv[e] = gc4[e] * (n1[cb][4 * q + e] - q2[cb][4 * q + e]);
                STG(f32x4, F.ws, WS_RN + ((((unsigned)cid * 2 + jb) * 2 + cb) * 4 + q) * 1024 + lane * 16) = nv; } }
        { const float gl = *(const LAS float*)(lds + L_GC + (32 * jb + r32) * 4);
#pragma unroll
          for (int cb = 0; cb < 2; ++cb)
#pragma unroll
            for (int s2 = 0; s2 < 2; ++s2) { float mv[8];
#pragma unroll
                for (int e = 0; e < 8; ++e) { const int r = 8 * s2 + e; const unsigned c = 32 * cb + (r & 3) + 8 * (r >> 2) + 4 * hi; mv[e] = (c == 32 * jb + r32 ? gl : 0.f) - gl * q1[cb][r]; }
                u32x4 w; w.x = pk2(mv[0], mv[1]); w.y = pk2(mv[2], mv[3]); w.z = pk2(mv[4], mv[5]); w.w = pk2(mv[6], mv[7]);
                STG(u32x4, F.ws, WS_RM + (unsigned)cid * 8192 + ((jb * 2 + cb) * 2 + s2) * 1024 + lane * 16) = w; } }
    }
    lds_barrier();
}
__device__ __forceinline__ void rwkv_chain_wave(Frame& F, int l, bool lat, int chain, int ib) {
    int lane = F.lane; asm volatile("" : "+v"(lane));
    const unsigned char* ws = F.ws; const unsigned r32 = lane & 31, hi = lane >> 5;
    const unsigned dir = chain & 1, h = (chain >> 1) % 6, b = chain / 12;
    const int nc = lat ? 64 : 4; const unsigned cid0 = lat ? 768 + chain * 64 : chain * 4;
    const unsigned i = 32 * ib + r32;
    const unsigned so = ((((b * 4 + l) * 6 + h) * 64 + i) * 64) * 4;
    f32x16 H[2];
#pragma unroll
    for (int jb = 0; jb < 2; ++jb)
#pragma unroll
        for (int g4 = 0; g4 < 4; ++g4) { f32x4 v = {0.f, 0.f, 0.f, 0.f}; if (lat) v = LDG(f32x4, dir ? INP(7) : INP(6), so + (32 * jb + 8 * g4 + 4 * hi) * 4);
            H[jb][4 * g4] = v[0]; H[jb][4 * g4 + 1] = v[1]; H[jb][4 * g4 + 2] = v[2]; H[jb][4 * g4 + 3] = v[3]; }
    bf16x8 maA[2][2][2], maB[2][2][2]; f32x16 ntA[2], ntB[2];
    const GAS unsigned char* pm = (const GAS unsigned char*)ws + (WS_RM + cid0 * 8192 + lane * 16);
    const GAS unsigned char* pn = (const GAS unsigned char*)ws + (WS_RN + (cid0 * 4 + ib) * 4096 + lane * 16);
#define RB_LOAD(ma, nt, k_) do { \
        _Pragma("unroll") for (int jo = 0; jo < 2; ++jo) _Pragma("unroll") for (int ji = 0; ji < 2; ++ji) _Pragma("unroll") for (int ks = 0; ks < 2; ++ks) ma[jo][ji][ks] = *(const GAS bf16x8*)(pm + ((k_) * 8192 + ((jo * 2 + ji) * 2 + ks) * 1024)); \
        _Pragma("unroll") for (int jo = 0; jo < 2; ++jo) _Pragma("unroll") for (int q = 0; q < 4; ++q) { const f32x4 t_ = *(const GAS f32x4*)(pn + ((k_) * 16384 + (jo * 8 + q) * 1024)); \
            nt[jo][4 * q] = t_[0]; nt[jo][4 * q + 1] = t_[1]; nt[jo][4 * q + 2] = t_[2]; nt[jo][4 * q + 3] = t_[3]; } } while (0)
#define RB_STEP(ma, nt, cid_) do { \
        bf16x8 hf[2][2]; \
        _Pragma("unroll") for (int ji = 0; ji < 2; ++ji) { hf[ji][0] = acc_frag(H[ji], 0, 1.f); hf[ji][1] = acc_frag(H[ji], 1, 1.f); } \
        _Pragma("unroll") for (int ji = 0; ji < 2; ++ji) _Pragma("unroll") for (int ks = 0; ks < 2; ++ks) STG(bf16x8, F.ws, WS_RH + (cid_) * 8192 + ((ib * 2 + ji) * 2 + ks) * 1024 + lane * 16) = hf[ji][ks]; \
        f32x16 acc[2] = {nt[0], nt[1]}; \
        _Pragma("unroll") for (int jo = 0; jo < 2; ++jo) _Pragma("unroll") for (int ji = 0; ji < 2; ++ji) _Pragma("unroll") for (int ks = 0; ks < 2; ++ks) acc[jo] = MFMA32(ma[jo][ji][ks], hf[ji][ks], acc[jo]); \
        H[0] = acc[0]; H[1] = acc[1]; } while (0)
    RB_LOAD(maA, ntA, 0); RB_LOAD(maB, ntB, 1);
#pragma unroll 1
    for (int c = 0; c < nc; c += 2) {
        const unsigned cid = cid0 + c;
        RB_STEP(maA, ntA, cid);
        if (c + 2 < nc) RB_LOAD(maA, ntA, 2);
        RB_STEP(maB, ntB, cid + 1);
        if (c + 2 < nc) RB_LOAD(maB, ntB, 3);
        pm += 16384; pn += 32768;
    }
#undef RB_LOAD
#undef RB_STEP
    if (!lat) {
#pragma unroll
        for (int jb = 0; jb < 2; ++jb)
#pragma unroll
            for (int g4 = 0; g4 < 4; ++g4) STG(f32x4, F.out, (dir ? OFF_CB : OFF_CF) * 4 + so + (32 * jb + 8 * g4 + 4 * hi) * 4) = (f32x4){H[jb][4 * g4], H[jb][4 * g4 + 1], H[jb][4 * g4 + 2], H[jb][4 * g4 + 3]};
    }
}
__device__ __forceinline__ void rwkv_apply_wave(Frame& F, int item) {
    int lane = F.lane; asm volatile("" : "+v"(lane));
    const unsigned char* ws = F.ws; const unsigned r32 = lane & 31, hi = lane >> 5;
    const int cid = item >> 1, tb = item & 1;
    unsigned seq0, b, h, dir; int T, c; chunk_decode(cid, seq0, T, b, h, dir, c);
    const unsigned yb = dir ? WS_YB : WS_YF;
    f32x16 acc[2];
#pragma unroll
    for (int r = 0; r < 16; ++r) { const int t = 32 * tb + (r & 3) + 8 * (r >> 2) + 4 * hi; const unsigned tok = seq0 + (dir ? T - 1 - (64 * c + t) : 64 * c + t);
        acc[0][r] = LDG(float, ws, yb + (tok * 384 + h * 64 + r32) * 4); acc[1][r] = LDG(float, ws, yb + (tok * 384 + h * 64 + 32 + r32) * 4); }
#pragma unroll
    for (int ks = 0; ks < 4; ++ks) { const bf16x8 a = LDG(bf16x8, ws, WS_RP + (((unsigned)cid * 64 + 32 * tb + r32) * 64 + 16 * ks + 8 * hi) * 2);
#pragma unroll
        for (int ib = 0; ib < 2; ++ib) acc[ib] = MFMA32(a, LDG(bf16x8, ws, WS_RH + (((unsigned)cid * 64 + 32 * ib + r32) * 64 + 16 * ks + 8 * hi) * 2), acc[ib]); }
#pragma unroll
    for (int r = 0; r < 16; ++r) { const int t = 32 * tb + (r & 3) + 8 * (r >> 2) + 4 * hi; const unsigned tok = seq0 + (dir ? T - 1 - (64 * c + t) : 64 * c + t);
        STG(float, F.ws, yb + (tok * 384 + h * 64 + r32) * 4) = acc[0][r]; STG(float, F.ws, yb + (tok * 384 + h * 64 + 32 + r32) * 4) = acc[1][r]; }
}

__device__ __forceinline__ void rwkv_out_item(Frame& F, int l, int item) {
    int lane = F.lane; asm volatile("" : "+v"(lane));
    const unsigned char* ws = F.ws; const unsigned r32 = lane & 31, hi = lane >> 5;
    const int tb = item & 1, h = (item >> 1) % 6, sk = item / 12;
    const bool lat = sk >= 64; const int b = lat ? (sk - 64) >> 6 : sk >> 2, k = lat ? (sk - 64) & 63 : sk & 3, nc = lat ? 64 : 4;
    const unsigned seq0 = lat ? MC + b * 4096 : b * 256, base = lat ? 768u : 0u;
    const unsigned chf = (b * 6 + h) * 2, cidf = base + chf * nc + k, cidb = base + (chf + 1) * nc + (nc - 1 - k);
    const unsigned tok0 = seq0 + 64 * k + 32 * tb;
    f32x16 acc[2];
#pragma unroll
    for (int r = 0; r < 16; ++r) { const unsigned tok = tok0 + (r & 3) + 8 * (r >> 2) + 4 * hi; const unsigned e = (tok * 384 + h * 64 + r32) * 4;
        acc[0][r] = LDG(float, ws, WS_YF + e) + LDG(float, ws, WS_YB + e); acc[1][r] = LDG(float, ws, WS_YF + e + 128) + LDG(float, ws, WS_YB + e + 128); }
    const unsigned pf = 32 * tb + r32, pb_ = 63 - 32 * tb - r32;
#pragma unroll
    for (int ks = 0; ks < 4; ++ks) {
        const s16x4 f0 = LDG(s16x4, ws, WS_RP + ((cidf * 64 + pf) * 64 + 16 * ks + 4 * hi) * 2), f1 = LDG(s16x4, ws, WS_RP + ((cidf * 64 + pf) * 64 + 16 * ks + 8 + 4 * hi) * 2);
        const s16x4 b0_ = LDG(s16x4, ws, WS_RP + ((cidb * 64 + pb_) * 64 + 16 * ks + 4 * hi) * 2), b1_ = LDG(s16x4, ws, WS_RP + ((cidb * 64 + pb_) * 64 + 16 * ks + 8 + 4 * hi) * 2);
        const bf16x8 af = {f0[0], f0[1], f0[2], f0[3], f1[0], f1[1], f1[2], f1[3]}, ab = {b0_[0], b0_[1], b0_[2], b0_[3], b1_[0], b1_[1], b1_[2], b1_[3]};
#pragma unroll
        for (int ib = 0; ib < 2; ++ib) { acc[ib] = MFMA32(af, LDG(bf16x8, ws, WS_RH + cidf * 8192 + (ib * 4 + ks) * 1024 + lane * 16), acc[ib]);
            acc[ib] = MFMA32(ab, LDG(bf16x8, ws, WS_RH + cidb * 8192 + (ib * 4 + ks) * 1024 + lane * 16), acc[ib]); } }
    const float g0 = LDG(float, INP(27), (l * 384 + h * 64 + r32) * 4), g1 = LDG(float, INP(27), (l * 384 + h * 64 + 32 + r32) * 4), b0 = LDG(float, INP(28), (l * 384 + h * 64 + r32) * 4), b1 = LDG(float, INP(28), (l * 384 + h * 64 + 32 + r32) * 4);
    const int xl = (lane ^ 16) << 2;
#pragma unroll
    for (int r = 0; r < 16; ++r) { const unsigned tok = tok0 + (r & 3) + 8 * (r >> 2) + 4 * hi; const unsigned e = tok * 384 + h * 64 + r32;
        const float bon = LDG(float, ws, WS_SB + (tok * 8 + h) * 4) + LDG(float, ws, WS_SB + ((M + tok) * 8 + h) * 4);
        const float y0 = acc[0][r] + bon * LDG(float, ws, WS_SV + e * 4), y1 = acc[1][r] + bon * LDG(float, ws, WS_SV + (e + 32) * 4);
        float s = allreduce16(y0 + y1); s += __builtin_bit_cast(float, __builtin_amdgcn_ds_bpermute(xl, __builtin_bit_cast(int, s)));
        const float mu = s * (1.f / 64.f), d0 = y0 - mu, d1 = y1 - mu;
        float q = allreduce16(d0 * d0 + d1 * d1); q += __builtin_bit_cast(float, __builtin_amdgcn_ds_bpermute(xl, __builtin_bit_cast(int, q)));
        const float rs = rsqrtf(q * (1.f / 64.f) + 64e-5f);
        const float o0 = (d0 * rs * g0 + b0) * bf_lo((unsigned)LDG(bf16_t, ws, WS_G + e * 2)), o1 = (d1 * rs * g1 + b1) * bf_lo((unsigned)LDG(bf16_t, ws, WS_G + (e + 32) * 2));
        const unsigned pk = pk2(o0, o1);
        STG(bf16_t, F.ws, WS_ACT + (tok * DM + 640 + h * 64 + r32) * 2) = (bf16_t)(pk & 0xffff); STG(bf16_t, F.ws, WS_ACT + (tok * DM + 640 + h * 64 + 32 + r32) * 2) = (bf16_t)(pk >> 16); }
}

#ifndef B_UNIT
#define B_UNIT 0
#endif
constexpr int AU_R = 8, AU_D = 4, AU_SLOT = 6144;
__device__ __forceinline__ void attn_b_unit(Frame& F, int l, int unit) {
    int lane = F.lane; asm volatile("" : "+v"(lane));
    const unsigned char* ws = F.ws; LAS unsigned char* lds = F.lds;
    const int w = F.wave; const unsigned r32 = lane & 31, hi = lane >> 5;
    const unsigned kh = unit & 1, qb = (unit >> 1) & 15, mp = (unit >> 5) & 1, h = (unit >> 6) & 3, b = unit >> 8;
    const unsigned seq0 = MC + b * 4096, row = seq0 + qb * 256 + 32 * w + r32;
    bf16x8 qf[1][2];
#pragma unroll
    for (int s = 0; s < 2; ++s) qf[0][s] = LDG(bf16x8, ws, WS_QB + (row * 256 + h * 64 + mp * 32 + 8 * hi) * 2 + 32 * s);
    AttnQ st[1]; attnq_init(st[0], 0.f);
    const int qpos[1] = {0};
    const int n0 = kh ? 56 : 72, nt = 72;
    const unsigned pofs = (w < 2 ? (h * 2 + mp) * 2048 + w * 1024 : h * 4096 + (w - 2) * 1024) + lane * 16;
    const unsigned base0 = (w < 2 ? WS_KB : WS_VTB) + ((seq0 >> 5) + (kh ? 72u : 0u)) * 16384 + pofs;
    const unsigned base1 = WS_CACHE + (w < 2 ? 2 * MiB : 4 * MiB) + (b * 4 + l) * 262144 + pofs;
#define AU_DMA(t_) do { const int tt_ = (t_) < nt ? (t_) : nt - 1; const unsigned src_ = tt_ < n0 ? base0 + tt_ * 16384 : base1 + (tt_ - n0) * 16384; \
        __builtin_amdgcn_global_load_lds((const GAS unsigned*)(ws + src_), (LAS unsigned*)(lds + ((t_) % AU_R) * AU_SLOT + w * 1024), 16, 0, 0); } while (0)
    if (w < 6) {
#pragma unroll
        for (int t = 0; t < AU_D; ++t) AU_DMA(t);
    }
    for (int t = 0; t < nt; ++t) {
        if (w < 6) asm volatile("s_waitcnt vmcnt(3)" ::: "memory");
        asm volatile("s_barrier" ::: "memory");
        const LAS unsigned char* sl = lds + (t % AU_R) * AU_SLOT + lane * 16;
        bf16x8 kf[2], vf[4];
        kf[0] = *(const LAS bf16x8*)(sl); kf[1] = *(const LAS bf16x8*)(sl + 1024);
#pragma unroll
        for (int f = 0; f < 4; ++f) vf[f] = *(const LAS bf16x8*)(sl + 2048 + 1024 * f);
        if (w < 6) AU_DMA(t + AU_D);
        attn_block<32, false, 1>(qf, kf, vf, st, t, qpos, 0, hi);
    }
#undef AU_DMA
    asm volatile("s_waitcnt vmcnt(0) lgkmcnt(0)\n\ts_barrier" ::: "memory");
    attn_b_store(F, st[0], mp, kh, row, h, hi);
}

constexpr int Q_BLAT = 2048, Q_ALAT = 1536, Q_BCTX = 1024, Q_ACTX = 768;
constexpr int Q_TOTAL = Q_BLAT + Q_ALAT + Q_BCTX + Q_ACTX;
#ifndef XCD_DEAL
#define XCD_DEAL 0
#endif
__device__ __forceinline__ void phase_mixer(Frame& F, int l, int rep) {
    if (rep == 0 || REP_PART == 0 || REP_PART == 1) {
        const int si = F.bid + F.G * F.wave;
        if (si < 48) rwkv_chain_wave(F, l, true, si >> 1, si & 1);
        else if (si < 48 + 384) rwkv_chain_wave(F, l, false, (si - 48) >> 1, (si - 48) & 1);
    }
    if (B_UNIT && (rep == 0 || REP_PART == 2 || REP_PART == 4)) {
        unsigned* uctr = (unsigned*)(F.ws + WS_CTL) + 64 * (32 + l + 4 * rep);
        LAS int* ubox = (LAS int*)(F.lds + 65536);
        for (;;) {
            if (F.wave == 0 && F.lane == 0) *ubox = (int)atomicAdd(uctr, 1u);
            lds_barrier();
            const int un = __builtin_amdgcn_readfirstlane(*ubox);
            lds_barrier();
            if (un >= 512) break;
            attn_b_unit(F, l, un);
        }
    }
    unsigned* ctr = (unsigned*)(F.ws + WS_CTL) + 64 * (1 + l + 4 * rep);
    if (rep == 0 || REP_PART != 1) for (;;) {
        int it = 0;
        if (F.lane == 0) it = (int)atomicAdd(ctr, 1u);
        it = __builtin_amdgcn_readfirstlane(it) + (B_UNIT ? Q_BLAT : 0);
        if (it >= Q_TOTAL) break;
        if (it < Q_BLAT) { if (rep == 0 || REP_PART == 2 || REP_PART == 4) attn_b_item(F, l, true, it); continue; } it -= Q_BLAT;
        if (it < Q_ALAT) { if (rep == 0 || REP_PART == 2 || REP_PART == 3) attn_a_item(F, l, true, it); continue; } it -= Q_ALAT;
        if (it < Q_BCTX) { if (rep == 0 || REP_PART == 2 || REP_PART == 5) attn_b_item(F, l, false, it); continue; } it -= Q_BCTX;
        if (rep == 0 || REP_PART == 2 || REP_PART == 5) attn_a_item(F, l, false, it);
    }
}

__device__ __forceinline__ void phase_finalize(Frame& F, int l) {
    const unsigned char* ws = F.ws;
    const unsigned lane = F.lane;
    const float lami = 0.8f - 0.6f * __expf(-0.3f * (float)l);
    const float lam = LDG(float, ws, WS_TAB + (TAB_LAM + l) * 4) + lami;
    const float omli = 1.f - lami;
    const float sg = LDG(float, INP(17), (l * 64 + lane) * 4);
    for (unsigned row = F.gw; row < M; row += F.ngw) {
#pragma unroll
        for (int k = 0; k < 4; ++k) { float om[2];
#pragma unroll
            for (int mp = 0; mp < 2; ++mp) { const unsigned o0 = (((mp * 2) * M + row) * 256 + 64 * k + lane) * 2, q0 = ((((mp * 2) * M + row) * 4 + k) * 2) * 4;
                const f32x2 ml0 = LDG(f32x2, ws, WS_ML + q0);
                if (row >= MC) { const f32x2 ml1 = LDG(f32x2, ws, WS_ML + q0 + M * 32); const float ms = fmaxf(ml0[0], ml1[0]), w0 = __builtin_amdgcn_exp2f(ml0[0] - ms), w1 = __builtin_amdgcn_exp2f(ml1[0] - ms);
                    om[mp] = (bf_lo((unsigned)LDG(bf16_t, ws, WS_BO2 + o0)) * w0 + bf_lo((unsigned)LDG(bf16_t, ws, WS_BO2 + o0 + M * 512)) * w1) * __builtin_amdgcn_rcpf(ml0[1] * w0 + ml1[1] * w1); }
                else om[mp] = bf_lo((unsigned)LDG(bf16_t, ws, WS_BO2 + o0)) * __builtin_amdgcn_rcpf(ml0[1]); }
            const float v = om[0] - lam * om[1];
            const float ms = wave_sum(v * v) * (1.f / 64.f);
            STG(bf16_t, F.ws, WS_ACT + (row * DM + 384 + 64 * k + lane) * 2) = (bf16_t)(pk2(v * rsqrtf(ms + 1e-6f) * sg * omli, 0.f) & 0xffff); }
    }
}


typedef unsigned v4u __attribute__((ext_vector_type(4)));
#define XB_TMO      128
#define XB_XCNT(j)  (256  + 64 * (j))
#define XB_XSUB(j)  (1280 + 64 * (j))
#define XB_XGEN(j)  (2304 + 64 * (j))
#define XB_TOP      3328
#define XB_TOPGEN   3392
#define XCD_BAR_WORDS 3456
#define XB_SPIN_CAP (1u << 18)

__device__ __forceinline__ unsigned xb_ld(unsigned* p)              { return __hip_atomic_load(p, __ATOMIC_RELAXED, __HIP_MEMORY_SCOPE_AGENT); }
__device__ __forceinline__ unsigned xb_add(unsigned* p, unsigned v) { return __hip_atomic_fetch_add(p, v, __ATOMIC_RELAXED, __HIP_MEMORY_SCOPE_AGENT); }
__device__ __forceinline__ unsigned xb_xcc_id() { return (unsigned)__builtin_amdgcn_s_getreg((3 << 11) | 20) & 0xFu; }
#define XB_SPIN(cond, bar) do { unsigned _sp = 0; while (cond) { __builtin_amdgcn_s_sleep(1); \
    if ((++_sp & 255u) == 0u) { if (xb_ld(&(bar)[XB_TMO])) break; if (_sp > XB_SPIN_CAP) { atomicAdd(&(bar)[XB_TMO], 1u); break; } } } } while (0)

struct XcdBarrier {
    unsigned* bar; unsigned x;
    volatile LAS unsigned* st;
};

__device__ __forceinline__ XcdBarrier xcd_barrier_post(unsigned* bar, volatile LAS unsigned* st) {
    XcdBarrier b; b.bar = bar; b.x = xb_xcc_id(); b.st = st;
    if (threadIdx.x == 0) (void)xb_add(&bar[XB_XCNT(b.x)], 1u);
    return b;
}
__device__ __forceinline__ void xcd_barrier_complete(unsigned* bar, unsigned x, unsigned& nloc, unsigned& nx) {
    const unsigned G = gridDim.x * gridDim.y * gridDim.z;
    unsigned sum, cnt, mine, sp = 0u;
    for (;;) {
        sum = 0u; cnt = 0u; mine = 0u;
#pragma unroll
        for (unsigned j = 0; j < 16; ++j) { const unsigned c = xb_ld(&bar[XB_XCNT(j)]); sum += c; cnt += (c > 0u) ? 1u : 0u; mine = (j == x) ? c : mine; }
        if (sum == G) break;
        __builtin_amdgcn_s_sleep(1);
        if ((++sp & 255u) == 0u) { if (xb_ld(&bar[XB_TMO])) break; if (sp > XB_SPIN_CAP) { atomicAdd(&bar[XB_TMO], 1u); break; } }
    }
    nloc = mine > 0u ? mine : 1u; nx = cnt > 0u ? cnt : 1u;
}

__device__ __forceinline__ void xcd_barrier(const XcdBarrier& b) {
    asm volatile("s_waitcnt vmcnt(0)" ::: "memory");
    __syncthreads();
    if (threadIdx.x == 0) {
        unsigned* bar = b.bar;
        __builtin_amdgcn_s_waitcnt(0);
        unsigned nloc = b.st[0], nx = b.st[1];
        if (nloc == 0u) { xcd_barrier_complete(bar, b.x, nloc, nx); b.st[0] = nloc; b.st[1] = nx; }
        const unsigned old = xb_add(&bar[XB_XSUB(b.x)], 1u);
        const unsigned gen = old / nloc;
        if (old + 1u == (gen + 1u) * nloc) {
            __builtin_amdgcn_fence(__ATOMIC_RELEASE, "agent");
            asm volatile("s_waitcnt vmcnt(0)" ::: "memory");
            const unsigned og = xb_add(&bar[XB_TOP], 1u);
            const unsigned tg = og / nx;
            if (og + 1u == (tg + 1u) * nx) xb_add(&bar[XB_TOPGEN], 1u);
            else XB_SPIN(xb_ld(&bar[XB_TOPGEN]) == tg, bar);
            __builtin_amdgcn_fence(__ATOMIC_ACQUIRE, "agent");
            xb_add(&bar[XB_XGEN(b.x)], 1u);
            asm volatile("s_waitcnt vmcnt(0)" ::: "memory");
        } else {
            XB_SPIN(xb_ld(&bar[XB_XGEN(b.x)]) == gen, bar);
            __builtin_amdgcn_fence(__ATOMIC_ACQUIRE, "agent");
            asm volatile("s_waitcnt vmcnt(0)" ::: "memory");
        }
    }
    __syncthreads();
}

#ifndef DIS
#define DIS 0
#endif
#ifndef GEMM_MF
#define GEMM_MF 7
#endif
#ifndef REP_PHASE
#define REP_PHASE -1
#define REP_COUNT 1
#endif
constexpr int NEXTRA = (REP_PHASE >= 0 && REP_PHASE < 9) ? REP_COUNT - 1 : 0, NPL = 9 + NEXTRA, NPRE = (REP_PHASE == 100) ? REP_COUNT : 1, NPHASE_RUN = NPRE + 1 + NPL * DEPTH;
__global__ void __launch_bounds__(512, 2) mega(Args a) {
    extern __shared__ __attribute__((aligned(16))) unsigned char lds[];
    Frame F;
    F.lds = (LAS unsigned char*)lds;
    volatile LAS unsigned* bst = (volatile LAS unsigned*)(F.lds + LDS_BYTES - 64);
    if (threadIdx.x < 2) bst[threadIdx.x] = 0u;
    __syncthreads();
    const XcdBarrier xbar = xcd_barrier_post((unsigned*)((GAS unsigned char*)a.ws + WS_CTL) + 4096, bst);
    const int wave_id = __builtin_amdgcn_readfirstlane((int)threadIdx.x >> 6);
    for (int ph = a.ph_lo; ph < a.ph_hi; ++ph) {
        { const unsigned char* kp = (const unsigned char*)__builtin_amdgcn_kernarg_segment_ptr(); asm volatile("" : "+s"(kp));
          const Args* ap = (const Args*)kp; F.in = ap->in; F.out = gptr(ap->out); F.ws = gptr(ap->ws); }
        { unsigned ones = ~0u; asm volatile("" : "+s"(ones)); int ln = (int)__builtin_amdgcn_mbcnt_hi(ones, __builtin_amdgcn_mbcnt_lo(ones, 0u)); int wv = wave_id, bid = (int)blockIdx.x, gg = (int)gridDim.x; asm volatile("" : "+s"(wv), "+s"(bid), "+s"(gg));
          F.lane = ln; F.wave = wv; F.bid = bid; F.G = gg; F.ngw = gg * 8; F.tid = wv * 64 + ln; F.gw = bid * 8 + wv; }
        if (ph < NPRE) { if (!(DIS & 1)) phase_prologue(F); }
        else if (ph == NPHASE_RUN - 1) { if (!(DIS & 2)) phase_final_norm(F); }
        else {
            const int l = (ph - NPRE) / NPL, sidx = (ph - NPRE) % NPL, rep = (REP_PHASE >= 0 && REP_PHASE < 9 && sidx > REP_PHASE && sidx <= REP_PHASE + NEXTRA) ? sidx - REP_PHASE : 0, s = (REP_PHASE >= 0 && REP_PHASE < 9 && sidx > REP_PHASE) ? (sidx <= REP_PHASE + NEXTRA ? REP_PHASE : sidx - NEXTRA) : sidx;
            if (s == 0) { convert_weights(F, l); phase_norm(F, l, 0); }
            else if (s == 1) {
                pg8::Gemm g{WSP(bf16_t, WS_ACT), WSP(bf16_t, WS_WIN + 0u * WSET_STRIDE), M, NIN, 1024}; pg8::StaticOrder S; S.init(M, NIN, F.G, F.bid, (GEMM_MF & 1) ? 192 : 256);
                EpiWin E{F.ws, F.out, l};
                if (!(DIS & 16)) pg8::gemm_phase<EpiWin, pg8::StaticOrder, false, true, (GEMM_MF & 1) ? 3 : 4>(F.lds, g, S, E, F.tid);
                if (false) { const int wv_ = (F.bid - 64) * 8 + F.wave; convert_item_any(F, l + 1, wv_); if (wv_ < CV_TOTAL - 1536) convert_item_any(F, l + 1, 1536 + wv_); }
            }
            else if (s == 2) { for (int cid = F.bid; cid < NCHUNK; cid += F.G) rwkv_chunk_block(F, l, cid); }
            else if (s == 3) { if (!(DIS & 64)) phase_mixer(F, l, rep); }
            else if (s == 4) { phase_finalize(F, l); for (int it = F.gw; it < 192 * 12; it += F.ngw) rwkv_out_item(F, l, it); }
            else if (s == 5 || s == 8) {
                const bool second = s == 8;
                pg8::Gemm g{second ? WSP(bf16_t, WS_U) : WSP(bf16_t, WS_ACT), second ? WSP(bf16_t, WS_W2 + 0u * WSET_STRIDE) : WSP(bf16_t, WS_WOUT + 0u * WSET_STRIDE), M, 1024, second ? FF : 1024};
                pg8::StaticOrder S; S.init(M, 1024, F.G, F.bid, (GEMM_MF & 2) ? 192 : 256);
                const bool first = (l == 0 && !second);
                EpiRes E{INP(0), INP(1) - (size_t)MC * DM, F.ws, WSP(float, WS_MOD) + (size_t)l * 3 * 6144 + (second ? 5120 : 2048), first};
                if (!(DIS & 256)) pg8::gemm_phase<EpiRes, pg8::StaticOrder, false, true, (GEMM_MF & 2) ? 3 : 4>(F.lds, g, S, E, F.tid);
            }
            else if (s == 6) { if (!(DIS & 8)) phase_norm(F, l, 1); }
            else {
                pg8::Gemm g{WSP(bf16_t, WS_ACT), WSP(bf16_t, WS_W13 + 0u * WSET_STRIDE), M, NFF2, 1024}; pg8::StaticOrder S; S.init(M, NFF2, F.G, F.bid, (GEMM_MF & 4) ? 192 : 256);
                EpiSwi E{WSP(bf16_t, WS_U)};
                if (!(DIS & 512)) pg8::gemm_phase<EpiSwi, pg8::StaticOrder, true, true, (GEMM_MF & 4) ? 3 : 4>(F.lds, g, S, E, F.tid);
            }
        }
        if (ph + 1 < a.ph_hi) { if (ph == a.ph_lo) { __threadfence(); cg::this_grid().sync(); } else xcd_barrier(xbar); }
    }
}

extern "C" void kernel_launch(void* const* d_in, const int* in_sizes, int n_in, void* d_out, int out_size, void* d_ws, size_t ws_size, hipStream_t stream) {
    static int grid = 0;
    if (grid == 0) {
        int dev = 0, cus = 0, per_cu = 0;
        if (n_in != 34 || ws_size < WS_END) { fprintf(stderr, "kernel_launch: unexpected n_in %d / ws_size %zu (need %zu)\n", n_in, ws_size, (size_t)WS_END); grid = -1; return; }
        if (hipGetDevice(&dev) != hipSuccess || hipDeviceGetAttribute(&cus, hipDeviceAttributeMultiprocessorCount, dev) != hipSuccess) { grid = -1; return; }
        if (hipFuncSetAttribute((const void*)mega, hipFuncAttributeMaxDynamicSharedMemorySize, LDS_BYTES) != hipSuccess) { fprintf(stderr, "kernel_launch: hipFuncSetAttribute failed\n"); grid = -1; return; }
        if (hipOccupancyMaxActiveBlocksPerMultiprocessor(&per_cu, (const void*)mega, 512, LDS_BYTES) != hipSuccess || per_cu < 1) { fprintf(stderr, "kernel_launch: occupancy query says %d\n", per_cu); per_cu = 1; }
        (void)hipGetLastError();
        grid = cus * 1;
        if (grid > cus * per_cu) grid = cus * per_cu;
    }
    if (grid < 0) return;
    (void)hipMemsetAsync((char*)d_ws + WS_CTL, 0, CTL_BYTES, stream);
    Args a{};
    for (int i = 0; i < 34; ++i) a.in[i] = (const float*)d_in[i];
    a.out = (float*)d_out; a.ws = (unsigned char*)d_ws;
#if MK_ONE_LAUNCH
    a.ph_lo = 0; a.ph_hi = NPHASE_RUN;
    void* args[] = {&a};
    hipError_t e = hipLaunchCooperativeKernel((const void*)mega, dim3(grid), dim3(512), args, LDS_BYTES, stream);
    if (e != hipSuccess) fprintf(stderr, "kernel_launch: cooperative launch failed: %s (grid %d)\n", hipGetErrorString(e), grid);
#else
    for (int ph = 0; ph < NPHASE_RUN; ++ph) { a.ph_lo = ph; a.ph_hi = ph + 1; hipLaunchKernelGGL(mega, dim3(grid), dim3(512), LDS_BYTES, stream, a); }
#endif
}
```

```cpp
#include <hip/hip_runtime.h>
#include <hip/hip_cooperative_groups.h>
#include <cstdio>
#include <cstdint>
namespace cg = cooperative_groups;

#ifndef MK_ONE_LAUNCH
#define MK_ONE_LAUNCH 1
#endif

#undef MK_ONE_LAUNCH
#define MK_ONE_LAUNCH 1
#define REP_PHASE -1
#define REP_COUNT 1
#define REP_PART 0
#define RA_REP 0
#define ATT_PROBE 0
namespace pg8 {
#define PG8_LAS __attribute__((address_space(3)))
typedef unsigned short bf16_t;
typedef short bf16x8 __attribute__((ext_vector_type(8)));
typedef float f32x4 __attribute__((ext_vector_type(4)));
typedef unsigned u32x4 __attribute__((ext_vector_type(4)));
constexpr int BM = 256, BK = 64, HALF = 128, HTB = HALF * BK * 2  , STAGE_BYTES = 8 * HTB, NXCD = 8, WGM = 8;

__host__ __device__ __forceinline__ int lds_byte(int r, int c) { const int st = (r >> 4) * 2 + (c >> 5), rr = r & 15, cc = c & 31, ob = rr * 64 + cc * 2; return st * 1024 + (ob ^ (((ob >> 9) & 1) << 5)); }
__host__ __device__ __forceinline__ void stage_rc(int b, int& R, int& C) { const int st = b / 1024, sb = b % 1024, swz = sb ^ (((sb >> 9) & 1) << 5); R = (st >> 1) * 16 + swz / 64; C = (st & 1) * 32 + (swz % 64) / 2; }
__host__ __device__ __forceinline__ int perm32(int rho) { const int n = rho >> 4, i = rho & 15; return 8 * (i >> 2) + 4 * n + (i & 3); }

struct Unit { int pm, pn; };
struct Gemm { const bf16_t* A; const bf16_t* Bt; int M, N, K; };

struct StaticOrder {
    int nM, nN, nwg, G, c;
    __host__ __device__ void init(int M, int N, int G_, int c_, int bm = BM) { nM = M / bm; nN = N / BM; nwg = nM * nN; G = G_; c = c_; }
    __host__ __device__ bool next(int i, Unit& u) const {
        const long L = (long)i * G + c; if (L >= nwg) return false;
        int wgid = (int)L; { const int q = nwg / NXCD, r = nwg % NXCD, xcd = wgid % NXCD, off = wgid / NXCD; wgid = (xcd < r ? xcd * (q + 1) : r * (q + 1) + (xcd - r) * q) + off; }
        const int nig = WGM * nN, gid = wgid / nig, fm = gid * WGM, gsz = (nM - fm) < WGM ? (nM - fm) : WGM;
        u.pm = fm + ((wgid % nig) % gsz); u.pn = (wgid % nig) / gsz; return true;
    }
    __device__ __forceinline__ void a_ready(const Unit&) const {}
    __device__ __forceinline__ void done(const Unit&) const {}
};

template <class Epi, class Sched, bool ALIGN_EPI = false, bool SP2 = false, int MF = 4>
__device__ __forceinline__ void gemm_phase(PG8_LAS unsigned char* lds, const Gemm g, const Sched& S, const Epi& E, const int tid_in) {
    const int tid = tid_in, wid = __builtin_amdgcn_readfirstlane(tid >> 6), lane = tid & 63, wr = wid >> 2, wc = wid & 3, fr = lane & 15, fq = lane >> 4;
    static_assert(MF == 4 || (MF == 3 && SP2), "192-row tiles: SP2 schedule only");
    const int K = g.K, nt = K / BK;
    unsigned voffA[2], voffB[2];
#pragma unroll
    for (int i = 0; i < 2; ++i) { int R, C; stage_rc(tid * 16 + i * 8192, R, C); const int Rb = Epi::PERM ? ((R & ~31) + perm32(R & 31)) : R;
        voffA[i] = (unsigned)(R * K + C) * 2u; voffB[i] = (unsigned)(Rb * K + C) * 2u; }
    const size_t kstep = (size_t)(BK * 2);
    const size_t hstep = (size_t)HALF * K * 2;
    const size_t tstep = 2 * hstep;
    const size_t hstepA = (size_t)(MF * 32) * K * 2, tstepA = 2 * hstepA;
    const unsigned ldsw = (unsigned)wid * 1024u;
    const int aoff = lds_byte(wr * (MF * 16) + fr, fq * 8), boff = lds_byte(wc * 32 + fr, fq * 8);
#define PG8_SA(b, h) (((b) * 2 + (h)) * HTB)
#define PG8_SB(b, h) ((4 + (b) * 2 + (h)) * HTB)
#define PG8_STAGE(bufoff, gbase, voff) do { _Pragma("unroll") for (int _i = 0; _i < 2; ++_i) \
        __builtin_amdgcn_global_load_lds((const unsigned*)((const char*)(gbase) + (voff)[_i]), (PG8_LAS unsigned*)(lds + (bufoff) + ldsw + _i * 8192), 16, 0, 0); } while (0)
#define PG8_STAGEA(bufoff, gbase, voff) do { __builtin_amdgcn_global_load_lds((const unsigned*)((const char*)(gbase) + (voff)[0]), (PG8_LAS unsigned*)(lds + (bufoff) + ldsw), 16, 0, 0); \
        if (MF == 4 || wr == 0) __builtin_amdgcn_global_load_lds((const unsigned*)((const char*)(gbase) + (voff)[1]), (PG8_LAS unsigned*)(lds + (bufoff) + ldsw + 8192), 16, 0, 0); } while (0)
#define PG8_LDA(dst, b, h) do { _Pragma("unroll") for (int m = 0; m < MF; ++m) _Pragma("unroll") for (int k = 0; k < 2; ++k) dst[m][k] = *(const PG8_LAS bf16x8*)(lds + PG8_SA(b, h) + aoff + m * 2048 + k * 1024); } while (0)
#define PG8_LDB(dst, b, h) do { _Pragma("unroll") for (int n = 0; n < 2; ++n) _Pragma("unroll") for (int k = 0; k < 2; ++k) dst[n][k] = *(const PG8_LAS bf16x8*)(lds + PG8_SB(b, h) + boff + n * 2048 + k * 1024); } while (0)
#define PG8_MMA(ai, bj, At, Bt) do { __builtin_amdgcn_s_setprio(1); _Pragma("unroll") for (int m = 0; m < MF; ++m) _Pragma("unroll") for (int n = 0; n < 2; ++n) _Pragma("unroll") for (int k = 0; k < 2; ++k) \
        acc[ai][bj][m][n] = __builtin_amdgcn_mfma_f32_16x16x32_bf16(Bt[n][k], At[m][k], acc[ai][bj][m][n], 0, 0, 0); __builtin_amdgcn_s_setprio(0); } while (0)
#define PG8_WAIT_V(n) asm volatile("s_waitcnt vmcnt(" #n ")" ::: "memory")
#define PG8_WAIT_V2(a, b) do { if (MF == 4 || wr == 0) asm volatile("s_waitcnt vmcnt(" #a ")" ::: "memory"); else asm volatile("s_waitcnt vmcnt(" #b ")" ::: "memory"); } while (0)
#define PG8_WAIT_L(n) asm volatile("s_waitcnt lgkmcnt(" #n ")" ::: "memory")
#define PG8_BAR __builtin_amdgcn_s_barrier()
#define PG8_SCHED __builtin_amdgcn_sched_barrier(0)
    Unit cur, nxt; int ui = 0;
    if (!S.next(0, cur)) return;
    f32x4 acc[2][2][MF][2];
#pragma unroll
    for (int a = 0; a < 2; ++a)
#pragma unroll
        for (int b = 0; b < 2; ++b)
#pragma unroll
            for (int m = 0; m < MF; ++m)
#pragma unroll
                for (int n = 0; n < 2; ++n) acc[a][b][m][n] = (f32x4){0.f, 0.f, 0.f, 0.f};
    bf16x8 At[MF][2], B0[2][2], B1[2][2];
#define PG8_SGPR64(p) ((const char*)(((unsigned long long)(unsigned)__builtin_amdgcn_readfirstlane((int)((unsigned long long)(p) >> 32)) << 32) | (unsigned)__builtin_amdgcn_readfirstlane((int)(unsigned long long)(p))))
    const char* cA = PG8_SGPR64((const char*)g.A + (size_t)cur.pm * tstepA); const char* cB = PG8_SGPR64((const char*)g.Bt + (size_t)cur.pn * tstep);
    S.a_ready(cur);
    if constexpr (SP2) {
        PG8_STAGE(PG8_SB(0, 0), cB, voffB); PG8_STAGE(PG8_SB(0, 1), cB + hstep, voffB); PG8_STAGEA(PG8_SA(0, 0), cA, voffA); PG8_STAGEA(PG8_SA(0, 1), cA + hstepA, voffA);
        if (wr == 1) PG8_BAR;
        PG8_WAIT_V2(2, 1); PG8_BAR;
        PG8_STAGE(PG8_SB(1, 0), cB + kstep, voffB); PG8_STAGEA(PG8_SA(1, 0), cA + kstep, voffA); PG8_STAGE(PG8_SB(1, 1), cB + hstep + kstep, voffB);
        PG8_WAIT_V2(6, 5); PG8_BAR;
    } else {
        PG8_STAGE(PG8_SB(0, 0), cB, voffB); PG8_STAGEA(PG8_SA(0, 0), cA, voffA); PG8_STAGE(PG8_SB(0, 1), cB + hstep, voffB); PG8_STAGEA(PG8_SA(0, 1), cA + hstepA, voffA);
        if (wr == 1) PG8_BAR;
        PG8_WAIT_V(4); PG8_BAR;
        PG8_STAGE(PG8_SB(1, 0), cB + kstep, voffB); PG8_STAGEA(PG8_SA(1, 0), cA + kstep, voffA); PG8_STAGE(PG8_SB(1, 1), cB + hstep + kstep, voffB);
        PG8_WAIT_V(6); PG8_BAR;
    }
    for (;;) {
        const bool has_next = S.next(ui + 1, nxt);
        const char* nA = PG8_SGPR64(has_next ? (const char*)g.A + (size_t)nxt.pm * tstepA : cA); const char* nB = PG8_SGPR64(has_next ? (const char*)g.Bt + (size_t)nxt.pn * tstep : cB);
        for (int t = 0; t < nt; t += 2) {
            const bool last = (t == nt - 2);
            const char* a1 = cA + (size_t)(t + 1) * kstep;
            const char* a2 = last ? nA : cA + (size_t)(t + 2) * kstep; const char* b2 = last ? nB : cB + (size_t)(t + 2) * kstep;
            const char* a3 = a2 + kstep; const char* b3 = b2 + kstep;
            if (last && has_next) S.a_ready(nxt);
            if constexpr (SP2) {
            PG8_LDB(B0, 0, 0); PG8_LDB(B1, 0, 1); PG8_SCHED; PG8_LDA(At, 0, 0); PG8_STAGEA(PG8_SA(1, 1), a1 + hstepA, voffA);
            PG8_WAIT_V2(8, 6); PG8_WAIT_L(0); PG8_BAR; PG8_MMA(0, 0, At, B0); PG8_MMA(0, 1, At, B1); PG8_BAR; PG8_SCHED;
            PG8_LDA(At, 0, 1); PG8_STAGE(PG8_SB(0, 0), b2, voffB); PG8_STAGE(PG8_SB(0, 1), b2 + hstep, voffB); PG8_STAGEA(PG8_SA(0, 0), a2, voffA);
            PG8_WAIT_V2(8, 6); PG8_WAIT_L(0); PG8_BAR; PG8_MMA(1, 0, At, B0); PG8_MMA(1, 1, At, B1); PG8_BAR; PG8_SCHED;
            PG8_LDB(B0, 1, 0); PG8_LDB(B1, 1, 1); PG8_SCHED; PG8_LDA(At, 1, 0); PG8_STAGEA(PG8_SA(0, 1), a2 + hstepA, voffA);
            PG8_WAIT_V2(8, 6); PG8_WAIT_L(0); PG8_BAR; PG8_MMA(0, 0, At, B0); PG8_MMA(0, 1, At, B1); PG8_BAR; PG8_SCHED;
            PG8_LDA(At, 1, 1); PG8_STAGE(PG8_SB(1, 0), b3, voffB); PG8_STAGE(PG8_SB(1, 1), b3 + hstep, voffB); PG8_STAGEA(PG8_SA(1, 0), a3, voffA);
            PG8_WAIT_V2(8, 6); PG8_WAIT_L(0); PG8_BAR; PG8_MMA(1, 0, At, B0); PG8_MMA(1, 1, At, B1); PG8_BAR; PG8_SCHED;
            } else {
            PG8_LDB(B0, 0, 0); PG8_SCHED; PG8_LDA(At, 0, 0); PG8_STAGEA(PG8_SA(1, 1), a1 + hstepA, voffA);
            PG8_WAIT_L(8); PG8_BAR; PG8_WAIT_L(0); PG8_MMA(0, 0, At, B0); PG8_BAR; PG8_SCHED;
            PG8_LDB(B1, 0, 1); PG8_STAGE(PG8_SB(0, 0), b2, voffB);
            PG8_BAR; PG8_WAIT_L(0); PG8_MMA(0, 1, At, B1); PG8_BAR;
            PG8_LDA(At, 0, 1); PG8_STAGEA(PG8_SA(0, 0), a2, voffA);
            PG8_BAR; PG8_WAIT_L(0); PG8_MMA(1, 0, At, B0); PG8_BAR; PG8_SCHED;
            PG8_STAGE(PG8_SB(0, 1), b2 + hstep, voffB);
            PG8_WAIT_V(6); PG8_BAR; PG8_MMA(1, 1, At, B1); PG8_BAR;
            PG8_LDB(B0, 1, 0); PG8_SCHED; PG8_LDA(At, 1, 0); PG8_STAGEA(PG8_SA(0, 1), a2 + hstepA, voffA);
            PG8_WAIT_L(8); PG8_BAR; PG8_WAIT_L(0); PG8_MMA(0, 0, At, B0); PG8_BAR; PG8_SCHED;
            PG8_LDB(B1, 1, 1); PG8_STAGE(PG8_SB(1, 0), b3, voffB);
            PG8_BAR; PG8_WAIT_L(0); PG8_MMA(0, 1, At, B1); PG8_BAR;
            PG8_LDA(At, 1, 1); PG8_STAGEA(PG8_SA(1, 0), a3, voffA);
            PG8_BAR; PG8_WAIT_L(0); PG8_MMA(1, 0, At, B0); PG8_BAR; PG8_SCHED;
            PG8_STAGE(PG8_SB(1, 1), b3 + hstep, voffB);
            PG8_WAIT_V(6); PG8_BAR; PG8_MMA(1, 1, At, B1); PG8_BAR;
            }
        }
        if constexpr (ALIGN_EPI) { if (wr == 0) PG8_BAR; }
        if constexpr (!Epi::AFTER_DRAIN) { E.template operator()<MF>(acc, cur, wr, wc, fr, fq); S.done(cur); }
        if (!has_next) break;
#pragma unroll
        for (int a = 0; a < 2; ++a)
#pragma unroll
            for (int b = 0; b < 2; ++b)
#pragma unroll
                for (int m = 0; m < MF; ++m)
#pragma unroll
                    for (int n = 0; n < 2; ++n) acc[a][b][m][n] = (f32x4){0.f, 0.f, 0.f, 0.f};
        cur = nxt; cA = nA; cB = nB; ++ui;
        if constexpr (ALIGN_EPI) { if (wr == 1) PG8_BAR; }
    }
    PG8_WAIT_V(0);
    if constexpr (!ALIGN_EPI) { if (wr == 0) PG8_BAR; }
    PG8_BAR;
    if constexpr (Epi::AFTER_DRAIN) { E.fused(acc, cur, wr, wc, fr, fq, lds, wid, lane); S.done(cur); }
#undef PG8_SA
#undef PG8_SB
#undef PG8_STAGE
#undef PG8_STAGEA
#undef PG8_WAIT_V2
#undef PG8_LDA
#undef PG8_LDB
#undef PG8_MMA
#undef PG8_WAIT_V
#undef PG8_WAIT_L
#undef PG8_BAR
#undef PG8_SCHED
}
}

using pg8::bf16_t; using pg8::bf16x8; using pg8::f32x4; using pg8::u32x4;
typedef float f32x16 __attribute__((ext_vector_type(16)));
typedef float f32x2 __attribute__((ext_vector_type(2)));
typedef short s16x4 __attribute__((ext_vector_type(4)));
typedef unsigned u32x2 __attribute__((ext_vector_type(2)));
typedef __bf16 bf16x2_t __attribute__((ext_vector_type(2)));
#define LAS __attribute__((address_space(3)))
#define LDG(T, base, boff) (*(const __attribute__((address_space(1))) T*)((const __attribute__((address_space(1))) unsigned char*)(base) + (unsigned)(boff)))
#define STG(T, base, boff) (*(__attribute__((address_space(1))) T*)((__attribute__((address_space(1))) unsigned char*)(base) + (unsigned)(boff)))

__device__ __forceinline__ unsigned pk2(float lo, float hi) { f32x2 v = {lo, hi}; bf16x2_t b = __builtin_convertvector(v, bf16x2_t); return __builtin_bit_cast(unsigned, b); }
__device__ __forceinline__ float bf_lo(unsigned u) { return __uint_as_float(u << 16); }
__device__ __forceinline__ float bf_hi(unsigned u) { return __uint_as_float(u & 0xffff0000u); }
__device__ __forceinline__ f32x4 unpack4(u32x2 v) { return (f32x4){bf_lo(v.x), bf_hi(v.x), bf_lo(v.y), bf_hi(v.y)}; }
__device__ __forceinline__ u32x2 pack4(f32x4 v) { u32x2 r; r.x = pk2(v[0], v[1]); r.y = pk2(v[2], v[3]); return r; }
__device__ __forceinline__ float sigmf(float x) { return __builtin_amdgcn_rcpf(1.f + __expf(-x)); }
template <int CTRL> __device__ __forceinline__ float dpp_f(float x) { return __builtin_bit_cast(float, __builtin_amdgcn_update_dpp(0, __builtin_bit_cast(int, x), CTRL, 0xF, 0xF, true)); }
__device__ __forceinline__ float allreduce16(float x) { x += dpp_f<0xB1>(x); x += dpp_f<0x4E>(x); x += dpp_f<0x141>(x); x += dpp_f<0x140>(x); return x; }
__device__ __forceinline__ float rdlane(float x, int l) { return __builtin_bit_cast(float, __builtin_amdgcn_readlane(__builtin_bit_cast(int, x), l)); }
__device__ __forceinline__ float wave_sum(float v) {
    v = allreduce16(v);
    return (rdlane(v, 0) + rdlane(v, 16)) + (rdlane(v, 32) + rdlane(v, 48));
}
__device__ __forceinline__ float swap32_sum(float x) { auto rr = __builtin_amdgcn_permlane32_swap(__float_as_uint(x), __float_as_uint(x), false, false); return __uint_as_float(rr[0]) + __uint_as_float(rr[1]); }
__device__ __forceinline__ float swap32_max(float x) { auto rr = __builtin_amdgcn_permlane32_swap(__float_as_uint(x), __float_as_uint(x), false, false); return fmaxf(__uint_as_float(rr[0]), __uint_as_float(rr[1])); }

constexpr int M = 12288, MC = 4096, DM = 1024, NIN = 3072, FF = 2816, NFF2 = 5632, DEPTH = 4;
constexpr float LOG2E = 1.4426950408889634f;
constexpr float QSCALE_A = 0.125f * LOG2E;
constexpr float QSCALE_B = 0.17677669529663687f * LOG2E;
constexpr unsigned OFF_AK = 12582912, OFF_AV = 14680064, OFF_BK = 16777216, OFF_BV = 20971520, OFF_CF = 25165824, OFF_CB = 26738688;
constexpr unsigned MiB = 1u << 20;
constexpr unsigned WS_CTL = 0, CTL_BYTES = 1 * MiB;
constexpr unsigned WS_MOD = 1 * MiB;
constexpr unsigned WS_TAB = 1 * MiB + 512 * 1024;
constexpr unsigned WS_SMALLW = 2 * MiB;
constexpr unsigned WS_CACHE = 4 * MiB;
constexpr unsigned WS_WIN = 10 * MiB, WS_WOUT = 16 * MiB, WS_W13 = 18 * MiB, WS_W2 = 29 * MiB;
constexpr unsigned WSET_STRIDE = 184 * MiB;
constexpr unsigned WS_ACT = 35 * MiB;
constexpr unsigned WS_QA = 59 * MiB, WS_KA = 68 * MiB, WS_VTA = 71 * MiB, WS_QB = 74 * MiB, WS_KB = 80 * MiB, WS_VTB = 86 * MiB;
constexpr unsigned WS_RKV = 92 * MiB, WS_CW = 119 * MiB, WS_CA = 122 * MiB, WS_CG = 125 * MiB;
constexpr unsigned WS_YF = 128 * MiB, WS_YB = 146 * MiB;
constexpr unsigned WS_SV = 164 * MiB;
constexpr unsigned WS_BO2 = 182 * MiB, WS_ML = 230 * MiB;
constexpr unsigned WS_XB = 206 * MiB;
constexpr unsigned WS_WSET1 = 194 * MiB;
constexpr unsigned WS_RM = 236 * MiB, WS_RN = 254 * MiB, WS_RP = 324 * MiB, WS_RH = 342 * MiB;
constexpr int NCHUNK = 2304;
constexpr unsigned WS_U = 128 * MiB;
constexpr unsigned WS_G = 290 * MiB, WS_SB = 299 * MiB, WS_BO = 300 * MiB, WS_END = 360 * MiB;
constexpr int SMALLW_L = 147456;
constexpr int TAB_COSA = 0, TAB_SINA = 1024, TAB_COSB = 2048, TAB_SINB = 2560, TAB_LAM = 3072;
constexpr int LDS_BYTES = 147456;
constexpr int NPHASE = 2 + 9 * DEPTH;

struct Args {
    const float* in[34];
    float* out; unsigned char* ws;
    int ph_lo, ph_hi;
};

struct EpiRes {
    static constexpr bool PERM = true, AFTER_DRAIN = false;
    const float* baseC; const float* baseL; unsigned char* ws; const float* gate; bool first;
    template <int MF>
    __device__ __forceinline__ void operator()(const f32x4 (&acc)[2][2][MF][2], const pg8::Unit& u, int wr, int wc, int fr_, int fq_) const {
        int fr = fr_, fq = fq_; asm volatile("" : "+v"(fr), "+v"(fq));
        const unsigned col0 = u.pn * 256 + wc * 32 + 8 * fq, rowb = u.pm * (MF * 64) + wr * (MF * 16);
        f32x4 g4[2][2]; int vcur = -1;
#pragma unroll
        for (int ai = 0; ai < 2; ++ai)
#pragma unroll
            for (int m = 0; m < MF; ++m) { const unsigned rf = rowb + ai * (MF * 32) + m * 16, off = (rf + fr) * DM + col0;
                const int v = rf < MC ? 0 : (rf < MC + 4096 ? 1 : 2);
                if (v != vcur) { vcur = v;
#pragma unroll
                    for (int bj = 0; bj < 2; ++bj)
#pragma unroll
                        for (int n = 0; n < 2; ++n) g4[bj][n] = LDG(f32x4, gate, (v * 6144 + col0 + bj * 128 + n * 4) * 4); }
#pragma unroll
                for (int bj = 0; bj < 2; ++bj) { f32x4 b0, b1;
                    if (first) { const float* base = rf < MC ? baseC : baseL; b0 = LDG(f32x4, base, (off + bj * 128) * 4); b1 = LDG(f32x4, base, (off + bj * 128 + 4) * 4); }
                    else { const u32x4 xb = LDG(u32x4, ws, WS_XB + (off + bj * 128) * 2); b0 = (f32x4){bf_lo(xb.x), bf_hi(xb.x), bf_lo(xb.y), bf_hi(xb.y)}; b1 = (f32x4){bf_lo(xb.z), bf_hi(xb.z), bf_lo(xb.w), bf_hi(xb.w)}; }
                    b0 = b0 + g4[bj][0] * acc[ai][bj][m][0]; b1 = b1 + g4[bj][1] * acc[ai][bj][m][1];
                    u32x4 w; w.x = pk2(b0[0], b0[1]); w.y = pk2(b0[2], b0[3]); w.z = pk2(b1[0], b1[1]); w.w = pk2(b1[2], b1[3]);
                    STG(u32x4, ws, WS_XB + (off + bj * 128) * 2) = w; } }
    }
};
struct EpiSwi {
    static constexpr bool PERM = true, AFTER_DRAIN = false;
    bf16_t* U;
    template <int MF>
    __device__ __forceinline__ void operator()(const f32x4 (&acc)[2][2][MF][2], const pg8::Unit& u, int wr, int wc, int fr_, int fq_) const {
        int fr = fr_, fq = fq_; asm volatile("" : "+v"(fr), "+v"(fq));
        const unsigned row0 = u.pm * (MF * 64) + wr * (MF * 16) + fr, oc0 = u.pn * 128 + wc * 32 + 8 * fq;
#pragma unroll
        for (int ai = 0; ai < 2; ++ai)
#pragma unroll
            for (int m = 0; m < MF; ++m) { const unsigned ro = ((row0 + ai * (MF * 32) + m * 16) * FF + oc0) * 2; f32x4 o[2];
#pragma unroll
                for (int bj = 0; bj < 2; ++bj) { const f32x4 g = acc[ai][bj][m][0], up = acc[ai][bj][m][1];
#pragma unroll
                    for (int e = 0; e < 4; ++e) o[bj][e] = g[e] * sigmf(g[e]) * up[e]; }
                const u32x2 lo = pack4(o[0]), hi2 = pack4(o[1]);
                STG(u32x4, U, ro) = (u32x4){lo.x, lo.y, hi2.x, hi2.y}; asm volatile("" ::: "memory"); }
    }
};
struct EpiWin {
    static constexpr bool PERM = true, AFTER_DRAIN = false;
    unsigned char* ws; float* out; int l; LAS unsigned char* lds;
    template <int MF>
    __device__ __forceinline__ void operator()(const f32x4 (&acc)[2][2][MF][2], const pg8::Unit& u, int wr, int wc, int fr_, int fq_) const {
        int fr = fr_, fq = fq_; asm volatile("" : "+v"(fr), "+v"(fq));
        const unsigned rowb = u.pm * (MF * 64) + wr * (MF * 16), row0 = rowb + fr;
#pragma unroll
        for (int bj = 0; bj < 2; ++bj) {
            const unsigned c32 = u.pn * 256 + bj * 128 + wc * 32;
            const unsigned c8 = c32 + 8 * fq;
            if (c32 < 1152 && (c32 < 512 || c32 >= 640)) {
                const bool isA = c32 < 512;
                const bool isK = isA ? (c32 >= 384) : (c32 >= 896);
                const float qs = isK ? 1.f : (isA ? QSCALE_A : QSCALE_B);
                const unsigned ck = isA ? c8 - 384 : c8 - 896;
                const unsigned dbase = isA ? (isK ? WS_KA + (((ck >> 6) * 4 + ((ck & 63) >> 4)) * 64 + ((ck >> 3) & 1) * 32) * 16 : WS_QA + c8 * 2)
                                           : (isK ? WS_KB + (((ck >> 5) * 2 + ((ck & 31) >> 4)) * 64 + ((ck >> 3) & 1) * 32) * 16 : WS_QB + (c8 - 640) * 2);
                const unsigned dpitch = isA ? 768u : 512u;
#pragma unroll
                for (int ai = 0; ai < 2; ++ai)
#pragma unroll
                    for (int m = 0; m < MF; ++m) {
                        const unsigned row = row0 + ai * (MF * 32) + m * 16; const bool lat = rowb + ai * (MF * 32) + m * 16 >= (unsigned)MC;
                        f32x4 v0 = acc[ai][bj][m][0], v1 = acc[ai][bj][m][1];
                        if (lat) {
                            const unsigned t = (row - MC) & 4095, rp = t >> 6, cp = t & 63;
                            unsigned to_;
                            if (isA) { const unsigned pos = ((c32 >> 5) & 1) ? cp : rp; to_ = WS_TAB + (TAB_COSA + pos * 16 + 4 * fq) * 4; }
                            else { const unsigned pos = (fq >> 1) ? cp : rp; to_ = WS_TAB + (TAB_COSB + pos * 8 + 4 * (fq & 1)) * 4; }
                            const f32x4 c4 = LDG(f32x4, ws, to_), s4 = LDG(f32x4, ws, to_ + (isA ? 4096u : 2048u));
                            f32x4 w0, w1;
                            w0[0] = v0[0] * c4[0] - v0[1] * s4[0]; w0[1] = v0[1] * c4[0] + v0[0] * s4[0];
                            w0[2] = v0[2] * c4[1] - v0[3] * s4[1]; w0[3] = v0[3] * c4[1] + v0[2] * s4[1];
                            w1[0] = v1[0] * c4[2] - v1[1] * s4[2]; w1[1] = v1[1] * c4[2] + v1[0] * s4[2];
                            w1[2] = v1[2] * c4[3] - v1[3] * s4[3]; w1[3] = v1[3] * c4[3] + v1[2] * s4[3];
                            v0 = w0; v1 = w1;
                        } else if (isK) {
                            const unsigned b = row >> 8, t = row & 255;
                            const f32x4 ev = {v0[0], v0[2], v1[0], v1[2]}, od = {v0[1], v0[3], v1[1], v1[3]};
                            if (isA) { const unsigned o = (OFF_AK + ((b * 4 + l) * 256 + t) * 128 + (c32 - 384) + 4 * fq) * 4; STG(f32x4, out, o) = ev; STG(f32x4, out, o + 64) = od; }
                            else { const unsigned o = (OFF_BK + ((b * 4 + l) * 256 + t) * 256 + ((c8 - 896) & ~15u) + 4 * (fq & 1)) * 4; STG(f32x4, out, o) = ev; STG(f32x4, out, o + 32) = od; }
                        }
                        v0 = v0 * qs; v1 = v1 * qs;
                        u32x4 w; w.x = pk2(v0[0], v0[1]); w.y = pk2(v0[2], v0[3]); w.z = pk2(v1[0], v1[1]); w.w = pk2(v1[2], v1[3]);
                        STG(u32x4, ws, isK ? dbase + (row >> 5) * (isA ? 8192u : 16384u) + (row & 31) * 16 : dbase + row * dpitch) = w;
                        asm volatile("" ::: "memory");
                    }
            } else if (c32 < 1408) {
                const bool isA = c32 < 640;
                const unsigned cc = isA ? (c8 - 512) : (c8 - 1152), cw = isA ? (c32 - 512) : (c32 - 1152);
                const unsigned vfrag = (isA ? WS_VTA : WS_VTB) + (((cw >> 6) * 2 + ((cw >> 5) & 1)) * 2) * 1024;
                LAS unsigned char* lw = lds + (wr * 4 + wc) * 1024;
                LAS bf16_t* lq = (LAS bf16_t*)(lw + ((((fr >> 2) & 1) * 32 + 8 * fq) * 16 + (4 * (fr >> 3) + (fr & 3)) * 2));
#pragma unroll
                for (int ai = 0; ai < 2; ++ai)
#pragma unroll
                    for (int m = 0; m < MF; ++m) {
                        const unsigned rf = rowb + ai * (MF * 32) + m * 16, row = rf + fr; const bool lat = rf >= (unsigned)MC;
                        const f32x4 v0 = acc[ai][bj][m][0], v1 = acc[ai][bj][m][1];
                        if (!lat) { const unsigned b = row >> 8, t = row & 255;
                            const unsigned o = isA ? (OFF_AV + ((b * 4 + l) * 256 + t) * 128 + cc) * 4 : (OFF_BV + ((b * 4 + l) * 256 + t) * 256 + cc) * 4;
                            STG(f32x4, out, o) = v0; STG(f32x4, out, o + 16) = v1; }
                        const unsigned p0 = pk2(v0[0], v0[1]), p1 = pk2(v0[2], v0[3]), p2 = pk2(v1[0], v1[1]), p3 = pk2(v1[2], v1[3]);
                        lq[0 * 8] = (bf16_t)(p0 & 0xffff); lq[1 * 8] = (bf16_t)(p0 >> 16); lq[2 * 8] = (bf16_t)(p1 & 0xffff); lq[3 * 8] = (bf16_t)(p1 >> 16);
                        lq[4 * 8] = (bf16_t)(p2 & 0xffff); lq[5 * 8] = (bf16_t)(p2 >> 16); lq[6 * 8] = (bf16_t)(p3 & 0xffff); lq[7 * 8] = (bf16_t)(p3 >> 16);
                        const u32x4 tv = *(const LAS u32x4*)(lw + (fq * 16 + fr) * 16);
                        STG(u32x4, ws, vfrag + (rf >> 5) * (isA ? 8192u : 16384u) + ((rf >> 4) & 1) * 1024 + (fq * 16 + fr) * 16) = tv;
                        asm volatile("" ::: "memory");
                    }
            } else if (c32 < 2944) {
                const int kind = c32 < 2560 ? 0 : (c32 < 2688 ? 1 : (c32 < 2816 ? 2 : 3));
                const unsigned dbase = kind == 0 ? WS_RKV + (c8 - 1408) * 2 : (kind == 1 ? WS_CW + (c8 - 2560) * 2 : (kind == 2 ? WS_CA + (c8 - 2688) * 2 : WS_CG + (c8 - 2816) * 2));
                const unsigned dpitch = kind == 0 ? 2304u : 256u;
#pragma unroll
                for (int ai = 0; ai < 2; ++ai)
#pragma unroll
                    for (int m = 0; m < MF; ++m) {
                        const unsigned row = row0 + ai * (MF * 32) + m * 16; const bool lat = rowb + ai * (MF * 32) + m * 16 >= (unsigned)MC;
                        f32x4 v0 = acc[ai][bj][m][0], v1 = acc[ai][bj][m][1];
                        if (kind == 1) {
#pragma unroll
                            for (int e = 0; e < 4; ++e) { v0[e] = 1.f - 2.f * __builtin_amdgcn_rcpf(__expf(2.f * v0[e]) + 1.f); v1[e] = 1.f - 2.f * __builtin_amdgcn_rcpf(__expf(2.f * v1[e]) + 1.f); }
                        } else if (kind == 3) {
#pragma unroll
                            for (int e = 0; e < 4; ++e) { v0[e] = sigmf(v0[e]); v1[e] = sigmf(v1[e]); }
                        }
                        u32x4 w; w.x = pk2(v0[0], v0[1]); w.y = pk2(v0[2], v0[3]); w.z = pk2(v1[0], v1[1]); w.w = pk2(v1[2], v1[3]);
                        STG(u32x4, ws, dbase + row * dpitch) = w;
                        asm volatile("" ::: "memory");
                    }
            }
        }
    }
};

struct Frame {
    LAS unsigned char* lds;
    const float* const* in;
    float* out; unsigned char* ws;
    int tid, lane, wave, gw, ngw, G, bid;
};
#define GAS __attribute__((address_space(1)))
template <class T> __device__ __forceinline__ T* gptr(T* p) {
#if defined(__HIP_DEVICE_COMPILE__)
    __builtin_assume(!__builtin_amdgcn_is_shared((const void*)p)); __builtin_assume(!__builtin_amdgcn_is_private((const void*)p));
#endif
    return p; }
#define INP(k) gptr(F.in[k])
#define WSP(T, off) gptr((T*)(F.ws + (off)))

__device__ __forceinline__ void phase_prologue(Frame& F) {
    const float* cvec = INP(8); const float* cctx = INP(9); const float* ada_w = INP(10); const float* ada_b = INP(11);
    LAS float* sl = (LAS float*)F.lds;
    LAS float* red = (LAS float*)(F.lds + 16384);
    for (int i = F.tid; i < 3072; i += 512) { const int v = i >> 10, k = i & 1023; const float x = v == 0 ? cctx[k] : cvec[(v - 1) * 1024 + k]; sl[i] = x / (1.f + __expf(-x)); }
    __syncthreads();
    float* mod = WSP(float, WS_MOD);
    for (int it = F.bid; it < 384; it += F.G) {
        const int l = it / 96, n0 = (it % 96) * 64;
        const float* W = ada_w + (size_t)l * 1024 * 6144 + n0 + F.lane;
        float a0 = 0.f, a1 = 0.f, a2 = 0.f;
        const int k0 = F.wave * 128;
#pragma unroll 8
        for (int k = k0; k < k0 + 128; ++k) { const float w = *(const GAS float*)(W + (size_t)k * 6144); a0 += sl[k] * w; a1 += sl[1024 + k] * w; a2 += sl[2048 + k] * w; }
        red[(F.wave * 3 + 0) * 64 + F.lane] = a0; red[(F.wave * 3 + 1) * 64 + F.lane] = a1; red[(F.wave * 3 + 2) * 64 + F.lane] = a2;
        __syncthreads();
        if (F.wave < 3) { float s = ada_b[l * 6144 + n0 + F.lane];
#pragma unroll
            for (int w = 0; w < 8; ++w) s += red[(w * 3 + F.wave) * 64 + F.lane];
            mod[(size_t)(l * 3 + F.wave) * 6144 + n0 + F.lane] = s; }
        __syncthreads();
    }
    float* tab = WSP(float, WS_TAB);
    if (F.bid == F.G - 1) {
        for (int i = F.tid; i < 1024; i += 512) { const int pos = i >> 4, f = i & 15; const float ang = (float)pos * __builtin_amdgcn_exp2f(-(float)f * (13.287712379549449f / 16.f)); tab[TAB_COSA + i] = __cosf(ang); tab[TAB_SINA + i] = __sinf(ang); }
        for (int i = F.tid; i < 512; i += 512) { const int pos = i >> 3, f = i & 7; const float ang = (float)pos * __builtin_amdgcn_exp2f(-(float)f * (13.287712379549449f / 8.f)); tab[TAB_COSB + i] = __cosf(ang); tab[TAB_SINB + i] = __sinf(ang); }
        if (F.wave < 4) { const float* lp = INP(16) + F.wave * 128; const int d = F.lane & 31;
            const float p1 = wave_sum(F.lane < 32 ? lp[d] * lp[32 + d] : 0.f), p2 = wave_sum(F.lane < 32 ? 0.f : lp[64 + d] * lp[96 + d]);
            if (F.lane == 0) tab[TAB_LAM + F.wave] = __expf(p1) - __expf(p2); }
    }
    const int gtid = F.bid * 512 + F.tid, gnt = F.G * 512;
    { bf16_t* sw = WSP(bf16_t, WS_SMALLW); const float* cw2 = INP(20); const float* ca2 = INP(22); const float* cg2 = INP(23);
      for (int idx = gtid; idx < 4 * SMALLW_L; idx += gnt) { const int l = idx / SMALLW_L, r = idx % SMALLW_L; float v;
          if (r < 98304) { const int which = r / 49152, rr = r % 49152, d = rr / 24576, ch = (rr % 24576) / 64, k = rr % 64; v = (which ? ca2 : cw2)[((size_t)(l * 2 + d) * 64 + k) * 384 + ch]; }
          else { const int rr = r - 98304, ch = rr / 128, k = rr % 128; v = cg2[((size_t)l * 128 + k) * 384 + ch]; }
          sw[idx] = (bf16_t)(pk2(v, 0.f) & 0xffff); } }
    { bf16_t* kca = WSP(bf16_t, WS_CACHE); bf16_t* vca = kca + 524288; bf16_t* kcb = vca + 524288; bf16_t* vcb = kcb + 1048576;
      const float* cak = INP(2); const float* cav = INP(3); const float* cbk = INP(4); const float* cbv = INP(5);
      for (int e = gtid; e < 524288; e += gnt) {
          const int j = e & 7, ln = (e >> 3) & 63, hi = ln >> 5, r32 = ln & 31, blk = (e >> 12) & 15, bl = e >> 16;
          { const int s = (e >> 9) & 3, kvh = (e >> 11) & 1, cp = kvh * 64 + 16 * s + 8 * hi + j, o = cp & 31, c = (cp - o) + (o >> 1) + 16 * (o & 1);
            kca[e] = (bf16_t)(pk2(cak[((size_t)bl * 512 + blk * 32 + r32) * 128 + c], 0.f) & 0xffff); }
          { const int ks = (e >> 9) & 1, db = (e >> 10) & 1, kvh = (e >> 11) & 1, key = blk * 32 + 16 * ks + 8 * (j >> 2) + 4 * hi + (j & 3);
            vca[e] = (bf16_t)(pk2(cav[((size_t)bl * 512 + key) * 128 + kvh * 64 + db * 32 + r32], 0.f) & 0xffff); } }
      for (int e = gtid; e < 1048576; e += gnt) {
          const int j = e & 7, ln = (e >> 3) & 63, hi = ln >> 5, r32 = ln & 31, blk = (e >> 13) & 15, bl = e >> 17;
          { const int s = (e >> 9) & 1, hm = (e >> 10) & 7, cp = hm * 32 + 16 * s + 8 * hi + j, o = cp & 15, c = (cp - o) + (o >> 1) + 8 * (o & 1);
            kcb[e] = (bf16_t)(pk2(cbk[((size_t)bl * 512 + blk * 32 + r32) * 256 + c], 0.f) & 0xffff); }
          { const int ks = (e >> 9) & 1, db = (e >> 10) & 1, h = (e >> 11) & 3, key = blk * 32 + 16 * ks + 8 * (j >> 2) + 4 * hi + (j & 3);
            vcb[e] = (bf16_t)(pk2(cbv[((size_t)bl * 512 + key) * 256 + h * 64 + db * 32 + r32], 0.f) & 0xffff); } } }
    for (int st = 0; st < 1; ++st) { u32x4* z = (u32x4*)(WSP(bf16_t, WS_WIN + st * WSET_STRIDE) + (size_t)2944 * 1024); unsigned z0; asm volatile("v_mov_b32 %0, 0" : "=v"(z0)); for (int i = gtid; i < 128 * 1024 / 8; i += gnt) z[i] = (u32x4){z0, z0, z0, z0}; }
}

template <int MAP> __device__ __forceinline__ int dest_row(int n) {
    if (MAP == 1) {
        if (n < 512) { const int o = n & 31; return (n - o) + 2 * (o & 15) + (o >> 4); }
        if (n >= 640 && n < 1152) { const int o = n & 15; return (n - o) + 2 * (o & 7) + (o >> 3); }
        return n;
    }
    if (MAP == 2 || MAP == 3) return (n >> 7) * 256 + ((n >> 2) & 1) * 128 + ((n >> 5) & 3) * 32 + ((n >> 3) & 3) * 8 + (MAP == 3 ? 4 : 0) + (n & 3);
    return n;
}
template <int MAP> __device__ __forceinline__ void transpose_item(const float* W, int K, int N, bf16_t* WT, LAS float* scr, int item, int lane) {
    const int nblk = N / 32, kb = item / nblk, nb = item % nblk, k0 = 64 * kb, n0 = 32 * nb;
#pragma unroll 8
    for (int i = 0; i < 32; ++i) { const int kk = 2 * i + (lane >> 5); scr[kk * 33 + (lane & 31)] = *(const GAS float*)(W + (size_t)(k0 + kk) * N + n0 + (lane & 31)); }
    asm volatile("s_waitcnt lgkmcnt(0)" ::: "memory");
    const int c = lane & 7;
#pragma unroll
    for (int j = 0; j < 4; ++j) { const int n = (lane >> 3) + 8 * j; const LAS float* s = scr + (8 * c) * 33 + n;
        u32x4 o; o.x = pk2(s[0 * 33], s[1 * 33]); o.y = pk2(s[2 * 33], s[3 * 33]); o.z = pk2(s[4 * 33], s[5 * 33]); o.w = pk2(s[6 * 33], s[7 * 33]);
        *(GAS u32x4*)(WT + (size_t)dest_row<MAP>(n0 + n) * K + k0 + 8 * c) = o; }
    asm volatile("s_waitcnt lgkmcnt(0)" ::: "memory");
}
template <int MAP> __device__ __forceinline__ void convert_item(const float* W, int K, int N, bf16_t* WT, int item, int lane) {
    const int nblk = N / 64, kb = item / nblk, nb = item % nblk, n = nb * 64 + lane;
    const GAS float* src = (const GAS float*)W + (size_t)(kb * 128) * N + n;
    GAS bf16_t* dst = (GAS bf16_t*)WT + (size_t)dest_row<MAP>(n) * K + kb * 128;
#pragma unroll
    for (int g = 0; g < 16; ++g) { float v[8];
#pragma unroll
        for (int e = 0; e < 8; ++e) v[e] = src[(size_t)(8 * g + e) * N];
        u32x4 o; o.x = pk2(v[0], v[1]); o.y = pk2(v[2], v[3]); o.z = pk2(v[4], v[5]); o.w = pk2(v[6], v[7]);
        *(GAS u32x4*)(dst + 8 * g) = o; }
}
constexpr int CV_IN = 46 * 8, CV_OUT = 16 * 8, CV_1 = 44 * 8, CV_2 = 16 * 22, CV_TOTAL = CV_IN + CV_OUT + 2 * CV_1 + CV_2;
__device__ __forceinline__ void convert_item_any(Frame& F, int l, int it) {
    const unsigned so = 0u * WSET_STRIDE;
    int r = it;
    if (r < CV_IN) { convert_item<1>(INP(14) + (size_t)l * 1024 * 2944, 1024, 2944, WSP(bf16_t, WS_WIN + so), r, F.lane); return; } r -= CV_IN;
    if (r < CV_OUT) { convert_item<0>(INP(29) + (size_t)l * 1024 * 1024, 1024, 1024, WSP(bf16_t, WS_WOUT + so), r, F.lane); return; } r -= CV_OUT;
    if (r < CV_1) { convert_item<2>(INP(30) + (size_t)l * 1024 * FF, 1024, FF, WSP(bf16_t, WS_W13 + so), r, F.lane); return; } r -= CV_1;
    if (r < CV_1) { convert_item<3>(INP(31) + (size_t)l * 1024 * FF, 1024, FF, WSP(bf16_t, WS_W13 + so), r, F.lane); return; } r -= CV_1;
    convert_item<0>(INP(32) + (size_t)l * FF * 1024, FF, 1024, WSP(bf16_t, WS_W2 + so), r, F.lane);
}
__device__ __forceinline__ void convert_weights(Frame& F, int l) {
    LAS float* scr = (LAS float*)(F.lds + F.wave * 16384); const unsigned so = 0u * WSET_STRIDE;
    const float* w_in = INP(14) + (size_t)l * 1024 * 2944; const float* w_out = INP(29) + (size_t)l * 1024 * 1024;
    const float* w1 = INP(30) + (size_t)l * 1024 * FF; const float* w3 = INP(31) + (size_t)l * 1024 * FF; const float* w2 = INP(32) + (size_t)l * FF * 1024;
    constexpr int I_IN = 16 * 92, I_OUT = 16 * 32, I_1 = 16 * 88, I_2 = 44 * 32;
    constexpr int NIT = I_IN + I_OUT + 2 * I_1 + I_2;
    for (int it = F.gw; it < NIT; it += F.ngw) {
        int r = it;
        if (r < I_IN) { transpose_item<1>(w_in, 1024, 2944, WSP(bf16_t, WS_WIN + so), scr, r, F.lane); continue; } r -= I_IN;
        if (r < I_OUT) { transpose_item<0>(w_out, 1024, 1024, WSP(bf16_t, WS_WOUT + so), scr, r, F.lane); continue; } r -= I_OUT;
        if (r < I_1) { transpose_item<2>(w1, 1024, FF, WSP(bf16_t, WS_W13 + so), scr, r, F.lane); continue; } r -= I_1;
        if (r < I_1) { transpose_item<3>(w3, 1024, FF, WSP(bf16_t, WS_W13 + so), scr, r, F.lane); continue; } r -= I_1;
        transpose_item<0>(w2, FF, 1024, WSP(bf16_t, WS_W2 + so), scr, r, F.lane);
    }
}

__device__ __forceinline__ void phase_norm(Frame& F, int l, int which  ) {
    const float* g = (which ? INP(13) : INP(12)) + l * 1024;
    const float* mod = WSP(float, WS_MOD) + (size_t)l * 3 * 6144 + (which ? 3072 : 0);
    bf16_t* H = WSP(bf16_t, WS_ACT);
    const bool first = (l == 0 && which == 0);
    f32x4 gv[4];
#pragma unroll
    for (int j = 0; j < 4; ++j) gv[j] = *(const GAS f32x4*)(g + 4 * F.lane + 256 * j);
    for (int row = F.gw; row < M; row += F.ngw) {
        const float* mv = mod + (row < MC ? 0 : (row < 2 * MC ? 1 : 2)) * 6144;
        f32x4 v[4]; float ss = 0.f;
        if (first) { const float* xr = row < MC ? INP(0) + (size_t)row * DM : INP(1) + (size_t)(row - MC) * DM;
#pragma unroll
            for (int j = 0; j < 4; ++j) v[j] = *(const GAS f32x4*)(xr + 4 * F.lane + 256 * j); }
        else {
#pragma unroll
            for (int j = 0; j < 4; ++j) v[j] = unpack4(LDG(u32x2, F.ws, WS_XB + ((unsigned)row * DM + 4 * F.lane + 256 * j) * 2)); }
#pragma unroll
        for (int j = 0; j < 4; ++j) ss += (v[j][0] * v[j][0] + v[j][1] * v[j][1]) + (v[j][2] * v[j][2] + v[j][3] * v[j][3]);
        const float rstd = rsqrtf(wave_sum(ss) * (1.f / 1024.f) + 1e-6f);
#pragma unroll
        for (int j = 0; j < 4; ++j) { const f32x4 sh = *(const GAS f32x4*)(mv + 4 * F.lane + 256 * j), sc = *(const GAS f32x4*)(mv + 1024 + 4 * F.lane + 256 * j);
            const f32x4 h = v[j] * rstd * gv[j] * (sc + 1.f) + sh;
            *(GAS u32x2*)(H + (size_t)row * DM + 4 * F.lane + 256 * j) = pack4(h); }
    }
}
__device__ __forceinline__ void phase_final_norm(Frame& F) {
    const float* g = INP(33);
    f32x4 gv[4];
#pragma unroll
    for (int j = 0; j < 4; ++j) gv[j] = *(const GAS f32x4*)(g + 4 * F.lane + 256 * j);
    for (int row = F.gw; row < M; row += F.ngw) {
        float* xr = gptr(F.out + (size_t)row * DM);
        f32x4 v[4]; float ss = 0.f;
#pragma unroll
        for (int j = 0; j < 4; ++j) { v[j] = unpack4(LDG(u32x2, F.ws, WS_XB + ((unsigned)row * DM + 4 * F.lane + 256 * j) * 2)); ss += (v[j][0] * v[j][0] + v[j][1] * v[j][1]) + (v[j][2] * v[j][2] + v[j][3] * v[j][3]); }
        const float rstd = rsqrtf(wave_sum(ss) * (1.f / 1024.f) + 1e-6f);
#pragma unroll
        for (int j = 0; j < 4; ++j) *(GAS f32x4*)(xr + 4 * F.lane + 256 * j) = v[j] * rstd * gv[j];
    }
}

#define MFMA32(a, b, c) __builtin_amdgcn_mfma_f32_32x32x16_bf16((a), (b), (c), 0, 0, 0)
#ifndef ATT_PROBE
#define ATT_PROBE 0
#endif
struct AttnQ { float m, l; bool mz; f32x16 o[2]; };
template <int DQK, bool MASK, int NQ>
__device__ __forceinline__ void attn_block(const bf16x8 (&qf)[NQ][DQK / 16], const bf16x8 (&kf)[DQK / 16], const bf16x8 (&vf)[4], AttnQ (&st)[NQ], int b, const int (&qpos)[NQ], int kpos0, int hi) {
    constexpr int NS = DQK / 16;
    f32x16 sc[NQ];
#pragma unroll
    for (int q = 0; q < NQ; ++q) { const f32x16 z = {}; sc[q] = MFMA32(kf[0], qf[q][0], z);
#pragma unroll
        for (int s = 1; s < NS; ++s) sc[q] = MFMA32(kf[s], qf[q][s], sc[q]); }
#pragma unroll
    for (int q = 0; q < NQ; ++q) {
        if (!st[q].mz) {
#pragma unroll
            for (int r = 0; r < 16; ++r) sc[q][r] -= st[q].m; }
        if (MASK) {
#pragma unroll
            for (int r = 0; r < 16; ++r) { const int key = kpos0 + 32 * b + (r & 3) + 8 * (r >> 2) + 4 * hi; const int dlt = key - qpos[q]; if (dlt > 128 || dlt < -128) sc[q][r] = -1e30f; }
        }
        float bm = fmaxf(fmaxf(sc[q][0], sc[q][1]), sc[q][2]);
#pragma unroll
        for (int r = 3; r < 15; r += 2) bm = fmaxf(fmaxf(bm, sc[q][r]), sc[q][r + 1]);
        bm = fmaxf(bm, sc[q][15]);
        bm = swap32_max(bm);
        if (__builtin_amdgcn_ballot_w64(bm > 64.f) != 0ull) {
            const float d = fmaxf(bm, 0.f);
            const float alpha = __builtin_amdgcn_exp2f(-d);
            st[q].m += d; st[q].l *= alpha; st[q].mz = false;
#pragma unroll
            for (int r = 0; r < 16; ++r) { st[q].o[0][r] *= alpha; st[q].o[1][r] *= alpha; sc[q][r] -= d; }
        }
#if ATT_PROBE == 1
        { float dmy = 0.f;
#pragma unroll
          for (int r = 0; r < 16; ++r) { float e_; asm volatile("v_exp_f32 %0, %1" : "=v"(e_) : "v"(sc[q][r])); dmy += e_; }
          asm volatile("" :: "v"(dmy)); }
#endif
        f32x2 rs2 = {0.f, 0.f};
#pragma unroll
        for (int r = 0; r < 16; r += 2) { sc[q][r] = __builtin_amdgcn_exp2f(sc[q][r]); sc[q][r + 1] = __builtin_amdgcn_exp2f(sc[q][r + 1]); rs2 += (f32x2){sc[q][r], sc[q][r + 1]}; }
        st[q].l += rs2[0] + rs2[1];
#if ATT_PROBE == 3
        { float d0 = 0.f, d1 = 0.f, d2 = 0.f, d3 = 0.f;
#pragma unroll
          for (int rr = 0; rr < 10; ++rr) { asm volatile("v_add_f32 %0, %0, %4\n\tv_add_f32 %1, %1, %5\n\tv_add_f32 %2, %2, %6\n\tv_add_f32 %3, %3, %7" : "+v"(d0), "+v"(d1), "+v"(d2), "+v"(d3) : "v"(sc[q][0]), "v"(sc[q][1]), "v"(sc[q][2]), "v"(sc[q][3])); }
          asm volatile("" :: "v"(d0), "v"(d1), "v"(d2), "v"(d3)); }
#endif
#if ATT_PROBE == 2
        { f32x16 dm = sc[q]; dm = MFMA32(kf[0], qf[q][0], dm); dm = MFMA32(kf[0], qf[q][0], dm); dm = MFMA32(kf[0], qf[q][0], dm); asm volatile("" :: "v"(dm)); }
#endif
        bf16x8 pb[2];
#pragma unroll
        for (int ks = 0; ks < 2; ++ks) { u32x4 w; w.x = pk2(sc[q][8 * ks], sc[q][8 * ks + 1]); w.y = pk2(sc[q][8 * ks + 2], sc[q][8 * ks + 3]); w.z = pk2(sc[q][8 * ks + 4], sc[q][8 * ks + 5]); w.w = pk2(sc[q][8 * ks + 6], sc[q][8 * ks + 7]); pb[ks] = __builtin_bit_cast(bf16x8, w); }
#pragma unroll
        for (int db = 0; db < 2; ++db)
#pragma unroll
            for (int ks = 0; ks < 2; ++ks) st[q].o[db] = MFMA32(vf[db * 2 + ks], pb[ks], st[q].o[db]);
    }
}
template <int DQK, bool MASK, int NQ>
__device__ __forceinline__ void attn_seg(const unsigned char* ws, const bf16x8 (&qf)[NQ][DQK / 16], AttnQ (&st)[NQ],
                                         unsigned kp, unsigned kblk  , unsigned vp, unsigned vblk, int nblk, const int (&qpos)[NQ], int kpos0, int hi) {
    constexpr int NS = DQK / 16;
    const GAS unsigned char* kq = (const GAS unsigned char*)ws + kp; const GAS unsigned char* vq = (const GAS unsigned char*)ws + vp;
    bf16x8 ka[NS], va[4], kb[NS], vb[4];
#define ATT_LOAD(kd, vd) do { _Pragma("unroll") for (int s = 0; s < NS; ++s) kd[s] = *(const GAS bf16x8*)(kq + 1024 * s); _Pragma("unroll") for (int f = 0; f < 4; ++f) vd[f] = *(const GAS bf16x8*)(vq + 1024 * f); } while (0)
    ATT_LOAD(ka, va);
    int b = 0;
    for (; b + 1 < nblk; b += 2) {
        kq += kblk; vq += vblk; ATT_LOAD(kb, vb);
        attn_block<DQK, MASK, NQ>(qf, ka, va, st, b, qpos, kpos0, hi);
        if (b + 2 < nblk) { kq += kblk; vq += vblk; }
        ATT_LOAD(ka, va);
        attn_block<DQK, MASK, NQ>(qf, kb, vb, st, b + 1, qpos, kpos0, hi);
    }
    if (b < nblk) attn_block<DQK, MASK, NQ>(qf, ka, va, st, b, qpos, kpos0, hi);
#undef ATT_LOAD
}
__device__ __forceinline__ void attnq_init(AttnQ& s, float l0) { s.m = 0.f; s.mz = true; s.l = l0; s.o[0] = (f32x16){}; s.o[1] = (f32x16){}; }
__device__ __forceinline__ void attn_a_item(Frame& F, int l, bool lat, int item) {
    int lane = F.lane; asm volatile("" : "+v"(lane));
    const unsigned char* ws = F.ws;
    const unsigned r32 = lane & 31, hi = lane >> 5;
    const unsigned nqb = lat ? 128 : 8;
    const unsigned qb = item % nqb, hq = (item / nqb) % 6, b = item / (nqb * 6), kvh = hq / 3;
    const unsigned seq0 = lat ? MC + b * 4096 : b * 256, q0 = qb * 32, row = seq0 + q0 + r32;
    const unsigned qo = WS_QA + (row * 384 + hq * 64 + 8 * hi) * 2;
    bf16x8 qf[1][4];
#pragma unroll
    for (int s = 0; s < 4; ++s) qf[0][s] = LDG(bf16x8, ws, qo + 32 * s);
    AttnQ st[1]; attnq_init(st[0], hi == 0 ? __builtin_amdgcn_exp2f(INP(15)[l * 6 + hq] * LOG2E) : 0.f);
    const int qpos[1] = {(int)(q0 + r32)};
    const unsigned fo = kvh * 4096 + lane * 16;
    if (!lat) {
        attn_seg<64, false, 1>(ws, qf, st, WS_KA + (seq0 >> 5) * 8192 + fo, 8192, WS_VTA + (seq0 >> 5) * 8192 + fo, 8192, 8, qpos, 0, hi);
    } else {
        const int ks = (int)q0 - 128 < 0 ? 0 : (int)q0 - 128, ke = q0 + 160 > 4096 ? 4096 : q0 + 160;
        attn_seg<64, true, 1>(ws, qf, st, WS_KA + ((seq0 + ks) >> 5) * 8192 + fo, 8192, WS_VTA + ((seq0 + ks) >> 5) * 8192 + fo, 8192, (ke - ks) >> 5, qpos, ks, hi);
        attn_seg<64, false, 1>(ws, qf, st, WS_CACHE + (b * 4 + l) * 131072 + fo, 8192, WS_CACHE + 1 * MiB + (b * 4 + l) * 131072 + fo, 8192, 16, qpos, 0, hi);
    }
    const float rl = 1.f / swap32_sum(st[0].l);
    const unsigned oo = WS_ACT + (row * DM + hq * 64 + 4 * hi) * 2;
#pragma unroll
    for (int db = 0; db < 2; ++db)
#pragma unroll
        for (int g = 0; g < 4; ++g) { const f32x4 v = {st[0].o[db][4 * g] * rl, st[0].o[db][4 * g + 1] * rl, st[0].o[db][4 * g + 2] * rl, st[0].o[db][4 * g + 3] * rl}; STG(u32x2, F.ws, oo + (32 * db + 8 * g) * 2) = pack4(v); }
}
__device__ __forceinline__ void attn_b_store(Frame& F, const AttnQ& s, unsigned mp, unsigned kh, unsigned row, unsigned h, unsigned hi) {
    const float lt = swap32_sum(s.l);
    const unsigned oo = WS_BO2 + (((mp * 2 + kh) * M + row) * 256 + h * 64 + 4 * hi) * 2;
#pragma unroll
    for (int db = 0; db < 2; ++db)
#pragma unroll
        for (int g = 0; g < 4; ++g) STG(u32x2, F.ws, oo + (32 * db + 8 * g) * 2) = pack4((f32x4){s.o[db][4 * g], s.o[db][4 * g + 1], s.o[db][4 * g + 2], s.o[db][4 * g + 3]});
    if (hi == 0) STG(f32x2, F.ws, WS_ML + ((((mp * 2 + kh) * M + row) * 4 + h) * 2) * 4) = (f32x2){s.m, lt};
}
__device__ __forceinline__ void attn_b_item(Frame& F, int l, bool lat, int item) {
    int lane = F.lane; asm volatile("" : "+v"(lane));
    const unsigned char* ws = F.ws;
    const unsigned r32 = lane & 31, hi = lane >> 5;
    if (lat) {
        const unsigned kh = item & 1, qb = (item >> 1) & 63, mp = (item >> 7) & 1, h = (item >> 8) & 3, b = item >> 10;
        const unsigned seq0 = MC + b * 4096, row0 = seq0 + qb * 64 + r32;
        bf16x8 qf[2][2];
#pragma unroll
        for (int q = 0; q < 2; ++q)
#pragma unroll
            for (int s = 0; s < 2; ++s) qf[q][s] = LDG(bf16x8, ws, WS_QB + ((row0 + 32 * q) * 256 + h * 64 + mp * 32 + 8 * hi) * 2 + 32 * s);
        AttnQ st[2]; attnq_init(st[0], 0.f); attnq_init(st[1], 0.f);
        const int qpos[2] = {0, 0};
        const unsigned kfo = (h * 2 + mp) * 2048 + lane * 16, vfo = h * 4096 + lane * 16;
        const unsigned blk0 = kh ? 72u : 0u, nb = kh ? 56 : 72;
        attn_seg<32, false, 2>(ws, qf, st, WS_KB + ((seq0 >> 5) + blk0) * 16384 + kfo, 16384, WS_VTB + ((seq0 >> 5) + blk0) * 16384 + vfo, 16384, nb, qpos, 0, hi);
        if (kh) attn_seg<32, false, 2>(ws, qf, st, WS_CACHE + 2 * MiB + (b * 4 + l) * 262144 + kfo, 16384, WS_CACHE + 4 * MiB + (b * 4 + l) * 262144 + vfo, 16384, 16, qpos, 0, hi);
        attn_b_store(F, st[0], mp, kh, row0, h, hi); attn_b_store(F, st[1], mp, kh, row0 + 32, h, hi);
    } else {
        const unsigned qb = item & 7, mp = (item >> 3) & 1, h = (item >> 4) & 3, b = item >> 6;
        const unsigned seq0 = b * 256, row = seq0 + qb * 32 + r32;
        bf16x8 qf[1][2];
#pragma unroll
        for (int s = 0; s < 2; ++s) qf[0][s] = LDG(bf16x8, ws, WS_QB + (row * 256 + h * 64 + mp * 32 + 8 * hi) * 2 + 32 * s);
        AttnQ st[1]; attnq_init(st[0], 0.f);
        const int qpos[1] = {0};
        const unsigned kfo = (h * 2 + mp) * 2048 + lane * 16, vfo = h * 4096 + lane * 16;
        attn_seg<32, false, 1>(ws, qf, st, WS_KB + (seq0 >> 5) * 16384 + kfo, 16384, WS_VTB + (seq0 >> 5) * 16384 + vfo, 16384, 8, qpos, 0, hi);
        attn_b_store(F, st[0], mp, 0, row, h, hi);
    }
}

constexpr int L_KT = 0, L_RT = 9216, L_BT = 18432, L_KK = 27648, L_VT = 36864, L_KKT = 46080, L_BTT = 55296, L_A1 = 64512, L_RHS2 = 81920, L_WT = 99328, L_U0T = 108544, L_GC = 117760, L_X0 = 118016;
constexpr int RPB = 144, RPF = 272;
__device__ __forceinline__ void chunk_decode(int cid, unsigned& seq0, int& T, unsigned& b, unsigned& h, unsigned& dir, int& c) {
    unsigned chain;
    if (cid < 768) { chain = (unsigned)cid >> 2; c = cid & 3; T = 256; b = chain / 12; seq0 = b * 256; }
    else { const unsigned x = (unsigned)cid - 768; chain = x >> 6; c = (int)(x & 63); T = 4096; b = chain / 12; seq0 = MC + b * 4096; }
    dir = chain & 1; h = (chain >> 1) % 6;
}
__device__ __forceinline__ bf16x8 acc_frag(const f32x16& x, int ks, float sgn) {
    u32x4 w; w.x = pk2(sgn * x[8 * ks], sgn * x[8 * ks + 1]); w.y = pk2(sgn * x[8 * ks + 2], sgn * x[8 * ks + 3]); w.z = pk2(sgn * x[8 * ks + 4], sgn * x[8 * ks + 5]); w.w = pk2(sgn * x[8 * ks + 6], sgn * x[8 * ks + 7]);
    return __builtin_bit_cast(bf16x8, w);
}
__device__ __forceinline__ bf16x8 lds_frag_nat(const LAS unsigned char* img, unsigned row, int ks, unsigned hi) { return *(const LAS bf16x8*)(img + row * RPB + (16 * ks + 8 * hi) * 2); }
__device__ __forceinline__ bf16x8 lds_frag_perm(const LAS unsigned char* img, unsigned row, int k0, unsigned hi) {
    const s16x4 a = *(const LAS s16x4*)(img + row * RPB + (k0 + 4 * hi) * 2), b = *(const LAS s16x4*)(img + row * RPB + (k0 + 8 + 4 * hi) * 2);
    return (bf16x8){a[0], a[1], a[2], a[3], b[0], b[1], b[2], b[3]};
}
__device__ __forceinline__ f32x16 gram_tile(const LAS unsigned char* lds, int aimg, int bimg, int sb, int tb, unsigned r32, unsigned hi, bool strict) {
    f32x16 acc = {};
#pragma unroll
    for (int ks = 0; ks < 4; ++ks) acc = MFMA32(lds_frag_nat(lds + aimg, 32 * sb + r32, ks, hi), lds_frag_nat(lds + bimg, 32 * tb + r32, ks, hi), acc);
    if (sb == tb) {
#pragma unroll
        for (int r = 0; r < 16; ++r) { const unsigned s_ = (r & 3) + 8 * (r >> 2) + 4 * hi; const bool keep = strict ? s_ < r32 : s_ <= r32; acc[r] = keep ? acc[r] : 0.f; }
    }
    return acc;
}
__device__ __forceinline__ void lds_barrier() { asm volatile("s_waitcnt lgkmcnt(0)\n\ts_barrier" ::: "memory"); }
__device__ __forceinline__ void rwkv_chunk_block(Frame& F, int l, int cid) {
    int lane = F.lane; asm volatile("" : "+v"(lane));
    const unsigned char* ws = F.ws; LAS unsigned char* lds = F.lds;
    const int w = F.wave; const unsigned r32 = lane & 31, hi = lane >> 5;
    unsigned seq0, b, h, dir; int T, c; chunk_decode(cid, seq0, T, b, h, dir, c);
    const int q0 = 64 * c;
#ifndef RA_REP
#define RA_REP 0
#endif
    const int role = w >> 1, tb = w & 1;
    const unsigned swo = WS_SMALLW + l * (SMALLW_L * 2);
    {
        const int pw_ = w < 4, pb = (w >> 1) & 1, cb = w & 1;
        const int p_ = 32 * pb + r32; const unsigned tokp = seq0 + (dir ? T - 1 - (q0 + p_) : q0 + p_);
        const unsigned xo = (pw_ ? WS_CW : WS_CA) + (tokp * 128 + dir * 64 + 8 * hi) * 2, wo = swo + ((pw_ ? 0 : 49152) + (dir * 384 + h * 64 + 32 * cb + r32) * 64 + 8 * hi) * 2;
        f32x16 acc = {};
#pragma unroll
        for (int ks = 0; ks < 4; ++ks) acc = MFMA32(LDG(bf16x8, ws, xo + 32 * ks), LDG(bf16x8, ws, wo + 32 * ks), acc);
        {
            const float bias = LDG(float, pw_ ? INP(19) : INP(21), ((l * 2 + dir) * 384 + h * 64 + 32 * cb + r32) * 4);
#pragma unroll
            for (int r = 0; r < 16; ++r) { const float sg = sigmf(bias + acc[r]);
                *(LAS float*)(lds + (pw_ ? L_A1 : L_RHS2) + (32 * pb + (r & 3) + 8 * (r >> 2) + 4 * hi) * RPF + (32 * cb + r32) * 4) = pw_ ? -0.606531f * sg : sg; }
        }
        if (dir == 0 && w < 4) {
            f32x16 ag = {};
            const unsigned go = WS_CG + (tokp * 128 + 8 * hi) * 2, gw_ = swo + (98304 + (h * 64 + 32 * cb + r32) * 128 + 8 * hi) * 2;
#pragma unroll
            for (int ks = 0; ks < 8; ++ks) ag = MFMA32(LDG(bf16x8, ws, go + 32 * ks), LDG(bf16x8, ws, gw_ + 32 * ks), ag);
#pragma unroll
            for (int r = 0; r < 16; ++r) { const int pp_ = 32 * pb + (r & 3) + 8 * (r >> 2) + 4 * hi; const unsigned tk = seq0 + q0 + pp_;
                STG(bf16_t, F.ws, WS_G + (tk * 384 + h * 64 + 32 * cb + r32) * 2) = (bf16_t)(pk2(ag[r], 0.f) & 0xffff); }
        }
    }
    lds_barrier();
    {
        const unsigned cch = h * 64 + lane;
        const float* convp = INP(18) + (size_t)l * 3 * 1152;
        float cw_[3][3];
#pragma unroll
        for (int tap = 0; tap < 3; ++tap)
#pragma unroll
            for (int seg = 0; seg < 3; ++seg) cw_[tap][seg] = LDG(float, convp, (tap * 1152 + seg * 384 + cch) * 4);
        const float ckk = LDG(float, INP(24), (l * 384 + cch) * 4), cka = LDG(float, INP(25), (l * 384 + cch) * 4), crk = LDG(float, INP(26), (l * 384 + cch) * 4);
        const int tb0 = dir ? T - 1 - (q0 + 8 * w + 7) : q0 + 8 * w;
        float xr[10][3];
#pragma unroll
        for (int rr = 0; rr < 10; ++rr) { const int tr = tb0 - 1 + rr; const bool ok = tr >= 0 && tr < T; const unsigned tk = seq0 + (ok ? tr : tb0);
#pragma unroll
            for (int seg = 0; seg < 3; ++seg) { const float x = bf_lo((unsigned)LDG(bf16_t, ws, WS_RKV + (tk * 1152 + seg * 384 + cch) * 2)); xr[rr][seg] = ok ? x : 0.f; } }
        float lwv[8], kkv[8], btv[8], kdv[8], rv[8], vv[8], g = 0.f;
#pragma unroll
        for (int pp = 0; pp < 8; ++pp) {
            const int rr = 1 + (dir ? 7 - pp : pp); const int p = 8 * w + pp; const unsigned tok = seq0 + (unsigned)(tb0 + rr - 1);
            const float r_ = xr[rr - 1][0] * cw_[0][0] + xr[rr][0] * cw_[1][0] + xr[rr + 1][0] * cw_[2][0];
            const float k_ = xr[rr - 1][1] * cw_[0][1] + xr[rr][1] * cw_[1][1] + xr[rr + 1][1] * cw_[2][1];
            const float v_ = xr[rr - 1][2] * cw_[0][2] + xr[rr][2] * cw_[1][2] + xr[rr + 1][2] * cw_[2][2];
            const float kraw = k_ * ckk; const float n2 = wave_sum(kraw * kraw); const float kk_ = kraw * __builtin_amdgcn_rsqf(fmaxf(n2, 1e-24f));
            const float lw = *(const LAS float*)(lds + L_A1 + p * RPF + lane * 4), av = *(const LAS float*)(lds + L_RHS2 + p * RPF + lane * 4);
            const float kd_ = k_ * (1.f + (av - 1.f) * cka);
            const float bon = wave_sum(r_ * kd_ * crk);
            if (lane == 0) STG(float, F.ws, WS_SB + ((dir * M + tok) * 8 + h) * 4) = bon;
            if (dir == 0) STG(float, F.ws, WS_SV + (tok * 384 + cch) * 4) = v_;
            lwv[pp] = lw; kkv[pp] = kk_; btv[pp] = kk_ * av; kdv[pp] = kd_; rv[pp] = r_; vv[pp] = v_; g += lw;
        }
        g = 0.f;
        for (int wq = 0; wq < w; ++wq) { float t8[8];
#pragma unroll
            for (int e = 0; e < 8; ++e) t8[e] = *(const LAS float*)(lds + L_A1 + (8 * wq + e) * RPF + lane * 4);
            g += ((t8[0] + t8[1]) + (t8[2] + t8[3])) + ((t8[4] + t8[5]) + (t8[6] + t8[7])); }
        unsigned vt[4], kkt[4], btt[4]; float e_pos = __expf(g);
#pragma unroll
        for (int pp = 0; pp < 8; ++pp) {
            const int p = 8 * w + pp;
            const float e_prev = e_pos; g += lwv[pp]; e_pos = __expf(g); const float e_neg = __expf(-g);
            const unsigned pk_kr = pk2(kkv[pp] * e_prev, rv[pp] * e_pos), pk_bk = pk2(btv[pp] * e_neg, kdv[pp] * e_neg), pk_v = pk2(vv[pp], 0.f);
            *(LAS bf16_t*)(lds + L_KT + p * RPB + lane * 2) = (bf16_t)(pk_kr & 0xffff); *(LAS bf16_t*)(lds + L_RT + p * RPB + lane * 2) = (bf16_t)(pk_kr >> 16);
            *(LAS bf16_t*)(lds + L_BT + p * RPB + lane * 2) = (bf16_t)(pk_bk & 0xffff); *(LAS bf16_t*)(lds + L_KK + p * RPB + lane * 2) = (bf16_t)(pk_bk >> 16);
            if (pp & 1) { vt[pp >> 1] |= pk_v << 16; kkt[pp >> 1] |= pk_bk & 0xffff0000u; btt[pp >> 1] |= pk_bk << 16; }
            else { vt[pp >> 1] = pk_v & 0xffff; kkt[pp >> 1] = pk_bk >> 16; btt[pp >> 1] = pk_bk & 0xffff; }
        }
        *(LAS u32x4*)(lds + L_VT + lane * RPB + 16 * w) = (u32x4){vt[0], vt[1], vt[2], vt[3]};
        *(LAS u32x4*)(lds + L_KKT + lane * RPB + 16 * w) = (u32x4){kkt[0], kkt[1], kkt[2], kkt[3]};
        *(LAS u32x4*)(lds + L_BTT + lane * RPB + 16 * w) = (u32x4){btt[0], btt[1], btt[2], btt[3]};
        if (w == 7) *(LAS float*)(lds + L_GC + lane * 4) = e_pos;
    }
    lds_barrier();
    f32x16 keep[2]; bf16x8 x4f[2][2];
    if (role == 0) {
        for (int sb = 0; sb <= tb; ++sb) { const f32x16 x = gram_tile(lds, L_BT, L_KT, sb, tb, r32, hi, true);
            if (sb == tb) {
#pragma unroll
                for (int r = 0; r < 16; ++r) *(LAS float*)(lds + L_A1 + tb * 4608 + ((r & 3) + 8 * (r >> 2) + 4 * hi) * 144 + r32 * 4) = -x[r];
            } else {
#pragma unroll
                for (int g4 = 0; g4 < 4; ++g4) *(LAS f32x4*)(lds + L_A1 + 9216 + r32 * 144 + (8 * g4 + 4 * hi) * 4) = (f32x4){x[4 * g4], x[4 * g4 + 1], x[4 * g4 + 2], x[4 * g4 + 3]};
            } }
    } else if (role == 1) {
        f32x16 o[2] = {};
        for (int sb = 0; sb <= tb; ++sb) {
            const f32x16 x = gram_tile(lds, L_KK, L_KT, sb, tb, r32, hi, true);
#pragma unroll
            for (int ks = 0; ks < 2; ++ks) { const bf16x8 a = acc_frag(x, ks, 1.f);
#pragma unroll
                for (int ib = 0; ib < 2; ++ib) o[ib] = MFMA32(a, lds_frag_perm(lds + L_VT, 32 * ib + r32, 32 * sb + 16 * ks, hi), o[ib]); }
        }
#pragma unroll
        for (int ib = 0; ib < 2; ++ib)
#pragma unroll
            for (int r = 0; r < 16; ++r) *(LAS float*)(lds + L_RHS2 + (32 * tb + (r & 3) + 8 * (r >> 2) + 4 * hi) * RPF + (32 * ib + r32) * 4) = o[ib][r];
    } else if (role == 2) {
#pragma unroll
        for (int sb = 0; sb < 2; ++sb) { x4f[sb][0] = (bf16x8){}; x4f[sb][1] = (bf16x8){}; }
        keep[0] = (f32x16){}; keep[1] = (f32x16){};
        for (int sb = 0; sb <= tb; ++sb) {
            const f32x16 x3 = gram_tile(lds, L_KK, L_RT, sb, tb, r32, hi, false), x4 = gram_tile(lds, L_BT, L_RT, sb, tb, r32, hi, false);
#pragma unroll
            for (int ks = 0; ks < 2; ++ks) { const bf16x8 a3 = acc_frag(x3, ks, 1.f); const bf16x8 a4 = acc_frag(x4, ks, -1.f);
                if (sb == 0) x4f[0][ks] = a4; else x4f[1][ks] = a4;
#pragma unroll
                for (int cb = 0; cb < 2; ++cb) keep[cb] = MFMA32(a3, lds_frag_perm(lds + L_VT, 32 * cb + r32, 32 * sb + 16 * ks, hi), keep[cb]); }
        }
    } else {
        keep[0] = (f32x16){}; keep[1] = (f32x16){};
#pragma unroll
        for (int ks = 0; ks < 4; ++ks) { const bf16x8 ak = lds_frag_nat(lds + L_KKT, 32 * tb + r32, ks, hi);
#pragma unroll
            for (int cb = 0; cb < 2; ++cb) keep[cb] = MFMA32(ak, lds_frag_nat(lds + L_VT, 32 * cb + r32, ks, hi), keep[cb]); }
    }
    lds_barrier();
    if (w < 2) {
        const LAS unsigned char* a1p = lds + L_A1; asm volatile("" : "+v"(a1p));
        LAS unsigned char* xp = lds + (w == 0 ? L_X0 : L_RHS2) + lane * 4; asm volatile("" : "+v"(xp));
        const LAS unsigned char* kp = lds + L_KT + lane * 2; asm volatile("" : "+v"(kp));
        LAS unsigned char* dst = lds + (w == 0 ? L_WT : L_U0T) + lane * RPB; asm volatile("" : "+v"(dst));
#pragma unroll
        for (int B = 0; B < 2; ++B) {
            float acc[32];
            if (w == 0 && B == 0) {
#pragma unroll
                for (int r = 0; r < 32; ++r) acc[r] = bf_lo((unsigned)*(const LAS bf16_t*)(kp + r * RPB));
            } else {
#pragma unroll
                for (int r = 0; r < 32; ++r) acc[r] = *(const LAS float*)(xp + (32 * B + r) * RPF);
            }
            f32x2 ac2[16];
#pragma unroll
            for (int k = 0; k < 16; ++k) ac2[k] = (f32x2){acc[2 * k], acc[2 * k + 1]};
            f32x4 ca[8], cn[8];
#pragma unroll
            for (int tg = 0; tg < 8; ++tg) ca[tg] = *(const LAS f32x4*)(a1p + B * 4608 + tg * 16);
#pragma unroll
            for (int s_ = 0; s_ < 31; ++s_) {
                if (s_ + 1 < 31) {
#pragma unroll
                    for (int tg = (s_ + 2) / 4; tg < 8; ++tg) cn[tg] = *(const LAS f32x4*)(a1p + B * 4608 + (s_ + 1) * 144 + tg * 16);
                }
                __builtin_amdgcn_sched_barrier(0);
                const float xs = ac2[s_ >> 1][s_ & 1];
                const f32x2 xs2 = {xs, xs};
#pragma unroll
                for (int tg = (s_ + 1) / 4; tg < 8; ++tg) {
                    ac2[2 * tg] = __builtin_elementwise_fma((f32x2){ca[tg][0], ca[tg][1]}, xs2, ac2[2 * tg]);
                    ac2[2 * tg + 1] = __builtin_elementwise_fma((f32x2){ca[tg][2], ca[tg][3]}, xs2, ac2[2 * tg + 1]); }
                __builtin_amdgcn_sched_barrier(0);
#pragma unroll
                for (int tg = 0; tg < 8; ++tg) ca[tg] = cn[tg];
            }
#pragma unroll
            for (int k = 0; k < 16; ++k) { acc[2 * k] = ac2[k][0]; acc[2 * k + 1] = ac2[k][1]; }
#pragma unroll
            for (int k8 = 0; k8 < 4; ++k8) { u32x4 v; v.x = pk2(acc[8 * k8], acc[8 * k8 + 1]); v.y = pk2(acc[8 * k8 + 2], acc[8 * k8 + 3]); v.z = pk2(acc[8 * k8 + 4], acc[8 * k8 + 5]); v.w = pk2(acc[8 * k8 + 6], acc[8 * k8 + 7]);
                *(LAS u32x4*)(dst + 64 * B + 16 * k8) = v; }
            if (B == 0) {
                asm volatile("s_waitcnt lgkmcnt(0)" ::: "memory");
                f32x16 u[2];
#pragma unroll
                for (int cb = 0; cb < 2; ++cb)
#pragma unroll
                    for (int r = 0; r < 16; ++r) { const int t = 32 + (r & 3) + 8 * (r >> 2) + 4 * hi;
                        u[cb][r] = w == 0 ? bf_lo((unsigned)*(const LAS bf16_t*)(lds + L_KT + t * RPB + (32 * cb + r32) * 2)) : *(const LAS float*)(lds + L_RHS2 + t * RPF + (32 * cb + r32) * 4); }
#pragma unroll
                for (int ks = 0; ks < 2; ++ks) { const f32x4 a0 = *(const LAS f32x4*)(lds + L_A1 + 9216 + r32 * 144 + (16 * ks + 8 * hi) * 4), a1 = *(const LAS f32x4*)(lds + L_A1 + 9216 + r32 * 144 + (16 * ks + 8 * hi + 4) * 4);
                    u32x4 aw; aw.x = pk2(-a0[0], -a0[1]); aw.y = pk2(-a0[2], -a0[3]); aw.z = pk2(-a1[0], -a1[1]); aw.w = pk2(-a1[2], -a1[3]);
#pragma unroll
                    for (int cb = 0; cb < 2; ++cb) u[cb] = MFMA32(__builtin_bit_cast(bf16x8, aw), lds_frag_nat(lds + (w == 0 ? L_WT : L_U0T), 32 * cb + r32, ks, hi), u[cb]); }
#pragma unroll
                for (int cb = 0; cb < 2; ++cb)
#pragma unroll
                    for (int r = 0; r < 16; ++r) *(LAS float*)(lds + (w == 0 ? L_X0 : L_RHS2) + (32 + (r & 3) + 8 * (r >> 2) + 4 * hi) * RPF + (32 * cb + r32) * 4) = u[cb][r];
                asm volatile("s_waitcnt lgkmcnt(0)" ::: "memory");
            }
        }
    }
    lds_barrier();
    if (role == 2) {
        f32x16 pj[2];
#pragma unroll
        for (int jb = 0; jb < 2; ++jb)
#pragma unroll
            for (int r = 0; r < 16; ++r) pj[jb][r] = bf_lo((unsigned)*(const LAS bf16_t*)(lds + L_RT + (32 * tb + (r & 3) + 8 * (r >> 2) + 4 * hi) * RPB + (32 * jb + r32) * 2));
#pragma unroll
        for (int sb = 0; sb < 2; ++sb)
#pragma unroll
            for (int ks = 0; ks < 2; ++ks)
#pragma unroll
                for (int cb = 0; cb < 2; ++cb) {
                    keep[cb] = MFMA32(x4f[sb][ks], lds_frag_perm(lds + L_U0T, 32 * cb + r32, 32 * sb + 16 * ks, hi), keep[cb]);
                    pj[cb] = MFMA32(x4f[sb][ks], lds_frag_perm(lds + L_WT, 32 * cb + r32, 32 * sb + 16 * ks, hi), pj[cb]); }
        f32x16 (&y0)[2] = keep;
        const unsigned yb = dir ? WS_YB : WS_YF;
#pragma unroll
        for (int r = 0; r < 16; ++r) { const int t = 32 * tb + (r & 3) + 8 * (r >> 2) + 4 * hi; const unsigned tok = seq0 + (dir ? T - 1 - (q0 + t) : q0 + t);
#pragma unroll
            for (int cb = 0; cb < 2; ++cb) { STG(float, F.ws, yb + (tok * 384 + h * 64 + 32 * cb + r32) * 4) = y0[cb][r];
                STG(bf16_t, F.ws, WS_RP + (((unsigned)cid * 64 + t) * 64 + 32 * cb + r32) * 2) = (bf16_t)(pk2(pj[cb][r], 0.f) & 0xffff); } }
    } else if (role == 3) {
        const int jb = tb;
        f32x16 q1[2] = {}, q2[2] = {}; f32x16 (&n1)[2] = keep;
#pragma unroll
        for (int ks = 0; ks < 4; ++ks) { const bf16x8 a = lds_frag_nat(lds + L_BTT, 32 * jb + r32, ks, hi);
#pragma unroll
            for (int cb = 0; cb < 2; ++cb) { q1[cb] = MFMA32(lds_frag_nat(lds + L_WT, 32 * cb + r32, ks, hi), a, q1[cb]); q2[cb] = MFMA32(a, lds_frag_nat(lds + L_U0T, 32 * cb + r32, ks, hi), q2[cb]); } }
#pragma unroll
        for (int q = 0; q < 4; ++q) { f32x4 gc4;
#pragma unroll
            for (int e = 0; e < 4; ++e) gc4[e] = *(const LAS float*)(lds + L_GC + (32 * jb + e + 8 * q + 4 * hi) * 4);
#pragma unroll
            for (int cb = 0; cb < 2; ++cb) { f32x4 nv;
#pragma unroll
                for (int e = 0; e < 4; ++e) nv[e] = gc4[e] * (n1[cb][4 * q + e] - q2[cb][4 * q + e]);
                STG(f32x4, F.ws, WS_RN + ((((unsigned)cid * 2 + jb) * 2 + cb) * 4 + q) * 1024 + lane * 16) = nv; } }
        { const float gl = *(const LAS float*)(lds + L_GC + (32 * jb + r32) * 4);
#pragma unroll
          for (int cb = 0; cb < 2; ++cb)
#pragma unroll
            for (int s2 = 0; s2 < 2; ++s2) { float mv[8];
#pragma unroll
                for (int e = 0; e < 8; ++e) { const int r = 8 * s2 + e; const unsigned c = 32 * cb + (r & 3) + 8 * (r >> 2) + 4 * hi; mv[e] = (c == 32 * jb + r32 ? gl : 0.f) - gl * q1[cb][r]; }
                u32x4 w; w.x = pk2(mv[0], mv[1]); w.y = pk2(mv[2], mv[3]); w.z = pk2(mv[4], mv[5]); w.w = pk2(mv[6], mv[7]);
                STG(u32x4, F.ws, WS_RM + (unsigned)cid * 8192 + ((jb * 2 + cb) * 2 + s2) * 1024 + lane * 16) = w; } }
    }
    lds_barrier();
}
__device__ __forceinline__ void rwkv_chain_wave(Frame& F, int l, bool lat, int chain, int ib) {
    int lane = F.lane; asm volatile("" : "+v"(lane));
    const unsigned char* ws = F.ws; const unsigned r32 = lane & 31, hi = lane >> 5;
    const unsigned dir = chain & 1, h = (chain >> 1) % 6, b = chain / 12;
    const int nc = lat ? 64 : 4; const unsigned cid0 = lat ? 768 + chain * 64 : chain * 4;
    const unsigned i = 32 * ib + r32;
    const unsigned so = ((((b * 4 + l) * 6 + h) * 64 + i) * 64) * 4;
    f32x16 H[2];
#pragma unroll
    for (int jb = 0; jb < 2; ++jb)
#pragma unroll
        for (int g4 = 0; g4 < 4; ++g4) { f32x4 v = {0.f, 0.f, 0.f, 0.f}; if (lat) v = LDG(f32x4, dir ? INP(7) : INP(6), so + (32 * jb + 8 * g4 + 4 * hi) * 4);
            H[jb][4 * g4] = v[0]; H[jb][4 * g4 + 1] = v[1]; H[jb][4 * g4 + 2] = v[2]; H[jb][4 * g4 + 3] = v[3]; }
    bf16x8 maA[2][2][2], maB[2][2][2]; f32x16 ntA[2], ntB[2];
    const GAS unsigned char* pm = (const GAS unsigned char*)ws + (WS_RM + cid0 * 8192 + lane * 16);
    const GAS unsigned char* pn = (const GAS unsigned char*)ws + (WS_RN + (cid0 * 4 + ib) * 4096 + lane * 16);
#define RB_LOAD(ma, nt, k_) do { \
        _Pragma("unroll") for (int jo = 0; jo < 2; ++jo) _Pragma("unroll") for (int ji = 0; ji < 2; ++ji) _Pragma("unroll") for (int ks = 0; ks < 2; ++ks) ma[jo][ji][ks] = *(const GAS bf16x8*)(pm + ((k_) * 8192 + ((jo * 2 + ji) * 2 + ks) * 1024)); \
        _Pragma("unroll") for (int jo = 0; jo < 2; ++jo) _Pragma("unroll") for (int q = 0; q < 4; ++q) { const f32x4 t_ = *(const GAS f32x4*)(pn + ((k_) * 16384 + (jo * 8 + q) * 1024)); \
            nt[jo][4 * q] = t_[0]; nt[jo][4 * q + 1] = t_[1]; nt[jo][4 * q + 2] = t_[2]; nt[jo][4 * q + 3] = t_[3]; } } while (0)
#define RB_STEP(ma, nt, cid_) do { \
        bf16x8 hf[2][2]; \
        _Pragma("unroll") for (int ji = 0; ji < 2; ++ji) { hf[ji][0] = acc_frag(H[ji], 0, 1.f); hf[ji][1] = acc_frag(H[ji], 1, 1.f); } \
        _Pragma("unroll") for (int ji = 0; ji < 2; ++ji) _Pragma("unroll") for (int ks = 0; ks < 2; ++ks) STG(bf16x8, F.ws, WS_RH + (cid_) * 8192 + ((ib * 2 + ji) * 2 + ks) * 1024 + lane * 16) = hf[ji][ks]; \
        f32x16 acc[2] = {nt[0], nt[1]}; \
        _Pragma("unroll") for (int jo = 0; jo < 2; ++jo) _Pragma("unroll") for (int ji = 0; ji < 2; ++ji) _Pragma("unroll") for (int ks = 0; ks < 2; ++ks) acc[jo] = MFMA32(ma[jo][ji][ks], hf[ji][ks], acc[jo]); \
        H[0] = acc[0]; H[1] = acc[1]; } while (0)
    RB_LOAD(maA, ntA, 0); RB_LOAD(maB, ntB, 1);
#pragma unroll 1
    for (int c = 0; c < nc; c += 2) {
        const unsigned cid = cid0 + c;
        RB_STEP(maA, ntA, cid);
        if (c + 2 < nc) RB_LOAD(maA, ntA, 2);
        RB_STEP(maB, ntB, cid + 1);
        if (c + 2 < nc) RB_LOAD(maB, ntB, 3);
        pm += 16384; pn += 32768;
    }
#undef RB_LOAD
#undef RB_STEP
    if (!lat) {
#pragma unroll
        for (int jb = 0; jb < 2; ++jb)
#pragma unroll
            for (int g4 = 0; g4 < 4; ++g4) STG(f32x4, F.out, (dir ? OFF_CB : OFF_CF) * 4 + so + (32 * jb + 8 * g4 + 4 * hi) * 4) = (f32x4){H[jb][4 * g4], H[jb][4 * g4 + 1], H[jb][4 * g4 + 2], H[jb][4 * g4 + 3]};
    }
}
__device__ __forceinline__ void rwkv_apply_wave(Frame& F, int item) {
    int lane = F.lane; asm volatile("" : "+v"(lane));
    const unsigned char* ws = F.ws; const unsigned r32 = lane & 31, hi = lane >> 5;
    const int cid = item >> 1, tb = item & 1;
    unsigned seq0, b, h, dir; int T, c; chunk_decode(cid, seq0, T, b, h, dir, c);
    const unsigned yb = dir ? WS_YB : WS_YF;
    f32x16 acc[2];
#pragma unroll
    for (int r = 0; r < 16; ++r) { const int t = 32 * tb + (r & 3) + 8 * (r >> 2) + 4 * hi; const unsigned tok = seq0 + (dir ? T - 1 - (64 * c + t) : 64 * c + t);
        acc[0][r] = LDG(float, ws, yb + (tok * 384 + h * 64 + r32) * 4); acc[1][r] = LDG(float, ws, yb + (tok * 384 + h * 64 + 32 + r32) * 4); }
#pragma unroll
    for (int ks = 0; ks < 4; ++ks) { const bf16x8 a = LDG(bf16x8, ws, WS_RP + (((unsigned)cid * 64 + 32 * tb + r32) * 64 + 16 * ks + 8 * hi) * 2);
#pragma unroll
        for (int ib = 0; ib < 2; ++ib) acc[ib] = MFMA32(a, LDG(bf16x8, ws, WS_RH + (((unsigned)cid * 64 + 32 * ib + r32) * 64 + 16 * ks + 8 * hi) * 2), acc[ib]); }
#pragma unroll
    for (int r = 0; r < 16; ++r) { const int t = 32 * tb + (r & 3) + 8 * (r >> 2) + 4 * hi; const unsigned tok = seq0 + (dir ? T - 1 - (64 * c + t) : 64 * c + t);
        STG(float, F.ws, yb + (tok * 384 + h * 64 + r32) * 4) = acc[0][r]; STG(float, F.ws, yb + (tok * 384 + h * 64 + 32 + r32) * 4) = acc[1][r]; }
}

__device__ __forceinline__ void rwkv_out_item(Frame& F, int l, int item) {
    int lane = F.lane; asm volatile("" : "+v"(lane));
    const unsigned char* ws = F.ws; const unsigned r32 = lane & 31, hi = lane >> 5;
    const int tb = item & 1, h = (item >> 1) % 6, sk = item / 12;
    const bool lat = sk >= 64; const int b = lat ? (sk - 64) >> 6 : sk >> 2, k = lat ? (sk - 64) & 63 : sk & 3, nc = lat ? 64 : 4;
    const unsigned seq0 = lat ? MC + b * 4096 : b * 256, base = lat ? 768u : 0u;
    const unsigned chf = (b * 6 + h) * 2, cidf = base + chf * nc + k, cidb = base + (chf + 1) * nc + (nc - 1 - k);
    const unsigned tok0 = seq0 + 64 * k + 32 * tb;
    f32x16 acc[2];
#pragma unroll
    for (int r = 0; r < 16; ++r) { const unsigned tok = tok0 + (r & 3) + 8 * (r >> 2) + 4 * hi; const unsigned e = (tok * 384 + h * 64 + r32) * 4;
        acc[0][r] = LDG(float, ws, WS_YF + e) + LDG(float, ws, WS_YB + e); acc[1][r] = LDG(float, ws, WS_YF + e + 128) + LDG(float, ws, WS_YB + e + 128); }
    const unsigned pf = 32 * tb + r32, pb_ = 63 - 32 * tb - r32;
#pragma unroll
    for (int ks = 0; ks < 4; ++ks) {
        const s16x4 f0 = LDG(s16x4, ws, WS_RP + ((cidf * 64 + pf) * 64 + 16 * ks + 4 * hi) * 2), f1 = LDG(s16x4, ws, WS_RP + ((cidf * 64 + pf) * 64 + 16 * ks + 8 + 4 * hi) * 2);
        const s16x4 b0_ = LDG(s16x4, ws, WS_RP + ((cidb * 64 + pb_) * 64 + 16 * ks + 4 * hi) * 2), b1_ = LDG(s16x4, ws, WS_RP + ((cidb * 64 + pb_) * 64 + 16 * ks + 8 + 4 * hi) * 2);
        const bf16x8 af = {f0[0], f0[1], f0[2], f0[3], f1[0], f1[1], f1[2], f1[3]}, ab = {b0_[0], b0_[1], b0_[2], b0_[3], b1_[0], b1_[1], b1_[2], b1_[3]};
#pragma unroll
        for (int ib = 0; ib < 2; ++ib) { acc[ib] = MFMA32(af, LDG(bf16x8, ws, WS_RH + cidf * 8192 + (ib * 4 + ks) * 1024 + lane * 16), acc[ib]);
            acc[ib] = MFMA32(ab, LDG(bf16x8, ws, WS_RH + cidb * 8192 + (ib * 4 + ks) * 1024 + lane * 16), acc[ib]); } }
    const float g0 = LDG(float, INP(27), (l * 384 + h * 64 + r32) * 4), g1 = LDG(float, INP(27), (l * 384 + h * 64 + 32 + r32) * 4), b0 = LDG(float, INP(28), (l * 384 + h * 64 + r32) * 4), b1 = LDG(float, INP(28), (l * 384 + h * 64 + 32 + r32) * 4);
    const int xl = (lane ^ 16) << 2;
#pragma unroll
    for (int r = 0; r < 16; ++r) { const unsigned tok = tok0 + (r & 3) + 8 * (r >> 2) + 4 * hi; const unsigned e = tok * 384 + h * 64 + r32;
        const float bon = LDG(float, ws, WS_SB + (tok * 8 + h) * 4) + LDG(float, ws, WS_SB + ((M + tok) * 8 + h) * 4);
        const float y0 = acc[0][r] + bon * LDG(float, ws, WS_SV + e * 4), y1 = acc[1][r] + bon * LDG(float, ws, WS_SV + (e + 32) * 4);
        float s = allreduce16(y0 + y1); s += __builtin_bit_cast(float, __builtin_amdgcn_ds_bpermute(xl, __builtin_bit_cast(int, s)));
        const float mu = s * (1.f / 64.f), d0 = y0 - mu, d1 = y1 - mu;
        float q = allreduce16(d0 * d0 + d1 * d1); q += __builtin_bit_cast(float, __builtin_amdgcn_ds_bpermute(xl, __builtin_bit_cast(int, q)));
        const float rs = rsqrtf(q * (1.f / 64.f) + 64e-5f);
        const float o0 = (d0 * rs * g0 + b0) * bf_lo((unsigned)LDG(bf16_t, ws, WS_G + e * 2)), o1 = (d1 * rs * g1 + b1) * bf_lo((unsigned)LDG(bf16_t, ws, WS_G + (e + 32) * 2));
        const unsigned pk = pk2(o0, o1);
        STG(bf16_t, F.ws, WS_ACT + (tok * DM + 640 + h * 64 + r32) * 2) = (bf16_t)(pk & 0xffff); STG(bf16_t, F.ws, WS_ACT + (tok * DM + 640 + h * 64 + 32 + r32) * 2) = (bf16_t)(pk >> 16); }
}

#ifndef B_UNIT
#define B_UNIT 0
#endif
constexpr int AU_R = 8, AU_D = 4, AU_SLOT = 6144;
__device__ __forceinline__ void attn_b_unit(Frame& F, int l, int unit) {
    int lane = F.lane; asm volatile("" : "+v"(lane));
    const unsigned char* ws = F.ws; LAS unsigned char* lds = F.lds;
    const int w = F.wave; const unsigned r32 = lane & 31, hi = lane >> 5;
    const unsigned kh = unit & 1, qb = (unit >> 1) & 15, mp = (unit >> 5) & 1, h = (unit >> 6) & 3, b = unit >> 8;
    const unsigned seq0 = MC + b * 4096, row = seq0 + qb * 256 + 32 * w + r32;
    bf16x8 qf[1][2];
#pragma unroll
    for (int s = 0; s < 2; ++s) qf[0][s] = LDG(bf16x8, ws, WS_QB + (row * 256 + h * 64 + mp * 32 + 8 * hi) * 2 + 32 * s);
    AttnQ st[1]; attnq_init(st[0], 0.f);
    const int qpos[1] = {0};
    const int n0 = kh ? 56 : 72, nt = 72;
    const unsigned pofs = (w < 2 ? (h * 2 + mp) * 2048 + w * 1024 : h * 4096 + (w - 2) * 1024) + lane * 16;
    const unsigned base0 = (w < 2 ? WS_KB : WS_VTB) + ((seq0 >> 5) + (kh ? 72u : 0u)) * 16384 + pofs;
    const unsigned base1 = WS_CACHE + (w < 2 ? 2 * MiB : 4 * MiB) + (b * 4 + l) * 262144 + pofs;
#define AU_DMA(t_) do { const int tt_ = (t_) < nt ? (t_) : nt - 1; const unsigned src_ = tt_ < n0 ? base0 + tt_ * 16384 : base1 + (tt_ - n0) * 16384; \
        __builtin_amdgcn_global_load_lds((const GAS unsigned*)(ws + src_), (LAS unsigned*)(lds + ((t_) % AU_R) * AU_SLOT + w * 1024), 16, 0, 0); } while (0)
    if (w < 6) {
#pragma unroll
        for (int t = 0; t < AU_D; ++t) AU_DMA(t);
    }
    for (int t = 0; t < nt; ++t) {
        if (w < 6) asm volatile("s_waitcnt vmcnt(3)" ::: "memory");
        asm volatile("s_barrier" ::: "memory");
        const LAS unsigned char* sl = lds + (t % AU_R) * AU_SLOT + lane * 16;
        bf16x8 kf[2], vf[4];
        kf[0] = *(const LAS bf16x8*)(sl); kf[1] = *(const LAS bf16x8*)(sl + 1024);
#pragma unroll
        for (int f = 0; f < 4; ++f) vf[f] = *(const LAS bf16x8*)(sl + 2048 + 1024 * f);
        if (w < 6) AU_DMA(t + AU_D);
        attn_block<32, false, 1>(qf, kf, vf, st, t, qpos, 0, hi);
    }
#undef AU_DMA
    asm volatile("s_waitcnt vmcnt(0) lgkmcnt(0)\n\ts_barrier" ::: "memory");
    attn_b_store(F, st[0], mp, kh, row, h, hi);
}

constexpr int Q_BLAT = 2048, Q_ALAT = 1536, Q_BCTX = 1024, Q_ACTX = 768;
constexpr int Q_TOTAL = Q_BLAT + Q_ALAT + Q_BCTX + Q_ACTX;
#ifndef XCD_DEAL
#define XCD_DEAL 0
#endif
__device__ __forceinline__ void phase_mixer(Frame& F, int l, int rep) {
    if (rep == 0 || REP_PART == 0 || REP_PART == 1) {
        const int si = F.bid + F.G * F.wave;
        if (si < 48) rwkv_chain_wave(F, l, true, si >> 1, si & 1);
        else if (si < 48 + 384) rwkv_chain_wave(F, l, false, (si - 48) >> 1, (si - 48) & 1);
    }
    if (B_UNIT && (rep == 0 || REP_PART == 2 || REP_PART == 4)) {
        unsigned* uctr = (unsigned*)(F.ws + WS_CTL) + 64 * (32 + l + 4 * rep);
        LAS int* ubox = (LAS int*)(F.lds + 65536);
        for (;;) {
            if (F.wave == 0 && F.lane == 0) *ubox = (int)atomicAdd(uctr, 1u);
            lds_barrier();
            const int un = __builtin_amdgcn_readfirstlane(*ubox);
            lds_barrier();
            if (un >= 512) break;
            attn_b_unit(F, l, un);
        }
    }
    unsigned* ctr = (unsigned*)(F.ws + WS_CTL) + 64 * (1 + l + 4 * rep);
    if (rep == 0 || REP_PART != 1) for (;;) {
        int it = 0;
        if (F.lane == 0) it = (int)atomicAdd(ctr, 1u);
        it = __builtin_amdgcn_readfirstlane(it) + (B_UNIT ? Q_BLAT : 0);
        if (it >= Q_TOTAL) break;
        if (it < Q_BLAT) { if (rep == 0 || REP_PART == 2 || REP_PART == 4) attn_b_item(F, l, true, it); continue; } it -= Q_BLAT;
        if (it < Q_ALAT) { if (rep == 0 || REP_PART == 2 || REP_PART == 3) attn_a_item(F, l, true, it); continue; } it -= Q_ALAT;
        if (it < Q_BCTX) { if (rep == 0 || REP_PART == 2 || REP_PART == 5) attn_b_item(F, l, false, it); continue; } it -= Q_BCTX;
        if (rep == 0 || REP_PART == 2 || REP_PART == 5) attn_a_item(F, l, false, it);
    }
}

__device__ __forceinline__ void phase_finalize(Frame& F, int l) {
    const unsigned char* ws = F.ws;
    const unsigned lane = F.lane;
    const float lami = 0.8f - 0.6f * __expf(-0.3f * (float)l);
    const float lam = LDG(float, ws, WS_TAB + (TAB_LAM + l) * 4) + lami;
    const float omli = 1.f - lami;
    const float sg = LDG(float, INP(17), (l * 64 + lane) * 4);
    for (unsigned row = F.gw; row < M; row += F.ngw) {
#pragma unroll
        for (int k = 0; k < 4; ++k) { float om[2];
#pragma unroll
            for (int mp = 0; mp < 2; ++mp) { const unsigned o0 = (((mp * 2) * M + row) * 256 + 64 * k + lane) * 2, q0 = ((((mp * 2) * M + row) * 4 + k) * 2) * 4;
                const f32x2 ml0 = LDG(f32x2, ws, WS_ML + q0);
                if (row >= MC) { const f32x2 ml1 = LDG(f32x2, ws, WS_ML + q0 + M * 32); const float ms = fmaxf(ml0[0], ml1[0]), w0 = __builtin_amdgcn_exp2f(ml0[0] - ms), w1 = __builtin_amdgcn_exp2f(ml1[0] - ms);
                    om[mp] = (bf_lo((unsigned)LDG(bf16_t, ws, WS_BO2 + o0)) * w0 + bf_lo((unsigned)LDG(bf16_t, ws, WS_BO2 + o0 + M * 512)) * w1) * __builtin_amdgcn_rcpf(ml0[1] * w0 + ml1[1] * w1); }
                else om[mp] = bf_lo((unsigned)LDG(bf16_t, ws, WS_BO2 + o0)) * __builtin_amdgcn_rcpf(ml0[1]); }
            const float v = om[0] - lam * om[1];
            const float ms = wave_sum(v * v) * (1.f / 64.f);
            STG(bf16_t, F.ws, WS_ACT + (row * DM + 384 + 64 * k + lane) * 2) = (bf16_t)(pk2(v * rsqrtf(ms + 1e-6f) * sg * omli, 0.f) & 0xffff); }
    }
}


typedef unsigned v4u __attribute__((ext_vector_type(4)));
#define XB_TMO      128
#define XB_XCNT(j)  (256  + 64 * (j))
#define XB_XSUB(j)  (1280 + 64 * (j))
#define XB_XGEN(j)  (2304 + 64 * (j))
#define XB_TOP      3328
#define XB_TOPGEN   3392
#define XCD_BAR_WORDS 3456
#define XB_SPIN_CAP (1u << 18)

__device__ __forceinline__ unsigned xb_ld(unsigned* p)              { return __hip_atomic_load(p, __ATOMIC_RELAXED, __HIP_MEMORY_SCOPE_AGENT); }
__device__ __forceinline__ unsigned xb_add(unsigned* p, unsigned v) { return __hip_atomic_fetch_add(p, v, __ATOMIC_RELAXED, __HIP_MEMORY_SCOPE_AGENT); }
__device__ __forceinline__ unsigned xb_xcc_id() { return (unsigned)__builtin_amdgcn_s_getreg((3 << 11) | 20) & 0xFu; }
#define XB_SPIN(cond, bar) do { unsigned _sp = 0; while (cond) { __builtin_amdgcn_s_sleep(1); \
    if ((++_sp & 255u) == 0u) { if (xb_ld(&(bar)[XB_TMO])) break; if (_sp > XB_SPIN_CAP) { atomicAdd(&(bar)[XB_TMO], 1u); break; } } } } while (0)

struct XcdBarrier {
    unsigned* bar; unsigned x;
    volatile LAS unsigned* st;
};

__device__ __forceinline__ XcdBarrier xcd_barrier_post(unsigned* bar, volatile LAS unsigned* st) {
    XcdBarrier b; b.bar = bar; b.x = xb_xcc_id(); b.st = st;
    if (threadIdx.x == 0) (void)xb_add(&bar[XB_XCNT(b.x)], 1u);
    return b;
}
__device__ __forceinline__ void xcd_barrier_complete(unsigned* bar, unsigned x, unsigned& nloc, unsigned& nx) {
    const unsigned G = gridDim.x * gridDim.y * gridDim.z;
    unsigned sum, cnt, mine, sp = 0u;
    for (;;) {
        sum = 0u; cnt = 0u; mine = 0u;
#pragma unroll
        for (unsigned j = 0; j < 16; ++j) { const unsigned c = xb_ld(&bar[XB_XCNT(j)]); sum += c; cnt += (c > 0u) ? 1u : 0u; mine = (j == x) ? c : mine; }
        if (sum == G) break;
        __builtin_amdgcn_s_sleep(1);
        if ((++sp & 255u) == 0u) { if (xb_ld(&bar[XB_TMO])) break; if (sp > XB_SPIN_CAP) { atomicAdd(&bar[XB_TMO], 1u); break; } }
    }
    nloc = mine > 0u ? mine : 1u; nx = cnt > 0u ? cnt : 1u;
}

__device__ __forceinline__ void xcd_barrier(const XcdBarrier& b) {
    asm volatile("s_waitcnt vmcnt(0)" ::: "memory");
    __syncthreads();
    if (threadIdx.x == 0) {
        unsigned* bar = b.bar;
        __builtin_amdgcn_s_waitcnt(0);
        unsigned nloc = b.st[0], nx = b.st[1];
        if (nloc == 0u) { xcd_barrier_complete(bar, b.x, nloc, nx); b.st[0] = nloc; b.st[1] = nx; }
        const unsigned old = xb_add(&bar[XB_XSUB(b.x)], 1u);
        const unsigned gen = old / nloc;
        if (old + 1u == (gen + 1u) * nloc) {
            __builtin_amdgcn_fence(__ATOMIC_RELEASE, "agent");
            asm volatile("s_waitcnt vmcnt(0)" ::: "memory");
            const unsigned og = xb_add(&bar[XB_TOP], 1u);
            const unsigned tg = og / nx;
            if (og + 1u == (tg + 1u) * nx) xb_add(&bar[XB_TOPGEN], 1u);
            else XB_SPIN(xb_ld(&bar[XB_TOPGEN]) == tg, bar);
            __builtin_amdgcn_fence(__ATOMIC_ACQUIRE, "agent");
            xb_add(&bar[XB_XGEN(b.x)], 1u);
            asm volatile("s_waitcnt vmcnt(0)" ::: "memory");
        } else {
            XB_SPIN(xb_ld(&bar[XB_XGEN(b.x)]) == gen, bar);
            __builtin_amdgcn_fence(__ATOMIC_ACQUIRE, "agent");
            asm volatile("s_waitcnt vmcnt(0)" ::: "memory");
        }
    }
    __syncthreads();
}

#ifndef DIS
#define DIS 0
#endif
#ifndef GEMM_MF
#define GEMM_MF 7
#endif
#ifndef REP_PHASE
#define REP_PHASE -1
#define REP_COUNT 1
#endif
constexpr int NEXTRA = (REP_PHASE >= 0 && REP_PHASE < 9) ? REP_COUNT - 1 : 0, NPL = 9 + NEXTRA, NPRE = (REP_PHASE == 100) ? REP_COUNT : 1, NPHASE_RUN = NPRE + 1 + NPL * DEPTH;
__global__ void __launch_bounds__(512, 2) mega(Args a) {
    extern __shared__ __attribute__((aligned(16))) unsigned char lds[];
    Frame F;
    F.lds = (LAS unsigned char*)lds;
    volatile LAS unsigned* bst = (volatile LAS unsigned*)(F.lds + LDS_BYTES - 64);
    if (threadIdx.x < 2) bst[threadIdx.x] = 0u;
    __syncthreads();
    const XcdBarrier xbar = xcd_barrier_post((unsigned*)((GAS unsigned char*)a.ws + WS_CTL) + 4096, bst);
    const int wave_id = __builtin_amdgcn_readfirstlane((int)threadIdx.x >> 6);
    for (int ph = a.ph_lo; ph < a.ph_hi; ++ph) {
        { const unsigned char* kp = (const unsigned char*)__builtin_amdgcn_kernarg_segment_ptr(); asm volatile("" : "+s"(kp));
          const Args* ap = (const Args*)kp; F.in = ap->in; F.out = gptr(ap->out); F.ws = gptr(ap->ws); }
        { unsigned ones = ~0u; asm volatile("" : "+s"(ones)); int ln = (int)__builtin_amdgcn_mbcnt_hi(ones, __builtin_amdgcn_mbcnt_lo(ones, 0u)); int wv = wave_id, bid = (int)blockIdx.x, gg = (int)gridDim.x; asm volatile("" : "+s"(wv), "+s"(bid), "+s"(gg));
          F.lane = ln; F.wave = wv; F.bid = bid; F.G = gg; F.ngw = gg * 8; F.tid = wv * 64 + ln; F.gw = bid * 8 + wv; }
        if (ph < NPRE) { if (!(DIS & 1)) phase_prologue(F); }
        else if (ph == NPHASE_RUN - 1) { if (!(DIS & 2)) phase_final_norm(F); }
        else {
            const int l = (ph - NPRE) / NPL, sidx = (ph - NPRE) % NPL, rep = (REP_PHASE >= 0 && REP_PHASE < 9 && sidx > REP_PHASE && sidx <= REP_PHASE + NEXTRA) ? sidx - REP_PHASE : 0, s = (REP_PHASE >= 0 && REP_PHASE < 9 && sidx > REP_PHASE) ? (sidx <= REP_PHASE + NEXTRA ? REP_PHASE : sidx - NEXTRA) : sidx;
            if (s == 0) { convert_weights(F, l); phase_norm(F, l, 0); }
            else if (s == 1) {
                pg8::Gemm g{WSP(bf16_t, WS_ACT), WSP(bf16_t, WS_WIN + 0u * WSET_STRIDE), M, NIN, 1024}; pg8::StaticOrder S; S.init(M, NIN, F.G, F.bid, (GEMM_MF & 1) ? 192 : 256);
                EpiWin E{F.ws, F.out, l, F.lds + pg8::STAGE_BYTES};
                if (!(DIS & 16)) pg8::gemm_phase<EpiWin, pg8::StaticOrder, false, true, (GEMM_MF & 1) ? 3 : 4>(F.lds, g, S, E, F.tid);
                if (false) { const int wv_ = (F.bid - 64) * 8 + F.wave; convert_item_any(F, l + 1, wv_); if (wv_ < CV_TOTAL - 1536) convert_item_any(F, l + 1, 1536 + wv_); }
            }
            else if (s == 2) { for (int cid = F.bid; cid < NCHUNK; cid += F.G) rwkv_chunk_block(F, l, cid); }
            else if (s == 3) { if (!(DIS & 64)) phase_mixer(F, l, rep); }
            else if (s == 4) { phase_finalize(F, l); for (int it = F.gw; it < 192 * 12; it += F.ngw) rwkv_out_item(F, l, it); }
            else if (s == 5 || s == 8) {
                const bool second = s == 8;
                pg8::Gemm g{second ? WSP(bf16_t, WS_U) : WSP(bf16_t, WS_ACT), second ? WSP(bf16_t, WS_W2 + 0u * WSET_STRIDE) : WSP(bf16_t, WS_WOUT + 0u * WSET_STRIDE), M, 1024, second ? FF : 1024};
                pg8::StaticOrder S; S.init(M, 1024, F.G, F.bid, (GEMM_MF & 2) ? 192 : 256);
                const bool first = (l == 0 && !second);
                EpiRes E{INP(0), INP(1) - (size_t)MC * DM, F.ws, WSP(float, WS_MOD) + (size_t)l * 3 * 6144 + (second ? 5120 : 2048), first};
                if (!(DIS & 256)) pg8::gemm_phase<EpiRes, pg8::StaticOrder, false, true, (GEMM_MF & 2) ? 3 : 4>(F.lds, g, S, E, F.tid);
            }
            else if (s == 6) { if (!(DIS & 8)) phase_norm(F, l, 1); }
            else {
                pg8::Gemm g{WSP(bf16_t, WS_ACT), WSP(bf16_t, WS_W13 + 0u * WSET_STRIDE), M, NFF2, 1024}; pg8::StaticOrder S; S.init(M, NFF2, F.G, F.bid, (GEMM_MF & 4) ? 192 : 256);
                EpiSwi E{WSP(bf16_t, WS_U)};
                if (!(DIS & 512)) pg8::gemm_phase<EpiSwi, pg8::StaticOrder, true, true, (GEMM_MF & 4) ? 3 : 4>(F.lds, g, S, E, F.tid);
            }
        }
        if (ph + 1 < a.ph_hi) { if (ph == a.ph_lo) { __threadfence(); cg::this_grid().sync(); } else xcd_barrier(xbar); }
    }
}

extern "C" void kernel_launch(void* const* d_in, const int* in_sizes, int n_in, void* d_out, int out_size, void* d_ws, size_t ws_size, hipStream_t stream) {
    static int grid = 0;
    if (grid == 0) {
        int dev = 0, cus = 0, per_cu = 0;
        if (n_in != 34 || ws_size < WS_END) { fprintf(stderr, "kernel_launch: unexpected n_in %d / ws_size %zu (need %zu)\n", n_in, ws_size, (size_t)WS_END); grid = -1; return; }
        if (hipGetDevice(&dev) != hipSuccess || hipDeviceGetAttribute(&cus, hipDeviceAttributeMultiprocessorCount, dev) != hipSuccess) { grid = -1; return; }
        if (hipFuncSetAttribute((const void*)mega, hipFuncAttributeMaxDynamicSharedMemorySize, LDS_BYTES) != hipSuccess) { fprintf(stderr, "kernel_launch: hipFuncSetAttribute failed\n"); grid = -1; return; }
        if (hipOccupancyMaxActiveBlocksPerMultiprocessor(&per_cu, (const void*)mega, 512, LDS_BYTES) != hipSuccess || per_cu < 1) { fprintf(stderr, "kernel_launch: occupancy query says %d\n", per_cu); per_cu = 1; }
        (void)hipGetLastError();
        grid = cus * 1;
        if (grid > cus * per_cu) grid = cus * per_cu;
    }
    if (grid < 0) return;
    (void)hipMemsetAsync((char*)d_ws + WS_CTL, 0, CTL_BYTES, stream);
    Args a{};
    for (int i = 0; i < 34; ++i) a.in[i] = (const float*)d_in[i];
    a.out = (float*)d_out; a.ws = (unsigned char*)d_ws;
#if MK_ONE_LAUNCH
    a.ph_lo = 0; a.ph_hi = NPHASE_RUN;
    void* args[] = {&a};
    hipError_t e = hipLaunchCooperativeKernel((const void*)mega, dim3(grid), dim3(512), args, LDS_BYTES, stream);
    if (e != hipSuccess) fprintf(stderr, "kernel_launch: cooperative launch failed: %s (grid %d)\n", hipGetErrorString(e), grid);
#else
    for (int ph = 0; ph < NPHASE_RUN; ++ph) { a.ph_lo = ph; a.ph_hi = ph + 1; hipLaunchKernelGGL(mega, dim3(grid), dim3(512), LDS_BYTES, stream, a); }
#endif
}
```

```cpp
#include <hip/hip_runtime.h>
#include <hip/hip_cooperative_groups.h>
#include <cstdio>
#include <cstdint>
namespace cg = cooperative_groups;

#ifndef MK_ONE_LAUNCH
#define MK_ONE_LAUNCH 1
#endif

#undef MK_ONE_LAUNCH
#define MK_ONE_LAUNCH 1
#define REP_PHASE -1
#define REP_COUNT 1
#define REP_PART 0
#define RA_REP 0
#define ATT_PROBE 0
namespace pg8 {
#define PG8_LAS __attribute__((address_space(3)))
typedef unsigned short bf16_t;
typedef short bf16x8 __attribute__((ext_vector_type(8)));
typedef float f32x4 __attribute__((ext_vector_type(4)));
typedef unsigned u32x4 __attribute__((ext_vector_type(4)));
constexpr int BM = 256, BK = 64, HALF = 128, HTB = HALF * BK * 2  , STAGE_BYTES = 8 * HTB, NXCD = 8, WGM = 8;

__host__ __device__ __forceinline__ int lds_byte(int r, int c) { const int st = (r >> 4) * 2 + (c >> 5), rr = r & 15, cc = c & 31, ob = rr * 64 + cc * 2; return st * 1024 + (ob ^ (((ob >> 9) & 1) << 5)); }
__host__ __device__ __forceinline__ void stage_rc(int b, int& R, int& C) { const int st = b / 1024, sb = b % 1024, swz = sb ^ (((sb >> 9) & 1) << 5); R = (st >> 1) * 16 + swz / 64; C = (st & 1) * 32 + (swz % 64) / 2; }
__host__ __device__ __forceinline__ int perm32(int rho) { const int n = rho >> 4, i = rho & 15; return 8 * (i >> 2) + 4 * n + (i & 3); }

struct Unit { int pm, pn; };
struct Gemm { const bf16_t* A; const bf16_t* Bt; int M, N, K; };

struct StaticOrder {
    int nM, nN, nwg, G, c;
    __host__ __device__ void init(int M, int N, int G_, int c_, int bm = BM) { nM = M / bm; nN = N / BM; nwg = nM * nN; G = G_; c = c_; }
    __host__ __device__ bool next(int i, Unit& u) const {
        const long L = (long)i * G + c; if (L >= nwg) return false;
        int wgid = (int)L; { const int q = nwg / NXCD, r = nwg % NXCD, xcd = wgid % NXCD, off = wgid / NXCD; wgid = (xcd < r ? xcd * (q + 1) : r * (q + 1) + (xcd - r) * q) + off; }
        const int nig = WGM * nN, gid = wgid / nig, fm = gid * WGM, gsz = (nM - fm) < WGM ? (nM - fm) : WGM;
        u.pm = fm + ((wgid % nig) % gsz); u.pn = (wgid % nig) / gsz; return true;
    }
    __device__ __forceinline__ void a_ready(const Unit&) const {}
    __device__ __forceinline__ void done(const Unit&) const {}
};

template <class Epi, class Sched, bool ALIGN_EPI = false, bool SP2 = false, int MF = 4>
__device__ __forceinline__ void gemm_phase(PG8_LAS unsigned char* lds, const Gemm g, const Sched& S, const Epi& E, const int tid_in) {
    const int tid = tid_in, wid = __builtin_amdgcn_readfirstlane(tid >> 6), lane = tid & 63, wr = wid >> 2, wc = wid & 3, fr = lane & 15, fq = lane >> 4;
    static_assert(MF == 4 || (MF == 3 && SP2), "192-row tiles: SP2 schedule only");
    const int K = g.K, nt = K / BK;
    unsigned voffA[2], voffB[2];
#pragma unroll
    for (int i = 0; i < 2; ++i) { int R, C; stage_rc(tid * 16 + i * 8192, R, C); const int Rb = Epi::PERM ? ((R & ~31) + perm32(R & 31)) : R;
        voffA[i] = (unsigned)(R * K + C) * 2u; voffB[i] = (unsigned)(Rb * K + C) * 2u; }
    const size_t kstep = (size_t)(BK * 2);
    const size_t hstep = (size_t)HALF * K * 2;
    const size_t tstep = 2 * hstep;
    const size_t hstepA = (size_t)(MF * 32) * K * 2, tstepA = 2 * hstepA;
    const unsigned ldsw = (unsigned)wid * 1024u;
    const int aoff = lds_byte(wr * (MF * 16) + fr, fq * 8), boff = lds_byte(wc * 32 + fr, fq * 8);
#define PG8_SA(b, h) (((b) * 2 + (h)) * HTB)
#define PG8_SB(b, h) ((4 + (b) * 2 + (h)) * HTB)
#define PG8_STAGE(bufoff, gbase, voff) do { _Pragma("unroll") for (int _i = 0; _i < 2; ++_i) \
        __builtin_amdgcn_global_load_lds((const unsigned*)((const char*)(gbase) + (voff)[_i]), (PG8_LAS unsigned*)(lds + (bufoff) + ldsw + _i * 8192), 16, 0, 0); } while (0)
#define PG8_STAGEA(bufoff, gbase, voff) do { __builtin_amdgcn_global_load_lds((const unsigned*)((const char*)(gbase) + (voff)[0]), (PG8_LAS unsigned*)(lds + (bufoff) + ldsw), 16, 0, 0); \
        if (MF == 4 || wr == 0) __builtin_amdgcn_global_load_lds((const unsigned*)((const char*)(gbase) + (voff)[1]), (PG8_LAS unsigned*)(lds + (bufoff) + ldsw + 8192), 16, 0, 0); } while (0)
#define PG8_LDA(dst, b, h) do { _Pragma("unroll") for (int m = 0; m < MF; ++m) _Pragma("unroll") for (int k = 0; k < 2; ++k) dst[m][k] = *(const PG8_LAS bf16x8*)(lds + PG8_SA(b, h) + aoff + m * 2048 + k * 1024); } while (0)
#define PG8_LDB(dst, b, h) do { _Pragma("unroll") for (int n = 0; n < 2; ++n) _Pragma("unroll") for (int k = 0; k < 2; ++k) dst[n][k] = *(const PG8_LAS bf16x8*)(lds + PG8_SB(b, h) + boff + n * 2048 + k * 1024); } while (0)
#define PG8_MMA(ai, bj, At, Bt) do { __builtin_amdgcn_s_setprio(1); _Pragma("unroll") for (int m = 0; m < MF; ++m) _Pragma("unroll") for (int n = 0; n < 2; ++n) _Pragma("unroll") for (int k = 0; k < 2; ++k) \
        acc[ai][bj][m][n] = __builtin_amdgcn_mfma_f32_16x16x32_bf16(Bt[n][k], At[m][k], acc[ai][bj][m][n], 0, 0, 0); __builtin_amdgcn_s_setprio(0); } while (0)
#define PG8_WAIT_V(n) asm volatile("s_waitcnt vmcnt(" #n ")" ::: "memory")
#define PG8_WAIT_V2(a, b) do { if (MF == 4 || wr == 0) asm volatile("s_waitcnt vmcnt(" #a ")" ::: "memory"); else asm volatile("s_waitcnt vmcnt(" #b ")" ::: "memory"); } while (0)
#define PG8_WAIT_L(n) asm volatile("s_waitcnt lgkmcnt(" #n ")" ::: "memory")
#define PG8_BAR __builtin_amdgcn_s_barrier()
#define PG8_SCHED __builtin_amdgcn_sched_barrier(0)
    Unit cur, nxt; int ui = 0;
    if (!S.next(0, cur)) return;
    f32x4 acc[2][2][MF][2];
#pragma unroll
    for (int a = 0; a < 2; ++a)
#pragma unroll
        for (int b = 0; b < 2; ++b)
#pragma unroll
            for (int m = 0; m < MF; ++m)
#pragma unroll
                for (int n = 0; n < 2; ++n) acc[a][b][m][n] = (f32x4){0.f, 0.f, 0.f, 0.f};
    bf16x8 At[MF][2], B0[2][2], B1[2][2];
#define PG8_SGPR64(p) ((const char*)(((unsigned long long)(unsigned)__builtin_amdgcn_readfirstlane((int)((unsigned long long)(p) >> 32)) << 32) | (unsigned)__builtin_amdgcn_readfirstlane((int)(unsigned long long)(p))))
    const char* cA = PG8_SGPR64((const char*)g.A + (size_t)cur.pm * tstepA); const char* cB = PG8_SGPR64((const char*)g.Bt + (size_t)cur.pn * tstep);
    S.a_ready(cur);
    if constexpr (SP2) {
        PG8_STAGE(PG8_SB(0, 0), cB, voffB); PG8_STAGE(PG8_SB(0, 1), cB + hstep, voffB); PG8_STAGEA(PG8_SA(0, 0), cA, voffA); PG8_STAGEA(PG8_SA(0, 1), cA + hstepA, voffA);
        if (wr == 1) PG8_BAR;
        PG8_WAIT_V2(2, 1); PG8_BAR;
        PG8_STAGE(PG8_SB(1, 0), cB + kstep, voffB); PG8_STAGEA(PG8_SA(1, 0), cA + kstep, voffA); PG8_STAGE(PG8_SB(1, 1), cB + hstep + kstep, voffB);
        PG8_WAIT_V2(6, 5); PG8_BAR;
    } else {
        PG8_STAGE(PG8_SB(0, 0), cB, voffB); PG8_STAGEA(PG8_SA(0, 0), cA, voffA); PG8_STAGE(PG8_SB(0, 1), cB + hstep, voffB); PG8_STAGEA(PG8_SA(0, 1), cA + hstepA, voffA);
        if (wr == 1) PG8_BAR;
        PG8_WAIT_V(4); PG8_BAR;
        PG8_STAGE(PG8_SB(1, 0), cB + kstep, voffB); PG8_STAGEA(PG8_SA(1, 0), cA + kstep, voffA); PG8_STAGE(PG8_SB(1, 1), cB + hstep + kstep, voffB);
        PG8_WAIT_V(6); PG8_BAR;
    }
    for (;;) {
        const bool has_next = S.next(ui + 1, nxt);
        const char* nA = PG8_SGPR64(has_next ? (const char*)g.A + (size_t)nxt.pm * tstepA : cA); const char* nB = PG8_SGPR64(has_next ? (const char*)g.Bt + (size_t)nxt.pn * tstep : cB);
        for (int t = 0; t < nt; t += 2) {
            const bool last = (t == nt - 2);
            const char* a1 = cA + (size_t)(t + 1) * kstep;
            const char* a2 = last ? nA : cA + (size_t)(t + 2) * kstep; const char* b2 = last ? nB : cB + (size_t)(t + 2) * kstep;
            const char* a3 = a2 + kstep; const char* b3 = b2 + kstep;
            if (last && has_next) S.a_ready(nxt);
            if constexpr (SP2) {
            PG8_LDB(B0, 0, 0); PG8_LDB(B1, 0, 1); PG8_SCHED; PG8_LDA(At, 0, 0); PG8_STAGEA(PG8_SA(1, 1), a1 + hstepA, voffA);
            PG8_WAIT_V2(8, 6); PG8_WAIT_L(0); PG8_BAR; PG8_MMA(0, 0, At, B0); PG8_MMA(0, 1, At, B1); PG8_BAR; PG8_SCHED;
            PG8_LDA(At, 0, 1); PG8_STAGE(PG8_SB(0, 0), b2, voffB); PG8_STAGE(PG8_SB(0, 1), b2 + hstep, voffB); PG8_STAGEA(PG8_SA(0, 0), a2, voffA);
            PG8_WAIT_V2(8, 6); PG8_WAIT_L(0); PG8_BAR; PG8_MMA(1, 0, At, B0); PG8_MMA(1, 1, At, B1); PG8_BAR; PG8_SCHED;
            PG8_LDB(B0, 1, 0); PG8_LDB(B1, 1, 1); PG8_SCHED; PG8_LDA(At, 1, 0); PG8_STAGEA(PG8_SA(0, 1), a2 + hstepA, voffA);
            PG8_WAIT_V2(8, 6); PG8_WAIT_L(0); PG8_BAR; PG8_MMA(0, 0, At, B0); PG8_MMA(0, 1, At, B1); PG8_BAR; PG8_SCHED;
            PG8_LDA(At, 1, 1); PG8_STAGE(PG8_SB(1, 0), b3, voffB); PG8_STAGE(PG8_SB(1, 1), b3 + hstep, voffB); PG8_STAGEA(PG8_SA(1, 0), a3, voffA);
            PG8_WAIT_V2(8, 6); PG8_WAIT_L(0); PG8_BAR; PG8_MMA(1, 0, At, B0); PG8_MMA(1, 1, At, B1); PG8_BAR; PG8_SCHED;
            } else {
            PG8_LDB(B0, 0, 0); PG8_SCHED; PG8_LDA(At, 0, 0); PG8_STAGEA(PG8_SA(1, 1), a1 + hstepA, voffA);
            PG8_WAIT_L(8); PG8_BAR; PG8_WAIT_L(0); PG8_MMA(0, 0, At, B0); PG8_BAR; PG8_SCHED;
            PG8_LDB(B1, 0, 1); PG8_STAGE(PG8_SB(0, 0), b2, voffB);
            PG8_BAR; PG8_WAIT_L(0); PG8_MMA(0, 1, At, B1); PG8_BAR;
            PG8_LDA(At, 0, 1); PG8_STAGEA(PG8_SA(0, 0), a2, voffA);
            PG8_BAR; PG8_WAIT_L(0); PG8_MMA(1, 0, At, B0); PG8_BAR; PG8_SCHED;
            PG8_STAGE(PG8_SB(0, 1), b2 + hstep, voffB);
            PG8_WAIT_V(6); PG8_BAR; PG8_MMA(1, 1, At, B1); PG8_BAR;
            PG8_LDB(B0, 1, 0); PG8_SCHED; PG8_LDA(At, 1, 0); PG8_STAGEA(PG8_SA(0, 1), a2 + hstepA, voffA);
            PG8_WAIT_L(8); PG8_BAR; PG8_WAIT_L(0); PG8_MMA(0, 0, At, B0); PG8_BAR; PG8_SCHED;
            PG8_LDB(B1, 1, 1); PG8_STAGE(PG8_SB(1, 0), b3, voffB);
            PG8_BAR; PG8_WAIT_L(0); PG8_MMA(0, 1, At, B1); PG8_BAR;
            PG8_LDA(At, 1, 1); PG8_STAGEA(PG8_SA(1, 0), a3, voffA);
            PG8_BAR; PG8_WAIT_L(0); PG8_MMA(1, 0, At, B0); PG8_BAR; PG8_SCHED;
            PG8_STAGE(PG8_SB(1, 1), b3 + hstep, voffB);
            PG8_WAIT_V(6); PG8_BAR; PG8_MMA(1, 1, At, B1); PG8_BAR;
            }
        }
        if constexpr (ALIGN_EPI) { if (wr == 0) PG8_BAR; }
        if constexpr (!Epi::AFTER_DRAIN) { E.template operator()<MF>(acc, cur, wr, wc, fr, fq); S.done(cur); }
        if (!has_next) break;
#pragma unroll
        for (int a = 0; a < 2; ++a)
#pragma unroll
            for (int b = 0; b < 2; ++b)
#pragma unroll
                for (int m = 0; m < MF; ++m)
#pragma unroll
                    for (int n = 0; n < 2; ++n) acc[a][b][m][n] = (f32x4){0.f, 0.f, 0.f, 0.f};
        cur = nxt; cA = nA; cB = nB; ++ui;
        if constexpr (ALIGN_EPI) { if (wr == 1) PG8_BAR; }
    }
    PG8_WAIT_V(0);
    if constexpr (!ALIGN_EPI) { if (wr == 0) PG8_BAR; }
    PG8_BAR;
    if constexpr (Epi::AFTER_DRAIN) { E.fused(acc, cur, wr, wc, fr, fq, lds, wid, lane); S.done(cur); }
#undef PG8_SA
#undef PG8_SB
#undef PG8_STAGE
#undef PG8_STAGEA
#undef PG8_WAIT_V2
#undef PG8_LDA
#undef PG8_LDB
#undef PG8_MMA
#undef PG8_WAIT_V
#undef PG8_WAIT_L
#undef PG8_BAR
#undef PG8_SCHED
}
}

using pg8::bf16_t; using pg8::bf16x8; using pg8::f32x4; using pg8::u32x4;
typedef float f32x16 __attribute__((ext_vector_type(16)));
typedef float f32x2 __attribute__((ext_vector_type(2)));
typedef short s16x4 __attribute__((ext_vector_type(4)));
typedef unsigned u32x2 __attribute__((ext_vector_type(2)));
typedef __bf16 bf16x2_t __attribute__((ext_vector_type(2)));
#define LAS __attribute__((address_space(3)))
#define LDG(T, base, boff) (*(const __attribute__((address_space(1))) T*)((const __attribute__((address_space(1))) unsigned char*)(base) + (unsigned)(boff)))
#define STG(T, base, boff) (*(__attribute__((address_space(1))) T*)((__attribute__((address_space(1))) unsigned char*)(base) + (unsigned)(boff)))

__device__ __forceinline__ unsigned pk2(float lo, float hi) { f32x2 v = {lo, hi}; bf16x2_t b = __builtin_convertvector(v, bf16x2_t); return __builtin_bit_cast(unsigned, b); }
__device__ __forceinline__ float bf_lo(unsigned u) { return __uint_as_float(u << 16); }
__device__ __forceinline__ float bf_hi(unsigned u) { return __uint_as_float(u & 0xffff0000u); }
__device__ __forceinline__ f32x4 unpack4(u32x2 v) { return (f32x4){bf_lo(v.x), bf_hi(v.x), bf_lo(v.y), bf_hi(v.y)}; }
__device__ __forceinline__ u32x2 pack4(f32x4 v) { u32x2 r; r.x = pk2(v[0], v[1]); r.y = pk2(v[2], v[3]); return r; }
__device__ __forceinline__ float sigmf(float x) { return __builtin_amdgcn_rcpf(1.f + __expf(-x)); }
template <int CTRL> __device__ __forceinline__ float dpp_f(float x) { return __builtin_bit_cast(float, __builtin_amdgcn_update_dpp(0, __builtin_bit_cast(int, x), CTRL, 0xF, 0xF, true)); }
__device__ __forceinline__ float allreduce16(float x) { x += dpp_f<0xB1>(x); x += dpp_f<0x4E>(x); x += dpp_f<0x141>(x); x += dpp_f<0x140>(x); return x; }
__device__ __forceinline__ float rdlane(float x, int l) { return __builtin_bit_cast(float, __builtin_amdgcn_readlane(__builtin_bit_cast(int, x), l)); }
__device__ __forceinline__ float wave_sum(float v) {
    v = allreduce16(v);
    return (rdlane(v, 0) + rdlane(v, 16)) + (rdlane(v, 32) + rdlane(v, 48));
}
__device__ __forceinline__ float swap32_sum(float x) { auto rr = __builtin_amdgcn_permlane32_swap(__float_as_uint(x), __float_as_uint(x), false, false); return __uint_as_float(rr[0]) + __uint_as_float(rr[1]); }
__device__ __forceinline__ float swap32_max(float x) { auto rr = __builtin_amdgcn_permlane32_swap(__float_as_uint(x), __float_as_uint(x), false, false); return fmaxf(__uint_as_float(rr[0]), __uint_as_float(rr[1])); }

constexpr int M = 12288, MC = 4096, DM = 1024, NIN = 3072, FF = 2816, NFF2 = 5632, DEPTH = 4;
constexpr float LOG2E = 1.4426950408889634f;
constexpr float QSCALE_A = 0.125f * LOG2E;
constexpr float QSCALE_B = 0.17677669529663687f * LOG2E;
constexpr unsigned OFF_AK = 12582912, OFF_AV = 14680064, OFF_BK = 16777216, OFF_BV = 20971520, OFF_CF = 25165824, OFF_CB = 26738688;
constexpr unsigned MiB = 1u << 20;
constexpr unsigned WS_CTL = 0, CTL_BYTES = 1 * MiB;
constexpr unsigned WS_MOD = 1 * MiB;
constexpr unsigned WS_TAB = 1 * MiB + 512 * 1024;
constexpr unsigned WS_SMALLW = 2 * MiB;
constexpr unsigned WS_CACHE = 4 * MiB;
constexpr unsigned WS_WIN = 10 * MiB, WS_WOUT = 16 * MiB, WS_W13 = 18 * MiB, WS_W2 = 29 * MiB;
constexpr unsigned WSET_STRIDE = 184 * MiB;
constexpr unsigned WS_ACT = 35 * MiB;
constexpr unsigned WS_QA = 59 * MiB, WS_KA = 68 * MiB, WS_VTA = 71 * MiB, WS_QB = 74 * MiB, WS_KB = 80 * MiB, WS_VTB = 86 * MiB;
constexpr unsigned WS_RKV = 92 * MiB, WS_CW = 119 * MiB, WS_CA = 122 * MiB, WS_CG = 125 * MiB;
constexpr unsigned WS_YF = 128 * MiB, WS_YB = 146 * MiB;
constexpr unsigned WS_SV = 164 * MiB;
constexpr unsigned WS_BO2 = 182 * MiB, WS_ML = 230 * MiB;
constexpr unsigned WS_XB = 206 * MiB;
constexpr unsigned WS_WSET1 = 194 * MiB;
constexpr unsigned WS_RM = 236 * MiB, WS_RN = 254 * MiB, WS_RP = 324 * MiB, WS_RH = 342 * MiB;
constexpr int NCHUNK = 2304;
constexpr unsigned WS_U = 128 * MiB;
constexpr unsigned WS_G = 290 * MiB, WS_SB = 299 * MiB, WS_BO = 300 * MiB, WS_END = 360 * MiB;
constexpr int SMALLW_L = 147456;
constexpr int TAB_COSA = 0, TAB_SINA = 1024, TAB_COSB = 2048, TAB_SINB = 2560, TAB_LAM = 3072;
constexpr int LDS_BYTES = 147456;
constexpr int NPHASE = 2 + 9 * DEPTH;

struct Args {
    const float* in[34];
    float* out; unsigned char* ws;
    int ph_lo, ph_hi;
};

struct EpiRes {
    static constexpr bool PERM = true, AFTER_DRAIN = false;
    const float* baseC; const float* baseL; unsigned char* ws; const float* gate; bool first;
    template <int MF>
    __device__ __forceinline__ void operator()(const f32x4 (&acc)[2][2][MF][2], const pg8::Unit& u, int wr, int wc, int fr_, int fq_) const {
        int fr = fr_, fq = fq_; asm volatile("" : "+v"(fr), "+v"(fq));
        const unsigned col0 = u.pn * 256 + wc * 32 + 8 * fq, rowb = u.pm * (MF * 64) + wr * (MF * 16);
        f32x4 g4[2][2]; int vcur = -1;
#pragma unroll
        for (int ai = 0; ai < 2; ++ai)
#pragma unroll
            for (int m = 0; m < MF; ++m) { const unsigned rf = rowb + ai * (MF * 32) + m * 16, off = (rf + fr) * DM + col0;
                const int v = rf < MC ? 0 : (rf < MC + 4096 ? 1 : 2);
                if (v != vcur) { vcur = v;
#pragma unroll
                    for (int bj = 0; bj < 2; ++bj)
#pragma unroll
                        for (int n = 0; n < 2; ++n) g4[bj][n] = LDG(f32x4, gate, (v * 6144 + col0 + bj * 128 + n * 4) * 4); }
#pragma unroll
                for (int bj = 0; bj < 2; ++bj) { f32x4 b0, b1;
                    if (first) { const float* base = rf < MC ? baseC : baseL; b0 = LDG(f32x4, base, (off + bj * 128) * 4); b1 = LDG(f32x4, base, (off + bj * 128 + 4) * 4); }
                    else { const u32x4 xb = LDG(u32x4, ws, WS_XB + (off + bj * 128) * 2); b0 = (f32x4){bf_lo(xb.x), bf_hi(xb.x), bf_lo(xb.y), bf_hi(xb.y)}; b1 = (f32x4){bf_lo(xb.z), bf_hi(xb.z), bf_lo(xb.w), bf_hi(xb.w)}; }
                    b0 = b0 + g4[bj][0] * acc[ai][bj][m][0]; b1 = b1 + g4[bj][1] * acc[ai][bj][m][1];
                    u32x4 w; w.x = pk2(b0[0], b0[1]); w.y = pk2(b0[2], b0[3]); w.z = pk2(b1[0], b1[1]); w.w = pk2(b1[2], b1[3]);
                    STG(u32x4, ws, WS_XB + (off + bj * 128) * 2) = w; } }
    }
};
struct EpiSwi {
    static constexpr bool PERM = true, AFTER_DRAIN = false;
    bf16_t* U;
    template <int MF>
    __device__ __forceinline__ void operator()(const f32x4 (&acc)[2][2][MF][2], const pg8::Unit& u, int wr, int wc, int fr_, int fq_) const {
        int fr = fr_, fq = fq_; asm volatile("" : "+v"(fr), "+v"(fq));
        const unsigned row0 = u.pm * (MF * 64) + wr * (MF * 16) + fr, oc0 = u.pn * 128 + wc * 32 + 8 * fq;
#pragma unroll
        for (int ai = 0; ai < 2; ++ai)
#pragma unroll
            for (int m = 0; m < MF; ++m) { const unsigned ro = ((row0 + ai * (MF * 32) + m * 16) * FF + oc0) * 2; f32x4 o[2];
#pragma unroll
                for (int bj = 0; bj < 2; ++bj) { const f32x4 g = acc[ai][bj][m][0], up = acc[ai][bj][m][1];
#pragma unroll
                    for (int e = 0; e < 4; ++e) o[bj][e] = g[e] * sigmf(g[e]) * up[e]; }
                const u32x2 lo = pack4(o[0]), hi2 = pack4(o[1]);
                STG(u32x4, U, ro) = (u32x4){lo.x, lo.y, hi2.x, hi2.y}; asm volatile("" ::: "memory"); }
    }
};
struct EpiWin {
    static constexpr bool PERM = true, AFTER_DRAIN = false;
    unsigned char* ws; float* out; int l; LAS unsigned char* lds;
    template <int MF>
    __device__ __forceinline__ void operator()(const f32x4 (&acc)[2][2][MF][2], const pg8::Unit& u, int wr, int wc, int fr_, int fq_) const {
        int fr = fr_, fq = fq_; asm volatile("" : "+v"(fr), "+v"(fq));
        const unsigned rowb = u.pm * (MF * 64) + wr * (MF * 16), row0 = rowb + fr;
#pragma unroll
        for (int bj = 0; bj < 2; ++bj) {
            const unsigned c32 = u.pn * 256 + bj * 128 + wc * 32;
            const unsigned c8 = c32 + 8 * fq;
            if (c32 < 1152 && (c32 < 512 || c32 >= 640)) {
                const bool isA = c32 < 512;
                const bool isK = isA ? (c32 >= 384) : (c32 >= 896);
                const float qs = isK ? 1.f : (isA ? QSCALE_A : QSCALE_B);
                const unsigned ck = isA ? c8 - 384 : c8 - 896;
                const unsigned dbase = isA ? (isK ? WS_KA + (((ck >> 6) * 4 + ((ck & 63) >> 4)) * 64 + ((ck >> 3) & 1) * 32) * 16 : WS_QA + c8 * 2)
                                           : (isK ? WS_KB + (((ck >> 5) * 2 + ((ck & 31) >> 4)) * 64 + ((ck >> 3) & 1) * 32) * 16 : WS_QB + (c8 - 640) * 2);
                const unsigned dpitch = isA ? 768u : 512u;
#pragma unroll
                for (int ai = 0; ai < 2; ++ai)
#pragma unroll
                    for (int m = 0; m < MF; ++m) {
                        const unsigned row = row0 + ai * (MF * 32) + m * 16; const bool lat = rowb + ai * (MF * 32) + m * 16 >= (unsigned)MC;
                        f32x4 v0 = acc[ai][bj][m][0], v1 = acc[ai][bj][m][1];
                        if (lat) {
                            const unsigned t = (row - MC) & 4095, rp = t >> 6, cp = t & 63;
                            unsigned to_;
                            if (isA) { const unsigned pos = ((c32 >> 5) & 1) ? cp : rp; to_ = WS_TAB + (TAB_COSA + pos * 16 + 4 * fq) * 4; }
                            else { const unsigned pos = (fq >> 1) ? cp : rp; to_ = WS_TAB + (TAB_COSB + pos * 8 + 4 * (fq & 1)) * 4; }
                            const f32x4 c4 = LDG(f32x4, ws, to_), s4 = LDG(f32x4, ws, to_ + (isA ? 4096u : 2048u));
                            f32x4 w0, w1;
                            w0[0] = v0[0] * c4[0] - v0[1] * s4[0]; w0[1] = v0[1] * c4[0] + v0[0] * s4[0];
                            w0[2] = v0[2] * c4[1] - v0[3] * s4[1]; w0[3] = v0[3] * c4[1] + v0[2] * s4[1];
                            w1[0] = v1[0] * c4[2] - v1[1] * s4[2]; w1[1] = v1[1] * c4[2] + v1[0] * s4[2];
                            w1[2] = v1[2] * c4[3] - v1[3] * s4[3]; w1[3] = v1[3] * c4[3] + v1[2] * s4[3];
                            v0 = w0; v1 = w1;
                        } else if (isK) {
                            const unsigned b = row >> 8, t = row & 255;
                            const f32x4 ev = {v0[0], v0[2], v1[0], v1[2]}, od = {v0[1], v0[3], v1[1], v1[3]};
                            if (isA) { const unsigned o = (OFF_AK + ((b * 4 + l) * 256 + t) * 128 + (c32 - 384) + 4 * fq) * 4; STG(f32x4, out, o) = ev; STG(f32x4, out, o + 64) = od; }
                            else { const unsigned o = (OFF_BK + ((b * 4 + l) * 256 + t) * 256 + ((c8 - 896) & ~15u) + 4 * (fq & 1)) * 4; STG(f32x4, out, o) = ev; STG(f32x4, out, o + 32) = od; }
                        }
                        v0 = v0 * qs; v1 = v1 * qs;
                        u32x4 w; w.x = pk2(v0[0], v0[1]); w.y = pk2(v0[2], v0[3]); w.z = pk2(v1[0], v1[1]); w.w = pk2(v1[2], v1[3]);
                        STG(u32x4, ws, isK ? dbase + (row >> 5) * (isA ? 8192u : 16384u) + (row & 31) * 16 : dbase + row * dpitch) = w;
                        asm volatile("" ::: "memory");
                    }
            } else if (c32 < 1408) {
                const bool isA = c32 < 640;
                const unsigned cc = isA ? (c8 - 512) : (c8 - 1152), cw = isA ? (c32 - 512) : (c32 - 1152);
                const unsigned vfrag = (isA ? WS_VTA : WS_VTB) + (((cw >> 6) * 2 + ((cw >> 5) & 1)) * 2) * 1024;
                LAS unsigned char* lw = lds + (wr * 4 + wc) * 1024;
                LAS bf16_t* lq = (LAS bf16_t*)(lw + ((((fr >> 2) & 1) * 32 + 8 * fq) * 16 + (4 * (fr >> 3) + (fr & 3)) * 2));
#pragma unroll
                for (int ai = 0; ai < 2; ++ai)
#pragma unroll
                    for (int m = 0; m < MF; ++m) {
                        const unsigned rf = rowb + ai * (MF * 32) + m * 16, row = rf + fr; const bool lat = rf >= (unsigned)MC;
                        const f32x4 v0 = acc[ai][bj][m][0], v1 = acc[ai][bj][m][1];
                        if (!lat) { const unsigned b = row >> 8, t = row & 255;
                            const unsigned o = isA ? (OFF_AV + ((b * 4 + l) * 256 + t) * 128 + cc) * 4 : (OFF_BV + ((b * 4 + l) * 256 + t) * 256 + cc) * 4;
                            STG(f32x4, out, o) = v0; STG(f32x4, out, o + 16) = v1; }
                        const unsigned p0 = pk2(v0[0], v0[1]), p1 = pk2(v0[2], v0[3]), p2 = pk2(v1[0], v1[1]), p3 = pk2(v1[2], v1[3]);
                        lq[0 * 8] = (bf16_t)(p0 & 0xffff); lq[1 * 8] = (bf16_t)(p0 >> 16); lq[2 * 8] = (bf16_t)(p1 & 0xffff); lq[3 * 8] = (bf16_t)(p1 >> 16);
                        lq[4 * 8] = (bf16_t)(p2 & 0xffff); lq[5 * 8] = (bf16_t)(p2 >> 16); lq[6 * 8] = (bf16_t)(p3 & 0xffff); lq[7 * 8] = (bf16_t)(p3 >> 16);
                        const u32x4 tv = *(const LAS u32x4*)(lw + (fq * 16 + fr) * 16);
                        STG(u32x4, ws, vfrag + (rf >> 5) * (isA ? 8192u : 16384u) + ((rf >> 4) & 1) * 1024 + (fq * 16 + fr) * 16) = tv;
                        asm volatile("" ::: "memory");
                    }
            } else if (c32 < 2944) {
                const int kind = c32 < 2560 ? 0 : (c32 < 2688 ? 1 : (c32 < 2816 ? 2 : 3));
                const unsigned dbase = kind == 0 ? WS_RKV + (c8 - 1408) * 2 : (kind == 1 ? WS_CW + (c8 - 2560) * 2 : (kind == 2 ? WS_CA + (c8 - 2688) * 2 : WS_CG + (c8 - 2816) * 2));
                const unsigned dpitch = kind == 0 ? 2304u : 256u;
#pragma unroll
                for (int ai = 0; ai < 2; ++ai)
#pragma unroll
                    for (int m = 0; m < MF; ++m) {
                        const unsigned row = row0 + ai * (MF * 32) + m * 16; const bool lat = rowb + ai * (MF * 32) + m * 16 >= (unsigned)MC;
                        f32x4 v0 = acc[ai][bj][m][0], v1 = acc[ai][bj][m][1];
                        if (kind == 1) {
#pragma unroll
                            for (int e = 0; e < 4; ++e) { v0[e] = 1.f - 2.f * __builtin_amdgcn_rcpf(__expf(2.f * v0[e]) + 1.f); v1[e] = 1.f - 2.f * __builtin_amdgcn_rcpf(__expf(2.f * v1[e]) + 1.f); }
                        } else if (kind == 3) {
#pragma unroll
                            for (int e = 0; e < 4; ++e) { v0[e] = sigmf(v0[e]); v1[e] = sigmf(v1[e]); }
                        }
                        u32x4 w; w.x = pk2(v0[0], v0[1]); w.y = pk2(v0[2], v0[3]); w.z = pk2(v1[0], v1[1]); w.w = pk2(v1[2], v1[3]);
                        STG(u32x4, ws, dbase + row * dpitch) = w;
                        asm volatile("" ::: "memory");
                    }
            }
        }
    }
};

struct Frame {
    LAS unsigned char* lds;
    const float* const* in;
    float* out; unsigned char* ws;
    int tid, lane, wave, gw, ngw, G, bid;
};
#define GAS __attribute__((address_space(1)))
template <class T> __device__ __forceinline__ T* gptr(T* p) {
#if defined(__HIP_DEVICE_COMPILE__)
    __builtin_assume(!__builtin_amdgcn_is_shared((const void*)p)); __builtin_assume(!__builtin_amdgcn_is_private((const void*)p));
#endif
    return p; }
#define INP(k) gptr(F.in[k])
#define WSP(T, off) gptr((T*)(F.ws + (off)))

__device__ __forceinline__ void phase_prologue(Frame& F) {
    const float* cvec = INP(8); const float* cctx = INP(9); const float* ada_w = INP(10); const float* ada_b = INP(11);
    LAS float* sl = (LAS float*)F.lds;
    LAS float* red = (LAS float*)(F.lds + 16384);
    for (int i = F.tid; i < 3072; i += 512) { const int v = i >> 10, k = i & 1023; const float x = v == 0 ? cctx[k] : cvec[(v - 1) * 1024 + k]; sl[i] = x / (1.f + __expf(-x)); }
    __syncthreads();
    float* mod = WSP(float, WS_MOD);
    for (int it = F.bid; it < 384; it += F.G) {
        const int l = it / 96, n0 = (it % 96) * 64;
        const float* W = ada_w + (size_t)l * 1024 * 6144 + n0 + F.lane;
        float a0 = 0.f, a1 = 0.f, a2 = 0.f;
        const int k0 = F.wave * 128;
#pragma unroll 8
        for (int k = k0; k < k0 + 128; ++k) { const float w = *(const GAS float*)(W + (size_t)k * 6144); a0 += sl[k] * w; a1 += sl[1024 + k] * w; a2 += sl[2048 + k] * w; }
        red[(F.wave * 3 + 0) * 64 + F.lane] = a0; red[(F.wave * 3 + 1) * 64 + F.lane] = a1; red[(F.wave * 3 + 2) * 64 + F.lane] = a2;
        __syncthreads();
        if (F.wave < 3) { float s = ada_b[l * 6144 + n0 + F.lane];
#pragma unroll
            for (int w = 0; w < 8; ++w) s += red[(w * 3 + F.wave) * 64 + F.lane];
            mod[(size_t)(l * 3 + F.wave) * 6144 + n0 + F.lane] = s; }
        __syncthreads();
    }
    float* tab = WSP(float, WS_TAB);
    if (F.bid == F.G - 1) {
        for (int i = F.tid; i < 1024; i += 512) { const int pos = i >> 4, f = i & 15; const float ang = (float)pos * __builtin_amdgcn_exp2f(-(float)f * (13.287712379549449f / 16.f)); tab[TAB_COSA + i] = __cosf(ang); tab[TAB_SINA + i] = __sinf(ang); }
        for (int i = F.tid; i < 512; i += 512) { const int pos = i >> 3, f = i & 7; const float ang = (float)pos * __builtin_amdgcn_exp2f(-(float)f * (13.287712379549449f / 8.f)); tab[TAB_COSB + i] = __cosf(ang); tab[TAB_SINB + i] = __sinf(ang); }
        if (F.wave < 4) { const float* lp = INP(16) + F.wave * 128; const int d = F.lane & 31;
            const float p1 = wave_sum(F.lane < 32 ? lp[d] * lp[32 + d] : 0.f), p2 = wave_sum(F.lane < 32 ? 0.f : lp[64 + d] * lp[96 + d]);
            if (F.lane == 0) tab[TAB_LAM + F.wave] = __expf(p1) - __expf(p2); }
    }
    const int gtid = F.bid * 512 + F.tid, gnt = F.G * 512;
    { bf16_t* sw = WSP(bf16_t, WS_SMALLW); const float* cw2 = INP(20); const float* ca2 = INP(22); const float* cg2 = INP(23);
      for (int idx = gtid; idx < 4 * SMALLW_L; idx += gnt) { const int l = idx / SMALLW_L, r = idx % SMALLW_L; float v;
          if (r < 98304) { const int which = r / 49152, rr = r % 49152, d = rr / 24576, ch = (rr % 24576) / 64, k = rr % 64; v = (which ? ca2 : cw2)[((size_t)(l * 2 + d) * 64 + k) * 384 + ch]; }
          else { const int rr = r - 98304, ch = rr / 128, k = rr % 128; v = cg2[((size_t)l * 128 + k) * 384 + ch]; }
          sw[idx] = (bf16_t)(pk2(v, 0.f) & 0xffff); } }
    { bf16_t* kca = WSP(bf16_t, WS_CACHE); bf16_t* vca = kca + 524288; bf16_t* kcb = vca + 524288; bf16_t* vcb = kcb + 1048576;
      const float* cak = INP(2); const float* cav = INP(3); const float* cbk = INP(4); const float* cbv = INP(5);
      for (int e = gtid; e < 524288; e += gnt) {
          const int j = e & 7, ln = (e >> 3) & 63, hi = ln >> 5, r32 = ln & 31, blk = (e >> 12) & 15, bl = e >> 16;
          { const int s = (e >> 9) & 3, kvh = (e >> 11) & 1, cp = kvh * 64 + 16 * s + 8 * hi + j, o = cp & 31, c = (cp - o) + (o >> 1) + 16 * (o & 1);
            kca[e] = (bf16_t)(pk2(cak[((size_t)bl * 512 + blk * 32 + r32) * 128 + c], 0.f) & 0xffff); }
          { const int ks = (e >> 9) & 1, db = (e >> 10) & 1, kvh = (e >> 11) & 1, key = blk * 32 + 16 * ks + 8 * (j >> 2) + 4 * hi + (j & 3);
            vca[e] = (bf16_t)(pk2(cav[((size_t)bl * 512 + key) * 128 + kvh * 64 + db * 32 + r32], 0.f) & 0xffff); } }
      for (int e = gtid; e < 1048576; e += gnt) {
          const int j = e & 7, ln = (e >> 3) & 63, hi = ln >> 5, r32 = ln & 31, blk = (e >> 13) & 15, bl = e >> 17;
          { const int s = (e >> 9) & 1, hm = (e >> 10) & 7, cp = hm * 32 + 16 * s + 8 * hi + j, o = cp & 15, c = (cp - o) + (o >> 1) + 8 * (o & 1);
            kcb[e] = (bf16_t)(pk2(cbk[((size_t)bl * 512 + blk * 32 + r32) * 256 + c], 0.f) & 0xffff); }
          { const int ks = (e >> 9) & 1, db = (e >> 10) & 1, h = (e >> 11) & 3, key = blk * 32 + 16 * ks + 8 * (j >> 2) + 4 * hi + (j & 3);
            vcb[e] = (bf16_t)(pk2(cbv[((size_t)bl * 512 + key) * 256 + h * 64 + db * 32 + r32], 0.f) & 0xffff); } } }
    for (int st = 0; st < 1; ++st) { u32x4* z = (u32x4*)(WSP(bf16_t, WS_WIN + st * WSET_STRIDE) + (size_t)2944 * 1024); unsigned z0; asm volatile("v_mov_b32 %0, 0" : "=v"(z0)); for (int i = gtid; i < 128 * 1024 / 8; i += gnt) z[i] = (u32x4){z0, z0, z0, z0}; }
}

template <int MAP> __device__ __forceinline__ int dest_row(int n) {
    if (MAP == 1) {
        if (n < 512) { const int o = n & 31; return (n - o) + 2 * (o & 15) + (o >> 4); }
        if (n >= 640 && n < 1152) { const int o = n & 15; return (n - o) + 2 * (o & 7) + (o >> 3); }
        return n;
    }
    if (MAP == 2 || MAP == 3) return (n >> 7) * 256 + ((n >> 2) & 1) * 128 + ((n >> 5) & 3) * 32 + ((n >> 3) & 3) * 8 + (MAP == 3 ? 4 : 0) + (n & 3);
    return n;
}
template <int MAP> __device__ __forceinline__ void transpose_item(const float* W, int K, int N, bf16_t* WT, LAS float* scr, int item, int lane) {
    const int nblk = N / 32, kb = item / nblk, nb = item % nblk, k0 = 64 * kb, n0 = 32 * nb;
#pragma unroll 8
    for (int i = 0; i < 32; ++i) { const int kk = 2 * i + (lane >> 5); scr[kk * 33 + (lane & 31)] = *(const GAS float*)(W + (size_t)(k0 + kk) * N + n0 + (lane & 31)); }
    asm volatile("s_waitcnt lgkmcnt(0)" ::: "memory");
    const int c = lane & 7;
#pragma unroll
    for (int j = 0; j < 4; ++j) { const int n = (lane >> 3) + 8 * j; const LAS float* s = scr + (8 * c) * 33 + n;
        u32x4 o; o.x = pk2(s[0 * 33], s[1 * 33]); o.y = pk2(s[2 * 33], s[3 * 33]); o.z = pk2(s[4 * 33], s[5 * 33]); o.w = pk2(s[6 * 33], s[7 * 33]);
        *(GAS u32x4*)(WT + (size_t)dest_row<MAP>(n0 + n) * K + k0 + 8 * c) = o; }
    asm volatile("s_waitcnt lgkmcnt(0)" ::: "memory");
}
template <int MAP> __device__ __forceinline__ void convert_item(const float* W, int K, int N, bf16_t* WT, int item, int lane) {
    const int nblk = N / 64, kb = item / nblk, nb = item % nblk, n = nb * 64 + lane;
    const GAS float* src = (const GAS float*)W + (size_t)(kb * 128) * N + n;
    GAS bf16_t* dst = (GAS bf16_t*)WT + (size_t)dest_row<MAP>(n) * K + kb * 128;
#pragma unroll
    for (int g = 0; g < 16; ++g) { float v[8];
#pragma unroll
        for (int e = 0; e < 8; ++e) v[e] = src[(size_t)(8 * g + e) * N];
        u32x4 o; o.x = pk2(v[0], v[1]); o.y = pk2(v[2], v[3]); o.z = pk2(v[4], v[5]); o.w = pk2(v[6], v[7]);
        *(GAS u32x4*)(dst + 8 * g) = o; }
}
constexpr int CV_IN = 46 * 8, CV_OUT = 16 * 8, CV_1 = 44 * 8, CV_2 = 16 * 22, CV_TOTAL = CV_IN + CV_OUT + 2 * CV_1 + CV_2;
__device__ __forceinline__ void convert_item_any(Frame& F, int l, int it) {
    const unsigned so = 0u * WSET_STRIDE;
    int r = it;
    if (r < CV_IN) { convert_item<1>(INP(14) + (size_t)l * 1024 * 2944, 1024, 2944, WSP(bf16_t, WS_WIN + so), r, F.lane); return; } r -= CV_IN;
    if (r < CV_OUT) { convert_item<0>(INP(29) + (size_t)l * 1024 * 1024, 1024, 1024, WSP(bf16_t, WS_WOUT + so), r, F.lane); return; } r -= CV_OUT;
    if (r < CV_1) { convert_item<2>(INP(30) + (size_t)l * 1024 * FF, 1024, FF, WSP(bf16_t, WS_W13 + so), r, F.lane); return; } r -= CV_1;
    if (r < CV_1) { convert_item<3>(INP(31) + (size_t)l * 1024 * FF, 1024, FF, WSP(bf16_t, WS_W13 + so), r, F.lane); return; } r -= CV_1;
    convert_item<0>(INP(32) + (size_t)l * FF * 1024, FF, 1024, WSP(bf16_t, WS_W2 + so), r, F.lane);
}
__device__ __forceinline__ void convert_weights(Frame& F, int l) {
    LAS float* scr = (LAS float*)(F.lds + F.wave * 16384); const unsigned so = 0u * WSET_STRIDE;
    const float* w_in = INP(14) + (size_t)l * 1024 * 2944; const float* w_out = INP(29) + (size_t)l * 1024 * 1024;
    const float* w1 = INP(30) + (size_t)l * 1024 * FF; const float* w3 = INP(31) + (size_t)l * 1024 * FF; const float* w2 = INP(32) + (size_t)l * FF * 1024;
    constexpr int I_IN = 16 * 92, I_OUT = 16 * 32, I_1 = 16 * 88, I_2 = 44 * 32;
    constexpr int NIT = I_IN + I_OUT + 2 * I_1 + I_2;
    for (int it = F.gw; it < NIT; it += F.ngw) {
        int r = it;
        if (r < I_IN) { transpose_item<1>(w_in, 1024, 2944, WSP(bf16_t, WS_WIN + so), scr, r, F.lane); continue; } r -= I_IN;
        if (r < I_OUT) { transpose_item<0>(w_out, 1024, 1024, WSP(bf16_t, WS_WOUT + so), scr, r, F.lane); continue; } r -= I_OUT;
        if (r < I_1) { transpose_item<2>(w1, 1024, FF, WSP(bf16_t, WS_W13 + so), scr, r, F.lane); continue; } r -= I_1;
        if (r < I_1) { transpose_item<3>(w3, 1024, FF, WSP(bf16_t, WS_W13 + so), scr, r, F.lane); continue; } r -= I_1;
        transpose_item<0>(w2, FF, 1024, WSP(bf16_t, WS_W2 + so), scr, r, F.lane);
    }
}

__device__ __forceinline__ void phase_norm(Frame& F, int l, int which  ) {
    const float* g = (which ? INP(13) : INP(12)) + l * 1024;
    const float* mod = WSP(float, WS_MOD) + (size_t)l * 3 * 6144 + (which ? 3072 : 0);
    bf16_t* H = WSP(bf16_t, WS_ACT);
    const bool first = (l == 0 && which == 0);
    f32x4 gv[4];
#pragma unroll
    for (int j = 0; j < 4; ++j) gv[j] = *(const GAS f32x4*)(g + 4 * F.lane + 256 * j);
    for (int row = F.gw; row < M; row += F.ngw) {
        const float* mv = mod + (row < MC ? 0 : (row < 2 * MC ? 1 : 2)) * 6144;
        f32x4 v[4]; float ss = 0.f;
        if (first) { const float* xr = row < MC ? INP(0) + (size_t)row * DM : INP(1) + (size_t)(row - MC) * DM;
#pragma unroll
            for (int j = 0; j < 4; ++j) v[j] = *(const GAS f32x4*)(xr + 4 * F.lane + 256 * j); }
        else {
#pragma unroll
            for (int j = 0; j < 4; ++j) v[j] = unpack4(LDG(u32x2, F.ws, WS_XB + ((unsigned)row * DM + 4 * F.lane + 256 * j) * 2)); }
#pragma unroll
        for (int j = 0; j < 4; ++j) ss += (v[j][0] * v[j][0] + v[j][1] * v[j][1]) + (v[j][2] * v[j][2] + v[j][3] * v[j][3]);
        const float rstd = rsqrtf(wave_sum(ss) * (1.f / 1024.f) + 1e-6f);
#pragma unroll
        for (int j = 0; j < 4; ++j) { const f32x4 sh = *(const GAS f32x4*)(mv + 4 * F.lane + 256 * j), sc = *(const GAS f32x4*)(mv + 1024 + 4 * F.lane + 256 * j);
            const f32x4 h = v[j] * rstd * gv[j] * (sc + 1.f) + sh;
            *(GAS u32x2*)(H + (size_t)row * DM + 4 * F.lane + 256 * j) = pack4(h); }
    }
}
__device__ __forceinline__ void phase_final_norm(Frame& F) {
    const float* g = INP(33);
    f32x4 gv[4];
#pragma unroll
    for (int j = 0; j < 4; ++j) gv[j] = *(const GAS f32x4*)(g + 4 * F.lane + 256 * j);
    for (int row = F.gw; row < M; row += F.ngw) {
        float* xr = gptr(F.out + (size_t)row * DM);
        f32x4 v[4]; float ss = 0.f;
#pragma unroll
        for (int j = 0; j < 4; ++j) { v[j] = unpack4(LDG(u32x2, F.ws, WS_XB + ((unsigned)row * DM + 4 * F.lane + 256 * j) * 2)); ss += (v[j][0] * v[j][0] + v[j][1] * v[j][1]) + (v[j][2] * v[j][2] + v[j][3] * v[j][3]); }
        const float rstd = rsqrtf(wave_sum(ss) * (1.f / 1024.f) + 1e-6f);
#pragma unroll
        for (int j = 0; j < 4; ++j) *(GAS f32x4*)(xr + 4 * F.lane + 256 * j) = v[j] * rstd * gv[j];
    }
}

#define MFMA32(a, b, c) __builtin_amdgcn_mfma_f32_32x32x16_bf16((a), (b), (c), 0, 0, 0)
#ifndef ATT_PROBE
#define ATT_PROBE 0
#endif
struct AttnQ { float m, l; bool mz; f32x16 o[2]; };
template <int DQK, bool MASK, int NQ>
__device__ __forceinline__ void attn_block(const bf16x8 (&qf)[NQ][DQK / 16], const bf16x8 (&kf)[DQK / 16], const bf16x8 (&vf)[4], AttnQ (&st)[NQ], int b, const int (&qpos)[NQ], int kpos0, int hi) {
    constexpr int NS = DQK / 16;
    f32x16 sc[NQ];
#pragma unroll
    for (int q = 0; q < NQ; ++q) { const f32x16 z = {}; sc[q] = MFMA32(kf[0], qf[q][0], z);
#pragma unroll
        for (int s = 1; s < NS; ++s) sc[q] = MFMA32(kf[s], qf[q][s], sc[q]); }
#pragma unroll
    for (int q = 0; q < NQ; ++q) {
        if (!st[q].mz) {
#pragma unroll
            for (int r = 0; r < 16; ++r) sc[q][r] -= st[q].m; }
        if (MASK) {
#pragma unroll
            for (int r = 0; r < 16; ++r) { const int key = kpos0 + 32 * b + (r & 3) + 8 * (r >> 2) + 4 * hi; const int dlt = key - qpos[q]; if (dlt > 128 || dlt < -128) sc[q][r] = -1e30f; }
        }
        float bm = fmaxf(fmaxf(sc[q][0], sc[q][1]), sc[q][2]);
#pragma unroll
        for (int r = 3; r < 15; r += 2) bm = fmaxf(fmaxf(bm, sc[q][r]), sc[q][r + 1]);
        bm = fmaxf(bm, sc[q][15]);
        bm = swap32_max(bm);
        if (__builtin_amdgcn_ballot_w64(bm > 64.f) != 0ull) {
            const float d = fmaxf(bm, 0.f);
            const float alpha = __builtin_amdgcn_exp2f(-d);
            st[q].m += d; st[q].l *= alpha; st[q].mz = false;
#pragma unroll
            for (int r = 0; r < 16; ++r) { st[q].o[0][r] *= alpha; st[q].o[1][r] *= alpha; sc[q][r] -= d; }
        }
#if ATT_PROBE == 1
        { float dmy = 0.f;
#pragma unroll
          for (int r = 0; r < 16; ++r) { float e_; asm volatile("v_exp_f32 %0, %1" : "=v"(e_) : "v"(sc[q][r])); dmy += e_; }
          asm volatile("" :: "v"(dmy)); }
#endif
        f32x2 rs2 = {0.f, 0.f};
#pragma unroll
        for (int r = 0; r < 16; r += 2) { sc[q][r] = __builtin_amdgcn_exp2f(sc[q][r]); sc[q][r + 1] = __builtin_amdgcn_exp2f(sc[q][r + 1]); rs2 += (f32x2){sc[q][r], sc[q][r + 1]}; }
        st[q].l += rs2[0] + rs2[1];
#if ATT_PROBE == 3
        { float d0 = 0.f, d1 = 0.f, d2 = 0.f, d3 = 0.f;
#pragma unroll
          for (int rr = 0; rr < 10; ++rr) { asm volatile("v_add_f32 %0, %0, %4\n\tv_add_f32 %1, %1, %5\n\tv_add_f32 %2, %2, %6\n\tv_add_f32 %3, %3, %7" : "+v"(d0), "+v"(d1), "+v"(d2), "+v"(d3) : "v"(sc[q][0]), "v"(sc[q][1]), "v"(sc[q][2]), "v"(sc[q][3])); }
          asm volatile("" :: "v"(d0), "v"(d1), "v"(d2), "v"(d3)); }
#endif
#if ATT_PROBE == 2
        { f32x16 dm = sc[q]; dm = MFMA32(kf[0], qf[q][0], dm); dm = MFMA32(kf[0], qf[q][0], dm); dm = MFMA32(kf[0], qf[q][0], dm); asm volatile("" :: "v"(dm)); }
#endif
        bf16x8 pb[2];
#pragma unroll
        for (int ks = 0; ks < 2; ++ks) { u32x4 w; w.x = pk2(sc[q][8 * ks], sc[q][8 * ks + 1]); w.y = pk2(sc[q][8 * ks + 2], sc[q][8 * ks + 3]); w.z = pk2(sc[q][8 * ks + 4], sc[q][8 * ks + 5]); w.w = pk2(sc[q][8 * ks + 6], sc[q][8 * ks + 7]); pb[ks] = __builtin_bit_cast(bf16x8, w); }
#pragma unroll
        for (int db = 0; db < 2; ++db)
#pragma unroll
            for (int ks = 0; ks < 2; ++ks) st[q].o[db] = MFMA32(vf[db * 2 + ks], pb[ks], st[q].o[db]);
    }
}
template <int DQK, bool MASK, int NQ>
__device__ __forceinline__ void attn_seg(const unsigned char* ws, const bf16x8 (&qf)[NQ][DQK / 16], AttnQ (&st)[NQ],
                                         unsigned kp, unsigned kblk  , unsigned vp, unsigned vblk, int nblk, const int (&qpos)[NQ], int kpos0, int hi) {
    constexpr int NS = DQK / 16;
    const GAS unsigned char* kq = (const GAS unsigned char*)ws + kp; const GAS unsigned char* vq = (const GAS unsigned char*)ws + vp;
    bf16x8 ka[NS], va[4], kb[NS], vb[4];
#define ATT_LOAD(kd, vd) do { _Pragma("unroll") for (int s = 0; s < NS; ++s) kd[s] = *(const GAS bf16x8*)(kq + 1024 * s); _Pragma("unroll") for (int f = 0; f < 4; ++f) vd[f] = *(const GAS bf16x8*)(vq + 1024 * f); } while (0)
    ATT_LOAD(ka, va);
    int b = 0;
    for (; b + 1 < nblk; b += 2) {
        kq += kblk; vq += vblk; ATT_LOAD(kb, vb);
        attn_block<DQK, MASK, NQ>(qf, ka, va, st, b, qpos, kpos0, hi);
        if (b + 2 < nblk) { kq += kblk; vq += vblk; }
        ATT_LOAD(ka, va);
        attn_block<DQK, MASK, NQ>(qf, kb, vb, st, b + 1, qpos, kpos0, hi);
    }
    if (b < nblk) attn_block<DQK, MASK, NQ>(qf, ka, va, st, b, qpos, kpos0, hi);
#undef ATT_LOAD
}
__device__ __forceinline__ void attnq_init(AttnQ& s, float l0) { s.m = 0.f; s.mz = true; s.l = l0; s.o[0] = (f32x16){}; s.o[1] = (f32x16){}; }
__device__ __forceinline__ void attn_a_item(Frame& F, int l, bool lat, int item) {
    int lane = F.lane; asm volatile("" : "+v"(lane));
    const unsigned char* ws = F.ws;
    const unsigned r32 = lane & 31, hi = lane >> 5;
    const unsigned nqb = lat ? 128 : 8;
    const unsigned qb = item % nqb, hq = (item / nqb) % 6, b = item / (nqb * 6), kvh = hq / 3;
    const unsigned seq0 = lat ? MC + b * 4096 : b * 256, q0 = qb * 32, row = seq0 + q0 + r32;
    const unsigned qo = WS_QA + (row * 384 + hq * 64 + 8 * hi) * 2;
    bf16x8 qf[1][4];
#pragma unroll
    for (int s = 0; s < 4; ++s) qf[0][s] = LDG(bf16x8, ws, qo + 32 * s);
    AttnQ st[1]; attnq_init(st[0], hi == 0 ? __builtin_amdgcn_exp2f(INP(15)[l * 6 + hq] * LOG2E) : 0.f);
    const int qpos[1] = {(int)(q0 + r32)};
    const unsigned fo = kvh * 4096 + lane * 16;
    if (!lat) {
        attn_seg<64, false, 1>(ws, qf, st, WS_KA + (seq0 >> 5) * 8192 + fo, 8192, WS_VTA + (seq0 >> 5) * 8192 + fo, 8192, 8, qpos, 0, hi);
    } else {
        const int ks = (int)q0 - 128 < 0 ? 0 : (int)q0 - 128, ke = q0 + 160 > 4096 ? 4096 : q0 + 160;
        attn_seg<64, true, 1>(ws, qf, st, WS_KA + ((seq0 + ks) >> 5) * 8192 + fo, 8192, WS_VTA + ((seq0 + ks) >> 5) * 8192 + fo, 8192, (ke - ks) >> 5, qpos, ks, hi);
        attn_seg<64, false, 1>(ws, qf, st, WS_CACHE + (b * 4 + l) * 131072 + fo, 8192, WS_CACHE + 1 * MiB + (b * 4 + l) * 131072 + fo, 8192, 16, qpos, 0, hi);
    }
    const float rl = 1.f / swap32_sum(st[0].l);
    const unsigned oo = WS_ACT + (row * DM + hq * 64 + 4 * hi) * 2;
#pragma unroll
    for (int db = 0; db < 2; ++db)
#pragma unroll
        for (int g = 0; g < 4; ++g) { const f32x4 v = {st[0].o[db][4 * g] * rl, st[0].o[db][4 * g + 1] * rl, st[0].o[db][4 * g + 2] * rl, st[0].o[db][4 * g + 3] * rl}; STG(u32x2, F.ws, oo + (32 * db + 8 * g) * 2) = pack4(v); }
}
__device__ __forceinline__ void attn_b_store(Frame& F, const AttnQ& s, unsigned mp, unsigned kh, unsigned row, unsigned h, unsigned hi) {
    const float lt = swap32_sum(s.l);
    const unsigned oo = WS_BO2 + (((mp * 2 + kh) * M + row) * 256 + h * 64 + 4 * hi) * 2;
#pragma unroll
    for (int db = 0; db < 2; ++db)
#pragma unroll
        for (int g = 0; g < 4; ++g) STG(u32x2, F.ws, oo + (32 * db + 8 * g) * 2) = pack4((f32x4){s.o[db][4 * g], s.o[db][4 * g + 1], s.o[db][4 * g + 2], s.o[db][4 * g + 3]});
    if (hi == 0) STG(f32x2, F.ws, WS_ML + ((((mp * 2 + kh) * M + row) * 4 + h) * 2) * 4) = (f32x2){s.m, lt};
}
__device__ __forceinline__ void attn_b_item(Frame& F, int l, bool lat, int item) {
    int lane = F.lane; asm volatile("" : "+v"(lane));
    const unsigned char* ws = F.ws;
    const unsigned r32 = lane & 31, hi = lane >> 5;
    if (lat) {
        const unsigned kh = item & 1, qb = (item >> 1) & 63, mp = (item >> 7) & 1, h = (item >> 8) & 3, b = item >> 10;
        const unsigned seq0 = MC + b * 4096, row0 = seq0 + qb * 64 + r32;
        bf16x8 qf[2][2];
#pragma unroll
        for (int q = 0; q < 2; ++q)
#pragma unroll
            for (int s = 0; s < 2; ++s) qf[q][s] = LDG(bf16x8, ws, WS_QB + ((row0 + 32 * q) * 256 + h * 64 + mp * 32 + 8 * hi) * 2 + 32 * s);
        AttnQ st[2]; attnq_init(st[0], 0.f); attnq_init(st[1], 0.f);
        const int qpos[2] = {0, 0};
        const unsigned kfo = (h * 2 + mp) * 2048 + lane * 16, vfo = h * 4096 + lane * 16;
        const unsigned blk0 = kh ? 72u : 0u, nb = kh ? 56 : 72;
        attn_seg<32, false, 2>(ws, qf, st, WS_KB + ((seq0 >> 5) + blk0) * 16384 + kfo, 16384, WS_VTB + ((seq0 >> 5) + blk0) * 16384 + vfo, 16384, nb, qpos, 0, hi);
        if (kh) attn_seg<32, false, 2>(ws, qf, st, WS_CACHE + 2 * MiB + (b * 4 + l) * 262144 + kfo, 16384, WS_CACHE + 4 * MiB + (b * 4 + l) * 262144 + vfo, 16384, 16, qpos, 0, hi);
        attn_b_store(F, st[0], mp, kh, row0, h, hi); attn_b_store(F, st[1], mp, kh, row0 + 32, h, hi);
    } else {
        const unsigned qb = item & 7, mp = (item >> 3) & 1, h = (item >> 4) & 3, b = item >> 6;
        const unsigned seq0 = b * 256, row = seq0 + qb * 32 + r32;
        bf16x8 qf[1][2];
#pragma unroll
        for (int s = 0; s < 2; ++s) qf[0][s] = LDG(bf16x8, ws, WS_QB + (row * 256 + h * 64 + mp * 32 + 8 * hi) * 2 + 32 * s);
        AttnQ st[1]; attnq_init(st[0], 0.f);
        const int qpos[1] = {0};
        const unsigned kfo = (h * 2 + mp) * 2048 + lane * 16, vfo = h * 4096 + lane * 16;
        attn_seg<32, false, 1>(ws, qf, st, WS_KB + (seq0 >> 5) * 16384 + kfo, 16384, WS_VTB + (seq0 >> 5) * 16384 + vfo, 16384, 8, qpos, 0, hi);
        attn_b_store(F, st[0], mp, 0, row, h, hi);
    }
}

constexpr int L_KT = 0, L_RT = 9216, L_BT = 18432, L_KK = 27648, L_VT = 36864, L_KKT = 46080, L_BTT = 55296, L_A1 = 64512, L_RHS2 = 81920, L_WT = 99328, L_U0T = 108544, L_GC = 117760, L_X0 = 118016;
constexpr int RPB = 144, RPF = 272;
__device__ __forceinline__ void chunk_decode(int cid, unsigned& seq0, int& T, unsigned& b, unsigned& h, unsigned& dir, int& c) {
    unsigned chain;
    if (cid < 768) { chain = (unsigned)cid >> 2; c = cid & 3; T = 256; b = chain / 12; seq0 = b * 256; }
    else { const unsigned x = (unsigned)cid - 768; chain = x >> 6; c = (int)(x & 63); T = 4096; b = chain / 12; seq0 = MC + b * 4096; }
    dir = chain & 1; h = (chain >> 1) % 6;
}
__device__ __forceinline__ bf16x8 acc_frag(const f32x16& x, int ks, float sgn) {
    u32x4 w; w.x = pk2(sgn * x[8 * ks], sgn * x[8 * ks + 1]); w.y = pk2(sgn * x[8 * ks + 2], sgn * x[8 * ks + 3]); w.z = pk2(sgn * x[8 * ks + 4], sgn * x[8 * ks + 5]); w.w = pk2(sgn * x[8 * ks + 6], sgn * x[8 * ks + 7]);
    return __builtin_bit_cast(bf16x8, w);
}
__device__ __forceinline__ bf16x8 lds_frag_nat(const LAS unsigned char* img, unsigned row, int ks, unsigned hi) { return *(const LAS bf16x8*)(img + row * RPB + (16 * ks + 8 * hi) * 2); }
__device__ __forceinline__ bf16x8 lds_frag_perm(const LAS unsigned char* img, unsigned row, int k0, unsigned hi) {
    const s16x4 a = *(const LAS s16x4*)(img + row * RPB + (k0 + 4 * hi) * 2), b = *(const LAS s16x4*)(img + row * RPB + (k0 + 8 + 4 * hi) * 2);
    return (bf16x8){a[0], a[1], a[2], a[3], b[0], b[1], b[2], b[3]};
}
__device__ __forceinline__ f32x16 gram_tile(const LAS unsigned char* lds, int aimg, int bimg, int sb, int tb, unsigned r32, unsigned hi, bool strict) {
    f32x16 acc = {};
#pragma unroll
    for (int ks = 0; ks < 4; ++ks) acc = MFMA32(lds_frag_nat(lds + aimg, 32 * sb + r32, ks, hi), lds_frag_nat(lds + bimg, 32 * tb + r32, ks, hi), acc);
    if (sb == tb) {
#pragma unroll
        for (int r = 0; r < 16; ++r) { const unsigned s_ = (r & 3) + 8 * (r >> 2) + 4 * hi; const bool keep = strict ? s_ < r32 : s_ <= r32; acc[r] = keep ? acc[r] : 0.f; }
    }
    return acc;
}
__device__ __forceinline__ void lds_barrier() { asm volatile("s_waitcnt lgkmcnt(0)\n\ts_barrier" ::: "memory"); }
__device__ __forceinline__ void rwkv_chunk_block(Frame& F, int l, int cid) {
    int lane = F.lane; asm volatile("" : "+v"(lane));
    const unsigned char* ws = F.ws; LAS unsigned char* lds = F.lds;
    const int w = F.wave; const unsigned r32 = lane & 31, hi = lane >> 5;
    unsigned seq0, b, h, dir; int T, c; chunk_decode(cid, seq0, T, b, h, dir, c);
    const int q0 = 64 * c;
#ifndef RA_REP
#define RA_REP 0
#endif
    const int role = w >> 1, tb = w & 1;
    const unsigned swo = WS_SMALLW + l * (SMALLW_L * 2);
    {
        const int pw_ = w < 4, pb = (w >> 1) & 1, cb = w & 1;
        const int p_ = 32 * pb + r32; const unsigned tokp = seq0 + (dir ? T - 1 - (q0 + p_) : q0 + p_);
        const unsigned xo = (pw_ ? WS_CW : WS_CA) + (tokp * 128 + dir * 64 + 8 * hi) * 2, wo = swo + ((pw_ ? 0 : 49152) + (dir * 384 + h * 64 + 32 * cb + r32) * 64 + 8 * hi) * 2;
        f32x16 acc = {};
#pragma unroll
        for (int ks = 0; ks < 4; ++ks) acc = MFMA32(LDG(bf16x8, ws, xo + 32 * ks), LDG(bf16x8, ws, wo + 32 * ks), acc);
        {
            const float bias = LDG(float, pw_ ? INP(19) : INP(21), ((l * 2 + dir) * 384 + h * 64 + 32 * cb + r32) * 4);
#pragma unroll
            for (int r = 0; r < 16; ++r) { const float sg = sigmf(bias + acc[r]);
                *(LAS float*)(lds + (pw_ ? L_A1 : L_RHS2) + (32 * pb + (r & 3) + 8 * (r >> 2) + 4 * hi) * RPF + (32 * cb + r32) * 4) = pw_ ? -0.606531f * sg : sg; }
        }
        if (dir == 0 && w < 4) {
            f32x16 ag = {};
            const unsigned go = WS_CG + (tokp * 128 + 8 * hi) * 2, gw_ = swo + (98304 + (h * 64 + 32 * cb + r32) * 128 + 8 * hi) * 2;
#pragma unroll
            for (int ks = 0; ks < 8; ++ks) ag = MFMA32(LDG(bf16x8, ws, go + 32 * ks), LDG(bf16x8, ws, gw_ + 32 * ks), ag);
#pragma unroll
            for (int r = 0; r < 16; ++r) { const int pp_ = 32 * pb + (r & 3) + 8 * (r >> 2) + 4 * hi; const unsigned tk = seq0 + q0 + pp_;
                STG(bf16_t, F.ws, WS_G + (tk * 384 + h * 64 + 32 * cb + r32) * 2) = (bf16_t)(pk2(ag[r], 0.f) & 0xffff); }
        }
    }
    lds_barrier();
    {
        const unsigned cch = h * 64 + lane;
        const float* convp = INP(18) + (size_t)l * 3 * 1152;
        float cw_[3][3];
#pragma unroll
        for (int tap = 0; tap < 3; ++tap)
#pragma unroll
            for (int seg = 0; seg < 3; ++seg) cw_[tap][seg] = LDG(float, convp, (tap * 1152 + seg * 384 + cch) * 4);
        const float ckk = LDG(float, INP(24), (l * 384 + cch) * 4), cka = LDG(float, INP(25), (l * 384 + cch) * 4), crk = LDG(float, INP(26), (l * 384 + cch) * 4);
        const int tb0 = dir ? T - 1 - (q0 + 8 * w + 7) : q0 + 8 * w;
        float xr[10][3];
#pragma unroll
        for (int rr = 0; rr < 10; ++rr) { const int tr = tb0 - 1 + rr; const bool ok = tr >= 0 && tr < T; const unsigned tk = seq0 + (ok ? tr : tb0);
#pragma unroll
            for (int seg = 0; seg < 3; ++seg) { const float x = bf_lo((unsigned)LDG(bf16_t, ws, WS_RKV + (tk * 1152 + seg * 384 + cch) * 2)); xr[rr][seg] = ok ? x : 0.f; } }
        float lwv[8], kkv[8], btv[8], kdv[8], rv[8], vv[8], g = 0.f;
#pragma unroll
        for (int pp = 0; pp < 8; ++pp) {
            const int rr = 1 + (dir ? 7 - pp : pp); const int p = 8 * w + pp; const unsigned tok = seq0 + (unsigned)(tb0 + rr - 1);
            const float r_ = xr[rr - 1][0] * cw_[0][0] + xr[rr][0] * cw_[1][0] + xr[rr + 1][0] * cw_[2][0];
            const float k_ = xr[rr - 1][1] * cw_[0][1] + xr[rr][1] * cw_[1][1] + xr[rr + 1][1] * cw_[2][1];
            const float v_ = xr[rr - 1][2] * cw_[0][2] + xr[rr][2] * cw_[1][2] + xr[rr + 1][2] * cw_[2][2];
            const float kraw = k_ * ckk; const float n2 = wave_sum(kraw * kraw); const float kk_ = kraw * __builtin_amdgcn_rsqf(fmaxf(n2, 1e-24f));
            const float lw = *(const LAS float*)(lds + L_A1 + p * RPF + lane * 4), av = *(const LAS float*)(lds + L_RHS2 + p * RPF + lane * 4);
            const float kd_ = k_ * (1.f + (av - 1.f) * cka);
            const float bon = wave_sum(r_ * kd_ * crk);
            if (lane == 0) STG(float, F.ws, WS_SB + ((dir * M + tok) * 8 + h) * 4) = bon;
            if (dir == 0) STG(float, F.ws, WS_SV + (tok * 384 + cch) * 4) = v_;
            lwv[pp] = lw; kkv[pp] = kk_; btv[pp] = kk_ * av; kdv[pp] = kd_; rv[pp] = r_; vv[pp] = v_; g += lw;
        }
        g = 0.f;
        for (int wq = 0; wq < w; ++wq) { float t8[8];
#pragma unroll
            for (int e = 0; e < 8; ++e) t8[e] = *(const LAS float*)(lds + L_A1 + (8 * wq + e) * RPF + lane * 4);
            g += ((t8[0] + t8[1]) + (t8[2] + t8[3])) + ((t8[4] + t8[5]) + (t8[6] + t8[7])); }
        unsigned vt[4], kkt[4], btt[4]; float e_pos = __expf(g);
#pragma unroll
        for (int pp = 0; pp < 8; ++pp) {
            const int p = 8 * w + pp;
            const float e_prev = e_pos; g += lwv[pp]; e_pos = __expf(g); const float e_neg = __expf(-g);
            const unsigned pk_kr = pk2(kkv[pp] * e_prev, rv[pp] * e_pos), pk_bk = pk2(btv[pp] * e_neg, kdv[pp] * e_neg), pk_v = pk2(vv[pp], 0.f);
            *(LAS bf16_t*)(lds + L_KT + p * RPB + lane * 2) = (bf16_t)(pk_kr & 0xffff); *(LAS bf16_t*)(lds + L_RT + p * RPB + lane * 2) = (bf16_t)(pk_kr >> 16);
            *(LAS bf16_t*)(lds + L_BT + p * RPB + lane * 2) = (bf16_t)(pk_bk & 0xffff); *(LAS bf16_t*)(lds + L_KK + p * RPB + lane * 2) = (bf16_t)(pk_bk >> 16);
            if (pp & 1) { vt[pp >> 1] |= pk_v << 16; kkt[pp >> 1] |= pk_bk & 0xffff0000u; btt[pp >> 1] |= pk_bk << 16; }
            else { vt[pp >> 1] = pk_v & 0xffff; kkt[pp >> 1] = pk_bk >> 16; btt[pp >> 1] = pk_bk & 0xffff; }
        }
        *(LAS u32x4*)(lds + L_VT + lane * RPB + 16 * w) = (u32x4){vt[0], vt[1], vt[2], vt[3]};
        *(LAS u32x4*)(lds + L_KKT + lane * RPB + 16 * w) = (u32x4){kkt[0], kkt[1], kkt[2], kkt[3]};
        *(LAS u32x4*)(lds + L_BTT + lane * RPB + 16 * w) = (u32x4){btt[0], btt[1], btt[2], btt[3]};
        if (w == 7) *(LAS float*)(lds + L_GC + lane * 4) = e_pos;
    }
    lds_barrier();
    f32x16 keep[2]; bf16x8 x4f[2][2];
    if (role == 0) {
        for (int sb = 0; sb <= tb; ++sb) { const f32x16 x = gram_tile(lds, L_BT, L_KT, sb, tb, r32, hi, true);
            if (sb == tb) {
#pragma unroll
                for (int r = 0; r < 16; ++r) *(LAS float*)(lds + L_A1 + tb * 4608 + ((r & 3) + 8 * (r >> 2) + 4 * hi) * 144 + r32 * 4) = -x[r];
            } else {
#pragma unroll
                for (int g4 = 0; g4 < 4; ++g4) *(LAS f32x4*)(lds + L_A1 + 9216 + r32 * 144 + (8 * g4 + 4 * hi) * 4) = (f32x4){x[4 * g4], x[4 * g4 + 1], x[4 * g4 + 2], x[4 * g4 + 3]};
            } }
    } else if (role == 1) {
        f32x16 o[2] = {};
        for (int sb = 0; sb <= tb; ++sb) {
            const f32x16 x = gram_tile(lds, L_KK, L_KT, sb, tb, r32, hi, true);
#pragma unroll
            for (int ks = 0; ks < 2; ++ks) { const bf16x8 a = acc_frag(x, ks, 1.f);
#pragma unroll
                for (int ib = 0; ib < 2; ++ib) o[ib] = MFMA32(a, lds_frag_perm(lds + L_VT, 32 * ib + r32, 32 * sb + 16 * ks, hi), o[ib]); }
        }
#pragma unroll
        for (int ib = 0; ib < 2; ++ib)
#pragma unroll
            for (int r = 0; r < 16; ++r) *(LAS float*)(lds + L_RHS2 + (32 * tb + (r & 3) + 8 * (r >> 2) + 4 * hi) * RPF + (32 * ib + r32) * 4) = o[ib][r];
    } else if (role == 2) {
#pragma unroll
        for (int sb = 0; sb < 2; ++sb) { x4f[sb][0] = (bf16x8){}; x4f[sb][1] = (bf16x8){}; }
        keep[0] = (f32x16){}; keep[1] = (f32x16){};
        for (int sb = 0; sb <= tb; ++sb) {
            const f32x16 x3 = gram_tile(lds, L_KK, L_RT, sb, tb, r32, hi, false), x4 = gram_tile(lds, L_BT, L_RT, sb, tb, r32, hi, false);
#pragma unroll
            for (int ks = 0; ks < 2; ++ks) { const bf16x8 a3 = acc_frag(x3, ks, 1.f); const bf16x8 a4 = acc_frag(x4, ks, -1.f);
                if (sb == 0) x4f[0][ks] = a4; else x4f[1][ks] = a4;
#pragma unroll
                for (int cb = 0; cb < 2; ++cb) keep[cb] = MFMA32(a3, lds_frag_perm(lds + L_VT, 32 * cb + r32, 32 * sb + 16 * ks, hi), keep[cb]); }
        }
    } else {
        keep[0] = (f32x16){}; keep[1] = (f32x16){};
#pragma unroll
        for (int ks = 0; ks < 4; ++ks) { const bf16x8 ak = lds_frag_nat(lds + L_KKT, 32 * tb + r32, ks, hi);
#pragma unroll
            for (int cb = 0; cb < 2; ++cb) keep[cb] = MFMA32(ak, lds_frag_nat(lds + L_VT, 32 * cb + r32, ks, hi), keep[cb]); }
    }
    lds_barrier();
    if (w < 2) {
        const LAS unsigned char* a1p = lds + L_A1; asm volatile("" : "+v"(a1p));
        LAS unsigned char* xp = lds + (w == 0 ? L_X0 : L_RHS2) + lane * 4; asm volatile("" : "+v"(xp));
        const LAS unsigned char* kp = lds + L_KT + lane * 2; asm volatile("" : "+v"(kp));
        LAS unsigned char* dst = lds + (w == 0 ? L_WT : L_U0T) + lane * RPB; asm volatile("" : "+v"(dst));
#pragma unroll
        for (int B = 0; B < 2; ++B) {
            float acc[32];
            if (w == 0 && B == 0) {
#pragma unroll
                for (int r = 0; r < 32; ++r) acc[r] = bf_lo((unsigned)*(const LAS bf16_t*)(kp + r * RPB));
            } else {
#pragma unroll
                for (int r = 0; r < 32; ++r) acc[r] = *(const LAS float*)(xp + (32 * B + r) * RPF);
            }
            f32x2 ac2[16];
#pragma unroll
            for (int k = 0; k < 16; ++k) ac2[k] = (f32x2){acc[2 * k], acc[2 * k + 1]};
            f32x4 ca[8], cn[8];
#pragma unroll
            for (int tg = 0; tg < 8; ++tg) ca[tg] = *(const LAS f32x4*)(a1p + B * 4608 + tg * 16);
#pragma unroll
            for (int s_ = 0; s_ < 31; ++s_) {
                if (s_ + 1 < 31) {
#pragma unroll
                    for (int tg = (s_ + 2) / 4; tg < 8; ++tg) cn[tg] = *(const LAS f32x4*)(a1p + B * 4608 + (s_ + 1) * 144 + tg * 16);
                }
                __builtin_amdgcn_sched_barrier(0);
                const float xs = ac2[s_ >> 1][s_ & 1];
                const f32x2 xs2 = {xs, xs};
#pragma unroll
                for (int tg = (s_ + 1) / 4; tg < 8; ++tg) {
                    ac2[2 * tg] = __builtin_elementwise_fma((f32x2){ca[tg][0], ca[tg][1]}, xs2, ac2[2 * tg]);
                    ac2[2 * tg + 1] = __builtin_elementwise_fma((f32x2){ca[tg][2], ca[tg][3]}, xs2, ac2[2 * tg + 1]); }
                __builtin_amdgcn_sched_barrier(0);
#pragma unroll
                for (int tg = 0; tg < 8; ++tg) ca[tg] = cn[tg];
            }
#pragma unroll
            for (int k = 0; k < 16; ++k) { acc[2 * k] = ac2[k][0]; acc[2 * k + 1] = ac2[k][1]; }
#pragma unroll
            for (int k8 = 0; k8 < 4; ++k8) { u32x4 v; v.x = pk2(acc[8 * k8], acc[8 * k8 + 1]); v.y = pk2(acc[8 * k8 + 2], acc[8 * k8 + 3]); v.z = pk2(acc[8 * k8 + 4], acc[8 * k8 + 5]); v.w = pk2(acc[8 * k8 + 6], acc[8 * k8 + 7]);
                *(LAS u32x4*)(dst + 64 * B + 16 * k8) = v; }
            if (B == 0) {
                asm volatile("s_waitcnt lgkmcnt(0)" ::: "memory");
                f32x16 u[2];
#pragma unroll
                for (int cb = 0; cb < 2; ++cb)
#pragma unroll
                    for (int r = 0; r < 16; ++r) { const int t = 32 + (r & 3) + 8 * (r >> 2) + 4 * hi;
                        u[cb][r] = w == 0 ? bf_lo((unsigned)*(const LAS bf16_t*)(lds + L_KT + t * RPB + (32 * cb + r32) * 2)) : *(const LAS float*)(lds + L_RHS2 + t * RPF + (32 * cb + r32) * 4); }
#pragma unroll
                for (int ks = 0; ks < 2; ++ks) { const f32x4 a0 = *(const LAS f32x4*)(lds + L_A1 + 9216 + r32 * 144 + (16 * ks + 8 * hi) * 4), a1 = *(const LAS f32x4*)(lds + L_A1 + 9216 + r32 * 144 + (16 * ks + 8 * hi + 4) * 4);
                    u32x4 aw; aw.x = pk2(-a0[0], -a0[1]); aw.y = pk2(-a0[2], -a0[3]); aw.z = pk2(-a1[0], -a1[1]); aw.w = pk2(-a1[2], -a1[3]);
#pragma unroll
                    for (int cb = 0; cb < 2; ++cb) u[cb] = MFMA32(__builtin_bit_cast(bf16x8, aw), lds_frag_nat(lds + (w == 0 ? L_WT : L_U0T), 32 * cb + r32, ks, hi), u[cb]); }
#pragma unroll
                for (int cb = 0; cb < 2; ++cb)
#pragma unroll
                    for (int r = 0; r < 16; ++r) *(LAS float*)(lds + (w == 0 ? L_X0 : L_RHS2) + (32 + (r & 3) + 8 * (r >> 2) + 4 * hi) * RPF + (32 * cb + r32) * 4) = u[cb][r];
                asm volatile("s_waitcnt lgkmcnt(0)" ::: "memory");
            }
        }
    }
    lds_barrier();
    if (role == 2) {
        f32x16 pj[2];
#pragma unroll
        for (int jb = 0; jb < 2; ++jb)
#pragma unroll
            for (int r = 0; r < 16; ++r) pj[jb][r] = bf_lo((unsigned)*(const LAS bf16_t*)(lds + L_RT + (32 * tb + (r & 3) + 8 * (r >> 2) + 4 * hi) * RPB + (32 * jb + r32) * 2));
#pragma unroll
        for (int sb = 0; sb < 2; ++sb)
#pragma unroll
            for (int ks = 0; ks < 2; ++ks)
#pragma unroll
                for (int cb = 0; cb < 2; ++cb) {
                    keep[cb] = MFMA32(x4f[sb][ks], lds_frag_perm(lds + L_U0T, 32 * cb + r32, 32 * sb + 16 * ks, hi), keep[cb]);
                    pj[cb] = MFMA32(x4f[sb][ks], lds_frag_perm(lds + L_WT, 32 * cb + r32, 32 * sb + 16 * ks, hi), pj[cb]); }
        f32x16 (&y0)[2] = keep;
        const unsigned yb = dir ? WS_YB : WS_YF;
#pragma unroll
        for (int r = 0; r < 16; ++r) { const int t = 32 * tb + (r & 3) + 8 * (r >> 2) + 4 * hi; const unsigned tok = seq0 + (dir ? T - 1 - (q0 + t) : q0 + t);
#pragma unroll
            for (int cb = 0; cb < 2; ++cb) { STG(float, F.ws, yb + (tok * 384 + h * 64 + 32 * cb + r32) * 4) = y0[cb][r];
                STG(bf16_t, F.ws, WS_RP + (((unsigned)cid * 64 + t) * 64 + 32 * cb + r32) * 2) = (bf16_t)(pk2(pj[cb][r], 0.f) & 0xffff); } }
    } else if (role == 3) {
        const int jb = tb;
        f32x16 q1[2] = {}, q2[2] = {}; f32x16 (&n1)[2] = keep;
#pragma unroll
        for (int ks = 0; ks < 4; ++ks) { const bf16x8 a = lds_frag_nat(lds + L_BTT, 32 * jb + r32, ks, hi);
#pragma unroll
            for (int cb = 0; cb < 2; ++cb) { q1[cb] = MFMA32(lds_frag_nat(lds + L_WT, 32 * cb + r32, ks, hi), a, q1[cb]); q2[cb] = MFMA32(a, lds_frag_nat(lds + L_U0T, 32 * cb + r32, ks, hi), q2[cb]); } }
#pragma unroll
        for (int q = 0; q < 4; ++q) { f32x4 gc4;
#pragma unroll
            for (int e = 0; e < 4; ++e) gc4[e] = *(const LAS float*)(lds + L_GC + (32 * jb + e + 8 * q + 4 * hi) * 4);
#pragma unroll
            for (int cb = 0; cb < 2; ++cb) { f32x4 nv;
#pragma unroll
                for (int e = 0; e < 4; ++e) nv[e] = gc4[e] * (n1[cb][4 * q + e] - q2[cb][4 * q + e]);
                STG(f32x4, F.ws, WS_RN + ((((unsigned)cid * 2 + jb) * 2 + cb) * 4 + q) * 1024 + lane * 16) = nv; } }
        { const float gl = *(const LAS float*)(lds + L_GC + (32 * jb + r32) * 4);
#pragma unroll
          for (int cb = 0; cb < 2; ++cb)
#pragma unroll
            for (int s2 = 0; s2 < 2; ++s2) { float mv[8];
#pragma unroll
                for (int e = 0; e < 8; ++e) { const int r = 8 * s2 + e; const unsigned c = 32 * cb + (r & 3) + 8 * (r >> 2) + 4 * hi; mv[e] = (c == 32 * jb + r32 ? gl : 0.f) - gl * q1[cb][r]; }
                u32x4 w; w.x = pk2(mv[0], mv[1]); w.y = pk2(mv[2], mv[3]); w.z = pk2(mv[4], mv[5]); w.w = pk2(mv[6], mv[7]);
                STG(u32x4, F.ws, WS_RM + (unsigned)cid * 8192 + ((jb * 2 + cb) * 2 + s2) * 1024 + lane * 16) = w; } }
    }
    lds_barrier();
}
__device__ __forceinline__ void rwkv_chain_wave(Frame& F, int l, bool lat, int chain, int ib) {
    int lane = F.lane; asm volatile("" : "+v"(lane));
    const unsigned char* ws = F.ws; const unsigned r32 = lane & 31, hi = lane >> 5;
    const unsigned dir = chain & 1, h = (chain >> 1) % 6, b = chain / 12;
    const int nc = lat ? 64 : 4; const unsigned cid0 = lat ? 768 + chain * 64 : chain * 4;
    const unsigned i = 32 * ib + r32;
    const unsigned so = ((((b * 4 + l) * 6 + h) * 64 + i) * 64) * 4;
    f32x16 H[2];
#pragma unroll
    for (int jb = 0; jb < 2; ++jb)
#pragma unroll
        for (int g4 = 0; g4 < 4; ++g4) { f32x4 v = {0.f, 0.f, 0.f, 0.f}; if (lat) v = LDG(f32x4, dir ? INP(7) : INP(6), so + (32 * jb + 8 * g4 + 4 * hi) * 4);
            H[jb][4 * g4] = v[0]; H[jb][4 * g4 + 1] = v[1]; H[jb][4 * g4 + 2] = v[2]; H[jb][4 * g4 + 3] = v[3]; }
    bf16x8 maA[2][2][2], maB[2][2][2]; f32x16 ntA[2], ntB[2];
    const GAS unsigned char* pm = (const GAS unsigned char*)ws + (WS_RM + cid0 * 8192 + lane * 16);
    const GAS unsigned char* pn = (const GAS unsigned char*)ws + (WS_RN + (cid0 * 4 + ib) * 4096 + lane * 16);
#define RB_LOAD(ma, nt, k_) do { \
        _Pragma("unroll") for (int jo = 0; jo < 2; ++jo) _Pragma("unroll") for (int ji = 0; ji < 2; ++ji) _Pragma("unroll") for (int ks = 0; ks < 2; ++ks) ma[jo][ji][ks] = *(const GAS bf16x8*)(pm + ((k_) * 8192 + ((jo * 2 + ji) * 2 + ks) * 1024)); \
        _Pragma("unroll") for (int jo = 0; jo < 2; ++jo) _Pragma("unroll") for (int q = 0; q < 4; ++q) { const f32x4 t_ = *(const GAS f32x4*)(pn + ((k_) * 16384 + (jo * 8 + q) * 1024)); \
            nt[jo][4 * q] = t_[0]; nt[jo][4 * q + 1] = t_[1]; nt[jo][4 * q + 2] = t_[2]; nt[jo][4 * q + 3] = t_[3]; } } while (0)
#define RB_STEP(ma, nt, cid_) do { \
        bf16x8 hf[2][2]; \
        _Pragma("unroll") for (int ji = 0; ji < 2; ++ji) { hf[ji][0] = acc_frag(H[ji], 0, 1.f); hf[ji][1] = acc_frag(H[ji], 1, 1.f); } \
        _Pragma("unroll") for (int ji = 0; ji < 2; ++ji) _Pragma("unroll") for (int ks = 0; ks < 2; ++ks) STG(bf16x8, F.ws, WS_RH + (cid_) * 8192 + ((ib * 2 + ji) * 2 + ks) * 1024 + lane * 16) = hf[ji][ks]; \
        f32x16 acc[2] = {nt[0], nt[1]}; \
        _Pragma("unroll") for (int jo = 0; jo < 2; ++jo) _Pragma("unroll") for (int ji = 0; ji < 2; ++ji) _Pragma("unroll") for (int ks = 0; ks < 2; ++ks) acc[jo] = MFMA32(ma[jo][ji][ks], hf[ji][ks], acc[jo]); \
        H[0] = acc[0]; H[1] = acc[1]; } while (0)
    RB_LOAD(maA, ntA, 0); RB_LOAD(maB, ntB, 1);
#pragma unroll 1
    for (int c = 0; c < nc; c += 2) {
        const unsigned cid = cid0 + c;
        RB_STEP(maA, ntA, cid);
        if (c + 2 < nc) RB_LOAD(maA, ntA, 2);
        RB_STEP(maB, ntB, cid + 1);
        if (c + 2 < nc) RB_LOAD(maB, ntB, 3);
        pm += 16384; pn += 32768;
    }
#undef RB_LOAD
#undef RB_STEP
    if (!lat) {
#pragma unroll
        for (int jb = 0; jb < 2; ++jb)
#pragma unroll
            for (int g4 = 0; g4 < 4; ++g4) STG(f32x4, F.out, (dir ? OFF_CB : OFF_CF) * 4 + so + (32 * jb + 8 * g4 + 4 * hi) * 4) = (f32x4){H[jb][4 * g4], H[jb][4 * g4 + 1], H[jb][4 * g4 + 2], H[jb][4 * g4 + 3]};
    }
}
__device__ __forceinline__ void rwkv_apply_wave(Frame& F, int item) {
    int lane = F.lane; asm volatile("" : "+v"(lane));
    const unsigned char* ws = F.ws; const unsigned r32 = lane & 31, hi = lane >> 5;
    const int cid = item >> 1, tb = item & 1;
    unsigned seq0, b, h, dir; int T, c; chunk_decode(cid, seq0, T, b, h, dir, c);
    const unsigned yb = dir ? WS_YB : WS_YF;
    f32x16 acc[2];
#pragma unroll
    for (int r = 0; r < 16; ++r) { const int t = 32 * tb + (r & 3) + 8 * (r >> 2) + 4 * hi; const unsigned tok = seq0 + (dir ? T - 1 - (64 * c + t) : 64 * c + t);
        acc[0][r] = LDG(float, ws, yb + (tok * 384 + h * 64 + r32) * 4); acc[1][r] = LDG(float, ws, yb + (tok * 384 + h * 64 + 32 + r32) * 4); }
#pragma unroll
    for (int ks = 0; ks < 4; ++ks) { const bf16x8 a = LDG(bf16x8, ws, WS_RP + (((unsigned)cid * 64 + 32 * tb + r32) * 64 + 16 * ks + 8 * hi) * 2);
#pragma unroll
        for (int ib = 0; ib < 2; ++ib) acc[ib] = MFMA32(a, LDG(bf16x8, ws, WS_RH + (((unsigned)cid * 64 + 32 * ib + r32) * 64 + 16 * ks + 8 * hi) * 2), acc[ib]); }
#pragma unroll
    for (int r = 0; r < 16; ++r) { const int t = 32 * tb + (r & 3) + 8 * (r >> 2) + 4 * hi; const unsigned tok = seq0 + (dir ? T - 1 - (64 * c + t) : 64 * c + t);
        STG(float, F.ws, yb + (tok * 384 + h * 64 + r32) * 4) = acc[0][r]; STG(float, F.ws, yb + (tok * 384 + h * 64 + 32 + r32) * 4) = acc[1][r]; }
}

__device__ __forceinline__ void rwkv_out_item(Frame& F, int l, int item) {
    int lane = F.lane; asm volatile("" : "+v"(lane));
    const unsigned char* ws = F.ws; const unsigned r32 = lane & 31, hi = lane >> 5;
    const int tb = item & 1, h = (item >> 1) % 6, sk = item / 12;
    const bool lat = sk >= 64; const int b = lat ? (sk - 64) >> 6 : sk >> 2, k = lat ? (sk - 64) & 63 : sk & 3, nc = lat ? 64 : 4;
    const unsigned seq0 = lat ? MC + b * 4096 : b * 256, base = lat ? 768u : 0u;
    const unsigned chf = (b * 6 + h) * 2, cidf = base + chf * nc + k, cidb = base + (chf + 1) * nc + (nc - 1 - k);
    const unsigned tok0 = seq0 + 64 * k + 32 * tb;
    f32x16 acc[2];
#pragma unroll
    for (int r = 0; r < 16; ++r) { const unsigned tok = tok0 + (r & 3) + 8 * (r >> 2) + 4 * hi; const unsigned e = (tok * 384 + h * 64 + r32) * 4;
        acc[0][r] = LDG(float, ws, WS_YF + e) + LDG(float, ws, WS_YB + e); acc[1][r] = LDG(float, ws, WS_YF + e + 128) + LDG(float, ws, WS_YB + e + 128); }
    const unsigned pf = 32 * tb + r32, pb_ = 63 - 32 * tb - r32;
#pragma unroll
    for (int ks = 0; ks < 4; ++ks) {
        const s16x4 f0 = LDG(s16x4, ws, WS_RP + ((cidf * 64 + pf) * 64 + 16 * ks + 4 * hi) * 2), f1 = LDG(s16x4, ws, WS_RP + ((cidf * 64 + pf) * 64 + 16 * ks + 8 + 4 * hi) * 2);
        const s16x4 b0_ = LDG(s16x4, ws, WS_RP + ((cidb * 64 + pb_) * 64 + 16 * ks + 4 * hi) * 2), b1_ = LDG(s16x4, ws, WS_RP + ((cidb * 64 + pb_) * 64 + 16 * ks + 8 + 4 * hi) * 2);
        const bf16x8 af = {f0[0], f0[1], f0[2], f0[3], f1[0], f1[1], f1[2], f1[3]}, ab = {b0_[0], b0_[1], b0_[2], b0_[3], b1_[0], b1_[1], b1_[2], b1_[3]};
#pragma unroll
        for (int ib = 0; ib < 2; ++ib) { acc[ib] = MFMA32(af, LDG(bf16x8, ws, WS_RH + cidf * 8192 + (ib * 4 + ks) * 1024 + lane * 16), acc[ib]);
            acc[ib] = MFMA32(ab, LDG(bf16x8, ws, WS_RH + cidb * 8192 + (ib * 4 + ks) * 1024 + lane * 16), acc[ib]); } }
    const float g0 = LDG(float, INP(27), (l * 384 + h * 64 + r32) * 4), g1 = LDG(float, INP(27), (l * 384 + h * 64 + 32 + r32) * 4), b0 = LDG(float, INP(28), (l * 384 + h * 64 + r32) * 4), b1 = LDG(float, INP(28), (l * 384 + h * 64 + 32 + r32) * 4);
    const int xl = (lane ^ 16) << 2;
#pragma unroll
    for (int r = 0; r < 16; ++r) { const unsigned tok = tok0 + (r & 3) + 8 * (r >> 2) + 4 * hi; const unsigned e = tok * 384 + h * 64 + r32;
        const float bon = LDG(float, ws, WS_SB + (tok * 8 + h) * 4) + LDG(float, ws, WS_SB + ((M + tok) * 8 + h) * 4);
        const float y0 = acc[0][r] + bon * LDG(float, ws, WS_SV + e * 4), y1 = acc[1][r] + bon * LDG(float, ws, WS_SV + (e + 32) * 4);
        float s = allreduce16(y0 + y1); s += __builtin_bit_cast(float, __builtin_amdgcn_ds_bpermute(xl, __builtin_bit_cast(int, s)));
        const float mu = s * (1.f / 64.f), d0 = y0 - mu, d1 = y1 - mu;
        float q = allreduce16(d0 * d0 + d1 * d1); q += __builtin_bit_cast(float, __builtin_amdgcn_ds_bpermute(xl, __builtin_bit_cast(int, q)));
        const float rs = rsqrtf(q * (1.f / 64.f) + 64e-5f);
        const float o0 = (d0 * rs * g0 + b0) * bf_lo((unsigned)LDG(bf16_t, ws, WS_G + e * 2)), o1 = (d1 * rs * g1 + b1) * bf_lo((unsigned)LDG(bf16_t, ws, WS_G + (e + 32) * 2));
        const unsigned pk = pk2(o0, o1);
        STG(bf16_t, F.ws, WS_ACT + (tok * DM + 640 + h * 64 + r32) * 2) = (bf16_t)(pk & 0xffff); STG(bf16_t, F.ws, WS_ACT + (tok * DM + 640 + h * 64 + 32 + r32) * 2) = (bf16_t)(pk >> 16); }
}

#ifndef B_UNIT
#define B_UNIT 0
#endif
constexpr int AU_R = 8, AU_D = 4, AU_SLOT = 6144;
__device__ __forceinline__ void attn_b_unit(Frame& F, int l, int unit) {
    int lane = F.lane; asm volatile("" : "+v"(lane));
    const unsigned char* ws = F.ws; LAS unsigned char* lds = F.lds;
    const int w = F.wave; const unsigned r32 = lane & 31, hi = lane >> 5;
    const unsigned kh = unit & 1, qb = (unit >> 1) & 15, mp = (unit >> 5) & 1, h = (unit >> 6) & 3, b = unit >> 8;
    const unsigned seq0 = MC + b * 4096, row = seq0 + qb * 256 + 32 * w + r32;
    bf16x8 qf[1][2];
#pragma unroll
    for (int s = 0; s < 2; ++s) qf[0][s] = LDG(bf16x8, ws, WS_QB + (row * 256 + h * 64 + mp * 32 + 8 * hi) * 2 + 32 * s);
    AttnQ st[1]; attnq_init(st[0], 0.f);
    const int qpos[1] = {0};
    const int n0 = kh ? 56 : 72, nt = 72;
    const unsigned pofs = (w < 2 ? (h * 2 + mp) * 2048 + w * 1024 : h * 4096 + (w - 2) * 1024) + lane * 16;
    const unsigned base0 = (w < 2 ? WS_KB : WS_VTB) + ((seq0 >> 5) + (kh ? 72u : 0u)) * 16384 + pofs;
    const unsigned base1 = WS_CACHE + (w < 2 ? 2 * MiB : 4 * MiB) + (b * 4 + l) * 262144 + pofs;
#define AU_DMA(t_) do { const int tt_ = (t_) < nt ? (t_) : nt - 1; const unsigned src_ = tt_ < n0 ? base0 + tt_ * 16384 : base1 + (tt_ - n0) * 16384; \
        __builtin_amdgcn_global_load_lds((const GAS unsigned*)(ws + src_), (LAS unsigned*)(lds + ((t_) % AU_R) * AU_SLOT + w * 1024), 16, 0, 0); } while (0)
    if (w < 6) {
#pragma unroll
        for (int t = 0; t < AU_D; ++t) AU_DMA(t);
    }
    for (int t = 0; t < nt; ++t) {
        if (w < 6) asm volatile("s_waitcnt vmcnt(3)" ::: "memory");
        asm volatile("s_barrier" ::: "memory");
        const LAS unsigned char* sl = lds + (t % AU_R) * AU_SLOT + lane * 16;
        bf16x8 kf[2], vf[4];
        kf[0] = *(const LAS bf16x8*)(sl); kf[1] = *(const LAS bf16x8*)(sl + 1024);
#pragma unroll
        for (int f = 0; f < 4; ++f) vf[f] = *(const LAS bf16x8*)(sl + 2048 + 1024 * f);
        if (w < 6) AU_DMA(t + AU_D);
        attn_block<32, false, 1>(qf, kf, vf, st, t, qpos, 0, hi);
    }
#undef AU_DMA
    asm volatile("s_waitcnt vmcnt(0) lgkmcnt(0)\n\ts_barrier" ::: "memory");
    attn_b_store(F, st[0], mp, kh, row, h, hi);
}

constexpr int Q_BLAT = 2048, Q_ALAT = 1536, Q_BCTX = 1024, Q_ACTX = 768;
constexpr int Q_TOTAL = Q_BLAT + Q_ALAT + Q_BCTX + Q_ACTX;
#ifndef XCD_DEAL
#define XCD_DEAL 1
#endif
__device__ __forceinline__ void phase_mixer(Frame& F, int l, int rep) {
    if (rep == 0 || REP_PART == 0 || REP_PART == 1) {
        const int si = F.bid + F.G * F.wave;
        if (si < 48) rwkv_chain_wave(F, l, true, si >> 1, si & 1);
        else if (si < 48 + 384) rwkv_chain_wave(F, l, false, (si - 48) >> 1, (si - 48) & 1);
    }
    if (B_UNIT && (rep == 0 || REP_PART == 2 || REP_PART == 4)) {
        unsigned* uctr = (unsigned*)(F.ws + WS_CTL) + 64 * (32 + l + 4 * rep);
        LAS int* ubox = (LAS int*)(F.lds + 65536);
        for (;;) {
            if (F.wave == 0 && F.lane == 0) *ubox = (int)atomicAdd(uctr, 1u);
            lds_barrier();
            const int un = __builtin_amdgcn_readfirstlane(*ubox);
            lds_barrier();
            if (un >= 512) break;
            attn_b_unit(F, l, un);
        }
    }
    unsigned* ctr = (unsigned*)(F.ws + WS_CTL) + 64 * (1 + l + 4 * rep);
    const bool xdeal = XCD_DEAL && !B_UNIT && F.G == 256;
    if (xdeal && (rep == 0 || REP_PART == 2 || REP_PART == 4)) attn_b_item(F, l, true, (F.bid & 7) * 256 + (F.bid >> 3) * 8 + F.wave);
    if (rep == 0 || REP_PART != 1) for (;;) {
        int it = 0;
        if (F.lane == 0) it = (int)atomicAdd(ctr, 1u);
        it = __builtin_amdgcn_readfirstlane(it) + ((B_UNIT || xdeal) ? Q_BLAT : 0);
        if (it >= Q_TOTAL) break;
        if (it < Q_BLAT) { if (rep == 0 || REP_PART == 2 || REP_PART == 4) attn_b_item(F, l, true, it); continue; } it -= Q_BLAT;
        if (it < Q_ALAT) { if (rep == 0 || REP_PART == 2 || REP_PART == 3) attn_a_item(F, l, true, it); continue; } it -= Q_ALAT;
        if (it < Q_BCTX) { if (rep == 0 || REP_PART == 2 || REP_PART == 5) attn_b_item(F, l, false, it); continue; } it -= Q_BCTX;
        if (rep == 0 || REP_PART == 2 || REP_PART == 5) attn_a_item(F, l, false, it);
    }
}

__device__ __forceinline__ void phase_finalize(Frame& F, int l) {
    const unsigned char* ws = F.ws;
    const unsigned lane = F.lane;
    const float lami = 0.8f - 0.6f * __expf(-0.3f * (float)l);
    const float lam = LDG(float, ws, WS_TAB + (TAB_LAM + l) * 4) + lami;
    const float omli = 1.f - lami;
    const float sg = LDG(float, INP(17), (l * 64 + lane) * 4);
    for (unsigned row = F.gw; row < M; row += F.ngw) {
#pragma unroll
        for (int k = 0; k < 4; ++k) { float om[2];
#pragma unroll
            for (int mp = 0; mp < 2; ++mp) { const unsigned o0 = (((mp * 2) * M + row) * 256 + 64 * k + lane) * 2, q0 = ((((mp * 2) * M + row) * 4 + k) * 2) * 4;
                const f32x2 ml0 = LDG(f32x2, ws, WS_ML + q0);
                if (row >= MC) { const f32x2 ml1 = LDG(f32x2, ws, WS_ML + q0 + M * 32); const float ms = fmaxf(ml0[0], ml1[0]), w0 = __builtin_amdgcn_exp2f(ml0[0] - ms), w1 = __builtin_amdgcn_exp2f(ml1[0] - ms);
                    om[mp] = (bf_lo((unsigned)LDG(bf16_t, ws, WS_BO2 + o0)) * w0 + bf_lo((unsigned)LDG(bf16_t, ws, WS_BO2 + o0 + M * 512)) * w1) * __builtin_amdgcn_rcpf(ml0[1] * w0 + ml1[1] * w1); }
                else om[mp] = bf_lo((unsigned)LDG(bf16_t, ws, WS_BO2 + o0)) * __builtin_amdgcn_rcpf(ml0[1]); }
            const float v = om[0] - lam * om[1];
            const float ms = wave_sum(v * v) * (1.f / 64.f);
            STG(bf16_t, F.ws, WS_ACT + (row * DM + 384 + 64 * k + lane) * 2) = (bf16_t)(pk2(v * rsqrtf(ms + 1e-6f) * sg * omli, 0.f) & 0xffff); }
    }
}


typedef unsigned v4u __attribute__((ext_vector_type(4)));
#define XB_TMO      128
#define XB_XCNT(j)  (256  + 64 * (j))
#define XB_XSUB(j)  (1280 + 64 * (j))
#define XB_XGEN(j)  (2304 + 64 * (j))
#define XB_TOP      3328
#define XB_TOPGEN   3392
#define XCD_BAR_WORDS 3456
#define XB_SPIN_CAP (1u << 18)

__device__ __forceinline__ unsigned xb_ld(unsigned* p)              { return __hip_atomic_load(p, __ATOMIC_RELAXED, __HIP_MEMORY_SCOPE_AGENT); }
__device__ __forceinline__ unsigned xb_add(unsigned* p, unsigned v) { return __hip_atomic_fetch_add(p, v, __ATOMIC_RELAXED, __HIP_MEMORY_SCOPE_AGENT); }
__device__ __forceinline__ unsigned xb_xcc_id() { return (unsigned)__builtin_amdgcn_s_getreg((3 << 11) | 20) & 0xFu; }
#define XB_SPIN(cond, bar) do { unsigned _sp = 0; while (cond) { __builtin_amdgcn_s_sleep(1); \
    if ((++_sp & 255u) == 0u) { if (xb_ld(&(bar)[XB_TMO])) break; if (_sp > XB_SPIN_CAP) { atomicAdd(&(bar)[XB_TMO], 1u); break; } } } } while (0)

struct XcdBarrier {
    unsigned* bar; unsigned x;
    volatile LAS unsigned* st;
};

__device__ __forceinline__ XcdBarrier xcd_barrier_post(unsigned* bar, volatile LAS unsigned* st) {
    XcdBarrier b; b.bar = bar; b.x = xb_xcc_id(); b.st = st;
    if (threadIdx.x == 0) (void)xb_add(&bar[XB_XCNT(b.x)], 1u);
    return b;
}
__device__ __forceinline__ void xcd_barrier_complete(unsigned* bar, unsigned x, unsigned& nloc, unsigned& nx) {
    const unsigned G = gridDim.x * gridDim.y * gridDim.z;
    unsigned sum, cnt, mine, sp = 0u;
    for (;;) {
        sum = 0u; cnt = 0u; mine = 0u;
#pragma unroll
        for (unsigned j = 0; j < 16; ++j) { const unsigned c = xb_ld(&bar[XB_XCNT(j)]); sum += c; cnt += (c > 0u) ? 1u : 0u; mine = (j == x) ? c : mine; }
        if (sum == G) break;
        __builtin_amdgcn_s_sleep(1);
        if ((++sp & 255u) == 0u) { if (xb_ld(&bar[XB_TMO])) break; if (sp > XB_SPIN_CAP) { atomicAdd(&bar[XB_TMO], 1u); break; } }
    }
    nloc = mine > 0u ? mine : 1u; nx = cnt > 0u ? cnt : 1u;
}

__device__ __forceinline__ void xcd_barrier(const XcdBarrier& b) {
    asm volatile("s_waitcnt vmcnt(0)" ::: "memory");
    __syncthreads();
    if (threadIdx.x == 0) {
        unsigned* bar = b.bar;
        __builtin_amdgcn_s_waitcnt(0);
        unsigned nloc = b.st[0], nx = b.st[1];
        if (nloc == 0u) { xcd_barrier_complete(bar, b.x, nloc, nx); b.st[0] = nloc; b.st[1] = nx; }
        const unsigned old = xb_add(&bar[XB_XSUB(b.x)], 1u);
        const unsigned gen = old / nloc;
        if (old + 1u == (gen + 1u) * nloc) {
            __builtin_amdgcn_fence(__ATOMIC_RELEASE, "agent");
            asm volatile("s_waitcnt vmcnt(0)" ::: "memory");
            const unsigned og = xb_add(&bar[XB_TOP], 1u);
            const unsigned tg = og / nx;
            if (og + 1u == (tg + 1u) * nx) xb_add(&bar[XB_TOPGEN], 1u);
            else XB_SPIN(xb_ld(&bar[XB_TOPGEN]) == tg, bar);
            __builtin_amdgcn_fence(__ATOMIC_ACQUIRE, "agent");
            xb_add(&bar[XB_XGEN(b.x)], 1u);
            asm volatile("s_waitcnt vmcnt(0)" ::: "memory");
        } else {
            XB_SPIN(xb_ld(&bar[XB_XGEN(b.x)]) == gen, bar);
            __builtin_amdgcn_fence(__ATOMIC_ACQUIRE, "agent");
            asm volatile("s_waitcnt vmcnt(0)" ::: "memory");
        }
    }
    __syncthreads();
}

#ifndef DIS
#define DIS 0
#endif
#ifndef GEMM_MF
#define GEMM_MF 7
#endif
#ifndef REP_PHASE
#define REP_PHASE -1
#define REP_COUNT 1
#endif
constexpr int NEXTRA = (REP_PHASE >= 0 && REP_PHASE < 9) ? REP_COUNT - 1 : 0, NPL = 9 + NEXTRA, NPRE = (REP_PHASE == 100) ? REP_COUNT : 1, NPHASE_RUN = NPRE + 1 + NPL * DEPTH;
__global__ void __launch_bounds__(512, 2) mega(Args a) {
    extern __shared__ __attribute__((aligned(16))) unsigned char lds[];
    Frame F;
    F.lds = (LAS unsigned char*)lds;
    volatile LAS unsigned* bst = (volatile LAS unsigned*)(F.lds + LDS_BYTES - 64);
    if (threadIdx.x < 2) bst[threadIdx.x] = 0u;
    __syncthreads();
    const XcdBarrier xbar = xcd_barrier_post((unsigned*)((GAS unsigned char*)a.ws + WS_CTL) + 4096, bst);
    const int wave_id = __builtin_amdgcn_readfirstlane((int)threadIdx.x >> 6);
    for (int ph = a.ph_lo; ph < a.ph_hi; ++ph) {
        { const unsigned char* kp = (const unsigned char*)__builtin_amdgcn_kernarg_segment_ptr(); asm volatile("" : "+s"(kp));
          const Args* ap = (const Args*)kp; F.in = ap->in; F.out = gptr(ap->out); F.ws = gptr(ap->ws); }
        { unsigned ones = ~0u; asm volatile("" : "+s"(ones)); int ln = (int)__builtin_amdgcn_mbcnt_hi(ones, __builtin_amdgcn_mbcnt_lo(ones, 0u)); int wv = wave_id, bid = (int)blockIdx.x, gg = (int)gridDim.x; asm volatile("" : "+s"(wv), "+s"(bid), "+s"(gg));
          F.lane = ln; F.wave = wv; F.bid = bid; F.G = gg; F.ngw = gg * 8; F.tid = wv * 64 + ln; F.gw = bid * 8 + wv; }
        if (ph < NPRE) { if (!(DIS & 1)) phase_prologue(F); }
        else if (ph == NPHASE_RUN - 1) { if (!(DIS & 2)) phase_final_norm(F); }
        else {
            const int l = (ph - NPRE) / NPL, sidx = (ph - NPRE) % NPL, rep = (REP_PHASE >= 0 && REP_PHASE < 9 && sidx > REP_PHASE && sidx <= REP_PHASE + NEXTRA) ? sidx - REP_PHASE : 0, s = (REP_PHASE >= 0 && REP_PHASE < 9 && sidx > REP_PHASE) ? (sidx <= REP_PHASE + NEXTRA ? REP_PHASE : sidx - NEXTRA) : sidx;
            if (s == 0) { convert_weights(F, l); phase_norm(F, l, 0); }
            else if (s == 1) {
                pg8::Gemm g{WSP(bf16_t, WS_ACT), WSP(bf16_t, WS_WIN + 0u * WSET_STRIDE), M, NIN, 1024}; pg8::StaticOrder S; S.init(M, NIN, F.G, F.bid, (GEMM_MF & 1) ? 192 : 256);
                EpiWin E{F.ws, F.out, l, F.lds + pg8::STAGE_BYTES};
                if (!(DIS & 16)) pg8::gemm_phase<EpiWin, pg8::StaticOrder, false, true, (GEMM_MF & 1) ? 3 : 4>(F.lds, g, S, E, F.tid);
                if (false) { const int wv_ = (F.bid - 64) * 8 + F.wave; convert_item_any(F, l + 1, wv_); if (wv_ < CV_TOTAL - 1536) convert_item_any(F, l + 1, 1536 + wv_); }
            }
            else if (s == 2) { for (int cid = F.bid; cid < NCHUNK; cid += F.G) rwkv_chunk_block(F, l, cid); }
            else if (s == 3) { if (!(DIS & 64)) phase_mixer(F, l, rep); }
            else if (s == 4) { phase_finalize(F, l); for (int it = F.gw; it < 192 * 12; it += F.ngw) rwkv_out_item(F, l, it); }
            else if (s == 5 || s == 8) {
                const bool second = s == 8;
                pg8::Gemm g{second ? WSP(bf16_t, WS_U) : WSP(bf16_t, WS_ACT), second ? WSP(bf16_t, WS_W2 + 0u * WSET_STRIDE) : WSP(bf16_t, WS_WOUT + 0u * WSET_STRIDE), M, 1024, second ? FF : 1024};
                pg8::StaticOrder S; S.init(M, 1024, F.G, F.bid, (GEMM_MF & 2) ? 192 : 256);
                const bool first = (l == 0 && !second);
                EpiRes E{INP(0), INP(1) - (size_t)MC * DM, F.ws, WSP(float, WS_MOD) + (size_t)l * 3 * 6144 + (second ? 5120 : 2048), first};
                if (!(DIS & 256)) pg8::gemm_phase<EpiRes, pg8::StaticOrder, false, true, (GEMM_MF & 2) ? 3 : 4>(F.lds, g, S, E, F.tid);
            }
            else if (s == 6) { if (!(DIS & 8)) phase_norm(F, l, 1); }
            else {
                pg8::Gemm g{WSP(bf16_t, WS_ACT), WSP(bf16_t, WS_W13 + 0u * WSET_STRIDE), M, NFF2, 1024}; pg8::StaticOrder S; S.init(M, NFF2, F.G, F.bid, (GEMM_MF & 4) ? 192 : 256);
                EpiSwi E{WSP(bf16_t, WS_U)};
                if (!(DIS & 512)) pg8::gemm_phase<EpiSwi, pg8::StaticOrder, true, true, (GEMM_MF & 4) ? 3 : 4>(F.lds, g, S, E, F.tid);
            }
        }
        if (ph + 1 < a.ph_hi) { if (ph == a.ph_lo) { __threadfence(); cg::this_grid().sync(); } else xcd_barrier(xbar); }
    }
}

extern "C" void kernel_launch(void* const* d_in, const int* in_sizes, int n_in, void* d_out, int out_size, void* d_ws, size_t ws_size, hipStream_t stream) {
    static int grid = 0;
    if (grid == 0) {
        int dev = 0, cus = 0, per_cu = 0;
        if (n_in != 34 || ws_size < WS_END) { fprintf(stderr, "kernel_launch: unexpected n_in %d / ws_size %zu (need %zu)\n", n_in, ws_size, (size_t)WS_END); grid = -1; return; }
        if (hipGetDevice(&dev) != hipSuccess || hipDeviceGetAttribute(&cus, hipDeviceAttributeMultiprocessorCount, dev) != hipSuccess) { grid = -1; return; }
        if (hipFuncSetAttribute((const void*)mega, hipFuncAttributeMaxDynamicSharedMemorySize, LDS_BYTES) != hipSuccess) { fprintf(stderr, "kernel_launch: hipFuncSetAttribute failed\n"); grid = -1; return; }
        if (hipOccupancyMaxActiveBlocksPerMultiprocessor(&per_cu, (const void*)mega, 512, LDS_BYTES) != hipSuccess || per_cu < 1) { fprintf(stderr, "kernel_launch: occupancy query says %d\n", per_cu); per_cu = 1; }
        (void)hipGetLastError();
        grid = cus * 1;
        if (grid > cus * per_cu) grid = cus * per_cu;
    }
    if (grid < 0) return;
    (void)hipMemsetAsync((char*)d_ws + WS_CTL, 0, CTL_BYTES, stream);
    Args a{};
    for (int i = 0; i < 34; ++i) a.in[i] = (const float*)d_in[i];
    a.out = (float*)d_out; a.ws = (unsigned char*)d_ws;
#if MK_ONE_LAUNCH
    a.ph_lo = 0; a.ph_hi = NPHASE_RUN;
    void* args[] = {&a};
    hipError_t e = hipLaunchCooperativeKernel((const void*)mega, dim3(grid), dim3(512), args, LDS_BYTES, stream);
    if (e != hipSuccess) fprintf(stderr, "kernel_launch: cooperative launch failed: %s (grid %d)\n", hipGetErrorString(e), grid);
#else
    for (int ph = 0; ph < NPHASE_RUN; ++ph) { a.ph_lo = ph; a.ph_hi = ph + 1; hipLaunchKernelGGL(mega, dim3(grid), dim3(512), LDS_BYTES, stream, a); }
#endif
}
```

```cpp
#include <hip/hip_runtime.h>
#include <hip/hip_cooperative_groups.h>
#include <cstdio>
#include <cstdint>
namespace cg = cooperative_groups;

#ifndef MK_ONE_LAUNCH
#define MK_ONE_LAUNCH 1
#endif

#undef MK_ONE_LAUNCH
#define MK_ONE_LAUNCH 1
#define REP_PHASE -1
#define REP_COUNT 1
#define REP_PART 0
#define RA_REP 0
#define ATT_PROBE 0
namespace pg8 {
#define PG8_LAS __attribute__((address_space(3)))
typedef unsigned short bf16_t;
typedef short bf16x8 __attribute__((ext_vector_type(8)));
typedef float f32x4 __attribute__((ext_vector_type(4)));
typedef unsigned u32x4 __attribute__((ext_vector_type(4)));
constexpr int BM = 256, BK = 64, HALF = 128, HTB = HALF * BK * 2  , STAGE_BYTES = 8 * HTB, NXCD = 8, WGM = 8;

__host__ __device__ __forceinline__ int lds_byte(int r, int c) { const int st = (r >> 4) * 2 + (c >> 5), rr = r & 15, cc = c & 31, ob = rr * 64 + cc * 2; return st * 1024 + (ob ^ (((ob >> 9) & 1) << 5)); }
__host__ __device__ __forceinline__ void stage_rc(int b, int& R, int& C) { const int st = b / 1024, sb = b % 1024, swz = sb ^ (((sb >> 9) & 1) << 5); R = (st >> 1) * 16 + swz / 64; C = (st & 1) * 32 + (swz % 64) / 2; }
__host__ __device__ __forceinline__ int perm32(int rho) { const int n = rho >> 4, i = rho & 15; return 8 * (i >> 2) + 4 * n + (i & 3); }

struct Unit { int pm, pn; };
struct Gemm { const bf16_t* A; const bf16_t* Bt; int M, N, K; };

struct StaticOrder {
    int nM, nN, nwg, G, c;
    __host__ __device__ void init(int M, int N, int G_, int c_, int bm = BM) { nM = M / bm; nN = N / BM; nwg = nM * nN; G = G_; c = c_; }
    __host__ __device__ bool next(int i, Unit& u) const {
        const long L = (long)i * G + c; if (L >= nwg) return false;
        int wgid = (int)L; { const int q = nwg / NXCD, r = nwg % NXCD, xcd = wgid % NXCD, off = wgid / NXCD; wgid = (xcd < r ? xcd * (q + 1) : r * (q + 1) + (xcd - r) * q) + off; }
        const int nig = WGM * nN, gid = wgid / nig, fm = gid * WGM, gsz = (nM - fm) < WGM ? (nM - fm) : WGM;
        u.pm = fm + ((wgid % nig) % gsz); u.pn = (wgid % nig) / gsz; return true;
    }
    __device__ __forceinline__ void a_ready(const Unit&) const {}
    __device__ __forceinline__ void done(const Unit&) const {}
};

template <class Epi, class Sched, bool ALIGN_EPI = false, bool SP2 = false, int MF = 4>
__device__ __forceinline__ void gemm_phase(PG8_LAS unsigned char* lds, const Gemm g, const Sched& S, const Epi& E, const int tid_in) {
    const int tid = tid_in, wid = __builtin_amdgcn_readfirstlane(tid >> 6), lane = tid & 63, wr = wid >> 2, wc = wid & 3, fr = lane & 15, fq = lane >> 4;
    static_assert(MF == 4 || (MF == 3 && SP2), "192-row tiles: SP2 schedule only");
    const int K = g.K, nt = K / BK;
    unsigned voffA[2], voffB[2];
#pragma unroll
    for (int i = 0; i < 2; ++i) { int R, C; stage_rc(tid * 16 + i * 8192, R, C); const int Rb = Epi::PERM ? ((R & ~31) + perm32(R & 31)) : R;
        voffA[i] = (unsigned)(R * K + C) * 2u; voffB[i] = (unsigned)(Rb * K + C) * 2u; }
    const size_t kstep = (size_t)(BK * 2);
    const size_t hstep = (size_t)HALF * K * 2;
    const size_t tstep = 2 * hstep;
    const size_t hstepA = (size_t)(MF * 32) * K * 2, tstepA = 2 * hstepA;
    const unsigned ldsw = (unsigned)wid * 1024u;
    const int aoff = lds_byte(wr * (MF * 16) + fr, fq * 8), boff = lds_byte(wc * 32 + fr, fq * 8);
#define PG8_SA(b, h) (((b) * 2 + (h)) * HTB)
#define PG8_SB(b, h) ((4 + (b) * 2 + (h)) * HTB)
#define PG8_STAGE(bufoff, gbase, voff) do { _Pragma("unroll") for (int _i = 0; _i < 2; ++_i) \
        __builtin_amdgcn_global_load_lds((const unsigned*)((const char*)(gbase) + (voff)[_i]), (PG8_LAS unsigned*)(lds + (bufoff) + ldsw + _i * 8192), 16, 0, 0); } while (0)
#define PG8_STAGEA(bufoff, gbase, voff) do { __builtin_amdgcn_global_load_lds((const unsigned*)((const char*)(gbase) + (voff)[0]), (PG8_LAS unsigned*)(lds + (bufoff) + ldsw), 16, 0, 0); \
        if (MF == 4 || wr == 0) __builtin_amdgcn_global_load_lds((const unsigned*)((const char*)(gbase) + (voff)[1]), (PG8_LAS unsigned*)(lds + (bufoff) + ldsw + 8192), 16, 0, 0); } while (0)
#define PG8_LDA(dst, b, h) do { _Pragma("unroll") for (int m = 0; m < MF; ++m) _Pragma("unroll") for (int k = 0; k < 2; ++k) dst[m][k] = *(const PG8_LAS bf16x8*)(lds + PG8_SA(b, h) + aoff + m * 2048 + k * 1024); } while (0)
#define PG8_LDB(dst, b, h) do { _Pragma("unroll") for (int n = 0; n < 2; ++n) _Pragma("unroll") for (int k = 0; k < 2; ++k) dst[n][k] = *(const PG8_LAS bf16x8*)(lds + PG8_SB(b, h) + boff + n * 2048 + k * 1024); } while (0)
#define PG8_MMA(ai, bj, At, Bt) do { __builtin_amdgcn_s_setprio(1); _Pragma("unroll") for (int m = 0; m < MF; ++m) _Pragma("unroll") for (int n = 0; n < 2; ++n) _Pragma("unroll") for (int k = 0; k < 2; ++k) \
        acc[ai][bj][m][n] = __builtin_amdgcn_mfma_f32_16x16x32_bf16(Bt[n][k], At[m][k], acc[ai][bj][m][n], 0, 0, 0); __builtin_amdgcn_s_setprio(0); } while (0)
#define PG8_WAIT_V(n) asm volatile("s_waitcnt vmcnt(" #n ")" ::: "memory")
#define PG8_WAIT_V2(a, b) do { if (MF == 4 || wr == 0) asm volatile("s_waitcnt vmcnt(" #a ")" ::: "memory"); else asm volatile("s_waitcnt vmcnt(" #b ")" ::: "memory"); } while (0)
#define PG8_WAIT_L(n) asm volatile("s_waitcnt lgkmcnt(" #n ")" ::: "memory")
#define PG8_BAR __builtin_amdgcn_s_barrier()
#define PG8_SCHED __builtin_amdgcn_sched_barrier(0)
    Unit cur, nxt; int ui = 0;
    if (!S.next(0, cur)) return;
    f32x4 acc[2][2][MF][2];
#pragma unroll
    for (int a = 0; a < 2; ++a)
#pragma unroll
        for (int b = 0; b < 2; ++b)
#pragma unroll
            for (int m = 0; m < MF; ++m)
#pragma unroll
                for (int n = 0; n < 2; ++n) acc[a][b][m][n] = (f32x4){0.f, 0.f, 0.f, 0.f};
    bf16x8 At[MF][2], B0[2][2], B1[2][2];
#define PG8_SGPR64(p) ((const char*)(((unsigned long long)(unsigned)__builtin_amdgcn_readfirstlane((int)((unsigned long long)(p) >> 32)) << 32) | (unsigned)__builtin_amdgcn_readfirstlane((int)(unsigned long long)(p))))
    const char* cA = PG8_SGPR64((const char*)g.A + (size_t)cur.pm * tstepA); const char* cB = PG8_SGPR64((const char*)g.Bt + (size_t)cur.pn * tstep);
    S.a_ready(cur);
    if constexpr (SP2) {
        PG8_STAGE(PG8_SB(0, 0), cB, voffB); PG8_STAGE(PG8_SB(0, 1), cB + hstep, voffB); PG8_STAGEA(PG8_SA(0, 0), cA, voffA); PG8_STAGEA(PG8_SA(0, 1), cA + hstepA, voffA);
        if (wr == 1) PG8_BAR;
        PG8_WAIT_V2(2, 1); PG8_BAR;
        PG8_STAGE(PG8_SB(1, 0), cB + kstep, voffB); PG8_STAGEA(PG8_SA(1, 0), cA + kstep, voffA); PG8_STAGE(PG8_SB(1, 1), cB + hstep + kstep, voffB);
        PG8_WAIT_V2(6, 5); PG8_BAR;
    } else {
        PG8_STAGE(PG8_SB(0, 0), cB, voffB); PG8_STAGEA(PG8_SA(0, 0), cA, voffA); PG8_STAGE(PG8_SB(0, 1), cB + hstep, voffB); PG8_STAGEA(PG8_SA(0, 1), cA + hstepA, voffA);
        if (wr == 1) PG8_BAR;
        PG8_WAIT_V(4); PG8_BAR;
        PG8_STAGE(PG8_SB(1, 0), cB + kstep, voffB); PG8_STAGEA(PG8_SA(1, 0), cA + kstep, voffA); PG8_STAGE(PG8_SB(1, 1), cB + hstep + kstep, voffB);
        PG8_WAIT_V(6); PG8_BAR;
    }
    for (;;) {
        const bool has_next = S.next(ui + 1, nxt);
        const char* nA = PG8_SGPR64(has_next ? (const char*)g.A + (size_t)nxt.pm * tstepA : cA); const char* nB = PG8_SGPR64(has_next ? (const char*)g.Bt + (size_t)nxt.pn * tstep : cB);
        for (int t = 0; t < nt; t += 2) {
            const bool last = (t == nt - 2);
            const char* a1 = cA + (size_t)(t + 1) * kstep;
            const char* a2 = last ? nA : cA + (size_t)(t + 2) * kstep; const char* b2 = last ? nB : cB + (size_t)(t + 2) * kstep;
            const char* a3 = a2 + kstep; const char* b3 = b2 + kstep;
            if (last && has_next) S.a_ready(nxt);
            if constexpr (SP2) {
            PG8_LDB(B0, 0, 0); PG8_LDB(B1, 0, 1); PG8_SCHED; PG8_LDA(At, 0, 0); PG8_STAGEA(PG8_SA(1, 1), a1 + hstepA, voffA);
            PG8_WAIT_V2(8, 6); PG8_WAIT_L(0); PG8_BAR; PG8_MMA(0, 0, At, B0); PG8_MMA(0, 1, At, B1); PG8_BAR; PG8_SCHED;
            PG8_LDA(At, 0, 1); PG8_STAGE(PG8_SB(0, 0), b2, voffB); PG8_STAGE(PG8_SB(0, 1), b2 + hstep, voffB); PG8_STAGEA(PG8_SA(0, 0), a2, voffA);
            PG8_WAIT_V2(8, 6); PG8_WAIT_L(0); PG8_BAR; PG8_MMA(1, 0, At, B0); PG8_MMA(1, 1, At, B1); PG8_BAR; PG8_SCHED;
            PG8_LDB(B0, 1, 0); PG8_LDB(B1, 1, 1); PG8_SCHED; PG8_LDA(At, 1, 0); PG8_STAGEA(PG8_SA(0, 1), a2 + hstepA, voffA);
            PG8_WAIT_V2(8, 6); PG8_WAIT_L(0); PG8_BAR; PG8_MMA(0, 0, At, B0); PG8_MMA(0, 1, At, B1); PG8_BAR; PG8_SCHED;
            PG8_LDA(At, 1, 1); PG8_STAGE(PG8_SB(1, 0), b3, voffB); PG8_STAGE(PG8_SB(1, 1), b3 + hstep, voffB); PG8_STAGEA(PG8_SA(1, 0), a3, voffA);
            PG8_WAIT_V2(8, 6); PG8_WAIT_L(0); PG8_BAR; PG8_MMA(1, 0, At, B0); PG8_MMA(1, 1, At, B1); PG8_BAR; PG8_SCHED;
            } else {
            PG8_LDB(B0, 0, 0); PG8_SCHED; PG8_LDA(At, 0, 0); PG8_STAGEA(PG8_SA(1, 1), a1 + hstepA, voffA);
            PG8_WAIT_L(8); PG8_BAR; PG8_WAIT_L(0); PG8_MMA(0, 0, At, B0); PG8_BAR; PG8_SCHED;
            PG8_LDB(B1, 0, 1); PG8_STAGE(PG8_SB(0, 0), b2, voffB);
            PG8_BAR; PG8_WAIT_L(0); PG8_MMA(0, 1, At, B1); PG8_BAR;
            PG8_LDA(At, 0, 1); PG8_STAGEA(PG8_SA(0, 0), a2, voffA);
            PG8_BAR; PG8_WAIT_L(0); PG8_MMA(1, 0, At, B0); PG8_BAR; PG8_SCHED;
            PG8_STAGE(PG8_SB(0, 1), b2 + hstep, voffB);
            PG8_WAIT_V(6); PG8_BAR; PG8_MMA(1, 1, At, B1); PG8_BAR;
            PG8_LDB(B0, 1, 0); PG8_SCHED; PG8_LDA(At, 1, 0); PG8_STAGEA(PG8_SA(0, 1), a2 + hstepA, voffA);
            PG8_WAIT_L(8); PG8_BAR; PG8_WAIT_L(0); PG8_MMA(0, 0, At, B0); PG8_BAR; PG8_SCHED;
            PG8_LDB(B1, 1, 1); PG8_STAGE(PG8_SB(1, 0), b3, voffB);
            PG8_BAR; PG8_WAIT_L(0); PG8_MMA(0, 1, At, B1); PG8_BAR;
            PG8_LDA(At, 1, 1); PG8_STAGEA(PG8_SA(1, 0), a3, voffA);
            PG8_BAR; PG8_WAIT_L(0); PG8_MMA(1, 0, At, B0); PG8_BAR; PG8_SCHED;
            PG8_STAGE(PG8_SB(1, 1), b3 + hstep, voffB);
            PG8_WAIT_V(6); PG8_BAR; PG8_MMA(1, 1, At, B1); PG8_BAR;
            }
        }
        if constexpr (ALIGN_EPI) { if (wr == 0) PG8_BAR; }
        if constexpr (!Epi::AFTER_DRAIN) { E.template operator()<MF>(acc, cur, wr, wc, fr, fq); S.done(cur); }
        if (!has_next) break;
#pragma unroll
        for (int a = 0; a < 2; ++a)
#pragma unroll
            for (int b = 0; b < 2; ++b)
#pragma unroll
                for (int m = 0; m < MF; ++m)
#pragma unroll
                    for (int n = 0; n < 2; ++n) acc[a][b][m][n] = (f32x4){0.f, 0.f, 0.f, 0.f};
        cur = nxt; cA = nA; cB = nB; ++ui;
        if constexpr (ALIGN_EPI) { if (wr == 1) PG8_BAR; }
    }
    PG8_WAIT_V(0);
    if constexpr (!ALIGN_EPI) { if (wr == 0) PG8_BAR; }
    PG8_BAR;
    if constexpr (Epi::AFTER_DRAIN) { E.fused(acc, cur, wr, wc, fr, fq, lds, wid, lane); S.done(cur); }
#undef PG8_SA
#undef PG8_SB
#undef PG8_STAGE
#undef PG8_STAGEA
#undef PG8_WAIT_V2
#undef PG8_LDA
#undef PG8_LDB
#undef PG8_MMA
#undef PG8_WAIT_V
#undef PG8_WAIT_L
#undef PG8_BAR
#undef PG8_SCHED
}
}

using pg8::bf16_t; using pg8::bf16x8; using pg8::f32x4; using pg8::u32x4;
typedef float f32x16 __attribute__((ext_vector_type(16)));
typedef float f32x2 __attribute__((ext_vector_type(2)));
typedef short s16x4 __attribute__((ext_vector_type(4)));
typedef unsigned u32x2 __attribute__((ext_vector_type(2)));
typedef __bf16 bf16x2_t __attribute__((ext_vector_type(2)));
#define LAS __attribute__((address_space(3)))
#define LDG(T, base, boff) (*(const __attribute__((address_space(1))) T*)((const __attribute__((address_space(1))) unsigned char*)(base) + (unsigned)(boff)))
#define STG(T, base, boff) (*(__attribute__((address_space(1))) T*)((__attribute__((address_space(1))) unsigned char*)(base) + (unsigned)(boff)))

__device__ __forceinline__ unsigned pk2(float lo, float hi) { f32x2 v = {lo, hi}; bf16x2_t b = __builtin_convertvector(v, bf16x2_t); return __builtin_bit_cast(unsigned, b); }
__device__ __forceinline__ float bf_lo(unsigned u) { return __uint_as_float(u << 16); }
__device__ __forceinline__ float bf_hi(unsigned u) { return __uint_as_float(u & 0xffff0000u); }
__device__ __forceinline__ f32x4 unpack4(u32x2 v) { return (f32x4){bf_lo(v.x), bf_hi(v.x), bf_lo(v.y), bf_hi(v.y)}; }
__device__ __forceinline__ u32x2 pack4(f32x4 v) { u32x2 r; r.x = pk2(v[0], v[1]); r.y = pk2(v[2], v[3]); return r; }
__device__ __forceinline__ float sigmf(float x) { return __builtin_amdgcn_rcpf(1.f + __expf(-x)); }
template <int CTRL> __device__ __forceinline__ float dpp_f(float x) { return __builtin_bit_cast(float, __builtin_amdgcn_update_dpp(0, __builtin_bit_cast(int, x), CTRL, 0xF, 0xF, true)); }
__device__ __forceinline__ float allreduce16(float x) { x += dpp_f<0xB1>(x); x += dpp_f<0x4E>(x); x += dpp_f<0x141>(x); x += dpp_f<0x140>(x); return x; }
__device__ __forceinline__ float rdlane(float x, int l) { return __builtin_bit_cast(float, __builtin_amdgcn_readlane(__builtin_bit_cast(int, x), l)); }
__device__ __forceinline__ float wave_sum(float v) {
    v = allreduce16(v);
    return (rdlane(v, 0) + rdlane(v, 16)) + (rdlane(v, 32) + rdlane(v, 48));
}
__device__ __forceinline__ float swap32_sum(float x) { auto rr = __builtin_amdgcn_permlane32_swap(__float_as_uint(x), __float_as_uint(x), false, false); return __uint_as_float(rr[0]) + __uint_as_float(rr[1]); }
__device__ __forceinline__ float swap32_max(float x) { auto rr = __builtin_amdgcn_permlane32_swap(__float_as_uint(x), __float_as_uint(x), false, false); return fmaxf(__uint_as_float(rr[0]), __uint_as_float(rr[1])); }

constexpr int M = 12288, MC = 4096, DM = 1024, NIN = 3072, FF = 2816, NFF2 = 5632, DEPTH = 4;
constexpr float LOG2E = 1.4426950408889634f;
constexpr float QSCALE_A = 0.125f * LOG2E;
constexpr float QSCALE_B = 0.17677669529663687f * LOG2E;
constexpr unsigned OFF_AK = 12582912, OFF_AV = 14680064, OFF_BK = 16777216, OFF_BV = 20971520, OFF_CF = 25165824, OFF_CB = 26738688;
constexpr unsigned MiB = 1u << 20;
constexpr unsigned WS_CTL = 0, CTL_BYTES = 1 * MiB;
constexpr unsigned WS_MOD = 1 * MiB;
constexpr unsigned WS_TAB = 1 * MiB + 512 * 1024;
constexpr unsigned WS_SMALLW = 2 * MiB;
constexpr unsigned WS_CACHE = 4 * MiB;
constexpr unsigned WS_WIN = 10 * MiB, WS_WOUT = 16 * MiB, WS_W13 = 18 * MiB, WS_W2 = 29 * MiB;
constexpr unsigned WSET_STRIDE = 184 * MiB;
constexpr unsigned WS_ACT = 35 * MiB;
constexpr unsigned WS_QA = 59 * MiB, WS_KA = 68 * MiB, WS_VTA = 71 * MiB, WS_QB = 74 * MiB, WS_KB = 80 * MiB, WS_VTB = 86 * MiB;
constexpr unsigned WS_RKV = 92 * MiB, WS_CW = 119 * MiB, WS_CA = 122 * MiB, WS_CG = 125 * MiB;
constexpr unsigned WS_YF = 128 * MiB, WS_YB = 146 * MiB;
constexpr unsigned WS_SV = 164 * MiB;
constexpr unsigned WS_BO2 = 182 * MiB, WS_ML = 230 * MiB;
constexpr unsigned WS_XB = 206 * MiB;
constexpr unsigned WS_WSET1 = 194 * MiB;
constexpr unsigned WS_RM = 236 * MiB, WS_RN = 254 * MiB, WS_RP = 324 * MiB, WS_RH = 342 * MiB;
constexpr int NCHUNK = 2304;
constexpr unsigned WS_U = 128 * MiB;
constexpr unsigned WS_G = 290 * MiB, WS_SB = 299 * MiB, WS_BO = 300 * MiB, WS_END = 360 * MiB;
constexpr int SMALLW_L = 147456;
constexpr int TAB_COSA = 0, TAB_SINA = 1024, TAB_COSB = 2048, TAB_SINB = 2560, TAB_LAM = 3072;
constexpr int LDS_BYTES = 147456;
constexpr int NPHASE = 2 + 9 * DEPTH;

struct Args {
    const float* in[34];
    float* out; unsigned char* ws;
    int ph_lo, ph_hi;
};

struct EpiRes {
    static constexpr bool PERM = true, AFTER_DRAIN = false;
    const float* baseC; const float* baseL; unsigned char* ws; const float* gate; bool first;
    template <int MF>
    __device__ __forceinline__ void operator()(const f32x4 (&acc)[2][2][MF][2], const pg8::Unit& u, int wr, int wc, int fr_, int fq_) const {
        int fr = fr_, fq = fq_; asm volatile("" : "+v"(fr), "+v"(fq));
        const unsigned col0 = u.pn * 256 + wc * 32 + 8 * fq, rowb = u.pm * (MF * 64) + wr * (MF * 16);
        f32x4 g4[2][2]; int vcur = -1;
#pragma unroll
        for (int ai = 0; ai < 2; ++ai)
#pragma unroll
            for (int m = 0; m < MF; ++m) { const unsigned rf = rowb + ai * (MF * 32) + m * 16, off = (rf + fr) * DM + col0;
                const int v = rf < MC ? 0 : (rf < MC + 4096 ? 1 : 2);
                if (v != vcur) { vcur = v;
#pragma unroll
                    for (int bj = 0; bj < 2; ++bj)
#pragma unroll
                        for (int n = 0; n < 2; ++n) g4[bj][n] = LDG(f32x4, gate, (v * 6144 + col0 + bj * 128 + n * 4) * 4); }
#pragma unroll
                for (int bj = 0; bj < 2; ++bj) { f32x4 b0, b1;
                    if (first) { const float* base = rf < MC ? baseC : baseL; b0 = LDG(f32x4, base, (off + bj * 128) * 4); b1 = LDG(f32x4, base, (off + bj * 128 + 4) * 4); }
                    else { const u32x4 xb = LDG(u32x4, ws, WS_XB + (off + bj * 128) * 2); b0 = (f32x4){bf_lo(xb.x), bf_hi(xb.x), bf_lo(xb.y), bf_hi(xb.y)}; b1 = (f32x4){bf_lo(xb.z), bf_hi(xb.z), bf_lo(xb.w), bf_hi(xb.w)}; }
                    b0 = b0 + g4[bj][0] * acc[ai][bj][m][0]; b1 = b1 + g4[bj][1] * acc[ai][bj][m][1];
                    u32x4 w; w.x = pk2(b0[0], b0[1]); w.y = pk2(b0[2], b0[3]); w.z = pk2(b1[0], b1[1]); w.w = pk2(b1[2], b1[3]);
                    STG(u32x4, ws, WS_XB + (off + bj * 128) * 2) = w; } }
    }
};
struct EpiSwi {
    static constexpr bool PERM = true, AFTER_DRAIN = false;
    bf16_t* U;
    template <int MF>
    __device__ __forceinline__ void operator()(const f32x4 (&acc)[2][2][MF][2], const pg8::Unit& u, int wr, int wc, int fr_, int fq_) const {
        int fr = fr_, fq = fq_; asm volatile("" : "+v"(fr), "+v"(fq));
        const unsigned row0 = u.pm * (MF * 64) + wr * (MF * 16) + fr, oc0 = u.pn * 128 + wc * 32 + 8 * fq;
#pragma unroll
        for (int ai = 0; ai < 2; ++ai)
#pragma unroll
            for (int m = 0; m < MF; ++m) { const unsigned ro = ((row0 + ai * (MF * 32) + m * 16) * FF + oc0) * 2; f32x4 o[2];
#pragma unroll
                for (int bj = 0; bj < 2; ++bj) { const f32x4 g = acc[ai][bj][m][0], up = acc[ai][bj][m][1];
#pragma unroll
                    for (int e = 0; e < 4; ++e) o[bj][e] = g[e] * sigmf(g[e]) * up[e]; }
                const u32x2 lo = pack4(o[0]), hi2 = pack4(o[1]);
                STG(u32x4, U, ro) = (u32x4){lo.x, lo.y, hi2.x, hi2.y}; asm volatile("" ::: "memory"); }
    }
};
struct EpiWin {
    static constexpr bool PERM = true, AFTER_DRAIN = false;
    unsigned char* ws; float* out; int l; LAS unsigned char* lds;
    template <int MF>
    __device__ __forceinline__ void operator()(const f32x4 (&acc)[2][2][MF][2], const pg8::Unit& u, int wr, int wc, int fr_, int fq_) const {
        int fr = fr_, fq = fq_; asm volatile("" : "+v"(fr), "+v"(fq));
        const unsigned rowb = u.pm * (MF * 64) + wr * (MF * 16), row0 = rowb + fr;
#pragma unroll
        for (int bj = 0; bj < 2; ++bj) {
            const unsigned c32 = u.pn * 256 + bj * 128 + wc * 32;
            const unsigned c8 = c32 + 8 * fq;
            if (c32 < 1152 && (c32 < 512 || c32 >= 640)) {
                const bool isA = c32 < 512;
                const bool isK = isA ? (c32 >= 384) : (c32 >= 896);
                const float qs = isK ? 1.f : (isA ? QSCALE_A : QSCALE_B);
                const unsigned ck = isA ? c8 - 384 : c8 - 896;
                const unsigned dbase = isA ? (isK ? WS_KA + (((ck >> 6) * 4 + ((ck & 63) >> 4)) * 64 + ((ck >> 3) & 1) * 32) * 16 : WS_QA + c8 * 2)
                                           : (isK ? WS_KB + (((ck >> 5) * 2 + ((ck & 31) >> 4)) * 64 + ((ck >> 3) & 1) * 32) * 16 : WS_QB + (c8 - 640) * 2);
                const unsigned dpitch = isA ? 768u : 512u;
#pragma unroll
                for (int ai = 0; ai < 2; ++ai)
#pragma unroll
                    for (int m = 0; m < MF; ++m) {
                        const unsigned row = row0 + ai * (MF * 32) + m * 16; const bool lat = rowb + ai * (MF * 32) + m * 16 >= (unsigned)MC;
                        f32x4 v0 = acc[ai][bj][m][0], v1 = acc[ai][bj][m][1];
                        if (lat) {
                            const unsigned t = (row - MC) & 4095, rp = t >> 6, cp = t & 63;
                            unsigned to_;
                            if (isA) { const unsigned pos = ((c32 >> 5) & 1) ? cp : rp; to_ = WS_TAB + (TAB_COSA + pos * 16 + 4 * fq) * 4; }
                            else { const unsigned pos = (fq >> 1) ? cp : rp; to_ = WS_TAB + (TAB_COSB + pos * 8 + 4 * (fq & 1)) * 4; }
                            const f32x4 c4 = LDG(f32x4, ws, to_), s4 = LDG(f32x4, ws, to_ + (isA ? 4096u : 2048u));
                            f32x4 w0, w1;
                            w0[0] = v0[0] * c4[0] - v0[1] * s4[0]; w0[1] = v0[1] * c4[0] + v0[0] * s4[0];
                            w0[2] = v0[2] * c4[1] - v0[3] * s4[1]; w0[3] = v0[3] * c4[1] + v0[2] * s4[1];
                            w1[0] = v1[0] * c4[2] - v1[1] * s4[2]; w1[1] = v1[1] * c4[2] + v1[0] * s4[2];
                            w1[2] = v1[2] * c4[3] - v1[3] * s4[3]; w1[3] = v1[3] * c4[3] + v1[2] * s4[3];
                            v0 = w0; v1 = w1;
                        } else if (isK) {
                            const unsigned b = row >> 8, t = row & 255;
                            const f32x4 ev = {v0[0], v0[2], v1[0], v1[2]}, od = {v0[1], v0[3], v1[1], v1[3]};
                            if (isA) { const unsigned o = (OFF_AK + ((b * 4 + l) * 256 + t) * 128 + (c32 - 384) + 4 * fq) * 4; STG(f32x4, out, o) = ev; STG(f32x4, out, o + 64) = od; }
                            else { const unsigned o = (OFF_BK + ((b * 4 + l) * 256 + t) * 256 + ((c8 - 896) & ~15u) + 4 * (fq & 1)) * 4; STG(f32x4, out, o) = ev; STG(f32x4, out, o + 32) = od; }
                        }
                        v0 = v0 * qs; v1 = v1 * qs;
                        u32x4 w; w.x = pk2(v0[0], v0[1]); w.y = pk2(v0[2], v0[3]); w.z = pk2(v1[0], v1[1]); w.w = pk2(v1[2], v1[3]);
                        STG(u32x4, ws, isK ? dbase + (row >> 5) * (isA ? 8192u : 16384u) + (row & 31) * 16 : dbase + row * dpitch) = w;
                        asm volatile("" ::: "memory");
                    }
            } else if (c32 < 1408) {
                const bool isA = c32 < 640;
                const unsigned cc = isA ? (c8 - 512) : (c8 - 1152), cw = isA ? (c32 - 512) : (c32 - 1152);
                const unsigned vfrag = (isA ? WS_VTA : WS_VTB) + (((cw >> 6) * 2 + ((cw >> 5) & 1)) * 2) * 1024;
                LAS unsigned char* lw = lds + (wr * 4 + wc) * 1024;
                LAS bf16_t* lq = (LAS bf16_t*)(lw + ((((fr >> 2) & 1) * 32 + 8 * fq) * 16 + (4 * (fr >> 3) + (fr & 3)) * 2));
#pragma unroll
                for (int ai = 0; ai < 2; ++ai)
#pragma unroll
                    for (int m = 0; m < MF; ++m) {
                        const unsigned rf = rowb + ai * (MF * 32) + m * 16, row = rf + fr; const bool lat = rf >= (unsigned)MC;
                        const f32x4 v0 = acc[ai][bj][m][0], v1 = acc[ai][bj][m][1];
                        if (!lat) { const unsigned b = row >> 8, t = row & 255;
                            const unsigned o = isA ? (OFF_AV + ((b * 4 + l) * 256 + t) * 128 + cc) * 4 : (OFF_BV + ((b * 4 + l) * 256 + t) * 256 + cc) * 4;
                            STG(f32x4, out, o) = v0; STG(f32x4, out, o + 16) = v1; }
                        const unsigned p0 = pk2(v0[0], v0[1]), p1 = pk2(v0[2], v0[3]), p2 = pk2(v1[0], v1[1]), p3 = pk2(v1[2], v1[3]);
                        lq[0 * 8] = (bf16_t)(p0 & 0xffff); lq[1 * 8] = (bf16_t)(p0 >> 16); lq[2 * 8] = (bf16_t)(p1 & 0xffff); lq[3 * 8] = (bf16_t)(p1 >> 16);
                        lq[4 * 8] = (bf16_t)(p2 & 0xffff); lq[5 * 8] = (bf16_t)(p2 >> 16); lq[6 * 8] = (bf16_t)(p3 & 0xffff); lq[7 * 8] = (bf16_t)(p3 >> 16);
                        const u32x4 tv = *(const LAS u32x4*)(lw + (fq * 16 + fr) * 16);
                        STG(u32x4, ws, vfrag + (rf >> 5) * (isA ? 8192u : 16384u) + ((rf >> 4) & 1) * 1024 + (fq * 16 + fr) * 16) = tv;
                        asm volatile("" ::: "memory");
                    }
            } else if (c32 < 2944) {
                const int kind = c32 < 2560 ? 0 : (c32 < 2688 ? 1 : (c32 < 2816 ? 2 : 3));
                const unsigned dbase = kind == 0 ? WS_RKV + (c8 - 1408) * 2 : (kind == 1 ? WS_CW + (c8 - 2560) * 2 : (kind == 2 ? WS_CA + (c8 - 2688) * 2 : WS_CG + (c8 - 2816) * 2));
                const unsigned dpitch = kind == 0 ? 2304u : 256u;
#pragma unroll
                for (int ai = 0; ai < 2; ++ai)
#pragma unroll
                    for (int m = 0; m < MF; ++m) {
                        const unsigned row = row0 + ai * (MF * 32) + m * 16; const bool lat = rowb + ai * (MF * 32) + m * 16 >= (unsigned)MC;
                        f32x4 v0 = acc[ai][bj][m][0], v1 = acc[ai][bj][m][1];
                        if (kind == 1) {
#pragma unroll
                            for (int e = 0; e < 4; ++e) { v0[e] = 1.f - 2.f * __builtin_amdgcn_rcpf(__expf(2.f * v0[e]) + 1.f); v1[e] = 1.f - 2.f * __builtin_amdgcn_rcpf(__expf(2.f * v1[e]) + 1.f); }
                        } else if (kind == 3) {
#pragma unroll
                            for (int e = 0; e < 4; ++e) { v0[e] = sigmf(v0[e]); v1[e] = sigmf(v1[e]); }
                        }
                        u32x4 w; w.x = pk2(v0[0], v0[1]); w.y = pk2(v0[2], v0[3]); w.z = pk2(v1[0], v1[1]); w.w = pk2(v1[2], v1[3]);
                        STG(u32x4, ws, dbase + row * dpitch) = w;
                        asm volatile("" ::: "memory");
                    }
            }
        }
    }
};

struct Frame {
    LAS unsigned char* lds;
    const float* const* in;
    float* out; unsigned char* ws;
    int tid, lane, wave, gw, ngw, G, bid;
};
#define GAS __attribute__((address_space(1)))
template <class T> __device__ __forceinline__ T* gptr(T* p) {
#if defined(__HIP_DEVICE_COMPILE__)
    __builtin_assume(!__builtin_amdgcn_is_shared((const void*)p)); __builtin_assume(!__builtin_amdgcn_is_private((const void*)p));
#endif
    return p; }
#define INP(k) gptr(F.in[k])
#define WSP(T, off) gptr((T*)(F.ws + (off)))

__device__ __forceinline__ void phase_prologue(Frame& F) {
    const float* cvec = INP(8); const float* cctx = INP(9); const float* ada_w = INP(10); const float* ada_b = INP(11);
    LAS float* sl = (LAS float*)F.lds;
    LAS float* red = (LAS float*)(F.lds + 16384);
    for (int i = F.tid; i < 3072; i += 512) { const int v = i >> 10, k = i & 1023; const float x = v == 0 ? cctx[k] : cvec[(v - 1) * 1024 + k]; sl[i] = x / (1.f + __expf(-x)); }
    __syncthreads();
    float* mod = WSP(float, WS_MOD);
    for (int it = F.bid; it < 384; it += F.G) {
        const int l = it / 96, n0 = (it % 96) * 64;
        const float* W = ada_w + (size_t)l * 1024 * 6144 + n0 + F.lane;
        float a0 = 0.f, a1 = 0.f, a2 = 0.f;
        const int k0 = F.wave * 128;
#pragma unroll 8
        for (int k = k0; k < k0 + 128; ++k) { const float w = *(const GAS float*)(W + (size_t)k * 6144); a0 += sl[k] * w; a1 += sl[1024 + k] * w; a2 += sl[2048 + k] * w; }
        red[(F.wave * 3 + 0) * 64 + F.lane] = a0; red[(F.wave * 3 + 1) * 64 + F.lane] = a1; red[(F.wave * 3 + 2) * 64 + F.lane] = a2;
        __syncthreads();
        if (F.wave < 3) { float s = ada_b[l * 6144 + n0 + F.lane];
#pragma unroll
            for (int w = 0; w < 8; ++w) s += red[(w * 3 + F.wave) * 64 + F.lane];
            mod[(size_t)(l * 3 + F.wave) * 6144 + n0 + F.lane] = s; }
        __syncthreads();
    }
    float* tab = WSP(float, WS_TAB);
    if (F.bid == F.G - 1) {
        for (int i = F.tid; i < 1024; i += 512) { const int pos = i >> 4, f = i & 15; const float ang = (float)pos * __builtin_amdgcn_exp2f(-(float)f * (13.287712379549449f / 16.f)); tab[TAB_COSA + i] = __cosf(ang); tab[TAB_SINA + i] = __sinf(ang); }
        for (int i = F.tid; i < 512; i += 512) { const int pos = i >> 3, f = i & 7; const float ang = (float)pos * __builtin_amdgcn_exp2f(-(float)f * (13.287712379549449f / 8.f)); tab[TAB_COSB + i] = __cosf(ang); tab[TAB_SINB + i] = __sinf(ang); }
        if (F.wave < 4) { const float* lp = INP(16) + F.wave * 128; const int d = F.lane & 31;
            const float p1 = wave_sum(F.lane < 32 ? lp[d] * lp[32 + d] : 0.f), p2 = wave_sum(F.lane < 32 ? 0.f : lp[64 + d] * lp[96 + d]);
            if (F.lane == 0) tab[TAB_LAM + F.wave] = __expf(p1) - __expf(p2); }
    }
    const int gtid = F.bid * 512 + F.tid, gnt = F.G * 512;
    { bf16_t* sw = WSP(bf16_t, WS_SMALLW); const float* cw2 = INP(20); const float* ca2 = INP(22); const float* cg2 = INP(23);
      for (int idx = gtid; idx < 4 * SMALLW_L; idx += gnt) { const int l = idx / SMALLW_L, r = idx % SMALLW_L; float v;
          if (r < 98304) { const int which = r / 49152, rr = r % 49152, d = rr / 24576, ch = (rr % 24576) / 64, k = rr % 64; v = (which ? ca2 : cw2)[((size_t)(l * 2 + d) * 64 + k) * 384 + ch]; }
          else { const int rr = r - 98304, ch = rr / 128, k = rr % 128; v = cg2[((size_t)l * 128 + k) * 384 + ch]; }
          sw[idx] = (bf16_t)(pk2(v, 0.f) & 0xffff); } }
    { bf16_t* kca = WSP(bf16_t, WS_CACHE); bf16_t* vca = kca + 524288; bf16_t* kcb = vca + 524288; bf16_t* vcb = kcb + 1048576;
      const float* cak = INP(2); const float* cav = INP(3); const float* cbk = INP(4); const float* cbv = INP(5);
      for (int e = gtid; e < 524288; e += gnt) {
          const int j = e & 7, ln = (e >> 3) & 63, hi = ln >> 5, r32 = ln & 31, blk = (e >> 12) & 15, bl = e >> 16;
          { const int s = (e >> 9) & 3, kvh = (e >> 11) & 1, cp = kvh * 64 + 16 * s + 8 * hi + j, o = cp & 31, c = (cp - o) + (o >> 1) + 16 * (o & 1);
            kca[e] = (bf16_t)(pk2(cak[((size_t)bl * 512 + blk * 32 + r32) * 128 + c], 0.f) & 0xffff); }
          { const int ks = (e >> 9) & 1, db = (e >> 10) & 1, kvh = (e >> 11) & 1, key = blk * 32 + 16 * ks + 8 * (j >> 2) + 4 * hi + (j & 3);
            vca[e] = (bf16_t)(pk2(cav[((size_t)bl * 512 + key) * 128 + kvh * 64 + db * 32 + r32], 0.f) & 0xffff); } }
      for (int e = gtid; e < 1048576; e += gnt) {
          const int j = e & 7, ln = (e >> 3) & 63, hi = ln >> 5, r32 = ln & 31, blk = (e >> 13) & 15, bl = e >> 17;
          { const int s = (e >> 9) & 1, hm = (e >> 10) & 7, cp = hm * 32 + 16 * s + 8 * hi + j, o = cp & 15, c = (cp - o) + (o >> 1) + 8 * (o & 1);
            kcb[e] = (bf16_t)(pk2(cbk[((size_t)bl * 512 + blk * 32 + r32) * 256 + c], 0.f) & 0xffff); }
          { const int ks = (e >> 9) & 1, db = (e >> 10) & 1, h = (e >> 11) & 3, key = blk * 32 + 16 * ks + 8 * (j >> 2) + 4 * hi + (j & 3);
            vcb[e] = (bf16_t)(pk2(cbv[((size_t)bl * 512 + key) * 256 + h * 64 + db * 32 + r32], 0.f) & 0xffff); } } }
    for (int st = 0; st < 1; ++st) { u32x4* z = (u32x4*)(WSP(bf16_t, WS_WIN + st * WSET_STRIDE) + (size_t)2944 * 1024); unsigned z0; asm volatile("v_mov_b32 %0, 0" : "=v"(z0)); for (int i = gtid; i < 128 * 1024 / 8; i += gnt) z[i] = (u32x4){z0, z0, z0, z0}; }
}

template <int MAP> __device__ __forceinline__ int dest_row(int n) {
    if (MAP == 1) {
        if (n < 512) { const int o = n & 31; return (n - o) + 2 * (o & 15) + (o >> 4); }
        if (n >= 640 && n < 1152) { const int o = n & 15; return (n - o) + 2 * (o & 7) + (o >> 3); }
        return n;
    }
    if (MAP == 2 || MAP == 3) return (n >> 7) * 256 + ((n >> 2) & 1) * 128 + ((n >> 5) & 3) * 32 + ((n >> 3) & 3) * 8 + (MAP == 3 ? 4 : 0) + (n & 3);
    return n;
}
template <int MAP> __device__ __forceinline__ void transpose_item(const float* W, int K, int N, bf16_t* WT, LAS float* scr, int item, int lane) {
    const int nblk = N / 32, kb = item / nblk, nb = item % nblk, k0 = 64 * kb, n0 = 32 * nb;
#pragma unroll 8
    for (int i = 0; i < 32; ++i) { const int kk = 2 * i + (lane >> 5); scr[kk * 33 + (lane & 31)] = *(const GAS float*)(W + (size_t)(k0 + kk) * N + n0 + (lane & 31)); }
    asm volatile("s_waitcnt lgkmcnt(0)" ::: "memory");
    const int c = lane & 7;
#pragma unroll
    for (int j = 0; j < 4; ++j) { const int n = (lane >> 3) + 8 * j; const LAS float* s = scr + (8 * c) * 33 + n;
        u32x4 o; o.x = pk2(s[0 * 33], s[1 * 33]); o.y = pk2(s[2 * 33], s[3 * 33]); o.z = pk2(s[4 * 33], s[5 * 33]); o.w = pk2(s[6 * 33], s[7 * 33]);
        *(GAS u32x4*)(WT + (size_t)dest_row<MAP>(n0 + n) * K + k0 + 8 * c) = o; }
    asm volatile("s_waitcnt lgkmcnt(0)" ::: "memory");
}
template <int MAP> __device__ __forceinline__ void convert_item(const float* W, int K, int N, bf16_t* WT, int item, int lane) {
    const int nblk = N / 64, kb = item / nblk, nb = item % nblk, n = nb * 64 + lane;
    const GAS float* src = (const GAS float*)W + (size_t)(kb * 128) * N + n;
    GAS bf16_t* dst = (GAS bf16_t*)WT + (size_t)dest_row<MAP>(n) * K + kb * 128;
#pragma unroll
    for (int g = 0; g < 16; ++g) { float v[8];
#pragma unroll
        for (int e = 0; e < 8; ++e) v[e] = src[(size_t)(8 * g + e) * N];
        u32x4 o; o.x = pk2(v[0], v[1]); o.y = pk2(v[2], v[3]); o.z = pk2(v[4], v[5]); o.w = pk2(v[6], v[7]);
        *(GAS u32x4*)(dst + 8 * g) = o; }
}
constexpr int CV_IN = 46 * 8, CV_OUT = 16 * 8, CV_1 = 44 * 8, CV_2 = 16 * 22, CV_TOTAL = CV_IN + CV_OUT + 2 * CV_1 + CV_2;
__device__ __forceinline__ void convert_item_any(Frame& F, int l, int it) {
    const unsigned so = 0u * WSET_STRIDE;
    int r = it;
    if (r < CV_IN) { convert_item<1>(INP(14) + (size_t)l * 1024 * 2944, 1024, 2944, WSP(bf16_t, WS_WIN + so), r, F.lane); return; } r -= CV_IN;
    if (r < CV_OUT) { convert_item<0>(INP(29) + (size_t)l * 1024 * 1024, 1024, 1024, WSP(bf16_t, WS_WOUT + so), r, F.lane); return; } r -= CV_OUT;
    if (r < CV_1) { convert_item<2>(INP(30) + (size_t)l * 1024 * FF, 1024, FF, WSP(bf16_t, WS_W13 + so), r, F.lane); return; } r -= CV_1;
    if (r < CV_1) { convert_item<3>(INP(31) + (size_t)l * 1024 * FF, 1024, FF, WSP(bf16_t, WS_W13 + so), r, F.lane); return; } r -= CV_1;
    convert_item<0>(INP(32) + (size_t)l * FF * 1024, FF, 1024, WSP(bf16_t, WS_W2 + so), r, F.lane);
}
__device__ __forceinline__ void convert_weights(Frame& F, int l) {
    LAS float* scr = (LAS float*)(F.lds + F.wave * 16384); const unsigned so = 0u * WSET_STRIDE;
    const float* w_in = INP(14) + (size_t)l * 1024 * 2944; const float* w_out = INP(29) + (size_t)l * 1024 * 1024;
    const float* w1 = INP(30) + (size_t)l * 1024 * FF; const float* w3 = INP(31) + (size_t)l * 1024 * FF; const float* w2 = INP(32) + (size_t)l * FF * 1024;
    constexpr int I_IN = 16 * 92, I_OUT = 16 * 32, I_1 = 16 * 88, I_2 = 44 * 32;
    constexpr int NIT = I_IN + I_OUT + 2 * I_1 + I_2;
    for (int it = F.gw; it < NIT; it += F.ngw) {
        int r = it;
        if (r < I_IN) { transpose_item<1>(w_in, 1024, 2944, WSP(bf16_t, WS_WIN + so), scr, r, F.lane); continue; } r -= I_IN;
        if (r < I_OUT) { transpose_item<0>(w_out, 1024, 1024, WSP(bf16_t, WS_WOUT + so), scr, r, F.lane); continue; } r -= I_OUT;
        if (r < I_1) { transpose_item<2>(w1, 1024, FF, WSP(bf16_t, WS_W13 + so), scr, r, F.lane); continue; } r -= I_1;
        if (r < I_1) { transpose_item<3>(w3, 1024, FF, WSP(bf16_t, WS_W13 + so), scr, r, F.lane); continue; } r -= I_1;
        transpose_item<0>(w2, FF, 1024, WSP(bf16_t, WS_W2 + so), scr, r, F.lane);
    }
}

__device__ __forceinline__ void phase_norm(Frame& F, int l, int which  ) {
    const float* g = (which ? INP(13) : INP(12)) + l * 1024;
    const float* mod = WSP(float, WS_MOD) + (size_t)l * 3 * 6144 + (which ? 3072 : 0);
    bf16_t* H = WSP(bf16_t, WS_ACT);
    const bool first = (l == 0 && which == 0);
    f32x4 gv[4];
#pragma unroll
    for (int j = 0; j < 4; ++j) gv[j] = *(const GAS f32x4*)(g + 4 * F.lane + 256 * j);
    for (int row = F.gw; row < M; row += F.ngw) {
        const float* mv = mod + (row < MC ? 0 : (row < 2 * MC ? 1 : 2)) * 6144;
        f32x4 v[4]; float ss = 0.f;
        if (first) { const float* xr = row < MC ? INP(0) + (size_t)row * DM : INP(1) + (size_t)(row - MC) * DM;
#pragma unroll
            for (int j = 0; j < 4; ++j) v[j] = *(const GAS f32x4*)(xr + 4 * F.lane + 256 * j); }
        else {
#pragma unroll
            for (int j = 0; j < 4; ++j) v[j] = unpack4(LDG(u32x2, F.ws, WS_XB + ((unsigned)row * DM + 4 * F.lane + 256 * j) * 2)); }
#pragma unroll
        for (int j = 0; j < 4; ++j) ss += (v[j][0] * v[j][0] + v[j][1] * v[j][1]) + (v[j][2] * v[j][2] + v[j][3] * v[j][3]);
        const float rstd = rsqrtf(wave_sum(ss) * (1.f / 1024.f) + 1e-6f);
#pragma unroll
        for (int j = 0; j < 4; ++j) { const f32x4 sh = *(const GAS f32x4*)(mv + 4 * F.lane + 256 * j), sc = *(const GAS f32x4*)(mv + 1024 + 4 * F.lane + 256 * j);
            const f32x4 h = v[j] * rstd * gv[j] * (sc + 1.f) + sh;
            *(GAS u32x2*)(H + (size_t)row * DM + 4 * F.lane + 256 * j) = pack4(h); }
    }
}
__device__ __forceinline__ void phase_final_norm(Frame& F) {
    const float* g = INP(33);
    f32x4 gv[4];
#pragma unroll
    for (int j = 0; j < 4; ++j) gv[j] = *(const GAS f32x4*)(g + 4 * F.lane + 256 * j);
    for (int row = F.gw; row < M; row += F.ngw) {
        float* xr = gptr(F.out + (size_t)row * DM);
        f32x4 v[4]; float ss = 0.f;
#pragma unroll
        for (int j = 0; j < 4; ++j) { v[j] = unpack4(LDG(u32x2, F.ws, WS_XB + ((unsigned)row * DM + 4 * F.lane + 256 * j) * 2)); ss += (v[j][0] * v[j][0] + v[j][1] * v[j][1]) + (v[j][2] * v[j][2] + v[j][3] * v[j][3]); }
        const float rstd = rsqrtf(wave_sum(ss) * (1.f / 1024.f) + 1e-6f);
#pragma unroll
        for (int j = 0; j < 4; ++j) *(GAS f32x4*)(xr + 4 * F.lane + 256 * j) = v[j] * rstd * gv[j];
    }
}

#define MFMA32(a, b, c) __builtin_amdgcn_mfma_f32_32x32x16_bf16((a), (b), (c), 0, 0, 0)
#ifndef ATT_PROBE
#define ATT_PROBE 0
#endif
struct AttnQ { float m, l; bool mz; f32x16 o[2]; };
template <int DQK, bool MASK, int NQ>
__device__ __forceinline__ void attn_block(const bf16x8 (&qf)[NQ][DQK / 16], const bf16x8 (&kf)[DQK / 16], const bf16x8 (&vf)[4], AttnQ (&st)[NQ], int b, const int (&qpos)[NQ], int kpos0, int hi) {
    constexpr int NS = DQK / 16;
    f32x16 sc[NQ];
#pragma unroll
    for (int q = 0; q < NQ; ++q) { const f32x16 z = {}; sc[q] = MFMA32(kf[0], qf[q][0], z);
#pragma unroll
        for (int s = 1; s < NS; ++s) sc[q] = MFMA32(kf[s], qf[q][s], sc[q]); }
#pragma unroll
    for (int q = 0; q < NQ; ++q) {
        if (!st[q].mz) {
#pragma unroll
            for (int r = 0; r < 16; ++r) sc[q][r] -= st[q].m; }
        if (MASK) {
#pragma unroll
            for (int r = 0; r < 16; ++r) { const int key = kpos0 + 32 * b + (r & 3) + 8 * (r >> 2) + 4 * hi; const int dlt = key - qpos[q]; if (dlt > 128 || dlt < -128) sc[q][r] = -1e30f; }
        }
        float bm = fmaxf(fmaxf(sc[q][0], sc[q][1]), sc[q][2]);
#pragma unroll
        for (int r = 3; r < 15; r += 2) bm = fmaxf(fmaxf(bm, sc[q][r]), sc[q][r + 1]);
        bm = fmaxf(bm, sc[q][15]);
        bm = swap32_max(bm);
        if (__builtin_amdgcn_ballot_w64(bm > 64.f) != 0ull) {
            const float d = fmaxf(bm, 0.f);
            const float alpha = __builtin_amdgcn_exp2f(-d);
            st[q].m += d; st[q].l *= alpha; st[q].mz = false;
#pragma unroll
            for (int r = 0; r < 16; ++r) { st[q].o[0][r] *= alpha; st[q].o[1][r] *= alpha; sc[q][r] -= d; }
        }
#if ATT_PROBE == 1
        { float dmy = 0.f;
#pragma unroll
          for (int r = 0; r < 16; ++r) { float e_; asm volatile("v_exp_f32 %0, %1" : "=v"(e_) : "v"(sc[q][r])); dmy += e_; }
          asm volatile("" :: "v"(dmy)); }
#endif
        f32x2 rs2 = {0.f, 0.f};
#pragma unroll
        for (int r = 0; r < 16; r += 2) { sc[q][r] = __builtin_amdgcn_exp2f(sc[q][r]); sc[q][r + 1] = __builtin_amdgcn_exp2f(sc[q][r + 1]); rs2 += (f32x2){sc[q][r], sc[q][r + 1]}; }
        st[q].l += rs2[0] + rs2[1];
#if ATT_PROBE == 3
        { float d0 = 0.f, d1 = 0.f, d2 = 0.f, d3 = 0.f;
#pragma unroll
          for (int rr = 0; rr < 10; ++rr) { asm volatile("v_add_f32 %0, %0, %4\n\tv_add_f32 %1, %1, %5\n\tv_add_f32 %2, %2, %6\n\tv_add_f32 %3, %3, %7" : "+v"(d0), "+v"(d1), "+v"(d2), "+v"(d3) : "v"(sc[q][0]), "v"(sc[q][1]), "v"(sc[q][2]), "v"(sc[q][3])); }
          asm volatile("" :: "v"(d0), "v"(d1), "v"(d2), "v"(d3)); }
#endif
#if ATT_PROBE == 2
        { f32x16 dm = sc[q]; dm = MFMA32(kf[0], qf[q][0], dm); dm = MFMA32(kf[0], qf[q][0], dm); dm = MFMA32(kf[0], qf[q][0], dm); asm volatile("" :: "v"(dm)); }
#endif
        bf16x8 pb[2];
#pragma unroll
        for (int ks = 0; ks < 2; ++ks) { u32x4 w; w.x = pk2(sc[q][8 * ks], sc[q][8 * ks + 1]); w.y = pk2(sc[q][8 * ks + 2], sc[q][8 * ks + 3]); w.z = pk2(sc[q][8 * ks + 4], sc[q][8 * ks + 5]); w.w = pk2(sc[q][8 * ks + 6], sc[q][8 * ks + 7]); pb[ks] = __builtin_bit_cast(bf16x8, w); }
#pragma unroll
        for (int db = 0; db < 2; ++db)
#pragma unroll
            for (int ks = 0; ks < 2; ++ks) st[q].o[db] = MFMA32(vf[db * 2 + ks], pb[ks], st[q].o[db]);
    }
}
template <int DQK, bool MASK, int NQ>
__device__ __forceinline__ void attn_seg(const unsigned char* ws, const bf16x8 (&qf)[NQ][DQK / 16], AttnQ (&st)[NQ],
                                         unsigned kp, unsigned kblk  , unsigned vp, unsigned vblk, int nblk, const int (&qpos)[NQ], int kpos0, int hi) {
    constexpr int NS = DQK / 16;
    const GAS unsigned char* kq = (const GAS unsigned char*)ws + kp; const GAS unsigned char* vq = (const GAS unsigned char*)ws + vp;
    bf16x8 ka[NS], va[4], kb[NS], vb[4];
#define ATT_LOAD(kd, vd) do { _Pragma("unroll") for (int s = 0; s < NS; ++s) kd[s] = *(const GAS bf16x8*)(kq + 1024 * s); _Pragma("unroll") for (int f = 0; f < 4; ++f) vd[f] = *(const GAS bf16x8*)(vq + 1024 * f); } while (0)
    ATT_LOAD(ka, va);
    int b = 0;
    for (; b + 1 < nblk; b += 2) {
        kq += kblk; vq += vblk; ATT_LOAD(kb, vb);
        attn_block<DQK, MASK, NQ>(qf, ka, va, st, b, qpos, kpos0, hi);
        if (b + 2 < nblk) { kq += kblk; vq += vblk; }
        ATT_LOAD(ka, va);
        attn_block<DQK, MASK, NQ>(qf, kb, vb, st, b + 1, qpos, kpos0, hi);
    }
    if (b < nblk) attn_block<DQK, MASK, NQ>(qf, ka, va, st, b, qpos, kpos0, hi);
#undef ATT_LOAD
}
__device__ __forceinline__ void attnq_init(AttnQ& s, float l0) { s.m = 0.f; s.mz = true; s.l = l0; s.o[0] = (f32x16){}; s.o[1] = (f32x16){}; }
__device__ __forceinline__ void attn_a_item(Frame& F, int l, bool lat, int item) {
    int lane = F.lane; asm volatile("" : "+v"(lane));
    const unsigned char* ws = F.ws;
    const unsigned r32 = lane & 31, hi = lane >> 5;
    const unsigned nqb = lat ? 128 : 8;
    const unsigned qb = item % nqb, hq = (item / nqb) % 6, b = item / (nqb * 6), kvh = hq / 3;
    const unsigned seq0 = lat ? MC + b * 4096 : b * 256, q0 = qb * 32, row = seq0 + q0 + r32;
    const unsigned qo = WS_QA + (row * 384 + hq * 64 + 8 * hi) * 2;
    bf16x8 qf[1][4];
#pragma unroll
    for (int s = 0; s < 4; ++s) qf[0][s] = LDG(bf16x8, ws, qo + 32 * s);
    AttnQ st[1]; attnq_init(st[0], hi == 0 ? __builtin_amdgcn_exp2f(INP(15)[l * 6 + hq] * LOG2E) : 0.f);
    const int qpos[1] = {(int)(q0 + r32)};
    const unsigned fo = kvh * 4096 + lane * 16;
    if (!lat) {
        attn_seg<64, false, 1>(ws, qf, st, WS_KA + (seq0 >> 5) * 8192 + fo, 8192, WS_VTA + (seq0 >> 5) * 8192 + fo, 8192, 8, qpos, 0, hi);
    } else {
        const int ks = (int)q0 - 128 < 0 ? 0 : (int)q0 - 128, ke = q0 + 160 > 4096 ? 4096 : q0 + 160;
        attn_seg<64, true, 1>(ws, qf, st, WS_KA + ((seq0 + ks) >> 5) * 8192 + fo, 8192, WS_VTA + ((seq0 + ks) >> 5) * 8192 + fo, 8192, (ke - ks) >> 5, qpos, ks, hi);
        attn_seg<64, false, 1>(ws, qf, st, WS_CACHE + (b * 4 + l) * 131072 + fo, 8192, WS_CACHE + 1 * MiB + (b * 4 + l) * 131072 + fo, 8192, 16, qpos, 0, hi);
    }
    const float rl = 1.f / swap32_sum(st[0].l);
    const unsigned oo = WS_ACT + (row * DM + hq * 64 + 4 * hi) * 2;
#pragma unroll
    for (int db = 0; db < 2; ++db)
#pragma unroll
        for (int g = 0; g < 4; ++g) { const f32x4 v = {st[0].o[db][4 * g] * rl, st[0].o[db][4 * g + 1] * rl, st[0].o[db][4 * g + 2] * rl, st[0].o[db][4 * g + 3] * rl}; STG(u32x2, F.ws, oo + (32 * db + 8 * g) * 2) = pack4(v); }
}
__device__ __forceinline__ void attn_b_store(Frame& F, const AttnQ& s, unsigned mp, unsigned kh, unsigned row, unsigned h, unsigned hi) {
    const float lt = swap32_sum(s.l);
    const unsigned oo = WS_BO2 + (((mp * 2 + kh) * M + row) * 256 + h * 64 + 4 * hi) * 2;
#pragma unroll
    for (int db = 0; db < 2; ++db)
#pragma unroll
        for (int g = 0; g < 4; ++g) STG(u32x2, F.ws, oo + (32 * db + 8 * g) * 2) = pack4((f32x4){s.o[db][4 * g], s.o[db][4 * g + 1], s.o[db][4 * g + 2], s.o[db][4 * g + 3]});
    if (hi == 0) STG(f32x2, F.ws, WS_ML + ((((mp * 2 + kh) * M + row) * 4 + h) * 2) * 4) = (f32x2){s.m, lt};
}
__device__ __forceinline__ void attn_b_item(Frame& F, int l, bool lat, int item) {
    int lane = F.lane; asm volatile("" : "+v"(lane));
    const unsigned char* ws = F.ws;
    const unsigned r32 = lane & 31, hi = lane >> 5;
    if (lat) {
        const unsigned kh = item & 1, qb = (item >> 1) & 63, mp = (item >> 7) & 1, h = (item >> 8) & 3, b = item >> 10;
        const unsigned seq0 = MC + b * 4096, row0 = seq0 + qb * 64 + r32;
        bf16x8 qf[2][2];
#pragma unroll
        for (int q = 0; q < 2; ++q)
#pragma unroll
            for (int s = 0; s < 2; ++s) qf[q][s] = LDG(bf16x8, ws, WS_QB + ((row0 + 32 * q) * 256 + h * 64 + mp * 32 + 8 * hi) * 2 + 32 * s);
        AttnQ st[2]; attnq_init(st[0], 0.f); attnq_init(st[1], 0.f);
        const int qpos[2] = {0, 0};
        const unsigned kfo = (h * 2 + mp) * 2048 + lane * 16, vfo = h * 4096 + lane * 16;
        const unsigned blk0 = kh ? 72u : 0u, nb = kh ? 56 : 72;
        attn_seg<32, false, 2>(ws, qf, st, WS_KB + ((seq0 >> 5) + blk0) * 16384 + kfo, 16384, WS_VTB + ((seq0 >> 5) + blk0) * 16384 + vfo, 16384, nb, qpos, 0, hi);
        if (kh) attn_seg<32, false, 2>(ws, qf, st, WS_CACHE + 2 * MiB + (b * 4 + l) * 262144 + kfo, 16384, WS_CACHE + 4 * MiB + (b * 4 + l) * 262144 + vfo, 16384, 16, qpos, 0, hi);
        attn_b_store(F, st[0], mp, kh, row0, h, hi); attn_b_store(F, st[1], mp, kh, row0 + 32, h, hi);
    } else {
        const unsigned qb = item & 7, mp = (item >> 3) & 1, h = (item >> 4) & 3, b = item >> 6;
        const unsigned seq0 = b * 256, row = seq0 + qb * 32 + r32;
        bf16x8 qf[1][2];
#pragma unroll
        for (int s = 0; s < 2; ++s) qf[0][s] = LDG(bf16x8, ws, WS_QB + (row * 256 + h * 64 + mp * 32 + 8 * hi) * 2 + 32 * s);
        AttnQ st[1]; attnq_init(st[0], 0.f);
        const int qpos[1] = {0};
        const unsigned kfo = (h * 2 + mp) * 2048 + lane * 16, vfo = h * 4096 + lane * 16;
        attn_seg<32, false, 1>(ws, qf, st, WS_KB + (seq0 >> 5) * 16384 + kfo, 16384, WS_VTB + (seq0 >> 5) * 16384 + vfo, 16384, 8, qpos, 0, hi);
        attn_b_store(F, st[0], mp, 0, row, h, hi);
    }
}

constexpr int L_KT = 0, L_RT = 9216, L_BT = 18432, L_KK = 27648, L_VT = 36864, L_KKT = 46080, L_BTT = 55296, L_A1 = 64512, L_RHS2 = 81920, L_WT = 99328, L_U0T = 108544, L_GC = 117760, L_X0 = 118016;
constexpr int RPB = 144, RPF = 272;
__device__ __forceinline__ void chunk_decode(int cid, unsigned& seq0, int& T, unsigned& b, unsigned& h, unsigned& dir, int& c) {
    unsigned chain;
    if (cid < 768) { chain = (unsigned)cid >> 2; c = cid & 3; T = 256; b = chain / 12; seq0 = b * 256; }
    else { const unsigned x = (unsigned)cid - 768; chain = x >> 6; c = (int)(x & 63); T = 4096; b = chain / 12; seq0 = MC + b * 4096; }
    dir = chain & 1; h = (chain >> 1) % 6;
}
__device__ __forceinline__ bf16x8 acc_frag(const f32x16& x, int ks, float sgn) {
    u32x4 w; w.x = pk2(sgn * x[8 * ks], sgn * x[8 * ks + 1]); w.y = pk2(sgn * x[8 * ks + 2], sgn * x[8 * ks + 3]); w.z = pk2(sgn * x[8 * ks + 4], sgn * x[8 * ks + 5]); w.w = pk2(sgn * x[8 * ks + 6], sgn * x[8 * ks + 7]);
    return __builtin_bit_cast(bf16x8, w);
}
__device__ __forceinline__ bf16x8 lds_frag_nat(const LAS unsigned char* img, unsigned row, int ks, unsigned hi) { return *(const LAS bf16x8*)(img + row * RPB + (16 * ks + 8 * hi) * 2); }
__device__ __forceinline__ bf16x8 lds_frag_perm(const LAS unsigned char* img, unsigned row, int k0, unsigned hi) {
    const s16x4 a = *(const LAS s16x4*)(img + row * RPB + (k0 + 4 * hi) * 2), b = *(const LAS s16x4*)(img + row * RPB + (k0 + 8 + 4 * hi) * 2);
    return (bf16x8){a[0], a[1], a[2], a[3], b[0], b[1], b[2], b[3]};
}
__device__ __forceinline__ f32x16 gram_tile(const LAS unsigned char* lds, int aimg, int bimg, int sb, int tb, unsigned r32, unsigned hi, bool strict) {
    f32x16 acc = {};
#pragma unroll
    for (int ks = 0; ks < 4; ++ks) acc = MFMA32(lds_frag_nat(lds + aimg, 32 * sb + r32, ks, hi), lds_frag_nat(lds + bimg, 32 * tb + r32, ks, hi), acc);
    if (sb == tb) {
#pragma unroll
        for (int r = 0; r < 16; ++r) { const unsigned s_ = (r & 3) + 8 * (r >> 2) + 4 * hi; const bool keep = strict ? s_ < r32 : s_ <= r32; acc[r] = keep ? acc[r] : 0.f; }
    }
    return acc;
}
__device__ __forceinline__ void lds_barrier() { asm volatile("s_waitcnt lgkmcnt(0)\n\ts_barrier" ::: "memory"); }
__device__ __forceinline__ void rwkv_chunk_block(Frame& F, int l, int cid) {
    int lane = F.lane; asm volatile("" : "+v"(lane));
    const unsigned char* ws = F.ws; LAS unsigned char* lds = F.lds;
    const int w = F.wave; const unsigned r32 = lane & 31, hi = lane >> 5;
    unsigned seq0, b, h, dir; int T, c; chunk_decode(cid, seq0, T, b, h, dir, c);
    const int q0 = 64 * c;
#ifndef RA_REP
#define RA_REP 0
#endif
    const int role = w >> 1, tb = w & 1;
    const unsigned swo = WS_SMALLW + l * (SMALLW_L * 2);
    {
        const int pw_ = w < 4, pb = (w >> 1) & 1, cb = w & 1;
        const int p_ = 32 * pb + r32; const unsigned tokp = seq0 + (dir ? T - 1 - (q0 + p_) : q0 + p_);
        const unsigned xo = (pw_ ? WS_CW : WS_CA) + (tokp * 128 + dir * 64 + 8 * hi) * 2, wo = swo + ((pw_ ? 0 : 49152) + (dir * 384 + h * 64 + 32 * cb + r32) * 64 + 8 * hi) * 2;
        f32x16 acc = {};
#pragma unroll
        for (int ks = 0; ks < 4; ++ks) acc = MFMA32(LDG(bf16x8, ws, xo + 32 * ks), LDG(bf16x8, ws, wo + 32 * ks), acc);
        {
            const float bias = LDG(float, pw_ ? INP(19) : INP(21), ((l * 2 + dir) * 384 + h * 64 + 32 * cb + r32) * 4);
#pragma unroll
            for (int r = 0; r < 16; ++r) { const float sg = sigmf(bias + acc[r]);
                *(LAS float*)(lds + (pw_ ? L_A1 : L_RHS2) + (32 * pb + (r & 3) + 8 * (r >> 2) + 4 * hi) * RPF + (32 * cb + r32) * 4) = pw_ ? -0.606531f * sg : sg; }
        }
        if (dir == 0 && w < 4) {
            f32x16 ag = {};
            const unsigned go = WS_CG + (tokp * 128 + 8 * hi) * 2, gw_ = swo + (98304 + (h * 64 + 32 * cb + r32) * 128 + 8 * hi) * 2;
#pragma unroll
            for (int ks = 0; ks < 8; ++ks) ag = MFMA32(LDG(bf16x8, ws, go + 32 * ks), LDG(bf16x8, ws, gw_ + 32 * ks), ag);
#pragma unroll
            for (int r = 0; r < 16; ++r) { const int pp_ = 32 * pb + (r & 3) + 8 * (r >> 2) + 4 * hi; const unsigned tk = seq0 + q0 + pp_;
                STG(bf16_t, F.ws, WS_G + (tk * 384 + h * 64 + 32 * cb + r32) * 2) = (bf16_t)(pk2(ag[r], 0.f) & 0xffff); }
        }
    }
    lds_barrier();
    {
        const unsigned cch = h * 64 + lane;
        const float* convp = INP(18) + (size_t)l * 3 * 1152;
        float cw_[3][3];
#pragma unroll
        for (int tap = 0; tap < 3; ++tap)
#pragma unroll
            for (int seg = 0; seg < 3; ++seg) cw_[tap][seg] = LDG(float, convp, (tap * 1152 + seg * 384 + cch) * 4);
        const float ckk = LDG(float, INP(24), (l * 384 + cch) * 4), cka = LDG(float, INP(25), (l * 384 + cch) * 4), crk = LDG(float, INP(26), (l * 384 + cch) * 4);
        const int tb0 = dir ? T - 1 - (q0 + 8 * w + 7) : q0 + 8 * w;
        float xr[10][3];
#pragma unroll
        for (int rr = 0; rr < 10; ++rr) { const int tr = tb0 - 1 + rr; const bool ok = tr >= 0 && tr < T; const unsigned tk = seq0 + (ok ? tr : tb0);
#pragma unroll
            for (int seg = 0; seg < 3; ++seg) { const float x = bf_lo((unsigned)LDG(bf16_t, ws, WS_RKV + (tk * 1152 + seg * 384 + cch) * 2)); xr[rr][seg] = ok ? x : 0.f; } }
        float lwv[8], kkv[8], btv[8], kdv[8], rv[8], vv[8], g = 0.f;
#pragma unroll
        for (int pp = 0; pp < 8; ++pp) {
            const int rr = 1 + (dir ? 7 - pp : pp); const int p = 8 * w + pp; const unsigned tok = seq0 + (unsigned)(tb0 + rr - 1);
            const float r_ = xr[rr - 1][0] * cw_[0][0] + xr[rr][0] * cw_[1][0] + xr[rr + 1][0] * cw_[2][0];
            const float k_ = xr[rr - 1][1] * cw_[0][1] + xr[rr][1] * cw_[1][1] + xr[rr + 1][1] * cw_[2][1];
            const float v_ = xr[rr - 1][2] * cw_[0][2] + xr[rr][2] * cw_[1][2] + xr[rr + 1][2] * cw_[2][2];
            const float kraw = k_ * ckk; const float n2 = wave_sum(kraw * kraw); const float kk_ = kraw * __builtin_amdgcn_rsqf(fmaxf(n2, 1e-24f));
            const float lw = *(const LAS float*)(lds + L_A1 + p * RPF + lane * 4), av = *(const LAS float*)(lds + L_RHS2 + p * RPF + lane * 4);
            const float kd_ = k_ * (1.f + (av - 1.f) * cka);
            const float bon = wave_sum(r_ * kd_ * crk);
            if (lane == 0) STG(float, F.ws, WS_SB + ((dir * M + tok) * 8 + h) * 4) = bon;
            if (dir == 0) STG(float, F.ws, WS_SV + (tok * 384 + cch) * 4) = v_;
            lwv[pp] = lw; kkv[pp] = kk_; btv[pp] = kk_ * av; kdv[pp] = kd_; rv[pp] = r_; vv[pp] = v_; g += lw;
        }
        g = 0.f;
        for (int wq = 0; wq < w; ++wq) { float t8[8];
#pragma unroll
            for (int e = 0; e < 8; ++e) t8[e] = *(const LAS float*)(lds + L_A1 + (8 * wq + e) * RPF + lane * 4);
            g += ((t8[0] + t8[1]) + (t8[2] + t8[3])) + ((t8[4] + t8[5]) + (t8[6] + t8[7])); }
        unsigned vt[4], kkt[4], btt[4]; float e_pos = __expf(g);
#pragma unroll
        for (int pp = 0; pp < 8; ++pp) {
            const int p = 8 * w + pp;
            const float e_prev = e_pos; g += lwv[pp]; e_pos = __expf(g); const float e_neg = __expf(-g);
            const unsigned pk_kr = pk2(kkv[pp] * e_prev, rv[pp] * e_pos), pk_bk = pk2(btv[pp] * e_neg, kdv[pp] * e_neg), pk_v = pk2(vv[pp], 0.f);
            *(LAS bf16_t*)(lds + L_KT + p * RPB + lane * 2) = (bf16_t)(pk_kr & 0xffff); *(LAS bf16_t*)(lds + L_RT + p * RPB + lane * 2) = (bf16_t)(pk_kr >> 16);
            *(LAS bf16_t*)(lds + L_BT + p * RPB + lane * 2) = (bf16_t)(pk_bk & 0xffff); *(LAS bf16_t*)(lds + L_KK + p * RPB + lane * 2) = (bf16_t)(pk_bk >> 16);
            if (pp & 1) { vt[pp >> 1] |= pk_v << 16; kkt[pp >> 1] |= pk_bk & 0xffff0000u; btt[pp >> 1] |= pk_bk << 16; }
            else { vt[pp >> 1] = pk_v & 0xffff; kkt[pp >> 1] = pk_bk >> 16; btt[pp >> 1] = pk_bk & 0xffff; }
        }
        *(LAS u32x4*)(lds + L_VT + lane * RPB + 16 * w) = (u32x4){vt[0], vt[1], vt[2], vt[3]};
        *(LAS u32x4*)(lds + L_KKT + lane * RPB + 16 * w) = (u32x4){kkt[0], kkt[1], kkt[2], kkt[3]};
        *(LAS u32x4*)(lds + L_BTT + lane * RPB + 16 * w) = (u32x4){btt[0], btt[1], btt[2], btt[3]};
        if (w == 7) *(LAS float*)(lds + L_GC + lane * 4) = e_pos;
    }
    lds_barrier();
    f32x16 keep[2]; bf16x8 x4f[2][2];
    if (role == 0) {
        for (int sb = 0; sb <= tb; ++sb) { const f32x16 x = gram_tile(lds, L_BT, L_KT, sb, tb, r32, hi, true);
            if (sb == tb) {
#pragma unroll
                for (int r = 0; r < 16; ++r) *(LAS float*)(lds + L_A1 + tb * 4608 + ((r & 3) + 8 * (r >> 2) + 4 * hi) * 144 + r32 * 4) = -x[r];
            } else {
#pragma unroll
                for (int g4 = 0; g4 < 4; ++g4) *(LAS f32x4*)(lds + L_A1 + 9216 + r32 * 144 + (8 * g4 + 4 * hi) * 4) = (f32x4){x[4 * g4], x[4 * g4 + 1], x[4 * g4 + 2], x[4 * g4 + 3]};
            } }
    } else if (role == 1) {
        f32x16 o[2] = {};
        for (int sb = 0; sb <= tb; ++sb) {
            const f32x16 x = gram_tile(lds, L_KK, L_KT, sb, tb, r32, hi, true);
#pragma unroll
            for (int ks = 0; ks < 2; ++ks) { const bf16x8 a = acc_frag(x, ks, 1.f);
#pragma unroll
                for (int ib = 0; ib < 2; ++ib) o[ib] = MFMA32(a, lds_frag_perm(lds + L_VT, 32 * ib + r32, 32 * sb + 16 * ks, hi), o[ib]); }
        }
#pragma unroll
        for (int ib = 0; ib < 2; ++ib)
#pragma unroll
            for (int r = 0; r < 16; ++r) *(LAS float*)(lds + L_RHS2 + (32 * tb + (r & 3) + 8 * (r >> 2) + 4 * hi) * RPF + (32 * ib + r32) * 4) = o[ib][r];
    } else if (role == 2) {
#pragma unroll
        for (int sb = 0; sb < 2; ++sb) { x4f[sb][0] = (bf16x8){}; x4f[sb][1] = (bf16x8){}; }
        keep[0] = (f32x16){}; keep[1] = (f32x16){};
        for (int sb = 0; sb <= tb; ++sb) {
            const f32x16 x3 = gram_tile(lds, L_KK, L_RT, sb, tb, r32, hi, false), x4 = gram_tile(lds, L_BT, L_RT, sb, tb, r32, hi, false);
#pragma unroll
            for (int ks = 0; ks < 2; ++ks) { const bf16x8 a3 = acc_frag(x3, ks, 1.f); const bf16x8 a4 = acc_frag(x4, ks, -1.f);
                if (sb == 0) x4f[0][ks] = a4; else x4f[1][ks] = a4;
#pragma unroll
                for (int cb = 0; cb < 2; ++cb) keep[cb] = MFMA32(a3, lds_frag_perm(lds + L_VT, 32 * cb + r32, 32 * sb + 16 * ks, hi), keep[cb]); }
        }
    } else {
        keep[0] = (f32x16){}; keep[1] = (f32x16){};
#pragma unroll
        for (int ks = 0; ks < 4; ++ks) { const bf16x8 ak = lds_frag_nat(lds + L_KKT, 32 * tb + r32, ks, hi);
#pragma unroll
            for (int cb = 0; cb < 2; ++cb) keep[cb] = MFMA32(ak, lds_frag_nat(lds + L_VT, 32 * cb + r32, ks, hi), keep[cb]); }
    }
    lds_barrier();
    if (w < 2) {
        const LAS unsigned char* a1p = lds + L_A1; asm volatile("" : "+v"(a1p));
        LAS unsigned char* xp = lds + (w == 0 ? L_X0 : L_RHS2) + lane * 4; asm volatile("" : "+v"(xp));
        const LAS unsigned char* kp = lds + L_KT + lane * 2; asm volatile("" : "+v"(kp));
        LAS unsigned char* dst = lds + (w == 0 ? L_WT : L_U0T) + lane * RPB; asm volatile("" : "+v"(dst));
#pragma unroll
        for (int B = 0; B < 2; ++B) {
            float acc[32];
            if (w == 0 && B == 0) {
#pragma unroll
                for (int r = 0; r < 32; ++r) acc[r] = bf_lo((unsigned)*(const LAS bf16_t*)(kp + r * RPB));
            } else {
#pragma unroll
                for (int r = 0; r < 32; ++r) acc[r] = *(const LAS float*)(xp + (32 * B + r) * RPF);
            }
            f32x2 ac2[16];
#pragma unroll
            for (int k = 0; k < 16; ++k) ac2[k] = (f32x2){acc[2 * k], acc[2 * k + 1]};
            f32x4 ca[8], cn[8];
#pragma unroll
            for (int tg = 0; tg < 8; ++tg) ca[tg] = *(const LAS f32x4*)(a1p + B * 4608 + tg * 16);
#pragma unroll
            for (int s_ = 0; s_ < 31; ++s_) {
                if (s_ + 1 < 31) {
#pragma unroll
                    for (int tg = (s_ + 2) / 4; tg < 8; ++tg) cn[tg] = *(const LAS f32x4*)(a1p + B * 4608 + (s_ + 1) * 144 + tg * 16);
                }
                __builtin_amdgcn_sched_barrier(0);
                const float xs = ac2[s_ >> 1][s_ & 1];
                const f32x2 xs2 = {xs, xs};
#pragma unroll
                for (int tg = (s_ + 1) / 4; tg < 8; ++tg) {
                    ac2[2 * tg] = __builtin_elementwise_fma((f32x2){ca[tg][0], ca[tg][1]}, xs2, ac2[2 * tg]);
                    ac2[2 * tg + 1] = __builtin_elementwise_fma((f32x2){ca[tg][2], ca[tg][3]}, xs2, ac2[2 * tg + 1]); }
                __builtin_amdgcn_sched_barrier(0);
#pragma unroll
                for (int tg = 0; tg < 8; ++tg) ca[tg] = cn[tg];
            }
#pragma unroll
            for (int k = 0; k < 16; ++k) { acc[2 * k] = ac2[k][0]; acc[2 * k + 1] = ac2[k][1]; }
#pragma unroll
            for (int k8 = 0; k8 < 4; ++k8) { u32x4 v; v.x = pk2(acc[8 * k8], acc[8 * k8 + 1]); v.y = pk2(acc[8 * k8 + 2], acc[8 * k8 + 3]); v.z = pk2(acc[8 * k8 + 4], acc[8 * k8 + 5]); v.w = pk2(acc[8 * k8 + 6], acc[8 * k8 + 7]);
                *(LAS u32x4*)(dst + 64 * B + 16 * k8) = v; }
            if (B == 0) {
                asm volatile("s_waitcnt lgkmcnt(0)" ::: "memory");
                f32x16 u[2];
#pragma unroll
                for (int cb = 0; cb < 2; ++cb)
#pragma unroll
                    for (int r = 0; r < 16; ++r) { const int t = 32 + (r & 3) + 8 * (r >> 2) + 4 * hi;
                        u[cb][r] = w == 0 ? bf_lo((unsigned)*(const LAS bf16_t*)(lds + L_KT + t * RPB + (32 * cb + r32) * 2)) : *(const LAS float*)(lds + L_RHS2 + t * RPF + (32 * cb + r32) * 4); }
#pragma unroll
                for (int ks = 0; ks < 2; ++ks) { const f32x4 a0 = *(const LAS f32x4*)(lds + L_A1 + 9216 + r32 * 144 + (16 * ks + 8 * hi) * 4), a1 = *(const LAS f32x4*)(lds + L_A1 + 9216 + r32 * 144 + (16 * ks + 8 * hi + 4) * 4);
                    u32x4 aw; aw.x = pk2(-a0[0], -a0[1]); aw.y = pk2(-a0[2], -a0[3]); aw.z = pk2(-a1[0], -a1[1]); aw.w = pk2(-a1[2], -a1[3]);
#pragma unroll
                    for (int cb = 0; cb < 2; ++cb) u[cb] = MFMA32(__builtin_bit_cast(bf16x8, aw), lds_frag_nat(lds + (w == 0 ? L_WT : L_U0T), 32 * cb + r32, ks, hi), u[cb]); }
#pragma unroll
                for (int cb = 0; cb < 2; ++cb)
#pragma unroll
                    for (int r = 0; r < 16; ++r) *(LAS float*)(lds + (w == 0 ? L_X0 : L_RHS2) + (32 + (r & 3) + 8 * (r >> 2) + 4 * hi) * RPF + (32 * cb + r32) * 4) = u[cb][r];
                asm volatile("s_waitcnt lgkmcnt(0)" ::: "memory");
            }
        }
    }
    lds_barrier();
    if (role == 2) {
        f32x16 pj[2];
#pragma unroll
        for (int jb = 0; jb < 2; ++jb)
#pragma unroll
            for (int r = 0; r < 16; ++r) pj[jb][r] = bf_lo((unsigned)*(const LAS bf16_t*)(lds + L_RT + (32 * tb + (r & 3) + 8 * (r >> 2) + 4 * hi) * RPB + (32 * jb + r32) * 2));
#pragma unroll
        for (int sb = 0; sb < 2; ++sb)
#pragma unroll
            for (int ks = 0; ks < 2; ++ks)
#pragma unroll
                for (int cb = 0; cb < 2; ++cb) {
                    keep[cb] = MFMA32(x4f[sb][ks], lds_frag_perm(lds + L_U0T, 32 * cb + r32, 32 * sb + 16 * ks, hi), keep[cb]);
                    pj[cb] = MFMA32(x4f[sb][ks], lds_frag_perm(lds + L_WT, 32 * cb + r32, 32 * sb + 16 * ks, hi), pj[cb]); }
        f32x16 (&y0)[2] = keep;
        const unsigned yb = dir ? WS_YB : WS_YF;
#pragma unroll
        for (int r = 0; r < 16; ++r) { const int t = 32 * tb + (r & 3) + 8 * (r >> 2) + 4 * hi; const unsigned tok = seq0 + (dir ? T - 1 - (q0 + t) : q0 + t);
#pragma unroll
            for (int cb = 0; cb < 2; ++cb) { STG(float, F.ws, yb + (tok * 384 + h * 64 + 32 * cb + r32) * 4) = y0[cb][r];
                STG(bf16_t, F.ws, WS_RP + (((unsigned)cid * 64 + t) * 64 + 32 * cb + r32) * 2) = (bf16_t)(pk2(pj[cb][r], 0.f) & 0xffff); } }
    } else if (role == 3) {
        const int jb = tb;
        f32x16 q1[2] = {}, q2[2] = {}; f32x16 (&n1)[2] = keep;
#pragma unroll
        for (int ks = 0; ks < 4; ++ks) { const bf16x8 a = lds_frag_nat(lds + L_BTT, 32 * jb + r32, ks, hi);
#pragma unroll
            for (int cb = 0; cb < 2; ++cb) { q1[cb] = MFMA32(lds_frag_nat(lds + L_WT, 32 * cb + r32, ks, hi), a, q1[cb]); q2[cb] = MFMA32(a, lds_frag_nat(lds + L_U0T, 32 * cb + r32, ks, hi), q2[cb]); } }
#pragma unroll
        for (int q = 0; q < 4; ++q) { f32x4 gc4;
#pragma unroll
            for (int e = 0; e < 4; ++e) gc4[e] = *(const LAS float*)(lds + L_GC + (32 * jb + e + 8 * q + 4 * hi) * 4);
#pragma unroll
            for (int cb = 0; cb < 2; ++cb) { f32x4 nv;
#pragma unroll
                for (int e = 0; e < 4; ++e) nv[e] = gc4[e] * (n1[cb][4 * q + e] - q2[cb][4 * q + e]);
                STG(f32x4, F.ws, WS_RN + ((((unsigned)cid * 2 + jb) * 2 + cb) * 4 + q) * 1024 + lane * 16) = nv; } }
        { const float gl = *(const LAS float*)(lds + L_GC + (32 * jb + r32) * 4);
#pragma unroll
          for (int cb = 0; cb < 2; ++cb)
#pragma unroll
            for (int s2 = 0; s2 < 2; ++s2) { float mv[8];
#pragma unroll
                for (int e = 0; e < 8; ++e) { const int r = 8 * s2 + e; const unsigned c = 32 * cb + (r & 3) + 8 * (r >> 2) + 4 * hi; mv[e] = (c == 32 * jb + r32 ? gl : 0.f) - gl * q1[cb][r]; }
                u32x4 w; w.x = pk2(mv[0], mv[1]); w.y = pk2(mv[2], mv[3]); w.z = pk2(mv[4], mv[5]); w.w = pk2(mv[6], mv[7]);
                STG(u32x4, F.ws, WS_RM + (unsigned)cid * 8192 + ((jb * 2 + cb) * 2 + s2) * 1024 + lane * 16) = w; } }
    }
    lds_barrier();
}
__device__ __forceinline__ void rwkv_chain_wave(Frame& F, int l, bool lat, int chain, int ib) {
    int lane = F.lane; asm volatile("" : "+v"(lane));
    const unsigned char* ws = F.ws; const unsigned r32 = lane & 31, hi = lane >> 5;
    const unsigned dir = chain & 1, h = (chain >> 1) % 6, b = chain / 12;
    const int nc = lat ? 64 : 4; const unsigned cid0 = lat ? 768 + chain * 64 : chain * 4;
    const unsigned i = 32 * ib + r32;
    const unsigned so = ((((b * 4 + l) * 6 + h) * 64 + i) * 64) * 4;
    f32x16 H[2];
#pragma unroll
    for (int jb = 0; jb < 2; ++jb)
#pragma unroll
        for (int g4 = 0; g4 < 4; ++g4) { f32x4 v = {0.f, 0.f, 0.f, 0.f}; if (lat) v = LDG(f32x4, dir ? INP(7) : INP(6), so + (32 * jb + 8 * g4 + 4 * hi) * 4);
            H[jb][4 * g4] = v[0]; H[jb][4 * g4 + 1] = v[1]; H[jb][4 * g4 + 2] = v[2]; H[jb][4 * g4 + 3] = v[3]; }
    bf16x8 maA[2][2][2], maB[2][2][2]; f32x16 ntA[2], ntB[2];
    const GAS unsigned char* pm = (const GAS unsigned char*)ws + (WS_RM + cid0 * 8192 + lane * 16);
    const GAS unsigned char* pn = (const GAS unsigned char*)ws + (WS_RN + (cid0 * 4 + ib) * 4096 + lane * 16);
#define RB_LOAD(ma, nt, k_) do { \
        _Pragma("unroll") for (int jo = 0; jo < 2; ++jo) _Pragma("unroll") for (int ji = 0; ji < 2; ++ji) _Pragma("unroll") for (int ks = 0; ks < 2; ++ks) ma[jo][ji][ks] = *(const GAS bf16x8*)(pm + ((k_) * 8192 + ((jo * 2 + ji) * 2 + ks) * 1024)); \
        _Pragma("unroll") for (int jo = 0; jo < 2; ++jo) _Pragma("unroll") for (int q = 0; q < 4; ++q) { const f32x4 t_ = *(const GAS f32x4*)(pn + ((k_) * 16384 + (jo * 8 + q) * 1024)); \
            nt[jo][4 * q] = t_[0]; nt[jo][4 * q + 1] = t_[1]; nt[jo][4 * q + 2] = t_[2]; nt[jo][4 * q + 3] = t_[3]; } } while (0)
#define RB_STEP(ma, nt, cid_) do { \
        bf16x8 hf[2][2]; \
        _Pragma("unroll") for (int ji = 0; ji < 2; ++ji) { hf[ji][0] = acc_frag(H[ji], 0, 1.f); hf[ji][1] = acc_frag(H[ji], 1, 1.f); } \
        _Pragma("unroll") for (int ji = 0; ji < 2; ++ji) _Pragma("unroll") for (int ks = 0; ks < 2; ++ks) STG(bf16x8, F.ws, WS_RH + (cid_) * 8192 + ((ib * 2 + ji) * 2 + ks) * 1024 + lane * 16) = hf[ji][ks]; \
        f32x16 acc[2] = {nt[0], nt[1]}; \
        _Pragma("unroll") for (int jo = 0; jo < 2; ++jo) _Pragma("unroll") for (int ji = 0; ji < 2; ++ji) _Pragma("unroll") for (int ks = 0; ks < 2; ++ks) acc[jo] = MFMA32(ma[jo][ji][ks], hf[ji][ks], acc[jo]); \
        H[0] = acc[0]; H[1] = acc[1]; } while (0)
    RB_LOAD(maA, ntA, 0); RB_LOAD(maB, ntB, 1);
#pragma unroll 1
    for (int c = 0; c < nc; c += 2) {
        const unsigned cid = cid0 + c;
        RB_STEP(maA, ntA, cid);
        if (c + 2 < nc) RB_LOAD(maA, ntA, 2);
        RB_STEP(maB, ntB, cid + 1);
        if (c + 2 < nc) RB_LOAD(maB, ntB, 3);
        pm += 16384; pn += 32768;
    }
#undef RB_LOAD
#undef RB_STEP
    if (!lat) {
#pragma unroll
        for (int jb = 0; jb < 2; ++jb)
#pragma unroll
            for (int g4 = 0; g4 < 4; ++g4) STG(f32x4, F.out, (dir ? OFF_CB : OFF_CF) * 4 + so + (32 * jb + 8 * g4 + 4 * hi) * 4) = (f32x4){H[jb][4 * g4], H[jb][4 * g4 + 1], H[jb][4 * g4 + 2], H[jb][4 * g4 + 3]};
    }
}
__device__ __forceinline__ void rwkv_apply_wave(Frame& F, int item) {
    int lane = F.lane; asm volatile("" : "+v"(lane));
    const unsigned char* ws = F.ws; const unsigned r32 = lane & 31, hi = lane >> 5;
    const int cid = item >> 1, tb = item & 1;
    unsigned seq0, b, h, dir; int T, c; chunk_decode(cid, seq0, T, b, h, dir, c);
    const unsigned yb = dir ? WS_YB : WS_YF;
    f32x16 acc[2];
#pragma unroll
    for (int r = 0; r < 16; ++r) { const int t = 32 * tb + (r & 3) + 8 * (r >> 2) + 4 * hi; const unsigned tok = seq0 + (dir ? T - 1 - (64 * c + t) : 64 * c + t);
        acc[0][r] = LDG(float, ws, yb + (tok * 384 + h * 64 + r32) * 4); acc[1][r] = LDG(float, ws, yb + (tok * 384 + h * 64 + 32 + r32) * 4); }
#pragma unroll
    for (int ks = 0; ks < 4; ++ks) { const bf16x8 a = LDG(bf16x8, ws, WS_RP + (((unsigned)cid * 64 + 32 * tb + r32) * 64 + 16 * ks + 8 * hi) * 2);
#pragma unroll
        for (int ib = 0; ib < 2; ++ib) acc[ib] = MFMA32(a, LDG(bf16x8, ws, WS_RH + (((unsigned)cid * 64 + 32 * ib + r32) * 64 + 16 * ks + 8 * hi) * 2), acc[ib]); }
#pragma unroll
    for (int r = 0; r < 16; ++r) { const int t = 32 * tb + (r & 3) + 8 * (r >> 2) + 4 * hi; const unsigned tok = seq0 + (dir ? T - 1 - (64 * c + t) : 64 * c + t);
        STG(float, F.ws, yb + (tok * 384 + h * 64 + r32) * 4) = acc[0][r]; STG(float, F.ws, yb + (tok * 384 + h * 64 + 32 + r32) * 4) = acc[1][r]; }
}

__device__ __forceinline__ void rwkv_out_item(Frame& F, int l, int item) {
    int lane = F.lane; asm volatile("" : "+v"(lane));
    const unsigned char* ws = F.ws; const unsigned r32 = lane & 31, hi = lane >> 5;
    const int tb = item & 1, h = (item >> 1) % 6, sk = item / 12;
    const bool lat = sk >= 64; const int b = lat ? (sk - 64) >> 6 : sk >> 2, k = lat ? (sk - 64) & 63 : sk & 3, nc = lat ? 64 : 4;
    const unsigned seq0 = lat ? MC + b * 4096 : b * 256, base = lat ? 768u : 0u;
    const unsigned chf = (b * 6 + h) * 2, cidf = base + chf * nc + k, cidb = base + (chf + 1) * nc + (nc - 1 - k);
    const unsigned tok0 = seq0 + 64 * k + 32 * tb;
    f32x16 acc[2];
#pragma unroll
    for (int r = 0; r < 16; ++r) { const unsigned tok = tok0 + (r & 3) + 8 * (r >> 2) + 4 * hi; const unsigned e = (tok * 384 + h * 64 + r32) * 4;
        acc[0][r] = LDG(float, ws, WS_YF + e) + LDG(float, ws, WS_YB + e); acc[1][r] = LDG(float, ws, WS_YF + e + 128) + LDG(float, ws, WS_YB + e + 128); }
    const unsigned pf = 32 * tb + r32, pb_ = 63 - 32 * tb - r32;
#pragma unroll
    for (int ks = 0; ks < 4; ++ks) {
        const s16x4 f0 = LDG(s16x4, ws, WS_RP + ((cidf * 64 + pf) * 64 + 16 * ks + 4 * hi) * 2), f1 = LDG(s16x4, ws, WS_RP + ((cidf * 64 + pf) * 64 + 16 * ks + 8 + 4 * hi) * 2);
        const s16x4 b0_ = LDG(s16x4, ws, WS_RP + ((cidb * 64 + pb_) * 64 + 16 * ks + 4 * hi) * 2), b1_ = LDG(s16x4, ws, WS_RP + ((cidb * 64 + pb_) * 64 + 16 * ks + 8 + 4 * hi) * 2);
        const bf16x8 af = {f0[0], f0[1], f0[2], f0[3], f1[0], f1[1], f1[2], f1[3]}, ab = {b0_[0], b0_[1], b0_[2], b0_[3], b1_[0], b1_[1], b1_[2], b1_[3]};
#pragma unroll
        for (int ib = 0; ib < 2; ++ib) { acc[ib] = MFMA32(af, LDG(bf16x8, ws, WS_RH + cidf * 8192 + (ib * 4 + ks) * 1024 + lane * 16), acc[ib]);
            acc[ib] = MFMA32(ab, LDG(bf16x8, ws, WS_RH + cidb * 8192 + (ib * 4 + ks) * 1024 + lane * 16), acc[ib]); } }
    const float g0 = LDG(float, INP(27), (l * 384 + h * 64 + r32) * 4), g1 = LDG(float, INP(27), (l * 384 + h * 64 + 32 + r32) * 4), b0 = LDG(float, INP(28), (l * 384 + h * 64 + r32) * 4), b1 = LDG(float, INP(28), (l * 384 + h * 64 + 32 + r32) * 4);
    const int xl = (lane ^ 16) << 2;
#pragma unroll
    for (int r = 0; r < 16; ++r) { const unsigned tok = tok0 + (r & 3) + 8 * (r >> 2) + 4 * hi; const unsigned e = tok * 384 + h * 64 + r32;
        const float bon = LDG(float, ws, WS_SB + (tok * 8 + h) * 4) + LDG(float, ws, WS_SB + ((M + tok) * 8 + h) * 4);
        const float y0 = acc[0][r] + bon * LDG(float, ws, WS_SV + e * 4), y1 = acc[1][r] + bon * LDG(float, ws, WS_SV + (e + 32) * 4);
        float s = allreduce16(y0 + y1); s += __builtin_bit_cast(float, __builtin_amdgcn_ds_bpermute(xl, __builtin_bit_cast(int, s)));
        const float mu = s * (1.f / 64.f), d0 = y0 - mu, d1 = y1 - mu;
        float q = allreduce16(d0 * d0 + d1 * d1); q += __builtin_bit_cast(float, __builtin_amdgcn_ds_bpermute(xl, __builtin_bit_cast(int, q)));
        const float rs = rsqrtf(q * (1.f / 64.f) + 64e-5f);
        const float o0 = (d0 * rs * g0 + b0) * bf_lo((unsigned)LDG(bf16_t, ws, WS_G + e * 2)), o1 = (d1 * rs * g1 + b1) * bf_lo((unsigned)LDG(bf16_t, ws, WS_G + (e + 32) * 2));
        const unsigned pk = pk2(o0, o1);
        STG(bf16_t, F.ws, WS_ACT + (tok * DM + 640 + h * 64 + r32) * 2) = (bf16_t)(pk & 0xffff); STG(bf16_t, F.ws, WS_ACT + (tok * DM + 640 + h * 64 + 32 + r32) * 2) = (bf16_t)(pk >> 16); }
}

#ifndef B_UNIT
#define B_UNIT 0
#endif
constexpr int AU_R = 8, AU_D = 4, AU_SLOT = 6144;
__device__ __forceinline__ void attn_b_unit(Frame& F, int l, int unit) {
    int lane = F.lane; asm volatile("" : "+v"(lane));
    const unsigned char* ws = F.ws; LAS unsigned char* lds = F.lds;
    const int w = F.wave; const unsigned r32 = lane & 31, hi = lane >> 5;
    const unsigned kh = unit & 1, qb = (unit >> 1) & 15, mp = (unit >> 5) & 1, h = (unit >> 6) & 3, b = unit >> 8;
    const unsigned seq0 = MC + b * 4096, row = seq0 + qb * 256 + 32 * w + r32;
    bf16x8 qf[1][2];
#pragma unroll
    for (int s = 0; s < 2; ++s) qf[0][s] = LDG(bf16x8, ws, WS_QB + (row * 256 + h * 64 + mp * 32 + 8 * hi) * 2 + 32 * s);
    AttnQ st[1]; attnq_init(st[0], 0.f);
    const int qpos[1] = {0};
    const int n0 = kh ? 56 : 72, nt = 72;
    const unsigned pofs = (w < 2 ? (h * 2 + mp) * 2048 + w * 1024 : h * 4096 + (w - 2) * 1024) + lane * 16;
    const unsigned base0 = (w < 2 ? WS_KB : WS_VTB) + ((seq0 >> 5) + (kh ? 72u : 0u)) * 16384 + pofs;
    const unsigned base1 = WS_CACHE + (w < 2 ? 2 * MiB : 4 * MiB) + (b * 4 + l) * 262144 + pofs;
#define AU_DMA(t_) do { const int tt_ = (t_) < nt ? (t_) : nt - 1; const unsigned src_ = tt_ < n0 ? base0 + tt_ * 16384 : base1 + (tt_ - n0) * 16384; \
        __builtin_amdgcn_global_load_lds((const GAS unsigned*)(ws + src_), (LAS unsigned*)(lds + ((t_) % AU_R) * AU_SLOT + w * 1024), 16, 0, 0); } while (0)
    if (w < 6) {
#pragma unroll
        for (int t = 0; t < AU_D; ++t) AU_DMA(t);
    }
    for (int t = 0; t < nt; ++t) {
        if (w < 6) asm volatile("s_waitcnt vmcnt(3)" ::: "memory");
        asm volatile("s_barrier" ::: "memory");
        const LAS unsigned char* sl = lds + (t % AU_R) * AU_SLOT + lane * 16;
        bf16x8 kf[2], vf[4];
        kf[0] = *(const LAS bf16x8*)(sl); kf[1] = *(const LAS bf16x8*)(sl + 1024);
#pragma unroll
        for (int f = 0; f < 4; ++f) vf[f] = *(const LAS bf16x8*)(sl + 2048 + 1024 * f);
        if (w < 6) AU_DMA(t + AU_D);
        attn_block<32, false, 1>(qf, kf, vf, st, t, qpos, 0, hi);
    }
#undef AU_DMA
    asm volatile("s_waitcnt vmcnt(0) lgkmcnt(0)\n\ts_barrier" ::: "memory");
    attn_b_store(F, st[0], mp, kh, row, h, hi);
}

constexpr int Q_BLAT = 2048, Q_ALAT = 1536, Q_BCTX = 1024, Q_ACTX = 768;
constexpr int Q_TOTAL = Q_BLAT + Q_ALAT + Q_BCTX + Q_ACTX;
#ifndef XCD_DEAL
#define XCD_DEAL 1
#endif
__device__ __forceinline__ void phase_mixer(Frame& F, int l, int rep) {
    if (rep == 0 || REP_PART == 0 || REP_PART == 1) {
        const int si = F.bid + F.G * F.wave;
        if (si < 48) rwkv_chain_wave(F, l, true, si >> 1, si & 1);
        else if (si < 48 + 384) rwkv_chain_wave(F, l, false, (si - 48) >> 1, (si - 48) & 1);
    }
    if (B_UNIT && (rep == 0 || REP_PART == 2 || REP_PART == 4)) {
        unsigned* uctr = (unsigned*)(F.ws + WS_CTL) + 64 * (32 + l + 4 * rep);
        LAS int* ubox = (LAS int*)(F.lds + 65536);
        for (;;) {
            if (F.wave == 0 && F.lane == 0) *ubox = (int)atomicAdd(uctr, 1u);
            lds_barrier();
            const int un = __builtin_amdgcn_readfirstlane(*ubox);
            lds_barrier();
            if (un >= 512) break;
            attn_b_unit(F, l, un);
        }
    }
    unsigned* ctr = (unsigned*)(F.ws + WS_CTL) + 64 * (1 + l + 4 * rep);
    const bool xdeal = XCD_DEAL && !B_UNIT && F.G == 256;
    if (xdeal && (rep == 0 || REP_PART == 2 || REP_PART == 4)) attn_b_item(F, l, true, (F.bid & 7) * 256 + (F.bid >> 3) * 8 + F.wave);
    unsigned* cx = (unsigned*)(F.ws + WS_CTL) + 8192 + ((l + 4 * rep) * 8 + (F.bid & 7)) * 64;
    bool xq = xdeal;
    if (rep == 0 || REP_PART != 1) for (;;) {
        int it = 0;
        if (F.lane == 0) it = (int)atomicAdd(xq ? cx : ctr, 1u);
        it = __builtin_amdgcn_readfirstlane(it);
        if (xq) { if (it >= 192) { xq = false; continue; }
            const int x = F.bid & 7; it = Q_BLAT + (((x >> 2) * 6 + ((x >> 1) & 1) * 3 + it / 64) * 128 + (x & 1) * 64 + it % 64); }
        else it += xdeal ? Q_BLAT + Q_ALAT : (B_UNIT ? Q_BLAT : 0);
        if (it >= Q_TOTAL) break;
        if (it < Q_BLAT) { if (rep == 0 || REP_PART == 2 || REP_PART == 4) attn_b_item(F, l, true, it); continue; } it -= Q_BLAT;
        if (it < Q_ALAT) { if (rep == 0 || REP_PART == 2 || REP_PART == 3) attn_a_item(F, l, true, it); continue; } it -= Q_ALAT;
        if (it < Q_BCTX) { if (rep == 0 || REP_PART == 2 || REP_PART == 5) attn_b_item(F, l, false, it); continue; } it -= Q_BCTX;
        if (rep == 0 || REP_PART == 2 || REP_PART == 5) attn_a_item(F, l, false, it);
    }
}

__device__ __forceinline__ void phase_finalize(Frame& F, int l) {
    const unsigned char* ws = F.ws;
    const unsigned lane = F.lane;
    const float lami = 0.8f - 0.6f * __expf(-0.3f * (float)l);
    const float lam = LDG(float, ws, WS_TAB + (TAB_LAM + l) * 4) + lami;
    const float omli = 1.f - lami;
    const float sg = LDG(float, INP(17), (l * 64 + lane) * 4);
    for (unsigned row = F.gw; row < M; row += F.ngw) {
#pragma unroll
        for (int k = 0; k < 4; ++k) { float om[2];
#pragma unroll
            for (int mp = 0; mp < 2; ++mp) { const unsigned o0 = (((mp * 2) * M + row) * 256 + 64 * k + lane) * 2, q0 = ((((mp * 2) * M + row) * 4 + k) * 2) * 4;
                const f32x2 ml0 = LDG(f32x2, ws, WS_ML + q0);
                if (row >= MC) { const f32x2 ml1 = LDG(f32x2, ws, WS_ML + q0 + M * 32); const float ms = fmaxf(ml0[0], ml1[0]), w0 = __builtin_amdgcn_exp2f(ml0[0] - ms), w1 = __builtin_amdgcn_exp2f(ml1[0] - ms);
                    om[mp] = (bf_lo((unsigned)LDG(bf16_t, ws, WS_BO2 + o0)) * w0 + bf_lo((unsigned)LDG(bf16_t, ws, WS_BO2 + o0 + M * 512)) * w1) * __builtin_amdgcn_rcpf(ml0[1] * w0 + ml1[1] * w1); }
                else om[mp] = bf_lo((unsigned)LDG(bf16_t, ws, WS_BO2 + o0)) * __builtin_amdgcn_rcpf(ml0[1]); }
            const float v = om[0] - lam * om[1];
            const float ms = wave_sum(v * v) * (1.f / 64.f);
            STG(bf16_t, F.ws, WS_ACT + (row * DM + 384 + 64 * k + lane) * 2) = (bf16_t)(pk2(v * rsqrtf(ms + 1e-6f) * sg * omli, 0.f) & 0xffff); }
    }
}


typedef unsigned v4u __attribute__((ext_vector_type(4)));
#define XB_TMO      128
#define XB_XCNT(j)  (256  + 64 * (j))
#define XB_XSUB(j)  (1280 + 64 * (j))
#define XB_XGEN(j)  (2304 + 64 * (j))
#define XB_TOP      3328
#define XB_TOPGEN   3392
#define XCD_BAR_WORDS 3456
#define XB_SPIN_CAP (1u << 18)

__device__ __forceinline__ unsigned xb_ld(unsigned* p)              { return __hip_atomic_load(p, __ATOMIC_RELAXED, __HIP_MEMORY_SCOPE_AGENT); }
__device__ __forceinline__ unsigned xb_add(unsigned* p, unsigned v) { return __hip_atomic_fetch_add(p, v, __ATOMIC_RELAXED, __HIP_MEMORY_SCOPE_AGENT); }
__device__ __forceinline__ unsigned xb_xcc_id() { return (unsigned)__builtin_amdgcn_s_getreg((3 << 11) | 20) & 0xFu; }
#define XB_SPIN(cond, bar) do { unsigned _sp = 0; while (cond) { __builtin_amdgcn_s_sleep(1); \
    if ((++_sp & 255u) == 0u) { if (xb_ld(&(bar)[XB_TMO])) break; if (_sp > XB_SPIN_CAP) { atomicAdd(&(bar)[XB_TMO], 1u); break; } } } } while (0)

struct XcdBarrier {
    unsigned* bar; unsigned x;
    volatile LAS unsigned* st;
};

__device__ __forceinline__ XcdBarrier xcd_barrier_post(unsigned* bar, volatile LAS unsigned* st) {
    XcdBarrier b; b.bar = bar; b.x = xb_xcc_id(); b.st = st;
    if (threadIdx.x == 0) (void)xb_add(&bar[XB_XCNT(b.x)], 1u);
    return b;
}
__device__ __forceinline__ void xcd_barrier_complete(unsigned* bar, unsigned x, unsigned& nloc, unsigned& nx) {
    const unsigned G = gridDim.x * gridDim.y * gridDim.z;
    unsigned sum, cnt, mine, sp = 0u;
    for (;;) {
        sum = 0u; cnt = 0u; mine = 0u;
#pragma unroll
        for (unsigned j = 0; j < 16; ++j) { const unsigned c = xb_ld(&bar[XB_XCNT(j)]); sum += c; cnt += (c > 0u) ? 1u : 0u; mine = (j == x) ? c : mine; }
        if (sum == G) break;
        __builtin_amdgcn_s_sleep(1);
        if ((++sp & 255u) == 0u) { if (xb_ld(&bar[XB_TMO])) break; if (sp > XB_SPIN_CAP) { atomicAdd(&bar[XB_TMO], 1u); break; } }
    }
    nloc = mine > 0u ? mine : 1u; nx = cnt > 0u ? cnt : 1u;
}

__device__ __forceinline__ void xcd_barrier(const XcdBarrier& b) {
    asm volatile("s_waitcnt vmcnt(0)" ::: "memory");
    __syncthreads();
    if (threadIdx.x == 0) {
        unsigned* bar = b.bar;
        __builtin_amdgcn_s_waitcnt(0);
        unsigned nloc = b.st[0], nx = b.st[1];
        if (nloc == 0u) { xcd_barrier_complete(bar, b.x, nloc, nx); b.st[0] = nloc; b.st[1] = nx; }
        const unsigned old = xb_add(&bar[XB_XSUB(b.x)], 1u);
        const unsigned gen = old / nloc;
        if (old + 1u == (gen + 1u) * nloc) {
            __builtin_amdgcn_fence(__ATOMIC_RELEASE, "agent");
            asm volatile("s_waitcnt vmcnt(0)" ::: "memory");
            const unsigned og = xb_add(&bar[XB_TOP], 1u);
            const unsigned tg = og / nx;
            if (og + 1u == (tg + 1u) * nx) xb_add(&bar[XB_TOPGEN], 1u);
            else XB_SPIN(xb_ld(&bar[XB_TOPGEN]) == tg, bar);
            __builtin_amdgcn_fence(__ATOMIC_ACQUIRE, "agent");
            xb_add(&bar[XB_XGEN(b.x)], 1u);
            asm volatile("s_waitcnt vmcnt(0)" ::: "memory");
        } else {
            XB_SPIN(xb_ld(&bar[XB_XGEN(b.x)]) == gen, bar);
            __builtin_amdgcn_fence(__ATOMIC_ACQUIRE, "agent");
            asm volatile("s_waitcnt vmcnt(0)" ::: "memory");
        }
    }
    __syncthreads();
}

#ifndef DIS
#define DIS 0
#endif
#ifndef GEMM_MF
#define GEMM_MF 7
#endif
#ifndef REP_PHASE
#define REP_PHASE -1
#define REP_COUNT 1
#endif
constexpr int NEXTRA = (REP_PHASE >= 0 && REP_PHASE < 9) ? REP_COUNT - 1 : 0, NPL = 9 + NEXTRA, NPRE = (REP_PHASE == 100) ? REP_COUNT : 1, NPHASE_RUN = NPRE + 1 + NPL * DEPTH;
__global__ void __launch_bounds__(512, 2) mega(Args a) {
    extern __shared__ __attribute__((aligned(16))) unsigned char lds[];
    Frame F;
    F.lds = (LAS unsigned char*)lds;
    volatile LAS unsigned* bst = (volatile LAS unsigned*)(F.lds + LDS_BYTES - 64);
    if (threadIdx.x < 2) bst[threadIdx.x] = 0u;
    __syncthreads();
    const XcdBarrier xbar = xcd_barrier_post((unsigned*)((GAS unsigned char*)a.ws + WS_CTL) + 4096, bst);
    const int wave_id = __builtin_amdgcn_readfirstlane((int)threadIdx.x >> 6);
    for (int ph = a.ph_lo; ph < a.ph_hi; ++ph) {
        { const unsigned char* kp = (const unsigned char*)__builtin_amdgcn_kernarg_segment_ptr(); asm volatile("" : "+s"(kp));
          const Args* ap = (const Args*)kp; F.in = ap->in; F.out = gptr(ap->out); F.ws = gptr(ap->ws); }
        { unsigned ones = ~0u; asm volatile("" : "+s"(ones)); int ln = (int)__builtin_amdgcn_mbcnt_hi(ones, __builtin_amdgcn_mbcnt_lo(ones, 0u)); int wv = wave_id, bid = (int)blockIdx.x, gg = (int)gridDim.x; asm volatile("" : "+s"(wv), "+s"(bid), "+s"(gg));
          F.lane = ln; F.wave = wv; F.bid = bid; F.G = gg; F.ngw = gg * 8; F.tid = wv * 64 + ln; F.gw = bid * 8 + wv; }
        if (ph < NPRE) { if (!(DIS & 1)) phase_prologue(F); }
        else if (ph == NPHASE_RUN - 1) { if (!(DIS & 2)) phase_final_norm(F); }
        else {
            const int l = (ph - NPRE) / NPL, sidx = (ph - NPRE) % NPL, rep = (REP_PHASE >= 0 && REP_PHASE < 9 && sidx > REP_PHASE && sidx <= REP_PHASE + NEXTRA) ? sidx - REP_PHASE : 0, s = (REP_PHASE >= 0 && REP_PHASE < 9 && sidx > REP_PHASE) ? (sidx <= REP_PHASE + NEXTRA ? REP_PHASE : sidx - NEXTRA) : sidx;
            if (s == 0) { convert_weights(F, l); phase_norm(F, l, 0); }
            else if (s == 1) {
                pg8::Gemm g{WSP(bf16_t, WS_ACT), WSP(bf16_t, WS_WIN + 0u * WSET_STRIDE), M, NIN, 1024}; pg8::StaticOrder S; S.init(M, NIN, F.G, F.bid, (GEMM_MF & 1) ? 192 : 256);
                EpiWin E{F.ws, F.out, l, F.lds + pg8::STAGE_BYTES};
                if (!(DIS & 16)) pg8::gemm_phase<EpiWin, pg8::StaticOrder, false, true, (GEMM_MF & 1) ? 3 : 4>(F.lds, g, S, E, F.tid);
                if (false) { const int wv_ = (F.bid - 64) * 8 + F.wave; convert_item_any(F, l + 1, wv_); if (wv_ < CV_TOTAL - 1536) convert_item_any(F, l + 1, 1536 + wv_); }
            }
            else if (s == 2) { for (int cid = F.bid; cid < NCHUNK; cid += F.G) rwkv_chunk_block(F, l, cid); }
            else if (s == 3) { if (!(DIS & 64)) phase_mixer(F, l, rep); }
            else if (s == 4) { phase_finalize(F, l); for (int it = F.gw; it < 192 * 12; it += F.ngw) rwkv_out_item(F, l, it); }
            else if (s == 5 || s == 8) {
                const bool second = s == 8;
                pg8::Gemm g{second ? WSP(bf16_t, WS_U) : WSP(bf16_t, WS_ACT), second ? WSP(bf16_t, WS_W2 + 0u * WSET_STRIDE) : WSP(bf16_t, WS_WOUT + 0u * WSET_STRIDE), M, 1024, second ? FF : 1024};
                pg8::StaticOrder S; S.init(M, 1024, F.G, F.bid, (GEMM_MF & 2) ? 192 : 256);
                const bool first = (l == 0 && !second);
                EpiRes E{INP(0), INP(1) - (size_t)MC * DM, F.ws, WSP(float, WS_MOD) + (size_t)l * 3 * 6144 + (second ? 5120 : 2048), first};
                if (!(DIS & 256)) pg8::gemm_phase<EpiRes, pg8::StaticOrder, false, true, (GEMM_MF & 2) ? 3 : 4>(F.lds, g, S, E, F.tid);
            }
            else if (s == 6) { if (!(DIS & 8)) phase_norm(F, l, 1); }
            else {
                pg8::Gemm g{WSP(bf16_t, WS_ACT), WSP(bf16_t, WS_W13 + 0u * WSET_STRIDE), M, NFF2, 1024}; pg8::StaticOrder S; S.init(M, NFF2, F.G, F.bid, (GEMM_MF & 4) ? 192 : 256);
                EpiSwi E{WSP(bf16_t, WS_U)};
                if (!(DIS & 512)) pg8::gemm_phase<EpiSwi, pg8::StaticOrder, true, true, (GEMM_MF & 4) ? 3 : 4>(F.lds, g, S, E, F.tid);
            }
        }
        if (ph + 1 < a.ph_hi) { if (ph == a.ph_lo) { __threadfence(); cg::this_grid().sync(); } else xcd_barrier(xbar); }
    }
}

extern "C" void kernel_launch(void* const* d_in, const int* in_sizes, int n_in, void* d_out, int out_size, void* d_ws, size_t ws_size, hipStream_t stream) {
    static int grid = 0;
    if (grid == 0) {
        int dev = 0, cus = 0, per_cu = 0;
        if (n_in != 34 || ws_size < WS_END) { fprintf(stderr, "kernel_launch: unexpected n_in %d / ws_size %zu (need %zu)\n", n_in, ws_size, (size_t)WS_END); grid = -1; return; }
        if (hipGetDevice(&dev) != hipSuccess || hipDeviceGetAttribute(&cus, hipDeviceAttributeMultiprocessorCount, dev) != hipSuccess) { grid = -1; return; }
        if (hipFuncSetAttribute((const void*)mega, hipFuncAttributeMaxDynamicSharedMemorySize, LDS_BYTES) != hipSuccess) { fprintf(stderr, "kernel_launch: hipFuncSetAttribute failed\n"); grid = -1; return; }
        if (hipOccupancyMaxActiveBlocksPerMultiprocessor(&per_cu, (const void*)mega, 512, LDS_BYTES) != hipSuccess || per_cu < 1) { fprintf(stderr, "kernel_launch: occupancy query says %d\n", per_cu); per_cu = 1; }
        (void)hipGetLastError();
        grid = cus * 1;
        if (grid > cus * per_cu) grid = cus * per_cu;
    }
    if (grid < 0) return;
    (void)hipMemsetAsync((char*)d_ws + WS_CTL, 0, CTL_BYTES, stream);
    Args a{};
    for (int i = 0; i < 34; ++i) a.in[i] = (const float*)d_in[i];
    a.out = (float*)d_out; a.ws = (unsigned char*)d_ws;
#if MK_ONE_LAUNCH
    a.ph_lo = 0; a.ph_hi = NPHASE_RUN;
    void* args[] = {&a};
    hipError_t e = hipLaunchCooperativeKernel((const void*)mega, dim3(grid), dim3(512), args, LDS_BYTES, stream);
    if (e != hipSuccess) fprintf(stderr, "kernel_launch: cooperative launch failed: %s (grid %d)\n", hipGetErrorString(e), grid);
#else
    for (int ph = 0; ph < NPHASE_RUN; ++ph) { a.ph_lo = ph; a.ph_hi = ph + 1; hipLaunchKernelGGL(mega, dim3(grid), dim3(512), LDS_BYTES, stream, a); }
#endif
}
```

```cpp
#include <hip/hip_runtime.h>
#include <hip/hip_cooperative_groups.h>
#include <cstdio>
#include <cstdint>
namespace cg = cooperative_groups;

#ifndef MK_ONE_LAUNCH
#define MK_ONE_LAUNCH 1
#endif

#undef MK_ONE_LAUNCH
#define MK_ONE_LAUNCH 1
#define REP_PHASE -1
#define REP_COUNT 1
#define REP_PART 0
#define RA_REP 0
#define ATT_PROBE 0
namespace pg8 {
#define PG8_LAS __attribute__((address_space(3)))
typedef unsigned short bf16_t;
typedef short bf16x8 __attribute__((ext_vector_type(8)));
typedef float f32x4 __attribute__((ext_vector_type(4)));
typedef unsigned u32x4 __attribute__((ext_vector_type(4)));
constexpr int BM = 256, BK = 64, HALF = 128, HTB = HALF * BK * 2  , STAGE_BYTES = 8 * HTB, NXCD = 8, WGM = 8;

__host__ __device__ __forceinline__ int lds_byte(int r, int c) { const int st = (r >> 4) * 2 + (c >> 5), rr = r & 15, cc = c & 31, ob = rr * 64 + cc * 2; return st * 1024 + (ob ^ (((ob >> 9) & 1) << 5)); }
__host__ __device__ __forceinline__ void stage_rc(int b, int& R, int& C) { const int st = b / 1024, sb = b % 1024, swz = sb ^ (((sb >> 9) & 1) << 5); R = (st >> 1) * 16 + swz / 64; C = (st & 1) * 32 + (swz % 64) / 2; }
__host__ __device__ __forceinline__ int perm32(int rho) { const int n = rho >> 4, i = rho & 15; return 8 * (i >> 2) + 4 * n + (i & 3); }

struct Unit { int pm, pn; };
struct Gemm { const bf16_t* A; const bf16_t* Bt; int M, N, K; };

struct StaticOrder {
    int nM, nN, nwg, G, c;
    __host__ __device__ void init(int M, int N, int G_, int c_, int bm = BM) { nM = M / bm; nN = N / BM; nwg = nM * nN; G = G_; c = c_; }
    __host__ __device__ bool next(int i, Unit& u) const {
        const long L = (long)i * G + c; if (L >= nwg) return false;
        int wgid = (int)L; { const int q = nwg / NXCD, r = nwg % NXCD, xcd = wgid % NXCD, off = wgid / NXCD; wgid = (xcd < r ? xcd * (q + 1) : r * (q + 1) + (xcd - r) * q) + off; }
        const int nig = WGM * nN, gid = wgid / nig, fm = gid * WGM, gsz = (nM - fm) < WGM ? (nM - fm) : WGM;
        u.pm = fm + ((wgid % nig) % gsz); u.pn = (wgid % nig) / gsz; return true;
    }
    __device__ __forceinline__ void a_ready(const Unit&) const {}
    __device__ __forceinline__ void done(const Unit&) const {}
};

template <class Epi, class Sched, bool ALIGN_EPI = false, bool SP2 = false, int MF = 4>
__device__ __forceinline__ void gemm_phase(PG8_LAS unsigned char* lds, const Gemm g, const Sched& S, const Epi& E, const int tid_in) {
    const int tid = tid_in, wid = __builtin_amdgcn_readfirstlane(tid >> 6), lane = tid & 63, wr = wid >> 2, wc = wid & 3, fr = lane & 15, fq = lane >> 4;
    static_assert(MF == 4 || (MF == 3 && SP2), "192-row tiles: SP2 schedule only");
    const int K = g.K, nt = K / BK;
    unsigned voffA[2], voffB[2];
#pragma unroll
    for (int i = 0; i < 2; ++i) { int R, C; stage_rc(tid * 16 + i * 8192, R, C); const int Rb = Epi::PERM ? ((R & ~31) + perm32(R & 31)) : R;
        voffA[i] = (unsigned)(R * K + C) * 2u; voffB[i] = (unsigned)(Rb * K + C) * 2u; }
    const size_t kstep = (size_t)(BK * 2);
    const size_t hstep = (size_t)HALF * K * 2;
    const size_t tstep = 2 * hstep;
    const size_t hstepA = (size_t)(MF * 32) * K * 2, tstepA = 2 * hstepA;
    const unsigned ldsw = (unsigned)wid * 1024u;
    const int aoff = lds_byte(wr * (MF * 16) + fr, fq * 8), boff = lds_byte(wc * 32 + fr, fq * 8);
#define PG8_SA(b, h) (((b) * 2 + (h)) * HTB)
#define PG8_SB(b, h) ((4 + (b) * 2 + (h)) * HTB)
#define PG8_STAGE(bufoff, gbase, voff) do { _Pragma("unroll") for (int _i = 0; _i < 2; ++_i) \
        __builtin_amdgcn_global_load_lds((const unsigned*)((const char*)(gbase) + (voff)[_i]), (PG8_LAS unsigned*)(lds + (bufoff) + ldsw + _i * 8192), 16, 0, 0); } while (0)
#define PG8_STAGEA(bufoff, gbase, voff) do { __builtin_amdgcn_global_load_lds((const unsigned*)((const char*)(gbase) + (voff)[0]), (PG8_LAS unsigned*)(lds + (bufoff) + ldsw), 16, 0, 0); \
        if (MF == 4 || wr == 0) __builtin_amdgcn_global_load_lds((const unsigned*)((const char*)(gbase) + (voff)[1]), (PG8_LAS unsigned*)(lds + (bufoff) + ldsw + 8192), 16, 0, 0); } while (0)
#define PG8_LDA(dst, b, h) do { _Pragma("unroll") for (int m = 0; m < MF; ++m) _Pragma("unroll") for (int k = 0; k < 2; ++k) dst[m][k] = *(const PG8_LAS bf16x8*)(lds + PG8_SA(b, h) + aoff + m * 2048 + k * 1024); } while (0)
#define PG8_LDB(dst, b, h) do { _Pragma("unroll") for (int n = 0; n < 2; ++n) _Pragma("unroll") for (int k = 0; k < 2; ++k) dst[n][k] = *(const PG8_LAS bf16x8*)(lds + PG8_SB(b, h) + boff + n * 2048 + k * 1024); } while (0)
#define PG8_MMA(ai, bj, At, Bt) do { __builtin_amdgcn_s_setprio(1); _Pragma("unroll") for (int m = 0; m < MF; ++m) _Pragma("unroll") for (int n = 0; n < 2; ++n) _Pragma("unroll") for (int k = 0; k < 2; ++k) \
        acc[ai][bj][m][n] = __builtin_amdgcn_mfma_f32_16x16x32_bf16(Bt[n][k], At[m][k], acc[ai][bj][m][n], 0, 0, 0); __builtin_amdgcn_s_setprio(0); } while (0)
#define PG8_WAIT_V(n) asm volatile("s_waitcnt vmcnt(" #n ")" ::: "memory")
#define PG8_WAIT_V2(a, b) do { if (MF == 4 || wr == 0) asm volatile("s_waitcnt vmcnt(" #a ")" ::: "memory"); else asm volatile("s_waitcnt vmcnt(" #b ")" ::: "memory"); } while (0)
#define PG8_WAIT_L(n) asm volatile("s_waitcnt lgkmcnt(" #n ")" ::: "memory")
#define PG8_BAR __builtin_amdgcn_s_barrier()
#define PG8_SCHED __builtin_amdgcn_sched_barrier(0)
    Unit cur, nxt; int ui = 0;
    if (!S.next(0, cur)) return;
    f32x4 acc[2][2][MF][2];
#pragma unroll
    for (int a = 0; a < 2; ++a)
#pragma unroll
        for (int b = 0; b < 2; ++b)
#pragma unroll
            for (int m = 0; m < MF; ++m)
#pragma unroll
                for (int n = 0; n < 2; ++n) acc[a][b][m][n] = (f32x4){0.f, 0.f, 0.f, 0.f};
    bf16x8 At[MF][2], B0[2][2], B1[2][2];
#define PG8_SGPR64(p) ((const char*)(((unsigned long long)(unsigned)__builtin_amdgcn_readfirstlane((int)((unsigned long long)(p) >> 32)) << 32) | (unsigned)__builtin_amdgcn_readfirstlane((int)(unsigned long long)(p))))
    const char* cA = PG8_SGPR64((const char*)g.A + (size_t)cur.pm * tstepA); const char* cB = PG8_SGPR64((const char*)g.Bt + (size_t)cur.pn * tstep);
    S.a_ready(cur);
    if constexpr (SP2) {
        PG8_STAGE(PG8_SB(0, 0), cB, voffB); PG8_STAGE(PG8_SB(0, 1), cB + hstep, voffB); PG8_STAGEA(PG8_SA(0, 0), cA, voffA); PG8_STAGEA(PG8_SA(0, 1), cA + hstepA, voffA);
        if (wr == 1) PG8_BAR;
        PG8_WAIT_V2(2, 1); PG8_BAR;
        PG8_STAGE(PG8_SB(1, 0), cB + kstep, voffB); PG8_STAGEA(PG8_SA(1, 0), cA + kstep, voffA); PG8_STAGE(PG8_SB(1, 1), cB + hstep + kstep, voffB);
        PG8_WAIT_V2(6, 5); PG8_BAR;
    } else {
        PG8_STAGE(PG8_SB(0, 0), cB, voffB); PG8_STAGEA(PG8_SA(0, 0), cA, voffA); PG8_STAGE(PG8_SB(0, 1), cB + hstep, voffB); PG8_STAGEA(PG8_SA(0, 1), cA + hstepA, voffA);
        if (wr == 1) PG8_BAR;
        PG8_WAIT_V(4); PG8_BAR;
        PG8_STAGE(PG8_SB(1, 0), cB + kstep, voffB); PG8_STAGEA(PG8_SA(1, 0), cA + kstep, voffA); PG8_STAGE(PG8_SB(1, 1), cB + hstep + kstep, voffB);
        PG8_WAIT_V(6); PG8_BAR;
    }
    for (;;) {
        const bool has_next = S.next(ui + 1, nxt);
        const char* nA = PG8_SGPR64(has_next ? (const char*)g.A + (size_t)nxt.pm * tstepA : cA); const char* nB = PG8_SGPR64(has_next ? (const char*)g.Bt + (size_t)nxt.pn * tstep : cB);
        for (int t = 0; t < nt; t += 2) {
            const bool last = (t == nt - 2);
            const char* a1 = cA + (size_t)(t + 1) * kstep;
            const char* a2 = last ? nA : cA + (size_t)(t + 2) * kstep; const char* b2 = last ? nB : cB + (size_t)(t + 2) * kstep;
            const char* a3 = a2 + kstep; const char* b3 = b2 + kstep;
            if (last && has_next) S.a_ready(nxt);
            if constexpr (SP2) {
            PG8_LDB(B0, 0, 0); PG8_LDB(B1, 0, 1); PG8_SCHED; PG8_LDA(At, 0, 0); PG8_STAGEA(PG8_SA(1, 1), a1 + hstepA, voffA);
            PG8_WAIT_V2(8, 6); PG8_WAIT_L(0); PG8_BAR; PG8_MMA(0, 0, At, B0); PG8_MMA(0, 1, At, B1); PG8_BAR; PG8_SCHED;
            PG8_LDA(At, 0, 1); PG8_STAGE(PG8_SB(0, 0), b2, voffB); PG8_STAGE(PG8_SB(0, 1), b2 + hstep, voffB); PG8_STAGEA(PG8_SA(0, 0), a2, voffA);
            PG8_WAIT_V2(8, 6); PG8_WAIT_L(0); PG8_BAR; PG8_MMA(1, 0, At, B0); PG8_MMA(1, 1, At, B1); PG8_BAR; PG8_SCHED;
            PG8_LDB(B0, 1, 0); PG8_LDB(B1, 1, 1); PG8_SCHED; PG8_LDA(At, 1, 0); PG8_STAGEA(PG8_SA(0, 1), a2 + hstepA, voffA);
            PG8_WAIT_V2(8, 6); PG8_WAIT_L(0); PG8_BAR; PG8_MMA(0, 0, At, B0); PG8_MMA(0, 1, At, B1); PG8_BAR; PG8_SCHED;
            PG8_LDA(At, 1, 1); PG8_STAGE(PG8_SB(1, 0), b3, voffB); PG8_STAGE(PG8_SB(1, 1), b3 + hstep, voffB); PG8_STAGEA(PG8_SA(1, 0), a3, voffA);
            PG8_WAIT_V2(8, 6); PG8_WAIT_L(0); PG8_BAR; PG8_MMA(1, 0, At, B0); PG8_MMA(1, 1, At, B1); PG8_BAR; PG8_SCHED;
            } else {
            PG8_LDB(B0, 0, 0); PG8_SCHED; PG8_LDA(At, 0, 0); PG8_STAGEA(PG8_SA(1, 1), a1 + hstepA, voffA);
            PG8_WAIT_L(8); PG8_BAR; PG8_WAIT_L(0); PG8_MMA(0, 0, At, B0); PG8_BAR; PG8_SCHED;
            PG8_LDB(B1, 0, 1); PG8_STAGE(PG8_SB(0, 0), b2, voffB);
            PG8_BAR; PG8_WAIT_L(0); PG8_MMA(0, 1, At, B1); PG8_BAR;
            PG8_LDA(At, 0, 1); PG8_STAGEA(PG8_SA(0, 0), a2, voffA);
            PG8_BAR; PG8_WAIT_L(0); PG8_MMA(1, 0, At, B0); PG8_BAR; PG8_SCHED;
            PG8_STAGE(PG8_SB(0, 1), b2 + hstep, voffB);
            PG8_WAIT_V(6); PG8_BAR; PG8_MMA(1, 1, At, B1); PG8_BAR;
            PG8_LDB(B0, 1, 0); PG8_SCHED; PG8_LDA(At, 1, 0); PG8_STAGEA(PG8_SA(0, 1), a2 + hstepA, voffA);
            PG8_WAIT_L(8); PG8_BAR; PG8_WAIT_L(0); PG8_MMA(0, 0, At, B0); PG8_BAR; PG8_SCHED;
            PG8_LDB(B1, 1, 1); PG8_STAGE(PG8_SB(1, 0), b3, voffB);
            PG8_BAR; PG8_WAIT_L(0); PG8_MMA(0, 1, At, B1); PG8_BAR;
            PG8_LDA(At, 1, 1); PG8_STAGEA(PG8_SA(1, 0), a3, voffA);
            PG8_BAR; PG8_WAIT_L(0); PG8_MMA(1, 0, At, B0); PG8_BAR; PG8_SCHED;
            PG8_STAGE(PG8_SB(1, 1), b3 + hstep, voffB);
            PG8_WAIT_V(6); PG8_BAR; PG8_MMA(1, 1, At, B1); PG8_BAR;
            }
        }
        if constexpr (ALIGN_EPI) { if (wr == 0) PG8_BAR; }
        if constexpr (!Epi::AFTER_DRAIN) { E.template operator()<MF>(acc, cur, wr, wc, fr, fq); S.done(cur); }
        if (!has_next) break;
#pragma unroll
        for (int a = 0; a < 2; ++a)
#pragma unroll
            for (int b = 0; b < 2; ++b)
#pragma unroll
                for (int m = 0; m < MF; ++m)
#pragma unroll
                    for (int n = 0; n < 2; ++n) acc[a][b][m][n] = (f32x4){0.f, 0.f, 0.f, 0.f};
        cur = nxt; cA = nA; cB = nB; ++ui;
        if constexpr (ALIGN_EPI) { if (wr == 1) PG8_BAR; }
    }
    PG8_WAIT_V(0);
    if constexpr (!ALIGN_EPI) { if (wr == 0) PG8_BAR; }
    PG8_BAR;
    if constexpr (Epi::AFTER_DRAIN) { E.fused(acc, cur, wr, wc, fr, fq, lds, wid, lane); S.done(cur); }
#undef PG8_SA
#undef PG8_SB
#undef PG8_STAGE
#undef PG8_STAGEA
#undef PG8_WAIT_V2
#undef PG8_LDA
#undef PG8_LDB
#undef PG8_MMA
#undef PG8_WAIT_V
#undef PG8_WAIT_L
#undef PG8_BAR
#undef PG8_SCHED
}
}

using pg8::bf16_t; using pg8::bf16x8; using pg8::f32x4; using pg8::u32x4;
typedef float f32x16 __attribute__((ext_vector_type(16)));
typedef float f32x2 __attribute__((ext_vector_type(2)));
typedef short s16x4 __attribute__((ext_vector_type(4)));
typedef unsigned u32x2 __attribute__((ext_vector_type(2)));
typedef __bf16 bf16x2_t __attribute__((ext_vector_type(2)));
#define LAS __attribute__((address_space(3)))
#define LDG(T, base, boff) (*(const __attribute__((address_space(1))) T*)((const __attribute__((address_space(1))) unsigned char*)(base) + (unsigned)(boff)))
#define STG(T, base, boff) (*(__attribute__((address_space(1))) T*)((__attribute__((address_space(1))) unsigned char*)(base) + (unsigned)(boff)))

__device__ __forceinline__ unsigned pk2(float lo, float hi) { f32x2 v = {lo, hi}; bf16x2_t b = __builtin_convertvector(v, bf16x2_t); return __builtin_bit_cast(unsigned, b); }
__device__ __forceinline__ float bf_lo(unsigned u) { return __uint_as_float(u << 16); }
__device__ __forceinline__ float bf_hi(unsigned u) { return __uint_as_float(u & 0xffff0000u); }
__device__ __forceinline__ f32x4 unpack4(u32x2 v) { return (f32x4){bf_lo(v.x), bf_hi(v.x), bf_lo(v.y), bf_hi(v.y)}; }
__device__ __forceinline__ u32x2 pack4(f32x4 v) { u32x2 r; r.x = pk2(v[0], v[1]); r.y = pk2(v[2], v[3]); return r; }
__device__ __forceinline__ float sigmf(float x) { return __builtin_amdgcn_rcpf(1.f + __expf(-x)); }
template <int CTRL> __device__ __forceinline__ float dpp_f(float x) { return __builtin_bit_cast(float, __builtin_amdgcn_update_dpp(0, __builtin_bit_cast(int, x), CTRL, 0xF, 0xF, true)); }
__device__ __forceinline__ float allreduce16(float x) { x += dpp_f<0xB1>(x); x += dpp_f<0x4E>(x); x += dpp_f<0x141>(x); x += dpp_f<0x140>(x); return x; }
__device__ __forceinline__ float rdlane(float x, int l) { return __builtin_bit_cast(float, __builtin_amdgcn_readlane(__builtin_bit_cast(int, x), l)); }
__device__ __forceinline__ float wave_sum(float v) {
    v = allreduce16(v);
    return (rdlane(v, 0) + rdlane(v, 16)) + (rdlane(v, 32) + rdlane(v, 48));
}
__device__ __forceinline__ float swap32_sum(float x) { auto rr = __builtin_amdgcn_permlane32_swap(__float_as_uint(x), __float_as_uint(x), false, false); return __uint_as_float(rr[0]) + __uint_as_float(rr[1]); }
__device__ __forceinline__ float swap32_max(float x) { auto rr = __builtin_amdgcn_permlane32_swap(__float_as_uint(x), __float_as_uint(x), false, false); return fmaxf(__uint_as_float(rr[0]), __uint_as_float(rr[1])); }

constexpr int M = 12288, MC = 4096, DM = 1024, NIN = 3072, FF = 2816, NFF2 = 5632, DEPTH = 4;
constexpr float LOG2E = 1.4426950408889634f;
constexpr float QSCALE_A = 0.125f * LOG2E;
constexpr float QSCALE_B = 0.17677669529663687f * LOG2E;
constexpr unsigned OFF_AK = 12582912, OFF_AV = 14680064, OFF_BK = 16777216, OFF_BV = 20971520, OFF_CF = 25165824, OFF_CB = 26738688;
constexpr unsigned MiB = 1u << 20;
constexpr unsigned WS_CTL = 0, CTL_BYTES = 1 * MiB;
constexpr unsigned WS_MOD = 1 * MiB;
constexpr unsigned WS_TAB = 1 * MiB + 512 * 1024;
constexpr unsigned WS_SMALLW = 2 * MiB;
constexpr unsigned WS_CACHE = 4 * MiB;
constexpr unsigned WS_WIN = 10 * MiB, WS_WOUT = 16 * MiB, WS_W13 = 18 * MiB, WS_W2 = 29 * MiB;
constexpr unsigned WSET_STRIDE = 184 * MiB;
constexpr unsigned WS_ACT = 35 * MiB;
constexpr unsigned WS_QA = 59 * MiB, WS_KA = 68 * MiB, WS_VTA = 71 * MiB, WS_QB = 74 * MiB, WS_KB = 80 * MiB, WS_VTB = 86 * MiB;
constexpr unsigned WS_RKV = 92 * MiB, WS_CW = 119 * MiB, WS_CA = 122 * MiB, WS_CG = 125 * MiB;
constexpr unsigned WS_YF = 128 * MiB, WS_YB = 146 * MiB;
constexpr unsigned WS_SV = 164 * MiB;
constexpr unsigned WS_BO2 = 182 * MiB, WS_ML = 230 * MiB;
constexpr unsigned WS_XB = 206 * MiB;
constexpr unsigned WS_WSET1 = 194 * MiB;
constexpr unsigned WS_RM = 236 * MiB, WS_RN = 254 * MiB, WS_RP = 324 * MiB, WS_RH = 342 * MiB;
constexpr int NCHUNK = 2304;
constexpr unsigned WS_U = 128 * MiB;
constexpr unsigned WS_G = 290 * MiB, WS_SB = 299 * MiB, WS_BO = 300 * MiB, WS_END = 360 * MiB;
constexpr int SMALLW_L = 147456;
constexpr int TAB_COSA = 0, TAB_SINA = 1024, TAB_COSB = 2048, TAB_SINB = 2560, TAB_LAM = 3072;
constexpr int LDS_BYTES = 147456;
constexpr int NPHASE = 2 + 9 * DEPTH;

struct Args {
    const float* in[34];
    float* out; unsigned char* ws;
    int ph_lo, ph_hi;
};

struct EpiRes {
    static constexpr bool PERM = true, AFTER_DRAIN = false;
    const float* baseC; const float* baseL; unsigned char* ws; const float* gate; bool first; unsigned xo; bool skip = false;
    template <int MF>
    __device__ __forceinline__ void operator()(const f32x4 (&acc)[2][2][MF][2], const pg8::Unit& u, int wr, int wc, int fr_, int fq_) const {
        if (skip) return;
        int fr = fr_, fq = fq_; asm volatile("" : "+v"(fr), "+v"(fq));
        const unsigned col0 = u.pn * 256 + wc * 32 + 8 * fq, rowb = u.pm * (MF * 64) + wr * (MF * 16);
        f32x4 g4[2][2]; int vcur = -1;
#pragma unroll
        for (int ai = 0; ai < 2; ++ai)
#pragma unroll
            for (int m = 0; m < MF; ++m) { const unsigned rf = rowb + ai * (MF * 32) + m * 16, off = (rf + fr) * DM + col0;
                const int v = rf < MC ? 0 : (rf < MC + 4096 ? 1 : 2);
                if (v != vcur) { vcur = v;
#pragma unroll
                    for (int bj = 0; bj < 2; ++bj)
#pragma unroll
                        for (int n = 0; n < 2; ++n) g4[bj][n] = LDG(f32x4, gate, (v * 6144 + col0 + bj * 128 + n * 4) * 4); }
#pragma unroll
                for (int bj = 0; bj < 2; ++bj) { f32x4 b0, b1;
                    if (first) { const float* base = rf < MC ? baseC : baseL; b0 = LDG(f32x4, base, (off + bj * 128) * 4); b1 = LDG(f32x4, base, (off + bj * 128 + 4) * 4); }
                    else { const u32x4 xb = LDG(u32x4, ws, WS_XB + (off + bj * 128) * 2); b0 = (f32x4){bf_lo(xb.x), bf_hi(xb.x), bf_lo(xb.y), bf_hi(xb.y)}; b1 = (f32x4){bf_lo(xb.z), bf_hi(xb.z), bf_lo(xb.w), bf_hi(xb.w)}; }
                    b0 = b0 + g4[bj][0] * acc[ai][bj][m][0]; b1 = b1 + g4[bj][1] * acc[ai][bj][m][1];
                    u32x4 w; w.x = pk2(b0[0], b0[1]); w.y = pk2(b0[2], b0[3]); w.z = pk2(b1[0], b1[1]); w.w = pk2(b1[2], b1[3]);
                    STG(u32x4, ws, xo + (off + bj * 128) * 2) = w; } }
    }
};
struct EpiSwi {
    static constexpr bool PERM = true, AFTER_DRAIN = false;
    bf16_t* U; bool skip = false;
    template <int MF>
    __device__ __forceinline__ void operator()(const f32x4 (&acc)[2][2][MF][2], const pg8::Unit& u, int wr, int wc, int fr_, int fq_) const {
        if (skip) return;
        int fr = fr_, fq = fq_; asm volatile("" : "+v"(fr), "+v"(fq));
        const unsigned row0 = u.pm * (MF * 64) + wr * (MF * 16) + fr, oc0 = u.pn * 128 + wc * 32 + 8 * fq;
#pragma unroll
        for (int ai = 0; ai < 2; ++ai)
#pragma unroll
            for (int m = 0; m < MF; ++m) { const unsigned ro = ((row0 + ai * (MF * 32) + m * 16) * FF + oc0) * 2; f32x4 o[2];
#pragma unroll
                for (int bj = 0; bj < 2; ++bj) { const f32x4 g = acc[ai][bj][m][0], up = acc[ai][bj][m][1];
#pragma unroll
                    for (int e = 0; e < 4; ++e) o[bj][e] = g[e] * sigmf(g[e]) * up[e]; }
                const u32x2 lo = pack4(o[0]), hi2 = pack4(o[1]);
                STG(u32x4, U, ro) = (u32x4){lo.x, lo.y, hi2.x, hi2.y}; asm volatile("" ::: "memory"); }
    }
};
struct EpiWin {
    static constexpr bool PERM = true, AFTER_DRAIN = false;
    unsigned char* ws; float* out; int l; LAS unsigned char* lds; bool skip = false;
    template <int MF>
    __device__ __forceinline__ void operator()(const f32x4 (&acc)[2][2][MF][2], const pg8::Unit& u, int wr, int wc, int fr_, int fq_) const {
        if (skip) return;
        int fr = fr_, fq = fq_; asm volatile("" : "+v"(fr), "+v"(fq));
        const unsigned rowb = u.pm * (MF * 64) + wr * (MF * 16), row0 = rowb + fr;
#pragma unroll
        for (int bj = 0; bj < 2; ++bj) {
            const unsigned c32 = u.pn * 256 + bj * 128 + wc * 32;
            const unsigned c8 = c32 + 8 * fq;
            if (c32 < 1152 && (c32 < 512 || c32 >= 640)) {
                const bool isA = c32 < 512;
                const bool isK = isA ? (c32 >= 384) : (c32 >= 896);
                const float qs = isK ? 1.f : (isA ? QSCALE_A : QSCALE_B);
                const unsigned ck = isA ? c8 - 384 : c8 - 896;
                const unsigned dbase = isA ? (isK ? WS_KA + (((ck >> 6) * 4 + ((ck & 63) >> 4)) * 64 + ((ck >> 3) & 1) * 32) * 16 : WS_QA + c8 * 2)
                                           : (isK ? WS_KB + (((ck >> 5) * 2 + ((ck & 31) >> 4)) * 64 + ((ck >> 3) & 1) * 32) * 16 : WS_QB + (c8 - 640) * 2);
                const unsigned dpitch = isA ? 768u : 512u;
#pragma unroll
                for (int ai = 0; ai < 2; ++ai)
#pragma unroll
                    for (int m = 0; m < MF; ++m) {
                        const unsigned row = row0 + ai * (MF * 32) + m * 16; const bool lat = rowb + ai * (MF * 32) + m * 16 >= (unsigned)MC;
                        f32x4 v0 = acc[ai][bj][m][0], v1 = acc[ai][bj][m][1];
                        if (lat) {
                            const unsigned t = (row - MC) & 4095, rp = t >> 6, cp = t & 63;
                            unsigned to_;
                            if (isA) { const unsigned pos = ((c32 >> 5) & 1) ? cp : rp; to_ = WS_TAB + (TAB_COSA + pos * 16 + 4 * fq) * 4; }
                            else { const unsigned pos = (fq >> 1) ? cp : rp; to_ = WS_TAB + (TAB_COSB + pos * 8 + 4 * (fq & 1)) * 4; }
                            const f32x4 c4 = LDG(f32x4, ws, to_), s4 = LDG(f32x4, ws, to_ + (isA ? 4096u : 2048u));
                            f32x4 w0, w1;
                            w0[0] = v0[0] * c4[0] - v0[1] * s4[0]; w0[1] = v0[1] * c4[0] + v0[0] * s4[0];
                            w0[2] = v0[2] * c4[1] - v0[3] * s4[1]; w0[3] = v0[3] * c4[1] + v0[2] * s4[1];
                            w1[0] = v1[0] * c4[2] - v1[1] * s4[2]; w1[1] = v1[1] * c4[2] + v1[0] * s4[2];
                            w1[2] = v1[2] * c4[3] - v1[3] * s4[3]; w1[3] = v1[3] * c4[3] + v1[2] * s4[3];
                            v0 = w0; v1 = w1;
                        } else if (isK) {
                            const unsigned b = row >> 8, t = row & 255;
                            const f32x4 ev = {v0[0], v0[2], v1[0], v1[2]}, od = {v0[1], v0[3], v1[1], v1[3]};
                            if (isA) { const unsigned o = (OFF_AK + ((b * 4 + l) * 256 + t) * 128 + (c32 - 384) + 4 * fq) * 4; STG(f32x4, out, o) = ev; STG(f32x4, out, o + 64) = od; }
                            else { const unsigned o = (OFF_BK + ((b * 4 + l) * 256 + t) * 256 + ((c8 - 896) & ~15u) + 4 * (fq & 1)) * 4; STG(f32x4, out, o) = ev; STG(f32x4, out, o + 32) = od; }
                        }
                        v0 = v0 * qs; v1 = v1 * qs;
                        u32x4 w; w.x = pk2(v0[0], v0[1]); w.y = pk2(v0[2], v0[3]); w.z = pk2(v1[0], v1[1]); w.w = pk2(v1[2], v1[3]);
                        STG(u32x4, ws, isK ? dbase + (row >> 5) * (isA ? 8192u : 16384u) + (row & 31) * 16 : dbase + row * dpitch) = w;
                        asm volatile("" ::: "memory");
                    }
            } else if (c32 < 1408) {
                const bool isA = c32 < 640;
                const unsigned cc = isA ? (c8 - 512) : (c8 - 1152), cw = isA ? (c32 - 512) : (c32 - 1152);
                const unsigned vfrag = (isA ? WS_VTA : WS_VTB) + (((cw >> 6) * 2 + ((cw >> 5) & 1)) * 2) * 1024;
                LAS unsigned char* lw = lds + (wr * 4 + wc) * 1024;
                LAS bf16_t* lq = (LAS bf16_t*)(lw + ((((fr >> 2) & 1) * 32 + 8 * fq) * 16 + (4 * (fr >> 3) + (fr & 3)) * 2));
#pragma unroll
                for (int ai = 0; ai < 2; ++ai)
#pragma unroll
                    for (int m = 0; m < MF; ++m) {
                        const unsigned rf = rowb + ai * (MF * 32) + m * 16, row = rf + fr; const bool lat = rf >= (unsigned)MC;
                        const f32x4 v0 = acc[ai][bj][m][0], v1 = acc[ai][bj][m][1];
                        if (!lat) { const unsigned b = row >> 8, t = row & 255;
                            const unsigned o = isA ? (OFF_AV + ((b * 4 + l) * 256 + t) * 128 + cc) * 4 : (OFF_BV + ((b * 4 + l) * 256 + t) * 256 + cc) * 4;
                            STG(f32x4, out, o) = v0; STG(f32x4, out, o + 16) = v1; }
                        const unsigned p0 = pk2(v0[0], v0[1]), p1 = pk2(v0[2], v0[3]), p2 = pk2(v1[0], v1[1]), p3 = pk2(v1[2], v1[3]);
                        lq[0 * 8] = (bf16_t)(p0 & 0xffff); lq[1 * 8] = (bf16_t)(p0 >> 16); lq[2 * 8] = (bf16_t)(p1 & 0xffff); lq[3 * 8] = (bf16_t)(p1 >> 16);
                        lq[4 * 8] = (bf16_t)(p2 & 0xffff); lq[5 * 8] = (bf16_t)(p2 >> 16); lq[6 * 8] = (bf16_t)(p3 & 0xffff); lq[7 * 8] = (bf16_t)(p3 >> 16);
                        const u32x4 tv = *(const LAS u32x4*)(lw + (fq * 16 + fr) * 16);
                        STG(u32x4, ws, vfrag + (rf >> 5) * (isA ? 8192u : 16384u) + ((rf >> 4) & 1) * 1024 + (fq * 16 + fr) * 16) = tv;
                        asm volatile("" ::: "memory");
                    }
            } else if (c32 < 2944) {
                const int kind = c32 < 2560 ? 0 : (c32 < 2688 ? 1 : (c32 < 2816 ? 2 : 3));
                const unsigned dbase = kind == 0 ? WS_RKV + (c8 - 1408) * 2 : (kind == 1 ? WS_CW + (c8 - 2560) * 2 : (kind == 2 ? WS_CA + (c8 - 2688) * 2 : WS_CG + (c8 - 2816) * 2));
                const unsigned dpitch = kind == 0 ? 2304u : 256u;
#pragma unroll
                for (int ai = 0; ai < 2; ++ai)
#pragma unroll
                    for (int m = 0; m < MF; ++m) {
                        const unsigned row = row0 + ai * (MF * 32) + m * 16; const bool lat = rowb + ai * (MF * 32) + m * 16 >= (unsigned)MC;
                        f32x4 v0 = acc[ai][bj][m][0], v1 = acc[ai][bj][m][1];
                        if (kind == 1) {
#pragma unroll
                            for (int e = 0; e < 4; ++e) { v0[e] = 1.f - 2.f * __builtin_amdgcn_rcpf(__expf(2.f * v0[e]) + 1.f); v1[e] = 1.f - 2.f * __builtin_amdgcn_rcpf(__expf(2.f * v1[e]) + 1.f); }
                        } else if (kind == 3) {
#pragma unroll
                            for (int e = 0; e < 4; ++e) { v0[e] = sigmf(v0[e]); v1[e] = sigmf(v1[e]); }
                        }
                        u32x4 w; w.x = pk2(v0[0], v0[1]); w.y = pk2(v0[2], v0[3]); w.z = pk2(v1[0], v1[1]); w.w = pk2(v1[2], v1[3]);
                        STG(u32x4, ws, dbase + row * dpitch) = w;
                        asm volatile("" ::: "memory");
                    }
            }
        }
    }
};

struct Frame {
    LAS unsigned char* lds;
    const float* const* in;
    float* out; unsigned char* ws;
    int tid, lane, wave, gw, ngw, G, bid;
};
#define GAS __attribute__((address_space(1)))
template <class T> __device__ __forceinline__ T* gptr(T* p) {
#if defined(__HIP_DEVICE_COMPILE__)
    __builtin_assume(!__builtin_amdgcn_is_shared((const void*)p)); __builtin_assume(!__builtin_amdgcn_is_private((const void*)p));
#endif
    return p; }
#define INP(k) gptr(F.in[k])
#define WSP(T, off) gptr((T*)(F.ws + (off)))

__device__ __forceinline__ void phase_prologue(Frame& F) {
    const float* cvec = INP(8); const float* cctx = INP(9); const float* ada_w = INP(10); const float* ada_b = INP(11);
    LAS float* sl = (LAS float*)F.lds;
    LAS float* red = (LAS float*)(F.lds + 16384);
    for (int i = F.tid; i < 3072; i += 512) { const int v = i >> 10, k = i & 1023; const float x = v == 0 ? cctx[k] : cvec[(v - 1) * 1024 + k]; sl[i] = x / (1.f + __expf(-x)); }
    __syncthreads();
    float* mod = WSP(float, WS_MOD);
    for (int it = F.bid; it < 384; it += F.G) {
        const int l = it / 96, n0 = (it % 96) * 64;
        const float* W = ada_w + (size_t)l * 1024 * 6144 + n0 + F.lane;
        float a0 = 0.f, a1 = 0.f, a2 = 0.f;
        const int k0 = F.wave * 128;
#pragma unroll 8
        for (int k = k0; k < k0 + 128; ++k) { const float w = *(const GAS float*)(W + (size_t)k * 6144); a0 += sl[k] * w; a1 += sl[1024 + k] * w; a2 += sl[2048 + k] * w; }
        red[(F.wave * 3 + 0) * 64 + F.lane] = a0; red[(F.wave * 3 + 1) * 64 + F.lane] = a1; red[(F.wave * 3 + 2) * 64 + F.lane] = a2;
        __syncthreads();
        if (F.wave < 3) { float s = ada_b[l * 6144 + n0 + F.lane];
#pragma unroll
            for (int w = 0; w < 8; ++w) s += red[(w * 3 + F.wave) * 64 + F.lane];
            mod[(size_t)(l * 3 + F.wave) * 6144 + n0 + F.lane] = s; }
        __syncthreads();
    }
    float* tab = WSP(float, WS_TAB);
    if (F.bid == F.G - 1) {
        for (int i = F.tid; i < 1024; i += 512) { const int pos = i >> 4, f = i & 15; const float ang = (float)pos * __builtin_amdgcn_exp2f(-(float)f * (13.287712379549449f / 16.f)); tab[TAB_COSA + i] = __cosf(ang); tab[TAB_SINA + i] = __sinf(ang); }
        for (int i = F.tid; i < 512; i += 512) { const int pos = i >> 3, f = i & 7; const float ang = (float)pos * __builtin_amdgcn_exp2f(-(float)f * (13.287712379549449f / 8.f)); tab[TAB_COSB + i] = __cosf(ang); tab[TAB_SINB + i] = __sinf(ang); }
        if (F.wave < 4) { const float* lp = INP(16) + F.wave * 128; const int d = F.lane & 31;
            const float p1 = wave_sum(F.lane < 32 ? lp[d] * lp[32 + d] : 0.f), p2 = wave_sum(F.lane < 32 ? 0.f : lp[64 + d] * lp[96 + d]);
            if (F.lane == 0) tab[TAB_LAM + F.wave] = __expf(p1) - __expf(p2); }
    }
    const int gtid = F.bid * 512 + F.tid, gnt = F.G * 512;
    { bf16_t* sw = WSP(bf16_t, WS_SMALLW); const float* cw2 = INP(20); const float* ca2 = INP(22); const float* cg2 = INP(23);
      for (int idx = gtid; idx < 4 * SMALLW_L; idx += gnt) { const int l = idx / SMALLW_L, r = idx % SMALLW_L; float v;
          if (r < 98304) { const int which = r / 49152, rr = r % 49152, d = rr / 24576, ch = (rr % 24576) / 64, k = rr % 64; v = (which ? ca2 : cw2)[((size_t)(l * 2 + d) * 64 + k) * 384 + ch]; }
          else { const int rr = r - 98304, ch = rr / 128, k = rr % 128; v = cg2[((size_t)l * 128 + k) * 384 + ch]; }
          sw[idx] = (bf16_t)(pk2(v, 0.f) & 0xffff); } }
    { bf16_t* kca = WSP(bf16_t, WS_CACHE); bf16_t* vca = kca + 524288; bf16_t* kcb = vca + 524288; bf16_t* vcb = kcb + 1048576;
      const float* cak = INP(2); const float* cav = INP(3); const float* cbk = INP(4); const float* cbv = INP(5);
      for (int e = gtid; e < 524288; e += gnt) {
          const int j = e & 7, ln = (e >> 3) & 63, hi = ln >> 5, r32 = ln & 31, blk = (e >> 12) & 15, bl = e >> 16;
          { const int s = (e >> 9) & 3, kvh = (e >> 11) & 1, cp = kvh * 64 + 16 * s + 8 * hi + j, o = cp & 31, c = (cp - o) + (o >> 1) + 16 * (o & 1);
            kca[e] = (bf16_t)(pk2(cak[((size_t)bl * 512 + blk * 32 + r32) * 128 + c], 0.f) & 0xffff); }
          { const int ks = (e >> 9) & 1, db = (e >> 10) & 1, kvh = (e >> 11) & 1, key = blk * 32 + 16 * ks + 8 * (j >> 2) + 4 * hi + (j & 3);
            vca[e] = (bf16_t)(pk2(cav[((size_t)bl * 512 + key) * 128 + kvh * 64 + db * 32 + r32], 0.f) & 0xffff); } }
      for (int e = gtid; e < 1048576; e += gnt) {
          const int j = e & 7, ln = (e >> 3) & 63, hi = ln >> 5, r32 = ln & 31, blk = (e >> 13) & 15, bl = e >> 17;
          { const int s = (e >> 9) & 1, hm = (e >> 10) & 7, cp = hm * 32 + 16 * s + 8 * hi + j, o = cp & 15, c = (cp - o) + (o >> 1) + 8 * (o & 1);
            kcb[e] = (bf16_t)(pk2(cbk[((size_t)bl * 512 + blk * 32 + r32) * 256 + c], 0.f) & 0xffff); }
          { const int ks = (e >> 9) & 1, db = (e >> 10) & 1, h = (e >> 11) & 3, key = blk * 32 + 16 * ks + 8 * (j >> 2) + 4 * hi + (j & 3);
            vcb[e] = (bf16_t)(pk2(cbv[((size_t)bl * 512 + key) * 256 + h * 64 + db * 32 + r32], 0.f) & 0xffff); } } }
    for (int st = 0; st < 1; ++st) { u32x4* z = (u32x4*)(WSP(bf16_t, WS_WIN + st * WSET_STRIDE) + (size_t)2944 * 1024); unsigned z0; asm volatile("v_mov_b32 %0, 0" : "=v"(z0)); for (int i = gtid; i < 128 * 1024 / 8; i += gnt) z[i] = (u32x4){z0, z0, z0, z0}; }
}

template <int MAP> __device__ __forceinline__ int dest_row(int n) {
    if (MAP == 1) {
        if (n < 512) { const int o = n & 31; return (n - o) + 2 * (o & 15) + (o >> 4); }
        if (n >= 640 && n < 1152) { const int o = n & 15; return (n - o) + 2 * (o & 7) + (o >> 3); }
        return n;
    }
    if (MAP == 2 || MAP == 3) return (n >> 7) * 256 + ((n >> 2) & 1) * 128 + ((n >> 5) & 3) * 32 + ((n >> 3) & 3) * 8 + (MAP == 3 ? 4 : 0) + (n & 3);
    return n;
}
template <int MAP> __device__ __forceinline__ void transpose_item(const float* W, int K, int N, bf16_t* WT, LAS float* scr, int item, int lane) {
    const int nblk = N / 32, kb = item / nblk, nb = item % nblk, k0 = 64 * kb, n0 = 32 * nb;
#pragma unroll 8
    for (int i = 0; i < 32; ++i) { const int kk = 2 * i + (lane >> 5); scr[kk * 33 + (lane & 31)] = *(const GAS float*)(W + (size_t)(k0 + kk) * N + n0 + (lane & 31)); }
    asm volatile("s_waitcnt lgkmcnt(0)" ::: "memory");
    const int c = lane & 7;
#pragma unroll
    for (int j = 0; j < 4; ++j) { const int n = (lane >> 3) + 8 * j; const LAS float* s = scr + (8 * c) * 33 + n;
        u32x4 o; o.x = pk2(s[0 * 33], s[1 * 33]); o.y = pk2(s[2 * 33], s[3 * 33]); o.z = pk2(s[4 * 33], s[5 * 33]); o.w = pk2(s[6 * 33], s[7 * 33]);
        *(GAS u32x4*)(WT + (size_t)dest_row<MAP>(n0 + n) * K + k0 + 8 * c) = o; }
    asm volatile("s_waitcnt lgkmcnt(0)" ::: "memory");
}
template <int MAP> __device__ __forceinline__ void convert_item(const float* W, int K, int N, bf16_t* WT, int item, int lane) {
    const int nblk = N / 64, kb = item / nblk, nb = item % nblk, n = nb * 64 + lane;
    const GAS float* src = (const GAS float*)W + (size_t)(kb * 128) * N + n;
    GAS bf16_t* dst = (GAS bf16_t*)WT + (size_t)dest_row<MAP>(n) * K + kb * 128;
#pragma unroll
    for (int g = 0; g < 16; ++g) { float v[8];
#pragma unroll
        for (int e = 0; e < 8; ++e) v[e] = src[(size_t)(8 * g + e) * N];
        u32x4 o; o.x = pk2(v[0], v[1]); o.y = pk2(v[2], v[3]); o.z = pk2(v[4], v[5]); o.w = pk2(v[6], v[7]);
        *(GAS u32x4*)(dst + 8 * g) = o; }
}
constexpr int CV_IN = 46 * 8, CV_OUT = 16 * 8, CV_1 = 44 * 8, CV_2 = 16 * 22, CV_TOTAL = CV_IN + CV_OUT + 2 * CV_1 + CV_2;
__device__ __forceinline__ void convert_item_any(Frame& F, int l, int it) {
    const unsigned so = 0u * WSET_STRIDE;
    int r = it;
    if (r < CV_IN) { convert_item<1>(INP(14) + (size_t)l * 1024 * 2944, 1024, 2944, WSP(bf16_t, WS_WIN + so), r, F.lane); return; } r -= CV_IN;
    if (r < CV_OUT) { convert_item<0>(INP(29) + (size_t)l * 1024 * 1024, 1024, 1024, WSP(bf16_t, WS_WOUT + so), r, F.lane); return; } r -= CV_OUT;
    if (r < CV_1) { convert_item<2>(INP(30) + (size_t)l * 1024 * FF, 1024, FF, WSP(bf16_t, WS_W13 + so), r, F.lane); return; } r -= CV_1;
    if (r < CV_1) { convert_item<3>(INP(31) + (size_t)l * 1024 * FF, 1024, FF, WSP(bf16_t, WS_W13 + so), r, F.lane); return; } r -= CV_1;
    convert_item<0>(INP(32) + (size_t)l * FF * 1024, FF, 1024, WSP(bf16_t, WS_W2 + so), r, F.lane);
}
__device__ __forceinline__ void convert_weights(Frame& F, int l) {
    LAS float* scr = (LAS float*)(F.lds + F.wave * 16384); const unsigned so = 0u * WSET_STRIDE;
    const float* w_in = INP(14) + (size_t)l * 1024 * 2944; const float* w_out = INP(29) + (size_t)l * 1024 * 1024;
    const float* w1 = INP(30) + (size_t)l * 1024 * FF; const float* w3 = INP(31) + (size_t)l * 1024 * FF; const float* w2 = INP(32) + (size_t)l * FF * 1024;
    constexpr int I_IN = 16 * 92, I_OUT = 16 * 32, I_1 = 16 * 88, I_2 = 44 * 32;
    constexpr int NIT = I_IN + I_OUT + 2 * I_1 + I_2;
    for (int it = F.gw; it < NIT; it += F.ngw) {
        int r = it;
        if (r < I_IN) { transpose_item<1>(w_in, 1024, 2944, WSP(bf16_t, WS_WIN + so), scr, r, F.lane); continue; } r -= I_IN;
        if (r < I_OUT) { transpose_item<0>(w_out, 1024, 1024, WSP(bf16_t, WS_WOUT + so), scr, r, F.lane); continue; } r -= I_OUT;
        if (r < I_1) { transpose_item<2>(w1, 1024, FF, WSP(bf16_t, WS_W13 + so), scr, r, F.lane); continue; } r -= I_1;
        if (r < I_1) { transpose_item<3>(w3, 1024, FF, WSP(bf16_t, WS_W13 + so), scr, r, F.lane); continue; } r -= I_1;
        transpose_item<0>(w2, FF, 1024, WSP(bf16_t, WS_W2 + so), scr, r, F.lane);
    }
}

__device__ __forceinline__ void phase_norm(Frame& F, int l, int which  ) {
    const float* g = (which ? INP(13) : INP(12)) + l * 1024;
    const float* mod = WSP(float, WS_MOD) + (size_t)l * 3 * 6144 + (which ? 3072 : 0);
    bf16_t* H = WSP(bf16_t, WS_ACT);
    const bool first = (l == 0 && which == 0);
    f32x4 gv[4];
#pragma unroll
    for (int j = 0; j < 4; ++j) gv[j] = *(const GAS f32x4*)(g + 4 * F.lane + 256 * j);
    for (int row = F.gw; row < M; row += F.ngw) {
        const float* mv = mod + (row < MC ? 0 : (row < 2 * MC ? 1 : 2)) * 6144;
        f32x4 v[4]; float ss = 0.f;
        if (first) { const float* xr = row < MC ? INP(0) + (size_t)row * DM : INP(1) + (size_t)(row - MC) * DM;
#pragma unroll
            for (int j = 0; j < 4; ++j) v[j] = *(const GAS f32x4*)(xr + 4 * F.lane + 256 * j); }
        else {
#pragma unroll
            for (int j = 0; j < 4; ++j) v[j] = unpack4(LDG(u32x2, F.ws, WS_XB + ((unsigned)row * DM + 4 * F.lane + 256 * j) * 2)); }
#pragma unroll
        for (int j = 0; j < 4; ++j) ss += (v[j][0] * v[j][0] + v[j][1] * v[j][1]) + (v[j][2] * v[j][2] + v[j][3] * v[j][3]);
        const float rstd = rsqrtf(wave_sum(ss) * (1.f / 1024.f) + 1e-6f);
#pragma unroll
        for (int j = 0; j < 4; ++j) { const f32x4 sh = *(const GAS f32x4*)(mv + 4 * F.lane + 256 * j), sc = *(const GAS f32x4*)(mv + 1024 + 4 * F.lane + 256 * j);
            const f32x4 h = v[j] * rstd * gv[j] * (sc + 1.f) + sh;
            *(GAS u32x2*)(H + (size_t)row * DM + 4 * F.lane + 256 * j) = pack4(h); }
    }
}
__device__ __forceinline__ void phase_final_norm(Frame& F) {
    const float* g = INP(33);
    f32x4 gv[4];
#pragma unroll
    for (int j = 0; j < 4; ++j) gv[j] = *(const GAS f32x4*)(g + 4 * F.lane + 256 * j);
    for (int row = F.gw; row < M; row += F.ngw) {
        float* xr = gptr(F.out + (size_t)row * DM);
        f32x4 v[4]; float ss = 0.f;
#pragma unroll
        for (int j = 0; j < 4; ++j) { v[j] = unpack4(LDG(u32x2, F.ws, WS_XB + ((unsigned)row * DM + 4 * F.lane + 256 * j) * 2)); ss += (v[j][0] * v[j][0] + v[j][1] * v[j][1]) + (v[j][2] * v[j][2] + v[j][3] * v[j][3]); }
        const float rstd = rsqrtf(wave_sum(ss) * (1.f / 1024.f) + 1e-6f);
#pragma unroll
        for (int j = 0; j < 4; ++j) *(GAS f32x4*)(xr + 4 * F.lane + 256 * j) = v[j] * rstd * gv[j];
    }
}

#define MFMA32(a, b, c) __builtin_amdgcn_mfma_f32_32x32x16_bf16((a), (b), (c), 0, 0, 0)
#ifndef ATT_PROBE
#define ATT_PROBE 0
#endif
struct AttnQ { float m, l; bool mz; f32x16 o[2]; };
template <int DQK, bool MASK, int NQ>
__device__ __forceinline__ void attn_block(const bf16x8 (&qf)[NQ][DQK / 16], const bf16x8 (&kf)[DQK / 16], const bf16x8 (&vf)[4], AttnQ (&st)[NQ], int b, const int (&qpos)[NQ], int kpos0, int hi) {
    constexpr int NS = DQK / 16;
    f32x16 sc[NQ];
#pragma unroll
    for (int q = 0; q < NQ; ++q) { const f32x16 z = {}; sc[q] = MFMA32(kf[0], qf[q][0], z);
#pragma unroll
        for (int s = 1; s < NS; ++s) sc[q] = MFMA32(kf[s], qf[q][s], sc[q]); }
#pragma unroll
    for (int q = 0; q < NQ; ++q) {
        if (!st[q].mz) {
#pragma unroll
            for (int r = 0; r < 16; ++r) sc[q][r] -= st[q].m; }
        if (MASK) {
#pragma unroll
            for (int r = 0; r < 16; ++r) { const int key = kpos0 + 32 * b + (r & 3) + 8 * (r >> 2) + 4 * hi; const int dlt = key - qpos[q]; if (dlt > 128 || dlt < -128) sc[q][r] = -1e30f; }
        }
        float bm = fmaxf(fmaxf(sc[q][0], sc[q][1]), sc[q][2]);
#pragma unroll
        for (int r = 3; r < 15; r += 2) bm = fmaxf(fmaxf(bm, sc[q][r]), sc[q][r + 1]);
        bm = fmaxf(bm, sc[q][15]);
        bm = swap32_max(bm);
        if (__builtin_amdgcn_ballot_w64(bm > 64.f) != 0ull) {
            const float d = fmaxf(bm, 0.f);
            const float alpha = __builtin_amdgcn_exp2f(-d);
            st[q].m += d; st[q].l *= alpha; st[q].mz = false;
#pragma unroll
            for (int r = 0; r < 16; ++r) { st[q].o[0][r] *= alpha; st[q].o[1][r] *= alpha; sc[q][r] -= d; }
        }
#if ATT_PROBE == 1
        { float dmy = 0.f;
#pragma unroll
          for (int r = 0; r < 16; ++r) { float e_; asm volatile("v_exp_f32 %0, %1" : "=v"(e_) : "v"(sc[q][r])); dmy += e_; }
          asm volatile("" :: "v"(dmy)); }
#endif
        f32x2 rs2 = {0.f, 0.f};
#pragma unroll
        for (int r = 0; r < 16; r += 2) { sc[q][r] = __builtin_amdgcn_exp2f(sc[q][r]); sc[q][r + 1] = __builtin_amdgcn_exp2f(sc[q][r + 1]); rs2 += (f32x2){sc[q][r], sc[q][r + 1]}; }
        st[q].l += rs2[0] + rs2[1];
#if ATT_PROBE == 3
        { float d0 = 0.f, d1 = 0.f, d2 = 0.f, d3 = 0.f;
#pragma unroll
          for (int rr = 0; rr < 10; ++rr) { asm volatile("v_add_f32 %0, %0, %4\n\tv_add_f32 %1, %1, %5\n\tv_add_f32 %2, %2, %6\n\tv_add_f32 %3, %3, %7" : "+v"(d0), "+v"(d1), "+v"(d2), "+v"(d3) : "v"(sc[q][0]), "v"(sc[q][1]), "v"(sc[q][2]), "v"(sc[q][3])); }
          asm volatile("" :: "v"(d0), "v"(d1), "v"(d2), "v"(d3)); }
#endif
#if ATT_PROBE == 2
        { f32x16 dm = sc[q]; dm = MFMA32(kf[0], qf[q][0], dm); dm = MFMA32(kf[0], qf[q][0], dm); dm = MFMA32(kf[0], qf[q][0], dm); asm volatile("" :: "v"(dm)); }
#endif
        bf16x8 pb[2];
#pragma unroll
        for (int ks = 0; ks < 2; ++ks) { u32x4 w; w.x = pk2(sc[q][8 * ks], sc[q][8 * ks + 1]); w.y = pk2(sc[q][8 * ks + 2], sc[q][8 * ks + 3]); w.z = pk2(sc[q][8 * ks + 4], sc[q][8 * ks + 5]); w.w = pk2(sc[q][8 * ks + 6], sc[q][8 * ks + 7]); pb[ks] = __builtin_bit_cast(bf16x8, w); }
#pragma unroll
        for (int db = 0; db < 2; ++db)
#pragma unroll
            for (int ks = 0; ks < 2; ++ks) st[q].o[db] = MFMA32(vf[db * 2 + ks], pb[ks], st[q].o[db]);
    }
}
template <int DQK, bool MASK, int NQ>
__device__ __forceinline__ void attn_seg(const unsigned char* ws, const bf16x8 (&qf)[NQ][DQK / 16], AttnQ (&st)[NQ],
                                         unsigned kp, unsigned kblk  , unsigned vp, unsigned vblk, int nblk, const int (&qpos)[NQ], int kpos0, int hi) {
    constexpr int NS = DQK / 16;
    const GAS unsigned char* kq = (const GAS unsigned char*)ws + kp; const GAS unsigned char* vq = (const GAS unsigned char*)ws + vp;
    bf16x8 ka[NS], va[4], kb[NS], vb[4];
#define ATT_LOAD(kd, vd) do { _Pragma("unroll") for (int s = 0; s < NS; ++s) kd[s] = *(const GAS bf16x8*)(kq + 1024 * s); _Pragma("unroll") for (int f = 0; f < 4; ++f) vd[f] = *(const GAS bf16x8*)(vq + 1024 * f); } while (0)
    ATT_LOAD(ka, va);
    int b = 0;
    for (; b + 1 < nblk; b += 2) {
        kq += kblk; vq += vblk; ATT_LOAD(kb, vb);
        attn_block<DQK, MASK, NQ>(qf, ka, va, st, b, qpos, kpos0, hi);
        if (b + 2 < nblk) { kq += kblk; vq += vblk; }
        ATT_LOAD(ka, va);
        attn_block<DQK, MASK, NQ>(qf, kb, vb, st, b + 1, qpos, kpos0, hi);
    }
    if (b < nblk) attn_block<DQK, MASK, NQ>(qf, ka, va, st, b, qpos, kpos0, hi);
#undef ATT_LOAD
}
__device__ __forceinline__ void attnq_init(AttnQ& s, float l0) { s.m = 0.f; s.mz = true; s.l = l0; s.o[0] = (f32x16){}; s.o[1] = (f32x16){}; }
__device__ __forceinline__ void attn_a_item(Frame& F, int l, bool lat, int item) {
    int lane = F.lane; asm volatile("" : "+v"(lane));
    const unsigned char* ws = F.ws;
    const unsigned r32 = lane & 31, hi = lane >> 5;
    const unsigned nqb = lat ? 128 : 8;
    const unsigned qb = item % nqb, hq = (item / nqb) % 6, b = item / (nqb * 6), kvh = hq / 3;
    const unsigned seq0 = lat ? MC + b * 4096 : b * 256, q0 = qb * 32, row = seq0 + q0 + r32;
    const unsigned qo = WS_QA + (row * 384 + hq * 64 + 8 * hi) * 2;
    bf16x8 qf[1][4];
#pragma unroll
    for (int s = 0; s < 4; ++s) qf[0][s] = LDG(bf16x8, ws, qo + 32 * s);
    AttnQ st[1]; attnq_init(st[0], hi == 0 ? __builtin_amdgcn_exp2f(INP(15)[l * 6 + hq] * LOG2E) : 0.f);
    const int qpos[1] = {(int)(q0 + r32)};
    const unsigned fo = kvh * 4096 + lane * 16;
    if (!lat) {
        attn_seg<64, false, 1>(ws, qf, st, WS_KA + (seq0 >> 5) * 8192 + fo, 8192, WS_VTA + (seq0 >> 5) * 8192 + fo, 8192, 8, qpos, 0, hi);
    } else {
        const int ks = (int)q0 - 128 < 0 ? 0 : (int)q0 - 128, ke = q0 + 160 > 4096 ? 4096 : q0 + 160;
        attn_seg<64, true, 1>(ws, qf, st, WS_KA + ((seq0 + ks) >> 5) * 8192 + fo, 8192, WS_VTA + ((seq0 + ks) >> 5) * 8192 + fo, 8192, (ke - ks) >> 5, qpos, ks, hi);
        attn_seg<64, false, 1>(ws, qf, st, WS_CACHE + (b * 4 + l) * 131072 + fo, 8192, WS_CACHE + 1 * MiB + (b * 4 + l) * 131072 + fo, 8192, 16, qpos, 0, hi);
    }
    const float rl = 1.f / swap32_sum(st[0].l);
    const unsigned oo = WS_ACT + (row * DM + hq * 64 + 4 * hi) * 2;
#pragma unroll
    for (int db = 0; db < 2; ++db)
#pragma unroll
        for (int g = 0; g < 4; ++g) { const f32x4 v = {st[0].o[db][4 * g] * rl, st[0].o[db][4 * g + 1] * rl, st[0].o[db][4 * g + 2] * rl, st[0].o[db][4 * g + 3] * rl}; STG(u32x2, F.ws, oo + (32 * db + 8 * g) * 2) = pack4(v); }
}
__device__ __forceinline__ void attn_b_store(Frame& F, const AttnQ& s, unsigned mp, unsigned kh, unsigned row, unsigned h, unsigned hi) {
    const float lt = swap32_sum(s.l);
    const unsigned oo = WS_BO2 + (((mp * 2 + kh) * M + row) * 256 + h * 64 + 4 * hi) * 2;
#pragma unroll
    for (int db = 0; db < 2; ++db)
#pragma unroll
        for (int g = 0; g < 4; ++g) STG(u32x2, F.ws, oo + (32 * db + 8 * g) * 2) = pack4((f32x4){s.o[db][4 * g], s.o[db][4 * g + 1], s.o[db][4 * g + 2], s.o[db][4 * g + 3]});
    if (hi == 0) STG(f32x2, F.ws, WS_ML + ((((mp * 2 + kh) * M + row) * 4 + h) * 2) * 4) = (f32x2){s.m, lt};
}
__device__ __forceinline__ void attn_b_item(Frame& F, int l, bool lat, int item) {
    int lane = F.lane; asm volatile("" : "+v"(lane));
    const unsigned char* ws = F.ws;
    const unsigned r32 = lane & 31, hi = lane >> 5;
    if (lat) {
        const unsigned kh = item & 1, qb = (item >> 1) & 63, mp = (item >> 7) & 1, h = (item >> 8) & 3, b = item >> 10;
        const unsigned seq0 = MC + b * 4096, row0 = seq0 + qb * 64 + r32;
        bf16x8 qf[2][2];
#pragma unroll
        for (int q = 0; q < 2; ++q)
#pragma unroll
            for (int s = 0; s < 2; ++s) qf[q][s] = LDG(bf16x8, ws, WS_QB + ((row0 + 32 * q) * 256 + h * 64 + mp * 32 + 8 * hi) * 2 + 32 * s);
        AttnQ st[2]; attnq_init(st[0], 0.f); attnq_init(st[1], 0.f);
        const int qpos[2] = {0, 0};
        const unsigned kfo = (h * 2 + mp) * 2048 + lane * 16, vfo = h * 4096 + lane * 16;
        const unsigned blk0 = kh ? 72u : 0u, nb = kh ? 56 : 72;
        attn_seg<32, false, 2>(ws, qf, st, WS_KB + ((seq0 >> 5) + blk0) * 16384 + kfo, 16384, WS_VTB + ((seq0 >> 5) + blk0) * 16384 + vfo, 16384, nb, qpos, 0, hi);
        if (kh) attn_seg<32, false, 2>(ws, qf, st, WS_CACHE + 2 * MiB + (b * 4 + l) * 262144 + kfo, 16384, WS_CACHE + 4 * MiB + (b * 4 + l) * 262144 + vfo, 16384, 16, qpos, 0, hi);
        attn_b_store(F, st[0], mp, kh, row0, h, hi); attn_b_store(F, st[1], mp, kh, row0 + 32, h, hi);
    } else {
        const unsigned qb = item & 7, mp = (item >> 3) & 1, h = (item >> 4) & 3, b = item >> 6;
        const unsigned seq0 = b * 256, row = seq0 + qb * 32 + r32;
        bf16x8 qf[1][2];
#pragma unroll
        for (int s = 0; s < 2; ++s) qf[0][s] = LDG(bf16x8, ws, WS_QB + (row * 256 + h * 64 + mp * 32 + 8 * hi) * 2 + 32 * s);
        AttnQ st[1]; attnq_init(st[0], 0.f);
        const int qpos[1] = {0};
        const unsigned kfo = (h * 2 + mp) * 2048 + lane * 16, vfo = h * 4096 + lane * 16;
        attn_seg<32, false, 1>(ws, qf, st, WS_KB + (seq0 >> 5) * 16384 + kfo, 16384, WS_VTB + (seq0 >> 5) * 16384 + vfo, 16384, 8, qpos, 0, hi);
        attn_b_store(F, st[0], mp, 0, row, h, hi);
    }
}

constexpr int L_KT = 0, L_RT = 9216, L_BT = 18432, L_KK = 27648, L_VT = 36864, L_KKT = 46080, L_BTT = 55296, L_A1 = 64512, L_RHS2 = 81920, L_WT = 99328, L_U0T = 108544, L_GC = 117760, L_X0 = 118016;
constexpr int RPB = 144, RPF = 272;
__device__ __forceinline__ void chunk_decode(int cid, unsigned& seq0, int& T, unsigned& b, unsigned& h, unsigned& dir, int& c) {
    unsigned chain;
    if (cid < 768) { chain = (unsigned)cid >> 2; c = cid & 3; T = 256; b = chain / 12; seq0 = b * 256; }
    else { const unsigned x = (unsigned)cid - 768; chain = x >> 6; c = (int)(x & 63); T = 4096; b = chain / 12; seq0 = MC + b * 4096; }
    dir = chain & 1; h = (chain >> 1) % 6;
}
__device__ __forceinline__ bf16x8 acc_frag(const f32x16& x, int ks, float sgn) {
    u32x4 w; w.x = pk2(sgn * x[8 * ks], sgn * x[8 * ks + 1]); w.y = pk2(sgn * x[8 * ks + 2], sgn * x[8 * ks + 3]); w.z = pk2(sgn * x[8 * ks + 4], sgn * x[8 * ks + 5]); w.w = pk2(sgn * x[8 * ks + 6], sgn * x[8 * ks + 7]);
    return __builtin_bit_cast(bf16x8, w);
}
__device__ __forceinline__ bf16x8 lds_frag_nat(const LAS unsigned char* img, unsigned row, int ks, unsigned hi) { return *(const LAS bf16x8*)(img + row * RPB + (16 * ks + 8 * hi) * 2); }
__device__ __forceinline__ bf16x8 lds_frag_perm(const LAS unsigned char* img, unsigned row, int k0, unsigned hi) {
    const s16x4 a = *(const LAS s16x4*)(img + row * RPB + (k0 + 4 * hi) * 2), b = *(const LAS s16x4*)(img + row * RPB + (k0 + 8 + 4 * hi) * 2);
    return (bf16x8){a[0], a[1], a[2], a[3], b[0], b[1], b[2], b[3]};
}
__device__ __forceinline__ f32x16 gram_tile(const LAS unsigned char* lds, int aimg, int bimg, int sb, int tb, unsigned r32, unsigned hi, bool strict) {
    f32x16 acc = {};
#pragma unroll
    for (int ks = 0; ks < 4; ++ks) acc = MFMA32(lds_frag_nat(lds + aimg, 32 * sb + r32, ks, hi), lds_frag_nat(lds + bimg, 32 * tb + r32, ks, hi), acc);
    if (sb == tb) {
#pragma unroll
        for (int r = 0; r < 16; ++r) { const unsigned s_ = (r & 3) + 8 * (r >> 2) + 4 * hi; const bool keep = strict ? s_ < r32 : s_ <= r32; acc[r] = keep ? acc[r] : 0.f; }
    }
    return acc;
}
__device__ __forceinline__ void lds_barrier() { asm volatile("s_waitcnt lgkmcnt(0)\n\ts_barrier" ::: "memory"); }
__device__ __forceinline__ void rwkv_chunk_block(Frame& F, int l, int cid) {
    int lane = F.lane; asm volatile("" : "+v"(lane));
    const unsigned char* ws = F.ws; LAS unsigned char* lds = F.lds;
    const int w = F.wave; const unsigned r32 = lane & 31, hi = lane >> 5;
    unsigned seq0, b, h, dir; int T, c; chunk_decode(cid, seq0, T, b, h, dir, c);
    const int q0 = 64 * c;
#ifndef RA_REP
#define RA_REP 0
#endif
    const int role = w >> 1, tb = w & 1;
    const unsigned swo = WS_SMALLW + l * (SMALLW_L * 2);
    {
        const int pw_ = w < 4, pb = (w >> 1) & 1, cb = w & 1;
        const int p_ = 32 * pb + r32; const unsigned tokp = seq0 + (dir ? T - 1 - (q0 + p_) : q0 + p_);
        const unsigned xo = (pw_ ? WS_CW : WS_CA) + (tokp * 128 + dir * 64 + 8 * hi) * 2, wo = swo + ((pw_ ? 0 : 49152) + (dir * 384 + h * 64 + 32 * cb + r32) * 64 + 8 * hi) * 2;
        f32x16 acc = {};
#pragma unroll
        for (int ks = 0; ks < 4; ++ks) acc = MFMA32(LDG(bf16x8, ws, xo + 32 * ks), LDG(bf16x8, ws, wo + 32 * ks), acc);
        {
            const float bias = LDG(float, pw_ ? INP(19) : INP(21), ((l * 2 + dir) * 384 + h * 64 + 32 * cb + r32) * 4);
#pragma unroll
            for (int r = 0; r < 16; ++r) { const float sg = sigmf(bias + acc[r]);
                *(LAS float*)(lds + (pw_ ? L_A1 : L_RHS2) + (32 * pb + (r & 3) + 8 * (r >> 2) + 4 * hi) * RPF + (32 * cb + r32) * 4) = pw_ ? -0.606531f * sg : sg; }
        }
        if (dir == 0 && w < 4) {
            f32x16 ag = {};
            const unsigned go = WS_CG + (tokp * 128 + 8 * hi) * 2, gw_ = swo + (98304 + (h * 64 + 32 * cb + r32) * 128 + 8 * hi) * 2;
#pragma unroll
            for (int ks = 0; ks < 8; ++ks) ag = MFMA32(LDG(bf16x8, ws, go + 32 * ks), LDG(bf16x8, ws, gw_ + 32 * ks), ag);
#pragma unroll
            for (int r = 0; r < 16; ++r) { const int pp_ = 32 * pb + (r & 3) + 8 * (r >> 2) + 4 * hi; const unsigned tk = seq0 + q0 + pp_;
                STG(bf16_t, F.ws, WS_G + (tk * 384 + h * 64 + 32 * cb + r32) * 2) = (bf16_t)(pk2(ag[r], 0.f) & 0xffff); }
        }
    }
    lds_barrier();
    {
        const unsigned cch = h * 64 + lane;
        const float* convp = INP(18) + (size_t)l * 3 * 1152;
        float cw_[3][3];
#pragma unroll
        for (int tap = 0; tap < 3; ++tap)
#pragma unroll
            for (int seg = 0; seg < 3; ++seg) cw_[tap][seg] = LDG(float, convp, (tap * 1152 + seg * 384 + cch) * 4);
        const float ckk = LDG(float, INP(24), (l * 384 + cch) * 4), cka = LDG(float, INP(25), (l * 384 + cch) * 4), crk = LDG(float, INP(26), (l * 384 + cch) * 4);
        const int tb0 = dir ? T - 1 - (q0 + 8 * w + 7) : q0 + 8 * w;
        float xr[10][3];
#pragma unroll
        for (int rr = 0; rr < 10; ++rr) { const int tr = tb0 - 1 + rr; const bool ok = tr >= 0 && tr < T; const unsigned tk = seq0 + (ok ? tr : tb0);
#pragma unroll
            for (int seg = 0; seg < 3; ++seg) { const float x = bf_lo((unsigned)LDG(bf16_t, ws, WS_RKV + (tk * 1152 + seg * 384 + cch) * 2)); xr[rr][seg] = ok ? x : 0.f; } }
        float lwv[8], kkv[8], btv[8], kdv[8], rv[8], vv[8], g = 0.f;
#pragma unroll
        for (int pp = 0; pp < 8; ++pp) {
            const int rr = 1 + (dir ? 7 - pp : pp); const int p = 8 * w + pp; const unsigned tok = seq0 + (unsigned)(tb0 + rr - 1);
            const float r_ = xr[rr - 1][0] * cw_[0][0] + xr[rr][0] * cw_[1][0] + xr[rr + 1][0] * cw_[2][0];
            const float k_ = xr[rr - 1][1] * cw_[0][1] + xr[rr][1] * cw_[1][1] + xr[rr + 1][1] * cw_[2][1];
            const float v_ = xr[rr - 1][2] * cw_[0][2] + xr[rr][2] * cw_[1][2] + xr[rr + 1][2] * cw_[2][2];
            const float kraw = k_ * ckk; const float n2 = wave_sum(kraw * kraw); const float kk_ = kraw * __builtin_amdgcn_rsqf(fmaxf(n2, 1e-24f));
            const float lw = *(const LAS float*)(lds + L_A1 + p * RPF + lane * 4), av = *(const LAS float*)(lds + L_RHS2 + p * RPF + lane * 4);
            const float kd_ = k_ * (1.f + (av - 1.f) * cka);
            const float bon = wave_sum(r_ * kd_ * crk);
            if (lane == 0) STG(float, F.ws, WS_SB + ((dir * M + tok) * 8 + h) * 4) = bon;
            if (dir == 0) STG(float, F.ws, WS_SV + (tok * 384 + cch) * 4) = v_;
            lwv[pp] = lw; kkv[pp] = kk_; btv[pp] = kk_ * av; kdv[pp] = kd_; rv[pp] = r_; vv[pp] = v_; g += lw;
        }
        g = 0.f;
        for (int wq = 0; wq < w; ++wq) { float t8[8];
#pragma unroll
            for (int e = 0; e < 8; ++e) t8[e] = *(const LAS float*)(lds + L_A1 + (8 * wq + e) * RPF + lane * 4);
            g += ((t8[0] + t8[1]) + (t8[2] + t8[3])) + ((t8[4] + t8[5]) + (t8[6] + t8[7])); }
        unsigned vt[4], kkt[4], btt[4]; float e_pos = __expf(g);
#pragma unroll
        for (int pp = 0; pp < 8; ++pp) {
            const int p = 8 * w + pp;
            const float e_prev = e_pos; g += lwv[pp]; e_pos = __expf(g); const float e_neg = __expf(-g);
            const unsigned pk_kr = pk2(kkv[pp] * e_prev, rv[pp] * e_pos), pk_bk = pk2(btv[pp] * e_neg, kdv[pp] * e_neg), pk_v = pk2(vv[pp], 0.f);
            *(LAS bf16_t*)(lds + L_KT + p * RPB + lane * 2) = (bf16_t)(pk_kr & 0xffff); *(LAS bf16_t*)(lds + L_RT + p * RPB + lane * 2) = (bf16_t)(pk_kr >> 16);
            *(LAS bf16_t*)(lds + L_BT + p * RPB + lane * 2) = (bf16_t)(pk_bk & 0xffff); *(LAS bf16_t*)(lds + L_KK + p * RPB + lane * 2) = (bf16_t)(pk_bk >> 16);
            if (pp & 1) { vt[pp >> 1] |= pk_v << 16; kkt[pp >> 1] |= pk_bk & 0xffff0000u; btt[pp >> 1] |= pk_bk << 16; }
            else { vt[pp >> 1] = pk_v & 0xffff; kkt[pp >> 1] = pk_bk >> 16; btt[pp >> 1] = pk_bk & 0xffff; }
        }
        *(LAS u32x4*)(lds + L_VT + lane * RPB + 16 * w) = (u32x4){vt[0], vt[1], vt[2], vt[3]};
        *(LAS u32x4*)(lds + L_KKT + lane * RPB + 16 * w) = (u32x4){kkt[0], kkt[1], kkt[2], kkt[3]};
        *(LAS u32x4*)(lds + L_BTT + lane * RPB + 16 * w) = (u32x4){btt[0], btt[1], btt[2], btt[3]};
        if (w == 7) *(LAS float*)(lds + L_GC + lane * 4) = e_pos;
    }
    lds_barrier();
    f32x16 keep[2]; bf16x8 x4f[2][2];
    if (role == 0) {
        for (int sb = 0; sb <= tb; ++sb) { const f32x16 x = gram_tile(lds, L_BT, L_KT, sb, tb, r32, hi, true);
            if (sb == tb) {
#pragma unroll
                for (int r = 0; r < 16; ++r) *(LAS float*)(lds + L_A1 + tb * 4608 + ((r & 3) + 8 * (r >> 2) + 4 * hi) * 144 + r32 * 4) = -x[r];
            } else {
#pragma unroll
                for (int g4 = 0; g4 < 4; ++g4) *(LAS f32x4*)(lds + L_A1 + 9216 + r32 * 144 + (8 * g4 + 4 * hi) * 4) = (f32x4){x[4 * g4], x[4 * g4 + 1], x[4 * g4 + 2], x[4 * g4 + 3]};
            } }
    } else if (role == 1) {
        f32x16 o[2] = {};
        for (int sb = 0; sb <= tb; ++sb) {
            const f32x16 x = gram_tile(lds, L_KK, L_KT, sb, tb, r32, hi, true);
#pragma unroll
            for (int ks = 0; ks < 2; ++ks) { const bf16x8 a = acc_frag(x, ks, 1.f);
#pragma unroll
                for (int ib = 0; ib < 2; ++ib) o[ib] = MFMA32(a, lds_frag_perm(lds + L_VT, 32 * ib + r32, 32 * sb + 16 * ks, hi), o[ib]); }
        }
#pragma unroll
        for (int ib = 0; ib < 2; ++ib)
#pragma unroll
            for (int r = 0; r < 16; ++r) *(LAS float*)(lds + L_RHS2 + (32 * tb + (r & 3) + 8 * (r >> 2) + 4 * hi) * RPF + (32 * ib + r32) * 4) = o[ib][r];
    } else if (role == 2) {
#pragma unroll
        for (int sb = 0; sb < 2; ++sb) { x4f[sb][0] = (bf16x8){}; x4f[sb][1] = (bf16x8){}; }
        keep[0] = (f32x16){}; keep[1] = (f32x16){};
        for (int sb = 0; sb <= tb; ++sb) {
            const f32x16 x3 = gram_tile(lds, L_KK, L_RT, sb, tb, r32, hi, false), x4 = gram_tile(lds, L_BT, L_RT, sb, tb, r32, hi, false);
#pragma unroll
            for (int ks = 0; ks < 2; ++ks) { const bf16x8 a3 = acc_frag(x3, ks, 1.f); const bf16x8 a4 = acc_frag(x4, ks, -1.f);
                if (sb == 0) x4f[0][ks] = a4; else x4f[1][ks] = a4;
#pragma unroll
                for (int cb = 0; cb < 2; ++cb) keep[cb] = MFMA32(a3, lds_frag_perm(lds + L_VT, 32 * cb + r32, 32 * sb + 16 * ks, hi), keep[cb]); }
        }
    } else {
        keep[0] = (f32x16){}; keep[1] = (f32x16){};
#pragma unroll
        for (int ks = 0; ks < 4; ++ks) { const bf16x8 ak = lds_frag_nat(lds + L_KKT, 32 * tb + r32, ks, hi);
#pragma unroll
            for (int cb = 0; cb < 2; ++cb) keep[cb] = MFMA32(ak, lds_frag_nat(lds + L_VT, 32 * cb + r32, ks, hi), keep[cb]); }
    }
    lds_barrier();
    if (w < 2) {
        const LAS unsigned char* a1p = lds + L_A1; asm volatile("" : "+v"(a1p));
        LAS unsigned char* xp = lds + (w == 0 ? L_X0 : L_RHS2) + lane * 4; asm volatile("" : "+v"(xp));
        const LAS unsigned char* kp = lds + L_KT + lane * 2; asm volatile("" : "+v"(kp));
        LAS unsigned char* dst = lds + (w == 0 ? L_WT : L_U0T) + lane * RPB; asm volatile("" : "+v"(dst));
#pragma unroll
        for (int B = 0; B < 2; ++B) {
            float acc[32];
            if (w == 0 && B == 0) {
#pragma unroll
                for (int r = 0; r < 32; ++r) acc[r] = bf_lo((unsigned)*(const LAS bf16_t*)(kp + r * RPB));
            } else {
#pragma unroll
                for (int r = 0; r < 32; ++r) acc[r] = *(const LAS float*)(xp + (32 * B + r) * RPF);
            }
            f32x2 ac2[16];
#pragma unroll
            for (int k = 0; k < 16; ++k) ac2[k] = (f32x2){acc[2 * k], acc[2 * k + 1]};
            f32x4 ca[8], cn[8];
#pragma unroll
            for (int tg = 0; tg < 8; ++tg) ca[tg] = *(const LAS f32x4*)(a1p + B * 4608 + tg * 16);
#pragma unroll
            for (int s_ = 0; s_ < 31; ++s_) {
                if (s_ + 1 < 31) {
#pragma unroll
                    for (int tg = (s_ + 2) / 4; tg < 8; ++tg) cn[tg] = *(const LAS f32x4*)(a1p + B * 4608 + (s_ + 1) * 144 + tg * 16);
                }
                __builtin_amdgcn_sched_barrier(0);
                const float xs = ac2[s_ >> 1][s_ & 1];
                const f32x2 xs2 = {xs, xs};
#pragma unroll
                for (int tg = (s_ + 1) / 4; tg < 8; ++tg) {
                    ac2[2 * tg] = __builtin_elementwise_fma((f32x2){ca[tg][0], ca[tg][1]}, xs2, ac2[2 * tg]);
                    ac2[2 * tg + 1] = __builtin_elementwise_fma((f32x2){ca[tg][2], ca[tg][3]}, xs2, ac2[2 * tg + 1]); }
                __builtin_amdgcn_sched_barrier(0);
#pragma unroll
                for (int tg = 0; tg < 8; ++tg) ca[tg] = cn[tg];
            }
#pragma unroll
            for (int k = 0; k < 16; ++k) { acc[2 * k] = ac2[k][0]; acc[2 * k + 1] = ac2[k][1]; }
#pragma unroll
            for (int k8 = 0; k8 < 4; ++k8) { u32x4 v; v.x = pk2(acc[8 * k8], acc[8 * k8 + 1]); v.y = pk2(acc[8 * k8 + 2], acc[8 * k8 + 3]); v.z = pk2(acc[8 * k8 + 4], acc[8 * k8 + 5]); v.w = pk2(acc[8 * k8 + 6], acc[8 * k8 + 7]);
                *(LAS u32x4*)(dst + 64 * B + 16 * k8) = v; }
            if (B == 0) {
                asm volatile("s_waitcnt lgkmcnt(0)" ::: "memory");
                f32x16 u[2];
#pragma unroll
                for (int cb = 0; cb < 2; ++cb)
#pragma unroll
                    for (int r = 0; r < 16; ++r) { const int t = 32 + (r & 3) + 8 * (r >> 2) + 4 * hi;
                        u[cb][r] = w == 0 ? bf_lo((unsigned)*(const LAS bf16_t*)(lds + L_KT + t * RPB + (32 * cb + r32) * 2)) : *(const LAS float*)(lds + L_RHS2 + t * RPF + (32 * cb + r32) * 4); }
#pragma unroll
                for (int ks = 0; ks < 2; ++ks) { const f32x4 a0 = *(const LAS f32x4*)(lds + L_A1 + 9216 + r32 * 144 + (16 * ks + 8 * hi) * 4), a1 = *(const LAS f32x4*)(lds + L_A1 + 9216 + r32 * 144 + (16 * ks + 8 * hi + 4) * 4);
                    u32x4 aw; aw.x = pk2(-a0[0], -a0[1]); aw.y = pk2(-a0[2], -a0[3]); aw.z = pk2(-a1[0], -a1[1]); aw.w = pk2(-a1[2], -a1[3]);
#pragma unroll
                    for (int cb = 0; cb < 2; ++cb) u[cb] = MFMA32(__builtin_bit_cast(bf16x8, aw), lds_frag_nat(lds + (w == 0 ? L_WT : L_U0T), 32 * cb + r32, ks, hi), u[cb]); }
#pragma unroll
                for (int cb = 0; cb < 2; ++cb)
#pragma unroll
                    for (int r = 0; r < 16; ++r) *(LAS float*)(lds + (w == 0 ? L_X0 : L_RHS2) + (32 + (r & 3) + 8 * (r >> 2) + 4 * hi) * RPF + (32 * cb + r32) * 4) = u[cb][r];
                asm volatile("s_waitcnt lgkmcnt(0)" ::: "memory");
            }
        }
    }
    lds_barrier();
    if (role == 2) {
        f32x16 pj[2];
#pragma unroll
        for (int jb = 0; jb < 2; ++jb)
#pragma unroll
            for (int r = 0; r < 16; ++r) pj[jb][r] = bf_lo((unsigned)*(const LAS bf16_t*)(lds + L_RT + (32 * tb + (r & 3) + 8 * (r >> 2) + 4 * hi) * RPB + (32 * jb + r32) * 2));
#pragma unroll
        for (int sb = 0; sb < 2; ++sb)
#pragma unroll
            for (int ks = 0; ks < 2; ++ks)
#pragma unroll
                for (int cb = 0; cb < 2; ++cb) {
                    keep[cb] = MFMA32(x4f[sb][ks], lds_frag_perm(lds + L_U0T, 32 * cb + r32, 32 * sb + 16 * ks, hi), keep[cb]);
                    pj[cb] = MFMA32(x4f[sb][ks], lds_frag_perm(lds + L_WT, 32 * cb + r32, 32 * sb + 16 * ks, hi), pj[cb]); }
        f32x16 (&y0)[2] = keep;
        const unsigned yb = dir ? WS_YB : WS_YF;
#pragma unroll
        for (int r = 0; r < 16; ++r) { const int t = 32 * tb + (r & 3) + 8 * (r >> 2) + 4 * hi; const unsigned tok = seq0 + (dir ? T - 1 - (q0 + t) : q0 + t);
#pragma unroll
            for (int cb = 0; cb < 2; ++cb) { STG(float, F.ws, yb + (tok * 384 + h * 64 + 32 * cb + r32) * 4) = y0[cb][r];
                STG(bf16_t, F.ws, WS_RP + (((unsigned)cid * 64 + t) * 64 + 32 * cb + r32) * 2) = (bf16_t)(pk2(pj[cb][r], 0.f) & 0xffff); } }
    } else if (role == 3) {
        const int jb = tb;
        f32x16 q1[2] = {}, q2[2] = {}; f32x16 (&n1)[2] = keep;
#pragma unroll
        for (int ks = 0; ks < 4; ++ks) { const bf16x8 a = lds_frag_nat(lds + L_BTT, 32 * jb + r32, ks, hi);
#pragma unroll
            for (int cb = 0; cb < 2; ++cb) { q1[cb] = MFMA32(lds_frag_nat(lds + L_WT, 32 * cb + r32, ks, hi), a, q1[cb]); q2[cb] = MFMA32(a, lds_frag_nat(lds + L_U0T, 32 * cb + r32, ks, hi), q2[cb]); } }
#pragma unroll
        for (int q = 0; q < 4; ++q) { f32x4 gc4;
#pragma unroll
            for (int e = 0; e < 4; ++e) gc4[e] = *(const LAS float*)(lds + L_GC + (32 * jb + e + 8 * q + 4 * hi) * 4);
#pragma unroll
            for (int cb = 0; cb < 2; ++cb) { f32x4 nv;
#pragma unroll
                for (int e = 0; e < 4; ++e) nv[e] = gc4[e] * (n1[cb][4 * q + e] - q2[cb][4 * q + e]);
                STG(f32x4, F.ws, WS_RN + ((((unsigned)cid * 2 + jb) * 2 + cb) * 4 + q) * 1024 + lane * 16) = nv; } }
        { const float gl = *(const LAS float*)(lds + L_GC + (32 * jb + r32) * 4);
#pragma unroll
          for (int cb = 0; cb < 2; ++cb)
#pragma unroll
            for (int s2 = 0; s2 < 2; ++s2) { float mv[8];
#pragma unroll
                for (int e = 0; e < 8; ++e) { const int r = 8 * s2 + e; const unsigned c = 32 * cb + (r & 3) + 8 * (r >> 2) + 4 * hi; mv[e] = (c == 32 * jb + r32 ? gl : 0.f) - gl * q1[cb][r]; }
                u32x4 w; w.x = pk2(mv[0], mv[1]); w.y = pk2(mv[2], mv[3]); w.z = pk2(mv[4], mv[5]); w.w = pk2(mv[6], mv[7]);
                STG(u32x4, F.ws, WS_RM + (unsigned)cid * 8192 + ((jb * 2 + cb) * 2 + s2) * 1024 + lane * 16) = w; } }
    }
    lds_barrier();
}
__device__ __forceinline__ void rwkv_chain_wave(Frame& F, int l, bool lat, int chain, int ib) {
    int lane = F.lane; asm volatile("" : "+v"(lane));
    const unsigned char* ws = F.ws; const unsigned r32 = lane & 31, hi = lane >> 5;
    const unsigned dir = chain & 1, h = (chain >> 1) % 6, b = chain / 12;
    const int nc = lat ? 64 : 4; const unsigned cid0 = lat ? 768 + chain * 64 : chain * 4;
    const unsigned i = 32 * ib + r32;
    const unsigned so = ((((b * 4 + l) * 6 + h) * 64 + i) * 64) * 4;
    f32x16 H[2];
#pragma unroll
    for (int jb = 0; jb < 2; ++jb)
#pragma unroll
        for (int g4 = 0; g4 < 4; ++g4) { f32x4 v = {0.f, 0.f, 0.f, 0.f}; if (lat) v = LDG(f32x4, dir ? INP(7) : INP(6), so + (32 * jb + 8 * g4 + 4 * hi) * 4);
            H[jb][4 * g4] = v[0]; H[jb][4 * g4 + 1] = v[1]; H[jb][4 * g4 + 2] = v[2]; H[jb][4 * g4 + 3] = v[3]; }
    bf16x8 maA[2][2][2], maB[2][2][2]; f32x16 ntA[2], ntB[2];
    const GAS unsigned char* pm = (const GAS unsigned char*)ws + (WS_RM + cid0 * 8192 + lane * 16);
    const GAS unsigned char* pn = (const GAS unsigned char*)ws + (WS_RN + (cid0 * 4 + ib) * 4096 + lane * 16);
#define RB_LOAD(ma, nt, k_) do { \
        _Pragma("unroll") for (int jo = 0; jo < 2; ++jo) _Pragma("unroll") for (int ji = 0; ji < 2; ++ji) _Pragma("unroll") for (int ks = 0; ks < 2; ++ks) ma[jo][ji][ks] = *(const GAS bf16x8*)(pm + ((k_) * 8192 + ((jo * 2 + ji) * 2 + ks) * 1024)); \
        _Pragma("unroll") for (int jo = 0; jo < 2; ++jo) _Pragma("unroll") for (int q = 0; q < 4; ++q) { const f32x4 t_ = *(const GAS f32x4*)(pn + ((k_) * 16384 + (jo * 8 + q) * 1024)); \
            nt[jo][4 * q] = t_[0]; nt[jo][4 * q + 1] = t_[1]; nt[jo][4 * q + 2] = t_[2]; nt[jo][4 * q + 3] = t_[3]; } } while (0)
#define RB_STEP(ma, nt, cid_) do { \
        bf16x8 hf[2][2]; \
        _Pragma("unroll") for (int ji = 0; ji < 2; ++ji) { hf[ji][0] = acc_frag(H[ji], 0, 1.f); hf[ji][1] = acc_frag(H[ji], 1, 1.f); } \
        _Pragma("unroll") for (int ji = 0; ji < 2; ++ji) _Pragma("unroll") for (int ks = 0; ks < 2; ++ks) STG(bf16x8, F.ws, WS_RH + (cid_) * 8192 + ((ib * 2 + ji) * 2 + ks) * 1024 + lane * 16) = hf[ji][ks]; \
        f32x16 acc[2] = {nt[0], nt[1]}; \
        _Pragma("unroll") for (int jo = 0; jo < 2; ++jo) _Pragma("unroll") for (int ji = 0; ji < 2; ++ji) _Pragma("unroll") for (int ks = 0; ks < 2; ++ks) acc[jo] = MFMA32(ma[jo][ji][ks], hf[ji][ks], acc[jo]); \
        H[0] = acc[0]; H[1] = acc[1]; } while (0)
    RB_LOAD(maA, ntA, 0); RB_LOAD(maB, ntB, 1);
#pragma unroll 1
    for (int c = 0; c < nc; c += 2) {
        const unsigned cid = cid0 + c;
        RB_STEP(maA, ntA, cid);
        if (c + 2 < nc) RB_LOAD(maA, ntA, 2);
        RB_STEP(maB, ntB, cid + 1);
        if (c + 2 < nc) RB_LOAD(maB, ntB, 3);
        pm += 16384; pn += 32768;
    }
#undef RB_LOAD
#undef RB_STEP
    if (!lat) {
#pragma unroll
        for (int jb = 0; jb < 2; ++jb)
#pragma unroll
            for (int g4 = 0; g4 < 4; ++g4) STG(f32x4, F.out, (dir ? OFF_CB : OFF_CF) * 4 + so + (32 * jb + 8 * g4 + 4 * hi) * 4) = (f32x4){H[jb][4 * g4], H[jb][4 * g4 + 1], H[jb][4 * g4 + 2], H[jb][4 * g4 + 3]};
    }
}
__device__ __forceinline__ void rwkv_apply_wave(Frame& F, int item) {
    int lane = F.lane; asm volatile("" : "+v"(lane));
    const unsigned char* ws = F.ws; const unsigned r32 = lane & 31, hi = lane >> 5;
    const int cid = item >> 1, tb = item & 1;
    unsigned seq0, b, h, dir; int T, c; chunk_decode(cid, seq0, T, b, h, dir, c);
    const unsigned yb = dir ? WS_YB : WS_YF;
    f32x16 acc[2];
#pragma unroll
    for (int r = 0; r < 16; ++r) { const int t = 32 * tb + (r & 3) + 8 * (r >> 2) + 4 * hi; const unsigned tok = seq0 + (dir ? T - 1 - (64 * c + t) : 64 * c + t);
        acc[0][r] = LDG(float, ws, yb + (tok * 384 + h * 64 + r32) * 4); acc[1][r] = LDG(float, ws, yb + (tok * 384 + h * 64 + 32 + r32) * 4); }
#pragma unroll
    for (int ks = 0; ks < 4; ++ks) { const bf16x8 a = LDG(bf16x8, ws, WS_RP + (((unsigned)cid * 64 + 32 * tb + r32) * 64 + 16 * ks + 8 * hi) * 2);
#pragma unroll
        for (int ib = 0; ib < 2; ++ib) acc[ib] = MFMA32(a, LDG(bf16x8, ws, WS_RH + (((unsigned)cid * 64 + 32 * ib + r32) * 64 + 16 * ks + 8 * hi) * 2), acc[ib]); }
#pragma unroll
    for (int r = 0; r < 16; ++r) { const int t = 32 * tb + (r & 3) + 8 * (r >> 2) + 4 * hi; const unsigned tok = seq0 + (dir ? T - 1 - (64 * c + t) : 64 * c + t);
        STG(float, F.ws, yb + (tok * 384 + h * 64 + r32) * 4) = acc[0][r]; STG(float, F.ws, yb + (tok * 384 + h * 64 + 32 + r32) * 4) = acc[1][r]; }
}

__device__ __forceinline__ void rwkv_out_item(Frame& F, int l, int item) {
    int lane = F.lane; asm volatile("" : "+v"(lane));
    const unsigned char* ws = F.ws; const unsigned r32 = lane & 31, hi = lane >> 5;
    const int tb = item & 1, h = (item >> 1) % 6, sk = item / 12;
    const bool lat = sk >= 64; const int b = lat ? (sk - 64) >> 6 : sk >> 2, k = lat ? (sk - 64) & 63 : sk & 3, nc = lat ? 64 : 4;
    const unsigned seq0 = lat ? MC + b * 4096 : b * 256, base = lat ? 768u : 0u;
    const unsigned chf = (b * 6 + h) * 2, cidf = base + chf * nc + k, cidb = base + (chf + 1) * nc + (nc - 1 - k);
    const unsigned tok0 = seq0 + 64 * k + 32 * tb;
    f32x16 acc[2];
#pragma unroll
    for (int r = 0; r < 16; ++r) { const unsigned tok = tok0 + (r & 3) + 8 * (r >> 2) + 4 * hi; const unsigned e = (tok * 384 + h * 64 + r32) * 4;
        acc[0][r] = LDG(float, ws, WS_YF + e) + LDG(float, ws, WS_YB + e); acc[1][r] = LDG(float, ws, WS_YF + e + 128) + LDG(float, ws, WS_YB + e + 128); }
    const unsigned pf = 32 * tb + r32, pb_ = 63 - 32 * tb - r32;
#pragma unroll
    for (int ks = 0; ks < 4; ++ks) {
        const s16x4 f0 = LDG(s16x4, ws, WS_RP + ((cidf * 64 + pf) * 64 + 16 * ks + 4 * hi) * 2), f1 = LDG(s16x4, ws, WS_RP + ((cidf * 64 + pf) * 64 + 16 * ks + 8 + 4 * hi) * 2);
        const s16x4 b0_ = LDG(s16x4, ws, WS_RP + ((cidb * 64 + pb_) * 64 + 16 * ks + 4 * hi) * 2), b1_ = LDG(s16x4, ws, WS_RP + ((cidb * 64 + pb_) * 64 + 16 * ks + 8 + 4 * hi) * 2);
        const bf16x8 af = {f0[0], f0[1], f0[2], f0[3], f1[0], f1[1], f1[2], f1[3]}, ab = {b0_[0], b0_[1], b0_[2], b0_[3], b1_[0], b1_[1], b1_[2], b1_[3]};
#pragma unroll
        for (int ib = 0; ib < 2; ++ib) { acc[ib] = MFMA32(af, LDG(bf16x8, ws, WS_RH + cidf * 8192 + (ib * 4 + ks) * 1024 + lane * 16), acc[ib]);
            acc[ib] = MFMA32(ab, LDG(bf16x8, ws, WS_RH + cidb * 8192 + (ib * 4 + ks) * 1024 + lane * 16), acc[ib]); } }
    const float g0 = LDG(float, INP(27), (l * 384 + h * 64 + r32) * 4), g1 = LDG(float, INP(27), (l * 384 + h * 64 + 32 + r32) * 4), b0 = LDG(float, INP(28), (l * 384 + h * 64 + r32) * 4), b1 = LDG(float, INP(28), (l * 384 + h * 64 + 32 + r32) * 4);
    const int xl = (lane ^ 16) << 2;
#pragma unroll
    for (int r = 0; r < 16; ++r) { const unsigned tok = tok0 + (r & 3) + 8 * (r >> 2) + 4 * hi; const unsigned e = tok * 384 + h * 64 + r32;
        const float bon = LDG(float, ws, WS_SB + (tok * 8 + h) * 4) + LDG(float, ws, WS_SB + ((M + tok) * 8 + h) * 4);
        const float y0 = acc[0][r] + bon * LDG(float, ws, WS_SV + e * 4), y1 = acc[1][r] + bon * LDG(float, ws, WS_SV + (e + 32) * 4);
        float s = allreduce16(y0 + y1); s += __builtin_bit_cast(float, __builtin_amdgcn_ds_bpermute(xl, __builtin_bit_cast(int, s)));
        const float mu = s * (1.f / 64.f), d0 = y0 - mu, d1 = y1 - mu;
        float q = allreduce16(d0 * d0 + d1 * d1); q += __builtin_bit_cast(float, __builtin_amdgcn_ds_bpermute(xl, __builtin_bit_cast(int, q)));
        const float rs = rsqrtf(q * (1.f / 64.f) + 64e-5f);
        const float o0 = (d0 * rs * g0 + b0) * bf_lo((unsigned)LDG(bf16_t, ws, WS_G + e * 2)), o1 = (d1 * rs * g1 + b1) * bf_lo((unsigned)LDG(bf16_t, ws, WS_G + (e + 32) * 2));
        const unsigned pk = pk2(o0, o1);
        STG(bf16_t, F.ws, WS_ACT + (tok * DM + 640 + h * 64 + r32) * 2) = (bf16_t)(pk & 0xffff); STG(bf16_t, F.ws, WS_ACT + (tok * DM + 640 + h * 64 + 32 + r32) * 2) = (bf16_t)(pk >> 16); }
}

#ifndef B_UNIT
#define B_UNIT 0
#endif
constexpr int AU_R = 8, AU_D = 4, AU_SLOT = 6144;
__device__ __forceinline__ void attn_b_unit(Frame& F, int l, int unit) {
    int lane = F.lane; asm volatile("" : "+v"(lane));
    const unsigned char* ws = F.ws; LAS unsigned char* lds = F.lds;
    const int w = F.wave; const unsigned r32 = lane & 31, hi = lane >> 5;
    const unsigned kh = unit & 1, qb = (unit >> 1) & 15, mp = (unit >> 5) & 1, h = (unit >> 6) & 3, b = unit >> 8;
    const unsigned seq0 = MC + b * 4096, row = seq0 + qb * 256 + 32 * w + r32;
    bf16x8 qf[1][2];
#pragma unroll
    for (int s = 0; s < 2; ++s) qf[0][s] = LDG(bf16x8, ws, WS_QB + (row * 256 + h * 64 + mp * 32 + 8 * hi) * 2 + 32 * s);
    AttnQ st[1]; attnq_init(st[0], 0.f);
    const int qpos[1] = {0};
    const int n0 = kh ? 56 : 72, nt = 72;
    const unsigned pofs = (w < 2 ? (h * 2 + mp) * 2048 + w * 1024 : h * 4096 + (w - 2) * 1024) + lane * 16;
    const unsigned base0 = (w < 2 ? WS_KB : WS_VTB) + ((seq0 >> 5) + (kh ? 72u : 0u)) * 16384 + pofs;
    const unsigned base1 = WS_CACHE + (w < 2 ? 2 * MiB : 4 * MiB) + (b * 4 + l) * 262144 + pofs;
#define AU_DMA(t_) do { const int tt_ = (t_) < nt ? (t_) : nt - 1; const unsigned src_ = tt_ < n0 ? base0 + tt_ * 16384 : base1 + (tt_ - n0) * 16384; \
        __builtin_amdgcn_global_load_lds((const GAS unsigned*)(ws + src_), (LAS unsigned*)(lds + ((t_) % AU_R) * AU_SLOT + w * 1024), 16, 0, 0); } while (0)
    if (w < 6) {
#pragma unroll
        for (int t = 0; t < AU_D; ++t) AU_DMA(t);
    }
    for (int t = 0; t < nt; ++t) {
        if (w < 6) asm volatile("s_waitcnt vmcnt(3)" ::: "memory");
        asm volatile("s_barrier" ::: "memory");
        const LAS unsigned char* sl = lds + (t % AU_R) * AU_SLOT + lane * 16;
        bf16x8 kf[2], vf[4];
        kf[0] = *(const LAS bf16x8*)(sl); kf[1] = *(const LAS bf16x8*)(sl + 1024);
#pragma unroll
        for (int f = 0; f < 4; ++f) vf[f] = *(const LAS bf16x8*)(sl + 2048 + 1024 * f);
        if (w < 6) AU_DMA(t + AU_D);
        attn_block<32, false, 1>(qf, kf, vf, st, t, qpos, 0, hi);
    }
#undef AU_DMA
    asm volatile("s_waitcnt vmcnt(0) lgkmcnt(0)\n\ts_barrier" ::: "memory");
    attn_b_store(F, st[0], mp, kh, row, h, hi);
}

constexpr int Q_BLAT = 2048, Q_ALAT = 1536, Q_BCTX = 1024, Q_ACTX = 768;
constexpr int Q_TOTAL = Q_BLAT + Q_ALAT + Q_BCTX + Q_ACTX;
#ifndef XCD_DEAL
#define XCD_DEAL 1
#endif
__device__ __forceinline__ void phase_mixer(Frame& F, int l, int rep) {
    if (rep == 0 || REP_PART == 0 || REP_PART == 1) {
        const int si = F.bid + F.G * F.wave;
        if (si < 48) rwkv_chain_wave(F, l, true, si >> 1, si & 1);
        else if (si < 48 + 384) rwkv_chain_wave(F, l, false, (si - 48) >> 1, (si - 48) & 1);
    }
    if (B_UNIT && (rep == 0 || REP_PART == 2 || REP_PART == 4)) {
        unsigned* uctr = (unsigned*)(F.ws + WS_CTL) + 64 * (32 + l + 4 * rep);
        LAS int* ubox = (LAS int*)(F.lds + 65536);
        for (;;) {
            if (F.wave == 0 && F.lane == 0) *ubox = (int)atomicAdd(uctr, 1u);
            lds_barrier();
            const int un = __builtin_amdgcn_readfirstlane(*ubox);
            lds_barrier();
            if (un >= 512) break;
            attn_b_unit(F, l, un);
        }
    }
    unsigned* ctr = (unsigned*)(F.ws + WS_CTL) + 64 * (1 + l + 4 * rep);
    const bool xdeal = XCD_DEAL && !B_UNIT && F.G == 256;
    if (xdeal && (rep == 0 || REP_PART == 2 || REP_PART == 4)) attn_b_item(F, l, true, (F.bid & 7) * 256 + (F.bid >> 3) * 8 + F.wave);
    unsigned* cx = (unsigned*)(F.ws + WS_CTL) + 8192 + ((l + 4 * rep) * 8 + (F.bid & 7)) * 64;
    bool xq = xdeal;
    if (rep == 0 || REP_PART != 1) for (;;) {
        int it = 0;
        if (F.lane == 0) it = (int)atomicAdd(xq ? cx : ctr, 1u);
        it = __builtin_amdgcn_readfirstlane(it);
        if (xq) { if (it >= 192) { xq = false; continue; }
            const int x = F.bid & 7; it = Q_BLAT + (((x >> 2) * 6 + ((x >> 1) & 1) * 3 + it / 64) * 128 + (x & 1) * 64 + it % 64); }
        else it += xdeal ? Q_BLAT + Q_ALAT : (B_UNIT ? Q_BLAT : 0);
        if (it >= Q_TOTAL) break;
        if (it < Q_BLAT) { if (rep == 0 || REP_PART == 2 || REP_PART == 4) attn_b_item(F, l, true, it); continue; } it -= Q_BLAT;
        if (it < Q_ALAT) { if (rep == 0 || REP_PART == 2 || REP_PART == 3) attn_a_item(F, l, true, it); continue; } it -= Q_ALAT;
        if (it < Q_BCTX) { if (rep == 0 || REP_PART == 2 || REP_PART == 5) attn_b_item(F, l, false, it); continue; } it -= Q_BCTX;
        if (rep == 0 || REP_PART == 2 || REP_PART == 5) attn_a_item(F, l, false, it);
    }
}

__device__ __forceinline__ void phase_finalize(Frame& F, int l) {
    const unsigned char* ws = F.ws;
    const unsigned lane = F.lane;
    const float lami = 0.8f - 0.6f * __expf(-0.3f * (float)l);
    const float lam = LDG(float, ws, WS_TAB + (TAB_LAM + l) * 4) + lami;
    const float omli = 1.f - lami;
    const float sg = LDG(float, INP(17), (l * 64 + lane) * 4);
    const unsigned skipw = (F.ngw < 2304 && 2 * F.ngw > 2304 + 64) ? 2304 - F.ngw : 0;
    if ((unsigned)F.gw < skipw) return;
    for (unsigned row = F.gw - skipw; row < M; row += F.ngw - skipw) {
#pragma unroll
        for (int k = 0; k < 4; ++k) { float om[2];
#pragma unroll
            for (int mp = 0; mp < 2; ++mp) { const unsigned o0 = (((mp * 2) * M + row) * 256 + 64 * k + lane) * 2, q0 = ((((mp * 2) * M + row) * 4 + k) * 2) * 4;
                const f32x2 ml0 = LDG(f32x2, ws, WS_ML + q0);
                if (row >= MC) { const f32x2 ml1 = LDG(f32x2, ws, WS_ML + q0 + M * 32); const float ms = fmaxf(ml0[0], ml1[0]), w0 = __builtin_amdgcn_exp2f(ml0[0] - ms), w1 = __builtin_amdgcn_exp2f(ml1[0] - ms);
                    om[mp] = (bf_lo((unsigned)LDG(bf16_t, ws, WS_BO2 + o0)) * w0 + bf_lo((unsigned)LDG(bf16_t, ws, WS_BO2 + o0 + M * 512)) * w1) * __builtin_amdgcn_rcpf(ml0[1] * w0 + ml1[1] * w1); }
                else om[mp] = bf_lo((unsigned)LDG(bf16_t, ws, WS_BO2 + o0)) * __builtin_amdgcn_rcpf(ml0[1]); }
            const float v = om[0] - lam * om[1];
            const float ms = wave_sum(v * v) * (1.f / 64.f);
            STG(bf16_t, F.ws, WS_ACT + (row * DM + 384 + 64 * k + lane) * 2) = (bf16_t)(pk2(v * rsqrtf(ms + 1e-6f) * sg * omli, 0.f) & 0xffff); }
    }
}


typedef unsigned v4u __attribute__((ext_vector_type(4)));
#define XB_TMO      128
#define XB_XCNT(j)  (256  + 64 * (j))
#define XB_XSUB(j)  (1280 + 64 * (j))
#define XB_XGEN(j)  (2304 + 64 * (j))
#define XB_TOP      3328
#define XB_TOPGEN   3392
#define XCD_BAR_WORDS 3456
#define XB_SPIN_CAP (1u << 18)

__device__ __forceinline__ unsigned xb_ld(unsigned* p)              { return __hip_atomic_load(p, __ATOMIC_RELAXED, __HIP_MEMORY_SCOPE_AGENT); }
__device__ __forceinline__ unsigned xb_add(unsigned* p, unsigned v) { return __hip_atomic_fetch_add(p, v, __ATOMIC_RELAXED, __HIP_MEMORY_SCOPE_AGENT); }
__device__ __forceinline__ unsigned xb_xcc_id() { return (unsigned)__builtin_amdgcn_s_getreg((3 << 11) | 20) & 0xFu; }
#define XB_SPIN(cond, bar) do { unsigned _sp = 0; while (cond) { __builtin_amdgcn_s_sleep(1); \
    if ((++_sp & 255u) == 0u) { if (xb_ld(&(bar)[XB_TMO])) break; if (_sp > XB_SPIN_CAP) { atomicAdd(&(bar)[XB_TMO], 1u); break; } } } } while (0)

struct XcdBarrier {
    unsigned* bar; unsigned x;
    volatile LAS unsigned* st;
};

__device__ __forceinline__ XcdBarrier xcd_barrier_post(unsigned* bar, volatile LAS unsigned* st) {
    XcdBarrier b; b.bar = bar; b.x = xb_xcc_id(); b.st = st;
    if (threadIdx.x == 0) (void)xb_add(&bar[XB_XCNT(b.x)], 1u);
    return b;
}
__device__ __forceinline__ void xcd_barrier_complete(unsigned* bar, unsigned x, unsigned& nloc, unsigned& nx) {
    const unsigned G = gridDim.x * gridDim.y * gridDim.z;
    unsigned sum, cnt, mine, sp = 0u;
    for (;;) {
        sum = 0u; cnt = 0u; mine = 0u;
#pragma unroll
        for (unsigned j = 0; j < 16; ++j) { const unsigned c = xb_ld(&bar[XB_XCNT(j)]); sum += c; cnt += (c > 0u) ? 1u : 0u; mine = (j == x) ? c : mine; }
        if (sum == G) break;
        __builtin_amdgcn_s_sleep(1);
        if ((++sp & 255u) == 0u) { if (xb_ld(&bar[XB_TMO])) break; if (sp > XB_SPIN_CAP) { atomicAdd(&bar[XB_TMO], 1u); break; } }
    }
    nloc = mine > 0u ? mine : 1u; nx = cnt > 0u ? cnt : 1u;
}

__device__ __forceinline__ void xcd_barrier(const XcdBarrier& b) {
    asm volatile("s_waitcnt vmcnt(0)" ::: "memory");
    __syncthreads();
    if (threadIdx.x == 0) {
        unsigned* bar = b.bar;
        __builtin_amdgcn_s_waitcnt(0);
        unsigned nloc = b.st[0], nx = b.st[1];
        if (nloc == 0u) { xcd_barrier_complete(bar, b.x, nloc, nx); b.st[0] = nloc; b.st[1] = nx; }
        const unsigned old = xb_add(&bar[XB_XSUB(b.x)], 1u);
        const unsigned gen = old / nloc;
        if (old + 1u == (gen + 1u) * nloc) {
            __builtin_amdgcn_fence(__ATOMIC_RELEASE, "agent");
            asm volatile("s_waitcnt vmcnt(0)" ::: "memory");
            const unsigned og = xb_add(&bar[XB_TOP], 1u);
            const unsigned tg = og / nx;
            if (og + 1u == (tg + 1u) * nx) xb_add(&bar[XB_TOPGEN], 1u);
            else XB_SPIN(xb_ld(&bar[XB_TOPGEN]) == tg, bar);
            __builtin_amdgcn_fence(__ATOMIC_ACQUIRE, "agent");
            xb_add(&bar[XB_XGEN(b.x)], 1u);
            asm volatile("s_waitcnt vmcnt(0)" ::: "memory");
        } else {
            XB_SPIN(xb_ld(&bar[XB_XGEN(b.x)]) == gen, bar);
            __builtin_amdgcn_fence(__ATOMIC_ACQUIRE, "agent");
            asm volatile("s_waitcnt vmcnt(0)" ::: "memory");
        }
    }
    __syncthreads();
}

#ifndef DIS
#define DIS 0
#endif
#ifndef GEMM_MF
#define GEMM_MF 7
#endif
#ifndef REP_PHASE
#define REP_PHASE -1
#define REP_COUNT 1
#endif
constexpr int NEXTRA = (REP_PHASE >= 0 && REP_PHASE < 9) ? REP_COUNT - 1 : 0, NPL = 9 + NEXTRA, NPRE = (REP_PHASE == 100) ? REP_COUNT : 1, NPHASE_RUN = NPRE + 1 + NPL * DEPTH;
__global__ void __launch_bounds__(512, 2) mega(Args a) {
    extern __shared__ __attribute__((aligned(16))) unsigned char lds[];
    Frame F;
    F.lds = (LAS unsigned char*)lds;
    volatile LAS unsigned* bst = (volatile LAS unsigned*)(F.lds + LDS_BYTES - 64);
    if (threadIdx.x < 2) bst[threadIdx.x] = 0u;
    __syncthreads();
    const XcdBarrier xbar = xcd_barrier_post((unsigned*)((GAS unsigned char*)a.ws + WS_CTL) + 4096, bst);
    const int wave_id = __builtin_amdgcn_readfirstlane((int)threadIdx.x >> 6);
    for (int ph = a.ph_lo; ph < a.ph_hi; ++ph) {
        { const unsigned char* kp = (const unsigned char*)__builtin_amdgcn_kernarg_segment_ptr(); asm volatile("" : "+s"(kp));
          const Args* ap = (const Args*)kp; F.in = ap->in; F.out = gptr(ap->out); F.ws = gptr(ap->ws); }
        { unsigned ones = ~0u; asm volatile("" : "+s"(ones)); int ln = (int)__builtin_amdgcn_mbcnt_hi(ones, __builtin_amdgcn_mbcnt_lo(ones, 0u)); int wv = wave_id, bid = (int)blockIdx.x, gg = (int)gridDim.x; asm volatile("" : "+s"(wv), "+s"(bid), "+s"(gg));
          F.lane = ln; F.wave = wv; F.bid = bid; F.G = gg; F.ngw = gg * 8; F.tid = wv * 64 + ln; F.gw = bid * 8 + wv; }
        if (ph < NPRE) { if (!(DIS & 1)) phase_prologue(F); }
        else if (ph == NPHASE_RUN - 1) { if (!(DIS & 2)) phase_final_norm(F); }
        else {
            const int l = (ph - NPRE) / NPL, sidx = (ph - NPRE) % NPL, rep = (REP_PHASE >= 0 && REP_PHASE < 9 && sidx > REP_PHASE && sidx <= REP_PHASE + NEXTRA) ? sidx - REP_PHASE : 0, s = (REP_PHASE >= 0 && REP_PHASE < 9 && sidx > REP_PHASE) ? (sidx <= REP_PHASE + NEXTRA ? REP_PHASE : sidx - NEXTRA) : sidx;
            if (s == 0) { convert_weights(F, l); phase_norm(F, l, 0); }
            else if (s == 1) {
                pg8::Gemm g{WSP(bf16_t, WS_ACT), WSP(bf16_t, WS_WIN + 0u * WSET_STRIDE), M, NIN, 1024}; pg8::StaticOrder S; S.init(M, NIN, F.G, F.bid, (GEMM_MF & 1) ? 192 : 256);
                EpiWin E{F.ws, F.out, l, F.lds + pg8::STAGE_BYTES, REP_PART == 9 && rep > 0};
                if (!(DIS & 16)) pg8::gemm_phase<EpiWin, pg8::StaticOrder, false, true, (GEMM_MF & 1) ? 3 : 4>(F.lds, g, S, E, F.tid);
                if (false) { const int wv_ = (F.bid - 64) * 8 + F.wave; convert_item_any(F, l + 1, wv_); if (wv_ < CV_TOTAL - 1536) convert_item_any(F, l + 1, 1536 + wv_); }
            }
            else if (s == 2) { for (int cid = F.bid; cid < NCHUNK; cid += F.G) rwkv_chunk_block(F, l, cid); }
            else if (s == 3) { if (!(DIS & 64)) phase_mixer(F, l, rep); }
            else if (s == 4) { if (rep == 0 || REP_PART != 7) phase_finalize(F, l); if (rep == 0 || REP_PART != 6) for (int it = F.gw; it < 192 * 12; it += F.ngw) rwkv_out_item(F, l, it); }
            else if (s == 5 || s == 8) {
                const bool second = s == 8;
                pg8::Gemm g{second ? WSP(bf16_t, WS_U) : WSP(bf16_t, WS_ACT), second ? WSP(bf16_t, WS_W2 + 0u * WSET_STRIDE) : WSP(bf16_t, WS_WOUT + 0u * WSET_STRIDE), M, 1024, second ? FF : 1024};
                pg8::StaticOrder S; S.init(M, 1024, F.G, F.bid, (GEMM_MF & 2) ? 192 : 256);
                const bool first = (l == 0 && !second);
                EpiRes E{INP(0), INP(1) - (size_t)MC * DM, F.ws, WSP(float, WS_MOD) + (size_t)l * 3 * 6144 + (second ? 5120 : 2048), first, rep ? WS_BO : WS_XB, REP_PART == 9 && rep > 0};
                if (!(DIS & 256)) pg8::gemm_phase<EpiRes, pg8::StaticOrder, false, true, (GEMM_MF & 2) ? 3 : 4>(F.lds, g, S, E, F.tid);
            }
            else if (s == 6) { if (!(DIS & 8)) phase_norm(F, l, 1); }
            else {
                pg8::Gemm g{WSP(bf16_t, WS_ACT), WSP(bf16_t, WS_W13 + 0u * WSET_STRIDE), M, NFF2, 1024}; pg8::StaticOrder S; S.init(M, NFF2, F.G, F.bid, (GEMM_MF & 4) ? 192 : 256);
                EpiSwi E{WSP(bf16_t, WS_U), REP_PART == 9 && rep > 0};
                if (!(DIS & 512)) pg8::gemm_phase<EpiSwi, pg8::StaticOrder, true, true, (GEMM_MF & 4) ? 3 : 4>(F.lds, g, S, E, F.tid);
            }
        }
        if (ph + 1 < a.ph_hi) { if (ph == a.ph_lo) { __threadfence(); cg::this_grid().sync(); } else xcd_barrier(xbar); }
    }
}

extern "C" void kernel_launch(void* const* d_in, const int* in_sizes, int n_in, void* d_out, int out_size, void* d_ws, size_t ws_size, hipStream_t stream) {
    static int grid = 0;
    if (grid == 0) {
        int dev = 0, cus = 0, per_cu = 0;
        if (n_in != 34 || ws_size < WS_END) { fprintf(stderr, "kernel_launch: unexpected n_in %d / ws_size %zu (need %zu)\n", n_in, ws_size, (size_t)WS_END); grid = -1; return; }
        if (hipGetDevice(&dev) != hipSuccess || hipDeviceGetAttribute(&cus, hipDeviceAttributeMultiprocessorCount, dev) != hipSuccess) { grid = -1; return; }
        if (hipFuncSetAttribute((const void*)mega, hipFuncAttributeMaxDynamicSharedMemorySize, LDS_BYTES) != hipSuccess) { fprintf(stderr, "kernel_launch: hipFuncSetAttribute failed\n"); grid = -1; return; }
        if (hipOccupancyMaxActiveBlocksPerMultiprocessor(&per_cu, (const void*)mega, 512, LDS_BYTES) != hipSuccess || per_cu < 1) { fprintf(stderr, "kernel_launch: occupancy query says %d\n", per_cu); per_cu = 1; }
        (void)hipGetLastError();
        grid = cus * 1;
        if (grid > cus * per_cu) grid = cus * per_cu;
    }
    if (grid < 0) return;
    (void)hipMemsetAsync((char*)d_ws + WS_CTL, 0, CTL_BYTES, stream);
    Args a{};
    for (int i = 0; i < 34; ++i) a.in[i] = (const float*)d_in[i];
    a.out = (float*)d_out; a.ws = (unsigned char*)d_ws;
#if MK_ONE_LAUNCH
    a.ph_lo = 0; a.ph_hi = NPHASE_RUN;
    void* args[] = {&a};
    hipError_t e = hipLaunchCooperativeKernel((const void*)mega, dim3(grid), dim3(512), args, LDS_BYTES, stream);
    if (e != hipSuccess) fprintf(stderr, "kernel_launch: cooperative launch failed: %s (grid %d)\n", hipGetErrorString(e), grid);
#else
    for (int ph = 0; ph < NPHASE_RUN; ++ph) { a.ph_lo = ph; a.ph_hi = ph + 1; hipLaunchKernelGGL(mega, dim3(grid), dim3(512), LDS_BYTES, stream, a); }
#endif
}
```

```cpp
#include <hip/hip_runtime.h>
#include <hip/hip_cooperative_groups.h>
#include <cstdio>
#include <cstdint>
namespace cg = cooperative_groups;

#ifndef MK_ONE_LAUNCH
#define MK_ONE_LAUNCH 1
#endif

#undef MK_ONE_LAUNCH
#define MK_ONE_LAUNCH 1
#define REP_PHASE -1
#define REP_COUNT 1
#define REP_PART 0
#define RA_REP 0
#define ATT_PROBE 0
namespace pg8 {
#define PG8_LAS __attribute__((address_space(3)))
typedef unsigned short bf16_t;
typedef short bf16x8 __attribute__((ext_vector_type(8)));
typedef float f32x4 __attribute__((ext_vector_type(4)));
typedef unsigned u32x4 __attribute__((ext_vector_type(4)));
constexpr int BM = 256, BK = 64, HALF = 128, HTB = HALF * BK * 2  , STAGE_BYTES = 8 * HTB, NXCD = 8, WGM = 8;

__host__ __device__ __forceinline__ int lds_byte(int r, int c) { const int st = (r >> 4) * 2 + (c >> 5), rr = r & 15, cc = c & 31, ob = rr * 64 + cc * 2; return st * 1024 + (ob ^ (((ob >> 9) & 1) << 5)); }
__host__ __device__ __forceinline__ void stage_rc(int b, int& R, int& C) { const int st = b / 1024, sb = b % 1024, swz = sb ^ (((sb >> 9) & 1) << 5); R = (st >> 1) * 16 + swz / 64; C = (st & 1) * 32 + (swz % 64) / 2; }
__host__ __device__ __forceinline__ int perm32(int rho) { const int n = rho >> 4, i = rho & 15; return 8 * (i >> 2) + 4 * n + (i & 3); }

struct Unit { int pm, pn; };
struct Gemm { const bf16_t* A; const bf16_t* Bt; int M, N, K; };

struct StaticOrder {
    int nM, nN, nwg, G, c;
    __host__ __device__ void init(int M, int N, int G_, int c_, int bm = BM) { nM = M / bm; nN = N / BM; nwg = nM * nN; G = G_; c = c_; }
    __host__ __device__ bool next(int i, Unit& u) const {
        const long L = (long)i * G + c; if (L >= nwg) return false;
        int wgid = (int)L; { const int q = nwg / NXCD, r = nwg % NXCD, xcd = wgid % NXCD, off = wgid / NXCD; wgid = (xcd < r ? xcd * (q + 1) : r * (q + 1) + (xcd - r) * q) + off; }
        const int nig = WGM * nN, gid = wgid / nig, fm = gid * WGM, gsz = (nM - fm) < WGM ? (nM - fm) : WGM;
        u.pm = fm + ((wgid % nig) % gsz); u.pn = (wgid % nig) / gsz; return true;
    }
    __device__ __forceinline__ void a_ready(const Unit&) const {}
    __device__ __forceinline__ void done(const Unit&) const {}
};

template <class Epi, class Sched, bool ALIGN_EPI = false, bool SP2 = false, int MF = 4>
__device__ __forceinline__ void gemm_phase(PG8_LAS unsigned char* lds, const Gemm g, const Sched& S, const Epi& E, const int tid_in) {
    const int tid = tid_in, wid = __builtin_amdgcn_readfirstlane(tid >> 6), lane = tid & 63, wr = wid >> 2, wc = wid & 3, fr = lane & 15, fq = lane >> 4;
    static_assert(MF == 4 || (MF == 3 && SP2), "192-row tiles: SP2 schedule only");
    const int K = g.K, nt = K / BK;
    unsigned voffA[2], voffB[2];
#pragma unroll
    for (int i = 0; i < 2; ++i) { int R, C; stage_rc(tid * 16 + i * 8192, R, C); const int Rb = Epi::PERM ? ((R & ~31) + perm32(R & 31)) : R;
        voffA[i] = (unsigned)(R * K + C) * 2u; voffB[i] = (unsigned)(Rb * K + C) * 2u; }
    const size_t kstep = (size_t)(BK * 2);
    const size_t hstep = (size_t)HALF * K * 2;
    const size_t tstep = 2 * hstep;
    const size_t hstepA = (size_t)(MF * 32) * K * 2, tstepA = 2 * hstepA;
    const unsigned ldsw = (unsigned)wid * 1024u;
    const int aoff = lds_byte(wr * (MF * 16) + fr, fq * 8), boff = lds_byte(wc * 32 + fr, fq * 8);
#define PG8_SA(b, h) (((b) * 2 + (h)) * HTB)
#define PG8_SB(b, h) ((4 + (b) * 2 + (h)) * HTB)
#define PG8_STAGE(bufoff, gbase, voff) do { _Pragma("unroll") for (int _i = 0; _i < 2; ++_i) \
        __builtin_amdgcn_global_load_lds((const unsigned*)((const char*)(gbase) + (voff)[_i]), (PG8_LAS unsigned*)(lds + (bufoff) + ldsw + _i * 8192), 16, 0, 0); } while (0)
#define PG8_STAGEA(bufoff, gbase, voff) do { __builtin_amdgcn_global_load_lds((const unsigned*)((const char*)(gbase) + (voff)[0]), (PG8_LAS unsigned*)(lds + (bufoff) + ldsw), 16, 0, 0); \
        if (MF == 4 || wr == 0) __builtin_amdgcn_global_load_lds((const unsigned*)((const char*)(gbase) + (voff)[1]), (PG8_LAS unsigned*)(lds + (bufoff) + ldsw + 8192), 16, 0, 0); } while (0)
#define PG8_LDA(dst, b, h) do { _Pragma("unroll") for (int m = 0; m < MF; ++m) _Pragma("unroll") for (int k = 0; k < 2; ++k) dst[m][k] = *(const PG8_LAS bf16x8*)(lds + PG8_SA(b, h) + aoff + m * 2048 + k * 1024); } while (0)
#define PG8_LDB(dst, b, h) do { _Pragma("unroll") for (int n = 0; n < 2; ++n) _Pragma("unroll") for (int k = 0; k < 2; ++k) dst[n][k] = *(const PG8_LAS bf16x8*)(lds + PG8_SB(b, h) + boff + n * 2048 + k * 1024); } while (0)
#define PG8_MMA(ai, bj, At, Bt) do { __builtin_amdgcn_s_setprio(1); _Pragma("unroll") for (int m = 0; m < MF; ++m) _Pragma("unroll") for (int n = 0; n < 2; ++n) _Pragma("unroll") for (int k = 0; k < 2; ++k) \
        acc[ai][bj][m][n] = __builtin_amdgcn_mfma_f32_16x16x32_bf16(Bt[n][k], At[m][k], acc[ai][bj][m][n], 0, 0, 0); __builtin_amdgcn_s_setprio(0); } while (0)
#define PG8_WAIT_V(n) asm volatile("s_waitcnt vmcnt(" #n ")" ::: "memory")
#define PG8_WAIT_V2(a, b) do { if (MF == 4 || wr == 0) asm volatile("s_waitcnt vmcnt(" #a ")" ::: "memory"); else asm volatile("s_waitcnt vmcnt(" #b ")" ::: "memory"); } while (0)
#define PG8_WAIT_L(n) asm volatile("s_waitcnt lgkmcnt(" #n ")" ::: "memory")
#define PG8_BAR __builtin_amdgcn_s_barrier()
#define PG8_SCHED __builtin_amdgcn_sched_barrier(0)
    Unit cur, nxt; int ui = 0;
    if (!S.next(0, cur)) return;
    f32x4 acc[2][2][MF][2];
#pragma unroll
    for (int a = 0; a < 2; ++a)
#pragma unroll
        for (int b = 0; b < 2; ++b)
#pragma unroll
            for (int m = 0; m < MF; ++m)
#pragma unroll
                for (int n = 0; n < 2; ++n) acc[a][b][m][n] = (f32x4){0.f, 0.f, 0.f, 0.f};
    bf16x8 At[MF][2], B0[2][2], B1[2][2];
#define PG8_SGPR64(p) ((const char*)(((unsigned long long)(unsigned)__builtin_amdgcn_readfirstlane((int)((unsigned long long)(p) >> 32)) << 32) | (unsigned)__builtin_amdgcn_readfirstlane((int)(unsigned long long)(p))))
    const char* cA = PG8_SGPR64((const char*)g.A + (size_t)cur.pm * tstepA); const char* cB = PG8_SGPR64((const char*)g.Bt + (size_t)cur.pn * tstep);
    S.a_ready(cur);
    if constexpr (SP2) {
        PG8_STAGE(PG8_SB(0, 0), cB, voffB); PG8_STAGE(PG8_SB(0, 1), cB + hstep, voffB); PG8_STAGEA(PG8_SA(0, 0), cA, voffA); PG8_STAGEA(PG8_SA(0, 1), cA + hstepA, voffA);
        if (wr == 1) PG8_BAR;
        PG8_WAIT_V2(2, 1); PG8_BAR;
        PG8_STAGE(PG8_SB(1, 0), cB + kstep, voffB); PG8_STAGEA(PG8_SA(1, 0), cA + kstep, voffA); PG8_STAGE(PG8_SB(1, 1), cB + hstep + kstep, voffB);
        PG8_WAIT_V2(6, 5); PG8_BAR;
    } else {
        PG8_STAGE(PG8_SB(0, 0), cB, voffB); PG8_STAGEA(PG8_SA(0, 0), cA, voffA); PG8_STAGE(PG8_SB(0, 1), cB + hstep, voffB); PG8_STAGEA(PG8_SA(0, 1), cA + hstepA, voffA);
        if (wr == 1) PG8_BAR;
        PG8_WAIT_V(4); PG8_BAR;
        PG8_STAGE(PG8_SB(1, 0), cB + kstep, voffB); PG8_STAGEA(PG8_SA(1, 0), cA + kstep, voffA); PG8_STAGE(PG8_SB(1, 1), cB + hstep + kstep, voffB);
        PG8_WAIT_V(6); PG8_BAR;
    }
    for (;;) {
        const bool has_next = S.next(ui + 1, nxt);
        const char* nA = PG8_SGPR64(has_next ? (const char*)g.A + (size_t)nxt.pm * tstepA : cA); const char* nB = PG8_SGPR64(has_next ? (const char*)g.Bt + (size_t)nxt.pn * tstep : cB);
        for (int t = 0; t < nt; t += 2) {
            const bool last = (t == nt - 2);
            const char* a1 = cA + (size_t)(t + 1) * kstep;
            const char* a2 = last ? nA : cA + (size_t)(t + 2) * kstep; const char* b2 = last ? nB : cB + (size_t)(t + 2) * kstep;
            const char* a3 = a2 + kstep; const char* b3 = b2 + kstep;
            if (last && has_next) S.a_ready(nxt);
            if constexpr (SP2) {
            PG8_LDB(B0, 0, 0); PG8_LDB(B1, 0, 1); PG8_SCHED; PG8_LDA(At, 0, 0); PG8_STAGEA(PG8_SA(1, 1), a1 + hstepA, voffA);
            PG8_WAIT_V2(8, 6); PG8_WAIT_L(0); PG8_BAR; PG8_MMA(0, 0, At, B0); PG8_MMA(0, 1, At, B1); PG8_BAR; PG8_SCHED;
            PG8_LDA(At, 0, 1); PG8_STAGE(PG8_SB(0, 0), b2, voffB); PG8_STAGE(PG8_SB(0, 1), b2 + hstep, voffB); PG8_STAGEA(PG8_SA(0, 0), a2, voffA);
            PG8_WAIT_V2(8, 6); PG8_WAIT_L(0); PG8_BAR; PG8_MMA(1, 0, At, B0); PG8_MMA(1, 1, At, B1); PG8_BAR; PG8_SCHED;
            PG8_LDB(B0, 1, 0); PG8_LDB(B1, 1, 1); PG8_SCHED; PG8_LDA(At, 1, 0); PG8_STAGEA(PG8_SA(0, 1), a2 + hstepA, voffA);
            PG8_WAIT_V2(8, 6); PG8_WAIT_L(0); PG8_BAR; PG8_MMA(0, 0, At, B0); PG8_MMA(0, 1, At, B1); PG8_BAR; PG8_SCHED;
            PG8_LDA(At, 1, 1); PG8_STAGE(PG8_SB(1, 0), b3, voffB); PG8_STAGE(PG8_SB(1, 1), b3 + hstep, voffB); PG8_STAGEA(PG8_SA(1, 0), a3, voffA);
            PG8_WAIT_V2(8, 6); PG8_WAIT_L(0); PG8_BAR; PG8_MMA(1, 0, At, B0); PG8_MMA(1, 1, At, B1); PG8_BAR; PG8_SCHED;
            } else {
            PG8_LDB(B0, 0, 0); PG8_SCHED; PG8_LDA(At, 0, 0); PG8_STAGEA(PG8_SA(1, 1), a1 + hstepA, voffA);
            PG8_WAIT_L(8); PG8_BAR; PG8_WAIT_L(0); PG8_MMA(0, 0, At, B0); PG8_BAR; PG8_SCHED;
            PG8_LDB(B1, 0, 1); PG8_STAGE(PG8_SB(0, 0), b2, voffB);
            PG8_BAR; PG8_WAIT_L(0); PG8_MMA(0, 1, At, B1); PG8_BAR;
            PG8_LDA(At, 0, 1); PG8_STAGEA(PG8_SA(0, 0), a2, voffA);
            PG8_BAR; PG8_WAIT_L(0); PG8_MMA(1, 0, At, B0); PG8_BAR; PG8_SCHED;
            PG8_STAGE(PG8_SB(0, 1), b2 + hstep, voffB);
            PG8_WAIT_V(6); PG8_BAR; PG8_MMA(1, 1, At, B1); PG8_BAR;
            PG8_LDB(B0, 1, 0); PG8_SCHED; PG8_LDA(At, 1, 0); PG8_STAGEA(PG8_SA(0, 1), a2 + hstepA, voffA);
            PG8_WAIT_L(8); PG8_BAR; PG8_WAIT_L(0); PG8_MMA(0, 0, At, B0); PG8_BAR; PG8_SCHED;
            PG8_LDB(B1, 1, 1); PG8_STAGE(PG8_SB(1, 0), b3, voffB);
            PG8_BAR; PG8_WAIT_L(0); PG8_MMA(0, 1, At, B1); PG8_BAR;
            PG8_LDA(At, 1, 1); PG8_STAGEA(PG8_SA(1, 0), a3, voffA);
            PG8_BAR; PG8_WAIT_L(0); PG8_MMA(1, 0, At, B0); PG8_BAR; PG8_SCHED;
            PG8_STAGE(PG8_SB(1, 1), b3 + hstep, voffB);
            PG8_WAIT_V(6); PG8_BAR; PG8_MMA(1, 1, At, B1); PG8_BAR;
            }
        }
        if constexpr (ALIGN_EPI) { if (wr == 0) PG8_BAR; }
        if constexpr (!Epi::AFTER_DRAIN) { E.template operator()<MF>(acc, cur, wr, wc, fr, fq); S.done(cur); }
        if (!has_next) break;
#pragma unroll
        for (int a = 0; a < 2; ++a)
#pragma unroll
            for (int b = 0; b < 2; ++b)
#pragma unroll
                for (int m = 0; m < MF; ++m)
#pragma unroll
                    for (int n = 0; n < 2; ++n) acc[a][b][m][n] = (f32x4){0.f, 0.f, 0.f, 0.f};
        cur = nxt; cA = nA; cB = nB; ++ui;
        if constexpr (ALIGN_EPI) { if (wr == 1) PG8_BAR; }
    }
    PG8_WAIT_V(0);
    if constexpr (!ALIGN_EPI) { if (wr == 0) PG8_BAR; }
    PG8_BAR;
    if constexpr (Epi::AFTER_DRAIN) { E.fused(acc, cur, wr, wc, fr, fq, lds, wid, lane); S.done(cur); }
#undef PG8_SA
#undef PG8_SB
#undef PG8_STAGE
#undef PG8_STAGEA
#undef PG8_WAIT_V2
#undef PG8_LDA
#undef PG8_LDB
#undef PG8_MMA
#undef PG8_WAIT_V
#undef PG8_WAIT_L
#undef PG8_BAR
#undef PG8_SCHED
}
}

using pg8::bf16_t; using pg8::bf16x8; using pg8::f32x4; using pg8::u32x4;
typedef float f32x16 __attribute__((ext_vector_type(16)));
typedef float f32x2 __attribute__((ext_vector_type(2)));
typedef short s16x4 __attribute__((ext_vector_type(4)));
typedef unsigned u32x2 __attribute__((ext_vector_type(2)));
typedef __bf16 bf16x2_t __attribute__((ext_vector_type(2)));
#define LAS __attribute__((address_space(3)))
#define LDG(T, base, boff) (*(const __attribute__((address_space(1))) T*)((const __attribute__((address_space(1))) unsigned char*)(base) + (unsigned)(boff)))
#define STG(T, base, boff) (*(__attribute__((address_space(1))) T*)((__attribute__((address_space(1))) unsigned char*)(base) + (unsigned)(boff)))

__device__ __forceinline__ unsigned pk2(float lo, float hi) { f32x2 v = {lo, hi}; bf16x2_t b = __builtin_convertvector(v, bf16x2_t); return __builtin_bit_cast(unsigned, b); }
__device__ __forceinline__ float bf_lo(unsigned u) { return __uint_as_float(u << 16); }
__device__ __forceinline__ float bf_hi(unsigned u) { return __uint_as_float(u & 0xffff0000u); }
__device__ __forceinline__ f32x4 unpack4(u32x2 v) { return (f32x4){bf_lo(v.x), bf_hi(v.x), bf_lo(v.y), bf_hi(v.y)}; }
__device__ __forceinline__ u32x2 pack4(f32x4 v) { u32x2 r; r.x = pk2(v[0], v[1]); r.y = pk2(v[2], v[3]); return r; }
__device__ __forceinline__ float sigmf(float x) { return __builtin_amdgcn_rcpf(1.f + __expf(-x)); }
template <int CTRL> __device__ __forceinline__ float dpp_f(float x) { return __builtin_bit_cast(float, __builtin_amdgcn_update_dpp(0, __builtin_bit_cast(int, x), CTRL, 0xF, 0xF, true)); }
__device__ __forceinline__ float allreduce16(float x) { x += dpp_f<0xB1>(x); x += dpp_f<0x4E>(x); x += dpp_f<0x141>(x); x += dpp_f<0x140>(x); return x; }
__device__ __forceinline__ float rdlane(float x, int l) { return __builtin_bit_cast(float, __builtin_amdgcn_readlane(__builtin_bit_cast(int, x), l)); }
__device__ __forceinline__ float wave_sum(float v) {
    v = allreduce16(v);
    return (rdlane(v, 0) + rdlane(v, 16)) + (rdlane(v, 32) + rdlane(v, 48));
}
__device__ __forceinline__ float swap32_sum(float x) { auto rr = __builtin_amdgcn_permlane32_swap(__float_as_uint(x), __float_as_uint(x), false, false); return __uint_as_float(rr[0]) + __uint_as_float(rr[1]); }
__device__ __forceinline__ float swap32_max(float x) { auto rr = __builtin_amdgcn_permlane32_swap(__float_as_uint(x), __float_as_uint(x), false, false); return fmaxf(__uint_as_float(rr[0]), __uint_as_float(rr[1])); }

constexpr int M = 12288, MC = 4096, DM = 1024, NIN = 3072, FF = 2816, NFF2 = 5632, DEPTH = 4;
constexpr float LOG2E = 1.4426950408889634f;
constexpr float QSCALE_A = 0.125f * LOG2E;
constexpr float QSCALE_B = 0.17677669529663687f * LOG2E;
constexpr unsigned OFF_AK = 12582912, OFF_AV = 14680064, OFF_BK = 16777216, OFF_BV = 20971520, OFF_CF = 25165824, OFF_CB = 26738688;
constexpr unsigned MiB = 1u << 20;
constexpr unsigned WS_CTL = 0, CTL_BYTES = 1 * MiB;
constexpr unsigned WS_MOD = 1 * MiB;
constexpr unsigned WS_TAB = 1 * MiB + 512 * 1024;
constexpr unsigned WS_SMALLW = 2 * MiB;
constexpr unsigned WS_CACHE = 4 * MiB;
constexpr unsigned WS_WIN = 10 * MiB, WS_WOUT = 16 * MiB, WS_W13 = 18 * MiB, WS_W2 = 29 * MiB;
constexpr unsigned WSET_STRIDE = 184 * MiB;
constexpr unsigned WS_ACT = 35 * MiB;
constexpr unsigned WS_QA = 59 * MiB, WS_KA = 68 * MiB, WS_VTA = 71 * MiB, WS_QB = 74 * MiB, WS_KB = 80 * MiB, WS_VTB = 86 * MiB;
constexpr unsigned WS_RKV = 92 * MiB, WS_CW = 119 * MiB, WS_CA = 122 * MiB, WS_CG = 125 * MiB;
constexpr unsigned WS_YF = 128 * MiB, WS_YB = 146 * MiB;
constexpr unsigned WS_SV = 164 * MiB;
constexpr unsigned WS_BO2 = 182 * MiB, WS_ML = 230 * MiB;
constexpr unsigned WS_XB = 206 * MiB;
constexpr unsigned WS_WSET1 = 194 * MiB;
constexpr unsigned WS_RM = 236 * MiB, WS_RN = 254 * MiB, WS_RP = 324 * MiB, WS_RH = 342 * MiB;
constexpr int NCHUNK = 2304;
constexpr unsigned WS_U = 128 * MiB;
constexpr unsigned WS_G = 290 * MiB, WS_SB = 299 * MiB, WS_BO = 300 * MiB, WS_END = 360 * MiB;
constexpr int SMALLW_L = 147456;
constexpr int TAB_COSA = 0, TAB_SINA = 1024, TAB_COSB = 2048, TAB_SINB = 2560, TAB_LAM = 3072;
constexpr int LDS_BYTES = 147456;
constexpr int NPHASE = 2 + 9 * DEPTH;

struct Args {
    const float* in[34];
    float* out; unsigned char* ws;
    int ph_lo, ph_hi;
};

struct EpiRes {
    static constexpr bool PERM = true, AFTER_DRAIN = false;
    const float* baseC; const float* baseL; unsigned char* ws; const float* gate; bool first; unsigned xo; bool skip = false;
    template <int MF>
    __device__ __forceinline__ void operator()(const f32x4 (&acc)[2][2][MF][2], const pg8::Unit& u, int wr, int wc, int fr_, int fq_) const {
        if (skip) return;
        int fr = fr_, fq = fq_; asm volatile("" : "+v"(fr), "+v"(fq));
        const unsigned col0 = u.pn * 256 + wc * 32 + 8 * fq, rowb = u.pm * (MF * 64) + wr * (MF * 16);
        f32x4 g4[2][2]; int vcur = -1;
#pragma unroll
        for (int ai = 0; ai < 2; ++ai)
#pragma unroll
            for (int m = 0; m < MF; ++m) { const unsigned rf = rowb + ai * (MF * 32) + m * 16, off = (rf + fr) * DM + col0;
                const int v = rf < MC ? 0 : (rf < MC + 4096 ? 1 : 2);
                if (v != vcur) { vcur = v;
#pragma unroll
                    for (int bj = 0; bj < 2; ++bj)
#pragma unroll
                        for (int n = 0; n < 2; ++n) g4[bj][n] = LDG(f32x4, gate, (v * 6144 + col0 + bj * 128 + n * 4) * 4); }
#pragma unroll
                for (int bj = 0; bj < 2; ++bj) { f32x4 b0, b1;
                    if (first) { const float* base = rf < MC ? baseC : baseL; b0 = LDG(f32x4, base, (off + bj * 128) * 4); b1 = LDG(f32x4, base, (off + bj * 128 + 4) * 4); }
                    else { const u32x4 xb = LDG(u32x4, ws, WS_XB + (off + bj * 128) * 2); b0 = (f32x4){bf_lo(xb.x), bf_hi(xb.x), bf_lo(xb.y), bf_hi(xb.y)}; b1 = (f32x4){bf_lo(xb.z), bf_hi(xb.z), bf_lo(xb.w), bf_hi(xb.w)}; }
                    b0 = b0 + g4[bj][0] * acc[ai][bj][m][0]; b1 = b1 + g4[bj][1] * acc[ai][bj][m][1];
                    u32x4 w; w.x = pk2(b0[0], b0[1]); w.y = pk2(b0[2], b0[3]); w.z = pk2(b1[0], b1[1]); w.w = pk2(b1[2], b1[3]);
                    STG(u32x4, ws, xo + (off + bj * 128) * 2) = w; } }
    }
};
struct EpiSwi {
    static constexpr bool PERM = true, AFTER_DRAIN = false;
    bf16_t* U; bool skip = false;
    template <int MF>
    __device__ __forceinline__ void operator()(const f32x4 (&acc)[2][2][MF][2], const pg8::Unit& u, int wr, int wc, int fr_, int fq_) const {
        if (skip) return;
        int fr = fr_, fq = fq_; asm volatile("" : "+v"(fr), "+v"(fq));
        const unsigned row0 = u.pm * (MF * 64) + wr * (MF * 16) + fr, oc0 = u.pn * 128 + wc * 32 + 8 * fq;
#pragma unroll
        for (int ai = 0; ai < 2; ++ai)
#pragma unroll
            for (int m = 0; m < MF; ++m) { const unsigned ro = ((row0 + ai * (MF * 32) + m * 16) * FF + oc0) * 2; f32x4 o[2];
#pragma unroll
                for (int bj = 0; bj < 2; ++bj) { const f32x4 g = acc[ai][bj][m][0], up = acc[ai][bj][m][1];
#pragma unroll
                    for (int e = 0; e < 4; ++e) o[bj][e] = g[e] * sigmf(g[e]) * up[e]; }
                const u32x2 lo = pack4(o[0]), hi2 = pack4(o[1]);
                STG(u32x4, U, ro) = (u32x4){lo.x, lo.y, hi2.x, hi2.y}; asm volatile("" ::: "memory"); }
    }
};
struct EpiWin {
    static constexpr bool PERM = true, AFTER_DRAIN = false;
    unsigned char* ws; float* out; int l; LAS unsigned char* lds; bool skip = false;
    template <int MF>
    __device__ __forceinline__ void operator()(const f32x4 (&acc)[2][2][MF][2], const pg8::Unit& u, int wr, int wc, int fr_, int fq_) const {
        if (skip) return;
        int fr = fr_, fq = fq_; asm volatile("" : "+v"(fr), "+v"(fq));
        const unsigned rowb = u.pm * (MF * 64) + wr * (MF * 16), row0 = rowb + fr;
#pragma unroll
        for (int bj = 0; bj < 2; ++bj) {
            const unsigned c32 = u.pn * 256 + bj * 128 + wc * 32;
            const unsigned c8 = c32 + 8 * fq;
            if (c32 < 1152 && (c32 < 512 || c32 >= 640)) {
                const bool isA = c32 < 512;
                const bool isK = isA ? (c32 >= 384) : (c32 >= 896);
                const float qs = isK ? 1.f : (isA ? QSCALE_A : QSCALE_B);
                const unsigned ck = isA ? c8 - 384 : c8 - 896;
                const unsigned dbase = isA ? (isK ? WS_KA + (((ck >> 6) * 4 + ((ck & 63) >> 4)) * 64 + ((ck >> 3) & 1) * 32) * 16 : WS_QA + c8 * 2)
                                           : (isK ? WS_KB + (((ck >> 5) * 2 + ((ck & 31) >> 4)) * 64 + ((ck >> 3) & 1) * 32) * 16 : WS_QB + (c8 - 640) * 2);
                const unsigned dpitch = isA ? 768u : 512u;
#pragma unroll
                for (int ai = 0; ai < 2; ++ai)
#pragma unroll
                    for (int m = 0; m < MF; ++m) {
                        const unsigned row = row0 + ai * (MF * 32) + m * 16; const bool lat = rowb + ai * (MF * 32) + m * 16 >= (unsigned)MC;
                        f32x4 v0 = acc[ai][bj][m][0], v1 = acc[ai][bj][m][1];
                        if (lat) {
                            const unsigned t = (row - MC) & 4095, rp = t >> 6, cp = t & 63;
                            unsigned to_;
                            if (isA) { const unsigned pos = ((c32 >> 5) & 1) ? cp : rp; to_ = WS_TAB + (TAB_COSA + pos * 16 + 4 * fq) * 4; }
                            else { const unsigned pos = (fq >> 1) ? cp : rp; to_ = WS_TAB + (TAB_COSB + pos * 8 + 4 * (fq & 1)) * 4; }
                            const f32x4 c4 = LDG(f32x4, ws, to_), s4 = LDG(f32x4, ws, to_ + (isA ? 4096u : 2048u));
                            f32x4 w0, w1;
                            w0[0] = v0[0] * c4[0] - v0[1] * s4[0]; w0[1] = v0[1] * c4[0] + v0[0] * s4[0];
                            w0[2] = v0[2] * c4[1] - v0[3] * s4[1]; w0[3] = v0[3] * c4[1] + v0[2] * s4[1];
                            w1[0] = v1[0] * c4[2] - v1[1] * s4[2]; w1[1] = v1[1] * c4[2] + v1[0] * s4[2];
                            w1[2] = v1[2] * c4[3] - v1[3] * s4[3]; w1[3] = v1[3] * c4[3] + v1[2] * s4[3];
                            v0 = w0; v1 = w1;
                        } else if (isK) {
                            const unsigned b = row >> 8, t = row & 255;
                            const f32x4 ev = {v0[0], v0[2], v1[0], v1[2]}, od = {v0[1], v0[3], v1[1], v1[3]};
                            if (isA) { const unsigned o = (OFF_AK + ((b * 4 + l) * 256 + t) * 128 + (c32 - 384) + 4 * fq) * 4; STG(f32x4, out, o) = ev; STG(f32x4, out, o + 64) = od; }
                            else { const unsigned o = (OFF_BK + ((b * 4 + l) * 256 + t) * 256 + ((c8 - 896) & ~15u) + 4 * (fq & 1)) * 4; STG(f32x4, out, o) = ev; STG(f32x4, out, o + 32) = od; }
                        }
                        v0 = v0 * qs; v1 = v1 * qs;
                        u32x4 w; w.x = pk2(v0[0], v0[1]); w.y = pk2(v0[2], v0[3]); w.z = pk2(v1[0], v1[1]); w.w = pk2(v1[2], v1[3]);
                        STG(u32x4, ws, isK ? dbase + (row >> 5) * (isA ? 8192u : 16384u) + (row & 31) * 16 : dbase + row * dpitch) = w;
                        asm volatile("" ::: "memory");
                    }
            } else if (c32 < 1408) {
                const bool isA = c32 < 640;
                const unsigned cc = isA ? (c8 - 512) : (c8 - 1152), cw = isA ? (c32 - 512) : (c32 - 1152);
                const unsigned vfrag = (isA ? WS_VTA : WS_VTB) + (((cw >> 6) * 2 + ((cw >> 5) & 1)) * 2) * 1024;
                LAS unsigned char* lw = lds + (wr * 4 + wc) * 1024;
                LAS bf16_t* lq = (LAS bf16_t*)(lw + ((((fr >> 2) & 1) * 32 + 8 * fq) * 16 + (4 * (fr >> 3) + (fr & 3)) * 2));
#pragma unroll
                for (int ai = 0; ai < 2; ++ai)
#pragma unroll
                    for (int m = 0; m < MF; ++m) {
                        const unsigned rf = rowb + ai * (MF * 32) + m * 16, row = rf + fr; const bool lat = rf >= (unsigned)MC;
                        const f32x4 v0 = acc[ai][bj][m][0], v1 = acc[ai][bj][m][1];
                        if (!lat) { const unsigned b = row >> 8, t = row & 255;
                            const unsigned o = isA ? (OFF_AV + ((b * 4 + l) * 256 + t) * 128 + cc) * 4 : (OFF_BV + ((b * 4 + l) * 256 + t) * 256 + cc) * 4;
                            STG(f32x4, out, o) = v0; STG(f32x4, out, o + 16) = v1; }
                        const unsigned p0 = pk2(v0[0], v0[1]), p1 = pk2(v0[2], v0[3]), p2 = pk2(v1[0], v1[1]), p3 = pk2(v1[2], v1[3]);
                        lq[0 * 8] = (bf16_t)(p0 & 0xffff); lq[1 * 8] = (bf16_t)(p0 >> 16); lq[2 * 8] = (bf16_t)(p1 & 0xffff); lq[3 * 8] = (bf16_t)(p1 >> 16);
                        lq[4 * 8] = (bf16_t)(p2 & 0xffff); lq[5 * 8] = (bf16_t)(p2 >> 16); lq[6 * 8] = (bf16_t)(p3 & 0xffff); lq[7 * 8] = (bf16_t)(p3 >> 16);
                        const u32x4 tv = *(const LAS u32x4*)(lw + (fq * 16 + fr) * 16);
                        STG(u32x4, ws, vfrag + (rf >> 5) * (isA ? 8192u : 16384u) + ((rf >> 4) & 1) * 1024 + (fq * 16 + fr) * 16) = tv;
                        asm volatile("" ::: "memory");
                    }
            } else if (c32 < 2944) {
                const int kind = c32 < 2560 ? 0 : (c32 < 2688 ? 1 : (c32 < 2816 ? 2 : 3));
                const unsigned dbase = kind == 0 ? WS_RKV + (c8 - 1408) * 2 : (kind == 1 ? WS_CW + (c8 - 2560) * 2 : (kind == 2 ? WS_CA + (c8 - 2688) * 2 : WS_CG + (c8 - 2816) * 2));
                const unsigned dpitch = kind == 0 ? 2304u : 256u;
#pragma unroll
                for (int ai = 0; ai < 2; ++ai)
#pragma unroll
                    for (int m = 0; m < MF; ++m) {
                        const unsigned row = row0 + ai * (MF * 32) + m * 16; const bool lat = rowb + ai * (MF * 32) + m * 16 >= (unsigned)MC;
                        f32x4 v0 = acc[ai][bj][m][0], v1 = acc[ai][bj][m][1];
                        if (kind == 1) {
#pragma unroll
                            for (int e = 0; e < 4; ++e) { v0[e] = 1.f - 2.f * __builtin_amdgcn_rcpf(__expf(2.f * v0[e]) + 1.f); v1[e] = 1.f - 2.f * __builtin_amdgcn_rcpf(__expf(2.f * v1[e]) + 1.f); }
                        } else if (kind == 3) {
#pragma unroll
                            for (int e = 0; e < 4; ++e) { v0[e] = sigmf(v0[e]); v1[e] = sigmf(v1[e]); }
                        }
                        u32x4 w; w.x = pk2(v0[0], v0[1]); w.y = pk2(v0[2], v0[3]); w.z = pk2(v1[0], v1[1]); w.w = pk2(v1[2], v1[3]);
                        STG(u32x4, ws, dbase + row * dpitch) = w;
                        asm volatile("" ::: "memory");
                    }
            }
        }
    }
};

struct Frame {
    LAS unsigned char* lds;
    const float* const* in;
    float* out; unsigned char* ws;
    int tid, lane, wave, gw, ngw, G, bid;
};
#define GAS __attribute__((address_space(1)))
template <class T> __device__ __forceinline__ T* gptr(T* p) {
#if defined(__HIP_DEVICE_COMPILE__)
    __builtin_assume(!__builtin_amdgcn_is_shared((const void*)p)); __builtin_assume(!__builtin_amdgcn_is_private((const void*)p));
#endif
    return p; }
#define INP(k) gptr(F.in[k])
#define WSP(T, off) gptr((T*)(F.ws + (off)))

__device__ __forceinline__ void phase_prologue(Frame& F) {
    const float* cvec = INP(8); const float* cctx = INP(9); const float* ada_w = INP(10); const float* ada_b = INP(11);
    LAS float* sl = (LAS float*)F.lds;
    LAS float* red = (LAS float*)(F.lds + 16384);
    for (int i = F.tid; i < 3072; i += 512) { const int v = i >> 10, k = i & 1023; const float x = v == 0 ? cctx[k] : cvec[(v - 1) * 1024 + k]; sl[i] = x / (1.f + __expf(-x)); }
    __syncthreads();
    float* mod = WSP(float, WS_MOD);
    for (int it = F.bid; it < 384; it += F.G) {
        const int l = it / 96, n0 = (it % 96) * 64;
        const float* W = ada_w + (size_t)l * 1024 * 6144 + n0 + F.lane;
        float a0 = 0.f, a1 = 0.f, a2 = 0.f;
        const int k0 = F.wave * 128;
#pragma unroll 8
        for (int k = k0; k < k0 + 128; ++k) { const float w = *(const GAS float*)(W + (size_t)k * 6144); a0 += sl[k] * w; a1 += sl[1024 + k] * w; a2 += sl[2048 + k] * w; }
        red[(F.wave * 3 + 0) * 64 + F.lane] = a0; red[(F.wave * 3 + 1) * 64 + F.lane] = a1; red[(F.wave * 3 + 2) * 64 + F.lane] = a2;
        __syncthreads();
        if (F.wave < 3) { float s = ada_b[l * 6144 + n0 + F.lane];
#pragma unroll
            for (int w = 0; w < 8; ++w) s += red[(w * 3 + F.wave) * 64 + F.lane];
            mod[(size_t)(l * 3 + F.wave) * 6144 + n0 + F.lane] = s; }
        __syncthreads();
    }
    float* tab = WSP(float, WS_TAB);
    if (F.bid == F.G - 1) {
        for (int i = F.tid; i < 1024; i += 512) { const int pos = i >> 4, f = i & 15; const float ang = (float)pos * __builtin_amdgcn_exp2f(-(float)f * (13.287712379549449f / 16.f)); tab[TAB_COSA + i] = __cosf(ang); tab[TAB_SINA + i] = __sinf(ang); }
        for (int i = F.tid; i < 512; i += 512) { const int pos = i >> 3, f = i & 7; const float ang = (float)pos * __builtin_amdgcn_exp2f(-(float)f * (13.287712379549449f / 8.f)); tab[TAB_COSB + i] = __cosf(ang); tab[TAB_SINB + i] = __sinf(ang); }
        if (F.wave < 4) { const float* lp = INP(16) + F.wave * 128; const int d = F.lane & 31;
            const float p1 = wave_sum(F.lane < 32 ? lp[d] * lp[32 + d] : 0.f), p2 = wave_sum(F.lane < 32 ? 0.f : lp[64 + d] * lp[96 + d]);
            if (F.lane == 0) tab[TAB_LAM + F.wave] = __expf(p1) - __expf(p2); }
    }
    const int gtid = F.bid * 512 + F.tid, gnt = F.G * 512;
    { bf16_t* sw = WSP(bf16_t, WS_SMALLW); const float* cw2 = INP(20); const float* ca2 = INP(22); const float* cg2 = INP(23);
      for (int idx = gtid; idx < 4 * SMALLW_L; idx += gnt) { const int l = idx / SMALLW_L, r = idx % SMALLW_L; float v;
          if (r < 98304) { const int which = r / 49152, rr = r % 49152, d = rr / 24576, ch = (rr % 24576) / 64, k = rr % 64; v = (which ? ca2 : cw2)[((size_t)(l * 2 + d) * 64 + k) * 384 + ch]; }
          else { const int rr = r - 98304, ch = rr / 128, k = rr % 128; v = cg2[((size_t)l * 128 + k) * 384 + ch]; }
          sw[idx] = (bf16_t)(pk2(v, 0.f) & 0xffff); } }
    { bf16_t* kca = WSP(bf16_t, WS_CACHE); bf16_t* vca = kca + 524288; bf16_t* kcb = vca + 524288; bf16_t* vcb = kcb + 1048576;
      const float* cak = INP(2); const float* cav = INP(3); const float* cbk = INP(4); const float* cbv = INP(5);
      for (int e = gtid; e < 524288; e += gnt) {
          const int j = e & 7, ln = (e >> 3) & 63, hi = ln >> 5, r32 = ln & 31, blk = (e >> 12) & 15, bl = e >> 16;
          { const int s = (e >> 9) & 3, kvh = (e >> 11) & 1, cp = kvh * 64 + 16 * s + 8 * hi + j, o = cp & 31, c = (cp - o) + (o >> 1) + 16 * (o & 1);
            kca[e] = (bf16_t)(pk2(cak[((size_t)bl * 512 + blk * 32 + r32) * 128 + c], 0.f) & 0xffff); }
          { const int ks = (e >> 9) & 1, db = (e >> 10) & 1, kvh = (e >> 11) & 1, key = blk * 32 + 16 * ks + 8 * (j >> 2) + 4 * hi + (j & 3);
            vca[e] = (bf16_t)(pk2(cav[((size_t)bl * 512 + key) * 128 + kvh * 64 + db * 32 + r32], 0.f) & 0xffff); } }
      for (int e = gtid; e < 1048576; e += gnt) {
          const int j = e & 7, ln = (e >> 3) & 63, hi = ln >> 5, r32 = ln & 31, blk = (e >> 13) & 15, bl = e >> 17;
          { const int s = (e >> 9) & 1, hm = (e >> 10) & 7, cp = hm * 32 + 16 * s + 8 * hi + j, o = cp & 15, c = (cp - o) + (o >> 1) + 8 * (o & 1);
            kcb[e] = (bf16_t)(pk2(cbk[((size_t)bl * 512 + blk * 32 + r32) * 256 + c], 0.f) & 0xffff); }
          { const int ks = (e >> 9) & 1, db = (e >> 10) & 1, h = (e >> 11) & 3, key = blk * 32 + 16 * ks + 8 * (j >> 2) + 4 * hi + (j & 3);
            vcb[e] = (bf16_t)(pk2(cbv[((size_t)bl * 512 + key) * 256 + h * 64 + db * 32 + r32], 0.f) & 0xffff); } } }
    for (int st = 0; st < 1; ++st) { u32x4* z = (u32x4*)(WSP(bf16_t, WS_WIN + st * WSET_STRIDE) + (size_t)2944 * 1024); unsigned z0; asm volatile("v_mov_b32 %0, 0" : "=v"(z0)); for (int i = gtid; i < 128 * 1024 / 8; i += gnt) z[i] = (u32x4){z0, z0, z0, z0}; }
}

template <int MAP> __device__ __forceinline__ int dest_row(int n) {
    if (MAP == 1) {
        if (n < 512) { const int o = n & 31; return (n - o) + 2 * (o & 15) + (o >> 4); }
        if (n >= 640 && n < 1152) { const int o = n & 15; return (n - o) + 2 * (o & 7) + (o >> 3); }
        return n;
    }
    if (MAP == 2 || MAP == 3) return (n >> 7) * 256 + ((n >> 2) & 1) * 128 + ((n >> 5) & 3) * 32 + ((n >> 3) & 3) * 8 + (MAP == 3 ? 4 : 0) + (n & 3);
    return n;
}
template <int MAP> __device__ __forceinline__ void transpose_item(const float* W, int K, int N, bf16_t* WT, LAS float* scr, int item, int lane) {
    const int nblk = N / 32, kb = item / nblk, nb = item % nblk, k0 = 64 * kb, n0 = 32 * nb;
#pragma unroll 8
    for (int i = 0; i < 32; ++i) { const int kk = 2 * i + (lane >> 5); scr[kk * 33 + (lane & 31)] = *(const GAS float*)(W + (size_t)(k0 + kk) * N + n0 + (lane & 31)); }
    asm volatile("s_waitcnt lgkmcnt(0)" ::: "memory");
    const int c = lane & 7;
#pragma unroll
    for (int j = 0; j < 4; ++j) { const int n = (lane >> 3) + 8 * j; const LAS float* s = scr + (8 * c) * 33 + n;
        u32x4 o; o.x = pk2(s[0 * 33], s[1 * 33]); o.y = pk2(s[2 * 33], s[3 * 33]); o.z = pk2(s[4 * 33], s[5 * 33]); o.w = pk2(s[6 * 33], s[7 * 33]);
        *(GAS u32x4*)(WT + (size_t)dest_row<MAP>(n0 + n) * K + k0 + 8 * c) = o; }
    asm volatile("s_waitcnt lgkmcnt(0)" ::: "memory");
}
template <int MAP> __device__ __forceinline__ void convert_item(const float* W, int K, int N, bf16_t* WT, int item, int lane) {
    const int nblk = N / 64, kb = item / nblk, nb = item % nblk, n = nb * 64 + lane;
    const GAS float* src = (const GAS float*)W + (size_t)(kb * 128) * N + n;
    GAS bf16_t* dst = (GAS bf16_t*)WT + (size_t)dest_row<MAP>(n) * K + kb * 128;
#pragma unroll
    for (int g = 0; g < 16; ++g) { float v[8];
#pragma unroll
        for (int e = 0; e < 8; ++e) v[e] = src[(size_t)(8 * g + e) * N];
        u32x4 o; o.x = pk2(v[0], v[1]); o.y = pk2(v[2], v[3]); o.z = pk2(v[4], v[5]); o.w = pk2(v[6], v[7]);
        *(GAS u32x4*)(dst + 8 * g) = o; }
}
constexpr int CV_IN = 46 * 8, CV_OUT = 16 * 8, CV_1 = 44 * 8, CV_2 = 16 * 22, CV_TOTAL = CV_IN + CV_OUT + 2 * CV_1 + CV_2;
__device__ __forceinline__ void convert_item_any(Frame& F, int l, int it) {
    const unsigned so = 0u * WSET_STRIDE;
    int r = it;
    if (r < CV_IN) { convert_item<1>(INP(14) + (size_t)l * 1024 * 2944, 1024, 2944, WSP(bf16_t, WS_WIN + so), r, F.lane); return; } r -= CV_IN;
    if (r < CV_OUT) { convert_item<0>(INP(29) + (size_t)l * 1024 * 1024, 1024, 1024, WSP(bf16_t, WS_WOUT + so), r, F.lane); return; } r -= CV_OUT;
    if (r < CV_1) { convert_item<2>(INP(30) + (size_t)l * 1024 * FF, 1024, FF, WSP(bf16_t, WS_W13 + so), r, F.lane); return; } r -= CV_1;
    if (r < CV_1) { convert_item<3>(INP(31) + (size_t)l * 1024 * FF, 1024, FF, WSP(bf16_t, WS_W13 + so), r, F.lane); return; } r -= CV_1;
    convert_item<0>(INP(32) + (size_t)l * FF * 1024, FF, 1024, WSP(bf16_t, WS_W2 + so), r, F.lane);
}
__device__ __forceinline__ void convert_weights(Frame& F, int l) {
    LAS float* scr = (LAS float*)(F.lds + F.wave * 16384); const unsigned so = 0u * WSET_STRIDE;
    const float* w_in = INP(14) + (size_t)l * 1024 * 2944; const float* w_out = INP(29) + (size_t)l * 1024 * 1024;
    const float* w1 = INP(30) + (size_t)l * 1024 * FF; const float* w3 = INP(31) + (size_t)l * 1024 * FF; const float* w2 = INP(32) + (size_t)l * FF * 1024;
    constexpr int I_IN = 16 * 92, I_OUT = 16 * 32, I_1 = 16 * 88, I_2 = 44 * 32;
    constexpr int NIT = I_IN + I_OUT + 2 * I_1 + I_2;
    for (int it = F.gw; it < NIT; it += F.ngw) {
        int r = it;
        if (r < I_IN) { transpose_item<1>(w_in, 1024, 2944, WSP(bf16_t, WS_WIN + so), scr, r, F.lane); continue; } r -= I_IN;
        if (r < I_OUT) { transpose_item<0>(w_out, 1024, 1024, WSP(bf16_t, WS_WOUT + so), scr, r, F.lane); continue; } r -= I_OUT;
        if (r < I_1) { transpose_item<2>(w1, 1024, FF, WSP(bf16_t, WS_W13 + so), scr, r, F.lane); continue; } r -= I_1;
        if (r < I_1) { transpose_item<3>(w3, 1024, FF, WSP(bf16_t, WS_W13 + so), scr, r, F.lane); continue; } r -= I_1;
        transpose_item<0>(w2, FF, 1024, WSP(bf16_t, WS_W2 + so), scr, r, F.lane);
    }
}

__device__ __forceinline__ void phase_norm(Frame& F, int l, int which  ) {
    const float* g = (which ? INP(13) : INP(12)) + l * 1024;
    const float* mod = WSP(float, WS_MOD) + (size_t)l * 3 * 6144 + (which ? 3072 : 0);
    bf16_t* H = WSP(bf16_t, WS_ACT);
    const bool first = (l == 0 && which == 0);
    f32x4 gv[4];
#pragma unroll
    for (int j = 0; j < 4; ++j) gv[j] = *(const GAS f32x4*)(g + 4 * F.lane + 256 * j);
    for (int row = F.gw; row < M; row += F.ngw) {
        const float* mv = mod + (row < MC ? 0 : (row < 2 * MC ? 1 : 2)) * 6144;
        f32x4 v[4]; float ss = 0.f;
        if (first) { const float* xr = row < MC ? INP(0) + (size_t)row * DM : INP(1) + (size_t)(row - MC) * DM;
#pragma unroll
            for (int j = 0; j < 4; ++j) v[j] = *(const GAS f32x4*)(xr + 4 * F.lane + 256 * j); }
        else {
#pragma unroll
            for (int j = 0; j < 4; ++j) v[j] = unpack4(LDG(u32x2, F.ws, WS_XB + ((unsigned)row * DM + 4 * F.lane + 256 * j) * 2)); }
#pragma unroll
        for (int j = 0; j < 4; ++j) ss += (v[j][0] * v[j][0] + v[j][1] * v[j][1]) + (v[j][2] * v[j][2] + v[j][3] * v[j][3]);
        const float rstd = rsqrtf(wave_sum(ss) * (1.f / 1024.f) + 1e-6f);
#pragma unroll
        for (int j = 0; j < 4; ++j) { const f32x4 sh = *(const GAS f32x4*)(mv + 4 * F.lane + 256 * j), sc = *(const GAS f32x4*)(mv + 1024 + 4 * F.lane + 256 * j);
            const f32x4 h = v[j] * rstd * gv[j] * (sc + 1.f) + sh;
            *(GAS u32x2*)(H + (size_t)row * DM + 4 * F.lane + 256 * j) = pack4(h); }
    }
}
__device__ __forceinline__ void phase_final_norm(Frame& F) {
    const float* g = INP(33);
    f32x4 gv[4];
#pragma unroll
    for (int j = 0; j < 4; ++j) gv[j] = *(const GAS f32x4*)(g + 4 * F.lane + 256 * j);
    for (int row = F.gw; row < M; row += F.ngw) {
        float* xr = gptr(F.out + (size_t)row * DM);
        f32x4 v[4]; float ss = 0.f;
#pragma unroll
        for (int j = 0; j < 4; ++j) { v[j] = unpack4(LDG(u32x2, F.ws, WS_XB + ((unsigned)row * DM + 4 * F.lane + 256 * j) * 2)); ss += (v[j][0] * v[j][0] + v[j][1] * v[j][1]) + (v[j][2] * v[j][2] + v[j][3] * v[j][3]); }
        const float rstd = rsqrtf(wave_sum(ss) * (1.f / 1024.f) + 1e-6f);
#pragma unroll
        for (int j = 0; j < 4; ++j) *(GAS f32x4*)(xr + 4 * F.lane + 256 * j) = v[j] * rstd * gv[j];
    }
}

#define MFMA32(a, b, c) __builtin_amdgcn_mfma_f32_32x32x16_bf16((a), (b), (c), 0, 0, 0)
#ifndef ATT_PROBE
#define ATT_PROBE 0
#endif
struct AttnQ { float m, l; bool mz; f32x16 o[2]; };
template <int DQK, bool MASK, int NQ>
__device__ __forceinline__ void attn_block(const bf16x8 (&qf)[NQ][DQK / 16], const bf16x8 (&kf)[DQK / 16], const bf16x8 (&vf)[4], AttnQ (&st)[NQ], int b, const int (&qpos)[NQ], int kpos0, int hi) {
    constexpr int NS = DQK / 16;
    f32x16 sc[NQ];
#pragma unroll
    for (int q = 0; q < NQ; ++q) { const f32x16 z = {}; sc[q] = MFMA32(kf[0], qf[q][0], z);
#pragma unroll
        for (int s = 1; s < NS; ++s) sc[q] = MFMA32(kf[s], qf[q][s], sc[q]); }
#pragma unroll
    for (int q = 0; q < NQ; ++q) {
        if (!st[q].mz) {
#pragma unroll
            for (int r = 0; r < 16; ++r) sc[q][r] -= st[q].m; }
        if (MASK) {
#pragma unroll
            for (int r = 0; r < 16; ++r) { const int key = kpos0 + 32 * b + (r & 3) + 8 * (r >> 2) + 4 * hi; const int dlt = key - qpos[q]; if (dlt > 128 || dlt < -128) sc[q][r] = -1e30f; }
        }
        float bm = fmaxf(fmaxf(sc[q][0], sc[q][1]), sc[q][2]);
#pragma unroll
        for (int r = 3; r < 15; r += 2) bm = fmaxf(fmaxf(bm, sc[q][r]), sc[q][r + 1]);
        bm = fmaxf(bm, sc[q][15]);
        bm = swap32_max(bm);
        if (__builtin_amdgcn_ballot_w64(bm > 64.f) != 0ull) {
            const float d = fmaxf(bm, 0.f);
            const float alpha = __builtin_amdgcn_exp2f(-d);
            st[q].m += d; st[q].l *= alpha; st[q].mz = false;
#pragma unroll
            for (int r = 0; r < 16; ++r) { st[q].o[0][r] *= alpha; st[q].o[1][r] *= alpha; sc[q][r] -= d; }
        }
#if ATT_PROBE == 1
        { float dmy = 0.f;
#pragma unroll
          for (int r = 0; r < 16; ++r) { float e_; asm volatile("v_exp_f32 %0, %1" : "=v"(e_) : "v"(sc[q][r])); dmy += e_; }
          asm volatile("" :: "v"(dmy)); }
#endif
        f32x2 rs2 = {0.f, 0.f};
#pragma unroll
        for (int r = 0; r < 16; r += 2) { sc[q][r] = __builtin_amdgcn_exp2f(sc[q][r]); sc[q][r + 1] = __builtin_amdgcn_exp2f(sc[q][r + 1]); rs2 += (f32x2){sc[q][r], sc[q][r + 1]}; }
        st[q].l += rs2[0] + rs2[1];
#if ATT_PROBE == 3
        { float d0 = 0.f, d1 = 0.f, d2 = 0.f, d3 = 0.f;
#pragma unroll
          for (int rr = 0; rr < 10; ++rr) { asm volatile("v_add_f32 %0, %0, %4\n\tv_add_f32 %1, %1, %5\n\tv_add_f32 %2, %2, %6\n\tv_add_f32 %3, %3, %7" : "+v"(d0), "+v"(d1), "+v"(d2), "+v"(d3) : "v"(sc[q][0]), "v"(sc[q][1]), "v"(sc[q][2]), "v"(sc[q][3])); }
          asm volatile("" :: "v"(d0), "v"(d1), "v"(d2), "v"(d3)); }
#endif
#if ATT_PROBE == 2
        { f32x16 dm = sc[q]; dm = MFMA32(kf[0], qf[q][0], dm); dm = MFMA32(kf[0], qf[q][0], dm); dm = MFMA32(kf[0], qf[q][0], dm); asm volatile("" :: "v"(dm)); }
#endif
        bf16x8 pb[2];
#pragma unroll
        for (int ks = 0; ks < 2; ++ks) { u32x4 w; w.x = pk2(sc[q][8 * ks], sc[q][8 * ks + 1]); w.y = pk2(sc[q][8 * ks + 2], sc[q][8 * ks + 3]); w.z = pk2(sc[q][8 * ks + 4], sc[q][8 * ks + 5]); w.w = pk2(sc[q][8 * ks + 6], sc[q][8 * ks + 7]); pb[ks] = __builtin_bit_cast(bf16x8, w); }
#pragma unroll
        for (int db = 0; db < 2; ++db)
#pragma unroll
            for (int ks = 0; ks < 2; ++ks) st[q].o[db] = MFMA32(vf[db * 2 + ks], pb[ks], st[q].o[db]);
    }
}
template <int DQK, bool MASK, int NQ>
__device__ __forceinline__ void attn_seg(const unsigned char* ws, const bf16x8 (&qf)[NQ][DQK / 16], AttnQ (&st)[NQ],
                                         unsigned kp, unsigned kblk  , unsigned vp, unsigned vblk, int nblk, const int (&qpos)[NQ], int kpos0, int hi) {
    constexpr int NS = DQK / 16;
    const GAS unsigned char* kq = (const GAS unsigned char*)ws + kp; const GAS unsigned char* vq = (const GAS unsigned char*)ws + vp;
    bf16x8 ka[NS], va[4], kb[NS], vb[4];
#define ATT_LOAD(kd, vd) do { _Pragma("unroll") for (int s = 0; s < NS; ++s) kd[s] = *(const GAS bf16x8*)(kq + 1024 * s); _Pragma("unroll") for (int f = 0; f < 4; ++f) vd[f] = *(const GAS bf16x8*)(vq + 1024 * f); } while (0)
    ATT_LOAD(ka, va);
    int b = 0;
    for (; b + 1 < nblk; b += 2) {
        kq += kblk; vq += vblk; ATT_LOAD(kb, vb);
        attn_block<DQK, MASK, NQ>(qf, ka, va, st, b, qpos, kpos0, hi);
        if (b + 2 < nblk) { kq += kblk; vq += vblk; }
        ATT_LOAD(ka, va);
        attn_block<DQK, MASK, NQ>(qf, kb, vb, st, b + 1, qpos, kpos0, hi);
    }
    if (b < nblk) attn_block<DQK, MASK, NQ>(qf, ka, va, st, b, qpos, kpos0, hi);
#undef ATT_LOAD
}
__device__ __forceinline__ void attnq_init(AttnQ& s, float l0) { s.m = 0.f; s.mz = true; s.l = l0; s.o[0] = (f32x16){}; s.o[1] = (f32x16){}; }
__device__ __forceinline__ void attn_a_item(Frame& F, int l, bool lat, int item) {
    int lane = F.lane; asm volatile("" : "+v"(lane));
    const unsigned char* ws = F.ws;
    const unsigned r32 = lane & 31, hi = lane >> 5;
    const unsigned nqb = lat ? 128 : 8;
    const unsigned qb = item % nqb, hq = (item / nqb) % 6, b = item / (nqb * 6), kvh = hq / 3;
    const unsigned seq0 = lat ? MC + b * 4096 : b * 256, q0 = qb * 32, row = seq0 + q0 + r32;
    const unsigned qo = WS_QA + (row * 384 + hq * 64 + 8 * hi) * 2;
    bf16x8 qf[1][4];
#pragma unroll
    for (int s = 0; s < 4; ++s) qf[0][s] = LDG(bf16x8, ws, qo + 32 * s);
    AttnQ st[1]; attnq_init(st[0], hi == 0 ? __builtin_amdgcn_exp2f(INP(15)[l * 6 + hq] * LOG2E) : 0.f);
    const int qpos[1] = {(int)(q0 + r32)};
    const unsigned fo = kvh * 4096 + lane * 16;
    if (!lat) {
        attn_seg<64, false, 1>(ws, qf, st, WS_KA + (seq0 >> 5) * 8192 + fo, 8192, WS_VTA + (seq0 >> 5) * 8192 + fo, 8192, 8, qpos, 0, hi);
    } else {
        const int ks = (int)q0 - 128 < 0 ? 0 : (int)q0 - 128, ke = q0 + 160 > 4096 ? 4096 : q0 + 160;
        attn_seg<64, true, 1>(ws, qf, st, WS_KA + ((seq0 + ks) >> 5) * 8192 + fo, 8192, WS_VTA + ((seq0 + ks) >> 5) * 8192 + fo, 8192, (ke - ks) >> 5, qpos, ks, hi);
        attn_seg<64, false, 1>(ws, qf, st, WS_CACHE + (b * 4 + l) * 131072 + fo, 8192, WS_CACHE + 1 * MiB + (b * 4 + l) * 131072 + fo, 8192, 16, qpos, 0, hi);
    }
    const float rl = 1.f / swap32_sum(st[0].l);
    const unsigned oo = WS_ACT + (row * DM + hq * 64 + 4 * hi) * 2;
#pragma unroll
    for (int db = 0; db < 2; ++db)
#pragma unroll
        for (int g = 0; g < 4; ++g) { const f32x4 v = {st[0].o[db][4 * g] * rl, st[0].o[db][4 * g + 1] * rl, st[0].o[db][4 * g + 2] * rl, st[0].o[db][4 * g + 3] * rl}; STG(u32x2, F.ws, oo + (32 * db + 8 * g) * 2) = pack4(v); }
}
__device__ __forceinline__ void attn_b_store(Frame& F, const AttnQ& s, unsigned mp, unsigned kh, unsigned row, unsigned h, unsigned hi) {
    const float lt = swap32_sum(s.l);
    const unsigned oo = WS_BO2 + (((mp * 2 + kh) * M + row) * 256 + h * 64 + 4 * hi) * 2;
#pragma unroll
    for (int db = 0; db < 2; ++db)
#pragma unroll
        for (int g = 0; g < 4; ++g) STG(u32x2, F.ws, oo + (32 * db + 8 * g) * 2) = pack4((f32x4){s.o[db][4 * g], s.o[db][4 * g + 1], s.o[db][4 * g + 2], s.o[db][4 * g + 3]});
    if (hi == 0) STG(f32x2, F.ws, WS_ML + ((((mp * 2 + kh) * M + row) * 4 + h) * 2) * 4) = (f32x2){s.m, lt};
}
__device__ __forceinline__ void attn_b_item(Frame& F, int l, bool lat, int item) {
    int lane = F.lane; asm volatile("" : "+v"(lane));
    const unsigned char* ws = F.ws;
    const unsigned r32 = lane & 31, hi = lane >> 5;
    if (lat) {
        const unsigned kh = item & 1, qb = (item >> 1) & 63, mp = (item >> 7) & 1, h = (item >> 8) & 3, b = item >> 10;
        const unsigned seq0 = MC + b * 4096, row0 = seq0 + qb * 64 + r32;
        bf16x8 qf[2][2];
#pragma unroll
        for (int q = 0; q < 2; ++q)
#pragma unroll
            for (int s = 0; s < 2; ++s) qf[q][s] = LDG(bf16x8, ws, WS_QB + ((row0 + 32 * q) * 256 + h * 64 + mp * 32 + 8 * hi) * 2 + 32 * s);
        AttnQ st[2]; attnq_init(st[0], 0.f); attnq_init(st[1], 0.f);
        const int qpos[2] = {0, 0};
        const unsigned kfo = (h * 2 + mp) * 2048 + lane * 16, vfo = h * 4096 + lane * 16;
        const unsigned blk0 = kh ? 72u : 0u, nb = kh ? 56 : 72;
        attn_seg<32, false, 2>(ws, qf, st, WS_KB + ((seq0 >> 5) + blk0) * 16384 + kfo, 16384, WS_VTB + ((seq0 >> 5) + blk0) * 16384 + vfo, 16384, nb, qpos, 0, hi);
        if (kh) attn_seg<32, false, 2>(ws, qf, st, WS_CACHE + 2 * MiB + (b * 4 + l) * 262144 + kfo, 16384, WS_CACHE + 4 * MiB + (b * 4 + l) * 262144 + vfo, 16384, 16, qpos, 0, hi);
        attn_b_store(F, st[0], mp, kh, row0, h, hi); attn_b_store(F, st[1], mp, kh, row0 + 32, h, hi);
    } else {
        const unsigned qb = item & 7, mp = (item >> 3) & 1, h = (item >> 4) & 3, b = item >> 6;
        const unsigned seq0 = b * 256, row = seq0 + qb * 32 + r32;
        bf16x8 qf[1][2];
#pragma unroll
        for (int s = 0; s < 2; ++s) qf[0][s] = LDG(bf16x8, ws, WS_QB + (row * 256 + h * 64 + mp * 32 + 8 * hi) * 2 + 32 * s);
        AttnQ st[1]; attnq_init(st[0], 0.f);
        const int qpos[1] = {0};
        const unsigned kfo = (h * 2 + mp) * 2048 + lane * 16, vfo = h * 4096 + lane * 16;
        attn_seg<32, false, 1>(ws, qf, st, WS_KB + (seq0 >> 5) * 16384 + kfo, 16384, WS_VTB + (seq0 >> 5) * 16384 + vfo, 16384, 8, qpos, 0, hi);
        attn_b_store(F, st[0], mp, 0, row, h, hi);
    }
}

constexpr int L_KT = 0, L_RT = 9216, L_BT = 18432, L_KK = 27648, L_VT = 36864, L_KKT = 46080, L_BTT = 55296, L_A1 = 64512, L_RHS2 = 81920, L_WT = 99328, L_U0T = 108544, L_GC = 117760, L_X0 = 118016;
constexpr int RPB = 144, RPF = 272;
__device__ __forceinline__ void chunk_decode(int cid, unsigned& seq0, int& T, unsigned& b, unsigned& h, unsigned& dir, int& c) {
    unsigned chain;
    if (cid < 768) { chain = (unsigned)cid >> 2; c = cid & 3; T = 256; b = chain / 12; seq0 = b * 256; }
    else { const unsigned x = (unsigned)cid - 768; chain = x >> 6; c = (int)(x & 63); T = 4096; b = chain / 12; seq0 = MC + b * 4096; }
    dir = chain & 1; h = (chain >> 1) % 6;
}
__device__ __forceinline__ bf16x8 acc_frag(const f32x16& x, int ks, float sgn) {
    u32x4 w; w.x = pk2(sgn * x[8 * ks], sgn * x[8 * ks + 1]); w.y = pk2(sgn * x[8 * ks + 2], sgn * x[8 * ks + 3]); w.z = pk2(sgn * x[8 * ks + 4], sgn * x[8 * ks + 5]); w.w = pk2(sgn * x[8 * ks + 6], sgn * x[8 * ks + 7]);
    return __builtin_bit_cast(bf16x8, w);
}
__device__ __forceinline__ bf16x8 lds_frag_nat(const LAS unsigned char* img, unsigned row, int ks, unsigned hi) { return *(const LAS bf16x8*)(img + row * RPB + (16 * ks + 8 * hi) * 2); }
__device__ __forceinline__ bf16x8 lds_frag_perm(const LAS unsigned char* img, unsigned row, int k0, unsigned hi) {
    const s16x4 a = *(const LAS s16x4*)(img + row * RPB + (k0 + 4 * hi) * 2), b = *(const LAS s16x4*)(img + row * RPB + (k0 + 8 + 4 * hi) * 2);
    return (bf16x8){a[0], a[1], a[2], a[3], b[0], b[1], b[2], b[3]};
}
__device__ __forceinline__ f32x16 gram_tile(const LAS unsigned char* lds, int aimg, int bimg, int sb, int tb, unsigned r32, unsigned hi, bool strict) {
    f32x16 acc = {};
#pragma unroll
    for (int ks = 0; ks < 4; ++ks) acc = MFMA32(lds_frag_nat(lds + aimg, 32 * sb + r32, ks, hi), lds_frag_nat(lds + bimg, 32 * tb + r32, ks, hi), acc);
    if (sb == tb) {
#pragma unroll
        for (int r = 0; r < 16; ++r) { const unsigned s_ = (r & 3) + 8 * (r >> 2) + 4 * hi; const bool keep = strict ? s_ < r32 : s_ <= r32; acc[r] = keep ? acc[r] : 0.f; }
    }
    return acc;
}
__device__ __forceinline__ void lds_barrier() { asm volatile("s_waitcnt lgkmcnt(0)\n\ts_barrier" ::: "memory"); }
__device__ __forceinline__ void rwkv_chunk_block(Frame& F, int l, int cid) {
    int lane = F.lane; asm volatile("" : "+v"(lane));
    const unsigned char* ws = F.ws; LAS unsigned char* lds = F.lds;
    const int w = F.wave; const unsigned r32 = lane & 31, hi = lane >> 5;
    unsigned seq0, b, h, dir; int T, c; chunk_decode(cid, seq0, T, b, h, dir, c);
    const int q0 = 64 * c;
#ifndef RA_REP
#define RA_REP 0
#endif
    const int role = w >> 1, tb = w & 1;
    const unsigned swo = WS_SMALLW + l * (SMALLW_L * 2);
    {
        const int pw_ = w < 4, pb = (w >> 1) & 1, cb = w & 1;
        const int p_ = 32 * pb + r32; const unsigned tokp = seq0 + (dir ? T - 1 - (q0 + p_) : q0 + p_);
        const unsigned xo = (pw_ ? WS_CW : WS_CA) + (tokp * 128 + dir * 64 + 8 * hi) * 2, wo = swo + ((pw_ ? 0 : 49152) + (dir * 384 + h * 64 + 32 * cb + r32) * 64 + 8 * hi) * 2;
        f32x16 acc = {};
#pragma unroll
        for (int ks = 0; ks < 4; ++ks) acc = MFMA32(LDG(bf16x8, ws, xo + 32 * ks), LDG(bf16x8, ws, wo + 32 * ks), acc);
        {
            const float bias = LDG(float, pw_ ? INP(19) : INP(21), ((l * 2 + dir) * 384 + h * 64 + 32 * cb + r32) * 4);
#pragma unroll
            for (int r = 0; r < 16; ++r) { const float sg = sigmf(bias + acc[r]);
                *(LAS float*)(lds + (pw_ ? L_A1 : L_RHS2) + (32 * pb + (r & 3) + 8 * (r >> 2) + 4 * hi) * RPF + (32 * cb + r32) * 4) = pw_ ? -0.606531f * sg : sg; }
        }
        if (dir == 0 && w < 4) {
            f32x16 ag = {};
            const unsigned go = WS_CG + (tokp * 128 + 8 * hi) * 2, gw_ = swo + (98304 + (h * 64 + 32 * cb + r32) * 128 + 8 * hi) * 2;
#pragma unroll
            for (int ks = 0; ks < 8; ++ks) ag = MFMA32(LDG(bf16x8, ws, go + 32 * ks), LDG(bf16x8, ws, gw_ + 32 * ks), ag);
#pragma unroll
            for (int r = 0; r < 16; ++r) { const int pp_ = 32 * pb + (r & 3) + 8 * (r >> 2) + 4 * hi; const unsigned tk = seq0 + q0 + pp_;
                STG(bf16_t, F.ws, WS_G + (tk * 384 + h * 64 + 32 * cb + r32) * 2) = (bf16_t)(pk2(ag[r], 0.f) & 0xffff); }
        }
    }
    lds_barrier();
    {
        const unsigned cch = h * 64 + lane;
        const float* convp = INP(18) + (size_t)l * 3 * 1152;
        float cw_[3][3];
#pragma unroll
        for (int tap = 0; tap < 3; ++tap)
#pragma unroll
            for (int seg = 0; seg < 3; ++seg) cw_[tap][seg] = LDG(float, convp, (tap * 1152 + seg * 384 + cch) * 4);
        const float ckk = LDG(float, INP(24), (l * 384 + cch) * 4), cka = LDG(float, INP(25), (l * 384 + cch) * 4), crk = LDG(float, INP(26), (l * 384 + cch) * 4);
        const int tb0 = dir ? T - 1 - (q0 + 8 * w + 7) : q0 + 8 * w;
        float xr[10][3];
#pragma unroll
        for (int rr = 0; rr < 10; ++rr) { const int tr = tb0 - 1 + rr; const bool ok = tr >= 0 && tr < T; const unsigned tk = seq0 + (ok ? tr : tb0);
#pragma unroll
            for (int seg = 0; seg < 3; ++seg) { const float x = bf_lo((unsigned)LDG(bf16_t, ws, WS_RKV + (tk * 1152 + seg * 384 + cch) * 2)); xr[rr][seg] = ok ? x : 0.f; } }
        float lwv[8], kkv[8], btv[8], kdv[8], rv[8], vv[8], g = 0.f;
#pragma unroll
        for (int pp = 0; pp < 8; ++pp) {
            const int rr = 1 + (dir ? 7 - pp : pp); const int p = 8 * w + pp; const unsigned tok = seq0 + (unsigned)(tb0 + rr - 1);
            const float r_ = xr[rr - 1][0] * cw_[0][0] + xr[rr][0] * cw_[1][0] + xr[rr + 1][0] * cw_[2][0];
            const float k_ = xr[rr - 1][1] * cw_[0][1] + xr[rr][1] * cw_[1][1] + xr[rr + 1][1] * cw_[2][1];
            const float v_ = xr[rr - 1][2] * cw_[0][2] + xr[rr][2] * cw_[1][2] + xr[rr + 1][2] * cw_[2][2];
            const float kraw = k_ * ckk; const float n2 = wave_sum(kraw * kraw); const float kk_ = kraw * __builtin_amdgcn_rsqf(fmaxf(n2, 1e-24f));
            const float lw = *(const LAS float*)(lds + L_A1 + p * RPF + lane * 4), av = *(const LAS float*)(lds + L_RHS2 + p * RPF + lane * 4);
            const float kd_ = k_ * (1.f + (av - 1.f) * cka);
            const float bon = wave_sum(r_ * kd_ * crk);
            if (lane == 0) STG(float, F.ws, WS_SB + ((dir * M + tok) * 8 + h) * 4) = bon;
            if (dir == 0) STG(float, F.ws, WS_SV + (tok * 384 + cch) * 4) = v_;
            lwv[pp] = lw; kkv[pp] = kk_; btv[pp] = kk_ * av; kdv[pp] = kd_; rv[pp] = r_; vv[pp] = v_; g += lw;
        }
        g = 0.f;
        for (int wq = 0; wq < w; ++wq) { float t8[8];
#pragma unroll
            for (int e = 0; e < 8; ++e) t8[e] = *(const LAS float*)(lds + L_A1 + (8 * wq + e) * RPF + lane * 4);
            g += ((t8[0] + t8[1]) + (t8[2] + t8[3])) + ((t8[4] + t8[5]) + (t8[6] + t8[7])); }
        unsigned vt[4], kkt[4], btt[4]; float e_pos = __expf(g);
#pragma unroll
        for (int pp = 0; pp < 8; ++pp) {
            const int p = 8 * w + pp;
            const float e_prev = e_pos; g += lwv[pp]; e_pos = __expf(g); const float e_neg = __expf(-g);
            const unsigned pk_kr = pk2(kkv[pp] * e_prev, rv[pp] * e_pos), pk_bk = pk2(btv[pp] * e_neg, kdv[pp] * e_neg), pk_v = pk2(vv[pp], 0.f);
            *(LAS bf16_t*)(lds + L_KT + p * RPB + lane * 2) = (bf16_t)(pk_kr & 0xffff); *(LAS bf16_t*)(lds + L_RT + p * RPB + lane * 2) = (bf16_t)(pk_kr >> 16);
            *(LAS bf16_t*)(lds + L_BT + p * RPB + lane * 2) = (bf16_t)(pk_bk & 0xffff); *(LAS bf16_t*)(lds + L_KK + p * RPB + lane * 2) = (bf16_t)(pk_bk >> 16);
            if (pp & 1) { vt[pp >> 1] |= pk_v << 16; kkt[pp >> 1] |= pk_bk & 0xffff0000u; btt[pp >> 1] |= pk_bk << 16; }
            else { vt[pp >> 1] = pk_v & 0xffff; kkt[pp >> 1] = pk_bk >> 16; btt[pp >> 1] = pk_bk & 0xffff; }
        }
        *(LAS u32x4*)(lds + L_VT + lane * RPB + 16 * w) = (u32x4){vt[0], vt[1], vt[2], vt[3]};
        *(LAS u32x4*)(lds + L_KKT + lane * RPB + 16 * w) = (u32x4){kkt[0], kkt[1], kkt[2], kkt[3]};
        *(LAS u32x4*)(lds + L_BTT + lane * RPB + 16 * w) = (u32x4){btt[0], btt[1], btt[2], btt[3]};
        if (w == 7) *(LAS float*)(lds + L_GC + lane * 4) = e_pos;
    }
    lds_barrier();
    f32x16 keep[2]; bf16x8 x4f[2][2];
    if (role == 0) {
        for (int sb = 0; sb <= tb; ++sb) { const f32x16 x = gram_tile(lds, L_BT, L_KT, sb, tb, r32, hi, true);
            if (sb == tb) {
#pragma unroll
                for (int r = 0; r < 16; ++r) *(LAS float*)(lds + L_A1 + tb * 4608 + ((r & 3) + 8 * (r >> 2) + 4 * hi) * 144 + r32 * 4) = -x[r];
            } else {
#pragma unroll
                for (int g4 = 0; g4 < 4; ++g4) *(LAS f32x4*)(lds + L_A1 + 9216 + r32 * 144 + (8 * g4 + 4 * hi) * 4) = (f32x4){x[4 * g4], x[4 * g4 + 1], x[4 * g4 + 2], x[4 * g4 + 3]};
            } }
    } else if (role == 1) {
        f32x16 o[2] = {};
        for (int sb = 0; sb <= tb; ++sb) {
            const f32x16 x = gram_tile(lds, L_KK, L_KT, sb, tb, r32, hi, true);
#pragma unroll
            for (int ks = 0; ks < 2; ++ks) { const bf16x8 a = acc_frag(x, ks, 1.f);
#pragma unroll
                for (int ib = 0; ib < 2; ++ib) o[ib] = MFMA32(a, lds_frag_perm(lds + L_VT, 32 * ib + r32, 32 * sb + 16 * ks, hi), o[ib]); }
        }
#pragma unroll
        for (int ib = 0; ib < 2; ++ib)
#pragma unroll
            for (int r = 0; r < 16; ++r) *(LAS float*)(lds + L_RHS2 + (32 * tb + (r & 3) + 8 * (r >> 2) + 4 * hi) * RPF + (32 * ib + r32) * 4) = o[ib][r];
    } else if (role == 2) {
#pragma unroll
        for (int sb = 0; sb < 2; ++sb) { x4f[sb][0] = (bf16x8){}; x4f[sb][1] = (bf16x8){}; }
        keep[0] = (f32x16){}; keep[1] = (f32x16){};
        for (int sb = 0; sb <= tb; ++sb) {
            const f32x16 x3 = gram_tile(lds, L_KK, L_RT, sb, tb, r32, hi, false), x4 = gram_tile(lds, L_BT, L_RT, sb, tb, r32, hi, false);
#pragma unroll
            for (int ks = 0; ks < 2; ++ks) { const bf16x8 a3 = acc_frag(x3, ks, 1.f); const bf16x8 a4 = acc_frag(x4, ks, -1.f);
                if (sb == 0) x4f[0][ks] = a4; else x4f[1][ks] = a4;
#pragma unroll
                for (int cb = 0; cb < 2; ++cb) keep[cb] = MFMA32(a3, lds_frag_perm(lds + L_VT, 32 * cb + r32, 32 * sb + 16 * ks, hi), keep[cb]); }
        }
    } else {
        keep[0] = (f32x16){}; keep[1] = (f32x16){};
#pragma unroll
        for (int ks = 0; ks < 4; ++ks) { const bf16x8 ak = lds_frag_nat(lds + L_KKT, 32 * tb + r32, ks, hi);
#pragma unroll
            for (int cb = 0; cb < 2; ++cb) keep[cb] = MFMA32(ak, lds_frag_nat(lds + L_VT, 32 * cb + r32, ks, hi), keep[cb]); }
    }
    lds_barrier();
    if (w < 2) {
        const LAS unsigned char* a1p = lds + L_A1; asm volatile("" : "+v"(a1p));
        LAS unsigned char* xp = lds + (w == 0 ? L_X0 : L_RHS2) + lane * 4; asm volatile("" : "+v"(xp));
        const LAS unsigned char* kp = lds + L_KT + lane * 2; asm volatile("" : "+v"(kp));
        LAS unsigned char* dst = lds + (w == 0 ? L_WT : L_U0T) + lane * RPB; asm volatile("" : "+v"(dst));
#pragma unroll
        for (int B = 0; B < 2; ++B) {
            float acc[32];
            if (w == 0 && B == 0) {
#pragma unroll
                for (int r = 0; r < 32; ++r) acc[r] = bf_lo((unsigned)*(const LAS bf16_t*)(kp + r * RPB));
            } else {
#pragma unroll
                for (int r = 0; r < 32; ++r) acc[r] = *(const LAS float*)(xp + (32 * B + r) * RPF);
            }
            f32x2 ac2[16];
#pragma unroll
            for (int k = 0; k < 16; ++k) ac2[k] = (f32x2){acc[2 * k], acc[2 * k + 1]};
            f32x4 ca[8], cn[8];
#pragma unroll
            for (int tg = 0; tg < 8; ++tg) ca[tg] = *(const LAS f32x4*)(a1p + B * 4608 + tg * 16);
#pragma unroll
            for (int s_ = 0; s_ < 31; ++s_) {
                if (s_ + 1 < 31) {
#pragma unroll
                    for (int tg = (s_ + 2) / 4; tg < 8; ++tg) cn[tg] = *(const LAS f32x4*)(a1p + B * 4608 + (s_ + 1) * 144 + tg * 16);
                }
                __builtin_amdgcn_sched_barrier(0);
                const float xs = ac2[s_ >> 1][s_ & 1];
                const f32x2 xs2 = {xs, xs};
#pragma unroll
                for (int tg = (s_ + 1) / 4; tg < 8; ++tg) {
                    ac2[2 * tg] = __builtin_elementwise_fma((f32x2){ca[tg][0], ca[tg][1]}, xs2, ac2[2 * tg]);
                    ac2[2 * tg + 1] = __builtin_elementwise_fma((f32x2){ca[tg][2], ca[tg][3]}, xs2, ac2[2 * tg + 1]); }
                __builtin_amdgcn_sched_barrier(0);
#pragma unroll
                for (int tg = 0; tg < 8; ++tg) ca[tg] = cn[tg];
            }
#pragma unroll
            for (int k = 0; k < 16; ++k) { acc[2 * k] = ac2[k][0]; acc[2 * k + 1] = ac2[k][1]; }
#pragma unroll
            for (int k8 = 0; k8 < 4; ++k8) { u32x4 v; v.x = pk2(acc[8 * k8], acc[8 * k8 + 1]); v.y = pk2(acc[8 * k8 + 2], acc[8 * k8 + 3]); v.z = pk2(acc[8 * k8 + 4], acc[8 * k8 + 5]); v.w = pk2(acc[8 * k8 + 6], acc[8 * k8 + 7]);
                *(LAS u32x4*)(dst + 64 * B + 16 * k8) = v; }
            if (B == 0) {
                asm volatile("s_waitcnt lgkmcnt(0)" ::: "memory");
                f32x16 u[2];
#pragma unroll
                for (int cb = 0; cb < 2; ++cb)
#pragma unroll
                    for (int r = 0; r < 16; ++r) { const int t = 32 + (r & 3) + 8 * (r >> 2) + 4 * hi;
                        u[cb][r] = w == 0 ? bf_lo((unsigned)*(const LAS bf16_t*)(lds + L_KT + t * RPB + (32 * cb + r32) * 2)) : *(const LAS float*)(lds + L_RHS2 + t * RPF + (32 * cb + r32) * 4); }
#pragma unroll
                for (int ks = 0; ks < 2; ++ks) { const f32x4 a0 = *(const LAS f32x4*)(lds + L_A1 + 9216 + r32 * 144 + (16 * ks + 8 * hi) * 4), a1 = *(const LAS f32x4*)(lds + L_A1 + 9216 + r32 * 144 + (16 * ks + 8 * hi + 4) * 4);
                    u32x4 aw; aw.x = pk2(-a0[0], -a0[1]); aw.y = pk2(-a0[2], -a0[3]); aw.z = pk2(-a1[0], -a1[1]); aw.w = pk2(-a1[2], -a1[3]);
#pragma unroll
                    for (int cb = 0; cb < 2; ++cb) u[cb] = MFMA32(__builtin_bit_cast(bf16x8, aw), lds_frag_nat(lds + (w == 0 ? L_WT : L_U0T), 32 * cb + r32, ks, hi), u[cb]); }
#pragma unroll
                for (int cb = 0; cb < 2; ++cb)
#pragma unroll
                    for (int r = 0; r < 16; ++r) *(LAS float*)(lds + (w == 0 ? L_X0 : L_RHS2) + (32 + (r & 3) + 8 * (r >> 2) + 4 * hi) * RPF + (32 * cb + r32) * 4) = u[cb][r];
                asm volatile("s_waitcnt lgkmcnt(0)" ::: "memory");
            }
        }
    }
    lds_barrier();
    if (role == 2) {
        f32x16 pj[2];
#pragma unroll
        for (int jb = 0; jb < 2; ++jb)
#pragma unroll
            for (int r = 0; r < 16; ++r) pj[jb][r] = bf_lo((unsigned)*(const LAS bf16_t*)(lds + L_RT + (32 * tb + (r & 3) + 8 * (r >> 2) + 4 * hi) * RPB + (32 * jb + r32) * 2));
#pragma unroll
        for (int sb = 0; sb < 2; ++sb)
#pragma unroll
            for (int ks = 0; ks < 2; ++ks)
#pragma unroll
                for (int cb = 0; cb < 2; ++cb) {
                    keep[cb] = MFMA32(x4f[sb][ks], lds_frag_perm(lds + L_U0T, 32 * cb + r32, 32 * sb + 16 * ks, hi), keep[cb]);
                    pj[cb] = MFMA32(x4f[sb][ks], lds_frag_perm(lds + L_WT, 32 * cb + r32, 32 * sb + 16 * ks, hi), pj[cb]); }
        f32x16 (&y0)[2] = keep;
        const unsigned yb = dir ? WS_YB : WS_YF;
#pragma unroll
        for (int r = 0; r < 16; ++r) { const int t = 32 * tb + (r & 3) + 8 * (r >> 2) + 4 * hi; const unsigned tok = seq0 + (dir ? T - 1 - (q0 + t) : q0 + t);
#pragma unroll
            for (int cb = 0; cb < 2; ++cb) { STG(float, F.ws, yb + (tok * 384 + h * 64 + 32 * cb + r32) * 4) = y0[cb][r];
                STG(bf16_t, F.ws, WS_RP + (((unsigned)cid * 64 + t) * 64 + 32 * cb + r32) * 2) = (bf16_t)(pk2(pj[cb][r], 0.f) & 0xffff); } }
    } else if (role == 3) {
        const int jb = tb;
        f32x16 q1[2] = {}, q2[2] = {}; f32x16 (&n1)[2] = keep;
#pragma unroll
        for (int ks = 0; ks < 4; ++ks) { const bf16x8 a = lds_frag_nat(lds + L_BTT, 32 * jb + r32, ks, hi);
#pragma unroll
            for (int cb = 0; cb < 2; ++cb) { q1[cb] = MFMA32(lds_frag_nat(lds + L_WT, 32 * cb + r32, ks, hi), a, q1[cb]); q2[cb] = MFMA32(a, lds_frag_nat(lds + L_U0T, 32 * cb + r32, ks, hi), q2[cb]); } }
#pragma unroll
        for (int q = 0; q < 4; ++q) { f32x4 gc4;
#pragma unroll
            for (int e = 0; e < 4; ++e) gc4[e] = *(const LAS float*)(lds + L_GC + (32 * jb + e + 8 * q + 4 * hi) * 4);
#pragma unroll
            for (int cb = 0; cb < 2; ++cb) { f32x4 nv;
#pragma unroll
                for (int e = 0; e < 4; ++e) nv[e] = gc4[e] * (n1[cb][4 * q + e] - q2[cb][4 * q + e]);
                STG(f32x4, F.ws, WS_RN + ((((unsigned)cid * 2 + jb) * 2 + cb) * 4 + q) * 1024 + lane * 16) = nv; } }
        { const float gl = *(const LAS float*)(lds + L_GC + (32 * jb + r32) * 4);
#pragma unroll
          for (int cb = 0; cb < 2; ++cb)
#pragma unroll
            for (int s2 = 0; s2 < 2; ++s2) { float mv[8];
#pragma unroll
                for (int e = 0; e < 8; ++e) { const int r = 8 * s2 + e; const unsigned c = 32 * cb + (r & 3) + 8 * (r >> 2) + 4 * hi; mv[e] = (c == 32 * jb + r32 ? gl : 0.f) - gl * q1[cb][r]; }
                u32x4 w; w.x = pk2(mv[0], mv[1]); w.y = pk2(mv[2], mv[3]); w.z = pk2(mv[4], mv[5]); w.w = pk2(mv[6], mv[7]);
                STG(u32x4, F.ws, WS_RM + (unsigned)cid * 8192 + ((jb * 2 + cb) * 2 + s2) * 1024 + lane * 16) = w; } }
    }
    lds_barrier();
}
__device__ __forceinline__ void rwkv_chain_wave(Frame& F, int l, bool lat, int chain, int ib) {
    int lane = F.lane; asm volatile("" : "+v"(lane));
    const unsigned char* ws = F.ws; const unsigned r32 = lane & 31, hi = lane >> 5;
    const unsigned dir = chain & 1, h = (chain >> 1) % 6, b = chain / 12;
    const int nc = lat ? 64 : 4; const unsigned cid0 = lat ? 768 + chain * 64 : chain * 4;
    const unsigned i = 32 * ib + r32;
    const unsigned so = ((((b * 4 + l) * 6 + h) * 64 + i) * 64) * 4;
    f32x16 H[2];
#pragma unroll
    for (int jb = 0; jb < 2; ++jb)
#pragma unroll
        for (int g4 = 0; g4 < 4; ++g4) { f32x4 v = {0.f, 0.f, 0.f, 0.f}; if (lat) v = LDG(f32x4, dir ? INP(7) : INP(6), so + (32 * jb + 8 * g4 + 4 * hi) * 4);
            H[jb][4 * g4] = v[0]; H[jb][4 * g4 + 1] = v[1]; H[jb][4 * g4 + 2] = v[2]; H[jb][4 * g4 + 3] = v[3]; }
    bf16x8 maA[2][2][2], maB[2][2][2]; f32x16 ntA[2], ntB[2];
    const GAS unsigned char* pm = (const GAS unsigned char*)ws + (WS_RM + cid0 * 8192 + lane * 16);
    const GAS unsigned char* pn = (const GAS unsigned char*)ws + (WS_RN + (cid0 * 4 + ib) * 4096 + lane * 16);
#define RB_LOAD(ma, nt, k_) do { \
        _Pragma("unroll") for (int jo = 0; jo < 2; ++jo) _Pragma("unroll") for (int ji = 0; ji < 2; ++ji) _Pragma("unroll") for (int ks = 0; ks < 2; ++ks) ma[jo][ji][ks] = *(const GAS bf16x8*)(pm + ((k_) * 8192 + ((jo * 2 + ji) * 2 + ks) * 1024)); \
        _Pragma("unroll") for (int jo = 0; jo < 2; ++jo) _Pragma("unroll") for (int q = 0; q < 4; ++q) { const f32x4 t_ = *(const GAS f32x4*)(pn + ((k_) * 16384 + (jo * 8 + q) * 1024)); \
            nt[jo][4 * q] = t_[0]; nt[jo][4 * q + 1] = t_[1]; nt[jo][4 * q + 2] = t_[2]; nt[jo][4 * q + 3] = t_[3]; } } while (0)
#define RB_STEP(ma, nt, cid_) do { \
        bf16x8 hf[2][2]; \
        _Pragma("unroll") for (int ji = 0; ji < 2; ++ji) { hf[ji][0] = acc_frag(H[ji], 0, 1.f); hf[ji][1] = acc_frag(H[ji], 1, 1.f); } \
        _Pragma("unroll") for (int ji = 0; ji < 2; ++ji) _Pragma("unroll") for (int ks = 0; ks < 2; ++ks) STG(bf16x8, F.ws, WS_RH + (cid_) * 8192 + ((ib * 2 + ji) * 2 + ks) * 1024 + lane * 16) = hf[ji][ks]; \
        f32x16 acc[2] = {nt[0], nt[1]}; \
        _Pragma("unroll") for (int jo = 0; jo < 2; ++jo) _Pragma("unroll") for (int ji = 0; ji < 2; ++ji) _Pragma("unroll") for (int ks = 0; ks < 2; ++ks) acc[jo] = MFMA32(ma[jo][ji][ks], hf[ji][ks], acc[jo]); \
        H[0] = acc[0]; H[1] = acc[1]; } while (0)
    RB_LOAD(maA, ntA, 0); RB_LOAD(maB, ntB, 1);
#pragma unroll 1
    for (int c = 0; c < nc; c += 2) {
        const unsigned cid = cid0 + c;
        RB_STEP(maA, ntA, cid);
        if (c + 2 < nc) RB_LOAD(maA, ntA, 2);
        RB_STEP(maB, ntB, cid + 1);
        if (c + 2 < nc) RB_LOAD(maB, ntB, 3);
        pm += 16384; pn += 32768;
    }
#undef RB_LOAD
#undef RB_STEP
    if (!lat) {
#pragma unroll
        for (int jb = 0; jb < 2; ++jb)
#pragma unroll
            for (int g4 = 0; g4 < 4; ++g4) STG(f32x4, F.out, (dir ? OFF_CB : OFF_CF) * 4 + so + (32 * jb + 8 * g4 + 4 * hi) * 4) = (f32x4){H[jb][4 * g4], H[jb][4 * g4 + 1], H[jb][4 * g4 + 2], H[jb][4 * g4 + 3]};
    }
}
__device__ __forceinline__ void rwkv_apply_wave(Frame& F, int item) {
    int lane = F.lane; asm volatile("" : "+v"(lane));
    const unsigned char* ws = F.ws; const unsigned r32 = lane & 31, hi = lane >> 5;
    const int cid = item >> 1, tb = item & 1;
    unsigned seq0, b, h, dir; int T, c; chunk_decode(cid, seq0, T, b, h, dir, c);
    const unsigned yb = dir ? WS_YB : WS_YF;
    f32x16 acc[2];
#pragma unroll
    for (int r = 0; r < 16; ++r) { const int t = 32 * tb + (r & 3) + 8 * (r >> 2) + 4 * hi; const unsigned tok = seq0 + (dir ? T - 1 - (64 * c + t) : 64 * c + t);
        acc[0][r] = LDG(float, ws, yb + (tok * 384 + h * 64 + r32) * 4); acc[1][r] = LDG(float, ws, yb + (tok * 384 + h * 64 + 32 + r32) * 4); }
#pragma unroll
    for (int ks = 0; ks < 4; ++ks) { const bf16x8 a = LDG(bf16x8, ws, WS_RP + (((unsigned)cid * 64 + 32 * tb + r32) * 64 + 16 * ks + 8 * hi) * 2);
#pragma unroll
        for (int ib = 0; ib < 2; ++ib) acc[ib] = MFMA32(a, LDG(bf16x8, ws, WS_RH + (((unsigned)cid * 64 + 32 * ib + r32) * 64 + 16 * ks + 8 * hi) * 2), acc[ib]); }
#pragma unroll
    for (int r = 0; r < 16; ++r) { const int t = 32 * tb + (r & 3) + 8 * (r >> 2) + 4 * hi; const unsigned tok = seq0 + (dir ? T - 1 - (64 * c + t) : 64 * c + t);
        STG(float, F.ws, yb + (tok * 384 + h * 64 + r32) * 4) = acc[0][r]; STG(float, F.ws, yb + (tok * 384 + h * 64 + 32 + r32) * 4) = acc[1][r]; }
}

__device__ __forceinline__ void rwkv_out_item(Frame& F, int l, int item) {
    int lane = F.lane; asm volatile("" : "+v"(lane));
    const unsigned char* ws = F.ws; const unsigned r32 = lane & 31, hi = lane >> 5;
    const int tb = item & 1, h = (item >> 1) % 6, sk = item / 12;
    const bool lat = sk >= 64; const int b = lat ? (sk - 64) >> 6 : sk >> 2, k = lat ? (sk - 64) & 63 : sk & 3, nc = lat ? 64 : 4;
    const unsigned seq0 = lat ? MC + b * 4096 : b * 256, base = lat ? 768u : 0u;
    const unsigned chf = (b * 6 + h) * 2, cidf = base + chf * nc + k, cidb = base + (chf + 1) * nc + (nc - 1 - k);
    const unsigned tok0 = seq0 + 64 * k + 32 * tb;
    f32x16 acc[2];
#pragma unroll
    for (int r = 0; r < 16; ++r) { const unsigned tok = tok0 + (r & 3) + 8 * (r >> 2) + 4 * hi; const unsigned e = (tok * 384 + h * 64 + r32) * 4;
        acc[0][r] = LDG(float, ws, WS_YF + e) + LDG(float, ws, WS_YB + e); acc[1][r] = LDG(float, ws, WS_YF + e + 128) + LDG(float, ws, WS_YB + e + 128); }
    const unsigned pf = 32 * tb + r32, pb_ = 63 - 32 * tb - r32;
#pragma unroll
    for (int ks = 0; ks < 4; ++ks) {
        const s16x4 f0 = LDG(s16x4, ws, WS_RP + ((cidf * 64 + pf) * 64 + 16 * ks + 4 * hi) * 2), f1 = LDG(s16x4, ws, WS_RP + ((cidf * 64 + pf) * 64 + 16 * ks + 8 + 4 * hi) * 2);
        const s16x4 b0_ = LDG(s16x4, ws, WS_RP + ((cidb * 64 + pb_) * 64 + 16 * ks + 4 * hi) * 2), b1_ = LDG(s16x4, ws, WS_RP + ((cidb * 64 + pb_) * 64 + 16 * ks + 8 + 4 * hi) * 2);
        const bf16x8 af = {f0[0], f0[1], f0[2], f0[3], f1[0], f1[1], f1[2], f1[3]}, ab = {b0_[0], b0_[1], b0_[2], b0_[3], b1_[0], b1_[1], b1_[2], b1_[3]};
#pragma unroll
        for (int ib = 0; ib < 2; ++ib) { acc[ib] = MFMA32(af, LDG(bf16x8, ws, WS_RH + cidf * 8192 + (ib * 4 + ks) * 1024 + lane * 16), acc[ib]);
            acc[ib] = MFMA32(ab, LDG(bf16x8, ws, WS_RH + cidb * 8192 + (ib * 4 + ks) * 1024 + lane * 16), acc[ib]); } }
    LAS unsigned char* lw = F.lds + F.wave * 9216;
#pragma unroll
    for (int ib = 0; ib < 2; ++ib)
#pragma unroll
        for (int r = 0; r < 16; ++r) *(LAS float*)(lw + ((r & 3) + 8 * (r >> 2) + 4 * hi) * 288 + (32 * ib + r32) * 4) = acc[ib][r];
    const unsigned ts = lane >> 4, dg = lane & 15;
    const f32x4 g4 = LDG(f32x4, INP(27), (l * 384 + h * 64 + 4 * dg) * 4), b4 = LDG(f32x4, INP(28), (l * 384 + h * 64 + 4 * dg) * 4);
#pragma unroll 2
    for (int i = 0; i < 8; ++i) { const unsigned tk = tok0 + 4 * i + ts, e = tk * 384 + h * 64 + 4 * dg;
        const float bon = LDG(float, ws, WS_SB + (tk * 8 + h) * 4) + LDG(float, ws, WS_SB + ((M + tk) * 8 + h) * 4);
        const f32x4 y = *(const LAS f32x4*)(lw + (4 * i + ts) * 288 + dg * 16) + bon * LDG(f32x4, ws, WS_SV + e * 4);
        const float mu = allreduce16((y[0] + y[1]) + (y[2] + y[3])) * (1.f / 64.f);
        const f32x4 d = y - mu;
        const float rs = rsqrtf(allreduce16((d[0] * d[0] + d[1] * d[1]) + (d[2] * d[2] + d[3] * d[3])) * (1.f / 64.f) + 64e-5f);
        const f32x4 o = (d * rs * g4 + b4) * unpack4(LDG(u32x2, ws, WS_G + e * 2));
        STG(u32x2, F.ws, WS_ACT + (tk * DM + 640 + h * 64 + 4 * dg) * 2) = pack4(o); }
}

#ifndef B_UNIT
#define B_UNIT 0
#endif
constexpr int AU_R = 8, AU_D = 4, AU_SLOT = 6144;
__device__ __forceinline__ void attn_b_unit(Frame& F, int l, int unit) {
    int lane = F.lane; asm volatile("" : "+v"(lane));
    const unsigned char* ws = F.ws; LAS unsigned char* lds = F.lds;
    const int w = F.wave; const unsigned r32 = lane & 31, hi = lane >> 5;
    const unsigned kh = unit & 1, qb = (unit >> 1) & 15, mp = (unit >> 5) & 1, h = (unit >> 6) & 3, b = unit >> 8;
    const unsigned seq0 = MC + b * 4096, row = seq0 + qb * 256 + 32 * w + r32;
    bf16x8 qf[1][2];
#pragma unroll
    for (int s = 0; s < 2; ++s) qf[0][s] = LDG(bf16x8, ws, WS_QB + (row * 256 + h * 64 + mp * 32 + 8 * hi) * 2 + 32 * s);
    AttnQ st[1]; attnq_init(st[0], 0.f);
    const int qpos[1] = {0};
    const int n0 = kh ? 56 : 72, nt = 72;
    const unsigned pofs = (w < 2 ? (h * 2 + mp) * 2048 + w * 1024 : h * 4096 + (w - 2) * 1024) + lane * 16;
    const unsigned base0 = (w < 2 ? WS_KB : WS_VTB) + ((seq0 >> 5) + (kh ? 72u : 0u)) * 16384 + pofs;
    const unsigned base1 = WS_CACHE + (w < 2 ? 2 * MiB : 4 * MiB) + (b * 4 + l) * 262144 + pofs;
#define AU_DMA(t_) do { const int tt_ = (t_) < nt ? (t_) : nt - 1; const unsigned src_ = tt_ < n0 ? base0 + tt_ * 16384 : base1 + (tt_ - n0) * 16384; \
        __builtin_amdgcn_global_load_lds((const GAS unsigned*)(ws + src_), (LAS unsigned*)(lds + ((t_) % AU_R) * AU_SLOT + w * 1024), 16, 0, 0); } while (0)
    if (w < 6) {
#pragma unroll
        for (int t = 0; t < AU_D; ++t) AU_DMA(t);
    }
    for (int t = 0; t < nt; ++t) {
        if (w < 6) asm volatile("s_waitcnt vmcnt(3)" ::: "memory");
        asm volatile("s_barrier" ::: "memory");
        const LAS unsigned char* sl = lds + (t % AU_R) * AU_SLOT + lane * 16;
        bf16x8 kf[2], vf[4];
        kf[0] = *(const LAS bf16x8*)(sl); kf[1] = *(const LAS bf16x8*)(sl + 1024);
#pragma unroll
        for (int f = 0; f < 4; ++f) vf[f] = *(const LAS bf16x8*)(sl + 2048 + 1024 * f);
        if (w < 6) AU_DMA(t + AU_D);
        attn_block<32, false, 1>(qf, kf, vf, st, t, qpos, 0, hi);
    }
#undef AU_DMA
    asm volatile("s_waitcnt vmcnt(0) lgkmcnt(0)\n\ts_barrier" ::: "memory");
    attn_b_store(F, st[0], mp, kh, row, h, hi);
}

constexpr int Q_BLAT = 2048, Q_ALAT = 1536, Q_BCTX = 1024, Q_ACTX = 768;
constexpr int Q_TOTAL = Q_BLAT + Q_ALAT + Q_BCTX + Q_ACTX;
#ifndef XCD_DEAL
#define XCD_DEAL 1
#endif
__device__ __forceinline__ void phase_mixer(Frame& F, int l, int rep) {
    if (rep == 0 || REP_PART == 0 || REP_PART == 1) {
        const int si = F.bid + F.G * F.wave;
        if (si < 48) rwkv_chain_wave(F, l, true, si >> 1, si & 1);
        else if (si < 48 + 384) rwkv_chain_wave(F, l, false, (si - 48) >> 1, (si - 48) & 1);
    }
    if (B_UNIT && (rep == 0 || REP_PART == 2 || REP_PART == 4)) {
        unsigned* uctr = (unsigned*)(F.ws + WS_CTL) + 64 * (32 + l + 4 * rep);
        LAS int* ubox = (LAS int*)(F.lds + 65536);
        for (;;) {
            if (F.wave == 0 && F.lane == 0) *ubox = (int)atomicAdd(uctr, 1u);
            lds_barrier();
            const int un = __builtin_amdgcn_readfirstlane(*ubox);
            lds_barrier();
            if (un >= 512) break;
            attn_b_unit(F, l, un);
        }
    }
    unsigned* ctr = (unsigned*)(F.ws + WS_CTL) + 64 * (1 + l + 4 * rep);
    const bool xdeal = XCD_DEAL && !B_UNIT && F.G == 256;
    if (xdeal && (rep == 0 || REP_PART == 2 || REP_PART == 4)) attn_b_item(F, l, true, (F.bid & 7) * 256 + (F.bid >> 3) * 8 + F.wave);
    unsigned* cx = (unsigned*)(F.ws + WS_CTL) + 8192 + ((l + 4 * rep) * 8 + (F.bid & 7)) * 64;
    bool xq = xdeal;
    if (rep == 0 || REP_PART != 1) for (;;) {
        int it = 0;
        if (F.lane == 0) it = (int)atomicAdd(xq ? cx : ctr, 1u);
        it = __builtin_amdgcn_readfirstlane(it);
        if (xq) { if (it >= 192) { xq = false; continue; }
            const int x = F.bid & 7; it = Q_BLAT + (((x >> 2) * 6 + ((x >> 1) & 1) * 3 + it / 64) * 128 + (x & 1) * 64 + it % 64); }
        else it += xdeal ? Q_BLAT + Q_ALAT : (B_UNIT ? Q_BLAT : 0);
        if (it >= Q_TOTAL) break;
        if (it < Q_BLAT) { if (rep == 0 || REP_PART == 2 || REP_PART == 4) attn_b_item(F, l, true, it); continue; } it -= Q_BLAT;
        if (it < Q_ALAT) { if (rep == 0 || REP_PART == 2 || REP_PART == 3) attn_a_item(F, l, true, it); continue; } it -= Q_ALAT;
        if (it < Q_BCTX) { if (rep == 0 || REP_PART == 2 || REP_PART == 5) attn_b_item(F, l, false, it); continue; } it -= Q_BCTX;
        if (rep == 0 || REP_PART == 2 || REP_PART == 5) attn_a_item(F, l, false, it);
    }
}

__device__ __forceinline__ void phase_finalize(Frame& F, int l) {
    const unsigned char* ws = F.ws;
    const unsigned lane = F.lane;
    const float lami = 0.8f - 0.6f * __expf(-0.3f * (float)l);
    const float lam = LDG(float, ws, WS_TAB + (TAB_LAM + l) * 4) + lami;
    const float omli = 1.f - lami;
    const float sg = LDG(float, INP(17), (l * 64 + lane) * 4);
    const unsigned skipw = (F.ngw < 2304 && 2 * F.ngw > 2304 + 64) ? 2304 - F.ngw : 0;
    if ((unsigned)F.gw < skipw) return;
    for (unsigned row = F.gw - skipw; row < M; row += F.ngw - skipw) {
#pragma unroll
        for (int k = 0; k < 4; ++k) { float om[2];
#pragma unroll
            for (int mp = 0; mp < 2; ++mp) { const unsigned o0 = (((mp * 2) * M + row) * 256 + 64 * k + lane) * 2, q0 = ((((mp * 2) * M + row) * 4 + k) * 2) * 4;
                const f32x2 ml0 = LDG(f32x2, ws, WS_ML + q0);
                if (row >= MC) { const f32x2 ml1 = LDG(f32x2, ws, WS_ML + q0 + M * 32); const float ms = fmaxf(ml0[0], ml1[0]), w0 = __builtin_amdgcn_exp2f(ml0[0] - ms), w1 = __builtin_amdgcn_exp2f(ml1[0] - ms);
                    om[mp] = (bf_lo((unsigned)LDG(bf16_t, ws, WS_BO2 + o0)) * w0 + bf_lo((unsigned)LDG(bf16_t, ws, WS_BO2 + o0 + M * 512)) * w1) * __builtin_amdgcn_rcpf(ml0[1] * w0 + ml1[1] * w1); }
                else om[mp] = bf_lo((unsigned)LDG(bf16_t, ws, WS_BO2 + o0)) * __builtin_amdgcn_rcpf(ml0[1]); }
            const float v = om[0] - lam * om[1];
            const float ms = wave_sum(v * v) * (1.f / 64.f);
            STG(bf16_t, F.ws, WS_ACT + (row * DM + 384 + 64 * k + lane) * 2) = (bf16_t)(pk2(v * rsqrtf(ms + 1e-6f) * sg * omli, 0.f) & 0xffff); }
    }
}


typedef unsigned v4u __attribute__((ext_vector_type(4)));
#define XB_TMO      128
#define XB_XCNT(j)  (256  + 64 * (j))
#define XB_XSUB(j)  (1280 + 64 * (j))
#define XB_XGEN(j)  (2304 + 64 * (j))
#define XB_TOP      3328
#define XB_TOPGEN   3392
#define XCD_BAR_WORDS 3456
#define XB_SPIN_CAP (1u << 18)

__device__ __forceinline__ unsigned xb_ld(unsigned* p)              { return __hip_atomic_load(p, __ATOMIC_RELAXED, __HIP_MEMORY_SCOPE_AGENT); }
__device__ __forceinline__ unsigned xb_add(unsigned* p, unsigned v) { return __hip_atomic_fetch_add(p, v, __ATOMIC_RELAXED, __HIP_MEMORY_SCOPE_AGENT); }
__device__ __forceinline__ unsigned xb_xcc_id() { return (unsigned)__builtin_amdgcn_s_getreg((3 << 11) | 20) & 0xFu; }
#define XB_SPIN(cond, bar) do { unsigned _sp = 0; while (cond) { __builtin_amdgcn_s_sleep(1); \
    if ((++_sp & 255u) == 0u) { if (xb_ld(&(bar)[XB_TMO])) break; if (_sp > XB_SPIN_CAP) { atomicAdd(&(bar)[XB_TMO], 1u); break; } } } } while (0)

struct XcdBarrier {
    unsigned* bar; unsigned x;
    volatile LAS unsigned* st;
};

__device__ __forceinline__ XcdBarrier xcd_barrier_post(unsigned* bar, volatile LAS unsigned* st) {
    XcdBarrier b; b.bar = bar; b.x = xb_xcc_id(); b.st = st;
    if (threadIdx.x == 0) (void)xb_add(&bar[XB_XCNT(b.x)], 1u);
    return b;
}
__device__ __forceinline__ void xcd_barrier_complete(unsigned* bar, unsigned x, unsigned& nloc, unsigned& nx) {
    const unsigned G = gridDim.x * gridDim.y * gridDim.z;
    unsigned sum, cnt, mine, sp = 0u;
    for (;;) {
        sum = 0u; cnt = 0u; mine = 0u;
#pragma unroll
        for (unsigned j = 0; j < 16; ++j) { const unsigned c = xb_ld(&bar[XB_XCNT(j)]); sum += c; cnt += (c > 0u) ? 1u : 0u; mine = (j == x) ? c : mine; }
        if (sum == G) break;
        __builtin_amdgcn_s_sleep(1);
        if ((++sp & 255u) == 0u) { if (xb_ld(&bar[XB_TMO])) break; if (sp > XB_SPIN_CAP) { atomicAdd(&bar[XB_TMO], 1u); break; } }
    }
    nloc = mine > 0u ? mine : 1u; nx = cnt > 0u ? cnt : 1u;
}

__device__ __forceinline__ void xcd_barrier(const XcdBarrier& b) {
    asm volatile("s_waitcnt vmcnt(0)" ::: "memory");
    __syncthreads();
    if (threadIdx.x == 0) {
        unsigned* bar = b.bar;
        __builtin_amdgcn_s_waitcnt(0);
        unsigned nloc = b.st[0], nx = b.st[1];
        if (nloc == 0u) { xcd_barrier_complete(bar, b.x, nloc, nx); b.st[0] = nloc; b.st[1] = nx; }
        const unsigned old = xb_add(&bar[XB_XSUB(b.x)], 1u);
        const unsigned gen = old / nloc;
        if (old + 1u == (gen + 1u) * nloc) {
            __builtin_amdgcn_fence(__ATOMIC_RELEASE, "agent");
            asm volatile("s_waitcnt vmcnt(0)" ::: "memory");
            const unsigned og = xb_add(&bar[XB_TOP], 1u);
            const unsigned tg = og / nx;
            if (og + 1u == (tg + 1u) * nx) xb_add(&bar[XB_TOPGEN], 1u);
            else XB_SPIN(xb_ld(&bar[XB_TOPGEN]) == tg, bar);
            __builtin_amdgcn_fence(__ATOMIC_ACQUIRE, "agent");
            xb_add(&bar[XB_XGEN(b.x)], 1u);
            asm volatile("s_waitcnt vmcnt(0)" ::: "memory");
        } else {
            XB_SPIN(xb_ld(&bar[XB_XGEN(b.x)]) == gen, bar);
            __builtin_amdgcn_fence(__ATOMIC_ACQUIRE, "agent");
            asm volatile("s_waitcnt vmcnt(0)" ::: "memory");
        }
    }
    __syncthreads();
}

#ifndef DIS
#define DIS 0
#endif
#ifndef GEMM_MF
#define GEMM_MF 7
#endif
#ifndef REP_PHASE
#define REP_PHASE -1
#define REP_COUNT 1
#endif
constexpr int NEXTRA = (REP_PHASE >= 0 && REP_PHASE < 9) ? REP_COUNT - 1 : 0, NPL = 9 + NEXTRA, NPRE = (REP_PHASE == 100) ? REP_COUNT : 1, NPHASE_RUN = NPRE + 1 + NPL * DEPTH;
__global__ void __launch_bounds__(512, 2) mega(Args a) {
    extern __shared__ __attribute__((aligned(16))) unsigned char lds[];
    Frame F;
    F.lds = (LAS unsigned char*)lds;
    volatile LAS unsigned* bst = (volatile LAS unsigned*)(F.lds + LDS_BYTES - 64);
    if (threadIdx.x < 2) bst[threadIdx.x] = 0u;
    __syncthreads();
    const XcdBarrier xbar = xcd_barrier_post((unsigned*)((GAS unsigned char*)a.ws + WS_CTL) + 4096, bst);
    const int wave_id = __builtin_amdgcn_readfirstlane((int)threadIdx.x >> 6);
    for (int ph = a.ph_lo; ph < a.ph_hi; ++ph) {
        { const unsigned char* kp = (const unsigned char*)__builtin_amdgcn_kernarg_segment_ptr(); asm volatile("" : "+s"(kp));
          const Args* ap = (const Args*)kp; F.in = ap->in; F.out = gptr(ap->out); F.ws = gptr(ap->ws); }
        { unsigned ones = ~0u; asm volatile("" : "+s"(ones)); int ln = (int)__builtin_amdgcn_mbcnt_hi(ones, __builtin_amdgcn_mbcnt_lo(ones, 0u)); int wv = wave_id, bid = (int)blockIdx.x, gg = (int)gridDim.x; asm volatile("" : "+s"(wv), "+s"(bid), "+s"(gg));
          F.lane = ln; F.wave = wv; F.bid = bid; F.G = gg; F.ngw = gg * 8; F.tid = wv * 64 + ln; F.gw = bid * 8 + wv; }
        if (ph < NPRE) { if (!(DIS & 1)) phase_prologue(F); }
        else if (ph == NPHASE_RUN - 1) { if (!(DIS & 2)) phase_final_norm(F); }
        else {
            const int l = (ph - NPRE) / NPL, sidx = (ph - NPRE) % NPL, rep = (REP_PHASE >= 0 && REP_PHASE < 9 && sidx > REP_PHASE && sidx <= REP_PHASE + NEXTRA) ? sidx - REP_PHASE : 0, s = (REP_PHASE >= 0 && REP_PHASE < 9 && sidx > REP_PHASE) ? (sidx <= REP_PHASE + NEXTRA ? REP_PHASE : sidx - NEXTRA) : sidx;
            if (s == 0) { convert_weights(F, l); phase_norm(F, l, 0); }
            else if (s == 1) {
                pg8::Gemm g{WSP(bf16_t, WS_ACT), WSP(bf16_t, WS_WIN + 0u * WSET_STRIDE), M, NIN, 1024}; pg8::StaticOrder S; S.init(M, NIN, F.G, F.bid, (GEMM_MF & 1) ? 192 : 256);
                EpiWin E{F.ws, F.out, l, F.lds + pg8::STAGE_BYTES, REP_PART == 9 && rep > 0};
                if (!(DIS & 16)) pg8::gemm_phase<EpiWin, pg8::StaticOrder, false, true, (GEMM_MF & 1) ? 3 : 4>(F.lds, g, S, E, F.tid);
                if (false) { const int wv_ = (F.bid - 64) * 8 + F.wave; convert_item_any(F, l + 1, wv_); if (wv_ < CV_TOTAL - 1536) convert_item_any(F, l + 1, 1536 + wv_); }
            }
            else if (s == 2) { for (int cid = F.bid; cid < NCHUNK; cid += F.G) rwkv_chunk_block(F, l, cid); }
            else if (s == 3) { if (!(DIS & 64)) phase_mixer(F, l, rep); }
            else if (s == 4) { if (rep == 0 || REP_PART != 7) phase_finalize(F, l); if (rep == 0 || REP_PART != 6) for (int it = F.gw; it < 192 * 12; it += F.ngw) rwkv_out_item(F, l, it); }
            else if (s == 5 || s == 8) {
                const bool second = s == 8;
                pg8::Gemm g{second ? WSP(bf16_t, WS_U) : WSP(bf16_t, WS_ACT), second ? WSP(bf16_t, WS_W2 + 0u * WSET_STRIDE) : WSP(bf16_t, WS_WOUT + 0u * WSET_STRIDE), M, 1024, second ? FF : 1024};
                pg8::StaticOrder S; S.init(M, 1024, F.G, F.bid, (GEMM_MF & 2) ? 192 : 256);
                const bool first = (l == 0 && !second);
                EpiRes E{INP(0), INP(1) - (size_t)MC * DM, F.ws, WSP(float, WS_MOD) + (size_t)l * 3 * 6144 + (second ? 5120 : 2048), first, rep ? WS_BO : WS_XB, REP_PART == 9 && rep > 0};
                if (!(DIS & 256)) pg8::gemm_phase<EpiRes, pg8::StaticOrder, false, true, (GEMM_MF & 2) ? 3 : 4>(F.lds, g, S, E, F.tid);
            }
            else if (s == 6) { if (!(DIS & 8)) phase_norm(F, l, 1); }
            else {
                pg8::Gemm g{WSP(bf16_t, WS_ACT), WSP(bf16_t, WS_W13 + 0u * WSET_STRIDE), M, NFF2, 1024}; pg8::StaticOrder S; S.init(M, NFF2, F.G, F.bid, (GEMM_MF & 4) ? 192 : 256);
                EpiSwi E{WSP(bf16_t, WS_U), REP_PART == 9 && rep > 0};
                if (!(DIS & 512)) pg8::gemm_phase<EpiSwi, pg8::StaticOrder, true, true, (GEMM_MF & 4) ? 3 : 4>(F.lds, g, S, E, F.tid);
            }
        }
        if (ph + 1 < a.ph_hi) { if (ph == a.ph_lo) { __threadfence(); cg::this_grid().sync(); } else xcd_barrier(xbar); }
    }
}

extern "C" void kernel_launch(void* const* d_in, const int* in_sizes, int n_in, void* d_out, int out_size, void* d_ws, size_t ws_size, hipStream_t stream) {
    static int grid = 0;
    if (grid == 0) {
        int dev = 0, cus = 0, per_cu = 0;
        if (n_in != 34 || ws_size < WS_END) { fprintf(stderr, "kernel_launch: unexpected n_in %d / ws_size %zu (need %zu)\n", n_in, ws_size, (size_t)WS_END); grid = -1; return; }
        if (hipGetDevice(&dev) != hipSuccess || hipDeviceGetAttribute(&cus, hipDeviceAttributeMultiprocessorCount, dev) != hipSuccess) { grid = -1; return; }
        if (hipFuncSetAttribute((const void*)mega, hipFuncAttributeMaxDynamicSharedMemorySize, LDS_BYTES) != hipSuccess) { fprintf(stderr, "kernel_launch: hipFuncSetAttribute failed\n"); grid = -1; return; }
        if (hipOccupancyMaxActiveBlocksPerMultiprocessor(&per_cu, (const void*)mega, 512, LDS_BYTES) != hipSuccess || per_cu < 1) { fprintf(stderr, "kernel_launch: occupancy query says %d\n", per_cu); per_cu = 1; }
        (void)hipGetLastError();
        grid = cus * 1;
        if (grid > cus * per_cu) grid = cus * per_cu;
    }
    if (grid < 0) return;
    (void)hipMemsetAsync((char*)d_ws + WS_CTL, 0, CTL_BYTES, stream);
    Args a{};
    for (int i = 0; i < 34; ++i) a.in[i] = (const float*)d_in[i];
    a.out = (float*)d_out; a.ws = (unsigned char*)d_ws;
#if MK_ONE_LAUNCH
    a.ph_lo = 0; a.ph_hi = NPHASE_RUN;
    void* args[] = {&a};
    hipError_t e = hipLaunchCooperativeKernel((const void*)mega, dim3(grid), dim3(512), args, LDS_BYTES, stream);
    if (e != hipSuccess) fprintf(stderr, "kernel_launch: cooperative launch failed: %s (grid %d)\n", hipGetErrorString(e), grid);
#else
    for (int ph = 0; ph < NPHASE_RUN; ++ph) { a.ph_lo = ph; a.ph_hi = ph + 1; hipLaunchKernelGGL(mega, dim3(grid), dim3(512), LDS_BYTES, stream, a); }
#endif
}
```

```cpp
#include <hip/hip_runtime.h>
#include <hip/hip_cooperative_groups.h>
#include <cstdio>
#include <cstdint>
namespace cg = cooperative_groups;

#ifndef MK_ONE_LAUNCH
#define MK_ONE_LAUNCH 1
#endif

#undef MK_ONE_LAUNCH
#define MK_ONE_LAUNCH 1
#define REP_PHASE -1
#define REP_COUNT 1
#define REP_PART 0
#define RA_REP 0
#define ATT_PROBE 0
namespace pg8 {
#define PG8_LAS __attribute__((address_space(3)))
typedef unsigned short bf16_t;
typedef short bf16x8 __attribute__((ext_vector_type(8)));
typedef float f32x4 __attribute__((ext_vector_type(4)));
typedef unsigned u32x4 __attribute__((ext_vector_type(4)));
constexpr int BM = 256, BK = 64, HALF = 128, HTB = HALF * BK * 2  , STAGE_BYTES = 8 * HTB, NXCD = 8, WGM = 8;

__host__ __device__ __forceinline__ int lds_byte(int r, int c) { const int st = (r >> 4) * 2 + (c >> 5), rr = r & 15, cc = c & 31, ob = rr * 64 + cc * 2; return st * 1024 + (ob ^ (((ob >> 9) & 1) << 5)); }
__host__ __device__ __forceinline__ void stage_rc(int b, int& R, int& C) { const int st = b / 1024, sb = b % 1024, swz = sb ^ (((sb >> 9) & 1) << 5); R = (st >> 1) * 16 + swz / 64; C = (st & 1) * 32 + (swz % 64) / 2; }
__host__ __device__ __forceinline__ int perm32(int rho) { const int n = rho >> 4, i = rho & 15; return 8 * (i >> 2) + 4 * n + (i & 3); }

struct Unit { int pm, pn; };
struct Gemm { const bf16_t* A; const bf16_t* Bt; int M, N, K; };

struct StaticOrder {
    int nM, nN, nwg, G, c;
    __host__ __device__ void init(int M, int N, int G_, int c_, int bm = BM) { nM = M / bm; nN = N / BM; nwg = nM * nN; G = G_; c = c_; }
    __host__ __device__ bool next(int i, Unit& u) const {
        const long L = (long)i * G + c; if (L >= nwg) return false;
        int wgid = (int)L; { const int q = nwg / NXCD, r = nwg % NXCD, xcd = wgid % NXCD, off = wgid / NXCD; wgid = (xcd < r ? xcd * (q + 1) : r * (q + 1) + (xcd - r) * q) + off; }
        const int nig = WGM * nN, gid = wgid / nig, fm = gid * WGM, gsz = (nM - fm) < WGM ? (nM - fm) : WGM;
        u.pm = fm + ((wgid % nig) % gsz); u.pn = (wgid % nig) / gsz; return true;
    }
    __device__ __forceinline__ void a_ready(const Unit&) const {}
    __device__ __forceinline__ void done(const Unit&) const {}
};

template <class Epi, class Sched, bool ALIGN_EPI = false, bool SP2 = false, int MF = 4>
__device__ __forceinline__ void gemm_phase(PG8_LAS unsigned char* lds, const Gemm g, const Sched& S, const Epi& E, const int tid_in) {
    const int tid = tid_in, wid = __builtin_amdgcn_readfirstlane(tid >> 6), lane = tid & 63, wr = wid >> 2, wc = wid & 3, fr = lane & 15, fq = lane >> 4;
    static_assert(MF == 4 || (MF == 3 && SP2), "192-row tiles: SP2 schedule only");
    const int K = g.K, nt = K / BK;
    unsigned voffA[2], voffB[2];
#pragma unroll
    for (int i = 0; i < 2; ++i) { int R, C; stage_rc(tid * 16 + i * 8192, R, C); const int Rb = Epi::PERM ? ((R & ~31) + perm32(R & 31)) : R;
        voffA[i] = (unsigned)(R * K + C) * 2u; voffB[i] = (unsigned)(Rb * K + C) * 2u; }
    const size_t kstep = (size_t)(BK * 2);
    const size_t hstep = (size_t)HALF * K * 2;
    const size_t tstep = 2 * hstep;
    const size_t hstepA = (size_t)(MF * 32) * K * 2, tstepA = 2 * hstepA;
    const unsigned ldsw = (unsigned)wid * 1024u;
    const int aoff = lds_byte(wr * (MF * 16) + fr, fq * 8), boff = lds_byte(wc * 32 + fr, fq * 8);
#define PG8_SA(b, h) (((b) * 2 + (h)) * HTB)
#define PG8_SB(b, h) ((4 + (b) * 2 + (h)) * HTB)
#define PG8_STAGE(bufoff, gbase, voff) do { _Pragma("unroll") for (int _i = 0; _i < 2; ++_i) \
        __builtin_amdgcn_global_load_lds((const unsigned*)((const char*)(gbase) + (voff)[_i]), (PG8_LAS unsigned*)(lds + (bufoff) + ldsw + _i * 8192), 16, 0, 0); } while (0)
#define PG8_STAGEA(bufoff, gbase, voff) do { __builtin_amdgcn_global_load_lds((const unsigned*)((const char*)(gbase) + (voff)[0]), (PG8_LAS unsigned*)(lds + (bufoff) + ldsw), 16, 0, 0); \
        if (MF == 4 || wr == 0) __builtin_amdgcn_global_load_lds((const unsigned*)((const char*)(gbase) + (voff)[1]), (PG8_LAS unsigned*)(lds + (bufoff) + ldsw + 8192), 16, 0, 0); } while (0)
#define PG8_LDA(dst, b, h) do { _Pragma("unroll") for (int m = 0; m < MF; ++m) _Pragma("unroll") for (int k = 0; k < 2; ++k) dst[m][k] = *(const PG8_LAS bf16x8*)(lds + PG8_SA(b, h) + aoff + m * 2048 + k * 1024); } while (0)
#define PG8_LDB(dst, b, h) do { _Pragma("unroll") for (int n = 0; n < 2; ++n) _Pragma("unroll") for (int k = 0; k < 2; ++k) dst[n][k] = *(const PG8_LAS bf16x8*)(lds + PG8_SB(b, h) + boff + n * 2048 + k * 1024); } while (0)
#define PG8_MMA(ai, bj, At, Bt) do { __builtin_amdgcn_s_setprio(1); _Pragma("unroll") for (int m = 0; m < MF; ++m) _Pragma("unroll") for (int n = 0; n < 2; ++n) _Pragma("unroll") for (int k = 0; k < 2; ++k) \
        acc[ai][bj][m][n] = __builtin_amdgcn_mfma_f32_16x16x32_bf16(Bt[n][k], At[m][k], acc[ai][bj][m][n], 0, 0, 0); __builtin_amdgcn_s_setprio(0); } while (0)
#define PG8_WAIT_V(n) asm volatile("s_waitcnt vmcnt(" #n ")" ::: "memory")
#define PG8_WAIT_V2(a, b) do { if (MF == 4 || wr == 0) asm volatile("s_waitcnt vmcnt(" #a ")" ::: "memory"); else asm volatile("s_waitcnt vmcnt(" #b ")" ::: "memory"); } while (0)
#define PG8_WAIT_L(n) asm volatile("s_waitcnt lgkmcnt(" #n ")" ::: "memory")
#define PG8_BAR __builtin_amdgcn_s_barrier()
#define PG8_SCHED __builtin_amdgcn_sched_barrier(0)
    Unit cur, nxt; int ui = 0;
    if (!S.next(0, cur)) return;
    f32x4 acc[2][2][MF][2];
#pragma unroll
    for (int a = 0; a < 2; ++a)
#pragma unroll
        for (int b = 0; b < 2; ++b)
#pragma unroll
            for (int m = 0; m < MF; ++m)
#pragma unroll
                for (int n = 0; n < 2; ++n) acc[a][b][m][n] = (f32x4){0.f, 0.f, 0.f, 0.f};
    bf16x8 At[MF][2], B0[2][2], B1[2][2];
#define PG8_SGPR64(p) ((const char*)(((unsigned long long)(unsigned)__builtin_amdgcn_readfirstlane((int)((unsigned long long)(p) >> 32)) << 32) | (unsigned)__builtin_amdgcn_readfirstlane((int)(unsigned long long)(p))))
    const char* cA = PG8_SGPR64((const char*)g.A + (size_t)cur.pm * tstepA); const char* cB = PG8_SGPR64((const char*)g.Bt + (size_t)cur.pn * tstep);
    S.a_ready(cur);
    if constexpr (SP2) {
        PG8_STAGE(PG8_SB(0, 0), cB, voffB); PG8_STAGE(PG8_SB(0, 1), cB + hstep, voffB); PG8_STAGEA(PG8_SA(0, 0), cA, voffA); PG8_STAGEA(PG8_SA(0, 1), cA + hstepA, voffA);
        if (wr == 1) PG8_BAR;
        PG8_WAIT_V2(2, 1); PG8_BAR;
        PG8_STAGE(PG8_SB(1, 0), cB + kstep, voffB); PG8_STAGEA(PG8_SA(1, 0), cA + kstep, voffA); PG8_STAGE(PG8_SB(1, 1), cB + hstep + kstep, voffB);
        PG8_WAIT_V2(6, 5); PG8_BAR;
    } else {
        PG8_STAGE(PG8_SB(0, 0), cB, voffB); PG8_STAGEA(PG8_SA(0, 0), cA, voffA); PG8_STAGE(PG8_SB(0, 1), cB + hstep, voffB); PG8_STAGEA(PG8_SA(0, 1), cA + hstepA, voffA);
        if (wr == 1) PG8_BAR;
        PG8_WAIT_V(4); PG8_BAR;
        PG8_STAGE(PG8_SB(1, 0), cB + kstep, voffB); PG8_STAGEA(PG8_SA(1, 0), cA + kstep, voffA); PG8_STAGE(PG8_SB(1, 1), cB + hstep + kstep, voffB);
        PG8_WAIT_V(6); PG8_BAR;
    }
    for (;;) {
        const bool has_next = S.next(ui + 1, nxt);
        const char* nA = PG8_SGPR64(has_next ? (const char*)g.A + (size_t)nxt.pm * tstepA : cA); const char* nB = PG8_SGPR64(has_next ? (const char*)g.Bt + (size_t)nxt.pn * tstep : cB);
        for (int t = 0; t < nt; t += 2) {
            const bool last = (t == nt - 2);
            const char* a1 = cA + (size_t)(t + 1) * kstep;
            const char* a2 = last ? nA : cA + (size_t)(t + 2) * kstep; const char* b2 = last ? nB : cB + (size_t)(t + 2) * kstep;
            const char* a3 = a2 + kstep; const char* b3 = b2 + kstep;
            if (last && has_next) S.a_ready(nxt);
            if constexpr (SP2) {
            PG8_LDB(B0, 0, 0); PG8_LDB(B1, 0, 1); PG8_SCHED; PG8_LDA(At, 0, 0); PG8_STAGEA(PG8_SA(1, 1), a1 + hstepA, voffA);
            PG8_WAIT_V2(8, 6); PG8_WAIT_L(0); PG8_BAR; PG8_MMA(0, 0, At, B0); PG8_MMA(0, 1, At, B1); PG8_BAR; PG8_SCHED;
            PG8_LDA(At, 0, 1); PG8_STAGE(PG8_SB(0, 0), b2, voffB); PG8_STAGE(PG8_SB(0, 1), b2 + hstep, voffB); PG8_STAGEA(PG8_SA(0, 0), a2, voffA);
            PG8_WAIT_V2(8, 6); PG8_WAIT_L(0); PG8_BAR; PG8_MMA(1, 0, At, B0); PG8_MMA(1, 1, At, B1); PG8_BAR; PG8_SCHED;
            PG8_LDB(B0, 1, 0); PG8_LDB(B1, 1, 1); PG8_SCHED; PG8_LDA(At, 1, 0); PG8_STAGEA(PG8_SA(0, 1), a2 + hstepA, voffA);
            PG8_WAIT_V2(8, 6); PG8_WAIT_L(0); PG8_BAR; PG8_MMA(0, 0, At, B0); PG8_MMA(0, 1, At, B1); PG8_BAR; PG8_SCHED;
            PG8_LDA(At, 1, 1); PG8_STAGE(PG8_SB(1, 0), b3, voffB); PG8_STAGE(PG8_SB(1, 1), b3 + hstep, voffB); PG8_STAGEA(PG8_SA(1, 0), a3, voffA);
            PG8_WAIT_V2(8, 6); PG8_WAIT_L(0); PG8_BAR; PG8_MMA(1, 0, At, B0); PG8_MMA(1, 1, At, B1); PG8_BAR; PG8_SCHED;
            } else {
            PG8_LDB(B0, 0, 0); PG8_SCHED; PG8_LDA(At, 0, 0); PG8_STAGEA(PG8_SA(1, 1), a1 + hstepA, voffA);
            PG8_WAIT_L(8); PG8_BAR; PG8_WAIT_L(0); PG8_MMA(0, 0, At, B0); PG8_BAR; PG8_SCHED;
            PG8_LDB(B1, 0, 1); PG8_STAGE(PG8_SB(0, 0), b2, voffB);
            PG8_BAR; PG8_WAIT_L(0); PG8_MMA(0, 1, At, B1); PG8_BAR;
            PG8_LDA(At, 0, 1); PG8_STAGEA(PG8_SA(0, 0), a2, voffA);
            PG8_BAR; PG8_WAIT_L(0); PG8_MMA(1, 0, At, B0); PG8_BAR; PG8_SCHED;
            PG8_STAGE(PG8_SB(0, 1), b2 + hstep, voffB);
            PG8_WAIT_V(6); PG8_BAR; PG8_MMA(1, 1, At, B1); PG8_BAR;
            PG8_LDB(B0, 1, 0); PG8_SCHED; PG8_LDA(At, 1, 0); PG8_STAGEA(PG8_SA(0, 1), a2 + hstepA, voffA);
            PG8_WAIT_L(8); PG8_BAR; PG8_WAIT_L(0); PG8_MMA(0, 0, At, B0); PG8_BAR; PG8_SCHED;
            PG8_LDB(B1, 1, 1); PG8_STAGE(PG8_SB(1, 0), b3, voffB);
            PG8_BAR; PG8_WAIT_L(0); PG8_MMA(0, 1, At, B1); PG8_BAR;
            PG8_LDA(At, 1, 1); PG8_STAGEA(PG8_SA(1, 0), a3, voffA);
            PG8_BAR; PG8_WAIT_L(0); PG8_MMA(1, 0, At, B0); PG8_BAR; PG8_SCHED;
            PG8_STAGE(PG8_SB(1, 1), b3 + hstep, voffB);
            PG8_WAIT_V(6); PG8_BAR; PG8_MMA(1, 1, At, B1); PG8_BAR;
            }
        }
        if constexpr (ALIGN_EPI) { if (wr == 0) PG8_BAR; }
        if constexpr (!Epi::AFTER_DRAIN) { E.template operator()<MF>(acc, cur, wr, wc, fr, fq); S.done(cur); }
        if (!has_next) break;
#pragma unroll
        for (int a = 0; a < 2; ++a)
#pragma unroll
            for (int b = 0; b < 2; ++b)
#pragma unroll
                for (int m = 0; m < MF; ++m)
#pragma unroll
                    for (int n = 0; n < 2; ++n) acc[a][b][m][n] = (f32x4){0.f, 0.f, 0.f, 0.f};
        cur = nxt; cA = nA; cB = nB; ++ui;
        if constexpr (ALIGN_EPI) { if (wr == 1) PG8_BAR; }
    }
    PG8_WAIT_V(0);
    if constexpr (!ALIGN_EPI) { if (wr == 0) PG8_BAR; }
    PG8_BAR;
    if constexpr (Epi::AFTER_DRAIN) { E.fused(acc, cur, wr, wc, fr, fq, lds, wid, lane); S.done(cur); }
#undef PG8_SA
#undef PG8_SB
#undef PG8_STAGE
#undef PG8_STAGEA
#undef PG8_WAIT_V2
#undef PG8_LDA
#undef PG8_LDB
#undef PG8_MMA
#undef PG8_WAIT_V
#undef PG8_WAIT_L
#undef PG8_BAR
#undef PG8_SCHED
}
}

using pg8::bf16_t; using pg8::bf16x8; using pg8::f32x4; using pg8::u32x4;
typedef float f32x16 __attribute__((ext_vector_type(16)));
typedef float f32x2 __attribute__((ext_vector_type(2)));
typedef short s16x4 __attribute__((ext_vector_type(4)));
typedef unsigned u32x2 __attribute__((ext_vector_type(2)));
typedef __bf16 bf16x2_t __attribute__((ext_vector_type(2)));
#define LAS __attribute__((address_space(3)))
#define LDG(T, base, boff) (*(const __attribute__((address_space(1))) T*)((const __attribute__((address_space(1))) unsigned char*)(base) + (unsigned)(boff)))
#define STG(T, base, boff) (*(__attribute__((address_space(1))) T*)((__attribute__((address_space(1))) unsigned char*)(base) + (unsigned)(boff)))

__device__ __forceinline__ unsigned pk2(float lo, float hi) { f32x2 v = {lo, hi}; bf16x2_t b = __builtin_convertvector(v, bf16x2_t); return __builtin_bit_cast(unsigned, b); }
__device__ __forceinline__ float bf_lo(unsigned u) { return __uint_as_float(u << 16); }
__device__ __forceinline__ float bf_hi(unsigned u) { return __uint_as_float(u & 0xffff0000u); }
__device__ __forceinline__ f32x4 unpack4(u32x2 v) { return (f32x4){bf_lo(v.x), bf_hi(v.x), bf_lo(v.y), bf_hi(v.y)}; }
__device__ __forceinline__ u32x2 pack4(f32x4 v) { u32x2 r; r.x = pk2(v[0], v[1]); r.y = pk2(v[2], v[3]); return r; }
__device__ __forceinline__ float sigmf(float x) { return __builtin_amdgcn_rcpf(1.f + __expf(-x)); }
template <int CTRL> __device__ __forceinline__ float dpp_f(float x) { return __builtin_bit_cast(float, __builtin_amdgcn_update_dpp(0, __builtin_bit_cast(int, x), CTRL, 0xF, 0xF, true)); }
__device__ __forceinline__ float allreduce16(float x) { x += dpp_f<0xB1>(x); x += dpp_f<0x4E>(x); x += dpp_f<0x141>(x); x += dpp_f<0x140>(x); return x; }
__device__ __forceinline__ float rdlane(float x, int l) { return __builtin_bit_cast(float, __builtin_amdgcn_readlane(__builtin_bit_cast(int, x), l)); }
__device__ __forceinline__ float wave_sum(float v) {
    v = allreduce16(v);
    return (rdlane(v, 0) + rdlane(v, 16)) + (rdlane(v, 32) + rdlane(v, 48));
}
__device__ __forceinline__ float swap32_sum(float x) { auto rr = __builtin_amdgcn_permlane32_swap(__float_as_uint(x), __float_as_uint(x), false, false); return __uint_as_float(rr[0]) + __uint_as_float(rr[1]); }
__device__ __forceinline__ float swap32_max(float x) { auto rr = __builtin_amdgcn_permlane32_swap(__float_as_uint(x), __float_as_uint(x), false, false); return fmaxf(__uint_as_float(rr[0]), __uint_as_float(rr[1])); }

constexpr int M = 12288, MC = 4096, DM = 1024, NIN = 3072, FF = 2816, NFF2 = 5632, DEPTH = 4;
constexpr float LOG2E = 1.4426950408889634f;
constexpr float QSCALE_A = 0.125f * LOG2E;
constexpr float QSCALE_B = 0.17677669529663687f * LOG2E;
constexpr unsigned OFF_AK = 12582912, OFF_AV = 14680064, OFF_BK = 16777216, OFF_BV = 20971520, OFF_CF = 25165824, OFF_CB = 26738688;
constexpr unsigned MiB = 1u << 20;
constexpr unsigned WS_CTL = 0, CTL_BYTES = 1 * MiB;
constexpr unsigned WS_MOD = 1 * MiB;
constexpr unsigned WS_TAB = 1 * MiB + 512 * 1024;
constexpr unsigned WS_SMALLW = 2 * MiB;
constexpr unsigned WS_CACHE = 4 * MiB;
constexpr unsigned WS_WIN = 10 * MiB, WS_WOUT = 16 * MiB, WS_W13 = 18 * MiB, WS_W2 = 29 * MiB;
constexpr unsigned WSET_STRIDE = 184 * MiB;
constexpr unsigned WS_ACT = 35 * MiB;
constexpr unsigned WS_QA = 59 * MiB, WS_KA = 68 * MiB, WS_VTA = 71 * MiB, WS_QB = 74 * MiB, WS_KB = 80 * MiB, WS_VTB = 86 * MiB;
constexpr unsigned WS_RKV = 92 * MiB, WS_CW = 119 * MiB, WS_CA = 122 * MiB, WS_CG = 125 * MiB;
constexpr unsigned WS_YF = 128 * MiB, WS_YB = 146 * MiB;
constexpr unsigned WS_SV = 164 * MiB;
constexpr unsigned WS_BO2 = 182 * MiB, WS_ML = 230 * MiB;
constexpr unsigned WS_XB = 206 * MiB;
constexpr unsigned WS_WSET1 = 194 * MiB;
constexpr unsigned WS_RM = 236 * MiB, WS_RN = 254 * MiB, WS_RP = 324 * MiB, WS_RH = 342 * MiB;
constexpr int NCHUNK = 2304;
constexpr unsigned WS_U = 128 * MiB;
constexpr unsigned WS_G = 290 * MiB, WS_SB = 299 * MiB, WS_BO = 300 * MiB, WS_END = 360 * MiB;
constexpr int SMALLW_L = 147456;
constexpr int TAB_COSA = 0, TAB_SINA = 1024, TAB_COSB = 2048, TAB_SINB = 2560, TAB_LAM = 3072;
constexpr int LDS_BYTES = 147456;
constexpr int NPHASE = 2 + 9 * DEPTH;

struct Args {
    const float* in[34];
    float* out; unsigned char* ws;
    int ph_lo, ph_hi;
};

struct EpiRes {
    static constexpr bool PERM = true, AFTER_DRAIN = false;
    const float* baseC; const float* baseL; unsigned char* ws; const float* gate; bool first; unsigned xo; bool skip = false;
    template <int MF>
    __device__ __forceinline__ void operator()(const f32x4 (&acc)[2][2][MF][2], const pg8::Unit& u, int wr, int wc, int fr_, int fq_) const {
        if (skip) return;
        int fr = fr_, fq = fq_; asm volatile("" : "+v"(fr), "+v"(fq));
        const unsigned col0 = u.pn * 256 + wc * 32 + 8 * fq, rowb = u.pm * (MF * 64) + wr * (MF * 16);
        f32x4 g4[2][2]; int vcur = -1;
#pragma unroll
        for (int ai = 0; ai < 2; ++ai)
#pragma unroll
            for (int m = 0; m < MF; ++m) { const unsigned rf = rowb + ai * (MF * 32) + m * 16, off = (rf + fr) * DM + col0;
                const int v = rf < MC ? 0 : (rf < MC + 4096 ? 1 : 2);
                if (v != vcur) { vcur = v;
#pragma unroll
                    for (int bj = 0; bj < 2; ++bj)
#pragma unroll
                        for (int n = 0; n < 2; ++n) g4[bj][n] = LDG(f32x4, gate, (v * 6144 + col0 + bj * 128 + n * 4) * 4); }
#pragma unroll
                for (int bj = 0; bj < 2; ++bj) { f32x4 b0, b1;
                    if (first) { const float* base = rf < MC ? baseC : baseL; b0 = LDG(f32x4, base, (off + bj * 128) * 4); b1 = LDG(f32x4, base, (off + bj * 128 + 4) * 4); }
                    else { const u32x4 xb = LDG(u32x4, ws, WS_XB + (off + bj * 128) * 2); b0 = (f32x4){bf_lo(xb.x), bf_hi(xb.x), bf_lo(xb.y), bf_hi(xb.y)}; b1 = (f32x4){bf_lo(xb.z), bf_hi(xb.z), bf_lo(xb.w), bf_hi(xb.w)}; }
                    b0 = b0 + g4[bj][0] * acc[ai][bj][m][0]; b1 = b1 + g4[bj][1] * acc[ai][bj][m][1];
                    u32x4 w; w.x = pk2(b0[0], b0[1]); w.y = pk2(b0[2], b0[3]); w.z = pk2(b1[0], b1[1]); w.w = pk2(b1[2], b1[3]);
                    STG(u32x4, ws, xo + (off + bj * 128) * 2) = w; } }
    }
};
struct EpiSwi {
    static constexpr bool PERM = true, AFTER_DRAIN = false;
    bf16_t* U; bool skip = false;
    template <int MF>
    __device__ __forceinline__ void operator()(const f32x4 (&acc)[2][2][MF][2], const pg8::Unit& u, int wr, int wc, int fr_, int fq_) const {
        if (skip) return;
        int fr = fr_, fq = fq_; asm volatile("" : "+v"(fr), "+v"(fq));
        const unsigned row0 = u.pm * (MF * 64) + wr * (MF * 16) + fr, oc0 = u.pn * 128 + wc * 32 + 8 * fq;
#pragma unroll
        for (int ai = 0; ai < 2; ++ai)
#pragma unroll
            for (int m = 0; m < MF; ++m) { const unsigned ro = ((row0 + ai * (MF * 32) + m * 16) * FF + oc0) * 2; f32x4 o[2];
#pragma unroll
                for (int bj = 0; bj < 2; ++bj) { const f32x4 g = acc[ai][bj][m][0], up = acc[ai][bj][m][1];
#pragma unroll
                    for (int e = 0; e < 4; ++e) o[bj][e] = g[e] * sigmf(g[e]) * up[e]; }
                const u32x2 lo = pack4(o[0]), hi2 = pack4(o[1]);
                STG(u32x4, U, ro) = (u32x4){lo.x, lo.y, hi2.x, hi2.y}; asm volatile("" ::: "memory"); }
    }
};
struct EpiWin {
    static constexpr bool PERM = true, AFTER_DRAIN = false;
    unsigned char* ws; float* out; int l; LAS unsigned char* lds; bool skip = false;
    template <int MF>
    __device__ __forceinline__ void operator()(const f32x4 (&acc)[2][2][MF][2], const pg8::Unit& u, int wr, int wc, int fr_, int fq_) const {
        if (skip) return;
        int fr = fr_, fq = fq_; asm volatile("" : "+v"(fr), "+v"(fq));
        const unsigned rowb = u.pm * (MF * 64) + wr * (MF * 16), row0 = rowb + fr;
#pragma unroll
        for (int bj = 0; bj < 2; ++bj) {
            const unsigned c32 = u.pn * 256 + bj * 128 + wc * 32;
            const unsigned c8 = c32 + 8 * fq;
            if (c32 < 1152 && (c32 < 512 || c32 >= 640)) {
                const bool isA = c32 < 512;
                const bool isK = isA ? (c32 >= 384) : (c32 >= 896);
                const float qs = isK ? 1.f : (isA ? QSCALE_A : QSCALE_B);
                const unsigned ck = isA ? c8 - 384 : c8 - 896;
                const unsigned dbase = isA ? (isK ? WS_KA + (((ck >> 6) * 4 + ((ck & 63) >> 4)) * 64 + ((ck >> 3) & 1) * 32) * 16 : WS_QA + c8 * 2)
                                           : (isK ? WS_KB + (((ck >> 5) * 2 + ((ck & 31) >> 4)) * 64 + ((ck >> 3) & 1) * 32) * 16 : WS_QB + (c8 - 640) * 2);
                const unsigned dpitch = isA ? 768u : 512u;
#pragma unroll
                for (int ai = 0; ai < 2; ++ai)
#pragma unroll
                    for (int m = 0; m < MF; ++m) {
                        const unsigned row = row0 + ai * (MF * 32) + m * 16; const bool lat = rowb + ai * (MF * 32) + m * 16 >= (unsigned)MC;
                        f32x4 v0 = acc[ai][bj][m][0], v1 = acc[ai][bj][m][1];
                        if (lat) {
                            const unsigned t = (row - MC) & 4095, rp = t >> 6, cp = t & 63;
                            unsigned to_;
                            if (isA) { const unsigned pos = ((c32 >> 5) & 1) ? cp : rp; to_ = WS_TAB + (TAB_COSA + pos * 16 + 4 * fq) * 4; }
                            else { const unsigned pos = (fq >> 1) ? cp : rp; to_ = WS_TAB + (TAB_COSB + pos * 8 + 4 * (fq & 1)) * 4; }
                            const f32x4 c4 = LDG(f32x4, ws, to_), s4 = LDG(f32x4, ws, to_ + (isA ? 4096u : 2048u));
                            f32x4 w0, w1;
                            w0[0] = v0[0] * c4[0] - v0[1] * s4[0]; w0[1] = v0[1] * c4[0] + v0[0] * s4[0];
                            w0[2] = v0[2] * c4[1] - v0[3] * s4[1]; w0[3] = v0[3] * c4[1] + v0[2] * s4[1];
                            w1[0] = v1[0] * c4[2] - v1[1] * s4[2]; w1[1] = v1[1] * c4[2] + v1[0] * s4[2];
                            w1[2] = v1[2] * c4[3] - v1[3] * s4[3]; w1[3] = v1[3] * c4[3] + v1[2] * s4[3];
                            v0 = w0; v1 = w1;
                        } else if (isK) {
                            const unsigned b = row >> 8, t = row & 255;
                            const f32x4 ev = {v0[0], v0[2], v1[0], v1[2]}, od = {v0[1], v0[3], v1[1], v1[3]};
                            if (isA) { const unsigned o = (OFF_AK + ((b * 4 + l) * 256 + t) * 128 + (c32 - 384) + 4 * fq) * 4; STG(f32x4, out, o) = ev; STG(f32x4, out, o + 64) = od; }
                            else { const unsigned o = (OFF_BK + ((b * 4 + l) * 256 + t) * 256 + ((c8 - 896) & ~15u) + 4 * (fq & 1)) * 4; STG(f32x4, out, o) = ev; STG(f32x4, out, o + 32) = od; }
                        }
                        v0 = v0 * qs; v1 = v1 * qs;
                        u32x4 w; w.x = pk2(v0[0], v0[1]); w.y = pk2(v0[2], v0[3]); w.z = pk2(v1[0], v1[1]); w.w = pk2(v1[2], v1[3]);
                        STG(u32x4, ws, isK ? dbase + (row >> 5) * (isA ? 8192u : 16384u) + (row & 31) * 16 : dbase + row * dpitch) = w;
                        asm volatile("" ::: "memory");
                    }
            } else if (c32 < 1408) {
                const bool isA = c32 < 640;
                const unsigned cc = isA ? (c8 - 512) : (c8 - 1152), cw = isA ? (c32 - 512) : (c32 - 1152);
                const unsigned vfrag = (isA ? WS_VTA : WS_VTB) + (((cw >> 6) * 2 + ((cw >> 5) & 1)) * 2) * 1024;
                LAS unsigned char* lw = lds + (wr * 4 + wc) * 1024;
                LAS bf16_t* lq = (LAS bf16_t*)(lw + ((((fr >> 2) & 1) * 32 + 8 * fq) * 16 + (4 * (fr >> 3) + (fr & 3)) * 2));
#pragma unroll
                for (int ai = 0; ai < 2; ++ai)
#pragma unroll
                    for (int m = 0; m < MF; ++m) {
                        const unsigned rf = rowb + ai * (MF * 32) + m * 16, row = rf + fr; const bool lat = rf >= (unsigned)MC;
                        const f32x4 v0 = acc[ai][bj][m][0], v1 = acc[ai][bj][m][1];
                        if (!lat) { const unsigned b = row >> 8, t = row & 255;
                            const unsigned o = isA ? (OFF_AV + ((b * 4 + l) * 256 + t) * 128 + cc) * 4 : (OFF_BV + ((b * 4 + l) * 256 + t) * 256 + cc) * 4;
                            STG(f32x4, out, o) = v0; STG(f32x4, out, o + 16) = v1; }
                        const unsigned p0 = pk2(v0[0], v0[1]), p1 = pk2(v0[2], v0[3]), p2 = pk2(v1[0], v1[1]), p3 = pk2(v1[2], v1[3]);
                        lq[0 * 8] = (bf16_t)(p0 & 0xffff); lq[1 * 8] = (bf16_t)(p0 >> 16); lq[2 * 8] = (bf16_t)(p1 & 0xffff); lq[3 * 8] = (bf16_t)(p1 >> 16);
                        lq[4 * 8] = (bf16_t)(p2 & 0xffff); lq[5 * 8] = (bf16_t)(p2 >> 16); lq[6 * 8] = (bf16_t)(p3 & 0xffff); lq[7 * 8] = (bf16_t)(p3 >> 16);
                        const u32x4 tv = *(const LAS u32x4*)(lw + (fq * 16 + fr) * 16);
                        STG(u32x4, ws, vfrag + (rf >> 5) * (isA ? 8192u : 16384u) + ((rf >> 4) & 1) * 1024 + (fq * 16 + fr) * 16) = tv;
                        asm volatile("" ::: "memory");
                    }
            } else if (c32 < 2944) {
                const int kind = c32 < 2560 ? 0 : (c32 < 2688 ? 1 : (c32 < 2816 ? 2 : 3));
                const unsigned dbase = kind == 0 ? WS_RKV + (c8 - 1408) * 2 : (kind == 1 ? WS_CW + (c8 - 2560) * 2 : (kind == 2 ? WS_CA + (c8 - 2688) * 2 : WS_CG + (c8 - 2816) * 2));
                const unsigned dpitch = kind == 0 ? 2304u : 256u;
#pragma unroll
                for (int ai = 0; ai < 2; ++ai)
#pragma unroll
                    for (int m = 0; m < MF; ++m) {
                        const unsigned row = row0 + ai * (MF * 32) + m * 16; const bool lat = rowb + ai * (MF * 32) + m * 16 >= (unsigned)MC;
                        f32x4 v0 = acc[ai][bj][m][0], v1 = acc[ai][bj][m][1];
                        if (kind == 1) {
#pragma unroll
                            for (int e = 0; e < 4; ++e) { v0[e] = 1.f - 2.f * __builtin_amdgcn_rcpf(__expf(2.f * v0[e]) + 1.f); v1[e] = 1.f - 2.f * __builtin_amdgcn_rcpf(__expf(2.f * v1[e]) + 1.f); }
                        } else if (kind == 3) {
#pragma unroll
                            for (int e = 0; e < 4; ++e) { v0[e] = sigmf(v0[e]); v1[e] = sigmf(v1[e]); }
                        }
                        u32x4 w; w.x = pk2(v0[0], v0[1]); w.y = pk2(v0[2], v0[3]); w.z = pk2(v1[0], v1[1]); w.w = pk2(v1[2], v1[3]);
                        STG(u32x4, ws, dbase + row * dpitch) = w;
                        asm volatile("" ::: "memory");
                    }
            }
        }
    }
};

struct Frame {
    LAS unsigned char* lds;
    const float* const* in;
    float* out; unsigned char* ws;
    int tid, lane, wave, gw, ngw, G, bid;
};
#define GAS __attribute__((address_space(1)))
template <class T> __device__ __forceinline__ T* gptr(T* p) {
#if defined(__HIP_DEVICE_COMPILE__)
    __builtin_assume(!__builtin_amdgcn_is_shared((const void*)p)); __builtin_assume(!__builtin_amdgcn_is_private((const void*)p));
#endif
    return p; }
#define INP(k) gptr(F.in[k])
#define WSP(T, off) gptr((T*)(F.ws + (off)))

__device__ __forceinline__ void phase_prologue(Frame& F) {
    const float* cvec = INP(8); const float* cctx = INP(9); const float* ada_w = INP(10); const float* ada_b = INP(11);
    LAS float* sl = (LAS float*)F.lds;
    LAS float* red = (LAS float*)(F.lds + 16384);
    for (int i = F.tid; i < 3072; i += 512) { const int v = i >> 10, k = i & 1023; const float x = v == 0 ? cctx[k] : cvec[(v - 1) * 1024 + k]; sl[i] = x / (1.f + __expf(-x)); }
    __syncthreads();
    float* mod = WSP(float, WS_MOD);
    for (int it = F.bid; it < 384; it += F.G) {
        const int l = it / 96, n0 = (it % 96) * 64;
        const float* W = ada_w + (size_t)l * 1024 * 6144 + n0 + F.lane;
        float a0 = 0.f, a1 = 0.f, a2 = 0.f;
        const int k0 = F.wave * 128;
#pragma unroll 8
        for (int k = k0; k < k0 + 128; ++k) { const float w = *(const GAS float*)(W + (size_t)k * 6144); a0 += sl[k] * w; a1 += sl[1024 + k] * w; a2 += sl[2048 + k] * w; }
        red[(F.wave * 3 + 0) * 64 + F.lane] = a0; red[(F.wave * 3 + 1) * 64 + F.lane] = a1; red[(F.wave * 3 + 2) * 64 + F.lane] = a2;
        __syncthreads();
        if (F.wave < 3) { float s = ada_b[l * 6144 + n0 + F.lane];
#pragma unroll
            for (int w = 0; w < 8; ++w) s += red[(w * 3 + F.wave) * 64 + F.lane];
            mod[(size_t)(l * 3 + F.wave) * 6144 + n0 + F.lane] = s; }
        __syncthreads();
    }
    float* tab = WSP(float, WS_TAB);
    if (F.bid == F.G - 1) {
        for (int i = F.tid; i < 1024; i += 512) { const int pos = i >> 4, f = i & 15; const float ang = (float)pos * __builtin_amdgcn_exp2f(-(float)f * (13.287712379549449f / 16.f)); tab[TAB_COSA + i] = __cosf(ang); tab[TAB_SINA + i] = __sinf(ang); }
        for (int i = F.tid; i < 512; i += 512) { const int pos = i >> 3, f = i & 7; const float ang = (float)pos * __builtin_amdgcn_exp2f(-(float)f * (13.287712379549449f / 8.f)); tab[TAB_COSB + i] = __cosf(ang); tab[TAB_SINB + i] = __sinf(ang); }
        if (F.wave < 4) { const float* lp = INP(16) + F.wave * 128; const int d = F.lane & 31;
            const float p1 = wave_sum(F.lane < 32 ? lp[d] * lp[32 + d] : 0.f), p2 = wave_sum(F.lane < 32 ? 0.f : lp[64 + d] * lp[96 + d]);
            if (F.lane == 0) tab[TAB_LAM + F.wave] = __expf(p1) - __expf(p2); }
    }
    const int gtid = F.bid * 512 + F.tid, gnt = F.G * 512;
    { bf16_t* sw = WSP(bf16_t, WS_SMALLW); const float* cw2 = INP(20); const float* ca2 = INP(22); const float* cg2 = INP(23);
      for (int idx = gtid; idx < 4 * SMALLW_L; idx += gnt) { const int l = idx / SMALLW_L, r = idx % SMALLW_L; float v;
          if (r < 98304) { const int which = r / 49152, rr = r % 49152, d = rr / 24576, ch = (rr % 24576) / 64, k = rr % 64; v = (which ? ca2 : cw2)[((size_t)(l * 2 + d) * 64 + k) * 384 + ch]; }
          else { const int rr = r - 98304, ch = rr / 128, k = rr % 128; v = cg2[((size_t)l * 128 + k) * 384 + ch]; }
          sw[idx] = (bf16_t)(pk2(v, 0.f) & 0xffff); } }
    { bf16_t* kca = WSP(bf16_t, WS_CACHE); bf16_t* vca = kca + 524288; bf16_t* kcb = vca + 524288; bf16_t* vcb = kcb + 1048576;
      const float* cak = INP(2); const float* cav = INP(3); const float* cbk = INP(4); const float* cbv = INP(5);
      for (int e = gtid; e < 524288; e += gnt) {
          const int j = e & 7, ln = (e >> 3) & 63, hi = ln >> 5, r32 = ln & 31, blk = (e >> 12) & 15, bl = e >> 16;
          { const int s = (e >> 9) & 3, kvh = (e >> 11) & 1, cp = kvh * 64 + 16 * s + 8 * hi + j, o = cp & 31, c = (cp - o) + (o >> 1) + 16 * (o & 1);
            kca[e] = (bf16_t)(pk2(cak[((size_t)bl * 512 + blk * 32 + r32) * 128 + c], 0.f) & 0xffff); }
          { const int ks = (e >> 9) & 1, db = (e >> 10) & 1, kvh = (e >> 11) & 1, key = blk * 32 + 16 * ks + 8 * (j >> 2) + 4 * hi + (j & 3);
            vca[e] = (bf16_t)(pk2(cav[((size_t)bl * 512 + key) * 128 + kvh * 64 + db * 32 + r32], 0.f) & 0xffff); } }
      for (int e = gtid; e < 1048576; e += gnt) {
          const int j = e & 7, ln = (e >> 3) & 63, hi = ln >> 5, r32 = ln & 31, blk = (e >> 13) & 15, bl = e >> 17;
          { const int s = (e >> 9) & 1, hm = (e >> 10) & 7, cp = hm * 32 + 16 * s + 8 * hi + j, o = cp & 15, c = (cp - o) + (o >> 1) + 8 * (o & 1);
            kcb[e] = (bf16_t)(pk2(cbk[((size_t)bl * 512 + blk * 32 + r32) * 256 + c], 0.f) & 0xffff); }
          { const int ks = (e >> 9) & 1, db = (e >> 10) & 1, h = (e >> 11) & 3, key = blk * 32 + 16 * ks + 8 * (j >> 2) + 4 * hi + (j & 3);
            vcb[e] = (bf16_t)(pk2(cbv[((size_t)bl * 512 + key) * 256 + h * 64 + db * 32 + r32], 0.f) & 0xffff); } } }
    for (int st = 0; st < 1; ++st) { u32x4* z = (u32x4*)(WSP(bf16_t, WS_WIN + st * WSET_STRIDE) + (size_t)2944 * 1024); unsigned z0; asm volatile("v_mov_b32 %0, 0" : "=v"(z0)); for (int i = gtid; i < 128 * 1024 / 8; i += gnt) z[i] = (u32x4){z0, z0, z0, z0}; }
}

template <int MAP> __device__ __forceinline__ int dest_row(int n) {
    if (MAP == 1) {
        if (n < 512) { const int o = n & 31; return (n - o) + 2 * (o & 15) + (o >> 4); }
        if (n >= 640 && n < 1152) { const int o = n & 15; return (n - o) + 2 * (o & 7) + (o >> 3); }
        return n;
    }
    if (MAP == 2 || MAP == 3) return (n >> 7) * 256 + ((n >> 2) & 1) * 128 + ((n >> 5) & 3) * 32 + ((n >> 3) & 3) * 8 + (MAP == 3 ? 4 : 0) + (n & 3);
    return n;
}
template <int MAP> __device__ __forceinline__ void transpose_item(const float* W, int K, int N, bf16_t* WT, LAS float* scr, int item, int lane) {
    const int nblk = N / 32, kb = item / nblk, nb = item % nblk, k0 = 64 * kb, n0 = 32 * nb;
#pragma unroll 8
    for (int i = 0; i < 32; ++i) { const int kk = 2 * i + (lane >> 5); scr[kk * 33 + (lane & 31)] = *(const GAS float*)(W + (size_t)(k0 + kk) * N + n0 + (lane & 31)); }
    asm volatile("s_waitcnt lgkmcnt(0)" ::: "memory");
    const int c = lane & 7;
#pragma unroll
    for (int j = 0; j < 4; ++j) { const int n = (lane >> 3) + 8 * j; const LAS float* s = scr + (8 * c) * 33 + n;
        u32x4 o; o.x = pk2(s[0 * 33], s[1 * 33]); o.y = pk2(s[2 * 33], s[3 * 33]); o.z = pk2(s[4 * 33], s[5 * 33]); o.w = pk2(s[6 * 33], s[7 * 33]);
        *(GAS u32x4*)(WT + (size_t)dest_row<MAP>(n0 + n) * K + k0 + 8 * c) = o; }
    asm volatile("s_waitcnt lgkmcnt(0)" ::: "memory");
}
template <int MAP> __device__ __forceinline__ void convert_item(const float* W, int K, int N, bf16_t* WT, int item, int lane) {
    const int nblk = N / 64, kb = item / nblk, nb = item % nblk, n = nb * 64 + lane;
    const GAS float* src = (const GAS float*)W + (size_t)(kb * 128) * N + n;
    GAS bf16_t* dst = (GAS bf16_t*)WT + (size_t)dest_row<MAP>(n) * K + kb * 128;
#pragma unroll
    for (int g = 0; g < 16; ++g) { float v[8];
#pragma unroll
        for (int e = 0; e < 8; ++e) v[e] = src[(size_t)(8 * g + e) * N];
        u32x4 o; o.x = pk2(v[0], v[1]); o.y = pk2(v[2], v[3]); o.z = pk2(v[4], v[5]); o.w = pk2(v[6], v[7]);
        *(GAS u32x4*)(dst + 8 * g) = o; }
}
constexpr int CV_IN = 46 * 8, CV_OUT = 16 * 8, CV_1 = 44 * 8, CV_2 = 16 * 22, CV_TOTAL = CV_IN + CV_OUT + 2 * CV_1 + CV_2;
__device__ __forceinline__ void convert_item_any(Frame& F, int l, int it) {
    const unsigned so = 0u * WSET_STRIDE;
    int r = it;
    if (r < CV_IN) { convert_item<1>(INP(14) + (size_t)l * 1024 * 2944, 1024, 2944, WSP(bf16_t, WS_WIN + so), r, F.lane); return; } r -= CV_IN;
    if (r < CV_OUT) { convert_item<0>(INP(29) + (size_t)l * 1024 * 1024, 1024, 1024, WSP(bf16_t, WS_WOUT + so), r, F.lane); return; } r -= CV_OUT;
    if (r < CV_1) { convert_item<2>(INP(30) + (size_t)l * 1024 * FF, 1024, FF, WSP(bf16_t, WS_W13 + so), r, F.lane); return; } r -= CV_1;
    if (r < CV_1) { convert_item<3>(INP(31) + (size_t)l * 1024 * FF, 1024, FF, WSP(bf16_t, WS_W13 + so), r, F.lane); return; } r -= CV_1;
    convert_item<0>(INP(32) + (size_t)l * FF * 1024, FF, 1024, WSP(bf16_t, WS_W2 + so), r, F.lane);
}
__device__ __forceinline__ void convert_weights(Frame& F, int l) {
    LAS float* scr = (LAS float*)(F.lds + F.wave * 16384); const unsigned so = 0u * WSET_STRIDE;
    const float* w_in = INP(14) + (size_t)l * 1024 * 2944; const float* w_out = INP(29) + (size_t)l * 1024 * 1024;
    const float* w1 = INP(30) + (size_t)l * 1024 * FF; const float* w3 = INP(31) + (size_t)l * 1024 * FF; const float* w2 = INP(32) + (size_t)l * FF * 1024;
    constexpr int I_IN = 16 * 92, I_OUT = 16 * 32, I_1 = 16 * 88, I_2 = 44 * 32;
    constexpr int NIT = I_IN + I_OUT + 2 * I_1 + I_2;
    for (int it = F.gw; it < NIT; it += F.ngw) {
        int r = it;
        if (r < I_IN) { transpose_item<1>(w_in, 1024, 2944, WSP(bf16_t, WS_WIN + so), scr, r, F.lane); continue; } r -= I_IN;
        if (r < I_OUT) { transpose_item<0>(w_out, 1024, 1024, WSP(bf16_t, WS_WOUT + so), scr, r, F.lane); continue; } r -= I_OUT;
        if (r < I_1) { transpose_item<2>(w1, 1024, FF, WSP(bf16_t, WS_W13 + so), scr, r, F.lane); continue; } r -= I_1;
        if (r < I_1) { transpose_item<3>(w3, 1024, FF, WSP(bf16_t, WS_W13 + so), scr, r, F.lane); continue; } r -= I_1;
        transpose_item<0>(w2, FF, 1024, WSP(bf16_t, WS_W2 + so), scr, r, F.lane);
    }
}

__device__ __forceinline__ void phase_norm(Frame& F, int l, int which  ) {
    const float* g = (which ? INP(13) : INP(12)) + l * 1024;
    const float* mod = WSP(float, WS_MOD) + (size_t)l * 3 * 6144 + (which ? 3072 : 0);
    bf16_t* H = WSP(bf16_t, WS_ACT);
    const bool first = (l == 0 && which == 0);
    f32x4 gv[4];
#pragma unroll
    for (int j = 0; j < 4; ++j) gv[j] = *(const GAS f32x4*)(g + 4 * F.lane + 256 * j);
    for (int row = F.gw; row < M; row += F.ngw) {
        const float* mv = mod + (row < MC ? 0 : (row < 2 * MC ? 1 : 2)) * 6144;
        f32x4 v[4]; float ss = 0.f;
        if (first) { const float* xr = row < MC ? INP(0) + (size_t)row * DM : INP(1) + (size_t)(row - MC) * DM;
#pragma unroll
            for (int j = 0; j < 4; ++j) v[j] = *(const GAS f32x4*)(xr + 4 * F.lane + 256 * j); }
        else {
#pragma unroll
            for (int j = 0; j < 4; ++j) v[j] = unpack4(LDG(u32x2, F.ws, WS_XB + ((unsigned)row * DM + 4 * F.lane + 256 * j) * 2)); }
#pragma unroll
        for (int j = 0; j < 4; ++j) ss += (v[j][0] * v[j][0] + v[j][1] * v[j][1]) + (v[j][2] * v[j][2] + v[j][3] * v[j][3]);
        const float rstd = rsqrtf(wave_sum(ss) * (1.f / 1024.f) + 1e-6f);
#pragma unroll
        for (int j = 0; j < 4; ++j) { const f32x4 sh = *(const GAS f32x4*)(mv + 4 * F.lane + 256 * j), sc = *(const GAS f32x4*)(mv + 1024 + 4 * F.lane + 256 * j);
            const f32x4 h = v[j] * rstd * gv[j] * (sc + 1.f) + sh;
            *(GAS u32x2*)(H + (size_t)row * DM + 4 * F.lane + 256 * j) = pack4(h); }
    }
}
__device__ __forceinline__ void phase_final_norm(Frame& F) {
    const float* g = INP(33);
    f32x4 gv[4];
#pragma unroll
    for (int j = 0; j < 4; ++j) gv[j] = *(const GAS f32x4*)(g + 4 * F.lane + 256 * j);
    for (int row = F.gw; row < M; row += F.ngw) {
        float* xr = gptr(F.out + (size_t)row * DM);
        f32x4 v[4]; float ss = 0.f;
#pragma unroll
        for (int j = 0; j < 4; ++j) { v[j] = unpack4(LDG(u32x2, F.ws, WS_XB + ((unsigned)row * DM + 4 * F.lane + 256 * j) * 2)); ss += (v[j][0] * v[j][0] + v[j][1] * v[j][1]) + (v[j][2] * v[j][2] + v[j][3] * v[j][3]); }
        const float rstd = rsqrtf(wave_sum(ss) * (1.f / 1024.f) + 1e-6f);
#pragma unroll
        for (int j = 0; j < 4; ++j) *(GAS f32x4*)(xr + 4 * F.lane + 256 * j) = v[j] * rstd * gv[j];
    }
}

#define MFMA32(a, b, c) __builtin_amdgcn_mfma_f32_32x32x16_bf16((a), (b), (c), 0, 0, 0)
#ifndef ATT_PROBE
#define ATT_PROBE 0
#endif
struct AttnQ { float m, l; bool mz; f32x16 o[2]; };
template <int DQK, bool MASK, int NQ>
__device__ __forceinline__ void attn_block(const bf16x8 (&qf)[NQ][DQK / 16], const bf16x8 (&kf)[DQK / 16], const bf16x8 (&vf)[4], AttnQ (&st)[NQ], int b, const int (&qpos)[NQ], int kpos0, int hi) {
    constexpr int NS = DQK / 16;
    f32x16 sc[NQ];
#pragma unroll
    for (int q = 0; q < NQ; ++q) { const f32x16 z = {}; sc[q] = MFMA32(kf[0], qf[q][0], z);
#pragma unroll
        for (int s = 1; s < NS; ++s) sc[q] = MFMA32(kf[s], qf[q][s], sc[q]); }
#pragma unroll
    for (int q = 0; q < NQ; ++q) {
        if (!st[q].mz) {
#pragma unroll
            for (int r = 0; r < 16; ++r) sc[q][r] -= st[q].m; }
        if (MASK) {
#pragma unroll
            for (int r = 0; r < 16; ++r) { const int key = kpos0 + 32 * b + (r & 3) + 8 * (r >> 2) + 4 * hi; const int dlt = key - qpos[q]; if (dlt > 128 || dlt < -128) sc[q][r] = -1e30f; }
        }
        float bm = fmaxf(fmaxf(sc[q][0], sc[q][1]), sc[q][2]);
#pragma unroll
        for (int r = 3; r < 15; r += 2) bm = fmaxf(fmaxf(bm, sc[q][r]), sc[q][r + 1]);
        bm = fmaxf(bm, sc[q][15]);
        bm = swap32_max(bm);
        if (__builtin_amdgcn_ballot_w64(bm > 64.f) != 0ull) {
            const float d = fmaxf(bm, 0.f);
            const float alpha = __builtin_amdgcn_exp2f(-d);
            st[q].m += d; st[q].l *= alpha; st[q].mz = false;
#pragma unroll
            for (int r = 0; r < 16; ++r) { st[q].o[0][r] *= alpha; st[q].o[1][r] *= alpha; sc[q][r] -= d; }
        }
#if ATT_PROBE == 1
        { float dmy = 0.f;
#pragma unroll
          for (int r = 0; r < 16; ++r) { float e_; asm volatile("v_exp_f32 %0, %1" : "=v"(e_) : "v"(sc[q][r])); dmy += e_; }
          asm volatile("" :: "v"(dmy)); }
#endif
        f32x2 rs2 = {0.f, 0.f};
#pragma unroll
        for (int r = 0; r < 16; r += 2) { sc[q][r] = __builtin_amdgcn_exp2f(sc[q][r]); sc[q][r + 1] = __builtin_amdgcn_exp2f(sc[q][r + 1]); rs2 += (f32x2){sc[q][r], sc[q][r + 1]}; }
        st[q].l += rs2[0] + rs2[1];
#if ATT_PROBE == 3
        { float d0 = 0.f, d1 = 0.f, d2 = 0.f, d3 = 0.f;
#pragma unroll
          for (int rr = 0; rr < 10; ++rr) { asm volatile("v_add_f32 %0, %0, %4\n\tv_add_f32 %1, %1, %5\n\tv_add_f32 %2, %2, %6\n\tv_add_f32 %3, %3, %7" : "+v"(d0), "+v"(d1), "+v"(d2), "+v"(d3) : "v"(sc[q][0]), "v"(sc[q][1]), "v"(sc[q][2]), "v"(sc[q][3])); }
          asm volatile("" :: "v"(d0), "v"(d1), "v"(d2), "v"(d3)); }
#endif
#if ATT_PROBE == 2
        { f32x16 dm = sc[q]; dm = MFMA32(kf[0], qf[q][0], dm); dm = MFMA32(kf[0], qf[q][0], dm); dm = MFMA32(kf[0], qf[q][0], dm); asm volatile("" :: "v"(dm)); }
#endif
        bf16x8 pb[2];
#pragma unroll
        for (int ks = 0; ks < 2; ++ks) { u32x4 w; w.x = pk2(sc[q][8 * ks], sc[q][8 * ks + 1]); w.y = pk2(sc[q][8 * ks + 2], sc[q][8 * ks + 3]); w.z = pk2(sc[q][8 * ks + 4], sc[q][8 * ks + 5]); w.w = pk2(sc[q][8 * ks + 6], sc[q][8 * ks + 7]); pb[ks] = __builtin_bit_cast(bf16x8, w); }
#pragma unroll
        for (int db = 0; db < 2; ++db)
#pragma unroll
            for (int ks = 0; ks < 2; ++ks) st[q].o[db] = MFMA32(vf[db * 2 + ks], pb[ks], st[q].o[db]);
    }
}
template <int DQK, bool MASK, int NQ>
__device__ __forceinline__ void attn_seg(const unsigned char* ws, const bf16x8 (&qf)[NQ][DQK / 16], AttnQ (&st)[NQ],
                                         unsigned kp, unsigned kblk  , unsigned vp, unsigned vblk, int nblk, const int (&qpos)[NQ], int kpos0, int hi) {
    constexpr int NS = DQK / 16;
    const GAS unsigned char* kq = (const GAS unsigned char*)ws + kp; const GAS unsigned char* vq = (const GAS unsigned char*)ws + vp;
    bf16x8 ka[NS], va[4], kb[NS], vb[4];
#define ATT_LOAD(kd, vd) do { _Pragma("unroll") for (int s = 0; s < NS; ++s) kd[s] = *(const GAS bf16x8*)(kq + 1024 * s); _Pragma("unroll") for (int f = 0; f < 4; ++f) vd[f] = *(const GAS bf16x8*)(vq + 1024 * f); } while (0)
    ATT_LOAD(ka, va);
    int b = 0;
    for (; b + 1 < nblk; b += 2) {
        kq += kblk; vq += vblk; ATT_LOAD(kb, vb);
        attn_block<DQK, MASK, NQ>(qf, ka, va, st, b, qpos, kpos0, hi);
        if (b + 2 < nblk) { kq += kblk; vq += vblk; }
        ATT_LOAD(ka, va);
        attn_block<DQK, MASK, NQ>(qf, kb, vb, st, b + 1, qpos, kpos0, hi);
    }
    if (b < nblk) attn_block<DQK, MASK, NQ>(qf, ka, va, st, b, qpos, kpos0, hi);
#undef ATT_LOAD
}
__device__ __forceinline__ void attnq_init(AttnQ& s, float l0) { s.m = 0.f; s.mz = true; s.l = l0; s.o[0] = (f32x16){}; s.o[1] = (f32x16){}; }
__device__ __forceinline__ void attn_a_item(Frame& F, int l, bool lat, int item) {
    int lane = F.lane; asm volatile("" : "+v"(lane));
    const unsigned char* ws = F.ws;
    const unsigned r32 = lane & 31, hi = lane >> 5;
    const unsigned nqb = lat ? 128 : 8;
    const unsigned qb = item % nqb, hq = (item / nqb) % 6, b = item / (nqb * 6), kvh = hq / 3;
    const unsigned seq0 = lat ? MC + b * 4096 : b * 256, q0 = qb * 32, row = seq0 + q0 + r32;
    const unsigned qo = WS_QA + (row * 384 + hq * 64 + 8 * hi) * 2;
    bf16x8 qf[1][4];
#pragma unroll
    for (int s = 0; s < 4; ++s) qf[0][s] = LDG(bf16x8, ws, qo + 32 * s);
    AttnQ st[1]; attnq_init(st[0], hi == 0 ? __builtin_amdgcn_exp2f(INP(15)[l * 6 + hq] * LOG2E) : 0.f);
    const int qpos[1] = {(int)(q0 + r32)};
    const unsigned fo = kvh * 4096 + lane * 16;
    if (!lat) {
        attn_seg<64, false, 1>(ws, qf, st, WS_KA + (seq0 >> 5) * 8192 + fo, 8192, WS_VTA + (seq0 >> 5) * 8192 + fo, 8192, 8, qpos, 0, hi);
    } else {
        const int ks = (int)q0 - 128 < 0 ? 0 : (int)q0 - 128, ke = q0 + 160 > 4096 ? 4096 : q0 + 160;
        attn_seg<64, true, 1>(ws, qf, st, WS_KA + ((seq0 + ks) >> 5) * 8192 + fo, 8192, WS_VTA + ((seq0 + ks) >> 5) * 8192 + fo, 8192, (ke - ks) >> 5, qpos, ks, hi);
        attn_seg<64, false, 1>(ws, qf, st, WS_CACHE + (b * 4 + l) * 131072 + fo, 8192, WS_CACHE + 1 * MiB + (b * 4 + l) * 131072 + fo, 8192, 16, qpos, 0, hi);
    }
    const float rl = 1.f / swap32_sum(st[0].l);
    const unsigned oo = WS_ACT + (row * DM + hq * 64 + 4 * hi) * 2;
#pragma unroll
    for (int db = 0; db < 2; ++db)
#pragma unroll
        for (int g = 0; g < 4; ++g) { const f32x4 v = {st[0].o[db][4 * g] * rl, st[0].o[db][4 * g + 1] * rl, st[0].o[db][4 * g + 2] * rl, st[0].o[db][4 * g + 3] * rl}; STG(u32x2, F.ws, oo + (32 * db + 8 * g) * 2) = pack4(v); }
}
__device__ __forceinline__ void attn_b_store(Frame& F, const AttnQ& s, unsigned mp, unsigned kh, unsigned row, unsigned h, unsigned hi) {
    const float lt = swap32_sum(s.l);
    const unsigned oo = WS_BO2 + (((mp * 2 + kh) * M + row) * 256 + h * 64 + 4 * hi) * 2;
#pragma unroll
    for (int db = 0; db < 2; ++db)
#pragma unroll
        for (int g = 0; g < 4; ++g) STG(u32x2, F.ws, oo + (32 * db + 8 * g) * 2) = pack4((f32x4){s.o[db][4 * g], s.o[db][4 * g + 1], s.o[db][4 * g + 2], s.o[db][4 * g + 3]});
    if (hi == 0) STG(f32x2, F.ws, WS_ML + ((((mp * 2 + kh) * M + row) * 4 + h) * 2) * 4) = (f32x2){s.m, lt};
}
__device__ __forceinline__ void attn_b_item(Frame& F, int l, bool lat, int item) {
    int lane = F.lane; asm volatile("" : "+v"(lane));
    const unsigned char* ws = F.ws;
    const unsigned r32 = lane & 31, hi = lane >> 5;
    if (lat) {
        const unsigned kh = item & 1, qb = (item >> 1) & 63, mp = (item >> 7) & 1, h = (item >> 8) & 3, b = item >> 10;
        const unsigned seq0 = MC + b * 4096, row0 = seq0 + qb * 64 + r32;
        bf16x8 qf[2][2];
#pragma unroll
        for (int q = 0; q < 2; ++q)
#pragma unroll
            for (int s = 0; s < 2; ++s) qf[q][s] = LDG(bf16x8, ws, WS_QB + ((row0 + 32 * q) * 256 + h * 64 + mp * 32 + 8 * hi) * 2 + 32 * s);
        AttnQ st[2]; attnq_init(st[0], 0.f); attnq_init(st[1], 0.f);
        const int qpos[2] = {0, 0};
        const unsigned kfo = (h * 2 + mp) * 2048 + lane * 16, vfo = h * 4096 + lane * 16;
        const unsigned blk0 = kh ? 72u : 0u, nb = kh ? 56 : 72;
        attn_seg<32, false, 2>(ws, qf, st, WS_KB + ((seq0 >> 5) + blk0) * 16384 + kfo, 16384, WS_VTB + ((seq0 >> 5) + blk0) * 16384 + vfo, 16384, nb, qpos, 0, hi);
        if (kh) attn_seg<32, false, 2>(ws, qf, st, WS_CACHE + 2 * MiB + (b * 4 + l) * 262144 + kfo, 16384, WS_CACHE + 4 * MiB + (b * 4 + l) * 262144 + vfo, 16384, 16, qpos, 0, hi);
        attn_b_store(F, st[0], mp, kh, row0, h, hi); attn_b_store(F, st[1], mp, kh, row0 + 32, h, hi);
    } else {
        const unsigned qb = item & 7, mp = (item >> 3) & 1, h = (item >> 4) & 3, b = item >> 6;
        const unsigned seq0 = b * 256, row = seq0 + qb * 32 + r32;
        bf16x8 qf[1][2];
#pragma unroll
        for (int s = 0; s < 2; ++s) qf[0][s] = LDG(bf16x8, ws, WS_QB + (row * 256 + h * 64 + mp * 32 + 8 * hi) * 2 + 32 * s);
        AttnQ st[1]; attnq_init(st[0], 0.f);
        const int qpos[1] = {0};
        const unsigned kfo = (h * 2 + mp) * 2048 + lane * 16, vfo = h * 4096 + lane * 16;
        attn_seg<32, false, 1>(ws, qf, st, WS_KB + (seq0 >> 5) * 16384 + kfo, 16384, WS_VTB + (seq0 >> 5) * 16384 + vfo, 16384, 8, qpos, 0, hi);
        attn_b_store(F, st[0], mp, 0, row, h, hi);
    }
}

constexpr int L_KT = 0, L_RT = 9216, L_BT = 18432, L_KK = 27648, L_VT = 36864, L_KKT = 46080, L_BTT = 55296, L_A1 = 64512, L_RHS2 = 81920, L_WT = 99328, L_U0T = 108544, L_GC = 117760, L_X0 = 118016;
constexpr int RPB = 144, RPF = 272;
__device__ __forceinline__ void chunk_decode(int cid, unsigned& seq0, int& T, unsigned& b, unsigned& h, unsigned& dir, int& c) {
    unsigned chain;
    if (cid < 768) { chain = (unsigned)cid >> 2; c = cid & 3; T = 256; b = chain / 12; seq0 = b * 256; }
    else { const unsigned x = (unsigned)cid - 768; chain = x >> 6; c = (int)(x & 63); T = 4096; b = chain / 12; seq0 = MC + b * 4096; }
    dir = chain & 1; h = (chain >> 1) % 6;
}
__device__ __forceinline__ bf16x8 acc_frag(const f32x16& x, int ks, float sgn) {
    u32x4 w; w.x = pk2(sgn * x[8 * ks], sgn * x[8 * ks + 1]); w.y = pk2(sgn * x[8 * ks + 2], sgn * x[8 * ks + 3]); w.z = pk2(sgn * x[8 * ks + 4], sgn * x[8 * ks + 5]); w.w = pk2(sgn * x[8 * ks + 6], sgn * x[8 * ks + 7]);
    return __builtin_bit_cast(bf16x8, w);
}
__device__ __forceinline__ bf16x8 lds_frag_nat(const LAS unsigned char* img, unsigned row, int ks, unsigned hi) { return *(const LAS bf16x8*)(img + row * RPB + (16 * ks + 8 * hi) * 2); }
__device__ __forceinline__ bf16x8 lds_frag_perm(const LAS unsigned char* img, unsigned row, int k0, unsigned hi) {
    const s16x4 a = *(const LAS s16x4*)(img + row * RPB + (k0 + 4 * hi) * 2), b = *(const LAS s16x4*)(img + row * RPB + (k0 + 8 + 4 * hi) * 2);
    return (bf16x8){a[0], a[1], a[2], a[3], b[0], b[1], b[2], b[3]};
}
__device__ __forceinline__ f32x16 gram_tile(const LAS unsigned char* lds, int aimg, int bimg, int sb, int tb, unsigned r32, unsigned hi, bool strict) {
    f32x16 acc = {};
#pragma unroll
    for (int ks = 0; ks < 4; ++ks) acc = MFMA32(lds_frag_nat(lds + aimg, 32 * sb + r32, ks, hi), lds_frag_nat(lds + bimg, 32 * tb + r32, ks, hi), acc);
    if (sb == tb) {
#pragma unroll
        for (int r = 0; r < 16; ++r) { const unsigned s_ = (r & 3) + 8 * (r >> 2) + 4 * hi; const bool keep = strict ? s_ < r32 : s_ <= r32; acc[r] = keep ? acc[r] : 0.f; }
    }
    return acc;
}
__device__ __forceinline__ void lds_barrier() { asm volatile("s_waitcnt lgkmcnt(0)\n\ts_barrier" ::: "memory"); }
__device__ __forceinline__ void rwkv_chunk_block(Frame& F, int l, int cid) {
    int lane = F.lane; asm volatile("" : "+v"(lane));
    const unsigned char* ws = F.ws; LAS unsigned char* lds = F.lds;
    const int w = F.wave; const unsigned r32 = lane & 31, hi = lane >> 5;
    unsigned seq0, b, h, dir; int T, c; chunk_decode(cid, seq0, T, b, h, dir, c);
    const int q0 = 64 * c;
#ifndef RA_REP
#define RA_REP 0
#endif
    const int role = w >> 1, tb = w & 1;
    const unsigned swo = WS_SMALLW + l * (SMALLW_L * 2);
    {
        const int pw_ = w < 4, pb = (w >> 1) & 1, cb = w & 1;
        const int p_ = 32 * pb + r32; const unsigned tokp = seq0 + (dir ? T - 1 - (q0 + p_) : q0 + p_);
        const unsigned xo = (pw_ ? WS_CW : WS_CA) + (tokp * 128 + dir * 64 + 8 * hi) * 2, wo = swo + ((pw_ ? 0 : 49152) + (dir * 384 + h * 64 + 32 * cb + r32) * 64 + 8 * hi) * 2;
        f32x16 acc = {};
#pragma unroll
        for (int ks = 0; ks < 4; ++ks) acc = MFMA32(LDG(bf16x8, ws, xo + 32 * ks), LDG(bf16x8, ws, wo + 32 * ks), acc);
        {
            const float bias = LDG(float, pw_ ? INP(19) : INP(21), ((l * 2 + dir) * 384 + h * 64 + 32 * cb + r32) * 4);
#pragma unroll
            for (int r = 0; r < 16; ++r) { const float sg = sigmf(bias + acc[r]);
                *(LAS float*)(lds + (pw_ ? L_A1 : L_RHS2) + (32 * pb + (r & 3) + 8 * (r >> 2) + 4 * hi) * RPF + (32 * cb + r32) * 4) = pw_ ? -0.606531f * sg : sg; }
        }
        if (dir == 0 && w < 4) {
            f32x16 ag = {};
            const unsigned go = WS_CG + (tokp * 128 + 8 * hi) * 2, gw_ = swo + (98304 + (h * 64 + 32 * cb + r32) * 128 + 8 * hi) * 2;
#pragma unroll
            for (int ks = 0; ks < 8; ++ks) ag = MFMA32(LDG(bf16x8, ws, go + 32 * ks), LDG(bf16x8, ws, gw_ + 32 * ks), ag);
#pragma unroll
            for (int r = 0; r < 16; ++r) { const int pp_ = 32 * pb + (r & 3) + 8 * (r >> 2) + 4 * hi; const unsigned tk = seq0 + q0 + pp_;
                STG(bf16_t, F.ws, WS_G + (tk * 384 + h * 64 + 32 * cb + r32) * 2) = (bf16_t)(pk2(ag[r], 0.f) & 0xffff); }
        }
    }
    lds_barrier();
    {
        const unsigned cch = h * 64 + lane;
        const float* convp = INP(18) + (size_t)l * 3 * 1152;
        float cw_[3][3];
#pragma unroll
        for (int tap = 0; tap < 3; ++tap)
#pragma unroll
            for (int seg = 0; seg < 3; ++seg) cw_[tap][seg] = LDG(float, convp, (tap * 1152 + seg * 384 + cch) * 4);
        const float ckk = LDG(float, INP(24), (l * 384 + cch) * 4), cka = LDG(float, INP(25), (l * 384 + cch) * 4), crk = LDG(float, INP(26), (l * 384 + cch) * 4);
        const int tb0 = dir ? T - 1 - (q0 + 8 * w + 7) : q0 + 8 * w;
        float xr[10][3];
#pragma unroll
        for (int rr = 0; rr < 10; ++rr) { const int tr = tb0 - 1 + rr; const bool ok = tr >= 0 && tr < T; const unsigned tk = seq0 + (ok ? tr : tb0);
#pragma unroll
            for (int seg = 0; seg < 3; ++seg) { const float x = bf_lo((unsigned)LDG(bf16_t, ws, WS_RKV + (tk * 1152 + seg * 384 + cch) * 2)); xr[rr][seg] = ok ? x : 0.f; } }
        float lwv[8], kkv[8], btv[8], kdv[8], rv[8], vv[8], g = 0.f;
#pragma unroll
        for (int pp = 0; pp < 8; ++pp) {
            const int rr = 1 + (dir ? 7 - pp : pp); const int p = 8 * w + pp; const unsigned tok = seq0 + (unsigned)(tb0 + rr - 1);
            const float r_ = xr[rr - 1][0] * cw_[0][0] + xr[rr][0] * cw_[1][0] + xr[rr + 1][0] * cw_[2][0];
            const float k_ = xr[rr - 1][1] * cw_[0][1] + xr[rr][1] * cw_[1][1] + xr[rr + 1][1] * cw_[2][1];
            const float v_ = xr[rr - 1][2] * cw_[0][2] + xr[rr][2] * cw_[1][2] + xr[rr + 1][2] * cw_[2][2];
            const float kraw = k_ * ckk; const float n2 = wave_sum(kraw * kraw); const float kk_ = kraw * __builtin_amdgcn_rsqf(fmaxf(n2, 1e-24f));
            const float lw = *(const LAS float*)(lds + L_A1 + p * RPF + lane * 4), av = *(const LAS float*)(lds + L_RHS2 + p * RPF + lane * 4);
            const float kd_ = k_ * (1.f + (av - 1.f) * cka);
            const float bon = wave_sum(r_ * kd_ * crk);
            if (lane == 0) STG(float, F.ws, WS_SB + ((dir * M + tok) * 8 + h) * 4) = bon;
            if (dir == 0) STG(float, F.ws, WS_SV + (tok * 384 + cch) * 4) = v_;
            lwv[pp] = lw; kkv[pp] = kk_; btv[pp] = kk_ * av; kdv[pp] = kd_; rv[pp] = r_; vv[pp] = v_; g += lw;
        }
        g = 0.f;
        for (int wq = 0; wq < w; ++wq) { float t8[8];
#pragma unroll
            for (int e = 0; e < 8; ++e) t8[e] = *(const LAS float*)(lds + L_A1 + (8 * wq + e) * RPF + lane * 4);
            g += ((t8[0] + t8[1]) + (t8[2] + t8[3])) + ((t8[4] + t8[5]) + (t8[6] + t8[7])); }
        unsigned vt[4], kkt[4], btt[4]; float e_pos = __expf(g);
#pragma unroll
        for (int pp = 0; pp < 8; ++pp) {
            const int p = 8 * w + pp;
            const float e_prev = e_pos; g += lwv[pp]; e_pos = __expf(g); const float e_neg = __expf(-g);
            const unsigned pk_kr = pk2(kkv[pp] * e_prev, rv[pp] * e_pos), pk_bk = pk2(btv[pp] * e_neg, kdv[pp] * e_neg), pk_v = pk2(vv[pp], 0.f);
            *(LAS bf16_t*)(lds + L_KT + p * RPB + lane * 2) = (bf16_t)(pk_kr & 0xffff); *(LAS bf16_t*)(lds + L_RT + p * RPB + lane * 2) = (bf16_t)(pk_kr >> 16);
            *(LAS bf16_t*)(lds + L_BT + p * RPB + lane * 2) = (bf16_t)(pk_bk & 0xffff); *(LAS bf16_t*)(lds + L_KK + p * RPB + lane * 2) = (bf16_t)(pk_bk >> 16);
            if (pp & 1) { vt[pp >> 1] |= pk_v << 16; kkt[pp >> 1] |= pk_bk & 0xffff0000u; btt[pp >> 1] |= pk_bk << 16; }
            else { vt[pp >> 1] = pk_v & 0xffff; kkt[pp >> 1] = pk_bk >> 16; btt[pp >> 1] = pk_bk & 0xffff; }
        }
        *(LAS u32x4*)(lds + L_VT + lane * RPB + 16 * w) = (u32x4){vt[0], vt[1], vt[2], vt[3]};
        *(LAS u32x4*)(lds + L_KKT + lane * RPB + 16 * w) = (u32x4){kkt[0], kkt[1], kkt[2], kkt[3]};
        *(LAS u32x4*)(lds + L_BTT + lane * RPB + 16 * w) = (u32x4){btt[0], btt[1], btt[2], btt[3]};
        if (w == 7) *(LAS float*)(lds + L_GC + lane * 4) = e_pos;
    }
    lds_barrier();
    f32x16 keep[2]; bf16x8 x4f[2][2];
    if (role == 0) {
        for (int sb = 0; sb <= tb; ++sb) { const f32x16 x = gram_tile(lds, L_BT, L_KT, sb, tb, r32, hi, true);
            if (sb == tb) {
#pragma unroll
                for (int r = 0; r < 16; ++r) *(LAS float*)(lds + L_A1 + tb * 4608 + ((r & 3) + 8 * (r >> 2) + 4 * hi) * 144 + r32 * 4) = -x[r];
            } else {
#pragma unroll
                for (int g4 = 0; g4 < 4; ++g4) *(LAS f32x4*)(lds + L_A1 + 9216 + r32 * 144 + (8 * g4 + 4 * hi) * 4) = (f32x4){x[4 * g4], x[4 * g4 + 1], x[4 * g4 + 2], x[4 * g4 + 3]};
            } }
    } else if (role == 1) {
        f32x16 o[2] = {};
        for (int sb = 0; sb <= tb; ++sb) {
            const f32x16 x = gram_tile(lds, L_KK, L_KT, sb, tb, r32, hi, true);
#pragma unroll
            for (int ks = 0; ks < 2; ++ks) { const bf16x8 a = acc_frag(x, ks, 1.f);
#pragma unroll
                for (int ib = 0; ib < 2; ++ib) o[ib] = MFMA32(a, lds_frag_perm(lds + L_VT, 32 * ib + r32, 32 * sb + 16 * ks, hi), o[ib]); }
        }
#pragma unroll
        for (int ib = 0; ib < 2; ++ib)
#pragma unroll
            for (int r = 0; r < 16; ++r) *(LAS float*)(lds + L_RHS2 + (32 * tb + (r & 3) + 8 * (r >> 2) + 4 * hi) * RPF + (32 * ib + r32) * 4) = o[ib][r];
    } else if (role == 2) {
#pragma unroll
        for (int sb = 0; sb < 2; ++sb) { x4f[sb][0] = (bf16x8){}; x4f[sb][1] = (bf16x8){}; }
        keep[0] = (f32x16){}; keep[1] = (f32x16){};
        for (int sb = 0; sb <= tb; ++sb) {
            const f32x16 x3 = gram_tile(lds, L_KK, L_RT, sb, tb, r32, hi, false), x4 = gram_tile(lds, L_BT, L_RT, sb, tb, r32, hi, false);
#pragma unroll
            for (int ks = 0; ks < 2; ++ks) { const bf16x8 a3 = acc_frag(x3, ks, 1.f); const bf16x8 a4 = acc_frag(x4, ks, -1.f);
                if (sb == 0) x4f[0][ks] = a4; else x4f[1][ks] = a4;
#pragma unroll
                for (int cb = 0; cb < 2; ++cb) keep[cb] = MFMA32(a3, lds_frag_perm(lds + L_VT, 32 * cb + r32, 32 * sb + 16 * ks, hi), keep[cb]); }
        }
    } else {
        keep[0] = (f32x16){}; keep[1] = (f32x16){};
#pragma unroll
        for (int ks = 0; ks < 4; ++ks) { const bf16x8 ak = lds_frag_nat(lds + L_KKT, 32 * tb + r32, ks, hi);
#pragma unroll
            for (int cb = 0; cb < 2; ++cb) keep[cb] = MFMA32(ak, lds_frag_nat(lds + L_VT, 32 * cb + r32, ks, hi), keep[cb]); }
    }
    lds_barrier();
    if (w < 2) {
        const LAS unsigned char* a1p = lds + L_A1; asm volatile("" : "+v"(a1p));
        LAS unsigned char* xp = lds + (w == 0 ? L_X0 : L_RHS2) + lane * 4; asm volatile("" : "+v"(xp));
        const LAS unsigned char* kp = lds + L_KT + lane * 2; asm volatile("" : "+v"(kp));
        LAS unsigned char* dst = lds + (w == 0 ? L_WT : L_U0T) + lane * RPB; asm volatile("" : "+v"(dst));
#pragma unroll
        for (int B = 0; B < 2; ++B) {
            float acc[32];
            if (w == 0 && B == 0) {
#pragma unroll
                for (int r = 0; r < 32; ++r) acc[r] = bf_lo((unsigned)*(const LAS bf16_t*)(kp + r * RPB));
            } else {
#pragma unroll
                for (int r = 0; r < 32; ++r) acc[r] = *(const LAS float*)(xp + (32 * B + r) * RPF);
            }
            f32x2 ac2[16];
#pragma unroll
            for (int k = 0; k < 16; ++k) ac2[k] = (f32x2){acc[2 * k], acc[2 * k + 1]};
            f32x4 ca[8], cn[8];
#pragma unroll
            for (int tg = 0; tg < 8; ++tg) ca[tg] = *(const LAS f32x4*)(a1p + B * 4608 + tg * 16);
#pragma unroll
            for (int s_ = 0; s_ < 31; ++s_) {
                if (s_ + 1 < 31) {
#pragma unroll
                    for (int tg = (s_ + 2) / 4; tg < 8; ++tg) cn[tg] = *(const LAS f32x4*)(a1p + B * 4608 + (s_ + 1) * 144 + tg * 16);
                }
                __builtin_amdgcn_sched_barrier(0);
                const float xs = ac2[s_ >> 1][s_ & 1];
                const f32x2 xs2 = {xs, xs};
#pragma unroll
                for (int tg = (s_ + 1) / 4; tg < 8; ++tg) {
                    ac2[2 * tg] = __builtin_elementwise_fma((f32x2){ca[tg][0], ca[tg][1]}, xs2, ac2[2 * tg]);
                    ac2[2 * tg + 1] = __builtin_elementwise_fma((f32x2){ca[tg][2], ca[tg][3]}, xs2, ac2[2 * tg + 1]); }
                __builtin_amdgcn_sched_barrier(0);
#pragma unroll
                for (int tg = 0; tg < 8; ++tg) ca[tg] = cn[tg];
            }
#pragma unroll
            for (int k = 0; k < 16; ++k) { acc[2 * k] = ac2[k][0]; acc[2 * k + 1] = ac2[k][1]; }
#pragma unroll
            for (int k8 = 0; k8 < 4; ++k8) { u32x4 v; v.x = pk2(acc[8 * k8], acc[8 * k8 + 1]); v.y = pk2(acc[8 * k8 + 2], acc[8 * k8 + 3]); v.z = pk2(acc[8 * k8 + 4], acc[8 * k8 + 5]); v.w = pk2(acc[8 * k8 + 6], acc[8 * k8 + 7]);
                *(LAS u32x4*)(dst + 64 * B + 16 * k8) = v; }
            if (B == 0) {
                asm volatile("s_waitcnt lgkmcnt(0)" ::: "memory");
                f32x16 u[2];
#pragma unroll
                for (int cb = 0; cb < 2; ++cb)
#pragma unroll
                    for (int r = 0; r < 16; ++r) { const int t = 32 + (r & 3) + 8 * (r >> 2) + 4 * hi;
                        u[cb][r] = w == 0 ? bf_lo((unsigned)*(const LAS bf16_t*)(lds + L_KT + t * RPB + (32 * cb + r32) * 2)) : *(const LAS float*)(lds + L_RHS2 + t * RPF + (32 * cb + r32) * 4); }
#pragma unroll
                for (int ks = 0; ks < 2; ++ks) { const f32x4 a0 = *(const LAS f32x4*)(lds + L_A1 + 9216 + r32 * 144 + (16 * ks + 8 * hi) * 4), a1 = *(const LAS f32x4*)(lds + L_A1 + 9216 + r32 * 144 + (16 * ks + 8 * hi + 4) * 4);
                    u32x4 aw; aw.x = pk2(-a0[0], -a0[1]); aw.y = pk2(-a0[2], -a0[3]); aw.z = pk2(-a1[0], -a1[1]); aw.w = pk2(-a1[2], -a1[3]);
#pragma unroll
                    for (int cb = 0; cb < 2; ++cb) u[cb] = MFMA32(__builtin_bit_cast(bf16x8, aw), lds_frag_nat(lds + (w == 0 ? L_WT : L_U0T), 32 * cb + r32, ks, hi), u[cb]); }
#pragma unroll
                for (int cb = 0; cb < 2; ++cb)
#pragma unroll
                    for (int r = 0; r < 16; ++r) *(LAS float*)(lds + (w == 0 ? L_X0 : L_RHS2) + (32 + (r & 3) + 8 * (r >> 2) + 4 * hi) * RPF + (32 * cb + r32) * 4) = u[cb][r];
                asm volatile("s_waitcnt lgkmcnt(0)" ::: "memory");
            }
        }
    }
    lds_barrier();
    if (role == 2) {
        f32x16 pj[2];
#pragma unroll
        for (int cb = 0; cb < 2; ++cb)
#pragma unroll
            for (int g = 0; g < 4; ++g) { const u32x2 v = *(const LAS u32x2*)(lds + L_RT + (32 * tb + r32) * RPB + (32 * cb + 8 * g + 4 * hi) * 2);
                pj[cb][4 * g] = bf_lo(v.x); pj[cb][4 * g + 1] = bf_hi(v.x); pj[cb][4 * g + 2] = bf_lo(v.y); pj[cb][4 * g + 3] = bf_hi(v.y); }
#pragma unroll
        for (int sb = 0; sb < 2; ++sb)
#pragma unroll
            for (int ks = 0; ks < 2; ++ks)
#pragma unroll
                for (int cb = 0; cb < 2; ++cb) {
                    keep[cb] = MFMA32(x4f[sb][ks], lds_frag_perm(lds + L_U0T, 32 * cb + r32, 32 * sb + 16 * ks, hi), keep[cb]);
                    pj[cb] = MFMA32(lds_frag_perm(lds + L_WT, 32 * cb + r32, 32 * sb + 16 * ks, hi), x4f[sb][ks], pj[cb]); }
        f32x16 (&y0)[2] = keep;
        const unsigned nc_ = (unsigned)T >> 6, kst = dir ? nc_ - 1 - (unsigned)c : (unsigned)c, yidx = cid < 768 ? (b * 6 + h) * 4 + kst : 384 + (b * 6 + h) * 64 + kst;
        const unsigned ybase = (dir ? WS_YB : WS_YF) + yidx * 16384 + ((dir ? 1 - tb : tb) * 8) * 1024 + (dir ? (lane ^ 32) : lane) * 16;
#pragma unroll
        for (int cb = 0; cb < 2; ++cb)
#pragma unroll
            for (int q = 0; q < 4; ++q) { const f32x4 vf = {y0[cb][4 * q], y0[cb][4 * q + 1], y0[cb][4 * q + 2], y0[cb][4 * q + 3]}, vb = {y0[cb][4 * q + 3], y0[cb][4 * q + 2], y0[cb][4 * q + 1], y0[cb][4 * q]};
                STG(f32x4, F.ws, ybase + (cb * 4 + (dir ? 3 - q : q)) * 1024) = dir ? vb : vf; }
#pragma unroll
        for (int cb = 0; cb < 2; ++cb)
#pragma unroll
            for (int s2 = 0; s2 < 2; ++s2) { u32x4 w; w.x = pk2(pj[cb][8 * s2], pj[cb][8 * s2 + 1]); w.y = pk2(pj[cb][8 * s2 + 2], pj[cb][8 * s2 + 3]); w.z = pk2(pj[cb][8 * s2 + 4], pj[cb][8 * s2 + 5]); w.w = pk2(pj[cb][8 * s2 + 6], pj[cb][8 * s2 + 7]);
                STG(u32x4, F.ws, WS_RP + (unsigned)cid * 8192 + ((tb * 2 + cb) * 2 + s2) * 1024 + lane * 16) = w; }
    } else if (role == 3) {
        const int jb = tb;
        f32x16 q1[2] = {}, q2[2] = {}; f32x16 (&n1)[2] = keep;
#pragma unroll
        for (int ks = 0; ks < 4; ++ks) { const bf16x8 a = lds_frag_nat(lds + L_BTT, 32 * jb + r32, ks, hi);
#pragma unroll
            for (int cb = 0; cb < 2; ++cb) { q1[cb] = MFMA32(lds_frag_nat(lds + L_WT, 32 * cb + r32, ks, hi), a, q1[cb]); q2[cb] = MFMA32(a, lds_frag_nat(lds + L_U0T, 32 * cb + r32, ks, hi), q2[cb]); } }
#pragma unroll
        for (int q = 0; q < 4; ++q) { f32x4 gc4;
#pragma unroll
            for (int e = 0; e < 4; ++e) gc4[e] = *(const LAS float*)(lds + L_GC + (32 * jb + e + 8 * q + 4 * hi) * 4);
#pragma unroll
            for (int cb = 0; cb < 2; ++cb) { f32x4 nv;
#pragma unroll
                for (int e = 0; e < 4; ++e) nv[e] = gc4[e] * (n1[cb][4 * q + e] - q2[cb][4 * q + e]);
                STG(f32x4, F.ws, WS_RN + ((((unsigned)cid * 2 + jb) * 2 + cb) * 4 + q) * 1024 + lane * 16) = nv; } }
        { const float gl = *(const LAS float*)(lds + L_GC + (32 * jb + r32) * 4);
#pragma unroll
          for (int cb = 0; cb < 2; ++cb)
#pragma unroll
            for (int s2 = 0; s2 < 2; ++s2) { float mv[8];
#pragma unroll
                for (int e = 0; e < 8; ++e) { const int r = 8 * s2 + e; const unsigned c = 32 * cb + (r & 3) + 8 * (r >> 2) + 4 * hi; mv[e] = (c == 32 * jb + r32 ? gl : 0.f) - gl * q1[cb][r]; }
                u32x4 w; w.x = pk2(mv[0], mv[1]); w.y = pk2(mv[2], mv[3]); w.z = pk2(mv[4], mv[5]); w.w = pk2(mv[6], mv[7]);
                STG(u32x4, F.ws, WS_RM + (unsigned)cid * 8192 + ((jb * 2 + cb) * 2 + s2) * 1024 + lane * 16) = w; } }
    }
    lds_barrier();
}
__device__ __forceinline__ void rwkv_chain_wave(Frame& F, int l, bool lat, int chain, int ib) {
    int lane = F.lane; asm volatile("" : "+v"(lane));
    const unsigned char* ws = F.ws; const unsigned r32 = lane & 31, hi = lane >> 5;
    const unsigned dir = chain & 1, h = (chain >> 1) % 6, b = chain / 12;
    const int nc = lat ? 64 : 4; const unsigned cid0 = lat ? 768 + chain * 64 : chain * 4;
    const unsigned i = 32 * ib + r32;
    const unsigned so = ((((b * 4 + l) * 6 + h) * 64 + i) * 64) * 4;
    f32x16 H[2];
#pragma unroll
    for (int jb = 0; jb < 2; ++jb)
#pragma unroll
        for (int g4 = 0; g4 < 4; ++g4) { f32x4 v = {0.f, 0.f, 0.f, 0.f}; if (lat) v = LDG(f32x4, dir ? INP(7) : INP(6), so + (32 * jb + 8 * g4 + 4 * hi) * 4);
            H[jb][4 * g4] = v[0]; H[jb][4 * g4 + 1] = v[1]; H[jb][4 * g4 + 2] = v[2]; H[jb][4 * g4 + 3] = v[3]; }
    bf16x8 maA[2][2][2], maB[2][2][2]; f32x16 ntA[2], ntB[2];
    const GAS unsigned char* pm = (const GAS unsigned char*)ws + (WS_RM + cid0 * 8192 + lane * 16);
    const GAS unsigned char* pn = (const GAS unsigned char*)ws + (WS_RN + (cid0 * 4 + ib) * 4096 + lane * 16);
#define RB_LOAD(ma, nt, k_) do { \
        _Pragma("unroll") for (int jo = 0; jo < 2; ++jo) _Pragma("unroll") for (int ji = 0; ji < 2; ++ji) _Pragma("unroll") for (int ks = 0; ks < 2; ++ks) ma[jo][ji][ks] = *(const GAS bf16x8*)(pm + ((k_) * 8192 + ((jo * 2 + ji) * 2 + ks) * 1024)); \
        _Pragma("unroll") for (int jo = 0; jo < 2; ++jo) _Pragma("unroll") for (int q = 0; q < 4; ++q) { const f32x4 t_ = *(const GAS f32x4*)(pn + ((k_) * 16384 + (jo * 8 + q) * 1024)); \
            nt[jo][4 * q] = t_[0]; nt[jo][4 * q + 1] = t_[1]; nt[jo][4 * q + 2] = t_[2]; nt[jo][4 * q + 3] = t_[3]; } } while (0)
#define RB_STEP(ma, nt, cid_) do { \
        bf16x8 hf[2][2]; \
        _Pragma("unroll") for (int ji = 0; ji < 2; ++ji) { hf[ji][0] = acc_frag(H[ji], 0, 1.f); hf[ji][1] = acc_frag(H[ji], 1, 1.f); } \
        _Pragma("unroll") for (int ji = 0; ji < 2; ++ji) _Pragma("unroll") for (int ks = 0; ks < 2; ++ks) STG(bf16x8, F.ws, WS_RH + (cid_) * 8192 + ((ib * 2 + ji) * 2 + ks) * 1024 + lane * 16) = hf[ji][ks]; \
        f32x16 acc[2] = {nt[0], nt[1]}; \
        _Pragma("unroll") for (int jo = 0; jo < 2; ++jo) _Pragma("unroll") for (int ji = 0; ji < 2; ++ji) _Pragma("unroll") for (int ks = 0; ks < 2; ++ks) acc[jo] = MFMA32(ma[jo][ji][ks], hf[ji][ks], acc[jo]); \
        H[0] = acc[0]; H[1] = acc[1]; } while (0)
    RB_LOAD(maA, ntA, 0); RB_LOAD(maB, ntB, 1);
#pragma unroll 1
    for (int c = 0; c < nc; c += 2) {
        const unsigned cid = cid0 + c;
        RB_STEP(maA, ntA, cid);
        if (c + 2 < nc) RB_LOAD(maA, ntA, 2);
        RB_STEP(maB, ntB, cid + 1);
        if (c + 2 < nc) RB_LOAD(maB, ntB, 3);
        pm += 16384; pn += 32768;
    }
#undef RB_LOAD
#undef RB_STEP
    if (!lat) {
#pragma unroll
        for (int jb = 0; jb < 2; ++jb)
#pragma unroll
            for (int g4 = 0; g4 < 4; ++g4) STG(f32x4, F.out, (dir ? OFF_CB : OFF_CF) * 4 + so + (32 * jb + 8 * g4 + 4 * hi) * 4) = (f32x4){H[jb][4 * g4], H[jb][4 * g4 + 1], H[jb][4 * g4 + 2], H[jb][4 * g4 + 3]};
    }
}
__device__ __forceinline__ void rwkv_apply_wave(Frame& F, int item) {
    int lane = F.lane; asm volatile("" : "+v"(lane));
    const unsigned char* ws = F.ws; const unsigned r32 = lane & 31, hi = lane >> 5;
    const int cid = item >> 1, tb = item & 1;
    unsigned seq0, b, h, dir; int T, c; chunk_decode(cid, seq0, T, b, h, dir, c);
    const unsigned yb = dir ? WS_YB : WS_YF;
    f32x16 acc[2];
#pragma unroll
    for (int r = 0; r < 16; ++r) { const int t = 32 * tb + (r & 3) + 8 * (r >> 2) + 4 * hi; const unsigned tok = seq0 + (dir ? T - 1 - (64 * c + t) : 64 * c + t);
        acc[0][r] = LDG(float, ws, yb + (tok * 384 + h * 64 + r32) * 4); acc[1][r] = LDG(float, ws, yb + (tok * 384 + h * 64 + 32 + r32) * 4); }
#pragma unroll
    for (int ks = 0; ks < 4; ++ks) { const bf16x8 a = LDG(bf16x8, ws, WS_RP + (((unsigned)cid * 64 + 32 * tb + r32) * 64 + 16 * ks + 8 * hi) * 2);
#pragma unroll
        for (int ib = 0; ib < 2; ++ib) acc[ib] = MFMA32(a, LDG(bf16x8, ws, WS_RH + (((unsigned)cid * 64 + 32 * ib + r32) * 64 + 16 * ks + 8 * hi) * 2), acc[ib]); }
#pragma unroll
    for (int r = 0; r < 16; ++r) { const int t = 32 * tb + (r & 3) + 8 * (r >> 2) + 4 * hi; const unsigned tok = seq0 + (dir ? T - 1 - (64 * c + t) : 64 * c + t);
        STG(float, F.ws, yb + (tok * 384 + h * 64 + r32) * 4) = acc[0][r]; STG(float, F.ws, yb + (tok * 384 + h * 64 + 32 + r32) * 4) = acc[1][r]; }
}

__device__ __forceinline__ void rwkv_out_item(Frame& F, int l, int item) {
    int lane = F.lane; asm volatile("" : "+v"(lane));
    const unsigned char* ws = F.ws; const unsigned r32 = lane & 31, hi = lane >> 5;
    const int tb = item & 1, h = (item >> 1) % 6, sk = item / 12;
    const bool lat = sk >= 64; const int b = lat ? (sk - 64) >> 6 : sk >> 2, k = lat ? (sk - 64) & 63 : sk & 3, nc = lat ? 64 : 4;
    const unsigned seq0 = lat ? MC + b * 4096 : b * 256, base = lat ? 768u : 0u;
    const unsigned chf = (b * 6 + h) * 2, cidf = base + chf * nc + k, cidb = base + (chf + 1) * nc + (nc - 1 - k);
    const unsigned tok0 = seq0 + 64 * k + 32 * tb;
    f32x16 acc[2];
    const unsigned yo = (lat ? 384 + (b * 6 + h) * 64 + k : (b * 6 + h) * 4 + k) * 16384 + (tb * 8) * 1024 + lane * 16;
#pragma unroll
    for (int ib = 0; ib < 2; ++ib)
#pragma unroll
        for (int q = 0; q < 4; ++q) { const f32x4 yf = LDG(f32x4, ws, WS_YF + yo + (ib * 4 + q) * 1024), yb = LDG(f32x4, ws, WS_YB + yo + (ib * 4 + q) * 1024);
            acc[ib][4 * q] = yf[0] + yb[0]; acc[ib][4 * q + 1] = yf[1] + yb[1]; acc[ib][4 * q + 2] = yf[2] + yb[2]; acc[ib][4 * q + 3] = yf[3] + yb[3]; }
#pragma unroll
    for (int ks = 0; ks < 4; ++ks) {
        const bf16x8 af = LDG(bf16x8, ws, WS_RP + cidf * 8192 + (tb * 4 + ks) * 1024 + lane * 16), ab = LDG(bf16x8, ws, WS_RP + cidb * 8192 + ((1 - tb) * 4 + ks) * 1024 + ((31 - r32) + 32 * hi) * 16);
#pragma unroll
        for (int ib = 0; ib < 2; ++ib) { acc[ib] = MFMA32(af, LDG(bf16x8, ws, WS_RH + cidf * 8192 + (ib * 4 + ks) * 1024 + lane * 16), acc[ib]);
            acc[ib] = MFMA32(ab, LDG(bf16x8, ws, WS_RH + cidb * 8192 + (ib * 4 + ks) * 1024 + lane * 16), acc[ib]); } }
    LAS unsigned char* lw = F.lds + F.wave * 9216;
#pragma unroll
    for (int ib = 0; ib < 2; ++ib)
#pragma unroll
        for (int r = 0; r < 16; ++r) *(LAS float*)(lw + ((r & 3) + 8 * (r >> 2) + 4 * hi) * 288 + (32 * ib + r32) * 4) = acc[ib][r];
    const unsigned ts = lane >> 4, dg = lane & 15;
    const f32x4 g4 = LDG(f32x4, INP(27), (l * 384 + h * 64 + 4 * dg) * 4), b4 = LDG(f32x4, INP(28), (l * 384 + h * 64 + 4 * dg) * 4);
#pragma unroll 2
    for (int i = 0; i < 8; ++i) { const unsigned tk = tok0 + 4 * i + ts, e = tk * 384 + h * 64 + 4 * dg;
        const float bon = LDG(float, ws, WS_SB + (tk * 8 + h) * 4) + LDG(float, ws, WS_SB + ((M + tk) * 8 + h) * 4);
        const f32x4 y = *(const LAS f32x4*)(lw + (4 * i + ts) * 288 + dg * 16) + bon * LDG(f32x4, ws, WS_SV + e * 4);
        const float mu = allreduce16((y[0] + y[1]) + (y[2] + y[3])) * (1.f / 64.f);
        const f32x4 d = y - mu;
        const float rs = rsqrtf(allreduce16((d[0] * d[0] + d[1] * d[1]) + (d[2] * d[2] + d[3] * d[3])) * (1.f / 64.f) + 64e-5f);
        const f32x4 o = (d * rs * g4 + b4) * unpack4(LDG(u32x2, ws, WS_G + e * 2));
        STG(u32x2, F.ws, WS_ACT + (tk * DM + 640 + h * 64 + 4 * dg) * 2) = pack4(o); }
}

#ifndef B_UNIT
#define B_UNIT 0
#endif
constexpr int AU_R = 8, AU_D = 4, AU_SLOT = 6144;
__device__ __forceinline__ void attn_b_unit(Frame& F, int l, int unit) {
    int lane = F.lane; asm volatile("" : "+v"(lane));
    const unsigned char* ws = F.ws; LAS unsigned char* lds = F.lds;
    const int w = F.wave; const unsigned r32 = lane & 31, hi = lane >> 5;
    const unsigned kh = unit & 1, qb = (unit >> 1) & 15, mp = (unit >> 5) & 1, h = (unit >> 6) & 3, b = unit >> 8;
    const unsigned seq0 = MC + b * 4096, row = seq0 + qb * 256 + 32 * w + r32;
    bf16x8 qf[1][2];
#pragma unroll
    for (int s = 0; s < 2; ++s) qf[0][s] = LDG(bf16x8, ws, WS_QB + (row * 256 + h * 64 + mp * 32 + 8 * hi) * 2 + 32 * s);
    AttnQ st[1]; attnq_init(st[0], 0.f);
    const int qpos[1] = {0};
    const int n0 = kh ? 56 : 72, nt = 72;
    const unsigned pofs = (w < 2 ? (h * 2 + mp) * 2048 + w * 1024 : h * 4096 + (w - 2) * 1024) + lane * 16;
    const unsigned base0 = (w < 2 ? WS_KB : WS_VTB) + ((seq0 >> 5) + (kh ? 72u : 0u)) * 16384 + pofs;
    const unsigned base1 = WS_CACHE + (w < 2 ? 2 * MiB : 4 * MiB) + (b * 4 + l) * 262144 + pofs;
#define AU_DMA(t_) do { const int tt_ = (t_) < nt ? (t_) : nt - 1; const unsigned src_ = tt_ < n0 ? base0 + tt_ * 16384 : base1 + (tt_ - n0) * 16384; \
        __builtin_amdgcn_global_load_lds((const GAS unsigned*)(ws + src_), (LAS unsigned*)(lds + ((t_) % AU_R) * AU_SLOT + w * 1024), 16, 0, 0); } while (0)
    if (w < 6) {
#pragma unroll
        for (int t = 0; t < AU_D; ++t) AU_DMA(t);
    }
    for (int t = 0; t < nt; ++t) {
        if (w < 6) asm volatile("s_waitcnt vmcnt(3)" ::: "memory");
        asm volatile("s_barrier" ::: "memory");
        const LAS unsigned char* sl = lds + (t % AU_R) * AU_SLOT + lane * 16;
        bf16x8 kf[2], vf[4];
        kf[0] = *(const LAS bf16x8*)(sl); kf[1] = *(const LAS bf16x8*)(sl + 1024);
#pragma unroll
        for (int f = 0; f < 4; ++f) vf[f] = *(const LAS bf16x8*)(sl + 2048 + 1024 * f);
        if (w < 6) AU_DMA(t + AU_D);
        attn_block<32, false, 1>(qf, kf, vf, st, t, qpos, 0, hi);
    }
#undef AU_DMA
    asm volatile("s_waitcnt vmcnt(0) lgkmcnt(0)\n\ts_barrier" ::: "memory");
    attn_b_store(F, st[0], mp, kh, row, h, hi);
}

constexpr int Q_BLAT = 2048, Q_ALAT = 1536, Q_BCTX = 1024, Q_ACTX = 768;
constexpr int Q_TOTAL = Q_BLAT + Q_ALAT + Q_BCTX + Q_ACTX;
#ifndef XCD_DEAL
#define XCD_DEAL 1
#endif
__device__ __forceinline__ void phase_mixer(Frame& F, int l, int rep) {
    if (rep == 0 || REP_PART == 0 || REP_PART == 1) {
        const int si = F.bid + F.G * F.wave;
        if (si < 48) rwkv_chain_wave(F, l, true, si >> 1, si & 1);
        else if (si < 48 + 384) rwkv_chain_wave(F, l, false, (si - 48) >> 1, (si - 48) & 1);
    }
    if (B_UNIT && (rep == 0 || REP_PART == 2 || REP_PART == 4)) {
        unsigned* uctr = (unsigned*)(F.ws + WS_CTL) + 64 * (32 + l + 4 * rep);
        LAS int* ubox = (LAS int*)(F.lds + 65536);
        for (;;) {
            if (F.wave == 0 && F.lane == 0) *ubox = (int)atomicAdd(uctr, 1u);
            lds_barrier();
            const int un = __builtin_amdgcn_readfirstlane(*ubox);
            lds_barrier();
            if (un >= 512) break;
            attn_b_unit(F, l, un);
        }
    }
    unsigned* ctr = (unsigned*)(F.ws + WS_CTL) + 64 * (1 + l + 4 * rep);
    const bool xdeal = XCD_DEAL && !B_UNIT && F.G == 256;
    if (xdeal && (rep == 0 || REP_PART == 2 || REP_PART == 4)) attn_b_item(F, l, true, (F.bid & 7) * 256 + (F.bid >> 3) * 8 + F.wave);
    unsigned* cx = (unsigned*)(F.ws + WS_CTL) + 8192 + ((l + 4 * rep) * 8 + (F.bid & 7)) * 64;
    bool xq = xdeal;
    if (rep == 0 || REP_PART != 1) for (;;) {
        int it = 0;
        if (F.lane == 0) it = (int)atomicAdd(xq ? cx : ctr, 1u);
        it = __builtin_amdgcn_readfirstlane(it);
        if (xq) { if (it >= 192) { xq = false; continue; }
            const int x = F.bid & 7; it = Q_BLAT + (((x >> 2) * 6 + ((x >> 1) & 1) * 3 + it / 64) * 128 + (x & 1) * 64 + it % 64); }
        else it += xdeal ? Q_BLAT + Q_ALAT : (B_UNIT ? Q_BLAT : 0);
        if (it >= Q_TOTAL) break;
        if (it < Q_BLAT) { if (rep == 0 || REP_PART == 2 || REP_PART == 4) attn_b_item(F, l, true, it); continue; } it -= Q_BLAT;
        if (it < Q_ALAT) { if (rep == 0 || REP_PART == 2 || REP_PART == 3) attn_a_item(F, l, true, it); continue; } it -= Q_ALAT;
        if (it < Q_BCTX) { if (rep == 0 || REP_PART == 2 || REP_PART == 5) attn_b_item(F, l, false, it); continue; } it -= Q_BCTX;
        if (rep == 0 || REP_PART == 2 || REP_PART == 5) attn_a_item(F, l, false, it);
    }
}

#ifndef FIN_R2
#define FIN_R2 1
#endif
__device__ __forceinline__ void phase_finalize(Frame& F, int l, int rep) {
    const unsigned char* ws = F.ws;
    int lane = F.lane; asm volatile("" : "+v"(lane));
    const float lami = 0.8f - 0.6f * __expf(-0.3f * (float)l);
    const float lam = LDG(float, ws, WS_TAB + (TAB_LAM + l) * 4) + lami;
    const float omli = 1.f - lami;
    const unsigned hk = lane >> 4, dg = lane & 15;
    const f32x4 sg = LDG(f32x4, INP(17), (l * 64 + 4 * dg) * 4) * omli;
    const unsigned nw2 = (F.ngw < 2304 && 2 * F.ngw > 2304 + 64) ? 2304 - F.ngw : 0, npair = M / 2;
    const unsigned n2 = nw2 * FIN_R2;
    unsigned p = (unsigned)F.gw < nw2 ? F.gw : n2 + (F.gw - nw2);
    const unsigned pe = (unsigned)F.gw < nw2 ? n2 : npair, ps = (unsigned)F.gw < nw2 ? nw2 : F.ngw - nw2;
    for (; p < pe; p += ps) {
        const unsigned r0 = 2 * p;
#pragma unroll
        for (int rr = 0; rr < 2; ++rr) { const unsigned row = r0 + rr; f32x4 om[2];
#pragma unroll
            for (int mp = 0; mp < 2; ++mp) { const unsigned o0 = (((mp * 2) * M + row) * 256 + 64 * hk + 4 * dg) * 2, q0 = ((((mp * 2) * M + row) * 4 + hk) * 2) * 4;
                const f32x2 ml0 = LDG(f32x2, ws, WS_ML + q0);
                if (row >= (unsigned)MC) { const f32x2 ml1 = LDG(f32x2, ws, WS_ML + q0 + M * 32); const float ms = fmaxf(ml0[0], ml1[0]), w0 = __builtin_amdgcn_exp2f(ml0[0] - ms), w1 = __builtin_amdgcn_exp2f(ml1[0] - ms);
                    om[mp] = (unpack4(LDG(u32x2, ws, WS_BO2 + o0)) * w0 + unpack4(LDG(u32x2, ws, WS_BO2 + o0 + M * 512)) * w1) * __builtin_amdgcn_rcpf(ml0[1] * w0 + ml1[1] * w1); }
                else om[mp] = unpack4(LDG(u32x2, ws, WS_BO2 + o0)) * __builtin_amdgcn_rcpf(ml0[1]); }
            const f32x4 v = om[0] - lam * om[1];
            const float ms = allreduce16((v[0] * v[0] + v[1] * v[1]) + (v[2] * v[2] + v[3] * v[3])) * (1.f / 64.f);
            STG(u32x2, F.ws, WS_ACT + (row * DM + 384 + 64 * hk + 4 * dg) * 2) = pack4(v * rsqrtf(ms + 1e-6f) * sg); }
    }
}


typedef unsigned v4u __attribute__((ext_vector_type(4)));
#define XB_TMO      128
#define XB_XCNT(j)  (256  + 64 * (j))
#define XB_XSUB(j)  (1280 + 64 * (j))
#define XB_XGEN(j)  (2304 + 64 * (j))
#define XB_TOP      3328
#define XB_TOPGEN   3392
#define XCD_BAR_WORDS 3456
#define XB_SPIN_CAP (1u << 18)

__device__ __forceinline__ unsigned xb_ld(unsigned* p)              { return __hip_atomic_load(p, __ATOMIC_RELAXED, __HIP_MEMORY_SCOPE_AGENT); }
__device__ __forceinline__ unsigned xb_add(unsigned* p, unsigned v) { return __hip_atomic_fetch_add(p, v, __ATOMIC_RELAXED, __HIP_MEMORY_SCOPE_AGENT); }
__device__ __forceinline__ unsigned xb_xcc_id() { return (unsigned)__builtin_amdgcn_s_getreg((3 << 11) | 20) & 0xFu; }
#define XB_SPIN(cond, bar) do { unsigned _sp = 0; while (cond) { __builtin_amdgcn_s_sleep(1); \
    if ((++_sp & 255u) == 0u) { if (xb_ld(&(bar)[XB_TMO])) break; if (_sp > XB_SPIN_CAP) { atomicAdd(&(bar)[XB_TMO], 1u); break; } } } } while (0)

struct XcdBarrier {
    unsigned* bar; unsigned x;
    volatile LAS unsigned* st;
};

__device__ __forceinline__ XcdBarrier xcd_barrier_post(unsigned* bar, volatile LAS unsigned* st) {
    XcdBarrier b; b.bar = bar; b.x = xb_xcc_id(); b.st = st;
    if (threadIdx.x == 0) (void)xb_add(&bar[XB_XCNT(b.x)], 1u);
    return b;
}
__device__ __forceinline__ void xcd_barrier_complete(unsigned* bar, unsigned x, unsigned& nloc, unsigned& nx) {
    const unsigned G = gridDim.x * gridDim.y * gridDim.z;
    unsigned sum, cnt, mine, sp = 0u;
    for (;;) {
        sum = 0u; cnt = 0u; mine = 0u;
#pragma unroll
        for (unsigned j = 0; j < 16; ++j) { const unsigned c = xb_ld(&bar[XB_XCNT(j)]); sum += c; cnt += (c > 0u) ? 1u : 0u; mine = (j == x) ? c : mine; }
        if (sum == G) break;
        __builtin_amdgcn_s_sleep(1);
        if ((++sp & 255u) == 0u) { if (xb_ld(&bar[XB_TMO])) break; if (sp > XB_SPIN_CAP) { atomicAdd(&bar[XB_TMO], 1u); break; } }
    }
    nloc = mine > 0u ? mine : 1u; nx = cnt > 0u ? cnt : 1u;
}

__device__ __forceinline__ void xcd_barrier(const XcdBarrier& b) {
    asm volatile("s_waitcnt vmcnt(0)" ::: "memory");
    __syncthreads();
    if (threadIdx.x == 0) {
        unsigned* bar = b.bar;
        __builtin_amdgcn_s_waitcnt(0);
        unsigned nloc = b.st[0], nx = b.st[1];
        if (nloc == 0u) { xcd_barrier_complete(bar, b.x, nloc, nx); b.st[0] = nloc; b.st[1] = nx; }
        const unsigned old = xb_add(&bar[XB_XSUB(b.x)], 1u);
        const unsigned gen = old / nloc;
        if (old + 1u == (gen + 1u) * nloc) {
            __builtin_amdgcn_fence(__ATOMIC_RELEASE, "agent");
            asm volatile("s_waitcnt vmcnt(0)" ::: "memory");
            const unsigned og = xb_add(&bar[XB_TOP], 1u);
            const unsigned tg = og / nx;
            if (og + 1u == (tg + 1u) * nx) xb_add(&bar[XB_TOPGEN], 1u);
            else XB_SPIN(xb_ld(&bar[XB_TOPGEN]) == tg, bar);
            __builtin_amdgcn_fence(__ATOMIC_ACQUIRE, "agent");
            xb_add(&bar[XB_XGEN(b.x)], 1u);
            asm volatile("s_waitcnt vmcnt(0)" ::: "memory");
        } else {
            XB_SPIN(xb_ld(&bar[XB_XGEN(b.x)]) == gen, bar);
            __builtin_amdgcn_fence(__ATOMIC_ACQUIRE, "agent");
            asm volatile("s_waitcnt vmcnt(0)" ::: "memory");
        }
    }
    __syncthreads();
}

#ifndef DIS
#define DIS 0
#endif
#ifndef GEMM_MF
#define GEMM_MF 7
#endif
#ifndef REP_PHASE
#define REP_PHASE -1
#define REP_COUNT 1
#endif
constexpr int NEXTRA = (REP_PHASE >= 0 && REP_PHASE < 9) ? REP_COUNT - 1 : 0, NPL = 9 + NEXTRA, NPRE = (REP_PHASE == 100) ? REP_COUNT : 1, NPHASE_RUN = NPRE + 1 + NPL * DEPTH;
__global__ void __launch_bounds__(512, 2) mega(Args a) {
    extern __shared__ __attribute__((aligned(16))) unsigned char lds[];
    Frame F;
    F.lds = (LAS unsigned char*)lds;
    volatile LAS unsigned* bst = (volatile LAS unsigned*)(F.lds + LDS_BYTES - 64);
    if (threadIdx.x < 2) bst[threadIdx.x] = 0u;
    __syncthreads();
    const XcdBarrier xbar = xcd_barrier_post((unsigned*)((GAS unsigned char*)a.ws + WS_CTL) + 4096, bst);
    const int wave_id = __builtin_amdgcn_readfirstlane((int)threadIdx.x >> 6);
    for (int ph = a.ph_lo; ph < a.ph_hi; ++ph) {
        { const unsigned char* kp = (const unsigned char*)__builtin_amdgcn_kernarg_segment_ptr(); asm volatile("" : "+s"(kp));
          const Args* ap = (const Args*)kp; F.in = ap->in; F.out = gptr(ap->out); F.ws = gptr(ap->ws); }
        { unsigned ones = ~0u; asm volatile("" : "+s"(ones)); int ln = (int)__builtin_amdgcn_mbcnt_hi(ones, __builtin_amdgcn_mbcnt_lo(ones, 0u)); int wv = wave_id, bid = (int)blockIdx.x, gg = (int)gridDim.x; asm volatile("" : "+s"(wv), "+s"(bid), "+s"(gg));
          F.lane = ln; F.wave = wv; F.bid = bid; F.G = gg; F.ngw = gg * 8; F.tid = wv * 64 + ln; F.gw = bid * 8 + wv; }
        if (ph < NPRE) { if (!(DIS & 1)) phase_prologue(F); }
        else if (ph == NPHASE_RUN - 1) { if (!(DIS & 2)) phase_final_norm(F); }
        else {
            const int l = (ph - NPRE) / NPL, sidx = (ph - NPRE) % NPL, rep = (REP_PHASE >= 0 && REP_PHASE < 9 && sidx > REP_PHASE && sidx <= REP_PHASE + NEXTRA) ? sidx - REP_PHASE : 0, s = (REP_PHASE >= 0 && REP_PHASE < 9 && sidx > REP_PHASE) ? (sidx <= REP_PHASE + NEXTRA ? REP_PHASE : sidx - NEXTRA) : sidx;
            if (s == 0) { convert_weights(F, l); phase_norm(F, l, 0); }
            else if (s == 1) {
                pg8::Gemm g{WSP(bf16_t, WS_ACT), WSP(bf16_t, WS_WIN + 0u * WSET_STRIDE), M, NIN, 1024}; pg8::StaticOrder S; S.init(M, NIN, F.G, F.bid, (GEMM_MF & 1) ? 192 : 256);
                EpiWin E{F.ws, F.out, l, F.lds + pg8::STAGE_BYTES, REP_PART == 9 && rep > 0};
                if (!(DIS & 16)) pg8::gemm_phase<EpiWin, pg8::StaticOrder, false, true, (GEMM_MF & 1) ? 3 : 4>(F.lds, g, S, E, F.tid);
                if (false) { const int wv_ = (F.bid - 64) * 8 + F.wave; convert_item_any(F, l + 1, wv_); if (wv_ < CV_TOTAL - 1536) convert_item_any(F, l + 1, 1536 + wv_); }
            }
            else if (s == 2) { for (int cid = F.bid; cid < NCHUNK; cid += F.G) rwkv_chunk_block(F, l, cid); }
            else if (s == 3) { if (!(DIS & 64)) phase_mixer(F, l, rep); }
            else if (s == 4) { if (rep == 0 || REP_PART != 6) for (int it = F.gw; it < 192 * 12; it += F.ngw) rwkv_out_item(F, l, it); if (rep == 0 || REP_PART != 7) phase_finalize(F, l, rep); }
            else if (s == 5 || s == 8) {
                const bool second = s == 8;
                pg8::Gemm g{second ? WSP(bf16_t, WS_U) : WSP(bf16_t, WS_ACT), second ? WSP(bf16_t, WS_W2 + 0u * WSET_STRIDE) : WSP(bf16_t, WS_WOUT + 0u * WSET_STRIDE), M, 1024, second ? FF : 1024};
                pg8::StaticOrder S; S.init(M, 1024, F.G, F.bid, (GEMM_MF & 2) ? 192 : 256);
                const bool first = (l == 0 && !second);
                EpiRes E{INP(0), INP(1) - (size_t)MC * DM, F.ws, WSP(float, WS_MOD) + (size_t)l * 3 * 6144 + (second ? 5120 : 2048), first, rep ? WS_BO : WS_XB, REP_PART == 9 && rep > 0};
                if (!(DIS & 256)) pg8::gemm_phase<EpiRes, pg8::StaticOrder, false, true, (GEMM_MF & 2) ? 3 : 4>(F.lds, g, S, E, F.tid);
            }
            else if (s == 6) { if (!(DIS & 8)) phase_norm(F, l, 1); }
            else {
                pg8::Gemm g{WSP(bf16_t, WS_ACT), WSP(bf16_t, WS_W13 + 0u * WSET_STRIDE), M, NFF2, 1024}; pg8::StaticOrder S; S.init(M, NFF2, F.G, F.bid, (GEMM_MF & 4) ? 192 : 256);
                EpiSwi E{WSP(bf16_t, WS_U), REP_PART == 9 && rep > 0};
                if (!(DIS & 512)) pg8::gemm_phase<EpiSwi, pg8::StaticOrder, true, true, (GEMM_MF & 4) ? 3 : 4>(F.lds, g, S, E, F.tid);
            }
        }
        if (ph + 1 < a.ph_hi) { if (ph == a.ph_lo) { __threadfence(); cg::this_grid().sync(); } else xcd_barrier(xbar); }
    }
}

extern "C" void kernel_launch(void* const* d_in, const int* in_sizes, int n_in, void* d_out, int out_size, void* d_ws, size_t ws_size, hipStream_t stream) {
    static int grid = 0;
    if (grid == 0) {
        int dev = 0, cus = 0, per_cu = 0;
        if (n_in != 34 || ws_size < WS_END) { fprintf(stderr, "kernel_launch: unexpected n_in %d / ws_size %zu (need %zu)\n", n_in, ws_size, (size_t)WS_END); grid = -1; return; }
        if (hipGetDevice(&dev) != hipSuccess || hipDeviceGetAttribute(&cus, hipDeviceAttributeMultiprocessorCount, dev) != hipSuccess) { grid = -1; return; }
        if (hipFuncSetAttribute((const void*)mega, hipFuncAttributeMaxDynamicSharedMemorySize, LDS_BYTES) != hipSuccess) { fprintf(stderr, "kernel_launch: hipFuncSetAttribute failed\n"); grid = -1; return; }
        if (hipOccupancyMaxActiveBlocksPerMultiprocessor(&per_cu, (const void*)mega, 512, LDS_BYTES) != hipSuccess || per_cu < 1) { fprintf(stderr, "kernel_launch: occupancy query says %d\n", per_cu); per_cu = 1; }
        (void)hipGetLastError();
        grid = cus * 1;
        if (grid > cus * per_cu) grid = cus * per_cu;
    }
    if (grid < 0) return;
    (void)hipMemsetAsync((char*)d_ws + WS_CTL, 0, CTL_BYTES, stream);
    Args a{};
    for (int i = 0; i < 34; ++i) a.in[i] = (const float*)d_in[i];
    a.out = (float*)d_out; a.ws = (unsigned char*)d_ws;
#if MK_ONE_LAUNCH
    a.ph_lo = 0; a.ph_hi = NPHASE_RUN;
    void* args[] = {&a};
    hipError_t e = hipLaunchCooperativeKernel((const void*)mega, dim3(grid), dim3(512), args, LDS_BYTES, stream);
    if (e != hipSuccess) fprintf(stderr, "kernel_launch: cooperative launch failed: %s (grid %d)\n", hipGetErrorString(e), grid);
#else
    for (int ph = 0; ph < NPHASE_RUN; ++ph) { a.ph_lo = ph; a.ph_hi = ph + 1; hipLaunchKernelGGL(mega, dim3(grid), dim3(512), LDS_BYTES, stream, a); }
#endif
}
```

```cpp
#include <hip/hip_runtime.h>
#include <hip/hip_cooperative_groups.h>
#include <cstdio>
#include <cstdint>
namespace cg = cooperative_groups;

#ifndef MK_ONE_LAUNCH
#define MK_ONE_LAUNCH 1
#endif

#undef MK_ONE_LAUNCH
#define MK_ONE_LAUNCH 1
#define REP_PHASE -1
#define REP_COUNT 1
#define REP_PART 0
#define RA_REP 0
#define ATT_PROBE 0
namespace pg8 {
#define PG8_LAS __attribute__((address_space(3)))
typedef unsigned short bf16_t;
typedef short bf16x8 __attribute__((ext_vector_type(8)));
typedef float f32x4 __attribute__((ext_vector_type(4)));
typedef unsigned u32x4 __attribute__((ext_vector_type(4)));
constexpr int BM = 256, BK = 64, HALF = 128, HTB = HALF * BK * 2  , STAGE_BYTES = 8 * HTB, NXCD = 8, WGM = 8;

__host__ __device__ __forceinline__ int lds_byte(int r, int c) { const int st = (r >> 4) * 2 + (c >> 5), rr = r & 15, cc = c & 31, ob = rr * 64 + cc * 2; return st * 1024 + (ob ^ (((ob >> 9) & 1) << 5)); }
__host__ __device__ __forceinline__ void stage_rc(int b, int& R, int& C) { const int st = b / 1024, sb = b % 1024, swz = sb ^ (((sb >> 9) & 1) << 5); R = (st >> 1) * 16 + swz / 64; C = (st & 1) * 32 + (swz % 64) / 2; }
__host__ __device__ __forceinline__ int perm32(int rho) { const int n = rho >> 4, i = rho & 15; return 8 * (i >> 2) + 4 * n + (i & 3); }

struct Unit { int pm, pn; };
struct Gemm { const bf16_t* A; const bf16_t* Bt; int M, N, K; };

struct StaticOrder {
    int nM, nN, nwg, G, c;
    __host__ __device__ void init(int M, int N, int G_, int c_, int bm = BM) { nM = M / bm; nN = N / BM; nwg = nM * nN; G = G_; c = c_; }
    __host__ __device__ bool next(int i, Unit& u) const {
        const long L = (long)i * G + c; if (L >= nwg) return false;
        int wgid = (int)L; { const int q = nwg / NXCD, r = nwg % NXCD, xcd = wgid % NXCD, off = wgid / NXCD; wgid = (xcd < r ? xcd * (q + 1) : r * (q + 1) + (xcd - r) * q) + off; }
        const int nig = WGM * nN, gid = wgid / nig, fm = gid * WGM, gsz = (nM - fm) < WGM ? (nM - fm) : WGM;
        u.pm = fm + ((wgid % nig) % gsz); u.pn = (wgid % nig) / gsz; return true;
    }
    __device__ __forceinline__ void a_ready(const Unit&) const {}
    __device__ __forceinline__ void done(const Unit&) const {}
};

template <class Epi, class Sched, bool ALIGN_EPI = false, bool SP2 = false, int MF = 4>
__device__ __forceinline__ void gemm_phase(PG8_LAS unsigned char* lds, const Gemm g, const Sched& S, const Epi& E, const int tid_in) {
    const int tid = tid_in, wid = __builtin_amdgcn_readfirstlane(tid >> 6), lane = tid & 63, wr = wid >> 2, wc = wid & 3, fr = lane & 15, fq = lane >> 4;
    static_assert(MF == 4 || (MF == 3 && SP2), "192-row tiles: SP2 schedule only");
    const int K = g.K, nt = K / BK;
    unsigned voffA[2], voffB[2];
#pragma unroll
    for (int i = 0; i < 2; ++i) { int R, C; stage_rc(tid * 16 + i * 8192, R, C); const int Rb = Epi::PERM ? ((R & ~31) + perm32(R & 31)) : R;
        voffA[i] = (unsigned)(R * K + C) * 2u; voffB[i] = (unsigned)(Rb * K + C) * 2u; }
    const size_t kstep = (size_t)(BK * 2);
    const size_t hstep = (size_t)HALF * K * 2;
    const size_t tstep = 2 * hstep;
    const size_t hstepA = (size_t)(MF * 32) * K * 2, tstepA = 2 * hstepA;
    const unsigned ldsw = (unsigned)wid * 1024u;
    const int aoff = lds_byte(wr * (MF * 16) + fr, fq * 8), boff = lds_byte(wc * 32 + fr, fq * 8);
#define PG8_SA(b, h) (((b) * 2 + (h)) * HTB)
#define PG8_SB(b, h) ((4 + (b) * 2 + (h)) * HTB)
#define PG8_STAGE(bufoff, gbase, voff) do { _Pragma("unroll") for (int _i = 0; _i < 2; ++_i) \
        __builtin_amdgcn_global_load_lds((const unsigned*)((const char*)(gbase) + (voff)[_i]), (PG8_LAS unsigned*)(lds + (bufoff) + ldsw + _i * 8192), 16, 0, 0); } while (0)
#define PG8_STAGEA(bufoff, gbase, voff) do { __builtin_amdgcn_global_load_lds((const unsigned*)((const char*)(gbase) + (voff)[0]), (PG8_LAS unsigned*)(lds + (bufoff) + ldsw), 16, 0, 0); \
        if (MF == 4 || wr == 0) __builtin_amdgcn_global_load_lds((const unsigned*)((const char*)(gbase) + (voff)[1]), (PG8_LAS unsigned*)(lds + (bufoff) + ldsw + 8192), 16, 0, 0); } while (0)
#define PG8_LDA(dst, b, h) do { _Pragma("unroll") for (int m = 0; m < MF; ++m) _Pragma("unroll") for (int k = 0; k < 2; ++k) dst[m][k] = *(const PG8_LAS bf16x8*)(lds + PG8_SA(b, h) + aoff + m * 2048 + k * 1024); } while (0)
#define PG8_LDB(dst, b, h) do { _Pragma("unroll") for (int n = 0; n < 2; ++n) _Pragma("unroll") for (int k = 0; k < 2; ++k) dst[n][k] = *(const PG8_LAS bf16x8*)(lds + PG8_SB(b, h) + boff + n * 2048 + k * 1024); } while (0)
#define PG8_MMA(ai, bj, At, Bt) do { __builtin_amdgcn_s_setprio(1); _Pragma("unroll") for (int m = 0; m < MF; ++m) _Pragma("unroll") for (int n = 0; n < 2; ++n) _Pragma("unroll") for (int k = 0; k < 2; ++k) \
        acc[ai][bj][m][n] = __builtin_amdgcn_mfma_f32_16x16x32_bf16(Bt[n][k], At[m][k], acc[ai][bj][m][n], 0, 0, 0); __builtin_amdgcn_s_setprio(0); } while (0)
#define PG8_WAIT_V(n) asm volatile("s_waitcnt vmcnt(" #n ")" ::: "memory")
#define PG8_WAIT_V2(a, b) do { if (MF == 4 || wr == 0) asm volatile("s_waitcnt vmcnt(" #a ")" ::: "memory"); else asm volatile("s_waitcnt vmcnt(" #b ")" ::: "memory"); } while (0)
#define PG8_WAIT_L(n) asm volatile("s_waitcnt lgkmcnt(" #n ")" ::: "memory")
#define PG8_BAR __builtin_amdgcn_s_barrier()
#define PG8_SCHED __builtin_amdgcn_sched_barrier(0)
    Unit cur, nxt; int ui = 0;
    if (!S.next(0, cur)) return;
    f32x4 acc[2][2][MF][2];
#pragma unroll
    for (int a = 0; a < 2; ++a)
#pragma unroll
        for (int b = 0; b < 2; ++b)
#pragma unroll
            for (int m = 0; m < MF; ++m)
#pragma unroll
                for (int n = 0; n < 2; ++n) acc[a][b][m][n] = (f32x4){0.f, 0.f, 0.f, 0.f};
    bf16x8 At[MF][2], B0[2][2], B1[2][2];
#define PG8_SGPR64(p) ((const char*)(((unsigned long long)(unsigned)__builtin_amdgcn_readfirstlane((int)((unsigned long long)(p) >> 32)) << 32) | (unsigned)__builtin_amdgcn_readfirstlane((int)(unsigned long long)(p))))
    const char* cA = PG8_SGPR64((const char*)g.A + (size_t)cur.pm * tstepA); const char* cB = PG8_SGPR64((const char*)g.Bt + (size_t)cur.pn * tstep);
    S.a_ready(cur);
    if constexpr (SP2) {
        PG8_STAGE(PG8_SB(0, 0), cB, voffB); PG8_STAGE(PG8_SB(0, 1), cB + hstep, voffB); PG8_STAGEA(PG8_SA(0, 0), cA, voffA); PG8_STAGEA(PG8_SA(0, 1), cA + hstepA, voffA);
        if (wr == 1) PG8_BAR;
        PG8_WAIT_V2(2, 1); PG8_BAR;
        PG8_STAGE(PG8_SB(1, 0), cB + kstep, voffB); PG8_STAGEA(PG8_SA(1, 0), cA + kstep, voffA); PG8_STAGE(PG8_SB(1, 1), cB + hstep + kstep, voffB);
        PG8_WAIT_V2(6, 5); PG8_BAR;
    } else {
        PG8_STAGE(PG8_SB(0, 0), cB, voffB); PG8_STAGEA(PG8_SA(0, 0), cA, voffA); PG8_STAGE(PG8_SB(0, 1), cB + hstep, voffB); PG8_STAGEA(PG8_SA(0, 1), cA + hstepA, voffA);
        if (wr == 1) PG8_BAR;
        PG8_WAIT_V(4); PG8_BAR;
        PG8_STAGE(PG8_SB(1, 0), cB + kstep, voffB); PG8_STAGEA(PG8_SA(1, 0), cA + kstep, voffA); PG8_STAGE(PG8_SB(1, 1), cB + hstep + kstep, voffB);
        PG8_WAIT_V(6); PG8_BAR;
    }
    for (;;) {
        const bool has_next = S.next(ui + 1, nxt);
        const char* nA = PG8_SGPR64(has_next ? (const char*)g.A + (size_t)nxt.pm * tstepA : cA); const char* nB = PG8_SGPR64(has_next ? (const char*)g.Bt + (size_t)nxt.pn * tstep : cB);
        for (int t = 0; t < nt; t += 2) {
            const bool last = (t == nt - 2);
            const char* a1 = cA + (size_t)(t + 1) * kstep;
            const char* a2 = last ? nA : cA + (size_t)(t + 2) * kstep; const char* b2 = last ? nB : cB + (size_t)(t + 2) * kstep;
            const char* a3 = a2 + kstep; const char* b3 = b2 + kstep;
            if (last && has_next) S.a_ready(nxt);
            if constexpr (SP2) {
            PG8_LDB(B0, 0, 0); PG8_LDB(B1, 0, 1); PG8_SCHED; PG8_LDA(At, 0, 0); PG8_STAGEA(PG8_SA(1, 1), a1 + hstepA, voffA);
            PG8_WAIT_V2(8, 6); PG8_WAIT_L(0); PG8_BAR; PG8_MMA(0, 0, At, B0); PG8_MMA(0, 1, At, B1); PG8_BAR; PG8_SCHED;
            PG8_LDA(At, 0, 1); PG8_STAGE(PG8_SB(0, 0), b2, voffB); PG8_STAGE(PG8_SB(0, 1), b2 + hstep, voffB); PG8_STAGEA(PG8_SA(0, 0), a2, voffA);
            PG8_WAIT_V2(8, 6); PG8_WAIT_L(0); PG8_BAR; PG8_MMA(1, 0, At, B0); PG8_MMA(1, 1, At, B1); PG8_BAR; PG8_SCHED;
            PG8_LDB(B0, 1, 0); PG8_LDB(B1, 1, 1); PG8_SCHED; PG8_LDA(At, 1, 0); PG8_STAGEA(PG8_SA(0, 1), a2 + hstepA, voffA);
            PG8_WAIT_V2(8, 6); PG8_WAIT_L(0); PG8_BAR; PG8_MMA(0, 0, At, B0); PG8_MMA(0, 1, At, B1); PG8_BAR; PG8_SCHED;
            PG8_LDA(At, 1, 1); PG8_STAGE(PG8_SB(1, 0), b3, voffB); PG8_STAGE(PG8_SB(1, 1), b3 + hstep, voffB); PG8_STAGEA(PG8_SA(1, 0), a3, voffA);
            PG8_WAIT_V2(8, 6); PG8_WAIT_L(0); PG8_BAR; PG8_MMA(1, 0, At, B0); PG8_MMA(1, 1, At, B1); PG8_BAR; PG8_SCHED;
            } else {
            PG8_LDB(B0, 0, 0); PG8_SCHED; PG8_LDA(At, 0, 0); PG8_STAGEA(PG8_SA(1, 1), a1 + hstepA, voffA);
            PG8_WAIT_L(8); PG8_BAR; PG8_WAIT_L(0); PG8_MMA(0, 0, At, B0); PG8_BAR; PG8_SCHED;
            PG8_LDB(B1, 0, 1); PG8_STAGE(PG8_SB(0, 0), b2, voffB);
            PG8_BAR; PG8_WAIT_L(0); PG8_MMA(0, 1, At, B1); PG8_BAR;
            PG8_LDA(At, 0, 1); PG8_STAGEA(PG8_SA(0, 0), a2, voffA);
            PG8_BAR; PG8_WAIT_L(0); PG8_MMA(1, 0, At, B0); PG8_BAR; PG8_SCHED;
            PG8_STAGE(PG8_SB(0, 1), b2 + hstep, voffB);
            PG8_WAIT_V(6); PG8_BAR; PG8_MMA(1, 1, At, B1); PG8_BAR;
            PG8_LDB(B0, 1, 0); PG8_SCHED; PG8_LDA(At, 1, 0); PG8_STAGEA(PG8_SA(0, 1), a2 + hstepA, voffA);
            PG8_WAIT_L(8); PG8_BAR; PG8_WAIT_L(0); PG8_MMA(0, 0, At, B0); PG8_BAR; PG8_SCHED;
            PG8_LDB(B1, 1, 1); PG8_STAGE(PG8_SB(1, 0), b3, voffB);
            PG8_BAR; PG8_WAIT_L(0); PG8_MMA(0, 1, At, B1); PG8_BAR;
            PG8_LDA(At, 1, 1); PG8_STAGEA(PG8_SA(1, 0), a3, voffA);
            PG8_BAR; PG8_WAIT_L(0); PG8_MMA(1, 0, At, B0); PG8_BAR; PG8_SCHED;
            PG8_STAGE(PG8_SB(1, 1), b3 + hstep, voffB);
            PG8_WAIT_V(6); PG8_BAR; PG8_MMA(1, 1, At, B1); PG8_BAR;
            }
        }
        if constexpr (ALIGN_EPI) { if (wr == 0) PG8_BAR; }
        if constexpr (!Epi::AFTER_DRAIN) { E.template operator()<MF>(acc, cur, wr, wc, fr, fq); S.done(cur); }
        if (!has_next) break;
#pragma unroll
        for (int a = 0; a < 2; ++a)
#pragma unroll
            for (int b = 0; b < 2; ++b)
#pragma unroll
                for (int m = 0; m < MF; ++m)
#pragma unroll
                    for (int n = 0; n < 2; ++n) acc[a][b][m][n] = (f32x4){0.f, 0.f, 0.f, 0.f};
        cur = nxt; cA = nA; cB = nB; ++ui;
        if constexpr (ALIGN_EPI) { if (wr == 1) PG8_BAR; }
    }
    PG8_WAIT_V(0);
    if constexpr (!ALIGN_EPI) { if (wr == 0) PG8_BAR; }
    PG8_BAR;
    if constexpr (Epi::AFTER_DRAIN) { E.fused(acc, cur, wr, wc, fr, fq, lds, wid, lane); S.done(cur); }
#undef PG8_SA
#undef PG8_SB
#undef PG8_STAGE
#undef PG8_STAGEA
#undef PG8_WAIT_V2
#undef PG8_LDA
#undef PG8_LDB
#undef PG8_MMA
#undef PG8_WAIT_V
#undef PG8_WAIT_L
#undef PG8_BAR
#undef PG8_SCHED
}
}

using pg8::bf16_t; using pg8::bf16x8; using pg8::f32x4; using pg8::u32x4;
typedef float f32x16 __attribute__((ext_vector_type(16)));
typedef float f32x2 __attribute__((ext_vector_type(2)));
typedef short s16x4 __attribute__((ext_vector_type(4)));
typedef unsigned u32x2 __attribute__((ext_vector_type(2)));
typedef __bf16 bf16x2_t __attribute__((ext_vector_type(2)));
#define LAS __attribute__((address_space(3)))
#define LDG(T, base, boff) (*(const __attribute__((address_space(1))) T*)((const __attribute__((address_space(1))) unsigned char*)(base) + (unsigned)(boff)))
#define STG(T, base, boff) (*(__attribute__((address_space(1))) T*)((__attribute__((address_space(1))) unsigned char*)(base) + (unsigned)(boff)))

__device__ __forceinline__ unsigned pk2(float lo, float hi) { f32x2 v = {lo, hi}; bf16x2_t b = __builtin_convertvector(v, bf16x2_t); return __builtin_bit_cast(unsigned, b); }
__device__ __forceinline__ float bf_lo(unsigned u) { return __uint_as_float(u << 16); }
__device__ __forceinline__ float bf_hi(unsigned u) { return __uint_as_float(u & 0xffff0000u); }
__device__ __forceinline__ f32x4 unpack4(u32x2 v) { return (f32x4){bf_lo(v.x), bf_hi(v.x), bf_lo(v.y), bf_hi(v.y)}; }
__device__ __forceinline__ u32x2 pack4(f32x4 v) { u32x2 r; r.x = pk2(v[0], v[1]); r.y = pk2(v[2], v[3]); return r; }
__device__ __forceinline__ float sigmf(float x) { return __builtin_amdgcn_rcpf(1.f + __expf(-x)); }
template <int CTRL> __device__ __forceinline__ float dpp_f(float x) { return __builtin_bit_cast(float, __builtin_amdgcn_update_dpp(0, __builtin_bit_cast(int, x), CTRL, 0xF, 0xF, true)); }
__device__ __forceinline__ float allreduce16(float x) { x += dpp_f<0xB1>(x); x += dpp_f<0x4E>(x); x += dpp_f<0x141>(x); x += dpp_f<0x140>(x); return x; }
__device__ __forceinline__ float rdlane(float x, int l) { return __builtin_bit_cast(float, __builtin_amdgcn_readlane(__builtin_bit_cast(int, x), l)); }
__device__ __forceinline__ float wave_sum(float v) {
    v = allreduce16(v);
    return (rdlane(v, 0) + rdlane(v, 16)) + (rdlane(v, 32) + rdlane(v, 48));
}
__device__ __forceinline__ float swap32_sum(float x) { auto rr = __builtin_amdgcn_permlane32_swap(__float_as_uint(x), __float_as_uint(x), false, false); return __uint_as_float(rr[0]) + __uint_as_float(rr[1]); }
__device__ __forceinline__ float swap32_max(float x) { auto rr = __builtin_amdgcn_permlane32_swap(__float_as_uint(x), __float_as_uint(x), false, false); return fmaxf(__uint_as_float(rr[0]), __uint_as_float(rr[1])); }

constexpr int M = 12288, MC = 4096, DM = 1024, NIN = 3072, FF = 2816, NFF2 = 5632, DEPTH = 4;
constexpr float LOG2E = 1.4426950408889634f;
constexpr float QSCALE_A = 0.125f * LOG2E;
constexpr float QSCALE_B = 0.17677669529663687f * LOG2E;
constexpr unsigned OFF_AK = 12582912, OFF_AV = 14680064, OFF_BK = 16777216, OFF_BV = 20971520, OFF_CF = 25165824, OFF_CB = 26738688;
constexpr unsigned MiB = 1u << 20;
constexpr unsigned WS_CTL = 0, CTL_BYTES = 1 * MiB;
constexpr unsigned WS_MOD = 1 * MiB;
constexpr unsigned WS_TAB = 1 * MiB + 512 * 1024;
constexpr unsigned WS_SMALLW = 2 * MiB;
constexpr unsigned WS_CACHE = 4 * MiB;
constexpr unsigned WS_WIN = 10 * MiB, WS_WOUT = 16 * MiB, WS_W13 = 18 * MiB, WS_W2 = 29 * MiB;
constexpr unsigned WSET_STRIDE = 184 * MiB;
constexpr unsigned WS_ACT = 35 * MiB;
constexpr unsigned WS_QA = 59 * MiB, WS_KA = 68 * MiB, WS_VTA = 71 * MiB, WS_QB = 74 * MiB, WS_KB = 80 * MiB, WS_VTB = 86 * MiB;
constexpr unsigned WS_RKV = 92 * MiB, WS_CW = 119 * MiB, WS_CA = 122 * MiB, WS_CG = 125 * MiB;
constexpr unsigned WS_YF = 128 * MiB, WS_YB = 146 * MiB;
constexpr unsigned WS_SV = 164 * MiB;
constexpr unsigned WS_BO2 = 182 * MiB, WS_ML = 230 * MiB;
constexpr unsigned WS_XB = 206 * MiB;
constexpr unsigned WS_WSET1 = 194 * MiB;
constexpr unsigned WS_RM = 236 * MiB, WS_RN = 254 * MiB, WS_RP = 324 * MiB, WS_RH = 342 * MiB;
constexpr int NCHUNK = 2304;
constexpr unsigned WS_U = 128 * MiB;
constexpr unsigned WS_G = 290 * MiB, WS_SB = 299 * MiB, WS_BO = 300 * MiB, WS_END = 360 * MiB;
constexpr int SMALLW_L = 147456;
constexpr int TAB_COSA = 0, TAB_SINA = 1024, TAB_COSB = 2048, TAB_SINB = 2560, TAB_LAM = 3072;
constexpr int LDS_BYTES = 147456;
constexpr int NPHASE = 2 + 9 * DEPTH;

struct Args {
    const float* in[34];
    float* out; unsigned char* ws;
    int ph_lo, ph_hi;
};

struct EpiRes {
    static constexpr bool PERM = true, AFTER_DRAIN = false;
    const float* baseC; const float* baseL; unsigned char* ws; const float* gate; bool first; unsigned xo; bool skip = false;
    template <int MF>
    __device__ __forceinline__ void operator()(const f32x4 (&acc)[2][2][MF][2], const pg8::Unit& u, int wr, int wc, int fr_, int fq_) const {
        if (skip) return;
        int fr = fr_, fq = fq_; asm volatile("" : "+v"(fr), "+v"(fq));
        const unsigned col0 = u.pn * 256 + wc * 32 + 8 * fq, rowb = u.pm * (MF * 64) + wr * (MF * 16);
        f32x4 g4[2][2]; int vcur = -1;
#pragma unroll
        for (int ai = 0; ai < 2; ++ai)
#pragma unroll
            for (int m = 0; m < MF; ++m) { const unsigned rf = rowb + ai * (MF * 32) + m * 16, off = (rf + fr) * DM + col0;
                const int v = rf < MC ? 0 : (rf < MC + 4096 ? 1 : 2);
                if (v != vcur) { vcur = v;
#pragma unroll
                    for (int bj = 0; bj < 2; ++bj)
#pragma unroll
                        for (int n = 0; n < 2; ++n) g4[bj][n] = LDG(f32x4, gate, (v * 6144 + col0 + bj * 128 + n * 4) * 4); }
#pragma unroll
                for (int bj = 0; bj < 2; ++bj) { f32x4 b0, b1;
                    if (first) { const float* base = rf < MC ? baseC : baseL; b0 = LDG(f32x4, base, (off + bj * 128) * 4); b1 = LDG(f32x4, base, (off + bj * 128 + 4) * 4); }
                    else { const u32x4 xb = LDG(u32x4, ws, WS_XB + (off + bj * 128) * 2); b0 = (f32x4){bf_lo(xb.x), bf_hi(xb.x), bf_lo(xb.y), bf_hi(xb.y)}; b1 = (f32x4){bf_lo(xb.z), bf_hi(xb.z), bf_lo(xb.w), bf_hi(xb.w)}; }
                    b0 = b0 + g4[bj][0] * acc[ai][bj][m][0]; b1 = b1 + g4[bj][1] * acc[ai][bj][m][1];
                    u32x4 w; w.x = pk2(b0[0], b0[1]); w.y = pk2(b0[2], b0[3]); w.z = pk2(b1[0], b1[1]); w.w = pk2(b1[2], b1[3]);
                    STG(u32x4, ws, xo + (off + bj * 128) * 2) = w; } }
    }
};
struct EpiResD : EpiRes {
    static constexpr bool AFTER_DRAIN = true;
    template <int MF>
    __device__ __forceinline__ void fused(const f32x4 (&acc)[2][2][MF][2], const pg8::Unit& u, int wr, int wc, int fr_, int fq_, LAS unsigned char* lds, int wid, int lane_) const {
        if (skip) return;
        int fr = fr_, fq = fq_, lane = lane_; asm volatile("" : "+v"(fr), "+v"(fq), "+v"(lane));
        constexpr int HR = MF * 32, PITCH = 1040;
        const unsigned c8 = (lane & 31) * 8, colg = u.pn * 256 + c8;
#pragma unroll
        for (int ai = 0; ai < 2; ++ai) {
            if (ai) asm volatile("s_waitcnt lgkmcnt(0)\n\ts_barrier" ::: "memory");
#pragma unroll
            for (int m = 0; m < MF; ++m)
#pragma unroll
                for (int bj = 0; bj < 2; ++bj)
#pragma unroll
                    for (int n = 0; n < 2; ++n) *(LAS f32x4*)(lds + (wr * (MF * 16) + m * 16 + fr) * PITCH + (bj * 128 + wc * 32 + 8 * fq + 4 * n) * 4) = acc[ai][bj][m][n];
            asm volatile("s_waitcnt lgkmcnt(0)\n\ts_barrier" ::: "memory");
#pragma unroll 2
            for (int i = 0; i < HR / 16; ++i) { const unsigned rl = i * 16 + wid * 2 + (lane >> 5), row = u.pm * (MF * 64) + ai * HR + rl, off = row * DM + colg;
                const f32x4 a0 = *(const LAS f32x4*)(lds + rl * PITCH + c8 * 4), a1 = *(const LAS f32x4*)(lds + rl * PITCH + c8 * 4 + 16);
                const unsigned v = row < (unsigned)MC ? 0u : (row < (unsigned)MC + 4096u ? 1u : 2u);
                const f32x4 g0 = LDG(f32x4, gate, (v * 6144 + colg) * 4), g1 = LDG(f32x4, gate, (v * 6144 + colg + 4) * 4);
                f32x4 b0, b1;
                if (first) { const float* base = row < (unsigned)MC ? baseC : baseL; b0 = LDG(f32x4, base, off * 4); b1 = LDG(f32x4, base, (off + 4) * 4); }
                else { const u32x4 xb = LDG(u32x4, ws, WS_XB + off * 2); b0 = (f32x4){bf_lo(xb.x), bf_hi(xb.x), bf_lo(xb.y), bf_hi(xb.y)}; b1 = (f32x4){bf_lo(xb.z), bf_hi(xb.z), bf_lo(xb.w), bf_hi(xb.w)}; }
                b0 = b0 + g0 * a0; b1 = b1 + g1 * a1;
                u32x4 w; w.x = pk2(b0[0], b0[1]); w.y = pk2(b0[2], b0[3]); w.z = pk2(b1[0], b1[1]); w.w = pk2(b1[2], b1[3]);
                STG(u32x4, ws, xo + off * 2) = w; }
        }
    }
};
struct EpiSwi {
    static constexpr bool PERM = true, AFTER_DRAIN = false;
    bf16_t* U; bool skip = false;
    template <int MF>
    __device__ __forceinline__ void operator()(const f32x4 (&acc)[2][2][MF][2], const pg8::Unit& u, int wr, int wc, int fr_, int fq_) const {
        if (skip) return;
        int fr = fr_, fq = fq_; asm volatile("" : "+v"(fr), "+v"(fq));
        const unsigned row0 = u.pm * (MF * 64) + wr * (MF * 16) + fr, oc0 = u.pn * 128 + wc * 32 + 8 * fq;
#pragma unroll
        for (int ai = 0; ai < 2; ++ai)
#pragma unroll
            for (int m = 0; m < MF; ++m) { const unsigned ro = ((row0 + ai * (MF * 32) + m * 16) * FF + oc0) * 2; f32x4 o[2];
#pragma unroll
                for (int bj = 0; bj < 2; ++bj) { const f32x4 g = acc[ai][bj][m][0], up = acc[ai][bj][m][1];
#pragma unroll
                    for (int e = 0; e < 4; ++e) o[bj][e] = g[e] * sigmf(g[e]) * up[e]; }
                const u32x2 lo = pack4(o[0]), hi2 = pack4(o[1]);
                STG(u32x4, U, ro) = (u32x4){lo.x, lo.y, hi2.x, hi2.y}; asm volatile("" ::: "memory"); }
    }
};
struct EpiWin {
    static constexpr bool PERM = true, AFTER_DRAIN = false;
    unsigned char* ws; float* out; int l; LAS unsigned char* lds; bool skip = false;
    template <int MF>
    __device__ __forceinline__ void operator()(const f32x4 (&acc)[2][2][MF][2], const pg8::Unit& u, int wr, int wc, int fr_, int fq_) const {
        if (skip) return;
        int fr = fr_, fq = fq_; asm volatile("" : "+v"(fr), "+v"(fq));
        const unsigned rowb = u.pm * (MF * 64) + wr * (MF * 16), row0 = rowb + fr;
#pragma unroll
        for (int bj = 0; bj < 2; ++bj) {
            const unsigned c32 = u.pn * 256 + bj * 128 + wc * 32;
            const unsigned c8 = c32 + 8 * fq;
            if (c32 < 1152 && (c32 < 512 || c32 >= 640)) {
                const bool isA = c32 < 512;
                const bool isK = isA ? (c32 >= 384) : (c32 >= 896);
                const float qs = isK ? 1.f : (isA ? QSCALE_A : QSCALE_B);
                const unsigned ck = isA ? c8 - 384 : c8 - 896;
                const unsigned dbase = isA ? (isK ? WS_KA + (((ck >> 6) * 4 + ((ck & 63) >> 4)) * 64 + ((ck >> 3) & 1) * 32) * 16 : WS_QA + c8 * 2)
                                           : (isK ? WS_KB + (((ck >> 5) * 2 + ((ck & 31) >> 4)) * 64 + ((ck >> 3) & 1) * 32) * 16 : WS_QB + (c8 - 640) * 2);
                const unsigned dpitch = isA ? 768u : 512u;
#pragma unroll
                for (int ai = 0; ai < 2; ++ai)
#pragma unroll
                    for (int m = 0; m < MF; ++m) {
                        const unsigned row = row0 + ai * (MF * 32) + m * 16; const bool lat = rowb + ai * (MF * 32) + m * 16 >= (unsigned)MC;
                        f32x4 v0 = acc[ai][bj][m][0], v1 = acc[ai][bj][m][1];
                        if (lat) {
                            const unsigned t = (row - MC) & 4095, rp = t >> 6, cp = t & 63;
                            unsigned to_;
                            if (isA) { const unsigned pos = ((c32 >> 5) & 1) ? cp : rp; to_ = WS_TAB + (TAB_COSA + pos * 16 + 4 * fq) * 4; }
                            else { const unsigned pos = (fq >> 1) ? cp : rp; to_ = WS_TAB + (TAB_COSB + pos * 8 + 4 * (fq & 1)) * 4; }
                            const f32x4 c4 = LDG(f32x4, ws, to_), s4 = LDG(f32x4, ws, to_ + (isA ? 4096u : 2048u));
                            f32x4 w0, w1;
                            w0[0] = v0[0] * c4[0] - v0[1] * s4[0]; w0[1] = v0[1] * c4[0] + v0[0] * s4[0];
                            w0[2] = v0[2] * c4[1] - v0[3] * s4[1]; w0[3] = v0[3] * c4[1] + v0[2] * s4[1];
                            w1[0] = v1[0] * c4[2] - v1[1] * s4[2]; w1[1] = v1[1] * c4[2] + v1[0] * s4[2];
                            w1[2] = v1[2] * c4[3] - v1[3] * s4[3]; w1[3] = v1[3] * c4[3] + v1[2] * s4[3];
                            v0 = w0; v1 = w1;
                        } else if (isK) {
                            const unsigned b = row >> 8, t = row & 255;
                            const f32x4 ev = {v0[0], v0[2], v1[0], v1[2]}, od = {v0[1], v0[3], v1[1], v1[3]};
                            if (isA) { const unsigned o = (OFF_AK + ((b * 4 + l) * 256 + t) * 128 + (c32 - 384) + 4 * fq) * 4; STG(f32x4, out, o) = ev; STG(f32x4, out, o + 64) = od; }
                            else { const unsigned o = (OFF_BK + ((b * 4 + l) * 256 + t) * 256 + ((c8 - 896) & ~15u) + 4 * (fq & 1)) * 4; STG(f32x4, out, o) = ev; STG(f32x4, out, o + 32) = od; }
                        }
                        v0 = v0 * qs; v1 = v1 * qs;
                        u32x4 w; w.x = pk2(v0[0], v0[1]); w.y = pk2(v0[2], v0[3]); w.z = pk2(v1[0], v1[1]); w.w = pk2(v1[2], v1[3]);
                        STG(u32x4, ws, isK ? dbase + (row >> 5) * (isA ? 8192u : 16384u) + (row & 31) * 16 : dbase + row * dpitch) = w;
                        asm volatile("" ::: "memory");
                    }
            } else if (c32 < 1408) {
                const bool isA = c32 < 640;
                const unsigned cc = isA ? (c8 - 512) : (c8 - 1152), cw = isA ? (c32 - 512) : (c32 - 1152);
                const unsigned vfrag = (isA ? WS_VTA : WS_VTB) + (((cw >> 6) * 2 + ((cw >> 5) & 1)) * 2) * 1024;
                LAS unsigned char* lw = lds + (wr * 4 + wc) * 1024;
                LAS bf16_t* lq = (LAS bf16_t*)(lw + ((((fr >> 2) & 1) * 32 + 8 * fq) * 16 + (4 * (fr >> 3) + (fr & 3)) * 2));
#pragma unroll
                for (int ai = 0; ai < 2; ++ai)
#pragma unroll
                    for (int m = 0; m < MF; ++m) {
                        const unsigned rf = rowb + ai * (MF * 32) + m * 16, row = rf + fr; const bool lat = rf >= (unsigned)MC;
                        const f32x4 v0 = acc[ai][bj][m][0], v1 = acc[ai][bj][m][1];
                        if (!lat) { const unsigned b = row >> 8, t = row & 255;
                            const unsigned o = isA ? (OFF_AV + ((b * 4 + l) * 256 + t) * 128 + cc) * 4 : (OFF_BV + ((b * 4 + l) * 256 + t) * 256 + cc) * 4;
                            STG(f32x4, out, o) = v0; STG(f32x4, out, o + 16) = v1; }
                        const unsigned p0 = pk2(v0[0], v0[1]), p1 = pk2(v0[2], v0[3]), p2 = pk2(v1[0], v1[1]), p3 = pk2(v1[2], v1[3]);
                        lq[0 * 8] = (bf16_t)(p0 & 0xffff); lq[1 * 8] = (bf16_t)(p0 >> 16); lq[2 * 8] = (bf16_t)(p1 & 0xffff); lq[3 * 8] = (bf16_t)(p1 >> 16);
                        lq[4 * 8] = (bf16_t)(p2 & 0xffff); lq[5 * 8] = (bf16_t)(p2 >> 16); lq[6 * 8] = (bf16_t)(p3 & 0xffff); lq[7 * 8] = (bf16_t)(p3 >> 16);
                        const u32x4 tv = *(const LAS u32x4*)(lw + (fq * 16 + fr) * 16);
                        STG(u32x4, ws, vfrag + (rf >> 5) * (isA ? 8192u : 16384u) + ((rf >> 4) & 1) * 1024 + (fq * 16 + fr) * 16) = tv;
                        asm volatile("" ::: "memory");
                    }
            } else if (c32 < 2944) {
                const int kind = c32 < 2560 ? 0 : (c32 < 2688 ? 1 : (c32 < 2816 ? 2 : 3));
                const unsigned dbase = kind == 0 ? WS_RKV + (c8 - 1408) * 2 : (kind == 1 ? WS_CW + (c8 - 2560) * 2 : (kind == 2 ? WS_CA + (c8 - 2688) * 2 : WS_CG + (c8 - 2816) * 2));
                const unsigned dpitch = kind == 0 ? 2304u : 256u;
#pragma unroll
                for (int ai = 0; ai < 2; ++ai)
#pragma unroll
                    for (int m = 0; m < MF; ++m) {
                        const unsigned row = row0 + ai * (MF * 32) + m * 16; const bool lat = rowb + ai * (MF * 32) + m * 16 >= (unsigned)MC;
                        f32x4 v0 = acc[ai][bj][m][0], v1 = acc[ai][bj][m][1];
                        if (kind == 1) {
#pragma unroll
                            for (int e = 0; e < 4; ++e) { v0[e] = 1.f - 2.f * __builtin_amdgcn_rcpf(__expf(2.f * v0[e]) + 1.f); v1[e] = 1.f - 2.f * __builtin_amdgcn_rcpf(__expf(2.f * v1[e]) + 1.f); }
                        } else if (kind == 3) {
#pragma unroll
                            for (int e = 0; e < 4; ++e) { v0[e] = sigmf(v0[e]); v1[e] = sigmf(v1[e]); }
                        }
                        u32x4 w; w.x = pk2(v0[0], v0[1]); w.y = pk2(v0[2], v0[3]); w.z = pk2(v1[0], v1[1]); w.w = pk2(v1[2], v1[3]);
                        STG(u32x4, ws, dbase + row * dpitch) = w;
                        asm volatile("" ::: "memory");
                    }
            }
        }
    }
};

struct Frame {
    LAS unsigned char* lds;
    const float* const* in;
    float* out; unsigned char* ws;
    int tid, lane, wave, gw, ngw, G, bid, crep;
};
#define GAS __attribute__((address_space(1)))
template <class T> __device__ __forceinline__ T* gptr(T* p) {
#if defined(__HIP_DEVICE_COMPILE__)
    __builtin_assume(!__builtin_amdgcn_is_shared((const void*)p)); __builtin_assume(!__builtin_amdgcn_is_private((const void*)p));
#endif
    return p; }
#define INP(k) gptr(F.in[k])
#define WSP(T, off) gptr((T*)(F.ws + (off)))

__device__ __forceinline__ void phase_prologue(Frame& F) {
    const float* cvec = INP(8); const float* cctx = INP(9); const float* ada_w = INP(10); const float* ada_b = INP(11);
    LAS float* sl = (LAS float*)F.lds;
    LAS float* red = (LAS float*)(F.lds + 16384);
    for (int i = F.tid; i < 3072; i += 512) { const int v = i >> 10, k = i & 1023; const float x = v == 0 ? cctx[k] : cvec[(v - 1) * 1024 + k]; sl[i] = x / (1.f + __expf(-x)); }
    __syncthreads();
    float* mod = WSP(float, WS_MOD);
    for (int it = F.bid; it < 384; it += F.G) {
        const int l = it / 96, n0 = (it % 96) * 64;
        const float* W = ada_w + (size_t)l * 1024 * 6144 + n0 + F.lane;
        float a0 = 0.f, a1 = 0.f, a2 = 0.f;
        const int k0 = F.wave * 128;
#pragma unroll 8
        for (int k = k0; k < k0 + 128; ++k) { const float w = *(const GAS float*)(W + (size_t)k * 6144); a0 += sl[k] * w; a1 += sl[1024 + k] * w; a2 += sl[2048 + k] * w; }
        red[(F.wave * 3 + 0) * 64 + F.lane] = a0; red[(F.wave * 3 + 1) * 64 + F.lane] = a1; red[(F.wave * 3 + 2) * 64 + F.lane] = a2;
        __syncthreads();
        if (F.wave < 3) { float s = ada_b[l * 6144 + n0 + F.lane];
#pragma unroll
            for (int w = 0; w < 8; ++w) s += red[(w * 3 + F.wave) * 64 + F.lane];
            mod[(size_t)(l * 3 + F.wave) * 6144 + n0 + F.lane] = s; }
        __syncthreads();
    }
    float* tab = WSP(float, WS_TAB);
    if (F.bid == F.G - 1) {
        for (int i = F.tid; i < 1024; i += 512) { const int pos = i >> 4, f = i & 15; const float ang = (float)pos * __builtin_amdgcn_exp2f(-(float)f * (13.287712379549449f / 16.f)); tab[TAB_COSA + i] = __cosf(ang); tab[TAB_SINA + i] = __sinf(ang); }
        for (int i = F.tid; i < 512; i += 512) { const int pos = i >> 3, f = i & 7; const float ang = (float)pos * __builtin_amdgcn_exp2f(-(float)f * (13.287712379549449f / 8.f)); tab[TAB_COSB + i] = __cosf(ang); tab[TAB_SINB + i] = __sinf(ang); }
        if (F.wave < 4) { const float* lp = INP(16) + F.wave * 128; const int d = F.lane & 31;
            const float p1 = wave_sum(F.lane < 32 ? lp[d] * lp[32 + d] : 0.f), p2 = wave_sum(F.lane < 32 ? 0.f : lp[64 + d] * lp[96 + d]);
            if (F.lane == 0) tab[TAB_LAM + F.wave] = __expf(p1) - __expf(p2); }
    }
    const int gtid = F.bid * 512 + F.tid, gnt = F.G * 512;
    { bf16_t* sw = WSP(bf16_t, WS_SMALLW); const float* cw2 = INP(20); const float* ca2 = INP(22); const float* cg2 = INP(23);
      for (int idx = gtid; idx < 4 * SMALLW_L; idx += gnt) { const int l = idx / SMALLW_L, r = idx % SMALLW_L; float v;
          if (r < 98304) { const int which = r / 49152, rr = r % 49152, d = rr / 24576, ch = (rr % 24576) / 64, k = rr % 64; v = (which ? ca2 : cw2)[((size_t)(l * 2 + d) * 64 + k) * 384 + ch]; }
          else { const int rr = r - 98304, ch = rr / 128, k = rr % 128; v = cg2[((size_t)l * 128 + k) * 384 + ch]; }
          sw[idx] = (bf16_t)(pk2(v, 0.f) & 0xffff); } }
    { bf16_t* kca = WSP(bf16_t, WS_CACHE); bf16_t* vca = kca + 524288; bf16_t* kcb = vca + 524288; bf16_t* vcb = kcb + 1048576;
      const float* cak = INP(2); const float* cav = INP(3); const float* cbk = INP(4); const float* cbv = INP(5);
      for (int e = gtid; e < 524288; e += gnt) {
          const int j = e & 7, ln = (e >> 3) & 63, hi = ln >> 5, r32 = ln & 31, blk = (e >> 12) & 15, bl = e >> 16;
          { const int s = (e >> 9) & 3, kvh = (e >> 11) & 1, cp = kvh * 64 + 16 * s + 8 * hi + j, o = cp & 31, c = (cp - o) + (o >> 1) + 16 * (o & 1);
            kca[e] = (bf16_t)(pk2(cak[((size_t)bl * 512 + blk * 32 + r32) * 128 + c], 0.f) & 0xffff); }
          { const int ks = (e >> 9) & 1, db = (e >> 10) & 1, kvh = (e >> 11) & 1, key = blk * 32 + 16 * ks + 8 * (j >> 2) + 4 * hi + (j & 3);
            vca[e] = (bf16_t)(pk2(cav[((size_t)bl * 512 + key) * 128 + kvh * 64 + db * 32 + r32], 0.f) & 0xffff); } }
      for (int e = gtid; e < 1048576; e += gnt) {
          const int j = e & 7, ln = (e >> 3) & 63, hi = ln >> 5, r32 = ln & 31, blk = (e >> 13) & 15, bl = e >> 17;
          { const int s = (e >> 9) & 1, hm = (e >> 10) & 7, cp = hm * 32 + 16 * s + 8 * hi + j, o = cp & 15, c = (cp - o) + (o >> 1) + 8 * (o & 1);
            kcb[e] = (bf16_t)(pk2(cbk[((size_t)bl * 512 + blk * 32 + r32) * 256 + c], 0.f) & 0xffff); }
          { const int ks = (e >> 9) & 1, db = (e >> 10) & 1, h = (e >> 11) & 3, key = blk * 32 + 16 * ks + 8 * (j >> 2) + 4 * hi + (j & 3);
            vcb[e] = (bf16_t)(pk2(cbv[((size_t)bl * 512 + key) * 256 + h * 64 + db * 32 + r32], 0.f) & 0xffff); } } }
    for (int st = 0; st < 1; ++st) { u32x4* z = (u32x4*)(WSP(bf16_t, WS_WIN + st * WSET_STRIDE) + (size_t)2944 * 1024); unsigned z0; asm volatile("v_mov_b32 %0, 0" : "=v"(z0)); for (int i = gtid; i < 128 * 1024 / 8; i += gnt) z[i] = (u32x4){z0, z0, z0, z0}; }
}

template <int MAP> __device__ __forceinline__ int dest_row(int n) {
    if (MAP == 1) {
        if (n < 512) { const int o = n & 31; return (n - o) + 2 * (o & 15) + (o >> 4); }
        if (n >= 640 && n < 1152) { const int o = n & 15; return (n - o) + 2 * (o & 7) + (o >> 3); }
        return n;
    }
    if (MAP == 2 || MAP == 3) return (n >> 7) * 256 + ((n >> 2) & 1) * 128 + ((n >> 5) & 3) * 32 + ((n >> 3) & 3) * 8 + (MAP == 3 ? 4 : 0) + (n & 3);
    return n;
}
template <int MAP> __device__ __forceinline__ void transpose_item(const float* W, int K, int N, bf16_t* WT, LAS float* scr, int item, int lane) {
    const int nblk = N / 32, kb = item / nblk, nb = item % nblk, k0 = 64 * kb, n0 = 32 * nb;
    f32x4 wv[8];
#pragma unroll
    for (int i = 0; i < 8; ++i) wv[i] = *(const GAS f32x4*)(W + (size_t)(k0 + 8 * i + (lane >> 3)) * N + n0 + 4 * (lane & 7));
#pragma unroll
    for (int i = 0; i < 8; ++i) { LAS float* d = scr + (8 * i + (lane >> 3)) * 33 + 4 * (lane & 7); d[0] = wv[i][0]; d[1] = wv[i][1]; d[2] = wv[i][2]; d[3] = wv[i][3]; }
    asm volatile("s_waitcnt lgkmcnt(0)" ::: "memory");
    const int c = lane & 7;
#pragma unroll
    for (int j = 0; j < 4; ++j) { const int n = (lane >> 3) + 8 * j; const LAS float* s = scr + (8 * c) * 33 + n;
        u32x4 o; o.x = pk2(s[0 * 33], s[1 * 33]); o.y = pk2(s[2 * 33], s[3 * 33]); o.z = pk2(s[4 * 33], s[5 * 33]); o.w = pk2(s[6 * 33], s[7 * 33]);
        *(GAS u32x4*)(WT + (size_t)dest_row<MAP>(n0 + n) * K + k0 + 8 * c) = o; }
    asm volatile("s_waitcnt lgkmcnt(0)" ::: "memory");
}
template <int MAP> __device__ __forceinline__ void convert_item(const float* W, int K, int N, bf16_t* WT, int item, int lane) {
    const int nblk = N / 64, kb = item / nblk, nb = item % nblk, n = nb * 64 + lane;
    const GAS float* src = (const GAS float*)W + (size_t)(kb * 128) * N + n;
    GAS bf16_t* dst = (GAS bf16_t*)WT + (size_t)dest_row<MAP>(n) * K + kb * 128;
#pragma unroll
    for (int g = 0; g < 16; ++g) { float v[8];
#pragma unroll
        for (int e = 0; e < 8; ++e) v[e] = src[(size_t)(8 * g + e) * N];
        u32x4 o; o.x = pk2(v[0], v[1]); o.y = pk2(v[2], v[3]); o.z = pk2(v[4], v[5]); o.w = pk2(v[6], v[7]);
        *(GAS u32x4*)(dst + 8 * g) = o; }
}
constexpr int CV_IN = 46 * 8, CV_OUT = 16 * 8, CV_1 = 44 * 8, CV_2 = 16 * 22, CV_TOTAL = CV_IN + CV_OUT + 2 * CV_1 + CV_2;
__device__ __forceinline__ void convert_item_any(Frame& F, int l, int it) {
    const unsigned so = 0u * WSET_STRIDE;
    int r = it;
    if (r < CV_IN) { convert_item<1>(INP(14) + (size_t)l * 1024 * 2944, 1024, 2944, WSP(bf16_t, WS_WIN + so), r, F.lane); return; } r -= CV_IN;
    if (r < CV_OUT) { convert_item<0>(INP(29) + (size_t)l * 1024 * 1024, 1024, 1024, WSP(bf16_t, WS_WOUT + so), r, F.lane); return; } r -= CV_OUT;
    if (r < CV_1) { convert_item<2>(INP(30) + (size_t)l * 1024 * FF, 1024, FF, WSP(bf16_t, WS_W13 + so), r, F.lane); return; } r -= CV_1;
    if (r < CV_1) { convert_item<3>(INP(31) + (size_t)l * 1024 * FF, 1024, FF, WSP(bf16_t, WS_W13 + so), r, F.lane); return; } r -= CV_1;
    convert_item<0>(INP(32) + (size_t)l * FF * 1024, FF, 1024, WSP(bf16_t, WS_W2 + so), r, F.lane);
}
__device__ __forceinline__ void convert_weights(Frame& F, int l) {
    LAS float* scr = (LAS float*)(F.lds + F.wave * 16384); const unsigned so = 0u * WSET_STRIDE;
    const float* w_in = INP(14) + (size_t)l * 1024 * 2944; const float* w_out = INP(29) + (size_t)l * 1024 * 1024;
    const float* w1 = INP(30) + (size_t)l * 1024 * FF; const float* w3 = INP(31) + (size_t)l * 1024 * FF; const float* w2 = INP(32) + (size_t)l * FF * 1024;
    constexpr int I_IN = 16 * 92, I_OUT = 16 * 32, I_1 = 16 * 88, I_2 = 44 * 32;
    constexpr int NIT = I_IN + I_OUT + 2 * I_1 + I_2;
    for (int it = F.gw; it < NIT; it += F.ngw) {
        int r = it;
        if (r < I_IN) { transpose_item<1>(w_in, 1024, 2944, WSP(bf16_t, WS_WIN + so), scr, r, F.lane); continue; } r -= I_IN;
        if (r < I_OUT) { transpose_item<0>(w_out, 1024, 1024, WSP(bf16_t, WS_WOUT + so), scr, r, F.lane); continue; } r -= I_OUT;
        if (r < I_1) { transpose_item<2>(w1, 1024, FF, WSP(bf16_t, WS_W13 + so), scr, r, F.lane); continue; } r -= I_1;
        if (r < I_1) { transpose_item<3>(w3, 1024, FF, WSP(bf16_t, WS_W13 + so), scr, r, F.lane); continue; } r -= I_1;
        transpose_item<0>(w2, FF, 1024, WSP(bf16_t, WS_W2 + so), scr, r, F.lane);
    }
}

__device__ __forceinline__ void phase_norm(Frame& F, int l, int which  ) {
    const float* g = (which ? INP(13) : INP(12)) + l * 1024;
    const float* mod = WSP(float, WS_MOD) + (size_t)l * 3 * 6144 + (which ? 3072 : 0);
    bf16_t* H = WSP(bf16_t, WS_ACT);
    const bool first = (l == 0 && which == 0);
    f32x4 gv[4];
#pragma unroll
    for (int j = 0; j < 4; ++j) gv[j] = *(const GAS f32x4*)(g + 4 * F.lane + 256 * j);
    for (int row0 = F.gw; row0 < M; row0 += 2 * F.ngw) {
        f32x4 v[2][4]; float ss[2] = {0.f, 0.f};
#pragma unroll
        for (int u = 0; u < 2; ++u) { const int row = row0 + u * F.ngw; if (row < M) {
            if (first) { const float* xr = row < MC ? INP(0) + (size_t)row * DM : INP(1) + (size_t)(row - MC) * DM;
#pragma unroll
                for (int j = 0; j < 4; ++j) v[u][j] = *(const GAS f32x4*)(xr + 4 * F.lane + 256 * j); }
            else {
#pragma unroll
                for (int j = 0; j < 4; ++j) v[u][j] = unpack4(LDG(u32x2, F.ws, WS_XB + ((unsigned)row * DM + 4 * F.lane + 256 * j) * 2)); }
#pragma unroll
            for (int j = 0; j < 4; ++j) ss[u] += (v[u][j][0] * v[u][j][0] + v[u][j][1] * v[u][j][1]) + (v[u][j][2] * v[u][j][2] + v[u][j][3] * v[u][j][3]); } }
#pragma unroll
        for (int u = 0; u < 2; ++u) { const int row = row0 + u * F.ngw; if (row < M) {
            const float* mv = mod + (row < MC ? 0 : (row < 2 * MC ? 1 : 2)) * 6144;
            const float rstd = rsqrtf(wave_sum(ss[u]) * (1.f / 1024.f) + 1e-6f);
#pragma unroll
            for (int j = 0; j < 4; ++j) { const f32x4 sh = *(const GAS f32x4*)(mv + 4 * F.lane + 256 * j), sc = *(const GAS f32x4*)(mv + 1024 + 4 * F.lane + 256 * j);
                const f32x4 h = v[u][j] * rstd * gv[j] * (sc + 1.f) + sh;
                *(GAS u32x2*)(H + (size_t)row * DM + 4 * F.lane + 256 * j) = pack4(h); } } }
    }
}
__device__ __forceinline__ void phase_final_norm(Frame& F) {
    const float* g = INP(33);
    f32x4 gv[4];
#pragma unroll
    for (int j = 0; j < 4; ++j) gv[j] = *(const GAS f32x4*)(g + 4 * F.lane + 256 * j);
    for (int row = F.gw; row < M; row += F.ngw) {
        float* xr = gptr(F.out + (size_t)row * DM);
        f32x4 v[4]; float ss = 0.f;
#pragma unroll
        for (int j = 0; j < 4; ++j) { v[j] = unpack4(LDG(u32x2, F.ws, WS_XB + ((unsigned)row * DM + 4 * F.lane + 256 * j) * 2)); ss += (v[j][0] * v[j][0] + v[j][1] * v[j][1]) + (v[j][2] * v[j][2] + v[j][3] * v[j][3]); }
        const float rstd = rsqrtf(wave_sum(ss) * (1.f / 1024.f) + 1e-6f);
#pragma unroll
        for (int j = 0; j < 4; ++j) *(GAS f32x4*)(xr + 4 * F.lane + 256 * j) = v[j] * rstd * gv[j];
    }
}

#define MFMA32(a, b, c) __builtin_amdgcn_mfma_f32_32x32x16_bf16((a), (b), (c), 0, 0, 0)
#ifndef ATT_PROBE
#define ATT_PROBE 0
#endif
struct AttnQ { float m, l; bool mz; f32x16 o[2]; };
template <int DQK, bool MASK, int NQ>
__device__ __forceinline__ void attn_block(const bf16x8 (&qf)[NQ][DQK / 16], const bf16x8 (&kf)[DQK / 16], const bf16x8 (&vf)[4], AttnQ (&st)[NQ], int b, const int (&qpos)[NQ], int kpos0, int hi) {
    constexpr int NS = DQK / 16;
    f32x16 sc[NQ];
#pragma unroll
    for (int q = 0; q < NQ; ++q) { const f32x16 z = {}; sc[q] = MFMA32(kf[0], qf[q][0], z);
#pragma unroll
        for (int s = 1; s < NS; ++s) sc[q] = MFMA32(kf[s], qf[q][s], sc[q]); }
#pragma unroll
    for (int q = 0; q < NQ; ++q) {
        if (!st[q].mz) {
#pragma unroll
            for (int r = 0; r < 16; ++r) sc[q][r] -= st[q].m; }
        if (MASK) {
#pragma unroll
            for (int r = 0; r < 16; ++r) { const int key = kpos0 + 32 * b + (r & 3) + 8 * (r >> 2) + 4 * hi; const int dlt = key - qpos[q]; if (dlt > 128 || dlt < -128) sc[q][r] = -1e30f; }
        }
        float bm = fmaxf(fmaxf(sc[q][0], sc[q][1]), sc[q][2]);
#pragma unroll
        for (int r = 3; r < 15; r += 2) bm = fmaxf(fmaxf(bm, sc[q][r]), sc[q][r + 1]);
        bm = fmaxf(bm, sc[q][15]);
        bm = swap32_max(bm);
        if (__builtin_amdgcn_ballot_w64(bm > 64.f) != 0ull) {
            const float d = fmaxf(bm, 0.f);
            const float alpha = __builtin_amdgcn_exp2f(-d);
            st[q].m += d; st[q].l *= alpha; st[q].mz = false;
#pragma unroll
            for (int r = 0; r < 16; ++r) { st[q].o[0][r] *= alpha; st[q].o[1][r] *= alpha; sc[q][r] -= d; }
        }
#if ATT_PROBE == 1
        { float dmy = 0.f;
#pragma unroll
          for (int r = 0; r < 16; ++r) { float e_; asm volatile("v_exp_f32 %0, %1" : "=v"(e_) : "v"(sc[q][r])); dmy += e_; }
          asm volatile("" :: "v"(dmy)); }
#endif
        f32x2 rs2 = {0.f, 0.f};
#pragma unroll
        for (int r = 0; r < 16; r += 2) { sc[q][r] = __builtin_amdgcn_exp2f(sc[q][r]); sc[q][r + 1] = __builtin_amdgcn_exp2f(sc[q][r + 1]); rs2 += (f32x2){sc[q][r], sc[q][r + 1]}; }
        st[q].l += rs2[0] + rs2[1];
#if ATT_PROBE == 3
        { float d0 = 0.f, d1 = 0.f, d2 = 0.f, d3 = 0.f;
#pragma unroll
          for (int rr = 0; rr < 10; ++rr) { asm volatile("v_add_f32 %0, %0, %4\n\tv_add_f32 %1, %1, %5\n\tv_add_f32 %2, %2, %6\n\tv_add_f32 %3, %3, %7" : "+v"(d0), "+v"(d1), "+v"(d2), "+v"(d3) : "v"(sc[q][0]), "v"(sc[q][1]), "v"(sc[q][2]), "v"(sc[q][3])); }
          asm volatile("" :: "v"(d0), "v"(d1), "v"(d2), "v"(d3)); }
#endif
#if ATT_PROBE == 2
        { f32x16 dm = sc[q]; dm = MFMA32(kf[0], qf[q][0], dm); dm = MFMA32(kf[0], qf[q][0], dm); dm = MFMA32(kf[0], qf[q][0], dm); asm volatile("" :: "v"(dm)); }
#endif
        bf16x8 pb[2];
#pragma unroll
        for (int ks = 0; ks < 2; ++ks) { u32x4 w; w.x = pk2(sc[q][8 * ks], sc[q][8 * ks + 1]); w.y = pk2(sc[q][8 * ks + 2], sc[q][8 * ks + 3]); w.z = pk2(sc[q][8 * ks + 4], sc[q][8 * ks + 5]); w.w = pk2(sc[q][8 * ks + 6], sc[q][8 * ks + 7]); pb[ks] = __builtin_bit_cast(bf16x8, w); }
#pragma unroll
        for (int db = 0; db < 2; ++db)
#pragma unroll
            for (int ks = 0; ks < 2; ++ks) st[q].o[db] = MFMA32(vf[db * 2 + ks], pb[ks], st[q].o[db]);
    }
}
template <int DQK, bool MASK, int NQ>
__device__ __forceinline__ void attn_seg(const unsigned char* ws, const bf16x8 (&qf)[NQ][DQK / 16], AttnQ (&st)[NQ],
                                         unsigned kp, unsigned kblk  , unsigned vp, unsigned vblk, int nblk, const int (&qpos)[NQ], int kpos0, int hi) {
    constexpr int NS = DQK / 16;
    const GAS unsigned char* kq = (const GAS unsigned char*)ws + kp; const GAS unsigned char* vq = (const GAS unsigned char*)ws + vp;
    bf16x8 ka[NS], va[4], kb[NS], vb[4];
#define ATT_LOAD(kd, vd) do { _Pragma("unroll") for (int s = 0; s < NS; ++s) kd[s] = *(const GAS bf16x8*)(kq + 1024 * s); _Pragma("unroll") for (int f = 0; f < 4; ++f) vd[f] = *(const GAS bf16x8*)(vq + 1024 * f); } while (0)
    ATT_LOAD(ka, va);
    int b = 0;
    for (; b + 1 < nblk; b += 2) {
        kq += kblk; vq += vblk; ATT_LOAD(kb, vb);
        attn_block<DQK, MASK, NQ>(qf, ka, va, st, b, qpos, kpos0, hi);
        if (b + 2 < nblk) { kq += kblk; vq += vblk; }
        ATT_LOAD(ka, va);
        attn_block<DQK, MASK, NQ>(qf, kb, vb, st, b + 1, qpos, kpos0, hi);
    }
    if (b < nblk) attn_block<DQK, MASK, NQ>(qf, ka, va, st, b, qpos, kpos0, hi);
#undef ATT_LOAD
}
__device__ __forceinline__ void attnq_init(AttnQ& s, float l0) { s.m = 0.f; s.mz = true; s.l = l0; s.o[0] = (f32x16){}; s.o[1] = (f32x16){}; }
__device__ __forceinline__ void attn_a_item(Frame& F, int l, bool lat, int item) {
    int lane = F.lane; asm volatile("" : "+v"(lane));
    const unsigned char* ws = F.ws;
    const unsigned r32 = lane & 31, hi = lane >> 5;
    const unsigned nqb = lat ? 128 : 8;
    const unsigned qb = item % nqb, hq = (item / nqb) % 6, b = item / (nqb * 6), kvh = hq / 3;
    const unsigned seq0 = lat ? MC + b * 4096 : b * 256, q0 = qb * 32, row = seq0 + q0 + r32;
    const unsigned qo = WS_QA + (row * 384 + hq * 64 + 8 * hi) * 2;
    bf16x8 qf[1][4];
#pragma unroll
    for (int s = 0; s < 4; ++s) qf[0][s] = LDG(bf16x8, ws, qo + 32 * s);
    AttnQ st[1]; attnq_init(st[0], hi == 0 ? __builtin_amdgcn_exp2f(INP(15)[l * 6 + hq] * LOG2E) : 0.f);
    const int qpos[1] = {(int)(q0 + r32)};
    const unsigned fo = kvh * 4096 + lane * 16;
    if (!lat) {
        attn_seg<64, false, 1>(ws, qf, st, WS_KA + (seq0 >> 5) * 8192 + fo, 8192, WS_VTA + (seq0 >> 5) * 8192 + fo, 8192, 8, qpos, 0, hi);
    } else {
        const int ks = (int)q0 - 128 < 0 ? 0 : (int)q0 - 128, ke = q0 + 160 > 4096 ? 4096 : q0 + 160;
        attn_seg<64, true, 1>(ws, qf, st, WS_KA + ((seq0 + ks) >> 5) * 8192 + fo, 8192, WS_VTA + ((seq0 + ks) >> 5) * 8192 + fo, 8192, (ke - ks) >> 5, qpos, ks, hi);
        attn_seg<64, false, 1>(ws, qf, st, WS_CACHE + (b * 4 + l) * 131072 + fo, 8192, WS_CACHE + 1 * MiB + (b * 4 + l) * 131072 + fo, 8192, 16, qpos, 0, hi);
    }
    const float rl = 1.f / swap32_sum(st[0].l);
    const unsigned oo = WS_ACT + (row * DM + hq * 64 + 4 * hi) * 2;
#pragma unroll
    for (int db = 0; db < 2; ++db)
#pragma unroll
        for (int g = 0; g < 4; ++g) { const f32x4 v = {st[0].o[db][4 * g] * rl, st[0].o[db][4 * g + 1] * rl, st[0].o[db][4 * g + 2] * rl, st[0].o[db][4 * g + 3] * rl}; STG(u32x2, F.ws, oo + (32 * db + 8 * g) * 2) = pack4(v); }
}
__device__ __forceinline__ void attn_b_store(Frame& F, const AttnQ& s, unsigned mp, unsigned kh, unsigned row, unsigned h, unsigned hi) {
    const float lt = swap32_sum(s.l);
    const unsigned oo = WS_BO2 + (((mp * 2 + kh) * M + row) * 256 + h * 64 + 4 * hi) * 2;
#pragma unroll
    for (int db = 0; db < 2; ++db)
#pragma unroll
        for (int g = 0; g < 4; ++g) STG(u32x2, F.ws, oo + (32 * db + 8 * g) * 2) = pack4((f32x4){s.o[db][4 * g], s.o[db][4 * g + 1], s.o[db][4 * g + 2], s.o[db][4 * g + 3]});
    if (hi == 0) STG(f32x2, F.ws, WS_ML + ((((mp * 2 + kh) * M + row) * 4 + h) * 2) * 4) = (f32x2){s.m, lt};
}
__device__ __forceinline__ void attn_b_item(Frame& F, int l, bool lat, int item) {
    int lane = F.lane; asm volatile("" : "+v"(lane));
    const unsigned char* ws = F.ws;
    const unsigned r32 = lane & 31, hi = lane >> 5;
    if (lat) {
        const unsigned kh = item & 1, qb = (item >> 1) & 63, mp = (item >> 7) & 1, h = (item >> 8) & 3, b = item >> 10;
        const unsigned seq0 = MC + b * 4096, row0 = seq0 + qb * 64 + r32;
        bf16x8 qf[2][2];
#pragma unroll
        for (int q = 0; q < 2; ++q)
#pragma unroll
            for (int s = 0; s < 2; ++s) qf[q][s] = LDG(bf16x8, ws, WS_QB + ((row0 + 32 * q) * 256 + h * 64 + mp * 32 + 8 * hi) * 2 + 32 * s);
        AttnQ st[2]; attnq_init(st[0], 0.f); attnq_init(st[1], 0.f);
        const int qpos[2] = {0, 0};
        const unsigned kfo = (h * 2 + mp) * 2048 + lane * 16, vfo = h * 4096 + lane * 16;
        const unsigned blk0 = kh ? 72u : 0u, nb = kh ? 56 : 72;
        attn_seg<32, false, 2>(ws, qf, st, WS_KB + ((seq0 >> 5) + blk0) * 16384 + kfo, 16384, WS_VTB + ((seq0 >> 5) + blk0) * 16384 + vfo, 16384, nb, qpos, 0, hi);
        if (kh) attn_seg<32, false, 2>(ws, qf, st, WS_CACHE + 2 * MiB + (b * 4 + l) * 262144 + kfo, 16384, WS_CACHE + 4 * MiB + (b * 4 + l) * 262144 + vfo, 16384, 16, qpos, 0, hi);
        attn_b_store(F, st[0], mp, kh, row0, h, hi); attn_b_store(F, st[1], mp, kh, row0 + 32, h, hi);
    } else {
        const unsigned qb = item & 7, mp = (item >> 3) & 1, h = (item >> 4) & 3, b = item >> 6;
        const unsigned seq0 = b * 256, row = seq0 + qb * 32 + r32;
        bf16x8 qf[1][2];
#pragma unroll
        for (int s = 0; s < 2; ++s) qf[0][s] = LDG(bf16x8, ws, WS_QB + (row * 256 + h * 64 + mp * 32 + 8 * hi) * 2 + 32 * s);
        AttnQ st[1]; attnq_init(st[0], 0.f);
        const int qpos[1] = {0};
        const unsigned kfo = (h * 2 + mp) * 2048 + lane * 16, vfo = h * 4096 + lane * 16;
        attn_seg<32, false, 1>(ws, qf, st, WS_KB + (seq0 >> 5) * 16384 + kfo, 16384, WS_VTB + (seq0 >> 5) * 16384 + vfo, 16384, 8, qpos, 0, hi);
        attn_b_store(F, st[0], mp, 0, row, h, hi);
    }
}

constexpr int L_KT = 0, L_RT = 9216, L_BT = 18432, L_KK = 27648, L_VT = 36864, L_KKT = 46080, L_BTT = 55296, L_A1 = 64512, L_RHS2 = 81920, L_WT = 99328, L_U0T = 108544, L_GC = 117760, L_X0 = 118016;
constexpr int RPB = 144, RPF = 272;
__device__ __forceinline__ void chunk_decode(int cid, unsigned& seq0, int& T, unsigned& b, unsigned& h, unsigned& dir, int& c) {
    unsigned chain;
    if (cid < 768) { chain = (unsigned)cid >> 2; c = cid & 3; T = 256; b = chain / 12; seq0 = b * 256; }
    else { const unsigned x = (unsigned)cid - 768; chain = x >> 6; c = (int)(x & 63); T = 4096; b = chain / 12; seq0 = MC + b * 4096; }
    dir = chain & 1; h = (chain >> 1) % 6;
}
__device__ __forceinline__ bf16x8 acc_frag(const f32x16& x, int ks, float sgn) {
    u32x4 w; w.x = pk2(sgn * x[8 * ks], sgn * x[8 * ks + 1]); w.y = pk2(sgn * x[8 * ks + 2], sgn * x[8 * ks + 3]); w.z = pk2(sgn * x[8 * ks + 4], sgn * x[8 * ks + 5]); w.w = pk2(sgn * x[8 * ks + 6], sgn * x[8 * ks + 7]);
    return __builtin_bit_cast(bf16x8, w);
}
__device__ __forceinline__ bf16x8 lds_frag_nat(const LAS unsigned char* img, unsigned row, int ks, unsigned hi) { return *(const LAS bf16x8*)(img + row * RPB + (16 * ks + 8 * hi) * 2); }
__device__ __forceinline__ bf16x8 lds_frag_perm(const LAS unsigned char* img, unsigned row, int k0, unsigned hi) {
    const s16x4 a = *(const LAS s16x4*)(img + row * RPB + (k0 + 4 * hi) * 2), b = *(const LAS s16x4*)(img + row * RPB + (k0 + 8 + 4 * hi) * 2);
    return (bf16x8){a[0], a[1], a[2], a[3], b[0], b[1], b[2], b[3]};
}
__device__ __forceinline__ f32x16 gram_tile(const LAS unsigned char* lds, int aimg, int bimg, int sb, int tb, unsigned r32, unsigned hi, bool strict) {
    f32x16 acc = {};
#pragma unroll
    for (int ks = 0; ks < 4; ++ks) acc = MFMA32(lds_frag_nat(lds + aimg, 32 * sb + r32, ks, hi), lds_frag_nat(lds + bimg, 32 * tb + r32, ks, hi), acc);
    if (sb == tb) {
#pragma unroll
        for (int r = 0; r < 16; ++r) { const unsigned s_ = (r & 3) + 8 * (r >> 2) + 4 * hi; const bool keep = strict ? s_ < r32 : s_ <= r32; acc[r] = keep ? acc[r] : 0.f; }
    }
    return acc;
}
__device__ __forceinline__ void lds_barrier() { asm volatile("s_waitcnt lgkmcnt(0)\n\ts_barrier" ::: "memory"); }
__device__ __forceinline__ void rwkv_chunk_block(Frame& F, int l, int cid) {
    int lane = F.lane; asm volatile("" : "+v"(lane));
    const unsigned char* ws = F.ws; LAS unsigned char* lds = F.lds;
    const int w = F.wave; const unsigned r32 = lane & 31, hi = lane >> 5;
    unsigned seq0, b, h, dir; int T, c; chunk_decode(cid, seq0, T, b, h, dir, c);
    const int q0 = 64 * c;
#ifndef RA_REP
#define RA_REP 0
#endif
    const int role = w >> 1, tb = w & 1;
    const unsigned swo = WS_SMALLW + l * (SMALLW_L * 2);
    {
        const int pw_ = w < 4, pb = (w >> 1) & 1, cb = w & 1;
        const int p_ = 32 * pb + r32; const unsigned tokp = seq0 + (dir ? T - 1 - (q0 + p_) : q0 + p_);
        const unsigned xo = (pw_ ? WS_CW : WS_CA) + (tokp * 128 + dir * 64 + 8 * hi) * 2, wo = swo + ((pw_ ? 0 : 49152) + (dir * 384 + h * 64 + 32 * cb + r32) * 64 + 8 * hi) * 2;
        f32x16 acc = {};
#pragma unroll
        for (int ks = 0; ks < 4; ++ks) acc = MFMA32(LDG(bf16x8, ws, xo + 32 * ks), LDG(bf16x8, ws, wo + 32 * ks), acc);
        {
            const float bias = LDG(float, pw_ ? INP(19) : INP(21), ((l * 2 + dir) * 384 + h * 64 + 32 * cb + r32) * 4);
#pragma unroll
            for (int r = 0; r < 16; ++r) { const float sg = sigmf(bias + acc[r]);
                *(LAS float*)(lds + (pw_ ? L_A1 : L_RHS2) + (32 * pb + (r & 3) + 8 * (r >> 2) + 4 * hi) * RPF + (32 * cb + r32) * 4) = pw_ ? -0.606531f * sg : sg; }
        }
        if (dir == 0 && w < 4) {
            f32x16 ag = {};
            const unsigned go = WS_CG + (tokp * 128 + 8 * hi) * 2, gw_ = swo + (98304 + (h * 64 + 32 * cb + r32) * 128 + 8 * hi) * 2;
#pragma unroll
            for (int ks = 0; ks < 8; ++ks) ag = MFMA32(LDG(bf16x8, ws, go + 32 * ks), LDG(bf16x8, ws, gw_ + 32 * ks), ag);
#pragma unroll
            for (int r = 0; r < 16; ++r) { const int pp_ = 32 * pb + (r & 3) + 8 * (r >> 2) + 4 * hi; const unsigned tk = seq0 + q0 + pp_;
                STG(bf16_t, F.ws, WS_G + (tk * 384 + h * 64 + 32 * cb + r32) * 2) = (bf16_t)(pk2(ag[r], 0.f) & 0xffff); }
        }
    }
    lds_barrier();
    {
        const unsigned cch = h * 64 + lane;
        const float* convp = INP(18) + (size_t)l * 3 * 1152;
        float cw_[3][3];
#pragma unroll
        for (int tap = 0; tap < 3; ++tap)
#pragma unroll
            for (int seg = 0; seg < 3; ++seg) cw_[tap][seg] = LDG(float, convp, (tap * 1152 + seg * 384 + cch) * 4);
        const float ckk = LDG(float, INP(24), (l * 384 + cch) * 4), cka = LDG(float, INP(25), (l * 384 + cch) * 4), crk = LDG(float, INP(26), (l * 384 + cch) * 4);
        const int tb0 = dir ? T - 1 - (q0 + 8 * w + 7) : q0 + 8 * w;
        float xr[10][3];
#pragma unroll
        for (int rr = 0; rr < 10; ++rr) { const int tr = tb0 - 1 + rr; const bool ok = tr >= 0 && tr < T; const unsigned tk = seq0 + (ok ? tr : tb0);
#pragma unroll
            for (int seg = 0; seg < 3; ++seg) { const float x = bf_lo((unsigned)LDG(bf16_t, ws, WS_RKV + (tk * 1152 + seg * 384 + cch) * 2)); xr[rr][seg] = ok ? x : 0.f; } }
        float lwv[8], kkv[8], btv[8], kdv[8], rv[8], vv[8], g = 0.f;
#pragma unroll
        for (int pp = 0; pp < 8; ++pp) {
            const int rr = 1 + (dir ? 7 - pp : pp); const int p = 8 * w + pp; const unsigned tok = seq0 + (unsigned)(tb0 + rr - 1);
            const float r_ = xr[rr - 1][0] * cw_[0][0] + xr[rr][0] * cw_[1][0] + xr[rr + 1][0] * cw_[2][0];
            const float k_ = xr[rr - 1][1] * cw_[0][1] + xr[rr][1] * cw_[1][1] + xr[rr + 1][1] * cw_[2][1];
            const float v_ = xr[rr - 1][2] * cw_[0][2] + xr[rr][2] * cw_[1][2] + xr[rr + 1][2] * cw_[2][2];
            const float kraw = k_ * ckk; const float n2 = wave_sum(kraw * kraw); const float kk_ = kraw * __builtin_amdgcn_rsqf(fmaxf(n2, 1e-24f));
            const float lw = *(const LAS float*)(lds + L_A1 + p * RPF + lane * 4), av = *(const LAS float*)(lds + L_RHS2 + p * RPF + lane * 4);
            const float kd_ = k_ * (1.f + (av - 1.f) * cka);
            const float bon = wave_sum(r_ * kd_ * crk);
            if (lane == 0) STG(float, F.ws, WS_SB + ((dir * M + tok) * 8 + h) * 4) = bon;
            if (dir == 0) STG(float, F.ws, WS_SV + (tok * 384 + cch) * 4) = v_;
            lwv[pp] = lw; kkv[pp] = kk_; btv[pp] = kk_ * av; kdv[pp] = kd_; rv[pp] = r_; vv[pp] = v_; g += lw;
        }
        g = 0.f;
        for (int wq = 0; wq < w; ++wq) { float t8[8];
#pragma unroll
            for (int e = 0; e < 8; ++e) t8[e] = *(const LAS float*)(lds + L_A1 + (8 * wq + e) * RPF + lane * 4);
            g += ((t8[0] + t8[1]) + (t8[2] + t8[3])) + ((t8[4] + t8[5]) + (t8[6] + t8[7])); }
        unsigned vt[4], kkt[4], btt[4]; float e_pos = __expf(g);
#pragma unroll
        for (int pp = 0; pp < 8; ++pp) {
            const int p = 8 * w + pp;
            const float e_prev = e_pos; g += lwv[pp]; e_pos = __expf(g); const float e_neg = __expf(-g);
            const unsigned pk_kr = pk2(kkv[pp] * e_prev, rv[pp] * e_pos), pk_bk = pk2(btv[pp] * e_neg, kdv[pp] * e_neg), pk_v = pk2(vv[pp], 0.f);
            *(LAS bf16_t*)(lds + L_KT + p * RPB + lane * 2) = (bf16_t)(pk_kr & 0xffff); *(LAS bf16_t*)(lds + L_RT + p * RPB + lane * 2) = (bf16_t)(pk_kr >> 16);
            *(LAS bf16_t*)(lds + L_BT + p * RPB + lane * 2) = (bf16_t)(pk_bk & 0xffff); *(LAS bf16_t*)(lds + L_KK + p * RPB + lane * 2) = (bf16_t)(pk_bk >> 16);
            if (pp & 1) { vt[pp >> 1] |= pk_v << 16; kkt[pp >> 1] |= pk_bk & 0xffff0000u; btt[pp >> 1] |= pk_bk << 16; }
            else { vt[pp >> 1] = pk_v & 0xffff; kkt[pp >> 1] = pk_bk >> 16; btt[pp >> 1] = pk_bk & 0xffff; }
        }
        *(LAS u32x4*)(lds + L_VT + lane * RPB + 16 * w) = (u32x4){vt[0], vt[1], vt[2], vt[3]};
        *(LAS u32x4*)(lds + L_KKT + lane * RPB + 16 * w) = (u32x4){kkt[0], kkt[1], kkt[2], kkt[3]};
        *(LAS u32x4*)(lds + L_BTT + lane * RPB + 16 * w) = (u32x4){btt[0], btt[1], btt[2], btt[3]};
        if (w == 7) *(LAS float*)(lds + L_GC + lane * 4) = e_pos;
    }
    lds_barrier();
    f32x16 keep[2]; bf16x8 x4f[2][2];
    if (role == 0) {
        for (int sb = 0; sb <= tb; ++sb) { const f32x16 x = gram_tile(lds, L_BT, L_KT, sb, tb, r32, hi, true);
            if (sb == tb) {
#pragma unroll
                for (int r = 0; r < 16; ++r) *(LAS float*)(lds + L_A1 + tb * 4608 + ((r & 3) + 8 * (r >> 2) + 4 * hi) * 144 + r32 * 4) = -x[r];
            } else {
#pragma unroll
                for (int g4 = 0; g4 < 4; ++g4) *(LAS f32x4*)(lds + L_A1 + 9216 + r32 * 144 + (8 * g4 + 4 * hi) * 4) = (f32x4){x[4 * g4], x[4 * g4 + 1], x[4 * g4 + 2], x[4 * g4 + 3]};
            } }
    } else if (role == 1) {
        f32x16 o[2] = {};
        for (int sb = 0; sb <= tb; ++sb) {
            const f32x16 x = gram_tile(lds, L_KK, L_KT, sb, tb, r32, hi, true);
#pragma unroll
            for (int ks = 0; ks < 2; ++ks) { const bf16x8 a = acc_frag(x, ks, 1.f);
#pragma unroll
                for (int ib = 0; ib < 2; ++ib) o[ib] = MFMA32(a, lds_frag_perm(lds + L_VT, 32 * ib + r32, 32 * sb + 16 * ks, hi), o[ib]); }
        }
#pragma unroll
        for (int ib = 0; ib < 2; ++ib)
#pragma unroll
            for (int r = 0; r < 16; ++r) *(LAS float*)(lds + L_RHS2 + (32 * tb + (r & 3) + 8 * (r >> 2) + 4 * hi) * RPF + (32 * ib + r32) * 4) = o[ib][r];
    } else if (role == 2) {
#pragma unroll
        for (int sb = 0; sb < 2; ++sb) { x4f[sb][0] = (bf16x8){}; x4f[sb][1] = (bf16x8){}; }
        keep[0] = (f32x16){}; keep[1] = (f32x16){};
        for (int sb = 0; sb <= tb; ++sb) {
            const f32x16 x3 = gram_tile(lds, L_KK, L_RT, sb, tb, r32, hi, false), x4 = gram_tile(lds, L_BT, L_RT, sb, tb, r32, hi, false);
#pragma unroll
            for (int ks = 0; ks < 2; ++ks) { const bf16x8 a3 = acc_frag(x3, ks, 1.f); const bf16x8 a4 = acc_frag(x4, ks, -1.f);
                if (sb == 0) x4f[0][ks] = a4; else x4f[1][ks] = a4;
#pragma unroll
                for (int cb = 0; cb < 2; ++cb) keep[cb] = MFMA32(a3, lds_frag_perm(lds + L_VT, 32 * cb + r32, 32 * sb + 16 * ks, hi), keep[cb]); }
        }
    } else {
        keep[0] = (f32x16){}; keep[1] = (f32x16){};
#pragma unroll
        for (int ks = 0; ks < 4; ++ks) { const bf16x8 ak = lds_frag_nat(lds + L_KKT, 32 * tb + r32, ks, hi);
#pragma unroll
            for (int cb = 0; cb < 2; ++cb) keep[cb] = MFMA32(ak, lds_frag_nat(lds + L_VT, 32 * cb + r32, ks, hi), keep[cb]); }
    }
    lds_barrier();
    if (w < 2) {
        const LAS unsigned char* a1p = lds + L_A1; asm volatile("" : "+v"(a1p));
        LAS unsigned char* xp = lds + (w == 0 ? L_X0 : L_RHS2) + lane * 4; asm volatile("" : "+v"(xp));
        const LAS unsigned char* kp = lds + L_KT + lane * 2; asm volatile("" : "+v"(kp));
        LAS unsigned char* dst = lds + (w == 0 ? L_WT : L_U0T) + lane * RPB; asm volatile("" : "+v"(dst));
#pragma unroll
        for (int B = 0; B < 2; ++B) {
            float acc[32];
            if (w == 0 && B == 0) {
#pragma unroll
                for (int r = 0; r < 32; ++r) acc[r] = bf_lo((unsigned)*(const LAS bf16_t*)(kp + r * RPB));
            } else {
#pragma unroll
                for (int r = 0; r < 32; ++r) acc[r] = *(const LAS float*)(xp + (32 * B + r) * RPF);
            }
            f32x2 ac2[16];
#pragma unroll
            for (int k = 0; k < 16; ++k) ac2[k] = (f32x2){acc[2 * k], acc[2 * k + 1]};
            f32x4 ca[8], cn[8];
#pragma unroll
            for (int tg = 0; tg < 8; ++tg) ca[tg] = *(const LAS f32x4*)(a1p + B * 4608 + tg * 16);
#pragma unroll
            for (int s_ = 0; s_ < 31; ++s_) {
                if (s_ + 1 < 31) {
#pragma unroll
                    for (int tg = (s_ + 2) / 4; tg < 8; ++tg) cn[tg] = *(const LAS f32x4*)(a1p + B * 4608 + (s_ + 1) * 144 + tg * 16);
                }
                __builtin_amdgcn_sched_barrier(0);
                const float xs = ac2[s_ >> 1][s_ & 1];
                const f32x2 xs2 = {xs, xs};
#pragma unroll
                for (int tg = (s_ + 1) / 4; tg < 8; ++tg) {
                    ac2[2 * tg] = __builtin_elementwise_fma((f32x2){ca[tg][0], ca[tg][1]}, xs2, ac2[2 * tg]);
                    ac2[2 * tg + 1] = __builtin_elementwise_fma((f32x2){ca[tg][2], ca[tg][3]}, xs2, ac2[2 * tg + 1]); }
                __builtin_amdgcn_sched_barrier(0);
#pragma unroll
                for (int tg = 0; tg < 8; ++tg) ca[tg] = cn[tg];
            }
#pragma unroll
            for (int k = 0; k < 16; ++k) { acc[2 * k] = ac2[k][0]; acc[2 * k + 1] = ac2[k][1]; }
#pragma unroll
            for (int k8 = 0; k8 < 4; ++k8) { u32x4 v; v.x = pk2(acc[8 * k8], acc[8 * k8 + 1]); v.y = pk2(acc[8 * k8 + 2], acc[8 * k8 + 3]); v.z = pk2(acc[8 * k8 + 4], acc[8 * k8 + 5]); v.w = pk2(acc[8 * k8 + 6], acc[8 * k8 + 7]);
                *(LAS u32x4*)(dst + 64 * B + 16 * k8) = v; }
            if (B == 0) {
                asm volatile("s_waitcnt lgkmcnt(0)" ::: "memory");
                f32x16 u[2];
#pragma unroll
                for (int cb = 0; cb < 2; ++cb)
#pragma unroll
                    for (int r = 0; r < 16; ++r) { const int t = 32 + (r & 3) + 8 * (r >> 2) + 4 * hi;
                        u[cb][r] = w == 0 ? bf_lo((unsigned)*(const LAS bf16_t*)(lds + L_KT + t * RPB + (32 * cb + r32) * 2)) : *(const LAS float*)(lds + L_RHS2 + t * RPF + (32 * cb + r32) * 4); }
#pragma unroll
                for (int ks = 0; ks < 2; ++ks) { const f32x4 a0 = *(const LAS f32x4*)(lds + L_A1 + 9216 + r32 * 144 + (16 * ks + 8 * hi) * 4), a1 = *(const LAS f32x4*)(lds + L_A1 + 9216 + r32 * 144 + (16 * ks + 8 * hi + 4) * 4);
                    u32x4 aw; aw.x = pk2(-a0[0], -a0[1]); aw.y = pk2(-a0[2], -a0[3]); aw.z = pk2(-a1[0], -a1[1]); aw.w = pk2(-a1[2], -a1[3]);
#pragma unroll
                    for (int cb = 0; cb < 2; ++cb) u[cb] = MFMA32(__builtin_bit_cast(bf16x8, aw), lds_frag_nat(lds + (w == 0 ? L_WT : L_U0T), 32 * cb + r32, ks, hi), u[cb]); }
#pragma unroll
                for (int cb = 0; cb < 2; ++cb)
#pragma unroll
                    for (int r = 0; r < 16; ++r) *(LAS float*)(lds + (w == 0 ? L_X0 : L_RHS2) + (32 + (r & 3) + 8 * (r >> 2) + 4 * hi) * RPF + (32 * cb + r32) * 4) = u[cb][r];
                asm volatile("s_waitcnt lgkmcnt(0)" ::: "memory");
            }
        }
    }
    lds_barrier();
    if (role == 2) {
        f32x16 pj[2];
#pragma unroll
        for (int cb = 0; cb < 2; ++cb)
#pragma unroll
            for (int g = 0; g < 4; ++g) { const u32x2 v = *(const LAS u32x2*)(lds + L_RT + (32 * tb + r32) * RPB + (32 * cb + 8 * g + 4 * hi) * 2);
                pj[cb][4 * g] = bf_lo(v.x); pj[cb][4 * g + 1] = bf_hi(v.x); pj[cb][4 * g + 2] = bf_lo(v.y); pj[cb][4 * g + 3] = bf_hi(v.y); }
#pragma unroll
        for (int sb = 0; sb < 2; ++sb)
#pragma unroll
            for (int ks = 0; ks < 2; ++ks)
#pragma unroll
                for (int cb = 0; cb < 2; ++cb) {
                    keep[cb] = MFMA32(x4f[sb][ks], lds_frag_perm(lds + L_U0T, 32 * cb + r32, 32 * sb + 16 * ks, hi), keep[cb]);
                    pj[cb] = MFMA32(lds_frag_perm(lds + L_WT, 32 * cb + r32, 32 * sb + 16 * ks, hi), x4f[sb][ks], pj[cb]); }
        f32x16 (&y0)[2] = keep;
        const unsigned nc_ = (unsigned)T >> 6, kst = dir ? nc_ - 1 - (unsigned)c : (unsigned)c, yidx = cid < 768 ? (b * 6 + h) * 4 + kst : 384 + (b * 6 + h) * 64 + kst;
        const unsigned ybase = (dir ? WS_YB : WS_YF) + yidx * 16384 + ((dir ? 1 - tb : tb) * 8) * 1024 + (dir ? (lane ^ 32) : lane) * 16;
#pragma unroll
        for (int cb = 0; cb < 2; ++cb)
#pragma unroll
            for (int q = 0; q < 4; ++q) { const f32x4 vf = {y0[cb][4 * q], y0[cb][4 * q + 1], y0[cb][4 * q + 2], y0[cb][4 * q + 3]}, vb = {y0[cb][4 * q + 3], y0[cb][4 * q + 2], y0[cb][4 * q + 1], y0[cb][4 * q]};
                STG(f32x4, F.ws, ybase + (cb * 4 + (dir ? 3 - q : q)) * 1024) = dir ? vb : vf; }
#pragma unroll
        for (int cb = 0; cb < 2; ++cb)
#pragma unroll
            for (int s2 = 0; s2 < 2; ++s2) { u32x4 w; w.x = pk2(pj[cb][8 * s2], pj[cb][8 * s2 + 1]); w.y = pk2(pj[cb][8 * s2 + 2], pj[cb][8 * s2 + 3]); w.z = pk2(pj[cb][8 * s2 + 4], pj[cb][8 * s2 + 5]); w.w = pk2(pj[cb][8 * s2 + 6], pj[cb][8 * s2 + 7]);
                STG(u32x4, F.ws, WS_RP + (unsigned)cid * 8192 + ((tb * 2 + cb) * 2 + s2) * 1024 + lane * 16) = w; }
    } else if (role == 3) {
        const int jb = tb;
        f32x16 q1[2] = {}, q2[2] = {}; f32x16 (&n1)[2] = keep;
#pragma unroll
        for (int ks = 0; ks < 4; ++ks) { const bf16x8 a = lds_frag_nat(lds + L_BTT, 32 * jb + r32, ks, hi);
#pragma unroll
            for (int cb = 0; cb < 2; ++cb) { q1[cb] = MFMA32(lds_frag_nat(lds + L_WT, 32 * cb + r32, ks, hi), a, q1[cb]); q2[cb] = MFMA32(a, lds_frag_nat(lds + L_U0T, 32 * cb + r32, ks, hi), q2[cb]); } }
#pragma unroll
        for (int q = 0; q < 4; ++q) { f32x4 gc4;
#pragma unroll
            for (int e = 0; e < 4; ++e) gc4[e] = *(const LAS float*)(lds + L_GC + (32 * jb + e + 8 * q + 4 * hi) * 4);
#pragma unroll
            for (int cb = 0; cb < 2; ++cb) { f32x4 nv;
#pragma unroll
                for (int e = 0; e < 4; ++e) nv[e] = gc4[e] * (n1[cb][4 * q + e] - q2[cb][4 * q + e]);
                STG(f32x4, F.ws, WS_RN + ((((unsigned)cid * 2 + jb) * 2 + cb) * 4 + q) * 1024 + lane * 16) = nv; } }
        { const float gl = *(const LAS float*)(lds + L_GC + (32 * jb + r32) * 4);
#pragma unroll
          for (int cb = 0; cb < 2; ++cb)
#pragma unroll
            for (int s2 = 0; s2 < 2; ++s2) { float mv[8];
#pragma unroll
                for (int e = 0; e < 8; ++e) { const int r = 8 * s2 + e; const unsigned c = 32 * cb + (r & 3) + 8 * (r >> 2) + 4 * hi; mv[e] = (c == 32 * jb + r32 ? gl : 0.f) - gl * q1[cb][r]; }
                u32x4 w; w.x = pk2(mv[0], mv[1]); w.y = pk2(mv[2], mv[3]); w.z = pk2(mv[4], mv[5]); w.w = pk2(mv[6], mv[7]);
                STG(u32x4, F.ws, WS_RM + (unsigned)cid * 8192 + ((jb * 2 + cb) * 2 + s2) * 1024 + lane * 16) = w; } }
    }
    lds_barrier();
}
__device__ __forceinline__ void rwkv_chain_wave(Frame& F, int l, bool lat, int chain, int ib) {
    int lane = F.lane; asm volatile("" : "+v"(lane));
    const unsigned char* ws = F.ws; const unsigned r32 = lane & 31, hi = lane >> 5;
    const unsigned dir = chain & 1, h = (chain >> 1) % 6, b = chain / 12;
    const int nc = lat ? 64 : 4; const unsigned cid0 = lat ? 768 + chain * 64 : chain * 4;
    const unsigned i = 32 * ib + r32;
    const unsigned so = ((((b * 4 + l) * 6 + h) * 64 + i) * 64) * 4;
    f32x16 H[2];
#pragma unroll
    for (int jb = 0; jb < 2; ++jb)
#pragma unroll
        for (int g4 = 0; g4 < 4; ++g4) { f32x4 v = {0.f, 0.f, 0.f, 0.f}; if (lat) v = LDG(f32x4, dir ? INP(7) : INP(6), so + (32 * jb + 8 * g4 + 4 * hi) * 4);
            H[jb][4 * g4] = v[0]; H[jb][4 * g4 + 1] = v[1]; H[jb][4 * g4 + 2] = v[2]; H[jb][4 * g4 + 3] = v[3]; }
    bf16x8 maA[2][2][2], maB[2][2][2]; f32x16 ntA[2], ntB[2];
    const GAS unsigned char* pm = (const GAS unsigned char*)ws + (WS_RM + cid0 * 8192 + lane * 16);
    const GAS unsigned char* pn = (const GAS unsigned char*)ws + (WS_RN + (cid0 * 4 + ib) * 4096 + lane * 16);
#define RB_LOAD(ma, nt, k_) do { \
        _Pragma("unroll") for (int jo = 0; jo < 2; ++jo) _Pragma("unroll") for (int ji = 0; ji < 2; ++ji) _Pragma("unroll") for (int ks = 0; ks < 2; ++ks) ma[jo][ji][ks] = *(const GAS bf16x8*)(pm + ((k_) * 8192 + ((jo * 2 + ji) * 2 + ks) * 1024)); \
        _Pragma("unroll") for (int jo = 0; jo < 2; ++jo) _Pragma("unroll") for (int q = 0; q < 4; ++q) { const f32x4 t_ = *(const GAS f32x4*)(pn + ((k_) * 16384 + (jo * 8 + q) * 1024)); \
            nt[jo][4 * q] = t_[0]; nt[jo][4 * q + 1] = t_[1]; nt[jo][4 * q + 2] = t_[2]; nt[jo][4 * q + 3] = t_[3]; } } while (0)
#define RB_STEP(ma, nt, cid_) do { \
        bf16x8 hf[2][2]; \
        _Pragma("unroll") for (int ji = 0; ji < 2; ++ji) { hf[ji][0] = acc_frag(H[ji], 0, 1.f); hf[ji][1] = acc_frag(H[ji], 1, 1.f); } \
        _Pragma("unroll") for (int ji = 0; ji < 2; ++ji) _Pragma("unroll") for (int ks = 0; ks < 2; ++ks) STG(bf16x8, F.ws, WS_RH + (cid_) * 8192 + ((ib * 2 + ji) * 2 + ks) * 1024 + lane * 16) = hf[ji][ks]; \
        f32x16 acc[2] = {nt[0], nt[1]}; \
        _Pragma("unroll") for (int jo = 0; jo < 2; ++jo) _Pragma("unroll") for (int ji = 0; ji < 2; ++ji) _Pragma("unroll") for (int ks = 0; ks < 2; ++ks) acc[jo] = MFMA32(ma[jo][ji][ks], hf[ji][ks], acc[jo]); \
        H[0] = acc[0]; H[1] = acc[1]; } while (0)
    RB_LOAD(maA, ntA, 0); RB_LOAD(maB, ntB, 1);
#pragma unroll 1
    for (int c = 0; c < nc; c += 2) {
        const unsigned cid = cid0 + c;
        RB_STEP(maA, ntA, cid);
        if (c + 2 < nc) RB_LOAD(maA, ntA, 2);
        RB_STEP(maB, ntB, cid + 1);
        if (c + 2 < nc) RB_LOAD(maB, ntB, 3);
        pm += 16384; pn += 32768;
    }
#undef RB_LOAD
#undef RB_STEP
    if (!lat) {
#pragma unroll
        for (int jb = 0; jb < 2; ++jb)
#pragma unroll
            for (int g4 = 0; g4 < 4; ++g4) STG(f32x4, F.out, (dir ? OFF_CB : OFF_CF) * 4 + so + (32 * jb + 8 * g4 + 4 * hi) * 4) = (f32x4){H[jb][4 * g4], H[jb][4 * g4 + 1], H[jb][4 * g4 + 2], H[jb][4 * g4 + 3]};
    }
}
__device__ __forceinline__ void rwkv_apply_wave(Frame& F, int item) {
    int lane = F.lane; asm volatile("" : "+v"(lane));
    const unsigned char* ws = F.ws; const unsigned r32 = lane & 31, hi = lane >> 5;
    const int cid = item >> 1, tb = item & 1;
    unsigned seq0, b, h, dir; int T, c; chunk_decode(cid, seq0, T, b, h, dir, c);
    const unsigned yb = dir ? WS_YB : WS_YF;
    f32x16 acc[2];
#pragma unroll
    for (int r = 0; r < 16; ++r) { const int t = 32 * tb + (r & 3) + 8 * (r >> 2) + 4 * hi; const unsigned tok = seq0 + (dir ? T - 1 - (64 * c + t) : 64 * c + t);
        acc[0][r] = LDG(float, ws, yb + (tok * 384 + h * 64 + r32) * 4); acc[1][r] = LDG(float, ws, yb + (tok * 384 + h * 64 + 32 + r32) * 4); }
#pragma unroll
    for (int ks = 0; ks < 4; ++ks) { const bf16x8 a = LDG(bf16x8, ws, WS_RP + (((unsigned)cid * 64 + 32 * tb + r32) * 64 + 16 * ks + 8 * hi) * 2);
#pragma unroll
        for (int ib = 0; ib < 2; ++ib) acc[ib] = MFMA32(a, LDG(bf16x8, ws, WS_RH + (((unsigned)cid * 64 + 32 * ib + r32) * 64 + 16 * ks + 8 * hi) * 2), acc[ib]); }
#pragma unroll
    for (int r = 0; r < 16; ++r) { const int t = 32 * tb + (r & 3) + 8 * (r >> 2) + 4 * hi; const unsigned tok = seq0 + (dir ? T - 1 - (64 * c + t) : 64 * c + t);
        STG(float, F.ws, yb + (tok * 384 + h * 64 + r32) * 4) = acc[0][r]; STG(float, F.ws, yb + (tok * 384 + h * 64 + 32 + r32) * 4) = acc[1][r]; }
}

__device__ __forceinline__ void rwkv_out_item(Frame& F, int l, int item) {
    int lane = F.lane; asm volatile("" : "+v"(lane));
    const unsigned char* ws = F.ws; const unsigned r32 = lane & 31, hi = lane >> 5;
    const int tb = item & 1, h = (item >> 1) % 6, sk = item / 12;
    const bool lat = sk >= 64; const int b = lat ? (sk - 64) >> 6 : sk >> 2, k = lat ? (sk - 64) & 63 : sk & 3, nc = lat ? 64 : 4;
    const unsigned seq0 = lat ? MC + b * 4096 : b * 256, base = lat ? 768u : 0u;
    const unsigned chf = (b * 6 + h) * 2, cidf = base + chf * nc + k, cidb = base + (chf + 1) * nc + (nc - 1 - k);
    const unsigned tok0 = seq0 + 64 * k + 32 * tb;
    f32x16 acc[2];
    const unsigned yo = (lat ? 384 + (b * 6 + h) * 64 + k : (b * 6 + h) * 4 + k) * 16384 + (tb * 8) * 1024 + lane * 16;
#pragma unroll
    for (int ib = 0; ib < 2; ++ib)
#pragma unroll
        for (int q = 0; q < 4; ++q) { const f32x4 yf = LDG(f32x4, ws, WS_YF + yo + (ib * 4 + q) * 1024), yb = LDG(f32x4, ws, WS_YB + yo + (ib * 4 + q) * 1024);
            acc[ib][4 * q] = yf[0] + yb[0]; acc[ib][4 * q + 1] = yf[1] + yb[1]; acc[ib][4 * q + 2] = yf[2] + yb[2]; acc[ib][4 * q + 3] = yf[3] + yb[3]; }
#pragma unroll
    for (int ks = 0; ks < 4; ++ks) {
        const bf16x8 af = LDG(bf16x8, ws, WS_RP + cidf * 8192 + (tb * 4 + ks) * 1024 + lane * 16), ab = LDG(bf16x8, ws, WS_RP + cidb * 8192 + ((1 - tb) * 4 + ks) * 1024 + ((31 - r32) + 32 * hi) * 16);
#pragma unroll
        for (int ib = 0; ib < 2; ++ib) { acc[ib] = MFMA32(af, LDG(bf16x8, ws, WS_RH + cidf * 8192 + (ib * 4 + ks) * 1024 + lane * 16), acc[ib]);
            acc[ib] = MFMA32(ab, LDG(bf16x8, ws, WS_RH + cidb * 8192 + (ib * 4 + ks) * 1024 + lane * 16), acc[ib]); } }
    LAS unsigned char* lw = F.lds + F.wave * 9216;
#pragma unroll
    for (int ib = 0; ib < 2; ++ib)
#pragma unroll
        for (int r = 0; r < 16; ++r) *(LAS float*)(lw + ((r & 3) + 8 * (r >> 2) + 4 * hi) * 288 + (32 * ib + r32) * 4) = acc[ib][r];
    const unsigned ts = lane >> 4, dg = lane & 15;
    const f32x4 g4 = LDG(f32x4, INP(27), (l * 384 + h * 64 + 4 * dg) * 4), b4 = LDG(f32x4, INP(28), (l * 384 + h * 64 + 4 * dg) * 4);
#pragma unroll 2
    for (int i = 0; i < 8; ++i) { const unsigned tk = tok0 + 4 * i + ts, e = tk * 384 + h * 64 + 4 * dg;
        const float bon = LDG(float, ws, WS_SB + (tk * 8 + h) * 4) + LDG(float, ws, WS_SB + ((M + tk) * 8 + h) * 4);
        const f32x4 y = *(const LAS f32x4*)(lw + (4 * i + ts) * 288 + dg * 16) + bon * LDG(f32x4, ws, WS_SV + e * 4);
        const float mu = allreduce16((y[0] + y[1]) + (y[2] + y[3])) * (1.f / 64.f);
        const f32x4 d = y - mu;
        const float rs = rsqrtf(allreduce16((d[0] * d[0] + d[1] * d[1]) + (d[2] * d[2] + d[3] * d[3])) * (1.f / 64.f) + 64e-5f);
        const f32x4 o = (d * rs * g4 + b4) * unpack4(LDG(u32x2, ws, WS_G + e * 2));
        STG(u32x2, F.ws, WS_ACT + (tk * DM + 640 + h * 64 + 4 * dg) * 2) = pack4(o); }
}

#ifndef B_UNIT
#define B_UNIT 0
#endif
constexpr int AU_R = 8, AU_D = 4, AU_SLOT = 6144;
__device__ __forceinline__ void attn_b_unit(Frame& F, int l, int unit) {
    int lane = F.lane; asm volatile("" : "+v"(lane));
    const unsigned char* ws = F.ws; LAS unsigned char* lds = F.lds;
    const int w = F.wave; const unsigned r32 = lane & 31, hi = lane >> 5;
    const unsigned kh = unit & 1, qb = (unit >> 1) & 15, mp = (unit >> 5) & 1, h = (unit >> 6) & 3, b = unit >> 8;
    const unsigned seq0 = MC + b * 4096, row = seq0 + qb * 256 + 32 * w + r32;
    bf16x8 qf[1][2];
#pragma unroll
    for (int s = 0; s < 2; ++s) qf[0][s] = LDG(bf16x8, ws, WS_QB + (row * 256 + h * 64 + mp * 32 + 8 * hi) * 2 + 32 * s);
    AttnQ st[1]; attnq_init(st[0], 0.f);
    const int qpos[1] = {0};
    const int n0 = kh ? 56 : 72, nt = 72;
    const unsigned pofs = (w < 2 ? (h * 2 + mp) * 2048 + w * 1024 : h * 4096 + (w - 2) * 1024) + lane * 16;
    const unsigned base0 = (w < 2 ? WS_KB : WS_VTB) + ((seq0 >> 5) + (kh ? 72u : 0u)) * 16384 + pofs;
    const unsigned base1 = WS_CACHE + (w < 2 ? 2 * MiB : 4 * MiB) + (b * 4 + l) * 262144 + pofs;
#define AU_DMA(t_) do { const int tt_ = (t_) < nt ? (t_) : nt - 1; const unsigned src_ = tt_ < n0 ? base0 + tt_ * 16384 : base1 + (tt_ - n0) * 16384; \
        __builtin_amdgcn_global_load_lds((const GAS unsigned*)(ws + src_), (LAS unsigned*)(lds + ((t_) % AU_R) * AU_SLOT + w * 1024), 16, 0, 0); } while (0)
    if (w < 6) {
#pragma unroll
        for (int t = 0; t < AU_D; ++t) AU_DMA(t);
    }
    for (int t = 0; t < nt; ++t) {
        if (w < 6) asm volatile("s_waitcnt vmcnt(3)" ::: "memory");
        asm volatile("s_barrier" ::: "memory");
        const LAS unsigned char* sl = lds + (t % AU_R) * AU_SLOT + lane * 16;
        bf16x8 kf[2], vf[4];
        kf[0] = *(const LAS bf16x8*)(sl); kf[1] = *(const LAS bf16x8*)(sl + 1024);
#pragma unroll
        for (int f = 0; f < 4; ++f) vf[f] = *(const LAS bf16x8*)(sl + 2048 + 1024 * f);
        if (w < 6) AU_DMA(t + AU_D);
        attn_block<32, false, 1>(qf, kf, vf, st, t, qpos, 0, hi);
    }
#undef AU_DMA
    asm volatile("s_waitcnt vmcnt(0) lgkmcnt(0)\n\ts_barrier" ::: "memory");
    attn_b_store(F, st[0], mp, kh, row, h, hi);
}

constexpr int Q_BLAT = 2048, Q_ALAT = 1536, Q_BCTX = 1024, Q_ACTX = 768;
constexpr int Q_TOTAL = Q_BLAT + Q_ALAT + Q_BCTX + Q_ACTX;
#ifndef XCD_DEAL
#define XCD_DEAL 1
#endif
__device__ __forceinline__ void phase_mixer(Frame& F, int l, int rep) {
    if (rep == 0 || REP_PART == 0 || REP_PART == 1) {
        const int si = F.bid + F.G * F.wave;
        if (si < 48) rwkv_chain_wave(F, l, true, si >> 1, si & 1);
        else if (si < 48 + 384) rwkv_chain_wave(F, l, false, (si - 48) >> 1, (si - 48) & 1);
    }
    if (B_UNIT && (rep == 0 || REP_PART == 2 || REP_PART == 4)) {
        unsigned* uctr = (unsigned*)(F.ws + WS_CTL) + 64 * (32 + l + 4 * (rep + F.crep));
        LAS int* ubox = (LAS int*)(F.lds + 65536);
        for (;;) {
            if (F.wave == 0 && F.lane == 0) *ubox = (int)atomicAdd(uctr, 1u);
            lds_barrier();
            const int un = __builtin_amdgcn_readfirstlane(*ubox);
            lds_barrier();
            if (un >= 512) break;
            attn_b_unit(F, l, un);
        }
    }
    unsigned* ctr = (unsigned*)(F.ws + WS_CTL) + 64 * (1 + l + 4 * (rep + F.crep));
    const bool xdeal = XCD_DEAL && !B_UNIT && F.G == 256;
    if (xdeal && (rep == 0 || REP_PART == 2 || REP_PART == 4)) attn_b_item(F, l, true, (F.bid & 7) * 256 + (F.bid >> 3) * 8 + F.wave);
    unsigned* cx = (unsigned*)(F.ws + WS_CTL) + 8192 + ((l + 4 * (rep + F.crep)) * 8 + (F.bid & 7)) * 64;
    bool xq = xdeal;
    if (rep == 0 || REP_PART != 1) for (;;) {
        int it = 0;
        if (F.lane == 0) it = (int)atomicAdd(xq ? cx : ctr, 1u);
        it = __builtin_amdgcn_readfirstlane(it);
        if (xq) { if (it >= 192) { xq = false; continue; }
            const int x = F.bid & 7; it = Q_BLAT + (((x >> 2) * 6 + ((x >> 1) & 1) * 3 + it / 64) * 128 + (x & 1) * 64 + it % 64); }
        else it += xdeal ? Q_BLAT + Q_ALAT : (B_UNIT ? Q_BLAT : 0);
        if (it >= Q_TOTAL) break;
        if (it < Q_BLAT) { if (rep == 0 || REP_PART == 2 || REP_PART == 4) attn_b_item(F, l, true, it); continue; } it -= Q_BLAT;
        if (it < Q_ALAT) { if (rep == 0 || REP_PART == 2 || REP_PART == 3) attn_a_item(F, l, true, it); continue; } it -= Q_ALAT;
        if (it < Q_BCTX) { if (rep == 0 || REP_PART == 2 || REP_PART == 5) attn_b_item(F, l, false, it); continue; } it -= Q_BCTX;
        if (rep == 0 || REP_PART == 2 || REP_PART == 5) attn_a_item(F, l, false, it);
    }
}

#ifndef FIN_R2
#define FIN_R2 1
#endif
__device__ __forceinline__ void phase_finalize(Frame& F, int l, int rep) {
    const unsigned char* ws = F.ws;
    int lane = F.lane; asm volatile("" : "+v"(lane));
    const float lami = 0.8f - 0.6f * __expf(-0.3f * (float)l);
    const float lam = LDG(float, ws, WS_TAB + (TAB_LAM + l) * 4) + lami;
    const float omli = 1.f - lami;
    const unsigned hk = lane >> 4, dg = lane & 15;
    const f32x4 sg = LDG(f32x4, INP(17), (l * 64 + 4 * dg) * 4) * omli;
    const unsigned nw2 = (F.ngw < 2304 && 2 * F.ngw > 2304 + 64) ? 2304 - F.ngw : 0, npair = M / 2;
    const unsigned n2 = nw2 * FIN_R2;
    unsigned p = (unsigned)F.gw < nw2 ? F.gw : n2 + (F.gw - nw2);
    const unsigned pe = (unsigned)F.gw < nw2 ? n2 : npair, ps = (unsigned)F.gw < nw2 ? nw2 : F.ngw - nw2;
    for (; p < pe; p += ps) {
        const unsigned r0 = 2 * p;
#pragma unroll
        for (int rr = 0; rr < 2; ++rr) { const unsigned row = r0 + rr; f32x4 om[2];
#pragma unroll
            for (int mp = 0; mp < 2; ++mp) { const unsigned o0 = (((mp * 2) * M + row) * 256 + 64 * hk + 4 * dg) * 2, q0 = ((((mp * 2) * M + row) * 4 + hk) * 2) * 4;
                const f32x2 ml0 = LDG(f32x2, ws, WS_ML + q0);
                if (row >= (unsigned)MC) { const f32x2 ml1 = LDG(f32x2, ws, WS_ML + q0 + M * 32); const float ms = fmaxf(ml0[0], ml1[0]), w0 = __builtin_amdgcn_exp2f(ml0[0] - ms), w1 = __builtin_amdgcn_exp2f(ml1[0] - ms);
                    om[mp] = (unpack4(LDG(u32x2, ws, WS_BO2 + o0)) * w0 + unpack4(LDG(u32x2, ws, WS_BO2 + o0 + M * 512)) * w1) * __builtin_amdgcn_rcpf(ml0[1] * w0 + ml1[1] * w1); }
                else om[mp] = unpack4(LDG(u32x2, ws, WS_BO2 + o0)) * __builtin_amdgcn_rcpf(ml0[1]); }
            const f32x4 v = om[0] - lam * om[1];
            const float ms = allreduce16((v[0] * v[0] + v[1] * v[1]) + (v[2] * v[2] + v[3] * v[3])) * (1.f / 64.f);
            STG(u32x2, F.ws, WS_ACT + (row * DM + 384 + 64 * hk + 4 * dg) * 2) = pack4(v * rsqrtf(ms + 1e-6f) * sg); }
    }
}


typedef unsigned v4u __attribute__((ext_vector_type(4)));
#define XB_TMO      128
#define XB_XCNT(j)  (256  + 64 * (j))
#define XB_XSUB(j)  (1280 + 64 * (j))
#define XB_XGEN(j)  (2304 + 64 * (j))
#define XB_TOP      3328
#define XB_TOPGEN   3392
#define XCD_BAR_WORDS 3456
#define XB_SPIN_CAP (1u << 18)

__device__ __forceinline__ unsigned xb_ld(unsigned* p)              { return __hip_atomic_load(p, __ATOMIC_RELAXED, __HIP_MEMORY_SCOPE_AGENT); }
__device__ __forceinline__ unsigned xb_add(unsigned* p, unsigned v) { return __hip_atomic_fetch_add(p, v, __ATOMIC_RELAXED, __HIP_MEMORY_SCOPE_AGENT); }
__device__ __forceinline__ unsigned xb_xcc_id() { return (unsigned)__builtin_amdgcn_s_getreg((3 << 11) | 20) & 0xFu; }
#define XB_SPIN(cond, bar) do { unsigned _sp = 0; while (cond) { __builtin_amdgcn_s_sleep(1); \
    if ((++_sp & 255u) == 0u) { if (xb_ld(&(bar)[XB_TMO])) break; if (_sp > XB_SPIN_CAP) { atomicAdd(&(bar)[XB_TMO], 1u); break; } } } } while (0)

struct XcdBarrier {
    unsigned* bar; unsigned x;
    volatile LAS unsigned* st;
};

__device__ __forceinline__ XcdBarrier xcd_barrier_post(unsigned* bar, volatile LAS unsigned* st) {
    XcdBarrier b; b.bar = bar; b.x = xb_xcc_id(); b.st = st;
    if (threadIdx.x == 0) (void)xb_add(&bar[XB_XCNT(b.x)], 1u);
    return b;
}
__device__ __forceinline__ void xcd_barrier_complete(unsigned* bar, unsigned x, unsigned& nloc, unsigned& nx) {
    const unsigned G = gridDim.x * gridDim.y * gridDim.z;
    unsigned sum, cnt, mine, sp = 0u;
    for (;;) {
        sum = 0u; cnt = 0u; mine = 0u;
#pragma unroll
        for (unsigned j = 0; j < 16; ++j) { const unsigned c = xb_ld(&bar[XB_XCNT(j)]); sum += c; cnt += (c > 0u) ? 1u : 0u; mine = (j == x) ? c : mine; }
        if (sum == G) break;
        __builtin_amdgcn_s_sleep(1);
        if ((++sp & 255u) == 0u) { if (xb_ld(&bar[XB_TMO])) break; if (sp > XB_SPIN_CAP) { atomicAdd(&bar[XB_TMO], 1u); break; } }
    }
    nloc = mine > 0u ? mine : 1u; nx = cnt > 0u ? cnt : 1u;
}

__device__ __forceinline__ void xcd_barrier(const XcdBarrier& b) {
    asm volatile("s_waitcnt vmcnt(0)" ::: "memory");
    __syncthreads();
    if (threadIdx.x == 0) {
        unsigned* bar = b.bar;
        __builtin_amdgcn_s_waitcnt(0);
        unsigned nloc = b.st[0], nx = b.st[1];
        if (nloc == 0u) { xcd_barrier_complete(bar, b.x, nloc, nx); b.st[0] = nloc; b.st[1] = nx; }
        const unsigned old = xb_add(&bar[XB_XSUB(b.x)], 1u);
        const unsigned gen = old / nloc;
        if (old + 1u == (gen + 1u) * nloc) {
            __builtin_amdgcn_fence(__ATOMIC_RELEASE, "agent");
            asm volatile("s_waitcnt vmcnt(0)" ::: "memory");
            const unsigned og = xb_add(&bar[XB_TOP], 1u);
            const unsigned tg = og / nx;
            if (og + 1u == (tg + 1u) * nx) xb_add(&bar[XB_TOPGEN], 1u);
            else XB_SPIN(xb_ld(&bar[XB_TOPGEN]) == tg, bar);
            __builtin_amdgcn_fence(__ATOMIC_ACQUIRE, "agent");
            xb_add(&bar[XB_XGEN(b.x)], 1u);
            asm volatile("s_waitcnt vmcnt(0)" ::: "memory");
        } else {
            XB_SPIN(xb_ld(&bar[XB_XGEN(b.x)]) == gen, bar);
            __builtin_amdgcn_fence(__ATOMIC_ACQUIRE, "agent");
            asm volatile("s_waitcnt vmcnt(0)" ::: "memory");
        }
    }
    __syncthreads();
}

#ifndef DIS
#define DIS 0
#endif
#ifndef GEMM_MF
#define GEMM_MF 7
#endif
#ifndef REP_PHASE
#define REP_PHASE -1
#define REP_COUNT 1
#endif
constexpr int NEXTRA = (REP_PHASE >= 0 && REP_PHASE < 9) ? REP_COUNT - 1 : 0, NPL = 9 + NEXTRA, NPRE = (REP_PHASE == 100) ? REP_COUNT : 1, NFWD = (REP_PHASE == 200) ? REP_COUNT : 1, NPHASE_RUN = NPRE + 1 + NPL * DEPTH * NFWD;
__global__ void __launch_bounds__(512, 2) mega(Args a) {
    extern __shared__ __attribute__((aligned(16))) unsigned char lds[];
    Frame F; F.crep = 0;
    F.lds = (LAS unsigned char*)lds;
    volatile LAS unsigned* bst = (volatile LAS unsigned*)(F.lds + LDS_BYTES - 64);
    if (threadIdx.x < 2) bst[threadIdx.x] = 0u;
    __syncthreads();
    const XcdBarrier xbar = xcd_barrier_post((unsigned*)((GAS unsigned char*)a.ws + WS_CTL) + 4096, bst);
    const int wave_id = __builtin_amdgcn_readfirstlane((int)threadIdx.x >> 6);
    for (int ph = a.ph_lo; ph < a.ph_hi; ++ph) {
        { const unsigned char* kp = (const unsigned char*)__builtin_amdgcn_kernarg_segment_ptr(); asm volatile("" : "+s"(kp));
          const Args* ap = (const Args*)kp; F.in = ap->in; F.out = gptr(ap->out); F.ws = gptr(ap->ws); }
        { unsigned ones = ~0u; asm volatile("" : "+s"(ones)); int ln = (int)__builtin_amdgcn_mbcnt_hi(ones, __builtin_amdgcn_mbcnt_lo(ones, 0u)); int wv = wave_id, bid = (int)blockIdx.x, gg = (int)gridDim.x; asm volatile("" : "+s"(wv), "+s"(bid), "+s"(gg));
          F.lane = ln; F.wave = wv; F.bid = bid; F.G = gg; F.ngw = gg * 8; F.tid = wv * 64 + ln; F.gw = bid * 8 + wv; }
        if (ph < NPRE) { if (!(DIS & 1)) phase_prologue(F); }
        else if (ph == NPHASE_RUN - 1) { if (!(DIS & 2)) phase_final_norm(F); }
        else {
            const int fwd_ = (ph - NPRE) / (NPL * DEPTH); F.crep = fwd_; const int l = ((ph - NPRE) / NPL) % DEPTH, sidx = (ph - NPRE) % NPL, rep = (REP_PHASE == 200) ? 0 : (REP_PHASE >= 0 && REP_PHASE < 9 && sidx > REP_PHASE && sidx <= REP_PHASE + NEXTRA) ? sidx - REP_PHASE : 0, s = (REP_PHASE >= 0 && REP_PHASE < 9 && sidx > REP_PHASE) ? (sidx <= REP_PHASE + NEXTRA ? REP_PHASE : sidx - NEXTRA) : sidx;
            if (s == 0) { convert_weights(F, l); phase_norm(F, l, 0); }
            else if (s == 1) {
                pg8::Gemm g{WSP(bf16_t, WS_ACT), WSP(bf16_t, WS_WIN + 0u * WSET_STRIDE), M, NIN, 1024}; pg8::StaticOrder S; S.init(M, NIN, F.G, F.bid, (GEMM_MF & 1) ? 192 : 256);
                EpiWin E{F.ws, F.out, l, F.lds + pg8::STAGE_BYTES, REP_PART == 9 && rep > 0};
                if (!(DIS & 16)) pg8::gemm_phase<EpiWin, pg8::StaticOrder, false, true, (GEMM_MF & 1) ? 3 : 4>(F.lds, g, S, E, F.tid);
                if (false) { const int wv_ = (F.bid - 64) * 8 + F.wave; convert_item_any(F, l + 1, wv_); if (wv_ < CV_TOTAL - 1536) convert_item_any(F, l + 1, 1536 + wv_); }
            }
            else if (s == 2) { for (int cid = F.bid; cid < NCHUNK; cid += F.G) rwkv_chunk_block(F, l, cid); }
            else if (s == 3) { if (!(DIS & 64)) phase_mixer(F, l, rep); }
            else if (s == 4) { if (rep == 0 || REP_PART != 6) for (int it = F.gw; it < 192 * 12; it += F.ngw) rwkv_out_item(F, l, it); if (rep == 0 || REP_PART != 7) phase_finalize(F, l, rep); }
            else if (s == 5 || s == 8) {
                const bool second = s == 8;
                pg8::Gemm g{second ? WSP(bf16_t, WS_U) : WSP(bf16_t, WS_ACT), second ? WSP(bf16_t, WS_W2 + 0u * WSET_STRIDE) : WSP(bf16_t, WS_WOUT + 0u * WSET_STRIDE), M, 1024, second ? FF : 1024};
                pg8::StaticOrder S; S.init(M, 1024, F.G, F.bid, (GEMM_MF & 2) ? 192 : 256);
                const bool first = (l == 0 && !second);
                EpiRes E{INP(0), INP(1) - (size_t)MC * DM, F.ws, WSP(float, WS_MOD) + (size_t)l * 3 * 6144 + (second ? 5120 : 2048), first, rep ? WS_BO : WS_XB, REP_PART == 9 && rep > 0};
                if (M / ((GEMM_MF & 2) ? 192 : 256) * 4 <= F.G) { EpiResD ED; static_cast<EpiRes&>(ED) = E; pg8::gemm_phase<EpiResD, pg8::StaticOrder, false, true, (GEMM_MF & 2) ? 3 : 4>(F.lds, g, S, ED, F.tid); }
                else pg8::gemm_phase<EpiRes, pg8::StaticOrder, false, true, (GEMM_MF & 2) ? 3 : 4>(F.lds, g, S, E, F.tid);
            }
            else if (s == 6) { if (!(DIS & 8)) phase_norm(F, l, 1); }
            else {
                pg8::Gemm g{WSP(bf16_t, WS_ACT), WSP(bf16_t, WS_W13 + 0u * WSET_STRIDE), M, NFF2, 1024}; pg8::StaticOrder S; S.init(M, NFF2, F.G, F.bid, (GEMM_MF & 4) ? 192 : 256);
                EpiSwi E{WSP(bf16_t, WS_U), REP_PART == 9 && rep > 0};
                if (!(DIS & 512)) pg8::gemm_phase<EpiSwi, pg8::StaticOrder, true, true, (GEMM_MF & 4) ? 3 : 4>(F.lds, g, S, E, F.tid);
            }
        }
        if (ph + 1 < a.ph_hi) { if (ph == a.ph_lo) { __threadfence(); cg::this_grid().sync(); } else xcd_barrier(xbar); }
    }
}

extern "C" void kernel_launch(void* const* d_in, const int* in_sizes, int n_in, void* d_out, int out_size, void* d_ws, size_t ws_size, hipStream_t stream) {
    static int grid = 0;
    if (grid == 0) {
        int dev = 0, cus = 0, per_cu = 0;
        if (n_in != 34 || ws_size < WS_END) { fprintf(stderr, "kernel_launch: unexpected n_in %d / ws_size %zu (need %zu)\n", n_in, ws_size, (size_t)WS_END); grid = -1; return; }
        if (hipGetDevice(&dev) != hipSuccess || hipDeviceGetAttribute(&cus, hipDeviceAttributeMultiprocessorCount, dev) != hipSuccess) { grid = -1; return; }
        if (hipFuncSetAttribute((const void*)mega, hipFuncAttributeMaxDynamicSharedMemorySize, LDS_BYTES) != hipSuccess) { fprintf(stderr, "kernel_launch: hipFuncSetAttribute failed\n"); grid = -1; return; }
        if (hipOccupancyMaxActiveBlocksPerMultiprocessor(&per_cu, (const void*)mega, 512, LDS_BYTES) != hipSuccess || per_cu < 1) { fprintf(stderr, "kernel_launch: occupancy query says %d\n", per_cu); per_cu = 1; }
        (void)hipGetLastError();
        grid = cus * 1;
        if (grid > cus * per_cu) grid = cus * per_cu;
    }
    if (grid < 0) return;
    (void)hipMemsetAsync((char*)d_ws + WS_CTL, 0, CTL_BYTES, stream);
    Args a{};
    for (int i = 0; i < 34; ++i) a.in[i] = (const float*)d_in[i];
    a.out = (float*)d_out; a.ws = (unsigned char*)d_ws;
#if MK_ONE_LAUNCH
    a.ph_lo = 0; a.ph_hi = NPHASE_RUN;
    void* args[] = {&a};
    hipError_t e = hipLaunchCooperativeKernel((const void*)mega, dim3(grid), dim3(512), args, LDS_BYTES, stream);
    if (e != hipSuccess) fprintf(stderr, "kernel_launch: cooperative launch failed: %s (grid %d)\n", hipGetErrorString(e), grid);
#else
    for (int ph = 0; ph < NPHASE_RUN; ++ph) { a.ph_lo = ph; a.ph_hi = ph + 1; hipLaunchKernelGGL(mega, dim3(grid), dim3(512), LDS_BYTES, stream, a); }
#endif
}
```

```cpp
#include <hip/hip_runtime.h>
#include <hip/hip_cooperative_groups.h>
#include <cstdio>
#include <cstdint>
namespace cg = cooperative_groups;

#ifndef MK_ONE_LAUNCH
#define MK_ONE_LAUNCH 1
#endif

#undef MK_ONE_LAUNCH
#define MK_ONE_LAUNCH 1
#define REP_PHASE -1
#define REP_COUNT 1
#define REP_PART 0
#define RA_REP 0
#define ATT_PROBE 0
namespace pg8 {
#define PG8_LAS __attribute__((address_space(3)))
typedef unsigned short bf16_t;
typedef short bf16x8 __attribute__((ext_vector_type(8)));
typedef float f32x4 __attribute__((ext_vector_type(4)));
typedef unsigned u32x4 __attribute__((ext_vector_type(4)));
constexpr int BM = 256, BK = 64, HALF = 128, HTB = HALF * BK * 2  , STAGE_BYTES = 8 * HTB, NXCD = 8, WGM = 8;

__host__ __device__ __forceinline__ int lds_byte(int r, int c) { const int st = (r >> 4) * 2 + (c >> 5), rr = r & 15, cc = c & 31, ob = rr * 64 + cc * 2; return st * 1024 + (ob ^ (((ob >> 9) & 1) << 5)); }
__host__ __device__ __forceinline__ void stage_rc(int b, int& R, int& C) { const int st = b / 1024, sb = b % 1024, swz = sb ^ (((sb >> 9) & 1) << 5); R = (st >> 1) * 16 + swz / 64; C = (st & 1) * 32 + (swz % 64) / 2; }
__host__ __device__ __forceinline__ int perm32(int rho) { const int n = rho >> 4, i = rho & 15; return 8 * (i >> 2) + 4 * n + (i & 3); }

struct Unit { int pm, pn; };
struct Gemm { const bf16_t* A; const bf16_t* Bt; int M, N, K; };

struct StaticOrder {
    int nM, nN, nwg, G, c;
    __host__ __device__ void init(int M, int N, int G_, int c_, int bm = BM) { nM = M / bm; nN = N / BM; nwg = nM * nN; G = G_; c = c_; }
    __host__ __device__ bool next(int i, Unit& u) const {
        const long L = (long)i * G + c; if (L >= nwg) return false;
        int wgid = (int)L; { const int q = nwg / NXCD, r = nwg % NXCD, xcd = wgid % NXCD, off = wgid / NXCD; wgid = (xcd < r ? xcd * (q + 1) : r * (q + 1) + (xcd - r) * q) + off; }
        const int nig = WGM * nN, gid = wgid / nig, fm = gid * WGM, gsz = (nM - fm) < WGM ? (nM - fm) : WGM;
        u.pm = fm + ((wgid % nig) % gsz); u.pn = (wgid % nig) / gsz; return true;
    }
    __device__ __forceinline__ void a_ready(const Unit&) const {}
    __device__ __forceinline__ void done(const Unit&) const {}
};

template <class Epi, class Sched, bool ALIGN_EPI = false, bool SP2 = false, int MF = 4>
__device__ __forceinline__ void gemm_phase(PG8_LAS unsigned char* lds, const Gemm g, const Sched& S, const Epi& E, const int tid_in) {
    const int tid = tid_in, wid = __builtin_amdgcn_readfirstlane(tid >> 6), lane = tid & 63, wr = wid >> 2, wc = wid & 3, fr = lane & 15, fq = lane >> 4;
    static_assert(MF == 4 || (MF == 3 && SP2), "192-row tiles: SP2 schedule only");
    const int K = g.K, nt = K / BK;
    unsigned voffA[2], voffB[2];
#pragma unroll
    for (int i = 0; i < 2; ++i) { int R, C; stage_rc(tid * 16 + i * 8192, R, C); const int Rb = Epi::PERM ? ((R & ~31) + perm32(R & 31)) : R;
        voffA[i] = (unsigned)(R * K + C) * 2u; voffB[i] = (unsigned)(Rb * K + C) * 2u; }
    const size_t kstep = (size_t)(BK * 2);
    const size_t hstep = (size_t)HALF * K * 2;
    const size_t tstep = 2 * hstep;
    const size_t hstepA = (size_t)(MF * 32) * K * 2, tstepA = 2 * hstepA;
    const unsigned ldsw = (unsigned)wid * 1024u;
    const int aoff = lds_byte(wr * (MF * 16) + fr, fq * 8), boff = lds_byte(wc * 32 + fr, fq * 8);
#define PG8_SA(b, h) (((b) * 2 + (h)) * HTB)
#define PG8_SB(b, h) ((4 + (b) * 2 + (h)) * HTB)
#define PG8_STAGE(bufoff, gbase, voff) do { _Pragma("unroll") for (int _i = 0; _i < 2; ++_i) \
        __builtin_amdgcn_global_load_lds((const unsigned*)((const char*)(gbase) + (voff)[_i]), (PG8_LAS unsigned*)(lds + (bufoff) + ldsw + _i * 8192), 16, 0, 0); } while (0)
#define PG8_STAGEA(bufoff, gbase, voff) do { __builtin_amdgcn_global_load_lds((const unsigned*)((const char*)(gbase) + (voff)[0]), (PG8_LAS unsigned*)(lds + (bufoff) + ldsw), 16, 0, 0); \
        if (MF == 4 || wr == 0) __builtin_amdgcn_global_load_lds((const unsigned*)((const char*)(gbase) + (voff)[1]), (PG8_LAS unsigned*)(lds + (bufoff) + ldsw + 8192), 16, 0, 0); } while (0)
#define PG8_LDA(dst, b, h) do { _Pragma("unroll") for (int m = 0; m < MF; ++m) _Pragma("unroll") for (int k = 0; k < 2; ++k) dst[m][k] = *(const PG8_LAS bf16x8*)(lds + PG8_SA(b, h) + aoff + m * 2048 + k * 1024); } while (0)
#define PG8_LDB(dst, b, h) do { _Pragma("unroll") for (int n = 0; n < 2; ++n) _Pragma("unroll") for (int k = 0; k < 2; ++k) dst[n][k] = *(const PG8_LAS bf16x8*)(lds + PG8_SB(b, h) + boff + n * 2048 + k * 1024); } while (0)
#define PG8_MMA(ai, bj, At, Bt) do { __builtin_amdgcn_s_setprio(1); _Pragma("unroll") for (int m = 0; m < MF; ++m) _Pragma("unroll") for (int n = 0; n < 2; ++n) _Pragma("unroll") for (int k = 0; k < 2; ++k) \
        acc[ai][bj][m][n] = __builtin_amdgcn_mfma_f32_16x16x32_bf16(Bt[n][k], At[m][k], acc[ai][bj][m][n], 0, 0, 0); __builtin_amdgcn_s_setprio(0); } while (0)
#define PG8_WAIT_V(n) asm volatile("s_waitcnt vmcnt(" #n ")" ::: "memory")
#define PG8_WAIT_V2(a, b) do { if (MF == 4 || wr == 0) asm volatile("s_waitcnt vmcnt(" #a ")" ::: "memory"); else asm volatile("s_waitcnt vmcnt(" #b ")" ::: "memory"); } while (0)
#define PG8_WAIT_L(n) asm volatile("s_waitcnt lgkmcnt(" #n ")" ::: "memory")
#define PG8_BAR __builtin_amdgcn_s_barrier()
#define PG8_SCHED __builtin_amdgcn_sched_barrier(0)
    Unit cur, nxt; int ui = 0;
    if (!S.next(0, cur)) return;
    f32x4 acc[2][2][MF][2];
#pragma unroll
    for (int a = 0; a < 2; ++a)
#pragma unroll
        for (int b = 0; b < 2; ++b)
#pragma unroll
            for (int m = 0; m < MF; ++m)
#pragma unroll
                for (int n = 0; n < 2; ++n) acc[a][b][m][n] = (f32x4){0.f, 0.f, 0.f, 0.f};
    bf16x8 At[MF][2], B0[2][2], B1[2][2];
#define PG8_SGPR64(p) ((const char*)(((unsigned long long)(unsigned)__builtin_amdgcn_readfirstlane((int)((unsigned long long)(p) >> 32)) << 32) | (unsigned)__builtin_amdgcn_readfirstlane((int)(unsigned long long)(p))))
    const char* cA = PG8_SGPR64((const char*)g.A + (size_t)cur.pm * tstepA); const char* cB = PG8_SGPR64((const char*)g.Bt + (size_t)cur.pn * tstep);
    S.a_ready(cur);
    if constexpr (SP2) {
        PG8_STAGE(PG8_SB(0, 0), cB, voffB); PG8_STAGE(PG8_SB(0, 1), cB + hstep, voffB); PG8_STAGEA(PG8_SA(0, 0), cA, voffA); PG8_STAGEA(PG8_SA(0, 1), cA + hstepA, voffA);
        if (wr == 1) PG8_BAR;
        PG8_WAIT_V2(2, 1); PG8_BAR;
        PG8_STAGE(PG8_SB(1, 0), cB + kstep, voffB); PG8_STAGEA(PG8_SA(1, 0), cA + kstep, voffA); PG8_STAGE(PG8_SB(1, 1), cB + hstep + kstep, voffB);
        PG8_WAIT_V2(6, 5); PG8_BAR;
    } else {
        PG8_STAGE(PG8_SB(0, 0), cB, voffB); PG8_STAGEA(PG8_SA(0, 0), cA, voffA); PG8_STAGE(PG8_SB(0, 1), cB + hstep, voffB); PG8_STAGEA(PG8_SA(0, 1), cA + hstepA, voffA);
        if (wr == 1) PG8_BAR;
        PG8_WAIT_V(4); PG8_BAR;
        PG8_STAGE(PG8_SB(1, 0), cB + kstep, voffB); PG8_STAGEA(PG8_SA(1, 0), cA + kstep, voffA); PG8_STAGE(PG8_SB(1, 1), cB + hstep + kstep, voffB);
        PG8_WAIT_V(6); PG8_BAR;
    }
    for (;;) {
        const bool has_next = S.next(ui + 1, nxt);
        const char* nA = PG8_SGPR64(has_next ? (const char*)g.A + (size_t)nxt.pm * tstepA : cA); const char* nB = PG8_SGPR64(has_next ? (const char*)g.Bt + (size_t)nxt.pn * tstep : cB);
        for (int t = 0; t < nt; t += 2) {
            const bool last = (t == nt - 2);
            const char* a1 = cA + (size_t)(t + 1) * kstep;
            const char* a2 = last ? nA : cA + (size_t)(t + 2) * kstep; const char* b2 = last ? nB : cB + (size_t)(t + 2) * kstep;
            const char* a3 = a2 + kstep; const char* b3 = b2 + kstep;
            if (last && has_next) S.a_ready(nxt);
            if constexpr (SP2) {
            PG8_LDB(B0, 0, 0); PG8_LDB(B1, 0, 1); PG8_SCHED; PG8_LDA(At, 0, 0); PG8_STAGEA(PG8_SA(1, 1), a1 + hstepA, voffA);
            PG8_WAIT_V2(8, 6); PG8_WAIT_L(0); PG8_BAR; PG8_MMA(0, 0, At, B0); PG8_MMA(0, 1, At, B1); PG8_BAR; PG8_SCHED;
            PG8_LDA(At, 0, 1); PG8_STAGE(PG8_SB(0, 0), b2, voffB); PG8_STAGE(PG8_SB(0, 1), b2 + hstep, voffB); PG8_STAGEA(PG8_SA(0, 0), a2, voffA);
            PG8_WAIT_V2(8, 6); PG8_WAIT_L(0); PG8_BAR; PG8_MMA(1, 0, At, B0); PG8_MMA(1, 1, At, B1); PG8_BAR; PG8_SCHED;
            PG8_LDB(B0, 1, 0); PG8_LDB(B1, 1, 1); PG8_SCHED; PG8_LDA(At, 1, 0); PG8_STAGEA(PG8_SA(0, 1), a2 + hstepA, voffA);
            PG8_WAIT_V2(8, 6); PG8_WAIT_L(0); PG8_BAR; PG8_MMA(0, 0, At, B0); PG8_MMA(0, 1, At, B1); PG8_BAR; PG8_SCHED;
            PG8_LDA(At, 1, 1); PG8_STAGE(PG8_SB(1, 0), b3, voffB); PG8_STAGE(PG8_SB(1, 1), b3 + hstep, voffB); PG8_STAGEA(PG8_SA(1, 0), a3, voffA);
            PG8_WAIT_V2(8, 6); PG8_WAIT_L(0); PG8_BAR; PG8_MMA(1, 0, At, B0); PG8_MMA(1, 1, At, B1); PG8_BAR; PG8_SCHED;
            } else {
            PG8_LDB(B0, 0, 0); PG8_SCHED; PG8_LDA(At, 0, 0); PG8_STAGEA(PG8_SA(1, 1), a1 + hstepA, voffA);
            PG8_WAIT_L(8); PG8_BAR; PG8_WAIT_L(0); PG8_MMA(0, 0, At, B0); PG8_BAR; PG8_SCHED;
            PG8_LDB(B1, 0, 1); PG8_STAGE(PG8_SB(0, 0), b2, voffB);
            PG8_BAR; PG8_WAIT_L(0); PG8_MMA(0, 1, At, B1); PG8_BAR;
            PG8_LDA(At, 0, 1); PG8_STAGEA(PG8_SA(0, 0), a2, voffA);
            PG8_BAR; PG8_WAIT_L(0); PG8_MMA(1, 0, At, B0); PG8_BAR; PG8_SCHED;
            PG8_STAGE(PG8_SB(0, 1), b2 + hstep, voffB);
            PG8_WAIT_V(6); PG8_BAR; PG8_MMA(1, 1, At, B1); PG8_BAR;
            PG8_LDB(B0, 1, 0); PG8_SCHED; PG8_LDA(At, 1, 0); PG8_STAGEA(PG8_SA(0, 1), a2 + hstepA, voffA);
            PG8_WAIT_L(8); PG8_BAR; PG8_WAIT_L(0); PG8_MMA(0, 0, At, B0); PG8_BAR; PG8_SCHED;
            PG8_LDB(B1, 1, 1); PG8_STAGE(PG8_SB(1, 0), b3, voffB);
            PG8_BAR; PG8_WAIT_L(0); PG8_MMA(0, 1, At, B1); PG8_BAR;
            PG8_LDA(At, 1, 1); PG8_STAGEA(PG8_SA(1, 0), a3, voffA);
            PG8_BAR; PG8_WAIT_L(0); PG8_MMA(1, 0, At, B0); PG8_BAR; PG8_SCHED;
            PG8_STAGE(PG8_SB(1, 1), b3 + hstep, voffB);
            PG8_WAIT_V(6); PG8_BAR; PG8_MMA(1, 1, At, B1); PG8_BAR;
            }
        }
        if constexpr (ALIGN_EPI) { if (wr == 0) PG8_BAR; }
        if constexpr (!Epi::AFTER_DRAIN) { E.template operator()<MF>(acc, cur, wr, wc, fr, fq); S.done(cur); }
        if (!has_next) break;
#pragma unroll
        for (int a = 0; a < 2; ++a)
#pragma unroll
            for (int b = 0; b < 2; ++b)
#pragma unroll
                for (int m = 0; m < MF; ++m)
#pragma unroll
                    for (int n = 0; n < 2; ++n) acc[a][b][m][n] = (f32x4){0.f, 0.f, 0.f, 0.f};
        cur = nxt; cA = nA; cB = nB; ++ui;
        if constexpr (ALIGN_EPI) { if (wr == 1) PG8_BAR; }
    }
    PG8_WAIT_V(0);
    if constexpr (!ALIGN_EPI) { if (wr == 0) PG8_BAR; }
    PG8_BAR;
    if constexpr (Epi::AFTER_DRAIN) { E.fused(acc, cur, wr, wc, fr, fq, lds, wid, lane); S.done(cur); }
#undef PG8_SA
#undef PG8_SB
#undef PG8_STAGE
#undef PG8_STAGEA
#undef PG8_WAIT_V2
#undef PG8_LDA
#undef PG8_LDB
#undef PG8_MMA
#undef PG8_WAIT_V
#undef PG8_WAIT_L
#undef PG8_BAR
#undef PG8_SCHED
}
}

using pg8::bf16_t; using pg8::bf16x8; using pg8::f32x4; using pg8::u32x4;
typedef float f32x16 __attribute__((ext_vector_type(16)));
typedef float f32x2 __attribute__((ext_vector_type(2)));
typedef short s16x4 __attribute__((ext_vector_type(4)));
typedef unsigned u32x2 __attribute__((ext_vector_type(2)));
typedef __bf16 bf16x2_t __attribute__((ext_vector_type(2)));
#define LAS __attribute__((address_space(3)))
#define LDG(T, base, boff) (*(const __attribute__((address_space(1))) T*)((const __attribute__((address_space(1))) unsigned char*)(base) + (unsigned)(boff)))
#define STG(T, base, boff) (*(__attribute__((address_space(1))) T*)((__attribute__((address_space(1))) unsigned char*)(base) + (unsigned)(boff)))

__device__ __forceinline__ unsigned pk2(float lo, float hi) { f32x2 v = {lo, hi}; bf16x2_t b = __builtin_convertvector(v, bf16x2_t); return __builtin_bit_cast(unsigned, b); }
__device__ __forceinline__ float bf_lo(unsigned u) { return __uint_as_float(u << 16); }
__device__ __forceinline__ float bf_hi(unsigned u) { return __uint_as_float(u & 0xffff0000u); }
__device__ __forceinline__ f32x4 unpack4(u32x2 v) { return (f32x4){bf_lo(v.x), bf_hi(v.x), bf_lo(v.y), bf_hi(v.y)}; }
__device__ __forceinline__ u32x2 pack4(f32x4 v) { u32x2 r; r.x = pk2(v[0], v[1]); r.y = pk2(v[2], v[3]); return r; }
__device__ __forceinline__ float sigmf(float x) { return __builtin_amdgcn_rcpf(1.f + __expf(-x)); }
template <int CTRL> __device__ __forceinline__ float dpp_f(float x) { return __builtin_bit_cast(float, __builtin_amdgcn_update_dpp(0, __builtin_bit_cast(int, x), CTRL, 0xF, 0xF, true)); }
__device__ __forceinline__ float allreduce16(float x) { x += dpp_f<0xB1>(x); x += dpp_f<0x4E>(x); x += dpp_f<0x141>(x); x += dpp_f<0x140>(x); return x; }
__device__ __forceinline__ float rdlane(float x, int l) { return __builtin_bit_cast(float, __builtin_amdgcn_readlane(__builtin_bit_cast(int, x), l)); }
__device__ __forceinline__ float wave_sum(float v) {
    v = allreduce16(v);
    return (rdlane(v, 0) + rdlane(v, 16)) + (rdlane(v, 32) + rdlane(v, 48));
}
__device__ __forceinline__ float swap32_sum(float x) { auto rr = __builtin_amdgcn_permlane32_swap(__float_as_uint(x), __float_as_uint(x), false, false); return __uint_as_float(rr[0]) + __uint_as_float(rr[1]); }
__device__ __forceinline__ float swap32_max(float x) { auto rr = __builtin_amdgcn_permlane32_swap(__float_as_uint(x), __float_as_uint(x), false, false); return fmaxf(__uint_as_float(rr[0]), __uint_as_float(rr[1])); }

constexpr int M = 12288, MC = 4096, DM = 1024, NIN = 3072, FF = 2816, NFF2 = 5632, DEPTH = 4;
constexpr float LOG2E = 1.4426950408889634f;
constexpr float QSCALE_A = 0.125f * LOG2E;
constexpr float QSCALE_B = 0.17677669529663687f * LOG2E;
constexpr unsigned OFF_AK = 12582912, OFF_AV = 14680064, OFF_BK = 16777216, OFF_BV = 20971520, OFF_CF = 25165824, OFF_CB = 26738688;
constexpr unsigned MiB = 1u << 20;
constexpr unsigned WS_CTL = 0, CTL_BYTES = 1 * MiB;
constexpr unsigned WS_MOD = 1 * MiB;
constexpr unsigned WS_TAB = 1 * MiB + 512 * 1024;
constexpr unsigned WS_SMALLW = 2 * MiB;
constexpr unsigned WS_CACHE = 4 * MiB;
constexpr unsigned WS_WIN = 10 * MiB, WS_WOUT = 16 * MiB, WS_W13 = 18 * MiB, WS_W2 = 29 * MiB;
constexpr unsigned WSET_STRIDE = 184 * MiB;
constexpr unsigned WS_ACT = 35 * MiB;
constexpr unsigned WS_QA = 59 * MiB, WS_KA = 68 * MiB, WS_VTA = 71 * MiB, WS_QB = 74 * MiB, WS_KB = 80 * MiB, WS_VTB = 86 * MiB;
constexpr unsigned WS_RKV = 92 * MiB, WS_CW = 119 * MiB, WS_CA = 122 * MiB, WS_CG = 125 * MiB;
constexpr unsigned WS_YF = 128 * MiB, WS_YB = 146 * MiB;
constexpr unsigned WS_SV = 164 * MiB;
constexpr unsigned WS_BO2 = 182 * MiB, WS_ML = 230 * MiB;
constexpr unsigned WS_XB = 206 * MiB;
constexpr unsigned WS_WSET1 = 194 * MiB;
constexpr unsigned WS_RM = 236 * MiB, WS_RN = 254 * MiB, WS_RP = 324 * MiB, WS_RH = 342 * MiB;
constexpr int NCHUNK = 2304;
constexpr unsigned WS_U = 128 * MiB;
constexpr unsigned WS_G = 290 * MiB, WS_SB = 299 * MiB, WS_BO = 300 * MiB, WS_END = 360 * MiB;
constexpr int SMALLW_L = 147456;
constexpr int TAB_COSA = 0, TAB_SINA = 1024, TAB_COSB = 2048, TAB_SINB = 2560, TAB_LAM = 3072;
constexpr int LDS_BYTES = 148480;
constexpr int NPHASE = 2 + 9 * DEPTH;

struct Args {
    const float* in[34];
    float* out; unsigned char* ws;
    int ph_lo, ph_hi;
};

struct EpiRes {
    static constexpr bool PERM = true, AFTER_DRAIN = false;
    const float* baseC; const float* baseL; unsigned char* ws; const float* gate; bool first; unsigned xo; bool skip = false;
    template <int MF>
    __device__ __forceinline__ void operator()(const f32x4 (&acc)[2][2][MF][2], const pg8::Unit& u, int wr, int wc, int fr_, int fq_) const {
        if (skip) return;
        int fr = fr_, fq = fq_; asm volatile("" : "+v"(fr), "+v"(fq));
        const unsigned col0 = u.pn * 256 + wc * 32 + 8 * fq, rowb = u.pm * (MF * 64) + wr * (MF * 16);
        f32x4 g4[2][2]; int vcur = -1;
#pragma unroll
        for (int ai = 0; ai < 2; ++ai)
#pragma unroll
            for (int m = 0; m < MF; ++m) { const unsigned rf = rowb + ai * (MF * 32) + m * 16, off = (rf + fr) * DM + col0;
                const int v = rf < MC ? 0 : (rf < MC + 4096 ? 1 : 2);
                if (v != vcur) { vcur = v;
#pragma unroll
                    for (int bj = 0; bj < 2; ++bj)
#pragma unroll
                        for (int n = 0; n < 2; ++n) g4[bj][n] = LDG(f32x4, gate, (v * 6144 + col0 + bj * 128 + n * 4) * 4); }
#pragma unroll
                for (int bj = 0; bj < 2; ++bj) { f32x4 b0, b1;
                    if (first) { const float* base = rf < MC ? baseC : baseL; b0 = LDG(f32x4, base, (off + bj * 128) * 4); b1 = LDG(f32x4, base, (off + bj * 128 + 4) * 4); }
                    else { const u32x4 xb = LDG(u32x4, ws, WS_XB + (off + bj * 128) * 2); b0 = (f32x4){bf_lo(xb.x), bf_hi(xb.x), bf_lo(xb.y), bf_hi(xb.y)}; b1 = (f32x4){bf_lo(xb.z), bf_hi(xb.z), bf_lo(xb.w), bf_hi(xb.w)}; }
                    b0 = b0 + g4[bj][0] * acc[ai][bj][m][0]; b1 = b1 + g4[bj][1] * acc[ai][bj][m][1];
                    u32x4 w; w.x = pk2(b0[0], b0[1]); w.y = pk2(b0[2], b0[3]); w.z = pk2(b1[0], b1[1]); w.w = pk2(b1[2], b1[3]);
                    STG(u32x4, ws, xo + (off + bj * 128) * 2) = w; } }
    }
};
struct EpiResD : EpiRes {
    static constexpr bool AFTER_DRAIN = true;
    template <int MF>
    __device__ __forceinline__ void fused(const f32x4 (&acc)[2][2][MF][2], const pg8::Unit& u, int wr, int wc, int fr_, int fq_, LAS unsigned char* lds, int wid, int lane_) const {
        if (skip) return;
        int fr = fr_, fq = fq_, lane = lane_; asm volatile("" : "+v"(fr), "+v"(fq), "+v"(lane));
        constexpr int HR = MF * 32, PITCH = 1040;
        const unsigned c8 = (lane & 31) * 8, colg = u.pn * 256 + c8;
#pragma unroll
        for (int ai = 0; ai < 2; ++ai) {
            if (ai) asm volatile("s_waitcnt lgkmcnt(0)\n\ts_barrier" ::: "memory");
#pragma unroll
            for (int m = 0; m < MF; ++m)
#pragma unroll
                for (int bj = 0; bj < 2; ++bj)
#pragma unroll
                    for (int n = 0; n < 2; ++n) *(LAS f32x4*)(lds + (wr * (MF * 16) + m * 16 + fr) * PITCH + (bj * 128 + wc * 32 + 8 * fq + 4 * n) * 4) = acc[ai][bj][m][n];
            asm volatile("s_waitcnt lgkmcnt(0)\n\ts_barrier" ::: "memory");
#pragma unroll 2
            for (int i = 0; i < HR / 16; ++i) { const unsigned rl = i * 16 + wid * 2 + (lane >> 5), row = u.pm * (MF * 64) + ai * HR + rl, off = row * DM + colg;
                const f32x4 a0 = *(const LAS f32x4*)(lds + rl * PITCH + c8 * 4), a1 = *(const LAS f32x4*)(lds + rl * PITCH + c8 * 4 + 16);
                const unsigned v = row < (unsigned)MC ? 0u : (row < (unsigned)MC + 4096u ? 1u : 2u);
                const f32x4 g0 = LDG(f32x4, gate, (v * 6144 + colg) * 4), g1 = LDG(f32x4, gate, (v * 6144 + colg + 4) * 4);
                f32x4 b0, b1;
                if (first) { const float* base = row < (unsigned)MC ? baseC : baseL; b0 = LDG(f32x4, base, off * 4); b1 = LDG(f32x4, base, (off + 4) * 4); }
                else { const u32x4 xb = LDG(u32x4, ws, WS_XB + off * 2); b0 = (f32x4){bf_lo(xb.x), bf_hi(xb.x), bf_lo(xb.y), bf_hi(xb.y)}; b1 = (f32x4){bf_lo(xb.z), bf_hi(xb.z), bf_lo(xb.w), bf_hi(xb.w)}; }
                b0 = b0 + g0 * a0; b1 = b1 + g1 * a1;
                u32x4 w; w.x = pk2(b0[0], b0[1]); w.y = pk2(b0[2], b0[3]); w.z = pk2(b1[0], b1[1]); w.w = pk2(b1[2], b1[3]);
                STG(u32x4, ws, xo + off * 2) = w; }
        }
    }
};
struct EpiSwi {
    static constexpr bool PERM = true, AFTER_DRAIN = false;
    bf16_t* U; bool skip = false;
    template <int MF>
    __device__ __forceinline__ void operator()(const f32x4 (&acc)[2][2][MF][2], const pg8::Unit& u, int wr, int wc, int fr_, int fq_) const {
        if (skip) return;
        int fr = fr_, fq = fq_; asm volatile("" : "+v"(fr), "+v"(fq));
        const unsigned row0 = u.pm * (MF * 64) + wr * (MF * 16) + fr, oc0 = u.pn * 128 + wc * 32 + 8 * fq;
#pragma unroll
        for (int ai = 0; ai < 2; ++ai)
#pragma unroll
            for (int m = 0; m < MF; ++m) { const unsigned ro = ((row0 + ai * (MF * 32) + m * 16) * FF + oc0) * 2; f32x4 o[2];
#pragma unroll
                for (int bj = 0; bj < 2; ++bj) { const f32x4 g = acc[ai][bj][m][0], up = acc[ai][bj][m][1];
#pragma unroll
                    for (int e = 0; e < 4; ++e) o[bj][e] = g[e] * sigmf(g[e]) * up[e]; }
                const u32x2 lo = pack4(o[0]), hi2 = pack4(o[1]);
                STG(u32x4, U, ro) = (u32x4){lo.x, lo.y, hi2.x, hi2.y}; asm volatile("" ::: "memory"); }
    }
};
struct EpiWin {
    static constexpr bool PERM = true, AFTER_DRAIN = false;
    unsigned char* ws; float* out; int l; LAS unsigned char* lds; bool skip = false;
    template <int MF>
    __device__ __forceinline__ void operator()(const f32x4 (&acc)[2][2][MF][2], const pg8::Unit& u, int wr, int wc, int fr_, int fq_) const {
        if (skip) return;
        int fr = fr_, fq = fq_; asm volatile("" : "+v"(fr), "+v"(fq));
        const unsigned rowb = u.pm * (MF * 64) + wr * (MF * 16), row0 = rowb + fr;
#pragma unroll
        for (int bj = 0; bj < 2; ++bj) {
            const unsigned c32 = u.pn * 256 + bj * 128 + wc * 32;
            const unsigned c8 = c32 + 8 * fq;
            if (c32 < 1152 && (c32 < 512 || c32 >= 640)) {
                const bool isA = c32 < 512;
                const bool isK = isA ? (c32 >= 384) : (c32 >= 896);
                const float qs = isK ? 1.f : (isA ? QSCALE_A : QSCALE_B);
                const unsigned ck = isA ? c8 - 384 : c8 - 896;
                const unsigned dbase = isA ? (isK ? WS_KA + (((ck >> 6) * 4 + ((ck & 63) >> 4)) * 64 + ((ck >> 3) & 1) * 32) * 16 : WS_QA + c8 * 2)
                                           : (isK ? WS_KB + (((ck >> 5) * 2 + ((ck & 31) >> 4)) * 64 + ((ck >> 3) & 1) * 32) * 16 : WS_QB + (c8 - 640) * 2);
                const unsigned dpitch = isA ? 768u : 512u;
#pragma unroll
                for (int ai = 0; ai < 2; ++ai)
#pragma unroll
                    for (int m = 0; m < MF; ++m) {
                        const unsigned row = row0 + ai * (MF * 32) + m * 16; const bool lat = rowb + ai * (MF * 32) + m * 16 >= (unsigned)MC;
                        f32x4 v0 = acc[ai][bj][m][0], v1 = acc[ai][bj][m][1];
                        if (lat) {
                            const unsigned t = (row - MC) & 4095, rp = t >> 6, cp = t & 63;
                            unsigned to_;
                            if (isA) { const unsigned pos = ((c32 >> 5) & 1) ? cp : rp; to_ = WS_TAB + (TAB_COSA + pos * 16 + 4 * fq) * 4; }
                            else { const unsigned pos = (fq >> 1) ? cp : rp; to_ = WS_TAB + (TAB_COSB + pos * 8 + 4 * (fq & 1)) * 4; }
                            const f32x4 c4 = LDG(f32x4, ws, to_), s4 = LDG(f32x4, ws, to_ + (isA ? 4096u : 2048u));
                            f32x4 w0, w1;
                            w0[0] = v0[0] * c4[0] - v0[1] * s4[0]; w0[1] = v0[1] * c4[0] + v0[0] * s4[0];
                            w0[2] = v0[2] * c4[1] - v0[3] * s4[1]; w0[3] = v0[3] * c4[1] + v0[2] * s4[1];
                            w1[0] = v1[0] * c4[2] - v1[1] * s4[2]; w1[1] = v1[1] * c4[2] + v1[0] * s4[2];
                            w1[2] = v1[2] * c4[3] - v1[3] * s4[3]; w1[3] = v1[3] * c4[3] + v1[2] * s4[3];
                            v0 = w0; v1 = w1;
                        } else if (isK) {
                            const unsigned b = row >> 8, t = row & 255;
                            const f32x4 ev = {v0[0], v0[2], v1[0], v1[2]}, od = {v0[1], v0[3], v1[1], v1[3]};
                            if (isA) { const unsigned o = (OFF_AK + ((b * 4 + l) * 256 + t) * 128 + (c32 - 384) + 4 * fq) * 4; STG(f32x4, out, o) = ev; STG(f32x4, out, o + 64) = od; }
                            else { const unsigned o = (OFF_BK + ((b * 4 + l) * 256 + t) * 256 + ((c8 - 896) & ~15u) + 4 * (fq & 1)) * 4; STG(f32x4, out, o) = ev; STG(f32x4, out, o + 32) = od; }
                        }
                        v0 = v0 * qs; v1 = v1 * qs;
                        u32x4 w; w.x = pk2(v0[0], v0[1]); w.y = pk2(v0[2], v0[3]); w.z = pk2(v1[0], v1[1]); w.w = pk2(v1[2], v1[3]);
                        STG(u32x4, ws, isK ? dbase + (row >> 5) * (isA ? 8192u : 16384u) + (row & 31) * 16 : dbase + row * dpitch) = w;
                        asm volatile("" ::: "memory");
                    }
            } else if (c32 < 1408) {
                const bool isA = c32 < 640;
                const unsigned cc = isA ? (c8 - 512) : (c8 - 1152), cw = isA ? (c32 - 512) : (c32 - 1152);
                const unsigned vfrag = (isA ? WS_VTA : WS_VTB) + (((cw >> 6) * 2 + ((cw >> 5) & 1)) * 2) * 1024;
                LAS unsigned char* lw = lds + (wr * 4 + wc) * 1024;
                LAS bf16_t* lq = (LAS bf16_t*)(lw + ((((fr >> 2) & 1) * 32 + 8 * fq) * 16 + (4 * (fr >> 3) + (fr & 3)) * 2));
#pragma unroll
                for (int ai = 0; ai < 2; ++ai)
#pragma unroll
                    for (int m = 0; m < MF; ++m) {
                        const unsigned rf = rowb + ai * (MF * 32) + m * 16, row = rf + fr; const bool lat = rf >= (unsigned)MC;
                        const f32x4 v0 = acc[ai][bj][m][0], v1 = acc[ai][bj][m][1];
                        if (!lat) { const unsigned b = row >> 8, t = row & 255;
                            const unsigned o = isA ? (OFF_AV + ((b * 4 + l) * 256 + t) * 128 + cc) * 4 : (OFF_BV + ((b * 4 + l) * 256 + t) * 256 + cc) * 4;
                            STG(f32x4, out, o) = v0; STG(f32x4, out, o + 16) = v1; }
                        const unsigned p0 = pk2(v0[0], v0[1]), p1 = pk2(v0[2], v0[3]), p2 = pk2(v1[0], v1[1]), p3 = pk2(v1[2], v1[3]);
                        lq[0 * 8] = (bf16_t)(p0 & 0xffff); lq[1 * 8] = (bf16_t)(p0 >> 16); lq[2 * 8] = (bf16_t)(p1 & 0xffff); lq[3 * 8] = (bf16_t)(p1 >> 16);
                        lq[4 * 8] = (bf16_t)(p2 & 0xffff); lq[5 * 8] = (bf16_t)(p2 >> 16); lq[6 * 8] = (bf16_t)(p3 & 0xffff); lq[7 * 8] = (bf16_t)(p3 >> 16);
                        const u32x4 tv = *(const LAS u32x4*)(lw + (fq * 16 + fr) * 16);
                        STG(u32x4, ws, vfrag + (rf >> 5) * (isA ? 8192u : 16384u) + ((rf >> 4) & 1) * 1024 + (fq * 16 + fr) * 16) = tv;
                        asm volatile("" ::: "memory");
                    }
            } else if (c32 < 2944) {
                const int kind = c32 < 2560 ? 0 : (c32 < 2688 ? 1 : (c32 < 2816 ? 2 : 3));
                const unsigned dbase = kind == 0 ? WS_RKV + (c8 - 1408) * 2 : (kind == 1 ? WS_CW + (c8 - 2560) * 2 : (kind == 2 ? WS_CA + (c8 - 2688) * 2 : WS_CG + (c8 - 2816) * 2));
                const unsigned dpitch = kind == 0 ? 2304u : 256u;
#pragma unroll
                for (int ai = 0; ai < 2; ++ai)
#pragma unroll
                    for (int m = 0; m < MF; ++m) {
                        const unsigned row = row0 + ai * (MF * 32) + m * 16; const bool lat = rowb + ai * (MF * 32) + m * 16 >= (unsigned)MC;
                        f32x4 v0 = acc[ai][bj][m][0], v1 = acc[ai][bj][m][1];
                        if (kind == 1) {
#pragma unroll
                            for (int e = 0; e < 4; ++e) { v0[e] = 1.f - 2.f * __builtin_amdgcn_rcpf(__expf(2.f * v0[e]) + 1.f); v1[e] = 1.f - 2.f * __builtin_amdgcn_rcpf(__expf(2.f * v1[e]) + 1.f); }
                        } else if (kind == 3) {
#pragma unroll
                            for (int e = 0; e < 4; ++e) { v0[e] = sigmf(v0[e]); v1[e] = sigmf(v1[e]); }
                        }
                        u32x4 w; w.x = pk2(v0[0], v0[1]); w.y = pk2(v0[2], v0[3]); w.z = pk2(v1[0], v1[1]); w.w = pk2(v1[2], v1[3]);
                        STG(u32x4, ws, dbase + row * dpitch) = w;
                        asm volatile("" ::: "memory");
                    }
            }
        }
    }
};

struct Frame {
    LAS unsigned char* lds;
    const float* const* in;
    float* out; unsigned char* ws;
    int tid, lane, wave, gw, ngw, G, bid, crep;
};
#define GAS __attribute__((address_space(1)))
template <class T> __device__ __forceinline__ T* gptr(T* p) {
#if defined(__HIP_DEVICE_COMPILE__)
    __builtin_assume(!__builtin_amdgcn_is_shared((const void*)p)); __builtin_assume(!__builtin_amdgcn_is_private((const void*)p));
#endif
    return p; }
#define INP(k) gptr(F.in[k])
#define WSP(T, off) gptr((T*)(F.ws + (off)))

__device__ __forceinline__ void phase_prologue(Frame& F) {
    const float* cvec = INP(8); const float* cctx = INP(9); const float* ada_w = INP(10); const float* ada_b = INP(11);
    LAS float* sl = (LAS float*)F.lds;
    LAS float* red = (LAS float*)(F.lds + 16384);
    for (int i = F.tid; i < 3072; i += 512) { const int v = i >> 10, k = i & 1023; const float x = v == 0 ? cctx[k] : cvec[(v - 1) * 1024 + k]; sl[i] = x / (1.f + __expf(-x)); }
    __syncthreads();
    float* mod = WSP(float, WS_MOD);
    for (int it = F.bid; it < 384; it += F.G) {
        const int l = it / 96, n0 = (it % 96) * 64;
        const float* W = ada_w + (size_t)l * 1024 * 6144 + n0 + F.lane;
        float a0 = 0.f, a1 = 0.f, a2 = 0.f;
        const int k0 = F.wave * 128;
#pragma unroll 8
        for (int k = k0; k < k0 + 128; ++k) { const float w = *(const GAS float*)(W + (size_t)k * 6144); a0 += sl[k] * w; a1 += sl[1024 + k] * w; a2 += sl[2048 + k] * w; }
        red[(F.wave * 3 + 0) * 64 + F.lane] = a0; red[(F.wave * 3 + 1) * 64 + F.lane] = a1; red[(F.wave * 3 + 2) * 64 + F.lane] = a2;
        __syncthreads();
        if (F.wave < 3) { float s = ada_b[l * 6144 + n0 + F.lane];
#pragma unroll
            for (int w = 0; w < 8; ++w) s += red[(w * 3 + F.wave) * 64 + F.lane];
            mod[(size_t)(l * 3 + F.wave) * 6144 + n0 + F.lane] = s; }
        __syncthreads();
    }
    float* tab = WSP(float, WS_TAB);
    if (F.bid == F.G - 1) {
        for (int i = F.tid; i < 1024; i += 512) { const int pos = i >> 4, f = i & 15; const float ang = (float)pos * __builtin_amdgcn_exp2f(-(float)f * (13.287712379549449f / 16.f)); tab[TAB_COSA + i] = __cosf(ang); tab[TAB_SINA + i] = __sinf(ang); }
        for (int i = F.tid; i < 512; i += 512) { const int pos = i >> 3, f = i & 7; const float ang = (float)pos * __builtin_amdgcn_exp2f(-(float)f * (13.287712379549449f / 8.f)); tab[TAB_COSB + i] = __cosf(ang); tab[TAB_SINB + i] = __sinf(ang); }
        if (F.wave < 4) { const float* lp = INP(16) + F.wave * 128; const int d = F.lane & 31;
            const float p1 = wave_sum(F.lane < 32 ? lp[d] * lp[32 + d] : 0.f), p2 = wave_sum(F.lane < 32 ? 0.f : lp[64 + d] * lp[96 + d]);
            if (F.lane == 0) tab[TAB_LAM + F.wave] = __expf(p1) - __expf(p2); }
    }
    const int gtid = F.bid * 512 + F.tid, gnt = F.G * 512;
    { bf16_t* sw = WSP(bf16_t, WS_SMALLW); const float* cw2 = INP(20); const float* ca2 = INP(22); const float* cg2 = INP(23);
      for (int idx = gtid; idx < 4 * SMALLW_L; idx += gnt) { const int l = idx / SMALLW_L, r = idx % SMALLW_L; float v;
          if (r < 98304) { const int which = r / 49152, rr = r % 49152, d = rr / 24576, ch = (rr % 24576) / 64, k = rr % 64; v = (which ? ca2 : cw2)[((size_t)(l * 2 + d) * 64 + k) * 384 + ch]; }
          else { const int rr = r - 98304, ch = rr / 128, k = rr % 128; v = cg2[((size_t)l * 128 + k) * 384 + ch]; }
          sw[idx] = (bf16_t)(pk2(v, 0.f) & 0xffff); } }
    { bf16_t* kca = WSP(bf16_t, WS_CACHE); bf16_t* vca = kca + 524288; bf16_t* kcb = vca + 524288; bf16_t* vcb = kcb + 1048576;
      const float* cak = INP(2); const float* cav = INP(3); const float* cbk = INP(4); const float* cbv = INP(5);
      for (int e = gtid; e < 524288; e += gnt) {
          const int j = e & 7, ln = (e >> 3) & 63, hi = ln >> 5, r32 = ln & 31, blk = (e >> 12) & 15, bl = e >> 16;
          { const int s = (e >> 9) & 3, kvh = (e >> 11) & 1, cp = kvh * 64 + 16 * s + 8 * hi + j, o = cp & 31, c = (cp - o) + (o >> 1) + 16 * (o & 1);
            kca[e] = (bf16_t)(pk2(cak[((size_t)bl * 512 + blk * 32 + r32) * 128 + c], 0.f) & 0xffff); }
          { const int ks = (e >> 9) & 1, db = (e >> 10) & 1, kvh = (e >> 11) & 1, key = blk * 32 + 16 * ks + 8 * (j >> 2) + 4 * hi + (j & 3);
            vca[e] = (bf16_t)(pk2(cav[((size_t)bl * 512 + key) * 128 + kvh * 64 + db * 32 + r32], 0.f) & 0xffff); } }
      for (int e = gtid; e < 1048576; e += gnt) {
          const int j = e & 7, ln = (e >> 3) & 63, hi = ln >> 5, r32 = ln & 31, blk = (e >> 13) & 15, bl = e >> 17;
          { const int s = (e >> 9) & 1, hm = (e >> 10) & 7, cp = hm * 32 + 16 * s + 8 * hi + j, o = cp & 15, c = (cp - o) + (o >> 1) + 8 * (o & 1);
            kcb[e] = (bf16_t)(pk2(cbk[((size_t)bl * 512 + blk * 32 + r32) * 256 + c], 0.f) & 0xffff); }
          { const int ks = (e >> 9) & 1, db = (e >> 10) & 1, h = (e >> 11) & 3, key = blk * 32 + 16 * ks + 8 * (j >> 2) + 4 * hi + (j & 3);
            vcb[e] = (bf16_t)(pk2(cbv[((size_t)bl * 512 + key) * 256 + h * 64 + db * 32 + r32], 0.f) & 0xffff); } } }
    for (int st = 0; st < 1; ++st) { u32x4* z = (u32x4*)(WSP(bf16_t, WS_WIN + st * WSET_STRIDE) + (size_t)2944 * 1024); unsigned z0; asm volatile("v_mov_b32 %0, 0" : "=v"(z0)); for (int i = gtid; i < 128 * 1024 / 8; i += gnt) z[i] = (u32x4){z0, z0, z0, z0}; }
}

template <int MAP> __device__ __forceinline__ int dest_row(int n) {
    if (MAP == 1) {
        if (n < 512) { const int o = n & 31; return (n - o) + 2 * (o & 15) + (o >> 4); }
        if (n >= 640 && n < 1152) { const int o = n & 15; return (n - o) + 2 * (o & 7) + (o >> 3); }
        return n;
    }
    if (MAP == 2 || MAP == 3) return (n >> 7) * 256 + ((n >> 2) & 1) * 128 + ((n >> 5) & 3) * 32 + ((n >> 3) & 3) * 8 + (MAP == 3 ? 4 : 0) + (n & 3);
    return n;
}
template <int MAP> __device__ __forceinline__ void transpose_item(const float* W, int K, int N, bf16_t* WT, LAS float* scr, int item, int lane) {
    const int nblk = N / 32, kb = item / nblk, nb = item % nblk, k0 = 64 * kb, n0 = 32 * nb;
    f32x4 wv[8];
#pragma unroll
    for (int i = 0; i < 8; ++i) wv[i] = *(const GAS f32x4*)(W + (size_t)(k0 + 8 * i + (lane >> 3)) * N + n0 + 4 * (lane & 7));
#pragma unroll
    for (int i = 0; i < 8; ++i) { LAS float* d = scr + (8 * i + (lane >> 3)) * 33 + 4 * (lane & 7); d[0] = wv[i][0]; d[1] = wv[i][1]; d[2] = wv[i][2]; d[3] = wv[i][3]; }
    asm volatile("s_waitcnt lgkmcnt(0)" ::: "memory");
    const int c = lane & 7;
#pragma unroll
    for (int j = 0; j < 4; ++j) { const int n = (lane >> 3) + 8 * j; const LAS float* s = scr + (8 * c) * 33 + n;
        u32x4 o; o.x = pk2(s[0 * 33], s[1 * 33]); o.y = pk2(s[2 * 33], s[3 * 33]); o.z = pk2(s[4 * 33], s[5 * 33]); o.w = pk2(s[6 * 33], s[7 * 33]);
        *(GAS u32x4*)(WT + (size_t)dest_row<MAP>(n0 + n) * K + k0 + 8 * c) = o; }
    asm volatile("s_waitcnt lgkmcnt(0)" ::: "memory");
}
template <int MAP> __device__ __forceinline__ void convert_item(const float* W, int K, int N, bf16_t* WT, int item, int lane) {
    const int nblk = N / 64, kb = item / nblk, nb = item % nblk, n = nb * 64 + lane;
    const GAS float* src = (const GAS float*)W + (size_t)(kb * 128) * N + n;
    GAS bf16_t* dst = (GAS bf16_t*)WT + (size_t)dest_row<MAP>(n) * K + kb * 128;
#pragma unroll
    for (int g = 0; g < 16; ++g) { float v[8];
#pragma unroll
        for (int e = 0; e < 8; ++e) v[e] = src[(size_t)(8 * g + e) * N];
        u32x4 o; o.x = pk2(v[0], v[1]); o.y = pk2(v[2], v[3]); o.z = pk2(v[4], v[5]); o.w = pk2(v[6], v[7]);
        *(GAS u32x4*)(dst + 8 * g) = o; }
}
constexpr int CV_IN = 46 * 8, CV_OUT = 16 * 8, CV_1 = 44 * 8, CV_2 = 16 * 22, CV_TOTAL = CV_IN + CV_OUT + 2 * CV_1 + CV_2;
__device__ __forceinline__ void convert_item_any(Frame& F, int l, int it) {
    const unsigned so = 0u * WSET_STRIDE;
    int r = it;
    if (r < CV_IN) { convert_item<1>(INP(14) + (size_t)l * 1024 * 2944, 1024, 2944, WSP(bf16_t, WS_WIN + so), r, F.lane); return; } r -= CV_IN;
    if (r < CV_OUT) { convert_item<0>(INP(29) + (size_t)l * 1024 * 1024, 1024, 1024, WSP(bf16_t, WS_WOUT + so), r, F.lane); return; } r -= CV_OUT;
    if (r < CV_1) { convert_item<2>(INP(30) + (size_t)l * 1024 * FF, 1024, FF, WSP(bf16_t, WS_W13 + so), r, F.lane); return; } r -= CV_1;
    if (r < CV_1) { convert_item<3>(INP(31) + (size_t)l * 1024 * FF, 1024, FF, WSP(bf16_t, WS_W13 + so), r, F.lane); return; } r -= CV_1;
    convert_item<0>(INP(32) + (size_t)l * FF * 1024, FF, 1024, WSP(bf16_t, WS_W2 + so), r, F.lane);
}
__device__ __forceinline__ void convert_weights(Frame& F, int l) {
    LAS float* scr = (LAS float*)(F.lds + F.wave * 16384); const unsigned so = 0u * WSET_STRIDE;
    const float* w_in = INP(14) + (size_t)l * 1024 * 2944; const float* w_out = INP(29) + (size_t)l * 1024 * 1024;
    const float* w1 = INP(30) + (size_t)l * 1024 * FF; const float* w3 = INP(31) + (size_t)l * 1024 * FF; const float* w2 = INP(32) + (size_t)l * FF * 1024;
    constexpr int I_IN = 16 * 92, I_OUT = 16 * 32, I_1 = 16 * 88, I_2 = 44 * 32;
    constexpr int NIT = I_IN + I_OUT + 2 * I_1 + I_2;
    for (int it = F.gw; it < NIT; it += F.ngw) {
        int r = it;
        if (r < I_IN) { transpose_item<1>(w_in, 1024, 2944, WSP(bf16_t, WS_WIN + so), scr, r, F.lane); continue; } r -= I_IN;
        if (r < I_OUT) { transpose_item<0>(w_out, 1024, 1024, WSP(bf16_t, WS_WOUT + so), scr, r, F.lane); continue; } r -= I_OUT;
        if (r < I_1) { transpose_item<2>(w1, 1024, FF, WSP(bf16_t, WS_W13 + so), scr, r, F.lane); continue; } r -= I_1;
        if (r < I_1) { transpose_item<3>(w3, 1024, FF, WSP(bf16_t, WS_W13 + so), scr, r, F.lane); continue; } r -= I_1;
        transpose_item<0>(w2, FF, 1024, WSP(bf16_t, WS_W2 + so), scr, r, F.lane);
    }
}

__device__ __forceinline__ void phase_norm(Frame& F, int l, int which  ) {
    const float* g = (which ? INP(13) : INP(12)) + l * 1024;
    const float* mod = WSP(float, WS_MOD) + (size_t)l * 3 * 6144 + (which ? 3072 : 0);
    bf16_t* H = WSP(bf16_t, WS_ACT);
    const bool first = (l == 0 && which == 0);
    f32x4 gv[4];
#pragma unroll
    for (int j = 0; j < 4; ++j) gv[j] = *(const GAS f32x4*)(g + 4 * F.lane + 256 * j);
    for (int row0 = F.gw; row0 < M; row0 += 2 * F.ngw) {
        f32x4 v[2][4]; float ss[2] = {0.f, 0.f};
#pragma unroll
        for (int u = 0; u < 2; ++u) { const int row = row0 + u * F.ngw; if (row < M) {
            if (first) { const float* xr = row < MC ? INP(0) + (size_t)row * DM : INP(1) + (size_t)(row - MC) * DM;
#pragma unroll
                for (int j = 0; j < 4; ++j) v[u][j] = *(const GAS f32x4*)(xr + 4 * F.lane + 256 * j); }
            else {
#pragma unroll
                for (int j = 0; j < 4; ++j) v[u][j] = unpack4(LDG(u32x2, F.ws, WS_XB + ((unsigned)row * DM + 4 * F.lane + 256 * j) * 2)); }
#pragma unroll
            for (int j = 0; j < 4; ++j) ss[u] += (v[u][j][0] * v[u][j][0] + v[u][j][1] * v[u][j][1]) + (v[u][j][2] * v[u][j][2] + v[u][j][3] * v[u][j][3]); } }
#pragma unroll
        for (int u = 0; u < 2; ++u) { const int row = row0 + u * F.ngw; if (row < M) {
            const float* mv = mod + (row < MC ? 0 : (row < 2 * MC ? 1 : 2)) * 6144;
            const float rstd = rsqrtf(wave_sum(ss[u]) * (1.f / 1024.f) + 1e-6f);
#pragma unroll
            for (int j = 0; j < 4; ++j) { const f32x4 sh = *(const GAS f32x4*)(mv + 4 * F.lane + 256 * j), sc = *(const GAS f32x4*)(mv + 1024 + 4 * F.lane + 256 * j);
                const f32x4 h = v[u][j] * rstd * gv[j] * (sc + 1.f) + sh;
                *(GAS u32x2*)(H + (size_t)row * DM + 4 * F.lane + 256 * j) = pack4(h); } } }
    }
}
__device__ __forceinline__ void phase_final_norm(Frame& F) {
    const float* g = INP(33);
    f32x4 gv[4];
#pragma unroll
    for (int j = 0; j < 4; ++j) gv[j] = *(const GAS f32x4*)(g + 4 * F.lane + 256 * j);
    for (int row = F.gw; row < M; row += F.ngw) {
        float* xr = gptr(F.out + (size_t)row * DM);
        f32x4 v[4]; float ss = 0.f;
#pragma unroll
        for (int j = 0; j < 4; ++j) { v[j] = unpack4(LDG(u32x2, F.ws, WS_XB + ((unsigned)row * DM + 4 * F.lane + 256 * j) * 2)); ss += (v[j][0] * v[j][0] + v[j][1] * v[j][1]) + (v[j][2] * v[j][2] + v[j][3] * v[j][3]); }
        const float rstd = rsqrtf(wave_sum(ss) * (1.f / 1024.f) + 1e-6f);
#pragma unroll
        for (int j = 0; j < 4; ++j) *(GAS f32x4*)(xr + 4 * F.lane + 256 * j) = v[j] * rstd * gv[j];
    }
}

#define MFMA32(a, b, c) __builtin_amdgcn_mfma_f32_32x32x16_bf16((a), (b), (c), 0, 0, 0)
#ifndef ATT_PROBE
#define ATT_PROBE 0
#endif
struct AttnQ { float m, l; bool mz; f32x16 o[2]; };
template <int DQK, bool MASK, int NQ>
__device__ __forceinline__ void attn_block(const bf16x8 (&qf)[NQ][DQK / 16], const bf16x8 (&kf)[DQK / 16], const bf16x8 (&vf)[4], AttnQ (&st)[NQ], int b, const int (&qpos)[NQ], int kpos0, int hi) {
    constexpr int NS = DQK / 16;
    f32x16 sc[NQ];
#pragma unroll
    for (int q = 0; q < NQ; ++q) { const f32x16 z = {}; sc[q] = MFMA32(kf[0], qf[q][0], z);
#pragma unroll
        for (int s = 1; s < NS; ++s) sc[q] = MFMA32(kf[s], qf[q][s], sc[q]); }
#pragma unroll
    for (int q = 0; q < NQ; ++q) {
        if (!st[q].mz) {
#pragma unroll
            for (int r = 0; r < 16; ++r) sc[q][r] -= st[q].m; }
        if (MASK) {
#pragma unroll
            for (int r = 0; r < 16; ++r) { const int key = kpos0 + 32 * b + (r & 3) + 8 * (r >> 2) + 4 * hi; const int dlt = key - qpos[q]; if (dlt > 128 || dlt < -128) sc[q][r] = -1e30f; }
        }
        float bm = fmaxf(fmaxf(sc[q][0], sc[q][1]), sc[q][2]);
#pragma unroll
        for (int r = 3; r < 15; r += 2) bm = fmaxf(fmaxf(bm, sc[q][r]), sc[q][r + 1]);
        bm = fmaxf(bm, sc[q][15]);
        bm = swap32_max(bm);
        if (__builtin_amdgcn_ballot_w64(bm > 64.f) != 0ull) {
            const float d = fmaxf(bm, 0.f);
            const float alpha = __builtin_amdgcn_exp2f(-d);
            st[q].m += d; st[q].l *= alpha; st[q].mz = false;
#pragma unroll
            for (int r = 0; r < 16; ++r) { st[q].o[0][r] *= alpha; st[q].o[1][r] *= alpha; sc[q][r] -= d; }
        }
#if ATT_PROBE == 1
        { float dmy = 0.f;
#pragma unroll
          for (int r = 0; r < 16; ++r) { float e_; asm volatile("v_exp_f32 %0, %1" : "=v"(e_) : "v"(sc[q][r])); dmy += e_; }
          asm volatile("" :: "v"(dmy)); }
#endif
        f32x2 rs2 = {0.f, 0.f};
#pragma unroll
        for (int r = 0; r < 16; r += 2) { sc[q][r] = __builtin_amdgcn_exp2f(sc[q][r]); sc[q][r + 1] = __builtin_amdgcn_exp2f(sc[q][r + 1]); rs2 += (f32x2){sc[q][r], sc[q][r + 1]}; }
        st[q].l += rs2[0] + rs2[1];
#if ATT_PROBE == 3
        { float d0 = 0.f, d1 = 0.f, d2 = 0.f, d3 = 0.f;
#pragma unroll
          for (int rr = 0; rr < 10; ++rr) { asm volatile("v_add_f32 %0, %0, %4\n\tv_add_f32 %1, %1, %5\n\tv_add_f32 %2, %2, %6\n\tv_add_f32 %3, %3, %7" : "+v"(d0), "+v"(d1), "+v"(d2), "+v"(d3) : "v"(sc[q][0]), "v"(sc[q][1]), "v"(sc[q][2]), "v"(sc[q][3])); }
          asm volatile("" :: "v"(d0), "v"(d1), "v"(d2), "v"(d3)); }
#endif
#if ATT_PROBE == 2
        { f32x16 dm = sc[q]; dm = MFMA32(kf[0], qf[q][0], dm); dm = MFMA32(kf[0], qf[q][0], dm); dm = MFMA32(kf[0], qf[q][0], dm); asm volatile("" :: "v"(dm)); }
#endif
        bf16x8 pb[2];
#pragma unroll
        for (int ks = 0; ks < 2; ++ks) { u32x4 w; w.x = pk2(sc[q][8 * ks], sc[q][8 * ks + 1]); w.y = pk2(sc[q][8 * ks + 2], sc[q][8 * ks + 3]); w.z = pk2(sc[q][8 * ks + 4], sc[q][8 * ks + 5]); w.w = pk2(sc[q][8 * ks + 6], sc[q][8 * ks + 7]); pb[ks] = __builtin_bit_cast(bf16x8, w); }
#pragma unroll
        for (int db = 0; db < 2; ++db)
#pragma unroll
            for (int ks = 0; ks < 2; ++ks) st[q].o[db] = MFMA32(vf[db * 2 + ks], pb[ks], st[q].o[db]);
    }
}
template <int DQK, bool MASK, int NQ>
__device__ __forceinline__ void attn_seg(const unsigned char* ws, const bf16x8 (&qf)[NQ][DQK / 16], AttnQ (&st)[NQ],
                                         unsigned kp, unsigned kblk  , unsigned vp, unsigned vblk, int nblk, const int (&qpos)[NQ], int kpos0, int hi) {
    constexpr int NS = DQK / 16;
    const GAS unsigned char* kq = (const GAS unsigned char*)ws + kp; const GAS unsigned char* vq = (const GAS unsigned char*)ws + vp;
    bf16x8 ka[NS], va[4], kb[NS], vb[4];
#define ATT_LOAD(kd, vd) do { _Pragma("unroll") for (int s = 0; s < NS; ++s) kd[s] = *(const GAS bf16x8*)(kq + 1024 * s); _Pragma("unroll") for (int f = 0; f < 4; ++f) vd[f] = *(const GAS bf16x8*)(vq + 1024 * f); } while (0)
    ATT_LOAD(ka, va);
    int b = 0;
    for (; b + 1 < nblk; b += 2) {
        kq += kblk; vq += vblk; ATT_LOAD(kb, vb);
        attn_block<DQK, MASK, NQ>(qf, ka, va, st, b, qpos, kpos0, hi);
        if (b + 2 < nblk) { kq += kblk; vq += vblk; }
        ATT_LOAD(ka, va);
        attn_block<DQK, MASK, NQ>(qf, kb, vb, st, b + 1, qpos, kpos0, hi);
    }
    if (b < nblk) attn_block<DQK, MASK, NQ>(qf, ka, va, st, b, qpos, kpos0, hi);
#undef ATT_LOAD
}
__device__ __forceinline__ void attnq_init(AttnQ& s, float l0) { s.m = 0.f; s.mz = true; s.l = l0; s.o[0] = (f32x16){}; s.o[1] = (f32x16){}; }
__device__ __forceinline__ void attn_a_item(Frame& F, int l, bool lat, int item) {
    int lane = F.lane; asm volatile("" : "+v"(lane));
    const unsigned char* ws = F.ws;
    const unsigned r32 = lane & 31, hi = lane >> 5;
    const unsigned nqb = lat ? 128 : 8;
    const unsigned qb = item % nqb, hq = (item / nqb) % 6, b = item / (nqb * 6), kvh = hq / 3;
    const unsigned seq0 = lat ? MC + b * 4096 : b * 256, q0 = qb * 32, row = seq0 + q0 + r32;
    const unsigned qo = WS_QA + (row * 384 + hq * 64 + 8 * hi) * 2;
    bf16x8 qf[1][4];
#pragma unroll
    for (int s = 0; s < 4; ++s) qf[0][s] = LDG(bf16x8, ws, qo + 32 * s);
    AttnQ st[1]; attnq_init(st[0], hi == 0 ? __builtin_amdgcn_exp2f(INP(15)[l * 6 + hq] * LOG2E) : 0.f);
    const int qpos[1] = {(int)(q0 + r32)};
    const unsigned fo = kvh * 4096 + lane * 16;
    if (!lat) {
        attn_seg<64, false, 1>(ws, qf, st, WS_KA + (seq0 >> 5) * 8192 + fo, 8192, WS_VTA + (seq0 >> 5) * 8192 + fo, 8192, 8, qpos, 0, hi);
    } else {
        const int ks = (int)q0 - 128 < 0 ? 0 : (int)q0 - 128, ke = q0 + 160 > 4096 ? 4096 : q0 + 160;
        attn_seg<64, true, 1>(ws, qf, st, WS_KA + ((seq0 + ks) >> 5) * 8192 + fo, 8192, WS_VTA + ((seq0 + ks) >> 5) * 8192 + fo, 8192, (ke - ks) >> 5, qpos, ks, hi);
        attn_seg<64, false, 1>(ws, qf, st, WS_CACHE + (b * 4 + l) * 131072 + fo, 8192, WS_CACHE + 1 * MiB + (b * 4 + l) * 131072 + fo, 8192, 16, qpos, 0, hi);
    }
    const float rl = 1.f / swap32_sum(st[0].l);
    const unsigned oo = WS_ACT + (row * DM + hq * 64 + 4 * hi) * 2;
#pragma unroll
    for (int db = 0; db < 2; ++db)
#pragma unroll
        for (int g = 0; g < 4; ++g) { const f32x4 v = {st[0].o[db][4 * g] * rl, st[0].o[db][4 * g + 1] * rl, st[0].o[db][4 * g + 2] * rl, st[0].o[db][4 * g + 3] * rl}; STG(u32x2, F.ws, oo + (32 * db + 8 * g) * 2) = pack4(v); }
}
__device__ __forceinline__ void attn_b_store(Frame& F, const AttnQ& s, unsigned mp, unsigned kh, unsigned row, unsigned h, unsigned hi) {
    const float lt = swap32_sum(s.l);
    const unsigned oo = WS_BO2 + (((mp * 2 + kh) * M + row) * 256 + h * 64 + 4 * hi) * 2;
#pragma unroll
    for (int db = 0; db < 2; ++db)
#pragma unroll
        for (int g = 0; g < 4; ++g) STG(u32x2, F.ws, oo + (32 * db + 8 * g) * 2) = pack4((f32x4){s.o[db][4 * g], s.o[db][4 * g + 1], s.o[db][4 * g + 2], s.o[db][4 * g + 3]});
    if (hi == 0) STG(f32x2, F.ws, WS_ML + ((((mp * 2 + kh) * M + row) * 4 + h) * 2) * 4) = (f32x2){s.m, lt};
}
__device__ __forceinline__ void attn_b_item(Frame& F, int l, bool lat, int item) {
    int lane = F.lane; asm volatile("" : "+v"(lane));
    const unsigned char* ws = F.ws;
    const unsigned r32 = lane & 31, hi = lane >> 5;
    if (lat) {
        const unsigned kh = item & 1, qb = (item >> 1) & 63, mp = (item >> 7) & 1, h = (item >> 8) & 3, b = item >> 10;
        const unsigned seq0 = MC + b * 4096, row0 = seq0 + qb * 64 + r32;
        bf16x8 qf[2][2];
#pragma unroll
        for (int q = 0; q < 2; ++q)
#pragma unroll
            for (int s = 0; s < 2; ++s) qf[q][s] = LDG(bf16x8, ws, WS_QB + ((row0 + 32 * q) * 256 + h * 64 + mp * 32 + 8 * hi) * 2 + 32 * s);
        AttnQ st[2]; attnq_init(st[0], 0.f); attnq_init(st[1], 0.f);
        const int qpos[2] = {0, 0};
        const unsigned kfo = (h * 2 + mp) * 2048 + lane * 16, vfo = h * 4096 + lane * 16;
        const unsigned blk0 = kh ? 72u : 0u, nb = kh ? 56 : 72;
        attn_seg<32, false, 2>(ws, qf, st, WS_KB + ((seq0 >> 5) + blk0) * 16384 + kfo, 16384, WS_VTB + ((seq0 >> 5) + blk0) * 16384 + vfo, 16384, nb, qpos, 0, hi);
        if (kh) attn_seg<32, false, 2>(ws, qf, st, WS_CACHE + 2 * MiB + (b * 4 + l) * 262144 + kfo, 16384, WS_CACHE + 4 * MiB + (b * 4 + l) * 262144 + vfo, 16384, 16, qpos, 0, hi);
        attn_b_store(F, st[0], mp, kh, row0, h, hi); attn_b_store(F, st[1], mp, kh, row0 + 32, h, hi);
    } else {
        const unsigned qb = item & 7, mp = (item >> 3) & 1, h = (item >> 4) & 3, b = item >> 6;
        const unsigned seq0 = b * 256, row = seq0 + qb * 32 + r32;
        bf16x8 qf[1][2];
#pragma unroll
        for (int s = 0; s < 2; ++s) qf[0][s] = LDG(bf16x8, ws, WS_QB + (row * 256 + h * 64 + mp * 32 + 8 * hi) * 2 + 32 * s);
        AttnQ st[1]; attnq_init(st[0], 0.f);
        const int qpos[1] = {0};
        const unsigned kfo = (h * 2 + mp) * 2048 + lane * 16, vfo = h * 4096 + lane * 16;
        attn_seg<32, false, 1>(ws, qf, st, WS_KB + (seq0 >> 5) * 16384 + kfo, 16384, WS_VTB + (seq0 >> 5) * 16384 + vfo, 16384, 8, qpos, 0, hi);
        attn_b_store(F, st[0], mp, 0, row, h, hi);
    }
}

constexpr int L_KT = 0, L_RT = 9216, L_BT = 18432, L_KK = 27648, L_VT = 36864, L_KKT = 46080, L_BTT = 55296, L_A1 = 64512, L_RHS2 = 81920, L_WT = 99328, L_U0T = 108544, L_GC = 117760, L_X0 = 118016;
constexpr int RPB = 144, RPF = 272;
__device__ __forceinline__ void chunk_decode(int cid, unsigned& seq0, int& T, unsigned& b, unsigned& h, unsigned& dir, int& c) {
    unsigned chain;
    if (cid < 768) { chain = (unsigned)cid >> 2; c = cid & 3; T = 256; b = chain / 12; seq0 = b * 256; }
    else { const unsigned x = (unsigned)cid - 768; chain = x >> 6; c = (int)(x & 63); T = 4096; b = chain / 12; seq0 = MC + b * 4096; }
    dir = chain & 1; h = (chain >> 1) % 6;
}
__device__ __forceinline__ bf16x8 acc_frag(const f32x16& x, int ks, float sgn) {
    u32x4 w; w.x = pk2(sgn * x[8 * ks], sgn * x[8 * ks + 1]); w.y = pk2(sgn * x[8 * ks + 2], sgn * x[8 * ks + 3]); w.z = pk2(sgn * x[8 * ks + 4], sgn * x[8 * ks + 5]); w.w = pk2(sgn * x[8 * ks + 6], sgn * x[8 * ks + 7]);
    return __builtin_bit_cast(bf16x8, w);
}
__device__ __forceinline__ bf16x8 lds_frag_nat(const LAS unsigned char* img, unsigned row, int ks, unsigned hi) { return *(const LAS bf16x8*)(img + row * RPB + (16 * ks + 8 * hi) * 2); }
__device__ __forceinline__ bf16x8 lds_frag_perm(const LAS unsigned char* img, unsigned row, int k0, unsigned hi) {
    const s16x4 a = *(const LAS s16x4*)(img + row * RPB + (k0 + 4 * hi) * 2), b = *(const LAS s16x4*)(img + row * RPB + (k0 + 8 + 4 * hi) * 2);
    return (bf16x8){a[0], a[1], a[2], a[3], b[0], b[1], b[2], b[3]};
}
__device__ __forceinline__ f32x16 gram_tile(const LAS unsigned char* lds, int aimg, int bimg, int sb, int tb, unsigned r32, unsigned hi, bool strict) {
    f32x16 acc = {};
#pragma unroll
    for (int ks = 0; ks < 4; ++ks) acc = MFMA32(lds_frag_nat(lds + aimg, 32 * sb + r32, ks, hi), lds_frag_nat(lds + bimg, 32 * tb + r32, ks, hi), acc);
    if (sb == tb) {
#pragma unroll
        for (int r = 0; r < 16; ++r) { const unsigned s_ = (r & 3) + 8 * (r >> 2) + 4 * hi; const bool keep = strict ? s_ < r32 : s_ <= r32; acc[r] = keep ? acc[r] : 0.f; }
    }
    return acc;
}
__device__ __forceinline__ void lds_barrier() { asm volatile("s_waitcnt lgkmcnt(0)\n\ts_barrier" ::: "memory"); }
__device__ __forceinline__ void rwkv_chunk_block(Frame& F, int l, int cid) {
    int lane = F.lane; asm volatile("" : "+v"(lane));
    const unsigned char* ws = F.ws; LAS unsigned char* lds = F.lds;
    const int w = F.wave; const unsigned r32 = lane & 31, hi = lane >> 5;
    unsigned seq0, b, h, dir; int T, c; chunk_decode(cid, seq0, T, b, h, dir, c);
    const int q0 = 64 * c;
#ifndef RA_REP
#define RA_REP 0
#endif
    const int role = w >> 1, tb = w & 1;
    const unsigned swo = WS_SMALLW + l * (SMALLW_L * 2);
    {
        const int pw_ = w < 4, pb = (w >> 1) & 1, cb = w & 1;
        const int p_ = 32 * pb + r32; const unsigned tokp = seq0 + (dir ? T - 1 - (q0 + p_) : q0 + p_);
        const unsigned xo = (pw_ ? WS_CW : WS_CA) + (tokp * 128 + dir * 64 + 8 * hi) * 2, wo = swo + ((pw_ ? 0 : 49152) + (dir * 384 + h * 64 + 32 * cb + r32) * 64 + 8 * hi) * 2;
        f32x16 acc = {};
#pragma unroll
        for (int ks = 0; ks < 4; ++ks) acc = MFMA32(LDG(bf16x8, ws, xo + 32 * ks), LDG(bf16x8, ws, wo + 32 * ks), acc);
        {
            const float bias = LDG(float, pw_ ? INP(19) : INP(21), ((l * 2 + dir) * 384 + h * 64 + 32 * cb + r32) * 4);
#pragma unroll
            for (int r = 0; r < 16; ++r) { const float sg = sigmf(bias + acc[r]);
                *(LAS float*)(lds + (pw_ ? L_A1 : L_RHS2) + (32 * pb + (r & 3) + 8 * (r >> 2) + 4 * hi) * RPF + (32 * cb + r32) * 4) = pw_ ? -0.606531f * sg : sg; }
        }
        if (dir == 0 && w < 4) {
            f32x16 ag = {};
            const unsigned go = WS_CG + (tokp * 128 + 8 * hi) * 2, gw_ = swo + (98304 + (h * 64 + 32 * cb + r32) * 128 + 8 * hi) * 2;
#pragma unroll
            for (int ks = 0; ks < 8; ++ks) ag = MFMA32(LDG(bf16x8, ws, go + 32 * ks), LDG(bf16x8, ws, gw_ + 32 * ks), ag);
#pragma unroll
            for (int r = 0; r < 16; ++r) { const int pp_ = 32 * pb + (r & 3) + 8 * (r >> 2) + 4 * hi; const unsigned tk = seq0 + q0 + pp_;
                STG(bf16_t, F.ws, WS_G + (tk * 384 + h * 64 + 32 * cb + r32) * 2) = (bf16_t)(pk2(ag[r], 0.f) & 0xffff); }
        }
    }
    lds_barrier();
    {
        const unsigned cch = h * 64 + lane;
        const float* convp = INP(18) + (size_t)l * 3 * 1152;
        float cw_[3][3];
#pragma unroll
        for (int tap = 0; tap < 3; ++tap)
#pragma unroll
            for (int seg = 0; seg < 3; ++seg) cw_[tap][seg] = LDG(float, convp, (tap * 1152 + seg * 384 + cch) * 4);
        const float ckk = LDG(float, INP(24), (l * 384 + cch) * 4), cka = LDG(float, INP(25), (l * 384 + cch) * 4), crk = LDG(float, INP(26), (l * 384 + cch) * 4);
        const int tb0 = dir ? T - 1 - (q0 + 8 * w + 7) : q0 + 8 * w;
        float xr[10][3];
#pragma unroll
        for (int rr = 0; rr < 10; ++rr) { const int tr = tb0 - 1 + rr; const bool ok = tr >= 0 && tr < T; const unsigned tk = seq0 + (ok ? tr : tb0);
#pragma unroll
            for (int seg = 0; seg < 3; ++seg) { const float x = bf_lo((unsigned)LDG(bf16_t, ws, WS_RKV + (tk * 1152 + seg * 384 + cch) * 2)); xr[rr][seg] = ok ? x : 0.f; } }
        float lwv[8], kkv[8], btv[8], kdv[8], rv[8], vv[8], g = 0.f;
#pragma unroll
        for (int pp = 0; pp < 8; ++pp) {
            const int rr = 1 + (dir ? 7 - pp : pp); const int p = 8 * w + pp; const unsigned tok = seq0 + (unsigned)(tb0 + rr - 1);
            const float r_ = xr[rr - 1][0] * cw_[0][0] + xr[rr][0] * cw_[1][0] + xr[rr + 1][0] * cw_[2][0];
            const float k_ = xr[rr - 1][1] * cw_[0][1] + xr[rr][1] * cw_[1][1] + xr[rr + 1][1] * cw_[2][1];
            const float v_ = xr[rr - 1][2] * cw_[0][2] + xr[rr][2] * cw_[1][2] + xr[rr + 1][2] * cw_[2][2];
            const float kraw = k_ * ckk; const float n2 = wave_sum(kraw * kraw); const float kk_ = kraw * __builtin_amdgcn_rsqf(fmaxf(n2, 1e-24f));
            const float lw = *(const LAS float*)(lds + L_A1 + p * RPF + lane * 4), av = *(const LAS float*)(lds + L_RHS2 + p * RPF + lane * 4);
            const float kd_ = k_ * (1.f + (av - 1.f) * cka);
            const float bon = wave_sum(r_ * kd_ * crk);
            if (lane == 0) STG(float, F.ws, WS_SB + ((dir * M + tok) * 8 + h) * 4) = bon;
            if (dir == 0) STG(float, F.ws, WS_SV + (tok * 384 + cch) * 4) = v_;
            lwv[pp] = lw; kkv[pp] = kk_; btv[pp] = kk_ * av; kdv[pp] = kd_; rv[pp] = r_; vv[pp] = v_; g += lw;
        }
        g = 0.f;
        for (int wq = 0; wq < w; ++wq) { float t8[8];
#pragma unroll
            for (int e = 0; e < 8; ++e) t8[e] = *(const LAS float*)(lds + L_A1 + (8 * wq + e) * RPF + lane * 4);
            g += ((t8[0] + t8[1]) + (t8[2] + t8[3])) + ((t8[4] + t8[5]) + (t8[6] + t8[7])); }
        unsigned vt[4], kkt[4], btt[4]; float e_pos = __expf(g);
#pragma unroll
        for (int pp = 0; pp < 8; ++pp) {
            const int p = 8 * w + pp;
            const float e_prev = e_pos; g += lwv[pp]; e_pos = __expf(g); const float e_neg = __expf(-g);
            const unsigned pk_kr = pk2(kkv[pp] * e_prev, rv[pp] * e_pos), pk_bk = pk2(btv[pp] * e_neg, kdv[pp] * e_neg), pk_v = pk2(vv[pp], 0.f);
            *(LAS bf16_t*)(lds + L_KT + p * RPB + lane * 2) = (bf16_t)(pk_kr & 0xffff); *(LAS bf16_t*)(lds + L_RT + p * RPB + lane * 2) = (bf16_t)(pk_kr >> 16);
            *(LAS bf16_t*)(lds + L_BT + p * RPB + lane * 2) = (bf16_t)(pk_bk & 0xffff); *(LAS bf16_t*)(lds + L_KK + p * RPB + lane * 2) = (bf16_t)(pk_bk >> 16);
            if (pp & 1) { vt[pp >> 1] |= pk_v << 16; kkt[pp >> 1] |= pk_bk & 0xffff0000u; btt[pp >> 1] |= pk_bk << 16; }
            else { vt[pp >> 1] = pk_v & 0xffff; kkt[pp >> 1] = pk_bk >> 16; btt[pp >> 1] = pk_bk & 0xffff; }
        }
        *(LAS u32x4*)(lds + L_VT + lane * RPB + 16 * w) = (u32x4){vt[0], vt[1], vt[2], vt[3]};
        *(LAS u32x4*)(lds + L_KKT + lane * RPB + 16 * w) = (u32x4){kkt[0], kkt[1], kkt[2], kkt[3]};
        *(LAS u32x4*)(lds + L_BTT + lane * RPB + 16 * w) = (u32x4){btt[0], btt[1], btt[2], btt[3]};
        if (w == 7) *(LAS float*)(lds + L_GC + lane * 4) = e_pos;
    }
    lds_barrier();
    f32x16 keep[2]; bf16x8 x4f[2][2];
    if (role == 0) {
        for (int sb = 0; sb <= tb; ++sb) { const f32x16 x = gram_tile(lds, L_BT, L_KT, sb, tb, r32, hi, true);
            if (sb == tb) {
#pragma unroll
                for (int r = 0; r < 16; ++r) *(LAS float*)(lds + L_A1 + tb * 4608 + ((r & 3) + 8 * (r >> 2) + 4 * hi) * 144 + r32 * 4) = -x[r];
            } else {
#pragma unroll
                for (int g4 = 0; g4 < 4; ++g4) *(LAS f32x4*)(lds + L_A1 + 9216 + r32 * 144 + (8 * g4 + 4 * hi) * 4) = (f32x4){x[4 * g4], x[4 * g4 + 1], x[4 * g4 + 2], x[4 * g4 + 3]};
            } }
    } else if (role == 1) {
        f32x16 o[2] = {};
        for (int sb = 0; sb <= tb; ++sb) {
            const f32x16 x = gram_tile(lds, L_KK, L_KT, sb, tb, r32, hi, true);
#pragma unroll
            for (int ks = 0; ks < 2; ++ks) { const bf16x8 a = acc_frag(x, ks, 1.f);
#pragma unroll
                for (int ib = 0; ib < 2; ++ib) o[ib] = MFMA32(a, lds_frag_perm(lds + L_VT, 32 * ib + r32, 32 * sb + 16 * ks, hi), o[ib]); }
        }
#pragma unroll
        for (int ib = 0; ib < 2; ++ib)
#pragma unroll
            for (int r = 0; r < 16; ++r) *(LAS float*)(lds + L_RHS2 + (32 * tb + (r & 3) + 8 * (r >> 2) + 4 * hi) * RPF + (32 * ib + r32) * 4) = o[ib][r];
    } else if (role == 2) {
#pragma unroll
        for (int sb = 0; sb < 2; ++sb) { x4f[sb][0] = (bf16x8){}; x4f[sb][1] = (bf16x8){}; }
        keep[0] = (f32x16){}; keep[1] = (f32x16){};
        for (int sb = 0; sb <= tb; ++sb) {
            const f32x16 x3 = gram_tile(lds, L_KK, L_RT, sb, tb, r32, hi, false), x4 = gram_tile(lds, L_BT, L_RT, sb, tb, r32, hi, false);
#pragma unroll
            for (int ks = 0; ks < 2; ++ks) { const bf16x8 a3 = acc_frag(x3, ks, 1.f); const bf16x8 a4 = acc_frag(x4, ks, -1.f);
                if (sb == 0) x4f[0][ks] = a4; else x4f[1][ks] = a4;
#pragma unroll
                for (int cb = 0; cb < 2; ++cb) keep[cb] = MFMA32(a3, lds_frag_perm(lds + L_VT, 32 * cb + r32, 32 * sb + 16 * ks, hi), keep[cb]); }
        }
    } else {
        keep[0] = (f32x16){}; keep[1] = (f32x16){};
#pragma unroll
        for (int ks = 0; ks < 4; ++ks) { const bf16x8 ak = lds_frag_nat(lds + L_KKT, 32 * tb + r32, ks, hi);
#pragma unroll
            for (int cb = 0; cb < 2; ++cb) keep[cb] = MFMA32(ak, lds_frag_nat(lds + L_VT, 32 * cb + r32, ks, hi), keep[cb]); }
    }
    lds_barrier();
    if (w < 2) {
        const LAS unsigned char* a1p = lds + L_A1; asm volatile("" : "+v"(a1p));
        LAS unsigned char* xp = lds + (w == 0 ? L_X0 : L_RHS2) + lane * 4; asm volatile("" : "+v"(xp));
        const LAS unsigned char* kp = lds + L_KT + lane * 2; asm volatile("" : "+v"(kp));
        LAS unsigned char* dst = lds + (w == 0 ? L_WT : L_U0T) + lane * RPB; asm volatile("" : "+v"(dst));
#pragma unroll
        for (int B = 0; B < 2; ++B) {
            float acc[32];
            if (w == 0 && B == 0) {
#pragma unroll
                for (int r = 0; r < 32; ++r) acc[r] = bf_lo((unsigned)*(const LAS bf16_t*)(kp + r * RPB));
            } else {
#pragma unroll
                for (int r = 0; r < 32; ++r) acc[r] = *(const LAS float*)(xp + (32 * B + r) * RPF);
            }
            f32x2 ac2[16];
#pragma unroll
            for (int k = 0; k < 16; ++k) ac2[k] = (f32x2){acc[2 * k], acc[2 * k + 1]};
            f32x4 ca[8], cn[8];
#pragma unroll
            for (int tg = 0; tg < 8; ++tg) ca[tg] = *(const LAS f32x4*)(a1p + B * 4608 + tg * 16);
#pragma unroll
            for (int s_ = 0; s_ < 31; ++s_) {
                if (s_ + 1 < 31) {
#pragma unroll
                    for (int tg = (s_ + 2) / 4; tg < 8; ++tg) cn[tg] = *(const LAS f32x4*)(a1p + B * 4608 + (s_ + 1) * 144 + tg * 16);
                }
                __builtin_amdgcn_sched_barrier(0);
                const float xs = ac2[s_ >> 1][s_ & 1];
                const f32x2 xs2 = {xs, xs};
#pragma unroll
                for (int tg = (s_ + 1) / 4; tg < 8; ++tg) {
                    ac2[2 * tg] = __builtin_elementwise_fma((f32x2){ca[tg][0], ca[tg][1]}, xs2, ac2[2 * tg]);
                    ac2[2 * tg + 1] = __builtin_elementwise_fma((f32x2){ca[tg][2], ca[tg][3]}, xs2, ac2[2 * tg + 1]); }
                __builtin_amdgcn_sched_barrier(0);
#pragma unroll
                for (int tg = 0; tg < 8; ++tg) ca[tg] = cn[tg];
            }
#pragma unroll
            for (int k = 0; k < 16; ++k) { acc[2 * k] = ac2[k][0]; acc[2 * k + 1] = ac2[k][1]; }
#pragma unroll
            for (int k8 = 0; k8 < 4; ++k8) { u32x4 v; v.x = pk2(acc[8 * k8], acc[8 * k8 + 1]); v.y = pk2(acc[8 * k8 + 2], acc[8 * k8 + 3]); v.z = pk2(acc[8 * k8 + 4], acc[8 * k8 + 5]); v.w = pk2(acc[8 * k8 + 6], acc[8 * k8 + 7]);
                *(LAS u32x4*)(dst + 64 * B + 16 * k8) = v; }
            if (B == 0) {
                asm volatile("s_waitcnt lgkmcnt(0)" ::: "memory");
                f32x16 u[2];
#pragma unroll
                for (int cb = 0; cb < 2; ++cb)
#pragma unroll
                    for (int r = 0; r < 16; ++r) { const int t = 32 + (r & 3) + 8 * (r >> 2) + 4 * hi;
                        u[cb][r] = w == 0 ? bf_lo((unsigned)*(const LAS bf16_t*)(lds + L_KT + t * RPB + (32 * cb + r32) * 2)) : *(const LAS float*)(lds + L_RHS2 + t * RPF + (32 * cb + r32) * 4); }
#pragma unroll
                for (int ks = 0; ks < 2; ++ks) { const f32x4 a0 = *(const LAS f32x4*)(lds + L_A1 + 9216 + r32 * 144 + (16 * ks + 8 * hi) * 4), a1 = *(const LAS f32x4*)(lds + L_A1 + 9216 + r32 * 144 + (16 * ks + 8 * hi + 4) * 4);
                    u32x4 aw; aw.x = pk2(-a0[0], -a0[1]); aw.y = pk2(-a0[2], -a0[3]); aw.z = pk2(-a1[0], -a1[1]); aw.w = pk2(-a1[2], -a1[3]);
#pragma unroll
                    for (int cb = 0; cb < 2; ++cb) u[cb] = MFMA32(__builtin_bit_cast(bf16x8, aw), lds_frag_nat(lds + (w == 0 ? L_WT : L_U0T), 32 * cb + r32, ks, hi), u[cb]); }
#pragma unroll
                for (int cb = 0; cb < 2; ++cb)
#pragma unroll
                    for (int r = 0; r < 16; ++r) *(LAS float*)(lds + (w == 0 ? L_X0 : L_RHS2) + (32 + (r & 3) + 8 * (r >> 2) + 4 * hi) * RPF + (32 * cb + r32) * 4) = u[cb][r];
                asm volatile("s_waitcnt lgkmcnt(0)" ::: "memory");
            }
        }
    }
    lds_barrier();
    if (role == 2) {
        f32x16 pj[2];
#pragma unroll
        for (int cb = 0; cb < 2; ++cb)
#pragma unroll
            for (int g = 0; g < 4; ++g) { const u32x2 v = *(const LAS u32x2*)(lds + L_RT + (32 * tb + r32) * RPB + (32 * cb + 8 * g + 4 * hi) * 2);
                pj[cb][4 * g] = bf_lo(v.x); pj[cb][4 * g + 1] = bf_hi(v.x); pj[cb][4 * g + 2] = bf_lo(v.y); pj[cb][4 * g + 3] = bf_hi(v.y); }
#pragma unroll
        for (int sb = 0; sb < 2; ++sb)
#pragma unroll
            for (int ks = 0; ks < 2; ++ks)
#pragma unroll
                for (int cb = 0; cb < 2; ++cb) {
                    keep[cb] = MFMA32(x4f[sb][ks], lds_frag_perm(lds + L_U0T, 32 * cb + r32, 32 * sb + 16 * ks, hi), keep[cb]);
                    pj[cb] = MFMA32(lds_frag_perm(lds + L_WT, 32 * cb + r32, 32 * sb + 16 * ks, hi), x4f[sb][ks], pj[cb]); }
        f32x16 (&y0)[2] = keep;
        const unsigned nc_ = (unsigned)T >> 6, kst = dir ? nc_ - 1 - (unsigned)c : (unsigned)c, yidx = cid < 768 ? (b * 6 + h) * 4 + kst : 384 + (b * 6 + h) * 64 + kst;
        const unsigned ybase = (dir ? WS_YB : WS_YF) + yidx * 16384 + ((dir ? 1 - tb : tb) * 8) * 1024 + (dir ? (lane ^ 32) : lane) * 16;
#pragma unroll
        for (int cb = 0; cb < 2; ++cb)
#pragma unroll
            for (int q = 0; q < 4; ++q) { const f32x4 vf = {y0[cb][4 * q], y0[cb][4 * q + 1], y0[cb][4 * q + 2], y0[cb][4 * q + 3]}, vb = {y0[cb][4 * q + 3], y0[cb][4 * q + 2], y0[cb][4 * q + 1], y0[cb][4 * q]};
                STG(f32x4, F.ws, ybase + (cb * 4 + (dir ? 3 - q : q)) * 1024) = dir ? vb : vf; }
#pragma unroll
        for (int cb = 0; cb < 2; ++cb)
#pragma unroll
            for (int s2 = 0; s2 < 2; ++s2) { u32x4 w; w.x = pk2(pj[cb][8 * s2], pj[cb][8 * s2 + 1]); w.y = pk2(pj[cb][8 * s2 + 2], pj[cb][8 * s2 + 3]); w.z = pk2(pj[cb][8 * s2 + 4], pj[cb][8 * s2 + 5]); w.w = pk2(pj[cb][8 * s2 + 6], pj[cb][8 * s2 + 7]);
                STG(u32x4, F.ws, WS_RP + (unsigned)cid * 8192 + ((tb * 2 + cb) * 2 + s2) * 1024 + lane * 16) = w; }
    } else if (role == 3) {
        const int jb = tb;
        f32x16 q1[2] = {}, q2[2] = {}; f32x16 (&n1)[2] = keep;
#pragma unroll
        for (int ks = 0; ks < 4; ++ks) { const bf16x8 a = lds_frag_nat(lds + L_BTT, 32 * jb + r32, ks, hi);
#pragma unroll
            for (int cb = 0; cb < 2; ++cb) { q1[cb] = MFMA32(lds_frag_nat(lds + L_WT, 32 * cb + r32, ks, hi), a, q1[cb]); q2[cb] = MFMA32(a, lds_frag_nat(lds + L_U0T, 32 * cb + r32, ks, hi), q2[cb]); } }
#pragma unroll
        for (int q = 0; q < 4; ++q) { f32x4 gc4;
#pragma unroll
            for (int e = 0; e < 4; ++e) gc4[e] = *(const LAS float*)(lds + L_GC + (32 * jb + e + 8 * q + 4 * hi) * 4);
#pragma unroll
            for (int cb = 0; cb < 2; ++cb) { f32x4 nv;
#pragma unroll
                for (int e = 0; e < 4; ++e) nv[e] = gc4[e] * (n1[cb][4 * q + e] - q2[cb][4 * q + e]);
                STG(f32x4, F.ws, WS_RN + ((((unsigned)cid * 2 + jb) * 2 + cb) * 4 + q) * 1024 + lane * 16) = nv; } }
        { const float gl = *(const LAS float*)(lds + L_GC + (32 * jb + r32) * 4);
#pragma unroll
          for (int cb = 0; cb < 2; ++cb)
#pragma unroll
            for (int s2 = 0; s2 < 2; ++s2) { float mv[8];
#pragma unroll
                for (int e = 0; e < 8; ++e) { const int r = 8 * s2 + e; const unsigned c = 32 * cb + (r & 3) + 8 * (r >> 2) + 4 * hi; mv[e] = (c == 32 * jb + r32 ? gl : 0.f) - gl * q1[cb][r]; }
                u32x4 w; w.x = pk2(mv[0], mv[1]); w.y = pk2(mv[2], mv[3]); w.z = pk2(mv[4], mv[5]); w.w = pk2(mv[6], mv[7]);
                STG(u32x4, F.ws, WS_RM + (unsigned)cid * 8192 + ((jb * 2 + cb) * 2 + s2) * 1024 + lane * 16) = w; } }
    }
    lds_barrier();
}
__device__ __forceinline__ void rwkv_chain_wave(Frame& F, int l, bool lat, int chain, int ib) {
    int lane = F.lane; asm volatile("" : "+v"(lane));
    const unsigned char* ws = F.ws; const unsigned r32 = lane & 31, hi = lane >> 5;
    const unsigned dir = chain & 1, h = (chain >> 1) % 6, b = chain / 12;
    const int nc = lat ? 64 : 4; const unsigned cid0 = lat ? 768 + chain * 64 : chain * 4;
    const unsigned i = 32 * ib + r32;
    const unsigned so = ((((b * 4 + l) * 6 + h) * 64 + i) * 64) * 4;
    f32x16 H[2];
#pragma unroll
    for (int jb = 0; jb < 2; ++jb)
#pragma unroll
        for (int g4 = 0; g4 < 4; ++g4) { f32x4 v = {0.f, 0.f, 0.f, 0.f}; if (lat) v = LDG(f32x4, dir ? INP(7) : INP(6), so + (32 * jb + 8 * g4 + 4 * hi) * 4);
            H[jb][4 * g4] = v[0]; H[jb][4 * g4 + 1] = v[1]; H[jb][4 * g4 + 2] = v[2]; H[jb][4 * g4 + 3] = v[3]; }
    bf16x8 maA[2][2][2], maB[2][2][2]; f32x16 ntA[2], ntB[2];
    const GAS unsigned char* pm = (const GAS unsigned char*)ws + (WS_RM + cid0 * 8192 + lane * 16);
    const GAS unsigned char* pn = (const GAS unsigned char*)ws + (WS_RN + (cid0 * 4 + ib) * 4096 + lane * 16);
#define RB_LOAD(ma, nt, k_) do { \
        _Pragma("unroll") for (int jo = 0; jo < 2; ++jo) _Pragma("unroll") for (int ji = 0; ji < 2; ++ji) _Pragma("unroll") for (int ks = 0; ks < 2; ++ks) ma[jo][ji][ks] = *(const GAS bf16x8*)(pm + ((k_) * 8192 + ((jo * 2 + ji) * 2 + ks) * 1024)); \
        _Pragma("unroll") for (int jo = 0; jo < 2; ++jo) _Pragma("unroll") for (int q = 0; q < 4; ++q) { const f32x4 t_ = *(const GAS f32x4*)(pn + ((k_) * 16384 + (jo * 8 + q) * 1024)); \
            nt[jo][4 * q] = t_[0]; nt[jo][4 * q + 1] = t_[1]; nt[jo][4 * q + 2] = t_[2]; nt[jo][4 * q + 3] = t_[3]; } } while (0)
#define RB_STEP(ma, nt, cid_) do { \
        bf16x8 hf[2][2]; \
        _Pragma("unroll") for (int ji = 0; ji < 2; ++ji) { hf[ji][0] = acc_frag(H[ji], 0, 1.f); hf[ji][1] = acc_frag(H[ji], 1, 1.f); } \
        _Pragma("unroll") for (int ji = 0; ji < 2; ++ji) _Pragma("unroll") for (int ks = 0; ks < 2; ++ks) STG(bf16x8, F.ws, WS_RH + (cid_) * 8192 + ((ib * 2 + ji) * 2 + ks) * 1024 + lane * 16) = hf[ji][ks]; \
        f32x16 acc[2] = {nt[0], nt[1]}; \
        _Pragma("unroll") for (int jo = 0; jo < 2; ++jo) _Pragma("unroll") for (int ji = 0; ji < 2; ++ji) _Pragma("unroll") for (int ks = 0; ks < 2; ++ks) acc[jo] = MFMA32(ma[jo][ji][ks], hf[ji][ks], acc[jo]); \
        H[0] = acc[0]; H[1] = acc[1]; } while (0)
    RB_LOAD(maA, ntA, 0); RB_LOAD(maB, ntB, 1);
#pragma unroll 1
    for (int c = 0; c < nc; c += 2) {
        const unsigned cid = cid0 + c;
        RB_STEP(maA, ntA, cid);
        if (c + 2 < nc) RB_LOAD(maA, ntA, 2);
        RB_STEP(maB, ntB, cid + 1);
        if (c + 2 < nc) RB_LOAD(maB, ntB, 3);
        pm += 16384; pn += 32768;
    }
#undef RB_LOAD
#undef RB_STEP
    if (!lat) {
#pragma unroll
        for (int jb = 0; jb < 2; ++jb)
#pragma unroll
            for (int g4 = 0; g4 < 4; ++g4) STG(f32x4, F.out, (dir ? OFF_CB : OFF_CF) * 4 + so + (32 * jb + 8 * g4 + 4 * hi) * 4) = (f32x4){H[jb][4 * g4], H[jb][4 * g4 + 1], H[jb][4 * g4 + 2], H[jb][4 * g4 + 3]};
    }
}
__device__ __forceinline__ void rwkv_apply_wave(Frame& F, int item) {
    int lane = F.lane; asm volatile("" : "+v"(lane));
    const unsigned char* ws = F.ws; const unsigned r32 = lane & 31, hi = lane >> 5;
    const int cid = item >> 1, tb = item & 1;
    unsigned seq0, b, h, dir; int T, c; chunk_decode(cid, seq0, T, b, h, dir, c);
    const unsigned yb = dir ? WS_YB : WS_YF;
    f32x16 acc[2];
#pragma unroll
    for (int r = 0; r < 16; ++r) { const int t = 32 * tb + (r & 3) + 8 * (r >> 2) + 4 * hi; const unsigned tok = seq0 + (dir ? T - 1 - (64 * c + t) : 64 * c + t);
        acc[0][r] = LDG(float, ws, yb + (tok * 384 + h * 64 + r32) * 4); acc[1][r] = LDG(float, ws, yb + (tok * 384 + h * 64 + 32 + r32) * 4); }
#pragma unroll
    for (int ks = 0; ks < 4; ++ks) { const bf16x8 a = LDG(bf16x8, ws, WS_RP + (((unsigned)cid * 64 + 32 * tb + r32) * 64 + 16 * ks + 8 * hi) * 2);
#pragma unroll
        for (int ib = 0; ib < 2; ++ib) acc[ib] = MFMA32(a, LDG(bf16x8, ws, WS_RH + (((unsigned)cid * 64 + 32 * ib + r32) * 64 + 16 * ks + 8 * hi) * 2), acc[ib]); }
#pragma unroll
    for (int r = 0; r < 16; ++r) { const int t = 32 * tb + (r & 3) + 8 * (r >> 2) + 4 * hi; const unsigned tok = seq0 + (dir ? T - 1 - (64 * c + t) : 64 * c + t);
        STG(float, F.ws, yb + (tok * 384 + h * 64 + r32) * 4) = acc[0][r]; STG(float, F.ws, yb + (tok * 384 + h * 64 + 32 + r32) * 4) = acc[1][r]; }
}

template <int NI>
__device__ __forceinline__ void rwkv_out_items(Frame& F, int l, int item0, int istep) {
    int lane = F.lane; asm volatile("" : "+v"(lane));
    const unsigned char* ws = F.ws; const unsigned r32 = lane & 31, hi = lane >> 5;
    unsigned cidf[NI], cidb[NI], tok0[NI], tbv[NI], hv[NI];
    f32x16 acc[NI][2];
#pragma unroll
    for (int ni = 0; ni < NI; ++ni) { const int item = item0 + ni * istep;
        const int tb = item & 1, h = (item >> 1) % 6, sk = item / 12;
        const bool lat = sk >= 64; const int b = lat ? (sk - 64) >> 6 : sk >> 2, k = lat ? (sk - 64) & 63 : sk & 3, nc = lat ? 64 : 4;
        const unsigned seq0 = lat ? MC + b * 4096 : b * 256, base = lat ? 768u : 0u;
        const unsigned chf = (b * 6 + h) * 2;
        cidf[ni] = base + chf * nc + k; cidb[ni] = base + (chf + 1) * nc + (nc - 1 - k); tok0[ni] = seq0 + 64 * k + 32 * tb; tbv[ni] = tb; hv[ni] = h;
        const unsigned yo = (lat ? 384 + (b * 6 + h) * 64 + k : (b * 6 + h) * 4 + k) * 16384 + (tb * 8) * 1024 + lane * 16;
#pragma unroll
        for (int ib = 0; ib < 2; ++ib)
#pragma unroll
            for (int q = 0; q < 4; ++q) { const f32x4 yf = LDG(f32x4, ws, WS_YF + yo + (ib * 4 + q) * 1024), yb = LDG(f32x4, ws, WS_YB + yo + (ib * 4 + q) * 1024);
                acc[ni][ib][4 * q] = yf[0] + yb[0]; acc[ni][ib][4 * q + 1] = yf[1] + yb[1]; acc[ni][ib][4 * q + 2] = yf[2] + yb[2]; acc[ni][ib][4 * q + 3] = yf[3] + yb[3]; } }
#pragma unroll
    for (int ks = 0; ks < 4; ++ks)
#pragma unroll
        for (int ni = 0; ni < NI; ++ni) {
            const bf16x8 af = LDG(bf16x8, ws, WS_RP + cidf[ni] * 8192 + (tbv[ni] * 4 + ks) * 1024 + lane * 16), ab = LDG(bf16x8, ws, WS_RP + cidb[ni] * 8192 + ((1 - tbv[ni]) * 4 + ks) * 1024 + ((31 - r32) + 32 * hi) * 16);
#pragma unroll
            for (int ib = 0; ib < 2; ++ib) { acc[ni][ib] = MFMA32(af, LDG(bf16x8, ws, WS_RH + cidf[ni] * 8192 + (ib * 4 + ks) * 1024 + lane * 16), acc[ni][ib]);
                acc[ni][ib] = MFMA32(ab, LDG(bf16x8, ws, WS_RH + cidb[ni] * 8192 + (ib * 4 + ks) * 1024 + lane * 16), acc[ni][ib]); } }
    LAS unsigned char* lw = F.lds + F.wave * 18432;
#pragma unroll
    for (int ni = 0; ni < NI; ++ni)
#pragma unroll
        for (int ib = 0; ib < 2; ++ib)
#pragma unroll
            for (int r = 0; r < 16; ++r) *(LAS float*)(lw + ni * 9216 + ((r & 3) + 8 * (r >> 2) + 4 * hi) * 288 + (32 * ib + r32) * 4) = acc[ni][ib][r];
    const unsigned ts = lane >> 4, dg = lane & 15;
    f32x4 g4[NI], b4[NI];
#pragma unroll
    for (int ni = 0; ni < NI; ++ni) { g4[ni] = LDG(f32x4, INP(27), (l * 384 + hv[ni] * 64 + 4 * dg) * 4); b4[ni] = LDG(f32x4, INP(28), (l * 384 + hv[ni] * 64 + 4 * dg) * 4); }
#pragma unroll 2
    for (int i = 0; i < 8; ++i)
#pragma unroll
        for (int ni = 0; ni < NI; ++ni) { const unsigned h = hv[ni], tk = tok0[ni] + 4 * i + ts, e = tk * 384 + h * 64 + 4 * dg;
            const float bon = LDG(float, ws, WS_SB + (tk * 8 + h) * 4) + LDG(float, ws, WS_SB + ((M + tk) * 8 + h) * 4);
            const f32x4 y = *(const LAS f32x4*)(lw + ni * 9216 + (4 * i + ts) * 288 + dg * 16) + bon * LDG(f32x4, ws, WS_SV + e * 4);
            const float mu = allreduce16((y[0] + y[1]) + (y[2] + y[3])) * (1.f / 64.f);
            const f32x4 d = y - mu;
            const float rs = rsqrtf(allreduce16((d[0] * d[0] + d[1] * d[1]) + (d[2] * d[2] + d[3] * d[3])) * (1.f / 64.f) + 64e-5f);
            const f32x4 o = (d * rs * g4[ni] + b4[ni]) * unpack4(LDG(u32x2, ws, WS_G + e * 2));
            STG(u32x2, F.ws, WS_ACT + (tk * DM + 640 + h * 64 + 4 * dg) * 2) = pack4(o); }
}

#ifndef B_UNIT
#define B_UNIT 0
#endif
constexpr int AU_R = 8, AU_D = 4, AU_SLOT = 6144;
__device__ __forceinline__ void attn_b_unit(Frame& F, int l, int unit) {
    int lane = F.lane; asm volatile("" : "+v"(lane));
    const unsigned char* ws = F.ws; LAS unsigned char* lds = F.lds;
    const int w = F.wave; const unsigned r32 = lane & 31, hi = lane >> 5;
    const unsigned kh = unit & 1, qb = (unit >> 1) & 15, mp = (unit >> 5) & 1, h = (unit >> 6) & 3, b = unit >> 8;
    const unsigned seq0 = MC + b * 4096, row = seq0 + qb * 256 + 32 * w + r32;
    bf16x8 qf[1][2];
#pragma unroll
    for (int s = 0; s < 2; ++s) qf[0][s] = LDG(bf16x8, ws, WS_QB + (row * 256 + h * 64 + mp * 32 + 8 * hi) * 2 + 32 * s);
    AttnQ st[1]; attnq_init(st[0], 0.f);
    const int qpos[1] = {0};
    const int n0 = kh ? 56 : 72, nt = 72;
    const unsigned pofs = (w < 2 ? (h * 2 + mp) * 2048 + w * 1024 : h * 4096 + (w - 2) * 1024) + lane * 16;
    const unsigned base0 = (w < 2 ? WS_KB : WS_VTB) + ((seq0 >> 5) + (kh ? 72u : 0u)) * 16384 + pofs;
    const unsigned base1 = WS_CACHE + (w < 2 ? 2 * MiB : 4 * MiB) + (b * 4 + l) * 262144 + pofs;
#define AU_DMA(t_) do { const int tt_ = (t_) < nt ? (t_) : nt - 1; const unsigned src_ = tt_ < n0 ? base0 + tt_ * 16384 : base1 + (tt_ - n0) * 16384; \
        __builtin_amdgcn_global_load_lds((const GAS unsigned*)(ws + src_), (LAS unsigned*)(lds + ((t_) % AU_R) * AU_SLOT + w * 1024), 16, 0, 0); } while (0)
    if (w < 6) {
#pragma unroll
        for (int t = 0; t < AU_D; ++t) AU_DMA(t);
    }
    for (int t = 0; t < nt; ++t) {
        if (w < 6) asm volatile("s_waitcnt vmcnt(3)" ::: "memory");
        asm volatile("s_barrier" ::: "memory");
        const LAS unsigned char* sl = lds + (t % AU_R) * AU_SLOT + lane * 16;
        bf16x8 kf[2], vf[4];
        kf[0] = *(const LAS bf16x8*)(sl); kf[1] = *(const LAS bf16x8*)(sl + 1024);
#pragma unroll
        for (int f = 0; f < 4; ++f) vf[f] = *(const LAS bf16x8*)(sl + 2048 + 1024 * f);
        if (w < 6) AU_DMA(t + AU_D);
        attn_block<32, false, 1>(qf, kf, vf, st, t, qpos, 0, hi);
    }
#undef AU_DMA
    asm volatile("s_waitcnt vmcnt(0) lgkmcnt(0)\n\ts_barrier" ::: "memory");
    attn_b_store(F, st[0], mp, kh, row, h, hi);
}

constexpr int Q_BLAT = 2048, Q_ALAT = 1536, Q_BCTX = 1024, Q_ACTX = 768;
constexpr int Q_TOTAL = Q_BLAT + Q_ALAT + Q_BCTX + Q_ACTX;
#ifndef XCD_DEAL
#define XCD_DEAL 1
#endif
__device__ __forceinline__ void phase_mixer(Frame& F, int l, int rep) {
    if (rep == 0 || REP_PART == 0 || REP_PART == 1) {
        const int si = F.bid + F.G * F.wave;
        if (si < 48) rwkv_chain_wave(F, l, true, si >> 1, si & 1);
        else if (si < 48 + 384) rwkv_chain_wave(F, l, false, (si - 48) >> 1, (si - 48) & 1);
    }
    if (B_UNIT && (rep == 0 || REP_PART == 2 || REP_PART == 4)) {
        unsigned* uctr = (unsigned*)(F.ws + WS_CTL) + 64 * (32 + l + 4 * (rep + F.crep));
        LAS int* ubox = (LAS int*)(F.lds + 65536);
        for (;;) {
            if (F.wave == 0 && F.lane == 0) *ubox = (int)atomicAdd(uctr, 1u);
            lds_barrier();
            const int un = __builtin_amdgcn_readfirstlane(*ubox);
            lds_barrier();
            if (un >= 512) break;
            attn_b_unit(F, l, un);
        }
    }
    unsigned* ctr = (unsigned*)(F.ws + WS_CTL) + 64 * (1 + l + 4 * (rep + F.crep));
    const bool xdeal = XCD_DEAL && !B_UNIT && F.G == 256;
    if (xdeal && (rep == 0 || REP_PART == 2 || REP_PART == 4)) attn_b_item(F, l, true, (F.bid & 7) * 256 + (F.bid >> 3) * 8 + F.wave);
    unsigned* cx = (unsigned*)(F.ws + WS_CTL) + 8192 + ((l + 4 * (rep + F.crep)) * 8 + (F.bid & 7)) * 64;
    bool xq = xdeal;
    if (rep == 0 || REP_PART != 1) for (;;) {
        int it = 0;
        if (F.lane == 0) it = (int)atomicAdd(xq ? cx : ctr, 1u);
        it = __builtin_amdgcn_readfirstlane(it);
        if (xq) { if (it >= 192) { xq = false; continue; }
            const int x = F.bid & 7; it = Q_BLAT + (((x >> 2) * 6 + ((x >> 1) & 1) * 3 + it / 64) * 128 + (x & 1) * 64 + it % 64); }
        else it += xdeal ? Q_BLAT + Q_ALAT : (B_UNIT ? Q_BLAT : 0);
        if (it >= Q_TOTAL) break;
        if (it < Q_BLAT) { if (rep == 0 || REP_PART == 2 || REP_PART == 4) attn_b_item(F, l, true, it); continue; } it -= Q_BLAT;
        if (it < Q_ALAT) { if (rep == 0 || REP_PART == 2 || REP_PART == 3) attn_a_item(F, l, true, it); continue; } it -= Q_ALAT;
        if (it < Q_BCTX) { if (rep == 0 || REP_PART == 2 || REP_PART == 5) attn_b_item(F, l, false, it); continue; } it -= Q_BCTX;
        if (rep == 0 || REP_PART == 2 || REP_PART == 5) attn_a_item(F, l, false, it);
    }
}

#ifndef FIN_R2
#define FIN_R2 1
#endif
__device__ __forceinline__ void phase_finalize(Frame& F, int l, int rep) {
    const unsigned char* ws = F.ws;
    int lane = F.lane; asm volatile("" : "+v"(lane));
    const float lami = 0.8f - 0.6f * __expf(-0.3f * (float)l);
    const float lam = LDG(float, ws, WS_TAB + (TAB_LAM + l) * 4) + lami;
    const float omli = 1.f - lami;
    const unsigned hk = lane >> 4, dg = lane & 15;
    const f32x4 sg = LDG(f32x4, INP(17), (l * 64 + 4 * dg) * 4) * omli;
    const unsigned nw2 = (F.ngw < 2304 && 2 * F.ngw > 2304 + 64) ? 2304 - F.ngw : 0, npair = M / 2;
    const unsigned n2 = nw2 * FIN_R2;
    unsigned p = (unsigned)F.gw < nw2 ? F.gw : n2 + (F.gw - nw2);
    const unsigned pe = (unsigned)F.gw < nw2 ? n2 : npair, ps = (unsigned)F.gw < nw2 ? nw2 : F.ngw - nw2;
    for (; p < pe; p += ps) {
        const unsigned r0 = 2 * p;
#pragma unroll
        for (int rr = 0; rr < 2; ++rr) { const unsigned row = r0 + rr; f32x4 om[2];
#pragma unroll
            for (int mp = 0; mp < 2; ++mp) { const unsigned o0 = (((mp * 2) * M + row) * 256 + 64 * hk + 4 * dg) * 2, q0 = ((((mp * 2) * M + row) * 4 + hk) * 2) * 4;
                const f32x2 ml0 = LDG(f32x2, ws, WS_ML + q0);
                if (row >= (unsigned)MC) { const f32x2 ml1 = LDG(f32x2, ws, WS_ML + q0 + M * 32); const float ms = fmaxf(ml0[0], ml1[0]), w0 = __builtin_amdgcn_exp2f(ml0[0] - ms), w1 = __builtin_amdgcn_exp2f(ml1[0] - ms);
                    om[mp] = (unpack4(LDG(u32x2, ws, WS_BO2 + o0)) * w0 + unpack4(LDG(u32x2, ws, WS_BO2 + o0 + M * 512)) * w1) * __builtin_amdgcn_rcpf(ml0[1] * w0 + ml1[1] * w1); }
                else om[mp] = unpack4(LDG(u32x2, ws, WS_BO2 + o0)) * __builtin_amdgcn_rcpf(ml0[1]); }
            const f32x4 v = om[0] - lam * om[1];
            const float ms = allreduce16((v[0] * v[0] + v[1] * v[1]) + (v[2] * v[2] + v[3] * v[3])) * (1.f / 64.f);
            STG(u32x2, F.ws, WS_ACT + (row * DM + 384 + 64 * hk + 4 * dg) * 2) = pack4(v * rsqrtf(ms + 1e-6f) * sg); }
    }
}


typedef unsigned v4u __attribute__((ext_vector_type(4)));
#define XB_TMO      128
#define XB_XCNT(j)  (256  + 64 * (j))
#define XB_XSUB(j)  (1280 + 64 * (j))
#define XB_XGEN(j)  (2304 + 64 * (j))
#define XB_TOP      3328
#define XB_TOPGEN   3392
#define XCD_BAR_WORDS 3456
#define XB_SPIN_CAP (1u << 18)

__device__ __forceinline__ unsigned xb_ld(unsigned* p)              { return __hip_atomic_load(p, __ATOMIC_RELAXED, __HIP_MEMORY_SCOPE_AGENT); }
__device__ __forceinline__ unsigned xb_add(unsigned* p, unsigned v) { return __hip_atomic_fetch_add(p, v, __ATOMIC_RELAXED, __HIP_MEMORY_SCOPE_AGENT); }
__device__ __forceinline__ unsigned xb_xcc_id() { return (unsigned)__builtin_amdgcn_s_getreg((3 << 11) | 20) & 0xFu; }
#define XB_SPIN(cond, bar) do { unsigned _sp = 0; while (cond) { __builtin_amdgcn_s_sleep(1); \
    if ((++_sp & 255u) == 0u) { if (xb_ld(&(bar)[XB_TMO])) break; if (_sp > XB_SPIN_CAP) { atomicAdd(&(bar)[XB_TMO], 1u); break; } } } } while (0)

struct XcdBarrier {
    unsigned* bar; unsigned x;
    volatile LAS unsigned* st;
};

__device__ __forceinline__ XcdBarrier xcd_barrier_post(unsigned* bar, volatile LAS unsigned* st) {
    XcdBarrier b; b.bar = bar; b.x = xb_xcc_id(); b.st = st;
    if (threadIdx.x == 0) (void)xb_add(&bar[XB_XCNT(b.x)], 1u);
    return b;
}
__device__ __forceinline__ void xcd_barrier_complete(unsigned* bar, unsigned x, unsigned& nloc, unsigned& nx) {
    const unsigned G = gridDim.x * gridDim.y * gridDim.z;
    unsigned sum, cnt, mine, sp = 0u;
    for (;;) {
        sum = 0u; cnt = 0u; mine = 0u;
#pragma unroll
        for (unsigned j = 0; j < 16; ++j) { const unsigned c = xb_ld(&bar[XB_XCNT(j)]); sum += c; cnt += (c > 0u) ? 1u : 0u; mine = (j == x) ? c : mine; }
        if (sum == G) break;
        __builtin_amdgcn_s_sleep(1);
        if ((++sp & 255u) == 0u) { if (xb_ld(&bar[XB_TMO])) break; if (sp > XB_SPIN_CAP) { atomicAdd(&bar[XB_TMO], 1u); break; } }
    }
    nloc = mine > 0u ? mine : 1u; nx = cnt > 0u ? cnt : 1u;
}

__device__ __forceinline__ void xcd_barrier(const XcdBarrier& b) {
    asm volatile("s_waitcnt vmcnt(0)" ::: "memory");
    __syncthreads();
    if (threadIdx.x == 0) {
        unsigned* bar = b.bar;
        __builtin_amdgcn_s_waitcnt(0);
        unsigned nloc = b.st[0], nx = b.st[1];
        if (nloc == 0u) { xcd_barrier_complete(bar, b.x, nloc, nx); b.st[0] = nloc; b.st[1] = nx; }
        const unsigned old = xb_add(&bar[XB_XSUB(b.x)], 1u);
        const unsigned gen = old / nloc;
        if (old + 1u == (gen + 1u) * nloc) {
            __builtin_amdgcn_fence(__ATOMIC_RELEASE, "agent");
            asm volatile("s_waitcnt vmcnt(0)" ::: "memory");
            const unsigned og = xb_add(&bar[XB_TOP], 1u);
            const unsigned tg = og / nx;
            if (og + 1u == (tg + 1u) * nx) xb_add(&bar[XB_TOPGEN], 1u);
            else XB_SPIN(xb_ld(&bar[XB_TOPGEN]) == tg, bar);
            __builtin_amdgcn_fence(__ATOMIC_ACQUIRE, "agent");
            xb_add(&bar[XB_XGEN(b.x)], 1u);
            asm volatile("s_waitcnt vmcnt(0)" ::: "memory");
        } else {
            XB_SPIN(xb_ld(&bar[XB_XGEN(b.x)]) == gen, bar);
            __builtin_amdgcn_fence(__ATOMIC_ACQUIRE, "agent");
            asm volatile("s_waitcnt vmcnt(0)" ::: "memory");
        }
    }
    __syncthreads();
}

#ifndef DIS
#define DIS 0
#endif
#ifndef OUT_NI2
#define OUT_NI2 0
#endif
#ifndef GEMM_MF
#define GEMM_MF 7
#endif
#ifndef REP_PHASE
#define REP_PHASE -1
#define REP_COUNT 1
#endif
constexpr int NEXTRA = (REP_PHASE >= 0 && REP_PHASE < 9) ? REP_COUNT - 1 : 0, NPL = 9 + NEXTRA, NPRE = (REP_PHASE == 100) ? REP_COUNT : 1, NFWD = (REP_PHASE == 200) ? REP_COUNT : 1, NPHASE_RUN = NPRE + 1 + NPL * DEPTH * NFWD;
__global__ void __launch_bounds__(512, 2) mega(Args a) {
    extern __shared__ __attribute__((aligned(16))) unsigned char lds[];
    Frame F; F.crep = 0;
    F.lds = (LAS unsigned char*)lds;
    volatile LAS unsigned* bst = (volatile LAS unsigned*)(F.lds + LDS_BYTES - 64);
    if (threadIdx.x < 2) bst[threadIdx.x] = 0u;
    __syncthreads();
    const XcdBarrier xbar = xcd_barrier_post((unsigned*)((GAS unsigned char*)a.ws + WS_CTL) + 4096, bst);
    const int wave_id = __builtin_amdgcn_readfirstlane((int)threadIdx.x >> 6);
    for (int ph = a.ph_lo; ph < a.ph_hi; ++ph) {
        { const unsigned char* kp = (const unsigned char*)__builtin_amdgcn_kernarg_segment_ptr(); asm volatile("" : "+s"(kp));
          const Args* ap = (const Args*)kp; F.in = ap->in; F.out = gptr(ap->out); F.ws = gptr(ap->ws); }
        { unsigned ones = ~0u; asm volatile("" : "+s"(ones)); int ln = (int)__builtin_amdgcn_mbcnt_hi(ones, __builtin_amdgcn_mbcnt_lo(ones, 0u)); int wv = wave_id, bid = (int)blockIdx.x, gg = (int)gridDim.x; asm volatile("" : "+s"(wv), "+s"(bid), "+s"(gg));
          F.lane = ln; F.wave = wv; F.bid = bid; F.G = gg; F.ngw = gg * 8; F.tid = wv * 64 + ln; F.gw = bid * 8 + wv; }
        if (ph < NPRE) { if (!(DIS & 1)) phase_prologue(F); }
        else if (ph == NPHASE_RUN - 1) { if (!(DIS & 2)) phase_final_norm(F); }
        else {
            const int fwd_ = (ph - NPRE) / (NPL * DEPTH); F.crep = fwd_; const int l = ((ph - NPRE) / NPL) % DEPTH, sidx = (ph - NPRE) % NPL, rep = (REP_PHASE == 200) ? 0 : (REP_PHASE >= 0 && REP_PHASE < 9 && sidx > REP_PHASE && sidx <= REP_PHASE + NEXTRA) ? sidx - REP_PHASE : 0, s = (REP_PHASE >= 0 && REP_PHASE < 9 && sidx > REP_PHASE) ? (sidx <= REP_PHASE + NEXTRA ? REP_PHASE : sidx - NEXTRA) : sidx;
            if (s == 0) { convert_weights(F, l); phase_norm(F, l, 0); }
            else if (s == 1) {
                pg8::Gemm g{WSP(bf16_t, WS_ACT), WSP(bf16_t, WS_WIN + 0u * WSET_STRIDE), M, NIN, 1024}; pg8::StaticOrder S; S.init(M, NIN, F.G, F.bid, (GEMM_MF & 1) ? 192 : 256);
                EpiWin E{F.ws, F.out, l, F.lds + pg8::STAGE_BYTES, REP_PART == 9 && rep > 0};
                if (!(DIS & 16)) pg8::gemm_phase<EpiWin, pg8::StaticOrder, false, true, (GEMM_MF & 1) ? 3 : 4>(F.lds, g, S, E, F.tid);
                if (false) { const int wv_ = (F.bid - 64) * 8 + F.wave; convert_item_any(F, l + 1, wv_); if (wv_ < CV_TOTAL - 1536) convert_item_any(F, l + 1, 1536 + wv_); }
            }
            else if (s == 2) { for (int cid = F.bid; cid < NCHUNK; cid += F.G) rwkv_chunk_block(F, l, cid); }
            else if (s == 3) { if (!(DIS & 64)) phase_mixer(F, l, rep); }
            else if (s == 4) { if (rep == 0 || REP_PART != 6) { if (OUT_NI2 && F.gw + F.ngw < 192 * 12 && F.gw + 2 * F.ngw >= 192 * 12) rwkv_out_items<2>(F, l, F.gw, F.ngw); else for (int it = F.gw; it < 192 * 12; it += F.ngw) rwkv_out_items<1>(F, l, it, 0); } if (rep == 0 || REP_PART != 7) phase_finalize(F, l, rep); }
            else if (s == 5 || s == 8) {
                const bool second = s == 8;
                pg8::Gemm g{second ? WSP(bf16_t, WS_U) : WSP(bf16_t, WS_ACT), second ? WSP(bf16_t, WS_W2 + 0u * WSET_STRIDE) : WSP(bf16_t, WS_WOUT + 0u * WSET_STRIDE), M, 1024, second ? FF : 1024};
                pg8::StaticOrder S; S.init(M, 1024, F.G, F.bid, (GEMM_MF & 2) ? 192 : 256);
                const bool first = (l == 0 && !second);
                EpiRes E{INP(0), INP(1) - (size_t)MC * DM, F.ws, WSP(float, WS_MOD) + (size_t)l * 3 * 6144 + (second ? 5120 : 2048), first, rep ? WS_BO : WS_XB, REP_PART == 9 && rep > 0};
                if (M / ((GEMM_MF & 2) ? 192 : 256) * 4 <= F.G) { EpiResD ED; static_cast<EpiRes&>(ED) = E; pg8::gemm_phase<EpiResD, pg8::StaticOrder, false, true, (GEMM_MF & 2) ? 3 : 4>(F.lds, g, S, ED, F.tid); }
                else pg8::gemm_phase<EpiRes, pg8::StaticOrder, false, true, (GEMM_MF & 2) ? 3 : 4>(F.lds, g, S, E, F.tid);
            }
            else if (s == 6) { if (!(DIS & 8)) phase_norm(F, l, 1); }
            else {
                pg8::Gemm g{WSP(bf16_t, WS_ACT), WSP(bf16_t, WS_W13 + 0u * WSET_STRIDE), M, NFF2, 1024}; pg8::StaticOrder S; S.init(M, NFF2, F.G, F.bid, (GEMM_MF & 4) ? 192 : 256);
                EpiSwi E{WSP(bf16_t, WS_U), REP_PART == 9 && rep > 0};
                if (!(DIS & 512)) pg8::gemm_phase<EpiSwi, pg8::StaticOrder, true, true, (GEMM_MF & 4) ? 3 : 4>(F.lds, g, S, E, F.tid);
            }
        }
        if (ph + 1 < a.ph_hi) { if (ph == a.ph_lo) { __threadfence(); cg::this_grid().sync(); } else xcd_barrier(xbar); }
    }
}

extern "C" void kernel_launch(void* const* d_in, const int* in_sizes, int n_in, void* d_out, int out_size, void* d_ws, size_t ws_size, hipStream_t stream) {
    static int grid = 0;
    if (grid == 0) {
        int dev = 0, cus = 0, per_cu = 0;
        if (n_in != 34 || ws_size < WS_END) { fprintf(stderr, "kernel_launch: unexpected n_in %d / ws_size %zu (need %zu)\n", n_in, ws_size, (size_t)WS_END); grid = -1; return; }
        if (hipGetDevice(&dev) != hipSuccess || hipDeviceGetAttribute(&cus, hipDeviceAttributeMultiprocessorCount, dev) != hipSuccess) { grid = -1; return; }
        if (hipFuncSetAttribute((const void*)mega, hipFuncAttributeMaxDynamicSharedMemorySize, LDS_BYTES) != hipSuccess) { fprintf(stderr, "kernel_launch: hipFuncSetAttribute failed\n"); grid = -1; return; }
        if (hipOccupancyMaxActiveBlocksPerMultiprocessor(&per_cu, (const void*)mega, 512, LDS_BYTES) != hipSuccess || per_cu < 1) { fprintf(stderr, "kernel_launch: occupancy query says %d\n", per_cu); per_cu = 1; }
        (void)hipGetLastError();
        grid = cus * 1;
        if (grid > cus * per_cu) grid = cus * per_cu;
    }
    if (grid < 0) return;
    (void)hipMemsetAsync((char*)d_ws + WS_CTL, 0, CTL_BYTES, stream);
    Args a{};
    for (int i = 0; i < 34; ++i) a.in[i] = (const float*)d_in[i];
    a.out = (float*)d_out; a.ws = (unsigned char*)d_ws;
#if MK_ONE_LAUNCH
    a.ph_lo = 0; a.ph_hi = NPHASE_RUN;
    void* args[] = {&a};
    hipError_t e = hipLaunchCooperativeKernel((const void*)mega, dim3(grid), dim3(512), args, LDS_BYTES, stream);
    if (e != hipSuccess) fprintf(stderr, "kernel_launch: cooperative launch failed: %s (grid %d)\n", hipGetErrorString(e), grid);
#else
    for (int ph = 0; ph < NPHASE_RUN; ++ph) { a.ph_lo = ph; a.ph_hi = ph + 1; hipLaunchKernelGGL(mega, dim3(grid), dim3(512), LDS_BYTES, stream, a); }
#endif
}
```

```cpp
#include <hip/hip_runtime.h>
#include <hip/hip_cooperative_groups.h>
#include <cstdio>
#include <cstdint>
namespace cg = cooperative_groups;

#ifndef MK_ONE_LAUNCH
#define MK_ONE_LAUNCH 1
#endif

#undef MK_ONE_LAUNCH
#define MK_ONE_LAUNCH 1
#define REP_PHASE -1
#define REP_COUNT 1
#define REP_PART 0
#define RA_REP 0
#define ATT_PROBE 0
namespace pg8 {
#define PG8_LAS __attribute__((address_space(3)))
typedef unsigned short bf16_t;
typedef short bf16x8 __attribute__((ext_vector_type(8)));
typedef float f32x4 __attribute__((ext_vector_type(4)));
typedef unsigned u32x4 __attribute__((ext_vector_type(4)));
constexpr int BM = 256, BK = 64, HALF = 128, HTB = HALF * BK * 2  , STAGE_BYTES = 8 * HTB, NXCD = 8, WGM = 8;

__host__ __device__ __forceinline__ int lds_byte(int r, int c) { const int st = (r >> 4) * 2 + (c >> 5), rr = r & 15, cc = c & 31, ob = rr * 64 + cc * 2; return st * 1024 + (ob ^ (((ob >> 9) & 1) << 5)); }
__host__ __device__ __forceinline__ void stage_rc(int b, int& R, int& C) { const int st = b / 1024, sb = b % 1024, swz = sb ^ (((sb >> 9) & 1) << 5); R = (st >> 1) * 16 + swz / 64; C = (st & 1) * 32 + (swz % 64) / 2; }
__host__ __device__ __forceinline__ int perm32(int rho) { const int n = rho >> 4, i = rho & 15; return 8 * (i >> 2) + 4 * n + (i & 3); }

struct Unit { int pm, pn; };
struct Gemm { const bf16_t* A; const bf16_t* Bt; int M, N, K; };

struct StaticOrder {
    int nM, nN, nwg, G, c;
    __host__ __device__ void init(int M, int N, int G_, int c_, int bm = BM) { nM = M / bm; nN = N / BM; nwg = nM * nN; G = G_; c = c_; }
    __host__ __device__ bool next(int i, Unit& u) const {
        const long L = (long)i * G + c; if (L >= nwg) return false;
        int wgid = (int)L; { const int q = nwg / NXCD, r = nwg % NXCD, xcd = wgid % NXCD, off = wgid / NXCD; wgid = (xcd < r ? xcd * (q + 1) : r * (q + 1) + (xcd - r) * q) + off; }
        const int nig = WGM * nN, gid = wgid / nig, fm = gid * WGM, gsz = (nM - fm) < WGM ? (nM - fm) : WGM;
        u.pm = fm + ((wgid % nig) % gsz); u.pn = (wgid % nig) / gsz; return true;
    }
    __device__ __forceinline__ void a_ready(const Unit&) const {}
    __device__ __forceinline__ void done(const Unit&) const {}
};

template <class Epi, class Sched, bool ALIGN_EPI = false, bool SP2 = false, int MF = 4>
__device__ __forceinline__ void gemm_phase(PG8_LAS unsigned char* lds, const Gemm g, const Sched& S, const Epi& E, const int tid_in) {
    const int tid = tid_in, wid = __builtin_amdgcn_readfirstlane(tid >> 6), lane = tid & 63, wr = wid >> 2, wc = wid & 3, fr = lane & 15, fq = lane >> 4;
    static_assert(MF == 4 || (MF == 3 && SP2), "192-row tiles: SP2 schedule only");
    const int K = g.K, nt = K / BK;
    unsigned voffA[2], voffB[2];
#pragma unroll
    for (int i = 0; i < 2; ++i) { int R, C; stage_rc(tid * 16 + i * 8192, R, C); const int Rb = Epi::PERM ? ((R & ~31) + perm32(R & 31)) : R;
        voffA[i] = (unsigned)(R * K + C) * 2u; voffB[i] = (unsigned)(Rb * K + C) * 2u; }
    const size_t kstep = (size_t)(BK * 2);
    const size_t hstep = (size_t)HALF * K * 2;
    const size_t tstep = 2 * hstep;
    const size_t hstepA = (size_t)(MF * 32) * K * 2, tstepA = 2 * hstepA;
    const unsigned ldsw = (unsigned)wid * 1024u;
    const int aoff = lds_byte(wr * (MF * 16) + fr, fq * 8), boff = lds_byte(wc * 32 + fr, fq * 8);
#define PG8_SA(b, h) (((b) * 2 + (h)) * HTB)
#define PG8_SB(b, h) ((4 + (b) * 2 + (h)) * HTB)
#define PG8_STAGE(bufoff, gbase, voff) do { _Pragma("unroll") for (int _i = 0; _i < 2; ++_i) \
        __builtin_amdgcn_global_load_lds((const unsigned*)((const char*)(gbase) + (voff)[_i]), (PG8_LAS unsigned*)(lds + (bufoff) + ldsw + _i * 8192), 16, 0, 0); } while (0)
#define PG8_STAGEA(bufoff, gbase, voff) do { __builtin_amdgcn_global_load_lds((const unsigned*)((const char*)(gbase) + (voff)[0]), (PG8_LAS unsigned*)(lds + (bufoff) + ldsw), 16, 0, 0); \
        if (MF == 4 || wr == 0) __builtin_amdgcn_global_load_lds((const unsigned*)((const char*)(gbase) + (voff)[1]), (PG8_LAS unsigned*)(lds + (bufoff) + ldsw + 8192), 16, 0, 0); } while (0)
#define PG8_LDA(dst, b, h) do { _Pragma("unroll") for (int m = 0; m < MF; ++m) _Pragma("unroll") for (int k = 0; k < 2; ++k) dst[m][k] = *(const PG8_LAS bf16x8*)(lds + PG8_SA(b, h) + aoff + m * 2048 + k * 1024); } while (0)
#define PG8_LDB(dst, b, h) do { _Pragma("unroll") for (int n = 0; n < 2; ++n) _Pragma("unroll") for (int k = 0; k < 2; ++k) dst[n][k] = *(const PG8_LAS bf16x8*)(lds + PG8_SB(b, h) + boff + n * 2048 + k * 1024); } while (0)
#define PG8_MMA(ai, bj, At, Bt) do { __builtin_amdgcn_s_setprio(1); _Pragma("unroll") for (int m = 0; m < MF; ++m) _Pragma("unroll") for (int n = 0; n < 2; ++n) _Pragma("unroll") for (int k = 0; k < 2; ++k) \
        acc[ai][bj][m][n] = __builtin_amdgcn_mfma_f32_16x16x32_bf16(Bt[n][k], At[m][k], acc[ai][bj][m][n], 0, 0, 0); __builtin_amdgcn_s_setprio(0); } while (0)
#define PG8_WAIT_V(n) asm volatile("s_waitcnt vmcnt(" #n ")" ::: "memory")
#define PG8_WAIT_V2(a, b) do { if (MF == 4 || wr == 0) asm volatile("s_waitcnt vmcnt(" #a ")" ::: "memory"); else asm volatile("s_waitcnt vmcnt(" #b ")" ::: "memory"); } while (0)
#define PG8_WAIT_L(n) asm volatile("s_waitcnt lgkmcnt(" #n ")" ::: "memory")
#define PG8_BAR __builtin_amdgcn_s_barrier()
#define PG8_SCHED __builtin_amdgcn_sched_barrier(0)
    Unit cur, nxt; int ui = 0;
    if (!S.next(0, cur)) return;
    f32x4 acc[2][2][MF][2];
#pragma unroll
    for (int a = 0; a < 2; ++a)
#pragma unroll
        for (int b = 0; b < 2; ++b)
#pragma unroll
            for (int m = 0; m < MF; ++m)
#pragma unroll
                for (int n = 0; n < 2; ++n) acc[a][b][m][n] = (f32x4){0.f, 0.f, 0.f, 0.f};
    bf16x8 At[MF][2], B0[2][2], B1[2][2];
#define PG8_SGPR64(p) ((const char*)(((unsigned long long)(unsigned)__builtin_amdgcn_readfirstlane((int)((unsigned long long)(p) >> 32)) << 32) | (unsigned)__builtin_amdgcn_readfirstlane((int)(unsigned long long)(p))))
    const char* cA = PG8_SGPR64((const char*)g.A + (size_t)cur.pm * tstepA); const char* cB = PG8_SGPR64((const char*)g.Bt + (size_t)cur.pn * tstep);
    S.a_ready(cur);
    if constexpr (SP2) {
        PG8_STAGE(PG8_SB(0, 0), cB, voffB); PG8_STAGE(PG8_SB(0, 1), cB + hstep, voffB); PG8_STAGEA(PG8_SA(0, 0), cA, voffA); PG8_STAGEA(PG8_SA(0, 1), cA + hstepA, voffA);
        if (wr == 1) PG8_BAR;
        PG8_WAIT_V2(2, 1); PG8_BAR;
        PG8_STAGE(PG8_SB(1, 0), cB + kstep, voffB); PG8_STAGEA(PG8_SA(1, 0), cA + kstep, voffA); PG8_STAGE(PG8_SB(1, 1), cB + hstep + kstep, voffB);
        PG8_WAIT_V2(6, 5); PG8_BAR;
    } else {
        PG8_STAGE(PG8_SB(0, 0), cB, voffB); PG8_STAGEA(PG8_SA(0, 0), cA, voffA); PG8_STAGE(PG8_SB(0, 1), cB + hstep, voffB); PG8_STAGEA(PG8_SA(0, 1), cA + hstepA, voffA);
        if (wr == 1) PG8_BAR;
        PG8_WAIT_V(4); PG8_BAR;
        PG8_STAGE(PG8_SB(1, 0), cB + kstep, voffB); PG8_STAGEA(PG8_SA(1, 0), cA + kstep, voffA); PG8_STAGE(PG8_SB(1, 1), cB + hstep + kstep, voffB);
        PG8_WAIT_V(6); PG8_BAR;
    }
    for (;;) {
        const bool has_next = S.next(ui + 1, nxt);
        const char* nA = PG8_SGPR64(has_next ? (const char*)g.A + (size_t)nxt.pm * tstepA : cA); const char* nB = PG8_SGPR64(has_next ? (const char*)g.Bt + (size_t)nxt.pn * tstep : cB);
        for (int t = 0; t < nt; t += 2) {
            const bool last = (t == nt - 2);
            const char* a1 = cA + (size_t)(t + 1) * kstep;
            const char* a2 = last ? nA : cA + (size_t)(t + 2) * kstep; const char* b2 = last ? nB : cB + (size_t)(t + 2) * kstep;
            const char* a3 = a2 + kstep; const char* b3 = b2 + kstep;
            if (last && has_next) S.a_ready(nxt);
            if constexpr (SP2) {
            PG8_LDB(B0, 0, 0); PG8_LDB(B1, 0, 1); PG8_SCHED; PG8_LDA(At, 0, 0); PG8_STAGEA(PG8_SA(1, 1), a1 + hstepA, voffA);
            PG8_WAIT_V2(8, 6); PG8_WAIT_L(0); PG8_BAR; PG8_MMA(0, 0, At, B0); PG8_MMA(0, 1, At, B1); PG8_BAR; PG8_SCHED;
            PG8_LDA(At, 0, 1); PG8_STAGE(PG8_SB(0, 0), b2, voffB); PG8_STAGE(PG8_SB(0, 1), b2 + hstep, voffB); PG8_STAGEA(PG8_SA(0, 0), a2, voffA);
            PG8_WAIT_V2(8, 6); PG8_WAIT_L(0); PG8_BAR; PG8_MMA(1, 0, At, B0); PG8_MMA(1, 1, At, B1); PG8_BAR; PG8_SCHED;
            PG8_LDB(B0, 1, 0); PG8_LDB(B1, 1, 1); PG8_SCHED; PG8_LDA(At, 1, 0); PG8_STAGEA(PG8_SA(0, 1), a2 + hstepA, voffA);
            PG8_WAIT_V2(8, 6); PG8_WAIT_L(0); PG8_BAR; PG8_MMA(0, 0, At, B0); PG8_MMA(0, 1, At, B1); PG8_BAR; PG8_SCHED;
            PG8_LDA(At, 1, 1); PG8_STAGE(PG8_SB(1, 0), b3, voffB); PG8_STAGE(PG8_SB(1, 1), b3 + hstep, voffB); PG8_STAGEA(PG8_SA(1, 0), a3, voffA);
            PG8_WAIT_V2(8, 6); PG8_WAIT_L(0); PG8_BAR; PG8_MMA(1, 0, At, B0); PG8_MMA(1, 1, At, B1); PG8_BAR; PG8_SCHED;
            } else {
            PG8_LDB(B0, 0, 0); PG8_SCHED; PG8_LDA(At, 0, 0); PG8_STAGEA(PG8_SA(1, 1), a1 + hstepA, voffA);
            PG8_WAIT_L(8); PG8_BAR; PG8_WAIT_L(0); PG8_MMA(0, 0, At, B0); PG8_BAR; PG8_SCHED;
            PG8_LDB(B1, 0, 1); PG8_STAGE(PG8_SB(0, 0), b2, voffB);
            PG8_BAR; PG8_WAIT_L(0); PG8_MMA(0, 1, At, B1); PG8_BAR;
            PG8_LDA(At, 0, 1); PG8_STAGEA(PG8_SA(0, 0), a2, voffA);
            PG8_BAR; PG8_WAIT_L(0); PG8_MMA(1, 0, At, B0); PG8_BAR; PG8_SCHED;
            PG8_STAGE(PG8_SB(0, 1), b2 + hstep, voffB);
            PG8_WAIT_V(6); PG8_BAR; PG8_MMA(1, 1, At, B1); PG8_BAR;
            PG8_LDB(B0, 1, 0); PG8_SCHED; PG8_LDA(At, 1, 0); PG8_STAGEA(PG8_SA(0, 1), a2 + hstepA, voffA);
            PG8_WAIT_L(8); PG8_BAR; PG8_WAIT_L(0); PG8_MMA(0, 0, At, B0); PG8_BAR; PG8_SCHED;
            PG8_LDB(B1, 1, 1); PG8_STAGE(PG8_SB(1, 0), b3, voffB);
            PG8_BAR; PG8_WAIT_L(0); PG8_MMA(0, 1, At, B1); PG8_BAR;
            PG8_LDA(At, 1, 1); PG8_STAGEA(PG8_SA(1, 0), a3, voffA);
            PG8_BAR; PG8_WAIT_L(0); PG8_MMA(1, 0, At, B0); PG8_BAR; PG8_SCHED;
            PG8_STAGE(PG8_SB(1, 1), b3 + hstep, voffB);
            PG8_WAIT_V(6); PG8_BAR; PG8_MMA(1, 1, At, B1); PG8_BAR;
            }
        }
        if constexpr (ALIGN_EPI) { if (wr == 0) PG8_BAR; }
        if constexpr (!Epi::AFTER_DRAIN) { E.template operator()<MF>(acc, cur, wr, wc, fr, fq); S.done(cur); }
        if (!has_next) break;
#pragma unroll
        for (int a = 0; a < 2; ++a)
#pragma unroll
            for (int b = 0; b < 2; ++b)
#pragma unroll
                for (int m = 0; m < MF; ++m)
#pragma unroll
                    for (int n = 0; n < 2; ++n) acc[a][b][m][n] = (f32x4){0.f, 0.f, 0.f, 0.f};
        cur = nxt; cA = nA; cB = nB; ++ui;
        if constexpr (ALIGN_EPI) { if (wr == 1) PG8_BAR; }
    }
    PG8_WAIT_V(0);
    if constexpr (!ALIGN_EPI) { if (wr == 0) PG8_BAR; }
    PG8_BAR;
    if constexpr (Epi::AFTER_DRAIN) { E.fused(acc, cur, wr, wc, fr, fq, lds, wid, lane); S.done(cur); }
#undef PG8_SA
#undef PG8_SB
#undef PG8_STAGE
#undef PG8_STAGEA
#undef PG8_WAIT_V2
#undef PG8_LDA
#undef PG8_LDB
#undef PG8_MMA
#undef PG8_WAIT_V
#undef PG8_WAIT_L
#undef PG8_BAR
#undef PG8_SCHED
}
}

using pg8::bf16_t; using pg8::bf16x8; using pg8::f32x4; using pg8::u32x4;
typedef float f32x16 __attribute__((ext_vector_type(16)));
typedef float f32x2 __attribute__((ext_vector_type(2)));
typedef short s16x4 __attribute__((ext_vector_type(4)));
typedef unsigned u32x2 __attribute__((ext_vector_type(2)));
typedef __bf16 bf16x2_t __attribute__((ext_vector_type(2)));
#define LAS __attribute__((address_space(3)))
#define LDG(T, base, boff) (*(const __attribute__((address_space(1))) T*)((const __attribute__((address_space(1))) unsigned char*)(base) + (unsigned)(boff)))
#define STG(T, base, boff) (*(__attribute__((address_space(1))) T*)((__attribute__((address_space(1))) unsigned char*)(base) + (unsigned)(boff)))

__device__ __forceinline__ unsigned pk2(float lo, float hi) { f32x2 v = {lo, hi}; bf16x2_t b = __builtin_convertvector(v, bf16x2_t); return __builtin_bit_cast(unsigned, b); }
__device__ __forceinline__ float bf_lo(unsigned u) { return __uint_as_float(u << 16); }
__device__ __forceinline__ float bf_hi(unsigned u) { return __uint_as_float(u & 0xffff0000u); }
__device__ __forceinline__ f32x4 unpack4(u32x2 v) { return (f32x4){bf_lo(v.x), bf_hi(v.x), bf_lo(v.y), bf_hi(v.y)}; }
__device__ __forceinline__ u32x2 pack4(f32x4 v) { u32x2 r; r.x = pk2(v[0], v[1]); r.y = pk2(v[2], v[3]); return r; }
__device__ __forceinline__ float sigmf(float x) { return __builtin_amdgcn_rcpf(1.f + __expf(-x)); }
template <int CTRL> __device__ __forceinline__ float dpp_f(float x) { return __builtin_bit_cast(float, __builtin_amdgcn_update_dpp(0, __builtin_bit_cast(int, x), CTRL, 0xF, 0xF, true)); }
__device__ __forceinline__ float allreduce16(float x) { x += dpp_f<0xB1>(x); x += dpp_f<0x4E>(x); x += dpp_f<0x141>(x); x += dpp_f<0x140>(x); return x; }
__device__ __forceinline__ float rdlane(float x, int l) { return __builtin_bit_cast(float, __builtin_amdgcn_readlane(__builtin_bit_cast(int, x), l)); }
__device__ __forceinline__ float wave_sum(float v) {
    v = allreduce16(v);
    return (rdlane(v, 0) + rdlane(v, 16)) + (rdlane(v, 32) + rdlane(v, 48));
}
__device__ __forceinline__ float swap32_sum(float x) { auto rr = __builtin_amdgcn_permlane32_swap(__float_as_uint(x), __float_as_uint(x), false, false); return __uint_as_float(rr[0]) + __uint_as_float(rr[1]); }
__device__ __forceinline__ float swap32_max(float x) { auto rr = __builtin_amdgcn_permlane32_swap(__float_as_uint(x), __float_as_uint(x), false, false); return fmaxf(__uint_as_float(rr[0]), __uint_as_float(rr[1])); }

constexpr int M = 12288, MC = 4096, DM = 1024, NIN = 3072, FF = 2816, NFF2 = 5632, DEPTH = 4;
constexpr float LOG2E = 1.4426950408889634f;
constexpr float QSCALE_A = 0.125f * LOG2E;
constexpr float QSCALE_B = 0.17677669529663687f * LOG2E;
constexpr unsigned OFF_AK = 12582912, OFF_AV = 14680064, OFF_BK = 16777216, OFF_BV = 20971520, OFF_CF = 25165824, OFF_CB = 26738688;
constexpr unsigned MiB = 1u << 20;
constexpr unsigned WS_CTL = 0, CTL_BYTES = 1 * MiB;
constexpr unsigned WS_MOD = 1 * MiB;
constexpr unsigned WS_TAB = 1 * MiB + 512 * 1024;
constexpr unsigned WS_SMALLW = 2 * MiB;
constexpr unsigned WS_CACHE = 4 * MiB;
constexpr unsigned WS_WIN = 10 * MiB, WS_WOUT = 16 * MiB, WS_W13 = 18 * MiB, WS_W2 = 29 * MiB;
constexpr unsigned WSET_STRIDE = 184 * MiB;
constexpr unsigned WS_ACT = 35 * MiB;
constexpr unsigned WS_QA = 59 * MiB, WS_KA = 68 * MiB, WS_VTA = 71 * MiB, WS_QB = 74 * MiB, WS_KB = 80 * MiB, WS_VTB = 86 * MiB;
constexpr unsigned WS_RKV = 92 * MiB, WS_CW = 119 * MiB, WS_CA = 122 * MiB, WS_CG = 125 * MiB;
constexpr unsigned WS_YF = 128 * MiB, WS_YB = 146 * MiB;
constexpr unsigned WS_SV = 164 * MiB;
constexpr unsigned WS_BO2 = 182 * MiB, WS_ML = 230 * MiB;
constexpr unsigned WS_XB = 206 * MiB;
constexpr unsigned WS_WSET1 = 194 * MiB;
constexpr unsigned WS_RM = 236 * MiB, WS_RN = 254 * MiB, WS_RP = 324 * MiB, WS_RH = 342 * MiB;
constexpr int NCHUNK = 2304;
constexpr unsigned WS_U = 128 * MiB;
constexpr unsigned WS_G = 290 * MiB, WS_SB = 299 * MiB, WS_BO = 300 * MiB, WS_END = 360 * MiB;
constexpr int SMALLW_L = 147456;
constexpr int TAB_COSA = 0, TAB_SINA = 1024, TAB_COSB = 2048, TAB_SINB = 2560, TAB_LAM = 3072;
constexpr int LDS_BYTES = 148480;
constexpr int NPHASE = 2 + 9 * DEPTH;

struct Args {
    const float* in[34];
    float* out; unsigned char* ws;
    int ph_lo, ph_hi;
};

struct EpiRes {
    static constexpr bool PERM = true, AFTER_DRAIN = false;
    const float* baseC; const float* baseL; unsigned char* ws; const float* gate; bool first; unsigned xo; bool skip = false;
    template <int MF>
    __device__ __forceinline__ void operator()(const f32x4 (&acc)[2][2][MF][2], const pg8::Unit& u, int wr, int wc, int fr_, int fq_) const {
        if (skip) return;
        int fr = fr_, fq = fq_; asm volatile("" : "+v"(fr), "+v"(fq));
        const unsigned col0 = u.pn * 256 + wc * 32 + 8 * fq, rowb = u.pm * (MF * 64) + wr * (MF * 16);
        f32x4 g4[2][2]; int vcur = -1;
#pragma unroll
        for (int ai = 0; ai < 2; ++ai)
#pragma unroll
            for (int m = 0; m < MF; ++m) { const unsigned rf = rowb + ai * (MF * 32) + m * 16, off = (rf + fr) * DM + col0;
                const int v = rf < MC ? 0 : (rf < MC + 4096 ? 1 : 2);
                if (v != vcur) { vcur = v;
#pragma unroll
                    for (int bj = 0; bj < 2; ++bj)
#pragma unroll
                        for (int n = 0; n < 2; ++n) g4[bj][n] = LDG(f32x4, gate, (v * 6144 + col0 + bj * 128 + n * 4) * 4); }
#pragma unroll
                for (int bj = 0; bj < 2; ++bj) { f32x4 b0, b1;
                    if (first) { const float* base = rf < MC ? baseC : baseL; b0 = LDG(f32x4, base, (off + bj * 128) * 4); b1 = LDG(f32x4, base, (off + bj * 128 + 4) * 4); }
                    else { const u32x4 xb = LDG(u32x4, ws, WS_XB + (off + bj * 128) * 2); b0 = (f32x4){bf_lo(xb.x), bf_hi(xb.x), bf_lo(xb.y), bf_hi(xb.y)}; b1 = (f32x4){bf_lo(xb.z), bf_hi(xb.z), bf_lo(xb.w), bf_hi(xb.w)}; }
                    b0 = b0 + g4[bj][0] * acc[ai][bj][m][0]; b1 = b1 + g4[bj][1] * acc[ai][bj][m][1];
                    u32x4 w; w.x = pk2(b0[0], b0[1]); w.y = pk2(b0[2], b0[3]); w.z = pk2(b1[0], b1[1]); w.w = pk2(b1[2], b1[3]);
                    STG(u32x4, ws, xo + (off + bj * 128) * 2) = w; } }
    }
};
struct EpiResD : EpiRes {
    static constexpr bool AFTER_DRAIN = true;
    template <int MF>
    __device__ __forceinline__ void fused(const f32x4 (&acc)[2][2][MF][2], const pg8::Unit& u, int wr, int wc, int fr_, int fq_, LAS unsigned char* lds, int wid, int lane_) const {
        if (skip) return;
        int fr = fr_, fq = fq_, lane = lane_; asm volatile("" : "+v"(fr), "+v"(fq), "+v"(lane));
        constexpr int HR = MF * 32, PITCH = 1040;
        const unsigned c8 = (lane & 31) * 8, colg = u.pn * 256 + c8;
#pragma unroll
        for (int ai = 0; ai < 2; ++ai) {
            if (ai) asm volatile("s_waitcnt lgkmcnt(0)\n\ts_barrier" ::: "memory");
#pragma unroll
            for (int m = 0; m < MF; ++m)
#pragma unroll
                for (int bj = 0; bj < 2; ++bj)
#pragma unroll
                    for (int n = 0; n < 2; ++n) *(LAS f32x4*)(lds + (wr * (MF * 16) + m * 16 + fr) * PITCH + (bj * 128 + wc * 32 + 8 * fq + 4 * n) * 4) = acc[ai][bj][m][n];
            asm volatile("s_waitcnt lgkmcnt(0)\n\ts_barrier" ::: "memory");
#pragma unroll 2
            for (int i = 0; i < HR / 16; ++i) { const unsigned rl = i * 16 + wid * 2 + (lane >> 5), row = u.pm * (MF * 64) + ai * HR + rl, off = row * DM + colg;
                const f32x4 a0 = *(const LAS f32x4*)(lds + rl * PITCH + c8 * 4), a1 = *(const LAS f32x4*)(lds + rl * PITCH + c8 * 4 + 16);
                const unsigned v = row < (unsigned)MC ? 0u : (row < (unsigned)MC + 4096u ? 1u : 2u);
                const f32x4 g0 = LDG(f32x4, gate, (v * 6144 + colg) * 4), g1 = LDG(f32x4, gate, (v * 6144 + colg + 4) * 4);
                f32x4 b0, b1;
                if (first) { const float* base = row < (unsigned)MC ? baseC : baseL; b0 = LDG(f32x4, base, off * 4); b1 = LDG(f32x4, base, (off + 4) * 4); }
                else { const u32x4 xb = LDG(u32x4, ws, WS_XB + off * 2); b0 = (f32x4){bf_lo(xb.x), bf_hi(xb.x), bf_lo(xb.y), bf_hi(xb.y)}; b1 = (f32x4){bf_lo(xb.z), bf_hi(xb.z), bf_lo(xb.w), bf_hi(xb.w)}; }
                b0 = b0 + g0 * a0; b1 = b1 + g1 * a1;
                u32x4 w; w.x = pk2(b0[0], b0[1]); w.y = pk2(b0[2], b0[3]); w.z = pk2(b1[0], b1[1]); w.w = pk2(b1[2], b1[3]);
                STG(u32x4, ws, xo + off * 2) = w; }
        }
    }
};
struct EpiSwi {
    static constexpr bool PERM = true, AFTER_DRAIN = false;
    bf16_t* U; bool skip = false;
    template <int MF>
    __device__ __forceinline__ void operator()(const f32x4 (&acc)[2][2][MF][2], const pg8::Unit& u, int wr, int wc, int fr_, int fq_) const {
        if (skip) return;
        int fr = fr_, fq = fq_; asm volatile("" : "+v"(fr), "+v"(fq));
        const unsigned row0 = u.pm * (MF * 64) + wr * (MF * 16) + fr, oc0 = u.pn * 128 + wc * 32 + 8 * fq;
#pragma unroll
        for (int ai = 0; ai < 2; ++ai)
#pragma unroll
            for (int m = 0; m < MF; ++m) { const unsigned ro = ((row0 + ai * (MF * 32) + m * 16) * FF + oc0) * 2; f32x4 o[2];
#pragma unroll
                for (int bj = 0; bj < 2; ++bj) { const f32x4 g = acc[ai][bj][m][0], up = acc[ai][bj][m][1];
#pragma unroll
                    for (int e = 0; e < 4; ++e) o[bj][e] = g[e] * sigmf(g[e]) * up[e]; }
                const u32x2 lo = pack4(o[0]), hi2 = pack4(o[1]);
                STG(u32x4, U, ro) = (u32x4){lo.x, lo.y, hi2.x, hi2.y}; asm volatile("" ::: "memory"); }
    }
};
struct EpiWin {
    static constexpr bool PERM = true, AFTER_DRAIN = false;
    unsigned char* ws; float* out; int l; LAS unsigned char* lds; bool skip = false;
    template <int MF>
    __device__ __forceinline__ void operator()(const f32x4 (&acc)[2][2][MF][2], const pg8::Unit& u, int wr, int wc, int fr_, int fq_) const {
        if (skip) return;
        int fr = fr_, fq = fq_; asm volatile("" : "+v"(fr), "+v"(fq));
        const unsigned rowb = u.pm * (MF * 64) + wr * (MF * 16), row0 = rowb + fr;
#pragma unroll
        for (int bj = 0; bj < 2; ++bj) {
            const unsigned c32 = u.pn * 256 + bj * 128 + wc * 32;
            const unsigned c8 = c32 + 8 * fq;
            if (c32 < 1152 && (c32 < 512 || c32 >= 640)) {
                const bool isA = c32 < 512;
                const bool isK = isA ? (c32 >= 384) : (c32 >= 896);
                const float qs = isK ? 1.f : (isA ? QSCALE_A : QSCALE_B);
                const unsigned ck = isA ? c8 - 384 : c8 - 896;
                const unsigned dbase = isA ? (isK ? WS_KA + (((ck >> 6) * 4 + ((ck & 63) >> 4)) * 64 + ((ck >> 3) & 1) * 32) * 16 : WS_QA + c8 * 2)
                                           : (isK ? WS_KB + (((ck >> 5) * 2 + ((ck & 31) >> 4)) * 64 + ((ck >> 3) & 1) * 32) * 16 : WS_QB + (c8 - 640) * 2);
                const unsigned dpitch = isA ? 768u : 512u;
#pragma unroll
                for (int ai = 0; ai < 2; ++ai)
#pragma unroll
                    for (int m = 0; m < MF; ++m) {
                        const unsigned row = row0 + ai * (MF * 32) + m * 16; const bool lat = rowb + ai * (MF * 32) + m * 16 >= (unsigned)MC;
                        f32x4 v0 = acc[ai][bj][m][0], v1 = acc[ai][bj][m][1];
                        if (lat) {
                            const unsigned t = (row - MC) & 4095, rp = t >> 6, cp = t & 63;
                            unsigned to_;
                            if (isA) { const unsigned pos = ((c32 >> 5) & 1) ? cp : rp; to_ = WS_TAB + (TAB_COSA + pos * 16 + 4 * fq) * 4; }
                            else { const unsigned pos = (fq >> 1) ? cp : rp; to_ = WS_TAB + (TAB_COSB + pos * 8 + 4 * (fq & 1)) * 4; }
                            const f32x4 c4 = LDG(f32x4, ws, to_), s4 = LDG(f32x4, ws, to_ + (isA ? 4096u : 2048u));
                            f32x4 w0, w1;
                            w0[0] = v0[0] * c4[0] - v0[1] * s4[0]; w0[1] = v0[1] * c4[0] + v0[0] * s4[0];
                            w0[2] = v0[2] * c4[1] - v0[3] * s4[1]; w0[3] = v0[3] * c4[1] + v0[2] * s4[1];
                            w1[0] = v1[0] * c4[2] - v1[1] * s4[2]; w1[1] = v1[1] * c4[2] + v1[0] * s4[2];
                            w1[2] = v1[2] * c4[3] - v1[3] * s4[3]; w1[3] = v1[3] * c4[3] + v1[2] * s4[3];
                            v0 = w0; v1 = w1;
                        } else if (isK) {
                            const unsigned b = row >> 8, t = row & 255;
                            const f32x4 ev = {v0[0], v0[2], v1[0], v1[2]}, od = {v0[1], v0[3], v1[1], v1[3]};
                            if (isA) { const unsigned o = (OFF_AK + ((b * 4 + l) * 256 + t) * 128 + (c32 - 384) + 4 * fq) * 4; STG(f32x4, out, o) = ev; STG(f32x4, out, o + 64) = od; }
                            else { const unsigned o = (OFF_BK + ((b * 4 + l) * 256 + t) * 256 + ((c8 - 896) & ~15u) + 4 * (fq & 1)) * 4; STG(f32x4, out, o) = ev; STG(f32x4, out, o + 32) = od; }
                        }
                        v0 = v0 * qs; v1 = v1 * qs;
                        u32x4 w; w.x = pk2(v0[0], v0[1]); w.y = pk2(v0[2], v0[3]); w.z = pk2(v1[0], v1[1]); w.w = pk2(v1[2], v1[3]);
                        STG(u32x4, ws, isK ? dbase + (row >> 5) * (isA ? 8192u : 16384u) + (row & 31) * 16 : dbase + row * dpitch) = w;
                        asm volatile("" ::: "memory");
                    }
            } else if (c32 < 1408) {
                const bool isA = c32 < 640;
                const unsigned cc = isA ? (c8 - 512) : (c8 - 1152), cw = isA ? (c32 - 512) : (c32 - 1152);
                const unsigned vfrag = (isA ? WS_VTA : WS_VTB) + (((cw >> 6) * 2 + ((cw >> 5) & 1)) * 2) * 1024;
                LAS unsigned char* lw = lds + (wr * 4 + wc) * 1024;
                LAS bf16_t* lq = (LAS bf16_t*)(lw + ((((fr >> 2) & 1) * 32 + 8 * fq) * 16 + (4 * (fr >> 3) + (fr & 3)) * 2));
#pragma unroll
                for (int ai = 0; ai < 2; ++ai)
#pragma unroll
                    for (int m = 0; m < MF; ++m) {
                        const unsigned rf = rowb + ai * (MF * 32) + m * 16, row = rf + fr; const bool lat = rf >= (unsigned)MC;
                        const f32x4 v0 = acc[ai][bj][m][0], v1 = acc[ai][bj][m][1];
                        if (!lat) { const unsigned b = row >> 8, t = row & 255;
                            const unsigned o = isA ? (OFF_AV + ((b * 4 + l) * 256 + t) * 128 + cc) * 4 : (OFF_BV + ((b * 4 + l) * 256 + t) * 256 + cc) * 4;
                            STG(f32x4, out, o) = v0; STG(f32x4, out, o + 16) = v1; }
                        const unsigned p0 = pk2(v0[0], v0[1]), p1 = pk2(v0[2], v0[3]), p2 = pk2(v1[0], v1[1]), p3 = pk2(v1[2], v1[3]);
                        lq[0 * 8] = (bf16_t)(p0 & 0xffff); lq[1 * 8] = (bf16_t)(p0 >> 16); lq[2 * 8] = (bf16_t)(p1 & 0xffff); lq[3 * 8] = (bf16_t)(p1 >> 16);
                        lq[4 * 8] = (bf16_t)(p2 & 0xffff); lq[5 * 8] = (bf16_t)(p2 >> 16); lq[6 * 8] = (bf16_t)(p3 & 0xffff); lq[7 * 8] = (bf16_t)(p3 >> 16);
                        const u32x4 tv = *(const LAS u32x4*)(lw + (fq * 16 + fr) * 16);
                        STG(u32x4, ws, vfrag + (rf >> 5) * (isA ? 8192u : 16384u) + ((rf >> 4) & 1) * 1024 + (fq * 16 + fr) * 16) = tv;
                        asm volatile("" ::: "memory");
                    }
            } else if (c32 < 2944) {
                const int kind = c32 < 2560 ? 0 : (c32 < 2688 ? 1 : (c32 < 2816 ? 2 : 3));
                const unsigned dbase = kind == 0 ? WS_RKV + (c8 - 1408) * 2 : (kind == 1 ? WS_CW + (c8 - 2560) * 2 : (kind == 2 ? WS_CA + (c8 - 2688) * 2 : WS_CG + (c8 - 2816) * 2));
                const unsigned dpitch = kind == 0 ? 2304u : 256u;
#pragma unroll
                for (int ai = 0; ai < 2; ++ai)
#pragma unroll
                    for (int m = 0; m < MF; ++m) {
                        const unsigned row = row0 + ai * (MF * 32) + m * 16; const bool lat = rowb + ai * (MF * 32) + m * 16 >= (unsigned)MC;
                        f32x4 v0 = acc[ai][bj][m][0], v1 = acc[ai][bj][m][1];
                        if (kind == 1) {
#pragma unroll
                            for (int e = 0; e < 4; ++e) { v0[e] = 1.f - 2.f * __builtin_amdgcn_rcpf(__expf(2.f * v0[e]) + 1.f); v1[e] = 1.f - 2.f * __builtin_amdgcn_rcpf(__expf(2.f * v1[e]) + 1.f); }
                        } else if (kind == 3) {
#pragma unroll
                            for (int e = 0; e < 4; ++e) { v0[e] = sigmf(v0[e]); v1[e] = sigmf(v1[e]); }
                        }
                        u32x4 w; w.x = pk2(v0[0], v0[1]); w.y = pk2(v0[2], v0[3]); w.z = pk2(v1[0], v1[1]); w.w = pk2(v1[2], v1[3]);
                        STG(u32x4, ws, dbase + row * dpitch) = w;
                        asm volatile("" ::: "memory");
                    }
            }
        }
    }
};

struct Frame {
    LAS unsigned char* lds;
    const float* const* in;
    float* out; unsigned char* ws;
    int tid, lane, wave, gw, ngw, G, bid, crep;
};
#define GAS __attribute__((address_space(1)))
template <class T> __device__ __forceinline__ T* gptr(T* p) {
#if defined(__HIP_DEVICE_COMPILE__)
    __builtin_assume(!__builtin_amdgcn_is_shared((const void*)p)); __builtin_assume(!__builtin_amdgcn_is_private((const void*)p));
#endif
    return p; }
#define INP(k) gptr(F.in[k])
#define WSP(T, off) gptr((T*)(F.ws + (off)))

__device__ __forceinline__ void phase_prologue(Frame& F) {
    const float* cvec = INP(8); const float* cctx = INP(9); const float* ada_w = INP(10); const float* ada_b = INP(11);
    LAS float* sl = (LAS float*)F.lds;
    LAS float* red = (LAS float*)(F.lds + 16384);
    for (int i = F.tid; i < 3072; i += 512) { const int v = i >> 10, k = i & 1023; const float x = v == 0 ? cctx[k] : cvec[(v - 1) * 1024 + k]; sl[i] = x / (1.f + __expf(-x)); }
    __syncthreads();
    float* mod = WSP(float, WS_MOD);
    for (int it = F.bid; it < 384; it += F.G) {
        const int l = it / 96, n0 = (it % 96) * 64;
        const float* W = ada_w + (size_t)l * 1024 * 6144 + n0 + F.lane;
        float a0 = 0.f, a1 = 0.f, a2 = 0.f;
        const int k0 = F.wave * 128;
#pragma unroll 8
        for (int k = k0; k < k0 + 128; ++k) { const float w = *(const GAS float*)(W + (size_t)k * 6144); a0 += sl[k] * w; a1 += sl[1024 + k] * w; a2 += sl[2048 + k] * w; }
        red[(F.wave * 3 + 0) * 64 + F.lane] = a0; red[(F.wave * 3 + 1) * 64 + F.lane] = a1; red[(F.wave * 3 + 2) * 64 + F.lane] = a2;
        __syncthreads();
        if (F.wave < 3) { float s = ada_b[l * 6144 + n0 + F.lane];
#pragma unroll
            for (int w = 0; w < 8; ++w) s += red[(w * 3 + F.wave) * 64 + F.lane];
            mod[(size_t)(l * 3 + F.wave) * 6144 + n0 + F.lane] = s; }
        __syncthreads();
    }
    float* tab = WSP(float, WS_TAB);
    if (F.bid == F.G - 1) {
        for (int i = F.tid; i < 1024; i += 512) { const int pos = i >> 4, f = i & 15; const float ang = (float)pos * __builtin_amdgcn_exp2f(-(float)f * (13.287712379549449f / 16.f)); tab[TAB_COSA + i] = __cosf(ang); tab[TAB_SINA + i] = __sinf(ang); }
        for (int i = F.tid; i < 512; i += 512) { const int pos = i >> 3, f = i & 7; const float ang = (float)pos * __builtin_amdgcn_exp2f(-(float)f * (13.287712379549449f / 8.f)); tab[TAB_COSB + i] = __cosf(ang); tab[TAB_SINB + i] = __sinf(ang); }
        if (F.wave < 4) { const float* lp = INP(16) + F.wave * 128; const int d = F.lane & 31;
            const float p1 = wave_sum(F.lane < 32 ? lp[d] * lp[32 + d] : 0.f), p2 = wave_sum(F.lane < 32 ? 0.f : lp[64 + d] * lp[96 + d]);
            if (F.lane == 0) tab[TAB_LAM + F.wave] = __expf(p1) - __expf(p2); }
    }
    const int gtid = F.bid * 512 + F.tid, gnt = F.G * 512;
    { bf16_t* sw = WSP(bf16_t, WS_SMALLW); const float* cw2 = INP(20); const float* ca2 = INP(22); const float* cg2 = INP(23);
      for (int idx = gtid; idx < 4 * SMALLW_L; idx += gnt) { const int l = idx / SMALLW_L, r = idx % SMALLW_L; float v;
          if (r < 98304) { const int which = r / 49152, rr = r % 49152, d = rr / 24576, ch = (rr % 24576) / 64, k = rr % 64; v = (which ? ca2 : cw2)[((size_t)(l * 2 + d) * 64 + k) * 384 + ch]; }
          else { const int rr = r - 98304, ch = rr / 128, k = rr % 128; v = cg2[((size_t)l * 128 + k) * 384 + ch]; }
          sw[idx] = (bf16_t)(pk2(v, 0.f) & 0xffff); } }
    { bf16_t* kca = WSP(bf16_t, WS_CACHE); bf16_t* vca = kca + 524288; bf16_t* kcb = vca + 524288; bf16_t* vcb = kcb + 1048576;
      const float* cak = INP(2); const float* cav = INP(3); const float* cbk = INP(4); const float* cbv = INP(5);
      for (int e = gtid; e < 524288; e += gnt) {
          const int j = e & 7, ln = (e >> 3) & 63, hi = ln >> 5, r32 = ln & 31, blk = (e >> 12) & 15, bl = e >> 16;
          { const int s = (e >> 9) & 3, kvh = (e >> 11) & 1, cp = kvh * 64 + 16 * s + 8 * hi + j, o = cp & 31, c = (cp - o) + (o >> 1) + 16 * (o & 1);
            kca[e] = (bf16_t)(pk2(cak[((size_t)bl * 512 + blk * 32 + r32) * 128 + c], 0.f) & 0xffff); }
          { const int ks = (e >> 9) & 1, db = (e >> 10) & 1, kvh = (e >> 11) & 1, key = blk * 32 + 16 * ks + 8 * (j >> 2) + 4 * hi + (j & 3);
            vca[e] = (bf16_t)(pk2(cav[((size_t)bl * 512 + key) * 128 + kvh * 64 + db * 32 + r32], 0.f) & 0xffff); } }
      for (int e = gtid; e < 1048576; e += gnt) {
          const int j = e & 7, ln = (e >> 3) & 63, hi = ln >> 5, r32 = ln & 31, blk = (e >> 13) & 15, bl = e >> 17;
          { const int s = (e >> 9) & 1, hm = (e >> 10) & 7, cp = hm * 32 + 16 * s + 8 * hi + j, o = cp & 15, c = (cp - o) + (o >> 1) + 8 * (o & 1);
            kcb[e] = (bf16_t)(pk2(cbk[((size_t)bl * 512 + blk * 32 + r32) * 256 + c], 0.f) & 0xffff); }
          { const int ks = (e >> 9) & 1, db = (e >> 10) & 1, h = (e >> 11) & 3, key = blk * 32 + 16 * ks + 8 * (j >> 2) + 4 * hi + (j & 3);
            vcb[e] = (bf16_t)(pk2(cbv[((size_t)bl * 512 + key) * 256 + h * 64 + db * 32 + r32], 0.f) & 0xffff); } } }
    for (int st = 0; st < 1; ++st) { u32x4* z = (u32x4*)(WSP(bf16_t, WS_WIN + st * WSET_STRIDE) + (size_t)2944 * 1024); unsigned z0; asm volatile("v_mov_b32 %0, 0" : "=v"(z0)); for (int i = gtid; i < 128 * 1024 / 8; i += gnt) z[i] = (u32x4){z0, z0, z0, z0}; }
}

template <int MAP> __device__ __forceinline__ int dest_row(int n) {
    if (MAP == 1) {
        if (n < 512) { const int o = n & 31; return (n - o) + 2 * (o & 15) + (o >> 4); }
        if (n >= 640 && n < 1152) { const int o = n & 15; return (n - o) + 2 * (o & 7) + (o >> 3); }
        return n;
    }
    if (MAP == 2 || MAP == 3) return (n >> 7) * 256 + ((n >> 2) & 1) * 128 + ((n >> 5) & 3) * 32 + ((n >> 3) & 3) * 8 + (MAP == 3 ? 4 : 0) + (n & 3);
    return n;
}
template <int MAP> __device__ __forceinline__ void transpose_item(const float* W, int K, int N, bf16_t* WT, LAS float* scr, int item, int lane) {
    const int nblk = N / 32, kb = item / nblk, nb = item % nblk, k0 = 64 * kb, n0 = 32 * nb;
    f32x4 wv[8];
#pragma unroll
    for (int i = 0; i < 8; ++i) wv[i] = *(const GAS f32x4*)(W + (size_t)(k0 + 8 * i + (lane >> 3)) * N + n0 + 4 * (lane & 7));
#pragma unroll
    for (int i = 0; i < 8; ++i) { LAS float* d = scr + (8 * i + (lane >> 3)) * 33 + 4 * (lane & 7); d[0] = wv[i][0]; d[1] = wv[i][1]; d[2] = wv[i][2]; d[3] = wv[i][3]; }
    asm volatile("s_waitcnt lgkmcnt(0)" ::: "memory");
    const int c = lane & 7;
#pragma unroll
    for (int j = 0; j < 4; ++j) { const int n = (lane >> 3) + 8 * j; const LAS float* s = scr + (8 * c) * 33 + n;
        u32x4 o; o.x = pk2(s[0 * 33], s[1 * 33]); o.y = pk2(s[2 * 33], s[3 * 33]); o.z = pk2(s[4 * 33], s[5 * 33]); o.w = pk2(s[6 * 33], s[7 * 33]);
        *(GAS u32x4*)(WT + (size_t)dest_row<MAP>(n0 + n) * K + k0 + 8 * c) = o; }
    asm volatile("s_waitcnt lgkmcnt(0)" ::: "memory");
}
template <int MAP> __device__ __forceinline__ void convert_item(const float* W, int K, int N, bf16_t* WT, int item, int lane) {
    const int nblk = N / 64, kb = item / nblk, nb = item % nblk, n = nb * 64 + lane;
    const GAS float* src = (const GAS float*)W + (size_t)(kb * 128) * N + n;
    GAS bf16_t* dst = (GAS bf16_t*)WT + (size_t)dest_row<MAP>(n) * K + kb * 128;
#pragma unroll
    for (int g = 0; g < 16; ++g) { float v[8];
#pragma unroll
        for (int e = 0; e < 8; ++e) v[e] = src[(size_t)(8 * g + e) * N];
        u32x4 o; o.x = pk2(v[0], v[1]); o.y = pk2(v[2], v[3]); o.z = pk2(v[4], v[5]); o.w = pk2(v[6], v[7]);
        *(GAS u32x4*)(dst + 8 * g) = o; }
}
constexpr int CV_IN = 46 * 8, CV_OUT = 16 * 8, CV_1 = 44 * 8, CV_2 = 16 * 22, CV_TOTAL = CV_IN + CV_OUT + 2 * CV_1 + CV_2;
__device__ __forceinline__ void convert_item_any(Frame& F, int l, int it) {
    const unsigned so = 0u * WSET_STRIDE;
    int r = it;
    if (r < CV_IN) { convert_item<1>(INP(14) + (size_t)l * 1024 * 2944, 1024, 2944, WSP(bf16_t, WS_WIN + so), r, F.lane); return; } r -= CV_IN;
    if (r < CV_OUT) { convert_item<0>(INP(29) + (size_t)l * 1024 * 1024, 1024, 1024, WSP(bf16_t, WS_WOUT + so), r, F.lane); return; } r -= CV_OUT;
    if (r < CV_1) { convert_item<2>(INP(30) + (size_t)l * 1024 * FF, 1024, FF, WSP(bf16_t, WS_W13 + so), r, F.lane); return; } r -= CV_1;
    if (r < CV_1) { convert_item<3>(INP(31) + (size_t)l * 1024 * FF, 1024, FF, WSP(bf16_t, WS_W13 + so), r, F.lane); return; } r -= CV_1;
    convert_item<0>(INP(32) + (size_t)l * FF * 1024, FF, 1024, WSP(bf16_t, WS_W2 + so), r, F.lane);
}
__device__ __forceinline__ void convert_weights(Frame& F, int l) {
    LAS float* scr = (LAS float*)(F.lds + F.wave * 16384); const unsigned so = 0u * WSET_STRIDE;
    const float* w_in = INP(14) + (size_t)l * 1024 * 2944; const float* w_out = INP(29) + (size_t)l * 1024 * 1024;
    const float* w1 = INP(30) + (size_t)l * 1024 * FF; const float* w3 = INP(31) + (size_t)l * 1024 * FF; const float* w2 = INP(32) + (size_t)l * FF * 1024;
    constexpr int I_IN = 16 * 92, I_OUT = 16 * 32, I_1 = 16 * 88, I_2 = 44 * 32;
    constexpr int NIT = I_IN + I_OUT + 2 * I_1 + I_2;
    for (int it = F.gw; it < NIT; it += F.ngw) {
        int r = it;
        if (r < I_IN) { transpose_item<1>(w_in, 1024, 2944, WSP(bf16_t, WS_WIN + so), scr, r, F.lane); continue; } r -= I_IN;
        if (r < I_OUT) { transpose_item<0>(w_out, 1024, 1024, WSP(bf16_t, WS_WOUT + so), scr, r, F.lane); continue; } r -= I_OUT;
        if (r < I_1) { transpose_item<2>(w1, 1024, FF, WSP(bf16_t, WS_W13 + so), scr, r, F.lane); continue; } r -= I_1;
        if (r < I_1) { transpose_item<3>(w3, 1024, FF, WSP(bf16_t, WS_W13 + so), scr, r, F.lane); continue; } r -= I_1;
        transpose_item<0>(w2, FF, 1024, WSP(bf16_t, WS_W2 + so), scr, r, F.lane);
    }
}

__device__ __forceinline__ void phase_norm(Frame& F, int l, int which  ) {
    const float* g = (which ? INP(13) : INP(12)) + l * 1024;
    const float* mod = WSP(float, WS_MOD) + (size_t)l * 3 * 6144 + (which ? 3072 : 0);
    bf16_t* H = WSP(bf16_t, WS_ACT);
    const bool first = (l == 0 && which == 0);
    f32x4 gv[4];
#pragma unroll
    for (int j = 0; j < 4; ++j) gv[j] = *(const GAS f32x4*)(g + 4 * F.lane + 256 * j);
    for (int row0 = F.gw; row0 < M; row0 += 2 * F.ngw) {
        f32x4 v[2][4]; float ss[2] = {0.f, 0.f};
#pragma unroll
        for (int u = 0; u < 2; ++u) { const int row = row0 + u * F.ngw; if (row < M) {
            if (first) { const float* xr = row < MC ? INP(0) + (size_t)row * DM : INP(1) + (size_t)(row - MC) * DM;
#pragma unroll
                for (int j = 0; j < 4; ++j) v[u][j] = *(const GAS f32x4*)(xr + 4 * F.lane + 256 * j); }
            else {
#pragma unroll
                for (int j = 0; j < 4; ++j) v[u][j] = unpack4(LDG(u32x2, F.ws, WS_XB + ((unsigned)row * DM + 4 * F.lane + 256 * j) * 2)); }
#pragma unroll
            for (int j = 0; j < 4; ++j) ss[u] += (v[u][j][0] * v[u][j][0] + v[u][j][1] * v[u][j][1]) + (v[u][j][2] * v[u][j][2] + v[u][j][3] * v[u][j][3]); } }
#pragma unroll
        for (int u = 0; u < 2; ++u) { const int row = row0 + u * F.ngw; if (row < M) {
            const float* mv = mod + (row < MC ? 0 : (row < 2 * MC ? 1 : 2)) * 6144;
            const float rstd = rsqrtf(wave_sum(ss[u]) * (1.f / 1024.f) + 1e-6f);
#pragma unroll
            for (int j = 0; j < 4; ++j) { const f32x4 sh = *(const GAS f32x4*)(mv + 4 * F.lane + 256 * j), sc = *(const GAS f32x4*)(mv + 1024 + 4 * F.lane + 256 * j);
                const f32x4 h = v[u][j] * rstd * gv[j] * (sc + 1.f) + sh;
                *(GAS u32x2*)(H + (size_t)row * DM + 4 * F.lane + 256 * j) = pack4(h); } } }
    }
}
__device__ __forceinline__ void phase_final_norm(Frame& F) {
    const float* g = INP(33);
    f32x4 gv[4];
#pragma unroll
    for (int j = 0; j < 4; ++j) gv[j] = *(const GAS f32x4*)(g + 4 * F.lane + 256 * j);
    for (int row = F.gw; row < M; row += F.ngw) {
        float* xr = gptr(F.out + (size_t)row * DM);
        f32x4 v[4]; float ss = 0.f;
#pragma unroll
        for (int j = 0; j < 4; ++j) { v[j] = unpack4(LDG(u32x2, F.ws, WS_XB + ((unsigned)row * DM + 4 * F.lane + 256 * j) * 2)); ss += (v[j][0] * v[j][0] + v[j][1] * v[j][1]) + (v[j][2] * v[j][2] + v[j][3] * v[j][3]); }
        const float rstd = rsqrtf(wave_sum(ss) * (1.f / 1024.f) + 1e-6f);
#pragma unroll
        for (int j = 0; j < 4; ++j) *(GAS f32x4*)(xr + 4 * F.lane + 256 * j) = v[j] * rstd * gv[j];
    }
}

#define MFMA32(a, b, c) __builtin_amdgcn_mfma_f32_32x32x16_bf16((a), (b), (c), 0, 0, 0)
#ifndef ATT_PROBE
#define ATT_PROBE 0
#endif
struct AttnQ { float m, l; bool mz; f32x16 o[2]; };
template <int DQK, bool MASK, int NQ>
__device__ __forceinline__ void attn_block(const bf16x8 (&qf)[NQ][DQK / 16], const bf16x8 (&kf)[DQK / 16], const bf16x8 (&vf)[4], AttnQ (&st)[NQ], int b, const int (&qpos)[NQ], int kpos0, int hi) {
    constexpr int NS = DQK / 16;
    f32x16 sc[NQ];
#pragma unroll
    for (int q = 0; q < NQ; ++q) { const f32x16 z = {}; sc[q] = MFMA32(kf[0], qf[q][0], z);
#pragma unroll
        for (int s = 1; s < NS; ++s) sc[q] = MFMA32(kf[s], qf[q][s], sc[q]); }
#pragma unroll
    for (int q = 0; q < NQ; ++q) {
        if (!st[q].mz) {
#pragma unroll
            for (int r = 0; r < 16; ++r) sc[q][r] -= st[q].m; }
        if (MASK) {
#pragma unroll
            for (int r = 0; r < 16; ++r) { const int key = kpos0 + 32 * b + (r & 3) + 8 * (r >> 2) + 4 * hi; const int dlt = key - qpos[q]; if (dlt > 128 || dlt < -128) sc[q][r] = -1e30f; }
        }
        float bm = fmaxf(fmaxf(sc[q][0], sc[q][1]), sc[q][2]);
#pragma unroll
        for (int r = 3; r < 15; r += 2) bm = fmaxf(fmaxf(bm, sc[q][r]), sc[q][r + 1]);
        bm = fmaxf(bm, sc[q][15]);
        bm = swap32_max(bm);
        if (__builtin_amdgcn_ballot_w64(bm > 64.f) != 0ull) {
            const float d = fmaxf(bm, 0.f);
            const float alpha = __builtin_amdgcn_exp2f(-d);
            st[q].m += d; st[q].l *= alpha; st[q].mz = false;
#pragma unroll
            for (int r = 0; r < 16; ++r) { st[q].o[0][r] *= alpha; st[q].o[1][r] *= alpha; sc[q][r] -= d; }
        }
#if ATT_PROBE == 1
        { float dmy = 0.f;
#pragma unroll
          for (int r = 0; r < 16; ++r) { float e_; asm volatile("v_exp_f32 %0, %1" : "=v"(e_) : "v"(sc[q][r])); dmy += e_; }
          asm volatile("" :: "v"(dmy)); }
#endif
        f32x2 rs2 = {0.f, 0.f};
#pragma unroll
        for (int r = 0; r < 16; r += 2) { sc[q][r] = __builtin_amdgcn_exp2f(sc[q][r]); sc[q][r + 1] = __builtin_amdgcn_exp2f(sc[q][r + 1]); rs2 += (f32x2){sc[q][r], sc[q][r + 1]}; }
        st[q].l += rs2[0] + rs2[1];
#if ATT_PROBE == 3
        { float d0 = 0.f, d1 = 0.f, d2 = 0.f, d3 = 0.f;
#pragma unroll
          for (int rr = 0; rr < 10; ++rr) { asm volatile("v_add_f32 %0, %0, %4\n\tv_add_f32 %1, %1, %5\n\tv_add_f32 %2, %2, %6\n\tv_add_f32 %3, %3, %7" : "+v"(d0), "+v"(d1), "+v"(d2), "+v"(d3) : "v"(sc[q][0]), "v"(sc[q][1]), "v"(sc[q][2]), "v"(sc[q][3])); }
          asm volatile("" :: "v"(d0), "v"(d1), "v"(d2), "v"(d3)); }
#endif
#if ATT_PROBE == 2
        { f32x16 dm = sc[q]; dm = MFMA32(kf[0], qf[q][0], dm); dm = MFMA32(kf[0], qf[q][0], dm); dm = MFMA32(kf[0], qf[q][0], dm); asm volatile("" :: "v"(dm)); }
#endif
        bf16x8 pb[2];
#pragma unroll
        for (int ks = 0; ks < 2; ++ks) { u32x4 w; w.x = pk2(sc[q][8 * ks], sc[q][8 * ks + 1]); w.y = pk2(sc[q][8 * ks + 2], sc[q][8 * ks + 3]); w.z = pk2(sc[q][8 * ks + 4], sc[q][8 * ks + 5]); w.w = pk2(sc[q][8 * ks + 6], sc[q][8 * ks + 7]); pb[ks] = __builtin_bit_cast(bf16x8, w); }
#pragma unroll
        for (int db = 0; db < 2; ++db)
#pragma unroll
            for (int ks = 0; ks < 2; ++ks) st[q].o[db] = MFMA32(vf[db * 2 + ks], pb[ks], st[q].o[db]);
    }
}
template <int DQK, bool MASK, int NQ>
__device__ __forceinline__ void attn_seg(const unsigned char* ws, const bf16x8 (&qf)[NQ][DQK / 16], AttnQ (&st)[NQ],
                                         unsigned kp, unsigned kblk  , unsigned vp, unsigned vblk, int nblk, const int (&qpos)[NQ], int kpos0, int hi) {
    constexpr int NS = DQK / 16;
    const GAS unsigned char* kq = (const GAS unsigned char*)ws + kp; const GAS unsigned char* vq = (const GAS unsigned char*)ws + vp;
    bf16x8 ka[NS], va[4], kb[NS], vb[4];
#define ATT_LOAD(kd, vd) do { _Pragma("unroll") for (int s = 0; s < NS; ++s) kd[s] = *(const GAS bf16x8*)(kq + 1024 * s); _Pragma("unroll") for (int f = 0; f < 4; ++f) vd[f] = *(const GAS bf16x8*)(vq + 1024 * f); } while (0)
    ATT_LOAD(ka, va);
    int b = 0;
    for (; b + 1 < nblk; b += 2) {
        kq += kblk; vq += vblk; ATT_LOAD(kb, vb);
        attn_block<DQK, MASK, NQ>(qf, ka, va, st, b, qpos, kpos0, hi);
        if (b + 2 < nblk) { kq += kblk; vq += vblk; }
        ATT_LOAD(ka, va);
        attn_block<DQK, MASK, NQ>(qf, kb, vb, st, b + 1, qpos, kpos0, hi);
    }
    if (b < nblk) attn_block<DQK, MASK, NQ>(qf, ka, va, st, b, qpos, kpos0, hi);
#undef ATT_LOAD
}
__device__ __forceinline__ void attnq_init(AttnQ& s, float l0) { s.m = 0.f; s.mz = true; s.l = l0; s.o[0] = (f32x16){}; s.o[1] = (f32x16){}; }
__device__ __forceinline__ void attn_a_item(Frame& F, int l, bool lat, int item) {
    int lane = F.lane; asm volatile("" : "+v"(lane));
    const unsigned char* ws = F.ws;
    const unsigned r32 = lane & 31, hi = lane >> 5;
    const unsigned nqb = lat ? 128 : 8;
    const unsigned qb = item % nqb, hq = (item / nqb) % 6, b = item / (nqb * 6), kvh = hq / 3;
    const unsigned seq0 = lat ? MC + b * 4096 : b * 256, q0 = qb * 32, row = seq0 + q0 + r32;
    const unsigned qo = WS_QA + (row * 384 + hq * 64 + 8 * hi) * 2;
    bf16x8 qf[1][4];
#pragma unroll
    for (int s = 0; s < 4; ++s) qf[0][s] = LDG(bf16x8, ws, qo + 32 * s);
    AttnQ st[1]; attnq_init(st[0], hi == 0 ? __builtin_amdgcn_exp2f(INP(15)[l * 6 + hq] * LOG2E) : 0.f);
    const int qpos[1] = {(int)(q0 + r32)};
    const unsigned fo = kvh * 4096 + lane * 16;
    if (!lat) {
        attn_seg<64, false, 1>(ws, qf, st, WS_KA + (seq0 >> 5) * 8192 + fo, 8192, WS_VTA + (seq0 >> 5) * 8192 + fo, 8192, 8, qpos, 0, hi);
    } else {
        const int ks = (int)q0 - 128 < 0 ? 0 : (int)q0 - 128, ke = q0 + 160 > 4096 ? 4096 : q0 + 160;
        attn_seg<64, true, 1>(ws, qf, st, WS_KA + ((seq0 + ks) >> 5) * 8192 + fo, 8192, WS_VTA + ((seq0 + ks) >> 5) * 8192 + fo, 8192, (ke - ks) >> 5, qpos, ks, hi);
        attn_seg<64, false, 1>(ws, qf, st, WS_CACHE + (b * 4 + l) * 131072 + fo, 8192, WS_CACHE + 1 * MiB + (b * 4 + l) * 131072 + fo, 8192, 16, qpos, 0, hi);
    }
    const float rl = 1.f / swap32_sum(st[0].l);
    const unsigned oo = WS_ACT + (row * DM + hq * 64 + 4 * hi) * 2;
#pragma unroll
    for (int db = 0; db < 2; ++db)
#pragma unroll
        for (int g = 0; g < 4; ++g) { const f32x4 v = {st[0].o[db][4 * g] * rl, st[0].o[db][4 * g + 1] * rl, st[0].o[db][4 * g + 2] * rl, st[0].o[db][4 * g + 3] * rl}; STG(u32x2, F.ws, oo + (32 * db + 8 * g) * 2) = pack4(v); }
}
__device__ __forceinline__ void attn_b_store(Frame& F, const AttnQ& s, unsigned mp, unsigned kh, unsigned row, unsigned h, unsigned hi) {
    const float lt = swap32_sum(s.l);
    const unsigned oo = WS_BO2 + (((mp * 2 + kh) * M + row) * 256 + h * 64 + 4 * hi) * 2;
#pragma unroll
    for (int db = 0; db < 2; ++db)
#pragma unroll
        for (int g = 0; g < 4; ++g) STG(u32x2, F.ws, oo + (32 * db + 8 * g) * 2) = pack4((f32x4){s.o[db][4 * g], s.o[db][4 * g + 1], s.o[db][4 * g + 2], s.o[db][4 * g + 3]});
    if (hi == 0) STG(f32x2, F.ws, WS_ML + ((((mp * 2 + kh) * M + row) * 4 + h) * 2) * 4) = (f32x2){s.m, lt};
}
__device__ __forceinline__ void attn_b_item(Frame& F, int l, bool lat, int item) {
    int lane = F.lane; asm volatile("" : "+v"(lane));
    const unsigned char* ws = F.ws;
    const unsigned r32 = lane & 31, hi = lane >> 5;
    if (lat) {
        const unsigned kh = item & 1, qb = (item >> 1) & 63, mp = (item >> 7) & 1, h = (item >> 8) & 3, b = item >> 10;
        const unsigned seq0 = MC + b * 4096, row0 = seq0 + qb * 64 + r32;
        bf16x8 qf[2][2];
#pragma unroll
        for (int q = 0; q < 2; ++q)
#pragma unroll
            for (int s = 0; s < 2; ++s) qf[q][s] = LDG(bf16x8, ws, WS_QB + ((row0 + 32 * q) * 256 + h * 64 + mp * 32 + 8 * hi) * 2 + 32 * s);
        AttnQ st[2]; attnq_init(st[0], 0.f); attnq_init(st[1], 0.f);
        const int qpos[2] = {0, 0};
        const unsigned kfo = (h * 2 + mp) * 2048 + lane * 16, vfo = h * 4096 + lane * 16;
        const unsigned blk0 = kh ? 72u : 0u, nb = kh ? 56 : 72;
        attn_seg<32, false, 2>(ws, qf, st, WS_KB + ((seq0 >> 5) + blk0) * 16384 + kfo, 16384, WS_VTB + ((seq0 >> 5) + blk0) * 16384 + vfo, 16384, nb, qpos, 0, hi);
        if (kh) attn_seg<32, false, 2>(ws, qf, st, WS_CACHE + 2 * MiB + (b * 4 + l) * 262144 + kfo, 16384, WS_CACHE + 4 * MiB + (b * 4 + l) * 262144 + vfo, 16384, 16, qpos, 0, hi);
        attn_b_store(F, st[0], mp, kh, row0, h, hi); attn_b_store(F, st[1], mp, kh, row0 + 32, h, hi);
    } else {
        const unsigned qb = item & 7, mp = (item >> 3) & 1, h = (item >> 4) & 3, b = item >> 6;
        const unsigned seq0 = b * 256, row = seq0 + qb * 32 + r32;
        bf16x8 qf[1][2];
#pragma unroll
        for (int s = 0; s < 2; ++s) qf[0][s] = LDG(bf16x8, ws, WS_QB + (row * 256 + h * 64 + mp * 32 + 8 * hi) * 2 + 32 * s);
        AttnQ st[1]; attnq_init(st[0], 0.f);
        const int qpos[1] = {0};
        const unsigned kfo = (h * 2 + mp) * 2048 + lane * 16, vfo = h * 4096 + lane * 16;
        attn_seg<32, false, 1>(ws, qf, st, WS_KB + (seq0 >> 5) * 16384 + kfo, 16384, WS_VTB + (seq0 >> 5) * 16384 + vfo, 16384, 8, qpos, 0, hi);
        attn_b_store(F, st[0], mp, 0, row, h, hi);
    }
}

constexpr int L_KT = 0, L_RT = 9216, L_BT = 18432, L_KK = 27648, L_VT = 36864, L_KKT = 46080, L_BTT = 55296, L_A1 = 64512, L_RHS2 = 81920, L_WT = 99328, L_U0T = 108544, L_GC = 117760, L_X0 = 118016;
constexpr int RPB = 144, RPF = 272;
__device__ __forceinline__ void chunk_decode(int cid, unsigned& seq0, int& T, unsigned& b, unsigned& h, unsigned& dir, int& c) {
    unsigned chain;
    if (cid < 768) { chain = (unsigned)cid >> 2; c = cid & 3; T = 256; b = chain / 12; seq0 = b * 256; }
    else { const unsigned x = (unsigned)cid - 768; chain = x >> 6; c = (int)(x & 63); T = 4096; b = chain / 12; seq0 = MC + b * 4096; }
    dir = chain & 1; h = (chain >> 1) % 6;
}
__device__ __forceinline__ bf16x8 acc_frag(const f32x16& x, int ks, float sgn) {
    u32x4 w; w.x = pk2(sgn * x[8 * ks], sgn * x[8 * ks + 1]); w.y = pk2(sgn * x[8 * ks + 2], sgn * x[8 * ks + 3]); w.z = pk2(sgn * x[8 * ks + 4], sgn * x[8 * ks + 5]); w.w = pk2(sgn * x[8 * ks + 6], sgn * x[8 * ks + 7]);
    return __builtin_bit_cast(bf16x8, w);
}
__device__ __forceinline__ bf16x8 lds_frag_nat(const LAS unsigned char* img, unsigned row, int ks, unsigned hi) { return *(const LAS bf16x8*)(img + row * RPB + (16 * ks + 8 * hi) * 2); }
__device__ __forceinline__ bf16x8 lds_frag_perm(const LAS unsigned char* img, unsigned row, int k0, unsigned hi) {
    const s16x4 a = *(const LAS s16x4*)(img + row * RPB + (k0 + 4 * hi) * 2), b = *(const LAS s16x4*)(img + row * RPB + (k0 + 8 + 4 * hi) * 2);
    return (bf16x8){a[0], a[1], a[2], a[3], b[0], b[1], b[2], b[3]};
}
__device__ __forceinline__ f32x16 gram_tile(const LAS unsigned char* lds, int aimg, int bimg, int sb, int tb, unsigned r32, unsigned hi, bool strict) {
    f32x16 acc = {};
#pragma unroll
    for (int ks = 0; ks < 4; ++ks) acc = MFMA32(lds_frag_nat(lds + aimg, 32 * sb + r32, ks, hi), lds_frag_nat(lds + bimg, 32 * tb + r32, ks, hi), acc);
    if (sb == tb) {
#pragma unroll
        for (int r = 0; r < 16; ++r) { const unsigned s_ = (r & 3) + 8 * (r >> 2) + 4 * hi; const bool keep = strict ? s_ < r32 : s_ <= r32; acc[r] = keep ? acc[r] : 0.f; }
    }
    return acc;
}
__device__ __forceinline__ void lds_barrier() { asm volatile("s_waitcnt lgkmcnt(0)\n\ts_barrier" ::: "memory"); }
__device__ __forceinline__ void rwkv_chunk_block(Frame& F, int l, int cid, int skip = 0) {
    int lane = F.lane; asm volatile("" : "+v"(lane));
    const unsigned char* ws = F.ws; LAS unsigned char* lds = F.lds;
    const int w = F.wave; const unsigned r32 = lane & 31, hi = lane >> 5;
    unsigned seq0, b, h, dir; int T, c; chunk_decode(cid, seq0, T, b, h, dir, c);
    const int q0 = 64 * c;
#ifndef RA_REP
#define RA_REP 0
#endif
#ifndef PF_NEXT
#define PF_NEXT 1
#endif
    const int role = w >> 1, tb = w & 1;
    const unsigned swo = WS_SMALLW + l * (SMALLW_L * 2);
    if (!(skip & 1)) {
        const int pw_ = w < 4, pb = (w >> 1) & 1, cb = w & 1;
        const int p_ = 32 * pb + r32; const unsigned tokp = seq0 + (dir ? T - 1 - (q0 + p_) : q0 + p_);
        const unsigned xo = (pw_ ? WS_CW : WS_CA) + (tokp * 128 + dir * 64 + 8 * hi) * 2, wo = swo + ((pw_ ? 0 : 49152) + (dir * 384 + h * 64 + 32 * cb + r32) * 64 + 8 * hi) * 2;
        f32x16 acc = {};
#pragma unroll
        for (int ks = 0; ks < 4; ++ks) acc = MFMA32(LDG(bf16x8, ws, xo + 32 * ks), LDG(bf16x8, ws, wo + 32 * ks), acc);
        {
            const float bias = LDG(float, pw_ ? INP(19) : INP(21), ((l * 2 + dir) * 384 + h * 64 + 32 * cb + r32) * 4);
#pragma unroll
            for (int r = 0; r < 16; ++r) { const float sg = sigmf(bias + acc[r]);
                *(LAS float*)(lds + (pw_ ? L_A1 : L_RHS2) + (32 * pb + (r & 3) + 8 * (r >> 2) + 4 * hi) * RPF + (32 * cb + r32) * 4) = pw_ ? -0.606531f * sg : sg; }
        }
        if (dir == 0 && w < 4) {
            f32x16 ag = {};
            const unsigned go = WS_CG + (tokp * 128 + 8 * hi) * 2, gw_ = swo + (98304 + (h * 64 + 32 * cb + r32) * 128 + 8 * hi) * 2;
#pragma unroll
            for (int ks = 0; ks < 8; ++ks) ag = MFMA32(LDG(bf16x8, ws, go + 32 * ks), LDG(bf16x8, ws, gw_ + 32 * ks), ag);
#pragma unroll
            for (int r = 0; r < 16; ++r) { const int pp_ = 32 * pb + (r & 3) + 8 * (r >> 2) + 4 * hi; const unsigned tk = seq0 + q0 + pp_;
                STG(bf16_t, F.ws, WS_G + (tk * 384 + h * 64 + 32 * cb + r32) * 2) = (bf16_t)(pk2(ag[r], 0.f) & 0xffff); }
        }
    }
    lds_barrier();
    if (!(skip & 2)) {
        const unsigned cch = h * 64 + lane;
        const float* convp = INP(18) + (size_t)l * 3 * 1152;
        float cw_[3][3];
#pragma unroll
        for (int tap = 0; tap < 3; ++tap)
#pragma unroll
            for (int seg = 0; seg < 3; ++seg) cw_[tap][seg] = LDG(float, convp, (tap * 1152 + seg * 384 + cch) * 4);
        const float ckk = LDG(float, INP(24), (l * 384 + cch) * 4), cka = LDG(float, INP(25), (l * 384 + cch) * 4), crk = LDG(float, INP(26), (l * 384 + cch) * 4);
        const int tb0 = dir ? T - 1 - (q0 + 8 * w + 7) : q0 + 8 * w;
        float xr[10][3];
#pragma unroll
        for (int rr = 0; rr < 10; ++rr) { const int tr = tb0 - 1 + rr; const bool ok = tr >= 0 && tr < T; const unsigned tk = seq0 + (ok ? tr : tb0);
#pragma unroll
            for (int seg = 0; seg < 3; ++seg) { const float x = bf_lo((unsigned)LDG(bf16_t, ws, WS_RKV + (tk * 1152 + seg * 384 + cch) * 2)); xr[rr][seg] = ok ? x : 0.f; } }
        float lwv[8], kkv[8], btv[8], kdv[8], rv[8], vv[8], g = 0.f;
#pragma unroll
        for (int pp = 0; pp < 8; ++pp) {
            const int rr = 1 + (dir ? 7 - pp : pp); const int p = 8 * w + pp; const unsigned tok = seq0 + (unsigned)(tb0 + rr - 1);
            const float r_ = xr[rr - 1][0] * cw_[0][0] + xr[rr][0] * cw_[1][0] + xr[rr + 1][0] * cw_[2][0];
            const float k_ = xr[rr - 1][1] * cw_[0][1] + xr[rr][1] * cw_[1][1] + xr[rr + 1][1] * cw_[2][1];
            const float v_ = xr[rr - 1][2] * cw_[0][2] + xr[rr][2] * cw_[1][2] + xr[rr + 1][2] * cw_[2][2];
            const float kraw = k_ * ckk; const float n2 = wave_sum(kraw * kraw); const float kk_ = kraw * __builtin_amdgcn_rsqf(fmaxf(n2, 1e-24f));
            const float lw = *(const LAS float*)(lds + L_A1 + p * RPF + lane * 4), av = *(const LAS float*)(lds + L_RHS2 + p * RPF + lane * 4);
            const float kd_ = k_ * (1.f + (av - 1.f) * cka);
            const float bon = wave_sum(r_ * kd_ * crk);
            if (lane == 0) STG(float, F.ws, WS_SB + ((dir * M + tok) * 8 + h) * 4) = bon;
            if (dir == 0) STG(float, F.ws, WS_SV + (tok * 384 + cch) * 4) = v_;
            lwv[pp] = lw; kkv[pp] = kk_; btv[pp] = kk_ * av; kdv[pp] = kd_; rv[pp] = r_; vv[pp] = v_; g += lw;
        }
        g = 0.f;
        for (int wq = 0; wq < w; ++wq) { float t8[8];
#pragma unroll
            for (int e = 0; e < 8; ++e) t8[e] = *(const LAS float*)(lds + L_A1 + (8 * wq + e) * RPF + lane * 4);
            g += ((t8[0] + t8[1]) + (t8[2] + t8[3])) + ((t8[4] + t8[5]) + (t8[6] + t8[7])); }
        unsigned vt[4], kkt[4], btt[4]; float e_pos = __expf(g);
#pragma unroll
        for (int pp = 0; pp < 8; ++pp) {
            const int p = 8 * w + pp;
            const float e_prev = e_pos; g += lwv[pp]; e_pos = __expf(g); const float e_neg = __expf(-g);
            const unsigned pk_kr = pk2(kkv[pp] * e_prev, rv[pp] * e_pos), pk_bk = pk2(btv[pp] * e_neg, kdv[pp] * e_neg), pk_v = pk2(vv[pp], 0.f);
            *(LAS bf16_t*)(lds + L_KT + p * RPB + lane * 2) = (bf16_t)(pk_kr & 0xffff); *(LAS bf16_t*)(lds + L_RT + p * RPB + lane * 2) = (bf16_t)(pk_kr >> 16);
            *(LAS bf16_t*)(lds + L_BT + p * RPB + lane * 2) = (bf16_t)(pk_bk & 0xffff); *(LAS bf16_t*)(lds + L_KK + p * RPB + lane * 2) = (bf16_t)(pk_bk >> 16);
            if (pp & 1) { vt[pp >> 1] |= pk_v << 16; kkt[pp >> 1] |= pk_bk & 0xffff0000u; btt[pp >> 1] |= pk_bk << 16; }
            else { vt[pp >> 1] = pk_v & 0xffff; kkt[pp >> 1] = pk_bk >> 16; btt[pp >> 1] = pk_bk & 0xffff; }
        }
        *(LAS u32x4*)(lds + L_VT + lane * RPB + 16 * w) = (u32x4){vt[0], vt[1], vt[2], vt[3]};
        *(LAS u32x4*)(lds + L_KKT + lane * RPB + 16 * w) = (u32x4){kkt[0], kkt[1], kkt[2], kkt[3]};
        *(LAS u32x4*)(lds + L_BTT + lane * RPB + 16 * w) = (u32x4){btt[0], btt[1], btt[2], btt[3]};
        if (w == 7) *(LAS float*)(lds + L_GC + lane * 4) = e_pos;
    }
    lds_barrier();
    float pf = 0.f;
    f32x16 keep[2]; bf16x8 x4f[2][2];
    if (skip & 4) {} else if (role == 0) {
        for (int sb = 0; sb <= tb; ++sb) { const f32x16 x = gram_tile(lds, L_BT, L_KT, sb, tb, r32, hi, true);
            if (sb == tb) {
#pragma unroll
                for (int r = 0; r < 16; ++r) *(LAS float*)(lds + L_A1 + tb * 4608 + ((r & 3) + 8 * (r >> 2) + 4 * hi) * 144 + r32 * 4) = -x[r];
            } else {
#pragma unroll
                for (int g4 = 0; g4 < 4; ++g4) *(LAS f32x4*)(lds + L_A1 + 9216 + r32 * 144 + (8 * g4 + 4 * hi) * 4) = (f32x4){x[4 * g4], x[4 * g4 + 1], x[4 * g4 + 2], x[4 * g4 + 3]};
            } }
    } else if (role == 1) {
        f32x16 o[2] = {};
        for (int sb = 0; sb <= tb; ++sb) {
            const f32x16 x = gram_tile(lds, L_KK, L_KT, sb, tb, r32, hi, true);
#pragma unroll
            for (int ks = 0; ks < 2; ++ks) { const bf16x8 a = acc_frag(x, ks, 1.f);
#pragma unroll
                for (int ib = 0; ib < 2; ++ib) o[ib] = MFMA32(a, lds_frag_perm(lds + L_VT, 32 * ib + r32, 32 * sb + 16 * ks, hi), o[ib]); }
        }
#pragma unroll
        for (int ib = 0; ib < 2; ++ib)
#pragma unroll
            for (int r = 0; r < 16; ++r) *(LAS float*)(lds + L_RHS2 + (32 * tb + (r & 3) + 8 * (r >> 2) + 4 * hi) * RPF + (32 * ib + r32) * 4) = o[ib][r];
    } else if (role == 2) {
#pragma unroll
        for (int sb = 0; sb < 2; ++sb) { x4f[sb][0] = (bf16x8){}; x4f[sb][1] = (bf16x8){}; }
        keep[0] = (f32x16){}; keep[1] = (f32x16){};
        for (int sb = 0; sb <= tb; ++sb) {
            const f32x16 x3 = gram_tile(lds, L_KK, L_RT, sb, tb, r32, hi, false), x4 = gram_tile(lds, L_BT, L_RT, sb, tb, r32, hi, false);
#pragma unroll
            for (int ks = 0; ks < 2; ++ks) { const bf16x8 a3 = acc_frag(x3, ks, 1.f); const bf16x8 a4 = acc_frag(x4, ks, -1.f);
                if (sb == 0) x4f[0][ks] = a4; else x4f[1][ks] = a4;
#pragma unroll
                for (int cb = 0; cb < 2; ++cb) keep[cb] = MFMA32(a3, lds_frag_perm(lds + L_VT, 32 * cb + r32, 32 * sb + 16 * ks, hi), keep[cb]); }
        }
    } else {
        keep[0] = (f32x16){}; keep[1] = (f32x16){};
#pragma unroll
        for (int ks = 0; ks < 4; ++ks) { const bf16x8 ak = lds_frag_nat(lds + L_KKT, 32 * tb + r32, ks, hi);
#pragma unroll
            for (int cb = 0; cb < 2; ++cb) keep[cb] = MFMA32(ak, lds_frag_nat(lds + L_VT, 32 * cb + r32, ks, hi), keep[cb]); }
    }
    lds_barrier();
    if (!(skip & 8) && w < 2) {
        const LAS unsigned char* a1p = lds + L_A1; asm volatile("" : "+v"(a1p));
        LAS unsigned char* xp = lds + (w == 0 ? L_X0 : L_RHS2) + lane * 4; asm volatile("" : "+v"(xp));
        const LAS unsigned char* kp = lds + L_KT + lane * 2; asm volatile("" : "+v"(kp));
        LAS unsigned char* dst = lds + (w == 0 ? L_WT : L_U0T) + lane * RPB; asm volatile("" : "+v"(dst));
#pragma unroll
        for (int B = 0; B < 2; ++B) {
            float acc[32];
            if (w == 0 && B == 0) {
#pragma unroll
                for (int r = 0; r < 32; ++r) acc[r] = bf_lo((unsigned)*(const LAS bf16_t*)(kp + r * RPB));
            } else {
#pragma unroll
                for (int r = 0; r < 32; ++r) acc[r] = *(const LAS float*)(xp + (32 * B + r) * RPF);
            }
            f32x2 ac2[16];
#pragma unroll
            for (int k = 0; k < 16; ++k) ac2[k] = (f32x2){acc[2 * k], acc[2 * k + 1]};
            f32x4 ca[8], cn[8];
#pragma unroll
            for (int tg = 0; tg < 8; ++tg) ca[tg] = *(const LAS f32x4*)(a1p + B * 4608 + tg * 16);
#pragma unroll
            for (int s_ = 0; s_ < 31; ++s_) {
                if (s_ + 1 < 31) {
#pragma unroll
                    for (int tg = (s_ + 2) / 4; tg < 8; ++tg) cn[tg] = *(const LAS f32x4*)(a1p + B * 4608 + (s_ + 1) * 144 + tg * 16);
                }
                __builtin_amdgcn_sched_barrier(0);
                const float xs = ac2[s_ >> 1][s_ & 1];
                const f32x2 xs2 = {xs, xs};
#pragma unroll
                for (int tg = (s_ + 1) / 4; tg < 8; ++tg) {
                    ac2[2 * tg] = __builtin_elementwise_fma((f32x2){ca[tg][0], ca[tg][1]}, xs2, ac2[2 * tg]);
                    ac2[2 * tg + 1] = __builtin_elementwise_fma((f32x2){ca[tg][2], ca[tg][3]}, xs2, ac2[2 * tg + 1]); }
                __builtin_amdgcn_sched_barrier(0);
#pragma unroll
                for (int tg = 0; tg < 8; ++tg) ca[tg] = cn[tg];
            }
#pragma unroll
            for (int k = 0; k < 16; ++k) { acc[2 * k] = ac2[k][0]; acc[2 * k + 1] = ac2[k][1]; }
#pragma unroll
            for (int k8 = 0; k8 < 4; ++k8) { u32x4 v; v.x = pk2(acc[8 * k8], acc[8 * k8 + 1]); v.y = pk2(acc[8 * k8 + 2], acc[8 * k8 + 3]); v.z = pk2(acc[8 * k8 + 4], acc[8 * k8 + 5]); v.w = pk2(acc[8 * k8 + 6], acc[8 * k8 + 7]);
                *(LAS u32x4*)(dst + 64 * B + 16 * k8) = v; }
            if (B == 0) {
                asm volatile("s_waitcnt lgkmcnt(0)" ::: "memory");
                f32x16 u[2];
#pragma unroll
                for (int cb = 0; cb < 2; ++cb)
#pragma unroll
                    for (int r = 0; r < 16; ++r) { const int t = 32 + (r & 3) + 8 * (r >> 2) + 4 * hi;
                        u[cb][r] = w == 0 ? bf_lo((unsigned)*(const LAS bf16_t*)(lds + L_KT + t * RPB + (32 * cb + r32) * 2)) : *(const LAS float*)(lds + L_RHS2 + t * RPF + (32 * cb + r32) * 4); }
#pragma unroll
                for (int ks = 0; ks < 2; ++ks) { const f32x4 a0 = *(const LAS f32x4*)(lds + L_A1 + 9216 + r32 * 144 + (16 * ks + 8 * hi) * 4), a1 = *(const LAS f32x4*)(lds + L_A1 + 9216 + r32 * 144 + (16 * ks + 8 * hi + 4) * 4);
                    u32x4 aw; aw.x = pk2(-a0[0], -a0[1]); aw.y = pk2(-a0[2], -a0[3]); aw.z = pk2(-a1[0], -a1[1]); aw.w = pk2(-a1[2], -a1[3]);
#pragma unroll
                    for (int cb = 0; cb < 2; ++cb) u[cb] = MFMA32(__builtin_bit_cast(bf16x8, aw), lds_frag_nat(lds + (w == 0 ? L_WT : L_U0T), 32 * cb + r32, ks, hi), u[cb]); }
#pragma unroll
                for (int cb = 0; cb < 2; ++cb)
#pragma unroll
                    for (int r = 0; r < 16; ++r) *(LAS float*)(lds + (w == 0 ? L_X0 : L_RHS2) + (32 + (r & 3) + 8 * (r >> 2) + 4 * hi) * RPF + (32 * cb + r32) * 4) = u[cb][r];
                asm volatile("s_waitcnt lgkmcnt(0)" ::: "memory");
            }
        }
    } else if (PF_NEXT && (w == 2 || w == 3) && cid + F.G < NCHUNK) {
        unsigned s0n, bn, hn, dn; int Tn, cn; chunk_decode(cid + F.G, s0n, Tn, bn, hn, dn, cn);
        const int tlo = dn ? Tn - 64 - 64 * cn : 64 * cn;
        if (w == 2) {
#pragma unroll
            for (int j = 0; j < 4; ++j) { const int idx = lane + 64 * j; if (idx < 198) { int tr = tlo - 1 + idx / 3; tr = tr < 0 ? 0 : (tr >= Tn ? Tn - 1 : tr);
                pf += LDG(float, ws, WS_RKV + ((s0n + tr) * 1152 + (idx % 3) * 384 + hn * 64) * 2); } }
        } else { const unsigned tok = s0n + tlo + lane;
            pf += LDG(float, ws, WS_CW + (tok * 128 + dn * 64) * 2) + LDG(float, ws, WS_CA + (tok * 128 + dn * 64) * 2);
            if (dn == 0) pf += LDG(float, ws, WS_CG + tok * 256) + LDG(float, ws, WS_CG + tok * 256 + 128); }
    }
    lds_barrier();
    if (skip & 16) {} else if (role == 2) {
        f32x16 pj[2];
#pragma unroll
        for (int cb = 0; cb < 2; ++cb)
#pragma unroll
            for (int g = 0; g < 4; ++g) { const u32x2 v = *(const LAS u32x2*)(lds + L_RT + (32 * tb + r32) * RPB + (32 * cb + 8 * g + 4 * hi) * 2);
                pj[cb][4 * g] = bf_lo(v.x); pj[cb][4 * g + 1] = bf_hi(v.x); pj[cb][4 * g + 2] = bf_lo(v.y); pj[cb][4 * g + 3] = bf_hi(v.y); }
#pragma unroll
        for (int sb = 0; sb < 2; ++sb)
#pragma unroll
            for (int ks = 0; ks < 2; ++ks)
#pragma unroll
                for (int cb = 0; cb < 2; ++cb) {
                    keep[cb] = MFMA32(x4f[sb][ks], lds_frag_perm(lds + L_U0T, 32 * cb + r32, 32 * sb + 16 * ks, hi), keep[cb]);
                    pj[cb] = MFMA32(lds_frag_perm(lds + L_WT, 32 * cb + r32, 32 * sb + 16 * ks, hi), x4f[sb][ks], pj[cb]); }
        f32x16 (&y0)[2] = keep;
        const unsigned nc_ = (unsigned)T >> 6, kst = dir ? nc_ - 1 - (unsigned)c : (unsigned)c, yidx = cid < 768 ? (b * 6 + h) * 4 + kst : 384 + (b * 6 + h) * 64 + kst;
        const unsigned ybase = (dir ? WS_YB : WS_YF) + yidx * 16384 + ((dir ? 1 - tb : tb) * 8) * 1024 + (dir ? (lane ^ 32) : lane) * 16;
#pragma unroll
        for (int cb = 0; cb < 2; ++cb)
#pragma unroll
            for (int q = 0; q < 4; ++q) { const f32x4 vf = {y0[cb][4 * q], y0[cb][4 * q + 1], y0[cb][4 * q + 2], y0[cb][4 * q + 3]}, vb = {y0[cb][4 * q + 3], y0[cb][4 * q + 2], y0[cb][4 * q + 1], y0[cb][4 * q]};
                STG(f32x4, F.ws, ybase + (cb * 4 + (dir ? 3 - q : q)) * 1024) = dir ? vb : vf; }
#pragma unroll
        for (int cb = 0; cb < 2; ++cb)
#pragma unroll
            for (int s2 = 0; s2 < 2; ++s2) { u32x4 w; w.x = pk2(pj[cb][8 * s2], pj[cb][8 * s2 + 1]); w.y = pk2(pj[cb][8 * s2 + 2], pj[cb][8 * s2 + 3]); w.z = pk2(pj[cb][8 * s2 + 4], pj[cb][8 * s2 + 5]); w.w = pk2(pj[cb][8 * s2 + 6], pj[cb][8 * s2 + 7]);
                STG(u32x4, F.ws, WS_RP + (unsigned)cid * 8192 + ((tb * 2 + cb) * 2 + s2) * 1024 + lane * 16) = w; }
    } else if (role == 3) {
        const int jb = tb;
        f32x16 q1[2] = {}, q2[2] = {}; f32x16 (&n1)[2] = keep;
#pragma unroll
        for (int ks = 0; ks < 4; ++ks) { const bf16x8 a = lds_frag_nat(lds + L_BTT, 32 * jb + r32, ks, hi);
#pragma unroll
            for (int cb = 0; cb < 2; ++cb) { q1[cb] = MFMA32(lds_frag_nat(lds + L_WT, 32 * cb + r32, ks, hi), a, q1[cb]); q2[cb] = MFMA32(a, lds_frag_nat(lds + L_U0T, 32 * cb + r32, ks, hi), q2[cb]); } }
#pragma unroll
        for (int q = 0; q < 4; ++q) { f32x4 gc4;
#pragma unroll
            for (int e = 0; e < 4; ++e) gc4[e] = *(const LAS float*)(lds + L_GC + (32 * jb + e + 8 * q + 4 * hi) * 4);
#pragma unroll
            for (int cb = 0; cb < 2; ++cb) { f32x4 nv;
#pragma unroll
                for (int e = 0; e < 4; ++e) nv[e] = gc4[e] * (n1[cb][4 * q + e] - q2[cb][4 * q + e]);
                STG(f32x4, F.ws, WS_RN + ((((unsigned)cid * 2 + jb) * 2 + cb) * 4 + q) * 1024 + lane * 16) = nv; } }
        { const float gl = *(const LAS float*)(lds + L_GC + (32 * jb + r32) * 4);
#pragma unroll
          for (int cb = 0; cb < 2; ++cb)
#pragma unroll
            for (int s2 = 0; s2 < 2; ++s2) { float mv[8];
#pragma unroll
                for (int e = 0; e < 8; ++e) { const int r = 8 * s2 + e; const unsigned c = 32 * cb + (r & 3) + 8 * (r >> 2) + 4 * hi; mv[e] = (c == 32 * jb + r32 ? gl : 0.f) - gl * q1[cb][r]; }
                u32x4 w; w.x = pk2(mv[0], mv[1]); w.y = pk2(mv[2], mv[3]); w.z = pk2(mv[4], mv[5]); w.w = pk2(mv[6], mv[7]);
                STG(u32x4, F.ws, WS_RM + (unsigned)cid * 8192 + ((jb * 2 + cb) * 2 + s2) * 1024 + lane * 16) = w; } }
    }
    lds_barrier();
    asm volatile("" :: "v"(pf));
}
__device__ __forceinline__ void rwkv_chain_wave(Frame& F, int l, bool lat, int chain, int ib) {
    int lane = F.lane; asm volatile("" : "+v"(lane));
    const unsigned char* ws = F.ws; const unsigned r32 = lane & 31, hi = lane >> 5;
    const unsigned dir = chain & 1, h = (chain >> 1) % 6, b = chain / 12;
    const int nc = lat ? 64 : 4; const unsigned cid0 = lat ? 768 + chain * 64 : chain * 4;
    const unsigned i = 32 * ib + r32;
    const unsigned so = ((((b * 4 + l) * 6 + h) * 64 + i) * 64) * 4;
    f32x16 H[2];
#pragma unroll
    for (int jb = 0; jb < 2; ++jb)
#pragma unroll
        for (int g4 = 0; g4 < 4; ++g4) { f32x4 v = {0.f, 0.f, 0.f, 0.f}; if (lat) v = LDG(f32x4, dir ? INP(7) : INP(6), so + (32 * jb + 8 * g4 + 4 * hi) * 4);
            H[jb][4 * g4] = v[0]; H[jb][4 * g4 + 1] = v[1]; H[jb][4 * g4 + 2] = v[2]; H[jb][4 * g4 + 3] = v[3]; }
    bf16x8 maA[2][2][2], maB[2][2][2]; f32x16 ntA[2], ntB[2];
    const GAS unsigned char* pm = (const GAS unsigned char*)ws + (WS_RM + cid0 * 8192 + lane * 16);
    const GAS unsigned char* pn = (const GAS unsigned char*)ws + (WS_RN + (cid0 * 4 + ib) * 4096 + lane * 16);
#define RB_LOAD(ma, nt, k_) do { \
        _Pragma("unroll") for (int jo = 0; jo < 2; ++jo) _Pragma("unroll") for (int ji = 0; ji < 2; ++ji) _Pragma("unroll") for (int ks = 0; ks < 2; ++ks) ma[jo][ji][ks] = *(const GAS bf16x8*)(pm + ((k_) * 8192 + ((jo * 2 + ji) * 2 + ks) * 1024)); \
        _Pragma("unroll") for (int jo = 0; jo < 2; ++jo) _Pragma("unroll") for (int q = 0; q < 4; ++q) { const f32x4 t_ = *(const GAS f32x4*)(pn + ((k_) * 16384 + (jo * 8 + q) * 1024)); \
            nt[jo][4 * q] = t_[0]; nt[jo][4 * q + 1] = t_[1]; nt[jo][4 * q + 2] = t_[2]; nt[jo][4 * q + 3] = t_[3]; } } while (0)
#define RB_STEP(ma, nt, cid_) do { \
        bf16x8 hf[2][2]; \
        _Pragma("unroll") for (int ji = 0; ji < 2; ++ji) { hf[ji][0] = acc_frag(H[ji], 0, 1.f); hf[ji][1] = acc_frag(H[ji], 1, 1.f); } \
        _Pragma("unroll") for (int ji = 0; ji < 2; ++ji) _Pragma("unroll") for (int ks = 0; ks < 2; ++ks) STG(bf16x8, F.ws, WS_RH + (cid_) * 8192 + ((ib * 2 + ji) * 2 + ks) * 1024 + lane * 16) = hf[ji][ks]; \
        f32x16 acc[2] = {nt[0], nt[1]}; \
        _Pragma("unroll") for (int jo = 0; jo < 2; ++jo) _Pragma("unroll") for (int ji = 0; ji < 2; ++ji) _Pragma("unroll") for (int ks = 0; ks < 2; ++ks) acc[jo] = MFMA32(ma[jo][ji][ks], hf[ji][ks], acc[jo]); \
        H[0] = acc[0]; H[1] = acc[1]; } while (0)
    RB_LOAD(maA, ntA, 0); RB_LOAD(maB, ntB, 1);
#pragma unroll 1
    for (int c = 0; c < nc; c += 2) {
        const unsigned cid = cid0 + c;
        RB_STEP(maA, ntA, cid);
        if (c + 2 < nc) RB_LOAD(maA, ntA, 2);
        RB_STEP(maB, ntB, cid + 1);
        if (c + 2 < nc) RB_LOAD(maB, ntB, 3);
        pm += 16384; pn += 32768;
    }
#undef RB_LOAD
#undef RB_STEP
    if (!lat) {
#pragma unroll
        for (int jb = 0; jb < 2; ++jb)
#pragma unroll
            for (int g4 = 0; g4 < 4; ++g4) STG(f32x4, F.out, (dir ? OFF_CB : OFF_CF) * 4 + so + (32 * jb + 8 * g4 + 4 * hi) * 4) = (f32x4){H[jb][4 * g4], H[jb][4 * g4 + 1], H[jb][4 * g4 + 2], H[jb][4 * g4 + 3]};
    }
}
__device__ __forceinline__ void rwkv_apply_wave(Frame& F, int item) {
    int lane = F.lane; asm volatile("" : "+v"(lane));
    const unsigned char* ws = F.ws; const unsigned r32 = lane & 31, hi = lane >> 5;
    const int cid = item >> 1, tb = item & 1;
    unsigned seq0, b, h, dir; int T, c; chunk_decode(cid, seq0, T, b, h, dir, c);
    const unsigned yb = dir ? WS_YB : WS_YF;
    f32x16 acc[2];
#pragma unroll
    for (int r = 0; r < 16; ++r) { const int t = 32 * tb + (r & 3) + 8 * (r >> 2) + 4 * hi; const unsigned tok = seq0 + (dir ? T - 1 - (64 * c + t) : 64 * c + t);
        acc[0][r] = LDG(float, ws, yb + (tok * 384 + h * 64 + r32) * 4); acc[1][r] = LDG(float, ws, yb + (tok * 384 + h * 64 + 32 + r32) * 4); }
#pragma unroll
    for (int ks = 0; ks < 4; ++ks) { const bf16x8 a = LDG(bf16x8, ws, WS_RP + (((unsigned)cid * 64 + 32 * tb + r32) * 64 + 16 * ks + 8 * hi) * 2);
#pragma unroll
        for (int ib = 0; ib < 2; ++ib) acc[ib] = MFMA32(a, LDG(bf16x8, ws, WS_RH + (((unsigned)cid * 64 + 32 * ib + r32) * 64 + 16 * ks + 8 * hi) * 2), acc[ib]); }
#pragma unroll
    for (int r = 0; r < 16; ++r) { const int t = 32 * tb + (r & 3) + 8 * (r >> 2) + 4 * hi; const unsigned tok = seq0 + (dir ? T - 1 - (64 * c + t) : 64 * c + t);
        STG(float, F.ws, yb + (tok * 384 + h * 64 + r32) * 4) = acc[0][r]; STG(float, F.ws, yb + (tok * 384 + h * 64 + 32 + r32) * 4) = acc[1][r]; }
}

template <int NI>
__device__ __forceinline__ void rwkv_out_items(Frame& F, int l, int item0, int istep) {
    int lane = F.lane; asm volatile("" : "+v"(lane));
    const unsigned char* ws = F.ws; const unsigned r32 = lane & 31, hi = lane >> 5;
    unsigned cidf[NI], cidb[NI], tok0[NI], tbv[NI], hv[NI];
    f32x16 acc[NI][2];
#pragma unroll
    for (int ni = 0; ni < NI; ++ni) { const int item = item0 + ni * istep;
        const int tb = item & 1, h = (item >> 1) % 6, sk = item / 12;
        const bool lat = sk >= 64; const int b = lat ? (sk - 64) >> 6 : sk >> 2, k = lat ? (sk - 64) & 63 : sk & 3, nc = lat ? 64 : 4;
        const unsigned seq0 = lat ? MC + b * 4096 : b * 256, base = lat ? 768u : 0u;
        const unsigned chf = (b * 6 + h) * 2;
        cidf[ni] = base + chf * nc + k; cidb[ni] = base + (chf + 1) * nc + (nc - 1 - k); tok0[ni] = seq0 + 64 * k + 32 * tb; tbv[ni] = tb; hv[ni] = h;
        const unsigned yo = (lat ? 384 + (b * 6 + h) * 64 + k : (b * 6 + h) * 4 + k) * 16384 + (tb * 8) * 1024 + lane * 16;
#pragma unroll
        for (int ib = 0; ib < 2; ++ib)
#pragma unroll
            for (int q = 0; q < 4; ++q) { const f32x4 yf = LDG(f32x4, ws, WS_YF + yo + (ib * 4 + q) * 1024), yb = LDG(f32x4, ws, WS_YB + yo + (ib * 4 + q) * 1024);
                acc[ni][ib][4 * q] = yf[0] + yb[0]; acc[ni][ib][4 * q + 1] = yf[1] + yb[1]; acc[ni][ib][4 * q + 2] = yf[2] + yb[2]; acc[ni][ib][4 * q + 3] = yf[3] + yb[3]; } }
#pragma unroll
    for (int ks = 0; ks < 4; ++ks)
#pragma unroll
        for (int ni = 0; ni < NI; ++ni) {
            const bf16x8 af = LDG(bf16x8, ws, WS_RP + cidf[ni] * 8192 + (tbv[ni] * 4 + ks) * 1024 + lane * 16), ab = LDG(bf16x8, ws, WS_RP + cidb[ni] * 8192 + ((1 - tbv[ni]) * 4 + ks) * 1024 + ((31 - r32) + 32 * hi) * 16);
#pragma unroll
            for (int ib = 0; ib < 2; ++ib) { acc[ni][ib] = MFMA32(af, LDG(bf16x8, ws, WS_RH + cidf[ni] * 8192 + (ib * 4 + ks) * 1024 + lane * 16), acc[ni][ib]);
                acc[ni][ib] = MFMA32(ab, LDG(bf16x8, ws, WS_RH + cidb[ni] * 8192 + (ib * 4 + ks) * 1024 + lane * 16), acc[ni][ib]); } }
    LAS unsigned char* lw = F.lds + F.wave * 18432;
#pragma unroll
    for (int ni = 0; ni < NI; ++ni)
#pragma unroll
        for (int ib = 0; ib < 2; ++ib)
#pragma unroll
            for (int r = 0; r < 16; ++r) *(LAS float*)(lw + ni * 9216 + ((r & 3) + 8 * (r >> 2) + 4 * hi) * 288 + (32 * ib + r32) * 4) = acc[ni][ib][r];
    const unsigned ts = lane >> 4, dg = lane & 15;
    f32x4 g4[NI], b4[NI];
#pragma unroll
    for (int ni = 0; ni < NI; ++ni) { g4[ni] = LDG(f32x4, INP(27), (l * 384 + hv[ni] * 64 + 4 * dg) * 4); b4[ni] = LDG(f32x4, INP(28), (l * 384 + hv[ni] * 64 + 4 * dg) * 4); }
#pragma unroll 2
    for (int i = 0; i < 8; ++i)
#pragma unroll
        for (int ni = 0; ni < NI; ++ni) { const unsigned h = hv[ni], tk = tok0[ni] + 4 * i + ts, e = tk * 384 + h * 64 + 4 * dg;
            const float bon = LDG(float, ws, WS_SB + (tk * 8 + h) * 4) + LDG(float, ws, WS_SB + ((M + tk) * 8 + h) * 4);
            const f32x4 y = *(const LAS f32x4*)(lw + ni * 9216 + (4 * i + ts) * 288 + dg * 16) + bon * LDG(f32x4, ws, WS_SV + e * 4);
            const float mu = allreduce16((y[0] + y[1]) + (y[2] + y[3])) * (1.f / 64.f);
            const f32x4 d = y - mu;
            const float rs = rsqrtf(allreduce16((d[0] * d[0] + d[1] * d[1]) + (d[2] * d[2] + d[3] * d[3])) * (1.f / 64.f) + 64e-5f);
            const f32x4 o = (d * rs * g4[ni] + b4[ni]) * unpack4(LDG(u32x2, ws, WS_G + e * 2));
            STG(u32x2, F.ws, WS_ACT + (tk * DM + 640 + h * 64 + 4 * dg) * 2) = pack4(o); }
}

#ifndef B_UNIT
#define B_UNIT 0
#endif
constexpr int AU_R = 8, AU_D = 4, AU_SLOT = 6144;
__device__ __forceinline__ void attn_b_unit(Frame& F, int l, int unit) {
    int lane = F.lane; asm volatile("" : "+v"(lane));
    const unsigned char* ws = F.ws; LAS unsigned char* lds = F.lds;
    const int w = F.wave; const unsigned r32 = lane & 31, hi = lane >> 5;
    const unsigned kh = unit & 1, qb = (unit >> 1) & 15, mp = (unit >> 5) & 1, h = (unit >> 6) & 3, b = unit >> 8;
    const unsigned seq0 = MC + b * 4096, row = seq0 + qb * 256 + 32 * w + r32;
    bf16x8 qf[1][2];
#pragma unroll
    for (int s = 0; s < 2; ++s) qf[0][s] = LDG(bf16x8, ws, WS_QB + (row * 256 + h * 64 + mp * 32 + 8 * hi) * 2 + 32 * s);
    AttnQ st[1]; attnq_init(st[0], 0.f);
    const int qpos[1] = {0};
    const int n0 = kh ? 56 : 72, nt = 72;
    const unsigned pofs = (w < 2 ? (h * 2 + mp) * 2048 + w * 1024 : h * 4096 + (w - 2) * 1024) + lane * 16;
    const unsigned base0 = (w < 2 ? WS_KB : WS_VTB) + ((seq0 >> 5) + (kh ? 72u : 0u)) * 16384 + pofs;
    const unsigned base1 = WS_CACHE + (w < 2 ? 2 * MiB : 4 * MiB) + (b * 4 + l) * 262144 + pofs;
#define AU_DMA(t_) do { const int tt_ = (t_) < nt ? (t_) : nt - 1; const unsigned src_ = tt_ < n0 ? base0 + tt_ * 16384 : base1 + (tt_ - n0) * 16384; \
        __builtin_amdgcn_global_load_lds((const GAS unsigned*)(ws + src_), (LAS unsigned*)(lds + ((t_) % AU_R) * AU_SLOT + w * 1024), 16, 0, 0); } while (0)
    if (w < 6) {
#pragma unroll
        for (int t = 0; t < AU_D; ++t) AU_DMA(t);
    }
    for (int t = 0; t < nt; ++t) {
        if (w < 6) asm volatile("s_waitcnt vmcnt(3)" ::: "memory");
        asm volatile("s_barrier" ::: "memory");
        const LAS unsigned char* sl = lds + (t % AU_R) * AU_SLOT + lane * 16;
        bf16x8 kf[2], vf[4];
        kf[0] = *(const LAS bf16x8*)(sl); kf[1] = *(const LAS bf16x8*)(sl + 1024);
#pragma unroll
        for (int f = 0; f < 4; ++f) vf[f] = *(const LAS bf16x8*)(sl + 2048 + 1024 * f);
        if (w < 6) AU_DMA(t + AU_D);
        attn_block<32, false, 1>(qf, kf, vf, st, t, qpos, 0, hi);
    }
#undef AU_DMA
    asm volatile("s_waitcnt vmcnt(0) lgkmcnt(0)\n\ts_barrier" ::: "memory");
    attn_b_store(F, st[0], mp, kh, row, h, hi);
}

constexpr int Q_BLAT = 2048, Q_ALAT = 1536, Q_BCTX = 1024, Q_ACTX = 768;
constexpr int Q_TOTAL = Q_BLAT + Q_ALAT + Q_BCTX + Q_ACTX;
#ifndef XCD_DEAL
#define XCD_DEAL 1
#endif
__device__ __forceinline__ void phase_mixer(Frame& F, int l, int rep) {
    if (rep == 0 || REP_PART == 0 || REP_PART == 1) {
        const int si = F.bid + F.G * F.wave;
        if (si < 48) rwkv_chain_wave(F, l, true, si >> 1, si & 1);
        else if (si < 48 + 384) rwkv_chain_wave(F, l, false, (si - 48) >> 1, (si - 48) & 1);
    }
    if (B_UNIT && (rep == 0 || REP_PART == 2 || REP_PART == 4)) {
        unsigned* uctr = (unsigned*)(F.ws + WS_CTL) + 64 * (32 + l + 4 * (rep + F.crep));
        LAS int* ubox = (LAS int*)(F.lds + 65536);
        for (;;) {
            if (F.wave == 0 && F.lane == 0) *ubox = (int)atomicAdd(uctr, 1u);
            lds_barrier();
            const int un = __builtin_amdgcn_readfirstlane(*ubox);
            lds_barrier();
            if (un >= 512) break;
            attn_b_unit(F, l, un);
        }
    }
    unsigned* ctr = (unsigned*)(F.ws + WS_CTL) + 64 * (1 + l + 4 * (rep + F.crep));
    const bool xdeal = XCD_DEAL && !B_UNIT && F.G == 256;
    if (xdeal && (rep == 0 || REP_PART == 2 || REP_PART == 4)) attn_b_item(F, l, true, (F.bid & 7) * 256 + (F.bid >> 3) * 8 + F.wave);
    unsigned* cx = (unsigned*)(F.ws + WS_CTL) + 8192 + ((l + 4 * (rep + F.crep)) * 8 + (F.bid & 7)) * 64;
    bool xq = xdeal;
    if (rep == 0 || REP_PART != 1) for (;;) {
        int it = 0;
        if (F.lane == 0) it = (int)atomicAdd(xq ? cx : ctr, 1u);
        it = __builtin_amdgcn_readfirstlane(it);
        if (xq) { if (it >= 192) { xq = false; continue; }
            const int x = F.bid & 7; it = Q_BLAT + (((x >> 2) * 6 + ((x >> 1) & 1) * 3 + it / 64) * 128 + (x & 1) * 64 + it % 64); }
        else it += xdeal ? Q_BLAT + Q_ALAT : (B_UNIT ? Q_BLAT : 0);
        if (it >= Q_TOTAL) break;
        if (it < Q_BLAT) { if (rep == 0 || REP_PART == 2 || REP_PART == 4) attn_b_item(F, l, true, it); continue; } it -= Q_BLAT;
        if (it < Q_ALAT) { if (rep == 0 || REP_PART == 2 || REP_PART == 3) attn_a_item(F, l, true, it); continue; } it -= Q_ALAT;
        if (it < Q_BCTX) { if (rep == 0 || REP_PART == 2 || REP_PART == 5) attn_b_item(F, l, false, it); continue; } it -= Q_BCTX;
        if (rep == 0 || REP_PART == 2 || REP_PART == 5) attn_a_item(F, l, false, it);
    }
}

#ifndef FIN_R2
#define FIN_R2 1
#endif
__device__ __forceinline__ void phase_finalize(Frame& F, int l, int rep) {
    const unsigned char* ws = F.ws;
    int lane = F.lane; asm volatile("" : "+v"(lane));
    const float lami = 0.8f - 0.6f * __expf(-0.3f * (float)l);
    const float lam = LDG(float, ws, WS_TAB + (TAB_LAM + l) * 4) + lami;
    const float omli = 1.f - lami;
    const unsigned hk = lane >> 4, dg = lane & 15;
    const f32x4 sg = LDG(f32x4, INP(17), (l * 64 + 4 * dg) * 4) * omli;
    const unsigned nw2 = (F.ngw < 2304 && 2 * F.ngw > 2304 + 64) ? 2304 - F.ngw : 0, npair = M / 2;
    const unsigned n2 = nw2 * FIN_R2;
    unsigned p = (unsigned)F.gw < nw2 ? F.gw : n2 + (F.gw - nw2);
    const unsigned pe = (unsigned)F.gw < nw2 ? n2 : npair, ps = (unsigned)F.gw < nw2 ? nw2 : F.ngw - nw2;
    for (; p < pe; p += ps) {
        const unsigned r0 = 2 * p;
#pragma unroll
        for (int rr = 0; rr < 2; ++rr) { const unsigned row = r0 + rr; f32x4 om[2];
#pragma unroll
            for (int mp = 0; mp < 2; ++mp) { const unsigned o0 = (((mp * 2) * M + row) * 256 + 64 * hk + 4 * dg) * 2, q0 = ((((mp * 2) * M + row) * 4 + hk) * 2) * 4;
                const f32x2 ml0 = LDG(f32x2, ws, WS_ML + q0);
                if (row >= (unsigned)MC) { const f32x2 ml1 = LDG(f32x2, ws, WS_ML + q0 + M * 32); const float ms = fmaxf(ml0[0], ml1[0]), w0 = __builtin_amdgcn_exp2f(ml0[0] - ms), w1 = __builtin_amdgcn_exp2f(ml1[0] - ms);
                    om[mp] = (unpack4(LDG(u32x2, ws, WS_BO2 + o0)) * w0 + unpack4(LDG(u32x2, ws, WS_BO2 + o0 + M * 512)) * w1) * __builtin_amdgcn_rcpf(ml0[1] * w0 + ml1[1] * w1); }
                else om[mp] = unpack4(LDG(u32x2, ws, WS_BO2 + o0)) * __builtin_amdgcn_rcpf(ml0[1]); }
            const f32x4 v = om[0] - lam * om[1];
            const float ms = allreduce16((v[0] * v[0] + v[1] * v[1]) + (v[2] * v[2] + v[3] * v[3])) * (1.f / 64.f);
            STG(u32x2, F.ws, WS_ACT + (row * DM + 384 + 64 * hk + 4 * dg) * 2) = pack4(v * rsqrtf(ms + 1e-6f) * sg); }
    }
}


typedef unsigned v4u __attribute__((ext_vector_type(4)));
#define XB_TMO      128
#define XB_XCNT(j)  (256  + 64 * (j))
#define XB_XSUB(j)  (1280 + 64 * (j))
#define XB_XGEN(j)  (2304 + 64 * (j))
#define XB_TOP      3328
#define XB_TOPGEN   3392
#define XCD_BAR_WORDS 3456
#define XB_SPIN_CAP (1u << 18)

__device__ __forceinline__ unsigned xb_ld(unsigned* p)              { return __hip_atomic_load(p, __ATOMIC_RELAXED, __HIP_MEMORY_SCOPE_AGENT); }
__device__ __forceinline__ unsigned xb_add(unsigned* p, unsigned v) { return __hip_atomic_fetch_add(p, v, __ATOMIC_RELAXED, __HIP_MEMORY_SCOPE_AGENT); }
__device__ __forceinline__ unsigned xb_xcc_id() { return (unsigned)__builtin_amdgcn_s_getreg((3 << 11) | 20) & 0xFu; }
#define XB_SPIN(cond, bar) do { unsigned _sp = 0; while (cond) { __builtin_amdgcn_s_sleep(1); \
    if ((++_sp & 255u) == 0u) { if (xb_ld(&(bar)[XB_TMO])) break; if (_sp > XB_SPIN_CAP) { atomicAdd(&(bar)[XB_TMO], 1u); break; } } } } while (0)

struct XcdBarrier {
    unsigned* bar; unsigned x;
    volatile LAS unsigned* st;
};

__device__ __forceinline__ XcdBarrier xcd_barrier_post(unsigned* bar, volatile LAS unsigned* st) {
    XcdBarrier b; b.bar = bar; b.x = xb_xcc_id(); b.st = st;
    if (threadIdx.x == 0) (void)xb_add(&bar[XB_XCNT(b.x)], 1u);
    return b;
}
__device__ __forceinline__ void xcd_barrier_complete(unsigned* bar, unsigned x, unsigned& nloc, unsigned& nx) {
    const unsigned G = gridDim.x * gridDim.y * gridDim.z;
    unsigned sum, cnt, mine, sp = 0u;
    for (;;) {
        sum = 0u; cnt = 0u; mine = 0u;
#pragma unroll
        for (unsigned j = 0; j < 16; ++j) { const unsigned c = xb_ld(&bar[XB_XCNT(j)]); sum += c; cnt += (c > 0u) ? 1u : 0u; mine = (j == x) ? c : mine; }
        if (sum == G) break;
        __builtin_amdgcn_s_sleep(1);
        if ((++sp & 255u) == 0u) { if (xb_ld(&bar[XB_TMO])) break; if (sp > XB_SPIN_CAP) { atomicAdd(&bar[XB_TMO], 1u); break; } }
    }
    nloc = mine > 0u ? mine : 1u; nx = cnt > 0u ? cnt : 1u;
}

__device__ __forceinline__ void xcd_barrier(const XcdBarrier& b) {
    asm volatile("s_waitcnt vmcnt(0)" ::: "memory");
    __syncthreads();
    if (threadIdx.x == 0) {
        unsigned* bar = b.bar;
        __builtin_amdgcn_s_waitcnt(0);
        unsigned nloc = b.st[0], nx = b.st[1];
        if (nloc == 0u) { xcd_barrier_complete(bar, b.x, nloc, nx); b.st[0] = nloc; b.st[1] = nx; }
        const unsigned old = xb_add(&bar[XB_XSUB(b.x)], 1u);
        const unsigned gen = old / nloc;
        if (old + 1u == (gen + 1u) * nloc) {
            __builtin_amdgcn_fence(__ATOMIC_RELEASE, "agent");
            asm volatile("s_waitcnt vmcnt(0)" ::: "memory");
            const unsigned og = xb_add(&bar[XB_TOP], 1u);
            const unsigned tg = og / nx;
            if (og + 1u == (tg + 1u) * nx) xb_add(&bar[XB_TOPGEN], 1u);
            else XB_SPIN(xb_ld(&bar[XB_TOPGEN]) == tg, bar);
            __builtin_amdgcn_fence(__ATOMIC_ACQUIRE, "agent");
            xb_add(&bar[XB_XGEN(b.x)], 1u);
            asm volatile("s_waitcnt vmcnt(0)" ::: "memory");
        } else {
            XB_SPIN(xb_ld(&bar[XB_XGEN(b.x)]) == gen, bar);
            __builtin_amdgcn_fence(__ATOMIC_ACQUIRE, "agent");
            asm volatile("s_waitcnt vmcnt(0)" ::: "memory");
        }
    }
    __syncthreads();
}

#ifndef DIS
#define DIS 0
#endif
#ifndef OUT_NI2
#define OUT_NI2 0
#endif
#ifndef GEMM_MF
#define GEMM_MF 7
#endif
#ifndef REP_PHASE
#define REP_PHASE -1
#define REP_COUNT 1
#endif
constexpr int NEXTRA = (REP_PHASE >= 0 && REP_PHASE < 9) ? REP_COUNT - 1 : 0, NPL = 9 + NEXTRA, NPRE = (REP_PHASE == 100) ? REP_COUNT : 1, NFWD = (REP_PHASE == 200) ? REP_COUNT : 1, NPHASE_RUN = NPRE + 1 + NPL * DEPTH * NFWD;
__global__ void __launch_bounds__(512, 2) mega(Args a) {
    extern __shared__ __attribute__((aligned(16))) unsigned char lds[];
    Frame F; F.crep = 0;
    F.lds = (LAS unsigned char*)lds;
    volatile LAS unsigned* bst = (volatile LAS unsigned*)(F.lds + LDS_BYTES - 64);
    if (threadIdx.x < 2) bst[threadIdx.x] = 0u;
    __syncthreads();
    const XcdBarrier xbar = xcd_barrier_post((unsigned*)((GAS unsigned char*)a.ws + WS_CTL) + 4096, bst);
    const int wave_id = __builtin_amdgcn_readfirstlane((int)threadIdx.x >> 6);
    for (int ph = a.ph_lo; ph < a.ph_hi; ++ph) {
        { const unsigned char* kp = (const unsigned char*)__builtin_amdgcn_kernarg_segment_ptr(); asm volatile("" : "+s"(kp));
          const Args* ap = (const Args*)kp; F.in = ap->in; F.out = gptr(ap->out); F.ws = gptr(ap->ws); }
        { unsigned ones = ~0u; asm volatile("" : "+s"(ones)); int ln = (int)__builtin_amdgcn_mbcnt_hi(ones, __builtin_amdgcn_mbcnt_lo(ones, 0u)); int wv = wave_id, bid = (int)blockIdx.x, gg = (int)gridDim.x; asm volatile("" : "+s"(wv), "+s"(bid), "+s"(gg));
          F.lane = ln; F.wave = wv; F.bid = bid; F.G = gg; F.ngw = gg * 8; F.tid = wv * 64 + ln; F.gw = bid * 8 + wv; }
        if (ph < NPRE) { if (!(DIS & 1)) phase_prologue(F); }
        else if (ph == NPHASE_RUN - 1) { if (!(DIS & 2)) phase_final_norm(F); }
        else {
            const int fwd_ = (ph - NPRE) / (NPL * DEPTH); F.crep = fwd_; const int l = ((ph - NPRE) / NPL) % DEPTH, sidx = (ph - NPRE) % NPL, rep = (REP_PHASE == 200) ? 0 : (REP_PHASE >= 0 && REP_PHASE < 9 && sidx > REP_PHASE && sidx <= REP_PHASE + NEXTRA) ? sidx - REP_PHASE : 0, s = (REP_PHASE >= 0 && REP_PHASE < 9 && sidx > REP_PHASE) ? (sidx <= REP_PHASE + NEXTRA ? REP_PHASE : sidx - NEXTRA) : sidx;
            if (s == 0) { convert_weights(F, l); phase_norm(F, l, 0); }
            else if (s == 1) {
                pg8::Gemm g{WSP(bf16_t, WS_ACT), WSP(bf16_t, WS_WIN + 0u * WSET_STRIDE), M, NIN, 1024}; pg8::StaticOrder S; S.init(M, NIN, F.G, F.bid, (GEMM_MF & 1) ? 192 : 256);
                EpiWin E{F.ws, F.out, l, F.lds + pg8::STAGE_BYTES, REP_PART == 9 && rep > 0};
                if (!(DIS & 16)) pg8::gemm_phase<EpiWin, pg8::StaticOrder, false, true, (GEMM_MF & 1) ? 3 : 4>(F.lds, g, S, E, F.tid);
                if (false) { const int wv_ = (F.bid - 64) * 8 + F.wave; convert_item_any(F, l + 1, wv_); if (wv_ < CV_TOTAL - 1536) convert_item_any(F, l + 1, 1536 + wv_); }
            }
            else if (s == 2) { const int skipm = (REP_PHASE == 2 && NEXTRA > 0 && sidx < REP_PHASE + NEXTRA) ? RA_REP : 0; for (int cid = F.bid; cid < NCHUNK; cid += F.G) rwkv_chunk_block(F, l, cid, skipm); }
            else if (s == 3) { if (!(DIS & 64)) phase_mixer(F, l, rep); }
            else if (s == 4) { if (rep == 0 || REP_PART != 6) { if (OUT_NI2 && F.gw + F.ngw < 192 * 12 && F.gw + 2 * F.ngw >= 192 * 12) rwkv_out_items<2>(F, l, F.gw, F.ngw); else for (int it = F.gw; it < 192 * 12; it += F.ngw) rwkv_out_items<1>(F, l, it, 0); } if (rep == 0 || REP_PART != 7) phase_finalize(F, l, rep); }
            else if (s == 5 || s == 8) {
                const bool second = s == 8;
                pg8::Gemm g{second ? WSP(bf16_t, WS_U) : WSP(bf16_t, WS_ACT), second ? WSP(bf16_t, WS_W2 + 0u * WSET_STRIDE) : WSP(bf16_t, WS_WOUT + 0u * WSET_STRIDE), M, 1024, second ? FF : 1024};
                pg8::StaticOrder S; S.init(M, 1024, F.G, F.bid, (GEMM_MF & 2) ? 192 : 256);
                const bool first = (l == 0 && !second);
                EpiRes E{INP(0), INP(1) - (size_t)MC * DM, F.ws, WSP(float, WS_MOD) + (size_t)l * 3 * 6144 + (second ? 5120 : 2048), first, rep ? WS_BO : WS_XB, REP_PART == 9 && rep > 0};
                if (M / ((GEMM_MF & 2) ? 192 : 256) * 4 <= F.G) { EpiResD ED; static_cast<EpiRes&>(ED) = E; pg8::gemm_phase<EpiResD, pg8::StaticOrder, false, true, (GEMM_MF & 2) ? 3 : 4>(F.lds, g, S, ED, F.tid); }
                else pg8::gemm_phase<EpiRes, pg8::StaticOrder, false, true, (GEMM_MF & 2) ? 3 : 4>(F.lds, g, S, E, F.tid);
            }
            else if (s == 6) { if (!(DIS & 8)) phase_norm(F, l, 1); }
            else {
                pg8::Gemm g{WSP(bf16_t, WS_ACT), WSP(bf16_t, WS_W13 + 0u * WSET_STRIDE), M, NFF2, 1024}; pg8::StaticOrder S; S.init(M, NFF2, F.G, F.bid, (GEMM_MF & 4) ? 192 : 256);
                EpiSwi E{WSP(bf16_t, WS_U), REP_PART == 9 && rep > 0};
                if (!(DIS & 512)) pg8::gemm_phase<EpiSwi, pg8::StaticOrder, true, true, (GEMM_MF & 4) ? 3 : 4>(F.lds, g, S, E, F.tid);
            }
        }
        if (ph + 1 < a.ph_hi) { if (ph == a.ph_lo) { __threadfence(); cg::this_grid().sync(); } else xcd_barrier(xbar); }
    }
}

extern "C" void kernel_launch(void* const* d_in, const int* in_sizes, int n_in, void* d_out, int out_size, void* d_ws, size_t ws_size, hipStream_t stream) {
    static int grid = 0;
    if (grid == 0) {
        int dev = 0, cus = 0, per_cu = 0;
        if (n_in != 34 || ws_size < WS_END) { fprintf(stderr, "kernel_launch: unexpected n_in %d / ws_size %zu (need %zu)\n", n_in, ws_size, (size_t)WS_END); grid = -1; return; }
        if (hipGetDevice(&dev) != hipSuccess || hipDeviceGetAttribute(&cus, hipDeviceAttributeMultiprocessorCount, dev) != hipSuccess) { grid = -1; return; }
        if (hipFuncSetAttribute((const void*)mega, hipFuncAttributeMaxDynamicSharedMemorySize, LDS_BYTES) != hipSuccess) { fprintf(stderr, "kernel_launch: hipFuncSetAttribute failed\n"); grid = -1; return; }
        if (hipOccupancyMaxActiveBlocksPerMultiprocessor(&per_cu, (const void*)mega, 512, LDS_BYTES) != hipSuccess || per_cu < 1) { fprintf(stderr, "kernel_launch: occupancy query says %d\n", per_cu); per_cu = 1; }
        (void)hipGetLastError();
        grid = cus * 1;
        if (grid > cus * per_cu) grid = cus * per_cu;
    }
    if (grid < 0) return;
    (void)hipMemsetAsync((char*)d_ws + WS_CTL, 0, CTL_BYTES, stream);
    Args a{};
    for (int i = 0; i < 34; ++i) a.in[i] = (const float*)d_in[i];
    a.out = (float*)d_out; a.ws = (unsigned char*)d_ws;
#if MK_ONE_LAUNCH
    a.ph_lo = 0; a.ph_hi = NPHASE_RUN;
    void* args[] = {&a};
    hipError_t e = hipLaunchCooperativeKernel((const void*)mega, dim3(grid), dim3(512), args, LDS_BYTES, stream);
    if (e != hipSuccess) fprintf(stderr, "kernel_launch: cooperative launch failed: %s (grid %d)\n", hipGetErrorString(e), grid);
#else
    for (int ph = 0; ph < NPHASE_RUN; ++ph) { a.ph_lo = ph; a.ph_hi = ph + 1; hipLaunchKernelGGL(mega, dim3(grid), dim3(512), LDS_BYTES, stream, a); }
#endif
}
```
